# Optimizing an MI355X kernel written in HIP

```python
import jax, jax.numpy as jnp
from jax import lax
import numpy as np

D_MODEL = 1024
BATCH = 32
SEQ = 256
DEPTH = 2
DEC_BATCH = 2
DEC_SEQ = 4096
PAST_LEN = 256

GRID_W = 64
CONV_W = 3
M_WIDTH = D_MODEL // 2
M_HEADS = 4
M_HEAD_DIM = M_WIDTH // M_HEADS
M_CHUNK = 64
R_WIDTH = D_MODEL // 2
R_HEAD_DIM = 64
R_HEADS = R_WIDTH // R_HEAD_DIM
W_LORA = 64
A_LORA = 64
G_LORA = 128
R_IN = 3 * R_WIDTH + 2 * W_LORA + 2 * A_LORA + G_LORA
FFN_HIDDEN = -(-(8 * D_MODEL) // (3 * 256)) * 256
IN_SIZES = (2 * M_WIDTH, M_WIDTH, M_WIDTH, 4 * M_HEADS, R_IN, 2 * D_MODEL)
P_IN = 2 * M_WIDTH + M_WIDTH + M_WIDTH + 4 * M_HEADS + R_IN + 2 * D_MODEL
RMS_EPS = 1e-6
GN_EPS = 64e-5

kernel_name = 'hybrid_mlstm_rwkv7_diffusion_step'


def _heads(x, n_heads):
    return x.reshape(x.shape[0], x.shape[1], n_heads, -1)


def _flat(x):
    return x.reshape(x.shape[0], x.shape[1], -1)


def _flip(x):
    return jnp.flip(x, axis=1)


def _split(x, sizes):
    return jnp.split(x, [int(s) for s in np.cumsum(sizes)[:-1]], axis=-1)


def rmsnorm(x, g):
    xf = x.astype(jnp.float32)
    y = xf * lax.rsqrt(jnp.mean(xf * xf, axis=-1, keepdims=True) + RMS_EPS)
    return (y * g.astype(jnp.float32)).astype(x.dtype)


def dwconv(x, w, grid):
    B, T, C = x.shape
    w = w.astype(x.dtype)
    if grid:
        rows = T // GRID_W
        y = lax.conv_general_dilated(x.reshape(B, rows, GRID_W, C), w[:, :, None, :], (1, 1), 'SAME',
                                     dimension_numbers=('NHWC', 'HWIO', 'NHWC'), feature_group_count=C)
    else:
        y = lax.conv_general_dilated(x, w[CONV_W // 2][:, None, :], (1,), 'SAME',
                                     dimension_numbers=('NWC', 'WIO', 'NWC'), feature_group_count=C)
    return y.reshape(B, T, C)


def mlstm_chunkwise(q, k, v, ig, lf, C0, n0, m0):
    f32 = jnp.float32
    B, T, H, Dh = q.shape
    nc = T // M_CHUNK

    def blocks(a):
        a = a.astype(f32).reshape((B, nc, M_CHUNK, H) + a.shape[3:])
        return jnp.swapaxes(jnp.swapaxes(a, 0, 1), 2, 3)

    mask = jnp.tril(jnp.ones((M_CHUNK, M_CHUNK), dtype=bool))

    def step(carry, inp):
        C, n, m = carry
        qc, kc, vc, ic, fc = inp
        b = jnp.cumsum(fc, axis=-1)
        logw = jnp.where(mask, b[..., :, None] - b[..., None, :] + ic[..., None, :], -jnp.inf)
        inter = b + m[..., None]
        mt = jnp.maximum(inter, jnp.max(logw, axis=-1))
        w = jnp.exp(logw - mt[..., None])
        wi = jnp.exp(inter - mt)
        s = jnp.einsum('bhtd,bhsd->bhts', qc, kc) * w
        num = jnp.einsum('bhts,bhsd->bhtd', s, vc) + wi[..., None] * jnp.einsum('bhtd,bhde->bhte', qc, C)
        den = jnp.sum(s, axis=-1) + wi * jnp.einsum('bhtd,bhd->bht', qc, n)
        h = num / jnp.maximum(jnp.abs(den), jnp.exp(-mt))[..., None]
        bl = b[..., -1:]
        le = bl - b + ic
        ie = bl[..., 0] + m
        mn = jnp.maximum(ie, jnp.max(le, axis=-1))
        we = jnp.exp(le - mn[..., None])
        wie = jnp.exp(ie - mn)
        C = wie[..., None, None] * C + jnp.einsum('bhs,bhsd,bhse->bhde', we, kc, vc)
        n = wie[..., None] * n + jnp.einsum('bhs,bhsd->bhd', we, kc)
        return (C, n, mn), h

    xs = tuple(blocks(a) for a in (q, k, v, ig, lf))
    (C, n, m), h = lax.scan(step, (C0.astype(f32), n0.astype(f32), m0.astype(f32)), xs)
    h = jnp.swapaxes(jnp.swapaxes(h, 2, 3), 0, 1).reshape(B, T, H, Dh)
    return h, C, n, m


def rwkv7_scan(r, decay, k, v, a_vec, b_vec, S0):
    f32 = jnp.float32
    xs = tuple(jnp.moveaxis(t.astype(f32), 1, 0) for t in (r, decay, k, v, a_vec, b_vec))

    def step(S, inp):
        r_t, w_t, k_t, v_t, a_t, b_t = inp
        sa = jnp.einsum('bhvk,bhk->bhv', S, a_t)
        S = S * w_t[:, :, None, :] + sa[..., None] * b_t[:, :, None, :] + v_t[..., None] * k_t[:, :, None, :]
        return S, jnp.einsum('bhvk,bhk->bhv', S, r_t)

    S, y = lax.scan(step, S0.astype(f32), xs)
    return jnp.moveaxis(y, 0, 1), S


def token_mixer(h, p, grid, st):
    f32 = jnp.float32
    B, T, _ = h.shape
    u = h @ p['w_in']
    u_qk, u_v, u_o, u_gate, u_r, u_merge = _split(u, IN_SIZES)

    qk = jax.nn.silu(dwconv(u_qk, p['m_conv'], grid))
    q, k = jnp.split(qk, 2, axis=-1)
    q = _heads(q, M_HEADS) * (M_HEAD_DIM ** -0.5)
    k = _heads(k, M_HEADS)
    v = _heads(u_v, M_HEADS)
    g = u_gate.astype(f32).reshape(B, T, 4, M_HEADS) + p['m_gate_b'].astype(f32)
    hf, Cf, nf, mf = mlstm_chunkwise(q, k, v, g[:, :, 0], jax.nn.log_sigmoid(g[:, :, 1]), st[0], st[1], st[2])
    hb, Cb, nb, mb = mlstm_chunkwise(_flip(q), _flip(k), _flip(v), _flip(g[:, :, 2]),
                                     _flip(jax.nn.log_sigmoid(g[:, :, 3])), st[3], st[4], st[5])
    hm = hf + _flip(hb)
    hm = hm * lax.rsqrt(jnp.mean(hm * hm, axis=-1, keepdims=True) + RMS_EPS)
    hm = (_flat(hm) * p['m_norm_g'].astype(f32) * jax.nn.sigmoid(u_o.astype(f32))).astype(h.dtype)

    rx = dwconv(u_r, p['r_conv'], grid)
    r, kr, vr, wl_f, wl_b, al_f, al_b, gl = _split(rx, (R_WIDTH, R_WIDTH, R_WIDTH, W_LORA, W_LORA, A_LORA, A_LORA, G_LORA))
    kk = _heads((kr * p['r_kk']).astype(f32), R_HEADS)
    kk = kk / jnp.maximum(jnp.linalg.norm(kk, axis=-1, keepdims=True), 1e-12)
    kk_flat = _flat(kk)
    ys, Ss = [], []
    for d, (wl, al) in enumerate(((wl_f, al_f), (wl_b, al_b))):
        w_raw = (p['r_w0'][d] + jnp.tanh(wl) @ p['r_w2'][d]).astype(f32)
        decay = jnp.exp(-jnp.exp(-jax.nn.softplus(-w_raw) - 0.5))
        a = jax.nn.sigmoid((p['r_a0'][d] + al @ p['r_a2'][d]).astype(f32))
        ktil = kr.astype(f32) * (1.0 + (a - 1.0) * p['r_ka'].astype(f32))
        args = [_heads(t, R_HEADS) for t in (r, decay, ktil, vr, -kk_flat, kk_flat * a)]
        if d == 1:
            args = [_flip(t) for t in args]
        y, S = rwkv7_scan(*args, st[6 + d])
        ys.append(_flip(y) if d == 1 else y)
        Ss.append(S)
    y = ys[0] + ys[1]
    mu = jnp.mean(y, axis=-1, keepdims=True)
    var = jnp.mean(jnp.square(y - mu), axis=-1, keepdims=True)
    yn = _flat((y - mu) * lax.rsqrt(var + GN_EPS)) * p['r_gn_w'].astype(f32) + p['r_gn_b'].astype(f32)
    rk = p['r_rk'].astype(f32).reshape(R_HEADS, R_HEAD_DIM)
    r_h, k_h, v_h = (_heads(t.astype(f32), R_HEADS) for t in (r, kr, vr))
    bonus = _flat(jnp.sum(r_h * k_h * rk, axis=-1, keepdims=True) * v_h)
    gate = jax.nn.sigmoid(gl) @ p['r_g2']
    hr = ((yn + bonus) * gate).astype(h.dtype)

    gm, gr = jnp.split(u_merge, 2, axis=-1)
    merged = jax.nn.sigmoid(gm) * (hm @ p['proj_m']) + jax.nn.sigmoid(gr) * (hr @ p['proj_r'])
    return merged @ p['w_out'], (Cf, nf, mf, Cb, nb, mb, Ss[0], Ss[1])


def swiglu(h, w1, w3, w2):
    return (jax.nn.silu(h @ w1) * (h @ w3)) @ w2


def trunk_layer(x, mod, p, grid, st):
    sh1, sc1, g1, sh2, sc2, g2 = jnp.split(mod, 6, axis=-1)
    h = rmsnorm(x, p['norm1_g']) * (1 + sc1) + sh1
    mix, st_new = token_mixer(h, p, grid, st)
    x = x + g1 * mix
    h = rmsnorm(x, p['norm2_g']) * (1 + sc2) + sh2
    x = x + g2 * swiglu(h, p['ffn_w1'], p['ffn_w3'], p['ffn_w2'])
    return x, st_new


def setup_inputs(seed: int = 0) -> dict:
    key = jax.random.key(seed)
    ks = iter(jax.random.split(key, 48))
    f32 = jnp.float32

    def nrm(shape, scale):
        return jax.random.normal(next(ks), shape, f32) * scale

    def conv_init(shape):
        return nrm(shape, 0.2).at[:, CONV_W // 2, CONV_W // 2, :].add(1.0)

    def fbias():
        return 3.0 + 3.0 * jax.random.uniform(next(ks), (DEPTH, M_HEADS), f32)

    m_gate_b = jnp.stack([nrm((DEPTH, M_HEADS), 0.1), fbias(), nrm((DEPTH, M_HEADS), 0.1), fbias()], axis=1)
    return {
        'x_prompt': nrm((BATCH, SEQ, D_MODEL), 1.0),
        'x_sample': nrm((DEC_BATCH, DEC_SEQ, D_MODEL), 1.0),
        'state_mlstm_c': nrm((DEC_BATCH, DEPTH, 2, M_HEADS, M_HEAD_DIM, M_HEAD_DIM), 0.1),
        'state_mlstm_n': nrm((DEC_BATCH, DEPTH, 2, M_HEADS, M_HEAD_DIM), 0.1),
        'state_mlstm_m': nrm((DEC_BATCH, DEPTH, 2, M_HEADS), 1.0),
        'state_rwkv': nrm((DEC_BATCH, DEPTH, 2, R_HEADS, R_HEAD_DIM, R_HEAD_DIM), 0.1),
        'c': nrm((DEC_BATCH, D_MODEL), 1.0),
        'c_ctx': nrm((D_MODEL,), 1.0),
        'ada_w': nrm((DEPTH, D_MODEL, 6 * D_MODEL), 0.5 * D_MODEL ** -0.5),
        'ada_b': nrm((DEPTH, 6 * D_MODEL), 0.05),
        'norm1_g': 1.0 + nrm((DEPTH, D_MODEL), 0.05),
        'norm2_g': 1.0 + nrm((DEPTH, D_MODEL), 0.05),
        'w_in': nrm((DEPTH, D_MODEL, P_IN), D_MODEL ** -0.5),
        'm_conv': conv_init((DEPTH, CONV_W, CONV_W, 2 * M_WIDTH)),
        'm_gate_b': m_gate_b,
        'm_norm_g': 1.0 + nrm((DEPTH, M_WIDTH), 0.05),
        'r_conv': conv_init((DEPTH, CONV_W, CONV_W, R_IN)),
        'r_w0': nrm((DEPTH, 2, R_WIDTH), 0.5),
        'r_w2': nrm((DEPTH, 2, W_LORA, R_WIDTH), 0.1),
        'r_a0': nrm((DEPTH, 2, R_WIDTH), 0.1),
        'r_a2': nrm((DEPTH, 2, A_LORA, R_WIDTH), A_LORA ** -0.5),
        'r_g2': nrm((DEPTH, G_LORA, R_WIDTH), G_LORA ** -0.5),
        'r_kk': 0.85 + nrm((DEPTH, R_WIDTH), 0.05),
        'r_ka': 1.0 + nrm((DEPTH, R_WIDTH), 0.05),
        'r_rk': nrm((DEPTH, R_WIDTH), 0.1),
        'r_gn_w': 1.0 + nrm((DEPTH, R_WIDTH), 0.05),
        'r_gn_b': nrm((DEPTH, R_WIDTH), 0.02),
        'proj_m': nrm((DEPTH, M_WIDTH, D_MODEL), M_WIDTH ** -0.5),
        'proj_r': nrm((DEPTH, R_WIDTH, D_MODEL), R_WIDTH ** -0.5),
        'w_out': nrm((DEPTH, D_MODEL, D_MODEL), D_MODEL ** -0.5),
        'ffn_w1': nrm((DEPTH, D_MODEL, FFN_HIDDEN), D_MODEL ** -0.5),
        'ffn_w3': nrm((DEPTH, D_MODEL, FFN_HIDDEN), D_MODEL ** -0.5),
        'ffn_w2': nrm((DEPTH, FFN_HIDDEN, D_MODEL), FFN_HIDDEN ** -0.5),
        'final_g': 1.0 + nrm((D_MODEL,), 0.05),
    }


def reference(x_prompt, x_sample, state_mlstm_c, state_mlstm_n, state_mlstm_m, state_rwkv, c, c_ctx,
              ada_w, ada_b, norm1_g, norm2_g, w_in, m_conv, m_gate_b, m_norm_g, r_conv, r_w0, r_w2,
              r_a0, r_a2, r_g2, r_kk, r_ka, r_rk, r_gn_w, r_gn_b, proj_m, proj_r, w_out,
              ffn_w1, ffn_w3, ffn_w2, final_g):
    f32 = jnp.float32

    def layer_params(l):
        return dict(ada_w=ada_w[l], ada_b=ada_b[l], norm1_g=norm1_g[l], norm2_g=norm2_g[l], w_in=w_in[l],
                    m_conv=m_conv[l], m_gate_b=m_gate_b[l], m_norm_g=m_norm_g[l], r_conv=r_conv[l],
                    r_w0=r_w0[l], r_w2=r_w2[l], r_a0=r_a0[l], r_a2=r_a2[l], r_g2=r_g2[l], r_kk=r_kk[l],
                    r_ka=r_ka[l], r_rk=r_rk[l], r_gn_w=r_gn_w[l], r_gn_b=r_gn_b[l], proj_m=proj_m[l],
                    proj_r=proj_r[l], w_out=w_out[l], ffn_w1=ffn_w1[l], ffn_w3=ffn_w3[l], ffn_w2=ffn_w2[l])

    bp = x_prompt.shape[0]
    m_zero = (jnp.zeros((bp, M_HEADS, M_HEAD_DIM, M_HEAD_DIM), f32), jnp.zeros((bp, M_HEADS, M_HEAD_DIM), f32),
              jnp.zeros((bp, M_HEADS), f32))
    r_zero = jnp.zeros((bp, R_HEADS, R_HEAD_DIM, R_HEAD_DIM), f32)
    zero_st = m_zero + m_zero + (r_zero, r_zero)
    x = x_prompt
    ctx_states = []
    for l in range(DEPTH):
        p = layer_params(l)
        mod = (jax.nn.silu(c_ctx) @ p['ada_w'] + p['ada_b'])[None, None, :]
        x, st = trunk_layer(x, mod, p, False, zero_st)
        ctx_states.append(st)
    y_prompt = rmsnorm(x, final_g)
    new_mlstm_c = jnp.stack([jnp.stack([s[0], s[3]], axis=1) for s in ctx_states], axis=1)
    new_mlstm_n = jnp.stack([jnp.stack([s[1], s[4]], axis=1) for s in ctx_states], axis=1)
    new_mlstm_m = jnp.stack([jnp.stack([s[2], s[5]], axis=1) for s in ctx_states], axis=1)
    new_rwkv_s = jnp.stack([jnp.stack([s[6], s[7]], axis=1) for s in ctx_states], axis=1)

    xs = x_sample
    for l in range(DEPTH):
        p = layer_params(l)
        mod = (jax.nn.silu(c) @ p['ada_w'] + p['ada_b'])[:, None, :]
        st = (state_mlstm_c[:, l, 0], state_mlstm_n[:, l, 0], state_mlstm_m[:, l, 0],
              state_mlstm_c[:, l, 1], state_mlstm_n[:, l, 1], state_mlstm_m[:, l, 1],
              state_rwkv[:, l, 0], state_rwkv[:, l, 1])
        xs, _ = trunk_layer(xs, mod, p, True, st)
    y_sample = rmsnorm(xs, final_g)
    return (y_prompt, y_sample, new_mlstm_c, new_mlstm_n, new_mlstm_m, new_rwkv_s)
```

```cpp
#ifndef HOST_EMU
#include <hip/hip_runtime.h>
#define HD __host__ __device__ __forceinline__
#define DEV __device__ __forceinline__
#else
#include <cmath>
#include <cstring>
#include <cstdio>
#include <cstdlib>
#define HD inline
#define DEV inline
#endif
#include <cstddef>

#ifdef SMALL_CFG
constexpr int D = 256, CB = 2, CT = 128, DEPTH = 2, LB = 1, LT = 256, GW = 16;
#else
constexpr int D = 1024, CB = 32, CT = 256, DEPTH = 2, LB = 2, LT = 4096, GW = 64;
#endif
constexpr int MW = D / 2, MD = 128, MH = MW / MD, RW = D / 2, RD = 64, RH = RW / RD;
constexpr int RIN = 3 * RW + 384, FF = ((8 * D + 767) / 768) * 256, PIN = 2 * MW + MW + MW + 4 * MH + RIN + 2 * D;
constexpr int NC = CB * CT, NL = LB * LT, NT = NC + NL, NSEQ = CB + LB, NCOND = 1 + LB;
constexpr int N1 = PIN - 2 * D;
constexpr int N1P = ((N1 + 255) / 256) * 256;
constexpr int PU = N1;
constexpr int OFF_QK = 0, OFF_V = 2 * MW, OFF_O = 3 * MW, OFF_G = 4 * MW, OFF_R = 4 * MW + 4 * MH;
constexpr int RX_R = 0, RX_K = RW, RX_V = 2 * RW, RX_WL = 3 * RW, RX_AL = 3 * RW + 128, RX_GL = 3 * RW + 256;
constexpr float RMS_EPS = 1e-6f, GN_EPS = 64e-5f;
static_assert(3 * D <= N1, "G + merged must fit the dead columns of U1");

enum { X_PROMPT = 0, X_SAMPLE, ST_C, ST_N, ST_M, ST_R, C_LAT, C_CTX, ADA_W, ADA_B, NORM1, NORM2, W_IN, M_CONV, M_GATE_B, M_NORM_G,
       R_CONV, R_W0, R_W2, R_A0, R_A2, R_G2, R_KK, R_KA, R_RK, R_GN_W, R_GN_B, PROJ_M, PROJ_R, W_OUT, FFN_W1, FFN_W3, FFN_W2, FINAL_G, N_IN };

constexpr size_t OUT_X = 0;
constexpr size_t OUT_C = (size_t)NT * D;
constexpr size_t OUT_N = OUT_C + (size_t)CB * DEPTH * 2 * MH * 128 * 128;
constexpr size_t OUT_M = OUT_N + (size_t)CB * DEPTH * 2 * MH * 128;
constexpr size_t OUT_S = OUT_M + (size_t)CB * DEPTH * 2 * MH;
constexpr size_t OUT_END = OUT_S + (size_t)CB * DEPTH * 2 * RH * 64 * 64;

constexpr size_t al256(size_t x) { return (x + 255) & ~(size_t)255; }
constexpr size_t cmax(size_t a, size_t b) { return a > b ? a : b; }
constexpr size_t WS_CTL = 0;
constexpr size_t WS_MOD = (size_t)1 << 20;
constexpr size_t WS_WREG = (size_t)2 << 20;
constexpr size_t O_WIN1 = WS_WREG;
constexpr size_t O_WIN2 = O_WIN1 + (size_t)N1P * D * 2;
constexpr size_t O_PM = O_WIN2 + (size_t)2 * D * D * 2;
constexpr size_t O_PR = O_PM + (size_t)D * MW * 2;
constexpr size_t O_WO = O_PR + (size_t)D * RW * 2;
constexpr size_t O_W13 = O_WO + (size_t)D * D * 2;
constexpr size_t O_W2 = O_W13 + (size_t)2 * FF * D * 2;
constexpr size_t WS_U1 = al256(O_W2 + (size_t)D * FF * 2);
constexpr size_t SZ_U1 = al256(cmax((size_t)NT * PU * 2, (size_t)NT * FF * 2));
constexpr size_t WS_QKC = WS_U1 + SZ_U1;
constexpr size_t WS_RXC = WS_QKC + (size_t)NT * D * 2;
constexpr size_t WS_END = WS_RXC + al256(cmax((size_t)NT * RIN * 2, (size_t)NT * D * 2));
#ifndef SMALL_CFG
static_assert(WS_END <= ((size_t)256 << 20), "workspace map must fit 256 MiB");
#endif

typedef unsigned short bf16;
HD float bf2f(bf16 b) { unsigned u = ((unsigned)b) << 16; return __builtin_bit_cast(float, u); }
HD bf16 f2bf(float f) { unsigned u = __builtin_bit_cast(unsigned, f); u += 0x7fffu + ((u >> 16) & 1u); return (bf16)(u >> 16); }
HD float sigmoidf_(float x) { return 1.0f / (1.0f + expf(-x)); }
HD float siluf_(float x) { return x / (1.0f + expf(-x)); }
HD float softplusf_(float x) { return fmaxf(x, 0.f) + log1pf(expf(-fabsf(x))); }
HD float logsigmoidf_(float x) { return -softplusf_(-x); }
HD int prow(int c) { return (c & ~31) | (((c >> 2) & 1) << 4) | (((c >> 3) & 3) << 2) | (c & 3); }

struct Params {
    const float* in[N_IN];
    float* out;
    unsigned char* ws;
    int layer;
    int mode;
};

struct SeqInfo { int T; int base; int grid; int cond; int b; };
HD SeqInfo seqinfo(int s) {
    SeqInfo q;
    if (s < CB) { q.T = CT; q.base = s * CT; q.grid = 0; q.cond = 0; q.b = s; }
    else { q.T = LT; q.base = NC + (s - CB) * LT; q.grid = 1; q.cond = 1 + (s - CB); q.b = s - CB; }
    return q;
}
HD int seq_of_token(int m) { return m < NC ? m / CT : CB + (m - NC) / LT; }

#define WSP(T, off) ((T*)(P.ws + (off)))

DEV void k_init_x(const Params& P, long i) {
    const size_t ncd = (size_t)NC * D;
    P.out[i] = (size_t)i < ncd ? P.in[X_PROMPT][i] : P.in[X_SAMPLE][i - ncd];
}
DEV void k_mod(const Params& P, long i) {
    const int j = (int)(i % (6 * D)); const int ci = (int)((i / (6 * D)) % NCOND); const int l = (int)(i / ((long)6 * D * NCOND));
    const float* cv = ci == 0 ? P.in[C_CTX] : P.in[C_LAT] + (size_t)(ci - 1) * D;
    const float* w = P.in[ADA_W] + (size_t)l * D * 6 * D;
    float acc = P.in[ADA_B][(size_t)l * 6 * D + j];
    for (int k = 0; k < D; ++k) acc += siluf_(cv[k]) * w[(size_t)k * 6 * D + j];
    WSP(float, WS_MOD)[i] = acc;
}
constexpr long WC_N0 = (long)N1P * D, WC_N1 = WC_N0 + (long)2 * D * D, WC_N2 = WC_N1 + (long)D * MW, WC_N3 = WC_N2 + (long)D * RW,
               WC_N4 = WC_N3 + (long)D * D, WC_N5 = WC_N4 + (long)2 * FF * D, WC_N6 = WC_N5 + (long)D * FF;
HD int unprow(int r) { return (r & ~31) | (((r >> 2) & 3) << 3) | (((r >> 4) & 1) << 2) | (r & 3); }
DEV void k_wconv(const Params& P, long i) {
    const int l = P.layer;
    if (i < WC_N0) { const int r = (int)(i / D), k = (int)(i % D); const int c = unprow(r);
        WSP(bf16, O_WIN1)[i] = c < N1 ? f2bf(P.in[W_IN][((size_t)l * D + k) * PIN + c]) : (bf16)0; return; }
    if (i < WC_N1) { const long j = i - WC_N0; const int r = (int)(j / D), k = (int)(j % D); const int c = unprow(r);
        WSP(bf16, O_WIN2)[j] = f2bf(P.in[W_IN][((size_t)l * D + k) * PIN + N1 + c]); return; }
    if (i < WC_N2) { const long j = i - WC_N1; const int r = (int)(j / MW), k = (int)(j % MW); const int c = unprow(r);
        WSP(bf16, O_PM)[j] = f2bf(P.in[PROJ_M][((size_t)l * MW + k) * D + c]); return; }
    if (i < WC_N3) { const long j = i - WC_N2; const int r = (int)(j / RW), k = (int)(j % RW); const int c = unprow(r);
        WSP(bf16, O_PR)[j] = f2bf(P.in[PROJ_R][((size_t)l * RW + k) * D + c]); return; }
    if (i < WC_N4) { const long j = i - WC_N3; const int r = (int)(j / D), k = (int)(j % D);
        WSP(bf16, O_WO)[j] = f2bf(P.in[W_OUT][((size_t)l * D + k) * D + r]); return; }
    if (i < WC_N5) { const long j = i - WC_N4; const int r = (int)(j / D), k = (int)(j % D);
        const int pn = r >> 8, rl = r & 255, which = rl >> 7, rho = rl & 127; const int jj = pn * 128 + unprow(rho);
        const float* W = which ? P.in[FFN_W3] : P.in[FFN_W1];
        WSP(bf16, O_W13)[j] = f2bf(W[((size_t)l * D + k) * FF + jj]); return; }
    { const long j = i - WC_N5; const int r = (int)(j / FF), k = (int)(j % FF);
        WSP(bf16, O_W2)[j] = f2bf(P.in[FFN_W2][((size_t)l * FF + k) * D + r]); }
}
DEV void k_norm(const Params& P, long m) {
    const int l = P.layer; const int second = (P.mode == 2);
    const float* x = P.out + (size_t)m * D;
    const float* g = P.in[second ? NORM2 : NORM1] + (size_t)l * D;
    const int cond = seqinfo(seq_of_token((int)m)).cond;
    const float* mod = WSP(float, WS_MOD) + ((size_t)l * NCOND + cond) * 6 * D + (second ? 3 * D : 0);
    float ss = 0.f;
    for (int k = 0; k < D; ++k) ss += x[k] * x[k];
    const float rs = 1.0f / sqrtf(ss / D + RMS_EPS);
    bf16* o = WSP(bf16, P.mode == 1 ? WS_RXC : WS_QKC) + (size_t)m * D;
    for (int k = 0; k < D; ++k) o[k] = f2bf(x[k] * rs * g[k] * (1.0f + mod[D + k]) + mod[k]);
}
DEV float dot_bf(const bf16* a, const bf16* b, int K) { float s = 0.f; for (int k = 0; k < K; ++k) s += bf2f(a[k]) * bf2f(b[k]); return s; }
DEV void k_gemm_a1(const Params& P, long i) {
    const int n = (int)(i % N1); const long m = i / N1;
    WSP(bf16, WS_U1)[(size_t)m * PU + n] = f2bf(dot_bf(WSP(bf16, WS_QKC) + (size_t)m * D, WSP(bf16, O_WIN1) + (size_t)prow(n) * D, D));
}
DEV void k_gemm_a2(const Params& P, long i) {
    const int n = (int)(i % (2 * D)); const long m = i / (2 * D);
    WSP(bf16, WS_U1)[(size_t)m * PU + D + n] = f2bf(sigmoidf_(dot_bf(WSP(bf16, WS_RXC) + (size_t)m * D, WSP(bf16, O_WIN2) + (size_t)prow(n) * D, D)));
}
DEV void k_gemm_pj(const Params& P, long i) {
    const int n = (int)(i % D); const long m = i / D;
    const bf16* hmr = WSP(bf16, WS_QKC) + (size_t)m * D; bf16* u = WSP(bf16, WS_U1) + (size_t)m * PU;
    const float a = dot_bf(hmr, WSP(bf16, O_PM) + (size_t)prow(n) * MW, MW), b = dot_bf(hmr + MW, WSP(bf16, O_PR) + (size_t)prow(n) * RW, RW);
    const float first = bf2f(f2bf(bf2f(u[D + n]) * a));
    u[n] = f2bf(first + bf2f(u[2 * D + n]) * b);
}
DEV void k_gemm_wo(const Params& P, long i) {
    const int n = (int)(i % D); const long m = i / D; const int l = P.layer;
    const int cond = seqinfo(seq_of_token((int)m)).cond;
    const float g1 = WSP(float, WS_MOD)[((size_t)l * NCOND + cond) * 6 * D + 2 * D + n];
    P.out[(size_t)m * D + n] += g1 * dot_bf(WSP(bf16, WS_U1) + (size_t)m * PU, WSP(bf16, O_WO) + (size_t)n * D, D);
}
DEV void k_gemm_f1(const Params& P, long i) {
    const int j = (int)(i % FF); const long m = i / FF;
    const int pn = j >> 7, rho = prow(j & 127);
    const bf16* h = WSP(bf16, WS_QKC) + (size_t)m * D;
    const float a = dot_bf(h, WSP(bf16, O_W13) + (size_t)(pn * 256 + rho) * D, D), b = dot_bf(h, WSP(bf16, O_W13) + (size_t)(pn * 256 + 128 + rho) * D, D);
    WSP(bf16, WS_U1)[(size_t)m * FF + j] = f2bf(siluf_(a) * b);
}
DEV void k_gemm_f2(const Params& P, long i) {
    const int n = (int)(i % D); const long m = i / D; const int l = P.layer;
    const int cond = seqinfo(seq_of_token((int)m)).cond;
    const float g2 = WSP(float, WS_MOD)[((size_t)l * NCOND + cond) * 6 * D + 5 * D + n];
    P.out[(size_t)m * D + n] += g2 * dot_bf(WSP(bf16, WS_U1) + (size_t)m * FF, WSP(bf16, O_W2) + (size_t)n * FF, FF);
}
DEV void k_conv(const Params& P, long i) {
    constexpr int NCH = 2 * MW + RIN;
    const int ch = (int)(i % NCH); const int m = (int)(i / NCH); const int l = P.layer;
    const int s = seq_of_token(m); const SeqInfo q = seqinfo(s); const int t = m - q.base;
    const bool isqk = ch < 2 * MW; const int c = isqk ? ch : ch - 2 * MW;
    const int ucol = isqk ? OFF_QK + c : OFF_R + c;
    const int CH = isqk ? 2 * MW : RIN;
    const float* w = (isqk ? P.in[M_CONV] : P.in[R_CONV]) + (size_t)l * 9 * CH;
    const bf16* U = WSP(bf16, WS_U1);
    float acc = 0.f;
    if (q.grid) {
        const int r = t / GW, cc = t % GW, rows = q.T / GW;
        for (int a = 0; a < 3; ++a) for (int b = 0; b < 3; ++b) {
            const int rr = r + a - 1, c2 = cc + b - 1;
            if (rr >= 0 && rr < rows && c2 >= 0 && c2 < GW) acc += w[(a * 3 + b) * CH + c] * bf2f(U[(size_t)(q.base + rr * GW + c2) * PU + ucol]);
        }
    } else {
        for (int b = 0; b < 3; ++b) { const int t2 = t + b - 1; if (t2 >= 0 && t2 < q.T) acc += w[(3 + b) * CH + c] * bf2f(U[(size_t)(q.base + t2) * PU + ucol]); }
    }
    if (isqk) { float v = siluf_(acc); if (c < MW) v *= 0.08838834764831845f; WSP(bf16, WS_QKC)[(size_t)m * (2 * MW) + c] = f2bf(v); }
    else { float v = acc; if (c >= RX_WL && c < RX_AL) v = tanhf(v); else if (c >= RX_GL) v = sigmoidf_(v); WSP(bf16, WS_RXC)[(size_t)m * RIN + c] = f2bf(v); }
}
DEV void k_mlstm(const Params& P, long i) {
    const int e = (int)(i % 128); const int chain = (int)(i / 128); const int dir = chain & 1, head = (chain >> 1) % MH, s = chain / (2 * MH);
    const int l = P.layer; const SeqInfo q = seqinfo(s);
    float C[128], n[128]; float m;
    if (!q.grid) {
#pragma unroll
        for (int d = 0; d < 128; ++d) { C[d] = 0.f; n[d] = 0.f; }
        m = 0.f;
    } else {
        const size_t sb = (((size_t)q.b * DEPTH + l) * 2 + dir) * MH + head;
#pragma unroll
        for (int d = 0; d < 128; ++d) { C[d] = P.in[ST_C][(sb * 128 + d) * 128 + e]; n[d] = P.in[ST_N][sb * 128 + d]; }
        m = P.in[ST_M][sb];
    }
    const float bi = P.in[M_GATE_B][(size_t)l * 4 * MH + (2 * dir) * MH + head], bfg = P.in[M_GATE_B][(size_t)l * 4 * MH + (2 * dir + 1) * MH + head];
    bf16* U = WSP(bf16, WS_U1); const bf16* QK = WSP(bf16, WS_QKC);
    float nsel = 0.f;
    for (int p = 0; p < q.T; ++p) {
        const int t = dir ? q.T - 1 - p : p; const size_t tok = (size_t)(q.base + t);
        const bf16* qk = QK + tok * (2 * MW); bf16* u = U + tok * PU;
        const float gi = bf2f(u[OFF_G + (2 * dir) * MH + head]) + bi, gf = bf2f(u[OFF_G + (2 * dir + 1) * MH + head]) + bfg;
        const float lf = logsigmoidf_(gf);
        const float mn = fmaxf(lf + m, gi); const float fw = expf(lf + m - mn), iw = expf(gi - mn);
        const float v = bf2f(u[OFF_V + head * 128 + e]);
        float num = 0.f, den = 0.f;
#pragma unroll
        for (int d = 0; d < 128; ++d) {
            const float kd = bf2f(qk[MW + head * 128 + d]), qd = bf2f(qk[head * 128 + d]);
            C[d] = fw * C[d] + iw * kd * v; n[d] = fw * n[d] + iw * kd; num += qd * C[d]; den += qd * n[d];
        }
        m = mn;
        u[dir * MW + head * 128 + e] = f2bf(num / fmaxf(fabsf(den), expf(-m)));
    }
    if (!q.grid) {
        const size_t sb = (((size_t)q.b * DEPTH + l) * 2 + dir) * MH + head;
#pragma unroll
        for (int d = 0; d < 128; ++d) { P.out[OUT_C + (sb * 128 + d) * 128 + e] = C[d]; if (d == e) nsel = n[d]; }
        P.out[OUT_N + sb * 128 + e] = nsel;
        if (e == 0) P.out[OUT_M + sb] = m;
    }
}
DEV void k_rwkv_prep(const Params& P, long i) {
    const int c = (int)(i % RW); const size_t tok = (size_t)(i / RW); const int l = P.layer, dir = P.mode;
    const bf16* rx = WSP(bf16, WS_RXC) + tok * RIN;
    const float* w2 = P.in[R_W2] + ((size_t)l * 2 + dir) * 64 * RW + c; const float* a2 = P.in[R_A2] + ((size_t)l * 2 + dir) * 64 * RW + c;
    float wr = P.in[R_W0][((size_t)l * 2 + dir) * RW + c], ar = P.in[R_A0][((size_t)l * 2 + dir) * RW + c];
    for (int j = 0; j < 64; ++j) { wr += bf2f(rx[RX_WL + dir * 64 + j]) * w2[(size_t)j * RW]; ar += bf2f(rx[RX_AL + dir * 64 + j]) * a2[(size_t)j * RW]; }
    bf16* o = WSP(bf16, WS_QKC) + tok * (2 * RW);
    o[c] = f2bf(wr); o[RW + c] = f2bf(ar);
}
DEV void k_rwkv(const Params& P, long i) {
    const int row = (int)(i % 64); const int chain = (int)(i / 64); const int dir = P.mode, head = chain % RH, s = chain / RH;
    const int l = P.layer; const SeqInfo q = seqinfo(s); const int hc = head * 64;
    float S[64];
    if (!q.grid) {
#pragma unroll
        for (int c = 0; c < 64; ++c) S[c] = 0.f;
    } else {
        const size_t sb = (((size_t)q.b * DEPTH + l) * 2 + dir) * RH + head;
#pragma unroll
        for (int c = 0; c < 64; ++c) S[c] = P.in[ST_R][(sb * 64 + row) * 64 + c];
    }
    const float* rkk = P.in[R_KK] + (size_t)l * RW + hc; const float* rka = P.in[R_KA] + (size_t)l * RW + hc;
    bf16* U = WSP(bf16, WS_U1); const bf16* RX = WSP(bf16, WS_RXC); const bf16* WA = WSP(bf16, WS_QKC);
    for (int p = 0; p < q.T; ++p) {
        const int t = dir ? q.T - 1 - p : p; const size_t tok = (size_t)(q.base + t);
        const bf16* rx = RX + tok * RIN; const bf16* wa = WA + tok * (2 * RW);
        float ss = 0.f;
        for (int c = 0; c < 64; ++c) { const float kc = bf2f(rx[RX_K + hc + c]) * rkk[c]; ss += kc * kc; }
        const float inv = 1.0f / fmaxf(sqrtf(ss), 1e-12f);
        float sa = 0.f;
#pragma unroll
        for (int c = 0; c < 64; ++c) sa -= S[c] * (bf2f(rx[RX_K + hc + c]) * rkk[c] * inv);
        const float v = bf2f(rx[RX_V + hc + row]);
        float y = 0.f;
#pragma unroll
        for (int c = 0; c < 64; ++c) {
            const float wr = bf2f(wa[hc + c]), ar = bf2f(wa[RW + hc + c]);
            const float decay = expf(-0.6065306597126334f * sigmoidf_(wr));
            const float alpha = sigmoidf_(ar);
            const float kr = bf2f(rx[RX_K + hc + c]);
            const float kt = kr * (1.0f + (alpha - 1.0f) * rka[c]);
            const float bb = kr * rkk[c] * inv * alpha;
            S[c] = S[c] * decay + sa * bb + v * kt;
            y += S[c] * bf2f(rx[RX_R + hc + c]);
        }
        U[tok * PU + OFF_R + dir * RW + hc + row] = f2bf(y);
    }
    if (!q.grid) {
        const size_t sb = (((size_t)q.b * DEPTH + l) * 2 + dir) * RH + head;
#pragma unroll
        for (int c = 0; c < 64; ++c) P.out[OUT_S + (sb * 64 + row) * 64 + c] = S[c];
    }
}
DEV void k_post(const Params& P, long i) {
    const int ch = (int)(i % D); const size_t m = (size_t)(i / D); const int l = P.layer;
    const bf16* u = WSP(bf16, WS_U1) + m * PU; const bf16* rx = WSP(bf16, WS_RXC) + m * RIN;
    bf16* o = WSP(bf16, WS_QKC) + m * D;
    if (ch < MW) {
        const int h0 = (ch / 128) * 128; float ss = 0.f;
        for (int d = 0; d < 128; ++d) { const float x = bf2f(u[h0 + d]) + bf2f(u[MW + h0 + d]); ss += x * x; }
        const float x = bf2f(u[ch]) + bf2f(u[MW + ch]);
        o[ch] = f2bf(x / sqrtf(ss / 128.f + RMS_EPS) * P.in[M_NORM_G][(size_t)l * MW + ch] * sigmoidf_(bf2f(u[OFF_O + ch])));
    } else {
        const int c = ch - MW; const int h0 = (c / 64) * 64;
        float mu = 0.f, bsum = 0.f;
        for (int d = 0; d < 64; ++d) { mu += bf2f(u[OFF_R + h0 + d]) + bf2f(u[OFF_R + RW + h0 + d]);
            bsum += bf2f(rx[RX_R + h0 + d]) * bf2f(rx[RX_K + h0 + d]) * P.in[R_RK][(size_t)l * RW + h0 + d]; }
        mu *= (1.0f / 64.f); float var = 0.f;
        for (int d = 0; d < 64; ++d) { const float x = bf2f(u[OFF_R + h0 + d]) + bf2f(u[OFF_R + RW + h0 + d]) - mu; var += x * x; }
        var *= (1.0f / 64.f);
        const float y = bf2f(u[OFF_R + c]) + bf2f(u[OFF_R + RW + c]);
        const float yn = (y - mu) / sqrtf(var + GN_EPS) * P.in[R_GN_W][(size_t)l * RW + c] + P.in[R_GN_B][(size_t)l * RW + c];
        float gate = 0.f;
        for (int j = 0; j < 128; ++j) gate += bf2f(rx[RX_GL + j]) * P.in[R_G2][((size_t)l * 128 + j) * RW + c];
        o[ch] = f2bf((yn + bsum * bf2f(rx[RX_V + c])) * gate);
    }
}
DEV void k_final(const Params& P, long m) {
    float* x = P.out + (size_t)m * D; float ss = 0.f;
    for (int k = 0; k < D; ++k) ss += x[k] * x[k];
    const float rs = 1.0f / sqrtf(ss / D + RMS_EPS);
    for (int k = 0; k < D; ++k) x[k] = x[k] * rs * P.in[FINAL_G][k];
}

typedef void (*BodyFn)(const Params&, long);
#ifndef HOST_EMU
template <BodyFn F, int BLOCK> __global__ void __launch_bounds__(BLOCK) run_k(Params P, long n) {
    const long i = (long)blockIdx.x * BLOCK + threadIdx.x;
    if (i < n) F(P, i);
}
#define RUN(F, BLOCK, n) do { const long n_ = (n); run_k<F, BLOCK><<<dim3((unsigned)((n_ + BLOCK - 1) / BLOCK)), dim3(BLOCK), 0, stream>>>(P, n_); } while (0)
#else
#define RUN(F, BLOCK, n) do { const long n_ = (n); for (long i_ = 0; i_ < n_; ++i_) F(P, i_); } while (0)
typedef void* hipStream_t;
#endif

static void forward(Params P, hipStream_t stream) {
    (void)stream;
    RUN(k_init_x, 256, (long)NT * D);
    RUN(k_mod, 256, (long)DEPTH * NCOND * 6 * D);
    for (int l = 0; l < DEPTH; ++l) {
        P.layer = l;
        RUN(k_wconv, 256, WC_N6);
        P.mode = 0; RUN(k_norm, 64, (long)NT);
        RUN(k_gemm_a1, 256, (long)NT * N1);
        RUN(k_conv, 256, (long)NT * (2 * MW + RIN));
        RUN(k_mlstm, 128, (long)NSEQ * MH * 2 * 128);
        for (int dir = 0; dir < 2; ++dir) { P.mode = dir; RUN(k_rwkv_prep, 256, (long)NT * RW); RUN(k_rwkv, 64, (long)NSEQ * RH * 64); }
        RUN(k_post, 256, (long)NT * D);
        P.mode = 1; RUN(k_norm, 64, (long)NT);
        RUN(k_gemm_a2, 256, (long)NT * 2 * D);
        RUN(k_gemm_pj, 256, (long)NT * D);
        RUN(k_gemm_wo, 256, (long)NT * D);
        P.mode = 2; RUN(k_norm, 64, (long)NT);
        RUN(k_gemm_f1, 256, (long)NT * FF);
        RUN(k_gemm_f2, 256, (long)NT * D);
    }
    RUN(k_final, 64, (long)NT);
}

#ifndef HOST_EMU
extern "C" void kernel_launch(void* const* d_in, const int* in_sizes, int n_in, void* d_out, int out_size, void* d_ws, size_t ws_size, hipStream_t stream) {
    if (n_in != N_IN || (size_t)out_size != OUT_END || ws_size < WS_END) return;
    Params P{};
    for (int i = 0; i < N_IN; ++i) P.in[i] = (const float*)d_in[i];
    P.out = (float*)d_out; P.ws = (unsigned char*)d_ws; P.layer = 0; P.mode = 0;
    forward(P, stream);
}
#endif
```

```cpp
#ifndef HOST_EMU
#include <hip/hip_runtime.h>
#define HD __host__ __device__ __forceinline__
#define DEV __device__ __forceinline__
#else
#include <cmath>
#include <cstring>
#include <cstdio>
#include <cstdlib>
#define HD inline
#define DEV inline
#endif
#include <cstddef>

#ifdef SMALL_CFG
constexpr int D = 256, CB = 2, CT = 128, DEPTH = 2, LB = 1, LT = 256, GW = 16;
#else
constexpr int D = 1024, CB = 32, CT = 256, DEPTH = 2, LB = 2, LT = 4096, GW = 64;
#endif
constexpr int MW = D / 2, MD = 128, MH = MW / MD, RW = D / 2, RD = 64, RH = RW / RD;
constexpr int RIN = 3 * RW + 384, FF = ((8 * D + 767) / 768) * 256, PIN = 2 * MW + MW + MW + 4 * MH + RIN + 2 * D;
constexpr int NC = CB * CT, NL = LB * LT, NT = NC + NL, NSEQ = CB + LB, NCOND = 1 + LB;
constexpr int N1 = PIN - 2 * D;
constexpr int N1P = ((N1 + 255) / 256) * 256;
constexpr int PU = N1;
constexpr int OFF_QK = 0, OFF_V = 2 * MW, OFF_O = 3 * MW, OFF_G = 4 * MW, OFF_R = 4 * MW + 4 * MH;
constexpr int RX_R = 0, RX_K = RW, RX_V = 2 * RW, RX_WL = 3 * RW, RX_AL = 3 * RW + 128, RX_GL = 3 * RW + 256;
constexpr float RMS_EPS = 1e-6f, GN_EPS = 64e-5f;
static_assert(3 * D <= N1, "G + merged must fit the dead columns of U1");

enum { X_PROMPT = 0, X_SAMPLE, ST_C, ST_N, ST_M, ST_R, C_LAT, C_CTX, ADA_W, ADA_B, NORM1, NORM2, W_IN, M_CONV, M_GATE_B, M_NORM_G,
       R_CONV, R_W0, R_W2, R_A0, R_A2, R_G2, R_KK, R_KA, R_RK, R_GN_W, R_GN_B, PROJ_M, PROJ_R, W_OUT, FFN_W1, FFN_W3, FFN_W2, FINAL_G, N_IN };

constexpr size_t OUT_X = 0;
constexpr size_t OUT_C = (size_t)NT * D;
constexpr size_t OUT_N = OUT_C + (size_t)CB * DEPTH * 2 * MH * 128 * 128;
constexpr size_t OUT_M = OUT_N + (size_t)CB * DEPTH * 2 * MH * 128;
constexpr size_t OUT_S = OUT_M + (size_t)CB * DEPTH * 2 * MH;
constexpr size_t OUT_END = OUT_S + (size_t)CB * DEPTH * 2 * RH * 64 * 64;

constexpr size_t al256(size_t x) { return (x + 255) & ~(size_t)255; }
constexpr size_t cmax(size_t a, size_t b) { return a > b ? a : b; }
constexpr size_t WS_CTL = 0;
constexpr size_t WS_MOD = (size_t)1 << 20;
constexpr size_t WS_WREG = (size_t)2 << 20;
constexpr size_t O_WIN1 = WS_WREG;
constexpr size_t O_WIN2 = O_WIN1 + (size_t)N1P * D * 2;
constexpr size_t O_PM = O_WIN2 + (size_t)2 * D * D * 2;
constexpr size_t O_PR = O_PM + (size_t)D * MW * 2;
constexpr size_t O_WO = O_PR + (size_t)D * RW * 2;
constexpr size_t O_W13 = O_WO + (size_t)D * D * 2;
constexpr size_t O_W2 = O_W13 + (size_t)2 * FF * D * 2;
constexpr size_t O_G2T = O_W2 + (size_t)D * FF * 2;
constexpr size_t WS_U1 = al256(O_G2T + (size_t)RW * 128 * 2);
constexpr size_t SZ_U1 = al256(cmax((size_t)NT * PU * 2, (size_t)NT * FF * 2));
constexpr size_t WS_QKC = WS_U1 + SZ_U1;
constexpr size_t WS_RXC = WS_QKC + (size_t)NT * D * 2;
constexpr size_t WS_END = WS_RXC + al256(cmax((size_t)NT * RIN * 2, (size_t)NT * D * 2));
#ifndef SMALL_CFG
static_assert(WS_END <= ((size_t)256 << 20), "workspace map must fit 256 MiB");
#endif

typedef unsigned short bf16;
HD float bf2f(bf16 b) { unsigned u = ((unsigned)b) << 16; return __builtin_bit_cast(float, u); }
HD bf16 f2bf(float f) { unsigned u = __builtin_bit_cast(unsigned, f); u += 0x7fffu + ((u >> 16) & 1u); return (bf16)(u >> 16); }
HD float sigmoidf_(float x) { return 1.0f / (1.0f + expf(-x)); }
HD float siluf_(float x) { return x / (1.0f + expf(-x)); }
HD float softplusf_(float x) { return fmaxf(x, 0.f) + log1pf(expf(-fabsf(x))); }
HD float logsigmoidf_(float x) { return -softplusf_(-x); }
HD int prow(int c) { return (c & ~31) | (((c >> 2) & 1) << 4) | (((c >> 3) & 3) << 2) | (c & 3); }

struct Params {
    const float* in[N_IN];
    float* out;
    unsigned char* ws;
    int layer;
    int mode;
};

struct SeqInfo { int T; int base; int grid; int cond; int b; };
HD SeqInfo seqinfo(int s) {
    SeqInfo q;
    if (s < CB) { q.T = CT; q.base = s * CT; q.grid = 0; q.cond = 0; q.b = s; }
    else { q.T = LT; q.base = NC + (s - CB) * LT; q.grid = 1; q.cond = 1 + (s - CB); q.b = s - CB; }
    return q;
}
HD int seq_of_token(int m) { return m < NC ? m / CT : CB + (m - NC) / LT; }

#define WSP(T, off) ((T*)(P.ws + (off)))

DEV void k_init_x(const Params& P, long i) {
    const size_t ncd = (size_t)NC * D;
    P.out[i] = (size_t)i < ncd ? P.in[X_PROMPT][i] : P.in[X_SAMPLE][i - ncd];
}
DEV void k_mod(const Params& P, long i) {
    const int j = (int)(i % (6 * D)); const int ci = (int)((i / (6 * D)) % NCOND); const int l = (int)(i / ((long)6 * D * NCOND));
    const float* cv = ci == 0 ? P.in[C_CTX] : P.in[C_LAT] + (size_t)(ci - 1) * D;
    const float* w = P.in[ADA_W] + (size_t)l * D * 6 * D;
    float acc = P.in[ADA_B][(size_t)l * 6 * D + j];
    for (int k = 0; k < D; ++k) acc += siluf_(cv[k]) * w[(size_t)k * 6 * D + j];
    WSP(float, WS_MOD)[i] = acc;
}
constexpr long WC_N0 = (long)N1P * D, WC_N1 = WC_N0 + (long)2 * D * D, WC_N2 = WC_N1 + (long)D * MW, WC_N3 = WC_N2 + (long)D * RW,
               WC_N4 = WC_N3 + (long)D * D, WC_N5 = WC_N4 + (long)2 * FF * D, WC_N6 = WC_N5 + (long)D * FF;
HD int unprow(int r) { return (r & ~31) | (((r >> 2) & 3) << 3) | (((r >> 4) & 1) << 2) | (r & 3); }
DEV void k_wconv(const Params& P, long i) {
    const int l = P.layer;
    if (i < WC_N0) { const int r = (int)(i / D), k = (int)(i % D); const int c = unprow(r);
        WSP(bf16, O_WIN1)[i] = c < N1 ? f2bf(P.in[W_IN][((size_t)l * D + k) * PIN + c]) : (bf16)0; return; }
    if (i < WC_N1) { const long j = i - WC_N0; const int r = (int)(j / D), k = (int)(j % D); const int c = unprow(r);
        WSP(bf16, O_WIN2)[j] = f2bf(P.in[W_IN][((size_t)l * D + k) * PIN + N1 + c]); return; }
    if (i < WC_N2) { const long j = i - WC_N1; const int r = (int)(j / MW), k = (int)(j % MW); const int c = unprow(r);
        WSP(bf16, O_PM)[j] = f2bf(P.in[PROJ_M][((size_t)l * MW + k) * D + c]); return; }
    if (i < WC_N3) { const long j = i - WC_N2; const int r = (int)(j / RW), k = (int)(j % RW); const int c = unprow(r);
        WSP(bf16, O_PR)[j] = f2bf(P.in[PROJ_R][((size_t)l * RW + k) * D + c]); return; }
    if (i < WC_N4) { const long j = i - WC_N3; const int r = (int)(j / D), k = (int)(j % D);
        WSP(bf16, O_WO)[j] = f2bf(P.in[W_OUT][((size_t)l * D + k) * D + r]); return; }
    if (i < WC_N5) { const long j = i - WC_N4; const int r = (int)(j / D), k = (int)(j % D);
        const int pn = r >> 8, rl = r & 255, which = rl >> 7, rho = rl & 127; const int jj = pn * 128 + unprow(rho);
        const float* W = which ? P.in[FFN_W3] : P.in[FFN_W1];
        WSP(bf16, O_W13)[j] = f2bf(W[((size_t)l * D + k) * FF + jj]); return; }
    { const long j = i - WC_N5; const int r = (int)(j / FF), k = (int)(j % FF);
        WSP(bf16, O_W2)[j] = f2bf(P.in[FFN_W2][((size_t)l * FF + k) * D + r]); }
}
DEV void k_norm(const Params& P, long m) {
    const int l = P.layer; const int second = (P.mode == 2);
    const float* x = P.out + (size_t)m * D;
    const float* g = P.in[second ? NORM2 : NORM1] + (size_t)l * D;
    const int cond = seqinfo(seq_of_token((int)m)).cond;
    const float* mod = WSP(float, WS_MOD) + ((size_t)l * NCOND + cond) * 6 * D + (second ? 3 * D : 0);
    float ss = 0.f;
    for (int k = 0; k < D; ++k) ss += x[k] * x[k];
    const float rs = 1.0f / sqrtf(ss / D + RMS_EPS);
    bf16* o = WSP(bf16, P.mode == 1 ? WS_RXC : WS_QKC) + (size_t)m * D;
    for (int k = 0; k < D; ++k) o[k] = f2bf(x[k] * rs * g[k] * (1.0f + mod[D + k]) + mod[k]);
}
DEV float dot_bf(const bf16* a, const bf16* b, int K) { float s = 0.f; for (int k = 0; k < K; ++k) s += bf2f(a[k]) * bf2f(b[k]); return s; }
DEV void k_gemm_a1(const Params& P, long i) {
    const int n = (int)(i % N1); const long m = i / N1;
    WSP(bf16, WS_U1)[(size_t)m * PU + n] = f2bf(dot_bf(WSP(bf16, WS_QKC) + (size_t)m * D, WSP(bf16, O_WIN1) + (size_t)prow(n) * D, D));
}
DEV void k_gemm_a2(const Params& P, long i) {
    const int n = (int)(i % (2 * D)); const long m = i / (2 * D);
    WSP(bf16, WS_U1)[(size_t)m * PU + D + n] = f2bf(sigmoidf_(dot_bf(WSP(bf16, WS_RXC) + (size_t)m * D, WSP(bf16, O_WIN2) + (size_t)prow(n) * D, D)));
}
DEV void k_gemm_pj(const Params& P, long i) {
    const int n = (int)(i % D); const long m = i / D;
    const bf16* hmr = WSP(bf16, WS_QKC) + (size_t)m * D; bf16* u = WSP(bf16, WS_U1) + (size_t)m * PU;
    const float a = dot_bf(hmr, WSP(bf16, O_PM) + (size_t)prow(n) * MW, MW), b = dot_bf(hmr + MW, WSP(bf16, O_PR) + (size_t)prow(n) * RW, RW);
    const float first = bf2f(f2bf(bf2f(u[D + n]) * a));
    u[n] = f2bf(first + bf2f(u[2 * D + n]) * b);
}
DEV void k_gemm_wo(const Params& P, long i) {
    const int n = (int)(i % D); const long m = i / D; const int l = P.layer;
    const int cond = seqinfo(seq_of_token((int)m)).cond;
    const float g1 = WSP(float, WS_MOD)[((size_t)l * NCOND + cond) * 6 * D + 2 * D + n];
    P.out[(size_t)m * D + n] += g1 * dot_bf(WSP(bf16, WS_U1) + (size_t)m * PU, WSP(bf16, O_WO) + (size_t)n * D, D);
}
DEV void k_gemm_f1(const Params& P, long i) {
    const int j = (int)(i % FF); const long m = i / FF;
    const int pn = j >> 7, rho = prow(j & 127);
    const bf16* h = WSP(bf16, WS_QKC) + (size_t)m * D;
    const float a = dot_bf(h, WSP(bf16, O_W13) + (size_t)(pn * 256 + rho) * D, D), b = dot_bf(h, WSP(bf16, O_W13) + (size_t)(pn * 256 + 128 + rho) * D, D);
    WSP(bf16, WS_U1)[(size_t)m * FF + j] = f2bf(siluf_(a) * b);
}
DEV void k_gemm_f2(const Params& P, long i) {
    const int n = (int)(i % D); const long m = i / D; const int l = P.layer;
    const int cond = seqinfo(seq_of_token((int)m)).cond;
    const float g2 = WSP(float, WS_MOD)[((size_t)l * NCOND + cond) * 6 * D + 5 * D + n];
    P.out[(size_t)m * D + n] += g2 * dot_bf(WSP(bf16, WS_U1) + (size_t)m * FF, WSP(bf16, O_W2) + (size_t)n * FF, FF);
}
DEV void k_conv(const Params& P, long i) {
    constexpr int NCH = 2 * MW + RIN;
    const int ch = (int)(i % NCH); const int m = (int)(i / NCH); const int l = P.layer;
    const int s = seq_of_token(m); const SeqInfo q = seqinfo(s); const int t = m - q.base;
    const bool isqk = ch < 2 * MW; const int c = isqk ? ch : ch - 2 * MW;
    const int ucol = isqk ? OFF_QK + c : OFF_R + c;
    const int CH = isqk ? 2 * MW : RIN;
    const float* w = (isqk ? P.in[M_CONV] : P.in[R_CONV]) + (size_t)l * 9 * CH;
    const bf16* U = WSP(bf16, WS_U1);
    float acc = 0.f;
    if (q.grid) {
        const int r = t / GW, cc = t % GW, rows = q.T / GW;
        for (int a = 0; a < 3; ++a) for (int b = 0; b < 3; ++b) {
            const int rr = r + a - 1, c2 = cc + b - 1;
            if (rr >= 0 && rr < rows && c2 >= 0 && c2 < GW) acc += w[(a * 3 + b) * CH + c] * bf2f(U[(size_t)(q.base + rr * GW + c2) * PU + ucol]);
        }
    } else {
        for (int b = 0; b < 3; ++b) { const int t2 = t + b - 1; if (t2 >= 0 && t2 < q.T) acc += w[(3 + b) * CH + c] * bf2f(U[(size_t)(q.base + t2) * PU + ucol]); }
    }
    if (isqk) { float v = siluf_(acc); if (c < MW) v *= 0.08838834764831845f; WSP(bf16, WS_QKC)[(size_t)m * (2 * MW) + c] = f2bf(v); }
    else { float v = acc; if (c >= RX_WL && c < RX_AL) v = tanhf(v); else if (c >= RX_GL) v = sigmoidf_(v); WSP(bf16, WS_RXC)[(size_t)m * RIN + c] = f2bf(v); }
}
DEV void k_mlstm(const Params& P, long i) {
    const int e = (int)(i % 128); const int chain = (int)(i / 128); const int dir = chain & 1, head = (chain >> 1) % MH, s = chain / (2 * MH);
    const int l = P.layer; const SeqInfo q = seqinfo(s);
    float C[128], n[128]; float m;
    if (!q.grid) {
#pragma unroll
        for (int d = 0; d < 128; ++d) { C[d] = 0.f; n[d] = 0.f; }
        m = 0.f;
    } else {
        const size_t sb = (((size_t)q.b * DEPTH + l) * 2 + dir) * MH + head;
#pragma unroll
        for (int d = 0; d < 128; ++d) { C[d] = P.in[ST_C][(sb * 128 + d) * 128 + e]; n[d] = P.in[ST_N][sb * 128 + d]; }
        m = P.in[ST_M][sb];
    }
    const float bi = P.in[M_GATE_B][(size_t)l * 4 * MH + (2 * dir) * MH + head], bfg = P.in[M_GATE_B][(size_t)l * 4 * MH + (2 * dir + 1) * MH + head];
    bf16* U = WSP(bf16, WS_U1); const bf16* QK = WSP(bf16, WS_QKC);
    float nsel = 0.f;
    for (int p = 0; p < q.T; ++p) {
        const int t = dir ? q.T - 1 - p : p; const size_t tok = (size_t)(q.base + t);
        const bf16* qk = QK + tok * (2 * MW); bf16* u = U + tok * PU;
        const float gi = bf2f(u[OFF_G + (2 * dir) * MH + head]) + bi, gf = bf2f(u[OFF_G + (2 * dir + 1) * MH + head]) + bfg;
        const float lf = logsigmoidf_(gf);
        const float mn = fmaxf(lf + m, gi); const float fw = expf(lf + m - mn), iw = expf(gi - mn);
        const float v = bf2f(u[OFF_V + head * 128 + e]);
        float num = 0.f, den = 0.f;
#pragma unroll
        for (int d = 0; d < 128; ++d) {
            const float kd = bf2f(qk[MW + head * 128 + d]), qd = bf2f(qk[head * 128 + d]);
            C[d] = fw * C[d] + iw * kd * v; n[d] = fw * n[d] + iw * kd; num += qd * C[d]; den += qd * n[d];
        }
        m = mn;
        u[dir * MW + head * 128 + e] = f2bf(num / fmaxf(fabsf(den), expf(-m)));
    }
    if (!q.grid) {
        const size_t sb = (((size_t)q.b * DEPTH + l) * 2 + dir) * MH + head;
#pragma unroll
        for (int d = 0; d < 128; ++d) { P.out[OUT_C + (sb * 128 + d) * 128 + e] = C[d]; if (d == e) nsel = n[d]; }
        P.out[OUT_N + sb * 128 + e] = nsel;
        if (e == 0) P.out[OUT_M + sb] = m;
    }
}
DEV void k_rwkv_prep(const Params& P, long i) {
    const int c = (int)(i % RW); const size_t tok = (size_t)(i / RW); const int l = P.layer, dir = P.mode;
    const bf16* rx = WSP(bf16, WS_RXC) + tok * RIN;
    const float* w2 = P.in[R_W2] + ((size_t)l * 2 + dir) * 64 * RW + c; const float* a2 = P.in[R_A2] + ((size_t)l * 2 + dir) * 64 * RW + c;
    float wr = P.in[R_W0][((size_t)l * 2 + dir) * RW + c], ar = P.in[R_A0][((size_t)l * 2 + dir) * RW + c];
    for (int j = 0; j < 64; ++j) { wr += bf2f(rx[RX_WL + dir * 64 + j]) * w2[(size_t)j * RW]; ar += bf2f(rx[RX_AL + dir * 64 + j]) * a2[(size_t)j * RW]; }
    bf16* o = WSP(bf16, WS_QKC) + tok * (2 * RW);
    o[c] = f2bf(wr); o[RW + c] = f2bf(ar);
}
DEV void k_rwkv(const Params& P, long i) {
    const int row = (int)(i % 64); const int chain = (int)(i / 64); const int dir = P.mode, head = chain % RH, s = chain / RH;
    const int l = P.layer; const SeqInfo q = seqinfo(s); const int hc = head * 64;
    float S[64];
    if (!q.grid) {
#pragma unroll
        for (int c = 0; c < 64; ++c) S[c] = 0.f;
    } else {
        const size_t sb = (((size_t)q.b * DEPTH + l) * 2 + dir) * RH + head;
#pragma unroll
        for (int c = 0; c < 64; ++c) S[c] = P.in[ST_R][(sb * 64 + row) * 64 + c];
    }
    const float* rkk = P.in[R_KK] + (size_t)l * RW + hc; const float* rka = P.in[R_KA] + (size_t)l * RW + hc;
    bf16* U = WSP(bf16, WS_U1); const bf16* RX = WSP(bf16, WS_RXC); const bf16* WA = WSP(bf16, WS_QKC);
    for (int p = 0; p < q.T; ++p) {
        const int t = dir ? q.T - 1 - p : p; const size_t tok = (size_t)(q.base + t);
        const bf16* rx = RX + tok * RIN; const bf16* wa = WA + tok * (2 * RW);
        float ss = 0.f;
        for (int c = 0; c < 64; ++c) { const float kc = bf2f(rx[RX_K + hc + c]) * rkk[c]; ss += kc * kc; }
        const float inv = 1.0f / fmaxf(sqrtf(ss), 1e-12f);
        float sa = 0.f;
#pragma unroll
        for (int c = 0; c < 64; ++c) sa -= S[c] * (bf2f(rx[RX_K + hc + c]) * rkk[c] * inv);
        const float v = bf2f(rx[RX_V + hc + row]);
        float y = 0.f;
#pragma unroll
        for (int c = 0; c < 64; ++c) {
            const float wr = bf2f(wa[hc + c]), ar = bf2f(wa[RW + hc + c]);
            const float decay = expf(-0.6065306597126334f * sigmoidf_(wr));
            const float alpha = sigmoidf_(ar);
            const float kr = bf2f(rx[RX_K + hc + c]);
            const float kt = kr * (1.0f + (alpha - 1.0f) * rka[c]);
            const float bb = kr * rkk[c] * inv * alpha;
            S[c] = S[c] * decay + sa * bb + v * kt;
            y += S[c] * bf2f(rx[RX_R + hc + c]);
        }
        U[tok * PU + OFF_R + dir * RW + hc + row] = f2bf(y);
    }
    if (!q.grid) {
        const size_t sb = (((size_t)q.b * DEPTH + l) * 2 + dir) * RH + head;
#pragma unroll
        for (int c = 0; c < 64; ++c) P.out[OUT_S + (sb * 64 + row) * 64 + c] = S[c];
    }
}
DEV void k_post(const Params& P, long i) {
    const int ch = (int)(i % D); const size_t m = (size_t)(i / D); const int l = P.layer;
    const bf16* u = WSP(bf16, WS_U1) + m * PU; const bf16* rx = WSP(bf16, WS_RXC) + m * RIN;
    bf16* o = WSP(bf16, WS_QKC) + m * D;
    if (ch < MW) {
        const int h0 = (ch / 128) * 128; float ss = 0.f;
        for (int d = 0; d < 128; ++d) { const float x = bf2f(u[h0 + d]) + bf2f(u[MW + h0 + d]); ss += x * x; }
        const float x = bf2f(u[ch]) + bf2f(u[MW + ch]);
        o[ch] = f2bf(x / sqrtf(ss / 128.f + RMS_EPS) * P.in[M_NORM_G][(size_t)l * MW + ch] * sigmoidf_(bf2f(u[OFF_O + ch])));
    } else {
        const int c = ch - MW; const int h0 = (c / 64) * 64;
        float mu = 0.f, bsum = 0.f;
        for (int d = 0; d < 64; ++d) { mu += bf2f(u[OFF_R + h0 + d]) + bf2f(u[OFF_R + RW + h0 + d]);
            bsum += bf2f(rx[RX_R + h0 + d]) * bf2f(rx[RX_K + h0 + d]) * P.in[R_RK][(size_t)l * RW + h0 + d]; }
        mu *= (1.0f / 64.f); float var = 0.f;
        for (int d = 0; d < 64; ++d) { const float x = bf2f(u[OFF_R + h0 + d]) + bf2f(u[OFF_R + RW + h0 + d]) - mu; var += x * x; }
        var *= (1.0f / 64.f);
        const float y = bf2f(u[OFF_R + c]) + bf2f(u[OFF_R + RW + c]);
        const float yn = (y - mu) / sqrtf(var + GN_EPS) * P.in[R_GN_W][(size_t)l * RW + c] + P.in[R_GN_B][(size_t)l * RW + c];
        float gate = 0.f;
        for (int j = 0; j < 128; ++j) gate += bf2f(rx[RX_GL + j]) * P.in[R_G2][((size_t)l * 128 + j) * RW + c];
        o[ch] = f2bf((yn + bsum * bf2f(rx[RX_V + c])) * gate);
    }
}
DEV void k_final(const Params& P, long m) {
    float* x = P.out + (size_t)m * D; float ss = 0.f;
    for (int k = 0; k < D; ++k) ss += x[k] * x[k];
    const float rs = 1.0f / sqrtf(ss / D + RMS_EPS);
    for (int k = 0; k < D; ++k) x[k] = x[k] * rs * P.in[FINAL_G][k];
}


#ifndef HOST_EMU
typedef const __attribute__((address_space(4))) Params CParams;
namespace pg8 {
#define PG8_LAS __attribute__((address_space(3)))
typedef short bf16x8 __attribute__((ext_vector_type(8)));
typedef float f32x4 __attribute__((ext_vector_type(4)));
typedef unsigned u32x4 __attribute__((ext_vector_type(4)));
constexpr int BM = 256, BK = 64, HALF = 128, HTB = HALF * BK * 2, STAGE_BYTES = 8 * HTB, NXCD = 8, WGM = 8;
__device__ __forceinline__ int lds_byte(int r, int c) { const int st = (r >> 4) * 2 + (c >> 5), rr = r & 15, cc = c & 31, ob = rr * 64 + cc * 2; return st * 1024 + (ob ^ (((ob >> 9) & 1) << 5)); }
__device__ __forceinline__ void stage_rc(int b, int& R, int& C) { const int st = b / 1024, sb = b % 1024, swz = sb ^ (((sb >> 9) & 1) << 5); R = (st >> 1) * 16 + swz / 64; C = (st & 1) * 32 + (swz % 64) / 2; }
struct Unit { int pm, pn, aoff; };
struct Gemm { const bf16* A; const bf16* Bt; int K, lda; };
struct StaticOrder {
    int nM, nN, nwg, G, c;
    __device__ __forceinline__ void init(int M, int N, int G_, int c_) { nM = M / BM; nN = N / BM; nwg = nM * nN; G = G_; c = c_; }
    __device__ __forceinline__ bool next(int i, Unit& u) const {
        const long L = (long)i * G + c; if (L >= nwg) return false;
        int wgid = (int)L; { const int q = nwg / NXCD, r = nwg % NXCD, xcd = wgid % NXCD, off = wgid / NXCD; wgid = (xcd < r ? xcd * (q + 1) : r * (q + 1) + (xcd - r) * q) + off; }
        const int nig = WGM * nN, gid = wgid / nig, fm = gid * WGM, gsz = (nM - fm) < WGM ? (nM - fm) : WGM;
        u.pm = fm + ((wgid % nig) % gsz); u.pn = (wgid % nig) / gsz; u.aoff = 0; return true;
    }
};
struct PairOrder {
    int nbase, G, v, nct;
    __device__ __forceinline__ void init(int M, int G_, int c_) { nct = D / BM; nbase = (M / BM) * nct; G = G_; v = (G_ % 8 == 0) ? (c_ % 8) * (G_ / 8) + c_ / 8 : c_; }
    __device__ __forceinline__ bool next(int i, Unit& u) const {
        const int j = v + (i >> 1) * G; if (j >= nbase) return false;
        const int half = i & 1; u.pm = j / nct; u.pn = half * nct + (j % nct); u.aoff = half * MW; return true;
    }
};
typedef float f32x2_t __attribute__((ext_vector_type(2)));
typedef __bf16 bf16x2_t __attribute__((ext_vector_type(2)));
__device__ __forceinline__ unsigned cvt_pk_bf16(float lo, float hi) { f32x2_t v = {lo, hi}; bf16x2_t b = __builtin_convertvector(v, bf16x2_t); return __builtin_bit_cast(unsigned, b); }
__device__ __forceinline__ float fsigmoid(float x) { return __builtin_amdgcn_rcpf(1.0f + __expf(-x)); }
__device__ __forceinline__ float bflo(unsigned w) { return __builtin_bit_cast(float, w << 16); }
__device__ __forceinline__ float bfhi(unsigned w) { return __builtin_bit_cast(float, w & 0xffff0000u); }

struct EpiA1 {
    bf16* U;
    __device__ __forceinline__ void operator()(const f32x4 (&acc)[2][2][4][2], const Unit& u, int wr, int wc, int fr, int fq) const {
        const int row0 = u.pm * BM + wr * 64 + fr, col0 = u.pn * BM + wc * 32 + 8 * fq;
#pragma unroll
        for (int ai = 0; ai < 2; ++ai)
#pragma unroll
            for (int m = 0; m < 4; ++m) { bf16* rowp = U + (size_t)(row0 + ai * HALF + m * 16) * PU + col0;
#pragma unroll
                for (int bj = 0; bj < 2; ++bj) { if (col0 + bj * HALF < N1) { const f32x4 v0 = acc[ai][bj][m][0], v1 = acc[ai][bj][m][1];
                    u32x4 w; w.x = cvt_pk_bf16(v0[0], v0[1]); w.y = cvt_pk_bf16(v0[2], v0[3]); w.z = cvt_pk_bf16(v1[0], v1[1]); w.w = cvt_pk_bf16(v1[2], v1[3]);
                    *(u32x4*)(rowp + bj * HALF) = w; } } }
    }
};
struct EpiA2 {
    bf16* U;
    __device__ __forceinline__ void operator()(const f32x4 (&acc)[2][2][4][2], const Unit& u, int wr, int wc, int fr, int fq) const {
        const int row0 = u.pm * BM + wr * 64 + fr, col0 = D + u.pn * BM + wc * 32 + 8 * fq;
#pragma unroll
        for (int ai = 0; ai < 2; ++ai)
#pragma unroll
            for (int m = 0; m < 4; ++m) { bf16* rowp = U + (size_t)(row0 + ai * HALF + m * 16) * PU + col0;
#pragma unroll
                for (int bj = 0; bj < 2; ++bj) { const f32x4 v0 = acc[ai][bj][m][0], v1 = acc[ai][bj][m][1];
                    u32x4 w; w.x = cvt_pk_bf16(fsigmoid(v0[0]), fsigmoid(v0[1])); w.y = cvt_pk_bf16(fsigmoid(v0[2]), fsigmoid(v0[3]));
                    w.z = cvt_pk_bf16(fsigmoid(v1[0]), fsigmoid(v1[1])); w.w = cvt_pk_bf16(fsigmoid(v1[2]), fsigmoid(v1[3]));
                    *(u32x4*)(rowp + bj * HALF) = w; } }
    }
};
struct EpiPJ {
    bf16* U;
    __device__ __forceinline__ void operator()(const f32x4 (&acc)[2][2][4][2], const Unit& u, int wr, int wc, int fr, int fq) const {
        const int nct = D / BM, half = u.pn >= nct ? 1 : 0, ct = u.pn - half * nct;
        const int row0 = u.pm * BM + wr * 64 + fr, col0 = ct * BM + wc * 32 + 8 * fq;
#pragma unroll
        for (int ai = 0; ai < 2; ++ai)
#pragma unroll
            for (int m = 0; m < 4; ++m) { bf16* rowp = U + (size_t)(row0 + ai * HALF + m * 16) * PU + col0;
#pragma unroll
                for (int bj = 0; bj < 2; ++bj) { const f32x4 v0 = acc[ai][bj][m][0], v1 = acc[ai][bj][m][1];
                    const u32x4 g = *(const u32x4*)(rowp + (1 + half) * D + bj * HALF);
                    float o[8] = { bflo(g.x) * v0[0], bfhi(g.x) * v0[1], bflo(g.y) * v0[2], bfhi(g.y) * v0[3], bflo(g.z) * v1[0], bfhi(g.z) * v1[1], bflo(g.w) * v1[2], bfhi(g.w) * v1[3] };
                    if (half) { const u32x4 p = *(const u32x4*)(rowp + bj * HALF);
                        o[0] += bflo(p.x); o[1] += bfhi(p.x); o[2] += bflo(p.y); o[3] += bfhi(p.y); o[4] += bflo(p.z); o[5] += bfhi(p.z); o[6] += bflo(p.w); o[7] += bfhi(p.w); }
                    u32x4 w; w.x = cvt_pk_bf16(o[0], o[1]); w.y = cvt_pk_bf16(o[2], o[3]); w.z = cvt_pk_bf16(o[4], o[5]); w.w = cvt_pk_bf16(o[6], o[7]);
                    *(u32x4*)(rowp + bj * HALF) = w; }
                asm volatile("" ::: "memory"); }
    }
};
struct EpiRes {
    float* X; const float* gate;
    __device__ __forceinline__ void operator()(const f32x4 (&acc)[2][2][4][2], const Unit& u, int wr, int wc, int fr, int fq) const {
        const int row0 = u.pm * BM + wr * 64 + fr, col0 = u.pn * BM + wc * 32 + 4 * fq;
        const int cond = seqinfo(seq_of_token(u.pm * BM)).cond;
        const float* gp = gate + (size_t)cond * 6 * D + col0;
        f32x4 gv[2][2];
#pragma unroll
        for (int bj = 0; bj < 2; ++bj)
#pragma unroll
            for (int n = 0; n < 2; ++n) gv[bj][n] = *(const f32x4*)(gp + bj * HALF + n * 16);
#pragma unroll
        for (int ai = 0; ai < 2; ++ai)
#pragma unroll
            for (int m = 0; m < 4; ++m) { float* rowp = X + (size_t)(row0 + ai * HALF + m * 16) * D + col0;
#pragma unroll
                for (int bj = 0; bj < 2; ++bj)
#pragma unroll
                    for (int n = 0; n < 2; ++n) { f32x4* p = (f32x4*)(rowp + bj * HALF + n * 16); *p = *p + gv[bj][n] * acc[ai][bj][m][n]; }
                asm volatile("" ::: "memory"); }
    }
};
struct EpiF1 {
    bf16* Hd;
    __device__ __forceinline__ void operator()(const f32x4 (&acc)[2][2][4][2], const Unit& u, int wr, int wc, int fr, int fq) const {
        const int row0 = u.pm * BM + wr * 64 + fr, col0 = u.pn * HALF + wc * 32 + 8 * fq;
#pragma unroll
        for (int ai = 0; ai < 2; ++ai)
#pragma unroll
            for (int m = 0; m < 4; ++m) { bf16* rowp = Hd + (size_t)(row0 + ai * HALF + m * 16) * FF + col0;
                float o[8];
#pragma unroll
                for (int n = 0; n < 2; ++n)
#pragma unroll
                    for (int e = 0; e < 4; ++e) { const float a = acc[ai][0][m][n][e], b = acc[ai][1][m][n][e]; o[n * 4 + e] = a * fsigmoid(a) * b; }
                u32x4 w; w.x = cvt_pk_bf16(o[0], o[1]); w.y = cvt_pk_bf16(o[2], o[3]); w.z = cvt_pk_bf16(o[4], o[5]); w.w = cvt_pk_bf16(o[6], o[7]);
                *(u32x4*)rowp = w; }
    }
};

template <class Epi, class Sched, bool ALIGN_EPI = true, bool SP2 = true>
__device__ __forceinline__ void gemm_phase(PG8_LAS unsigned char* lds, const Gemm g, const Sched& S, const Epi& E) {
    const int tid = threadIdx.x, wid = __builtin_amdgcn_readfirstlane(tid >> 6), lane = tid & 63, wr = wid >> 2, wc = wid & 3, fr = lane & 15, fq = lane >> 4;
    const int K = g.K, nt = K / BK;
    unsigned voffA[2], voffB[2];
#pragma unroll
    for (int i = 0; i < 2; ++i) { int R, C; stage_rc(tid * 16 + i * 8192, R, C);
        voffA[i] = (unsigned)(R * g.lda + C) * 2u; voffB[i] = (unsigned)(R * K + C) * 2u; }
    const size_t kstep = (size_t)(BK * 2);
    const size_t hstepA = (size_t)HALF * g.lda * 2, hstepB = (size_t)HALF * K * 2;
    const size_t tstepA = 2 * hstepA, tstepB = 2 * hstepB;
    const unsigned ldsw = (unsigned)wid * 1024u;
    const int aoff = lds_byte(wr * 64 + fr, fq * 8), boff = lds_byte(wc * 32 + fr, fq * 8);
#define PG8_SA(b, h) (((b) * 2 + (h)) * HTB)
#define PG8_SB(b, h) ((4 + (b) * 2 + (h)) * HTB)
#define PG8_STAGE(bufoff, gbase, voff) do { _Pragma("unroll") for (int _i = 0; _i < 2; ++_i) \
        __builtin_amdgcn_global_load_lds((const unsigned*)((const char*)(gbase) + (voff)[_i]), (PG8_LAS unsigned*)(lds + (bufoff) + ldsw + _i * 8192), 16, 0, 0); } while (0)
#define PG8_LDA(dst, b, h) do { _Pragma("unroll") for (int m = 0; m < 4; ++m) _Pragma("unroll") for (int k = 0; k < 2; ++k) dst[m][k] = *(const PG8_LAS bf16x8*)(lds + PG8_SA(b, h) + aoff + m * 2048 + k * 1024); } while (0)
#define PG8_LDB(dst, b, h) do { _Pragma("unroll") for (int n = 0; n < 2; ++n) _Pragma("unroll") for (int k = 0; k < 2; ++k) dst[n][k] = *(const PG8_LAS bf16x8*)(lds + PG8_SB(b, h) + boff + n * 2048 + k * 1024); } while (0)
#define PG8_MMA(ai, bj, At, Bt) do { __builtin_amdgcn_s_setprio(1); _Pragma("unroll") for (int m = 0; m < 4; ++m) _Pragma("unroll") for (int n = 0; n < 2; ++n) _Pragma("unroll") for (int k = 0; k < 2; ++k) \
        acc[ai][bj][m][n] = __builtin_amdgcn_mfma_f32_16x16x32_bf16(Bt[n][k], At[m][k], acc[ai][bj][m][n], 0, 0, 0); __builtin_amdgcn_s_setprio(0); } while (0)
#define PG8_WAIT_V(n) asm volatile("s_waitcnt vmcnt(" #n ")" ::: "memory")
#define PG8_WAIT_L(n) asm volatile("s_waitcnt lgkmcnt(" #n ")" ::: "memory")
#define PG8_BAR __builtin_amdgcn_s_barrier()
#define PG8_SCHED __builtin_amdgcn_sched_barrier(0)
    Unit cur, nxt; int ui = 0;
    if (!S.next(0, cur)) return;
    f32x4 acc[2][2][4][2];
#pragma unroll
    for (int a = 0; a < 2; ++a)
#pragma unroll
        for (int b = 0; b < 2; ++b)
#pragma unroll
            for (int m = 0; m < 4; ++m)
#pragma unroll
                for (int n = 0; n < 2; ++n) acc[a][b][m][n] = (f32x4){0.f, 0.f, 0.f, 0.f};
    bf16x8 At[4][2], B0[2][2], B1[2][2];
    const char* cA = (const char*)g.A + (size_t)cur.pm * tstepA + (size_t)cur.aoff * 2; const char* cB = (const char*)g.Bt + (size_t)cur.pn * tstepB;
    if constexpr (SP2) {
        PG8_STAGE(PG8_SB(0, 0), cB, voffB); PG8_STAGE(PG8_SB(0, 1), cB + hstepB, voffB); PG8_STAGE(PG8_SA(0, 0), cA, voffA); PG8_STAGE(PG8_SA(0, 1), cA + hstepA, voffA);
        if (wr == 1) PG8_BAR;
        PG8_WAIT_V(2); PG8_BAR;
        PG8_STAGE(PG8_SB(1, 0), cB + kstep, voffB); PG8_STAGE(PG8_SA(1, 0), cA + kstep, voffA); PG8_STAGE(PG8_SB(1, 1), cB + hstepB + kstep, voffB);
        PG8_WAIT_V(6); PG8_BAR;
    } else {
        PG8_STAGE(PG8_SB(0, 0), cB, voffB); PG8_STAGE(PG8_SA(0, 0), cA, voffA); PG8_STAGE(PG8_SB(0, 1), cB + hstepB, voffB); PG8_STAGE(PG8_SA(0, 1), cA + hstepA, voffA);
        if (wr == 1) PG8_BAR;
        PG8_WAIT_V(4); PG8_BAR;
        PG8_STAGE(PG8_SB(1, 0), cB + kstep, voffB); PG8_STAGE(PG8_SA(1, 0), cA + kstep, voffA); PG8_STAGE(PG8_SB(1, 1), cB + hstepB + kstep, voffB);
        PG8_WAIT_V(6); PG8_BAR;
    }
    for (;;) {
        const bool has_next = S.next(ui + 1, nxt);
        const char* nA = has_next ? (const char*)g.A + (size_t)nxt.pm * tstepA + (size_t)nxt.aoff * 2 : cA; const char* nB = has_next ? (const char*)g.Bt + (size_t)nxt.pn * tstepB : cB;
        for (int t = 0; t < nt; t += 2) {
            const bool last = (t == nt - 2);
            const char* a1 = cA + (size_t)(t + 1) * kstep;
            const char* a2 = last ? nA : cA + (size_t)(t + 2) * kstep; const char* b2 = last ? nB : cB + (size_t)(t + 2) * kstep;
            const char* a3 = a2 + kstep; const char* b3 = b2 + kstep;
            if constexpr (SP2) {
            PG8_LDB(B0, 0, 0); PG8_LDB(B1, 0, 1); PG8_SCHED; PG8_LDA(At, 0, 0); PG8_STAGE(PG8_SA(1, 1), a1 + hstepA, voffA);
            PG8_WAIT_V(8); PG8_WAIT_L(0); PG8_BAR; PG8_MMA(0, 0, At, B0); PG8_MMA(0, 1, At, B1); PG8_BAR; PG8_SCHED;
            PG8_LDA(At, 0, 1); PG8_STAGE(PG8_SB(0, 0), b2, voffB); PG8_STAGE(PG8_SB(0, 1), b2 + hstepB, voffB); PG8_STAGE(PG8_SA(0, 0), a2, voffA);
            PG8_WAIT_V(8); PG8_WAIT_L(0); PG8_BAR; PG8_MMA(1, 0, At, B0); PG8_MMA(1, 1, At, B1); PG8_BAR; PG8_SCHED;
            PG8_LDB(B0, 1, 0); PG8_LDB(B1, 1, 1); PG8_SCHED; PG8_LDA(At, 1, 0); PG8_STAGE(PG8_SA(0, 1), a2 + hstepA, voffA);
            PG8_WAIT_V(8); PG8_WAIT_L(0); PG8_BAR; PG8_MMA(0, 0, At, B0); PG8_MMA(0, 1, At, B1); PG8_BAR; PG8_SCHED;
            PG8_LDA(At, 1, 1); PG8_STAGE(PG8_SB(1, 0), b3, voffB); PG8_STAGE(PG8_SB(1, 1), b3 + hstepB, voffB); PG8_STAGE(PG8_SA(1, 0), a3, voffA);
            PG8_WAIT_V(8); PG8_WAIT_L(0); PG8_BAR; PG8_MMA(1, 0, At, B0); PG8_MMA(1, 1, At, B1); PG8_BAR; PG8_SCHED;
            } else {
            PG8_LDB(B0, 0, 0); PG8_SCHED; PG8_LDA(At, 0, 0); PG8_STAGE(PG8_SA(1, 1), a1 + hstepA, voffA);
            PG8_WAIT_L(8); PG8_BAR; PG8_WAIT_L(0); PG8_MMA(0, 0, At, B0); PG8_BAR; PG8_SCHED;
            PG8_LDB(B1, 0, 1); PG8_STAGE(PG8_SB(0, 0), b2, voffB);
            PG8_BAR; PG8_WAIT_L(0); PG8_MMA(0, 1, At, B1); PG8_BAR;
            PG8_LDA(At, 0, 1); PG8_STAGE(PG8_SA(0, 0), a2, voffA);
            PG8_BAR; PG8_WAIT_L(0); PG8_MMA(1, 0, At, B0); PG8_BAR; PG8_SCHED;
            PG8_STAGE(PG8_SB(0, 1), b2 + hstepB, voffB);
            PG8_WAIT_V(6); PG8_BAR; PG8_MMA(1, 1, At, B1); PG8_BAR;
            PG8_LDB(B0, 1, 0); PG8_SCHED; PG8_LDA(At, 1, 0); PG8_STAGE(PG8_SA(0, 1), a2 + hstepA, voffA);
            PG8_WAIT_L(8); PG8_BAR; PG8_WAIT_L(0); PG8_MMA(0, 0, At, B0); PG8_BAR; PG8_SCHED;
            PG8_LDB(B1, 1, 1); PG8_STAGE(PG8_SB(1, 0), b3, voffB);
            PG8_BAR; PG8_WAIT_L(0); PG8_MMA(0, 1, At, B1); PG8_BAR;
            PG8_LDA(At, 1, 1); PG8_STAGE(PG8_SA(1, 0), a3, voffA);
            PG8_BAR; PG8_WAIT_L(0); PG8_MMA(1, 0, At, B0); PG8_BAR; PG8_SCHED;
            PG8_STAGE(PG8_SB(1, 1), b3 + hstepB, voffB);
            PG8_WAIT_V(6); PG8_BAR; PG8_MMA(1, 1, At, B1); PG8_BAR;
            }
        }
        if constexpr (ALIGN_EPI) { if (wr == 0) PG8_BAR; }
        E(acc, cur, wr, wc, fr, fq);
        if (!has_next) break;
#pragma unroll
        for (int a = 0; a < 2; ++a)
#pragma unroll
            for (int b = 0; b < 2; ++b)
#pragma unroll
                for (int m = 0; m < 4; ++m)
#pragma unroll
                    for (int n = 0; n < 2; ++n) acc[a][b][m][n] = (f32x4){0.f, 0.f, 0.f, 0.f};
        cur = nxt; cA = nA; cB = nB; ++ui;
        if constexpr (ALIGN_EPI) { if (wr == 1) PG8_BAR; }
    }
    PG8_WAIT_V(0);
    if constexpr (!ALIGN_EPI) { if (wr == 0) PG8_BAR; }
    PG8_BAR;
#undef PG8_SA
#undef PG8_SB
#undef PG8_STAGE
#undef PG8_LDA
#undef PG8_LDB
#undef PG8_MMA
#undef PG8_WAIT_V
#undef PG8_WAIT_L
#undef PG8_BAR
#undef PG8_SCHED
}
}


namespace ml {
#define LAS __attribute__((address_space(3)))
typedef short bf16x8 __attribute__((ext_vector_type(8)));
typedef float f32x4 __attribute__((ext_vector_type(4)));
typedef unsigned u32x4 __attribute__((ext_vector_type(4)));
constexpr int NVB = 4, EV = MD / NVB;
constexpr int PQ = 272, PT = 144;
constexpr int L_QS = 0, L_KS = L_QS + 64 * PQ, L_KT = L_KS + 64 * PQ, L_VT = L_KT + 128 * PT, L_SB = L_VT + 48 * PT, L_CT = L_SB + 64 * PT,
              L_HS = L_CT + 48 * PQ, L_SC = L_HS + 64 * 80, L_END = L_SC + 4096;
static_assert(L_END <= 131072, "mLSTM LDS map");
enum { SC_A = 0, SC_PM = 64, SC_WI = 128, SC_EMT = 192, SC_WE = 256, SC_DEN = 320, SC_MISC = 384 };
__device__ __forceinline__ f32x4 mma(bf16x8 a, bf16x8 b, f32x4 c) { return __builtin_amdgcn_mfma_f32_16x16x32_bf16(a, b, c, 0, 0, 0); }
__device__ __forceinline__ bf16x8 frag(LAS unsigned char* lds, int base, int pitch, int row0, int k0, int lane) {
    return *(const LAS bf16x8*)(lds + base + (row0 + (lane & 15)) * pitch + (k0 + 8 * (lane >> 4)) * 2);
}
__device__ __forceinline__ void mlstm_item(LAS unsigned char* lds, CParams& P, int l, int s, int head, int dir, int vb) {
    const int tid = threadIdx.x, w = __builtin_amdgcn_readfirstlane(tid >> 6), lane = tid & 63, fr = lane & 15, fq = lane >> 4;
    const int rt = w & 3, half = w >> 2;
    const SeqInfo q = seqinfo(s); const int nchunk = q.T / 64;
    const bf16* QK = WSP(bf16, WS_QKC); bf16* U = WSP(bf16, WS_U1);
    LAS float* SC = (LAS float*)(lds + L_SC);
    f32x4 cacc[3];
    float m_prev;
    if (!q.grid) { cacc[0] = cacc[1] = cacc[2] = (f32x4){0.f, 0.f, 0.f, 0.f}; m_prev = 0.f; }
    else {
        const size_t sb = (((size_t)q.b * DEPTH + l) * 2 + dir) * MH + head; const int d = 16 * w + fr;
#pragma unroll
        for (int et = 0; et < 2; ++et)
#pragma unroll
            for (int r = 0; r < 4; ++r) cacc[et][r] = P.in[ST_C][(sb * 128 + d) * 128 + vb * EV + 16 * et + 4 * fq + r];
        cacc[2] = (f32x4){0.f, 0.f, 0.f, 0.f}; if (fq == 0) cacc[2][0] = P.in[ST_N][sb * 128 + d];
        m_prev = P.in[ST_M][sb];
    }
    const float bi = P.in[M_GATE_B][(size_t)l * 4 * MH + (2 * dir) * MH + head], bfg = P.in[M_GATE_B][(size_t)l * 4 * MH + (2 * dir + 1) * MH + head];
    for (int i = tid; i < 16 * 64; i += 512) { const int r = i >> 6, c = i & 63; *(LAS bf16*)(lds + L_VT + (32 + r) * PT + c * 2) = (r == 0) ? (bf16)0x3f80 : (bf16)0; }
    u32x4 pqk[4]; u32x4 pv; bf16 pgi = 0, pgf = 0;
#define ML_TOK(c, j) ((size_t)(q.base + (dir ? q.T - 1 - ((c) * 64 + (j)) : ((c) * 64 + (j)))))
#define ML_PREFETCH(c) do { _Pragma("unroll") for (int i = 0; i < 4; ++i) { const int id = tid + 512 * i, j = id >> 5, pc = id & 31; \
            pqk[i] = *(const u32x4*)(QK + ML_TOK(c, j) * (2 * MW) + (pc < 16 ? head * 128 + 8 * pc : MW + head * 128 + 8 * (pc - 16))); } \
        if (tid < 256) { const int j = tid >> 2, pc = tid & 3; pv = *(const u32x4*)(U + ML_TOK(c, j) * PU + OFF_V + head * 128 + vb * EV + 8 * pc); } \
        if (w == 0) { const bf16* g = U + ML_TOK(c, lane) * PU + OFF_G; pgi = g[(2 * dir) * MH + head]; pgf = g[(2 * dir + 1) * MH + head]; } } while (0)
    ML_PREFETCH(0);
    for (int c = 0; c < nchunk; ++c) {
#pragma unroll
        for (int i = 0; i < 4; ++i) { const int id = tid + 512 * i, j = id >> 5, pc = id & 31;
            *(LAS u32x4*)(lds + (pc < 16 ? L_QS : L_KS) + j * PQ + (pc & 15) * 16) = pqk[i]; }
        if (tid < 256) { const int j = tid >> 2, pc = tid & 3; const unsigned wv[4] = {pv.x, pv.y, pv.z, pv.w};
#pragma unroll
            for (int e = 0; e < 8; ++e) *(LAS bf16*)(lds + L_VT + (8 * pc + e) * PT + j * 2) = (bf16)((wv[e >> 1] >> ((e & 1) * 16)) & 0xffffu); }
#pragma unroll
        for (int et = 0; et < 3; ++et)
#pragma unroll
            for (int r = 0; r < 4; ++r) *(LAS bf16*)(lds + L_CT + (16 * et + 4 * fq + r) * PQ + (16 * w + fr) * 2) = f2bf(cacc[et][r]);
        float wie = 1.f;
        if (w == 0) {
            const float gi = bf2f(pgi) + bi, gf = bf2f(pgf) + bfg;
            const float lf = fminf(gf, 0.f) - log1pf(__expf(-fabsf(gf)));
            float b = lf;
#pragma unroll
            for (int o = 1; o < 64; o <<= 1) { const float t = __shfl_up(b, o); if (lane >= o) b += t; }
            const float a = gi - b; float pm = a;
#pragma unroll
            for (int o = 1; o < 64; o <<= 1) { const float t = __shfl_up(pm, o); if (lane >= o) pm = fmaxf(pm, t); }
            pm = fmaxf(pm, m_prev);
            const float pm63 = __shfl(pm, 63), b63 = __shfl(b, 63);
            SC[SC_A + lane] = a; SC[SC_PM + lane] = pm; SC[SC_WI + lane] = __expf(m_prev - pm); SC[SC_EMT + lane] = __expf(-(b + pm)); SC[SC_WE + lane] = __expf(a - pm63);
            if (lane == 0) { SC[SC_MISC] = __expf(m_prev - pm63); SC[SC_MISC + 1] = b63 + pm63; }
        }
        __syncthreads();
        if (c + 1 < nchunk) ML_PREFETCH(c + 1);
        wie = SC[SC_MISC]; m_prev = SC[SC_MISC + 1];
#pragma unroll
        for (int i = 0; i < 2; ++i) { const int id = tid + 512 * i, j = id >> 4, pc = id & 15; const float we = SC[SC_WE + j];
            const u32x4 kv = *(const LAS u32x4*)(lds + L_KS + j * PQ + pc * 16); const unsigned wv[4] = {kv.x, kv.y, kv.z, kv.w};
#pragma unroll
            for (int e = 0; e < 8; ++e) { const float kf = __builtin_bit_cast(float, (e & 1) ? (wv[e >> 1] & 0xffff0000u) : (wv[e >> 1] << 16));
                *(LAS bf16*)(lds + L_KT + (8 * pc + e) * PT + j * 2) = f2bf(kf * we); } }
#pragma unroll
        for (int cc = 0; cc < 2; ++cc) { const int ct = 2 * half + cc;
            f32x4 acc = (f32x4){0.f, 0.f, 0.f, 0.f};
            if (ct <= rt) {
#pragma unroll
                for (int k = 0; k < 4; ++k) acc = mma(frag(lds, L_QS, PQ, 16 * rt, 32 * k, lane), frag(lds, L_KS, PQ, 16 * ct, 32 * k, lane), acc);
            }
            const int sp = 16 * ct + fr; const float as = SC[SC_A + sp];
#pragma unroll
            for (int r = 0; r < 4; ++r) { const int t = 16 * rt + 4 * fq + r; const float v = (sp <= t) ? acc[r] * __expf(as - SC[SC_PM + t]) : 0.f;
                *(LAS bf16*)(lds + L_SB + t * PT + sp * 2) = f2bf(v); } }
        __syncthreads();
        f32x4 nacc[2]; const int nct = half ? 1 : 2;
#pragma unroll
        for (int cc = 0; cc < 2; ++cc) { if (cc < nct) { const int ct = half ? 2 : cc;
            f32x4 a1 = (f32x4){0.f, 0.f, 0.f, 0.f}, a2 = (f32x4){0.f, 0.f, 0.f, 0.f};
#pragma unroll
            for (int k = 0; k < 2; ++k) a1 = mma(frag(lds, L_SB, PT, 16 * rt, 32 * k, lane), frag(lds, L_VT, PT, 16 * ct, 32 * k, lane), a1);
#pragma unroll
            for (int k = 0; k < 4; ++k) a2 = mma(frag(lds, L_QS, PQ, 16 * rt, 32 * k, lane), frag(lds, L_CT, PQ, 16 * ct, 32 * k, lane), a2);
#pragma unroll
            for (int r = 0; r < 4; ++r) a1[r] += SC[SC_WI + 16 * rt + 4 * fq + r] * a2[r];
            nacc[cc] = a1; } }
        if (half && fr == 0) {
#pragma unroll
            for (int r = 0; r < 4; ++r) SC[SC_DEN + 16 * rt + 4 * fq + r] = nacc[0][r];
        }
#pragma unroll
        for (int et = 0; et < 3; ++et) { cacc[et] = cacc[et] * wie;
#pragma unroll
            for (int k = 0; k < 2; ++k) cacc[et] = mma(frag(lds, L_VT, PT, 16 * et, 32 * k, lane), frag(lds, L_KT, PT, 16 * w, 32 * k, lane), cacc[et]); }
        __syncthreads();
        if (!half) {
#pragma unroll
            for (int cc = 0; cc < 2; ++cc)
#pragma unroll
                for (int r = 0; r < 4; ++r) { const int t = 16 * rt + 4 * fq + r; const float den = fmaxf(fabsf(SC[SC_DEN + t]), SC[SC_EMT + t]);
                    *(LAS bf16*)(lds + L_HS + t * 80 + (16 * cc + fr) * 2) = f2bf(nacc[cc][r] / den); }
        }
        __syncthreads();
        if (tid < 256) { const int j = tid >> 2, pc = tid & 3;
            *(u32x4*)(U + ML_TOK(c, j) * PU + dir * MW + head * 128 + vb * EV + 8 * pc) = *(const LAS u32x4*)(lds + L_HS + j * 80 + pc * 16); }
    }
    if (!q.grid) {
        const size_t sb = (((size_t)q.b * DEPTH + l) * 2 + dir) * MH + head; const int d = 16 * w + fr;
#pragma unroll
        for (int et = 0; et < 2; ++et)
#pragma unroll
            for (int r = 0; r < 4; ++r) P.out[OUT_C + (sb * 128 + d) * 128 + vb * EV + 16 * et + 4 * fq + r] = cacc[et][r];
        if (vb == 0) { if (fq == 0) P.out[OUT_N + sb * 128 + d] = cacc[2][0]; if (tid == 0) P.out[OUT_M + sb] = m_prev; }
    }
    __syncthreads();
#undef ML_TOK
#undef ML_PREFETCH
}
constexpr int N_ITEMS = NSEQ * MH * 2 * NVB;
__device__ __forceinline__ void decode_item(int it, int& s, int& head, int& dir, int& vb) {
    vb = it % NVB; int ch = it / NVB; dir = ch & 1; ch >>= 1; head = ch % MH; const int sq = ch / MH;
    s = sq < LB ? CB + sq : sq - LB;
}
}


namespace rw {
typedef short bf16x8 __attribute__((ext_vector_type(8)));
typedef float f32x4 __attribute__((ext_vector_type(4)));
typedef unsigned u32x4 __attribute__((ext_vector_type(4)));
enum { V_A = 0, V_W, V_B, V_K, V_R, V_V, NVEC };
constexpr int REC = NVEC * 64 * 4;
constexpr int PT = 144;
constexpr int L_SBUF = 0, L_TW = L_SBUF + 64 * REC, L_AL = L_TW + 64 * PT, L_YS = L_AL + 64 * PT, L_INV = L_YS + 64 * 32 * 4, L_END = L_INV + 256;
static_assert(L_END <= 131072, "RWKV LDS map");
__device__ __forceinline__ float dpp_xor1(float x) { return __builtin_bit_cast(float, __builtin_amdgcn_update_dpp(0, __builtin_bit_cast(int, x), 0xB1, 0xF, 0xF, true)); }
__device__ __forceinline__ float dpp_xor2(float x) { return __builtin_bit_cast(float, __builtin_amdgcn_update_dpp(0, __builtin_bit_cast(int, x), 0x4E, 0xF, 0xF, true)); }
__device__ __forceinline__ float dpp_ror4(float x) { return __builtin_bit_cast(float, __builtin_amdgcn_update_dpp(0, __builtin_bit_cast(int, x), 0x124, 0xF, 0xF, true)); }
__device__ __forceinline__ float dpp_ror8(float x) { return __builtin_bit_cast(float, __builtin_amdgcn_update_dpp(0, __builtin_bit_cast(int, x), 0x128, 0xF, 0xF, true)); }
__device__ __forceinline__ float allsum16(float x) { x += dpp_xor1(x); x += dpp_xor2(x); x += dpp_ror4(x); x += dpp_ror8(x); return x; }
__device__ __forceinline__ f32x4 cvt_lo4(unsigned a, unsigned b) { return (f32x4){__builtin_bit_cast(float, a << 16), __builtin_bit_cast(float, a & 0xffff0000u), __builtin_bit_cast(float, b << 16), __builtin_bit_cast(float, b & 0xffff0000u)}; }
__device__ __forceinline__ void rwkv_item(LAS unsigned char* lds, CParams& P, int l, int s, int head, int dir, int rh) {
    const int tid = threadIdx.x, w = __builtin_amdgcn_readfirstlane(tid >> 6), lane = tid & 63, fr = lane & 15, fq = lane >> 4;
    const int rt = w & 3, half = w >> 2, hc = head * 64;
    const SeqInfo q = seqinfo(s); const int nchunk = q.T / 64;
    const bf16* RX = WSP(bf16, WS_RXC); bf16* U = WSP(bf16, WS_U1);
    const int pj = tid >> 3, psub = tid & 7;
    const int row = 32 * rh + 4 * w + fq;
    f32x4 S;
    if (!q.grid) S = (f32x4){0.f, 0.f, 0.f, 0.f};
    else { const size_t sb = (((size_t)q.b * DEPTH + l) * 2 + dir) * RH + head; S = *(const f32x4*)(P.in[ST_R] + (sb * 64 + row) * 64 + 4 * fr); }
    float rkk8[8];
#pragma unroll
    for (int e = 0; e < 8; ++e) rkk8[e] = P.in[R_KK][(size_t)l * RW + hc + 8 * psub + e];
    float c_w0[2], c_a0[2], c_kk[2], c_ka[2];
    bf16x8 bw[2][2], ba[2][2];
#pragma unroll
    for (int cc = 0; cc < 2; ++cc) { const int c = 16 * (2 * half + cc) + fr;
        c_w0[cc] = P.in[R_W0][((size_t)l * 2 + dir) * RW + hc + c]; c_a0[cc] = P.in[R_A0][((size_t)l * 2 + dir) * RW + hc + c];
        c_kk[cc] = P.in[R_KK][(size_t)l * RW + hc + c]; c_ka[cc] = P.in[R_KA][(size_t)l * RW + hc + c];
#pragma unroll
        for (int ks = 0; ks < 2; ++ks)
#pragma unroll
            for (int e = 0; e < 8; ++e) { const int j = 32 * ks + 8 * fq + e;
                bw[cc][ks][e] = (short)f2bf(P.in[R_W2][(((size_t)l * 2 + dir) * 64 + j) * RW + hc + c]);
                ba[cc][ks][e] = (short)f2bf(P.in[R_A2][(((size_t)l * 2 + dir) * 64 + j) * RW + hc + c]); } }
    u32x4 pf[5];
#define RW_TOK(c, j) ((size_t)(q.base + (dir ? q.T - 1 - ((c) * 64 + (j)) : ((c) * 64 + (j)))))
#define RW_PREFETCH(c) do { const bf16* rx = RX + RW_TOK(c, pj) * RIN + 8 * psub; \
        pf[0] = *(const u32x4*)(rx + RX_R + hc); pf[1] = *(const u32x4*)(rx + RX_K + hc); pf[2] = *(const u32x4*)(rx + RX_V + hc); \
        pf[3] = *(const u32x4*)(rx + RX_WL + dir * 64); pf[4] = *(const u32x4*)(rx + RX_AL + dir * 64); } while (0)
    RW_PREFETCH(0);
    for (int c = 0; c < nchunk; ++c) {
        { LAS unsigned char* rec = lds + L_SBUF + pj * REC + psub * 32;
          *(LAS f32x4*)(rec + V_R * 256) = cvt_lo4(pf[0].x, pf[0].y); *(LAS f32x4*)(rec + V_R * 256 + 16) = cvt_lo4(pf[0].z, pf[0].w);
          *(LAS f32x4*)(rec + V_V * 256) = cvt_lo4(pf[2].x, pf[2].y); *(LAS f32x4*)(rec + V_V * 256 + 16) = cvt_lo4(pf[2].z, pf[2].w);
          const f32x4 k0 = cvt_lo4(pf[1].x, pf[1].y), k1 = cvt_lo4(pf[1].z, pf[1].w);
          *(LAS f32x4*)(rec + V_K * 256) = k0; *(LAS f32x4*)(rec + V_K * 256 + 16) = k1;
          float ss = 0.f;
#pragma unroll
          for (int e = 0; e < 4; ++e) { const float x0 = k0[e] * rkk8[e], x1 = k1[e] * rkk8[4 + e]; ss += x0 * x0 + x1 * x1; }
          ss += dpp_xor1(ss); ss += dpp_xor2(ss); ss += __shfl_xor(ss, 4);
          if (psub == 0) *(LAS float*)(lds + L_INV + pj * 4) = 1.0f / fmaxf(sqrtf(ss), 1e-12f);
          *(LAS u32x4*)(lds + L_TW + pj * PT + psub * 16) = pf[3]; *(LAS u32x4*)(lds + L_AL + pj * PT + psub * 16) = pf[4]; }
        __syncthreads();
        if (c + 1 < nchunk) RW_PREFETCH(c + 1);
#pragma unroll
        for (int cc = 0; cc < 2; ++cc) { const int ct = 2 * half + cc; const int cidx = 16 * ct + fr;
            f32x4 aw = (f32x4){0.f, 0.f, 0.f, 0.f}, aa = (f32x4){0.f, 0.f, 0.f, 0.f};
#pragma unroll
            for (int ks = 0; ks < 2; ++ks) { aw = ml::mma(ml::frag(lds, L_TW, PT, 16 * rt, 32 * ks, lane), bw[cc][ks], aw); aa = ml::mma(ml::frag(lds, L_AL, PT, 16 * rt, 32 * ks, lane), ba[cc][ks], aa); }
#pragma unroll
            for (int r = 0; r < 4; ++r) { const int tok = 16 * rt + 4 * fq + r; LAS float* rec = (LAS float*)(lds + L_SBUF + tok * REC) + cidx;
                const float decay = __expf(-0.6065306597126334f * pg8::fsigmoid(c_w0[cc] + aw[r])); const float alpha = pg8::fsigmoid(c_a0[cc] + aa[r]);
                const float kraw = rec[V_K * 64]; const float kkn = kraw * c_kk[cc] * *(LAS float*)(lds + L_INV + tok * 4);
                rec[V_A * 64] = -kkn; rec[V_W * 64] = decay; rec[V_B * 64] = kkn * alpha; rec[V_K * 64] = kraw * (1.0f + (alpha - 1.0f) * c_ka[cc]); } }
        __syncthreads();
#pragma unroll 4
        for (int tt = 0; tt < 64; ++tt) {
            const LAS unsigned char* rec = lds + L_SBUF + tt * REC + fr * 16;
            const f32x4 va = *(const LAS f32x4*)(rec + V_A * 256), vw = *(const LAS f32x4*)(rec + V_W * 256), vb = *(const LAS f32x4*)(rec + V_B * 256),
                        vk = *(const LAS f32x4*)(rec + V_K * 256), vr = *(const LAS f32x4*)(rec + V_R * 256);
            const float vv = *(const LAS float*)(lds + L_SBUF + tt * REC + V_V * 256 + row * 4);
            const float sa = allsum16((S[0] * va[0] + S[1] * va[1]) + (S[2] * va[2] + S[3] * va[3]));
            S = S * vw + vk * vv;
            S = S + vb * sa;
            const float y = allsum16((S[0] * vr[0] + S[1] * vr[1]) + (S[2] * vr[2] + S[3] * vr[3]));
            if (fr == 0) *(LAS float*)(lds + L_YS + (tt * 32 + 4 * w + fq) * 4) = y;
        }
        __syncthreads();
        if (tid < 256) { const int j = tid >> 2, pc = tid & 3; const LAS float* ys = (const LAS float*)(lds + L_YS) + j * 32 + 8 * pc;
            u32x4 o; o.x = pg8::cvt_pk_bf16(ys[0], ys[1]); o.y = pg8::cvt_pk_bf16(ys[2], ys[3]); o.z = pg8::cvt_pk_bf16(ys[4], ys[5]); o.w = pg8::cvt_pk_bf16(ys[6], ys[7]);
            *(u32x4*)(U + RW_TOK(c, j) * PU + OFF_R + dir * RW + hc + 32 * rh + 8 * pc) = o; }
    }
    if (!q.grid) { const size_t sb = (((size_t)q.b * DEPTH + l) * 2 + dir) * RH + head; *(f32x4*)(P.out + OUT_S + (sb * 64 + row) * 64 + 4 * fr) = S; }
    __syncthreads();
#undef RW_TOK
#undef RW_PREFETCH
}
constexpr int N_ITEMS = NSEQ * RH * 2 * 2;
__device__ __forceinline__ void decode_item(int it, int& s, int& head, int& dir, int& rh) {
    rh = it & 1; int ch = it >> 1; dir = ch & 1; ch >>= 1; head = ch % RH; const int sq = ch / RH;
    s = sq < LB ? CB + sq : sq - LB;
}
}


namespace el {
typedef float f32x4 __attribute__((ext_vector_type(4)));
typedef unsigned u32x4 __attribute__((ext_vector_type(4)));
typedef unsigned u32x2 __attribute__((ext_vector_type(2)));
typedef short bf16x8 __attribute__((ext_vector_type(8)));
__device__ __forceinline__ float wave_sum(float v) {
#pragma unroll
    for (int o = 1; o < 64; o <<= 1) v += __shfl_xor(v, o);
    return v;
}
__device__ __forceinline__ void unpack8(const u32x4 p, float (&f)[8]) {
    f[0] = pg8::bflo(p.x); f[1] = pg8::bfhi(p.x); f[2] = pg8::bflo(p.y); f[3] = pg8::bfhi(p.y); f[4] = pg8::bflo(p.z); f[5] = pg8::bfhi(p.z); f[6] = pg8::bflo(p.w); f[7] = pg8::bfhi(p.w);
}
__device__ __forceinline__ u32x4 pack8(const float (&f)[8]) {
    u32x4 o; o.x = pg8::cvt_pk_bf16(f[0], f[1]); o.y = pg8::cvt_pk_bf16(f[2], f[3]); o.z = pg8::cvt_pk_bf16(f[4], f[5]); o.w = pg8::cvt_pk_bf16(f[6], f[7]); return o;
}
__device__ __forceinline__ void init_phase(LAS unsigned char* lds, CParams& P, int vb, int G) {
    const int tid = threadIdx.x, w = tid >> 6, lane = tid & 63;
    { const size_t n4 = (size_t)NT * D / 4, nc4 = (size_t)NC * D / 4; f32x4* o = (f32x4*)P.out; const f32x4* a = (const f32x4*)P.in[X_PROMPT]; const f32x4* b = (const f32x4*)P.in[X_SAMPLE];
      for (size_t i = (size_t)vb * 512 + tid; i < n4; i += (size_t)G * 512) o[i] = i < nc4 ? a[i] : b[i - nc4]; }
    LAS float* red = (LAS float*)lds;
    constexpr int KW = D / 8;
    for (int it = vb; it < DEPTH * (6 * D / 64); it += G) {
        const int l = it / (6 * D / 64), j = (it % (6 * D / 64)) * 64 + lane;
        const float* wp = P.in[ADA_W] + ((size_t)l * D + w * KW) * 6 * D + j;
        float acc[NCOND];
#pragma unroll
        for (int ci = 0; ci < NCOND; ++ci) acc[ci] = 0.f;
        for (int k = 0; k < KW; ++k) { const float wv = wp[(size_t)k * 6 * D];
#pragma unroll
            for (int ci = 0; ci < NCOND; ++ci) { const float cv = ci == 0 ? P.in[C_CTX][w * KW + k] : P.in[C_LAT][(size_t)(ci - 1) * D + w * KW + k]; acc[ci] += cv * pg8::fsigmoid(cv) * wv; } }
#pragma unroll
        for (int ci = 0; ci < NCOND; ++ci) red[(w * NCOND + ci) * 64 + lane] = acc[ci];
        __syncthreads();
        if (w < NCOND) { float sum = P.in[ADA_B][(size_t)l * 6 * D + j];
#pragma unroll
            for (int ww = 0; ww < 8; ++ww) sum += red[(ww * NCOND + w) * 64 + lane];
            WSP(float, WS_MOD)[((size_t)l * NCOND + w) * 6 * D + j] = sum; }
        __syncthreads();
    }
}
__device__ __forceinline__ int perm5(int n) { return (((n >> 2) & 1) << 4) | (((n >> 3) & 3) << 2) | (n & 3); }
__device__ __forceinline__ void transpose_item(const float* W, int ldw, int nvalid, bf16* dst, int K, int k0, int drow0, bool perm, LAS float* scr, int lane) {
#pragma unroll 8
    for (int i = 0; i < 32; ++i) { const int kk = 2 * i + (lane >> 5), n = lane & 31; scr[kk * 33 + n] = n < nvalid ? W[(size_t)kk * ldw + n] : 0.f; }
    asm volatile("s_waitcnt lgkmcnt(0)" ::: "memory");
    const int c = lane & 7;
#pragma unroll
    for (int j = 0; j < 4; ++j) { const int n = (lane >> 3) + 8 * j; const LAS float* sp = scr + (8 * c) * 33 + n;
        u32x4 o; o.x = pg8::cvt_pk_bf16(sp[0 * 33], sp[1 * 33]); o.y = pg8::cvt_pk_bf16(sp[2 * 33], sp[3 * 33]); o.z = pg8::cvt_pk_bf16(sp[4 * 33], sp[5 * 33]); o.w = pg8::cvt_pk_bf16(sp[6 * 33], sp[7 * 33]);
        *(u32x4*)(dst + (size_t)(drow0 + (perm ? perm5(n) : n)) * K + k0 + 8 * c) = o; }
    asm volatile("s_waitcnt lgkmcnt(0)" ::: "memory");
}
constexpr int WI_0 = (N1P / 32) * (D / 64), WI_1 = WI_0 + (2 * D / 32) * (D / 64), WI_2 = WI_1 + (D / 32) * (MW / 64), WI_3 = WI_2 + (D / 32) * (RW / 64),
              WI_4 = WI_3 + (D / 32) * (D / 64), WI_5 = WI_4 + 2 * (FF / 32) * (D / 64), WI_6 = WI_5 + (D / 32) * (FF / 64), WI_7 = WI_6 + (RW / 32) * (128 / 64);
__device__ __forceinline__ void wconv_phase(LAS unsigned char* lds, CParams& P, int l, int vb, int G) {
    const int tid = threadIdx.x, w = tid >> 6, lane = tid & 63;
    LAS float* scr = (LAS float*)(lds + w * 8704);
    for (int it = vb * 8 + w; it < WI_7; it += G * 8) {
        if (it < WI_0) { const int nb = it / (D / 64), kb = it % (D / 64); const int n0 = nb * 32; const int nv = n0 >= N1 ? 0 : (N1 - n0 < 32 ? N1 - n0 : 32);
            transpose_item(P.in[W_IN] + ((size_t)l * D + kb * 64) * PIN + n0, PIN, nv, WSP(bf16, O_WIN1), D, kb * 64, n0, true, scr, lane); }
        else if (it < WI_1) { const int r = it - WI_0, nb = r / (D / 64), kb = r % (D / 64);
            transpose_item(P.in[W_IN] + ((size_t)l * D + kb * 64) * PIN + N1 + nb * 32, PIN, 32, WSP(bf16, O_WIN2), D, kb * 64, nb * 32, true, scr, lane); }
        else if (it < WI_2) { const int r = it - WI_1, nb = r / (MW / 64), kb = r % (MW / 64);
            transpose_item(P.in[PROJ_M] + ((size_t)l * MW + kb * 64) * D + nb * 32, D, 32, WSP(bf16, O_PM), MW, kb * 64, nb * 32, true, scr, lane); }
        else if (it < WI_3) { const int r = it - WI_2, nb = r / (RW / 64), kb = r % (RW / 64);
            transpose_item(P.in[PROJ_R] + ((size_t)l * RW + kb * 64) * D + nb * 32, D, 32, WSP(bf16, O_PR), RW, kb * 64, nb * 32, true, scr, lane); }
        else if (it < WI_4) { const int r = it - WI_3, nb = r / (D / 64), kb = r % (D / 64);
            transpose_item(P.in[W_OUT] + ((size_t)l * D + kb * 64) * D + nb * 32, D, 32, WSP(bf16, O_WO), D, kb * 64, nb * 32, false, scr, lane); }
        else if (it < WI_5) { const int r = it - WI_4, which = r / ((FF / 32) * (D / 64)), r2 = r % ((FF / 32) * (D / 64)), nb = r2 / (D / 64), kb = r2 % (D / 64);
            const int j0 = nb * 32, pn = j0 >> 7, drow0 = pn * 256 + which * 128 + (j0 & 127);
            transpose_item((which ? P.in[FFN_W3] : P.in[FFN_W1]) + ((size_t)l * D + kb * 64) * FF + j0, FF, 32, WSP(bf16, O_W13), D, kb * 64, drow0, true, scr, lane); }
        else if (it < WI_6) { const int r = it - WI_5, nb = r / (FF / 64), kb = r % (FF / 64);
            transpose_item(P.in[FFN_W2] + ((size_t)l * FF + kb * 64) * D + nb * 32, D, 32, WSP(bf16, O_W2), FF, kb * 64, nb * 32, false, scr, lane); }
        else { const int r = it - WI_6, nb = r / 2, kb = r % 2;
            transpose_item(P.in[R_G2] + ((size_t)l * 128 + kb * 64) * RW + nb * 32, RW, 32, WSP(bf16, O_G2T), 128, kb * 64, nb * 32, false, scr, lane); }
    }
}
__device__ __forceinline__ void norm_phase(CParams& P, int l, int mode, int vb, int G) {
    const int tid = threadIdx.x, w = tid >> 6, lane = tid & 63;
    for (int m = vb * 8 + w; m < NT; m += G * 8) {
        float* xr = P.out + (size_t)m * D;
        f32x4 v[D / 256]; float ss = 0.f;
#pragma unroll
        for (int j = 0; j < D / 256; ++j) { v[j] = *(const f32x4*)(xr + 256 * j + 4 * lane); ss += (v[j][0] * v[j][0] + v[j][1] * v[j][1]) + (v[j][2] * v[j][2] + v[j][3] * v[j][3]); }
        const float rs = 1.0f / sqrtf(wave_sum(ss) * (1.0f / D) + RMS_EPS);
        if (mode == 3) {
#pragma unroll
            for (int j = 0; j < D / 256; ++j) { const f32x4 g = *(const f32x4*)(P.in[FINAL_G] + 256 * j + 4 * lane); *(f32x4*)(xr + 256 * j + 4 * lane) = v[j] * rs * g; }
        } else {
            const int second = (mode == 2); const int cond = seqinfo(seq_of_token(m)).cond;
            const float* gp = P.in[second ? NORM2 : NORM1] + (size_t)l * D; const float* mod = WSP(float, WS_MOD) + ((size_t)l * NCOND + cond) * 6 * D + (second ? 3 * D : 0);
            bf16* o = WSP(bf16, mode == 1 ? WS_RXC : WS_QKC) + (size_t)m * D;
#pragma unroll
            for (int j = 0; j < D / 256; ++j) { const int c = 256 * j + 4 * lane; const f32x4 g = *(const f32x4*)(gp + c), sh = *(const f32x4*)(mod + c), sc = *(const f32x4*)(mod + D + c);
                const f32x4 y = v[j] * rs * g * (sc + 1.0f) + sh; u32x2 pk; pk.x = pg8::cvt_pk_bf16(y[0], y[1]); pk.y = pg8::cvt_pk_bf16(y[2], y[3]); *(u32x2*)(o + c) = pk; }
        }
    }
}
constexpr int CV_NCH = 2 * MW + RIN, CV_NG = CV_NCH / 8, CV_NCHUNK = (CV_NG + 63) / 64, CV_ITEMS = (NT / 64) * CV_NCHUNK;
__device__ __forceinline__ void conv_phase(CParams& P, int l, int vb, int G) {
    const int tid = threadIdx.x, w = tid >> 6, lane = tid & 63;
    const bf16* U = WSP(bf16, WS_U1);
    for (int it = vb * 8 + w; it < CV_ITEMS; it += G * 8) {
        const int seg = it / CV_NCHUNK, g = (it % CV_NCHUNK) * 64 + lane;
        if (g >= CV_NG) continue;
        const int ch = 8 * g; const bool isqk = ch < 2 * MW; const int c = isqk ? ch : ch - 2 * MW;
        const int ucol = isqk ? OFF_QK + c : OFF_R + c, CH = isqk ? 2 * MW : RIN;
        const float* wsrc = (isqk ? P.in[M_CONV] : P.in[R_CONV]) + (size_t)l * 9 * CH + c;
        const int kind = isqk ? (c < MW ? 0 : 1) : (c >= RX_GL ? 4 : (c >= RX_AL ? 2 : (c >= RX_WL ? 3 : 2)));
        const int m0 = seg * 64; const SeqInfo q = seqinfo(seq_of_token(m0)); const int t0 = m0 - q.base;
        if (q.grid) {
            float wt[9][8];
#pragma unroll
            for (int a = 0; a < 9; ++a) { const f32x4 w0 = *(const f32x4*)(wsrc + (size_t)a * CH), w1 = *(const f32x4*)(wsrc + (size_t)a * CH + 4);
#pragma unroll
                for (int e = 0; e < 4; ++e) { wt[a][e] = w0[e]; wt[a][4 + e] = w1[e]; } }
            const int r = t0 / GW, rows = q.T / GW;
            for (int cc = 0; cc < 64; ++cc) { const int col = (t0 % GW) + cc; float acc[8];
#pragma unroll
                for (int e = 0; e < 8; ++e) acc[e] = 0.f;
#pragma unroll
                for (int a = 0; a < 3; ++a)
#pragma unroll
                    for (int b = 0; b < 3; ++b) { const int rr = r + a - 1, c2 = col + b - 1;
                        if (rr >= 0 && rr < rows && c2 >= 0 && c2 < GW) { float xv[8]; unpack8(*(const u32x4*)(U + (size_t)(q.base + rr * GW + c2) * PU + ucol), xv);
#pragma unroll
                            for (int e = 0; e < 8; ++e) acc[e] += wt[a * 3 + b][e] * xv[e]; } }
                const size_t m = (size_t)m0 + cc;
#pragma unroll
                for (int e = 0; e < 8; ++e) { float v = acc[e];
                    if (kind <= 1) { v = v * pg8::fsigmoid(v); if (kind == 0) v *= 0.08838834764831845f; } else if (kind == 3) v = 1.0f - 2.0f * __builtin_amdgcn_rcpf(__expf(2.0f * v) + 1.0f); else if (kind == 4) v = pg8::fsigmoid(v);
                    acc[e] = v; }
                if (isqk) *(u32x4*)(WSP(bf16, WS_QKC) + m * (2 * MW) + c) = pack8(acc); else *(u32x4*)(WSP(bf16, WS_RXC) + m * RIN + c) = pack8(acc);
            }
        } else {
            float wt[3][8];
#pragma unroll
            for (int b = 0; b < 3; ++b) { const f32x4 w0 = *(const f32x4*)(wsrc + (size_t)(3 + b) * CH), w1 = *(const f32x4*)(wsrc + (size_t)(3 + b) * CH + 4);
#pragma unroll
                for (int e = 0; e < 4; ++e) { wt[b][e] = w0[e]; wt[b][4 + e] = w1[e]; } }
            for (int cc = 0; cc < 64; ++cc) { const int t = t0 + cc; float acc[8];
#pragma unroll
                for (int e = 0; e < 8; ++e) acc[e] = 0.f;
#pragma unroll
                for (int b = 0; b < 3; ++b) { const int t2 = t + b - 1;
                    if (t2 >= 0 && t2 < q.T) { float xv[8]; unpack8(*(const u32x4*)(U + (size_t)(q.base + t2) * PU + ucol), xv);
#pragma unroll
                        for (int e = 0; e < 8; ++e) acc[e] += wt[b][e] * xv[e]; } }
                const size_t m = (size_t)m0 + cc;
#pragma unroll
                for (int e = 0; e < 8; ++e) { float v = acc[e];
                    if (kind <= 1) { v = v * pg8::fsigmoid(v); if (kind == 0) v *= 0.08838834764831845f; } else if (kind == 3) v = 1.0f - 2.0f * __builtin_amdgcn_rcpf(__expf(2.0f * v) + 1.0f); else if (kind == 4) v = pg8::fsigmoid(v);
                    acc[e] = v; }
                if (isqk) *(u32x4*)(WSP(bf16, WS_QKC) + m * (2 * MW) + c) = pack8(acc); else *(u32x4*)(WSP(bf16, WS_RXC) + m * RIN + c) = pack8(acc);
            }
        }
    }
}
constexpr int PO_ITEMS = (NT / 16) * 2, PO_HC = RW / 2;
__device__ __forceinline__ void post_phase(LAS unsigned char* lds, CParams& P, int l, int vb, int G) {
    const int tid = threadIdx.x, w = tid >> 6, lane = tid & 63, fr = lane & 15, fq = lane >> 4, l32 = lane & 31, th = lane >> 5;
    constexpr int GP = PO_HC * 2 + 16;
    LAS unsigned char* gt = lds + w * (16 * GP);
    const bf16* U = WSP(bf16, WS_U1); const bf16* RX = WSP(bf16, WS_RXC); const bf16* G2T = WSP(bf16, O_G2T); bf16* O = WSP(bf16, WS_QKC);
    for (int it = vb * 8 + w; it < PO_ITEMS; it += G * 8) {
        const int tile = it >> 1, h = it & 1; const size_t tok0 = (size_t)tile * 16;
        bf16x8 af[4];
#pragma unroll
        for (int ks = 0; ks < 4; ++ks) af[ks] = *(const bf16x8*)(RX + (tok0 + fr) * RIN + RX_GL + 32 * ks + 8 * fq);
        for (int ct = 0; ct < PO_HC / 16; ++ct) { f32x4 acc = (f32x4){0.f, 0.f, 0.f, 0.f};
#pragma unroll
            for (int ks = 0; ks < 4; ++ks) acc = ml::mma(af[ks], *(const bf16x8*)(G2T + (size_t)(h * PO_HC + 16 * ct + fr) * 128 + 32 * ks + 8 * fq), acc);
#pragma unroll
            for (int r = 0; r < 4; ++r) *(LAS bf16*)(gt + (4 * fq + r) * GP + (16 * ct + fr) * 2) = f2bf(acc[r]); }
        asm volatile("s_waitcnt lgkmcnt(0)" ::: "memory");
        const int cb = h * PO_HC + 8 * l32;
        float gn[8], gw[8], gb[8], rk[8];
        { const f32x4 a0 = *(const f32x4*)(P.in[M_NORM_G] + (size_t)l * MW + cb), a1 = *(const f32x4*)(P.in[M_NORM_G] + (size_t)l * MW + cb + 4);
          const f32x4 b0 = *(const f32x4*)(P.in[R_GN_W] + (size_t)l * RW + cb), b1 = *(const f32x4*)(P.in[R_GN_W] + (size_t)l * RW + cb + 4);
          const f32x4 c0 = *(const f32x4*)(P.in[R_GN_B] + (size_t)l * RW + cb), c1 = *(const f32x4*)(P.in[R_GN_B] + (size_t)l * RW + cb + 4);
          const f32x4 d0 = *(const f32x4*)(P.in[R_RK] + (size_t)l * RW + cb), d1 = *(const f32x4*)(P.in[R_RK] + (size_t)l * RW + cb + 4);
#pragma unroll
          for (int e = 0; e < 4; ++e) { gn[e] = a0[e]; gn[4 + e] = a1[e]; gw[e] = b0[e]; gw[4 + e] = b1[e]; gb[e] = c0[e]; gb[4 + e] = c1[e]; rk[e] = d0[e]; rk[4 + e] = d1[e]; } }
        for (int tp = 0; tp < 8; ++tp) { const int tl = 2 * tp + th; const size_t m = tok0 + tl; const bf16* u = U + m * PU; const bf16* rx = RX + m * RIN;
            float hf[8], hb[8], ov[8], x[8]; unpack8(*(const u32x4*)(u + cb), hf); unpack8(*(const u32x4*)(u + MW + cb), hb); unpack8(*(const u32x4*)(u + OFF_O + cb), ov);
            float ss = 0.f;
#pragma unroll
            for (int e = 0; e < 8; ++e) { x[e] = hf[e] + hb[e]; ss += x[e] * x[e]; }
            ss = rw::allsum16(ss); const float rs = 1.0f / sqrtf(ss * (1.0f / 128.f) + RMS_EPS);
#pragma unroll
            for (int e = 0; e < 8; ++e) x[e] = x[e] * rs * gn[e] * pg8::fsigmoid(ov[e]);
            *(u32x4*)(O + m * D + cb) = pack8(x);
            float yf[8], yb[8], rr[8], kk[8], vv[8], gg[8], y[8]; unpack8(*(const u32x4*)(u + OFF_R + cb), yf); unpack8(*(const u32x4*)(u + OFF_R + RW + cb), yb);
            unpack8(*(const u32x4*)(rx + RX_R + cb), rr); unpack8(*(const u32x4*)(rx + RX_K + cb), kk); unpack8(*(const u32x4*)(rx + RX_V + cb), vv);
            unpack8(*(const LAS u32x4*)(gt + tl * GP + l32 * 16), gg);
            float mu = 0.f, bs = 0.f;
#pragma unroll
            for (int e = 0; e < 8; ++e) { y[e] = yf[e] + yb[e]; mu += y[e]; bs += rr[e] * kk[e] * rk[e]; }
            mu += rw::dpp_xor1(mu); mu += rw::dpp_xor2(mu); mu += __shfl_xor(mu, 4); mu *= (1.0f / 64.f);
            bs += rw::dpp_xor1(bs); bs += rw::dpp_xor2(bs); bs += __shfl_xor(bs, 4);
            float var = 0.f;
#pragma unroll
            for (int e = 0; e < 8; ++e) { y[e] -= mu; var += y[e] * y[e]; }
            var += rw::dpp_xor1(var); var += rw::dpp_xor2(var); var += __shfl_xor(var, 4); var *= (1.0f / 64.f);
            const float rsd = 1.0f / sqrtf(var + GN_EPS);
#pragma unroll
            for (int e = 0; e < 8; ++e) y[e] = (y[e] * rsd * gw[e] + gb[e] + bs * vv[e]) * gg[e];
            *(u32x4*)(O + m * D + MW + cb) = pack8(y);
        }
        asm volatile("s_waitcnt lgkmcnt(0)" ::: "memory");
    }
}
}

constexpr int LDS_BYTES = 147456;
constexpr int LDS_MISC = 131072 + 320;
constexpr size_t CTL_ZERO_BYTES = 65536;
constexpr int CW_BAR = 4096, CW_Q = 8192;

#define XB_TMO      128
#define XB_XCNT(j)  (256  + 64 * (j))
#define XB_XSUB(j)  (1280 + 64 * (j))
#define XB_XGEN(j)  (2304 + 64 * (j))
#define XB_TOP      3328
#define XB_TOPGEN   3392
#define XCD_BAR_WORDS 3456
#define XB_SPIN_CAP (1u << 18)
__device__ __forceinline__ unsigned xb_ld(unsigned* p)              { return __hip_atomic_load(p, __ATOMIC_RELAXED, __HIP_MEMORY_SCOPE_AGENT); }
__device__ __forceinline__ unsigned xb_add(unsigned* p, unsigned v) { return __hip_atomic_fetch_add(p, v, __ATOMIC_RELAXED, __HIP_MEMORY_SCOPE_AGENT); }
__device__ __forceinline__ unsigned xb_xcc_id() { return (unsigned)__builtin_amdgcn_s_getreg((3 << 11) | 20) & 0xFu; }
#define XB_SPIN(cond, bar) do { unsigned _sp = 0; while (cond) { __builtin_amdgcn_s_sleep(1); \
    if ((++_sp & 255u) == 0u) { if (xb_ld(&(bar)[XB_TMO])) break; if (_sp > XB_SPIN_CAP) { atomicAdd(&(bar)[XB_TMO], 1u); break; } } } } while (0)
struct XcdBarrier { unsigned* bar; unsigned x; volatile LAS unsigned* st; };
__device__ __forceinline__ XcdBarrier xcd_barrier_post(unsigned* bar, volatile LAS unsigned* st) {
    XcdBarrier b; b.bar = bar; b.x = xb_xcc_id(); b.st = st;
    if (threadIdx.x == 0) (void)xb_add(&bar[XB_XCNT(b.x)], 1u);
    return b;
}
__device__ __forceinline__ void xcd_barrier_complete(unsigned* bar, unsigned x, unsigned& nloc, unsigned& nx) {
    const unsigned G = gridDim.x * gridDim.y * gridDim.z;
    unsigned sum, cnt, mine, sp = 0u;
    for (;;) {
        sum = 0u; cnt = 0u; mine = 0u;
#pragma unroll
        for (unsigned j = 0; j < 16; ++j) { const unsigned c = xb_ld(&bar[XB_XCNT(j)]); sum += c; cnt += (c > 0u) ? 1u : 0u; mine = (j == x) ? c : mine; }
        if (sum == G) break;
        __builtin_amdgcn_s_sleep(1);
        if ((++sp & 255u) == 0u) { if (xb_ld(&bar[XB_TMO])) break; if (sp > XB_SPIN_CAP) { atomicAdd(&bar[XB_TMO], 1u); break; } }
    }
    nloc = mine > 0u ? mine : 1u; nx = cnt > 0u ? cnt : 1u;
}
__device__ __forceinline__ void xcd_barrier(const XcdBarrier& b) {
    asm volatile("s_waitcnt vmcnt(0)" ::: "memory");
    __syncthreads();
    if (threadIdx.x == 0) {
        unsigned* bar = b.bar;
        __builtin_amdgcn_s_waitcnt(0);
        unsigned nloc = b.st[0], nx = b.st[1];
        if (nloc == 0u) { xcd_barrier_complete(bar, b.x, nloc, nx); b.st[0] = nloc; b.st[1] = nx; }
        const unsigned old = xb_add(&bar[XB_XSUB(b.x)], 1u);
        const unsigned gen = old / nloc;
        if (old + 1u == (gen + 1u) * nloc) {
            __builtin_amdgcn_fence(__ATOMIC_RELEASE, "agent");
            asm volatile("s_waitcnt vmcnt(0)" ::: "memory");
            const unsigned og = xb_add(&bar[XB_TOP], 1u);
            const unsigned tg = og / nx;
            if (og + 1u == (tg + 1u) * nx) xb_add(&bar[XB_TOPGEN], 1u);
            else XB_SPIN(xb_ld(&bar[XB_TOPGEN]) == tg, bar);
            __builtin_amdgcn_fence(__ATOMIC_ACQUIRE, "agent");
            xb_add(&bar[XB_XGEN(b.x)], 1u);
            asm volatile("s_waitcnt vmcnt(0)" ::: "memory");
        } else {
            XB_SPIN(xb_ld(&bar[XB_XGEN(b.x)]) == gen, bar);
            __builtin_amdgcn_fence(__ATOMIC_ACQUIRE, "agent");
            asm volatile("s_waitcnt vmcnt(0)" ::: "memory");
        }
    }
    __syncthreads();
}

constexpr int MX_RL = LB * RH * 2 * 2, MX_ML = LB * MH * 2 * ml::NVB, MX_RC = CB * RH * 2 * 2, MX_MC = CB * MH * 2 * ml::NVB;
constexpr int MX_ITEMS = MX_RL + MX_ML + MX_RC + MX_MC;
static_assert(MX_RL + MX_RC == rw::N_ITEMS && MX_ML + MX_MC == ml::N_ITEMS, "scan item counts");
__device__ __forceinline__ void scan_phase(LAS unsigned char* lds, CParams& P, int l, unsigned* qhead) {
    volatile LAS unsigned* bc = (volatile LAS unsigned*)(lds + LDS_MISC) + 16;
    for (;;) {
        if (threadIdx.x == 0) bc[0] = xb_add(qhead, 1u);
        __syncthreads();
        const int it = (int)bc[0];
        __syncthreads();
        if (it >= MX_ITEMS) break;
        int s_, head, dir, sub; bool is_rw;
        if (it < MX_RL) { is_rw = true; rw::decode_item(it, s_, head, dir, sub); }
        else if (it < MX_RL + MX_ML) { is_rw = false; ml::decode_item(it - MX_RL, s_, head, dir, sub); }
        else if (it < MX_RL + MX_ML + MX_RC) { is_rw = true; rw::decode_item(it - MX_ML, s_, head, dir, sub); }
        else { is_rw = false; ml::decode_item(it - MX_RL - MX_RC, s_, head, dir, sub); }
        if (is_rw) rw::rwkv_item(lds, P, l, s_, head, dir, sub); else ml::mlstm_item(lds, P, l, s_, head, dir, sub);
    }
}

enum { ST_N0 = 0, ST_A1, ST_CV, ST_MX, ST_PO, ST_N1, ST_A2, ST_PJ, ST_WO, ST_N2, ST_F1, ST_F2, ST_PER_LAYER };
constexpr int N_STEPS = 1 + DEPTH * ST_PER_LAYER + 1;
struct MkArgs { Params P; int ph_lo, ph_hi; };
__global__ void __launch_bounds__(512, 2) mk(MkArgs a) {
    extern __shared__ __attribute__((aligned(16))) unsigned char lds_raw[];
    LAS unsigned char* lds = (LAS unsigned char*)lds_raw;
    const int G = gridDim.x, vb = (int)blockIdx.x;
    unsigned* ctl = (unsigned*)(a.P.ws + WS_CTL);
    volatile LAS unsigned* MISC = (volatile LAS unsigned*)(lds + LDS_MISC);
    for (int u = threadIdx.x; u < 64; u += 512) MISC[u] = 0u;
    __syncthreads();
    const bool multi = a.ph_hi - a.ph_lo > 1;
    XcdBarrier bar; bar.bar = ctl + CW_BAR; bar.x = 0; bar.st = nullptr;
    if (multi) bar = xcd_barrier_post(ctl + CW_BAR, MISC + 8);
    const int lo = a.ph_lo, hi = a.ph_hi;
#define STEP_BEGIN(id) if (lo <= (id) && (id) < hi) { unsigned long long kp_ = (unsigned long long)__builtin_amdgcn_kernarg_segment_ptr(); asm volatile("" : "+s"(kp_)); CParams& P = *(CParams*)kp_;
#define STEP_END(id) if ((id) + 1 < hi) xcd_barrier(bar); }
    STEP_BEGIN(0) el::init_phase(lds, P, vb, G); el::wconv_phase(lds, P, 0, vb, G); STEP_END(0)
#define LAYER(l) { \
        const int base = 1 + (l) * ST_PER_LAYER; \
        STEP_BEGIN(base + ST_N0) if ((l) > 0) el::wconv_phase(lds, P, (l), vb, G); el::norm_phase(P, (l), 0, vb, G); STEP_END(base + ST_N0) \
        STEP_BEGIN(base + ST_A1) { pg8::Gemm g{WSP(bf16, WS_QKC), WSP(bf16, O_WIN1), D, D}; pg8::StaticOrder S; S.init(NT, N1P, G, vb); \
            pg8::EpiA1 E{WSP(bf16, WS_U1)}; pg8::gemm_phase(lds, g, S, E); } STEP_END(base + ST_A1) \
        STEP_BEGIN(base + ST_CV) el::conv_phase(P, (l), vb, G); STEP_END(base + ST_CV) \
        STEP_BEGIN(base + ST_MX) scan_phase(lds, P, (l), ctl + CW_Q + 64 * (l)); STEP_END(base + ST_MX) \
        STEP_BEGIN(base + ST_PO) el::post_phase(lds, P, (l), vb, G); STEP_END(base + ST_PO) \
        STEP_BEGIN(base + ST_N1) el::norm_phase(P, (l), 1, vb, G); STEP_END(base + ST_N1) \
        STEP_BEGIN(base + ST_A2) { pg8::Gemm g{WSP(bf16, WS_RXC), WSP(bf16, O_WIN2), D, D}; pg8::StaticOrder S; S.init(NT, 2 * D, G, vb); \
            pg8::EpiA2 E{WSP(bf16, WS_U1)}; pg8::gemm_phase(lds, g, S, E); } STEP_END(base + ST_A2) \
        STEP_BEGIN(base + ST_PJ) { pg8::Gemm g{WSP(bf16, WS_QKC), WSP(bf16, O_PM), MW, D}; pg8::PairOrder S; S.init(NT, G, vb); \
            pg8::EpiPJ E{WSP(bf16, WS_U1)}; pg8::gemm_phase(lds, g, S, E); } STEP_END(base + ST_PJ) \
        STEP_BEGIN(base + ST_WO) { pg8::Gemm g{WSP(bf16, WS_U1), WSP(bf16, O_WO), D, PU}; pg8::StaticOrder S; S.init(NT, D, G, vb); \
            pg8::EpiRes E{P.out, WSP(float, WS_MOD) + (size_t)(l) * NCOND * 6 * D + 2 * D}; pg8::gemm_phase(lds, g, S, E); } STEP_END(base + ST_WO) \
        STEP_BEGIN(base + ST_N2) el::norm_phase(P, (l), 2, vb, G); STEP_END(base + ST_N2) \
        STEP_BEGIN(base + ST_F1) { pg8::Gemm g{WSP(bf16, WS_QKC), WSP(bf16, O_W13), D, D}; pg8::StaticOrder S; S.init(NT, 2 * FF, G, vb); \
            pg8::EpiF1 E{WSP(bf16, WS_U1)}; pg8::gemm_phase(lds, g, S, E); } STEP_END(base + ST_F1) \
        STEP_BEGIN(base + ST_F2) { pg8::Gemm g{WSP(bf16, WS_U1), WSP(bf16, O_W2), FF, FF}; pg8::StaticOrder S; S.init(NT, D, G, vb); \
            pg8::EpiRes E{P.out, WSP(float, WS_MOD) + (size_t)(l) * NCOND * 6 * D + 5 * D}; pg8::gemm_phase(lds, g, S, E); } STEP_END(base + ST_F2) \
    }
    static_assert(DEPTH == 2, "layers are unrolled by hand");
    LAYER(0)
    LAYER(1)
#undef LAYER
    STEP_BEGIN(N_STEPS - 1) el::norm_phase(P, 0, 3, vb, G); STEP_END(N_STEPS - 1)
#undef STEP_BEGIN
#undef STEP_END
}
#endif

typedef void (*BodyFn)(const Params&, long);
#ifndef HOST_EMU
template <BodyFn F, int BLOCK> __global__ void __launch_bounds__(BLOCK) run_k(Params P, long n) {
    const long i = (long)blockIdx.x * BLOCK + threadIdx.x;
    if (i < n) F(P, i);
}
#define RUN(F, BLOCK, n) do { const long n_ = (n); run_k<F, BLOCK><<<dim3((unsigned)((n_ + BLOCK - 1) / BLOCK)), dim3(BLOCK), 0, stream>>>(P, n_); } while (0)
static int g_grid = 0;
#else
#define RUN(F, BLOCK, n) do { const long n_ = (n); for (long i_ = 0; i_ < n_; ++i_) F(P, i_); } while (0)
typedef void* hipStream_t;
#endif

static void forward(Params P, hipStream_t stream) {
    (void)stream;
#ifndef HOST_EMU
    if (hipMemsetAsync(P.ws + WS_CTL, 0, CTL_ZERO_BYTES, stream) != hipSuccess) return;
#ifdef MK_PER_STEP
    for (int st = 0; st < N_STEPS; ++st) { MkArgs a_{}; a_.P = P; a_.ph_lo = st; a_.ph_hi = st + 1; mk<<<dim3(g_grid), dim3(512), LDS_BYTES, stream>>>(a_); }
#else
    { MkArgs a_{}; a_.P = P; a_.ph_lo = 0; a_.ph_hi = N_STEPS; mk<<<dim3(g_grid), dim3(512), LDS_BYTES, stream>>>(a_); }
#endif
#else
    RUN(k_init_x, 256, (long)NT * D);
    RUN(k_mod, 256, (long)DEPTH * NCOND * 6 * D);
    for (int l = 0; l < DEPTH; ++l) {
        P.layer = l;
        RUN(k_wconv, 256, WC_N6);
        P.mode = 0; RUN(k_norm, 64, (long)NT);
        RUN(k_gemm_a1, 256, (long)NT * N1);
        RUN(k_conv, 256, (long)NT * (2 * MW + RIN));
        RUN(k_mlstm, 128, (long)NSEQ * MH * 2 * 128);
        for (int dir = 0; dir < 2; ++dir) { P.mode = dir; RUN(k_rwkv_prep, 256, (long)NT * RW); RUN(k_rwkv, 64, (long)NSEQ * RH * 64); }
        RUN(k_post, 256, (long)NT * D);
        P.mode = 1; RUN(k_norm, 64, (long)NT);
        RUN(k_gemm_a2, 256, (long)NT * 2 * D);
        RUN(k_gemm_pj, 256, (long)NT * D);
        RUN(k_gemm_wo, 256, (long)NT * D);
        P.mode = 2; RUN(k_norm, 64, (long)NT);
        RUN(k_gemm_f1, 256, (long)NT * FF);
        RUN(k_gemm_f2, 256, (long)NT * D);
    }
    RUN(k_final, 64, (long)NT);
#endif
}

#ifndef HOST_EMU
extern "C" void kernel_launch(void* const* d_in, const int* in_sizes, int n_in, void* d_out, int out_size, void* d_ws, size_t ws_size, hipStream_t stream) {
    if (n_in != N_IN || (size_t)out_size != OUT_END || ws_size < WS_END) return;
    if (g_grid == 0) {
        int dev = 0, cus = 0;
        if (hipGetDevice(&dev) != hipSuccess || hipDeviceGetAttribute(&cus, hipDeviceAttributeMultiprocessorCount, dev) != hipSuccess) { g_grid = -1; return; }
        if (hipFuncSetAttribute((const void*)mk, hipFuncAttributeMaxDynamicSharedMemorySize, LDS_BYTES) != hipSuccess) { g_grid = -1; return; }
        g_grid = cus;
    }
    if (g_grid < 0) return;
    Params P{};
    for (int i = 0; i < N_IN; ++i) P.in[i] = (const float*)d_in[i];
    P.out = (float*)d_out; P.ws = (unsigned char*)d_ws; P.layer = 0; P.mode = 0;
    forward(P, stream);
}
#endif
```

```cpp
#ifndef HOST_EMU
#include <hip/hip_runtime.h>
#define HD __host__ __device__ __forceinline__
#define DEV __device__ __forceinline__
#else
#include <cmath>
#include <cstring>
#include <cstdio>
#include <cstdlib>
#define HD inline
#define DEV inline
#endif
#include <cstddef>

#ifdef SMALL_CFG
constexpr int D = 256, CB = 2, CT = 128, DEPTH = 2, LB = 1, LT = 256, GW = 16;
#else
constexpr int D = 1024, CB = 32, CT = 256, DEPTH = 2, LB = 2, LT = 4096, GW = 64;
#endif
constexpr int MW = D / 2, MD = 128, MH = MW / MD, RW = D / 2, RD = 64, RH = RW / RD;
constexpr int RIN = 3 * RW + 384, FF = ((8 * D + 767) / 768) * 256, PIN = 2 * MW + MW + MW + 4 * MH + RIN + 2 * D;
constexpr int NC = CB * CT, NL = LB * LT, NT = NC + NL, NSEQ = CB + LB, NCOND = 1 + LB;
constexpr int N1 = PIN - 2 * D;
constexpr int N1P = ((N1 + 255) / 256) * 256;
constexpr int PU = N1;
constexpr int OFF_QK = 0, OFF_V = 2 * MW, OFF_O = 3 * MW, OFF_G = 4 * MW, OFF_R = 4 * MW + 4 * MH;
constexpr int RX_R = 0, RX_K = RW, RX_V = 2 * RW, RX_WL = 3 * RW, RX_AL = 3 * RW + 128, RX_GL = 3 * RW + 256;
constexpr float RMS_EPS = 1e-6f, GN_EPS = 64e-5f;
static_assert(3 * D <= N1, "G + merged must fit the dead columns of U1");

enum { X_PROMPT = 0, X_SAMPLE, ST_C, ST_N, ST_M, ST_R, C_LAT, C_CTX, ADA_W, ADA_B, NORM1, NORM2, W_IN, M_CONV, M_GATE_B, M_NORM_G,
       R_CONV, R_W0, R_W2, R_A0, R_A2, R_G2, R_KK, R_KA, R_RK, R_GN_W, R_GN_B, PROJ_M, PROJ_R, W_OUT, FFN_W1, FFN_W3, FFN_W2, FINAL_G, N_IN };

constexpr size_t OUT_X = 0;
constexpr size_t OUT_C = (size_t)NT * D;
constexpr size_t OUT_N = OUT_C + (size_t)CB * DEPTH * 2 * MH * 128 * 128;
constexpr size_t OUT_M = OUT_N + (size_t)CB * DEPTH * 2 * MH * 128;
constexpr size_t OUT_S = OUT_M + (size_t)CB * DEPTH * 2 * MH;
constexpr size_t OUT_END = OUT_S + (size_t)CB * DEPTH * 2 * RH * 64 * 64;

constexpr size_t al256(size_t x) { return (x + 255) & ~(size_t)255; }
constexpr size_t cmax(size_t a, size_t b) { return a > b ? a : b; }
constexpr size_t WS_CTL = 0;
constexpr size_t WS_MOD = (size_t)1 << 20;
constexpr size_t WS_WREG = (size_t)2 << 20;
constexpr size_t O_WIN1 = WS_WREG;
constexpr size_t O_WIN2 = O_WIN1 + (size_t)N1P * D * 2;
constexpr size_t O_PM = O_WIN2 + (size_t)2 * D * D * 2;
constexpr size_t O_PR = O_PM + (size_t)D * MW * 2;
constexpr size_t O_WO = O_PR + (size_t)D * RW * 2;
constexpr size_t O_W13 = O_WO + (size_t)D * D * 2;
constexpr size_t O_W2 = O_W13 + (size_t)2 * FF * D * 2;
constexpr size_t O_G2T = O_W2 + (size_t)D * FF * 2;
constexpr size_t O_W2T = O_G2T + (size_t)RW * 128 * 2;
constexpr size_t O_A2T = O_W2T + (size_t)2 * RW * 64 * 2;
constexpr size_t WS_U1 = al256(O_A2T + (size_t)2 * RW * 64 * 2);
constexpr size_t SZ_U1 = al256(cmax((size_t)NT * PU * 2, (size_t)NT * FF * 2));
constexpr size_t WS_QKC = WS_U1 + SZ_U1;
constexpr size_t WS_RXC = WS_QKC + (size_t)NT * D * 2;
constexpr size_t WS_END = WS_RXC + al256(cmax((size_t)NT * RIN * 2, (size_t)NT * D * 2));
#ifndef SMALL_CFG
static_assert(WS_END <= ((size_t)256 << 20), "workspace map must fit 256 MiB");
#endif

typedef unsigned short bf16;
HD float bf2f(bf16 b) { unsigned u = ((unsigned)b) << 16; return __builtin_bit_cast(float, u); }
HD bf16 f2bf(float f) { unsigned u = __builtin_bit_cast(unsigned, f); u += 0x7fffu + ((u >> 16) & 1u); return (bf16)(u >> 16); }
HD float sigmoidf_(float x) { return 1.0f / (1.0f + expf(-x)); }
HD float siluf_(float x) { return x / (1.0f + expf(-x)); }
HD float softplusf_(float x) { return fmaxf(x, 0.f) + log1pf(expf(-fabsf(x))); }
HD float logsigmoidf_(float x) { return -softplusf_(-x); }
HD int prow(int c) { return (c & ~31) | (((c >> 2) & 1) << 4) | (((c >> 3) & 3) << 2) | (c & 3); }

struct Params {
    const float* in[N_IN];
    float* out;
    unsigned char* ws;
    int layer;
    int mode;
};

struct SeqInfo { int T; int base; int grid; int cond; int b; };
HD SeqInfo seqinfo(int s) {
    SeqInfo q;
    if (s < CB) { q.T = CT; q.base = s * CT; q.grid = 0; q.cond = 0; q.b = s; }
    else { q.T = LT; q.base = NC + (s - CB) * LT; q.grid = 1; q.cond = 1 + (s - CB); q.b = s - CB; }
    return q;
}
HD int seq_of_token(int m) { return m < NC ? m / CT : CB + (m - NC) / LT; }

#define WSP(T, off) ((T*)(P.ws + (off)))

DEV void k_init_x(const Params& P, long i) {
    const size_t ncd = (size_t)NC * D;
    P.out[i] = (size_t)i < ncd ? P.in[X_PROMPT][i] : P.in[X_SAMPLE][i - ncd];
}
DEV void k_mod(const Params& P, long i) {
    const int j = (int)(i % (6 * D)); const int ci = (int)((i / (6 * D)) % NCOND); const int l = (int)(i / ((long)6 * D * NCOND));
    const float* cv = ci == 0 ? P.in[C_CTX] : P.in[C_LAT] + (size_t)(ci - 1) * D;
    const float* w = P.in[ADA_W] + (size_t)l * D * 6 * D;
    float acc = P.in[ADA_B][(size_t)l * 6 * D + j];
    for (int k = 0; k < D; ++k) acc += siluf_(cv[k]) * w[(size_t)k * 6 * D + j];
    WSP(float, WS_MOD)[i] = acc;
}
constexpr long WC_N0 = (long)N1P * D, WC_N1 = WC_N0 + (long)2 * D * D, WC_N2 = WC_N1 + (long)D * MW, WC_N3 = WC_N2 + (long)D * RW,
               WC_N4 = WC_N3 + (long)D * D, WC_N5 = WC_N4 + (long)2 * FF * D, WC_N6 = WC_N5 + (long)D * FF;
HD int unprow(int r) { return (r & ~31) | (((r >> 2) & 3) << 3) | (((r >> 4) & 1) << 2) | (r & 3); }
DEV void k_wconv(const Params& P, long i) {
    const int l = P.layer;
    if (i < WC_N0) { const int r = (int)(i / D), k = (int)(i % D); const int c = unprow(r);
        WSP(bf16, O_WIN1)[i] = c < N1 ? f2bf(P.in[W_IN][((size_t)l * D + k) * PIN + c]) : (bf16)0; return; }
    if (i < WC_N1) { const long j = i - WC_N0; const int r = (int)(j / D), k = (int)(j % D); const int c = unprow(r);
        WSP(bf16, O_WIN2)[j] = f2bf(P.in[W_IN][((size_t)l * D + k) * PIN + N1 + c]); return; }
    if (i < WC_N2) { const long j = i - WC_N1; const int r = (int)(j / MW), k = (int)(j % MW); const int c = unprow(r);
        WSP(bf16, O_PM)[j] = f2bf(P.in[PROJ_M][((size_t)l * MW + k) * D + c]); return; }
    if (i < WC_N3) { const long j = i - WC_N2; const int r = (int)(j / RW), k = (int)(j % RW); const int c = unprow(r);
        WSP(bf16, O_PR)[j] = f2bf(P.in[PROJ_R][((size_t)l * RW + k) * D + c]); return; }
    if (i < WC_N4) { const long j = i - WC_N3; const int r = (int)(j / D), k = (int)(j % D);
        WSP(bf16, O_WO)[j] = f2bf(P.in[W_OUT][((size_t)l * D + k) * D + r]); return; }
    if (i < WC_N5) { const long j = i - WC_N4; const int r = (int)(j / D), k = (int)(j % D);
        const int pn = r >> 8, rl = r & 255, which = rl >> 7, rho = rl & 127; const int jj = pn * 128 + unprow(rho);
        const float* W = which ? P.in[FFN_W3] : P.in[FFN_W1];
        WSP(bf16, O_W13)[j] = f2bf(W[((size_t)l * D + k) * FF + jj]); return; }
    { const long j = i - WC_N5; const int r = (int)(j / FF), k = (int)(j % FF);
        WSP(bf16, O_W2)[j] = f2bf(P.in[FFN_W2][((size_t)l * FF + k) * D + r]); }
}
DEV void k_norm(const Params& P, long m) {
    const int l = P.layer; const int second = (P.mode == 2);
    const float* x = P.out + (size_t)m * D;
    const float* g = P.in[second ? NORM2 : NORM1] + (size_t)l * D;
    const int cond = seqinfo(seq_of_token((int)m)).cond;
    const float* mod = WSP(float, WS_MOD) + ((size_t)l * NCOND + cond) * 6 * D + (second ? 3 * D : 0);
    float ss = 0.f;
    for (int k = 0; k < D; ++k) ss += x[k] * x[k];
    const float rs = 1.0f / sqrtf(ss / D + RMS_EPS);
    bf16* o = WSP(bf16, P.mode == 1 ? WS_RXC : WS_QKC) + (size_t)m * D;
    for (int k = 0; k < D; ++k) o[k] = f2bf(x[k] * rs * g[k] * (1.0f + mod[D + k]) + mod[k]);
}
DEV float dot_bf(const bf16* a, const bf16* b, int K) { float s = 0.f; for (int k = 0; k < K; ++k) s += bf2f(a[k]) * bf2f(b[k]); return s; }
DEV void k_gemm_a1(const Params& P, long i) {
    const int n = (int)(i % N1); const long m = i / N1;
    WSP(bf16, WS_U1)[(size_t)m * PU + n] = f2bf(dot_bf(WSP(bf16, WS_QKC) + (size_t)m * D, WSP(bf16, O_WIN1) + (size_t)prow(n) * D, D));
}
DEV void k_gemm_a2(const Params& P, long i) {
    const int n = (int)(i % (2 * D)); const long m = i / (2 * D);
    WSP(bf16, WS_U1)[(size_t)m * PU + D + n] = f2bf(sigmoidf_(dot_bf(WSP(bf16, WS_RXC) + (size_t)m * D, WSP(bf16, O_WIN2) + (size_t)prow(n) * D, D)));
}
DEV void k_gemm_pj(const Params& P, long i) {
    const int n = (int)(i % D); const long m = i / D;
    const bf16* hmr = WSP(bf16, WS_QKC) + (size_t)m * D; bf16* u = WSP(bf16, WS_U1) + (size_t)m * PU;
    const float a = dot_bf(hmr, WSP(bf16, O_PM) + (size_t)prow(n) * MW, MW), b = dot_bf(hmr + MW, WSP(bf16, O_PR) + (size_t)prow(n) * RW, RW);
    const float first = bf2f(f2bf(bf2f(u[D + n]) * a));
    u[n] = f2bf(first + bf2f(u[2 * D + n]) * b);
}
DEV void k_gemm_wo(const Params& P, long i) {
    const int n = (int)(i % D); const long m = i / D; const int l = P.layer;
    const int cond = seqinfo(seq_of_token((int)m)).cond;
    const float g1 = WSP(float, WS_MOD)[((size_t)l * NCOND + cond) * 6 * D + 2 * D + n];
    P.out[(size_t)m * D + n] += g1 * dot_bf(WSP(bf16, WS_U1) + (size_t)m * PU, WSP(bf16, O_WO) + (size_t)n * D, D);
}
DEV void k_gemm_f1(const Params& P, long i) {
    const int j = (int)(i % FF); const long m = i / FF;
    const int pn = j >> 7, rho = prow(j & 127);
    const bf16* h = WSP(bf16, WS_QKC) + (size_t)m * D;
    const float a = dot_bf(h, WSP(bf16, O_W13) + (size_t)(pn * 256 + rho) * D, D), b = dot_bf(h, WSP(bf16, O_W13) + (size_t)(pn * 256 + 128 + rho) * D, D);
    WSP(bf16, WS_U1)[(size_t)m * FF + j] = f2bf(siluf_(a) * b);
}
DEV void k_gemm_f2(const Params& P, long i) {
    const int n = (int)(i % D); const long m = i / D; const int l = P.layer;
    const int cond = seqinfo(seq_of_token((int)m)).cond;
    const float g2 = WSP(float, WS_MOD)[((size_t)l * NCOND + cond) * 6 * D + 5 * D + n];
    P.out[(size_t)m * D + n] += g2 * dot_bf(WSP(bf16, WS_U1) + (size_t)m * FF, WSP(bf16, O_W2) + (size_t)n * FF, FF);
}
DEV void k_conv(const Params& P, long i) {
    constexpr int NCH = 2 * MW + RIN;
    const int ch = (int)(i % NCH); const int m = (int)(i / NCH); const int l = P.layer;
    const int s = seq_of_token(m); const SeqInfo q = seqinfo(s); const int t = m - q.base;
    const bool isqk = ch < 2 * MW; const int c = isqk ? ch : ch - 2 * MW;
    const int ucol = isqk ? OFF_QK + c : OFF_R + c;
    const int CH = isqk ? 2 * MW : RIN;
    const float* w = (isqk ? P.in[M_CONV] : P.in[R_CONV]) + (size_t)l * 9 * CH;
    const bf16* U = WSP(bf16, WS_U1);
    float acc = 0.f;
    if (q.grid) {
        const int r = t / GW, cc = t % GW, rows = q.T / GW;
        for (int a = 0; a < 3; ++a) for (int b = 0; b < 3; ++b) {
            const int rr = r + a - 1, c2 = cc + b - 1;
            if (rr >= 0 && rr < rows && c2 >= 0 && c2 < GW) acc += w[(a * 3 + b) * CH + c] * bf2f(U[(size_t)(q.base + rr * GW + c2) * PU + ucol]);
        }
    } else {
        for (int b = 0; b < 3; ++b) { const int t2 = t + b - 1; if (t2 >= 0 && t2 < q.T) acc += w[(3 + b) * CH + c] * bf2f(U[(size_t)(q.base + t2) * PU + ucol]); }
    }
    if (isqk) { float v = siluf_(acc); if (c < MW) v *= 0.08838834764831845f; WSP(bf16, WS_QKC)[(size_t)m * (2 * MW) + c] = f2bf(v); }
    else { float v = acc; if (c >= RX_WL && c < RX_AL) v = tanhf(v); else if (c >= RX_GL) v = sigmoidf_(v); WSP(bf16, WS_RXC)[(size_t)m * RIN + c] = f2bf(v); }
}
DEV void k_mlstm(const Params& P, long i) {
    const int e = (int)(i % 128); const int chain = (int)(i / 128); const int dir = chain & 1, head = (chain >> 1) % MH, s = chain / (2 * MH);
    const int l = P.layer; const SeqInfo q = seqinfo(s);
    float C[128], n[128]; float m;
    if (!q.grid) {
#pragma unroll
        for (int d = 0; d < 128; ++d) { C[d] = 0.f; n[d] = 0.f; }
        m = 0.f;
    } else {
        const size_t sb = (((size_t)q.b * DEPTH + l) * 2 + dir) * MH + head;
#pragma unroll
        for (int d = 0; d < 128; ++d) { C[d] = P.in[ST_C][(sb * 128 + d) * 128 + e]; n[d] = P.in[ST_N][sb * 128 + d]; }
        m = P.in[ST_M][sb];
    }
    const float bi = P.in[M_GATE_B][(size_t)l * 4 * MH + (2 * dir) * MH + head], bfg = P.in[M_GATE_B][(size_t)l * 4 * MH + (2 * dir + 1) * MH + head];
    bf16* U = WSP(bf16, WS_U1); const bf16* QK = WSP(bf16, WS_QKC);
    float nsel = 0.f;
    for (int p = 0; p < q.T; ++p) {
        const int t = dir ? q.T - 1 - p : p; const size_t tok = (size_t)(q.base + t);
        const bf16* qk = QK + tok * (2 * MW); bf16* u = U + tok * PU;
        const float gi = bf2f(u[OFF_G + (2 * dir) * MH + head]) + bi, gf = bf2f(u[OFF_G + (2 * dir + 1) * MH + head]) + bfg;
        const float lf = logsigmoidf_(gf);
        const float mn = fmaxf(lf + m, gi); const float fw = expf(lf + m - mn), iw = expf(gi - mn);
        const float v = bf2f(u[OFF_V + head * 128 + e]);
        float num = 0.f, den = 0.f;
#pragma unroll
        for (int d = 0; d < 128; ++d) {
            const float kd = bf2f(qk[MW + head * 128 + d]), qd = bf2f(qk[head * 128 + d]);
            C[d] = fw * C[d] + iw * kd * v; n[d] = fw * n[d] + iw * kd; num += qd * C[d]; den += qd * n[d];
        }
        m = mn;
        u[dir * MW + head * 128 + e] = f2bf(num / fmaxf(fabsf(den), expf(-m)));
    }
    if (!q.grid) {
        const size_t sb = (((size_t)q.b * DEPTH + l) * 2 + dir) * MH + head;
#pragma unroll
        for (int d = 0; d < 128; ++d) { P.out[OUT_C + (sb * 128 + d) * 128 + e] = C[d]; if (d == e) nsel = n[d]; }
        P.out[OUT_N + sb * 128 + e] = nsel;
        if (e == 0) P.out[OUT_M + sb] = m;
    }
}
DEV void k_rwkv_prep(const Params& P, long i) {
    const int c = (int)(i % RW); const size_t tok = (size_t)(i / RW); const int l = P.layer, dir = P.mode;
    const bf16* rx = WSP(bf16, WS_RXC) + tok * RIN;
    const float* w2 = P.in[R_W2] + ((size_t)l * 2 + dir) * 64 * RW + c; const float* a2 = P.in[R_A2] + ((size_t)l * 2 + dir) * 64 * RW + c;
    float wr = P.in[R_W0][((size_t)l * 2 + dir) * RW + c], ar = P.in[R_A0][((size_t)l * 2 + dir) * RW + c];
    for (int j = 0; j < 64; ++j) { wr += bf2f(rx[RX_WL + dir * 64 + j]) * w2[(size_t)j * RW]; ar += bf2f(rx[RX_AL + dir * 64 + j]) * a2[(size_t)j * RW]; }
    bf16* o = WSP(bf16, WS_QKC) + tok * (2 * RW);
    o[c] = f2bf(wr); o[RW + c] = f2bf(ar);
}
DEV void k_rwkv(const Params& P, long i) {
    const int row = (int)(i % 64); const int chain = (int)(i / 64); const int dir = P.mode, head = chain % RH, s = chain / RH;
    const int l = P.layer; const SeqInfo q = seqinfo(s); const int hc = head * 64;
    float S[64];
    if (!q.grid) {
#pragma unroll
        for (int c = 0; c < 64; ++c) S[c] = 0.f;
    } else {
        const size_t sb = (((size_t)q.b * DEPTH + l) * 2 + dir) * RH + head;
#pragma unroll
        for (int c = 0; c < 64; ++c) S[c] = P.in[ST_R][(sb * 64 + row) * 64 + c];
    }
    const float* rkk = P.in[R_KK] + (size_t)l * RW + hc; const float* rka = P.in[R_KA] + (size_t)l * RW + hc;
    bf16* U = WSP(bf16, WS_U1); const bf16* RX = WSP(bf16, WS_RXC); const bf16* WA = WSP(bf16, WS_QKC);
    for (int p = 0; p < q.T; ++p) {
        const int t = dir ? q.T - 1 - p : p; const size_t tok = (size_t)(q.base + t);
        const bf16* rx = RX + tok * RIN; const bf16* wa = WA + tok * (2 * RW);
        float ss = 0.f;
        for (int c = 0; c < 64; ++c) { const float kc = bf2f(rx[RX_K + hc + c]) * rkk[c]; ss += kc * kc; }
        const float inv = 1.0f / fmaxf(sqrtf(ss), 1e-12f);
        float sa = 0.f;
#pragma unroll
        for (int c = 0; c < 64; ++c) sa -= S[c] * (bf2f(rx[RX_K + hc + c]) * rkk[c] * inv);
        const float v = bf2f(rx[RX_V + hc + row]);
        float y = 0.f;
#pragma unroll
        for (int c = 0; c < 64; ++c) {
            const float wr = bf2f(wa[hc + c]), ar = bf2f(wa[RW + hc + c]);
            const float decay = expf(-0.6065306597126334f * sigmoidf_(wr));
            const float alpha = sigmoidf_(ar);
            const float kr = bf2f(rx[RX_K + hc + c]);
            const float kt = kr * (1.0f + (alpha - 1.0f) * rka[c]);
            const float bb = kr * rkk[c] * inv * alpha;
            S[c] = S[c] * decay + sa * bb + v * kt;
            y += S[c] * bf2f(rx[RX_R + hc + c]);
        }
        U[tok * PU + OFF_R + dir * RW + hc + row] = f2bf(y);
    }
    if (!q.grid) {
        const size_t sb = (((size_t)q.b * DEPTH + l) * 2 + dir) * RH + head;
#pragma unroll
        for (int c = 0; c < 64; ++c) P.out[OUT_S + (sb * 64 + row) * 64 + c] = S[c];
    }
}
DEV void k_post(const Params& P, long i) {
    const int ch = (int)(i % D); const size_t m = (size_t)(i / D); const int l = P.layer;
    const bf16* u = WSP(bf16, WS_U1) + m * PU; const bf16* rx = WSP(bf16, WS_RXC) + m * RIN;
    bf16* o = WSP(bf16, WS_QKC) + m * D;
    if (ch < MW) {
        const int h0 = (ch / 128) * 128; float ss = 0.f;
        for (int d = 0; d < 128; ++d) { const float x = bf2f(u[h0 + d]) + bf2f(u[MW + h0 + d]); ss += x * x; }
        const float x = bf2f(u[ch]) + bf2f(u[MW + ch]);
        o[ch] = f2bf(x / sqrtf(ss / 128.f + RMS_EPS) * P.in[M_NORM_G][(size_t)l * MW + ch] * sigmoidf_(bf2f(u[OFF_O + ch])));
    } else {
        const int c = ch - MW; const int h0 = (c / 64) * 64;
        float mu = 0.f, bsum = 0.f;
        for (int d = 0; d < 64; ++d) { mu += bf2f(u[OFF_R + h0 + d]) + bf2f(u[OFF_R + RW + h0 + d]);
            bsum += bf2f(rx[RX_R + h0 + d]) * bf2f(rx[RX_K + h0 + d]) * P.in[R_RK][(size_t)l * RW + h0 + d]; }
        mu *= (1.0f / 64.f); float var = 0.f;
        for (int d = 0; d < 64; ++d) { const float x = bf2f(u[OFF_R + h0 + d]) + bf2f(u[OFF_R + RW + h0 + d]) - mu; var += x * x; }
        var *= (1.0f / 64.f);
        const float y = bf2f(u[OFF_R + c]) + bf2f(u[OFF_R + RW + c]);
        const float yn = (y - mu) / sqrtf(var + GN_EPS) * P.in[R_GN_W][(size_t)l * RW + c] + P.in[R_GN_B][(size_t)l * RW + c];
        float gate = 0.f;
        for (int j = 0; j < 128; ++j) gate += bf2f(rx[RX_GL + j]) * P.in[R_G2][((size_t)l * 128 + j) * RW + c];
        o[ch] = f2bf((yn + bsum * bf2f(rx[RX_V + c])) * gate);
    }
}
DEV void k_final(const Params& P, long m) {
    float* x = P.out + (size_t)m * D; float ss = 0.f;
    for (int k = 0; k < D; ++k) ss += x[k] * x[k];
    const float rs = 1.0f / sqrtf(ss / D + RMS_EPS);
    for (int k = 0; k < D; ++k) x[k] = x[k] * rs * P.in[FINAL_G][k];
}


#ifndef HOST_EMU
typedef const __attribute__((address_space(4))) Params CParams;
namespace pg8 {
#define PG8_LAS __attribute__((address_space(3)))
typedef short bf16x8 __attribute__((ext_vector_type(8)));
typedef float f32x4 __attribute__((ext_vector_type(4)));
typedef unsigned u32x4 __attribute__((ext_vector_type(4)));
constexpr int BM = 256, BK = 64, HALF = 128, HTB = HALF * BK * 2, STAGE_BYTES = 8 * HTB, NXCD = 8, WGM = 8;
__device__ __forceinline__ int lds_byte(int r, int c) { const int st = (r >> 4) * 2 + (c >> 5), rr = r & 15, cc = c & 31, ob = rr * 64 + cc * 2; return st * 1024 + (ob ^ (((ob >> 9) & 1) << 5)); }
__device__ __forceinline__ void stage_rc(int b, int& R, int& C) { const int st = b / 1024, sb = b % 1024, swz = sb ^ (((sb >> 9) & 1) << 5); R = (st >> 1) * 16 + swz / 64; C = (st & 1) * 32 + (swz % 64) / 2; }
struct Unit { int pm, pn, aoff; };
struct Gemm { const bf16* A; const bf16* Bt; int K, lda; };
struct StaticOrder {
    int nM, nN, nwg, G, c;
    __device__ __forceinline__ void init(int M, int N, int G_, int c_) { nM = M / BM; nN = N / BM; nwg = nM * nN; G = G_; c = c_; }
    __device__ __forceinline__ bool next(int i, Unit& u) const {
        const long L = (long)i * G + c; if (L >= nwg) return false;
        int wgid = (int)L; { const int q = nwg / NXCD, r = nwg % NXCD, xcd = wgid % NXCD, off = wgid / NXCD; wgid = (xcd < r ? xcd * (q + 1) : r * (q + 1) + (xcd - r) * q) + off; }
        const int nig = WGM * nN, gid = wgid / nig, fm = gid * WGM, gsz = (nM - fm) < WGM ? (nM - fm) : WGM;
        u.pm = fm + ((wgid % nig) % gsz); u.pn = (wgid % nig) / gsz; u.aoff = 0; return true;
    }
};
struct PairOrder {
    int nbase, G, v, nct;
    __device__ __forceinline__ void init(int M, int G_, int c_) { nct = D / BM; nbase = (M / BM) * nct; G = G_; v = (G_ % 8 == 0) ? (c_ % 8) * (G_ / 8) + c_ / 8 : c_; }
    __device__ __forceinline__ bool next(int i, Unit& u) const {
        const int j = v + (i >> 1) * G; if (j >= nbase) return false;
        const int half = i & 1; u.pm = j / nct; u.pn = half * nct + (j % nct); u.aoff = half * MW; return true;
    }
};
typedef float f32x2_t __attribute__((ext_vector_type(2)));
typedef __bf16 bf16x2_t __attribute__((ext_vector_type(2)));
__device__ __forceinline__ unsigned cvt_pk_bf16(float lo, float hi) { f32x2_t v = {lo, hi}; bf16x2_t b = __builtin_convertvector(v, bf16x2_t); return __builtin_bit_cast(unsigned, b); }
__device__ __forceinline__ float fsigmoid(float x) { return __builtin_amdgcn_rcpf(1.0f + __expf(-x)); }
__device__ __forceinline__ float bflo(unsigned w) { return __builtin_bit_cast(float, w << 16); }
__device__ __forceinline__ float bfhi(unsigned w) { return __builtin_bit_cast(float, w & 0xffff0000u); }

struct EpiA1 {
    bf16* U;
    __device__ __forceinline__ void operator()(const f32x4 (&acc)[2][2][4][2], const Unit& u, int wr, int wc, int fr, int fq) const {
        const int row0 = u.pm * BM + wr * 64 + fr, col0 = u.pn * BM + wc * 32 + 8 * fq;
#pragma unroll
        for (int ai = 0; ai < 2; ++ai)
#pragma unroll
            for (int m = 0; m < 4; ++m) { bf16* rowp = U + (size_t)(row0 + ai * HALF + m * 16) * PU + col0;
#pragma unroll
                for (int bj = 0; bj < 2; ++bj) { if (col0 + bj * HALF < N1) { const f32x4 v0 = acc[ai][bj][m][0], v1 = acc[ai][bj][m][1];
                    u32x4 w; w.x = cvt_pk_bf16(v0[0], v0[1]); w.y = cvt_pk_bf16(v0[2], v0[3]); w.z = cvt_pk_bf16(v1[0], v1[1]); w.w = cvt_pk_bf16(v1[2], v1[3]);
                    *(u32x4*)(rowp + bj * HALF) = w; } } }
    }
};
struct EpiA2 {
    bf16* U;
    __device__ __forceinline__ void operator()(const f32x4 (&acc)[2][2][4][2], const Unit& u, int wr, int wc, int fr, int fq) const {
        const int row0 = u.pm * BM + wr * 64 + fr, col0 = D + u.pn * BM + wc * 32 + 8 * fq;
#pragma unroll
        for (int ai = 0; ai < 2; ++ai)
#pragma unroll
            for (int m = 0; m < 4; ++m) { bf16* rowp = U + (size_t)(row0 + ai * HALF + m * 16) * PU + col0;
#pragma unroll
                for (int bj = 0; bj < 2; ++bj) { const f32x4 v0 = acc[ai][bj][m][0], v1 = acc[ai][bj][m][1];
                    u32x4 w; w.x = cvt_pk_bf16(fsigmoid(v0[0]), fsigmoid(v0[1])); w.y = cvt_pk_bf16(fsigmoid(v0[2]), fsigmoid(v0[3]));
                    w.z = cvt_pk_bf16(fsigmoid(v1[0]), fsigmoid(v1[1])); w.w = cvt_pk_bf16(fsigmoid(v1[2]), fsigmoid(v1[3]));
                    *(u32x4*)(rowp + bj * HALF) = w; } }
    }
};
struct EpiPJ {
    bf16* U;
    __device__ __forceinline__ void operator()(const f32x4 (&acc)[2][2][4][2], const Unit& u, int wr, int wc, int fr, int fq) const {
        const int nct = D / BM, half = u.pn >= nct ? 1 : 0, ct = u.pn - half * nct;
        const int row0 = u.pm * BM + wr * 64 + fr, col0 = ct * BM + wc * 32 + 8 * fq;
#pragma unroll
        for (int ai = 0; ai < 2; ++ai)
#pragma unroll
            for (int m = 0; m < 4; ++m) { bf16* rowp = U + (size_t)(row0 + ai * HALF + m * 16) * PU + col0;
#pragma unroll
                for (int bj = 0; bj < 2; ++bj) { const f32x4 v0 = acc[ai][bj][m][0], v1 = acc[ai][bj][m][1];
                    const u32x4 g = *(const u32x4*)(rowp + (1 + half) * D + bj * HALF);
                    float o[8] = { bflo(g.x) * v0[0], bfhi(g.x) * v0[1], bflo(g.y) * v0[2], bfhi(g.y) * v0[3], bflo(g.z) * v1[0], bfhi(g.z) * v1[1], bflo(g.w) * v1[2], bfhi(g.w) * v1[3] };
                    if (half) { const u32x4 p = *(const u32x4*)(rowp + bj * HALF);
                        o[0] += bflo(p.x); o[1] += bfhi(p.x); o[2] += bflo(p.y); o[3] += bfhi(p.y); o[4] += bflo(p.z); o[5] += bfhi(p.z); o[6] += bflo(p.w); o[7] += bfhi(p.w); }
                    u32x4 w; w.x = cvt_pk_bf16(o[0], o[1]); w.y = cvt_pk_bf16(o[2], o[3]); w.z = cvt_pk_bf16(o[4], o[5]); w.w = cvt_pk_bf16(o[6], o[7]);
                    *(u32x4*)(rowp + bj * HALF) = w; }
                asm volatile("" ::: "memory"); }
    }
};
struct EpiRes {
    float* X; const float* gate;
    __device__ __forceinline__ void operator()(const f32x4 (&acc)[2][2][4][2], const Unit& u, int wr, int wc, int fr, int fq) const {
        const int row0 = u.pm * BM + wr * 64 + fr, col0 = u.pn * BM + wc * 32 + 4 * fq;
        const int cond = seqinfo(seq_of_token(u.pm * BM)).cond;
        const float* gp = gate + (size_t)cond * 6 * D + col0;
        f32x4 gv[2][2];
#pragma unroll
        for (int bj = 0; bj < 2; ++bj)
#pragma unroll
            for (int n = 0; n < 2; ++n) gv[bj][n] = *(const f32x4*)(gp + bj * HALF + n * 16);
#pragma unroll
        for (int ai = 0; ai < 2; ++ai)
#pragma unroll
            for (int m = 0; m < 4; ++m) { float* rowp = X + (size_t)(row0 + ai * HALF + m * 16) * D + col0;
#pragma unroll
                for (int bj = 0; bj < 2; ++bj)
#pragma unroll
                    for (int n = 0; n < 2; ++n) { f32x4* p = (f32x4*)(rowp + bj * HALF + n * 16); *p = *p + gv[bj][n] * acc[ai][bj][m][n]; }
                asm volatile("" ::: "memory"); }
    }
};
struct EpiF1 {
    bf16* Hd;
    __device__ __forceinline__ void operator()(const f32x4 (&acc)[2][2][4][2], const Unit& u, int wr, int wc, int fr, int fq) const {
        const int row0 = u.pm * BM + wr * 64 + fr, col0 = u.pn * HALF + wc * 32 + 8 * fq;
#pragma unroll
        for (int ai = 0; ai < 2; ++ai)
#pragma unroll
            for (int m = 0; m < 4; ++m) { bf16* rowp = Hd + (size_t)(row0 + ai * HALF + m * 16) * FF + col0;
                float o[8];
#pragma unroll
                for (int n = 0; n < 2; ++n)
#pragma unroll
                    for (int e = 0; e < 4; ++e) { const float a = acc[ai][0][m][n][e], b = acc[ai][1][m][n][e]; o[n * 4 + e] = a * fsigmoid(a) * b; }
                u32x4 w; w.x = cvt_pk_bf16(o[0], o[1]); w.y = cvt_pk_bf16(o[2], o[3]); w.z = cvt_pk_bf16(o[4], o[5]); w.w = cvt_pk_bf16(o[6], o[7]);
                *(u32x4*)rowp = w; }
    }
};

template <class Epi, class Sched, bool ALIGN_EPI = true, bool SP2 = true>
__device__ __forceinline__ void gemm_phase(PG8_LAS unsigned char* lds, const Gemm g, const Sched& S, const Epi& E) {
    const int tid = threadIdx.x, wid = __builtin_amdgcn_readfirstlane(tid >> 6), lane = tid & 63, wr = wid >> 2, wc = wid & 3, fr = lane & 15, fq = lane >> 4;
    const int K = g.K, nt = K / BK;
    unsigned voffA[2], voffB[2];
#pragma unroll
    for (int i = 0; i < 2; ++i) { int R, C; stage_rc(tid * 16 + i * 8192, R, C);
        voffA[i] = (unsigned)(R * g.lda + C) * 2u; voffB[i] = (unsigned)(R * K + C) * 2u; }
    const size_t kstep = (size_t)(BK * 2);
    const size_t hstepA = (size_t)HALF * g.lda * 2, hstepB = (size_t)HALF * K * 2;
    const size_t tstepA = 2 * hstepA, tstepB = 2 * hstepB;
    const unsigned ldsw = (unsigned)wid * 1024u;
    const int aoff = lds_byte(wr * 64 + fr, fq * 8), boff = lds_byte(wc * 32 + fr, fq * 8);
#define PG8_SA(b, h) (((b) * 2 + (h)) * HTB)
#define PG8_SB(b, h) ((4 + (b) * 2 + (h)) * HTB)
#define PG8_STAGE(bufoff, gbase, voff) do { _Pragma("unroll") for (int _i = 0; _i < 2; ++_i) \
        __builtin_amdgcn_global_load_lds((const unsigned*)((const char*)(gbase) + (voff)[_i]), (PG8_LAS unsigned*)(lds + (bufoff) + ldsw + _i * 8192), 16, 0, 0); } while (0)
#define PG8_LDA(dst, b, h) do { _Pragma("unroll") for (int m = 0; m < 4; ++m) _Pragma("unroll") for (int k = 0; k < 2; ++k) dst[m][k] = *(const PG8_LAS bf16x8*)(lds + PG8_SA(b, h) + aoff + m * 2048 + k * 1024); } while (0)
#define PG8_LDB(dst, b, h) do { _Pragma("unroll") for (int n = 0; n < 2; ++n) _Pragma("unroll") for (int k = 0; k < 2; ++k) dst[n][k] = *(const PG8_LAS bf16x8*)(lds + PG8_SB(b, h) + boff + n * 2048 + k * 1024); } while (0)
#define PG8_MMA(ai, bj, At, Bt) do { __builtin_amdgcn_s_setprio(1); _Pragma("unroll") for (int m = 0; m < 4; ++m) _Pragma("unroll") for (int n = 0; n < 2; ++n) _Pragma("unroll") for (int k = 0; k < 2; ++k) \
        acc[ai][bj][m][n] = __builtin_amdgcn_mfma_f32_16x16x32_bf16(Bt[n][k], At[m][k], acc[ai][bj][m][n], 0, 0, 0); __builtin_amdgcn_s_setprio(0); } while (0)
#define PG8_WAIT_V(n) asm volatile("s_waitcnt vmcnt(" #n ")" ::: "memory")
#define PG8_WAIT_L(n) asm volatile("s_waitcnt lgkmcnt(" #n ")" ::: "memory")
#define PG8_BAR __builtin_amdgcn_s_barrier()
#define PG8_SCHED __builtin_amdgcn_sched_barrier(0)
    Unit cur, nxt; int ui = 0;
    if (!S.next(0, cur)) return;
    f32x4 acc[2][2][4][2];
#pragma unroll
    for (int a = 0; a < 2; ++a)
#pragma unroll
        for (int b = 0; b < 2; ++b)
#pragma unroll
            for (int m = 0; m < 4; ++m)
#pragma unroll
                for (int n = 0; n < 2; ++n) acc[a][b][m][n] = (f32x4){0.f, 0.f, 0.f, 0.f};
    bf16x8 At[4][2], B0[2][2], B1[2][2];
    const char* cA = (const char*)g.A + (size_t)cur.pm * tstepA + (size_t)cur.aoff * 2; const char* cB = (const char*)g.Bt + (size_t)cur.pn * tstepB;
    if constexpr (SP2) {
        PG8_STAGE(PG8_SB(0, 0), cB, voffB); PG8_STAGE(PG8_SB(0, 1), cB + hstepB, voffB); PG8_STAGE(PG8_SA(0, 0), cA, voffA); PG8_STAGE(PG8_SA(0, 1), cA + hstepA, voffA);
        if (wr == 1) PG8_BAR;
        PG8_WAIT_V(2); PG8_BAR;
        PG8_STAGE(PG8_SB(1, 0), cB + kstep, voffB); PG8_STAGE(PG8_SA(1, 0), cA + kstep, voffA); PG8_STAGE(PG8_SB(1, 1), cB + hstepB + kstep, voffB);
        PG8_WAIT_V(6); PG8_BAR;
    } else {
        PG8_STAGE(PG8_SB(0, 0), cB, voffB); PG8_STAGE(PG8_SA(0, 0), cA, voffA); PG8_STAGE(PG8_SB(0, 1), cB + hstepB, voffB); PG8_STAGE(PG8_SA(0, 1), cA + hstepA, voffA);
        if (wr == 1) PG8_BAR;
        PG8_WAIT_V(4); PG8_BAR;
        PG8_STAGE(PG8_SB(1, 0), cB + kstep, voffB); PG8_STAGE(PG8_SA(1, 0), cA + kstep, voffA); PG8_STAGE(PG8_SB(1, 1), cB + hstepB + kstep, voffB);
        PG8_WAIT_V(6); PG8_BAR;
    }
    for (;;) {
        const bool has_next = S.next(ui + 1, nxt);
        const char* nA = has_next ? (const char*)g.A + (size_t)nxt.pm * tstepA + (size_t)nxt.aoff * 2 : cA; const char* nB = has_next ? (const char*)g.Bt + (size_t)nxt.pn * tstepB : cB;
        for (int t = 0; t < nt; t += 2) {
            const bool last = (t == nt - 2);
            const char* a1 = cA + (size_t)(t + 1) * kstep;
            const char* a2 = last ? nA : cA + (size_t)(t + 2) * kstep; const char* b2 = last ? nB : cB + (size_t)(t + 2) * kstep;
            const char* a3 = a2 + kstep; const char* b3 = b2 + kstep;
            if constexpr (SP2) {
            PG8_LDB(B0, 0, 0); PG8_LDB(B1, 0, 1); PG8_SCHED; PG8_LDA(At, 0, 0); PG8_STAGE(PG8_SA(1, 1), a1 + hstepA, voffA);
            PG8_WAIT_V(8); PG8_WAIT_L(0); PG8_BAR; PG8_MMA(0, 0, At, B0); PG8_MMA(0, 1, At, B1); PG8_BAR; PG8_SCHED;
            PG8_LDA(At, 0, 1); PG8_STAGE(PG8_SB(0, 0), b2, voffB); PG8_STAGE(PG8_SB(0, 1), b2 + hstepB, voffB); PG8_STAGE(PG8_SA(0, 0), a2, voffA);
            PG8_WAIT_V(8); PG8_WAIT_L(0); PG8_BAR; PG8_MMA(1, 0, At, B0); PG8_MMA(1, 1, At, B1); PG8_BAR; PG8_SCHED;
            PG8_LDB(B0, 1, 0); PG8_LDB(B1, 1, 1); PG8_SCHED; PG8_LDA(At, 1, 0); PG8_STAGE(PG8_SA(0, 1), a2 + hstepA, voffA);
            PG8_WAIT_V(8); PG8_WAIT_L(0); PG8_BAR; PG8_MMA(0, 0, At, B0); PG8_MMA(0, 1, At, B1); PG8_BAR; PG8_SCHED;
            PG8_LDA(At, 1, 1); PG8_STAGE(PG8_SB(1, 0), b3, voffB); PG8_STAGE(PG8_SB(1, 1), b3 + hstepB, voffB); PG8_STAGE(PG8_SA(1, 0), a3, voffA);
            PG8_WAIT_V(8); PG8_WAIT_L(0); PG8_BAR; PG8_MMA(1, 0, At, B0); PG8_MMA(1, 1, At, B1); PG8_BAR; PG8_SCHED;
            } else {
            PG8_LDB(B0, 0, 0); PG8_SCHED; PG8_LDA(At, 0, 0); PG8_STAGE(PG8_SA(1, 1), a1 + hstepA, voffA);
            PG8_WAIT_L(8); PG8_BAR; PG8_WAIT_L(0); PG8_MMA(0, 0, At, B0); PG8_BAR; PG8_SCHED;
            PG8_LDB(B1, 0, 1); PG8_STAGE(PG8_SB(0, 0), b2, voffB);
            PG8_BAR; PG8_WAIT_L(0); PG8_MMA(0, 1, At, B1); PG8_BAR;
            PG8_LDA(At, 0, 1); PG8_STAGE(PG8_SA(0, 0), a2, voffA);
            PG8_BAR; PG8_WAIT_L(0); PG8_MMA(1, 0, At, B0); PG8_BAR; PG8_SCHED;
            PG8_STAGE(PG8_SB(0, 1), b2 + hstepB, voffB);
            PG8_WAIT_V(6); PG8_BAR; PG8_MMA(1, 1, At, B1); PG8_BAR;
            PG8_LDB(B0, 1, 0); PG8_SCHED; PG8_LDA(At, 1, 0); PG8_STAGE(PG8_SA(0, 1), a2 + hstepA, voffA);
            PG8_WAIT_L(8); PG8_BAR; PG8_WAIT_L(0); PG8_MMA(0, 0, At, B0); PG8_BAR; PG8_SCHED;
            PG8_LDB(B1, 1, 1); PG8_STAGE(PG8_SB(1, 0), b3, voffB);
            PG8_BAR; PG8_WAIT_L(0); PG8_MMA(0, 1, At, B1); PG8_BAR;
            PG8_LDA(At, 1, 1); PG8_STAGE(PG8_SA(1, 0), a3, voffA);
            PG8_BAR; PG8_WAIT_L(0); PG8_MMA(1, 0, At, B0); PG8_BAR; PG8_SCHED;
            PG8_STAGE(PG8_SB(1, 1), b3 + hstepB, voffB);
            PG8_WAIT_V(6); PG8_BAR; PG8_MMA(1, 1, At, B1); PG8_BAR;
            }
        }
        if constexpr (ALIGN_EPI) { if (wr == 0) PG8_BAR; }
        E(acc, cur, wr, wc, fr, fq);
        if (!has_next) break;
#pragma unroll
        for (int a = 0; a < 2; ++a)
#pragma unroll
            for (int b = 0; b < 2; ++b)
#pragma unroll
                for (int m = 0; m < 4; ++m)
#pragma unroll
                    for (int n = 0; n < 2; ++n) acc[a][b][m][n] = (f32x4){0.f, 0.f, 0.f, 0.f};
        cur = nxt; cA = nA; cB = nB; ++ui;
        if constexpr (ALIGN_EPI) { if (wr == 1) PG8_BAR; }
    }
    PG8_WAIT_V(0);
    if constexpr (!ALIGN_EPI) { if (wr == 0) PG8_BAR; }
    PG8_BAR;
#undef PG8_SA
#undef PG8_SB
#undef PG8_STAGE
#undef PG8_LDA
#undef PG8_LDB
#undef PG8_MMA
#undef PG8_WAIT_V
#undef PG8_WAIT_L
#undef PG8_BAR
#undef PG8_SCHED
}
}


#define LDS_BARRIER() do { asm volatile("s_waitcnt lgkmcnt(0)" ::: "memory"); __builtin_amdgcn_s_barrier(); asm volatile("" ::: "memory"); } while (0)
namespace ml {
#define LAS __attribute__((address_space(3)))
typedef short bf16x8 __attribute__((ext_vector_type(8)));
typedef float f32x4 __attribute__((ext_vector_type(4)));
typedef unsigned u32x4 __attribute__((ext_vector_type(4)));
constexpr int NVB = 4, EV = MD / NVB;
constexpr int PQ = 272, PT = 144;
constexpr int L_QS = 0, L_KS = L_QS + 64 * PQ, L_KT = L_KS + 64 * PQ, L_VT = L_KT + 128 * PT, L_SB = L_VT + 48 * PT, L_CT = L_SB + 64 * PT,
              L_HS = L_CT + 48 * PQ, L_SC = L_HS + 64 * 80, L_END = L_SC + 4096;
static_assert(L_END <= 131072, "mLSTM LDS map");
enum { SC_A = 0, SC_PM = 64, SC_WI = 128, SC_EMT = 192, SC_WE = 256, SC_DEN = 320, SC_MISC = 384 };
__device__ __forceinline__ f32x4 mma(bf16x8 a, bf16x8 b, f32x4 c) { return __builtin_amdgcn_mfma_f32_16x16x32_bf16(a, b, c, 0, 0, 0); }
__device__ __forceinline__ bf16x8 frag(LAS unsigned char* lds, int base, int pitch, int row0, int k0, int lane) {
    return *(const LAS bf16x8*)(lds + base + (row0 + (lane & 15)) * pitch + (k0 + 8 * (lane >> 4)) * 2);
}
__device__ __forceinline__ void mlstm_item(LAS unsigned char* lds, CParams& P, int l, int s, int head, int dir, int vb) {
    const int tid = threadIdx.x, w = __builtin_amdgcn_readfirstlane(tid >> 6), lane = tid & 63, fr = lane & 15, fq = lane >> 4;
    const int rt = w & 3, half = w >> 2;
    const SeqInfo q = seqinfo(s); const int nchunk = q.T / 64;
    const bf16* QK = WSP(bf16, WS_QKC); bf16* U = WSP(bf16, WS_U1);
    LAS float* SC = (LAS float*)(lds + L_SC);
    f32x4 cacc[3];
    float m_prev;
    if (!q.grid) { cacc[0] = cacc[1] = cacc[2] = (f32x4){0.f, 0.f, 0.f, 0.f}; m_prev = 0.f; }
    else {
        const size_t sb = (((size_t)q.b * DEPTH + l) * 2 + dir) * MH + head; const int d = 16 * w + fr;
#pragma unroll
        for (int et = 0; et < 2; ++et)
#pragma unroll
            for (int r = 0; r < 4; ++r) cacc[et][r] = P.in[ST_C][(sb * 128 + d) * 128 + vb * EV + 16 * et + 4 * fq + r];
        cacc[2] = (f32x4){0.f, 0.f, 0.f, 0.f}; if (fq == 0) cacc[2][0] = P.in[ST_N][sb * 128 + d];
        m_prev = P.in[ST_M][sb];
    }
    const float bi = P.in[M_GATE_B][(size_t)l * 4 * MH + (2 * dir) * MH + head], bfg = P.in[M_GATE_B][(size_t)l * 4 * MH + (2 * dir + 1) * MH + head];
    for (int i = tid; i < 16 * 64; i += 512) { const int r = i >> 6, c = i & 63; *(LAS bf16*)(lds + L_VT + (32 + r) * PT + c * 2) = (r == 0) ? (bf16)0x3f80 : (bf16)0; }
    u32x4 pqk[4]; u32x4 pv; bf16 pgi = 0, pgf = 0;
#define ML_TOK(c, j) ((size_t)(q.base + (dir ? q.T - 1 - ((c) * 64 + (j)) : ((c) * 64 + (j)))))
#define ML_PREFETCH(c) do { _Pragma("unroll") for (int i = 0; i < 4; ++i) { const int id = tid + 512 * i, j = id >> 5, pc = id & 31; \
            pqk[i] = *(const u32x4*)(QK + ML_TOK(c, j) * (2 * MW) + (pc < 16 ? head * 128 + 8 * pc : MW + head * 128 + 8 * (pc - 16))); } \
        if (tid < 256) { const int j = tid >> 2, pc = tid & 3; pv = *(const u32x4*)(U + ML_TOK(c, j) * PU + OFF_V + head * 128 + vb * EV + 8 * pc); } \
        if (w == 0) { const bf16* g = U + ML_TOK(c, lane) * PU + OFF_G; pgi = g[(2 * dir) * MH + head]; pgf = g[(2 * dir + 1) * MH + head]; } } while (0)
    ML_PREFETCH(0);
    for (int c = 0; c < nchunk; ++c) {
#pragma unroll
        for (int i = 0; i < 4; ++i) { const int id = tid + 512 * i, j = id >> 5, pc = id & 31;
            *(LAS u32x4*)(lds + (pc < 16 ? L_QS : L_KS) + j * PQ + (pc & 15) * 16) = pqk[i]; }
        if (tid < 256) { const int j = tid >> 2, pc = tid & 3; const unsigned wv[4] = {pv.x, pv.y, pv.z, pv.w};
#pragma unroll
            for (int e = 0; e < 8; ++e) *(LAS bf16*)(lds + L_VT + (8 * pc + e) * PT + j * 2) = (bf16)((wv[e >> 1] >> ((e & 1) * 16)) & 0xffffu); }
#pragma unroll
        for (int et = 0; et < 3; ++et)
#pragma unroll
            for (int r = 0; r < 4; ++r) *(LAS bf16*)(lds + L_CT + (16 * et + 4 * fq + r) * PQ + (16 * w + fr) * 2) = f2bf(cacc[et][r]);
        float wie = 1.f;
        if (w == 0) {
            const float gi = bf2f(pgi) + bi, gf = bf2f(pgf) + bfg;
            const float lf = fminf(gf, 0.f) - log1pf(__expf(-fabsf(gf)));
            float b = lf;
#pragma unroll
            for (int o = 1; o < 64; o <<= 1) { const float t = __shfl_up(b, o); if (lane >= o) b += t; }
            const float a = gi - b; float pm = a;
#pragma unroll
            for (int o = 1; o < 64; o <<= 1) { const float t = __shfl_up(pm, o); if (lane >= o) pm = fmaxf(pm, t); }
            pm = fmaxf(pm, m_prev);
            const float pm63 = __shfl(pm, 63), b63 = __shfl(b, 63);
            SC[SC_A + lane] = a; SC[SC_PM + lane] = pm; SC[SC_WI + lane] = __expf(m_prev - pm); SC[SC_EMT + lane] = __expf(-(b + pm)); SC[SC_WE + lane] = __expf(a - pm63);
            if (lane == 0) { SC[SC_MISC] = __expf(m_prev - pm63); SC[SC_MISC + 1] = b63 + pm63; }
        }
        LDS_BARRIER();
        if (c + 1 < nchunk) ML_PREFETCH(c + 1);
        wie = SC[SC_MISC]; m_prev = SC[SC_MISC + 1];
#pragma unroll
        for (int i = 0; i < 2; ++i) { const int id = tid + 512 * i, j = id >> 4, pc = id & 15; const float we = SC[SC_WE + j];
            const u32x4 kv = *(const LAS u32x4*)(lds + L_KS + j * PQ + pc * 16); const unsigned wv[4] = {kv.x, kv.y, kv.z, kv.w};
#pragma unroll
            for (int e = 0; e < 8; ++e) { const float kf = __builtin_bit_cast(float, (e & 1) ? (wv[e >> 1] & 0xffff0000u) : (wv[e >> 1] << 16));
                *(LAS bf16*)(lds + L_KT + (8 * pc + e) * PT + j * 2) = f2bf(kf * we); } }
#pragma unroll
        for (int cc = 0; cc < 2; ++cc) { const int ct = 2 * half + cc;
            f32x4 acc = (f32x4){0.f, 0.f, 0.f, 0.f};
            if (ct <= rt) {
#pragma unroll
                for (int k = 0; k < 4; ++k) acc = mma(frag(lds, L_QS, PQ, 16 * rt, 32 * k, lane), frag(lds, L_KS, PQ, 16 * ct, 32 * k, lane), acc);
            }
            const int sp = 16 * ct + fr; const float as = SC[SC_A + sp];
#pragma unroll
            for (int r = 0; r < 4; ++r) { const int t = 16 * rt + 4 * fq + r; const float v = (sp <= t) ? acc[r] * __expf(as - SC[SC_PM + t]) : 0.f;
                *(LAS bf16*)(lds + L_SB + t * PT + sp * 2) = f2bf(v); } }
        LDS_BARRIER();
        f32x4 nacc[2]; const int nct = half ? 1 : 2;
#pragma unroll
        for (int cc = 0; cc < 2; ++cc) { if (cc < nct) { const int ct = half ? 2 : cc;
            f32x4 a1 = (f32x4){0.f, 0.f, 0.f, 0.f}, a2 = (f32x4){0.f, 0.f, 0.f, 0.f};
#pragma unroll
            for (int k = 0; k < 2; ++k) a1 = mma(frag(lds, L_SB, PT, 16 * rt, 32 * k, lane), frag(lds, L_VT, PT, 16 * ct, 32 * k, lane), a1);
#pragma unroll
            for (int k = 0; k < 4; ++k) a2 = mma(frag(lds, L_QS, PQ, 16 * rt, 32 * k, lane), frag(lds, L_CT, PQ, 16 * ct, 32 * k, lane), a2);
#pragma unroll
            for (int r = 0; r < 4; ++r) a1[r] += SC[SC_WI + 16 * rt + 4 * fq + r] * a2[r];
            nacc[cc] = a1; } }
        if (half && fr == 0) {
#pragma unroll
            for (int r = 0; r < 4; ++r) SC[SC_DEN + 16 * rt + 4 * fq + r] = nacc[0][r];
        }
#pragma unroll
        for (int et = 0; et < 3; ++et) { cacc[et] = cacc[et] * wie;
#pragma unroll
            for (int k = 0; k < 2; ++k) cacc[et] = mma(frag(lds, L_VT, PT, 16 * et, 32 * k, lane), frag(lds, L_KT, PT, 16 * w, 32 * k, lane), cacc[et]); }
        LDS_BARRIER();
        if (!half) {
#pragma unroll
            for (int cc = 0; cc < 2; ++cc)
#pragma unroll
                for (int r = 0; r < 4; ++r) { const int t = 16 * rt + 4 * fq + r; const float den = fmaxf(fabsf(SC[SC_DEN + t]), SC[SC_EMT + t]);
                    *(LAS bf16*)(lds + L_HS + t * 80 + (16 * cc + fr) * 2) = f2bf(nacc[cc][r] / den); }
        }
        LDS_BARRIER();
        if (tid < 256) { const int j = tid >> 2, pc = tid & 3;
            *(u32x4*)(U + ML_TOK(c, j) * PU + dir * MW + head * 128 + vb * EV + 8 * pc) = *(const LAS u32x4*)(lds + L_HS + j * 80 + pc * 16); }
    }
    if (!q.grid) {
        const size_t sb = (((size_t)q.b * DEPTH + l) * 2 + dir) * MH + head; const int d = 16 * w + fr;
#pragma unroll
        for (int et = 0; et < 2; ++et)
#pragma unroll
            for (int r = 0; r < 4; ++r) P.out[OUT_C + (sb * 128 + d) * 128 + vb * EV + 16 * et + 4 * fq + r] = cacc[et][r];
        if (vb == 0) { if (fq == 0) P.out[OUT_N + sb * 128 + d] = cacc[2][0]; if (tid == 0) P.out[OUT_M + sb] = m_prev; }
    }
    LDS_BARRIER();
#undef ML_TOK
#undef ML_PREFETCH
}
constexpr int N_ITEMS = NSEQ * MH * 2 * NVB;
__device__ __forceinline__ void decode_item(int it, int& s, int& head, int& dir, int& vb) {
    vb = it % NVB; int ch = it / NVB; dir = ch & 1; ch >>= 1; head = ch % MH; const int sq = ch / MH;
    s = sq < LB ? CB + sq : sq - LB;
}
}


namespace rw {
typedef short bf16x8 __attribute__((ext_vector_type(8)));
typedef float f32x4 __attribute__((ext_vector_type(4)));
typedef unsigned u32x4 __attribute__((ext_vector_type(4)));
enum { V_A = 0, V_W, V_B, V_K, V_R, NVEC };
constexpr int REC = NVEC * 64 * 4;
constexpr int PT = 144;
constexpr int L_SBUF = 0, L_VT = L_SBUF + 64 * REC, L_TW = L_VT + 64 * 256, L_AL = L_TW + 64 * PT, L_YS = L_AL + 64 * PT, L_INV = L_YS + 64 * 16 * 4, L_END = L_INV + 256;
__device__ __forceinline__ int vt_off(int row, int tt) { return row * 256 + ((tt ^ (((row >> 3) & 7) << 2)) << 2); }
static_assert(L_END <= 131072, "RWKV LDS map");
__device__ __forceinline__ float dpp_xor1(float x) { return __builtin_bit_cast(float, __builtin_amdgcn_update_dpp(0, __builtin_bit_cast(int, x), 0xB1, 0xF, 0xF, true)); }
__device__ __forceinline__ float dpp_xor2(float x) { return __builtin_bit_cast(float, __builtin_amdgcn_update_dpp(0, __builtin_bit_cast(int, x), 0x4E, 0xF, 0xF, true)); }
__device__ __forceinline__ float dpp_ror4(float x) { return __builtin_bit_cast(float, __builtin_amdgcn_update_dpp(0, __builtin_bit_cast(int, x), 0x124, 0xF, 0xF, true)); }
__device__ __forceinline__ float dpp_ror8(float x) { return __builtin_bit_cast(float, __builtin_amdgcn_update_dpp(0, __builtin_bit_cast(int, x), 0x128, 0xF, 0xF, true)); }
__device__ __forceinline__ float allsum16(float x) { x += dpp_xor1(x); x += dpp_xor2(x); x += dpp_ror4(x); x += dpp_ror8(x); return x; }
__device__ __forceinline__ f32x4 cvt_lo4(unsigned a, unsigned b) { return (f32x4){__builtin_bit_cast(float, a << 16), __builtin_bit_cast(float, a & 0xffff0000u), __builtin_bit_cast(float, b << 16), __builtin_bit_cast(float, b & 0xffff0000u)}; }
__device__ __forceinline__ float allsum32(float x) {
    x = allsum16(x);
    float xa = x, xb = x;
    asm volatile("v_mov_b32 %1, %0\n\ts_nop 1\n\tv_permlane32_swap_b32 %0, %1\n\ts_nop 1" : "+v"(xa), "=&v"(xb));
    return xa + xb;
}
__device__ __forceinline__ void rwkv_item(LAS unsigned char* lds, CParams& P, int l, int s, int head, int dir, int rh) {
    const int tid = threadIdx.x, w = __builtin_amdgcn_readfirstlane(tid >> 6), lane = tid & 63, fr = lane & 15, fq = lane >> 4;
    const int rt = w & 3, half = w >> 2, hc = head * 64;
    const SeqInfo q = seqinfo(s); const int nchunk = q.T / 64;
    const bf16* RX = WSP(bf16, WS_RXC); bf16* U = WSP(bf16, WS_U1);
    const int pj = tid >> 3, psub = tid & 7;
    const int hh = lane >> 5, rsel = (lane >> 4) & 1, cg = lane & 15;
    const int row = 16 * rh + 2 * w + rsel, col0 = 32 * hh + 2 * cg;
    typedef float f32x2 __attribute__((ext_vector_type(2)));
    f32x2 S2;
    if (!q.grid) S2 = (f32x2){0.f, 0.f};
    else { const size_t sb = (((size_t)q.b * DEPTH + l) * 2 + dir) * RH + head; S2 = *(const f32x2*)(P.in[ST_R] + (sb * 64 + row) * 64 + col0); }
    float rkk8[8];
#pragma unroll
    for (int e = 0; e < 8; ++e) rkk8[e] = P.in[R_KK][(size_t)l * RW + hc + 8 * psub + e];
    float c_w0[2], c_a0[2], c_kk[2], c_ka[2];
    bf16x8 bw[2][2], ba[2][2];
#pragma unroll
    for (int cc = 0; cc < 2; ++cc) { const int c = 16 * (2 * half + cc) + fr;
        c_w0[cc] = P.in[R_W0][((size_t)l * 2 + dir) * RW + hc + c]; c_a0[cc] = P.in[R_A0][((size_t)l * 2 + dir) * RW + hc + c];
        c_kk[cc] = P.in[R_KK][(size_t)l * RW + hc + c]; c_ka[cc] = P.in[R_KA][(size_t)l * RW + hc + c];
#pragma unroll
        for (int ks = 0; ks < 2; ++ks)
#pragma unroll
            for (int e = 0; e < 8; ++e) { const int j = 32 * ks + 8 * fq + e;
                bw[cc][ks][e] = (short)f2bf(P.in[R_W2][(((size_t)l * 2 + dir) * 64 + j) * RW + hc + c]);
                ba[cc][ks][e] = (short)f2bf(P.in[R_A2][(((size_t)l * 2 + dir) * 64 + j) * RW + hc + c]); } }
    u32x4 pf[5];
#define RW_TOK(c, j) ((size_t)(q.base + (dir ? q.T - 1 - ((c) * 64 + (j)) : ((c) * 64 + (j)))))
#define RW_PREFETCH(c) do { const bf16* rx = RX + RW_TOK(c, pj) * RIN + 8 * psub; \
        pf[0] = *(const u32x4*)(rx + RX_R + hc); pf[1] = *(const u32x4*)(rx + RX_K + hc); pf[2] = *(const u32x4*)(rx + RX_V + hc); \
        pf[3] = *(const u32x4*)(rx + RX_WL + dir * 64); pf[4] = *(const u32x4*)(rx + RX_AL + dir * 64); } while (0)
    RW_PREFETCH(0);
    for (int c = 0; c < nchunk; ++c) {
        { LAS unsigned char* rec = lds + L_SBUF + pj * REC + psub * 32;
          *(LAS f32x4*)(rec + V_R * 256) = cvt_lo4(pf[0].x, pf[0].y); *(LAS f32x4*)(rec + V_R * 256 + 16) = cvt_lo4(pf[0].z, pf[0].w);
          { const f32x4 v0 = cvt_lo4(pf[2].x, pf[2].y), v1 = cvt_lo4(pf[2].z, pf[2].w);
#pragma unroll
            for (int e = 0; e < 4; ++e) { *(LAS float*)(lds + L_VT + vt_off(8 * psub + e, pj)) = v0[e]; *(LAS float*)(lds + L_VT + vt_off(8 * psub + 4 + e, pj)) = v1[e]; } }
          const f32x4 k0 = cvt_lo4(pf[1].x, pf[1].y), k1 = cvt_lo4(pf[1].z, pf[1].w);
          *(LAS f32x4*)(rec + V_K * 256) = k0; *(LAS f32x4*)(rec + V_K * 256 + 16) = k1;
          float ss = 0.f;
#pragma unroll
          for (int e = 0; e < 4; ++e) { const float x0 = k0[e] * rkk8[e], x1 = k1[e] * rkk8[4 + e]; ss += x0 * x0 + x1 * x1; }
          ss += dpp_xor1(ss); ss += dpp_xor2(ss); ss += __shfl_xor(ss, 4);
          if (psub == 0) *(LAS float*)(lds + L_INV + pj * 4) = 1.0f / fmaxf(sqrtf(ss), 1e-12f);
          *(LAS u32x4*)(lds + L_TW + pj * PT + psub * 16) = pf[3]; *(LAS u32x4*)(lds + L_AL + pj * PT + psub * 16) = pf[4]; }
        __syncthreads();
        if (c + 1 < nchunk) RW_PREFETCH(c + 1);
#pragma unroll
        for (int cc = 0; cc < 2; ++cc) { const int ct = 2 * half + cc; const int cidx = 16 * ct + fr;
            f32x4 aw = (f32x4){0.f, 0.f, 0.f, 0.f}, aa = (f32x4){0.f, 0.f, 0.f, 0.f};
#pragma unroll
            for (int ks = 0; ks < 2; ++ks) { aw = ml::mma(ml::frag(lds, L_TW, PT, 16 * rt, 32 * ks, lane), bw[cc][ks], aw); aa = ml::mma(ml::frag(lds, L_AL, PT, 16 * rt, 32 * ks, lane), ba[cc][ks], aa); }
#pragma unroll
            for (int r = 0; r < 4; ++r) { const int tok = 16 * rt + 4 * fq + r; LAS float* rec = (LAS float*)(lds + L_SBUF + tok * REC) + cidx;
                const float decay = __expf(-0.6065306597126334f * pg8::fsigmoid(c_w0[cc] + aw[r])); const float alpha = pg8::fsigmoid(c_a0[cc] + aa[r]);
                const float kraw = rec[V_K * 64]; const float kkn = kraw * c_kk[cc] * *(LAS float*)(lds + L_INV + tok * 4);
                rec[V_A * 64] = -kkn; rec[V_W * 64] = decay; rec[V_B * 64] = kkn * alpha; rec[V_K * 64] = kraw * (1.0f + (alpha - 1.0f) * c_ka[cc]); } }
        __syncthreads();
        {
            const LAS unsigned char* rbase = lds + L_SBUF + col0 * 4;
            f32x2 ca = *(const LAS f32x2*)(rbase + V_A * 256), cw = *(const LAS f32x2*)(rbase + V_W * 256), cb = *(const LAS f32x2*)(rbase + V_B * 256),
                  ck = *(const LAS f32x2*)(rbase + V_K * 256), cr = *(const LAS f32x2*)(rbase + V_R * 256);
#pragma unroll 1
            for (int blk = 0; blk < 4; ++blk) {
                float ykeep = 0.f;
#pragma unroll
                for (int g4 = 0; g4 < 4; ++g4) {
                    const f32x4 v4 = *(const LAS f32x4*)(lds + L_VT + vt_off(row, 16 * blk + 4 * g4));
#pragma unroll
                    for (int i4 = 0; i4 < 4; ++i4) {
                        const int i = 4 * g4 + i4, tt = 16 * blk + i, tn = tt < 63 ? tt + 1 : 63;
                        const LAS unsigned char* rn = rbase + tn * REC;
                        const f32x2 na = *(const LAS f32x2*)(rn + V_A * 256), nw = *(const LAS f32x2*)(rn + V_W * 256), nb = *(const LAS f32x2*)(rn + V_B * 256),
                                    nk = *(const LAS f32x2*)(rn + V_K * 256), nr = *(const LAS f32x2*)(rn + V_R * 256);
                        const float vv = v4[i4];
                        const f32x2 p = S2 * ca;
                        const float sa = allsum32(p.x + p.y);
                        S2 = S2 * cw + ck * vv;
                        S2 = cb * sa + S2;
                        const f32x2 yq = S2 * cr;
                        const float y = allsum32(yq.x + yq.y);
                        ykeep = (cg == i) ? y : ykeep;
                        ca = na; cw = nw; cb = nb; ck = nk; cr = nr;
                    }
                }
                if (hh == 0) *(LAS float*)(lds + L_YS + ((16 * blk + cg) * 16 + 2 * w + rsel) * 4) = ykeep;
            }
        }
        __syncthreads();
        if (tid < 128) { const int j = tid >> 1, pc = tid & 1; const LAS float* ys = (const LAS float*)(lds + L_YS) + j * 16 + 8 * pc;
            u32x4 o; o.x = pg8::cvt_pk_bf16(ys[0], ys[1]); o.y = pg8::cvt_pk_bf16(ys[2], ys[3]); o.z = pg8::cvt_pk_bf16(ys[4], ys[5]); o.w = pg8::cvt_pk_bf16(ys[6], ys[7]);
            *(u32x4*)(U + RW_TOK(c, j) * PU + OFF_R + dir * RW + hc + 16 * rh + 8 * pc) = o; }
    }
    if (!q.grid) { const size_t sb = (((size_t)q.b * DEPTH + l) * 2 + dir) * RH + head; *(f32x2*)(P.out + OUT_S + (sb * 64 + row) * 64 + col0) = S2; }
    __syncthreads();
#undef RW_TOK
#undef RW_PREFETCH
}
constexpr int N_ITEMS = NSEQ * RH * 2 * 4;
__device__ __forceinline__ void decode_item(int it, int& s, int& head, int& dir, int& rh) {
    rh = it & 3; int ch = it >> 2; dir = ch & 1; ch >>= 1; head = ch % RH; const int sq = ch / RH;
    s = sq < LB ? CB + sq : sq - LB;
}
}


namespace wy {
typedef short bf16x8 __attribute__((ext_vector_type(8)));
typedef float f32x4 __attribute__((ext_vector_type(4)));
typedef unsigned u32x4 __attribute__((ext_vector_type(4)));
constexpr int PV = 144, PS = 48;
constexpr int L_AH = 0, L_RH = L_AH + 64 * PV, L_BH = L_RH + 64 * PV, L_KH = L_BH + 64 * PV, L_BT = L_KH + 64 * PV, L_KT = L_BT + 64 * PV, L_VS = L_KT + 64 * PV,
              L_SS = L_VS + 64 * PV, L_YS = L_SS + 64 * PV, L_TW = L_YS + 64 * PV, L_AL = L_TW + 64 * PV, L_NAB = L_AL + 64 * PV, L_NAKT = L_NAB + 4096,
              L_NRKT = L_NAKT + 4 * 16 * PS, L_NRBT = L_NRKT + 4 * 16 * PS, L_TT = L_NRBT + 4 * 16 * PS, L_XS = L_TT + 4 * 16 * PS, L_US = L_XS + 64 * PS, L_GL = L_US + 64 * PS,
              L_INV = L_GL + 1024, L_END = L_INV + 256;
static_assert(L_END <= 131072, "WY LDS map");
__device__ __forceinline__ bf16x8 fragk16(LAS unsigned char* lds, int base, int pitch, int row0, int k0, int lane) {
    const bf16x8 v = *(const LAS bf16x8*)(lds + base + (row0 + (lane & 15)) * pitch + (k0 + 8 * ((lane >> 4) & 1)) * 2);
    const bf16x8 z = {0, 0, 0, 0, 0, 0, 0, 0};
    return (lane < 32) ? v : z;
}
__device__ __forceinline__ void stb(LAS unsigned char* lds, int off, float v) { *(LAS bf16*)(lds + off) = f2bf(v); }
typedef unsigned u32x2 __attribute__((ext_vector_type(2)));
__device__ __forceinline__ bf16x8 pack_k16(const f32x4 v) { u32x4 o; o.x = pg8::cvt_pk_bf16(v[0], v[1]); o.y = pg8::cvt_pk_bf16(v[2], v[3]); o.z = 0u; o.w = 0u; return __builtin_bit_cast(bf16x8, o); }
__device__ __forceinline__ bf16x8 pack_k32(const f32x4 a, const f32x4 b) { u32x4 o; o.x = pg8::cvt_pk_bf16(a[0], a[1]); o.y = pg8::cvt_pk_bf16(a[2], a[3]); o.z = pg8::cvt_pk_bf16(b[0], b[1]); o.w = pg8::cvt_pk_bf16(b[2], b[3]);
    return __builtin_bit_cast(bf16x8, o); }
__device__ __forceinline__ bf16x8 ld_k16(LAS unsigned char* lds, int base, int pitch, int row0, int col0, int lane) {
    const u32x2 v = *(const LAS u32x2*)(lds + base + (row0 + (lane & 15)) * pitch + (col0 + 4 * (lane >> 4)) * 2); u32x4 o; o.x = v.x; o.y = v.y; o.z = 0u; o.w = 0u; return __builtin_bit_cast(bf16x8, o); }
__device__ __forceinline__ bf16x8 ld_k32(LAS unsigned char* lds, int base, int pitch, int row0, int col0, int lane) {
    const LAS unsigned char* p = lds + base + (row0 + (lane & 15)) * pitch + (col0 + 4 * (lane >> 4)) * 2;
    const u32x2 v0 = *(const LAS u32x2*)p, v1 = *(const LAS u32x2*)(p + 32); u32x4 o; o.x = v0.x; o.y = v0.y; o.z = v1.x; o.w = v1.y; return __builtin_bit_cast(bf16x8, o); }
__device__ __forceinline__ void rwkv_item(LAS unsigned char* lds, CParams& P, int l, int s, int head, int dir) {
    const int tid = threadIdx.x, w = __builtin_amdgcn_readfirstlane(tid >> 6), lane = tid & 63, fr = lane & 15, fq = lane >> 4;
    const int rt = w & 3, half = w >> 2, hc = head * 64;
    const SeqInfo q = seqinfo(s); const int nchunk = q.T / 64;
    const bf16* RX = WSP(bf16, WS_RXC); bf16* U = WSP(bf16, WS_U1);
    const int pj = tid >> 3, psub = tid & 7;
    f32x4 sacc[4];
#pragma unroll
    for (int ct = 0; ct < 4; ++ct) sacc[ct] = (f32x4){0.f, 0.f, 0.f, 0.f};
    if (w < 4 && q.grid) { const size_t sb = (((size_t)q.b * DEPTH + l) * 2 + dir) * RH + head;
#pragma unroll
        for (int ct = 0; ct < 4; ++ct) sacc[ct] = *(const f32x4*)(P.in[ST_R] + (sb * 64 + 16 * w + fr) * 64 + 16 * ct + 4 * fq); }
    float rkk8[8];
#pragma unroll
    for (int e = 0; e < 8; ++e) rkk8[e] = P.in[R_KK][(size_t)l * RW + hc + 8 * psub + e];
    float c_w0[2], c_a0[2], c_kk[2], c_ka[2];
#pragma unroll
    for (int cc = 0; cc < 2; ++cc) { const int c = 16 * (2 * half + cc) + fr;
        c_w0[cc] = P.in[R_W0][((size_t)l * 2 + dir) * RW + hc + c]; c_a0[cc] = P.in[R_A0][((size_t)l * 2 + dir) * RW + hc + c];
        c_kk[cc] = P.in[R_KK][(size_t)l * RW + hc + c]; c_ka[cc] = P.in[R_KA][(size_t)l * RW + hc + c]; }
    const bf16* w2t = WSP(bf16, O_W2T) + ((size_t)dir * RW + hc) * 64; const bf16* a2t = WSP(bf16, O_A2T) + ((size_t)dir * RW + hc) * 64;
    u32x4 pf[5];
#define WY_TOK(c, j) ((size_t)(q.base + (dir ? q.T - 1 - ((c) * 64 + (j)) : ((c) * 64 + (j)))))
#define WY_PREFETCH(c) do { const bf16* rx = RX + WY_TOK(c, pj) * RIN + 8 * psub; \
        pf[0] = *(const u32x4*)(rx + RX_R + hc); pf[1] = *(const u32x4*)(rx + RX_K + hc); pf[2] = *(const u32x4*)(rx + RX_V + hc); \
        pf[3] = *(const u32x4*)(rx + RX_WL + dir * 64); pf[4] = *(const u32x4*)(rx + RX_AL + dir * 64); } while (0)
    WY_PREFETCH(0);
    for (int c = 0; c < nchunk; ++c) {
        { *(LAS u32x4*)(lds + L_RH + pj * PV + psub * 16) = pf[0]; *(LAS u32x4*)(lds + L_KH + pj * PV + psub * 16) = pf[1];
          const unsigned kw[4] = {pf[1].x, pf[1].y, pf[1].z, pf[1].w}, vw[4] = {pf[2].x, pf[2].y, pf[2].z, pf[2].w};
          float ss = 0.f;
#pragma unroll
          for (int e = 0; e < 8; ++e) { const float kf = __builtin_bit_cast(float, (e & 1) ? (kw[e >> 1] & 0xffff0000u) : (kw[e >> 1] << 16)) * rkk8[e]; ss += kf * kf;
              *(LAS bf16*)(lds + L_VS + (8 * psub + e) * PV + pj * 2) = (bf16)((vw[e >> 1] >> ((e & 1) * 16)) & 0xffffu); }
          ss += rw::dpp_xor1(ss); ss += rw::dpp_xor2(ss); ss += __shfl_xor(ss, 4);
          if (psub == 0) *(LAS float*)(lds + L_INV + pj * 4) = 1.0f / fmaxf(sqrtf(ss), 1e-12f);
          *(LAS u32x4*)(lds + L_TW + pj * PV + psub * 16) = pf[3]; *(LAS u32x4*)(lds + L_AL + pj * PV + psub * 16) = pf[4]; }
        LDS_BARRIER();
        if (c + 1 < nchunk) WY_PREFETCH(c + 1);
#pragma unroll
        for (int cc = 0; cc < 2; ++cc) { const int ct = 2 * half + cc; const int cidx = 16 * ct + fr;
            f32x4 aw = (f32x4){0.f, 0.f, 0.f, 0.f}, aa = (f32x4){0.f, 0.f, 0.f, 0.f};
#pragma unroll
            for (int ks = 0; ks < 2; ++ks) { const size_t bo = (size_t)cidx * 64 + 32 * ks + 8 * fq;
                aw = ml::mma(ml::frag(lds, L_TW, PV, 16 * rt, 32 * ks, lane), *(const bf16x8*)(w2t + bo), aw); aa = ml::mma(ml::frag(lds, L_AL, PV, 16 * rt, 32 * ks, lane), *(const bf16x8*)(a2t + bo), aa); }
            float kr4[4], rr4[4], iv4[4];
#pragma unroll
            for (int r = 0; r < 4; ++r) { const int tok = 16 * rt + 4 * fq + r; kr4[r] = bf2f(*(const LAS bf16*)(lds + L_KH + tok * PV + cidx * 2)); rr4[r] = bf2f(*(const LAS bf16*)(lds + L_RH + tok * PV + cidx * 2));
                iv4[r] = *(const LAS float*)(lds + L_INV + tok * 4); }
            float lw[4], cum[4];
#pragma unroll
            for (int r = 0; r < 4; ++r) { lw[r] = -0.6065306597126334f * pg8::fsigmoid(c_w0[cc] + aw[r]); cum[r] = (r ? cum[r - 1] : 0.f) + lw[r]; }
            const float tot = cum[3]; const float p1 = __shfl_up(tot, 16), p2 = __shfl_up(tot, 32), p3 = __shfl_up(tot, 48);
            const float off = (fq >= 1 ? p1 : 0.f) + (fq >= 2 ? p2 : 0.f) + (fq >= 3 ? p3 : 0.f);
            float gprev = __expf(off);
#pragma unroll
            for (int r = 0; r < 4; ++r) { const int tok = 16 * rt + 4 * fq + r; const float lam = off + cum[r]; const float g = __expf(lam), gi = __builtin_amdgcn_rcpf(g);
                const float alpha = pg8::fsigmoid(c_a0[cc] + aa[r]);
                const float kraw = kr4[r], rraw = rr4[r];
                const float kkn = kraw * c_kk[cc] * iv4[r];
                const bf16 bh = f2bf(kkn * alpha * gi), kh = f2bf(kraw * (1.0f + (alpha - 1.0f) * c_ka[cc]) * gi);
                stb(lds, L_AH + tok * PV + cidx * 2, -kkn * gprev); stb(lds, L_RH + tok * PV + cidx * 2, rraw * g);
                *(LAS bf16*)(lds + L_BH + tok * PV + cidx * 2) = bh; *(LAS bf16*)(lds + L_KH + tok * PV + cidx * 2) = kh;
                *(LAS bf16*)(lds + L_BT + cidx * PV + tok * 2) = bh; *(LAS bf16*)(lds + L_KT + cidx * PV + tok * 2) = kh;
                if (fq == 3 && r == 3) *(LAS float*)(lds + L_GL + (rt * 64 + cidx) * 4) = g;
                gprev = g; } }
        LDS_BARRIER();
        { const int sc = w >> 1, side = w & 1; f32x4 gB = (f32x4){0.f, 0.f, 0.f, 0.f}, gK = (f32x4){0.f, 0.f, 0.f, 0.f};
#pragma unroll
          for (int ks = 0; ks < 2; ++ks) { const bf16x8 af = ml::frag(lds, side ? L_RH : L_AH, PV, 16 * sc, 32 * ks, lane);
              gB = ml::mma(af, ml::frag(lds, L_BH, PV, 16 * sc, 32 * ks, lane), gB); gK = ml::mma(af, ml::frag(lds, L_KH, PV, 16 * sc, 32 * ks, lane), gK); }
#pragma unroll
          for (int r = 0; r < 4; ++r) { const int t = 4 * fq + r; const bool keep = side ? (fr <= t) : (fr < t); const float vB = keep ? gB[r] : 0.f, vK = keep ? gK[r] : 0.f;
              if (side == 0) { *(LAS float*)(lds + L_NAB + ((sc * 16 + t) * 16 + fr) * 4) = vB; stb(lds, L_NAKT + (sc * 16 + t) * PS + fr * 2, vK); }
              else { stb(lds, L_NRBT + (sc * 16 + t) * PS + fr * 2, vB); stb(lds, L_NRKT + (sc * 16 + t) * PS + fr * 2, vK); } } }
        LDS_BARRIER();
        if (w < 4 && lane < 16) { float Tr[16];
#pragma unroll
            for (int ph = 0; ph < 4; ++ph) { f32x4 nv[4][4];
#pragma unroll
                for (int tq = 0; tq < 4; ++tq)
#pragma unroll
                    for (int u4 = 0; u4 <= ph; ++u4) nv[tq][u4] = *(const LAS f32x4*)(lds + L_NAB + ((w * 16 + 4 * ph + tq) * 16 + 4 * u4) * 4);
#pragma unroll
                for (int tq = 0; tq < 4; ++tq) { const int t = 4 * ph + tq; float x0 = (lane == t) ? 1.f : 0.f, x1 = 0.f;
#pragma unroll
                    for (int u = 0; u < 16; ++u) if (u < t) { if (u & 1) x1 += Tr[u] * nv[tq][u >> 2][u & 3]; else x0 += Tr[u] * nv[tq][u >> 2][u & 3]; }
                    Tr[t] = x0 + x1; stb(lds, L_TT + (w * 16 + t) * PS + lane * 2, Tr[t]); } } }
        LDS_BARRIER();
        if (w < 4) {
#pragma unroll 1
            for (int sc = 0; sc < 4; ++sc) {
                const bf16x8 ah0 = ld_k32(lds, L_AH, PV, 16 * sc, 0, lane), ah1 = ld_k32(lds, L_AH, PV, 16 * sc, 32, lane), rh0 = ld_k32(lds, L_RH, PV, 16 * sc, 0, lane), rh1 = ld_k32(lds, L_RH, PV, 16 * sc, 32, lane);
                const bf16x8 nak = ld_k16(lds, L_NAKT, PS, 16 * sc, 0, lane), nrk = ld_k16(lds, L_NRKT, PS, 16 * sc, 0, lane), ttf = ld_k16(lds, L_TT, PS, 16 * sc, 0, lane), nrb = ld_k16(lds, L_NRBT, PS, 16 * sc, 0, lane);
                const bf16x8 vsf = ld_k16(lds, L_VS, PV, 16 * w, 16 * sc, lane);
                bf16x8 btf[4], ktf[4]; f32x4 glv[4];
#pragma unroll
                for (int ct = 0; ct < 4; ++ct) { btf[ct] = ld_k16(lds, L_BT, PV, 16 * ct, 16 * sc, lane); ktf[ct] = ld_k16(lds, L_KT, PV, 16 * ct, 16 * sc, lane);
                    glv[ct] = *(const LAS f32x4*)(lds + L_GL + (sc * 64 + 16 * ct + 4 * fq) * 4); }
                const bf16x8 sb0 = pack_k32(sacc[0], sacc[1]), sb1 = pack_k32(sacc[2], sacc[3]);
                f32x4 XT = (f32x4){0.f, 0.f, 0.f, 0.f}, YT = (f32x4){0.f, 0.f, 0.f, 0.f};
                XT = ml::mma(ah0, sb0, XT); XT = ml::mma(ah1, sb1, XT); XT = ml::mma(nak, vsf, XT);
                YT = ml::mma(rh0, sb0, YT); YT = ml::mma(rh1, sb1, YT); YT = ml::mma(nrk, vsf, YT);
                f32x4 UT = (f32x4){0.f, 0.f, 0.f, 0.f};
                UT = ml::mma(ttf, pack_k16(XT), UT);
                const bf16x8 ub = pack_k16(UT);
                YT = ml::mma(nrb, ub, YT);
#pragma unroll
                for (int r = 0; r < 4; ++r) stb(lds, L_YS + (16 * sc + 4 * fq + r) * PV + (16 * w + fr) * 2, YT[r]);
#pragma unroll
                for (int ct = 0; ct < 4; ++ct) { sacc[ct] = ml::mma(btf[ct], ub, sacc[ct]); sacc[ct] = ml::mma(ktf[ct], vsf, sacc[ct]); sacc[ct] = sacc[ct] * glv[ct]; }
            }
        }
        LDS_BARRIER();
        *(u32x4*)(U + WY_TOK(c, pj) * PU + OFF_R + dir * RW + hc + 8 * psub) = *(const LAS u32x4*)(lds + L_YS + pj * PV + psub * 16);
    }
    if (!q.grid && w < 4) { const size_t sb = (((size_t)q.b * DEPTH + l) * 2 + dir) * RH + head;
#pragma unroll
        for (int ct = 0; ct < 4; ++ct) *(f32x4*)(P.out + OUT_S + (sb * 64 + 16 * w + fr) * 64 + 16 * ct + 4 * fq) = sacc[ct]; }
    LDS_BARRIER();
#undef WY_TOK
#undef WY_PREFETCH
}
constexpr int N_ITEMS = NSEQ * RH * 2;
__device__ __forceinline__ void decode_item(int it, int& s, int& head, int& dir) {
    dir = it & 1; int ch = it >> 1; head = ch % RH; const int sq = ch / RH;
    s = sq < LB ? CB + sq : sq - LB;
}
}

namespace el {
typedef float f32x4 __attribute__((ext_vector_type(4)));
typedef unsigned u32x4 __attribute__((ext_vector_type(4)));
typedef unsigned u32x2 __attribute__((ext_vector_type(2)));
typedef short bf16x8 __attribute__((ext_vector_type(8)));
__device__ __forceinline__ float wave_sum(float v) {
#pragma unroll
    for (int o = 1; o < 64; o <<= 1) v += __shfl_xor(v, o);
    return v;
}
__device__ __forceinline__ void unpack8(const u32x4 p, float (&f)[8]) {
    f[0] = pg8::bflo(p.x); f[1] = pg8::bfhi(p.x); f[2] = pg8::bflo(p.y); f[3] = pg8::bfhi(p.y); f[4] = pg8::bflo(p.z); f[5] = pg8::bfhi(p.z); f[6] = pg8::bflo(p.w); f[7] = pg8::bfhi(p.w);
}
__device__ __forceinline__ u32x4 pack8(const float (&f)[8]) {
    u32x4 o; o.x = pg8::cvt_pk_bf16(f[0], f[1]); o.y = pg8::cvt_pk_bf16(f[2], f[3]); o.z = pg8::cvt_pk_bf16(f[4], f[5]); o.w = pg8::cvt_pk_bf16(f[6], f[7]); return o;
}
__device__ __forceinline__ void init_phase(LAS unsigned char* lds, CParams& P, int vb, int G) {
    const int tid = threadIdx.x, w = tid >> 6, lane = tid & 63;
    { const size_t n4 = (size_t)NT * D / 4, nc4 = (size_t)NC * D / 4; f32x4* o = (f32x4*)P.out; const f32x4* a = (const f32x4*)P.in[X_PROMPT]; const f32x4* b = (const f32x4*)P.in[X_SAMPLE];
      for (size_t i = (size_t)vb * 512 + tid; i < n4; i += (size_t)G * 512) o[i] = i < nc4 ? a[i] : b[i - nc4]; }
    LAS float* red = (LAS float*)lds;
    constexpr int KW = D / 8;
    for (int it = vb; it < DEPTH * (6 * D / 64); it += G) {
        const int l = it / (6 * D / 64), j = (it % (6 * D / 64)) * 64 + lane;
        const float* wp = P.in[ADA_W] + ((size_t)l * D + w * KW) * 6 * D + j;
        float acc[NCOND];
#pragma unroll
        for (int ci = 0; ci < NCOND; ++ci) acc[ci] = 0.f;
        for (int k = 0; k < KW; ++k) { const float wv = wp[(size_t)k * 6 * D];
#pragma unroll
            for (int ci = 0; ci < NCOND; ++ci) { const float cv = ci == 0 ? P.in[C_CTX][w * KW + k] : P.in[C_LAT][(size_t)(ci - 1) * D + w * KW + k]; acc[ci] += cv * pg8::fsigmoid(cv) * wv; } }
#pragma unroll
        for (int ci = 0; ci < NCOND; ++ci) red[(w * NCOND + ci) * 64 + lane] = acc[ci];
        __syncthreads();
        if (w < NCOND) { float sum = P.in[ADA_B][(size_t)l * 6 * D + j];
#pragma unroll
            for (int ww = 0; ww < 8; ++ww) sum += red[(ww * NCOND + w) * 64 + lane];
            WSP(float, WS_MOD)[((size_t)l * NCOND + w) * 6 * D + j] = sum; }
        __syncthreads();
    }
}
__device__ __forceinline__ int perm5(int n) { return (((n >> 2) & 1) << 4) | (((n >> 3) & 3) << 2) | (n & 3); }
__device__ __forceinline__ void transpose_item(const float* W, int ldw, int nvalid, bf16* dst, int K, int k0, int drow0, bool perm, LAS float* scr, int lane) {
#pragma unroll 8
    for (int i = 0; i < 32; ++i) { const int kk = 2 * i + (lane >> 5), n = lane & 31; scr[kk * 33 + n] = n < nvalid ? W[(size_t)kk * ldw + n] : 0.f; }
    asm volatile("s_waitcnt lgkmcnt(0)" ::: "memory");
    const int c = lane & 7;
#pragma unroll
    for (int j = 0; j < 4; ++j) { const int n = (lane >> 3) + 8 * j; const LAS float* sp = scr + (8 * c) * 33 + n;
        u32x4 o; o.x = pg8::cvt_pk_bf16(sp[0 * 33], sp[1 * 33]); o.y = pg8::cvt_pk_bf16(sp[2 * 33], sp[3 * 33]); o.z = pg8::cvt_pk_bf16(sp[4 * 33], sp[5 * 33]); o.w = pg8::cvt_pk_bf16(sp[6 * 33], sp[7 * 33]);
        *(u32x4*)(dst + (size_t)(drow0 + (perm ? perm5(n) : n)) * K + k0 + 8 * c) = o; }
    asm volatile("s_waitcnt lgkmcnt(0)" ::: "memory");
}
constexpr int WI_0 = (N1P / 32) * (D / 64), WI_1 = WI_0 + (2 * D / 32) * (D / 64), WI_2 = WI_1 + (D / 32) * (MW / 64), WI_3 = WI_2 + (D / 32) * (RW / 64),
              WI_4 = WI_3 + (D / 32) * (D / 64), WI_5 = WI_4 + 2 * (FF / 32) * (D / 64), WI_6 = WI_5 + (D / 32) * (FF / 64), WI_7 = WI_6 + (RW / 32) * (128 / 64), WI_8 = WI_7 + 4 * (RW / 32);
__device__ __forceinline__ void wconv_phase(LAS unsigned char* lds, CParams& P, int l, int vb, int G) {
    const int tid = threadIdx.x, w = tid >> 6, lane = tid & 63;
    LAS float* scr = (LAS float*)(lds + w * 8704);
    for (int it = vb * 8 + w; it < WI_8; it += G * 8) {
        if (it < WI_0) { const int nb = it / (D / 64), kb = it % (D / 64); const int n0 = nb * 32; const int nv = n0 >= N1 ? 0 : (N1 - n0 < 32 ? N1 - n0 : 32);
            transpose_item(P.in[W_IN] + ((size_t)l * D + kb * 64) * PIN + n0, PIN, nv, WSP(bf16, O_WIN1), D, kb * 64, n0, true, scr, lane); }
        else if (it < WI_1) { const int r = it - WI_0, nb = r / (D / 64), kb = r % (D / 64);
            transpose_item(P.in[W_IN] + ((size_t)l * D + kb * 64) * PIN + N1 + nb * 32, PIN, 32, WSP(bf16, O_WIN2), D, kb * 64, nb * 32, true, scr, lane); }
        else if (it < WI_2) { const int r = it - WI_1, nb = r / (MW / 64), kb = r % (MW / 64);
            transpose_item(P.in[PROJ_M] + ((size_t)l * MW + kb * 64) * D + nb * 32, D, 32, WSP(bf16, O_PM), MW, kb * 64, nb * 32, true, scr, lane); }
        else if (it < WI_3) { const int r = it - WI_2, nb = r / (RW / 64), kb = r % (RW / 64);
            transpose_item(P.in[PROJ_R] + ((size_t)l * RW + kb * 64) * D + nb * 32, D, 32, WSP(bf16, O_PR), RW, kb * 64, nb * 32, true, scr, lane); }
        else if (it < WI_4) { const int r = it - WI_3, nb = r / (D / 64), kb = r % (D / 64);
            transpose_item(P.in[W_OUT] + ((size_t)l * D + kb * 64) * D + nb * 32, D, 32, WSP(bf16, O_WO), D, kb * 64, nb * 32, false, scr, lane); }
        else if (it < WI_5) { const int r = it - WI_4, which = r / ((FF / 32) * (D / 64)), r2 = r % ((FF / 32) * (D / 64)), nb = r2 / (D / 64), kb = r2 % (D / 64);
            const int j0 = nb * 32, pn = j0 >> 7, drow0 = pn * 256 + which * 128 + (j0 & 127);
            transpose_item((which ? P.in[FFN_W3] : P.in[FFN_W1]) + ((size_t)l * D + kb * 64) * FF + j0, FF, 32, WSP(bf16, O_W13), D, kb * 64, drow0, true, scr, lane); }
        else if (it < WI_6) { const int r = it - WI_5, nb = r / (FF / 64), kb = r % (FF / 64);
            transpose_item(P.in[FFN_W2] + ((size_t)l * FF + kb * 64) * D + nb * 32, D, 32, WSP(bf16, O_W2), FF, kb * 64, nb * 32, false, scr, lane); }
        else if (it < WI_7) { const int r = it - WI_6, nb = r / 2, kb = r % 2;
            transpose_item(P.in[R_G2] + ((size_t)l * 128 + kb * 64) * RW + nb * 32, RW, 32, WSP(bf16, O_G2T), 128, kb * 64, nb * 32, false, scr, lane); }
        else { const int r = it - WI_7, which = r / (2 * (RW / 32)), d = (r / (RW / 32)) & 1, nb = r % (RW / 32);
            transpose_item((which ? P.in[R_A2] : P.in[R_W2]) + ((size_t)l * 2 + d) * 64 * RW + nb * 32, RW, 32, WSP(bf16, which ? O_A2T : O_W2T) + (size_t)d * RW * 64, 64, 0, nb * 32, false, scr, lane); }
    }
}
__device__ __forceinline__ void norm_phase(CParams& P, int l, int mode, int vb, int G) {
    const int tid = threadIdx.x, w = tid >> 6, lane = tid & 63;
    for (int m = vb * 8 + w; m < NT; m += G * 8) {
        float* xr = P.out + (size_t)m * D;
        f32x4 v[D / 256]; float ss = 0.f;
#pragma unroll
        for (int j = 0; j < D / 256; ++j) { v[j] = *(const f32x4*)(xr + 256 * j + 4 * lane); ss += (v[j][0] * v[j][0] + v[j][1] * v[j][1]) + (v[j][2] * v[j][2] + v[j][3] * v[j][3]); }
        const float rs = 1.0f / sqrtf(wave_sum(ss) * (1.0f / D) + RMS_EPS);
        if (mode == 3) {
#pragma unroll
            for (int j = 0; j < D / 256; ++j) { const f32x4 g = *(const f32x4*)(P.in[FINAL_G] + 256 * j + 4 * lane); *(f32x4*)(xr + 256 * j + 4 * lane) = v[j] * rs * g; }
        } else {
            const int second = (mode == 2); const int cond = seqinfo(seq_of_token(m)).cond;
            const float* gp = P.in[second ? NORM2 : NORM1] + (size_t)l * D; const float* mod = WSP(float, WS_MOD) + ((size_t)l * NCOND + cond) * 6 * D + (second ? 3 * D : 0);
            bf16* o = WSP(bf16, mode == 1 ? WS_RXC : WS_QKC) + (size_t)m * D;
#pragma unroll
            for (int j = 0; j < D / 256; ++j) { const int c = 256 * j + 4 * lane; const f32x4 g = *(const f32x4*)(gp + c), sh = *(const f32x4*)(mod + c), sc = *(const f32x4*)(mod + D + c);
                const f32x4 y = v[j] * rs * g * (sc + 1.0f) + sh; u32x2 pk; pk.x = pg8::cvt_pk_bf16(y[0], y[1]); pk.y = pg8::cvt_pk_bf16(y[2], y[3]); *(u32x2*)(o + c) = pk; }
        }
    }
}
constexpr int CV_NCH = 2 * MW + RIN, CV_NG = CV_NCH / 8, CV_NCHUNK = (CV_NG + 63) / 64, CV_ITEMS = (NT / 64) * CV_NCHUNK;
__device__ __forceinline__ void cv_act_store(CParams& P, float (&acc)[8], int kind, bool isqk, size_t m, int c) {
#pragma unroll
    for (int e = 0; e < 8; ++e) { float v = acc[e];
        if (kind <= 1) { v = v * pg8::fsigmoid(v); if (kind == 0) v *= 0.08838834764831845f; } else if (kind == 3) v = 1.0f - 2.0f * __builtin_amdgcn_rcpf(__expf(2.0f * v) + 1.0f); else if (kind == 4) v = pg8::fsigmoid(v);
        acc[e] = v; }
    if (isqk) *(u32x4*)(WSP(bf16, WS_QKC) + m * (2 * MW) + c) = pack8(acc); else *(u32x4*)(WSP(bf16, WS_RXC) + m * RIN + c) = pack8(acc);
}
__device__ __forceinline__ void conv_phase(CParams& P, int l, int vb, int G) {
    const int tid = threadIdx.x, w = tid >> 6, lane = tid & 63;
    const bf16* U = WSP(bf16, WS_U1);
    const u32x4 zero4 = {0u, 0u, 0u, 0u};
    for (int it = vb * 8 + w; it < CV_ITEMS; it += G * 8) {
        const int seg = it / CV_NCHUNK, g = (it % CV_NCHUNK) * 64 + lane;
        if (g >= CV_NG) continue;
        const int ch = 8 * g; const bool isqk = ch < 2 * MW; const int c = isqk ? ch : ch - 2 * MW;
        const int ucol = isqk ? OFF_QK + c : OFF_R + c, CH = isqk ? 2 * MW : RIN;
        const float* wsrc = (isqk ? P.in[M_CONV] : P.in[R_CONV]) + (size_t)l * 9 * CH + c;
        const int kind = isqk ? (c < MW ? 0 : 1) : (c >= RX_GL ? 4 : (c >= RX_AL ? 2 : (c >= RX_WL ? 3 : 2)));
        const int m0 = seg * 64; const SeqInfo q = seqinfo(seq_of_token(m0)); const int t0 = m0 - q.base;
        if (q.grid) {
            float wt[9][8];
#pragma unroll
            for (int a = 0; a < 9; ++a) { const f32x4 w0 = *(const f32x4*)(wsrc + (size_t)a * CH), w1 = *(const f32x4*)(wsrc + (size_t)a * CH + 4);
#pragma unroll
                for (int e = 0; e < 4; ++e) { wt[a][e] = w0[e]; wt[a][4 + e] = w1[e]; } }
            const int r = t0 / GW, cs = t0 % GW, rows = q.T / GW;
            const bf16* rowp[3]; bool rok[3];
#pragma unroll
            for (int a = 0; a < 3; ++a) { const int rr = r + a - 1; rok[a] = rr >= 0 && rr < rows; rowp[a] = U + (size_t)(q.base + (rok[a] ? rr : r) * GW) * PU + ucol; }
            u32x4 win[3][6];
#pragma unroll
            for (int a = 0; a < 3; ++a) { win[a][4] = (rok[a] && cs - 1 >= 0) ? *(const u32x4*)(rowp[a] + (size_t)(cs - 1) * PU) : zero4; win[a][5] = rok[a] ? *(const u32x4*)(rowp[a] + (size_t)cs * PU) : zero4; }
            for (int cb = 0; cb < 64; cb += 4) { const int c0 = cs + cb;
#pragma unroll
                for (int a = 0; a < 3; ++a) { win[a][0] = win[a][4]; win[a][1] = win[a][5];
#pragma unroll
                    for (int j = 2; j < 6; ++j) { const int col = c0 - 1 + j; win[a][j] = (rok[a] && col < GW) ? *(const u32x4*)(rowp[a] + (size_t)col * PU) : zero4; } }
#pragma unroll
                for (int o = 0; o < 4; ++o) { float acc[8];
#pragma unroll
                    for (int e = 0; e < 8; ++e) acc[e] = 0.f;
#pragma unroll
                    for (int a = 0; a < 3; ++a)
#pragma unroll
                        for (int b = 0; b < 3; ++b) { float xv[8]; unpack8(win[a][o + b], xv);
#pragma unroll
                            for (int e = 0; e < 8; ++e) acc[e] += wt[a * 3 + b][e] * xv[e]; }
                    cv_act_store(P, acc, kind, isqk, (size_t)m0 + cb + o, c); }
            }
        } else {
            float wt[3][8];
#pragma unroll
            for (int b = 0; b < 3; ++b) { const f32x4 w0 = *(const f32x4*)(wsrc + (size_t)(3 + b) * CH), w1 = *(const f32x4*)(wsrc + (size_t)(3 + b) * CH + 4);
#pragma unroll
                for (int e = 0; e < 4; ++e) { wt[b][e] = w0[e]; wt[b][4 + e] = w1[e]; } }
            const bf16* base = U + (size_t)q.base * PU + ucol;
            u32x4 win[10];
            win[8] = (t0 - 1 >= 0) ? *(const u32x4*)(base + (size_t)(t0 - 1) * PU) : zero4; win[9] = *(const u32x4*)(base + (size_t)t0 * PU);
            for (int cb = 0; cb < 64; cb += 8) { const int tb = t0 + cb;
                win[0] = win[8]; win[1] = win[9];
#pragma unroll
                for (int j = 2; j < 10; ++j) { const int t = tb - 1 + j; win[j] = (t < q.T) ? *(const u32x4*)(base + (size_t)t * PU) : zero4; }
#pragma unroll
                for (int o = 0; o < 8; ++o) { float acc[8], x0[8], x1[8], x2[8]; unpack8(win[o], x0); unpack8(win[o + 1], x1); unpack8(win[o + 2], x2);
#pragma unroll
                    for (int e = 0; e < 8; ++e) acc[e] = wt[0][e] * x0[e] + wt[1][e] * x1[e] + wt[2][e] * x2[e];
                    cv_act_store(P, acc, kind, isqk, (size_t)m0 + cb + o, c); }
            }
        }
    }
}
constexpr int PO_ITEMS = (NT / 16) * 2, PO_HC = RW / 2;
__device__ __forceinline__ void post_phase(LAS unsigned char* lds, CParams& P, int l, int vb, int G) {
    const int tid = threadIdx.x, w = tid >> 6, lane = tid & 63, fr = lane & 15, fq = lane >> 4, l32 = lane & 31, th = lane >> 5;
    constexpr int GP = PO_HC * 2 + 16;
    LAS unsigned char* gt = lds + w * (16 * GP);
    const bf16* U = WSP(bf16, WS_U1); const bf16* RX = WSP(bf16, WS_RXC); const bf16* G2T = WSP(bf16, O_G2T); bf16* O = WSP(bf16, WS_QKC);
    for (int it = vb * 8 + w; it < PO_ITEMS; it += G * 8) {
        const int tile = it >> 1, h = it & 1; const size_t tok0 = (size_t)tile * 16;
        bf16x8 af[4];
#pragma unroll
        for (int ks = 0; ks < 4; ++ks) af[ks] = *(const bf16x8*)(RX + (tok0 + fr) * RIN + RX_GL + 32 * ks + 8 * fq);
        for (int ct = 0; ct < PO_HC / 16; ++ct) { f32x4 acc = (f32x4){0.f, 0.f, 0.f, 0.f};
#pragma unroll
            for (int ks = 0; ks < 4; ++ks) acc = ml::mma(af[ks], *(const bf16x8*)(G2T + (size_t)(h * PO_HC + 16 * ct + fr) * 128 + 32 * ks + 8 * fq), acc);
#pragma unroll
            for (int r = 0; r < 4; ++r) *(LAS bf16*)(gt + (4 * fq + r) * GP + (16 * ct + fr) * 2) = f2bf(acc[r]); }
        asm volatile("s_waitcnt lgkmcnt(0)" ::: "memory");
        const int cb = h * PO_HC + 8 * l32;
        float gn[8], gw[8], gb[8], rk[8];
        { const f32x4 a0 = *(const f32x4*)(P.in[M_NORM_G] + (size_t)l * MW + cb), a1 = *(const f32x4*)(P.in[M_NORM_G] + (size_t)l * MW + cb + 4);
          const f32x4 b0 = *(const f32x4*)(P.in[R_GN_W] + (size_t)l * RW + cb), b1 = *(const f32x4*)(P.in[R_GN_W] + (size_t)l * RW + cb + 4);
          const f32x4 c0 = *(const f32x4*)(P.in[R_GN_B] + (size_t)l * RW + cb), c1 = *(const f32x4*)(P.in[R_GN_B] + (size_t)l * RW + cb + 4);
          const f32x4 d0 = *(const f32x4*)(P.in[R_RK] + (size_t)l * RW + cb), d1 = *(const f32x4*)(P.in[R_RK] + (size_t)l * RW + cb + 4);
#pragma unroll
          for (int e = 0; e < 4; ++e) { gn[e] = a0[e]; gn[4 + e] = a1[e]; gw[e] = b0[e]; gw[4 + e] = b1[e]; gb[e] = c0[e]; gb[4 + e] = c1[e]; rk[e] = d0[e]; rk[4 + e] = d1[e]; } }
        for (int tp = 0; tp < 8; ++tp) { const int tl = 2 * tp + th; const size_t m = tok0 + tl; const bf16* u = U + m * PU; const bf16* rx = RX + m * RIN;
            float hf[8], hb[8], ov[8], x[8]; unpack8(*(const u32x4*)(u + cb), hf); unpack8(*(const u32x4*)(u + MW + cb), hb); unpack8(*(const u32x4*)(u + OFF_O + cb), ov);
            float ss = 0.f;
#pragma unroll
            for (int e = 0; e < 8; ++e) { x[e] = hf[e] + hb[e]; ss += x[e] * x[e]; }
            ss = rw::allsum16(ss); const float rs = 1.0f / sqrtf(ss * (1.0f / 128.f) + RMS_EPS);
#pragma unroll
            for (int e = 0; e < 8; ++e) x[e] = x[e] * rs * gn[e] * pg8::fsigmoid(ov[e]);
            *(u32x4*)(O + m * D + cb) = pack8(x);
            float yf[8], yb[8], rr[8], kk[8], vv[8], gg[8], y[8]; unpack8(*(const u32x4*)(u + OFF_R + cb), yf); unpack8(*(const u32x4*)(u + OFF_R + RW + cb), yb);
            unpack8(*(const u32x4*)(rx + RX_R + cb), rr); unpack8(*(const u32x4*)(rx + RX_K + cb), kk); unpack8(*(const u32x4*)(rx + RX_V + cb), vv);
            unpack8(*(const LAS u32x4*)(gt + tl * GP + l32 * 16), gg);
            float mu = 0.f, bs = 0.f;
#pragma unroll
            for (int e = 0; e < 8; ++e) { y[e] = yf[e] + yb[e]; mu += y[e]; bs += rr[e] * kk[e] * rk[e]; }
            mu += rw::dpp_xor1(mu); mu += rw::dpp_xor2(mu); mu += __shfl_xor(mu, 4); mu *= (1.0f / 64.f);
            bs += rw::dpp_xor1(bs); bs += rw::dpp_xor2(bs); bs += __shfl_xor(bs, 4);
            float var = 0.f;
#pragma unroll
            for (int e = 0; e < 8; ++e) { y[e] -= mu; var += y[e] * y[e]; }
            var += rw::dpp_xor1(var); var += rw::dpp_xor2(var); var += __shfl_xor(var, 4); var *= (1.0f / 64.f);
            const float rsd = 1.0f / sqrtf(var + GN_EPS);
#pragma unroll
            for (int e = 0; e < 8; ++e) y[e] = (y[e] * rsd * gw[e] + gb[e] + bs * vv[e]) * gg[e];
            *(u32x4*)(O + m * D + MW + cb) = pack8(y);
        }
        asm volatile("s_waitcnt lgkmcnt(0)" ::: "memory");
    }
}
}

constexpr int LDS_BYTES = 147456;
constexpr int LDS_MISC = 131072 + 320;
constexpr size_t CTL_ZERO_BYTES = 65536;
constexpr int CW_BAR = 4096, CW_Q = 8192;

#define XB_TMO      128
#define XB_XCNT(j)  (256  + 64 * (j))
#define XB_XSUB(j)  (1280 + 64 * (j))
#define XB_XGEN(j)  (2304 + 64 * (j))
#define XB_TOP      3328
#define XB_TOPGEN   3392
#define XCD_BAR_WORDS 3456
#define XB_SPIN_CAP (1u << 18)
__device__ __forceinline__ unsigned xb_ld(unsigned* p)              { return __hip_atomic_load(p, __ATOMIC_RELAXED, __HIP_MEMORY_SCOPE_AGENT); }
__device__ __forceinline__ unsigned xb_add(unsigned* p, unsigned v) { return __hip_atomic_fetch_add(p, v, __ATOMIC_RELAXED, __HIP_MEMORY_SCOPE_AGENT); }
__device__ __forceinline__ unsigned xb_xcc_id() { return (unsigned)__builtin_amdgcn_s_getreg((3 << 11) | 20) & 0xFu; }
#define XB_SPIN(cond, bar) do { unsigned _sp = 0; while (cond) { __builtin_amdgcn_s_sleep(1); \
    if ((++_sp & 255u) == 0u) { if (xb_ld(&(bar)[XB_TMO])) break; if (_sp > XB_SPIN_CAP) { atomicAdd(&(bar)[XB_TMO], 1u); break; } } } } while (0)
struct XcdBarrier { unsigned* bar; unsigned x; volatile LAS unsigned* st; };
__device__ __forceinline__ XcdBarrier xcd_barrier_post(unsigned* bar, volatile LAS unsigned* st) {
    XcdBarrier b; b.bar = bar; b.x = xb_xcc_id(); b.st = st;
    if (threadIdx.x == 0) (void)xb_add(&bar[XB_XCNT(b.x)], 1u);
    return b;
}
__device__ __forceinline__ void xcd_barrier_complete(unsigned* bar, unsigned x, unsigned& nloc, unsigned& nx) {
    const unsigned G = gridDim.x * gridDim.y * gridDim.z;
    unsigned sum, cnt, mine, sp = 0u;
    for (;;) {
        sum = 0u; cnt = 0u; mine = 0u;
#pragma unroll
        for (unsigned j = 0; j < 16; ++j) { const unsigned c = xb_ld(&bar[XB_XCNT(j)]); sum += c; cnt += (c > 0u) ? 1u : 0u; mine = (j == x) ? c : mine; }
        if (sum == G) break;
        __builtin_amdgcn_s_sleep(1);
        if ((++sp & 255u) == 0u) { if (xb_ld(&bar[XB_TMO])) break; if (sp > XB_SPIN_CAP) { atomicAdd(&bar[XB_TMO], 1u); break; } }
    }
    nloc = mine > 0u ? mine : 1u; nx = cnt > 0u ? cnt : 1u;
}
__device__ __forceinline__ void xcd_barrier(const XcdBarrier& b) {
    asm volatile("s_waitcnt vmcnt(0)" ::: "memory");
    __syncthreads();
    if (threadIdx.x == 0) {
        unsigned* bar = b.bar;
        __builtin_amdgcn_s_waitcnt(0);
        unsigned nloc = b.st[0], nx = b.st[1];
        if (nloc == 0u) { xcd_barrier_complete(bar, b.x, nloc, nx); b.st[0] = nloc; b.st[1] = nx; }
        const unsigned old = xb_add(&bar[XB_XSUB(b.x)], 1u);
        const unsigned gen = old / nloc;
        if (old + 1u == (gen + 1u) * nloc) {
            __builtin_amdgcn_fence(__ATOMIC_RELEASE, "agent");
            asm volatile("s_waitcnt vmcnt(0)" ::: "memory");
            const unsigned og = xb_add(&bar[XB_TOP], 1u);
            const unsigned tg = og / nx;
            if (og + 1u == (tg + 1u) * nx) xb_add(&bar[XB_TOPGEN], 1u);
            else XB_SPIN(xb_ld(&bar[XB_TOPGEN]) == tg, bar);
            __builtin_amdgcn_fence(__ATOMIC_ACQUIRE, "agent");
            xb_add(&bar[XB_XGEN(b.x)], 1u);
            asm volatile("s_waitcnt vmcnt(0)" ::: "memory");
        } else {
            XB_SPIN(xb_ld(&bar[XB_XGEN(b.x)]) == gen, bar);
            __builtin_amdgcn_fence(__ATOMIC_ACQUIRE, "agent");
            asm volatile("s_waitcnt vmcnt(0)" ::: "memory");
        }
    }
    __syncthreads();
}

constexpr int MX_RL = LB * RH * 2 * 4, MX_ML = LB * MH * 2 * ml::NVB, MX_RC = CB * RH * 2 * 4, MX_MC = CB * MH * 2 * ml::NVB;
constexpr int MX_ITEMS = MX_RL + MX_ML + MX_RC + MX_MC;

__device__ __forceinline__ void scan_phase(LAS unsigned char* lds, CParams& P, int l, unsigned* qhead) {
    volatile LAS unsigned* bc = (volatile LAS unsigned*)(lds + LDS_MISC) + 16;
    for (;;) {
        if (threadIdx.x == 0) bc[0] = xb_add(qhead, 1u);
        __syncthreads();
        const int it = (int)bc[0];
        __syncthreads();
        if (it >= LB * RH * 2) break;
        int s_, head, dir; wy::decode_item(it, s_, head, dir);
        wy::rwkv_item(lds, P, l, s_, head, dir);
    }
    for (;;) {
        if (threadIdx.x == 0) bc[0] = xb_add(qhead + 16, 1u);
        __syncthreads();
        const int it = (int)bc[0];
        __syncthreads();
        if (it >= ml::N_ITEMS) break;
        int s_, head, dir, sub; ml::decode_item(it, s_, head, dir, sub);
        ml::mlstm_item(lds, P, l, s_, head, dir, sub);
    }
    for (;;) {
        if (threadIdx.x == 0) bc[0] = xb_add(qhead + 32, 1u);
        __syncthreads();
        const int it = (int)bc[0] + LB * RH * 2;
        __syncthreads();
        if (it >= wy::N_ITEMS) break;
        int s_, head, dir; wy::decode_item(it, s_, head, dir);
        wy::rwkv_item(lds, P, l, s_, head, dir);
    }
}

enum { ST_N0 = 0, ST_A1, ST_CV, ST_MX, ST_PO, ST_N1, ST_A2, ST_PJ, ST_WO, ST_N2, ST_F1, ST_F2, ST_PER_LAYER };
constexpr int N_STEPS = 1 + DEPTH * ST_PER_LAYER + 1;
struct MkArgs { Params P; int ph_lo, ph_hi; };
__global__ void __launch_bounds__(512, 2) mk(MkArgs a) {
    extern __shared__ __attribute__((aligned(16))) unsigned char lds_raw[];
    LAS unsigned char* lds = (LAS unsigned char*)lds_raw;
    const int G = gridDim.x, vb = (int)blockIdx.x;
    unsigned* ctl = (unsigned*)(a.P.ws + WS_CTL);
    volatile LAS unsigned* MISC = (volatile LAS unsigned*)(lds + LDS_MISC);
    for (int u = threadIdx.x; u < 64; u += 512) MISC[u] = 0u;
    __syncthreads();
    const bool multi = a.ph_hi - a.ph_lo > 1;
    XcdBarrier bar; bar.bar = ctl + CW_BAR; bar.x = 0; bar.st = nullptr;
    if (multi) bar = xcd_barrier_post(ctl + CW_BAR, MISC + 8);
    const int lo = a.ph_lo, hi = a.ph_hi;
#define STEP_BEGIN(id) if (lo <= (id) && (id) < hi) { unsigned long long kp_ = (unsigned long long)__builtin_amdgcn_kernarg_segment_ptr(); asm volatile("" : "+s"(kp_)); CParams& P = *(CParams*)kp_;
#define STEP_END(id) if ((id) + 1 < hi) xcd_barrier(bar); }
    STEP_BEGIN(0) el::init_phase(lds, P, vb, G); el::wconv_phase(lds, P, 0, vb, G); STEP_END(0)
#define LAYER(l) { \
        const int base = 1 + (l) * ST_PER_LAYER; \
        STEP_BEGIN(base + ST_N0) if ((l) > 0) el::wconv_phase(lds, P, (l), vb, G); el::norm_phase(P, (l), 0, vb, G); STEP_END(base + ST_N0) \
        STEP_BEGIN(base + ST_A1) { pg8::Gemm g{WSP(bf16, WS_QKC), WSP(bf16, O_WIN1), D, D}; pg8::StaticOrder S; S.init(NT, N1P, G, vb); \
            pg8::EpiA1 E{WSP(bf16, WS_U1)}; pg8::gemm_phase(lds, g, S, E); } STEP_END(base + ST_A1) \
        STEP_BEGIN(base + ST_CV) el::conv_phase(P, (l), vb, G); STEP_END(base + ST_CV) \
        STEP_BEGIN(base + ST_MX) scan_phase(lds, P, (l), ctl + CW_Q + 64 * (l)); STEP_END(base + ST_MX) \
        STEP_BEGIN(base + ST_PO) el::post_phase(lds, P, (l), vb, G); STEP_END(base + ST_PO) \
        STEP_BEGIN(base + ST_N1) el::norm_phase(P, (l), 1, vb, G); STEP_END(base + ST_N1) \
        STEP_BEGIN(base + ST_A2) { pg8::Gemm g{WSP(bf16, WS_RXC), WSP(bf16, O_WIN2), D, D}; pg8::StaticOrder S; S.init(NT, 2 * D, G, vb); \
            pg8::EpiA2 E{WSP(bf16, WS_U1)}; pg8::gemm_phase(lds, g, S, E); } STEP_END(base + ST_A2) \
        STEP_BEGIN(base + ST_PJ) { pg8::Gemm g{WSP(bf16, WS_QKC), WSP(bf16, O_PM), MW, D}; pg8::PairOrder S; S.init(NT, G, vb); \
            pg8::EpiPJ E{WSP(bf16, WS_U1)}; pg8::gemm_phase(lds, g, S, E); } STEP_END(base + ST_PJ) \
        STEP_BEGIN(base + ST_WO) { pg8::Gemm g{WSP(bf16, WS_U1), WSP(bf16, O_WO), D, PU}; pg8::StaticOrder S; S.init(NT, D, G, vb); \
            pg8::EpiRes E{P.out, WSP(float, WS_MOD) + (size_t)(l) * NCOND * 6 * D + 2 * D}; pg8::gemm_phase(lds, g, S, E); } STEP_END(base + ST_WO) \
        STEP_BEGIN(base + ST_N2) el::norm_phase(P, (l), 2, vb, G); STEP_END(base + ST_N2) \
        STEP_BEGIN(base + ST_F1) { pg8::Gemm g{WSP(bf16, WS_QKC), WSP(bf16, O_W13), D, D}; pg8::StaticOrder S; S.init(NT, 2 * FF, G, vb); \
            pg8::EpiF1 E{WSP(bf16, WS_U1)}; pg8::gemm_phase(lds, g, S, E); } STEP_END(base + ST_F1) \
        STEP_BEGIN(base + ST_F2) { pg8::Gemm g{WSP(bf16, WS_U1), WSP(bf16, O_W2), FF, FF}; pg8::StaticOrder S; S.init(NT, D, G, vb); \
            pg8::EpiRes E{P.out, WSP(float, WS_MOD) + (size_t)(l) * NCOND * 6 * D + 5 * D}; pg8::gemm_phase(lds, g, S, E); } STEP_END(base + ST_F2) \
    }
    static_assert(DEPTH == 2, "layers are unrolled by hand");
    LAYER(0)
    LAYER(1)
#undef LAYER
    STEP_BEGIN(N_STEPS - 1) el::norm_phase(P, 0, 3, vb, G); STEP_END(N_STEPS - 1)
#undef STEP_BEGIN
#undef STEP_END
}
#endif

typedef void (*BodyFn)(const Params&, long);
#ifndef HOST_EMU
template <BodyFn F, int BLOCK> __global__ void __launch_bounds__(BLOCK) run_k(Params P, long n) {
    const long i = (long)blockIdx.x * BLOCK + threadIdx.x;
    if (i < n) F(P, i);
}
#define RUN(F, BLOCK, n) do { const long n_ = (n); run_k<F, BLOCK><<<dim3((unsigned)((n_ + BLOCK - 1) / BLOCK)), dim3(BLOCK), 0, stream>>>(P, n_); } while (0)
static int g_grid = 0;
#else
#define RUN(F, BLOCK, n) do { const long n_ = (n); for (long i_ = 0; i_ < n_; ++i_) F(P, i_); } while (0)
typedef void* hipStream_t;
#endif

static void forward(Params P, hipStream_t stream) {
    (void)stream;
#ifndef HOST_EMU
    if (hipMemsetAsync(P.ws + WS_CTL, 0, CTL_ZERO_BYTES, stream) != hipSuccess) return;
#ifdef MK_PER_STEP
    for (int st = 0; st < N_STEPS; ++st) { MkArgs a_{}; a_.P = P; a_.ph_lo = st; a_.ph_hi = st + 1; mk<<<dim3(g_grid), dim3(512), LDS_BYTES, stream>>>(a_); }
#else
    { MkArgs a_{}; a_.P = P; a_.ph_lo = 0; a_.ph_hi = N_STEPS; mk<<<dim3(g_grid), dim3(512), LDS_BYTES, stream>>>(a_); }
#endif
#else
    RUN(k_init_x, 256, (long)NT * D);
    RUN(k_mod, 256, (long)DEPTH * NCOND * 6 * D);
    for (int l = 0; l < DEPTH; ++l) {
        P.layer = l;
        RUN(k_wconv, 256, WC_N6);
        P.mode = 0; RUN(k_norm, 64, (long)NT);
        RUN(k_gemm_a1, 256, (long)NT * N1);
        RUN(k_conv, 256, (long)NT * (2 * MW + RIN));
        RUN(k_mlstm, 128, (long)NSEQ * MH * 2 * 128);
        for (int dir = 0; dir < 2; ++dir) { P.mode = dir; RUN(k_rwkv_prep, 256, (long)NT * RW); RUN(k_rwkv, 64, (long)NSEQ * RH * 64); }
        RUN(k_post, 256, (long)NT * D);
        P.mode = 1; RUN(k_norm, 64, (long)NT);
        RUN(k_gemm_a2, 256, (long)NT * 2 * D);
        RUN(k_gemm_pj, 256, (long)NT * D);
        RUN(k_gemm_wo, 256, (long)NT * D);
        P.mode = 2; RUN(k_norm, 64, (long)NT);
        RUN(k_gemm_f1, 256, (long)NT * FF);
        RUN(k_gemm_f2, 256, (long)NT * D);
    }
    RUN(k_final, 64, (long)NT);
#endif
}

#ifndef HOST_EMU
extern "C" void kernel_launch(void* const* d_in, const int* in_sizes, int n_in, void* d_out, int out_size, void* d_ws, size_t ws_size, hipStream_t stream) {
    if (n_in != N_IN || (size_t)out_size != OUT_END || ws_size < WS_END) return;
    if (g_grid == 0) {
        int dev = 0, cus = 0;
        if (hipGetDevice(&dev) != hipSuccess || hipDeviceGetAttribute(&cus, hipDeviceAttributeMultiprocessorCount, dev) != hipSuccess) { g_grid = -1; return; }
        if (hipFuncSetAttribute((const void*)mk, hipFuncAttributeMaxDynamicSharedMemorySize, LDS_BYTES) != hipSuccess) { g_grid = -1; return; }
        g_grid = cus;
    }
    if (g_grid < 0) return;
    Params P{};
    for (int i = 0; i < N_IN; ++i) P.in[i] = (const float*)d_in[i];
    P.out = (float*)d_out; P.ws = (unsigned char*)d_ws; P.layer = 0; P.mode = 0;
    forward(P, stream);
}
#endif
```

```cpp
#ifndef HOST_EMU
#include <hip/hip_runtime.h>
#define HD __host__ __device__ __forceinline__
#define DEV __device__ __forceinline__
#else
#include <cmath>
#include <cstring>
#include <cstdio>
#include <cstdlib>
#define HD inline
#define DEV inline
#endif
#include <cstddef>

#ifdef SMALL_CFG
constexpr int D = 256, CB = 2, CT = 128, DEPTH = 2, LB = 1, LT = 256, GW = 16;
#else
constexpr int D = 1024, CB = 32, CT = 256, DEPTH = 2, LB = 2, LT = 4096, GW = 64;
#endif
constexpr int MW = D / 2, MD = 128, MH = MW / MD, RW = D / 2, RD = 64, RH = RW / RD;
constexpr int RIN = 3 * RW + 384, FF = ((8 * D + 767) / 768) * 256, PIN = 2 * MW + MW + MW + 4 * MH + RIN + 2 * D;
constexpr int NC = CB * CT, NL = LB * LT, NT = NC + NL, NSEQ = CB + LB, NCOND = 1 + LB;
constexpr int N1 = PIN - 2 * D;
constexpr int N1P = ((N1 + 255) / 256) * 256;
constexpr int PU = N1;
constexpr int OFF_QK = 0, OFF_V = 2 * MW, OFF_O = 3 * MW, OFF_G = 4 * MW, OFF_R = 4 * MW + 4 * MH;
constexpr int RX_R = 0, RX_K = RW, RX_V = 2 * RW, RX_WL = 3 * RW, RX_AL = 3 * RW + 128, RX_GL = 3 * RW + 256;
constexpr float RMS_EPS = 1e-6f, GN_EPS = 64e-5f;
static_assert(3 * D <= N1, "G + merged must fit the dead columns of U1");

enum { X_PROMPT = 0, X_SAMPLE, ST_C, ST_N, ST_M, ST_R, C_LAT, C_CTX, ADA_W, ADA_B, NORM1, NORM2, W_IN, M_CONV, M_GATE_B, M_NORM_G,
       R_CONV, R_W0, R_W2, R_A0, R_A2, R_G2, R_KK, R_KA, R_RK, R_GN_W, R_GN_B, PROJ_M, PROJ_R, W_OUT, FFN_W1, FFN_W3, FFN_W2, FINAL_G, N_IN };

constexpr size_t OUT_X = 0;
constexpr size_t OUT_C = (size_t)NT * D;
constexpr size_t OUT_N = OUT_C + (size_t)CB * DEPTH * 2 * MH * 128 * 128;
constexpr size_t OUT_M = OUT_N + (size_t)CB * DEPTH * 2 * MH * 128;
constexpr size_t OUT_S = OUT_M + (size_t)CB * DEPTH * 2 * MH;
constexpr size_t OUT_END = OUT_S + (size_t)CB * DEPTH * 2 * RH * 64 * 64;

constexpr size_t al256(size_t x) { return (x + 255) & ~(size_t)255; }
constexpr size_t cmax(size_t a, size_t b) { return a > b ? a : b; }
constexpr size_t WS_CTL = 0;
constexpr size_t WS_MOD = (size_t)1 << 20;
constexpr size_t WS_WREG = (size_t)2 << 20;
constexpr size_t O_WIN1 = WS_WREG;
constexpr size_t O_WIN2 = O_WIN1 + (size_t)N1P * D * 2;
constexpr size_t O_PM = O_WIN2 + (size_t)2 * D * D * 2;
constexpr size_t O_PR = O_PM + (size_t)D * MW * 2;
constexpr size_t O_WO = O_PR + (size_t)D * RW * 2;
constexpr size_t O_W13 = O_WO + (size_t)D * D * 2;
constexpr size_t O_W2 = O_W13 + (size_t)2 * FF * D * 2;
constexpr size_t O_G2T = O_W2 + (size_t)D * FF * 2;
constexpr size_t O_W2T = O_G2T + (size_t)RW * 128 * 2;
constexpr size_t O_A2T = O_W2T + (size_t)2 * RW * 64 * 2;
constexpr size_t WS_U1 = al256(O_A2T + (size_t)2 * RW * 64 * 2);
constexpr size_t SZ_U1 = al256(cmax((size_t)NT * PU * 2, (size_t)NT * FF * 2));
constexpr size_t WS_QKC = WS_U1 + SZ_U1;
constexpr size_t WS_RXC = WS_QKC + (size_t)NT * D * 2;
constexpr size_t WS_END = WS_RXC + al256(cmax((size_t)NT * RIN * 2, (size_t)NT * D * 2));
#ifndef SMALL_CFG
static_assert(WS_END <= ((size_t)256 << 20), "workspace map must fit 256 MiB");
#endif

typedef unsigned short bf16;
HD float bf2f(bf16 b) { unsigned u = ((unsigned)b) << 16; return __builtin_bit_cast(float, u); }
#if defined(__HIP_DEVICE_COMPILE__)
HD bf16 f2bf(float f) { return __builtin_bit_cast(bf16, (__bf16)f); }
#else
HD bf16 f2bf(float f) { unsigned u = __builtin_bit_cast(unsigned, f); u += 0x7fffu + ((u >> 16) & 1u); return (bf16)(u >> 16); }
#endif
HD float sigmoidf_(float x) { return 1.0f / (1.0f + expf(-x)); }
HD float siluf_(float x) { return x / (1.0f + expf(-x)); }
HD float softplusf_(float x) { return fmaxf(x, 0.f) + log1pf(expf(-fabsf(x))); }
HD float logsigmoidf_(float x) { return -softplusf_(-x); }
HD int prow(int c) { return (c & ~31) | (((c >> 2) & 1) << 4) | (((c >> 3) & 3) << 2) | (c & 3); }

struct Params {
    const float* in[N_IN];
    float* out;
    unsigned char* ws;
    int layer;
    int mode;
};

struct SeqInfo { int T; int base; int grid; int cond; int b; };
HD SeqInfo seqinfo(int s) {
    SeqInfo q;
    if (s < CB) { q.T = CT; q.base = s * CT; q.grid = 0; q.cond = 0; q.b = s; }
    else { q.T = LT; q.base = NC + (s - CB) * LT; q.grid = 1; q.cond = 1 + (s - CB); q.b = s - CB; }
    return q;
}
HD int seq_of_token(int m) { return m < NC ? m / CT : CB + (m - NC) / LT; }

#define WSP(T, off) ((T*)(P.ws + (off)))

DEV void k_init_x(const Params& P, long i) {
    const size_t ncd = (size_t)NC * D;
    P.out[i] = (size_t)i < ncd ? P.in[X_PROMPT][i] : P.in[X_SAMPLE][i - ncd];
}
DEV void k_mod(const Params& P, long i) {
    const int j = (int)(i % (6 * D)); const int ci = (int)((i / (6 * D)) % NCOND); const int l = (int)(i / ((long)6 * D * NCOND));
    const float* cv = ci == 0 ? P.in[C_CTX] : P.in[C_LAT] + (size_t)(ci - 1) * D;
    const float* w = P.in[ADA_W] + (size_t)l * D * 6 * D;
    float acc = P.in[ADA_B][(size_t)l * 6 * D + j];
    for (int k = 0; k < D; ++k) acc += siluf_(cv[k]) * w[(size_t)k * 6 * D + j];
    WSP(float, WS_MOD)[i] = acc;
}
constexpr long WC_N0 = (long)N1P * D, WC_N1 = WC_N0 + (long)2 * D * D, WC_N2 = WC_N1 + (long)D * MW, WC_N3 = WC_N2 + (long)D * RW,
               WC_N4 = WC_N3 + (long)D * D, WC_N5 = WC_N4 + (long)2 * FF * D, WC_N6 = WC_N5 + (long)D * FF;
HD int unprow(int r) { return (r & ~31) | (((r >> 2) & 3) << 3) | (((r >> 4) & 1) << 2) | (r & 3); }
DEV void k_wconv(const Params& P, long i) {
    const int l = P.layer;
    if (i < WC_N0) { const int r = (int)(i / D), k = (int)(i % D); const int c = unprow(r);
        WSP(bf16, O_WIN1)[i] = c < N1 ? f2bf(P.in[W_IN][((size_t)l * D + k) * PIN + c]) : (bf16)0; return; }
    if (i < WC_N1) { const long j = i - WC_N0; const int r = (int)(j / D), k = (int)(j % D); const int c = unprow(r);
        WSP(bf16, O_WIN2)[j] = f2bf(P.in[W_IN][((size_t)l * D + k) * PIN + N1 + c]); return; }
    if (i < WC_N2) { const long j = i - WC_N1; const int r = (int)(j / MW), k = (int)(j % MW); const int c = unprow(r);
        WSP(bf16, O_PM)[j] = f2bf(P.in[PROJ_M][((size_t)l * MW + k) * D + c]); return; }
    if (i < WC_N3) { const long j = i - WC_N2; const int r = (int)(j / RW), k = (int)(j % RW); const int c = unprow(r);
        WSP(bf16, O_PR)[j] = f2bf(P.in[PROJ_R][((size_t)l * RW + k) * D + c]); return; }
    if (i < WC_N4) { const long j = i - WC_N3; const int r = (int)(j / D), k = (int)(j % D);
        WSP(bf16, O_WO)[j] = f2bf(P.in[W_OUT][((size_t)l * D + k) * D + r]); return; }
    if (i < WC_N5) { const long j = i - WC_N4; const int r = (int)(j / D), k = (int)(j % D);
        const int pn = r >> 8, rl = r & 255, which = rl >> 7, rho = rl & 127; const int jj = pn * 128 + unprow(rho);
        const float* W = which ? P.in[FFN_W3] : P.in[FFN_W1];
        WSP(bf16, O_W13)[j] = f2bf(W[((size_t)l * D + k) * FF + jj]); return; }
    { const long j = i - WC_N5; const int r = (int)(j / FF), k = (int)(j % FF);
        WSP(bf16, O_W2)[j] = f2bf(P.in[FFN_W2][((size_t)l * FF + k) * D + r]); }
}
DEV void k_norm(const Params& P, long m) {
    const int l = P.layer; const int second = (P.mode == 2);
    const float* x = P.out + (size_t)m * D;
    const float* g = P.in[second ? NORM2 : NORM1] + (size_t)l * D;
    const int cond = seqinfo(seq_of_token((int)m)).cond;
    const float* mod = WSP(float, WS_MOD) + ((size_t)l * NCOND + cond) * 6 * D + (second ? 3 * D : 0);
    float ss = 0.f;
    for (int k = 0; k < D; ++k) ss += x[k] * x[k];
    const float rs = 1.0f / sqrtf(ss / D + RMS_EPS);
    bf16* o = WSP(bf16, P.mode == 1 ? WS_RXC : WS_QKC) + (size_t)m * D;
    for (int k = 0; k < D; ++k) o[k] = f2bf(x[k] * rs * g[k] * (1.0f + mod[D + k]) + mod[k]);
}
DEV float dot_bf(const bf16* a, const bf16* b, int K) { float s = 0.f; for (int k = 0; k < K; ++k) s += bf2f(a[k]) * bf2f(b[k]); return s; }
DEV void k_gemm_a1(const Params& P, long i) {
    const int n = (int)(i % N1); const long m = i / N1;
    WSP(bf16, WS_U1)[(size_t)m * PU + n] = f2bf(dot_bf(WSP(bf16, WS_QKC) + (size_t)m * D, WSP(bf16, O_WIN1) + (size_t)prow(n) * D, D));
}
DEV void k_gemm_a2(const Params& P, long i) {
    const int n = (int)(i % (2 * D)); const long m = i / (2 * D);
    WSP(bf16, WS_U1)[(size_t)m * PU + D + n] = f2bf(sigmoidf_(dot_bf(WSP(bf16, WS_RXC) + (size_t)m * D, WSP(bf16, O_WIN2) + (size_t)prow(n) * D, D)));
}
DEV void k_gemm_pj(const Params& P, long i) {
    const int n = (int)(i % D); const long m = i / D;
    const bf16* hmr = WSP(bf16, WS_QKC) + (size_t)m * D; bf16* u = WSP(bf16, WS_U1) + (size_t)m * PU;
    const float a = dot_bf(hmr, WSP(bf16, O_PM) + (size_t)prow(n) * MW, MW), b = dot_bf(hmr + MW, WSP(bf16, O_PR) + (size_t)prow(n) * RW, RW);
    const float first = bf2f(f2bf(bf2f(u[D + n]) * a));
    u[n] = f2bf(first + bf2f(u[2 * D + n]) * b);
}
DEV void k_gemm_wo(const Params& P, long i) {
    const int n = (int)(i % D); const long m = i / D; const int l = P.layer;
    const int cond = seqinfo(seq_of_token((int)m)).cond;
    const float g1 = WSP(float, WS_MOD)[((size_t)l * NCOND + cond) * 6 * D + 2 * D + n];
    P.out[(size_t)m * D + n] += g1 * dot_bf(WSP(bf16, WS_U1) + (size_t)m * PU, WSP(bf16, O_WO) + (size_t)n * D, D);
}
DEV void k_gemm_f1(const Params& P, long i) {
    const int j = (int)(i % FF); const long m = i / FF;
    const int pn = j >> 7, rho = prow(j & 127);
    const bf16* h = WSP(bf16, WS_QKC) + (size_t)m * D;
    const float a = dot_bf(h, WSP(bf16, O_W13) + (size_t)(pn * 256 + rho) * D, D), b = dot_bf(h, WSP(bf16, O_W13) + (size_t)(pn * 256 + 128 + rho) * D, D);
    WSP(bf16, WS_U1)[(size_t)m * FF + j] = f2bf(siluf_(a) * b);
}
DEV void k_gemm_f2(const Params& P, long i) {
    const int n = (int)(i % D); const long m = i / D; const int l = P.layer;
    const int cond = seqinfo(seq_of_token((int)m)).cond;
    const float g2 = WSP(float, WS_MOD)[((size_t)l * NCOND + cond) * 6 * D + 5 * D + n];
    P.out[(size_t)m * D + n] += g2 * dot_bf(WSP(bf16, WS_U1) + (size_t)m * FF, WSP(bf16, O_W2) + (size_t)n * FF, FF);
}
DEV void k_conv(const Params& P, long i) {
    constexpr int NCH = 2 * MW + RIN;
    const int ch = (int)(i % NCH); const int m = (int)(i / NCH); const int l = P.layer;
    const int s = seq_of_token(m); const SeqInfo q = seqinfo(s); const int t = m - q.base;
    const bool isqk = ch < 2 * MW; const int c = isqk ? ch : ch - 2 * MW;
    const int ucol = isqk ? OFF_QK + c : OFF_R + c;
    const int CH = isqk ? 2 * MW : RIN;
    const float* w = (isqk ? P.in[M_CONV] : P.in[R_CONV]) + (size_t)l * 9 * CH;
    const bf16* U = WSP(bf16, WS_U1);
    float acc = 0.f;
    if (q.grid) {
        const int r = t / GW, cc = t % GW, rows = q.T / GW;
        for (int a = 0; a < 3; ++a) for (int b = 0; b < 3; ++b) {
            const int rr = r + a - 1, c2 = cc + b - 1;
            if (rr >= 0 && rr < rows && c2 >= 0 && c2 < GW) acc += w[(a * 3 + b) * CH + c] * bf2f(U[(size_t)(q.base + rr * GW + c2) * PU + ucol]);
        }
    } else {
        for (int b = 0; b < 3; ++b) { const int t2 = t + b - 1; if (t2 >= 0 && t2 < q.T) acc += w[(3 + b) * CH + c] * bf2f(U[(size_t)(q.base + t2) * PU + ucol]); }
    }
    if (isqk) { float v = siluf_(acc); if (c < MW) v *= 0.08838834764831845f; WSP(bf16, WS_QKC)[(size_t)m * (2 * MW) + c] = f2bf(v); }
    else { float v = acc; if (c >= RX_WL && c < RX_AL) v = tanhf(v); else if (c >= RX_GL) v = sigmoidf_(v); WSP(bf16, WS_RXC)[(size_t)m * RIN + c] = f2bf(v); }
}
DEV void k_mlstm(const Params& P, long i) {
    const int e = (int)(i % 128); const int chain = (int)(i / 128); const int dir = chain & 1, head = (chain >> 1) % MH, s = chain / (2 * MH);
    const int l = P.layer; const SeqInfo q = seqinfo(s);
    float C[128], n[128]; float m;
    if (!q.grid) {
#pragma unroll
        for (int d = 0; d < 128; ++d) { C[d] = 0.f; n[d] = 0.f; }
        m = 0.f;
    } else {
        const size_t sb = (((size_t)q.b * DEPTH + l) * 2 + dir) * MH + head;
#pragma unroll
        for (int d = 0; d < 128; ++d) { C[d] = P.in[ST_C][(sb * 128 + d) * 128 + e]; n[d] = P.in[ST_N][sb * 128 + d]; }
        m = P.in[ST_M][sb];
    }
    const float bi = P.in[M_GATE_B][(size_t)l * 4 * MH + (2 * dir) * MH + head], bfg = P.in[M_GATE_B][(size_t)l * 4 * MH + (2 * dir + 1) * MH + head];
    bf16* U = WSP(bf16, WS_U1); const bf16* QK = WSP(bf16, WS_QKC);
    float nsel = 0.f;
    for (int p = 0; p < q.T; ++p) {
        const int t = dir ? q.T - 1 - p : p; const size_t tok = (size_t)(q.base + t);
        const bf16* qk = QK + tok * (2 * MW); bf16* u = U + tok * PU;
        const float gi = bf2f(u[OFF_G + (2 * dir) * MH + head]) + bi, gf = bf2f(u[OFF_G + (2 * dir + 1) * MH + head]) + bfg;
        const float lf = logsigmoidf_(gf);
        const float mn = fmaxf(lf + m, gi); const float fw = expf(lf + m - mn), iw = expf(gi - mn);
        const float v = bf2f(u[OFF_V + head * 128 + e]);
        float num = 0.f, den = 0.f;
#pragma unroll
        for (int d = 0; d < 128; ++d) {
            const float kd = bf2f(qk[MW + head * 128 + d]), qd = bf2f(qk[head * 128 + d]);
            C[d] = fw * C[d] + iw * kd * v; n[d] = fw * n[d] + iw * kd; num += qd * C[d]; den += qd * n[d];
        }
        m = mn;
        u[dir * MW + head * 128 + e] = f2bf(num / fmaxf(fabsf(den), expf(-m)));
    }
    if (!q.grid) {
        const size_t sb = (((size_t)q.b * DEPTH + l) * 2 + dir) * MH + head;
#pragma unroll
        for (int d = 0; d < 128; ++d) { P.out[OUT_C + (sb * 128 + d) * 128 + e] = C[d]; if (d == e) nsel = n[d]; }
        P.out[OUT_N + sb * 128 + e] = nsel;
        if (e == 0) P.out[OUT_M + sb] = m;
    }
}
DEV void k_rwkv_prep(const Params& P, long i) {
    const int c = (int)(i % RW); const size_t tok = (size_t)(i / RW); const int l = P.layer, dir = P.mode;
    const bf16* rx = WSP(bf16, WS_RXC) + tok * RIN;
    const float* w2 = P.in[R_W2] + ((size_t)l * 2 + dir) * 64 * RW + c; const float* a2 = P.in[R_A2] + ((size_t)l * 2 + dir) * 64 * RW + c;
    float wr = P.in[R_W0][((size_t)l * 2 + dir) * RW + c], ar = P.in[R_A0][((size_t)l * 2 + dir) * RW + c];
    for (int j = 0; j < 64; ++j) { wr += bf2f(rx[RX_WL + dir * 64 + j]) * w2[(size_t)j * RW]; ar += bf2f(rx[RX_AL + dir * 64 + j]) * a2[(size_t)j * RW]; }
    bf16* o = WSP(bf16, WS_QKC) + tok * (2 * RW);
    o[c] = f2bf(wr); o[RW + c] = f2bf(ar);
}
DEV void k_rwkv(const Params& P, long i) {
    const int row = (int)(i % 64); const int chain = (int)(i / 64); const int dir = P.mode, head = chain % RH, s = chain / RH;
    const int l = P.layer; const SeqInfo q = seqinfo(s); const int hc = head * 64;
    float S[64];
    if (!q.grid) {
#pragma unroll
        for (int c = 0; c < 64; ++c) S[c] = 0.f;
    } else {
        const size_t sb = (((size_t)q.b * DEPTH + l) * 2 + dir) * RH + head;
#pragma unroll
        for (int c = 0; c < 64; ++c) S[c] = P.in[ST_R][(sb * 64 + row) * 64 + c];
    }
    const float* rkk = P.in[R_KK] + (size_t)l * RW + hc; const float* rka = P.in[R_KA] + (size_t)l * RW + hc;
    bf16* U = WSP(bf16, WS_U1); const bf16* RX = WSP(bf16, WS_RXC); const bf16* WA = WSP(bf16, WS_QKC);
    for (int p = 0; p < q.T; ++p) {
        const int t = dir ? q.T - 1 - p : p; const size_t tok = (size_t)(q.base + t);
        const bf16* rx = RX + tok * RIN; const bf16* wa = WA + tok * (2 * RW);
        float ss = 0.f;
        for (int c = 0; c < 64; ++c) { const float kc = bf2f(rx[RX_K + hc + c]) * rkk[c]; ss += kc * kc; }
        const float inv = 1.0f / fmaxf(sqrtf(ss), 1e-12f);
        float sa = 0.f;
#pragma unroll
        for (int c = 0; c < 64; ++c) sa -= S[c] * (bf2f(rx[RX_K + hc + c]) * rkk[c] * inv);
        const float v = bf2f(rx[RX_V + hc + row]);
        float y = 0.f;
#pragma unroll
        for (int c = 0; c < 64; ++c) {
            const float wr = bf2f(wa[hc + c]), ar = bf2f(wa[RW + hc + c]);
            const float decay = expf(-0.6065306597126334f * sigmoidf_(wr));
            const float alpha = sigmoidf_(ar);
            const float kr = bf2f(rx[RX_K + hc + c]);
            const float kt = kr * (1.0f + (alpha - 1.0f) * rka[c]);
            const float bb = kr * rkk[c] * inv * alpha;
            S[c] = S[c] * decay + sa * bb + v * kt;
            y += S[c] * bf2f(rx[RX_R + hc + c]);
        }
        U[tok * PU + OFF_R + dir * RW + hc + row] = f2bf(y);
    }
    if (!q.grid) {
        const size_t sb = (((size_t)q.b * DEPTH + l) * 2 + dir) * RH + head;
#pragma unroll
        for (int c = 0; c < 64; ++c) P.out[OUT_S + (sb * 64 + row) * 64 + c] = S[c];
    }
}
DEV void k_post(const Params& P, long i) {
    const int ch = (int)(i % D); const size_t m = (size_t)(i / D); const int l = P.layer;
    const bf16* u = WSP(bf16, WS_U1) + m * PU; const bf16* rx = WSP(bf16, WS_RXC) + m * RIN;
    bf16* o = WSP(bf16, WS_QKC) + m * D;
    if (ch < MW) {
        const int h0 = (ch / 128) * 128; float ss = 0.f;
        for (int d = 0; d < 128; ++d) { const float x = bf2f(u[h0 + d]) + bf2f(u[MW + h0 + d]); ss += x * x; }
        const float x = bf2f(u[ch]) + bf2f(u[MW + ch]);
        o[ch] = f2bf(x / sqrtf(ss / 128.f + RMS_EPS) * P.in[M_NORM_G][(size_t)l * MW + ch] * sigmoidf_(bf2f(u[OFF_O + ch])));
    } else {
        const int c = ch - MW; const int h0 = (c / 64) * 64;
        float mu = 0.f, bsum = 0.f;
        for (int d = 0; d < 64; ++d) { mu += bf2f(u[OFF_R + h0 + d]) + bf2f(u[OFF_R + RW + h0 + d]);
            bsum += bf2f(rx[RX_R + h0 + d]) * bf2f(rx[RX_K + h0 + d]) * P.in[R_RK][(size_t)l * RW + h0 + d]; }
        mu *= (1.0f / 64.f); float var = 0.f;
        for (int d = 0; d < 64; ++d) { const float x = bf2f(u[OFF_R + h0 + d]) + bf2f(u[OFF_R + RW + h0 + d]) - mu; var += x * x; }
        var *= (1.0f / 64.f);
        const float y = bf2f(u[OFF_R + c]) + bf2f(u[OFF_R + RW + c]);
        const float yn = (y - mu) / sqrtf(var + GN_EPS) * P.in[R_GN_W][(size_t)l * RW + c] + P.in[R_GN_B][(size_t)l * RW + c];
        float gate = 0.f;
        for (int j = 0; j < 128; ++j) gate += bf2f(rx[RX_GL + j]) * P.in[R_G2][((size_t)l * 128 + j) * RW + c];
        o[ch] = f2bf((yn + bsum * bf2f(rx[RX_V + c])) * gate);
    }
}
DEV void k_final(const Params& P, long m) {
    float* x = P.out + (size_t)m * D; float ss = 0.f;
    for (int k = 0; k < D; ++k) ss += x[k] * x[k];
    const float rs = 1.0f / sqrtf(ss / D + RMS_EPS);
    for (int k = 0; k < D; ++k) x[k] = x[k] * rs * P.in[FINAL_G][k];
}


#ifndef HOST_EMU
typedef const __attribute__((address_space(4))) Params CParams;
namespace pg8 {
#define PG8_LAS __attribute__((address_space(3)))
typedef short bf16x8 __attribute__((ext_vector_type(8)));
typedef float f32x4 __attribute__((ext_vector_type(4)));
typedef unsigned u32x4 __attribute__((ext_vector_type(4)));
constexpr int BM = 256, BK = 64, HALF = 128, HTB = HALF * BK * 2, STAGE_BYTES = 8 * HTB, NXCD = 8, WGM = 8;
__device__ __forceinline__ int lds_byte(int r, int c) { const int st = (r >> 4) * 2 + (c >> 5), rr = r & 15, cc = c & 31, ob = rr * 64 + cc * 2; return st * 1024 + (ob ^ (((ob >> 9) & 1) << 5)); }
__device__ __forceinline__ void stage_rc(int b, int& R, int& C) { const int st = b / 1024, sb = b % 1024, swz = sb ^ (((sb >> 9) & 1) << 5); R = (st >> 1) * 16 + swz / 64; C = (st & 1) * 32 + (swz % 64) / 2; }
struct Unit { int pm, pn, aoff; };
struct Gemm { const bf16* A; const bf16* Bt; int K, lda; };
struct StaticOrder {
    int nM, nN, nwg, G, c;
    __device__ __forceinline__ void init(int M, int N, int G_, int c_) { nM = M / BM; nN = N / BM; nwg = nM * nN; G = G_; c = c_; }
    __device__ __forceinline__ bool next(int i, Unit& u) const {
        const long L = (long)i * G + c; if (L >= nwg) return false;
        int wgid = (int)L; { const int q = nwg / NXCD, r = nwg % NXCD, xcd = wgid % NXCD, off = wgid / NXCD; wgid = (xcd < r ? xcd * (q + 1) : r * (q + 1) + (xcd - r) * q) + off; }
        const int nig = WGM * nN, gid = wgid / nig, fm = gid * WGM, gsz = (nM - fm) < WGM ? (nM - fm) : WGM;
        u.pm = fm + ((wgid % nig) % gsz); u.pn = (wgid % nig) / gsz; u.aoff = 0; return true;
    }
};
struct PairOrder {
    int nbase, G, v, nct;
    __device__ __forceinline__ void init(int M, int G_, int c_) { nct = D / BM; nbase = (M / BM) * nct; G = G_; v = (G_ % 8 == 0) ? (c_ % 8) * (G_ / 8) + c_ / 8 : c_; }
    __device__ __forceinline__ bool next(int i, Unit& u) const {
        const int j = v + (i >> 1) * G; if (j >= nbase) return false;
        const int half = i & 1; u.pm = j / nct; u.pn = half * nct + (j % nct); u.aoff = half * MW; return true;
    }
};
typedef float f32x2_t __attribute__((ext_vector_type(2)));
typedef __bf16 bf16x2_t __attribute__((ext_vector_type(2)));
__device__ __forceinline__ unsigned cvt_pk_bf16(float lo, float hi) { f32x2_t v = {lo, hi}; bf16x2_t b = __builtin_convertvector(v, bf16x2_t); return __builtin_bit_cast(unsigned, b); }
__device__ __forceinline__ float fsigmoid(float x) { return __builtin_amdgcn_rcpf(1.0f + __expf(-x)); }
__device__ __forceinline__ float bflo(unsigned w) { return __builtin_bit_cast(float, w << 16); }
__device__ __forceinline__ float bfhi(unsigned w) { return __builtin_bit_cast(float, w & 0xffff0000u); }

struct EpiA1 {
    bf16* U;
    __device__ __forceinline__ void operator()(const f32x4 (&acc)[2][2][4][2], const Unit& u, int wr, int wc, int fr, int fq) const {
        const int row0 = u.pm * BM + wr * 64 + fr, col0 = u.pn * BM + wc * 32 + 8 * fq;
#pragma unroll
        for (int ai = 0; ai < 2; ++ai)
#pragma unroll
            for (int m = 0; m < 4; ++m) { bf16* rowp = U + (size_t)(row0 + ai * HALF + m * 16) * PU + col0;
#pragma unroll
                for (int bj = 0; bj < 2; ++bj) { if (col0 + bj * HALF < N1) { const f32x4 v0 = acc[ai][bj][m][0], v1 = acc[ai][bj][m][1];
                    u32x4 w; w.x = cvt_pk_bf16(v0[0], v0[1]); w.y = cvt_pk_bf16(v0[2], v0[3]); w.z = cvt_pk_bf16(v1[0], v1[1]); w.w = cvt_pk_bf16(v1[2], v1[3]);
                    *(u32x4*)(rowp + bj * HALF) = w; } } }
    }
};
struct EpiA2 {
    bf16* U;
    __device__ __forceinline__ void operator()(const f32x4 (&acc)[2][2][4][2], const Unit& u, int wr, int wc, int fr, int fq) const {
        const int row0 = u.pm * BM + wr * 64 + fr, col0 = D + u.pn * BM + wc * 32 + 8 * fq;
#pragma unroll
        for (int ai = 0; ai < 2; ++ai)
#pragma unroll
            for (int m = 0; m < 4; ++m) { bf16* rowp = U + (size_t)(row0 + ai * HALF + m * 16) * PU + col0;
#pragma unroll
                for (int bj = 0; bj < 2; ++bj) { const f32x4 v0 = acc[ai][bj][m][0], v1 = acc[ai][bj][m][1];
                    u32x4 w; w.x = cvt_pk_bf16(fsigmoid(v0[0]), fsigmoid(v0[1])); w.y = cvt_pk_bf16(fsigmoid(v0[2]), fsigmoid(v0[3]));
                    w.z = cvt_pk_bf16(fsigmoid(v1[0]), fsigmoid(v1[1])); w.w = cvt_pk_bf16(fsigmoid(v1[2]), fsigmoid(v1[3]));
                    *(u32x4*)(rowp + bj * HALF) = w; } }
    }
};
struct EpiPJ {
    bf16* U;
    __device__ __forceinline__ void operator()(const f32x4 (&acc)[2][2][4][2], const Unit& u, int wr, int wc, int fr, int fq) const {
        const int nct = D / BM, half = u.pn >= nct ? 1 : 0, ct = u.pn - half * nct;
        const int row0 = u.pm * BM + wr * 64 + fr, col0 = ct * BM + wc * 32 + 8 * fq;
#pragma unroll
        for (int ai = 0; ai < 2; ++ai)
#pragma unroll
            for (int m = 0; m < 4; ++m) { bf16* rowp = U + (size_t)(row0 + ai * HALF + m * 16) * PU + col0;
#pragma unroll
                for (int bj = 0; bj < 2; ++bj) { const f32x4 v0 = acc[ai][bj][m][0], v1 = acc[ai][bj][m][1];
                    const u32x4 g = *(const u32x4*)(rowp + (1 + half) * D + bj * HALF);
                    float o[8] = { bflo(g.x) * v0[0], bfhi(g.x) * v0[1], bflo(g.y) * v0[2], bfhi(g.y) * v0[3], bflo(g.z) * v1[0], bfhi(g.z) * v1[1], bflo(g.w) * v1[2], bfhi(g.w) * v1[3] };
                    if (half) { const u32x4 p = *(const u32x4*)(rowp + bj * HALF);
                        o[0] += bflo(p.x); o[1] += bfhi(p.x); o[2] += bflo(p.y); o[3] += bfhi(p.y); o[4] += bflo(p.z); o[5] += bfhi(p.z); o[6] += bflo(p.w); o[7] += bfhi(p.w); }
                    u32x4 w; w.x = cvt_pk_bf16(o[0], o[1]); w.y = cvt_pk_bf16(o[2], o[3]); w.z = cvt_pk_bf16(o[4], o[5]); w.w = cvt_pk_bf16(o[6], o[7]);
                    *(u32x4*)(rowp + bj * HALF) = w; }
                asm volatile("" ::: "memory"); }
    }
};
struct EpiRes {
    float* X; const float* gate;
    __device__ __forceinline__ void operator()(const f32x4 (&acc)[2][2][4][2], const Unit& u, int wr, int wc, int fr, int fq) const {
        const int row0 = u.pm * BM + wr * 64 + fr, col0 = u.pn * BM + wc * 32 + 4 * fq;
        const int cond = seqinfo(seq_of_token(u.pm * BM)).cond;
        const float* gp = gate + (size_t)cond * 6 * D + col0;
        f32x4 gv[2][2];
#pragma unroll
        for (int bj = 0; bj < 2; ++bj)
#pragma unroll
            for (int n = 0; n < 2; ++n) gv[bj][n] = *(const f32x4*)(gp + bj * HALF + n * 16);
#pragma unroll
        for (int ai = 0; ai < 2; ++ai)
#pragma unroll
            for (int m = 0; m < 4; ++m) { float* rowp = X + (size_t)(row0 + ai * HALF + m * 16) * D + col0;
#pragma unroll
                for (int bj = 0; bj < 2; ++bj)
#pragma unroll
                    for (int n = 0; n < 2; ++n) { f32x4* p = (f32x4*)(rowp + bj * HALF + n * 16); *p = *p + gv[bj][n] * acc[ai][bj][m][n]; }
                asm volatile("" ::: "memory"); }
    }
};
struct EpiF1 {
    bf16* Hd;
    __device__ __forceinline__ void operator()(const f32x4 (&acc)[2][2][4][2], const Unit& u, int wr, int wc, int fr, int fq) const {
        const int row0 = u.pm * BM + wr * 64 + fr, col0 = u.pn * HALF + wc * 32 + 8 * fq;
#pragma unroll
        for (int ai = 0; ai < 2; ++ai)
#pragma unroll
            for (int m = 0; m < 4; ++m) { bf16* rowp = Hd + (size_t)(row0 + ai * HALF + m * 16) * FF + col0;
                float o[8];
#pragma unroll
                for (int n = 0; n < 2; ++n)
#pragma unroll
                    for (int e = 0; e < 4; ++e) { const float a = acc[ai][0][m][n][e], b = acc[ai][1][m][n][e]; o[n * 4 + e] = a * fsigmoid(a) * b; }
                u32x4 w; w.x = cvt_pk_bf16(o[0], o[1]); w.y = cvt_pk_bf16(o[2], o[3]); w.z = cvt_pk_bf16(o[4], o[5]); w.w = cvt_pk_bf16(o[6], o[7]);
                *(u32x4*)rowp = w; }
    }
};

template <class Epi, class Sched, bool ALIGN_EPI = true, bool SP2 = true>
__device__ __forceinline__ void gemm_phase(PG8_LAS unsigned char* lds, const Gemm g, const Sched& S, const Epi& E) {
    const int tid = threadIdx.x, wid = __builtin_amdgcn_readfirstlane(tid >> 6), lane = tid & 63, wr = wid >> 2, wc = wid & 3, fr = lane & 15, fq = lane >> 4;
    const int K = g.K, nt = K / BK;
    unsigned voffA[2], voffB[2];
#pragma unroll
    for (int i = 0; i < 2; ++i) { int R, C; stage_rc(tid * 16 + i * 8192, R, C);
        voffA[i] = (unsigned)(R * g.lda + C) * 2u; voffB[i] = (unsigned)(R * K + C) * 2u; }
    const size_t kstep = (size_t)(BK * 2);
    const size_t hstepA = (size_t)HALF * g.lda * 2, hstepB = (size_t)HALF * K * 2;
    const size_t tstepA = 2 * hstepA, tstepB = 2 * hstepB;
    const unsigned ldsw = (unsigned)wid * 1024u;
    const int aoff = lds_byte(wr * 64 + fr, fq * 8), boff = lds_byte(wc * 32 + fr, fq * 8);
#define PG8_SA(b, h) (((b) * 2 + (h)) * HTB)
#define PG8_SB(b, h) ((4 + (b) * 2 + (h)) * HTB)
#define PG8_STAGE(bufoff, gbase, voff) do { _Pragma("unroll") for (int _i = 0; _i < 2; ++_i) \
        __builtin_amdgcn_global_load_lds((const unsigned*)((const char*)(gbase) + (voff)[_i]), (PG8_LAS unsigned*)(lds + (bufoff) + ldsw + _i * 8192), 16, 0, 0); } while (0)
#define PG8_LDA(dst, b, h) do { _Pragma("unroll") for (int m = 0; m < 4; ++m) _Pragma("unroll") for (int k = 0; k < 2; ++k) dst[m][k] = *(const PG8_LAS bf16x8*)(lds + PG8_SA(b, h) + aoff + m * 2048 + k * 1024); } while (0)
#define PG8_LDB(dst, b, h) do { _Pragma("unroll") for (int n = 0; n < 2; ++n) _Pragma("unroll") for (int k = 0; k < 2; ++k) dst[n][k] = *(const PG8_LAS bf16x8*)(lds + PG8_SB(b, h) + boff + n * 2048 + k * 1024); } while (0)
#define PG8_MMA(ai, bj, At, Bt) do { __builtin_amdgcn_s_setprio(1); _Pragma("unroll") for (int m = 0; m < 4; ++m) _Pragma("unroll") for (int n = 0; n < 2; ++n) _Pragma("unroll") for (int k = 0; k < 2; ++k) \
        acc[ai][bj][m][n] = __builtin_amdgcn_mfma_f32_16x16x32_bf16(Bt[n][k], At[m][k], acc[ai][bj][m][n], 0, 0, 0); __builtin_amdgcn_s_setprio(0); } while (0)
#define PG8_WAIT_V(n) asm volatile("s_waitcnt vmcnt(" #n ")" ::: "memory")
#define PG8_WAIT_L(n) asm volatile("s_waitcnt lgkmcnt(" #n ")" ::: "memory")
#define PG8_BAR __builtin_amdgcn_s_barrier()
#define PG8_SCHED __builtin_amdgcn_sched_barrier(0)
    Unit cur, nxt; int ui = 0;
    if (!S.next(0, cur)) return;
    f32x4 acc[2][2][4][2];
#pragma unroll
    for (int a = 0; a < 2; ++a)
#pragma unroll
        for (int b = 0; b < 2; ++b)
#pragma unroll
            for (int m = 0; m < 4; ++m)
#pragma unroll
                for (int n = 0; n < 2; ++n) acc[a][b][m][n] = (f32x4){0.f, 0.f, 0.f, 0.f};
    bf16x8 At[4][2], B0[2][2], B1[2][2];
    const char* cA = (const char*)g.A + (size_t)cur.pm * tstepA + (size_t)cur.aoff * 2; const char* cB = (const char*)g.Bt + (size_t)cur.pn * tstepB;
    if constexpr (SP2) {
        PG8_STAGE(PG8_SB(0, 0), cB, voffB); PG8_STAGE(PG8_SB(0, 1), cB + hstepB, voffB); PG8_STAGE(PG8_SA(0, 0), cA, voffA); PG8_STAGE(PG8_SA(0, 1), cA + hstepA, voffA);
        if (wr == 1) PG8_BAR;
        PG8_WAIT_V(2); PG8_BAR;
        PG8_STAGE(PG8_SB(1, 0), cB + kstep, voffB); PG8_STAGE(PG8_SA(1, 0), cA + kstep, voffA); PG8_STAGE(PG8_SB(1, 1), cB + hstepB + kstep, voffB);
        PG8_WAIT_V(6); PG8_BAR;
    } else {
        PG8_STAGE(PG8_SB(0, 0), cB, voffB); PG8_STAGE(PG8_SA(0, 0), cA, voffA); PG8_STAGE(PG8_SB(0, 1), cB + hstepB, voffB); PG8_STAGE(PG8_SA(0, 1), cA + hstepA, voffA);
        if (wr == 1) PG8_BAR;
        PG8_WAIT_V(4); PG8_BAR;
        PG8_STAGE(PG8_SB(1, 0), cB + kstep, voffB); PG8_STAGE(PG8_SA(1, 0), cA + kstep, voffA); PG8_STAGE(PG8_SB(1, 1), cB + hstepB + kstep, voffB);
        PG8_WAIT_V(6); PG8_BAR;
    }
    for (;;) {
        const bool has_next = S.next(ui + 1, nxt);
        const char* nA = has_next ? (const char*)g.A + (size_t)nxt.pm * tstepA + (size_t)nxt.aoff * 2 : cA; const char* nB = has_next ? (const char*)g.Bt + (size_t)nxt.pn * tstepB : cB;
        for (int t = 0; t < nt; t += 2) {
            const bool last = (t == nt - 2);
            const char* a1 = cA + (size_t)(t + 1) * kstep;
            const char* a2 = last ? nA : cA + (size_t)(t + 2) * kstep; const char* b2 = last ? nB : cB + (size_t)(t + 2) * kstep;
            const char* a3 = a2 + kstep; const char* b3 = b2 + kstep;
            if constexpr (SP2) {
            PG8_LDB(B0, 0, 0); PG8_LDB(B1, 0, 1); PG8_SCHED; PG8_LDA(At, 0, 0); PG8_STAGE(PG8_SA(1, 1), a1 + hstepA, voffA);
            PG8_WAIT_V(8); PG8_WAIT_L(0); PG8_BAR; PG8_MMA(0, 0, At, B0); PG8_MMA(0, 1, At, B1); PG8_BAR; PG8_SCHED;
            PG8_LDA(At, 0, 1); PG8_STAGE(PG8_SB(0, 0), b2, voffB); PG8_STAGE(PG8_SB(0, 1), b2 + hstepB, voffB); PG8_STAGE(PG8_SA(0, 0), a2, voffA);
            PG8_WAIT_V(8); PG8_WAIT_L(0); PG8_BAR; PG8_MMA(1, 0, At, B0); PG8_MMA(1, 1, At, B1); PG8_BAR; PG8_SCHED;
            PG8_LDB(B0, 1, 0); PG8_LDB(B1, 1, 1); PG8_SCHED; PG8_LDA(At, 1, 0); PG8_STAGE(PG8_SA(0, 1), a2 + hstepA, voffA);
            PG8_WAIT_V(8); PG8_WAIT_L(0); PG8_BAR; PG8_MMA(0, 0, At, B0); PG8_MMA(0, 1, At, B1); PG8_BAR; PG8_SCHED;
            PG8_LDA(At, 1, 1); PG8_STAGE(PG8_SB(1, 0), b3, voffB); PG8_STAGE(PG8_SB(1, 1), b3 + hstepB, voffB); PG8_STAGE(PG8_SA(1, 0), a3, voffA);
            PG8_WAIT_V(8); PG8_WAIT_L(0); PG8_BAR; PG8_MMA(1, 0, At, B0); PG8_MMA(1, 1, At, B1); PG8_BAR; PG8_SCHED;
            } else {
            PG8_LDB(B0, 0, 0); PG8_SCHED; PG8_LDA(At, 0, 0); PG8_STAGE(PG8_SA(1, 1), a1 + hstepA, voffA);
            PG8_WAIT_L(8); PG8_BAR; PG8_WAIT_L(0); PG8_MMA(0, 0, At, B0); PG8_BAR; PG8_SCHED;
            PG8_LDB(B1, 0, 1); PG8_STAGE(PG8_SB(0, 0), b2, voffB);
            PG8_BAR; PG8_WAIT_L(0); PG8_MMA(0, 1, At, B1); PG8_BAR;
            PG8_LDA(At, 0, 1); PG8_STAGE(PG8_SA(0, 0), a2, voffA);
            PG8_BAR; PG8_WAIT_L(0); PG8_MMA(1, 0, At, B0); PG8_BAR; PG8_SCHED;
            PG8_STAGE(PG8_SB(0, 1), b2 + hstepB, voffB);
            PG8_WAIT_V(6); PG8_BAR; PG8_MMA(1, 1, At, B1); PG8_BAR;
            PG8_LDB(B0, 1, 0); PG8_SCHED; PG8_LDA(At, 1, 0); PG8_STAGE(PG8_SA(0, 1), a2 + hstepA, voffA);
            PG8_WAIT_L(8); PG8_BAR; PG8_WAIT_L(0); PG8_MMA(0, 0, At, B0); PG8_BAR; PG8_SCHED;
            PG8_LDB(B1, 1, 1); PG8_STAGE(PG8_SB(1, 0), b3, voffB);
            PG8_BAR; PG8_WAIT_L(0); PG8_MMA(0, 1, At, B1); PG8_BAR;
            PG8_LDA(At, 1, 1); PG8_STAGE(PG8_SA(1, 0), a3, voffA);
            PG8_BAR; PG8_WAIT_L(0); PG8_MMA(1, 0, At, B0); PG8_BAR; PG8_SCHED;
            PG8_STAGE(PG8_SB(1, 1), b3 + hstepB, voffB);
            PG8_WAIT_V(6); PG8_BAR; PG8_MMA(1, 1, At, B1); PG8_BAR;
            }
        }
        if constexpr (ALIGN_EPI) { if (wr == 0) PG8_BAR; }
        E(acc, cur, wr, wc, fr, fq);
        if (!has_next) break;
#pragma unroll
        for (int a = 0; a < 2; ++a)
#pragma unroll
            for (int b = 0; b < 2; ++b)
#pragma unroll
                for (int m = 0; m < 4; ++m)
#pragma unroll
                    for (int n = 0; n < 2; ++n) acc[a][b][m][n] = (f32x4){0.f, 0.f, 0.f, 0.f};
        cur = nxt; cA = nA; cB = nB; ++ui;
        if constexpr (ALIGN_EPI) { if (wr == 1) PG8_BAR; }
    }
    PG8_WAIT_V(0);
    if constexpr (!ALIGN_EPI) { if (wr == 0) PG8_BAR; }
    PG8_BAR;
#undef PG8_SA
#undef PG8_SB
#undef PG8_STAGE
#undef PG8_LDA
#undef PG8_LDB
#undef PG8_MMA
#undef PG8_WAIT_V
#undef PG8_WAIT_L
#undef PG8_BAR
#undef PG8_SCHED
}
}


#define LDS_BARRIER() do { asm volatile("s_waitcnt lgkmcnt(0)" ::: "memory"); __builtin_amdgcn_s_barrier(); asm volatile("" ::: "memory"); } while (0)
namespace ml {
#define LAS __attribute__((address_space(3)))
typedef short bf16x8 __attribute__((ext_vector_type(8)));
typedef float f32x4 __attribute__((ext_vector_type(4)));
typedef unsigned u32x4 __attribute__((ext_vector_type(4)));
constexpr int NVB = 4, EV = MD / NVB;
constexpr int PQ = 272, PT = 144;
constexpr int L_QS = 0, L_KS = L_QS + 64 * PQ, L_KT = L_KS + 64 * PQ, L_VT = L_KT + 128 * PT, L_SB = L_VT + 48 * PT, L_CT = L_SB + 64 * PT,
              L_HS = L_CT + 48 * PQ, L_SC = L_HS + 64 * 80, L_END = L_SC + 4096;
static_assert(L_END <= 131072, "mLSTM LDS map");
enum { SC_A = 0, SC_PM = 64, SC_WI = 128, SC_EMT = 192, SC_WE = 256, SC_DEN = 320, SC_MISC = 384 };
__device__ __forceinline__ f32x4 mma(bf16x8 a, bf16x8 b, f32x4 c) { return __builtin_amdgcn_mfma_f32_16x16x32_bf16(a, b, c, 0, 0, 0); }
__device__ __forceinline__ bf16x8 frag(LAS unsigned char* lds, int base, int pitch, int row0, int k0, int lane) {
    return *(const LAS bf16x8*)(lds + base + (row0 + (lane & 15)) * pitch + (k0 + 8 * (lane >> 4)) * 2);
}
__device__ __forceinline__ void mlstm_item(LAS unsigned char* lds, CParams& P, int l, int s, int head, int dir, int vb) {
    const int tid = threadIdx.x, w = __builtin_amdgcn_readfirstlane(tid >> 6), lane = tid & 63, fr = lane & 15, fq = lane >> 4;
    const int rt = w & 3, half = w >> 2;
    const SeqInfo q = seqinfo(s); const int nchunk = q.T / 64;
    const bf16* QK = WSP(bf16, WS_QKC); bf16* U = WSP(bf16, WS_U1);
    LAS float* SC = (LAS float*)(lds + L_SC);
    f32x4 cacc[3];
    float m_prev;
    if (!q.grid) { cacc[0] = cacc[1] = cacc[2] = (f32x4){0.f, 0.f, 0.f, 0.f}; m_prev = 0.f; }
    else {
        const size_t sb = (((size_t)q.b * DEPTH + l) * 2 + dir) * MH + head; const int d = 16 * w + fr;
#pragma unroll
        for (int et = 0; et < 2; ++et)
#pragma unroll
            for (int r = 0; r < 4; ++r) cacc[et][r] = P.in[ST_C][(sb * 128 + d) * 128 + vb * EV + 16 * et + 4 * fq + r];
        cacc[2] = (f32x4){0.f, 0.f, 0.f, 0.f}; if (fq == 0) cacc[2][0] = P.in[ST_N][sb * 128 + d];
        m_prev = P.in[ST_M][sb];
    }
    const float bi = P.in[M_GATE_B][(size_t)l * 4 * MH + (2 * dir) * MH + head], bfg = P.in[M_GATE_B][(size_t)l * 4 * MH + (2 * dir + 1) * MH + head];
    for (int i = tid; i < 16 * 64; i += 512) { const int r = i >> 6, c = i & 63; *(LAS bf16*)(lds + L_VT + (32 + r) * PT + c * 2) = (r == 0) ? (bf16)0x3f80 : (bf16)0; }
    u32x4 pqk[4]; u32x4 pv; bf16 pgi = 0, pgf = 0;
#define ML_TOK(c, j) ((size_t)(q.base + (dir ? q.T - 1 - ((c) * 64 + (j)) : ((c) * 64 + (j)))))
#define ML_PREFETCH(c) do { _Pragma("unroll") for (int i = 0; i < 4; ++i) { const int id = tid + 512 * i, j = id >> 5, pc = id & 31; \
            pqk[i] = *(const u32x4*)(QK + ML_TOK(c, j) * (2 * MW) + (pc < 16 ? head * 128 + 8 * pc : MW + head * 128 + 8 * (pc - 16))); } \
        if (tid < 256) { const int j = tid >> 2, pc = tid & 3; pv = *(const u32x4*)(U + ML_TOK(c, j) * PU + OFF_V + head * 128 + vb * EV + 8 * pc); } \
        if (w == 0) { const bf16* g = U + ML_TOK(c, lane) * PU + OFF_G; pgi = g[(2 * dir) * MH + head]; pgf = g[(2 * dir + 1) * MH + head]; } } while (0)
    ML_PREFETCH(0);
    for (int c = 0; c < nchunk; ++c) {
#pragma unroll
        for (int i = 0; i < 4; ++i) { const int id = tid + 512 * i, j = id >> 5, pc = id & 31;
            *(LAS u32x4*)(lds + (pc < 16 ? L_QS : L_KS) + j * PQ + (pc & 15) * 16) = pqk[i]; }
        if (tid < 256) { const int j = tid >> 2, pc = tid & 3; const unsigned wv[4] = {pv.x, pv.y, pv.z, pv.w};
#pragma unroll
            for (int e = 0; e < 8; ++e) *(LAS bf16*)(lds + L_VT + (8 * pc + e) * PT + j * 2) = (bf16)((wv[e >> 1] >> ((e & 1) * 16)) & 0xffffu); }
#pragma unroll
        for (int et = 0; et < 3; ++et)
#pragma unroll
            for (int r = 0; r < 4; ++r) *(LAS bf16*)(lds + L_CT + (16 * et + 4 * fq + r) * PQ + (16 * w + fr) * 2) = f2bf(cacc[et][r]);
        float wie = 1.f;
        if (w == 0) {
            const float gi = bf2f(pgi) + bi, gf = bf2f(pgf) + bfg;
            const float lf = fminf(gf, 0.f) - log1pf(__expf(-fabsf(gf)));
            float b = lf;
#pragma unroll
            for (int o = 1; o < 64; o <<= 1) { const float t = __shfl_up(b, o); if (lane >= o) b += t; }
            const float a = gi - b; float pm = a;
#pragma unroll
            for (int o = 1; o < 64; o <<= 1) { const float t = __shfl_up(pm, o); if (lane >= o) pm = fmaxf(pm, t); }
            pm = fmaxf(pm, m_prev);
            const float pm63 = __shfl(pm, 63), b63 = __shfl(b, 63);
            SC[SC_A + lane] = a; SC[SC_PM + lane] = pm; SC[SC_WI + lane] = __expf(m_prev - pm); SC[SC_EMT + lane] = __expf(-(b + pm)); SC[SC_WE + lane] = __expf(a - pm63);
            if (lane == 0) { SC[SC_MISC] = __expf(m_prev - pm63); SC[SC_MISC + 1] = b63 + pm63; }
        }
        LDS_BARRIER();
        if (c + 1 < nchunk) ML_PREFETCH(c + 1);
        wie = SC[SC_MISC]; m_prev = SC[SC_MISC + 1];
#pragma unroll
        for (int i = 0; i < 2; ++i) { const int id = tid + 512 * i, j = id >> 4, pc = id & 15; const float we = SC[SC_WE + j];
            const u32x4 kv = *(const LAS u32x4*)(lds + L_KS + j * PQ + pc * 16); const unsigned wv[4] = {kv.x, kv.y, kv.z, kv.w};
#pragma unroll
            for (int e = 0; e < 8; ++e) { const float kf = __builtin_bit_cast(float, (e & 1) ? (wv[e >> 1] & 0xffff0000u) : (wv[e >> 1] << 16));
                *(LAS bf16*)(lds + L_KT + (8 * pc + e) * PT + j * 2) = f2bf(kf * we); } }
#pragma unroll
        for (int cc = 0; cc < 2; ++cc) { const int ct = 2 * half + cc;
            f32x4 acc = (f32x4){0.f, 0.f, 0.f, 0.f};
            if (ct <= rt) {
#pragma unroll
                for (int k = 0; k < 4; ++k) acc = mma(frag(lds, L_QS, PQ, 16 * rt, 32 * k, lane), frag(lds, L_KS, PQ, 16 * ct, 32 * k, lane), acc);
            }
            const int sp = 16 * ct + fr; const float as = SC[SC_A + sp];
#pragma unroll
            for (int r = 0; r < 4; ++r) { const int t = 16 * rt + 4 * fq + r; const float v = (sp <= t) ? acc[r] * __expf(as - SC[SC_PM + t]) : 0.f;
                *(LAS bf16*)(lds + L_SB + t * PT + sp * 2) = f2bf(v); } }
        LDS_BARRIER();
        f32x4 nacc[2]; const int nct = half ? 1 : 2;
#pragma unroll
        for (int cc = 0; cc < 2; ++cc) { if (cc < nct) { const int ct = half ? 2 : cc;
            f32x4 a1 = (f32x4){0.f, 0.f, 0.f, 0.f}, a2 = (f32x4){0.f, 0.f, 0.f, 0.f};
#pragma unroll
            for (int k = 0; k < 2; ++k) a1 = mma(frag(lds, L_SB, PT, 16 * rt, 32 * k, lane), frag(lds, L_VT, PT, 16 * ct, 32 * k, lane), a1);
#pragma unroll
            for (int k = 0; k < 4; ++k) a2 = mma(frag(lds, L_QS, PQ, 16 * rt, 32 * k, lane), frag(lds, L_CT, PQ, 16 * ct, 32 * k, lane), a2);
#pragma unroll
            for (int r = 0; r < 4; ++r) a1[r] += SC[SC_WI + 16 * rt + 4 * fq + r] * a2[r];
            nacc[cc] = a1; } }
        if (half && fr == 0) {
#pragma unroll
            for (int r = 0; r < 4; ++r) SC[SC_DEN + 16 * rt + 4 * fq + r] = nacc[0][r];
        }
#pragma unroll
        for (int et = 0; et < 3; ++et) { cacc[et] = cacc[et] * wie;
#pragma unroll
            for (int k = 0; k < 2; ++k) cacc[et] = mma(frag(lds, L_VT, PT, 16 * et, 32 * k, lane), frag(lds, L_KT, PT, 16 * w, 32 * k, lane), cacc[et]); }
        LDS_BARRIER();
        if (!half) {
#pragma unroll
            for (int cc = 0; cc < 2; ++cc)
#pragma unroll
                for (int r = 0; r < 4; ++r) { const int t = 16 * rt + 4 * fq + r; const float den = fmaxf(fabsf(SC[SC_DEN + t]), SC[SC_EMT + t]);
                    *(LAS bf16*)(lds + L_HS + t * 80 + (16 * cc + fr) * 2) = f2bf(nacc[cc][r] / den); }
        }
        LDS_BARRIER();
        if (tid < 256) { const int j = tid >> 2, pc = tid & 3;
            *(u32x4*)(U + ML_TOK(c, j) * PU + dir * MW + head * 128 + vb * EV + 8 * pc) = *(const LAS u32x4*)(lds + L_HS + j * 80 + pc * 16); }
    }
    if (!q.grid) {
        const size_t sb = (((size_t)q.b * DEPTH + l) * 2 + dir) * MH + head; const int d = 16 * w + fr;
#pragma unroll
        for (int et = 0; et < 2; ++et)
#pragma unroll
            for (int r = 0; r < 4; ++r) P.out[OUT_C + (sb * 128 + d) * 128 + vb * EV + 16 * et + 4 * fq + r] = cacc[et][r];
        if (vb == 0) { if (fq == 0) P.out[OUT_N + sb * 128 + d] = cacc[2][0]; if (tid == 0) P.out[OUT_M + sb] = m_prev; }
    }
    LDS_BARRIER();
#undef ML_TOK
#undef ML_PREFETCH
}
constexpr int N_ITEMS = NSEQ * MH * 2 * NVB;
__device__ __forceinline__ void decode_item(int it, int& s, int& head, int& dir, int& vb) {
    vb = it % NVB; int ch = it / NVB; dir = ch & 1; ch >>= 1; head = ch % MH; const int sq = ch / MH;
    s = sq < LB ? CB + sq : sq - LB;
}
}


namespace rw {
typedef short bf16x8 __attribute__((ext_vector_type(8)));
typedef float f32x4 __attribute__((ext_vector_type(4)));
typedef unsigned u32x4 __attribute__((ext_vector_type(4)));
enum { V_A = 0, V_W, V_B, V_K, V_R, NVEC };
constexpr int REC = NVEC * 64 * 4;
constexpr int PT = 144;
constexpr int L_SBUF = 0, L_VT = L_SBUF + 64 * REC, L_TW = L_VT + 64 * 256, L_AL = L_TW + 64 * PT, L_YS = L_AL + 64 * PT, L_INV = L_YS + 64 * 16 * 4, L_END = L_INV + 256;
__device__ __forceinline__ int vt_off(int row, int tt) { return row * 256 + ((tt ^ (((row >> 3) & 7) << 2)) << 2); }
static_assert(L_END <= 131072, "RWKV LDS map");
__device__ __forceinline__ float dpp_xor1(float x) { return __builtin_bit_cast(float, __builtin_amdgcn_update_dpp(0, __builtin_bit_cast(int, x), 0xB1, 0xF, 0xF, true)); }
__device__ __forceinline__ float dpp_xor2(float x) { return __builtin_bit_cast(float, __builtin_amdgcn_update_dpp(0, __builtin_bit_cast(int, x), 0x4E, 0xF, 0xF, true)); }
__device__ __forceinline__ float dpp_ror4(float x) { return __builtin_bit_cast(float, __builtin_amdgcn_update_dpp(0, __builtin_bit_cast(int, x), 0x124, 0xF, 0xF, true)); }
__device__ __forceinline__ float dpp_ror8(float x) { return __builtin_bit_cast(float, __builtin_amdgcn_update_dpp(0, __builtin_bit_cast(int, x), 0x128, 0xF, 0xF, true)); }
__device__ __forceinline__ float allsum16(float x) { x += dpp_xor1(x); x += dpp_xor2(x); x += dpp_ror4(x); x += dpp_ror8(x); return x; }
__device__ __forceinline__ f32x4 cvt_lo4(unsigned a, unsigned b) { return (f32x4){__builtin_bit_cast(float, a << 16), __builtin_bit_cast(float, a & 0xffff0000u), __builtin_bit_cast(float, b << 16), __builtin_bit_cast(float, b & 0xffff0000u)}; }
__device__ __forceinline__ float allsum32(float x) {
    x = allsum16(x);
    float xa = x, xb = x;
    asm volatile("v_mov_b32 %1, %0\n\ts_nop 1\n\tv_permlane32_swap_b32 %0, %1\n\ts_nop 1" : "+v"(xa), "=&v"(xb));
    return xa + xb;
}
__device__ __forceinline__ void rwkv_item(LAS unsigned char* lds, CParams& P, int l, int s, int head, int dir, int rh) {
    const int tid = threadIdx.x, w = __builtin_amdgcn_readfirstlane(tid >> 6), lane = tid & 63, fr = lane & 15, fq = lane >> 4;
    const int rt = w & 3, half = w >> 2, hc = head * 64;
    const SeqInfo q = seqinfo(s); const int nchunk = q.T / 64;
    const bf16* RX = WSP(bf16, WS_RXC); bf16* U = WSP(bf16, WS_U1);
    const int pj = tid >> 3, psub = tid & 7;
    const int hh = lane >> 5, rsel = (lane >> 4) & 1, cg = lane & 15;
    const int row = 16 * rh + 2 * w + rsel, col0 = 32 * hh + 2 * cg;
    typedef float f32x2 __attribute__((ext_vector_type(2)));
    f32x2 S2;
    if (!q.grid) S2 = (f32x2){0.f, 0.f};
    else { const size_t sb = (((size_t)q.b * DEPTH + l) * 2 + dir) * RH + head; S2 = *(const f32x2*)(P.in[ST_R] + (sb * 64 + row) * 64 + col0); }
    float rkk8[8];
#pragma unroll
    for (int e = 0; e < 8; ++e) rkk8[e] = P.in[R_KK][(size_t)l * RW + hc + 8 * psub + e];
    float c_w0[2], c_a0[2], c_kk[2], c_ka[2];
    bf16x8 bw[2][2], ba[2][2];
#pragma unroll
    for (int cc = 0; cc < 2; ++cc) { const int c = 16 * (2 * half + cc) + fr;
        c_w0[cc] = P.in[R_W0][((size_t)l * 2 + dir) * RW + hc + c]; c_a0[cc] = P.in[R_A0][((size_t)l * 2 + dir) * RW + hc + c];
        c_kk[cc] = P.in[R_KK][(size_t)l * RW + hc + c]; c_ka[cc] = P.in[R_KA][(size_t)l * RW + hc + c];
#pragma unroll
        for (int ks = 0; ks < 2; ++ks)
#pragma unroll
            for (int e = 0; e < 8; ++e) { const int j = 32 * ks + 8 * fq + e;
                bw[cc][ks][e] = (short)f2bf(P.in[R_W2][(((size_t)l * 2 + dir) * 64 + j) * RW + hc + c]);
                ba[cc][ks][e] = (short)f2bf(P.in[R_A2][(((size_t)l * 2 + dir) * 64 + j) * RW + hc + c]); } }
    u32x4 pf[5];
#define RW_TOK(c, j) ((size_t)(q.base + (dir ? q.T - 1 - ((c) * 64 + (j)) : ((c) * 64 + (j)))))
#define RW_PREFETCH(c) do { const bf16* rx = RX + RW_TOK(c, pj) * RIN + 8 * psub; \
        pf[0] = *(const u32x4*)(rx + RX_R + hc); pf[1] = *(const u32x4*)(rx + RX_K + hc); pf[2] = *(const u32x4*)(rx + RX_V + hc); \
        pf[3] = *(const u32x4*)(rx + RX_WL + dir * 64); pf[4] = *(const u32x4*)(rx + RX_AL + dir * 64); } while (0)
    RW_PREFETCH(0);
    for (int c = 0; c < nchunk; ++c) {
        { LAS unsigned char* rec = lds + L_SBUF + pj * REC + psub * 32;
          *(LAS f32x4*)(rec + V_R * 256) = cvt_lo4(pf[0].x, pf[0].y); *(LAS f32x4*)(rec + V_R * 256 + 16) = cvt_lo4(pf[0].z, pf[0].w);
          { const f32x4 v0 = cvt_lo4(pf[2].x, pf[2].y), v1 = cvt_lo4(pf[2].z, pf[2].w);
#pragma unroll
            for (int e = 0; e < 4; ++e) { *(LAS float*)(lds + L_VT + vt_off(8 * psub + e, pj)) = v0[e]; *(LAS float*)(lds + L_VT + vt_off(8 * psub + 4 + e, pj)) = v1[e]; } }
          const f32x4 k0 = cvt_lo4(pf[1].x, pf[1].y), k1 = cvt_lo4(pf[1].z, pf[1].w);
          *(LAS f32x4*)(rec + V_K * 256) = k0; *(LAS f32x4*)(rec + V_K * 256 + 16) = k1;
          float ss = 0.f;
#pragma unroll
          for (int e = 0; e < 4; ++e) { const float x0 = k0[e] * rkk8[e], x1 = k1[e] * rkk8[4 + e]; ss += x0 * x0 + x1 * x1; }
          ss += dpp_xor1(ss); ss += dpp_xor2(ss); ss += __shfl_xor(ss, 4);
          if (psub == 0) *(LAS float*)(lds + L_INV + pj * 4) = 1.0f / fmaxf(sqrtf(ss), 1e-12f);
          *(LAS u32x4*)(lds + L_TW + pj * PT + psub * 16) = pf[3]; *(LAS u32x4*)(lds + L_AL + pj * PT + psub * 16) = pf[4]; }
        __syncthreads();
        if (c + 1 < nchunk) RW_PREFETCH(c + 1);
#pragma unroll
        for (int cc = 0; cc < 2; ++cc) { const int ct = 2 * half + cc; const int cidx = 16 * ct + fr;
            f32x4 aw = (f32x4){0.f, 0.f, 0.f, 0.f}, aa = (f32x4){0.f, 0.f, 0.f, 0.f};
#pragma unroll
            for (int ks = 0; ks < 2; ++ks) { aw = ml::mma(ml::frag(lds, L_TW, PT, 16 * rt, 32 * ks, lane), bw[cc][ks], aw); aa = ml::mma(ml::frag(lds, L_AL, PT, 16 * rt, 32 * ks, lane), ba[cc][ks], aa); }
#pragma unroll
            for (int r = 0; r < 4; ++r) { const int tok = 16 * rt + 4 * fq + r; LAS float* rec = (LAS float*)(lds + L_SBUF + tok * REC) + cidx;
                const float decay = __expf(-0.6065306597126334f * pg8::fsigmoid(c_w0[cc] + aw[r])); const float alpha = pg8::fsigmoid(c_a0[cc] + aa[r]);
                const float kraw = rec[V_K * 64]; const float kkn = kraw * c_kk[cc] * *(LAS float*)(lds + L_INV + tok * 4);
                rec[V_A * 64] = -kkn; rec[V_W * 64] = decay; rec[V_B * 64] = kkn * alpha; rec[V_K * 64] = kraw * (1.0f + (alpha - 1.0f) * c_ka[cc]); } }
        __syncthreads();
        {
            const LAS unsigned char* rbase = lds + L_SBUF + col0 * 4;
            f32x2 ca = *(const LAS f32x2*)(rbase + V_A * 256), cw = *(const LAS f32x2*)(rbase + V_W * 256), cb = *(const LAS f32x2*)(rbase + V_B * 256),
                  ck = *(const LAS f32x2*)(rbase + V_K * 256), cr = *(const LAS f32x2*)(rbase + V_R * 256);
#pragma unroll 1
            for (int blk = 0; blk < 4; ++blk) {
                float ykeep = 0.f;
#pragma unroll
                for (int g4 = 0; g4 < 4; ++g4) {
                    const f32x4 v4 = *(const LAS f32x4*)(lds + L_VT + vt_off(row, 16 * blk + 4 * g4));
#pragma unroll
                    for (int i4 = 0; i4 < 4; ++i4) {
                        const int i = 4 * g4 + i4, tt = 16 * blk + i, tn = tt < 63 ? tt + 1 : 63;
                        const LAS unsigned char* rn = rbase + tn * REC;
                        const f32x2 na = *(const LAS f32x2*)(rn + V_A * 256), nw = *(const LAS f32x2*)(rn + V_W * 256), nb = *(const LAS f32x2*)(rn + V_B * 256),
                                    nk = *(const LAS f32x2*)(rn + V_K * 256), nr = *(const LAS f32x2*)(rn + V_R * 256);
                        const float vv = v4[i4];
                        const f32x2 p = S2 * ca;
                        const float sa = allsum32(p.x + p.y);
                        S2 = S2 * cw + ck * vv;
                        S2 = cb * sa + S2;
                        const f32x2 yq = S2 * cr;
                        const float y = allsum32(yq.x + yq.y);
                        ykeep = (cg == i) ? y : ykeep;
                        ca = na; cw = nw; cb = nb; ck = nk; cr = nr;
                    }
                }
                if (hh == 0) *(LAS float*)(lds + L_YS + ((16 * blk + cg) * 16 + 2 * w + rsel) * 4) = ykeep;
            }
        }
        __syncthreads();
        if (tid < 128) { const int j = tid >> 1, pc = tid & 1; const LAS float* ys = (const LAS float*)(lds + L_YS) + j * 16 + 8 * pc;
            u32x4 o; o.x = pg8::cvt_pk_bf16(ys[0], ys[1]); o.y = pg8::cvt_pk_bf16(ys[2], ys[3]); o.z = pg8::cvt_pk_bf16(ys[4], ys[5]); o.w = pg8::cvt_pk_bf16(ys[6], ys[7]);
            *(u32x4*)(U + RW_TOK(c, j) * PU + OFF_R + dir * RW + hc + 16 * rh + 8 * pc) = o; }
    }
    if (!q.grid) { const size_t sb = (((size_t)q.b * DEPTH + l) * 2 + dir) * RH + head; *(f32x2*)(P.out + OUT_S + (sb * 64 + row) * 64 + col0) = S2; }
    __syncthreads();
#undef RW_TOK
#undef RW_PREFETCH
}
constexpr int N_ITEMS = NSEQ * RH * 2 * 4;
__device__ __forceinline__ void decode_item(int it, int& s, int& head, int& dir, int& rh) {
    rh = it & 3; int ch = it >> 2; dir = ch & 1; ch >>= 1; head = ch % RH; const int sq = ch / RH;
    s = sq < LB ? CB + sq : sq - LB;
}
}


namespace wy {
typedef short bf16x8 __attribute__((ext_vector_type(8)));
typedef float f32x4 __attribute__((ext_vector_type(4)));
typedef unsigned u32x4 __attribute__((ext_vector_type(4)));
constexpr int PV = 144, PS = 48;
constexpr int L_AH = 0, L_RH = L_AH + 64 * PV, L_BH = L_RH + 64 * PV, L_KH = L_BH + 64 * PV, L_BT = L_KH + 64 * PV, L_KT = L_BT + 64 * PV, L_VS = L_KT + 64 * PV,
              L_SS = L_VS + 64 * PV, L_YS = L_SS + 64 * PV, L_TW = L_YS + 64 * PV, L_AL = L_TW + 64 * PV, L_NAB = L_AL + 64 * PV, L_NAKT = L_NAB + 4096,
              L_NRKT = L_NAKT + 4 * 16 * PS, L_NRBT = L_NRKT + 4 * 16 * PS, L_TT = L_NRBT + 4 * 16 * PS, L_XS = L_TT + 4 * 16 * PS, L_US = L_XS + 64 * PS, L_GL = L_US + 64 * PS,
              L_INV = L_GL + 1024, L_END = L_INV + 256;
static_assert(L_END <= 131072, "WY LDS map");
__device__ __forceinline__ bf16x8 fragk16(LAS unsigned char* lds, int base, int pitch, int row0, int k0, int lane) {
    const bf16x8 v = *(const LAS bf16x8*)(lds + base + (row0 + (lane & 15)) * pitch + (k0 + 8 * ((lane >> 4) & 1)) * 2);
    const bf16x8 z = {0, 0, 0, 0, 0, 0, 0, 0};
    return (lane < 32) ? v : z;
}
__device__ __forceinline__ void stb(LAS unsigned char* lds, int off, float v) { *(LAS bf16*)(lds + off) = f2bf(v); }
typedef unsigned u32x2 __attribute__((ext_vector_type(2)));
__device__ __forceinline__ bf16x8 pack_k16(const f32x4 v) { u32x4 o; o.x = pg8::cvt_pk_bf16(v[0], v[1]); o.y = pg8::cvt_pk_bf16(v[2], v[3]); o.z = 0u; o.w = 0u; return __builtin_bit_cast(bf16x8, o); }
__device__ __forceinline__ bf16x8 pack_k32(const f32x4 a, const f32x4 b) { u32x4 o; o.x = pg8::cvt_pk_bf16(a[0], a[1]); o.y = pg8::cvt_pk_bf16(a[2], a[3]); o.z = pg8::cvt_pk_bf16(b[0], b[1]); o.w = pg8::cvt_pk_bf16(b[2], b[3]);
    return __builtin_bit_cast(bf16x8, o); }
__device__ __forceinline__ bf16x8 ld_k16(LAS unsigned char* lds, int base, int pitch, int row0, int col0, int lane) {
    const u32x2 v = *(const LAS u32x2*)(lds + base + (row0 + (lane & 15)) * pitch + (col0 + 4 * (lane >> 4)) * 2); u32x4 o; o.x = v.x; o.y = v.y; o.z = 0u; o.w = 0u; return __builtin_bit_cast(bf16x8, o); }
__device__ __forceinline__ bf16x8 ld_k32(LAS unsigned char* lds, int base, int pitch, int row0, int col0, int lane) {
    const LAS unsigned char* p = lds + base + (row0 + (lane & 15)) * pitch + (col0 + 4 * (lane >> 4)) * 2;
    const u32x2 v0 = *(const LAS u32x2*)p, v1 = *(const LAS u32x2*)(p + 32); u32x4 o; o.x = v0.x; o.y = v0.y; o.z = v1.x; o.w = v1.y; return __builtin_bit_cast(bf16x8, o); }
__device__ __forceinline__ void rwkv_item(LAS unsigned char* lds, CParams& P, int l, int s, int head, int dir) {
    const int tid = threadIdx.x, w = __builtin_amdgcn_readfirstlane(tid >> 6), lane = tid & 63, fr = lane & 15, fq = lane >> 4;
    const int rt = w & 3, half = w >> 2, hc = head * 64;
    const SeqInfo q = seqinfo(s); const int nchunk = q.T / 64;
    const bf16* RX = WSP(bf16, WS_RXC); bf16* U = WSP(bf16, WS_U1);
    const int pj = tid >> 3, psub = tid & 7;
    f32x4 sacc[4];
#pragma unroll
    for (int ct = 0; ct < 4; ++ct) sacc[ct] = (f32x4){0.f, 0.f, 0.f, 0.f};
    if (w < 4 && q.grid) { const size_t sb = (((size_t)q.b * DEPTH + l) * 2 + dir) * RH + head;
#pragma unroll
        for (int ct = 0; ct < 4; ++ct) sacc[ct] = *(const f32x4*)(P.in[ST_R] + (sb * 64 + 16 * w + fr) * 64 + 16 * ct + 4 * fq); }
    float rkk8[8];
#pragma unroll
    for (int e = 0; e < 8; ++e) rkk8[e] = P.in[R_KK][(size_t)l * RW + hc + 8 * psub + e];
    float c_w0[2], c_a0[2], c_kk[2], c_ka[2];
#pragma unroll
    for (int cc = 0; cc < 2; ++cc) { const int c = 16 * (2 * half + cc) + fr;
        c_w0[cc] = P.in[R_W0][((size_t)l * 2 + dir) * RW + hc + c]; c_a0[cc] = P.in[R_A0][((size_t)l * 2 + dir) * RW + hc + c];
        c_kk[cc] = P.in[R_KK][(size_t)l * RW + hc + c]; c_ka[cc] = P.in[R_KA][(size_t)l * RW + hc + c]; }
    const bf16* w2t = WSP(bf16, O_W2T) + ((size_t)dir * RW + hc) * 64; const bf16* a2t = WSP(bf16, O_A2T) + ((size_t)dir * RW + hc) * 64;
    u32x4 pf[5];
#define WY_TOK(c, j) ((size_t)(q.base + (dir ? q.T - 1 - ((c) * 64 + (j)) : ((c) * 64 + (j)))))
#define WY_PREFETCH(c) do { const bf16* rx = RX + WY_TOK(c, pj) * RIN + 8 * psub; \
        pf[0] = *(const u32x4*)(rx + RX_R + hc); pf[1] = *(const u32x4*)(rx + RX_K + hc); pf[2] = *(const u32x4*)(rx + RX_V + hc); \
        pf[3] = *(const u32x4*)(rx + RX_WL + dir * 64); pf[4] = *(const u32x4*)(rx + RX_AL + dir * 64); } while (0)
    WY_PREFETCH(0);
    for (int c = 0; c < nchunk; ++c) {
        { *(LAS u32x4*)(lds + L_RH + pj * PV + psub * 16) = pf[0]; *(LAS u32x4*)(lds + L_KH + pj * PV + psub * 16) = pf[1];
          const unsigned kw[4] = {pf[1].x, pf[1].y, pf[1].z, pf[1].w}, vw[4] = {pf[2].x, pf[2].y, pf[2].z, pf[2].w};
          float ss = 0.f;
#pragma unroll
          for (int e = 0; e < 8; ++e) { const float kf = __builtin_bit_cast(float, (e & 1) ? (kw[e >> 1] & 0xffff0000u) : (kw[e >> 1] << 16)) * rkk8[e]; ss += kf * kf;
              *(LAS bf16*)(lds + L_VS + (8 * psub + e) * PV + pj * 2) = (bf16)((vw[e >> 1] >> ((e & 1) * 16)) & 0xffffu); }
          ss += rw::dpp_xor1(ss); ss += rw::dpp_xor2(ss); ss += __shfl_xor(ss, 4);
          if (psub == 0) *(LAS float*)(lds + L_INV + pj * 4) = 1.0f / fmaxf(sqrtf(ss), 1e-12f);
          *(LAS u32x4*)(lds + L_TW + pj * PV + psub * 16) = pf[3]; *(LAS u32x4*)(lds + L_AL + pj * PV + psub * 16) = pf[4]; }
        LDS_BARRIER();
        if (c + 1 < nchunk) WY_PREFETCH(c + 1);
#pragma unroll
        for (int cc = 0; cc < 2; ++cc) { const int ct = 2 * half + cc; const int cidx = 16 * ct + fr;
            f32x4 aw = (f32x4){0.f, 0.f, 0.f, 0.f}, aa = (f32x4){0.f, 0.f, 0.f, 0.f};
#pragma unroll
            for (int ks = 0; ks < 2; ++ks) { const size_t bo = (size_t)cidx * 64 + 32 * ks + 8 * fq;
                aw = ml::mma(ml::frag(lds, L_TW, PV, 16 * rt, 32 * ks, lane), *(const bf16x8*)(w2t + bo), aw); aa = ml::mma(ml::frag(lds, L_AL, PV, 16 * rt, 32 * ks, lane), *(const bf16x8*)(a2t + bo), aa); }
            float kr4[4], rr4[4], iv4[4];
#pragma unroll
            for (int r = 0; r < 4; ++r) { const int tok = 16 * rt + 4 * fq + r; kr4[r] = bf2f(*(const LAS bf16*)(lds + L_KH + tok * PV + cidx * 2)); rr4[r] = bf2f(*(const LAS bf16*)(lds + L_RH + tok * PV + cidx * 2));
                iv4[r] = *(const LAS float*)(lds + L_INV + tok * 4); }
            float lw[4], cum[4];
#pragma unroll
            for (int r = 0; r < 4; ++r) { lw[r] = -0.6065306597126334f * pg8::fsigmoid(c_w0[cc] + aw[r]); cum[r] = (r ? cum[r - 1] : 0.f) + lw[r]; }
            const float tot = cum[3]; const float p1 = __shfl_up(tot, 16), p2 = __shfl_up(tot, 32), p3 = __shfl_up(tot, 48);
            const float off = (fq >= 1 ? p1 : 0.f) + (fq >= 2 ? p2 : 0.f) + (fq >= 3 ? p3 : 0.f);
            float gprev = __expf(off);
#pragma unroll
            for (int r = 0; r < 4; ++r) { const int tok = 16 * rt + 4 * fq + r; const float lam = off + cum[r]; const float g = __expf(lam), gi = __builtin_amdgcn_rcpf(g);
                const float alpha = pg8::fsigmoid(c_a0[cc] + aa[r]);
                const float kraw = kr4[r], rraw = rr4[r];
                const float kkn = kraw * c_kk[cc] * iv4[r];
                const bf16 bh = f2bf(kkn * alpha * gi), kh = f2bf(kraw * (1.0f + (alpha - 1.0f) * c_ka[cc]) * gi);
                stb(lds, L_AH + tok * PV + cidx * 2, -kkn * gprev); stb(lds, L_RH + tok * PV + cidx * 2, rraw * g);
                *(LAS bf16*)(lds + L_BH + tok * PV + cidx * 2) = bh; *(LAS bf16*)(lds + L_KH + tok * PV + cidx * 2) = kh;
                *(LAS bf16*)(lds + L_BT + cidx * PV + tok * 2) = bh; *(LAS bf16*)(lds + L_KT + cidx * PV + tok * 2) = kh;
                if (fq == 3 && r == 3) *(LAS float*)(lds + L_GL + (rt * 64 + cidx) * 4) = g;
                gprev = g; } }
        LDS_BARRIER();
        { const int sc = w >> 1, side = w & 1; f32x4 gB = (f32x4){0.f, 0.f, 0.f, 0.f}, gK = (f32x4){0.f, 0.f, 0.f, 0.f};
#pragma unroll
          for (int ks = 0; ks < 2; ++ks) { const bf16x8 af = ml::frag(lds, side ? L_RH : L_AH, PV, 16 * sc, 32 * ks, lane);
              gB = ml::mma(af, ml::frag(lds, L_BH, PV, 16 * sc, 32 * ks, lane), gB); gK = ml::mma(af, ml::frag(lds, L_KH, PV, 16 * sc, 32 * ks, lane), gK); }
#pragma unroll
          for (int r = 0; r < 4; ++r) { const int t = 4 * fq + r; const bool keep = side ? (fr <= t) : (fr < t); const float vB = keep ? gB[r] : 0.f, vK = keep ? gK[r] : 0.f;
              if (side == 0) { *(LAS float*)(lds + L_NAB + ((sc * 16 + t) * 16 + fr) * 4) = vB; stb(lds, L_NAKT + (sc * 16 + t) * PS + fr * 2, vK); }
              else { stb(lds, L_NRBT + (sc * 16 + t) * PS + fr * 2, vB); stb(lds, L_NRKT + (sc * 16 + t) * PS + fr * 2, vK); } } }
        if ((w & 1) == 0 && lane < 16) { const int sc = w >> 1; float Tr[16];
            asm volatile("" ::: "memory");
#pragma unroll
            for (int ph = 0; ph < 4; ++ph) { f32x4 nv[4][4];
#pragma unroll
                for (int tq = 0; tq < 4; ++tq)
#pragma unroll
                    for (int u4 = 0; u4 <= ph; ++u4) nv[tq][u4] = *(const LAS f32x4*)(lds + L_NAB + ((sc * 16 + 4 * ph + tq) * 16 + 4 * u4) * 4);
#pragma unroll
                for (int tq = 0; tq < 4; ++tq) { const int t = 4 * ph + tq; float x0 = (lane == t) ? 1.f : 0.f, x1 = 0.f;
#pragma unroll
                    for (int u = 0; u < 16; ++u) if (u < t) { if (u & 1) x1 += Tr[u] * nv[tq][u >> 2][u & 3]; else x0 += Tr[u] * nv[tq][u >> 2][u & 3]; }
                    Tr[t] = x0 + x1; stb(lds, L_TT + (sc * 16 + t) * PS + lane * 2, Tr[t]); } } }
        LDS_BARRIER();
        if (w < 4) {
#pragma unroll 1
            for (int sc = 0; sc < 4; ++sc) {
                const bf16x8 ah0 = ld_k32(lds, L_AH, PV, 16 * sc, 0, lane), ah1 = ld_k32(lds, L_AH, PV, 16 * sc, 32, lane), rh0 = ld_k32(lds, L_RH, PV, 16 * sc, 0, lane), rh1 = ld_k32(lds, L_RH, PV, 16 * sc, 32, lane);
                const bf16x8 nak = ld_k16(lds, L_NAKT, PS, 16 * sc, 0, lane), nrk = ld_k16(lds, L_NRKT, PS, 16 * sc, 0, lane), ttf = ld_k16(lds, L_TT, PS, 16 * sc, 0, lane), nrb = ld_k16(lds, L_NRBT, PS, 16 * sc, 0, lane);
                const bf16x8 vsf = ld_k16(lds, L_VS, PV, 16 * w, 16 * sc, lane);
                bf16x8 btf[4], ktf[4]; f32x4 glv[4];
#pragma unroll
                for (int ct = 0; ct < 4; ++ct) { btf[ct] = ld_k16(lds, L_BT, PV, 16 * ct, 16 * sc, lane); ktf[ct] = ld_k16(lds, L_KT, PV, 16 * ct, 16 * sc, lane);
                    glv[ct] = *(const LAS f32x4*)(lds + L_GL + (sc * 64 + 16 * ct + 4 * fq) * 4); }
                const bf16x8 sb0 = pack_k32(sacc[0], sacc[1]), sb1 = pack_k32(sacc[2], sacc[3]);
                f32x4 XT = (f32x4){0.f, 0.f, 0.f, 0.f}, YT = (f32x4){0.f, 0.f, 0.f, 0.f};
                XT = ml::mma(ah0, sb0, XT); XT = ml::mma(ah1, sb1, XT); XT = ml::mma(nak, vsf, XT);
                YT = ml::mma(rh0, sb0, YT); YT = ml::mma(rh1, sb1, YT); YT = ml::mma(nrk, vsf, YT);
                f32x4 UT = (f32x4){0.f, 0.f, 0.f, 0.f};
                UT = ml::mma(ttf, pack_k16(XT), UT);
                const bf16x8 ub = pack_k16(UT);
                YT = ml::mma(nrb, ub, YT);
#pragma unroll
                for (int r = 0; r < 4; ++r) stb(lds, L_YS + (16 * sc + 4 * fq + r) * PV + (16 * w + fr) * 2, YT[r]);
#pragma unroll
                for (int ct = 0; ct < 4; ++ct) { sacc[ct] = ml::mma(btf[ct], ub, sacc[ct]); sacc[ct] = ml::mma(ktf[ct], vsf, sacc[ct]); sacc[ct] = sacc[ct] * glv[ct]; }
            }
        }
        LDS_BARRIER();
        *(u32x4*)(U + WY_TOK(c, pj) * PU + OFF_R + dir * RW + hc + 8 * psub) = *(const LAS u32x4*)(lds + L_YS + pj * PV + psub * 16);
    }
    if (!q.grid && w < 4) { const size_t sb = (((size_t)q.b * DEPTH + l) * 2 + dir) * RH + head;
#pragma unroll
        for (int ct = 0; ct < 4; ++ct) *(f32x4*)(P.out + OUT_S + (sb * 64 + 16 * w + fr) * 64 + 16 * ct + 4 * fq) = sacc[ct]; }
    LDS_BARRIER();
#undef WY_TOK
#undef WY_PREFETCH
}
constexpr int N_ITEMS = NSEQ * RH * 2;
__device__ __forceinline__ void decode_item(int it, int& s, int& head, int& dir) {
    dir = it & 1; int ch = it >> 1; head = ch % RH; const int sq = ch / RH;
    s = sq < LB ? CB + sq : sq - LB;
}
}

namespace el {
typedef float f32x4 __attribute__((ext_vector_type(4)));
typedef unsigned u32x4 __attribute__((ext_vector_type(4)));
typedef unsigned u32x2 __attribute__((ext_vector_type(2)));
typedef short bf16x8 __attribute__((ext_vector_type(8)));
__device__ __forceinline__ float wave_sum(float v) {
#pragma unroll
    for (int o = 1; o < 64; o <<= 1) v += __shfl_xor(v, o);
    return v;
}
__device__ __forceinline__ void unpack8(const u32x4 p, float (&f)[8]) {
    f[0] = pg8::bflo(p.x); f[1] = pg8::bfhi(p.x); f[2] = pg8::bflo(p.y); f[3] = pg8::bfhi(p.y); f[4] = pg8::bflo(p.z); f[5] = pg8::bfhi(p.z); f[6] = pg8::bflo(p.w); f[7] = pg8::bfhi(p.w);
}
__device__ __forceinline__ u32x4 pack8(const float (&f)[8]) {
    u32x4 o; o.x = pg8::cvt_pk_bf16(f[0], f[1]); o.y = pg8::cvt_pk_bf16(f[2], f[3]); o.z = pg8::cvt_pk_bf16(f[4], f[5]); o.w = pg8::cvt_pk_bf16(f[6], f[7]); return o;
}
__device__ __forceinline__ void init_phase(LAS unsigned char* lds, CParams& P, int vb, int G) {
    const int tid = threadIdx.x, w = tid >> 6, lane = tid & 63;
    { const size_t n4 = (size_t)NT * D / 4, nc4 = (size_t)NC * D / 4; f32x4* o = (f32x4*)P.out; const f32x4* a = (const f32x4*)P.in[X_PROMPT]; const f32x4* b = (const f32x4*)P.in[X_SAMPLE];
      for (size_t i = (size_t)vb * 512 + tid; i < n4; i += (size_t)G * 512) o[i] = i < nc4 ? a[i] : b[i - nc4]; }
    LAS float* red = (LAS float*)lds;
    constexpr int KW = D / 8;
    for (int it = vb; it < DEPTH * (6 * D / 64); it += G) {
        const int l = it / (6 * D / 64), j = (it % (6 * D / 64)) * 64 + lane;
        const float* wp = P.in[ADA_W] + ((size_t)l * D + w * KW) * 6 * D + j;
        float acc[NCOND];
#pragma unroll
        for (int ci = 0; ci < NCOND; ++ci) acc[ci] = 0.f;
        for (int k = 0; k < KW; ++k) { const float wv = wp[(size_t)k * 6 * D];
#pragma unroll
            for (int ci = 0; ci < NCOND; ++ci) { const float cv = ci == 0 ? P.in[C_CTX][w * KW + k] : P.in[C_LAT][(size_t)(ci - 1) * D + w * KW + k]; acc[ci] += cv * pg8::fsigmoid(cv) * wv; } }
#pragma unroll
        for (int ci = 0; ci < NCOND; ++ci) red[(w * NCOND + ci) * 64 + lane] = acc[ci];
        __syncthreads();
        if (w < NCOND) { float sum = P.in[ADA_B][(size_t)l * 6 * D + j];
#pragma unroll
            for (int ww = 0; ww < 8; ++ww) sum += red[(ww * NCOND + w) * 64 + lane];
            WSP(float, WS_MOD)[((size_t)l * NCOND + w) * 6 * D + j] = sum; }
        __syncthreads();
    }
}
__device__ __forceinline__ int perm5(int n) { return (((n >> 2) & 1) << 4) | (((n >> 3) & 3) << 2) | (n & 3); }
__device__ __forceinline__ void transpose_item(const float* W, int ldw, int nvalid, bf16* dst, int K, int k0, int drow0, bool perm, LAS float* scr, int lane) {
#pragma unroll 8
    for (int i = 0; i < 32; ++i) { const int kk = 2 * i + (lane >> 5), n = lane & 31; scr[kk * 33 + n] = n < nvalid ? W[(size_t)kk * ldw + n] : 0.f; }
    asm volatile("s_waitcnt lgkmcnt(0)" ::: "memory");
    const int c = lane & 7;
#pragma unroll
    for (int j = 0; j < 4; ++j) { const int n = (lane >> 3) + 8 * j; const LAS float* sp = scr + (8 * c) * 33 + n;
        u32x4 o; o.x = pg8::cvt_pk_bf16(sp[0 * 33], sp[1 * 33]); o.y = pg8::cvt_pk_bf16(sp[2 * 33], sp[3 * 33]); o.z = pg8::cvt_pk_bf16(sp[4 * 33], sp[5 * 33]); o.w = pg8::cvt_pk_bf16(sp[6 * 33], sp[7 * 33]);
        *(u32x4*)(dst + (size_t)(drow0 + (perm ? perm5(n) : n)) * K + k0 + 8 * c) = o; }
    asm volatile("s_waitcnt lgkmcnt(0)" ::: "memory");
}
constexpr int WI_0 = (N1P / 32) * (D / 64), WI_1 = WI_0 + (2 * D / 32) * (D / 64), WI_2 = WI_1 + (D / 32) * (MW / 64), WI_3 = WI_2 + (D / 32) * (RW / 64),
              WI_4 = WI_3 + (D / 32) * (D / 64), WI_5 = WI_4 + 2 * (FF / 32) * (D / 64), WI_6 = WI_5 + (D / 32) * (FF / 64), WI_7 = WI_6 + (RW / 32) * (128 / 64), WI_8 = WI_7 + 4 * (RW / 32);
__device__ __forceinline__ void wconv_phase(LAS unsigned char* lds, CParams& P, int l, int vb, int G) {
    const int tid = threadIdx.x, w = tid >> 6, lane = tid & 63;
    LAS float* scr = (LAS float*)(lds + w * 8704);
    for (int it = vb * 8 + w; it < WI_8; it += G * 8) {
        if (it < WI_0) { const int nb = it / (D / 64), kb = it % (D / 64); const int n0 = nb * 32; const int nv = n0 >= N1 ? 0 : (N1 - n0 < 32 ? N1 - n0 : 32);
            transpose_item(P.in[W_IN] + ((size_t)l * D + kb * 64) * PIN + n0, PIN, nv, WSP(bf16, O_WIN1), D, kb * 64, n0, true, scr, lane); }
        else if (it < WI_1) { const int r = it - WI_0, nb = r / (D / 64), kb = r % (D / 64);
            transpose_item(P.in[W_IN] + ((size_t)l * D + kb * 64) * PIN + N1 + nb * 32, PIN, 32, WSP(bf16, O_WIN2), D, kb * 64, nb * 32, true, scr, lane); }
        else if (it < WI_2) { const int r = it - WI_1, nb = r / (MW / 64), kb = r % (MW / 64);
            transpose_item(P.in[PROJ_M] + ((size_t)l * MW + kb * 64) * D + nb * 32, D, 32, WSP(bf16, O_PM), MW, kb * 64, nb * 32, true, scr, lane); }
        else if (it < WI_3) { const int r = it - WI_2, nb = r / (RW / 64), kb = r % (RW / 64);
            transpose_item(P.in[PROJ_R] + ((size_t)l * RW + kb * 64) * D + nb * 32, D, 32, WSP(bf16, O_PR), RW, kb * 64, nb * 32, true, scr, lane); }
        else if (it < WI_4) { const int r = it - WI_3, nb = r / (D / 64), kb = r % (D / 64);
            transpose_item(P.in[W_OUT] + ((size_t)l * D + kb * 64) * D + nb * 32, D, 32, WSP(bf16, O_WO), D, kb * 64, nb * 32, false, scr, lane); }
        else if (it < WI_5) { const int r = it - WI_4, which = r / ((FF / 32) * (D / 64)), r2 = r % ((FF / 32) * (D / 64)), nb = r2 / (D / 64), kb = r2 % (D / 64);
            const int j0 = nb * 32, pn = j0 >> 7, drow0 = pn * 256 + which * 128 + (j0 & 127);
            transpose_item((which ? P.in[FFN_W3] : P.in[FFN_W1]) + ((size_t)l * D + kb * 64) * FF + j0, FF, 32, WSP(bf16, O_W13), D, kb * 64, drow0, true, scr, lane); }
        else if (it < WI_6) { const int r = it - WI_5, nb = r / (FF / 64), kb = r % (FF / 64);
            transpose_item(P.in[FFN_W2] + ((size_t)l * FF + kb * 64) * D + nb * 32, D, 32, WSP(bf16, O_W2), FF, kb * 64, nb * 32, false, scr, lane); }
        else if (it < WI_7) { const int r = it - WI_6, nb = r / 2, kb = r % 2;
            transpose_item(P.in[R_G2] + ((size_t)l * 128 + kb * 64) * RW + nb * 32, RW, 32, WSP(bf16, O_G2T), 128, kb * 64, nb * 32, false, scr, lane); }
        else { const int r = it - WI_7, which = r / (2 * (RW / 32)), d = (r / (RW / 32)) & 1, nb = r % (RW / 32);
            transpose_item((which ? P.in[R_A2] : P.in[R_W2]) + ((size_t)l * 2 + d) * 64 * RW + nb * 32, RW, 32, WSP(bf16, which ? O_A2T : O_W2T) + (size_t)d * RW * 64, 64, 0, nb * 32, false, scr, lane); }
    }
}
__device__ __forceinline__ void norm_phase(CParams& P, int l, int mode, int vb, int G) {
    const int tid = threadIdx.x, w = tid >> 6, lane = tid & 63;
    for (int m = vb * 8 + w; m < NT; m += G * 8) {
        float* xr = P.out + (size_t)m * D;
        f32x4 v[D / 256]; float ss = 0.f;
#pragma unroll
        for (int j = 0; j < D / 256; ++j) { v[j] = *(const f32x4*)(xr + 256 * j + 4 * lane); ss += (v[j][0] * v[j][0] + v[j][1] * v[j][1]) + (v[j][2] * v[j][2] + v[j][3] * v[j][3]); }
        const float rs = 1.0f / sqrtf(wave_sum(ss) * (1.0f / D) + RMS_EPS);
        if (mode == 3) {
#pragma unroll
            for (int j = 0; j < D / 256; ++j) { const f32x4 g = *(const f32x4*)(P.in[FINAL_G] + 256 * j + 4 * lane); *(f32x4*)(xr + 256 * j + 4 * lane) = v[j] * rs * g; }
        } else {
            const int second = (mode == 2); const int cond = seqinfo(seq_of_token(m)).cond;
            const float* gp = P.in[second ? NORM2 : NORM1] + (size_t)l * D; const float* mod = WSP(float, WS_MOD) + ((size_t)l * NCOND + cond) * 6 * D + (second ? 3 * D : 0);
            bf16* o = WSP(bf16, mode == 1 ? WS_RXC : WS_QKC) + (size_t)m * D;
#pragma unroll
            for (int j = 0; j < D / 256; ++j) { const int c = 256 * j + 4 * lane; const f32x4 g = *(const f32x4*)(gp + c), sh = *(const f32x4*)(mod + c), sc = *(const f32x4*)(mod + D + c);
                const f32x4 y = v[j] * rs * g * (sc + 1.0f) + sh; u32x2 pk; pk.x = pg8::cvt_pk_bf16(y[0], y[1]); pk.y = pg8::cvt_pk_bf16(y[2], y[3]); *(u32x2*)(o + c) = pk; }
        }
    }
}
constexpr int CV_NCH = 2 * MW + RIN, CV_NG = CV_NCH / 4, CV_NCHUNK = (CV_NG + 63) / 64, CV_SEG = 16, CV_PAIRS = NC / (2 * CV_SEG);
static_assert(CV_NCHUNK == 12 && NC == NT - NC && GW % CV_SEG == 0 && CT % CV_SEG == 0 && 2 * MW == 1024 && RX_WL == 1536, "conv item layout");
typedef float f32x2 __attribute__((ext_vector_type(2)));
struct CvAct { float alpha, cA, cB, cC, cD; bool any; };
template <int NR> struct CvState { f32x2 wt[NR * 3][2]; f32x2 fw[NR][3][2]; u32x2 p[3][NR]; };
__device__ __forceinline__ void cv_unpk(const u32x2 p, f32x2 (&f)[2]) { f[0].x = pg8::bflo(p.x); f[0].y = pg8::bfhi(p.x); f[1].x = pg8::bflo(p.y); f[1].y = pg8::bfhi(p.y); }
template <int NR> __device__ __forceinline__ u32x2 cv_ld(const bf16* const (&rowp)[NR], const bool (&rok)[NR], int a, int col, int W) {
    const u32x2 zero2 = {0u, 0u};
    return (rok[a] && col >= 0 && col < W) ? *(const u32x2*)(rowp[a] + (size_t)col * PU) : zero2;
}
template <int NR, int S> __device__ __forceinline__ void cv_col(CvState<NR>& st, const bf16* const (&rowp)[NR], const bool (&rok)[NR], int cs, int W, int o, const CvAct& act, bf16* dst) {
#pragma unroll
    for (int a = 0; a < NR; ++a) { cv_unpk(st.p[S][a], st.fw[a][(S + 2) % 3]); const u32x2 zero2 = {0u, 0u}; st.p[S][a] = (o + 4 <= CV_SEG) ? cv_ld<NR>(rowp, rok, a, cs + o + 4, W) : zero2; }
    f32x2 acc[2];
#pragma unroll
    for (int e = 0; e < 2; ++e) acc[e] = st.wt[0][e] * st.fw[0][S][e];
#pragma unroll
    for (int a = 0; a < NR; ++a)
#pragma unroll
        for (int b = 0; b < 3; ++b) if (a + b > 0) {
#pragma unroll
            for (int e = 0; e < 2; ++e) acc[e] = __builtin_elementwise_fma(st.wt[a * 3 + b][e], st.fw[a][(S + b) % 3][e], acc[e]); }
    float v[4] = {acc[0].x, acc[0].y, acc[1].x, acc[1].y};
    if (act.any) {
#pragma unroll
        for (int e = 0; e < 4; ++e) { const float t = __builtin_amdgcn_rcpf(__builtin_amdgcn_exp2f(act.alpha * v[e]) + 1.0f); v[e] = (act.cA * v[e] + act.cB) * t + (act.cC * v[e] + act.cD); }
    }
    u32x2 pk; pk.x = pg8::cvt_pk_bf16(v[0], v[1]); pk.y = pg8::cvt_pk_bf16(v[2], v[3]);
    *(u32x2*)dst = pk;
}
template <int NR> __device__ __forceinline__ void conv_item(const bf16* const (&rowp)[NR], const bool (&rok)[NR], int cs, int W, const float* wsrc, int CH, const CvAct& act, bf16* dst, int dpitch) {
    CvState<NR> st;
#pragma unroll
    for (int a = 0; a < NR * 3; ++a) { const int tap = NR == 3 ? a : 3 + a; const f32x4 w0 = *(const f32x4*)(wsrc + (size_t)tap * CH);
        st.wt[a][0].x = w0[0]; st.wt[a][0].y = w0[1]; st.wt[a][1].x = w0[2]; st.wt[a][1].y = w0[3]; }
#pragma unroll
    for (int a = 0; a < NR; ++a) { cv_unpk(cv_ld<NR>(rowp, rok, a, cs - 1, W), st.fw[a][0]); cv_unpk(cv_ld<NR>(rowp, rok, a, cs, W), st.fw[a][1]); }
#pragma unroll
    for (int s3 = 0; s3 < 3; ++s3)
#pragma unroll
        for (int a = 0; a < NR; ++a) st.p[s3][a] = cv_ld<NR>(rowp, rok, a, cs + 1 + s3, W);
#pragma unroll 1
    for (int o = 0; o < CV_SEG - 1; o += 3) {
        cv_col<NR, 0>(st, rowp, rok, cs, W, o, act, dst + (size_t)o * dpitch);
        cv_col<NR, 1>(st, rowp, rok, cs, W, o + 1, act, dst + (size_t)(o + 1) * dpitch);
        cv_col<NR, 2>(st, rowp, rok, cs, W, o + 2, act, dst + (size_t)(o + 2) * dpitch);
    }
    cv_col<NR, 0>(st, rowp, rok, cs, W, CV_SEG - 1, act, dst + (size_t)(CV_SEG - 1) * dpitch);
}
__device__ __forceinline__ void conv_phase(LAS unsigned char* lds, CParams& P, int l, int vb, int G) {
    const int tid = threadIdx.x, lane = tid & 63;
    const bf16* U = WSP(bf16, WS_U1);
    LAS unsigned* cnt = (LAS unsigned*)lds;
    for (int sp = vb; sp < CV_PAIRS; sp += G) {
        __syncthreads();
        if (tid == 0) *cnt = 0u;
        __syncthreads();
        for (;;) {
            unsigned j = 0; if (lane == 0) j = __hip_atomic_fetch_add(cnt, 1u, __ATOMIC_RELAXED, __HIP_MEMORY_SCOPE_WORKGROUP);
            j = __builtin_amdgcn_readfirstlane(j);
            if (j >= 48u) break;
            const int cls = j / 12, jj = j % 12, lat = (cls & 1) == 0, heavy = cls < 2, ci = jj >> 1, chunk = heavy ? (ci >= 4 ? 6 + ci : ci) : 4 + ci;
            const int seg = (lat ? NC / CV_SEG : 0) + 2 * sp + (jj & 1), g = chunk * 64 + lane;
            if (g >= CV_NG) continue;
            const int ch = 4 * g; const bool isqk = ch < 2 * MW; const int c = isqk ? ch : ch - 2 * MW;
            const int ucol = isqk ? OFF_QK + c : OFF_R + c, CH = isqk ? 2 * MW : RIN;
            const float* wsrc = (isqk ? P.in[M_CONV] : P.in[R_CONV]) + (size_t)l * 9 * CH + c;
            const int kind = isqk ? (c < MW ? 0 : 1) : (c >= RX_GL ? 4 : (c >= RX_AL ? 2 : (c >= RX_WL ? 3 : 2)));
            CvAct act; act.alpha = kind == 3 ? 2.8853900817779268f : -1.4426950408889634f;
            act.cA = kind == 0 ? 0.08838834764831845f : (kind == 1 ? 1.0f : 0.0f); act.cB = kind == 3 ? -2.0f : (kind == 4 ? 1.0f : 0.0f); act.cC = kind == 2 ? 1.0f : 0.0f; act.cD = kind == 3 ? 1.0f : 0.0f;
            act.any = heavy;
            const int m0 = seg * CV_SEG; const SeqInfo q = seqinfo(seq_of_token(m0)); const int t0 = m0 - q.base;
            bf16* dst = isqk ? WSP(bf16, WS_QKC) + (size_t)m0 * (2 * MW) + c : WSP(bf16, WS_RXC) + (size_t)m0 * RIN + c; const int dpitch = isqk ? 2 * MW : RIN;
            if (q.grid) {
                const int r = t0 / GW, cs = t0 % GW, rows = q.T / GW;
                const bf16* rowp[3]; bool rok[3];
#pragma unroll
                for (int a = 0; a < 3; ++a) { const int rr = r + a - 1; rok[a] = rr >= 0 && rr < rows; rowp[a] = U + (size_t)(q.base + (rok[a] ? rr : r) * GW) * PU + ucol; }
                conv_item<3>(rowp, rok, cs, GW, wsrc, CH, act, dst, dpitch);
            } else {
                const bf16* rowp[1] = {U + (size_t)q.base * PU + ucol}; const bool rok[1] = {true};
                conv_item<1>(rowp, rok, t0, q.T, wsrc, CH, act, dst, dpitch);
            }
        }
    }
}
constexpr int PO_ITEMS = (NT / 16) * 2, PO_HC = RW / 2;
__device__ __forceinline__ void post_phase(LAS unsigned char* lds, CParams& P, int l, int vb, int G) {
    const int tid = threadIdx.x, w = tid >> 6, lane = tid & 63, fr = lane & 15, fq = lane >> 4, l32 = lane & 31, th = lane >> 5;
    constexpr int GP = PO_HC * 2 + 16;
    LAS unsigned char* gt = lds + w * (16 * GP);
    const bf16* U = WSP(bf16, WS_U1); const bf16* RX = WSP(bf16, WS_RXC); const bf16* G2T = WSP(bf16, O_G2T); bf16* O = WSP(bf16, WS_QKC);
    for (int it = vb * 8 + w; it < PO_ITEMS; it += G * 8) {
        const int tile = it >> 1, h = it & 1; const size_t tok0 = (size_t)tile * 16;
        bf16x8 af[4];
#pragma unroll
        for (int ks = 0; ks < 4; ++ks) af[ks] = *(const bf16x8*)(RX + (tok0 + fr) * RIN + RX_GL + 32 * ks + 8 * fq);
        for (int ct = 0; ct < PO_HC / 16; ++ct) { f32x4 acc = (f32x4){0.f, 0.f, 0.f, 0.f};
#pragma unroll
            for (int ks = 0; ks < 4; ++ks) acc = ml::mma(af[ks], *(const bf16x8*)(G2T + (size_t)(h * PO_HC + 16 * ct + fr) * 128 + 32 * ks + 8 * fq), acc);
#pragma unroll
            for (int r = 0; r < 4; ++r) *(LAS bf16*)(gt + (4 * fq + r) * GP + (16 * ct + fr) * 2) = f2bf(acc[r]); }
        asm volatile("s_waitcnt lgkmcnt(0)" ::: "memory");
        const int cb = h * PO_HC + 8 * l32;
        float gn[8], gw[8], gb[8], rk[8];
        { const f32x4 a0 = *(const f32x4*)(P.in[M_NORM_G] + (size_t)l * MW + cb), a1 = *(const f32x4*)(P.in[M_NORM_G] + (size_t)l * MW + cb + 4);
          const f32x4 b0 = *(const f32x4*)(P.in[R_GN_W] + (size_t)l * RW + cb), b1 = *(const f32x4*)(P.in[R_GN_W] + (size_t)l * RW + cb + 4);
          const f32x4 c0 = *(const f32x4*)(P.in[R_GN_B] + (size_t)l * RW + cb), c1 = *(const f32x4*)(P.in[R_GN_B] + (size_t)l * RW + cb + 4);
          const f32x4 d0 = *(const f32x4*)(P.in[R_RK] + (size_t)l * RW + cb), d1 = *(const f32x4*)(P.in[R_RK] + (size_t)l * RW + cb + 4);
#pragma unroll
          for (int e = 0; e < 4; ++e) { gn[e] = a0[e]; gn[4 + e] = a1[e]; gw[e] = b0[e]; gw[4 + e] = b1[e]; gb[e] = c0[e]; gb[4 + e] = c1[e]; rk[e] = d0[e]; rk[4 + e] = d1[e]; } }
        for (int tp = 0; tp < 8; ++tp) { const int tl = 2 * tp + th; const size_t m = tok0 + tl; const bf16* u = U + m * PU; const bf16* rx = RX + m * RIN;
            float hf[8], hb[8], ov[8], x[8]; unpack8(*(const u32x4*)(u + cb), hf); unpack8(*(const u32x4*)(u + MW + cb), hb); unpack8(*(const u32x4*)(u + OFF_O + cb), ov);
            float ss = 0.f;
#pragma unroll
            for (int e = 0; e < 8; ++e) { x[e] = hf[e] + hb[e]; ss += x[e] * x[e]; }
            ss = rw::allsum16(ss); const float rs = 1.0f / sqrtf(ss * (1.0f / 128.f) + RMS_EPS);
#pragma unroll
            for (int e = 0; e < 8; ++e) x[e] = x[e] * rs * gn[e] * pg8::fsigmoid(ov[e]);
            *(u32x4*)(O + m * D + cb) = pack8(x);
            float yf[8], yb[8], rr[8], kk[8], vv[8], gg[8], y[8]; unpack8(*(const u32x4*)(u + OFF_R + cb), yf); unpack8(*(const u32x4*)(u + OFF_R + RW + cb), yb);
            unpack8(*(const u32x4*)(rx + RX_R + cb), rr); unpack8(*(const u32x4*)(rx + RX_K + cb), kk); unpack8(*(const u32x4*)(rx + RX_V + cb), vv);
            unpack8(*(const LAS u32x4*)(gt + tl * GP + l32 * 16), gg);
            float mu = 0.f, bs = 0.f;
#pragma unroll
            for (int e = 0; e < 8; ++e) { y[e] = yf[e] + yb[e]; mu += y[e]; bs += rr[e] * kk[e] * rk[e]; }
            mu += rw::dpp_xor1(mu); mu += rw::dpp_xor2(mu); mu += __shfl_xor(mu, 4); mu *= (1.0f / 64.f);
            bs += rw::dpp_xor1(bs); bs += rw::dpp_xor2(bs); bs += __shfl_xor(bs, 4);
            float var = 0.f;
#pragma unroll
            for (int e = 0; e < 8; ++e) { y[e] -= mu; var += y[e] * y[e]; }
            var += rw::dpp_xor1(var); var += rw::dpp_xor2(var); var += __shfl_xor(var, 4); var *= (1.0f / 64.f);
            const float rsd = 1.0f / sqrtf(var + GN_EPS);
#pragma unroll
            for (int e = 0; e < 8; ++e) y[e] = (y[e] * rsd * gw[e] + gb[e] + bs * vv[e]) * gg[e];
            *(u32x4*)(O + m * D + MW + cb) = pack8(y);
        }
        asm volatile("s_waitcnt lgkmcnt(0)" ::: "memory");
    }
}
}

constexpr int LDS_BYTES = 147456;
constexpr int LDS_MISC = 131072 + 320;
constexpr size_t CTL_ZERO_BYTES = 65536;
constexpr int CW_BAR = 4096, CW_Q = 8192;

#define XB_TMO      128
#define XB_XCNT(j)  (256  + 64 * (j))
#define XB_XSUB(j)  (1280 + 64 * (j))
#define XB_XGEN(j)  (2304 + 64 * (j))
#define XB_TOP      3328
#define XB_TOPGEN   3392
#define XCD_BAR_WORDS 3456
#define XB_SPIN_CAP (1u << 18)
__device__ __forceinline__ unsigned xb_ld(unsigned* p)              { return __hip_atomic_load(p, __ATOMIC_RELAXED, __HIP_MEMORY_SCOPE_AGENT); }
__device__ __forceinline__ unsigned xb_add(unsigned* p, unsigned v) { return __hip_atomic_fetch_add(p, v, __ATOMIC_RELAXED, __HIP_MEMORY_SCOPE_AGENT); }
__device__ __forceinline__ unsigned xb_xcc_id() { return (unsigned)__builtin_amdgcn_s_getreg((3 << 11) | 20) & 0xFu; }
#define XB_SPIN(cond, bar) do { unsigned _sp = 0; while (cond) { __builtin_amdgcn_s_sleep(1); \
    if ((++_sp & 255u) == 0u) { if (xb_ld(&(bar)[XB_TMO])) break; if (_sp > XB_SPIN_CAP) { atomicAdd(&(bar)[XB_TMO], 1u); break; } } } } while (0)
struct XcdBarrier { unsigned* bar; unsigned x; volatile LAS unsigned* st; };
__device__ __forceinline__ XcdBarrier xcd_barrier_post(unsigned* bar, volatile LAS unsigned* st) {
    XcdBarrier b; b.bar = bar; b.x = xb_xcc_id(); b.st = st;
    if (threadIdx.x == 0) (void)xb_add(&bar[XB_XCNT(b.x)], 1u);
    return b;
}
__device__ __forceinline__ void xcd_barrier_complete(unsigned* bar, unsigned x, unsigned& nloc, unsigned& nx) {
    const unsigned G = gridDim.x * gridDim.y * gridDim.z;
    unsigned sum, cnt, mine, sp = 0u;
    for (;;) {
        sum = 0u; cnt = 0u; mine = 0u;
#pragma unroll
        for (unsigned j = 0; j < 16; ++j) { const unsigned c = xb_ld(&bar[XB_XCNT(j)]); sum += c; cnt += (c > 0u) ? 1u : 0u; mine = (j == x) ? c : mine; }
        if (sum == G) break;
        __builtin_amdgcn_s_sleep(1);
        if ((++sp & 255u) == 0u) { if (xb_ld(&bar[XB_TMO])) break; if (sp > XB_SPIN_CAP) { atomicAdd(&bar[XB_TMO], 1u); break; } }
    }
    nloc = mine > 0u ? mine : 1u; nx = cnt > 0u ? cnt : 1u;
}
__device__ __forceinline__ void xcd_barrier(const XcdBarrier& b) {
    asm volatile("s_waitcnt vmcnt(0)" ::: "memory");
    __syncthreads();
    if (threadIdx.x == 0) {
        unsigned* bar = b.bar;
        __builtin_amdgcn_s_waitcnt(0);
        unsigned nloc = b.st[0], nx = b.st[1];
        if (nloc == 0u) { xcd_barrier_complete(bar, b.x, nloc, nx); b.st[0] = nloc; b.st[1] = nx; }
        const unsigned old = xb_add(&bar[XB_XSUB(b.x)], 1u);
        const unsigned gen = old / nloc;
        if (old + 1u == (gen + 1u) * nloc) {
            __builtin_amdgcn_fence(__ATOMIC_RELEASE, "agent");
            asm volatile("s_waitcnt vmcnt(0)" ::: "memory");
            const unsigned og = xb_add(&bar[XB_TOP], 1u);
            const unsigned tg = og / nx;
            if (og + 1u == (tg + 1u) * nx) xb_add(&bar[XB_TOPGEN], 1u);
            else XB_SPIN(xb_ld(&bar[XB_TOPGEN]) == tg, bar);
            __builtin_amdgcn_fence(__ATOMIC_ACQUIRE, "agent");
            xb_add(&bar[XB_XGEN(b.x)], 1u);
            asm volatile("s_waitcnt vmcnt(0)" ::: "memory");
        } else {
            XB_SPIN(xb_ld(&bar[XB_XGEN(b.x)]) == gen, bar);
            __builtin_amdgcn_fence(__ATOMIC_ACQUIRE, "agent");
            asm volatile("s_waitcnt vmcnt(0)" ::: "memory");
        }
    }
    __syncthreads();
}

constexpr int MX_RL = LB * RH * 2 * 4, MX_ML = LB * MH * 2 * ml::NVB, MX_RC = CB * RH * 2 * 4, MX_MC = CB * MH * 2 * ml::NVB;
constexpr int MX_ITEMS = MX_RL + MX_ML + MX_RC + MX_MC;

__device__ __forceinline__ void scan_phase(LAS unsigned char* lds, CParams& P, int l, unsigned* qhead) {
    volatile LAS unsigned* bc = (volatile LAS unsigned*)(lds + LDS_MISC) + 16;
    for (;;) {
        if (threadIdx.x == 0) bc[0] = xb_add(qhead, 1u);
        __syncthreads();
        const int it = (int)bc[0];
        __syncthreads();
        if (it >= LB * RH * 2) break;
        int s_, head, dir; wy::decode_item(it, s_, head, dir);
        wy::rwkv_item(lds, P, l, s_, head, dir);
    }
    for (;;) {
        if (threadIdx.x == 0) bc[0] = xb_add(qhead + 16, 1u);
        __syncthreads();
        const int it = (int)bc[0];
        __syncthreads();
        if (it >= ml::N_ITEMS) break;
        int s_, head, dir, sub; ml::decode_item(it, s_, head, dir, sub);
        ml::mlstm_item(lds, P, l, s_, head, dir, sub);
    }
    for (;;) {
        if (threadIdx.x == 0) bc[0] = xb_add(qhead + 32, 1u);
        __syncthreads();
        const int it = (int)bc[0] + LB * RH * 2;
        __syncthreads();
        if (it >= wy::N_ITEMS) break;
        int s_, head, dir; wy::decode_item(it, s_, head, dir);
        wy::rwkv_item(lds, P, l, s_, head, dir);
    }
}

enum { ST_N0 = 0, ST_A1, ST_CV, ST_MX, ST_PO, ST_N1, ST_A2, ST_PJ, ST_WO, ST_N2, ST_F1, ST_F2, ST_PER_LAYER };
constexpr int N_STEPS = 1 + DEPTH * ST_PER_LAYER + 1;
struct MkArgs { Params P; int ph_lo, ph_hi; };
__global__ void __launch_bounds__(512, 2) mk(MkArgs a) {
    extern __shared__ __attribute__((aligned(16))) unsigned char lds_raw[];
    LAS unsigned char* lds = (LAS unsigned char*)lds_raw;
    const int G = gridDim.x, vb = (int)blockIdx.x;
    unsigned* ctl = (unsigned*)(a.P.ws + WS_CTL);
    volatile LAS unsigned* MISC = (volatile LAS unsigned*)(lds + LDS_MISC);
    for (int u = threadIdx.x; u < 64; u += 512) MISC[u] = 0u;
    __syncthreads();
    const bool multi = a.ph_hi - a.ph_lo > 1;
    XcdBarrier bar; bar.bar = ctl + CW_BAR; bar.x = 0; bar.st = nullptr;
    if (multi) bar = xcd_barrier_post(ctl + CW_BAR, MISC + 8);
    const int lo = a.ph_lo, hi = a.ph_hi;
#define STEP_BEGIN(id) if (lo <= (id) && (id) < hi) { unsigned long long kp_ = (unsigned long long)__builtin_amdgcn_kernarg_segment_ptr(); asm volatile("" : "+s"(kp_)); CParams& P = *(CParams*)kp_;
#define STEP_END(id) if ((id) + 1 < hi) xcd_barrier(bar); }
    STEP_BEGIN(0) el::init_phase(lds, P, vb, G); el::wconv_phase(lds, P, 0, vb, G); STEP_END(0)
#define LAYER(l) { \
        const int base = 1 + (l) * ST_PER_LAYER; \
        STEP_BEGIN(base + ST_N0) if ((l) > 0) el::wconv_phase(lds, P, (l), vb, G); el::norm_phase(P, (l), 0, vb, G); STEP_END(base + ST_N0) \
        STEP_BEGIN(base + ST_A1) { pg8::Gemm g{WSP(bf16, WS_QKC), WSP(bf16, O_WIN1), D, D}; pg8::StaticOrder S; S.init(NT, N1P, G, vb); \
            pg8::EpiA1 E{WSP(bf16, WS_U1)}; pg8::gemm_phase(lds, g, S, E); } STEP_END(base + ST_A1) \
        STEP_BEGIN(base + ST_CV) el::conv_phase(lds, P, (l), vb, G); STEP_END(base + ST_CV) \
        STEP_BEGIN(base + ST_MX) scan_phase(lds, P, (l), ctl + CW_Q + 64 * (l)); STEP_END(base + ST_MX) \
        STEP_BEGIN(base + ST_PO) el::post_phase(lds, P, (l), vb, G); STEP_END(base + ST_PO) \
        STEP_BEGIN(base + ST_N1) el::norm_phase(P, (l), 1, vb, G); STEP_END(base + ST_N1) \
        STEP_BEGIN(base + ST_A2) { pg8::Gemm g{WSP(bf16, WS_RXC), WSP(bf16, O_WIN2), D, D}; pg8::StaticOrder S; S.init(NT, 2 * D, G, vb); \
            pg8::EpiA2 E{WSP(bf16, WS_U1)}; pg8::gemm_phase(lds, g, S, E); } STEP_END(base + ST_A2) \
        STEP_BEGIN(base + ST_PJ) { pg8::Gemm g{WSP(bf16, WS_QKC), WSP(bf16, O_PM), MW, D}; pg8::PairOrder S; S.init(NT, G, vb); \
            pg8::EpiPJ E{WSP(bf16, WS_U1)}; pg8::gemm_phase(lds, g, S, E); } STEP_END(base + ST_PJ) \
        STEP_BEGIN(base + ST_WO) { pg8::Gemm g{WSP(bf16, WS_U1), WSP(bf16, O_WO), D, PU}; pg8::StaticOrder S; S.init(NT, D, G, vb); \
            pg8::EpiRes E{P.out, WSP(float, WS_MOD) + (size_t)(l) * NCOND * 6 * D + 2 * D}; pg8::gemm_phase(lds, g, S, E); } STEP_END(base + ST_WO) \
        STEP_BEGIN(base + ST_N2) el::norm_phase(P, (l), 2, vb, G); STEP_END(base + ST_N2) \
        STEP_BEGIN(base + ST_F1) { pg8::Gemm g{WSP(bf16, WS_QKC), WSP(bf16, O_W13), D, D}; pg8::StaticOrder S; S.init(NT, 2 * FF, G, vb); \
            pg8::EpiF1 E{WSP(bf16, WS_U1)}; pg8::gemm_phase(lds, g, S, E); } STEP_END(base + ST_F1) \
        STEP_BEGIN(base + ST_F2) { pg8::Gemm g{WSP(bf16, WS_U1), WSP(bf16, O_W2), FF, FF}; pg8::StaticOrder S; S.init(NT, D, G, vb); \
            pg8::EpiRes E{P.out, WSP(float, WS_MOD) + (size_t)(l) * NCOND * 6 * D + 5 * D}; pg8::gemm_phase(lds, g, S, E); } STEP_END(base + ST_F2) \
    }
    static_assert(DEPTH == 2, "layers are unrolled by hand");
    LAYER(0)
    LAYER(1)
#undef LAYER
    STEP_BEGIN(N_STEPS - 1) el::norm_phase(P, 0, 3, vb, G); STEP_END(N_STEPS - 1)
#undef STEP_BEGIN
#undef STEP_END
}
#endif

typedef void (*BodyFn)(const Params&, long);
#ifndef HOST_EMU
template <BodyFn F, int BLOCK> __global__ void __launch_bounds__(BLOCK) run_k(Params P, long n) {
    const long i = (long)blockIdx.x * BLOCK + threadIdx.x;
    if (i < n) F(P, i);
}
#define RUN(F, BLOCK, n) do { const long n_ = (n); run_k<F, BLOCK><<<dim3((unsigned)((n_ + BLOCK - 1) / BLOCK)), dim3(BLOCK), 0, stream>>>(P, n_); } while (0)
static int g_grid = 0;
#else
#define RUN(F, BLOCK, n) do { const long n_ = (n); for (long i_ = 0; i_ < n_; ++i_) F(P, i_); } while (0)
typedef void* hipStream_t;
#endif

static void forward(Params P, hipStream_t stream) {
    (void)stream;
#ifndef HOST_EMU
    if (hipMemsetAsync(P.ws + WS_CTL, 0, CTL_ZERO_BYTES, stream) != hipSuccess) return;
#ifdef MK_PER_STEP
    for (int st = 0; st < N_STEPS; ++st) { MkArgs a_{}; a_.P = P; a_.ph_lo = st; a_.ph_hi = st + 1; mk<<<dim3(g_grid), dim3(512), LDS_BYTES, stream>>>(a_); }
#else
    { MkArgs a_{}; a_.P = P; a_.ph_lo = 0; a_.ph_hi = N_STEPS; mk<<<dim3(g_grid), dim3(512), LDS_BYTES, stream>>>(a_); }
#endif
#else
    RUN(k_init_x, 256, (long)NT * D);
    RUN(k_mod, 256, (long)DEPTH * NCOND * 6 * D);
    for (int l = 0; l < DEPTH; ++l) {
        P.layer = l;
        RUN(k_wconv, 256, WC_N6);
        P.mode = 0; RUN(k_norm, 64, (long)NT);
        RUN(k_gemm_a1, 256, (long)NT * N1);
        RUN(k_conv, 256, (long)NT * (2 * MW + RIN));
        RUN(k_mlstm, 128, (long)NSEQ * MH * 2 * 128);
        for (int dir = 0; dir < 2; ++dir) { P.mode = dir; RUN(k_rwkv_prep, 256, (long)NT * RW); RUN(k_rwkv, 64, (long)NSEQ * RH * 64); }
        RUN(k_post, 256, (long)NT * D);
        P.mode = 1; RUN(k_norm, 64, (long)NT);
        RUN(k_gemm_a2, 256, (long)NT * 2 * D);
        RUN(k_gemm_pj, 256, (long)NT * D);
        RUN(k_gemm_wo, 256, (long)NT * D);
        P.mode = 2; RUN(k_norm, 64, (long)NT);
        RUN(k_gemm_f1, 256, (long)NT * FF);
        RUN(k_gemm_f2, 256, (long)NT * D);
    }
    RUN(k_final, 64, (long)NT);
#endif
}

#ifndef HOST_EMU
extern "C" void kernel_launch(void* const* d_in, const int* in_sizes, int n_in, void* d_out, int out_size, void* d_ws, size_t ws_size, hipStream_t stream) {
    if (n_in != N_IN || (size_t)out_size != OUT_END || ws_size < WS_END) return;
    if (g_grid == 0) {
        int dev = 0, cus = 0;
        if (hipGetDevice(&dev) != hipSuccess || hipDeviceGetAttribute(&cus, hipDeviceAttributeMultiprocessorCount, dev) != hipSuccess) { g_grid = -1; return; }
        if (hipFuncSetAttribute((const void*)mk, hipFuncAttributeMaxDynamicSharedMemorySize, LDS_BYTES) != hipSuccess) { g_grid = -1; return; }
        g_grid = cus;
    }
    if (g_grid < 0) return;
    Params P{};
    for (int i = 0; i < N_IN; ++i) P.in[i] = (const float*)d_in[i];
    P.out = (float*)d_out; P.ws = (unsigned char*)d_ws; P.layer = 0; P.mode = 0;
    forward(P, stream);
}
#endif
```

```cpp
#ifndef HOST_EMU
#include <hip/hip_runtime.h>
#define HD __host__ __device__ __forceinline__
#define DEV __device__ __forceinline__
#else
#include <cmath>
#include <cstring>
#include <cstdio>
#include <cstdlib>
#define HD inline
#define DEV inline
#endif
#include <cstddef>

#ifdef SMALL_CFG
constexpr int D = 256, CB = 2, CT = 128, DEPTH = 2, LB = 1, LT = 256, GW = 16;
#else
constexpr int D = 1024, CB = 32, CT = 256, DEPTH = 2, LB = 2, LT = 4096, GW = 64;
#endif
constexpr int MW = D / 2, MD = 128, MH = MW / MD, RW = D / 2, RD = 64, RH = RW / RD;
constexpr int RIN = 3 * RW + 384, FF = ((8 * D + 767) / 768) * 256, PIN = 2 * MW + MW + MW + 4 * MH + RIN + 2 * D;
constexpr int NC = CB * CT, NL = LB * LT, NT = NC + NL, NSEQ = CB + LB, NCOND = 1 + LB;
constexpr int N1 = PIN - 2 * D;
constexpr int N1P = ((N1 + 255) / 256) * 256;
constexpr int PU = N1;
constexpr int OFF_QK = 0, OFF_V = 2 * MW, OFF_O = 3 * MW, OFF_G = 4 * MW, OFF_R = 4 * MW + 4 * MH;
constexpr int RX_R = 0, RX_K = RW, RX_V = 2 * RW, RX_WL = 3 * RW, RX_AL = 3 * RW + 128, RX_GL = 3 * RW + 256;
constexpr float RMS_EPS = 1e-6f, GN_EPS = 64e-5f;
static_assert(3 * D <= N1, "G + merged must fit the dead columns of U1");

enum { X_PROMPT = 0, X_SAMPLE, ST_C, ST_N, ST_M, ST_R, C_LAT, C_CTX, ADA_W, ADA_B, NORM1, NORM2, W_IN, M_CONV, M_GATE_B, M_NORM_G,
       R_CONV, R_W0, R_W2, R_A0, R_A2, R_G2, R_KK, R_KA, R_RK, R_GN_W, R_GN_B, PROJ_M, PROJ_R, W_OUT, FFN_W1, FFN_W3, FFN_W2, FINAL_G, N_IN };

constexpr size_t OUT_X = 0;
constexpr size_t OUT_C = (size_t)NT * D;
constexpr size_t OUT_N = OUT_C + (size_t)CB * DEPTH * 2 * MH * 128 * 128;
constexpr size_t OUT_M = OUT_N + (size_t)CB * DEPTH * 2 * MH * 128;
constexpr size_t OUT_S = OUT_M + (size_t)CB * DEPTH * 2 * MH;
constexpr size_t OUT_END = OUT_S + (size_t)CB * DEPTH * 2 * RH * 64 * 64;

constexpr size_t al256(size_t x) { return (x + 255) & ~(size_t)255; }
constexpr size_t cmax(size_t a, size_t b) { return a > b ? a : b; }
constexpr size_t WS_CTL = 0;
constexpr size_t WS_MOD = (size_t)1 << 20;
constexpr size_t WS_WREG = (size_t)2 << 20;
constexpr size_t O_WIN1 = WS_WREG;
constexpr size_t O_WIN2 = O_WIN1 + (size_t)N1P * D * 2;
constexpr size_t O_PM = O_WIN2 + (size_t)2 * D * D * 2;
constexpr size_t O_PR = O_PM + (size_t)D * MW * 2;
constexpr size_t O_WO = O_PR + (size_t)D * RW * 2;
constexpr size_t O_W13 = O_WO + (size_t)D * D * 2;
constexpr size_t O_W2 = O_W13 + (size_t)2 * FF * D * 2;
constexpr size_t O_G2T = O_W2 + (size_t)D * FF * 2;
constexpr size_t O_W2T = O_G2T + (size_t)RW * 128 * 2;
constexpr size_t O_A2T = O_W2T + (size_t)2 * RW * 64 * 2;
constexpr size_t WS_U1 = al256(O_A2T + (size_t)2 * RW * 64 * 2);
constexpr size_t SZ_U1 = al256(cmax((size_t)NT * PU * 2, (size_t)NT * FF * 2));
constexpr size_t WS_QKC = WS_U1 + SZ_U1;
constexpr size_t WS_RXC = WS_QKC + (size_t)NT * D * 2;
constexpr size_t WS_END = WS_RXC + al256(cmax((size_t)NT * RIN * 2, (size_t)NT * D * 2));
#ifndef SMALL_CFG
static_assert(WS_END <= ((size_t)256 << 20), "workspace map must fit 256 MiB");
#endif

typedef unsigned short bf16;
HD float bf2f(bf16 b) { unsigned u = ((unsigned)b) << 16; return __builtin_bit_cast(float, u); }
#if defined(__HIP_DEVICE_COMPILE__)
HD bf16 f2bf(float f) { return __builtin_bit_cast(bf16, (__bf16)f); }
#else
HD bf16 f2bf(float f) { unsigned u = __builtin_bit_cast(unsigned, f); u += 0x7fffu + ((u >> 16) & 1u); return (bf16)(u >> 16); }
#endif
HD float sigmoidf_(float x) { return 1.0f / (1.0f + expf(-x)); }
HD float siluf_(float x) { return x / (1.0f + expf(-x)); }
HD float softplusf_(float x) { return fmaxf(x, 0.f) + log1pf(expf(-fabsf(x))); }
HD float logsigmoidf_(float x) { return -softplusf_(-x); }
HD int prow(int c) { return (c & ~31) | (((c >> 2) & 1) << 4) | (((c >> 3) & 3) << 2) | (c & 3); }

struct Params {
    const float* in[N_IN];
    float* out;
    unsigned char* ws;
    int layer;
    int mode;
};

struct SeqInfo { int T; int base; int grid; int cond; int b; };
HD SeqInfo seqinfo(int s) {
    SeqInfo q;
    if (s < CB) { q.T = CT; q.base = s * CT; q.grid = 0; q.cond = 0; q.b = s; }
    else { q.T = LT; q.base = NC + (s - CB) * LT; q.grid = 1; q.cond = 1 + (s - CB); q.b = s - CB; }
    return q;
}
HD int seq_of_token(int m) { return m < NC ? m / CT : CB + (m - NC) / LT; }

#define WSP(T, off) ((T*)(P.ws + (off)))

DEV void k_init_x(const Params& P, long i) {
    const size_t ncd = (size_t)NC * D;
    P.out[i] = (size_t)i < ncd ? P.in[X_PROMPT][i] : P.in[X_SAMPLE][i - ncd];
}
DEV void k_mod(const Params& P, long i) {
    const int j = (int)(i % (6 * D)); const int ci = (int)((i / (6 * D)) % NCOND); const int l = (int)(i / ((long)6 * D * NCOND));
    const float* cv = ci == 0 ? P.in[C_CTX] : P.in[C_LAT] + (size_t)(ci - 1) * D;
    const float* w = P.in[ADA_W] + (size_t)l * D * 6 * D;
    float acc = P.in[ADA_B][(size_t)l * 6 * D + j];
    for (int k = 0; k < D; ++k) acc += siluf_(cv[k]) * w[(size_t)k * 6 * D + j];
    WSP(float, WS_MOD)[i] = acc;
}
constexpr long WC_N0 = (long)N1P * D, WC_N1 = WC_N0 + (long)2 * D * D, WC_N2 = WC_N1 + (long)D * MW, WC_N3 = WC_N2 + (long)D * RW,
               WC_N4 = WC_N3 + (long)D * D, WC_N5 = WC_N4 + (long)2 * FF * D, WC_N6 = WC_N5 + (long)D * FF;
HD int unprow(int r) { return (r & ~31) | (((r >> 2) & 3) << 3) | (((r >> 4) & 1) << 2) | (r & 3); }
DEV void k_wconv(const Params& P, long i) {
    const int l = P.layer;
    if (i < WC_N0) { const int r = (int)(i / D), k = (int)(i % D); const int c = unprow(r);
        WSP(bf16, O_WIN1)[i] = c < N1 ? f2bf(P.in[W_IN][((size_t)l * D + k) * PIN + c]) : (bf16)0; return; }
    if (i < WC_N1) { const long j = i - WC_N0; const int r = (int)(j / D), k = (int)(j % D); const int c = unprow(r);
        WSP(bf16, O_WIN2)[j] = f2bf(P.in[W_IN][((size_t)l * D + k) * PIN + N1 + c]); return; }
    if (i < WC_N2) { const long j = i - WC_N1; const int r = (int)(j / MW), k = (int)(j % MW); const int c = unprow(r);
        WSP(bf16, O_PM)[j] = f2bf(P.in[PROJ_M][((size_t)l * MW + k) * D + c]); return; }
    if (i < WC_N3) { const long j = i - WC_N2; const int r = (int)(j / RW), k = (int)(j % RW); const int c = unprow(r);
        WSP(bf16, O_PR)[j] = f2bf(P.in[PROJ_R][((size_t)l * RW + k) * D + c]); return; }
    if (i < WC_N4) { const long j = i - WC_N3; const int r = (int)(j / D), k = (int)(j % D);
        WSP(bf16, O_WO)[j] = f2bf(P.in[W_OUT][((size_t)l * D + k) * D + r]); return; }
    if (i < WC_N5) { const long j = i - WC_N4; const int r = (int)(j / D), k = (int)(j % D);
        const int pn = r >> 8, rl = r & 255, which = rl >> 7, rho = rl & 127; const int jj = pn * 128 + unprow(rho);
        const float* W = which ? P.in[FFN_W3] : P.in[FFN_W1];
        WSP(bf16, O_W13)[j] = f2bf(W[((size_t)l * D + k) * FF + jj]); return; }
    { const long j = i - WC_N5; const int r = (int)(j / FF), k = (int)(j % FF);
        WSP(bf16, O_W2)[j] = f2bf(P.in[FFN_W2][((size_t)l * FF + k) * D + r]); }
}
DEV void k_norm(const Params& P, long m) {
    const int l = P.layer; const int second = (P.mode == 2);
    const float* x = P.out + (size_t)m * D;
    const float* g = P.in[second ? NORM2 : NORM1] + (size_t)l * D;
    const int cond = seqinfo(seq_of_token((int)m)).cond;
    const float* mod = WSP(float, WS_MOD) + ((size_t)l * NCOND + cond) * 6 * D + (second ? 3 * D : 0);
    float ss = 0.f;
    for (int k = 0; k < D; ++k) ss += x[k] * x[k];
    const float rs = 1.0f / sqrtf(ss / D + RMS_EPS);
    bf16* o = WSP(bf16, P.mode == 1 ? WS_RXC : WS_QKC) + (size_t)m * D;
    for (int k = 0; k < D; ++k) o[k] = f2bf(x[k] * rs * g[k] * (1.0f + mod[D + k]) + mod[k]);
}
DEV float dot_bf(const bf16* a, const bf16* b, int K) { float s = 0.f; for (int k = 0; k < K; ++k) s += bf2f(a[k]) * bf2f(b[k]); return s; }
DEV void k_gemm_a1(const Params& P, long i) {
    const int n = (int)(i % N1); const long m = i / N1;
    WSP(bf16, WS_U1)[(size_t)m * PU + n] = f2bf(dot_bf(WSP(bf16, WS_QKC) + (size_t)m * D, WSP(bf16, O_WIN1) + (size_t)prow(n) * D, D));
}
DEV void k_gemm_a2(const Params& P, long i) {
    const int n = (int)(i % (2 * D)); const long m = i / (2 * D);
    WSP(bf16, WS_U1)[(size_t)m * PU + D + n] = f2bf(sigmoidf_(dot_bf(WSP(bf16, WS_RXC) + (size_t)m * D, WSP(bf16, O_WIN2) + (size_t)prow(n) * D, D)));
}
DEV void k_gemm_pj(const Params& P, long i) {
    const int n = (int)(i % D); const long m = i / D;
    const bf16* hmr = WSP(bf16, WS_QKC) + (size_t)m * D; bf16* u = WSP(bf16, WS_U1) + (size_t)m * PU;
    const float a = dot_bf(hmr, WSP(bf16, O_PM) + (size_t)prow(n) * MW, MW), b = dot_bf(hmr + MW, WSP(bf16, O_PR) + (size_t)prow(n) * RW, RW);
    const float first = bf2f(f2bf(bf2f(u[D + n]) * a));
    u[n] = f2bf(first + bf2f(u[2 * D + n]) * b);
}
DEV void k_gemm_wo(const Params& P, long i) {
    const int n = (int)(i % D); const long m = i / D; const int l = P.layer;
    const int cond = seqinfo(seq_of_token((int)m)).cond;
    const float g1 = WSP(float, WS_MOD)[((size_t)l * NCOND + cond) * 6 * D + 2 * D + n];
    P.out[(size_t)m * D + n] += g1 * dot_bf(WSP(bf16, WS_U1) + (size_t)m * PU, WSP(bf16, O_WO) + (size_t)n * D, D);
}
DEV void k_gemm_f1(const Params& P, long i) {
    const int j = (int)(i % FF); const long m = i / FF;
    const int pn = j >> 7, rho = prow(j & 127);
    const bf16* h = WSP(bf16, WS_QKC) + (size_t)m * D;
    const float a = dot_bf(h, WSP(bf16, O_W13) + (size_t)(pn * 256 + rho) * D, D), b = dot_bf(h, WSP(bf16, O_W13) + (size_t)(pn * 256 + 128 + rho) * D, D);
    WSP(bf16, WS_U1)[(size_t)m * FF + j] = f2bf(siluf_(a) * b);
}
DEV void k_gemm_f2(const Params& P, long i) {
    const int n = (int)(i % D); const long m = i / D; const int l = P.layer;
    const int cond = seqinfo(seq_of_token((int)m)).cond;
    const float g2 = WSP(float, WS_MOD)[((size_t)l * NCOND + cond) * 6 * D + 5 * D + n];
    P.out[(size_t)m * D + n] += g2 * dot_bf(WSP(bf16, WS_U1) + (size_t)m * FF, WSP(bf16, O_W2) + (size_t)n * FF, FF);
}
DEV void k_conv(const Params& P, long i) {
    constexpr int NCH = 2 * MW + RIN;
    const int ch = (int)(i % NCH); const int m = (int)(i / NCH); const int l = P.layer;
    const int s = seq_of_token(m); const SeqInfo q = seqinfo(s); const int t = m - q.base;
    const bool isqk = ch < 2 * MW; const int c = isqk ? ch : ch - 2 * MW;
    const int ucol = isqk ? OFF_QK + c : OFF_R + c;
    const int CH = isqk ? 2 * MW : RIN;
    const float* w = (isqk ? P.in[M_CONV] : P.in[R_CONV]) + (size_t)l * 9 * CH;
    const bf16* U = WSP(bf16, WS_U1);
    float acc = 0.f;
    if (q.grid) {
        const int r = t / GW, cc = t % GW, rows = q.T / GW;
        for (int a = 0; a < 3; ++a) for (int b = 0; b < 3; ++b) {
            const int rr = r + a - 1, c2 = cc + b - 1;
            if (rr >= 0 && rr < rows && c2 >= 0 && c2 < GW) acc += w[(a * 3 + b) * CH + c] * bf2f(U[(size_t)(q.base + rr * GW + c2) * PU + ucol]);
        }
    } else {
        for (int b = 0; b < 3; ++b) { const int t2 = t + b - 1; if (t2 >= 0 && t2 < q.T) acc += w[(3 + b) * CH + c] * bf2f(U[(size_t)(q.base + t2) * PU + ucol]); }
    }
    if (isqk) { float v = siluf_(acc); if (c < MW) v *= 0.08838834764831845f; WSP(bf16, WS_QKC)[(size_t)m * (2 * MW) + c] = f2bf(v); }
    else { float v = acc; if (c >= RX_WL && c < RX_AL) v = tanhf(v); else if (c >= RX_GL) v = sigmoidf_(v); WSP(bf16, WS_RXC)[(size_t)m * RIN + c] = f2bf(v); }
}
DEV void k_mlstm(const Params& P, long i) {
    const int e = (int)(i % 128); const int chain = (int)(i / 128); const int dir = chain & 1, head = (chain >> 1) % MH, s = chain / (2 * MH);
    const int l = P.layer; const SeqInfo q = seqinfo(s);
    float C[128], n[128]; float m;
    if (!q.grid) {
#pragma unroll
        for (int d = 0; d < 128; ++d) { C[d] = 0.f; n[d] = 0.f; }
        m = 0.f;
    } else {
        const size_t sb = (((size_t)q.b * DEPTH + l) * 2 + dir) * MH + head;
#pragma unroll
        for (int d = 0; d < 128; ++d) { C[d] = P.in[ST_C][(sb * 128 + d) * 128 + e]; n[d] = P.in[ST_N][sb * 128 + d]; }
        m = P.in[ST_M][sb];
    }
    const float bi = P.in[M_GATE_B][(size_t)l * 4 * MH + (2 * dir) * MH + head], bfg = P.in[M_GATE_B][(size_t)l * 4 * MH + (2 * dir + 1) * MH + head];
    bf16* U = WSP(bf16, WS_U1); const bf16* QK = WSP(bf16, WS_QKC);
    float nsel = 0.f;
    for (int p = 0; p < q.T; ++p) {
        const int t = dir ? q.T - 1 - p : p; const size_t tok = (size_t)(q.base + t);
        const bf16* qk = QK + tok * (2 * MW); bf16* u = U + tok * PU;
        const float gi = bf2f(u[OFF_G + (2 * dir) * MH + head]) + bi, gf = bf2f(u[OFF_G + (2 * dir + 1) * MH + head]) + bfg;
        const float lf = logsigmoidf_(gf);
        const float mn = fmaxf(lf + m, gi); const float fw = expf(lf + m - mn), iw = expf(gi - mn);
        const float v = bf2f(u[OFF_V + head * 128 + e]);
        float num = 0.f, den = 0.f;
#pragma unroll
        for (int d = 0; d < 128; ++d) {
            const float kd = bf2f(qk[MW + head * 128 + d]), qd = bf2f(qk[head * 128 + d]);
            C[d] = fw * C[d] + iw * kd * v; n[d] = fw * n[d] + iw * kd; num += qd * C[d]; den += qd * n[d];
        }
        m = mn;
        u[dir * MW + head * 128 + e] = f2bf(num / fmaxf(fabsf(den), expf(-m)));
    }
    if (!q.grid) {
        const size_t sb = (((size_t)q.b * DEPTH + l) * 2 + dir) * MH + head;
#pragma unroll
        for (int d = 0; d < 128; ++d) { P.out[OUT_C + (sb * 128 + d) * 128 + e] = C[d]; if (d == e) nsel = n[d]; }
        P.out[OUT_N + sb * 128 + e] = nsel;
        if (e == 0) P.out[OUT_M + sb] = m;
    }
}
DEV void k_rwkv_prep(const Params& P, long i) {
    const int c = (int)(i % RW); const size_t tok = (size_t)(i / RW); const int l = P.layer, dir = P.mode;
    const bf16* rx = WSP(bf16, WS_RXC) + tok * RIN;
    const float* w2 = P.in[R_W2] + ((size_t)l * 2 + dir) * 64 * RW + c; const float* a2 = P.in[R_A2] + ((size_t)l * 2 + dir) * 64 * RW + c;
    float wr = P.in[R_W0][((size_t)l * 2 + dir) * RW + c], ar = P.in[R_A0][((size_t)l * 2 + dir) * RW + c];
    for (int j = 0; j < 64; ++j) { wr += bf2f(rx[RX_WL + dir * 64 + j]) * w2[(size_t)j * RW]; ar += bf2f(rx[RX_AL + dir * 64 + j]) * a2[(size_t)j * RW]; }
    bf16* o = WSP(bf16, WS_QKC) + tok * (2 * RW);
    o[c] = f2bf(wr); o[RW + c] = f2bf(ar);
}
DEV void k_rwkv(const Params& P, long i) {
    const int row = (int)(i % 64); const int chain = (int)(i / 64); const int dir = P.mode, head = chain % RH, s = chain / RH;
    const int l = P.layer; const SeqInfo q = seqinfo(s); const int hc = head * 64;
    float S[64];
    if (!q.grid) {
#pragma unroll
        for (int c = 0; c < 64; ++c) S[c] = 0.f;
    } else {
        const size_t sb = (((size_t)q.b * DEPTH + l) * 2 + dir) * RH + head;
#pragma unroll
        for (int c = 0; c < 64; ++c) S[c] = P.in[ST_R][(sb * 64 + row) * 64 + c];
    }
    const float* rkk = P.in[R_KK] + (size_t)l * RW + hc; const float* rka = P.in[R_KA] + (size_t)l * RW + hc;
    bf16* U = WSP(bf16, WS_U1); const bf16* RX = WSP(bf16, WS_RXC); const bf16* WA = WSP(bf16, WS_QKC);
    for (int p = 0; p < q.T; ++p) {
        const int t = dir ? q.T - 1 - p : p; const size_t tok = (size_t)(q.base + t);
        const bf16* rx = RX + tok * RIN; const bf16* wa = WA + tok * (2 * RW);
        float ss = 0.f;
        for (int c = 0; c < 64; ++c) { const float kc = bf2f(rx[RX_K + hc + c]) * rkk[c]; ss += kc * kc; }
        const float inv = 1.0f / fmaxf(sqrtf(ss), 1e-12f);
        float sa = 0.f;
#pragma unroll
        for (int c = 0; c < 64; ++c) sa -= S[c] * (bf2f(rx[RX_K + hc + c]) * rkk[c] * inv);
        const float v = bf2f(rx[RX_V + hc + row]);
        float y = 0.f;
#pragma unroll
        for (int c = 0; c < 64; ++c) {
            const float wr = bf2f(wa[hc + c]), ar = bf2f(wa[RW + hc + c]);
            const float decay = expf(-0.6065306597126334f * sigmoidf_(wr));
            const float alpha = sigmoidf_(ar);
            const float kr = bf2f(rx[RX_K + hc + c]);
            const float kt = kr * (1.0f + (alpha - 1.0f) * rka[c]);
            const float bb = kr * rkk[c] * inv * alpha;
            S[c] = S[c] * decay + sa * bb + v * kt;
            y += S[c] * bf2f(rx[RX_R + hc + c]);
        }
        U[tok * PU + OFF_R + dir * RW + hc + row] = f2bf(y);
    }
    if (!q.grid) {
        const size_t sb = (((size_t)q.b * DEPTH + l) * 2 + dir) * RH + head;
#pragma unroll
        for (int c = 0; c < 64; ++c) P.out[OUT_S + (sb * 64 + row) * 64 + c] = S[c];
    }
}
DEV void k_post(const Params& P, long i) {
    const int ch = (int)(i % D); const size_t m = (size_t)(i / D); const int l = P.layer;
    const bf16* u = WSP(bf16, WS_U1) + m * PU; const bf16* rx = WSP(bf16, WS_RXC) + m * RIN;
    bf16* o = WSP(bf16, WS_QKC) + m * D;
    if (ch < MW) {
        const int h0 = (ch / 128) * 128; float ss = 0.f;
        for (int d = 0; d < 128; ++d) { const float x = bf2f(u[h0 + d]) + bf2f(u[MW + h0 + d]); ss += x * x; }
        const float x = bf2f(u[ch]) + bf2f(u[MW + ch]);
        o[ch] = f2bf(x / sqrtf(ss / 128.f + RMS_EPS) * P.in[M_NORM_G][(size_t)l * MW + ch] * sigmoidf_(bf2f(u[OFF_O + ch])));
    } else {
        const int c = ch - MW; const int h0 = (c / 64) * 64;
        float mu = 0.f, bsum = 0.f;
        for (int d = 0; d < 64; ++d) { mu += bf2f(u[OFF_R + h0 + d]) + bf2f(u[OFF_R + RW + h0 + d]);
            bsum += bf2f(rx[RX_R + h0 + d]) * bf2f(rx[RX_K + h0 + d]) * P.in[R_RK][(size_t)l * RW + h0 + d]; }
        mu *= (1.0f / 64.f); float var = 0.f;
        for (int d = 0; d < 64; ++d) { const float x = bf2f(u[OFF_R + h0 + d]) + bf2f(u[OFF_R + RW + h0 + d]) - mu; var += x * x; }
        var *= (1.0f / 64.f);
        const float y = bf2f(u[OFF_R + c]) + bf2f(u[OFF_R + RW + c]);
        const float yn = (y - mu) / sqrtf(var + GN_EPS) * P.in[R_GN_W][(size_t)l * RW + c] + P.in[R_GN_B][(size_t)l * RW + c];
        float gate = 0.f;
        for (int j = 0; j < 128; ++j) gate += bf2f(rx[RX_GL + j]) * P.in[R_G2][((size_t)l * 128 + j) * RW + c];
        o[ch] = f2bf((yn + bsum * bf2f(rx[RX_V + c])) * gate);
    }
}
DEV void k_final(const Params& P, long m) {
    float* x = P.out + (size_t)m * D; float ss = 0.f;
    for (int k = 0; k < D; ++k) ss += x[k] * x[k];
    const float rs = 1.0f / sqrtf(ss / D + RMS_EPS);
    for (int k = 0; k < D; ++k) x[k] = x[k] * rs * P.in[FINAL_G][k];
}


#ifndef HOST_EMU
typedef const __attribute__((address_space(4))) Params CParams;
namespace pg8 {
#define PG8_LAS __attribute__((address_space(3)))
typedef short bf16x8 __attribute__((ext_vector_type(8)));
typedef float f32x4 __attribute__((ext_vector_type(4)));
typedef unsigned u32x4 __attribute__((ext_vector_type(4)));
constexpr int BM = 256, BK = 64, HALF = 128, HTB = HALF * BK * 2, STAGE_BYTES = 8 * HTB, NXCD = 8, WGM = 8;
__device__ __forceinline__ int lds_byte(int r, int c) { const int st = (r >> 4) * 2 + (c >> 5), rr = r & 15, cc = c & 31, ob = rr * 64 + cc * 2; return st * 1024 + (ob ^ (((ob >> 9) & 1) << 5)); }
__device__ __forceinline__ void stage_rc(int b, int& R, int& C) { const int st = b / 1024, sb = b % 1024, swz = sb ^ (((sb >> 9) & 1) << 5); R = (st >> 1) * 16 + swz / 64; C = (st & 1) * 32 + (swz % 64) / 2; }
struct Unit { int pm, pn, aoff; };
struct Gemm { const bf16* A; const bf16* Bt; int K, lda; };
struct StaticOrder {
    int nM, nN, nwg, G, c;
    __device__ __forceinline__ void init(int M, int N, int G_, int c_) { nM = M / BM; nN = N / BM; nwg = nM * nN; G = G_; c = c_; }
    __device__ __forceinline__ bool next(int i, Unit& u) const {
        const long L = (long)i * G + c; if (L >= nwg) return false;
        int wgid = (int)L; { const int q = nwg / NXCD, r = nwg % NXCD, xcd = wgid % NXCD, off = wgid / NXCD; wgid = (xcd < r ? xcd * (q + 1) : r * (q + 1) + (xcd - r) * q) + off; }
        const int nig = WGM * nN, gid = wgid / nig, fm = gid * WGM, gsz = (nM - fm) < WGM ? (nM - fm) : WGM;
        u.pm = fm + ((wgid % nig) % gsz); u.pn = (wgid % nig) / gsz; u.aoff = 0; return true;
    }
};
struct PairOrder {
    int nbase, G, v, nct;
    __device__ __forceinline__ void init(int M, int G_, int c_) { nct = D / BM; nbase = (M / BM) * nct; G = G_; v = (G_ % 8 == 0) ? (c_ % 8) * (G_ / 8) + c_ / 8 : c_; }
    __device__ __forceinline__ bool next(int i, Unit& u) const {
        const int j = v + (i >> 1) * G; if (j >= nbase) return false;
        const int half = i & 1; u.pm = j / nct; u.pn = half * nct + (j % nct); u.aoff = half * MW; return true;
    }
};
typedef float f32x2_t __attribute__((ext_vector_type(2)));
typedef __bf16 bf16x2_t __attribute__((ext_vector_type(2)));
__device__ __forceinline__ unsigned cvt_pk_bf16(float lo, float hi) { f32x2_t v = {lo, hi}; bf16x2_t b = __builtin_convertvector(v, bf16x2_t); return __builtin_bit_cast(unsigned, b); }
__device__ __forceinline__ float fsigmoid(float x) { return __builtin_amdgcn_rcpf(1.0f + __expf(-x)); }
__device__ __forceinline__ float bflo(unsigned w) { return __builtin_bit_cast(float, w << 16); }
__device__ __forceinline__ float bfhi(unsigned w) { return __builtin_bit_cast(float, w & 0xffff0000u); }

struct EpiA1 {
    bf16* U;
    __device__ __forceinline__ void operator()(const f32x4 (&acc)[2][2][4][2], const Unit& u, int wr, int wc, int fr, int fq) const {
        const int row0 = u.pm * BM + wr * 64 + fr, col0 = u.pn * BM + wc * 32 + 8 * fq;
#pragma unroll
        for (int ai = 0; ai < 2; ++ai)
#pragma unroll
            for (int m = 0; m < 4; ++m) { bf16* rowp = U + (size_t)(row0 + ai * HALF + m * 16) * PU + col0;
#pragma unroll
                for (int bj = 0; bj < 2; ++bj) { if (col0 + bj * HALF < N1) { const f32x4 v0 = acc[ai][bj][m][0], v1 = acc[ai][bj][m][1];
                    u32x4 w; w.x = cvt_pk_bf16(v0[0], v0[1]); w.y = cvt_pk_bf16(v0[2], v0[3]); w.z = cvt_pk_bf16(v1[0], v1[1]); w.w = cvt_pk_bf16(v1[2], v1[3]);
                    *(u32x4*)(rowp + bj * HALF) = w; } } }
    }
};
struct EpiA2 {
    bf16* U;
    __device__ __forceinline__ void operator()(const f32x4 (&acc)[2][2][4][2], const Unit& u, int wr, int wc, int fr, int fq) const {
        const int row0 = u.pm * BM + wr * 64 + fr, col0 = D + u.pn * BM + wc * 32 + 8 * fq;
#pragma unroll
        for (int ai = 0; ai < 2; ++ai)
#pragma unroll
            for (int m = 0; m < 4; ++m) { bf16* rowp = U + (size_t)(row0 + ai * HALF + m * 16) * PU + col0;
#pragma unroll
                for (int bj = 0; bj < 2; ++bj) { const f32x4 v0 = acc[ai][bj][m][0], v1 = acc[ai][bj][m][1];
                    u32x4 w; w.x = cvt_pk_bf16(fsigmoid(v0[0]), fsigmoid(v0[1])); w.y = cvt_pk_bf16(fsigmoid(v0[2]), fsigmoid(v0[3]));
                    w.z = cvt_pk_bf16(fsigmoid(v1[0]), fsigmoid(v1[1])); w.w = cvt_pk_bf16(fsigmoid(v1[2]), fsigmoid(v1[3]));
                    *(u32x4*)(rowp + bj * HALF) = w; } }
    }
};
struct EpiPJ {
    bf16* U;
    __device__ __forceinline__ void operator()(const f32x4 (&acc)[2][2][4][2], const Unit& u, int wr, int wc, int fr, int fq) const {
        const int nct = D / BM, half = u.pn >= nct ? 1 : 0, ct = u.pn - half * nct;
        const int row0 = u.pm * BM + wr * 64 + fr, col0 = ct * BM + wc * 32 + 8 * fq;
#pragma unroll
        for (int ai = 0; ai < 2; ++ai)
#pragma unroll
            for (int m = 0; m < 4; ++m) { bf16* rowp = U + (size_t)(row0 + ai * HALF + m * 16) * PU + col0;
#pragma unroll
                for (int bj = 0; bj < 2; ++bj) { const f32x4 v0 = acc[ai][bj][m][0], v1 = acc[ai][bj][m][1];
                    const u32x4 g = *(const u32x4*)(rowp + (1 + half) * D + bj * HALF);
                    float o[8] = { bflo(g.x) * v0[0], bfhi(g.x) * v0[1], bflo(g.y) * v0[2], bfhi(g.y) * v0[3], bflo(g.z) * v1[0], bfhi(g.z) * v1[1], bflo(g.w) * v1[2], bfhi(g.w) * v1[3] };
                    if (half) { const u32x4 p = *(const u32x4*)(rowp + bj * HALF);
                        o[0] += bflo(p.x); o[1] += bfhi(p.x); o[2] += bflo(p.y); o[3] += bfhi(p.y); o[4] += bflo(p.z); o[5] += bfhi(p.z); o[6] += bflo(p.w); o[7] += bfhi(p.w); }
                    u32x4 w; w.x = cvt_pk_bf16(o[0], o[1]); w.y = cvt_pk_bf16(o[2], o[3]); w.z = cvt_pk_bf16(o[4], o[5]); w.w = cvt_pk_bf16(o[6], o[7]);
                    *(u32x4*)(rowp + bj * HALF) = w; }
                asm volatile("" ::: "memory"); }
    }
};
struct EpiRes {
    float* X; const float* gate;
    __device__ __forceinline__ void operator()(const f32x4 (&acc)[2][2][4][2], const Unit& u, int wr, int wc, int fr, int fq) const {
        const int row0 = u.pm * BM + wr * 64 + fr, col0 = u.pn * BM + wc * 32 + 4 * fq;
        const int cond = seqinfo(seq_of_token(u.pm * BM)).cond;
        const float* gp = gate + (size_t)cond * 6 * D + col0;
        f32x4 gv[2][2];
#pragma unroll
        for (int bj = 0; bj < 2; ++bj)
#pragma unroll
            for (int n = 0; n < 2; ++n) gv[bj][n] = *(const f32x4*)(gp + bj * HALF + n * 16);
#pragma unroll
        for (int ai = 0; ai < 2; ++ai)
#pragma unroll
            for (int m = 0; m < 4; ++m) { float* rowp = X + (size_t)(row0 + ai * HALF + m * 16) * D + col0;
#pragma unroll
                for (int bj = 0; bj < 2; ++bj)
#pragma unroll
                    for (int n = 0; n < 2; ++n) { f32x4* p = (f32x4*)(rowp + bj * HALF + n * 16); *p = *p + gv[bj][n] * acc[ai][bj][m][n]; }
                asm volatile("" ::: "memory"); }
    }
};
struct EpiF1 {
    bf16* Hd;
    __device__ __forceinline__ void operator()(const f32x4 (&acc)[2][2][4][2], const Unit& u, int wr, int wc, int fr, int fq) const {
        const int row0 = u.pm * BM + wr * 64 + fr, col0 = u.pn * HALF + wc * 32 + 8 * fq;
#pragma unroll
        for (int ai = 0; ai < 2; ++ai)
#pragma unroll
            for (int m = 0; m < 4; ++m) { bf16* rowp = Hd + (size_t)(row0 + ai * HALF + m * 16) * FF + col0;
                float o[8];
#pragma unroll
                for (int n = 0; n < 2; ++n)
#pragma unroll
                    for (int e = 0; e < 4; ++e) { const float a = acc[ai][0][m][n][e], b = acc[ai][1][m][n][e]; o[n * 4 + e] = a * fsigmoid(a) * b; }
                u32x4 w; w.x = cvt_pk_bf16(o[0], o[1]); w.y = cvt_pk_bf16(o[2], o[3]); w.z = cvt_pk_bf16(o[4], o[5]); w.w = cvt_pk_bf16(o[6], o[7]);
                *(u32x4*)rowp = w; }
    }
};

template <class Epi, class Sched, bool ALIGN_EPI = true, bool SP2 = true>
__device__ __forceinline__ void gemm_phase(PG8_LAS unsigned char* lds, const Gemm g, const Sched& S, const Epi& E) {
    const int tid = threadIdx.x, wid = __builtin_amdgcn_readfirstlane(tid >> 6), lane = tid & 63, wr = wid >> 2, wc = wid & 3, fr = lane & 15, fq = lane >> 4;
    const int K = g.K, nt = K / BK;
    unsigned voffA[2], voffB[2];
#pragma unroll
    for (int i = 0; i < 2; ++i) { int R, C; stage_rc(tid * 16 + i * 8192, R, C);
        voffA[i] = (unsigned)(R * g.lda + C) * 2u; voffB[i] = (unsigned)(R * K + C) * 2u; }
    const size_t kstep = (size_t)(BK * 2);
    const size_t hstepA = (size_t)HALF * g.lda * 2, hstepB = (size_t)HALF * K * 2;
    const size_t tstepA = 2 * hstepA, tstepB = 2 * hstepB;
    const unsigned ldsw = (unsigned)wid * 1024u;
    const int aoff = lds_byte(wr * 64 + fr, fq * 8), boff = lds_byte(wc * 32 + fr, fq * 8);
#define PG8_SA(b, h) (((b) * 2 + (h)) * HTB)
#define PG8_SB(b, h) ((4 + (b) * 2 + (h)) * HTB)
#define PG8_STAGE(bufoff, gbase, voff) do { _Pragma("unroll") for (int _i = 0; _i < 2; ++_i) \
        __builtin_amdgcn_global_load_lds((const unsigned*)((const char*)(gbase) + (voff)[_i]), (PG8_LAS unsigned*)(lds + (bufoff) + ldsw + _i * 8192), 16, 0, 0); } while (0)
#define PG8_LDA(dst, b, h) do { _Pragma("unroll") for (int m = 0; m < 4; ++m) _Pragma("unroll") for (int k = 0; k < 2; ++k) dst[m][k] = *(const PG8_LAS bf16x8*)(lds + PG8_SA(b, h) + aoff + m * 2048 + k * 1024); } while (0)
#define PG8_LDB(dst, b, h) do { _Pragma("unroll") for (int n = 0; n < 2; ++n) _Pragma("unroll") for (int k = 0; k < 2; ++k) dst[n][k] = *(const PG8_LAS bf16x8*)(lds + PG8_SB(b, h) + boff + n * 2048 + k * 1024); } while (0)
#define PG8_MMA(ai, bj, At, Bt) do { __builtin_amdgcn_s_setprio(1); _Pragma("unroll") for (int m = 0; m < 4; ++m) _Pragma("unroll") for (int n = 0; n < 2; ++n) _Pragma("unroll") for (int k = 0; k < 2; ++k) \
        acc[ai][bj][m][n] = __builtin_amdgcn_mfma_f32_16x16x32_bf16(Bt[n][k], At[m][k], acc[ai][bj][m][n], 0, 0, 0); __builtin_amdgcn_s_setprio(0); } while (0)
#define PG8_WAIT_V(n) asm volatile("s_waitcnt vmcnt(" #n ")" ::: "memory")
#define PG8_WAIT_L(n) asm volatile("s_waitcnt lgkmcnt(" #n ")" ::: "memory")
#define PG8_BAR __builtin_amdgcn_s_barrier()
#define PG8_SCHED __builtin_amdgcn_sched_barrier(0)
    Unit cur, nxt; int ui = 0;
    if (!S.next(0, cur)) return;
    f32x4 acc[2][2][4][2];
#pragma unroll
    for (int a = 0; a < 2; ++a)
#pragma unroll
        for (int b = 0; b < 2; ++b)
#pragma unroll
            for (int m = 0; m < 4; ++m)
#pragma unroll
                for (int n = 0; n < 2; ++n) acc[a][b][m][n] = (f32x4){0.f, 0.f, 0.f, 0.f};
    bf16x8 At[4][2], B0[2][2], B1[2][2];
    const char* cA = (const char*)g.A + (size_t)cur.pm * tstepA + (size_t)cur.aoff * 2; const char* cB = (const char*)g.Bt + (size_t)cur.pn * tstepB;
    if constexpr (SP2) {
        PG8_STAGE(PG8_SB(0, 0), cB, voffB); PG8_STAGE(PG8_SB(0, 1), cB + hstepB, voffB); PG8_STAGE(PG8_SA(0, 0), cA, voffA); PG8_STAGE(PG8_SA(0, 1), cA + hstepA, voffA);
        if (wr == 1) PG8_BAR;
        PG8_WAIT_V(2); PG8_BAR;
        PG8_STAGE(PG8_SB(1, 0), cB + kstep, voffB); PG8_STAGE(PG8_SA(1, 0), cA + kstep, voffA); PG8_STAGE(PG8_SB(1, 1), cB + hstepB + kstep, voffB);
        PG8_WAIT_V(6); PG8_BAR;
    } else {
        PG8_STAGE(PG8_SB(0, 0), cB, voffB); PG8_STAGE(PG8_SA(0, 0), cA, voffA); PG8_STAGE(PG8_SB(0, 1), cB + hstepB, voffB); PG8_STAGE(PG8_SA(0, 1), cA + hstepA, voffA);
        if (wr == 1) PG8_BAR;
        PG8_WAIT_V(4); PG8_BAR;
        PG8_STAGE(PG8_SB(1, 0), cB + kstep, voffB); PG8_STAGE(PG8_SA(1, 0), cA + kstep, voffA); PG8_STAGE(PG8_SB(1, 1), cB + hstepB + kstep, voffB);
        PG8_WAIT_V(6); PG8_BAR;
    }
    for (;;) {
        const bool has_next = S.next(ui + 1, nxt);
        const char* nA = has_next ? (const char*)g.A + (size_t)nxt.pm * tstepA + (size_t)nxt.aoff * 2 : cA; const char* nB = has_next ? (const char*)g.Bt + (size_t)nxt.pn * tstepB : cB;
        for (int t = 0; t < nt; t += 2) {
            const bool last = (t == nt - 2);
            const char* a1 = cA + (size_t)(t + 1) * kstep;
            const char* a2 = last ? nA : cA + (size_t)(t + 2) * kstep; const char* b2 = last ? nB : cB + (size_t)(t + 2) * kstep;
            const char* a3 = a2 + kstep; const char* b3 = b2 + kstep;
            if constexpr (SP2) {
            PG8_LDB(B0, 0, 0); PG8_LDB(B1, 0, 1); PG8_SCHED; PG8_LDA(At, 0, 0); PG8_STAGE(PG8_SA(1, 1), a1 + hstepA, voffA);
            PG8_WAIT_V(8); PG8_WAIT_L(0); PG8_BAR; PG8_MMA(0, 0, At, B0); PG8_MMA(0, 1, At, B1); PG8_BAR; PG8_SCHED;
            PG8_LDA(At, 0, 1); PG8_STAGE(PG8_SB(0, 0), b2, voffB); PG8_STAGE(PG8_SB(0, 1), b2 + hstepB, voffB); PG8_STAGE(PG8_SA(0, 0), a2, voffA);
            PG8_WAIT_V(8); PG8_WAIT_L(0); PG8_BAR; PG8_MMA(1, 0, At, B0); PG8_MMA(1, 1, At, B1); PG8_BAR; PG8_SCHED;
            PG8_LDB(B0, 1, 0); PG8_LDB(B1, 1, 1); PG8_SCHED; PG8_LDA(At, 1, 0); PG8_STAGE(PG8_SA(0, 1), a2 + hstepA, voffA);
            PG8_WAIT_V(8); PG8_WAIT_L(0); PG8_BAR; PG8_MMA(0, 0, At, B0); PG8_MMA(0, 1, At, B1); PG8_BAR; PG8_SCHED;
            PG8_LDA(At, 1, 1); PG8_STAGE(PG8_SB(1, 0), b3, voffB); PG8_STAGE(PG8_SB(1, 1), b3 + hstepB, voffB); PG8_STAGE(PG8_SA(1, 0), a3, voffA);
            PG8_WAIT_V(8); PG8_WAIT_L(0); PG8_BAR; PG8_MMA(1, 0, At, B0); PG8_MMA(1, 1, At, B1); PG8_BAR; PG8_SCHED;
            } else {
            PG8_LDB(B0, 0, 0); PG8_SCHED; PG8_LDA(At, 0, 0); PG8_STAGE(PG8_SA(1, 1), a1 + hstepA, voffA);
            PG8_WAIT_L(8); PG8_BAR; PG8_WAIT_L(0); PG8_MMA(0, 0, At, B0); PG8_BAR; PG8_SCHED;
            PG8_LDB(B1, 0, 1); PG8_STAGE(PG8_SB(0, 0), b2, voffB);
            PG8_BAR; PG8_WAIT_L(0); PG8_MMA(0, 1, At, B1); PG8_BAR;
            PG8_LDA(At, 0, 1); PG8_STAGE(PG8_SA(0, 0), a2, voffA);
            PG8_BAR; PG8_WAIT_L(0); PG8_MMA(1, 0, At, B0); PG8_BAR; PG8_SCHED;
            PG8_STAGE(PG8_SB(0, 1), b2 + hstepB, voffB);
            PG8_WAIT_V(6); PG8_BAR; PG8_MMA(1, 1, At, B1); PG8_BAR;
            PG8_LDB(B0, 1, 0); PG8_SCHED; PG8_LDA(At, 1, 0); PG8_STAGE(PG8_SA(0, 1), a2 + hstepA, voffA);
            PG8_WAIT_L(8); PG8_BAR; PG8_WAIT_L(0); PG8_MMA(0, 0, At, B0); PG8_BAR; PG8_SCHED;
            PG8_LDB(B1, 1, 1); PG8_STAGE(PG8_SB(1, 0), b3, voffB);
            PG8_BAR; PG8_WAIT_L(0); PG8_MMA(0, 1, At, B1); PG8_BAR;
            PG8_LDA(At, 1, 1); PG8_STAGE(PG8_SA(1, 0), a3, voffA);
            PG8_BAR; PG8_WAIT_L(0); PG8_MMA(1, 0, At, B0); PG8_BAR; PG8_SCHED;
            PG8_STAGE(PG8_SB(1, 1), b3 + hstepB, voffB);
            PG8_WAIT_V(6); PG8_BAR; PG8_MMA(1, 1, At, B1); PG8_BAR;
            }
        }
        if constexpr (ALIGN_EPI) { if (wr == 0) PG8_BAR; }
        E(acc, cur, wr, wc, fr, fq);
        if (!has_next) break;
#pragma unroll
        for (int a = 0; a < 2; ++a)
#pragma unroll
            for (int b = 0; b < 2; ++b)
#pragma unroll
                for (int m = 0; m < 4; ++m)
#pragma unroll
                    for (int n = 0; n < 2; ++n) acc[a][b][m][n] = (f32x4){0.f, 0.f, 0.f, 0.f};
        cur = nxt; cA = nA; cB = nB; ++ui;
        if constexpr (ALIGN_EPI) { if (wr == 1) PG8_BAR; }
    }
    PG8_WAIT_V(0);
    if constexpr (!ALIGN_EPI) { if (wr == 0) PG8_BAR; }
    PG8_BAR;
#undef PG8_SA
#undef PG8_SB
#undef PG8_STAGE
#undef PG8_LDA
#undef PG8_LDB
#undef PG8_MMA
#undef PG8_WAIT_V
#undef PG8_WAIT_L
#undef PG8_BAR
#undef PG8_SCHED
}
}


#define LDS_BARRIER() do { asm volatile("s_waitcnt lgkmcnt(0)" ::: "memory"); __builtin_amdgcn_s_barrier(); asm volatile("" ::: "memory"); } while (0)
namespace ml {
#define LAS __attribute__((address_space(3)))
typedef short bf16x8 __attribute__((ext_vector_type(8)));
typedef float f32x4 __attribute__((ext_vector_type(4)));
typedef unsigned u32x4 __attribute__((ext_vector_type(4)));
constexpr int NVB = 4, EV = MD / NVB;
constexpr int PQ = 272, PT = 144;
constexpr int L_QS = 0, L_KS = L_QS + 64 * PQ, L_KT = L_KS + 64 * PQ, L_VT = L_KT + 128 * PT, L_SB = L_VT + 48 * PT, L_CT = L_SB + 64 * PT,
              L_HS = L_CT + 48 * PQ, L_SC = L_HS + 64 * 80, L_END = L_SC + 4096;
static_assert(L_END <= 131072, "mLSTM LDS map");
enum { SC_A = 0, SC_PM = 64, SC_WI = 128, SC_EMT = 192, SC_WE = 256, SC_DEN = 320, SC_MISC = 384 };
__device__ __forceinline__ f32x4 mma(bf16x8 a, bf16x8 b, f32x4 c) { return __builtin_amdgcn_mfma_f32_16x16x32_bf16(a, b, c, 0, 0, 0); }
__device__ __forceinline__ bf16x8 frag(LAS unsigned char* lds, int base, int pitch, int row0, int k0, int lane) {
    return *(const LAS bf16x8*)(lds + base + (row0 + (lane & 15)) * pitch + (k0 + 8 * (lane >> 4)) * 2);
}
__device__ __forceinline__ void mlstm_item(LAS unsigned char* lds, CParams& P, int l, int s, int head, int dir, int vb) {
    const int tid = threadIdx.x, w = __builtin_amdgcn_readfirstlane(tid >> 6), lane = tid & 63, fr = lane & 15, fq = lane >> 4;
    const int rt = w & 3, half = w >> 2;
    const SeqInfo q = seqinfo(s); const int nchunk = q.T / 64;
    const bf16* QK = WSP(bf16, WS_QKC); bf16* U = WSP(bf16, WS_U1);
    LAS float* SC = (LAS float*)(lds + L_SC);
    f32x4 cacc[3];
    float m_prev;
    if (!q.grid) { cacc[0] = cacc[1] = cacc[2] = (f32x4){0.f, 0.f, 0.f, 0.f}; m_prev = 0.f; }
    else {
        const size_t sb = (((size_t)q.b * DEPTH + l) * 2 + dir) * MH + head; const int d = 16 * w + fr;
#pragma unroll
        for (int et = 0; et < 2; ++et)
#pragma unroll
            for (int r = 0; r < 4; ++r) cacc[et][r] = P.in[ST_C][(sb * 128 + d) * 128 + vb * EV + 16 * et + 4 * fq + r];
        cacc[2] = (f32x4){0.f, 0.f, 0.f, 0.f}; if (fq == 0) cacc[2][0] = P.in[ST_N][sb * 128 + d];
        m_prev = P.in[ST_M][sb];
    }
    const float bi = P.in[M_GATE_B][(size_t)l * 4 * MH + (2 * dir) * MH + head], bfg = P.in[M_GATE_B][(size_t)l * 4 * MH + (2 * dir + 1) * MH + head];
    for (int i = tid; i < 16 * 64; i += 512) { const int r = i >> 6, c = i & 63; *(LAS bf16*)(lds + L_VT + (32 + r) * PT + c * 2) = (r == 0) ? (bf16)0x3f80 : (bf16)0; }
    u32x4 pqk[4]; u32x4 pv; bf16 pgi = 0, pgf = 0;
#define ML_TOK(c, j) ((size_t)(q.base + (dir ? q.T - 1 - ((c) * 64 + (j)) : ((c) * 64 + (j)))))
#define ML_PREFETCH(c) do { _Pragma("unroll") for (int i = 0; i < 4; ++i) { const int id = tid + 512 * i, j = id >> 5, pc = id & 31; \
            pqk[i] = *(const u32x4*)(QK + ML_TOK(c, j) * (2 * MW) + (pc < 16 ? head * 128 + 8 * pc : MW + head * 128 + 8 * (pc - 16))); } \
        if (tid < 256) { const int j = tid >> 2, pc = tid & 3; pv = *(const u32x4*)(U + ML_TOK(c, j) * PU + OFF_V + head * 128 + vb * EV + 8 * pc); } \
        if (w == 0) { const bf16* g = U + ML_TOK(c, lane) * PU + OFF_G; pgi = g[(2 * dir) * MH + head]; pgf = g[(2 * dir + 1) * MH + head]; } } while (0)
    ML_PREFETCH(0);
    for (int c = 0; c < nchunk; ++c) {
#pragma unroll
        for (int i = 0; i < 4; ++i) { const int id = tid + 512 * i, j = id >> 5, pc = id & 31;
            *(LAS u32x4*)(lds + (pc < 16 ? L_QS : L_KS) + j * PQ + (pc & 15) * 16) = pqk[i]; }
        if (tid < 256) { const int j = tid >> 2, pc = tid & 3; const unsigned wv[4] = {pv.x, pv.y, pv.z, pv.w};
#pragma unroll
            for (int e = 0; e < 8; ++e) *(LAS bf16*)(lds + L_VT + (8 * pc + e) * PT + j * 2) = (bf16)((wv[e >> 1] >> ((e & 1) * 16)) & 0xffffu); }
#pragma unroll
        for (int et = 0; et < 3; ++et)
#pragma unroll
            for (int r = 0; r < 4; ++r) *(LAS bf16*)(lds + L_CT + (16 * et + 4 * fq + r) * PQ + (16 * w + fr) * 2) = f2bf(cacc[et][r]);
        float wie = 1.f;
        if (w == 0) {
            const float gi = bf2f(pgi) + bi, gf = bf2f(pgf) + bfg;
            const float lf = fminf(gf, 0.f) - log1pf(__expf(-fabsf(gf)));
            float b = lf;
#pragma unroll
            for (int o = 1; o < 64; o <<= 1) { const float t = __shfl_up(b, o); if (lane >= o) b += t; }
            const float a = gi - b; float pm = a;
#pragma unroll
            for (int o = 1; o < 64; o <<= 1) { const float t = __shfl_up(pm, o); if (lane >= o) pm = fmaxf(pm, t); }
            pm = fmaxf(pm, m_prev);
            const float pm63 = __shfl(pm, 63), b63 = __shfl(b, 63);
            SC[SC_A + lane] = a; SC[SC_PM + lane] = pm; SC[SC_WI + lane] = __expf(m_prev - pm); SC[SC_EMT + lane] = __expf(-(b + pm)); SC[SC_WE + lane] = __expf(a - pm63);
            if (lane == 0) { SC[SC_MISC] = __expf(m_prev - pm63); SC[SC_MISC + 1] = b63 + pm63; }
        }
        LDS_BARRIER();
        if (c + 1 < nchunk) ML_PREFETCH(c + 1);
        wie = SC[SC_MISC]; m_prev = SC[SC_MISC + 1];
#pragma unroll
        for (int i = 0; i < 2; ++i) { const int id = tid + 512 * i, j = id >> 4, pc = id & 15; const float we = SC[SC_WE + j];
            const u32x4 kv = *(const LAS u32x4*)(lds + L_KS + j * PQ + pc * 16); const unsigned wv[4] = {kv.x, kv.y, kv.z, kv.w};
#pragma unroll
            for (int e = 0; e < 8; ++e) { const float kf = __builtin_bit_cast(float, (e & 1) ? (wv[e >> 1] & 0xffff0000u) : (wv[e >> 1] << 16));
                *(LAS bf16*)(lds + L_KT + (8 * pc + e) * PT + j * 2) = f2bf(kf * we); } }
#pragma unroll
        for (int cc = 0; cc < 2; ++cc) { const int ct = 2 * half + cc;
            f32x4 acc = (f32x4){0.f, 0.f, 0.f, 0.f};
            if (ct <= rt) {
#pragma unroll
                for (int k = 0; k < 4; ++k) acc = mma(frag(lds, L_QS, PQ, 16 * rt, 32 * k, lane), frag(lds, L_KS, PQ, 16 * ct, 32 * k, lane), acc);
            }
            const int sp = 16 * ct + fr; const float as = SC[SC_A + sp];
#pragma unroll
            for (int r = 0; r < 4; ++r) { const int t = 16 * rt + 4 * fq + r; const float v = (sp <= t) ? acc[r] * __expf(as - SC[SC_PM + t]) : 0.f;
                *(LAS bf16*)(lds + L_SB + t * PT + sp * 2) = f2bf(v); } }
        LDS_BARRIER();
        f32x4 nacc[2]; const int nct = half ? 1 : 2;
#pragma unroll
        for (int cc = 0; cc < 2; ++cc) { if (cc < nct) { const int ct = half ? 2 : cc;
            f32x4 a1 = (f32x4){0.f, 0.f, 0.f, 0.f}, a2 = (f32x4){0.f, 0.f, 0.f, 0.f};
#pragma unroll
            for (int k = 0; k < 2; ++k) a1 = mma(frag(lds, L_SB, PT, 16 * rt, 32 * k, lane), frag(lds, L_VT, PT, 16 * ct, 32 * k, lane), a1);
#pragma unroll
            for (int k = 0; k < 4; ++k) a2 = mma(frag(lds, L_QS, PQ, 16 * rt, 32 * k, lane), frag(lds, L_CT, PQ, 16 * ct, 32 * k, lane), a2);
#pragma unroll
            for (int r = 0; r < 4; ++r) a1[r] += SC[SC_WI + 16 * rt + 4 * fq + r] * a2[r];
            nacc[cc] = a1; } }
        if (half && fr == 0) {
#pragma unroll
            for (int r = 0; r < 4; ++r) SC[SC_DEN + 16 * rt + 4 * fq + r] = nacc[0][r];
        }
#pragma unroll
        for (int et = 0; et < 3; ++et) { cacc[et] = cacc[et] * wie;
#pragma unroll
            for (int k = 0; k < 2; ++k) cacc[et] = mma(frag(lds, L_VT, PT, 16 * et, 32 * k, lane), frag(lds, L_KT, PT, 16 * w, 32 * k, lane), cacc[et]); }
        LDS_BARRIER();
        if (!half) {
#pragma unroll
            for (int cc = 0; cc < 2; ++cc)
#pragma unroll
                for (int r = 0; r < 4; ++r) { const int t = 16 * rt + 4 * fq + r; const float den = fmaxf(fabsf(SC[SC_DEN + t]), SC[SC_EMT + t]);
                    *(LAS bf16*)(lds + L_HS + t * 80 + (16 * cc + fr) * 2) = f2bf(nacc[cc][r] / den); }
        }
        LDS_BARRIER();
        if (tid < 256) { const int j = tid >> 2, pc = tid & 3;
            *(u32x4*)(U + ML_TOK(c, j) * PU + dir * MW + head * 128 + vb * EV + 8 * pc) = *(const LAS u32x4*)(lds + L_HS + j * 80 + pc * 16); }
    }
    if (!q.grid) {
        const size_t sb = (((size_t)q.b * DEPTH + l) * 2 + dir) * MH + head; const int d = 16 * w + fr;
#pragma unroll
        for (int et = 0; et < 2; ++et)
#pragma unroll
            for (int r = 0; r < 4; ++r) P.out[OUT_C + (sb * 128 + d) * 128 + vb * EV + 16 * et + 4 * fq + r] = cacc[et][r];
        if (vb == 0) { if (fq == 0) P.out[OUT_N + sb * 128 + d] = cacc[2][0]; if (tid == 0) P.out[OUT_M + sb] = m_prev; }
    }
    LDS_BARRIER();
#undef ML_TOK
#undef ML_PREFETCH
}
constexpr int N_ITEMS = NSEQ * MH * 2 * NVB;
__device__ __forceinline__ void decode_item(int it, int& s, int& head, int& dir, int& vb) {
    vb = it % NVB; int ch = it / NVB; dir = ch & 1; ch >>= 1; head = ch % MH; const int sq = ch / MH;
    s = sq < LB ? CB + sq : sq - LB;
}
}


namespace rw {
typedef short bf16x8 __attribute__((ext_vector_type(8)));
typedef float f32x4 __attribute__((ext_vector_type(4)));
typedef unsigned u32x4 __attribute__((ext_vector_type(4)));
enum { V_A = 0, V_W, V_B, V_K, V_R, NVEC };
constexpr int REC = NVEC * 64 * 4;
constexpr int PT = 144;
constexpr int L_SBUF = 0, L_VT = L_SBUF + 64 * REC, L_TW = L_VT + 64 * 256, L_AL = L_TW + 64 * PT, L_YS = L_AL + 64 * PT, L_INV = L_YS + 64 * 16 * 4, L_END = L_INV + 256;
__device__ __forceinline__ int vt_off(int row, int tt) { return row * 256 + ((tt ^ (((row >> 3) & 7) << 2)) << 2); }
static_assert(L_END <= 131072, "RWKV LDS map");
__device__ __forceinline__ float dpp_xor1(float x) { return __builtin_bit_cast(float, __builtin_amdgcn_update_dpp(0, __builtin_bit_cast(int, x), 0xB1, 0xF, 0xF, true)); }
__device__ __forceinline__ float dpp_xor2(float x) { return __builtin_bit_cast(float, __builtin_amdgcn_update_dpp(0, __builtin_bit_cast(int, x), 0x4E, 0xF, 0xF, true)); }
__device__ __forceinline__ float dpp_ror4(float x) { return __builtin_bit_cast(float, __builtin_amdgcn_update_dpp(0, __builtin_bit_cast(int, x), 0x124, 0xF, 0xF, true)); }
__device__ __forceinline__ float dpp_ror8(float x) { return __builtin_bit_cast(float, __builtin_amdgcn_update_dpp(0, __builtin_bit_cast(int, x), 0x128, 0xF, 0xF, true)); }
__device__ __forceinline__ float allsum16(float x) { x += dpp_xor1(x); x += dpp_xor2(x); x += dpp_ror4(x); x += dpp_ror8(x); return x; }
__device__ __forceinline__ f32x4 cvt_lo4(unsigned a, unsigned b) { return (f32x4){__builtin_bit_cast(float, a << 16), __builtin_bit_cast(float, a & 0xffff0000u), __builtin_bit_cast(float, b << 16), __builtin_bit_cast(float, b & 0xffff0000u)}; }
__device__ __forceinline__ float allsum32(float x) {
    x = allsum16(x);
    float xa = x, xb = x;
    asm volatile("v_mov_b32 %1, %0\n\ts_nop 1\n\tv_permlane32_swap_b32 %0, %1\n\ts_nop 1" : "+v"(xa), "=&v"(xb));
    return xa + xb;
}
__device__ __forceinline__ void rwkv_item(LAS unsigned char* lds, CParams& P, int l, int s, int head, int dir, int rh) {
    const int tid = threadIdx.x, w = __builtin_amdgcn_readfirstlane(tid >> 6), lane = tid & 63, fr = lane & 15, fq = lane >> 4;
    const int rt = w & 3, half = w >> 2, hc = head * 64;
    const SeqInfo q = seqinfo(s); const int nchunk = q.T / 64;
    const bf16* RX = WSP(bf16, WS_RXC); bf16* U = WSP(bf16, WS_U1);
    const int pj = tid >> 3, psub = tid & 7;
    const int hh = lane >> 5, rsel = (lane >> 4) & 1, cg = lane & 15;
    const int row = 16 * rh + 2 * w + rsel, col0 = 32 * hh + 2 * cg;
    typedef float f32x2 __attribute__((ext_vector_type(2)));
    f32x2 S2;
    if (!q.grid) S2 = (f32x2){0.f, 0.f};
    else { const size_t sb = (((size_t)q.b * DEPTH + l) * 2 + dir) * RH + head; S2 = *(const f32x2*)(P.in[ST_R] + (sb * 64 + row) * 64 + col0); }
    float rkk8[8];
#pragma unroll
    for (int e = 0; e < 8; ++e) rkk8[e] = P.in[R_KK][(size_t)l * RW + hc + 8 * psub + e];
    float c_w0[2], c_a0[2], c_kk[2], c_ka[2];
    bf16x8 bw[2][2], ba[2][2];
#pragma unroll
    for (int cc = 0; cc < 2; ++cc) { const int c = 16 * (2 * half + cc) + fr;
        c_w0[cc] = P.in[R_W0][((size_t)l * 2 + dir) * RW + hc + c]; c_a0[cc] = P.in[R_A0][((size_t)l * 2 + dir) * RW + hc + c];
        c_kk[cc] = P.in[R_KK][(size_t)l * RW + hc + c]; c_ka[cc] = P.in[R_KA][(size_t)l * RW + hc + c];
#pragma unroll
        for (int ks = 0; ks < 2; ++ks)
#pragma unroll
            for (int e = 0; e < 8; ++e) { const int j = 32 * ks + 8 * fq + e;
                bw[cc][ks][e] = (short)f2bf(P.in[R_W2][(((size_t)l * 2 + dir) * 64 + j) * RW + hc + c]);
                ba[cc][ks][e] = (short)f2bf(P.in[R_A2][(((size_t)l * 2 + dir) * 64 + j) * RW + hc + c]); } }
    u32x4 pf[5];
#define RW_TOK(c, j) ((size_t)(q.base + (dir ? q.T - 1 - ((c) * 64 + (j)) : ((c) * 64 + (j)))))
#define RW_PREFETCH(c) do { const bf16* rx = RX + RW_TOK(c, pj) * RIN + 8 * psub; \
        pf[0] = *(const u32x4*)(rx + RX_R + hc); pf[1] = *(const u32x4*)(rx + RX_K + hc); pf[2] = *(const u32x4*)(rx + RX_V + hc); \
        pf[3] = *(const u32x4*)(rx + RX_WL + dir * 64); pf[4] = *(const u32x4*)(rx + RX_AL + dir * 64); } while (0)
    RW_PREFETCH(0);
    for (int c = 0; c < nchunk; ++c) {
        { LAS unsigned char* rec = lds + L_SBUF + pj * REC + psub * 32;
          *(LAS f32x4*)(rec + V_R * 256) = cvt_lo4(pf[0].x, pf[0].y); *(LAS f32x4*)(rec + V_R * 256 + 16) = cvt_lo4(pf[0].z, pf[0].w);
          { const f32x4 v0 = cvt_lo4(pf[2].x, pf[2].y), v1 = cvt_lo4(pf[2].z, pf[2].w);
#pragma unroll
            for (int e = 0; e < 4; ++e) { *(LAS float*)(lds + L_VT + vt_off(8 * psub + e, pj)) = v0[e]; *(LAS float*)(lds + L_VT + vt_off(8 * psub + 4 + e, pj)) = v1[e]; } }
          const f32x4 k0 = cvt_lo4(pf[1].x, pf[1].y), k1 = cvt_lo4(pf[1].z, pf[1].w);
          *(LAS f32x4*)(rec + V_K * 256) = k0; *(LAS f32x4*)(rec + V_K * 256 + 16) = k1;
          float ss = 0.f;
#pragma unroll
          for (int e = 0; e < 4; ++e) { const float x0 = k0[e] * rkk8[e], x1 = k1[e] * rkk8[4 + e]; ss += x0 * x0 + x1 * x1; }
          ss += dpp_xor1(ss); ss += dpp_xor2(ss); ss += __shfl_xor(ss, 4);
          if (psub == 0) *(LAS float*)(lds + L_INV + pj * 4) = 1.0f / fmaxf(sqrtf(ss), 1e-12f);
          *(LAS u32x4*)(lds + L_TW + pj * PT + psub * 16) = pf[3]; *(LAS u32x4*)(lds + L_AL + pj * PT + psub * 16) = pf[4]; }
        __syncthreads();
        if (c + 1 < nchunk) RW_PREFETCH(c + 1);
#pragma unroll
        for (int cc = 0; cc < 2; ++cc) { const int ct = 2 * half + cc; const int cidx = 16 * ct + fr;
            f32x4 aw = (f32x4){0.f, 0.f, 0.f, 0.f}, aa = (f32x4){0.f, 0.f, 0.f, 0.f};
#pragma unroll
            for (int ks = 0; ks < 2; ++ks) { aw = ml::mma(ml::frag(lds, L_TW, PT, 16 * rt, 32 * ks, lane), bw[cc][ks], aw); aa = ml::mma(ml::frag(lds, L_AL, PT, 16 * rt, 32 * ks, lane), ba[cc][ks], aa); }
#pragma unroll
            for (int r = 0; r < 4; ++r) { const int tok = 16 * rt + 4 * fq + r; LAS float* rec = (LAS float*)(lds + L_SBUF + tok * REC) + cidx;
                const float decay = __expf(-0.6065306597126334f * pg8::fsigmoid(c_w0[cc] + aw[r])); const float alpha = pg8::fsigmoid(c_a0[cc] + aa[r]);
                const float kraw = rec[V_K * 64]; const float kkn = kraw * c_kk[cc] * *(LAS float*)(lds + L_INV + tok * 4);
                rec[V_A * 64] = -kkn; rec[V_W * 64] = decay; rec[V_B * 64] = kkn * alpha; rec[V_K * 64] = kraw * (1.0f + (alpha - 1.0f) * c_ka[cc]); } }
        __syncthreads();
        {
            const LAS unsigned char* rbase = lds + L_SBUF + col0 * 4;
            f32x2 ca = *(const LAS f32x2*)(rbase + V_A * 256), cw = *(const LAS f32x2*)(rbase + V_W * 256), cb = *(const LAS f32x2*)(rbase + V_B * 256),
                  ck = *(const LAS f32x2*)(rbase + V_K * 256), cr = *(const LAS f32x2*)(rbase + V_R * 256);
#pragma unroll 1
            for (int blk = 0; blk < 4; ++blk) {
                float ykeep = 0.f;
#pragma unroll
                for (int g4 = 0; g4 < 4; ++g4) {
                    const f32x4 v4 = *(const LAS f32x4*)(lds + L_VT + vt_off(row, 16 * blk + 4 * g4));
#pragma unroll
                    for (int i4 = 0; i4 < 4; ++i4) {
                        const int i = 4 * g4 + i4, tt = 16 * blk + i, tn = tt < 63 ? tt + 1 : 63;
                        const LAS unsigned char* rn = rbase + tn * REC;
                        const f32x2 na = *(const LAS f32x2*)(rn + V_A * 256), nw = *(const LAS f32x2*)(rn + V_W * 256), nb = *(const LAS f32x2*)(rn + V_B * 256),
                                    nk = *(const LAS f32x2*)(rn + V_K * 256), nr = *(const LAS f32x2*)(rn + V_R * 256);
                        const float vv = v4[i4];
                        const f32x2 p = S2 * ca;
                        const float sa = allsum32(p.x + p.y);
                        S2 = S2 * cw + ck * vv;
                        S2 = cb * sa + S2;
                        const f32x2 yq = S2 * cr;
                        const float y = allsum32(yq.x + yq.y);
                        ykeep = (cg == i) ? y : ykeep;
                        ca = na; cw = nw; cb = nb; ck = nk; cr = nr;
                    }
                }
                if (hh == 0) *(LAS float*)(lds + L_YS + ((16 * blk + cg) * 16 + 2 * w + rsel) * 4) = ykeep;
            }
        }
        __syncthreads();
        if (tid < 128) { const int j = tid >> 1, pc = tid & 1; const LAS float* ys = (const LAS float*)(lds + L_YS) + j * 16 + 8 * pc;
            u32x4 o; o.x = pg8::cvt_pk_bf16(ys[0], ys[1]); o.y = pg8::cvt_pk_bf16(ys[2], ys[3]); o.z = pg8::cvt_pk_bf16(ys[4], ys[5]); o.w = pg8::cvt_pk_bf16(ys[6], ys[7]);
            *(u32x4*)(U + RW_TOK(c, j) * PU + OFF_R + dir * RW + hc + 16 * rh + 8 * pc) = o; }
    }
    if (!q.grid) { const size_t sb = (((size_t)q.b * DEPTH + l) * 2 + dir) * RH + head; *(f32x2*)(P.out + OUT_S + (sb * 64 + row) * 64 + col0) = S2; }
    __syncthreads();
#undef RW_TOK
#undef RW_PREFETCH
}
constexpr int N_ITEMS = NSEQ * RH * 2 * 4;
__device__ __forceinline__ void decode_item(int it, int& s, int& head, int& dir, int& rh) {
    rh = it & 3; int ch = it >> 2; dir = ch & 1; ch >>= 1; head = ch % RH; const int sq = ch / RH;
    s = sq < LB ? CB + sq : sq - LB;
}
}


namespace wy {
typedef short bf16x8 __attribute__((ext_vector_type(8)));
typedef float f32x4 __attribute__((ext_vector_type(4)));
typedef unsigned u32x4 __attribute__((ext_vector_type(4)));
constexpr int PV = 144, PS = 48;
constexpr int L_AH = 0, L_RH = L_AH + 64 * PV, L_BT = L_RH + 64 * PV, L_KT = L_BT + 64 * PV, L_VS = L_KT + 64 * PV, L_NAKT = L_VS + 64 * PV, L_NRKT = L_NAKT + 4 * 16 * PS,
              L_NRBT = L_NRKT + 4 * 16 * PS, L_TT = L_NRBT + 4 * 16 * PS, L_GL = L_TT + 4 * 16 * PS, PACK_BYTES = L_GL + 1024,
              L_BH = PACK_BYTES, L_KH = L_BH + 64 * PV, L_YS = L_KH + 64 * PV, L_TW = L_YS + 64 * PV, L_AL = L_TW + 64 * PV, L_NAB = L_AL + 64 * PV, L_INV = L_NAB + 4096, L_END = L_INV + 256;
constexpr int RING = 4, PACK_U = PACK_BYTES / 16, N_LAT = LB * RH * 2;
static_assert(PACK_BYTES % 16 == 0 && PACK_U <= 8 * 512 && (size_t)N_LAT * RING * PACK_BYTES <= (size_t)N1P * D * 2, "ring lives in the (dead during MX) w_in region");
static_assert(L_END <= 131072, "WY LDS map");
__device__ __forceinline__ bf16x8 fragk16(LAS unsigned char* lds, int base, int pitch, int row0, int k0, int lane) {
    const bf16x8 v = *(const LAS bf16x8*)(lds + base + (row0 + (lane & 15)) * pitch + (k0 + 8 * ((lane >> 4) & 1)) * 2);
    const bf16x8 z = {0, 0, 0, 0, 0, 0, 0, 0};
    return (lane < 32) ? v : z;
}
__device__ __forceinline__ void stb(LAS unsigned char* lds, int off, float v) { *(LAS bf16*)(lds + off) = f2bf(v); }
typedef unsigned u32x2 __attribute__((ext_vector_type(2)));
__device__ __forceinline__ bf16x8 pack_k16(const f32x4 v) { u32x4 o; o.x = pg8::cvt_pk_bf16(v[0], v[1]); o.y = pg8::cvt_pk_bf16(v[2], v[3]); o.z = 0u; o.w = 0u; return __builtin_bit_cast(bf16x8, o); }
__device__ __forceinline__ bf16x8 pack_k32(const f32x4 a, const f32x4 b) { u32x4 o; o.x = pg8::cvt_pk_bf16(a[0], a[1]); o.y = pg8::cvt_pk_bf16(a[2], a[3]); o.z = pg8::cvt_pk_bf16(b[0], b[1]); o.w = pg8::cvt_pk_bf16(b[2], b[3]);
    return __builtin_bit_cast(bf16x8, o); }
__device__ __forceinline__ bf16x8 ld_k16(LAS unsigned char* lds, int base, int pitch, int row0, int col0, int lane) {
    const u32x2 v = *(const LAS u32x2*)(lds + base + (row0 + (lane & 15)) * pitch + (col0 + 4 * (lane >> 4)) * 2); u32x4 o; o.x = v.x; o.y = v.y; o.z = 0u; o.w = 0u; return __builtin_bit_cast(bf16x8, o); }
__device__ __forceinline__ bf16x8 ld_k32(LAS unsigned char* lds, int base, int pitch, int row0, int col0, int lane) {
    const LAS unsigned char* p = lds + base + (row0 + (lane & 15)) * pitch + (col0 + 4 * (lane >> 4)) * 2;
    const u32x2 v0 = *(const LAS u32x2*)p, v1 = *(const LAS u32x2*)(p + 32); u32x4 o; o.x = v0.x; o.y = v0.y; o.z = v1.x; o.w = v1.y; return __builtin_bit_cast(bf16x8, o); }
__device__ __forceinline__ void rwkv_item(LAS unsigned char* lds, CParams& P, int l, int s, int head, int dir) {
    const int tid = threadIdx.x, w = __builtin_amdgcn_readfirstlane(tid >> 6), lane = tid & 63, fr = lane & 15, fq = lane >> 4;
    const int rt = w & 3, half = w >> 2, hc = head * 64;
    const SeqInfo q = seqinfo(s); const int nchunk = q.T / 64;
    const bf16* RX = WSP(bf16, WS_RXC); bf16* U = WSP(bf16, WS_U1);
    const int pj = tid >> 3, psub = tid & 7;
    f32x4 sacc[4];
#pragma unroll
    for (int ct = 0; ct < 4; ++ct) sacc[ct] = (f32x4){0.f, 0.f, 0.f, 0.f};
    if (w < 4 && q.grid) { const size_t sb = (((size_t)q.b * DEPTH + l) * 2 + dir) * RH + head;
#pragma unroll
        for (int ct = 0; ct < 4; ++ct) sacc[ct] = *(const f32x4*)(P.in[ST_R] + (sb * 64 + 16 * w + fr) * 64 + 16 * ct + 4 * fq); }
    float rkk8[8];
#pragma unroll
    for (int e = 0; e < 8; ++e) rkk8[e] = P.in[R_KK][(size_t)l * RW + hc + 8 * psub + e];
    float c_w0[2], c_a0[2], c_kk[2], c_ka[2];
#pragma unroll
    for (int cc = 0; cc < 2; ++cc) { const int c = 16 * (2 * half + cc) + fr;
        c_w0[cc] = P.in[R_W0][((size_t)l * 2 + dir) * RW + hc + c]; c_a0[cc] = P.in[R_A0][((size_t)l * 2 + dir) * RW + hc + c];
        c_kk[cc] = P.in[R_KK][(size_t)l * RW + hc + c]; c_ka[cc] = P.in[R_KA][(size_t)l * RW + hc + c]; }
    const bf16* w2t = WSP(bf16, O_W2T) + ((size_t)dir * RW + hc) * 64; const bf16* a2t = WSP(bf16, O_A2T) + ((size_t)dir * RW + hc) * 64;
    u32x4 pf[5];
#define WY_TOK(c, j) ((size_t)(q.base + (dir ? q.T - 1 - ((c) * 64 + (j)) : ((c) * 64 + (j)))))
#define WY_PREFETCH(c) do { const bf16* rx = RX + WY_TOK(c, pj) * RIN + 8 * psub; \
        pf[0] = *(const u32x4*)(rx + RX_R + hc); pf[1] = *(const u32x4*)(rx + RX_K + hc); pf[2] = *(const u32x4*)(rx + RX_V + hc); \
        pf[3] = *(const u32x4*)(rx + RX_WL + dir * 64); pf[4] = *(const u32x4*)(rx + RX_AL + dir * 64); } while (0)
    WY_PREFETCH(0);
    for (int c = 0; c < nchunk; ++c) {
        { *(LAS u32x4*)(lds + L_RH + pj * PV + psub * 16) = pf[0]; *(LAS u32x4*)(lds + L_KH + pj * PV + psub * 16) = pf[1];
          const unsigned kw[4] = {pf[1].x, pf[1].y, pf[1].z, pf[1].w}, vw[4] = {pf[2].x, pf[2].y, pf[2].z, pf[2].w};
          float ss = 0.f;
#pragma unroll
          for (int e = 0; e < 8; ++e) { const float kf = __builtin_bit_cast(float, (e & 1) ? (kw[e >> 1] & 0xffff0000u) : (kw[e >> 1] << 16)) * rkk8[e]; ss += kf * kf;
              *(LAS bf16*)(lds + L_VS + (8 * psub + e) * PV + pj * 2) = (bf16)((vw[e >> 1] >> ((e & 1) * 16)) & 0xffffu); }
          ss += rw::dpp_xor1(ss); ss += rw::dpp_xor2(ss); ss += __shfl_xor(ss, 4);
          if (psub == 0) *(LAS float*)(lds + L_INV + pj * 4) = 1.0f / fmaxf(sqrtf(ss), 1e-12f);
          *(LAS u32x4*)(lds + L_TW + pj * PV + psub * 16) = pf[3]; *(LAS u32x4*)(lds + L_AL + pj * PV + psub * 16) = pf[4]; }
        LDS_BARRIER();
        if (c + 1 < nchunk) WY_PREFETCH(c + 1);
#pragma unroll
        for (int cc = 0; cc < 2; ++cc) { const int ct = 2 * half + cc; const int cidx = 16 * ct + fr;
            f32x4 aw = (f32x4){0.f, 0.f, 0.f, 0.f}, aa = (f32x4){0.f, 0.f, 0.f, 0.f};
#pragma unroll
            for (int ks = 0; ks < 2; ++ks) { const size_t bo = (size_t)cidx * 64 + 32 * ks + 8 * fq;
                aw = ml::mma(ml::frag(lds, L_TW, PV, 16 * rt, 32 * ks, lane), *(const bf16x8*)(w2t + bo), aw); aa = ml::mma(ml::frag(lds, L_AL, PV, 16 * rt, 32 * ks, lane), *(const bf16x8*)(a2t + bo), aa); }
            float kr4[4], rr4[4], iv4[4];
#pragma unroll
            for (int r = 0; r < 4; ++r) { const int tok = 16 * rt + 4 * fq + r; kr4[r] = bf2f(*(const LAS bf16*)(lds + L_KH + tok * PV + cidx * 2)); rr4[r] = bf2f(*(const LAS bf16*)(lds + L_RH + tok * PV + cidx * 2));
                iv4[r] = *(const LAS float*)(lds + L_INV + tok * 4); }
            float lw[4], cum[4];
#pragma unroll
            for (int r = 0; r < 4; ++r) { lw[r] = -0.6065306597126334f * pg8::fsigmoid(c_w0[cc] + aw[r]); cum[r] = (r ? cum[r - 1] : 0.f) + lw[r]; }
            const float tot = cum[3]; const float p1 = __shfl_up(tot, 16), p2 = __shfl_up(tot, 32), p3 = __shfl_up(tot, 48);
            const float off = (fq >= 1 ? p1 : 0.f) + (fq >= 2 ? p2 : 0.f) + (fq >= 3 ? p3 : 0.f);
            float gprev = __expf(off);
#pragma unroll
            for (int r = 0; r < 4; ++r) { const int tok = 16 * rt + 4 * fq + r; const float lam = off + cum[r]; const float g = __expf(lam), gi = __builtin_amdgcn_rcpf(g);
                const float alpha = pg8::fsigmoid(c_a0[cc] + aa[r]);
                const float kraw = kr4[r], rraw = rr4[r];
                const float kkn = kraw * c_kk[cc] * iv4[r];
                const bf16 bh = f2bf(kkn * alpha * gi), kh = f2bf(kraw * (1.0f + (alpha - 1.0f) * c_ka[cc]) * gi);
                stb(lds, L_AH + tok * PV + cidx * 2, -kkn * gprev); stb(lds, L_RH + tok * PV + cidx * 2, rraw * g);
                *(LAS bf16*)(lds + L_BH + tok * PV + cidx * 2) = bh; *(LAS bf16*)(lds + L_KH + tok * PV + cidx * 2) = kh;
                *(LAS bf16*)(lds + L_BT + cidx * PV + tok * 2) = bh; *(LAS bf16*)(lds + L_KT + cidx * PV + tok * 2) = kh;
                if (fq == 3 && r == 3) *(LAS float*)(lds + L_GL + (rt * 64 + cidx) * 4) = g;
                gprev = g; } }
        LDS_BARRIER();
        { const int sc = w >> 1, side = w & 1; f32x4 gB = (f32x4){0.f, 0.f, 0.f, 0.f}, gK = (f32x4){0.f, 0.f, 0.f, 0.f};
#pragma unroll
          for (int ks = 0; ks < 2; ++ks) { const bf16x8 af = ml::frag(lds, side ? L_RH : L_AH, PV, 16 * sc, 32 * ks, lane);
              gB = ml::mma(af, ml::frag(lds, L_BH, PV, 16 * sc, 32 * ks, lane), gB); gK = ml::mma(af, ml::frag(lds, L_KH, PV, 16 * sc, 32 * ks, lane), gK); }
#pragma unroll
          for (int r = 0; r < 4; ++r) { const int t = 4 * fq + r; const bool keep = side ? (fr <= t) : (fr < t); const float vB = keep ? gB[r] : 0.f, vK = keep ? gK[r] : 0.f;
              if (side == 0) { *(LAS float*)(lds + L_NAB + ((sc * 16 + t) * 16 + fr) * 4) = vB; stb(lds, L_NAKT + (sc * 16 + t) * PS + fr * 2, vK); }
              else { stb(lds, L_NRBT + (sc * 16 + t) * PS + fr * 2, vB); stb(lds, L_NRKT + (sc * 16 + t) * PS + fr * 2, vK); } } }
        if ((w & 1) == 0 && lane < 16) { const int sc = w >> 1; float Tr[16];
            asm volatile("" ::: "memory");
#pragma unroll
            for (int ph = 0; ph < 4; ++ph) { f32x4 nv[4][4];
#pragma unroll
                for (int tq = 0; tq < 4; ++tq)
#pragma unroll
                    for (int u4 = 0; u4 <= ph; ++u4) nv[tq][u4] = *(const LAS f32x4*)(lds + L_NAB + ((sc * 16 + 4 * ph + tq) * 16 + 4 * u4) * 4);
#pragma unroll
                for (int tq = 0; tq < 4; ++tq) { const int t = 4 * ph + tq; float x0 = (lane == t) ? 1.f : 0.f, x1 = 0.f;
#pragma unroll
                    for (int u = 0; u < 16; ++u) if (u < t) { if (u & 1) x1 += Tr[u] * nv[tq][u >> 2][u & 3]; else x0 += Tr[u] * nv[tq][u >> 2][u & 3]; }
                    Tr[t] = x0 + x1; stb(lds, L_TT + (sc * 16 + t) * PS + lane * 2, Tr[t]); } } }
        LDS_BARRIER();
        if (w < 4) {
#pragma unroll 1
            for (int sc = 0; sc < 4; ++sc) {
                const bf16x8 ah0 = ld_k32(lds, L_AH, PV, 16 * sc, 0, lane), ah1 = ld_k32(lds, L_AH, PV, 16 * sc, 32, lane), rh0 = ld_k32(lds, L_RH, PV, 16 * sc, 0, lane), rh1 = ld_k32(lds, L_RH, PV, 16 * sc, 32, lane);
                const bf16x8 nak = ld_k16(lds, L_NAKT, PS, 16 * sc, 0, lane), nrk = ld_k16(lds, L_NRKT, PS, 16 * sc, 0, lane), ttf = ld_k16(lds, L_TT, PS, 16 * sc, 0, lane), nrb = ld_k16(lds, L_NRBT, PS, 16 * sc, 0, lane);
                const bf16x8 vsf = ld_k16(lds, L_VS, PV, 16 * w, 16 * sc, lane);
                bf16x8 btf[4], ktf[4]; f32x4 glv[4];
#pragma unroll
                for (int ct = 0; ct < 4; ++ct) { btf[ct] = ld_k16(lds, L_BT, PV, 16 * ct, 16 * sc, lane); ktf[ct] = ld_k16(lds, L_KT, PV, 16 * ct, 16 * sc, lane);
                    glv[ct] = *(const LAS f32x4*)(lds + L_GL + (sc * 64 + 16 * ct + 4 * fq) * 4); }
                const bf16x8 sb0 = pack_k32(sacc[0], sacc[1]), sb1 = pack_k32(sacc[2], sacc[3]);
                f32x4 XT = (f32x4){0.f, 0.f, 0.f, 0.f}, YT = (f32x4){0.f, 0.f, 0.f, 0.f};
                XT = ml::mma(ah0, sb0, XT); XT = ml::mma(ah1, sb1, XT); XT = ml::mma(nak, vsf, XT);
                YT = ml::mma(rh0, sb0, YT); YT = ml::mma(rh1, sb1, YT); YT = ml::mma(nrk, vsf, YT);
                f32x4 UT = (f32x4){0.f, 0.f, 0.f, 0.f};
                UT = ml::mma(ttf, pack_k16(XT), UT);
                const bf16x8 ub = pack_k16(UT);
                YT = ml::mma(nrb, ub, YT);
#pragma unroll
                for (int r = 0; r < 4; ++r) stb(lds, L_YS + (16 * sc + 4 * fq + r) * PV + (16 * w + fr) * 2, YT[r]);
#pragma unroll
                for (int ct = 0; ct < 4; ++ct) { sacc[ct] = ml::mma(btf[ct], ub, sacc[ct]); sacc[ct] = ml::mma(ktf[ct], vsf, sacc[ct]); sacc[ct] = sacc[ct] * glv[ct]; }
            }
        }
        LDS_BARRIER();
        *(u32x4*)(U + WY_TOK(c, pj) * PU + OFF_R + dir * RW + hc + 8 * psub) = *(const LAS u32x4*)(lds + L_YS + pj * PV + psub * 16);
    }
    if (!q.grid && w < 4) { const size_t sb = (((size_t)q.b * DEPTH + l) * 2 + dir) * RH + head;
#pragma unroll
        for (int ct = 0; ct < 4; ++ct) *(f32x4*)(P.out + OUT_S + (sb * 64 + 16 * w + fr) * 64 + 16 * ct + 4 * fq) = sacc[ct]; }
    LDS_BARRIER();
#undef WY_TOK
#undef WY_PREFETCH
}
__device__ __forceinline__ int tid_opaque() { int t = threadIdx.x; asm volatile("" : "+v"(t)); return t; }
constexpr int CW_F = 16384, FL_STRIDE = 64, NPROD = 2;
static_assert(RING % NPROD == 0 && NPROD + 1 <= 4 && CW_F + DEPTH * N_LAT * 4 * FL_STRIDE <= 32768, "flag block");
constexpr unsigned FL_SPIN_CAP = 1u << 18;
__device__ __forceinline__ unsigned fl_ld(unsigned* p) { return __hip_atomic_load(p, __ATOMIC_RELAXED, __HIP_MEMORY_SCOPE_AGENT); }
__device__ __forceinline__ unsigned fl_wait_ge(unsigned* p, unsigned want, unsigned* tmo) {
    unsigned sp = 0, v;
    while ((v = fl_ld(p)) < want) { __builtin_amdgcn_s_sleep(1); if ((++sp & 255u) == 0u) { if (fl_ld(tmo)) break; if (sp > FL_SPIN_CAP) { atomicAdd(tmo, 1u); break; } } }
    return v;
}
__device__ __forceinline__ void rwkv_prod(LAS unsigned char* lds, CParams& P, int l, int s, int head, int dir, int chain, int pp, unsigned* ctl) {
    const int tid = tid_opaque(), w = __builtin_amdgcn_readfirstlane(tid >> 6), lane = tid & 63, fr = lane & 15, fq = lane >> 4;
    const int rt = w & 3, half = w >> 2, hc = head * 64;
    const SeqInfo q = seqinfo(s); const int nchunk = q.T / 64;
    const bf16* RX = WSP(bf16, WS_RXC);
    const int pj = tid >> 3, psub = tid & 7;
    unsigned char* ring = P.ws + O_WIN1 + (size_t)chain * RING * PACK_BYTES;
    unsigned* f_base = ctl + CW_F + (size_t)((l * N_LAT + chain) * 4) * FL_STRIDE; unsigned* f_ready = f_base + pp * FL_STRIDE; unsigned* f_ack = f_base + NPROD * FL_STRIDE; unsigned* tmo = ctl + 4096 + 128;
    float rkk8[8];
#pragma unroll
    for (int e = 0; e < 8; ++e) rkk8[e] = P.in[R_KK][(size_t)l * RW + hc + 8 * psub + e];
    float c_w0[2], c_a0[2], c_kk[2], c_ka[2];
#pragma unroll
    for (int cc = 0; cc < 2; ++cc) { const int c = 16 * (2 * half + cc) + fr;
        c_w0[cc] = P.in[R_W0][((size_t)l * 2 + dir) * RW + hc + c]; c_a0[cc] = P.in[R_A0][((size_t)l * 2 + dir) * RW + hc + c];
        c_kk[cc] = P.in[R_KK][(size_t)l * RW + hc + c]; c_ka[cc] = P.in[R_KA][(size_t)l * RW + hc + c]; }
    const bf16* w2t = WSP(bf16, O_W2T) + ((size_t)dir * RW + hc) * 64; const bf16* a2t = WSP(bf16, O_A2T) + ((size_t)dir * RW + hc) * 64;
    u32x4 pf[5];
#define WY_TOK(c, j) ((size_t)(q.base + (dir ? q.T - 1 - ((c) * 64 + (j)) : ((c) * 64 + (j)))))
#define WY_PREFETCH(c) do { const bf16* rx = RX + WY_TOK(c, pj) * RIN + 8 * psub; \
        pf[0] = *(const u32x4*)(rx + RX_R + hc); pf[1] = *(const u32x4*)(rx + RX_K + hc); pf[2] = *(const u32x4*)(rx + RX_V + hc); \
        pf[3] = *(const u32x4*)(rx + RX_WL + dir * 64); pf[4] = *(const u32x4*)(rx + RX_AL + dir * 64); } while (0)
    WY_PREFETCH(pp);
    unsigned acked = 0u;
    for (int c = pp; c < nchunk; c += NPROD) {
        { *(LAS u32x4*)(lds + L_RH + pj * PV + psub * 16) = pf[0]; *(LAS u32x4*)(lds + L_KH + pj * PV + psub * 16) = pf[1];
          const unsigned kw[4] = {pf[1].x, pf[1].y, pf[1].z, pf[1].w}, vw[4] = {pf[2].x, pf[2].y, pf[2].z, pf[2].w};
          float ss = 0.f;
#pragma unroll
          for (int e = 0; e < 8; ++e) { const float kf = __builtin_bit_cast(float, (e & 1) ? (kw[e >> 1] & 0xffff0000u) : (kw[e >> 1] << 16)) * rkk8[e]; ss += kf * kf;
              *(LAS bf16*)(lds + L_VS + (8 * psub + e) * PV + pj * 2) = (bf16)((vw[e >> 1] >> ((e & 1) * 16)) & 0xffffu); }
          ss += rw::dpp_xor1(ss); ss += rw::dpp_xor2(ss); ss += __shfl_xor(ss, 4);
          if (psub == 0) *(LAS float*)(lds + L_INV + pj * 4) = 1.0f / fmaxf(sqrtf(ss), 1e-12f);
          *(LAS u32x4*)(lds + L_TW + pj * PV + psub * 16) = pf[3]; *(LAS u32x4*)(lds + L_AL + pj * PV + psub * 16) = pf[4]; }
        LDS_BARRIER();
        if (c + NPROD < nchunk) WY_PREFETCH(c + NPROD);
#pragma unroll
        for (int cc = 0; cc < 2; ++cc) { const int ct = 2 * half + cc; const int cidx = 16 * ct + fr;
            f32x4 aw = (f32x4){0.f, 0.f, 0.f, 0.f}, aa = (f32x4){0.f, 0.f, 0.f, 0.f};
#pragma unroll
            for (int ks = 0; ks < 2; ++ks) { const size_t bo = (size_t)cidx * 64 + 32 * ks + 8 * fq;
                aw = ml::mma(ml::frag(lds, L_TW, PV, 16 * rt, 32 * ks, lane), *(const bf16x8*)(w2t + bo), aw); aa = ml::mma(ml::frag(lds, L_AL, PV, 16 * rt, 32 * ks, lane), *(const bf16x8*)(a2t + bo), aa); }
            float kr4[4], rr4[4], iv4[4];
#pragma unroll
            for (int r = 0; r < 4; ++r) { const int tok = 16 * rt + 4 * fq + r; kr4[r] = bf2f(*(const LAS bf16*)(lds + L_KH + tok * PV + cidx * 2)); rr4[r] = bf2f(*(const LAS bf16*)(lds + L_RH + tok * PV + cidx * 2));
                iv4[r] = *(const LAS float*)(lds + L_INV + tok * 4); }
            float lw[4], cum[4];
#pragma unroll
            for (int r = 0; r < 4; ++r) { lw[r] = -0.6065306597126334f * pg8::fsigmoid(c_w0[cc] + aw[r]); cum[r] = (r ? cum[r - 1] : 0.f) + lw[r]; }
            const float tot = cum[3]; const float p1 = __shfl_up(tot, 16), p2 = __shfl_up(tot, 32), p3 = __shfl_up(tot, 48);
            const float off = (fq >= 1 ? p1 : 0.f) + (fq >= 2 ? p2 : 0.f) + (fq >= 3 ? p3 : 0.f);
            float gprev = __expf(off);
#pragma unroll
            for (int r = 0; r < 4; ++r) { const int tok = 16 * rt + 4 * fq + r; const float lam = off + cum[r]; const float g = __expf(lam), gi = __builtin_amdgcn_rcpf(g);
                const float alpha = pg8::fsigmoid(c_a0[cc] + aa[r]);
                const float kraw = kr4[r], rraw = rr4[r];
                const float kkn = kraw * c_kk[cc] * iv4[r];
                const bf16 bh = f2bf(kkn * alpha * gi), kh = f2bf(kraw * (1.0f + (alpha - 1.0f) * c_ka[cc]) * gi);
                stb(lds, L_AH + tok * PV + cidx * 2, -kkn * gprev); stb(lds, L_RH + tok * PV + cidx * 2, rraw * g);
                *(LAS bf16*)(lds + L_BH + tok * PV + cidx * 2) = bh; *(LAS bf16*)(lds + L_KH + tok * PV + cidx * 2) = kh;
                *(LAS bf16*)(lds + L_BT + cidx * PV + tok * 2) = bh; *(LAS bf16*)(lds + L_KT + cidx * PV + tok * 2) = kh;
                if (fq == 3 && r == 3) *(LAS float*)(lds + L_GL + (rt * 64 + cidx) * 4) = g;
                gprev = g; } }
        asm volatile("s_waitcnt vmcnt(0)" ::: "memory");
        LDS_BARRIER();
        if (tid == 0 && c > pp) __hip_atomic_store(f_ready, (unsigned)((c - pp) / NPROD), __ATOMIC_RELAXED, __HIP_MEMORY_SCOPE_AGENT);
        { const int sc = w >> 1, side = w & 1; f32x4 gB = (f32x4){0.f, 0.f, 0.f, 0.f}, gK = (f32x4){0.f, 0.f, 0.f, 0.f};
#pragma unroll
          for (int ks = 0; ks < 2; ++ks) { const bf16x8 af = ml::frag(lds, side ? L_RH : L_AH, PV, 16 * sc, 32 * ks, lane);
              gB = ml::mma(af, ml::frag(lds, L_BH, PV, 16 * sc, 32 * ks, lane), gB); gK = ml::mma(af, ml::frag(lds, L_KH, PV, 16 * sc, 32 * ks, lane), gK); }
#pragma unroll
          for (int r = 0; r < 4; ++r) { const int t = 4 * fq + r; const bool keep = side ? (fr <= t) : (fr < t); const float vB = keep ? gB[r] : 0.f, vK = keep ? gK[r] : 0.f;
              if (side == 0) { *(LAS float*)(lds + L_NAB + ((sc * 16 + t) * 16 + fr) * 4) = vB; stb(lds, L_NAKT + (sc * 16 + t) * PS + fr * 2, vK); }
              else { stb(lds, L_NRBT + (sc * 16 + t) * PS + fr * 2, vB); stb(lds, L_NRKT + (sc * 16 + t) * PS + fr * 2, vK); } } }
        if ((w & 1) == 0 && lane < 16) { const int sc = w >> 1; float Tr[16];
            asm volatile("" ::: "memory");
#pragma unroll
            for (int ph = 0; ph < 4; ++ph) { f32x4 nv[4][4];
#pragma unroll
                for (int tq = 0; tq < 4; ++tq)
#pragma unroll
                    for (int u4 = 0; u4 <= ph; ++u4) nv[tq][u4] = *(const LAS f32x4*)(lds + L_NAB + ((sc * 16 + 4 * ph + tq) * 16 + 4 * u4) * 4);
#pragma unroll
                for (int tq = 0; tq < 4; ++tq) { const int t = 4 * ph + tq; float x0 = (lane == t) ? 1.f : 0.f, x1 = 0.f;
#pragma unroll
                    for (int u = 0; u < 16; ++u) if (u < t) { if (u & 1) x1 += Tr[u] * nv[tq][u >> 2][u & 3]; else x0 += Tr[u] * nv[tq][u >> 2][u & 3]; }
                    Tr[t] = x0 + x1; stb(lds, L_TT + (sc * 16 + t) * PS + lane * 2, Tr[t]); } } }
        if (tid == 0 && c >= RING && acked < (unsigned)(c - RING + 1)) acked = fl_wait_ge(f_ack, (unsigned)(c - RING + 1), tmo);
        LDS_BARRIER();
        { unsigned char* slot = ring + (size_t)(c % RING) * PACK_BYTES;
#pragma unroll
          for (int k = 0; k < 8; ++k) { const int u = tid + 512 * k;
              if (u < PACK_U) { const u32x4 v = *(const LAS u32x4*)(lds + 16 * u); const u32x4* gp = (const u32x4*)(slot + (size_t)16 * u);
                  asm volatile("global_store_dwordx4 %0, %1, off sc1" :: "v"(gp), "v"(v) : "memory"); } } }
        LDS_BARRIER();
    }
    asm volatile("s_waitcnt vmcnt(0)" ::: "memory");
    __syncthreads();
    if (tid == 0) __hip_atomic_store(f_ready, (unsigned)((nchunk - pp + NPROD - 1) / NPROD), __ATOMIC_RELAXED, __HIP_MEMORY_SCOPE_AGENT);
    LDS_BARRIER();
#undef WY_TOK
#undef WY_PREFETCH
}
__device__ __forceinline__ void rwkv_cons(LAS unsigned char* lds, CParams& P, int l, int s, int head, int dir, int chain, unsigned* ctl) {
    const int tid = tid_opaque(), w = __builtin_amdgcn_readfirstlane(tid >> 6), lane = tid & 63, fr = lane & 15, fq = lane >> 4;
    const int hc = head * 64;
    const SeqInfo q = seqinfo(s); const int nchunk = q.T / 64;
    bf16* U = WSP(bf16, WS_U1);
    const unsigned char* ring = P.ws + O_WIN1 + (size_t)chain * RING * PACK_BYTES;
    unsigned* f_base = ctl + CW_F + (size_t)((l * N_LAT + chain) * 4) * FL_STRIDE; unsigned* f_ack = f_base + NPROD * FL_STRIDE; unsigned* tmo = ctl + 4096 + 128;
    constexpr int C_YS = 2 * PACK_BYTES;
    static_assert(C_YS + 64 * PV <= 131072, "consumer LDS map");
    f32x4 sacc[4];
#pragma unroll
    for (int ct = 0; ct < 4; ++ct) sacc[ct] = (f32x4){0.f, 0.f, 0.f, 0.f};
    if (w < 4 && q.grid) { const size_t sb = (((size_t)q.b * DEPTH + l) * 2 + dir) * RH + head;
#pragma unroll
        for (int ct = 0; ct < 4; ++ct) sacc[ct] = *(const f32x4*)(P.in[ST_R] + (sb * 64 + 16 * w + fr) * 64 + 16 * ct + 4 * fq); }
#define WY_TOK(c, j) ((size_t)(q.base + (dir ? q.T - 1 - ((c) * 64 + (j)) : ((c) * 64 + (j)))))
#define CONS_FETCH(c, boff) do { if (lane == 0) (void)fl_wait_ge(f_base + ((c) % NPROD) * FL_STRIDE, (unsigned)((c) / NPROD + 1), tmo); \
        __builtin_amdgcn_fence(__ATOMIC_ACQUIRE, "agent"); \
        const unsigned char* slot = ring + (size_t)((c) % RING) * PACK_BYTES; \
        for (int k = w - 4; k < PACK_BYTES / 1024; k += 4) \
            __builtin_amdgcn_global_load_lds((const unsigned*)(slot + (size_t)k * 1024 + lane * 16), (LAS unsigned*)(lds + (boff) + k * 1024), 16, 0, 0); \
        asm volatile("s_waitcnt vmcnt(0)" ::: "memory"); } while (0)
    if (w >= 4) CONS_FETCH(0, 0);
    LDS_BARRIER();
    if (tid == 256) __hip_atomic_store(f_ack, 1u, __ATOMIC_RELAXED, __HIP_MEMORY_SCOPE_AGENT);
    for (int c = 0; c < nchunk; ++c) {
        const int boff = (c & 1) * PACK_BYTES;
        if (w >= 4) { if (c + 1 < nchunk) CONS_FETCH(c + 1, PACK_BYTES - boff); }
        else {
            LAS unsigned char* pb = lds + boff;
#pragma unroll 1
            for (int sc = 0; sc < 4; ++sc) {
                const bf16x8 ah0 = ld_k32(pb, L_AH, PV, 16 * sc, 0, lane), ah1 = ld_k32(pb, L_AH, PV, 16 * sc, 32, lane), rh0 = ld_k32(pb, L_RH, PV, 16 * sc, 0, lane), rh1 = ld_k32(pb, L_RH, PV, 16 * sc, 32, lane);
                const bf16x8 nak = ld_k16(pb, L_NAKT, PS, 16 * sc, 0, lane), nrk = ld_k16(pb, L_NRKT, PS, 16 * sc, 0, lane), ttf = ld_k16(pb, L_TT, PS, 16 * sc, 0, lane), nrb = ld_k16(pb, L_NRBT, PS, 16 * sc, 0, lane);
                const bf16x8 vsf = ld_k16(pb, L_VS, PV, 16 * w, 16 * sc, lane);
                bf16x8 btf[4], ktf[4]; f32x4 glv[4];
#pragma unroll
                for (int ct = 0; ct < 4; ++ct) { btf[ct] = ld_k16(pb, L_BT, PV, 16 * ct, 16 * sc, lane); ktf[ct] = ld_k16(pb, L_KT, PV, 16 * ct, 16 * sc, lane);
                    glv[ct] = *(const LAS f32x4*)(pb + L_GL + (sc * 64 + 16 * ct + 4 * fq) * 4); }
                const bf16x8 sb0 = pack_k32(sacc[0], sacc[1]), sb1 = pack_k32(sacc[2], sacc[3]);
                f32x4 XT = (f32x4){0.f, 0.f, 0.f, 0.f}, YT = (f32x4){0.f, 0.f, 0.f, 0.f};
                XT = ml::mma(ah0, sb0, XT); XT = ml::mma(ah1, sb1, XT); XT = ml::mma(nak, vsf, XT);
                YT = ml::mma(rh0, sb0, YT); YT = ml::mma(rh1, sb1, YT); YT = ml::mma(nrk, vsf, YT);
                f32x4 UT = (f32x4){0.f, 0.f, 0.f, 0.f};
                UT = ml::mma(ttf, pack_k16(XT), UT);
                const bf16x8 ub = pack_k16(UT);
                YT = ml::mma(nrb, ub, YT);
#pragma unroll
                for (int r = 0; r < 4; ++r) stb(lds, C_YS + (16 * sc + 4 * fq + r) * PV + (16 * w + fr) * 2, YT[r]);
#pragma unroll
                for (int ct = 0; ct < 4; ++ct) { sacc[ct] = ml::mma(btf[ct], ub, sacc[ct]); sacc[ct] = ml::mma(ktf[ct], vsf, sacc[ct]); sacc[ct] = sacc[ct] * glv[ct]; }
            }
            { const LAS unsigned char* yp = lds + C_YS + lane * PV + 32 * w; const u32x4 y0 = *(const LAS u32x4*)yp, y1 = *(const LAS u32x4*)(yp + 16);
              bf16* up = U + WY_TOK(c, lane) * PU + OFF_R + dir * RW + hc + 16 * w; *(u32x4*)up = y0; *(u32x4*)(up + 8) = y1; }
        }
        LDS_BARRIER();
        if (tid == 256 && c + 1 < nchunk) __hip_atomic_store(f_ack, (unsigned)(c + 2), __ATOMIC_RELAXED, __HIP_MEMORY_SCOPE_AGENT);
    }
    if (!q.grid && w < 4) { const size_t sb = (((size_t)q.b * DEPTH + l) * 2 + dir) * RH + head;
#pragma unroll
        for (int ct = 0; ct < 4; ++ct) *(f32x4*)(P.out + OUT_S + (sb * 64 + 16 * w + fr) * 64 + 16 * ct + 4 * fq) = sacc[ct]; }
    LDS_BARRIER();
#undef WY_TOK
#undef CONS_FETCH
}
constexpr int N_ITEMS = NSEQ * RH * 2;
__device__ __forceinline__ void decode_item(int it, int& s, int& head, int& dir) {
    dir = it & 1; int ch = it >> 1; head = ch % RH; const int sq = ch / RH;
    s = sq < LB ? CB + sq : sq - LB;
}
}

namespace el {
typedef float f32x4 __attribute__((ext_vector_type(4)));
typedef unsigned u32x4 __attribute__((ext_vector_type(4)));
typedef unsigned u32x2 __attribute__((ext_vector_type(2)));
typedef short bf16x8 __attribute__((ext_vector_type(8)));
__device__ __forceinline__ float wave_sum(float v) {
#pragma unroll
    for (int o = 1; o < 64; o <<= 1) v += __shfl_xor(v, o);
    return v;
}
__device__ __forceinline__ void unpack8(const u32x4 p, float (&f)[8]) {
    f[0] = pg8::bflo(p.x); f[1] = pg8::bfhi(p.x); f[2] = pg8::bflo(p.y); f[3] = pg8::bfhi(p.y); f[4] = pg8::bflo(p.z); f[5] = pg8::bfhi(p.z); f[6] = pg8::bflo(p.w); f[7] = pg8::bfhi(p.w);
}
__device__ __forceinline__ u32x4 pack8(const float (&f)[8]) {
    u32x4 o; o.x = pg8::cvt_pk_bf16(f[0], f[1]); o.y = pg8::cvt_pk_bf16(f[2], f[3]); o.z = pg8::cvt_pk_bf16(f[4], f[5]); o.w = pg8::cvt_pk_bf16(f[6], f[7]); return o;
}
__device__ __forceinline__ void init_phase(LAS unsigned char* lds, CParams& P, int vb, int G) {
    const int tid = threadIdx.x, w = tid >> 6, lane = tid & 63;
    { const size_t n4 = (size_t)NT * D / 4, nc4 = (size_t)NC * D / 4; f32x4* o = (f32x4*)P.out; const f32x4* a = (const f32x4*)P.in[X_PROMPT]; const f32x4* b = (const f32x4*)P.in[X_SAMPLE];
      for (size_t i = (size_t)vb * 512 + tid; i < n4; i += (size_t)G * 512) o[i] = i < nc4 ? a[i] : b[i - nc4]; }
    LAS float* red = (LAS float*)lds;
    constexpr int KW = D / 8;
    for (int it = vb; it < DEPTH * (6 * D / 64); it += G) {
        const int l = it / (6 * D / 64), j = (it % (6 * D / 64)) * 64 + lane;
        const float* wp = P.in[ADA_W] + ((size_t)l * D + w * KW) * 6 * D + j;
        float acc[NCOND];
#pragma unroll
        for (int ci = 0; ci < NCOND; ++ci) acc[ci] = 0.f;
        for (int k = 0; k < KW; ++k) { const float wv = wp[(size_t)k * 6 * D];
#pragma unroll
            for (int ci = 0; ci < NCOND; ++ci) { const float cv = ci == 0 ? P.in[C_CTX][w * KW + k] : P.in[C_LAT][(size_t)(ci - 1) * D + w * KW + k]; acc[ci] += cv * pg8::fsigmoid(cv) * wv; } }
#pragma unroll
        for (int ci = 0; ci < NCOND; ++ci) red[(w * NCOND + ci) * 64 + lane] = acc[ci];
        __syncthreads();
        if (w < NCOND) { float sum = P.in[ADA_B][(size_t)l * 6 * D + j];
#pragma unroll
            for (int ww = 0; ww < 8; ++ww) sum += red[(ww * NCOND + w) * 64 + lane];
            WSP(float, WS_MOD)[((size_t)l * NCOND + w) * 6 * D + j] = sum; }
        __syncthreads();
    }
}
__device__ __forceinline__ int perm5(int n) { return (((n >> 2) & 1) << 4) | (((n >> 3) & 3) << 2) | (n & 3); }
__device__ __forceinline__ void transpose_item(const float* W, int ldw, int nvalid, bf16* dst, int K, int k0, int drow0, bool perm, LAS float* scr, int lane) {
#pragma unroll 8
    for (int i = 0; i < 32; ++i) { const int kk = 2 * i + (lane >> 5), n = lane & 31; scr[kk * 33 + n] = n < nvalid ? W[(size_t)kk * ldw + n] : 0.f; }
    asm volatile("s_waitcnt lgkmcnt(0)" ::: "memory");
    const int c = lane & 7;
#pragma unroll
    for (int j = 0; j < 4; ++j) { const int n = (lane >> 3) + 8 * j; const LAS float* sp = scr + (8 * c) * 33 + n;
        u32x4 o; o.x = pg8::cvt_pk_bf16(sp[0 * 33], sp[1 * 33]); o.y = pg8::cvt_pk_bf16(sp[2 * 33], sp[3 * 33]); o.z = pg8::cvt_pk_bf16(sp[4 * 33], sp[5 * 33]); o.w = pg8::cvt_pk_bf16(sp[6 * 33], sp[7 * 33]);
        *(u32x4*)(dst + (size_t)(drow0 + (perm ? perm5(n) : n)) * K + k0 + 8 * c) = o; }
    asm volatile("s_waitcnt lgkmcnt(0)" ::: "memory");
}
constexpr int WI_0 = (N1P / 32) * (D / 64), WI_1 = WI_0 + (2 * D / 32) * (D / 64), WI_2 = WI_1 + (D / 32) * (MW / 64), WI_3 = WI_2 + (D / 32) * (RW / 64),
              WI_4 = WI_3 + (D / 32) * (D / 64), WI_5 = WI_4 + 2 * (FF / 32) * (D / 64), WI_6 = WI_5 + (D / 32) * (FF / 64), WI_7 = WI_6 + (RW / 32) * (128 / 64), WI_8 = WI_7 + 4 * (RW / 32);
__device__ __forceinline__ void wconv_phase(LAS unsigned char* lds, CParams& P, int l, int vb, int G) {
    const int tid = threadIdx.x, w = tid >> 6, lane = tid & 63;
    LAS float* scr = (LAS float*)(lds + w * 8704);
    for (int it = vb * 8 + w; it < WI_8; it += G * 8) {
        if (it < WI_0) { const int nb = it / (D / 64), kb = it % (D / 64); const int n0 = nb * 32; const int nv = n0 >= N1 ? 0 : (N1 - n0 < 32 ? N1 - n0 : 32);
            transpose_item(P.in[W_IN] + ((size_t)l * D + kb * 64) * PIN + n0, PIN, nv, WSP(bf16, O_WIN1), D, kb * 64, n0, true, scr, lane); }
        else if (it < WI_1) { const int r = it - WI_0, nb = r / (D / 64), kb = r % (D / 64);
            transpose_item(P.in[W_IN] + ((size_t)l * D + kb * 64) * PIN + N1 + nb * 32, PIN, 32, WSP(bf16, O_WIN2), D, kb * 64, nb * 32, true, scr, lane); }
        else if (it < WI_2) { const int r = it - WI_1, nb = r / (MW / 64), kb = r % (MW / 64);
            transpose_item(P.in[PROJ_M] + ((size_t)l * MW + kb * 64) * D + nb * 32, D, 32, WSP(bf16, O_PM), MW, kb * 64, nb * 32, true, scr, lane); }
        else if (it < WI_3) { const int r = it - WI_2, nb = r / (RW / 64), kb = r % (RW / 64);
            transpose_item(P.in[PROJ_R] + ((size_t)l * RW + kb * 64) * D + nb * 32, D, 32, WSP(bf16, O_PR), RW, kb * 64, nb * 32, true, scr, lane); }
        else if (it < WI_4) { const int r = it - WI_3, nb = r / (D / 64), kb = r % (D / 64);
            transpose_item(P.in[W_OUT] + ((size_t)l * D + kb * 64) * D + nb * 32, D, 32, WSP(bf16, O_WO), D, kb * 64, nb * 32, false, scr, lane); }
        else if (it < WI_5) { const int r = it - WI_4, which = r / ((FF / 32) * (D / 64)), r2 = r % ((FF / 32) * (D / 64)), nb = r2 / (D / 64), kb = r2 % (D / 64);
            const int j0 = nb * 32, pn = j0 >> 7, drow0 = pn * 256 + which * 128 + (j0 & 127);
            transpose_item((which ? P.in[FFN_W3] : P.in[FFN_W1]) + ((size_t)l * D + kb * 64) * FF + j0, FF, 32, WSP(bf16, O_W13), D, kb * 64, drow0, true, scr, lane); }
        else if (it < WI_6) { const int r = it - WI_5, nb = r / (FF / 64), kb = r % (FF / 64);
            transpose_item(P.in[FFN_W2] + ((size_t)l * FF + kb * 64) * D + nb * 32, D, 32, WSP(bf16, O_W2), FF, kb * 64, nb * 32, false, scr, lane); }
        else if (it < WI_7) { const int r = it - WI_6, nb = r / 2, kb = r % 2;
            transpose_item(P.in[R_G2] + ((size_t)l * 128 + kb * 64) * RW + nb * 32, RW, 32, WSP(bf16, O_G2T), 128, kb * 64, nb * 32, false, scr, lane); }
        else { const int r = it - WI_7, which = r / (2 * (RW / 32)), d = (r / (RW / 32)) & 1, nb = r % (RW / 32);
            transpose_item((which ? P.in[R_A2] : P.in[R_W2]) + ((size_t)l * 2 + d) * 64 * RW + nb * 32, RW, 32, WSP(bf16, which ? O_A2T : O_W2T) + (size_t)d * RW * 64, 64, 0, nb * 32, false, scr, lane); }
    }
}
__device__ __forceinline__ void norm_phase(CParams& P, int l, int mode, int vb, int G) {
    const int tid = threadIdx.x, w = tid >> 6, lane = tid & 63;
    for (int m = vb * 8 + w; m < NT; m += G * 8) {
        float* xr = P.out + (size_t)m * D;
        f32x4 v[D / 256]; float ss = 0.f;
#pragma unroll
        for (int j = 0; j < D / 256; ++j) { v[j] = *(const f32x4*)(xr + 256 * j + 4 * lane); ss += (v[j][0] * v[j][0] + v[j][1] * v[j][1]) + (v[j][2] * v[j][2] + v[j][3] * v[j][3]); }
        const float rs = 1.0f / sqrtf(wave_sum(ss) * (1.0f / D) + RMS_EPS);
        if (mode == 3) {
#pragma unroll
            for (int j = 0; j < D / 256; ++j) { const f32x4 g = *(const f32x4*)(P.in[FINAL_G] + 256 * j + 4 * lane); *(f32x4*)(xr + 256 * j + 4 * lane) = v[j] * rs * g; }
        } else {
            const int second = (mode == 2); const int cond = seqinfo(seq_of_token(m)).cond;
            const float* gp = P.in[second ? NORM2 : NORM1] + (size_t)l * D; const float* mod = WSP(float, WS_MOD) + ((size_t)l * NCOND + cond) * 6 * D + (second ? 3 * D : 0);
            bf16* o = WSP(bf16, mode == 1 ? WS_RXC : WS_QKC) + (size_t)m * D;
#pragma unroll
            for (int j = 0; j < D / 256; ++j) { const int c = 256 * j + 4 * lane; const f32x4 g = *(const f32x4*)(gp + c), sh = *(const f32x4*)(mod + c), sc = *(const f32x4*)(mod + D + c);
                const f32x4 y = v[j] * rs * g * (sc + 1.0f) + sh; u32x2 pk; pk.x = pg8::cvt_pk_bf16(y[0], y[1]); pk.y = pg8::cvt_pk_bf16(y[2], y[3]); *(u32x2*)(o + c) = pk; }
        }
    }
}
constexpr int CV_NCH = 2 * MW + RIN, CV_NG = CV_NCH / 4, CV_NCHUNK = (CV_NG + 63) / 64, CV_SEG = 16, CV_PAIRS = NC / (2 * CV_SEG);
static_assert(CV_NCHUNK == 12 && NC == NT - NC && GW % CV_SEG == 0 && CT % CV_SEG == 0 && 2 * MW == 1024 && RX_WL == 1536, "conv item layout");
typedef float f32x2 __attribute__((ext_vector_type(2)));
struct CvAct { float alpha, cA, cB, cC, cD; bool any; };
template <int NR> struct CvState { f32x2 wt[NR * 3][2]; f32x2 fw[NR][3][2]; u32x2 p[3][NR]; };
__device__ __forceinline__ void cv_unpk(const u32x2 p, f32x2 (&f)[2]) { f[0].x = pg8::bflo(p.x); f[0].y = pg8::bfhi(p.x); f[1].x = pg8::bflo(p.y); f[1].y = pg8::bfhi(p.y); }
template <int NR> __device__ __forceinline__ u32x2 cv_ld(const bf16* const (&rowp)[NR], const bool (&rok)[NR], int a, int col, int W) {
    const u32x2 zero2 = {0u, 0u};
    return (rok[a] && col >= 0 && col < W) ? *(const u32x2*)(rowp[a] + (size_t)col * PU) : zero2;
}
template <int NR, int S> __device__ __forceinline__ void cv_col(CvState<NR>& st, const bf16* const (&rowp)[NR], const bool (&rok)[NR], int cs, int W, int o, const CvAct& act, bf16* dst) {
#pragma unroll
    for (int a = 0; a < NR; ++a) { cv_unpk(st.p[S][a], st.fw[a][(S + 2) % 3]); const u32x2 zero2 = {0u, 0u}; st.p[S][a] = (o + 4 <= CV_SEG) ? cv_ld<NR>(rowp, rok, a, cs + o + 4, W) : zero2; }
    f32x2 acc[2];
#pragma unroll
    for (int e = 0; e < 2; ++e) acc[e] = st.wt[0][e] * st.fw[0][S][e];
#pragma unroll
    for (int a = 0; a < NR; ++a)
#pragma unroll
        for (int b = 0; b < 3; ++b) if (a + b > 0) {
#pragma unroll
            for (int e = 0; e < 2; ++e) acc[e] = __builtin_elementwise_fma(st.wt[a * 3 + b][e], st.fw[a][(S + b) % 3][e], acc[e]); }
    float v[4] = {acc[0].x, acc[0].y, acc[1].x, acc[1].y};
    if (act.any) {
#pragma unroll
        for (int e = 0; e < 4; ++e) { const float t = __builtin_amdgcn_rcpf(__builtin_amdgcn_exp2f(act.alpha * v[e]) + 1.0f); v[e] = (act.cA * v[e] + act.cB) * t + (act.cC * v[e] + act.cD); }
    }
    u32x2 pk; pk.x = pg8::cvt_pk_bf16(v[0], v[1]); pk.y = pg8::cvt_pk_bf16(v[2], v[3]);
    *(u32x2*)dst = pk;
}
template <int NR> __device__ __forceinline__ void conv_item(const bf16* const (&rowp)[NR], const bool (&rok)[NR], int cs, int W, const float* wsrc, int CH, const CvAct& act, bf16* dst, int dpitch) {
    CvState<NR> st;
#pragma unroll
    for (int a = 0; a < NR * 3; ++a) { const int tap = NR == 3 ? a : 3 + a; const f32x4 w0 = *(const f32x4*)(wsrc + (size_t)tap * CH);
        st.wt[a][0].x = w0[0]; st.wt[a][0].y = w0[1]; st.wt[a][1].x = w0[2]; st.wt[a][1].y = w0[3]; }
#pragma unroll
    for (int a = 0; a < NR; ++a) { cv_unpk(cv_ld<NR>(rowp, rok, a, cs - 1, W), st.fw[a][0]); cv_unpk(cv_ld<NR>(rowp, rok, a, cs, W), st.fw[a][1]); }
#pragma unroll
    for (int s3 = 0; s3 < 3; ++s3)
#pragma unroll
        for (int a = 0; a < NR; ++a) st.p[s3][a] = cv_ld<NR>(rowp, rok, a, cs + 1 + s3, W);
#pragma unroll 1
    for (int o = 0; o < CV_SEG - 1; o += 3) {
        cv_col<NR, 0>(st, rowp, rok, cs, W, o, act, dst + (size_t)o * dpitch);
        cv_col<NR, 1>(st, rowp, rok, cs, W, o + 1, act, dst + (size_t)(o + 1) * dpitch);
        cv_col<NR, 2>(st, rowp, rok, cs, W, o + 2, act, dst + (size_t)(o + 2) * dpitch);
    }
    cv_col<NR, 0>(st, rowp, rok, cs, W, CV_SEG - 1, act, dst + (size_t)(CV_SEG - 1) * dpitch);
}
__device__ __forceinline__ void conv_phase(LAS unsigned char* lds, CParams& P, int l, int vb, int G) {
    const int tid = threadIdx.x, lane = tid & 63;
    const bf16* U = WSP(bf16, WS_U1);
    LAS unsigned* cnt = (LAS unsigned*)lds;
    for (int sp = vb; sp < CV_PAIRS; sp += G) {
        __syncthreads();
        if (tid == 0) *cnt = 0u;
        __syncthreads();
        for (;;) {
            unsigned j = 0; if (lane == 0) j = __hip_atomic_fetch_add(cnt, 1u, __ATOMIC_RELAXED, __HIP_MEMORY_SCOPE_WORKGROUP);
            j = __builtin_amdgcn_readfirstlane(j);
            if (j >= 48u) break;
            const int cls = j / 12, jj = j % 12, lat = (cls & 1) == 0, heavy = cls < 2, ci = jj >> 1, chunk = heavy ? (ci >= 4 ? 6 + ci : ci) : 4 + ci;
            const int seg = (lat ? NC / CV_SEG : 0) + 2 * sp + (jj & 1), g = chunk * 64 + lane;
            if (g >= CV_NG) continue;
            const int ch = 4 * g; const bool isqk = ch < 2 * MW; const int c = isqk ? ch : ch - 2 * MW;
            const int ucol = isqk ? OFF_QK + c : OFF_R + c, CH = isqk ? 2 * MW : RIN;
            const float* wsrc = (isqk ? P.in[M_CONV] : P.in[R_CONV]) + (size_t)l * 9 * CH + c;
            const int kind = isqk ? (c < MW ? 0 : 1) : (c >= RX_GL ? 4 : (c >= RX_AL ? 2 : (c >= RX_WL ? 3 : 2)));
            CvAct act; act.alpha = kind == 3 ? 2.8853900817779268f : -1.4426950408889634f;
            act.cA = kind == 0 ? 0.08838834764831845f : (kind == 1 ? 1.0f : 0.0f); act.cB = kind == 3 ? -2.0f : (kind == 4 ? 1.0f : 0.0f); act.cC = kind == 2 ? 1.0f : 0.0f; act.cD = kind == 3 ? 1.0f : 0.0f;
            act.any = heavy;
            const int m0 = seg * CV_SEG; const SeqInfo q = seqinfo(seq_of_token(m0)); const int t0 = m0 - q.base;
            bf16* dst = isqk ? WSP(bf16, WS_QKC) + (size_t)m0 * (2 * MW) + c : WSP(bf16, WS_RXC) + (size_t)m0 * RIN + c; const int dpitch = isqk ? 2 * MW : RIN;
            if (q.grid) {
                const int r = t0 / GW, cs = t0 % GW, rows = q.T / GW;
                const bf16* rowp[3]; bool rok[3];
#pragma unroll
                for (int a = 0; a < 3; ++a) { const int rr = r + a - 1; rok[a] = rr >= 0 && rr < rows; rowp[a] = U + (size_t)(q.base + (rok[a] ? rr : r) * GW) * PU + ucol; }
                conv_item<3>(rowp, rok, cs, GW, wsrc, CH, act, dst, dpitch);
            } else {
                const bf16* rowp[1] = {U + (size_t)q.base * PU + ucol}; const bool rok[1] = {true};
                conv_item<1>(rowp, rok, t0, q.T, wsrc, CH, act, dst, dpitch);
            }
        }
    }
}
constexpr int PO_ITEMS = (NT / 16) * 2, PO_HC = RW / 2;
__device__ __forceinline__ void post_phase(LAS unsigned char* lds, CParams& P, int l, int vb, int G) {
    const int tid = threadIdx.x, w = tid >> 6, lane = tid & 63, fr = lane & 15, fq = lane >> 4, l32 = lane & 31, th = lane >> 5;
    constexpr int GP = PO_HC * 2 + 16;
    LAS unsigned char* gt = lds + w * (16 * GP);
    const bf16* U = WSP(bf16, WS_U1); const bf16* RX = WSP(bf16, WS_RXC); const bf16* G2T = WSP(bf16, O_G2T); bf16* O = WSP(bf16, WS_QKC);
    for (int it = vb * 8 + w; it < PO_ITEMS; it += G * 8) {
        const int tile = it >> 1, h = it & 1; const size_t tok0 = (size_t)tile * 16;
        bf16x8 af[4];
#pragma unroll
        for (int ks = 0; ks < 4; ++ks) af[ks] = *(const bf16x8*)(RX + (tok0 + fr) * RIN + RX_GL + 32 * ks + 8 * fq);
        for (int ct = 0; ct < PO_HC / 16; ++ct) { f32x4 acc = (f32x4){0.f, 0.f, 0.f, 0.f};
#pragma unroll
            for (int ks = 0; ks < 4; ++ks) acc = ml::mma(af[ks], *(const bf16x8*)(G2T + (size_t)(h * PO_HC + 16 * ct + fr) * 128 + 32 * ks + 8 * fq), acc);
#pragma unroll
            for (int r = 0; r < 4; ++r) *(LAS bf16*)(gt + (4 * fq + r) * GP + (16 * ct + fr) * 2) = f2bf(acc[r]); }
        asm volatile("s_waitcnt lgkmcnt(0)" ::: "memory");
        const int cb = h * PO_HC + 8 * l32;
        float gn[8], gw[8], gb[8], rk[8];
        { const f32x4 a0 = *(const f32x4*)(P.in[M_NORM_G] + (size_t)l * MW + cb), a1 = *(const f32x4*)(P.in[M_NORM_G] + (size_t)l * MW + cb + 4);
          const f32x4 b0 = *(const f32x4*)(P.in[R_GN_W] + (size_t)l * RW + cb), b1 = *(const f32x4*)(P.in[R_GN_W] + (size_t)l * RW + cb + 4);
          const f32x4 c0 = *(const f32x4*)(P.in[R_GN_B] + (size_t)l * RW + cb), c1 = *(const f32x4*)(P.in[R_GN_B] + (size_t)l * RW + cb + 4);
          const f32x4 d0 = *(const f32x4*)(P.in[R_RK] + (size_t)l * RW + cb), d1 = *(const f32x4*)(P.in[R_RK] + (size_t)l * RW + cb + 4);
#pragma unroll
          for (int e = 0; e < 4; ++e) { gn[e] = a0[e]; gn[4 + e] = a1[e]; gw[e] = b0[e]; gw[4 + e] = b1[e]; gb[e] = c0[e]; gb[4 + e] = c1[e]; rk[e] = d0[e]; rk[4 + e] = d1[e]; } }
        for (int tp = 0; tp < 8; ++tp) { const int tl = 2 * tp + th; const size_t m = tok0 + tl; const bf16* u = U + m * PU; const bf16* rx = RX + m * RIN;
            float hf[8], hb[8], ov[8], x[8]; unpack8(*(const u32x4*)(u + cb), hf); unpack8(*(const u32x4*)(u + MW + cb), hb); unpack8(*(const u32x4*)(u + OFF_O + cb), ov);
            float ss = 0.f;
#pragma unroll
            for (int e = 0; e < 8; ++e) { x[e] = hf[e] + hb[e]; ss += x[e] * x[e]; }
            ss = rw::allsum16(ss); const float rs = 1.0f / sqrtf(ss * (1.0f / 128.f) + RMS_EPS);
#pragma unroll
            for (int e = 0; e < 8; ++e) x[e] = x[e] * rs * gn[e] * pg8::fsigmoid(ov[e]);
            *(u32x4*)(O + m * D + cb) = pack8(x);
            float yf[8], yb[8], rr[8], kk[8], vv[8], gg[8], y[8]; unpack8(*(const u32x4*)(u + OFF_R + cb), yf); unpack8(*(const u32x4*)(u + OFF_R + RW + cb), yb);
            unpack8(*(const u32x4*)(rx + RX_R + cb), rr); unpack8(*(const u32x4*)(rx + RX_K + cb), kk); unpack8(*(const u32x4*)(rx + RX_V + cb), vv);
            unpack8(*(const LAS u32x4*)(gt + tl * GP + l32 * 16), gg);
            float mu = 0.f, bs = 0.f;
#pragma unroll
            for (int e = 0; e < 8; ++e) { y[e] = yf[e] + yb[e]; mu += y[e]; bs += rr[e] * kk[e] * rk[e]; }
            mu += rw::dpp_xor1(mu); mu += rw::dpp_xor2(mu); mu += __shfl_xor(mu, 4); mu *= (1.0f / 64.f);
            bs += rw::dpp_xor1(bs); bs += rw::dpp_xor2(bs); bs += __shfl_xor(bs, 4);
            float var = 0.f;
#pragma unroll
            for (int e = 0; e < 8; ++e) { y[e] -= mu; var += y[e] * y[e]; }
            var += rw::dpp_xor1(var); var += rw::dpp_xor2(var); var += __shfl_xor(var, 4); var *= (1.0f / 64.f);
            const float rsd = 1.0f / sqrtf(var + GN_EPS);
#pragma unroll
            for (int e = 0; e < 8; ++e) y[e] = (y[e] * rsd * gw[e] + gb[e] + bs * vv[e]) * gg[e];
            *(u32x4*)(O + m * D + MW + cb) = pack8(y);
        }
        asm volatile("s_waitcnt lgkmcnt(0)" ::: "memory");
    }
}
}

constexpr int LDS_BYTES = 147456;
constexpr int LDS_MISC = 131072 + 320;
constexpr size_t CTL_ZERO_BYTES = 131072;
constexpr int CW_BAR = 4096, CW_Q = 8192;

#define XB_TMO      128
#define XB_XCNT(j)  (256  + 64 * (j))
#define XB_XSUB(j)  (1280 + 64 * (j))
#define XB_XGEN(j)  (2304 + 64 * (j))
#define XB_TOP      3328
#define XB_TOPGEN   3392
#define XCD_BAR_WORDS 3456
#define XB_SPIN_CAP (1u << 18)
__device__ __forceinline__ unsigned xb_ld(unsigned* p)              { return __hip_atomic_load(p, __ATOMIC_RELAXED, __HIP_MEMORY_SCOPE_AGENT); }
__device__ __forceinline__ unsigned xb_add(unsigned* p, unsigned v) { return __hip_atomic_fetch_add(p, v, __ATOMIC_RELAXED, __HIP_MEMORY_SCOPE_AGENT); }
__device__ __forceinline__ unsigned xb_xcc_id() { return (unsigned)__builtin_amdgcn_s_getreg((3 << 11) | 20) & 0xFu; }
#define XB_SPIN(cond, bar) do { unsigned _sp = 0; while (cond) { __builtin_amdgcn_s_sleep(1); \
    if ((++_sp & 255u) == 0u) { if (xb_ld(&(bar)[XB_TMO])) break; if (_sp > XB_SPIN_CAP) { atomicAdd(&(bar)[XB_TMO], 1u); break; } } } } while (0)
struct XcdBarrier { unsigned* bar; unsigned x; volatile LAS unsigned* st; };
__device__ __forceinline__ XcdBarrier xcd_barrier_post(unsigned* bar, volatile LAS unsigned* st) {
    XcdBarrier b; b.bar = bar; b.x = xb_xcc_id(); b.st = st;
    if (threadIdx.x == 0) (void)xb_add(&bar[XB_XCNT(b.x)], 1u);
    return b;
}
__device__ __forceinline__ void xcd_barrier_complete(unsigned* bar, unsigned x, unsigned& nloc, unsigned& nx) {
    const unsigned G = gridDim.x * gridDim.y * gridDim.z;
    unsigned sum, cnt, mine, sp = 0u;
    for (;;) {
        sum = 0u; cnt = 0u; mine = 0u;
#pragma unroll
        for (unsigned j = 0; j < 16; ++j) { const unsigned c = xb_ld(&bar[XB_XCNT(j)]); sum += c; cnt += (c > 0u) ? 1u : 0u; mine = (j == x) ? c : mine; }
        if (sum == G) break;
        __builtin_amdgcn_s_sleep(1);
        if ((++sp & 255u) == 0u) { if (xb_ld(&bar[XB_TMO])) break; if (sp > XB_SPIN_CAP) { atomicAdd(&bar[XB_TMO], 1u); break; } }
    }
    nloc = mine > 0u ? mine : 1u; nx = cnt > 0u ? cnt : 1u;
}
__device__ __forceinline__ void xcd_barrier(const XcdBarrier& b) {
    asm volatile("s_waitcnt vmcnt(0)" ::: "memory");
    __syncthreads();
    if (threadIdx.x == 0) {
        unsigned* bar = b.bar;
        __builtin_amdgcn_s_waitcnt(0);
        unsigned nloc = b.st[0], nx = b.st[1];
        if (nloc == 0u) { xcd_barrier_complete(bar, b.x, nloc, nx); b.st[0] = nloc; b.st[1] = nx; }
        const unsigned old = xb_add(&bar[XB_XSUB(b.x)], 1u);
        const unsigned gen = old / nloc;
        if (old + 1u == (gen + 1u) * nloc) {
            __builtin_amdgcn_fence(__ATOMIC_RELEASE, "agent");
            asm volatile("s_waitcnt vmcnt(0)" ::: "memory");
            const unsigned og = xb_add(&bar[XB_TOP], 1u);
            const unsigned tg = og / nx;
            if (og + 1u == (tg + 1u) * nx) xb_add(&bar[XB_TOPGEN], 1u);
            else XB_SPIN(xb_ld(&bar[XB_TOPGEN]) == tg, bar);
            __builtin_amdgcn_fence(__ATOMIC_ACQUIRE, "agent");
            xb_add(&bar[XB_XGEN(b.x)], 1u);
            asm volatile("s_waitcnt vmcnt(0)" ::: "memory");
        } else {
            XB_SPIN(xb_ld(&bar[XB_XGEN(b.x)]) == gen, bar);
            __builtin_amdgcn_fence(__ATOMIC_ACQUIRE, "agent");
            asm volatile("s_waitcnt vmcnt(0)" ::: "memory");
        }
    }
    __syncthreads();
}

constexpr int MX_RL = LB * RH * 2 * 4, MX_ML = LB * MH * 2 * ml::NVB, MX_RC = CB * RH * 2 * 4, MX_MC = CB * MH * 2 * ml::NVB;
constexpr int MX_ITEMS = MX_RL + MX_ML + MX_RC + MX_MC;

__device__ __forceinline__ void scan_phase(LAS unsigned char* lds, CParams& P, int l, unsigned* ctl) {
    unsigned* qhead = ctl + CW_Q + 64 * l;
    volatile LAS unsigned* bc = (volatile LAS unsigned*)(lds + LDS_MISC) + 16;
    for (;;) {
        if (threadIdx.x == 0) bc[0] = xb_add(qhead, 1u);
        __syncthreads();
        const int it = (int)bc[0];
        __syncthreads();
        if (it >= wy::N_LAT) break;
        int s_, head, dir; wy::decode_item(it, s_, head, dir);
        wy::rwkv_cons(lds, P, l, s_, head, dir, it, ctl);
    }
    for (;;) {
        if (threadIdx.x == 0) bc[0] = xb_add(qhead + 48, 1u);
        __syncthreads();
        const int it = (int)bc[0];
        __syncthreads();
        if (it >= wy::N_LAT * wy::NPROD) break;
        const int chain = it % wy::N_LAT;
        int s_, head, dir; wy::decode_item(chain, s_, head, dir);
        wy::rwkv_prod(lds, P, l, s_, head, dir, chain, it / wy::N_LAT, ctl);
    }
    for (;;) {
        if (threadIdx.x == 0) bc[0] = xb_add(qhead + 16, 1u);
        __syncthreads();
        const int it = (int)bc[0];
        __syncthreads();
        if (it >= ml::N_ITEMS) break;
        int s_, head, dir, sub; ml::decode_item(it, s_, head, dir, sub);
        ml::mlstm_item(lds, P, l, s_, head, dir, sub);
    }
    for (;;) {
        if (threadIdx.x == 0) bc[0] = xb_add(qhead + 32, 1u);
        __syncthreads();
        const int it = (int)bc[0] + LB * RH * 2;
        __syncthreads();
        if (it >= wy::N_ITEMS) break;
        int s_, head, dir; wy::decode_item(it, s_, head, dir);
        wy::rwkv_item(lds, P, l, s_, head, dir);
    }
}

enum { ST_N0 = 0, ST_A1, ST_CV, ST_MX, ST_PO, ST_N1, ST_A2, ST_PJ, ST_WO, ST_N2, ST_F1, ST_F2, ST_PER_LAYER };
constexpr int N_STEPS = 1 + DEPTH * ST_PER_LAYER + 1;
struct MkArgs { Params P; int ph_lo, ph_hi; };
__global__ void __launch_bounds__(512, 2) mk(MkArgs a) {
    extern __shared__ __attribute__((aligned(16))) unsigned char lds_raw[];
    LAS unsigned char* lds = (LAS unsigned char*)lds_raw;
    const int G = gridDim.x, vb = (int)blockIdx.x;
    unsigned* ctl = (unsigned*)(a.P.ws + WS_CTL);
    volatile LAS unsigned* MISC = (volatile LAS unsigned*)(lds + LDS_MISC);
    for (int u = threadIdx.x; u < 64; u += 512) MISC[u] = 0u;
    __syncthreads();
    const bool multi = a.ph_hi - a.ph_lo > 1;
    XcdBarrier bar; bar.bar = ctl + CW_BAR; bar.x = 0; bar.st = nullptr;
    if (multi) bar = xcd_barrier_post(ctl + CW_BAR, MISC + 8);
    const int lo = a.ph_lo, hi = a.ph_hi;
#define STEP_BEGIN(id) if (lo <= (id) && (id) < hi) { unsigned long long kp_ = (unsigned long long)__builtin_amdgcn_kernarg_segment_ptr(); asm volatile("" : "+s"(kp_)); CParams& P = *(CParams*)kp_;
#define STEP_END(id) if ((id) + 1 < hi) xcd_barrier(bar); }
    STEP_BEGIN(0) el::init_phase(lds, P, vb, G); el::wconv_phase(lds, P, 0, vb, G); STEP_END(0)
#define LAYER(l) { \
        const int base = 1 + (l) * ST_PER_LAYER; \
        STEP_BEGIN(base + ST_N0) if ((l) > 0) el::wconv_phase(lds, P, (l), vb, G); el::norm_phase(P, (l), 0, vb, G); STEP_END(base + ST_N0) \
        STEP_BEGIN(base + ST_A1) { pg8::Gemm g{WSP(bf16, WS_QKC), WSP(bf16, O_WIN1), D, D}; pg8::StaticOrder S; S.init(NT, N1P, G, vb); \
            pg8::EpiA1 E{WSP(bf16, WS_U1)}; pg8::gemm_phase(lds, g, S, E); } STEP_END(base + ST_A1) \
        STEP_BEGIN(base + ST_CV) el::conv_phase(lds, P, (l), vb, G); STEP_END(base + ST_CV) \
        STEP_BEGIN(base + ST_MX) scan_phase(lds, P, (l), ctl); STEP_END(base + ST_MX) \
        STEP_BEGIN(base + ST_PO) el::post_phase(lds, P, (l), vb, G); STEP_END(base + ST_PO) \
        STEP_BEGIN(base + ST_N1) el::norm_phase(P, (l), 1, vb, G); STEP_END(base + ST_N1) \
        STEP_BEGIN(base + ST_A2) { pg8::Gemm g{WSP(bf16, WS_RXC), WSP(bf16, O_WIN2), D, D}; pg8::StaticOrder S; S.init(NT, 2 * D, G, vb); \
            pg8::EpiA2 E{WSP(bf16, WS_U1)}; pg8::gemm_phase(lds, g, S, E); } STEP_END(base + ST_A2) \
        STEP_BEGIN(base + ST_PJ) { pg8::Gemm g{WSP(bf16, WS_QKC), WSP(bf16, O_PM), MW, D}; pg8::PairOrder S; S.init(NT, G, vb); \
            pg8::EpiPJ E{WSP(bf16, WS_U1)}; pg8::gemm_phase(lds, g, S, E); } STEP_END(base + ST_PJ) \
        STEP_BEGIN(base + ST_WO) { pg8::Gemm g{WSP(bf16, WS_U1), WSP(bf16, O_WO), D, PU}; pg8::StaticOrder S; S.init(NT, D, G, vb); \
            pg8::EpiRes E{P.out, WSP(float, WS_MOD) + (size_t)(l) * NCOND * 6 * D + 2 * D}; pg8::gemm_phase(lds, g, S, E); } STEP_END(base + ST_WO) \
        STEP_BEGIN(base + ST_N2) el::norm_phase(P, (l), 2, vb, G); STEP_END(base + ST_N2) \
        STEP_BEGIN(base + ST_F1) { pg8::Gemm g{WSP(bf16, WS_QKC), WSP(bf16, O_W13), D, D}; pg8::StaticOrder S; S.init(NT, 2 * FF, G, vb); \
            pg8::EpiF1 E{WSP(bf16, WS_U1)}; pg8::gemm_phase(lds, g, S, E); } STEP_END(base + ST_F1) \
        STEP_BEGIN(base + ST_F2) { pg8::Gemm g{WSP(bf16, WS_U1), WSP(bf16, O_W2), FF, FF}; pg8::StaticOrder S; S.init(NT, D, G, vb); \
            pg8::EpiRes E{P.out, WSP(float, WS_MOD) + (size_t)(l) * NCOND * 6 * D + 5 * D}; pg8::gemm_phase(lds, g, S, E); } STEP_END(base + ST_F2) \
    }
    static_assert(DEPTH == 2, "layers are unrolled by hand");
    LAYER(0)
    LAYER(1)
#undef LAYER
    STEP_BEGIN(N_STEPS - 1) el::norm_phase(P, 0, 3, vb, G); STEP_END(N_STEPS - 1)
#undef STEP_BEGIN
#undef STEP_END
}
#endif

typedef void (*BodyFn)(const Params&, long);
#ifndef HOST_EMU
template <BodyFn F, int BLOCK> __global__ void __launch_bounds__(BLOCK) run_k(Params P, long n) {
    const long i = (long)blockIdx.x * BLOCK + threadIdx.x;
    if (i < n) F(P, i);
}
#define RUN(F, BLOCK, n) do { const long n_ = (n); run_k<F, BLOCK><<<dim3((unsigned)((n_ + BLOCK - 1) / BLOCK)), dim3(BLOCK), 0, stream>>>(P, n_); } while (0)
static int g_grid = 0;
#else
#define RUN(F, BLOCK, n) do { const long n_ = (n); for (long i_ = 0; i_ < n_; ++i_) F(P, i_); } while (0)
typedef void* hipStream_t;
#endif

static void forward(Params P, hipStream_t stream) {
    (void)stream;
#ifndef HOST_EMU
    if (hipMemsetAsync(P.ws + WS_CTL, 0, CTL_ZERO_BYTES, stream) != hipSuccess) return;
#ifdef MK_PER_STEP
    for (int st = 0; st < N_STEPS; ++st) { MkArgs a_{}; a_.P = P; a_.ph_lo = st; a_.ph_hi = st + 1; mk<<<dim3(g_grid), dim3(512), LDS_BYTES, stream>>>(a_); }
#else
    { MkArgs a_{}; a_.P = P; a_.ph_lo = 0; a_.ph_hi = N_STEPS; mk<<<dim3(g_grid), dim3(512), LDS_BYTES, stream>>>(a_); }
#endif
#else
    RUN(k_init_x, 256, (long)NT * D);
    RUN(k_mod, 256, (long)DEPTH * NCOND * 6 * D);
    for (int l = 0; l < DEPTH; ++l) {
        P.layer = l;
        RUN(k_wconv, 256, WC_N6);
        P.mode = 0; RUN(k_norm, 64, (long)NT);
        RUN(k_gemm_a1, 256, (long)NT * N1);
        RUN(k_conv, 256, (long)NT * (2 * MW + RIN));
        RUN(k_mlstm, 128, (long)NSEQ * MH * 2 * 128);
        for (int dir = 0; dir < 2; ++dir) { P.mode = dir; RUN(k_rwkv_prep, 256, (long)NT * RW); RUN(k_rwkv, 64, (long)NSEQ * RH * 64); }
        RUN(k_post, 256, (long)NT * D);
        P.mode = 1; RUN(k_norm, 64, (long)NT);
        RUN(k_gemm_a2, 256, (long)NT * 2 * D);
        RUN(k_gemm_pj, 256, (long)NT * D);
        RUN(k_gemm_wo, 256, (long)NT * D);
        P.mode = 2; RUN(k_norm, 64, (long)NT);
        RUN(k_gemm_f1, 256, (long)NT * FF);
        RUN(k_gemm_f2, 256, (long)NT * D);
    }
    RUN(k_final, 64, (long)NT);
#endif
}

#ifndef HOST_EMU
extern "C" void kernel_launch(void* const* d_in, const int* in_sizes, int n_in, void* d_out, int out_size, void* d_ws, size_t ws_size, hipStream_t stream) {
    if (n_in != N_IN || (size_t)out_size != OUT_END || ws_size < WS_END) return;
    if (g_grid == 0) {
        int dev = 0, cus = 0;
        if (hipGetDevice(&dev) != hipSuccess || hipDeviceGetAttribute(&cus, hipDeviceAttributeMultiprocessorCount, dev) != hipSuccess) { g_grid = -1; return; }
        if (hipFuncSetAttribute((const void*)mk, hipFuncAttributeMaxDynamicSharedMemorySize, LDS_BYTES) != hipSuccess) { g_grid = -1; return; }
        g_grid = cus;
    }
    if (g_grid < 0) return;
    Params P{};
    for (int i = 0; i < N_IN; ++i) P.in[i] = (const float*)d_in[i];
    P.out = (float*)d_out; P.ws = (unsigned char*)d_ws; P.layer = 0; P.mode = 0;
    forward(P, stream);
}
#endif
```

```cpp
#ifndef HOST_EMU
#include <hip/hip_runtime.h>
#define HD __host__ __device__ __forceinline__
#define DEV __device__ __forceinline__
#else
#include <cmath>
#include <cstring>
#include <cstdio>
#include <cstdlib>
#define HD inline
#define DEV inline
#endif
#include <cstddef>

#ifdef SMALL_CFG
constexpr int D = 256, CB = 2, CT = 128, DEPTH = 2, LB = 1, LT = 256, GW = 16;
#else
constexpr int D = 1024, CB = 32, CT = 256, DEPTH = 2, LB = 2, LT = 4096, GW = 64;
#endif
constexpr int MW = D / 2, MD = 128, MH = MW / MD, RW = D / 2, RD = 64, RH = RW / RD;
constexpr int RIN = 3 * RW + 384, FF = ((8 * D + 767) / 768) * 256, PIN = 2 * MW + MW + MW + 4 * MH + RIN + 2 * D;
constexpr int NC = CB * CT, NL = LB * LT, NT = NC + NL, NSEQ = CB + LB, NCOND = 1 + LB;
constexpr int N1 = PIN - 2 * D;
constexpr int N1P = ((N1 + 255) / 256) * 256;
constexpr int PU = N1;
constexpr int OFF_QK = 0, OFF_V = 2 * MW, OFF_O = 3 * MW, OFF_G = 4 * MW, OFF_R = 4 * MW + 4 * MH;
constexpr int RX_R = 0, RX_K = RW, RX_V = 2 * RW, RX_WL = 3 * RW, RX_AL = 3 * RW + 128, RX_GL = 3 * RW + 256;
constexpr float RMS_EPS = 1e-6f, GN_EPS = 64e-5f;
static_assert(3 * D <= N1, "G + merged must fit the dead columns of U1");

enum { X_PROMPT = 0, X_SAMPLE, ST_C, ST_N, ST_M, ST_R, C_LAT, C_CTX, ADA_W, ADA_B, NORM1, NORM2, W_IN, M_CONV, M_GATE_B, M_NORM_G,
       R_CONV, R_W0, R_W2, R_A0, R_A2, R_G2, R_KK, R_KA, R_RK, R_GN_W, R_GN_B, PROJ_M, PROJ_R, W_OUT, FFN_W1, FFN_W3, FFN_W2, FINAL_G, N_IN };

constexpr size_t OUT_X = 0;
constexpr size_t OUT_C = (size_t)NT * D;
constexpr size_t OUT_N = OUT_C + (size_t)CB * DEPTH * 2 * MH * 128 * 128;
constexpr size_t OUT_M = OUT_N + (size_t)CB * DEPTH * 2 * MH * 128;
constexpr size_t OUT_S = OUT_M + (size_t)CB * DEPTH * 2 * MH;
constexpr size_t OUT_END = OUT_S + (size_t)CB * DEPTH * 2 * RH * 64 * 64;

constexpr size_t al256(size_t x) { return (x + 255) & ~(size_t)255; }
constexpr size_t cmax(size_t a, size_t b) { return a > b ? a : b; }
constexpr size_t WS_CTL = 0;
constexpr size_t WS_MOD = (size_t)1 << 20;
constexpr size_t WS_WREG = (size_t)2 << 20;
constexpr size_t O_WIN1 = WS_WREG;
constexpr size_t O_WIN2 = O_WIN1 + (size_t)N1P * D * 2;
constexpr size_t O_PM = O_WIN2 + (size_t)2 * D * D * 2;
constexpr size_t O_PR = O_PM + (size_t)D * MW * 2;
constexpr size_t O_WO = O_PR + (size_t)D * RW * 2;
constexpr size_t O_W13 = O_WO + (size_t)D * D * 2;
constexpr size_t O_W2 = O_W13 + (size_t)2 * FF * D * 2;
constexpr size_t O_G2T = O_W2 + (size_t)D * FF * 2;
constexpr size_t O_W2T = O_G2T + (size_t)RW * 128 * 2;
constexpr size_t O_A2T = O_W2T + (size_t)2 * RW * 64 * 2;
constexpr size_t WS_U1 = al256(O_A2T + (size_t)2 * RW * 64 * 2);
constexpr size_t SZ_U1 = al256(cmax((size_t)NT * PU * 2, (size_t)NT * FF * 2));
constexpr size_t WS_QKC = WS_U1 + SZ_U1;
constexpr size_t WS_RXC = WS_QKC + (size_t)NT * D * 2;
constexpr size_t WS_END = WS_RXC + al256(cmax((size_t)NT * RIN * 2, (size_t)NT * D * 2));
#ifndef SMALL_CFG
static_assert(WS_END <= ((size_t)256 << 20), "workspace map must fit 256 MiB");
#endif

typedef unsigned short bf16;
HD float bf2f(bf16 b) { unsigned u = ((unsigned)b) << 16; return __builtin_bit_cast(float, u); }
#if defined(__HIP_DEVICE_COMPILE__)
HD bf16 f2bf(float f) { return __builtin_bit_cast(bf16, (__bf16)f); }
#else
HD bf16 f2bf(float f) { unsigned u = __builtin_bit_cast(unsigned, f); u += 0x7fffu + ((u >> 16) & 1u); return (bf16)(u >> 16); }
#endif
HD float sigmoidf_(float x) { return 1.0f / (1.0f + expf(-x)); }
HD float siluf_(float x) { return x / (1.0f + expf(-x)); }
HD float softplusf_(float x) { return fmaxf(x, 0.f) + log1pf(expf(-fabsf(x))); }
HD float logsigmoidf_(float x) { return -softplusf_(-x); }
HD int prow(int c) { return (c & ~31) | (((c >> 2) & 1) << 4) | (((c >> 3) & 3) << 2) | (c & 3); }

struct Params {
    const float* in[N_IN];
    float* out;
    unsigned char* ws;
    int layer;
    int mode;
};

struct SeqInfo { int T; int base; int grid; int cond; int b; };
HD SeqInfo seqinfo(int s) {
    SeqInfo q;
    if (s < CB) { q.T = CT; q.base = s * CT; q.grid = 0; q.cond = 0; q.b = s; }
    else { q.T = LT; q.base = NC + (s - CB) * LT; q.grid = 1; q.cond = 1 + (s - CB); q.b = s - CB; }
    return q;
}
HD int seq_of_token(int m) { return m < NC ? m / CT : CB + (m - NC) / LT; }

#define WSP(T, off) ((T*)(P.ws + (off)))

DEV void k_init_x(const Params& P, long i) {
    const size_t ncd = (size_t)NC * D;
    P.out[i] = (size_t)i < ncd ? P.in[X_PROMPT][i] : P.in[X_SAMPLE][i - ncd];
}
DEV void k_mod(const Params& P, long i) {
    const int j = (int)(i % (6 * D)); const int ci = (int)((i / (6 * D)) % NCOND); const int l = (int)(i / ((long)6 * D * NCOND));
    const float* cv = ci == 0 ? P.in[C_CTX] : P.in[C_LAT] + (size_t)(ci - 1) * D;
    const float* w = P.in[ADA_W] + (size_t)l * D * 6 * D;
    float acc = P.in[ADA_B][(size_t)l * 6 * D + j];
    for (int k = 0; k < D; ++k) acc += siluf_(cv[k]) * w[(size_t)k * 6 * D + j];
    WSP(float, WS_MOD)[i] = acc;
}
constexpr long WC_N0 = (long)N1P * D, WC_N1 = WC_N0 + (long)2 * D * D, WC_N2 = WC_N1 + (long)D * MW, WC_N3 = WC_N2 + (long)D * RW,
               WC_N4 = WC_N3 + (long)D * D, WC_N5 = WC_N4 + (long)2 * FF * D, WC_N6 = WC_N5 + (long)D * FF;
HD int unprow(int r) { return (r & ~31) | (((r >> 2) & 3) << 3) | (((r >> 4) & 1) << 2) | (r & 3); }
DEV void k_wconv(const Params& P, long i) {
    const int l = P.layer;
    if (i < WC_N0) { const int r = (int)(i / D), k = (int)(i % D); const int c = unprow(r);
        WSP(bf16, O_WIN1)[i] = c < N1 ? f2bf(P.in[W_IN][((size_t)l * D + k) * PIN + c]) : (bf16)0; return; }
    if (i < WC_N1) { const long j = i - WC_N0; const int r = (int)(j / D), k = (int)(j % D); const int c = unprow(r);
        WSP(bf16, O_WIN2)[j] = f2bf(P.in[W_IN][((size_t)l * D + k) * PIN + N1 + c]); return; }
    if (i < WC_N2) { const long j = i - WC_N1; const int r = (int)(j / MW), k = (int)(j % MW); const int c = unprow(r);
        WSP(bf16, O_PM)[j] = f2bf(P.in[PROJ_M][((size_t)l * MW + k) * D + c]); return; }
    if (i < WC_N3) { const long j = i - WC_N2; const int r = (int)(j / RW), k = (int)(j % RW); const int c = unprow(r);
        WSP(bf16, O_PR)[j] = f2bf(P.in[PROJ_R][((size_t)l * RW + k) * D + c]); return; }
    if (i < WC_N4) { const long j = i - WC_N3; const int r = (int)(j / D), k = (int)(j % D);
        WSP(bf16, O_WO)[j] = f2bf(P.in[W_OUT][((size_t)l * D + k) * D + r]); return; }
    if (i < WC_N5) { const long j = i - WC_N4; const int r = (int)(j / D), k = (int)(j % D);
        const int pn = r >> 8, rl = r & 255, which = rl >> 7, rho = rl & 127; const int jj = pn * 128 + unprow(rho);
        const float* W = which ? P.in[FFN_W3] : P.in[FFN_W1];
        WSP(bf16, O_W13)[j] = f2bf(W[((size_t)l * D + k) * FF + jj]); return; }
    { const long j = i - WC_N5; const int r = (int)(j / FF), k = (int)(j % FF);
        WSP(bf16, O_W2)[j] = f2bf(P.in[FFN_W2][((size_t)l * FF + k) * D + r]); }
}
DEV void k_norm(const Params& P, long m) {
    const int l = P.layer; const int second = (P.mode == 2);
    const float* x = P.out + (size_t)m * D;
    const float* g = P.in[second ? NORM2 : NORM1] + (size_t)l * D;
    const int cond = seqinfo(seq_of_token((int)m)).cond;
    const float* mod = WSP(float, WS_MOD) + ((size_t)l * NCOND + cond) * 6 * D + (second ? 3 * D : 0);
    float ss = 0.f;
    for (int k = 0; k < D; ++k) ss += x[k] * x[k];
    const float rs = 1.0f / sqrtf(ss / D + RMS_EPS);
    bf16* o = WSP(bf16, P.mode == 1 ? WS_RXC : WS_QKC) + (size_t)m * D;
    for (int k = 0; k < D; ++k) o[k] = f2bf(x[k] * rs * g[k] * (1.0f + mod[D + k]) + mod[k]);
}
DEV float dot_bf(const bf16* a, const bf16* b, int K) { float s = 0.f; for (int k = 0; k < K; ++k) s += bf2f(a[k]) * bf2f(b[k]); return s; }
DEV void k_gemm_a1(const Params& P, long i) {
    const int n = (int)(i % N1); const long m = i / N1;
    WSP(bf16, WS_U1)[(size_t)m * PU + n] = f2bf(dot_bf(WSP(bf16, WS_QKC) + (size_t)m * D, WSP(bf16, O_WIN1) + (size_t)prow(n) * D, D));
}
DEV void k_gemm_a2(const Params& P, long i) {
    const int n = (int)(i % (2 * D)); const long m = i / (2 * D);
    WSP(bf16, WS_U1)[(size_t)m * PU + D + n] = f2bf(sigmoidf_(dot_bf(WSP(bf16, WS_RXC) + (size_t)m * D, WSP(bf16, O_WIN2) + (size_t)prow(n) * D, D)));
}
DEV void k_gemm_pj(const Params& P, long i) {
    const int n = (int)(i % D); const long m = i / D;
    const bf16* hmr = WSP(bf16, WS_QKC) + (size_t)m * D; bf16* u = WSP(bf16, WS_U1) + (size_t)m * PU;
    const float a = dot_bf(hmr, WSP(bf16, O_PM) + (size_t)prow(n) * MW, MW), b = dot_bf(hmr + MW, WSP(bf16, O_PR) + (size_t)prow(n) * RW, RW);
    const float first = bf2f(f2bf(bf2f(u[D + n]) * a));
    u[n] = f2bf(first + bf2f(u[2 * D + n]) * b);
}
DEV void k_gemm_wo(const Params& P, long i) {
    const int n = (int)(i % D); const long m = i / D; const int l = P.layer;
    const int cond = seqinfo(seq_of_token((int)m)).cond;
    const float g1 = WSP(float, WS_MOD)[((size_t)l * NCOND + cond) * 6 * D + 2 * D + n];
    P.out[(size_t)m * D + n] += g1 * dot_bf(WSP(bf16, WS_U1) + (size_t)m * PU, WSP(bf16, O_WO) + (size_t)n * D, D);
}
DEV void k_gemm_f1(const Params& P, long i) {
    const int j = (int)(i % FF); const long m = i / FF;
    const int pn = j >> 7, rho = prow(j & 127);
    const bf16* h = WSP(bf16, WS_QKC) + (size_t)m * D;
    const float a = dot_bf(h, WSP(bf16, O_W13) + (size_t)(pn * 256 + rho) * D, D), b = dot_bf(h, WSP(bf16, O_W13) + (size_t)(pn * 256 + 128 + rho) * D, D);
    WSP(bf16, WS_U1)[(size_t)m * FF + j] = f2bf(siluf_(a) * b);
}
DEV void k_gemm_f2(const Params& P, long i) {
    const int n = (int)(i % D); const long m = i / D; const int l = P.layer;
    const int cond = seqinfo(seq_of_token((int)m)).cond;
    const float g2 = WSP(float, WS_MOD)[((size_t)l * NCOND + cond) * 6 * D + 5 * D + n];
    P.out[(size_t)m * D + n] += g2 * dot_bf(WSP(bf16, WS_U1) + (size_t)m * FF, WSP(bf16, O_W2) + (size_t)n * FF, FF);
}
DEV void k_conv(const Params& P, long i) {
    constexpr int NCH = 2 * MW + RIN;
    const int ch = (int)(i % NCH); const int m = (int)(i / NCH); const int l = P.layer;
    const int s = seq_of_token(m); const SeqInfo q = seqinfo(s); const int t = m - q.base;
    const bool isqk = ch < 2 * MW; const int c = isqk ? ch : ch - 2 * MW;
    const int ucol = isqk ? OFF_QK + c : OFF_R + c;
    const int CH = isqk ? 2 * MW : RIN;
    const float* w = (isqk ? P.in[M_CONV] : P.in[R_CONV]) + (size_t)l * 9 * CH;
    const bf16* U = WSP(bf16, WS_U1);
    float acc = 0.f;
    if (q.grid) {
        const int r = t / GW, cc = t % GW, rows = q.T / GW;
        for (int a = 0; a < 3; ++a) for (int b = 0; b < 3; ++b) {
            const int rr = r + a - 1, c2 = cc + b - 1;
            if (rr >= 0 && rr < rows && c2 >= 0 && c2 < GW) acc += w[(a * 3 + b) * CH + c] * bf2f(U[(size_t)(q.base + rr * GW + c2) * PU + ucol]);
        }
    } else {
        for (int b = 0; b < 3; ++b) { const int t2 = t + b - 1; if (t2 >= 0 && t2 < q.T) acc += w[(3 + b) * CH + c] * bf2f(U[(size_t)(q.base + t2) * PU + ucol]); }
    }
    if (isqk) { float v = siluf_(acc); if (c < MW) v *= 0.08838834764831845f; WSP(bf16, WS_QKC)[(size_t)m * (2 * MW) + c] = f2bf(v); }
    else { float v = acc; if (c >= RX_WL && c < RX_AL) v = tanhf(v); else if (c >= RX_GL) v = sigmoidf_(v); WSP(bf16, WS_RXC)[(size_t)m * RIN + c] = f2bf(v); }
}
DEV void k_mlstm(const Params& P, long i) {
    const int e = (int)(i % 128); const int chain = (int)(i / 128); const int dir = chain & 1, head = (chain >> 1) % MH, s = chain / (2 * MH);
    const int l = P.layer; const SeqInfo q = seqinfo(s);
    float C[128], n[128]; float m;
    if (!q.grid) {
#pragma unroll
        for (int d = 0; d < 128; ++d) { C[d] = 0.f; n[d] = 0.f; }
        m = 0.f;
    } else {
        const size_t sb = (((size_t)q.b * DEPTH + l) * 2 + dir) * MH + head;
#pragma unroll
        for (int d = 0; d < 128; ++d) { C[d] = P.in[ST_C][(sb * 128 + d) * 128 + e]; n[d] = P.in[ST_N][sb * 128 + d]; }
        m = P.in[ST_M][sb];
    }
    const float bi = P.in[M_GATE_B][(size_t)l * 4 * MH + (2 * dir) * MH + head], bfg = P.in[M_GATE_B][(size_t)l * 4 * MH + (2 * dir + 1) * MH + head];
    bf16* U = WSP(bf16, WS_U1); const bf16* QK = WSP(bf16, WS_QKC);
    float nsel = 0.f;
    for (int p = 0; p < q.T; ++p) {
        const int t = dir ? q.T - 1 - p : p; const size_t tok = (size_t)(q.base + t);
        const bf16* qk = QK + tok * (2 * MW); bf16* u = U + tok * PU;
        const float gi = bf2f(u[OFF_G + (2 * dir) * MH + head]) + bi, gf = bf2f(u[OFF_G + (2 * dir + 1) * MH + head]) + bfg;
        const float lf = logsigmoidf_(gf);
        const float mn = fmaxf(lf + m, gi); const float fw = expf(lf + m - mn), iw = expf(gi - mn);
        const float v = bf2f(u[OFF_V + head * 128 + e]);
        float num = 0.f, den = 0.f;
#pragma unroll
        for (int d = 0; d < 128; ++d) {
            const float kd = bf2f(qk[MW + head * 128 + d]), qd = bf2f(qk[head * 128 + d]);
            C[d] = fw * C[d] + iw * kd * v; n[d] = fw * n[d] + iw * kd; num += qd * C[d]; den += qd * n[d];
        }
        m = mn;
        u[dir * MW + head * 128 + e] = f2bf(num / fmaxf(fabsf(den), expf(-m)));
    }
    if (!q.grid) {
        const size_t sb = (((size_t)q.b * DEPTH + l) * 2 + dir) * MH + head;
#pragma unroll
        for (int d = 0; d < 128; ++d) { P.out[OUT_C + (sb * 128 + d) * 128 + e] = C[d]; if (d == e) nsel = n[d]; }
        P.out[OUT_N + sb * 128 + e] = nsel;
        if (e == 0) P.out[OUT_M + sb] = m;
    }
}
DEV void k_rwkv_prep(const Params& P, long i) {
    const int c = (int)(i % RW); const size_t tok = (size_t)(i / RW); const int l = P.layer, dir = P.mode;
    const bf16* rx = WSP(bf16, WS_RXC) + tok * RIN;
    const float* w2 = P.in[R_W2] + ((size_t)l * 2 + dir) * 64 * RW + c; const float* a2 = P.in[R_A2] + ((size_t)l * 2 + dir) * 64 * RW + c;
    float wr = P.in[R_W0][((size_t)l * 2 + dir) * RW + c], ar = P.in[R_A0][((size_t)l * 2 + dir) * RW + c];
    for (int j = 0; j < 64; ++j) { wr += bf2f(rx[RX_WL + dir * 64 + j]) * w2[(size_t)j * RW]; ar += bf2f(rx[RX_AL + dir * 64 + j]) * a2[(size_t)j * RW]; }
    bf16* o = WSP(bf16, WS_QKC) + tok * (2 * RW);
    o[c] = f2bf(wr); o[RW + c] = f2bf(ar);
}
DEV void k_rwkv(const Params& P, long i) {
    const int row = (int)(i % 64); const int chain = (int)(i / 64); const int dir = P.mode, head = chain % RH, s = chain / RH;
    const int l = P.layer; const SeqInfo q = seqinfo(s); const int hc = head * 64;
    float S[64];
    if (!q.grid) {
#pragma unroll
        for (int c = 0; c < 64; ++c) S[c] = 0.f;
    } else {
        const size_t sb = (((size_t)q.b * DEPTH + l) * 2 + dir) * RH + head;
#pragma unroll
        for (int c = 0; c < 64; ++c) S[c] = P.in[ST_R][(sb * 64 + row) * 64 + c];
    }
    const float* rkk = P.in[R_KK] + (size_t)l * RW + hc; const float* rka = P.in[R_KA] + (size_t)l * RW + hc;
    bf16* U = WSP(bf16, WS_U1); const bf16* RX = WSP(bf16, WS_RXC); const bf16* WA = WSP(bf16, WS_QKC);
    for (int p = 0; p < q.T; ++p) {
        const int t = dir ? q.T - 1 - p : p; const size_t tok = (size_t)(q.base + t);
        const bf16* rx = RX + tok * RIN; const bf16* wa = WA + tok * (2 * RW);
        float ss = 0.f;
        for (int c = 0; c < 64; ++c) { const float kc = bf2f(rx[RX_K + hc + c]) * rkk[c]; ss += kc * kc; }
        const float inv = 1.0f / fmaxf(sqrtf(ss), 1e-12f);
        float sa = 0.f;
#pragma unroll
        for (int c = 0; c < 64; ++c) sa -= S[c] * (bf2f(rx[RX_K + hc + c]) * rkk[c] * inv);
        const float v = bf2f(rx[RX_V + hc + row]);
        float y = 0.f;
#pragma unroll
        for (int c = 0; c < 64; ++c) {
            const float wr = bf2f(wa[hc + c]), ar = bf2f(wa[RW + hc + c]);
            const float decay = expf(-0.6065306597126334f * sigmoidf_(wr));
            const float alpha = sigmoidf_(ar);
            const float kr = bf2f(rx[RX_K + hc + c]);
            const float kt = kr * (1.0f + (alpha - 1.0f) * rka[c]);
            const float bb = kr * rkk[c] * inv * alpha;
            S[c] = S[c] * decay + sa * bb + v * kt;
            y += S[c] * bf2f(rx[RX_R + hc + c]);
        }
        U[tok * PU + OFF_R + dir * RW + hc + row] = f2bf(y);
    }
    if (!q.grid) {
        const size_t sb = (((size_t)q.b * DEPTH + l) * 2 + dir) * RH + head;
#pragma unroll
        for (int c = 0; c < 64; ++c) P.out[OUT_S + (sb * 64 + row) * 64 + c] = S[c];
    }
}
DEV void k_post(const Params& P, long i) {
    const int ch = (int)(i % D); const size_t m = (size_t)(i / D); const int l = P.layer;
    const bf16* u = WSP(bf16, WS_U1) + m * PU; const bf16* rx = WSP(bf16, WS_RXC) + m * RIN;
    bf16* o = WSP(bf16, WS_QKC) + m * D;
    if (ch < MW) {
        const int h0 = (ch / 128) * 128; float ss = 0.f;
        for (int d = 0; d < 128; ++d) { const float x = bf2f(u[h0 + d]) + bf2f(u[MW + h0 + d]); ss += x * x; }
        const float x = bf2f(u[ch]) + bf2f(u[MW + ch]);
        o[ch] = f2bf(x / sqrtf(ss / 128.f + RMS_EPS) * P.in[M_NORM_G][(size_t)l * MW + ch] * sigmoidf_(bf2f(u[OFF_O + ch])));
    } else {
        const int c = ch - MW; const int h0 = (c / 64) * 64;
        float mu = 0.f, bsum = 0.f;
        for (int d = 0; d < 64; ++d) { mu += bf2f(u[OFF_R + h0 + d]) + bf2f(u[OFF_R + RW + h0 + d]);
            bsum += bf2f(rx[RX_R + h0 + d]) * bf2f(rx[RX_K + h0 + d]) * P.in[R_RK][(size_t)l * RW + h0 + d]; }
        mu *= (1.0f / 64.f); float var = 0.f;
        for (int d = 0; d < 64; ++d) { const float x = bf2f(u[OFF_R + h0 + d]) + bf2f(u[OFF_R + RW + h0 + d]) - mu; var += x * x; }
        var *= (1.0f / 64.f);
        const float y = bf2f(u[OFF_R + c]) + bf2f(u[OFF_R + RW + c]);
        const float yn = (y - mu) / sqrtf(var + GN_EPS) * P.in[R_GN_W][(size_t)l * RW + c] + P.in[R_GN_B][(size_t)l * RW + c];
        float gate = 0.f;
        for (int j = 0; j < 128; ++j) gate += bf2f(rx[RX_GL + j]) * P.in[R_G2][((size_t)l * 128 + j) * RW + c];
        o[ch] = f2bf((yn + bsum * bf2f(rx[RX_V + c])) * gate);
    }
}
DEV void k_final(const Params& P, long m) {
    float* x = P.out + (size_t)m * D; float ss = 0.f;
    for (int k = 0; k < D; ++k) ss += x[k] * x[k];
    const float rs = 1.0f / sqrtf(ss / D + RMS_EPS);
    for (int k = 0; k < D; ++k) x[k] = x[k] * rs * P.in[FINAL_G][k];
}


#ifndef HOST_EMU
typedef const __attribute__((address_space(4))) Params CParams;
namespace pg8 {
#define PG8_LAS __attribute__((address_space(3)))
typedef short bf16x8 __attribute__((ext_vector_type(8)));
typedef float f32x4 __attribute__((ext_vector_type(4)));
typedef unsigned u32x4 __attribute__((ext_vector_type(4)));
constexpr int BM = 256, BK = 64, HALF = 128, HTB = HALF * BK * 2, STAGE_BYTES = 8 * HTB, NXCD = 8, WGM = 8;
__device__ __forceinline__ int lds_byte(int r, int c) { const int st = (r >> 4) * 2 + (c >> 5), rr = r & 15, cc = c & 31, ob = rr * 64 + cc * 2; return st * 1024 + (ob ^ (((ob >> 9) & 1) << 5)); }
__device__ __forceinline__ void stage_rc(int b, int& R, int& C) { const int st = b / 1024, sb = b % 1024, swz = sb ^ (((sb >> 9) & 1) << 5); R = (st >> 1) * 16 + swz / 64; C = (st & 1) * 32 + (swz % 64) / 2; }
struct Unit { int pm, pn, aoff; };
struct Gemm { const bf16* A; const bf16* Bt; int K, lda; };
struct StaticOrder {
    int nM, nN, nwg, G, c;
    __device__ __forceinline__ void init(int M, int N, int G_, int c_) { nM = M / BM; nN = N / BM; nwg = nM * nN; G = G_; c = c_; }
    __device__ __forceinline__ bool next(int i, Unit& u) const {
        const long L = (long)i * G + c; if (L >= nwg) return false;
        int wgid = (int)L; { const int q = nwg / NXCD, r = nwg % NXCD, xcd = wgid % NXCD, off = wgid / NXCD; wgid = (xcd < r ? xcd * (q + 1) : r * (q + 1) + (xcd - r) * q) + off; }
        const int nig = WGM * nN, gid = wgid / nig, fm = gid * WGM, gsz = (nM - fm) < WGM ? (nM - fm) : WGM;
        u.pm = fm + ((wgid % nig) % gsz); u.pn = (wgid % nig) / gsz; u.aoff = 0; return true;
    }
};
struct PairOrder {
    int nbase, G, v, nct;
    __device__ __forceinline__ void init(int M, int G_, int c_) { nct = D / BM; nbase = (M / BM) * nct; G = G_; v = (G_ % 8 == 0) ? (c_ % 8) * (G_ / 8) + c_ / 8 : c_; }
    __device__ __forceinline__ bool next(int i, Unit& u) const {
        const int j = v + (i >> 1) * G; if (j >= nbase) return false;
        const int half = i & 1; u.pm = j / nct; u.pn = half * nct + (j % nct); u.aoff = half * MW; return true;
    }
};
typedef float f32x2_t __attribute__((ext_vector_type(2)));
typedef __bf16 bf16x2_t __attribute__((ext_vector_type(2)));
__device__ __forceinline__ unsigned cvt_pk_bf16(float lo, float hi) { f32x2_t v = {lo, hi}; bf16x2_t b = __builtin_convertvector(v, bf16x2_t); return __builtin_bit_cast(unsigned, b); }
__device__ __forceinline__ float fsigmoid(float x) { return __builtin_amdgcn_rcpf(1.0f + __expf(-x)); }
__device__ __forceinline__ float bflo(unsigned w) { return __builtin_bit_cast(float, w << 16); }
__device__ __forceinline__ float bfhi(unsigned w) { return __builtin_bit_cast(float, w & 0xffff0000u); }

struct EpiA1 {
    bf16* U;
    __device__ __forceinline__ void operator()(const f32x4 (&acc)[2][2][4][2], const Unit& u, int wr, int wc, int fr, int fq) const {
        const int row0 = u.pm * BM + wr * 64 + fr, col0 = u.pn * BM + wc * 32 + 8 * fq;
#pragma unroll
        for (int ai = 0; ai < 2; ++ai)
#pragma unroll
            for (int m = 0; m < 4; ++m) { bf16* rowp = U + (size_t)(row0 + ai * HALF + m * 16) * PU + col0;
#pragma unroll
                for (int bj = 0; bj < 2; ++bj) { if (col0 + bj * HALF < N1) { const f32x4 v0 = acc[ai][bj][m][0], v1 = acc[ai][bj][m][1];
                    u32x4 w; w.x = cvt_pk_bf16(v0[0], v0[1]); w.y = cvt_pk_bf16(v0[2], v0[3]); w.z = cvt_pk_bf16(v1[0], v1[1]); w.w = cvt_pk_bf16(v1[2], v1[3]);
                    *(u32x4*)(rowp + bj * HALF) = w; } } }
    }
};
struct EpiA2 {
    bf16* U;
    __device__ __forceinline__ void operator()(const f32x4 (&acc)[2][2][4][2], const Unit& u, int wr, int wc, int fr, int fq) const {
        const int row0 = u.pm * BM + wr * 64 + fr, col0 = D + u.pn * BM + wc * 32 + 8 * fq;
#pragma unroll
        for (int ai = 0; ai < 2; ++ai)
#pragma unroll
            for (int m = 0; m < 4; ++m) { bf16* rowp = U + (size_t)(row0 + ai * HALF + m * 16) * PU + col0;
#pragma unroll
                for (int bj = 0; bj < 2; ++bj) { const f32x4 v0 = acc[ai][bj][m][0], v1 = acc[ai][bj][m][1];
                    u32x4 w; w.x = cvt_pk_bf16(fsigmoid(v0[0]), fsigmoid(v0[1])); w.y = cvt_pk_bf16(fsigmoid(v0[2]), fsigmoid(v0[3]));
                    w.z = cvt_pk_bf16(fsigmoid(v1[0]), fsigmoid(v1[1])); w.w = cvt_pk_bf16(fsigmoid(v1[2]), fsigmoid(v1[3]));
                    *(u32x4*)(rowp + bj * HALF) = w; } }
    }
};
struct EpiPJ {
    bf16* U;
    __device__ __forceinline__ void operator()(const f32x4 (&acc)[2][2][4][2], const Unit& u, int wr, int wc, int fr, int fq) const {
        const int nct = D / BM, half = u.pn >= nct ? 1 : 0, ct = u.pn - half * nct;
        const int row0 = u.pm * BM + wr * 64 + fr, col0 = ct * BM + wc * 32 + 8 * fq;
#pragma unroll
        for (int ai = 0; ai < 2; ++ai)
#pragma unroll
            for (int m = 0; m < 4; ++m) { bf16* rowp = U + (size_t)(row0 + ai * HALF + m * 16) * PU + col0;
#pragma unroll
                for (int bj = 0; bj < 2; ++bj) { const f32x4 v0 = acc[ai][bj][m][0], v1 = acc[ai][bj][m][1];
                    const u32x4 g = *(const u32x4*)(rowp + (1 + half) * D + bj * HALF);
                    float o[8] = { bflo(g.x) * v0[0], bfhi(g.x) * v0[1], bflo(g.y) * v0[2], bfhi(g.y) * v0[3], bflo(g.z) * v1[0], bfhi(g.z) * v1[1], bflo(g.w) * v1[2], bfhi(g.w) * v1[3] };
                    if (half) { const u32x4 p = *(const u32x4*)(rowp + bj * HALF);
                        o[0] += bflo(p.x); o[1] += bfhi(p.x); o[2] += bflo(p.y); o[3] += bfhi(p.y); o[4] += bflo(p.z); o[5] += bfhi(p.z); o[6] += bflo(p.w); o[7] += bfhi(p.w); }
                    u32x4 w; w.x = cvt_pk_bf16(o[0], o[1]); w.y = cvt_pk_bf16(o[2], o[3]); w.z = cvt_pk_bf16(o[4], o[5]); w.w = cvt_pk_bf16(o[6], o[7]);
                    *(u32x4*)(rowp + bj * HALF) = w; }
                asm volatile("" ::: "memory"); }
    }
};
struct EpiRes {
    float* X; const float* gate;
    __device__ __forceinline__ void operator()(const f32x4 (&acc)[2][2][4][2], const Unit& u, int wr, int wc, int fr, int fq) const {
        const int row0 = u.pm * BM + wr * 64 + fr, col0 = u.pn * BM + wc * 32 + 4 * fq;
        const int cond = seqinfo(seq_of_token(u.pm * BM)).cond;
        const float* gp = gate + (size_t)cond * 6 * D + col0;
        f32x4 gv[2][2];
#pragma unroll
        for (int bj = 0; bj < 2; ++bj)
#pragma unroll
            for (int n = 0; n < 2; ++n) gv[bj][n] = *(const f32x4*)(gp + bj * HALF + n * 16);
#pragma unroll
        for (int ai = 0; ai < 2; ++ai)
#pragma unroll
            for (int m = 0; m < 4; ++m) { float* rowp = X + (size_t)(row0 + ai * HALF + m * 16) * D + col0;
#pragma unroll
                for (int bj = 0; bj < 2; ++bj)
#pragma unroll
                    for (int n = 0; n < 2; ++n) { f32x4* p = (f32x4*)(rowp + bj * HALF + n * 16); *p = *p + gv[bj][n] * acc[ai][bj][m][n]; }
                asm volatile("" ::: "memory"); }
    }
};
struct EpiF1 {
    bf16* Hd;
    __device__ __forceinline__ void operator()(const f32x4 (&acc)[2][2][4][2], const Unit& u, int wr, int wc, int fr, int fq) const {
        const int row0 = u.pm * BM + wr * 64 + fr, col0 = u.pn * HALF + wc * 32 + 8 * fq;
#pragma unroll
        for (int ai = 0; ai < 2; ++ai)
#pragma unroll
            for (int m = 0; m < 4; ++m) { bf16* rowp = Hd + (size_t)(row0 + ai * HALF + m * 16) * FF + col0;
                float o[8];
#pragma unroll
                for (int n = 0; n < 2; ++n)
#pragma unroll
                    for (int e = 0; e < 4; ++e) { const float a = acc[ai][0][m][n][e], b = acc[ai][1][m][n][e]; o[n * 4 + e] = a * fsigmoid(a) * b; }
                u32x4 w; w.x = cvt_pk_bf16(o[0], o[1]); w.y = cvt_pk_bf16(o[2], o[3]); w.z = cvt_pk_bf16(o[4], o[5]); w.w = cvt_pk_bf16(o[6], o[7]);
                *(u32x4*)rowp = w; }
    }
};

template <class Epi, class Sched, bool ALIGN_EPI = true, bool SP2 = true>
__device__ __forceinline__ void gemm_phase(PG8_LAS unsigned char* lds, const Gemm g, const Sched& S, const Epi& E) {
    const int tid = threadIdx.x, wid = __builtin_amdgcn_readfirstlane(tid >> 6), lane = tid & 63, wr = wid >> 2, wc = wid & 3, fr = lane & 15, fq = lane >> 4;
    const int K = g.K, nt = K / BK;
    unsigned voffA[2], voffB[2];
#pragma unroll
    for (int i = 0; i < 2; ++i) { int R, C; stage_rc(tid * 16 + i * 8192, R, C);
        voffA[i] = (unsigned)(R * g.lda + C) * 2u; voffB[i] = (unsigned)(R * K + C) * 2u; }
    const size_t kstep = (size_t)(BK * 2);
    const size_t hstepA = (size_t)HALF * g.lda * 2, hstepB = (size_t)HALF * K * 2;
    const size_t tstepA = 2 * hstepA, tstepB = 2 * hstepB;
    const unsigned ldsw = (unsigned)wid * 1024u;
    const int aoff = lds_byte(wr * 64 + fr, fq * 8), boff = lds_byte(wc * 32 + fr, fq * 8);
#define PG8_SA(b, h) (((b) * 2 + (h)) * HTB)
#define PG8_SB(b, h) ((4 + (b) * 2 + (h)) * HTB)
#define PG8_STAGE(bufoff, gbase, voff) do { _Pragma("unroll") for (int _i = 0; _i < 2; ++_i) \
        __builtin_amdgcn_global_load_lds((const unsigned*)((const char*)(gbase) + (voff)[_i]), (PG8_LAS unsigned*)(lds + (bufoff) + ldsw + _i * 8192), 16, 0, 0); } while (0)
#define PG8_LDA(dst, b, h) do { _Pragma("unroll") for (int m = 0; m < 4; ++m) _Pragma("unroll") for (int k = 0; k < 2; ++k) dst[m][k] = *(const PG8_LAS bf16x8*)(lds + PG8_SA(b, h) + aoff + m * 2048 + k * 1024); } while (0)
#define PG8_LDB(dst, b, h) do { _Pragma("unroll") for (int n = 0; n < 2; ++n) _Pragma("unroll") for (int k = 0; k < 2; ++k) dst[n][k] = *(const PG8_LAS bf16x8*)(lds + PG8_SB(b, h) + boff + n * 2048 + k * 1024); } while (0)
#define PG8_MMA(ai, bj, At, Bt) do { __builtin_amdgcn_s_setprio(1); _Pragma("unroll") for (int m = 0; m < 4; ++m) _Pragma("unroll") for (int n = 0; n < 2; ++n) _Pragma("unroll") for (int k = 0; k < 2; ++k) \
        acc[ai][bj][m][n] = __builtin_amdgcn_mfma_f32_16x16x32_bf16(Bt[n][k], At[m][k], acc[ai][bj][m][n], 0, 0, 0); __builtin_amdgcn_s_setprio(0); } while (0)
#define PG8_WAIT_V(n) asm volatile("s_waitcnt vmcnt(" #n ")" ::: "memory")
#define PG8_WAIT_L(n) asm volatile("s_waitcnt lgkmcnt(" #n ")" ::: "memory")
#define PG8_BAR __builtin_amdgcn_s_barrier()
#define PG8_SCHED __builtin_amdgcn_sched_barrier(0)
    Unit cur, nxt; int ui = 0;
    if (!S.next(0, cur)) return;
    f32x4 acc[2][2][4][2];
#pragma unroll
    for (int a = 0; a < 2; ++a)
#pragma unroll
        for (int b = 0; b < 2; ++b)
#pragma unroll
            for (int m = 0; m < 4; ++m)
#pragma unroll
                for (int n = 0; n < 2; ++n) acc[a][b][m][n] = (f32x4){0.f, 0.f, 0.f, 0.f};
    bf16x8 At[4][2], B0[2][2], B1[2][2];
    const char* cA = (const char*)g.A + (size_t)cur.pm * tstepA + (size_t)cur.aoff * 2; const char* cB = (const char*)g.Bt + (size_t)cur.pn * tstepB;
    if constexpr (SP2) {
        PG8_STAGE(PG8_SB(0, 0), cB, voffB); PG8_STAGE(PG8_SB(0, 1), cB + hstepB, voffB); PG8_STAGE(PG8_SA(0, 0), cA, voffA); PG8_STAGE(PG8_SA(0, 1), cA + hstepA, voffA);
        if (wr == 1) PG8_BAR;
        PG8_WAIT_V(2); PG8_BAR;
        PG8_STAGE(PG8_SB(1, 0), cB + kstep, voffB); PG8_STAGE(PG8_SA(1, 0), cA + kstep, voffA); PG8_STAGE(PG8_SB(1, 1), cB + hstepB + kstep, voffB);
        PG8_WAIT_V(6); PG8_BAR;
    } else {
        PG8_STAGE(PG8_SB(0, 0), cB, voffB); PG8_STAGE(PG8_SA(0, 0), cA, voffA); PG8_STAGE(PG8_SB(0, 1), cB + hstepB, voffB); PG8_STAGE(PG8_SA(0, 1), cA + hstepA, voffA);
        if (wr == 1) PG8_BAR;
        PG8_WAIT_V(4); PG8_BAR;
        PG8_STAGE(PG8_SB(1, 0), cB + kstep, voffB); PG8_STAGE(PG8_SA(1, 0), cA + kstep, voffA); PG8_STAGE(PG8_SB(1, 1), cB + hstepB + kstep, voffB);
        PG8_WAIT_V(6); PG8_BAR;
    }
    for (;;) {
        const bool has_next = S.next(ui + 1, nxt);
        const char* nA = has_next ? (const char*)g.A + (size_t)nxt.pm * tstepA + (size_t)nxt.aoff * 2 : cA; const char* nB = has_next ? (const char*)g.Bt + (size_t)nxt.pn * tstepB : cB;
        for (int t = 0; t < nt; t += 2) {
            const bool last = (t == nt - 2);
            const char* a1 = cA + (size_t)(t + 1) * kstep;
            const char* a2 = last ? nA : cA + (size_t)(t + 2) * kstep; const char* b2 = last ? nB : cB + (size_t)(t + 2) * kstep;
            const char* a3 = a2 + kstep; const char* b3 = b2 + kstep;
            if constexpr (SP2) {
            PG8_LDB(B0, 0, 0); PG8_LDB(B1, 0, 1); PG8_SCHED; PG8_LDA(At, 0, 0); PG8_STAGE(PG8_SA(1, 1), a1 + hstepA, voffA);
            PG8_WAIT_V(8); PG8_WAIT_L(0); PG8_BAR; PG8_MMA(0, 0, At, B0); PG8_MMA(0, 1, At, B1); PG8_BAR; PG8_SCHED;
            PG8_LDA(At, 0, 1); PG8_STAGE(PG8_SB(0, 0), b2, voffB); PG8_STAGE(PG8_SB(0, 1), b2 + hstepB, voffB); PG8_STAGE(PG8_SA(0, 0), a2, voffA);
            PG8_WAIT_V(8); PG8_WAIT_L(0); PG8_BAR; PG8_MMA(1, 0, At, B0); PG8_MMA(1, 1, At, B1); PG8_BAR; PG8_SCHED;
            PG8_LDB(B0, 1, 0); PG8_LDB(B1, 1, 1); PG8_SCHED; PG8_LDA(At, 1, 0); PG8_STAGE(PG8_SA(0, 1), a2 + hstepA, voffA);
            PG8_WAIT_V(8); PG8_WAIT_L(0); PG8_BAR; PG8_MMA(0, 0, At, B0); PG8_MMA(0, 1, At, B1); PG8_BAR; PG8_SCHED;
            PG8_LDA(At, 1, 1); PG8_STAGE(PG8_SB(1, 0), b3, voffB); PG8_STAGE(PG8_SB(1, 1), b3 + hstepB, voffB); PG8_STAGE(PG8_SA(1, 0), a3, voffA);
            PG8_WAIT_V(8); PG8_WAIT_L(0); PG8_BAR; PG8_MMA(1, 0, At, B0); PG8_MMA(1, 1, At, B1); PG8_BAR; PG8_SCHED;
            } else {
            PG8_LDB(B0, 0, 0); PG8_SCHED; PG8_LDA(At, 0, 0); PG8_STAGE(PG8_SA(1, 1), a1 + hstepA, voffA);
            PG8_WAIT_L(8); PG8_BAR; PG8_WAIT_L(0); PG8_MMA(0, 0, At, B0); PG8_BAR; PG8_SCHED;
            PG8_LDB(B1, 0, 1); PG8_STAGE(PG8_SB(0, 0), b2, voffB);
            PG8_BAR; PG8_WAIT_L(0); PG8_MMA(0, 1, At, B1); PG8_BAR;
            PG8_LDA(At, 0, 1); PG8_STAGE(PG8_SA(0, 0), a2, voffA);
            PG8_BAR; PG8_WAIT_L(0); PG8_MMA(1, 0, At, B0); PG8_BAR; PG8_SCHED;
            PG8_STAGE(PG8_SB(0, 1), b2 + hstepB, voffB);
            PG8_WAIT_V(6); PG8_BAR; PG8_MMA(1, 1, At, B1); PG8_BAR;
            PG8_LDB(B0, 1, 0); PG8_SCHED; PG8_LDA(At, 1, 0); PG8_STAGE(PG8_SA(0, 1), a2 + hstepA, voffA);
            PG8_WAIT_L(8); PG8_BAR; PG8_WAIT_L(0); PG8_MMA(0, 0, At, B0); PG8_BAR; PG8_SCHED;
            PG8_LDB(B1, 1, 1); PG8_STAGE(PG8_SB(1, 0), b3, voffB);
            PG8_BAR; PG8_WAIT_L(0); PG8_MMA(0, 1, At, B1); PG8_BAR;
            PG8_LDA(At, 1, 1); PG8_STAGE(PG8_SA(1, 0), a3, voffA);
            PG8_BAR; PG8_WAIT_L(0); PG8_MMA(1, 0, At, B0); PG8_BAR; PG8_SCHED;
            PG8_STAGE(PG8_SB(1, 1), b3 + hstepB, voffB);
            PG8_WAIT_V(6); PG8_BAR; PG8_MMA(1, 1, At, B1); PG8_BAR;
            }
        }
        if constexpr (ALIGN_EPI) { if (wr == 0) PG8_BAR; }
        E(acc, cur, wr, wc, fr, fq);
        if (!has_next) break;
#pragma unroll
        for (int a = 0; a < 2; ++a)
#pragma unroll
            for (int b = 0; b < 2; ++b)
#pragma unroll
                for (int m = 0; m < 4; ++m)
#pragma unroll
                    for (int n = 0; n < 2; ++n) acc[a][b][m][n] = (f32x4){0.f, 0.f, 0.f, 0.f};
        cur = nxt; cA = nA; cB = nB; ++ui;
        if constexpr (ALIGN_EPI) { if (wr == 1) PG8_BAR; }
    }
    PG8_WAIT_V(0);
    if constexpr (!ALIGN_EPI) { if (wr == 0) PG8_BAR; }
    PG8_BAR;
#undef PG8_SA
#undef PG8_SB
#undef PG8_STAGE
#undef PG8_LDA
#undef PG8_LDB
#undef PG8_MMA
#undef PG8_WAIT_V
#undef PG8_WAIT_L
#undef PG8_BAR
#undef PG8_SCHED
}
}


#define LDS_BARRIER() do { asm volatile("s_waitcnt lgkmcnt(0)" ::: "memory"); __builtin_amdgcn_s_barrier(); asm volatile("" ::: "memory"); } while (0)
namespace ml {
#define LAS __attribute__((address_space(3)))
typedef short bf16x8 __attribute__((ext_vector_type(8)));
typedef float f32x4 __attribute__((ext_vector_type(4)));
typedef unsigned u32x4 __attribute__((ext_vector_type(4)));
constexpr int NVB = 4, EV = MD / NVB;
constexpr int PQ = 272, PT = 144;
constexpr int L_QS = 0, L_KS = L_QS + 64 * PQ, L_KT = L_KS + 64 * PQ, L_VT = L_KT + 128 * PT, L_SB = L_VT + 48 * PT, L_CT = L_SB + 64 * PT,
              L_HS = L_CT + 48 * PQ, L_SC = L_HS + 64 * 80, L_END = L_SC + 4096;
static_assert(L_END <= 131072, "mLSTM LDS map");
enum { SC_A = 0, SC_PM = 64, SC_WI = 128, SC_EMT = 192, SC_WE = 256, SC_DEN = 320, SC_MISC = 384 };
__device__ __forceinline__ f32x4 mma(bf16x8 a, bf16x8 b, f32x4 c) { return __builtin_amdgcn_mfma_f32_16x16x32_bf16(a, b, c, 0, 0, 0); }
__device__ __forceinline__ bf16x8 frag(LAS unsigned char* lds, int base, int pitch, int row0, int k0, int lane) {
    return *(const LAS bf16x8*)(lds + base + (row0 + (lane & 15)) * pitch + (k0 + 8 * (lane >> 4)) * 2);
}
__device__ __forceinline__ void mlstm_item(LAS unsigned char* lds, CParams& P, int l, int s, int head, int dir, int vb) {
    const int tid = threadIdx.x, w = __builtin_amdgcn_readfirstlane(tid >> 6), lane = tid & 63, fr = lane & 15, fq = lane >> 4;
    const int rt = w & 3, half = w >> 2;
    const SeqInfo q = seqinfo(s); const int nchunk = q.T / 64;
    const bf16* QK = WSP(bf16, WS_QKC); bf16* U = WSP(bf16, WS_U1);
    LAS float* SC = (LAS float*)(lds + L_SC);
    f32x4 cacc[3];
    float m_prev;
    if (!q.grid) { cacc[0] = cacc[1] = cacc[2] = (f32x4){0.f, 0.f, 0.f, 0.f}; m_prev = 0.f; }
    else {
        const size_t sb = (((size_t)q.b * DEPTH + l) * 2 + dir) * MH + head; const int d = 16 * w + fr;
#pragma unroll
        for (int et = 0; et < 2; ++et)
#pragma unroll
            for (int r = 0; r < 4; ++r) cacc[et][r] = P.in[ST_C][(sb * 128 + d) * 128 + vb * EV + 16 * et + 4 * fq + r];
        cacc[2] = (f32x4){0.f, 0.f, 0.f, 0.f}; if (fq == 0) cacc[2][0] = P.in[ST_N][sb * 128 + d];
        m_prev = P.in[ST_M][sb];
    }
    const float bi = P.in[M_GATE_B][(size_t)l * 4 * MH + (2 * dir) * MH + head], bfg = P.in[M_GATE_B][(size_t)l * 4 * MH + (2 * dir + 1) * MH + head];
    for (int i = tid; i < 16 * 64; i += 512) { const int r = i >> 6, c = i & 63; *(LAS bf16*)(lds + L_VT + (32 + r) * PT + c * 2) = (r == 0) ? (bf16)0x3f80 : (bf16)0; }
    u32x4 pqk[4]; u32x4 pv; bf16 pgi = 0, pgf = 0;
#define ML_TOK(c, j) ((size_t)(q.base + (dir ? q.T - 1 - ((c) * 64 + (j)) : ((c) * 64 + (j)))))
#define ML_PREFETCH(c) do { _Pragma("unroll") for (int i = 0; i < 4; ++i) { const int id = tid + 512 * i, j = id >> 5, pc = id & 31; \
            pqk[i] = *(const u32x4*)(QK + ML_TOK(c, j) * (2 * MW) + (pc < 16 ? head * 128 + 8 * pc : MW + head * 128 + 8 * (pc - 16))); } \
        if (tid < 256) { const int j = tid >> 2, pc = tid & 3; pv = *(const u32x4*)(U + ML_TOK(c, j) * PU + OFF_V + head * 128 + vb * EV + 8 * pc); } \
        if (w == 0) { const bf16* g = U + ML_TOK(c, lane) * PU + OFF_G; pgi = g[(2 * dir) * MH + head]; pgf = g[(2 * dir + 1) * MH + head]; } } while (0)
    ML_PREFETCH(0);
    for (int c = 0; c < nchunk; ++c) {
#pragma unroll
        for (int i = 0; i < 4; ++i) { const int id = tid + 512 * i, j = id >> 5, pc = id & 31;
            *(LAS u32x4*)(lds + (pc < 16 ? L_QS : L_KS) + j * PQ + (pc & 15) * 16) = pqk[i]; }
        if (tid < 256) { const int j = tid >> 2, pc = tid & 3; const unsigned wv[4] = {pv.x, pv.y, pv.z, pv.w};
#pragma unroll
            for (int e = 0; e < 8; ++e) *(LAS bf16*)(lds + L_VT + (8 * pc + e) * PT + j * 2) = (bf16)((wv[e >> 1] >> ((e & 1) * 16)) & 0xffffu); }
#pragma unroll
        for (int et = 0; et < 3; ++et)
#pragma unroll
            for (int r = 0; r < 4; ++r) *(LAS bf16*)(lds + L_CT + (16 * et + 4 * fq + r) * PQ + (16 * w + fr) * 2) = f2bf(cacc[et][r]);
        float wie = 1.f;
        if (w == 0) {
            const float gi = bf2f(pgi) + bi, gf = bf2f(pgf) + bfg;
            const float lf = fminf(gf, 0.f) - log1pf(__expf(-fabsf(gf)));
            float b = lf;
#pragma unroll
            for (int o = 1; o < 64; o <<= 1) { const float t = __shfl_up(b, o); if (lane >= o) b += t; }
            const float a = gi - b; float pm = a;
#pragma unroll
            for (int o = 1; o < 64; o <<= 1) { const float t = __shfl_up(pm, o); if (lane >= o) pm = fmaxf(pm, t); }
            pm = fmaxf(pm, m_prev);
            const float pm63 = __shfl(pm, 63), b63 = __shfl(b, 63);
            SC[SC_A + lane] = a; SC[SC_PM + lane] = pm; SC[SC_WI + lane] = __expf(m_prev - pm); SC[SC_EMT + lane] = __expf(-(b + pm)); SC[SC_WE + lane] = __expf(a - pm63);
            if (lane == 0) { SC[SC_MISC] = __expf(m_prev - pm63); SC[SC_MISC + 1] = b63 + pm63; }
        }
        LDS_BARRIER();
        if (c + 1 < nchunk) ML_PREFETCH(c + 1);
        wie = SC[SC_MISC]; m_prev = SC[SC_MISC + 1];
#pragma unroll
        for (int i = 0; i < 2; ++i) { const int id = tid + 512 * i, j = id & 63, pc = id >> 6; const float we = SC[SC_WE + j];
            const u32x4 kv = *(const LAS u32x4*)(lds + L_KS + j * PQ + pc * 16); const unsigned wv[4] = {kv.x, kv.y, kv.z, kv.w};
#pragma unroll
            for (int e = 0; e < 8; ++e) { const float kf = __builtin_bit_cast(float, (e & 1) ? (wv[e >> 1] & 0xffff0000u) : (wv[e >> 1] << 16));
                *(LAS bf16*)(lds + L_KT + (8 * pc + e) * PT + j * 2) = f2bf(kf * we); } }
#pragma unroll
        for (int cc = 0; cc < 2; ++cc) { const int ct = 2 * half + cc;
            f32x4 acc = (f32x4){0.f, 0.f, 0.f, 0.f};
            if (ct <= rt) {
#pragma unroll
                for (int k = 0; k < 4; ++k) acc = mma(frag(lds, L_QS, PQ, 16 * rt, 32 * k, lane), frag(lds, L_KS, PQ, 16 * ct, 32 * k, lane), acc);
            }
            const int sp = 16 * ct + fr; const float as = SC[SC_A + sp];
#pragma unroll
            for (int r = 0; r < 4; ++r) { const int t = 16 * rt + 4 * fq + r; const float v = (sp <= t) ? acc[r] * __expf(as - SC[SC_PM + t]) : 0.f;
                *(LAS bf16*)(lds + L_SB + t * PT + sp * 2) = f2bf(v); } }
        LDS_BARRIER();
        f32x4 nacc[2]; const int nct = half ? 1 : 2;
#pragma unroll
        for (int cc = 0; cc < 2; ++cc) { if (cc < nct) { const int ct = half ? 2 : cc;
            f32x4 a1 = (f32x4){0.f, 0.f, 0.f, 0.f}, a2 = (f32x4){0.f, 0.f, 0.f, 0.f};
#pragma unroll
            for (int k = 0; k < 2; ++k) a1 = mma(frag(lds, L_SB, PT, 16 * rt, 32 * k, lane), frag(lds, L_VT, PT, 16 * ct, 32 * k, lane), a1);
#pragma unroll
            for (int k = 0; k < 4; ++k) a2 = mma(frag(lds, L_QS, PQ, 16 * rt, 32 * k, lane), frag(lds, L_CT, PQ, 16 * ct, 32 * k, lane), a2);
#pragma unroll
            for (int r = 0; r < 4; ++r) a1[r] += SC[SC_WI + 16 * rt + 4 * fq + r] * a2[r];
            nacc[cc] = a1; } }
        if (half && fr == 0) {
#pragma unroll
            for (int r = 0; r < 4; ++r) SC[SC_DEN + 16 * rt + 4 * fq + r] = nacc[0][r];
        }
#pragma unroll
        for (int et = 0; et < 3; ++et) { cacc[et] = cacc[et] * wie;
#pragma unroll
            for (int k = 0; k < 2; ++k) cacc[et] = mma(frag(lds, L_VT, PT, 16 * et, 32 * k, lane), frag(lds, L_KT, PT, 16 * w, 32 * k, lane), cacc[et]); }
        LDS_BARRIER();
        if (!half) {
#pragma unroll
            for (int cc = 0; cc < 2; ++cc)
#pragma unroll
                for (int r = 0; r < 4; ++r) { const int t = 16 * rt + 4 * fq + r; const float den = fmaxf(fabsf(SC[SC_DEN + t]), SC[SC_EMT + t]);
                    *(LAS bf16*)(lds + L_HS + t * 80 + (16 * cc + fr) * 2) = f2bf(nacc[cc][r] * __builtin_amdgcn_rcpf(den)); }
        }
        LDS_BARRIER();
        if (tid < 256) { const int j = tid >> 2, pc = tid & 3;
            *(u32x4*)(U + ML_TOK(c, j) * PU + dir * MW + head * 128 + vb * EV + 8 * pc) = *(const LAS u32x4*)(lds + L_HS + j * 80 + pc * 16); }
    }
    if (!q.grid) {
        const size_t sb = (((size_t)q.b * DEPTH + l) * 2 + dir) * MH + head; const int d = 16 * w + fr;
#pragma unroll
        for (int et = 0; et < 2; ++et)
#pragma unroll
            for (int r = 0; r < 4; ++r) P.out[OUT_C + (sb * 128 + d) * 128 + vb * EV + 16 * et + 4 * fq + r] = cacc[et][r];
        if (vb == 0) { if (fq == 0) P.out[OUT_N + sb * 128 + d] = cacc[2][0]; if (tid == 0) P.out[OUT_M + sb] = m_prev; }
    }
    LDS_BARRIER();
#undef ML_TOK
#undef ML_PREFETCH
}
constexpr int N_ITEMS = NSEQ * MH * 2 * NVB;
__device__ __forceinline__ void decode_item(int it, int& s, int& head, int& dir, int& vb) {
    vb = it % NVB; int ch = it / NVB; dir = ch & 1; ch >>= 1; head = ch % MH; const int sq = ch / MH;
    s = sq < LB ? CB + sq : sq - LB;
}
}


namespace rw {
typedef short bf16x8 __attribute__((ext_vector_type(8)));
typedef float f32x4 __attribute__((ext_vector_type(4)));
typedef unsigned u32x4 __attribute__((ext_vector_type(4)));
enum { V_A = 0, V_W, V_B, V_K, V_R, NVEC };
constexpr int REC = NVEC * 64 * 4;
constexpr int PT = 144;
constexpr int L_SBUF = 0, L_VT = L_SBUF + 64 * REC, L_TW = L_VT + 64 * 256, L_AL = L_TW + 64 * PT, L_YS = L_AL + 64 * PT, L_INV = L_YS + 64 * 16 * 4, L_END = L_INV + 256;
__device__ __forceinline__ int vt_off(int row, int tt) { return row * 256 + ((tt ^ (((row >> 3) & 7) << 2)) << 2); }
static_assert(L_END <= 131072, "RWKV LDS map");
__device__ __forceinline__ float dpp_xor1(float x) { return __builtin_bit_cast(float, __builtin_amdgcn_update_dpp(0, __builtin_bit_cast(int, x), 0xB1, 0xF, 0xF, true)); }
__device__ __forceinline__ float dpp_xor2(float x) { return __builtin_bit_cast(float, __builtin_amdgcn_update_dpp(0, __builtin_bit_cast(int, x), 0x4E, 0xF, 0xF, true)); }
__device__ __forceinline__ float dpp_ror4(float x) { return __builtin_bit_cast(float, __builtin_amdgcn_update_dpp(0, __builtin_bit_cast(int, x), 0x124, 0xF, 0xF, true)); }
__device__ __forceinline__ float dpp_ror8(float x) { return __builtin_bit_cast(float, __builtin_amdgcn_update_dpp(0, __builtin_bit_cast(int, x), 0x128, 0xF, 0xF, true)); }
__device__ __forceinline__ float allsum16(float x) { x += dpp_xor1(x); x += dpp_xor2(x); x += dpp_ror4(x); x += dpp_ror8(x); return x; }
__device__ __forceinline__ f32x4 cvt_lo4(unsigned a, unsigned b) { return (f32x4){__builtin_bit_cast(float, a << 16), __builtin_bit_cast(float, a & 0xffff0000u), __builtin_bit_cast(float, b << 16), __builtin_bit_cast(float, b & 0xffff0000u)}; }
__device__ __forceinline__ float allsum32(float x) {
    x = allsum16(x);
    float xa = x, xb = x;
    asm volatile("v_mov_b32 %1, %0\n\ts_nop 1\n\tv_permlane32_swap_b32 %0, %1\n\ts_nop 1" : "+v"(xa), "=&v"(xb));
    return xa + xb;
}
__device__ __forceinline__ void rwkv_item(LAS unsigned char* lds, CParams& P, int l, int s, int head, int dir, int rh) {
    const int tid = threadIdx.x, w = __builtin_amdgcn_readfirstlane(tid >> 6), lane = tid & 63, fr = lane & 15, fq = lane >> 4;
    const int rt = w & 3, half = w >> 2, hc = head * 64;
    const SeqInfo q = seqinfo(s); const int nchunk = q.T / 64;
    const bf16* RX = WSP(bf16, WS_RXC); bf16* U = WSP(bf16, WS_U1);
    const int pj = tid >> 3, psub = tid & 7;
    const int hh = lane >> 5, rsel = (lane >> 4) & 1, cg = lane & 15;
    const int row = 16 * rh + 2 * w + rsel, col0 = 32 * hh + 2 * cg;
    typedef float f32x2 __attribute__((ext_vector_type(2)));
    f32x2 S2;
    if (!q.grid) S2 = (f32x2){0.f, 0.f};
    else { const size_t sb = (((size_t)q.b * DEPTH + l) * 2 + dir) * RH + head; S2 = *(const f32x2*)(P.in[ST_R] + (sb * 64 + row) * 64 + col0); }
    float rkk8[8];
#pragma unroll
    for (int e = 0; e < 8; ++e) rkk8[e] = P.in[R_KK][(size_t)l * RW + hc + 8 * psub + e];
    float c_w0[2], c_a0[2], c_kk[2], c_ka[2];
    bf16x8 bw[2][2], ba[2][2];
#pragma unroll
    for (int cc = 0; cc < 2; ++cc) { const int c = 16 * (2 * half + cc) + fr;
        c_w0[cc] = P.in[R_W0][((size_t)l * 2 + dir) * RW + hc + c]; c_a0[cc] = P.in[R_A0][((size_t)l * 2 + dir) * RW + hc + c];
        c_kk[cc] = P.in[R_KK][(size_t)l * RW + hc + c]; c_ka[cc] = P.in[R_KA][(size_t)l * RW + hc + c];
#pragma unroll
        for (int ks = 0; ks < 2; ++ks)
#pragma unroll
            for (int e = 0; e < 8; ++e) { const int j = 32 * ks + 8 * fq + e;
                bw[cc][ks][e] = (short)f2bf(P.in[R_W2][(((size_t)l * 2 + dir) * 64 + j) * RW + hc + c]);
                ba[cc][ks][e] = (short)f2bf(P.in[R_A2][(((size_t)l * 2 + dir) * 64 + j) * RW + hc + c]); } }
    u32x4 pf[5];
#define RW_TOK(c, j) ((size_t)(q.base + (dir ? q.T - 1 - ((c) * 64 + (j)) : ((c) * 64 + (j)))))
#define RW_PREFETCH(c) do { const bf16* rx = RX + RW_TOK(c, pj) * RIN + 8 * psub; \
        pf[0] = *(const u32x4*)(rx + RX_R + hc); pf[1] = *(const u32x4*)(rx + RX_K + hc); pf[2] = *(const u32x4*)(rx + RX_V + hc); \
        pf[3] = *(const u32x4*)(rx + RX_WL + dir * 64); pf[4] = *(const u32x4*)(rx + RX_AL + dir * 64); } while (0)
    RW_PREFETCH(0);
    for (int c = 0; c < nchunk; ++c) {
        { LAS unsigned char* rec = lds + L_SBUF + pj * REC + psub * 32;
          *(LAS f32x4*)(rec + V_R * 256) = cvt_lo4(pf[0].x, pf[0].y); *(LAS f32x4*)(rec + V_R * 256 + 16) = cvt_lo4(pf[0].z, pf[0].w);
          { const f32x4 v0 = cvt_lo4(pf[2].x, pf[2].y), v1 = cvt_lo4(pf[2].z, pf[2].w);
#pragma unroll
            for (int e = 0; e < 4; ++e) { *(LAS float*)(lds + L_VT + vt_off(8 * psub + e, pj)) = v0[e]; *(LAS float*)(lds + L_VT + vt_off(8 * psub + 4 + e, pj)) = v1[e]; } }
          const f32x4 k0 = cvt_lo4(pf[1].x, pf[1].y), k1 = cvt_lo4(pf[1].z, pf[1].w);
          *(LAS f32x4*)(rec + V_K * 256) = k0; *(LAS f32x4*)(rec + V_K * 256 + 16) = k1;
          float ss = 0.f;
#pragma unroll
          for (int e = 0; e < 4; ++e) { const float x0 = k0[e] * rkk8[e], x1 = k1[e] * rkk8[4 + e]; ss += x0 * x0 + x1 * x1; }
          ss += dpp_xor1(ss); ss += dpp_xor2(ss); ss += __shfl_xor(ss, 4);
          if (psub == 0) *(LAS float*)(lds + L_INV + pj * 4) = 1.0f / fmaxf(sqrtf(ss), 1e-12f);
          *(LAS u32x4*)(lds + L_TW + pj * PT + psub * 16) = pf[3]; *(LAS u32x4*)(lds + L_AL + pj * PT + psub * 16) = pf[4]; }
        __syncthreads();
        if (c + 1 < nchunk) RW_PREFETCH(c + 1);
#pragma unroll
        for (int cc = 0; cc < 2; ++cc) { const int ct = 2 * half + cc; const int cidx = 16 * ct + fr;
            f32x4 aw = (f32x4){0.f, 0.f, 0.f, 0.f}, aa = (f32x4){0.f, 0.f, 0.f, 0.f};
#pragma unroll
            for (int ks = 0; ks < 2; ++ks) { aw = ml::mma(ml::frag(lds, L_TW, PT, 16 * rt, 32 * ks, lane), bw[cc][ks], aw); aa = ml::mma(ml::frag(lds, L_AL, PT, 16 * rt, 32 * ks, lane), ba[cc][ks], aa); }
#pragma unroll
            for (int r = 0; r < 4; ++r) { const int tok = 16 * rt + 4 * fq + r; LAS float* rec = (LAS float*)(lds + L_SBUF + tok * REC) + cidx;
                const float decay = __expf(-0.6065306597126334f * pg8::fsigmoid(c_w0[cc] + aw[r])); const float alpha = pg8::fsigmoid(c_a0[cc] + aa[r]);
                const float kraw = rec[V_K * 64]; const float kkn = kraw * c_kk[cc] * *(LAS float*)(lds + L_INV + tok * 4);
                rec[V_A * 64] = -kkn; rec[V_W * 64] = decay; rec[V_B * 64] = kkn * alpha; rec[V_K * 64] = kraw * (1.0f + (alpha - 1.0f) * c_ka[cc]); } }
        __syncthreads();
        {
            const LAS unsigned char* rbase = lds + L_SBUF + col0 * 4;
            f32x2 ca = *(const LAS f32x2*)(rbase + V_A * 256), cw = *(const LAS f32x2*)(rbase + V_W * 256), cb = *(const LAS f32x2*)(rbase + V_B * 256),
                  ck = *(const LAS f32x2*)(rbase + V_K * 256), cr = *(const LAS f32x2*)(rbase + V_R * 256);
#pragma unroll 1
            for (int blk = 0; blk < 4; ++blk) {
                float ykeep = 0.f;
#pragma unroll
                for (int g4 = 0; g4 < 4; ++g4) {
                    const f32x4 v4 = *(const LAS f32x4*)(lds + L_VT + vt_off(row, 16 * blk + 4 * g4));
#pragma unroll
                    for (int i4 = 0; i4 < 4; ++i4) {
                        const int i = 4 * g4 + i4, tt = 16 * blk + i, tn = tt < 63 ? tt + 1 : 63;
                        const LAS unsigned char* rn = rbase + tn * REC;
                        const f32x2 na = *(const LAS f32x2*)(rn + V_A * 256), nw = *(const LAS f32x2*)(rn + V_W * 256), nb = *(const LAS f32x2*)(rn + V_B * 256),
                                    nk = *(const LAS f32x2*)(rn + V_K * 256), nr = *(const LAS f32x2*)(rn + V_R * 256);
                        const float vv = v4[i4];
                        const f32x2 p = S2 * ca;
                        const float sa = allsum32(p.x + p.y);
                        S2 = S2 * cw + ck * vv;
                        S2 = cb * sa + S2;
                        const f32x2 yq = S2 * cr;
                        const float y = allsum32(yq.x + yq.y);
                        ykeep = (cg == i) ? y : ykeep;
                        ca = na; cw = nw; cb = nb; ck = nk; cr = nr;
                    }
                }
                if (hh == 0) *(LAS float*)(lds + L_YS + ((16 * blk + cg) * 16 + 2 * w + rsel) * 4) = ykeep;
            }
        }
        __syncthreads();
        if (tid < 128) { const int j = tid >> 1, pc = tid & 1; const LAS float* ys = (const LAS float*)(lds + L_YS) + j * 16 + 8 * pc;
            u32x4 o; o.x = pg8::cvt_pk_bf16(ys[0], ys[1]); o.y = pg8::cvt_pk_bf16(ys[2], ys[3]); o.z = pg8::cvt_pk_bf16(ys[4], ys[5]); o.w = pg8::cvt_pk_bf16(ys[6], ys[7]);
            *(u32x4*)(U + RW_TOK(c, j) * PU + OFF_R + dir * RW + hc + 16 * rh + 8 * pc) = o; }
    }
    if (!q.grid) { const size_t sb = (((size_t)q.b * DEPTH + l) * 2 + dir) * RH + head; *(f32x2*)(P.out + OUT_S + (sb * 64 + row) * 64 + col0) = S2; }
    __syncthreads();
#undef RW_TOK
#undef RW_PREFETCH
}
constexpr int N_ITEMS = NSEQ * RH * 2 * 4;
__device__ __forceinline__ void decode_item(int it, int& s, int& head, int& dir, int& rh) {
    rh = it & 3; int ch = it >> 2; dir = ch & 1; ch >>= 1; head = ch % RH; const int sq = ch / RH;
    s = sq < LB ? CB + sq : sq - LB;
}
}


namespace wy {
typedef short bf16x8 __attribute__((ext_vector_type(8)));
typedef float f32x4 __attribute__((ext_vector_type(4)));
typedef unsigned u32x4 __attribute__((ext_vector_type(4)));
constexpr int PV = 144, PS = 48;
constexpr int L_AH = 0, L_RH = L_AH + 64 * PV, L_BT = L_RH + 64 * PV, L_KT = L_BT + 64 * PV, L_VS = L_KT + 64 * PV, L_NAKT = L_VS + 64 * PV, L_NRKT = L_NAKT + 4 * 16 * PS,
              L_NRBT = L_NRKT + 4 * 16 * PS, L_TT = L_NRBT + 4 * 16 * PS, L_GL = L_TT + 4 * 16 * PS, PACK_BYTES = L_GL + 1024,
              L_BH = PACK_BYTES, L_KH = L_BH + 64 * PV, L_YS = L_KH + 64 * PV, L_TW = L_YS + 64 * PV, L_AL = L_TW + 64 * PV, L_NAB = L_AL + 64 * PV, L_INV = L_NAB + 4096, L_END = L_INV + 256;
constexpr int RING = 4, PACK_U = PACK_BYTES / 16, N_LAT = LB * RH * 2;
static_assert(PACK_BYTES % 16 == 0 && PACK_U <= 8 * 512 && (size_t)N_LAT * RING * PACK_BYTES <= (size_t)N1P * D * 2, "ring lives in the (dead during MX) w_in region");
static_assert(L_END <= 131072, "WY LDS map");
__device__ __forceinline__ bf16x8 fragk16(LAS unsigned char* lds, int base, int pitch, int row0, int k0, int lane) {
    const bf16x8 v = *(const LAS bf16x8*)(lds + base + (row0 + (lane & 15)) * pitch + (k0 + 8 * ((lane >> 4) & 1)) * 2);
    const bf16x8 z = {0, 0, 0, 0, 0, 0, 0, 0};
    return (lane < 32) ? v : z;
}
__device__ __forceinline__ void stb(LAS unsigned char* lds, int off, float v) { *(LAS bf16*)(lds + off) = f2bf(v); }
typedef unsigned u32x2 __attribute__((ext_vector_type(2)));
__device__ __forceinline__ bf16x8 pack_k16(const f32x4 v) { u32x4 o; o.x = pg8::cvt_pk_bf16(v[0], v[1]); o.y = pg8::cvt_pk_bf16(v[2], v[3]); o.z = 0u; o.w = 0u; return __builtin_bit_cast(bf16x8, o); }
__device__ __forceinline__ bf16x8 pack_k32(const f32x4 a, const f32x4 b) { u32x4 o; o.x = pg8::cvt_pk_bf16(a[0], a[1]); o.y = pg8::cvt_pk_bf16(a[2], a[3]); o.z = pg8::cvt_pk_bf16(b[0], b[1]); o.w = pg8::cvt_pk_bf16(b[2], b[3]);
    return __builtin_bit_cast(bf16x8, o); }
__device__ __forceinline__ bf16x8 ld_k16(LAS unsigned char* lds, int base, int pitch, int row0, int col0, int lane) {
    const u32x2 v = *(const LAS u32x2*)(lds + base + (row0 + (lane & 15)) * pitch + (col0 + 4 * (lane >> 4)) * 2); u32x4 o; o.x = v.x; o.y = v.y; o.z = 0u; o.w = 0u; return __builtin_bit_cast(bf16x8, o); }
__device__ __forceinline__ bf16x8 ld_k32(LAS unsigned char* lds, int base, int pitch, int row0, int col0, int lane) {
    const LAS unsigned char* p = lds + base + (row0 + (lane & 15)) * pitch + (col0 + 4 * (lane >> 4)) * 2;
    const u32x2 v0 = *(const LAS u32x2*)p, v1 = *(const LAS u32x2*)(p + 32); u32x4 o; o.x = v0.x; o.y = v0.y; o.z = v1.x; o.w = v1.y; return __builtin_bit_cast(bf16x8, o); }
__device__ __forceinline__ void rwkv_item(LAS unsigned char* lds, CParams& P, int l, int s, int head, int dir) {
    const int tid = threadIdx.x, w = __builtin_amdgcn_readfirstlane(tid >> 6), lane = tid & 63, fr = lane & 15, fq = lane >> 4;
    const int rt = w & 3, half = w >> 2, hc = head * 64;
    const SeqInfo q = seqinfo(s); const int nchunk = q.T / 64;
    const bf16* RX = WSP(bf16, WS_RXC); bf16* U = WSP(bf16, WS_U1);
    const int pj = tid >> 3, psub = tid & 7;
    f32x4 sacc[4];
#pragma unroll
    for (int ct = 0; ct < 4; ++ct) sacc[ct] = (f32x4){0.f, 0.f, 0.f, 0.f};
    if (w < 4 && q.grid) { const size_t sb = (((size_t)q.b * DEPTH + l) * 2 + dir) * RH + head;
#pragma unroll
        for (int ct = 0; ct < 4; ++ct) sacc[ct] = *(const f32x4*)(P.in[ST_R] + (sb * 64 + 16 * w + fr) * 64 + 16 * ct + 4 * fq); }
    float rkk8[8];
#pragma unroll
    for (int e = 0; e < 8; ++e) rkk8[e] = P.in[R_KK][(size_t)l * RW + hc + 8 * psub + e];
    float c_w0[2], c_a0[2], c_kk[2], c_ka[2];
#pragma unroll
    for (int cc = 0; cc < 2; ++cc) { const int c = 16 * (2 * half + cc) + fr;
        c_w0[cc] = P.in[R_W0][((size_t)l * 2 + dir) * RW + hc + c]; c_a0[cc] = P.in[R_A0][((size_t)l * 2 + dir) * RW + hc + c];
        c_kk[cc] = P.in[R_KK][(size_t)l * RW + hc + c]; c_ka[cc] = P.in[R_KA][(size_t)l * RW + hc + c]; }
    const bf16* w2t = WSP(bf16, O_W2T) + ((size_t)dir * RW + hc) * 64; const bf16* a2t = WSP(bf16, O_A2T) + ((size_t)dir * RW + hc) * 64;
    u32x4 pf[5];
#define WY_TOK(c, j) ((size_t)(q.base + (dir ? q.T - 1 - ((c) * 64 + (j)) : ((c) * 64 + (j)))))
#define WY_PREFETCH(c) do { const bf16* rx = RX + WY_TOK(c, pj) * RIN + 8 * psub; \
        pf[0] = *(const u32x4*)(rx + RX_R + hc); pf[1] = *(const u32x4*)(rx + RX_K + hc); pf[2] = *(const u32x4*)(rx + RX_V + hc); \
        pf[3] = *(const u32x4*)(rx + RX_WL + dir * 64); pf[4] = *(const u32x4*)(rx + RX_AL + dir * 64); } while (0)
    WY_PREFETCH(0);
    for (int c = 0; c < nchunk; ++c) {
        { *(LAS u32x4*)(lds + L_RH + pj * PV + psub * 16) = pf[0]; *(LAS u32x4*)(lds + L_KH + pj * PV + psub * 16) = pf[1];
          const unsigned kw[4] = {pf[1].x, pf[1].y, pf[1].z, pf[1].w}, vw[4] = {pf[2].x, pf[2].y, pf[2].z, pf[2].w};
          float ss = 0.f;
#pragma unroll
          for (int e = 0; e < 8; ++e) { const float kf = __builtin_bit_cast(float, (e & 1) ? (kw[e >> 1] & 0xffff0000u) : (kw[e >> 1] << 16)) * rkk8[e]; ss += kf * kf;
              *(LAS bf16*)(lds + L_VS + (8 * psub + e) * PV + pj * 2) = (bf16)((vw[e >> 1] >> ((e & 1) * 16)) & 0xffffu); }
          ss += rw::dpp_xor1(ss); ss += rw::dpp_xor2(ss); ss += __shfl_xor(ss, 4);
          if (psub == 0) *(LAS float*)(lds + L_INV + pj * 4) = 1.0f / fmaxf(sqrtf(ss), 1e-12f);
          *(LAS u32x4*)(lds + L_TW + pj * PV + psub * 16) = pf[3]; *(LAS u32x4*)(lds + L_AL + pj * PV + psub * 16) = pf[4]; }
        LDS_BARRIER();
        if (c + 1 < nchunk) WY_PREFETCH(c + 1);
#pragma unroll
        for (int cc = 0; cc < 2; ++cc) { const int ct = 2 * half + cc; const int cidx = 16 * ct + fr;
            f32x4 aw = (f32x4){0.f, 0.f, 0.f, 0.f}, aa = (f32x4){0.f, 0.f, 0.f, 0.f};
#pragma unroll
            for (int ks = 0; ks < 2; ++ks) { const size_t bo = (size_t)cidx * 64 + 32 * ks + 8 * fq;
                aw = ml::mma(ml::frag(lds, L_TW, PV, 16 * rt, 32 * ks, lane), *(const bf16x8*)(w2t + bo), aw); aa = ml::mma(ml::frag(lds, L_AL, PV, 16 * rt, 32 * ks, lane), *(const bf16x8*)(a2t + bo), aa); }
            float kr4[4], rr4[4], iv4[4];
#pragma unroll
            for (int r = 0; r < 4; ++r) { const int tok = 16 * rt + 4 * fq + r; kr4[r] = bf2f(*(const LAS bf16*)(lds + L_KH + tok * PV + cidx * 2)); rr4[r] = bf2f(*(const LAS bf16*)(lds + L_RH + tok * PV + cidx * 2));
                iv4[r] = *(const LAS float*)(lds + L_INV + tok * 4); }
            float lw[4], cum[4];
#pragma unroll
            for (int r = 0; r < 4; ++r) { lw[r] = -0.6065306597126334f * pg8::fsigmoid(c_w0[cc] + aw[r]); cum[r] = (r ? cum[r - 1] : 0.f) + lw[r]; }
            const float tot = cum[3]; const float p1 = __shfl_up(tot, 16), p2 = __shfl_up(tot, 32), p3 = __shfl_up(tot, 48);
            const float off = (fq >= 1 ? p1 : 0.f) + (fq >= 2 ? p2 : 0.f) + (fq >= 3 ? p3 : 0.f);
            float gprev = __expf(off);
#pragma unroll
            for (int r = 0; r < 4; ++r) { const int tok = 16 * rt + 4 * fq + r; const float lam = off + cum[r]; const float g = __expf(lam), gi = __builtin_amdgcn_rcpf(g);
                const float alpha = pg8::fsigmoid(c_a0[cc] + aa[r]);
                const float kraw = kr4[r], rraw = rr4[r];
                const float kkn = kraw * c_kk[cc] * iv4[r];
                const bf16 bh = f2bf(kkn * alpha * gi), kh = f2bf(kraw * (1.0f + (alpha - 1.0f) * c_ka[cc]) * gi);
                stb(lds, L_AH + tok * PV + cidx * 2, -kkn * gprev); stb(lds, L_RH + tok * PV + cidx * 2, rraw * g);
                *(LAS bf16*)(lds + L_BH + tok * PV + cidx * 2) = bh; *(LAS bf16*)(lds + L_KH + tok * PV + cidx * 2) = kh;
                *(LAS bf16*)(lds + L_BT + cidx * PV + tok * 2) = bh; *(LAS bf16*)(lds + L_KT + cidx * PV + tok * 2) = kh;
                if (fq == 3 && r == 3) *(LAS float*)(lds + L_GL + (rt * 64 + cidx) * 4) = g;
                gprev = g; } }
        LDS_BARRIER();
        { const int sc = w >> 1, side = w & 1; f32x4 gB = (f32x4){0.f, 0.f, 0.f, 0.f}, gK = (f32x4){0.f, 0.f, 0.f, 0.f};
#pragma unroll
          for (int ks = 0; ks < 2; ++ks) { const bf16x8 af = ml::frag(lds, side ? L_RH : L_AH, PV, 16 * sc, 32 * ks, lane);
              gB = ml::mma(af, ml::frag(lds, L_BH, PV, 16 * sc, 32 * ks, lane), gB); gK = ml::mma(af, ml::frag(lds, L_KH, PV, 16 * sc, 32 * ks, lane), gK); }
#pragma unroll
          for (int r = 0; r < 4; ++r) { const int t = 4 * fq + r; const bool keep = side ? (fr <= t) : (fr < t); const float vB = keep ? gB[r] : 0.f, vK = keep ? gK[r] : 0.f;
              if (side == 0) { *(LAS float*)(lds + L_NAB + ((sc * 16 + t) * 16 + fr) * 4) = vB; stb(lds, L_NAKT + (sc * 16 + t) * PS + fr * 2, vK); }
              else { stb(lds, L_NRBT + (sc * 16 + t) * PS + fr * 2, vB); stb(lds, L_NRKT + (sc * 16 + t) * PS + fr * 2, vK); } } }
        if ((w & 1) == 0 && lane < 16) { const int sc = w >> 1; float Tr[16];
            asm volatile("" ::: "memory");
#pragma unroll
            for (int ph = 0; ph < 4; ++ph) { f32x4 nv[4][4];
#pragma unroll
                for (int tq = 0; tq < 4; ++tq)
#pragma unroll
                    for (int u4 = 0; u4 <= ph; ++u4) nv[tq][u4] = *(const LAS f32x4*)(lds + L_NAB + ((sc * 16 + 4 * ph + tq) * 16 + 4 * u4) * 4);
#pragma unroll
                for (int tq = 0; tq < 4; ++tq) { const int t = 4 * ph + tq; float x0 = (lane == t) ? 1.f : 0.f, x1 = 0.f;
#pragma unroll
                    for (int u = 0; u < 16; ++u) if (u < t) { if (u & 1) x1 += Tr[u] * nv[tq][u >> 2][u & 3]; else x0 += Tr[u] * nv[tq][u >> 2][u & 3]; }
                    Tr[t] = x0 + x1; stb(lds, L_TT + (sc * 16 + t) * PS + lane * 2, Tr[t]); } } }
        LDS_BARRIER();
        if (w < 4) {
#pragma unroll 1
            for (int sc = 0; sc < 4; ++sc) {
                const bf16x8 ah0 = ld_k32(lds, L_AH, PV, 16 * sc, 0, lane), ah1 = ld_k32(lds, L_AH, PV, 16 * sc, 32, lane), rh0 = ld_k32(lds, L_RH, PV, 16 * sc, 0, lane), rh1 = ld_k32(lds, L_RH, PV, 16 * sc, 32, lane);
                const bf16x8 nak = ld_k16(lds, L_NAKT, PS, 16 * sc, 0, lane), nrk = ld_k16(lds, L_NRKT, PS, 16 * sc, 0, lane), ttf = ld_k16(lds, L_TT, PS, 16 * sc, 0, lane), nrb = ld_k16(lds, L_NRBT, PS, 16 * sc, 0, lane);
                const bf16x8 vsf = ld_k16(lds, L_VS, PV, 16 * w, 16 * sc, lane);
                bf16x8 btf[4], ktf[4]; f32x4 glv[4];
#pragma unroll
                for (int ct = 0; ct < 4; ++ct) { btf[ct] = ld_k16(lds, L_BT, PV, 16 * ct, 16 * sc, lane); ktf[ct] = ld_k16(lds, L_KT, PV, 16 * ct, 16 * sc, lane);
                    glv[ct] = *(const LAS f32x4*)(lds + L_GL + (sc * 64 + 16 * ct + 4 * fq) * 4); }
                const bf16x8 sb0 = pack_k32(sacc[0], sacc[1]), sb1 = pack_k32(sacc[2], sacc[3]);
                f32x4 XT = (f32x4){0.f, 0.f, 0.f, 0.f}, YT = (f32x4){0.f, 0.f, 0.f, 0.f};
                XT = ml::mma(ah0, sb0, XT); XT = ml::mma(ah1, sb1, XT); XT = ml::mma(nak, vsf, XT);
                YT = ml::mma(rh0, sb0, YT); YT = ml::mma(rh1, sb1, YT); YT = ml::mma(nrk, vsf, YT);
                f32x4 UT = (f32x4){0.f, 0.f, 0.f, 0.f};
                UT = ml::mma(ttf, pack_k16(XT), UT);
                const bf16x8 ub = pack_k16(UT);
                YT = ml::mma(nrb, ub, YT);
#pragma unroll
                for (int r = 0; r < 4; ++r) stb(lds, L_YS + (16 * sc + 4 * fq + r) * PV + (16 * w + fr) * 2, YT[r]);
#pragma unroll
                for (int ct = 0; ct < 4; ++ct) { sacc[ct] = ml::mma(btf[ct], ub, sacc[ct]); sacc[ct] = ml::mma(ktf[ct], vsf, sacc[ct]); sacc[ct] = sacc[ct] * glv[ct]; }
            }
        }
        LDS_BARRIER();
        *(u32x4*)(U + WY_TOK(c, pj) * PU + OFF_R + dir * RW + hc + 8 * psub) = *(const LAS u32x4*)(lds + L_YS + pj * PV + psub * 16);
    }
    if (!q.grid && w < 4) { const size_t sb = (((size_t)q.b * DEPTH + l) * 2 + dir) * RH + head;
#pragma unroll
        for (int ct = 0; ct < 4; ++ct) *(f32x4*)(P.out + OUT_S + (sb * 64 + 16 * w + fr) * 64 + 16 * ct + 4 * fq) = sacc[ct]; }
    LDS_BARRIER();
#undef WY_TOK
#undef WY_PREFETCH
}
__device__ __forceinline__ int tid_opaque() { int t = threadIdx.x; asm volatile("" : "+v"(t)); return t; }
constexpr int CW_F = 16384, FL_STRIDE = 64, NPROD = 2;
static_assert(RING % NPROD == 0 && NPROD + 1 <= 4 && CW_F + DEPTH * N_LAT * 4 * FL_STRIDE <= 32768, "flag block");
constexpr unsigned FL_SPIN_CAP = 1u << 18;
__device__ __forceinline__ unsigned fl_ld(unsigned* p) { return __hip_atomic_load(p, __ATOMIC_RELAXED, __HIP_MEMORY_SCOPE_AGENT); }
__device__ __forceinline__ unsigned fl_wait_ge(unsigned* p, unsigned want, unsigned* tmo) {
    unsigned sp = 0, v;
    while ((v = fl_ld(p)) < want) { __builtin_amdgcn_s_sleep(1); if ((++sp & 255u) == 0u) { if (fl_ld(tmo)) break; if (sp > FL_SPIN_CAP) { atomicAdd(tmo, 1u); break; } } }
    return v;
}
__device__ __forceinline__ void rwkv_prod(LAS unsigned char* lds, CParams& P, int l, int s, int head, int dir, int chain, int pp, unsigned* ctl) {
    const int tid = tid_opaque(), w = __builtin_amdgcn_readfirstlane(tid >> 6), lane = tid & 63, fr = lane & 15, fq = lane >> 4;
    const int rt = w & 3, half = w >> 2, hc = head * 64;
    const SeqInfo q = seqinfo(s); const int nchunk = q.T / 64;
    const bf16* RX = WSP(bf16, WS_RXC);
    const int pj = tid >> 3, psub = tid & 7;
    unsigned char* ring = P.ws + O_WIN1 + (size_t)chain * RING * PACK_BYTES;
    unsigned* f_base = ctl + CW_F + (size_t)((l * N_LAT + chain) * 4) * FL_STRIDE; unsigned* f_ready = f_base + pp * FL_STRIDE; unsigned* f_ack = f_base + NPROD * FL_STRIDE; unsigned* tmo = ctl + 4096 + 128;
    float rkk8[8];
#pragma unroll
    for (int e = 0; e < 8; ++e) rkk8[e] = P.in[R_KK][(size_t)l * RW + hc + 8 * psub + e];
    float c_w0[2], c_a0[2], c_kk[2], c_ka[2];
#pragma unroll
    for (int cc = 0; cc < 2; ++cc) { const int c = 16 * (2 * half + cc) + fr;
        c_w0[cc] = P.in[R_W0][((size_t)l * 2 + dir) * RW + hc + c]; c_a0[cc] = P.in[R_A0][((size_t)l * 2 + dir) * RW + hc + c];
        c_kk[cc] = P.in[R_KK][(size_t)l * RW + hc + c]; c_ka[cc] = P.in[R_KA][(size_t)l * RW + hc + c]; }
    const bf16* w2t = WSP(bf16, O_W2T) + ((size_t)dir * RW + hc) * 64; const bf16* a2t = WSP(bf16, O_A2T) + ((size_t)dir * RW + hc) * 64;
    u32x4 pf[5];
#define WY_TOK(c, j) ((size_t)(q.base + (dir ? q.T - 1 - ((c) * 64 + (j)) : ((c) * 64 + (j)))))
#define WY_PREFETCH(c) do { const bf16* rx = RX + WY_TOK(c, pj) * RIN + 8 * psub; \
        pf[0] = *(const u32x4*)(rx + RX_R + hc); pf[1] = *(const u32x4*)(rx + RX_K + hc); pf[2] = *(const u32x4*)(rx + RX_V + hc); \
        pf[3] = *(const u32x4*)(rx + RX_WL + dir * 64); pf[4] = *(const u32x4*)(rx + RX_AL + dir * 64); } while (0)
    WY_PREFETCH(pp);
    asm volatile("" :: "v"(pf[0]), "v"(pf[1]), "v"(pf[2]), "v"(pf[3]), "v"(pf[4]) : "memory");
    unsigned acked = 0u;
    for (int c = pp; c < nchunk; c += NPROD) {
        { *(LAS u32x4*)(lds + L_RH + pj * PV + psub * 16) = pf[0]; *(LAS u32x4*)(lds + L_KH + pj * PV + psub * 16) = pf[1];
          const unsigned kw[4] = {pf[1].x, pf[1].y, pf[1].z, pf[1].w}, vw[4] = {pf[2].x, pf[2].y, pf[2].z, pf[2].w};
          float ss = 0.f;
#pragma unroll
          for (int e = 0; e < 8; ++e) { const float kf = __builtin_bit_cast(float, (e & 1) ? (kw[e >> 1] & 0xffff0000u) : (kw[e >> 1] << 16)) * rkk8[e]; ss += kf * kf;
              *(LAS bf16*)(lds + L_VS + (8 * psub + e) * PV + pj * 2) = (bf16)((vw[e >> 1] >> ((e & 1) * 16)) & 0xffffu); }
          ss += rw::dpp_xor1(ss); ss += rw::dpp_xor2(ss); ss += __shfl_xor(ss, 4);
          if (psub == 0) *(LAS float*)(lds + L_INV + pj * 4) = 1.0f / fmaxf(sqrtf(ss), 1e-12f);
          *(LAS u32x4*)(lds + L_TW + pj * PV + psub * 16) = pf[3]; *(LAS u32x4*)(lds + L_AL + pj * PV + psub * 16) = pf[4]; }
        LDS_BARRIER();
        if (c + NPROD < nchunk) WY_PREFETCH(c + NPROD);
#pragma unroll
        for (int cc = 0; cc < 2; ++cc) { const int ct = 2 * half + cc; const int cidx = 16 * ct + fr;
            f32x4 aw = (f32x4){0.f, 0.f, 0.f, 0.f}, aa = (f32x4){0.f, 0.f, 0.f, 0.f};
#pragma unroll
            for (int ks = 0; ks < 2; ++ks) { const size_t bo = (size_t)cidx * 64 + 32 * ks + 8 * fq;
                aw = ml::mma(ml::frag(lds, L_TW, PV, 16 * rt, 32 * ks, lane), *(const bf16x8*)(w2t + bo), aw); aa = ml::mma(ml::frag(lds, L_AL, PV, 16 * rt, 32 * ks, lane), *(const bf16x8*)(a2t + bo), aa); }
            float kr4[4], rr4[4], iv4[4];
#pragma unroll
            for (int r = 0; r < 4; ++r) { const int tok = 16 * rt + 4 * fq + r; kr4[r] = bf2f(*(const LAS bf16*)(lds + L_KH + tok * PV + cidx * 2)); rr4[r] = bf2f(*(const LAS bf16*)(lds + L_RH + tok * PV + cidx * 2));
                iv4[r] = *(const LAS float*)(lds + L_INV + tok * 4); }
            float lw[4], cum[4];
#pragma unroll
            for (int r = 0; r < 4; ++r) { lw[r] = -0.6065306597126334f * pg8::fsigmoid(c_w0[cc] + aw[r]); cum[r] = (r ? cum[r - 1] : 0.f) + lw[r]; }
            const float tot = cum[3]; const float p1 = __shfl_up(tot, 16), p2 = __shfl_up(tot, 32), p3 = __shfl_up(tot, 48);
            const float off = (fq >= 1 ? p1 : 0.f) + (fq >= 2 ? p2 : 0.f) + (fq >= 3 ? p3 : 0.f);
            float gprev = __expf(off);
#pragma unroll
            for (int r = 0; r < 4; ++r) { const int tok = 16 * rt + 4 * fq + r; const float lam = off + cum[r]; const float g = __expf(lam), gi = __builtin_amdgcn_rcpf(g);
                const float alpha = pg8::fsigmoid(c_a0[cc] + aa[r]);
                const float kraw = kr4[r], rraw = rr4[r];
                const float kkn = kraw * c_kk[cc] * iv4[r];
                const bf16 bh = f2bf(kkn * alpha * gi), kh = f2bf(kraw * (1.0f + (alpha - 1.0f) * c_ka[cc]) * gi);
                stb(lds, L_AH + tok * PV + cidx * 2, -kkn * gprev); stb(lds, L_RH + tok * PV + cidx * 2, rraw * g);
                *(LAS bf16*)(lds + L_BH + tok * PV + cidx * 2) = bh; *(LAS bf16*)(lds + L_KH + tok * PV + cidx * 2) = kh;
                *(LAS bf16*)(lds + L_BT + cidx * PV + tok * 2) = bh; *(LAS bf16*)(lds + L_KT + cidx * PV + tok * 2) = kh;
                if (fq == 3 && r == 3) *(LAS float*)(lds + L_GL + (rt * 64 + cidx) * 4) = g;
                gprev = g; } }
        asm volatile("s_waitcnt vmcnt(0)" ::: "memory");
        LDS_BARRIER();
        if (tid == 0 && c > pp) __hip_atomic_store(f_ready, (unsigned)((c - pp) / NPROD), __ATOMIC_RELAXED, __HIP_MEMORY_SCOPE_AGENT);
        { const int sc = w >> 1, side = w & 1; f32x4 gB = (f32x4){0.f, 0.f, 0.f, 0.f}, gK = (f32x4){0.f, 0.f, 0.f, 0.f};
#pragma unroll
          for (int ks = 0; ks < 2; ++ks) { const bf16x8 af = ml::frag(lds, side ? L_RH : L_AH, PV, 16 * sc, 32 * ks, lane);
              gB = ml::mma(af, ml::frag(lds, L_BH, PV, 16 * sc, 32 * ks, lane), gB); gK = ml::mma(af, ml::frag(lds, L_KH, PV, 16 * sc, 32 * ks, lane), gK); }
#pragma unroll
          for (int r = 0; r < 4; ++r) { const int t = 4 * fq + r; const bool keep = side ? (fr <= t) : (fr < t); const float vB = keep ? gB[r] : 0.f, vK = keep ? gK[r] : 0.f;
              if (side == 0) { *(LAS float*)(lds + L_NAB + ((sc * 16 + t) * 16 + fr) * 4) = vB; stb(lds, L_NAKT + (sc * 16 + t) * PS + fr * 2, vK); }
              else { stb(lds, L_NRBT + (sc * 16 + t) * PS + fr * 2, vB); stb(lds, L_NRKT + (sc * 16 + t) * PS + fr * 2, vK); } } }
        if ((w & 1) == 0 && lane < 16) { const int sc = w >> 1; float Tr[16];
            asm volatile("" ::: "memory");
#pragma unroll
            for (int ph = 0; ph < 4; ++ph) { f32x4 nv[4][4];
#pragma unroll
                for (int tq = 0; tq < 4; ++tq)
#pragma unroll
                    for (int u4 = 0; u4 <= ph; ++u4) nv[tq][u4] = *(const LAS f32x4*)(lds + L_NAB + ((sc * 16 + 4 * ph + tq) * 16 + 4 * u4) * 4);
#pragma unroll
                for (int tq = 0; tq < 4; ++tq) { const int t = 4 * ph + tq; float x0 = (lane == t) ? 1.f : 0.f, x1 = 0.f;
#pragma unroll
                    for (int u = 0; u < 16; ++u) if (u < t) { if (u & 1) x1 += Tr[u] * nv[tq][u >> 2][u & 3]; else x0 += Tr[u] * nv[tq][u >> 2][u & 3]; }
                    Tr[t] = x0 + x1; stb(lds, L_TT + (sc * 16 + t) * PS + lane * 2, Tr[t]); } } }
        if (tid == 0 && c >= RING && acked < (unsigned)(c - RING + 1)) acked = fl_wait_ge(f_ack, (unsigned)(c - RING + 1), tmo);
        LDS_BARRIER();
        asm volatile("" :: "v"(pf[0]), "v"(pf[1]), "v"(pf[2]), "v"(pf[3]), "v"(pf[4]) : "memory");
        { unsigned char* slot = ring + (size_t)(c % RING) * PACK_BYTES;
#pragma unroll
          for (int k = 0; k < 8; ++k) { const int u = tid + 512 * k;
              if (u < PACK_U) { const u32x4 v = *(const LAS u32x4*)(lds + 16 * u); const u32x4* gp = (const u32x4*)(slot + (size_t)16 * u);
                  asm volatile("global_store_dwordx4 %0, %1, off sc1" :: "v"(gp), "v"(v) : "memory"); } } }
        LDS_BARRIER();
    }
    asm volatile("s_waitcnt vmcnt(0)" ::: "memory");
    __syncthreads();
    if (tid == 0) __hip_atomic_store(f_ready, (unsigned)((nchunk - pp + NPROD - 1) / NPROD), __ATOMIC_RELAXED, __HIP_MEMORY_SCOPE_AGENT);
    LDS_BARRIER();
#undef WY_TOK
#undef WY_PREFETCH
}
__device__ __forceinline__ void rwkv_cons(LAS unsigned char* lds, CParams& P, int l, int s, int head, int dir, int chain, unsigned* ctl) {
    const int tid = tid_opaque(), w = __builtin_amdgcn_readfirstlane(tid >> 6), lane = tid & 63, fr = lane & 15, fq = lane >> 4;
    const int hc = head * 64;
    const SeqInfo q = seqinfo(s); const int nchunk = q.T / 64;
    bf16* U = WSP(bf16, WS_U1);
    const unsigned char* ring = P.ws + O_WIN1 + (size_t)chain * RING * PACK_BYTES;
    unsigned* f_base = ctl + CW_F + (size_t)((l * N_LAT + chain) * 4) * FL_STRIDE; unsigned* f_ack = f_base + NPROD * FL_STRIDE; unsigned* tmo = ctl + 4096 + 128;
    constexpr int C_YS = 2 * PACK_BYTES;
    static_assert(C_YS + 64 * PV <= 131072, "consumer LDS map");
    f32x4 sacc[4];
#pragma unroll
    for (int ct = 0; ct < 4; ++ct) sacc[ct] = (f32x4){0.f, 0.f, 0.f, 0.f};
    if (w < 4 && q.grid) { const size_t sb = (((size_t)q.b * DEPTH + l) * 2 + dir) * RH + head;
#pragma unroll
        for (int ct = 0; ct < 4; ++ct) sacc[ct] = *(const f32x4*)(P.in[ST_R] + (sb * 64 + 16 * w + fr) * 64 + 16 * ct + 4 * fq); }
#define WY_TOK(c, j) ((size_t)(q.base + (dir ? q.T - 1 - ((c) * 64 + (j)) : ((c) * 64 + (j)))))
    unsigned seen0 = 0u, seen1 = 0u;
#define CONS_FETCH(c, boff) do { const int p_ = (c) % NPROD; const unsigned need_ = (unsigned)((c) / NPROD + 1); \
        if ((p_ ? seen1 : seen0) < need_) { unsigned v_ = 0u; if (lane == 0) v_ = fl_wait_ge(f_base + p_ * FL_STRIDE, need_, tmo); v_ = __builtin_amdgcn_readfirstlane(v_); \
            if (p_) seen1 = v_; else seen0 = v_; __builtin_amdgcn_fence(__ATOMIC_ACQUIRE, "agent"); } \
        const unsigned char* slot = ring + (size_t)((c) % RING) * PACK_BYTES; \
        for (int k = w - 4; k < PACK_BYTES / 1024; k += 4) \
            __builtin_amdgcn_global_load_lds((const unsigned*)(slot + (size_t)k * 1024 + lane * 16), (LAS unsigned*)(lds + (boff) + k * 1024), 16, 0, 0); \
        asm volatile("s_waitcnt vmcnt(0)" ::: "memory"); } while (0)
    if (w >= 4) CONS_FETCH(0, 0);
    LDS_BARRIER();
    if (tid == 256) __hip_atomic_store(f_ack, 1u, __ATOMIC_RELAXED, __HIP_MEMORY_SCOPE_AGENT);
    for (int c = 0; c < nchunk; ++c) {
        const int boff = (c & 1) * PACK_BYTES;
        if (w >= 4) { if (c + 1 < nchunk) CONS_FETCH(c + 1, PACK_BYTES - boff); }
        else {
            LAS unsigned char* pb = lds + boff;
#pragma unroll 1
            for (int sc = 0; sc < 4; ++sc) {
                const bf16x8 ah0 = ld_k32(pb, L_AH, PV, 16 * sc, 0, lane), ah1 = ld_k32(pb, L_AH, PV, 16 * sc, 32, lane), rh0 = ld_k32(pb, L_RH, PV, 16 * sc, 0, lane), rh1 = ld_k32(pb, L_RH, PV, 16 * sc, 32, lane);
                const bf16x8 nak = ld_k16(pb, L_NAKT, PS, 16 * sc, 0, lane), nrk = ld_k16(pb, L_NRKT, PS, 16 * sc, 0, lane), ttf = ld_k16(pb, L_TT, PS, 16 * sc, 0, lane), nrb = ld_k16(pb, L_NRBT, PS, 16 * sc, 0, lane);
                const bf16x8 vsf = ld_k16(pb, L_VS, PV, 16 * w, 16 * sc, lane);
                bf16x8 btf[4], ktf[4]; f32x4 glv[4];
#pragma unroll
                for (int ct = 0; ct < 4; ++ct) { btf[ct] = ld_k16(pb, L_BT, PV, 16 * ct, 16 * sc, lane); ktf[ct] = ld_k16(pb, L_KT, PV, 16 * ct, 16 * sc, lane);
                    glv[ct] = *(const LAS f32x4*)(pb + L_GL + (sc * 64 + 16 * ct + 4 * fq) * 4); }
                const bf16x8 sb0 = pack_k32(sacc[0], sacc[1]), sb1 = pack_k32(sacc[2], sacc[3]);
                f32x4 XT = (f32x4){0.f, 0.f, 0.f, 0.f}, YT = (f32x4){0.f, 0.f, 0.f, 0.f};
                XT = ml::mma(ah0, sb0, XT); XT = ml::mma(ah1, sb1, XT); XT = ml::mma(nak, vsf, XT);
                YT = ml::mma(rh0, sb0, YT); YT = ml::mma(rh1, sb1, YT); YT = ml::mma(nrk, vsf, YT);
                f32x4 UT = (f32x4){0.f, 0.f, 0.f, 0.f};
                UT = ml::mma(ttf, pack_k16(XT), UT);
                const bf16x8 ub = pack_k16(UT);
                YT = ml::mma(nrb, ub, YT);
#pragma unroll
                for (int r = 0; r < 4; ++r) stb(lds, C_YS + (16 * sc + 4 * fq + r) * PV + (16 * w + fr) * 2, YT[r]);
#pragma unroll
                for (int ct = 0; ct < 4; ++ct) { sacc[ct] = ml::mma(btf[ct], ub, sacc[ct]); sacc[ct] = ml::mma(ktf[ct], vsf, sacc[ct]); sacc[ct] = sacc[ct] * glv[ct]; }
            }
            { const LAS unsigned char* yp = lds + C_YS + lane * PV + 32 * w; const u32x4 y0 = *(const LAS u32x4*)yp, y1 = *(const LAS u32x4*)(yp + 16);
              bf16* up = U + WY_TOK(c, lane) * PU + OFF_R + dir * RW + hc + 16 * w; *(u32x4*)up = y0; *(u32x4*)(up + 8) = y1; }
        }
        LDS_BARRIER();
        if (tid == 256 && c + 1 < nchunk) __hip_atomic_store(f_ack, (unsigned)(c + 2), __ATOMIC_RELAXED, __HIP_MEMORY_SCOPE_AGENT);
    }
    if (!q.grid && w < 4) { const size_t sb = (((size_t)q.b * DEPTH + l) * 2 + dir) * RH + head;
#pragma unroll
        for (int ct = 0; ct < 4; ++ct) *(f32x4*)(P.out + OUT_S + (sb * 64 + 16 * w + fr) * 64 + 16 * ct + 4 * fq) = sacc[ct]; }
    LDS_BARRIER();
#undef WY_TOK
#undef CONS_FETCH
}
constexpr int N_ITEMS = NSEQ * RH * 2;
__device__ __forceinline__ void decode_item(int it, int& s, int& head, int& dir) {
    dir = it & 1; int ch = it >> 1; head = ch % RH; const int sq = ch / RH;
    s = sq < LB ? CB + sq : sq - LB;
}
}

namespace ms {
using ml::PQ; using ml::PT; using ml::mma; using ml::frag; using wy::bf16x8; using wy::f32x4; using wy::u32x4;
constexpr int P_QS = 0, P_KT = P_QS + 64 * PQ, P_SB = P_KT + 128 * PT, P_SC = P_SB + 64 * PT, P_VT = P_SC + 4096, VT_BYTES = 21504, ML_PACK = P_VT + VT_BYTES, P_KS = ML_PACK, P_END = P_KS + 64 * PQ;
constexpr int ML_RING = 4, ML_PACK_U = ML_PACK / 16, N_MLAT = LB * MH * 2, CW_MF = 32768, MLPROD = 2;
static_assert(MLPROD == 2 && ML_RING % MLPROD == 0, "two producers per chain: even / odd chunks");
static_assert(ML_PACK % 1024 == 0 && ML_PACK_U <= 9 * 512 && 145 * PT <= VT_BYTES && P_END <= 131072 && 2 * ML_PACK <= 146432, "mLSTM pack layout");
static_assert(WS_END + (size_t)N_MLAT * ML_RING * ML_PACK <= ((size_t)256 << 20), "mLSTM ring fits behind the activations");
__device__ __forceinline__ void ml_prod(LAS unsigned char* lds, CParams& P, int l, int s, int head, int dir, int chain, int pp, unsigned* ctl) {
    const int tid = wy::tid_opaque(), w = __builtin_amdgcn_readfirstlane(tid >> 6), lane = tid & 63, fr = lane & 15, fq = lane >> 4;
    const int rt = w & 3, half = w >> 2;
    const SeqInfo q = seqinfo(s); const int nchunk = q.T / 64;
    const bf16* QK = WSP(bf16, WS_QKC); const bf16* U = WSP(bf16, WS_U1);
    LAS float* SC = (LAS float*)(lds + P_SC);
    unsigned char* ring = P.ws + WS_END + (size_t)chain * ML_RING * ML_PACK;
    unsigned* f_base = ctl + CW_MF + (size_t)((l * N_MLAT + chain) * 4) * wy::FL_STRIDE; unsigned* f_ready = f_base + pp * wy::FL_STRIDE; unsigned* f_ack = f_base + MLPROD * wy::FL_STRIDE; unsigned* tmo = ctl + 4096 + 128;
    float m_prev = 0.f;
    if (q.grid) m_prev = P.in[ST_M][(((size_t)q.b * DEPTH + l) * 2 + dir) * MH + head];
    const float bi = P.in[M_GATE_B][(size_t)l * 4 * MH + (2 * dir) * MH + head], bfg = P.in[M_GATE_B][(size_t)l * 4 * MH + (2 * dir + 1) * MH + head];
    for (int i = tid; i < (VT_BYTES - 128 * PT) / 2; i += 512) *(LAS bf16*)(lds + P_VT + 128 * PT + i * 2) = (i < 64) ? (bf16)0x3f80 : (bf16)0;
    u32x4 pqk[4]; u32x4 pv[2]; bf16 pgi = 0, pgf = 0, sgi = 0, sgf = 0;
#define ML_TOK(c, j) ((size_t)(q.base + (dir ? q.T - 1 - ((c) * 64 + (j)) : ((c) * 64 + (j)))))
#define ML_PREFETCH(c) do { _Pragma("unroll") for (int i = 0; i < 4; ++i) { const int id = tid + 512 * i, j = id >> 5, pc = id & 31; \
            pqk[i] = *(const u32x4*)(QK + ML_TOK(c, j) * (2 * MW) + (pc < 16 ? head * 128 + 8 * pc : MW + head * 128 + 8 * (pc - 16))); } \
        _Pragma("unroll") for (int i = 0; i < 2; ++i) { const int id = tid + 512 * i, j = id >> 4, pc = id & 15; pv[i] = *(const u32x4*)(U + ML_TOK(c, j) * PU + OFF_V + head * 128 + 8 * pc); } \
        if (w == 0) { const bf16* g = U + ML_TOK(c, lane) * PU + OFF_G; pgi = g[(2 * dir) * MH + head]; pgf = g[(2 * dir + 1) * MH + head]; \
            if ((c) >= 1) { const bf16* g2 = U + ML_TOK((c) - 1, lane) * PU + OFF_G; sgi = g2[(2 * dir) * MH + head]; sgf = g2[(2 * dir + 1) * MH + head]; } } } while (0)
#define ML_TOUCH() asm volatile("" :: "v"(pqk[0]), "v"(pqk[1]), "v"(pqk[2]), "v"(pqk[3]), "v"(pv[0]), "v"(pv[1]), "v"((unsigned)pgi), "v"((unsigned)pgf), "v"((unsigned)sgi), "v"((unsigned)sgf) : "memory")
#define ML_SCAN(gi_, gf_) \
            const float gi = bf2f(gi_) + bi, gf = bf2f(gf_) + bfg; \
            const float lf = fminf(gf, 0.f) - log1pf(__expf(-fabsf(gf))); \
            float b = lf; \
            _Pragma("unroll") for (int o = 1; o < 64; o <<= 1) { const float t = __shfl_up(b, o); if (lane >= o) b += t; } \
            const float a = gi - b; float pm = a; \
            _Pragma("unroll") for (int o = 1; o < 64; o <<= 1) { const float t = __shfl_up(pm, o); if (lane >= o) pm = fmaxf(pm, t); } \
            pm = fmaxf(pm, m_prev); \
            const float pm63 = __shfl(pm, 63), b63 = __shfl(b, 63);
    ML_PREFETCH(pp);
    ML_TOUCH();
    unsigned acked = 0u;
    for (int c = pp; c < nchunk; c += MLPROD) {
        if (w == 0 && c >= 1) { ML_SCAN(sgi, sgf) m_prev = b63 + pm63; }
#pragma unroll
        for (int i = 0; i < 4; ++i) { const int id = tid + 512 * i, j = id >> 5, pc = id & 31;
            *(LAS u32x4*)(lds + (pc < 16 ? P_QS : P_KS) + j * PQ + (pc & 15) * 16) = pqk[i]; }
#pragma unroll
        for (int i = 0; i < 2; ++i) { const int id = tid + 512 * i, j = id >> 4, pc = id & 15; const unsigned wv[4] = {pv[i].x, pv[i].y, pv[i].z, pv[i].w};
#pragma unroll
            for (int e = 0; e < 8; ++e) *(LAS bf16*)(lds + P_VT + (8 * pc + e) * PT + j * 2) = (bf16)((wv[e >> 1] >> ((e & 1) * 16)) & 0xffffu); }
        if (w == 0) {
            ML_SCAN(pgi, pgf)
            SC[ml::SC_A + lane] = a; SC[ml::SC_PM + lane] = pm; SC[ml::SC_WI + lane] = __expf(m_prev - pm); SC[ml::SC_EMT + lane] = __expf(-(b + pm)); SC[ml::SC_WE + lane] = __expf(a - pm63);
            if (lane == 0) { SC[ml::SC_MISC] = __expf(m_prev - pm63); SC[ml::SC_MISC + 1] = b63 + pm63; }
            m_prev = b63 + pm63;
        }
        LDS_BARRIER();
        if (c + MLPROD < nchunk) ML_PREFETCH(c + MLPROD);
#pragma unroll
        for (int i = 0; i < 2; ++i) { const int id = tid + 512 * i, j = id & 63, pc = id >> 6; const float we = SC[ml::SC_WE + j];
            const u32x4 kv = *(const LAS u32x4*)(lds + P_KS + j * PQ + pc * 16); const unsigned wv[4] = {kv.x, kv.y, kv.z, kv.w};
#pragma unroll
            for (int e = 0; e < 8; ++e) { const float kf = __builtin_bit_cast(float, (e & 1) ? (wv[e >> 1] & 0xffff0000u) : (wv[e >> 1] << 16));
                *(LAS bf16*)(lds + P_KT + (8 * pc + e) * PT + j * 2) = f2bf(kf * we); } }
#pragma unroll
        for (int cc = 0; cc < 2; ++cc) { const int ct = 2 * half + cc;
            f32x4 acc = (f32x4){0.f, 0.f, 0.f, 0.f};
            if (ct <= rt) {
#pragma unroll
                for (int k = 0; k < 4; ++k) acc = mma(frag(lds, P_QS, PQ, 16 * rt, 32 * k, lane), frag(lds, P_KS, PQ, 16 * ct, 32 * k, lane), acc);
            }
            const int sp = 16 * ct + fr; const float as = SC[ml::SC_A + sp];
#pragma unroll
            for (int r = 0; r < 4; ++r) { const int t = 16 * rt + 4 * fq + r; const float v = (sp <= t) ? acc[r] * __expf(as - SC[ml::SC_PM + t]) : 0.f;
                *(LAS bf16*)(lds + P_SB + t * PT + sp * 2) = f2bf(v); } }
        asm volatile("s_waitcnt vmcnt(0)" ::: "memory");
        if (tid == 0 && c >= ML_RING && acked < (unsigned)(c - ML_RING + 1)) acked = wy::fl_wait_ge(f_ack, (unsigned)(c - ML_RING + 1), tmo);
        LDS_BARRIER();
        if (tid == 0 && c > pp) __hip_atomic_store(f_ready, (unsigned)((c - pp) / MLPROD), __ATOMIC_RELAXED, __HIP_MEMORY_SCOPE_AGENT);
        ML_TOUCH();
        { unsigned char* slot = ring + (size_t)(c % ML_RING) * ML_PACK;
#pragma unroll
          for (int k = 0; k < 9; ++k) { const int u = tid + 512 * k;
              if (u < ML_PACK_U) { const u32x4 v = *(const LAS u32x4*)(lds + 16 * u); const u32x4* gp = (const u32x4*)(slot + (size_t)16 * u);
                  asm volatile("global_store_dwordx4 %0, %1, off sc1" :: "v"(gp), "v"(v) : "memory"); } } }
        LDS_BARRIER();
    }
    asm volatile("s_waitcnt vmcnt(0)" ::: "memory");
    __syncthreads();
    if (tid == 0) __hip_atomic_store(f_ready, (unsigned)((nchunk - pp + MLPROD - 1) / MLPROD), __ATOMIC_RELAXED, __HIP_MEMORY_SCOPE_AGENT);
    LDS_BARRIER();
#undef ML_TOK
#undef ML_PREFETCH
#undef ML_TOUCH
#undef ML_SCAN
}
__device__ __forceinline__ void ml_cons(LAS unsigned char* lds, CParams& P, int l, int s, int head, int dir, int chain, unsigned* ctl) {
    const int tid = wy::tid_opaque(), w = __builtin_amdgcn_readfirstlane(tid >> 6), lane = tid & 63, fr = lane & 15, fq = lane >> 4;
    const SeqInfo q = seqinfo(s); const int nchunk = q.T / 64;
    bf16* U = WSP(bf16, WS_U1);
    const unsigned char* ring = P.ws + WS_END + (size_t)chain * ML_RING * ML_PACK;
    unsigned* f_base = ctl + CW_MF + (size_t)((l * N_MLAT + chain) * 4) * wy::FL_STRIDE; unsigned* f_ack = f_base + MLPROD * wy::FL_STRIDE; unsigned* tmo = ctl + 4096 + 128;
    f32x4 cst[8][3];
#pragma unroll
    for (int kt = 0; kt < 8; ++kt)
#pragma unroll
        for (int j = 0; j < 3; ++j) cst[kt][j] = (f32x4){0.f, 0.f, 0.f, 0.f};
    if (w < 4 && q.grid) { const size_t sb = (((size_t)q.b * DEPTH + l) * 2 + dir) * MH + head;
#pragma unroll
        for (int kt = 0; kt < 8; ++kt)
#pragma unroll
            for (int r = 0; r < 4; ++r) { const int d = 16 * kt + 4 * fq + r;
                cst[kt][0][r] = P.in[ST_C][(sb * 128 + d) * 128 + 32 * w + fr]; cst[kt][1][r] = P.in[ST_C][(sb * 128 + d) * 128 + 32 * w + 16 + fr];
                cst[kt][2][r] = (fr == 0) ? P.in[ST_N][sb * 128 + d] : 0.f; } }
#define ML_TOK(c, j) ((size_t)(q.base + (dir ? q.T - 1 - ((c) * 64 + (j)) : ((c) * 64 + (j)))))
    unsigned seen0 = 0u, seen1 = 0u;
#define MLC_FETCH(c, boff) do { const int p_ = (c) % MLPROD; const unsigned need_ = (unsigned)((c) / MLPROD + 1); \
        if ((p_ ? seen1 : seen0) < need_) { unsigned v_ = 0u; if (lane == 0) v_ = wy::fl_wait_ge(f_base + p_ * wy::FL_STRIDE, need_, tmo); v_ = __builtin_amdgcn_readfirstlane(v_); \
            if (p_) seen1 = v_; else seen0 = v_; __builtin_amdgcn_fence(__ATOMIC_ACQUIRE, "agent"); } \
        const unsigned char* slot = ring + (size_t)((c) % ML_RING) * ML_PACK; \
        for (int k = w - 4; k < ML_PACK / 1024; k += 4) \
            __builtin_amdgcn_global_load_lds((const unsigned*)(slot + (size_t)k * 1024 + lane * 16), (LAS unsigned*)(lds + (boff) + k * 1024), 16, 0, 0); \
        asm volatile("s_waitcnt vmcnt(0)" ::: "memory"); } while (0)
    if (w >= 4) MLC_FETCH(0, 0);
    LDS_BARRIER();
    if (tid == 256) __hip_atomic_store(f_ack, 1u, __ATOMIC_RELAXED, __HIP_MEMORY_SCOPE_AGENT);
    for (int c = 0; c < nchunk; ++c) {
        const int boff = (c & 1) * ML_PACK;
        if (w >= 4) { if (c + 1 < nchunk) MLC_FETCH(c + 1, ML_PACK - boff); }
        else {
            LAS unsigned char* pb = lds + boff; const LAS float* SC = (const LAS float*)(pb + P_SC);
            const float wie = SC[ml::SC_MISC];
            bf16x8 vf[3][2];
#pragma unroll
            for (int j = 0; j < 3; ++j)
#pragma unroll
                for (int k = 0; k < 2; ++k) vf[j][k] = frag(pb, P_VT, PT, j < 2 ? 32 * w + 16 * j : 128, 32 * k, lane);
            asm volatile("s_waitcnt lgkmcnt(0)" ::: "memory");
            LAS unsigned char* hp = pb + P_VT + 32 * w * PT;
#pragma unroll
            for (int rt = 0; rt < 4; ++rt) {
                f32x4 num[3];
#pragma unroll
                for (int j = 0; j < 3; ++j) { f32x4 a1 = (f32x4){0.f, 0.f, 0.f, 0.f}, a2 = (f32x4){0.f, 0.f, 0.f, 0.f};
#pragma unroll
                    for (int k = 0; k < 2; ++k) a1 = mma(frag(pb, P_SB, PT, 16 * rt, 32 * k, lane), vf[j][k], a1);
#pragma unroll
                    for (int kb = 0; kb < 4; ++kb) a2 = mma(wy::ld_k32(pb, P_QS, PQ, 16 * rt, 32 * kb, lane), wy::pack_k32(cst[2 * kb][j], cst[2 * kb + 1][j]), a2);
#pragma unroll
                    for (int r = 0; r < 4; ++r) a1[r] += SC[ml::SC_WI + 16 * rt + 4 * fq + r] * a2[r];
                    num[j] = a1; }
#pragma unroll
                for (int r = 0; r < 4; ++r) { const int t = 16 * rt + 4 * fq + r; const float dn = __shfl(num[2][r], lane & 48);
                    const float rden = __builtin_amdgcn_rcpf(fmaxf(fabsf(dn), SC[ml::SC_EMT + t]));
                    *(LAS bf16*)(hp + t * 64 + fr * 2) = f2bf(num[0][r] * rden); *(LAS bf16*)(hp + t * 64 + (16 + fr) * 2) = f2bf(num[1][r] * rden); }
            }
#pragma unroll
            for (int kt = 0; kt < 8; ++kt) { const bf16x8 k0 = frag(pb, P_KT, PT, 16 * kt, 0, lane), k1 = frag(pb, P_KT, PT, 16 * kt, 32, lane);
#pragma unroll
                for (int j = 0; j < 3; ++j) { cst[kt][j] = cst[kt][j] * wie; cst[kt][j] = mma(k0, vf[j][0], cst[kt][j]); cst[kt][j] = mma(k1, vf[j][1], cst[kt][j]); } }
            { const LAS unsigned char* yp = hp + lane * 64; bf16* up = U + ML_TOK(c, lane) * PU + dir * MW + head * 128 + 32 * w;
#pragma unroll
              for (int i = 0; i < 4; ++i) *(u32x4*)(up + 8 * i) = *(const LAS u32x4*)(yp + 16 * i); }
        }
        LDS_BARRIER();
        if (tid == 256 && c + 1 < nchunk) __hip_atomic_store(f_ack, (unsigned)(c + 2), __ATOMIC_RELAXED, __HIP_MEMORY_SCOPE_AGENT);
    }
    LDS_BARRIER();
#undef ML_TOK
#undef MLC_FETCH
}
}

namespace el {
typedef float f32x4 __attribute__((ext_vector_type(4)));
typedef unsigned u32x4 __attribute__((ext_vector_type(4)));
typedef unsigned u32x2 __attribute__((ext_vector_type(2)));
typedef short bf16x8 __attribute__((ext_vector_type(8)));
__device__ __forceinline__ float wave_sum(float v) {
#pragma unroll
    for (int o = 1; o < 64; o <<= 1) v += __shfl_xor(v, o);
    return v;
}
__device__ __forceinline__ void unpack8(const u32x4 p, float (&f)[8]) {
    f[0] = pg8::bflo(p.x); f[1] = pg8::bfhi(p.x); f[2] = pg8::bflo(p.y); f[3] = pg8::bfhi(p.y); f[4] = pg8::bflo(p.z); f[5] = pg8::bfhi(p.z); f[6] = pg8::bflo(p.w); f[7] = pg8::bfhi(p.w);
}
__device__ __forceinline__ u32x4 pack8(const float (&f)[8]) {
    u32x4 o; o.x = pg8::cvt_pk_bf16(f[0], f[1]); o.y = pg8::cvt_pk_bf16(f[2], f[3]); o.z = pg8::cvt_pk_bf16(f[4], f[5]); o.w = pg8::cvt_pk_bf16(f[6], f[7]); return o;
}
__device__ __forceinline__ void init_phase(LAS unsigned char* lds, CParams& P, int vb, int G) {
    const int tid = threadIdx.x, w = tid >> 6, lane = tid & 63;
    { const size_t n4 = (size_t)NT * D / 4, nc4 = (size_t)NC * D / 4; f32x4* o = (f32x4*)P.out; const f32x4* a = (const f32x4*)P.in[X_PROMPT]; const f32x4* b = (const f32x4*)P.in[X_SAMPLE];
      for (size_t i = (size_t)vb * 512 + tid; i < n4; i += (size_t)G * 512) o[i] = i < nc4 ? a[i] : b[i - nc4]; }
    LAS float* red = (LAS float*)lds;
    constexpr int KW = D / 8;
    for (int it = vb; it < DEPTH * (6 * D / 64); it += G) {
        const int l = it / (6 * D / 64), j = (it % (6 * D / 64)) * 64 + lane;
        const float* wp = P.in[ADA_W] + ((size_t)l * D + w * KW) * 6 * D + j;
        float acc[NCOND];
#pragma unroll
        for (int ci = 0; ci < NCOND; ++ci) acc[ci] = 0.f;
        for (int k = 0; k < KW; ++k) { const float wv = wp[(size_t)k * 6 * D];
#pragma unroll
            for (int ci = 0; ci < NCOND; ++ci) { const float cv = ci == 0 ? P.in[C_CTX][w * KW + k] : P.in[C_LAT][(size_t)(ci - 1) * D + w * KW + k]; acc[ci] += cv * pg8::fsigmoid(cv) * wv; } }
#pragma unroll
        for (int ci = 0; ci < NCOND; ++ci) red[(w * NCOND + ci) * 64 + lane] = acc[ci];
        __syncthreads();
        if (w < NCOND) { float sum = P.in[ADA_B][(size_t)l * 6 * D + j];
#pragma unroll
            for (int ww = 0; ww < 8; ++ww) sum += red[(ww * NCOND + w) * 64 + lane];
            WSP(float, WS_MOD)[((size_t)l * NCOND + w) * 6 * D + j] = sum; }
        __syncthreads();
    }
}
__device__ __forceinline__ int perm5(int n) { return (((n >> 2) & 1) << 4) | (((n >> 3) & 3) << 2) | (n & 3); }
__device__ __forceinline__ void transpose_item(const float* W, int ldw, int nvalid, bf16* dst, int K, int k0, int drow0, bool perm, LAS float* scr, int lane) {
#pragma unroll 8
    for (int i = 0; i < 32; ++i) { const int kk = 2 * i + (lane >> 5), n = lane & 31; scr[kk * 33 + n] = n < nvalid ? W[(size_t)kk * ldw + n] : 0.f; }
    asm volatile("s_waitcnt lgkmcnt(0)" ::: "memory");
    const int c = lane & 7;
#pragma unroll
    for (int j = 0; j < 4; ++j) { const int n = (lane >> 3) + 8 * j; const LAS float* sp = scr + (8 * c) * 33 + n;
        u32x4 o; o.x = pg8::cvt_pk_bf16(sp[0 * 33], sp[1 * 33]); o.y = pg8::cvt_pk_bf16(sp[2 * 33], sp[3 * 33]); o.z = pg8::cvt_pk_bf16(sp[4 * 33], sp[5 * 33]); o.w = pg8::cvt_pk_bf16(sp[6 * 33], sp[7 * 33]);
        *(u32x4*)(dst + (size_t)(drow0 + (perm ? perm5(n) : n)) * K + k0 + 8 * c) = o; }
    asm volatile("s_waitcnt lgkmcnt(0)" ::: "memory");
}
constexpr int WI_0 = (N1P / 32) * (D / 64), WI_1 = WI_0 + (2 * D / 32) * (D / 64), WI_2 = WI_1 + (D / 32) * (MW / 64), WI_3 = WI_2 + (D / 32) * (RW / 64),
              WI_4 = WI_3 + (D / 32) * (D / 64), WI_5 = WI_4 + 2 * (FF / 32) * (D / 64), WI_6 = WI_5 + (D / 32) * (FF / 64), WI_7 = WI_6 + (RW / 32) * (128 / 64), WI_8 = WI_7 + 4 * (RW / 32);
__device__ __forceinline__ void wconv_phase(LAS unsigned char* lds, CParams& P, int l, int vb, int G) {
    const int tid = threadIdx.x, w = tid >> 6, lane = tid & 63;
    LAS float* scr = (LAS float*)(lds + w * 8704);
    for (int it = vb * 8 + w; it < WI_8; it += G * 8) {
        if (it < WI_0) { const int nb = it / (D / 64), kb = it % (D / 64); const int n0 = nb * 32; const int nv = n0 >= N1 ? 0 : (N1 - n0 < 32 ? N1 - n0 : 32);
            transpose_item(P.in[W_IN] + ((size_t)l * D + kb * 64) * PIN + n0, PIN, nv, WSP(bf16, O_WIN1), D, kb * 64, n0, true, scr, lane); }
        else if (it < WI_1) { const int r = it - WI_0, nb = r / (D / 64), kb = r % (D / 64);
            transpose_item(P.in[W_IN] + ((size_t)l * D + kb * 64) * PIN + N1 + nb * 32, PIN, 32, WSP(bf16, O_WIN2), D, kb * 64, nb * 32, true, scr, lane); }
        else if (it < WI_2) { const int r = it - WI_1, nb = r / (MW / 64), kb = r % (MW / 64);
            transpose_item(P.in[PROJ_M] + ((size_t)l * MW + kb * 64) * D + nb * 32, D, 32, WSP(bf16, O_PM), MW, kb * 64, nb * 32, true, scr, lane); }
        else if (it < WI_3) { const int r = it - WI_2, nb = r / (RW / 64), kb = r % (RW / 64);
            transpose_item(P.in[PROJ_R] + ((size_t)l * RW + kb * 64) * D + nb * 32, D, 32, WSP(bf16, O_PR), RW, kb * 64, nb * 32, true, scr, lane); }
        else if (it < WI_4) { const int r = it - WI_3, nb = r / (D / 64), kb = r % (D / 64);
            transpose_item(P.in[W_OUT] + ((size_t)l * D + kb * 64) * D + nb * 32, D, 32, WSP(bf16, O_WO), D, kb * 64, nb * 32, false, scr, lane); }
        else if (it < WI_5) { const int r = it - WI_4, which = r / ((FF / 32) * (D / 64)), r2 = r % ((FF / 32) * (D / 64)), nb = r2 / (D / 64), kb = r2 % (D / 64);
            const int j0 = nb * 32, pn = j0 >> 7, drow0 = pn * 256 + which * 128 + (j0 & 127);
            transpose_item((which ? P.in[FFN_W3] : P.in[FFN_W1]) + ((size_t)l * D + kb * 64) * FF + j0, FF, 32, WSP(bf16, O_W13), D, kb * 64, drow0, true, scr, lane); }
        else if (it < WI_6) { const int r = it - WI_5, nb = r / (FF / 64), kb = r % (FF / 64);
            transpose_item(P.in[FFN_W2] + ((size_t)l * FF + kb * 64) * D + nb * 32, D, 32, WSP(bf16, O_W2), FF, kb * 64, nb * 32, false, scr, lane); }
        else if (it < WI_7) { const int r = it - WI_6, nb = r / 2, kb = r % 2;
            transpose_item(P.in[R_G2] + ((size_t)l * 128 + kb * 64) * RW + nb * 32, RW, 32, WSP(bf16, O_G2T), 128, kb * 64, nb * 32, false, scr, lane); }
        else { const int r = it - WI_7, which = r / (2 * (RW / 32)), d = (r / (RW / 32)) & 1, nb = r % (RW / 32);
            transpose_item((which ? P.in[R_A2] : P.in[R_W2]) + ((size_t)l * 2 + d) * 64 * RW + nb * 32, RW, 32, WSP(bf16, which ? O_A2T : O_W2T) + (size_t)d * RW * 64, 64, 0, nb * 32, false, scr, lane); }
    }
}
__device__ __forceinline__ void norm_phase(CParams& P, int l, int mode, int vb, int G) {
    const int tid = threadIdx.x, w = tid >> 6, lane = tid & 63;
    for (int m = vb * 8 + w; m < NT; m += G * 8) {
        float* xr = P.out + (size_t)m * D;
        f32x4 v[D / 256]; float ss = 0.f;
#pragma unroll
        for (int j = 0; j < D / 256; ++j) { v[j] = *(const f32x4*)(xr + 256 * j + 4 * lane); ss += (v[j][0] * v[j][0] + v[j][1] * v[j][1]) + (v[j][2] * v[j][2] + v[j][3] * v[j][3]); }
        const float rs = 1.0f / sqrtf(wave_sum(ss) * (1.0f / D) + RMS_EPS);
        if (mode == 3) {
#pragma unroll
            for (int j = 0; j < D / 256; ++j) { const f32x4 g = *(const f32x4*)(P.in[FINAL_G] + 256 * j + 4 * lane); *(f32x4*)(xr + 256 * j + 4 * lane) = v[j] * rs * g; }
        } else {
            const int second = (mode == 2); const int cond = seqinfo(seq_of_token(m)).cond;
            const float* gp = P.in[second ? NORM2 : NORM1] + (size_t)l * D; const float* mod = WSP(float, WS_MOD) + ((size_t)l * NCOND + cond) * 6 * D + (second ? 3 * D : 0);
            bf16* o = WSP(bf16, mode == 1 ? WS_RXC : WS_QKC) + (size_t)m * D;
#pragma unroll
            for (int j = 0; j < D / 256; ++j) { const int c = 256 * j + 4 * lane; const f32x4 g = *(const f32x4*)(gp + c), sh = *(const f32x4*)(mod + c), sc = *(const f32x4*)(mod + D + c);
                const f32x4 y = v[j] * rs * g * (sc + 1.0f) + sh; u32x2 pk; pk.x = pg8::cvt_pk_bf16(y[0], y[1]); pk.y = pg8::cvt_pk_bf16(y[2], y[3]); *(u32x2*)(o + c) = pk; }
        }
    }
}
constexpr int CV_NCH = 2 * MW + RIN, CV_NG = CV_NCH / 4, CV_NCHUNK = (CV_NG + 63) / 64, CV_SEG = 16, CV_PAIRS = NC / (2 * CV_SEG);
static_assert(CV_NCHUNK == 12 && NC == NT - NC && GW % CV_SEG == 0 && CT % CV_SEG == 0 && 2 * MW == 1024 && RX_WL == 1536, "conv item layout");
typedef float f32x2 __attribute__((ext_vector_type(2)));
struct CvAct { float alpha, cA, cB, cC, cD; bool any; };
template <int NR> struct CvState { f32x2 wt[NR * 3][2]; f32x2 fw[NR][3][2]; u32x2 p[3][NR]; };
__device__ __forceinline__ void cv_unpk(const u32x2 p, f32x2 (&f)[2]) { f[0].x = pg8::bflo(p.x); f[0].y = pg8::bfhi(p.x); f[1].x = pg8::bflo(p.y); f[1].y = pg8::bfhi(p.y); }
template <int NR> __device__ __forceinline__ u32x2 cv_ld(const bf16* const (&rowp)[NR], const bool (&rok)[NR], int a, int col, int W) {
    const u32x2 zero2 = {0u, 0u};
    return (rok[a] && col >= 0 && col < W) ? *(const u32x2*)(rowp[a] + (size_t)col * PU) : zero2;
}
template <int NR, int S> __device__ __forceinline__ void cv_col(CvState<NR>& st, const bf16* const (&rowp)[NR], const bool (&rok)[NR], int cs, int W, int o, const CvAct& act, bf16* dst) {
#pragma unroll
    for (int a = 0; a < NR; ++a) { cv_unpk(st.p[S][a], st.fw[a][(S + 2) % 3]); const u32x2 zero2 = {0u, 0u}; st.p[S][a] = (o + 4 <= CV_SEG) ? cv_ld<NR>(rowp, rok, a, cs + o + 4, W) : zero2; }
    f32x2 acc[2];
#pragma unroll
    for (int e = 0; e < 2; ++e) acc[e] = st.wt[0][e] * st.fw[0][S][e];
#pragma unroll
    for (int a = 0; a < NR; ++a)
#pragma unroll
        for (int b = 0; b < 3; ++b) if (a + b > 0) {
#pragma unroll
            for (int e = 0; e < 2; ++e) acc[e] = __builtin_elementwise_fma(st.wt[a * 3 + b][e], st.fw[a][(S + b) % 3][e], acc[e]); }
    float v[4] = {acc[0].x, acc[0].y, acc[1].x, acc[1].y};
    if (act.any) {
#pragma unroll
        for (int e = 0; e < 4; ++e) { const float t = __builtin_amdgcn_rcpf(__builtin_amdgcn_exp2f(act.alpha * v[e]) + 1.0f); v[e] = (act.cA * v[e] + act.cB) * t + (act.cC * v[e] + act.cD); }
    }
    u32x2 pk; pk.x = pg8::cvt_pk_bf16(v[0], v[1]); pk.y = pg8::cvt_pk_bf16(v[2], v[3]);
    *(u32x2*)dst = pk;
}
template <int NR> __device__ __forceinline__ void conv_item(const bf16* const (&rowp)[NR], const bool (&rok)[NR], int cs, int W, const float* wsrc, int CH, const CvAct& act, bf16* dst, int dpitch) {
    CvState<NR> st;
#pragma unroll
    for (int a = 0; a < NR * 3; ++a) { const int tap = NR == 3 ? a : 3 + a; const f32x4 w0 = *(const f32x4*)(wsrc + (size_t)tap * CH);
        st.wt[a][0].x = w0[0]; st.wt[a][0].y = w0[1]; st.wt[a][1].x = w0[2]; st.wt[a][1].y = w0[3]; }
#pragma unroll
    for (int a = 0; a < NR; ++a) { cv_unpk(cv_ld<NR>(rowp, rok, a, cs - 1, W), st.fw[a][0]); cv_unpk(cv_ld<NR>(rowp, rok, a, cs, W), st.fw[a][1]); }
#pragma unroll
    for (int s3 = 0; s3 < 3; ++s3)
#pragma unroll
        for (int a = 0; a < NR; ++a) st.p[s3][a] = cv_ld<NR>(rowp, rok, a, cs + 1 + s3, W);
#pragma unroll 1
    for (int o = 0; o < CV_SEG - 1; o += 3) {
        cv_col<NR, 0>(st, rowp, rok, cs, W, o, act, dst + (size_t)o * dpitch);
        cv_col<NR, 1>(st, rowp, rok, cs, W, o + 1, act, dst + (size_t)(o + 1) * dpitch);
        cv_col<NR, 2>(st, rowp, rok, cs, W, o + 2, act, dst + (size_t)(o + 2) * dpitch);
    }
    cv_col<NR, 0>(st, rowp, rok, cs, W, CV_SEG - 1, act, dst + (size_t)(CV_SEG - 1) * dpitch);
}
__device__ __forceinline__ void conv_phase(LAS unsigned char* lds, CParams& P, int l, int vb, int G) {
    const int tid = threadIdx.x, lane = tid & 63;
    const bf16* U = WSP(bf16, WS_U1);
    LAS unsigned* cnt = (LAS unsigned*)lds;
    for (int sp = vb; sp < CV_PAIRS; sp += G) {
        __syncthreads();
        if (tid == 0) *cnt = 0u;
        __syncthreads();
        for (;;) {
            unsigned j = 0; if (lane == 0) j = __hip_atomic_fetch_add(cnt, 1u, __ATOMIC_RELAXED, __HIP_MEMORY_SCOPE_WORKGROUP);
            j = __builtin_amdgcn_readfirstlane(j);
            if (j >= 48u) break;
            const int cls = j / 12, jj = j % 12, lat = (cls & 1) == 0, heavy = cls < 2, ci = jj >> 1, chunk = heavy ? (ci >= 4 ? 6 + ci : ci) : 4 + ci;
            const int seg = (lat ? NC / CV_SEG : 0) + 2 * sp + (jj & 1), g = chunk * 64 + lane;
            if (g >= CV_NG) continue;
            const int ch = 4 * g; const bool isqk = ch < 2 * MW; const int c = isqk ? ch : ch - 2 * MW;
            const int ucol = isqk ? OFF_QK + c : OFF_R + c, CH = isqk ? 2 * MW : RIN;
            const float* wsrc = (isqk ? P.in[M_CONV] : P.in[R_CONV]) + (size_t)l * 9 * CH + c;
            const int kind = isqk ? (c < MW ? 0 : 1) : (c >= RX_GL ? 4 : (c >= RX_AL ? 2 : (c >= RX_WL ? 3 : 2)));
            CvAct act; act.alpha = kind == 3 ? 2.8853900817779268f : -1.4426950408889634f;
            act.cA = kind == 0 ? 0.08838834764831845f : (kind == 1 ? 1.0f : 0.0f); act.cB = kind == 3 ? -2.0f : (kind == 4 ? 1.0f : 0.0f); act.cC = kind == 2 ? 1.0f : 0.0f; act.cD = kind == 3 ? 1.0f : 0.0f;
            act.any = heavy;
            const int m0 = seg * CV_SEG; const SeqInfo q = seqinfo(seq_of_token(m0)); const int t0 = m0 - q.base;
            bf16* dst = isqk ? WSP(bf16, WS_QKC) + (size_t)m0 * (2 * MW) + c : WSP(bf16, WS_RXC) + (size_t)m0 * RIN + c; const int dpitch = isqk ? 2 * MW : RIN;
            if (q.grid) {
                const int r = t0 / GW, cs = t0 % GW, rows = q.T / GW;
                const bf16* rowp[3]; bool rok[3];
#pragma unroll
                for (int a = 0; a < 3; ++a) { const int rr = r + a - 1; rok[a] = rr >= 0 && rr < rows; rowp[a] = U + (size_t)(q.base + (rok[a] ? rr : r) * GW) * PU + ucol; }
                conv_item<3>(rowp, rok, cs, GW, wsrc, CH, act, dst, dpitch);
            } else {
                const bf16* rowp[1] = {U + (size_t)q.base * PU + ucol}; const bool rok[1] = {true};
                conv_item<1>(rowp, rok, t0, q.T, wsrc, CH, act, dst, dpitch);
            }
        }
    }
}
constexpr int PO_ITEMS = (NT / 16) * 2, PO_HC = RW / 2;
__device__ __forceinline__ void post_phase(LAS unsigned char* lds, CParams& P, int l, int vb, int G) {
    const int tid = threadIdx.x, w = tid >> 6, lane = tid & 63, fr = lane & 15, fq = lane >> 4, l32 = lane & 31, th = lane >> 5;
    constexpr int GP = PO_HC * 2 + 16;
    LAS unsigned char* gt = lds + w * (16 * GP);
    const bf16* U = WSP(bf16, WS_U1); const bf16* RX = WSP(bf16, WS_RXC); const bf16* G2T = WSP(bf16, O_G2T); bf16* O = WSP(bf16, WS_QKC);
    for (int it = vb * 8 + w; it < PO_ITEMS; it += G * 8) {
        const int tile = it >> 1, h = it & 1; const size_t tok0 = (size_t)tile * 16;
        bf16x8 af[4];
#pragma unroll
        for (int ks = 0; ks < 4; ++ks) af[ks] = *(const bf16x8*)(RX + (tok0 + fr) * RIN + RX_GL + 32 * ks + 8 * fq);
        for (int ct = 0; ct < PO_HC / 16; ++ct) { f32x4 acc = (f32x4){0.f, 0.f, 0.f, 0.f};
#pragma unroll
            for (int ks = 0; ks < 4; ++ks) acc = ml::mma(af[ks], *(const bf16x8*)(G2T + (size_t)(h * PO_HC + 16 * ct + fr) * 128 + 32 * ks + 8 * fq), acc);
#pragma unroll
            for (int r = 0; r < 4; ++r) *(LAS bf16*)(gt + (4 * fq + r) * GP + (16 * ct + fr) * 2) = f2bf(acc[r]); }
        asm volatile("s_waitcnt lgkmcnt(0)" ::: "memory");
        const int cb = h * PO_HC + 8 * l32;
        float gn[8], gw[8], gb[8], rk[8];
        { const f32x4 a0 = *(const f32x4*)(P.in[M_NORM_G] + (size_t)l * MW + cb), a1 = *(const f32x4*)(P.in[M_NORM_G] + (size_t)l * MW + cb + 4);
          const f32x4 b0 = *(const f32x4*)(P.in[R_GN_W] + (size_t)l * RW + cb), b1 = *(const f32x4*)(P.in[R_GN_W] + (size_t)l * RW + cb + 4);
          const f32x4 c0 = *(const f32x4*)(P.in[R_GN_B] + (size_t)l * RW + cb), c1 = *(const f32x4*)(P.in[R_GN_B] + (size_t)l * RW + cb + 4);
          const f32x4 d0 = *(const f32x4*)(P.in[R_RK] + (size_t)l * RW + cb), d1 = *(const f32x4*)(P.in[R_RK] + (size_t)l * RW + cb + 4);
#pragma unroll
          for (int e = 0; e < 4; ++e) { gn[e] = a0[e]; gn[4 + e] = a1[e]; gw[e] = b0[e]; gw[4 + e] = b1[e]; gb[e] = c0[e]; gb[4 + e] = c1[e]; rk[e] = d0[e]; rk[4 + e] = d1[e]; } }
        for (int tp = 0; tp < 8; ++tp) { const int tl = 2 * tp + th; const size_t m = tok0 + tl; const bf16* u = U + m * PU; const bf16* rx = RX + m * RIN;
            float hf[8], hb[8], ov[8], x[8]; unpack8(*(const u32x4*)(u + cb), hf); unpack8(*(const u32x4*)(u + MW + cb), hb); unpack8(*(const u32x4*)(u + OFF_O + cb), ov);
            float ss = 0.f;
#pragma unroll
            for (int e = 0; e < 8; ++e) { x[e] = hf[e] + hb[e]; ss += x[e] * x[e]; }
            ss = rw::allsum16(ss); const float rs = 1.0f / sqrtf(ss * (1.0f / 128.f) + RMS_EPS);
#pragma unroll
            for (int e = 0; e < 8; ++e) x[e] = x[e] * rs * gn[e] * pg8::fsigmoid(ov[e]);
            *(u32x4*)(O + m * D + cb) = pack8(x);
            float yf[8], yb[8], rr[8], kk[8], vv[8], gg[8], y[8]; unpack8(*(const u32x4*)(u + OFF_R + cb), yf); unpack8(*(const u32x4*)(u + OFF_R + RW + cb), yb);
            unpack8(*(const u32x4*)(rx + RX_R + cb), rr); unpack8(*(const u32x4*)(rx + RX_K + cb), kk); unpack8(*(const u32x4*)(rx + RX_V + cb), vv);
            unpack8(*(const LAS u32x4*)(gt + tl * GP + l32 * 16), gg);
            float mu = 0.f, bs = 0.f;
#pragma unroll
            for (int e = 0; e < 8; ++e) { y[e] = yf[e] + yb[e]; mu += y[e]; bs += rr[e] * kk[e] * rk[e]; }
            mu += rw::dpp_xor1(mu); mu += rw::dpp_xor2(mu); mu += __shfl_xor(mu, 4); mu *= (1.0f / 64.f);
            bs += rw::dpp_xor1(bs); bs += rw::dpp_xor2(bs); bs += __shfl_xor(bs, 4);
            float var = 0.f;
#pragma unroll
            for (int e = 0; e < 8; ++e) { y[e] -= mu; var += y[e] * y[e]; }
            var += rw::dpp_xor1(var); var += rw::dpp_xor2(var); var += __shfl_xor(var, 4); var *= (1.0f / 64.f);
            const float rsd = 1.0f / sqrtf(var + GN_EPS);
#pragma unroll
            for (int e = 0; e < 8; ++e) y[e] = (y[e] * rsd * gw[e] + gb[e] + bs * vv[e]) * gg[e];
            *(u32x4*)(O + m * D + MW + cb) = pack8(y);
        }
        asm volatile("s_waitcnt lgkmcnt(0)" ::: "memory");
    }
}
}

constexpr int LDS_BYTES = 147456;
constexpr int LDS_MISC = 147456 - 1024;
constexpr size_t CTL_ZERO_BYTES = 262144;
constexpr int CW_BAR = 4096, CW_Q = 8192;

#define XB_TMO      128
#define XB_XCNT(j)  (256  + 64 * (j))
#define XB_XSUB(j)  (1280 + 64 * (j))
#define XB_XGEN(j)  (2304 + 64 * (j))
#define XB_TOP      3328
#define XB_TOPGEN   3392
#define XCD_BAR_WORDS 3456
#define XB_SPIN_CAP (1u << 18)
__device__ __forceinline__ unsigned xb_ld(unsigned* p)              { return __hip_atomic_load(p, __ATOMIC_RELAXED, __HIP_MEMORY_SCOPE_AGENT); }
__device__ __forceinline__ unsigned xb_add(unsigned* p, unsigned v) { return __hip_atomic_fetch_add(p, v, __ATOMIC_RELAXED, __HIP_MEMORY_SCOPE_AGENT); }
__device__ __forceinline__ unsigned xb_xcc_id() { return (unsigned)__builtin_amdgcn_s_getreg((3 << 11) | 20) & 0xFu; }
#define XB_SPIN(cond, bar) do { unsigned _sp = 0; while (cond) { __builtin_amdgcn_s_sleep(1); \
    if ((++_sp & 255u) == 0u) { if (xb_ld(&(bar)[XB_TMO])) break; if (_sp > XB_SPIN_CAP) { atomicAdd(&(bar)[XB_TMO], 1u); break; } } } } while (0)
struct XcdBarrier { unsigned* bar; unsigned x; volatile LAS unsigned* st; };
__device__ __forceinline__ XcdBarrier xcd_barrier_post(unsigned* bar, volatile LAS unsigned* st) {
    XcdBarrier b; b.bar = bar; b.x = xb_xcc_id(); b.st = st;
    if (threadIdx.x == 0) (void)xb_add(&bar[XB_XCNT(b.x)], 1u);
    return b;
}
__device__ __forceinline__ void xcd_barrier_complete(unsigned* bar, unsigned x, unsigned& nloc, unsigned& nx) {
    const unsigned G = gridDim.x * gridDim.y * gridDim.z;
    unsigned sum, cnt, mine, sp = 0u;
    for (;;) {
        sum = 0u; cnt = 0u; mine = 0u;
#pragma unroll
        for (unsigned j = 0; j < 16; ++j) { const unsigned c = xb_ld(&bar[XB_XCNT(j)]); sum += c; cnt += (c > 0u) ? 1u : 0u; mine = (j == x) ? c : mine; }
        if (sum == G) break;
        __builtin_amdgcn_s_sleep(1);
        if ((++sp & 255u) == 0u) { if (xb_ld(&bar[XB_TMO])) break; if (sp > XB_SPIN_CAP) { atomicAdd(&bar[XB_TMO], 1u); break; } }
    }
    nloc = mine > 0u ? mine : 1u; nx = cnt > 0u ? cnt : 1u;
}
__device__ __forceinline__ void xcd_barrier(const XcdBarrier& b) {
    asm volatile("s_waitcnt vmcnt(0)" ::: "memory");
    __syncthreads();
    if (threadIdx.x == 0) {
        unsigned* bar = b.bar;
        __builtin_amdgcn_s_waitcnt(0);
        unsigned nloc = b.st[0], nx = b.st[1];
        if (nloc == 0u) { xcd_barrier_complete(bar, b.x, nloc, nx); b.st[0] = nloc; b.st[1] = nx; }
        const unsigned old = xb_add(&bar[XB_XSUB(b.x)], 1u);
        const unsigned gen = old / nloc;
        if (old + 1u == (gen + 1u) * nloc) {
            __builtin_amdgcn_fence(__ATOMIC_RELEASE, "agent");
            asm volatile("s_waitcnt vmcnt(0)" ::: "memory");
            const unsigned og = xb_add(&bar[XB_TOP], 1u);
            const unsigned tg = og / nx;
            if (og + 1u == (tg + 1u) * nx) xb_add(&bar[XB_TOPGEN], 1u);
            else XB_SPIN(xb_ld(&bar[XB_TOPGEN]) == tg, bar);
            __builtin_amdgcn_fence(__ATOMIC_ACQUIRE, "agent");
            xb_add(&bar[XB_XGEN(b.x)], 1u);
            asm volatile("s_waitcnt vmcnt(0)" ::: "memory");
        } else {
            XB_SPIN(xb_ld(&bar[XB_XGEN(b.x)]) == gen, bar);
            __builtin_amdgcn_fence(__ATOMIC_ACQUIRE, "agent");
            asm volatile("s_waitcnt vmcnt(0)" ::: "memory");
        }
    }
    __syncthreads();
}

constexpr int MX_RL = LB * RH * 2 * 4, MX_ML = LB * MH * 2 * ml::NVB, MX_RC = CB * RH * 2 * 4, MX_MC = CB * MH * 2 * ml::NVB;
constexpr int MX_ITEMS = MX_RL + MX_ML + MX_RC + MX_MC;

constexpr int ML_SPLIT = 0;
__device__ __forceinline__ void scan_phase(LAS unsigned char* lds, CParams& P, int l, unsigned* ctl) {
    unsigned* qhead = ctl + CW_Q + 64 * l;
    volatile LAS unsigned* bc = (volatile LAS unsigned*)(lds + LDS_MISC) + 16;
    for (;;) {
        if (threadIdx.x == 0) bc[0] = xb_add(qhead, 1u);
        __syncthreads();
        const int it = (int)bc[0];
        __syncthreads();
        if (it >= wy::N_LAT) break;
        int s_, head, dir; wy::decode_item(it, s_, head, dir);
        wy::rwkv_cons(lds, P, l, s_, head, dir, it, ctl);
    }
    for (;;) {
        if (threadIdx.x == 0) bc[0] = xb_add(qhead + 8, 1u);
        __syncthreads();
        const int it = (int)bc[0];
        __syncthreads();
        if (it >= ML_SPLIT * ms::N_MLAT) break;
        int s_, head, dir, sub; ml::decode_item(it * ml::NVB, s_, head, dir, sub);
        ms::ml_cons(lds, P, l, s_, head, dir, it, ctl);
    }
    for (;;) {
        if (threadIdx.x == 0) bc[0] = xb_add(qhead + 48, 1u);
        __syncthreads();
        const int it = (int)bc[0];
        __syncthreads();
        if (it >= wy::N_LAT * wy::NPROD) break;
        const int chain = it % wy::N_LAT;
        int s_, head, dir; wy::decode_item(chain, s_, head, dir);
        wy::rwkv_prod(lds, P, l, s_, head, dir, chain, it / wy::N_LAT, ctl);
    }
    for (;;) {
        if (threadIdx.x == 0) bc[0] = xb_add(qhead + 24, 1u);
        __syncthreads();
        const int it = (int)bc[0];
        __syncthreads();
        if (it >= ML_SPLIT * ms::N_MLAT * ms::MLPROD) break;
        const int chain = it % ms::N_MLAT;
        int s_, head, dir, sub; ml::decode_item(chain * ml::NVB, s_, head, dir, sub);
        ms::ml_prod(lds, P, l, s_, head, dir, chain, it / ms::N_MLAT, ctl);
    }
    for (;;) {
        if (threadIdx.x == 0) bc[0] = xb_add(qhead + 16, 1u);
        __syncthreads();
        const int it = (int)bc[0] + ML_SPLIT * ms::N_MLAT * ml::NVB;
        __syncthreads();
        if (it >= ml::N_ITEMS) break;
        int s_, head, dir, sub; ml::decode_item(it, s_, head, dir, sub);
        ml::mlstm_item(lds, P, l, s_, head, dir, sub);
    }
    for (;;) {
        if (threadIdx.x == 0) bc[0] = xb_add(qhead + 32, 1u);
        __syncthreads();
        const int it = (int)bc[0] + LB * RH * 2;
        __syncthreads();
        if (it >= wy::N_ITEMS) break;
        int s_, head, dir; wy::decode_item(it, s_, head, dir);
        wy::rwkv_item(lds, P, l, s_, head, dir);
    }
}

enum { ST_N0 = 0, ST_A1, ST_CV, ST_MX, ST_PO, ST_N1, ST_A2, ST_PJ, ST_WO, ST_N2, ST_F1, ST_F2, ST_PER_LAYER };
constexpr int N_STEPS = 1 + DEPTH * ST_PER_LAYER + 1;
struct MkArgs { Params P; int ph_lo, ph_hi; };
__global__ void __launch_bounds__(512, 2) mk(MkArgs a) {
    extern __shared__ __attribute__((aligned(16))) unsigned char lds_raw[];
    LAS unsigned char* lds = (LAS unsigned char*)lds_raw;
    const int G = gridDim.x, vb = (int)blockIdx.x;
    unsigned* ctl = (unsigned*)(a.P.ws + WS_CTL);
    volatile LAS unsigned* MISC = (volatile LAS unsigned*)(lds + LDS_MISC);
    for (int u = threadIdx.x; u < 64; u += 512) MISC[u] = 0u;
    __syncthreads();
    const bool multi = a.ph_hi - a.ph_lo > 1;
    XcdBarrier bar; bar.bar = ctl + CW_BAR; bar.x = 0; bar.st = nullptr;
    if (multi) bar = xcd_barrier_post(ctl + CW_BAR, MISC + 8);
    const int lo = a.ph_lo, hi = a.ph_hi;
#define STEP_BEGIN(id) if (lo <= (id) && (id) < hi) { unsigned long long kp_ = (unsigned long long)__builtin_amdgcn_kernarg_segment_ptr(); asm volatile("" : "+s"(kp_)); CParams& P = *(CParams*)kp_;
#define STEP_END(id) if ((id) + 1 < hi) xcd_barrier(bar); }
    STEP_BEGIN(0) el::init_phase(lds, P, vb, G); el::wconv_phase(lds, P, 0, vb, G); STEP_END(0)
#define LAYER(l) { \
        const int base = 1 + (l) * ST_PER_LAYER; \
        STEP_BEGIN(base + ST_N0) if ((l) > 0) el::wconv_phase(lds, P, (l), vb, G); el::norm_phase(P, (l), 0, vb, G); STEP_END(base + ST_N0) \
        STEP_BEGIN(base + ST_A1) { pg8::Gemm g{WSP(bf16, WS_QKC), WSP(bf16, O_WIN1), D, D}; pg8::StaticOrder S; S.init(NT, N1P, G, vb); \
            pg8::EpiA1 E{WSP(bf16, WS_U1)}; pg8::gemm_phase(lds, g, S, E); } STEP_END(base + ST_A1) \
        STEP_BEGIN(base + ST_CV) el::conv_phase(lds, P, (l), vb, G); STEP_END(base + ST_CV) \
        STEP_BEGIN(base + ST_MX) scan_phase(lds, P, (l), ctl); STEP_END(base + ST_MX) \
        STEP_BEGIN(base + ST_PO) el::post_phase(lds, P, (l), vb, G); STEP_END(base + ST_PO) \
        STEP_BEGIN(base + ST_N1) el::norm_phase(P, (l), 1, vb, G); STEP_END(base + ST_N1) \
        STEP_BEGIN(base + ST_A2) { pg8::Gemm g{WSP(bf16, WS_RXC), WSP(bf16, O_WIN2), D, D}; pg8::StaticOrder S; S.init(NT, 2 * D, G, vb); \
            pg8::EpiA2 E{WSP(bf16, WS_U1)}; pg8::gemm_phase(lds, g, S, E); } STEP_END(base + ST_A2) \
        STEP_BEGIN(base + ST_PJ) { pg8::Gemm g{WSP(bf16, WS_QKC), WSP(bf16, O_PM), MW, D}; pg8::PairOrder S; S.init(NT, G, vb); \
            pg8::EpiPJ E{WSP(bf16, WS_U1)}; pg8::gemm_phase(lds, g, S, E); } STEP_END(base + ST_PJ) \
        STEP_BEGIN(base + ST_WO) { pg8::Gemm g{WSP(bf16, WS_U1), WSP(bf16, O_WO), D, PU}; pg8::StaticOrder S; S.init(NT, D, G, vb); \
            pg8::EpiRes E{P.out, WSP(float, WS_MOD) + (size_t)(l) * NCOND * 6 * D + 2 * D}; pg8::gemm_phase(lds, g, S, E); } STEP_END(base + ST_WO) \
        STEP_BEGIN(base + ST_N2) el::norm_phase(P, (l), 2, vb, G); STEP_END(base + ST_N2) \
        STEP_BEGIN(base + ST_F1) { pg8::Gemm g{WSP(bf16, WS_QKC), WSP(bf16, O_W13), D, D}; pg8::StaticOrder S; S.init(NT, 2 * FF, G, vb); \
            pg8::EpiF1 E{WSP(bf16, WS_U1)}; pg8::gemm_phase(lds, g, S, E); } STEP_END(base + ST_F1) \
        STEP_BEGIN(base + ST_F2) { pg8::Gemm g{WSP(bf16, WS_U1), WSP(bf16, O_W2), FF, FF}; pg8::StaticOrder S; S.init(NT, D, G, vb); \
            pg8::EpiRes E{P.out, WSP(float, WS_MOD) + (size_t)(l) * NCOND * 6 * D + 5 * D}; pg8::gemm_phase(lds, g, S, E); } STEP_END(base + ST_F2) \
    }
    static_assert(DEPTH == 2, "layers are unrolled by hand");
    LAYER(0)
    LAYER(1)
#undef LAYER
    STEP_BEGIN(N_STEPS - 1) el::norm_phase(P, 0, 3, vb, G); STEP_END(N_STEPS - 1)
#undef STEP_BEGIN
#undef STEP_END
}
#endif

typedef void (*BodyFn)(const Params&, long);
#ifndef HOST_EMU
template <BodyFn F, int BLOCK> __global__ void __launch_bounds__(BLOCK) run_k(Params P, long n) {
    const long i = (long)blockIdx.x * BLOCK + threadIdx.x;
    if (i < n) F(P, i);
}
#define RUN(F, BLOCK, n) do { const long n_ = (n); run_k<F, BLOCK><<<dim3((unsigned)((n_ + BLOCK - 1) / BLOCK)), dim3(BLOCK), 0, stream>>>(P, n_); } while (0)
static int g_grid = 0;
#else
#define RUN(F, BLOCK, n) do { const long n_ = (n); for (long i_ = 0; i_ < n_; ++i_) F(P, i_); } while (0)
typedef void* hipStream_t;
#endif

static void forward(Params P, hipStream_t stream) {
    (void)stream;
#ifndef HOST_EMU
    if (hipMemsetAsync(P.ws + WS_CTL, 0, CTL_ZERO_BYTES, stream) != hipSuccess) return;
#ifdef MK_PER_STEP
    for (int st = 0; st < N_STEPS; ++st) { MkArgs a_{}; a_.P = P; a_.ph_lo = st; a_.ph_hi = st + 1; mk<<<dim3(g_grid), dim3(512), LDS_BYTES, stream>>>(a_); }
#else
    { MkArgs a_{}; a_.P = P; a_.ph_lo = 0; a_.ph_hi = N_STEPS; mk<<<dim3(g_grid), dim3(512), LDS_BYTES, stream>>>(a_); }
#endif
#else
    RUN(k_init_x, 256, (long)NT * D);
    RUN(k_mod, 256, (long)DEPTH * NCOND * 6 * D);
    for (int l = 0; l < DEPTH; ++l) {
        P.layer = l;
        RUN(k_wconv, 256, WC_N6);
        P.mode = 0; RUN(k_norm, 64, (long)NT);
        RUN(k_gemm_a1, 256, (long)NT * N1);
        RUN(k_conv, 256, (long)NT * (2 * MW + RIN));
        RUN(k_mlstm, 128, (long)NSEQ * MH * 2 * 128);
        for (int dir = 0; dir < 2; ++dir) { P.mode = dir; RUN(k_rwkv_prep, 256, (long)NT * RW); RUN(k_rwkv, 64, (long)NSEQ * RH * 64); }
        RUN(k_post, 256, (long)NT * D);
        P.mode = 1; RUN(k_norm, 64, (long)NT);
        RUN(k_gemm_a2, 256, (long)NT * 2 * D);
        RUN(k_gemm_pj, 256, (long)NT * D);
        RUN(k_gemm_wo, 256, (long)NT * D);
        P.mode = 2; RUN(k_norm, 64, (long)NT);
        RUN(k_gemm_f1, 256, (long)NT * FF);
        RUN(k_gemm_f2, 256, (long)NT * D);
    }
    RUN(k_final, 64, (long)NT);
#endif
}

#ifndef HOST_EMU
extern "C" void kernel_launch(void* const* d_in, const int* in_sizes, int n_in, void* d_out, int out_size, void* d_ws, size_t ws_size, hipStream_t stream) {
    if (n_in != N_IN || (size_t)out_size != OUT_END || ws_size < WS_END) return;
    if (g_grid == 0) {
        int dev = 0, cus = 0;
        if (hipGetDevice(&dev) != hipSuccess || hipDeviceGetAttribute(&cus, hipDeviceAttributeMultiprocessorCount, dev) != hipSuccess) { g_grid = -1; return; }
        if (hipFuncSetAttribute((const void*)mk, hipFuncAttributeMaxDynamicSharedMemorySize, LDS_BYTES) != hipSuccess) { g_grid = -1; return; }
        g_grid = cus;
    }
    if (g_grid < 0) return;
    Params P{};
    for (int i = 0; i < N_IN; ++i) P.in[i] = (const float*)d_in[i];
    P.out = (float*)d_out; P.ws = (unsigned char*)d_ws; P.layer = 0; P.mode = 0;
    forward(P, stream);
}
#endif
```

```cpp
#ifndef HOST_EMU
#include <hip/hip_runtime.h>
#define HD __host__ __device__ __forceinline__
#define DEV __device__ __forceinline__
#else
#include <cmath>
#include <cstring>
#include <cstdio>
#include <cstdlib>
#define HD inline
#define DEV inline
#endif
#include <cstddef>

#ifdef SMALL_CFG
constexpr int D = 256, CB = 2, CT = 128, DEPTH = 2, LB = 1, LT = 256, GW = 16;
#else
constexpr int D = 1024, CB = 32, CT = 256, DEPTH = 2, LB = 2, LT = 4096, GW = 64;
#endif
constexpr int MW = D / 2, MD = 128, MH = MW / MD, RW = D / 2, RD = 64, RH = RW / RD;
constexpr int RIN = 3 * RW + 384, FF = ((8 * D + 767) / 768) * 256, PIN = 2 * MW + MW + MW + 4 * MH + RIN + 2 * D;
constexpr int NC = CB * CT, NL = LB * LT, NT = NC + NL, NSEQ = CB + LB, NCOND = 1 + LB;
constexpr int N1 = PIN - 2 * D;
constexpr int N1P = ((N1 + 255) / 256) * 256;
constexpr int PU = N1;
constexpr int OFF_QK = 0, OFF_V = 2 * MW, OFF_O = 3 * MW, OFF_G = 4 * MW, OFF_R = 4 * MW + 4 * MH;
constexpr int RX_R = 0, RX_K = RW, RX_V = 2 * RW, RX_WL = 3 * RW, RX_AL = 3 * RW + 128, RX_GL = 3 * RW + 256;
constexpr float RMS_EPS = 1e-6f, GN_EPS = 64e-5f;
static_assert(3 * D <= N1, "G + merged must fit the dead columns of U1");

enum { X_PROMPT = 0, X_SAMPLE, ST_C, ST_N, ST_M, ST_R, C_LAT, C_CTX, ADA_W, ADA_B, NORM1, NORM2, W_IN, M_CONV, M_GATE_B, M_NORM_G,
       R_CONV, R_W0, R_W2, R_A0, R_A2, R_G2, R_KK, R_KA, R_RK, R_GN_W, R_GN_B, PROJ_M, PROJ_R, W_OUT, FFN_W1, FFN_W3, FFN_W2, FINAL_G, N_IN };

constexpr size_t OUT_X = 0;
constexpr size_t OUT_C = (size_t)NT * D;
constexpr size_t OUT_N = OUT_C + (size_t)CB * DEPTH * 2 * MH * 128 * 128;
constexpr size_t OUT_M = OUT_N + (size_t)CB * DEPTH * 2 * MH * 128;
constexpr size_t OUT_S = OUT_M + (size_t)CB * DEPTH * 2 * MH;
constexpr size_t OUT_END = OUT_S + (size_t)CB * DEPTH * 2 * RH * 64 * 64;

constexpr size_t al256(size_t x) { return (x + 255) & ~(size_t)255; }
constexpr size_t cmax(size_t a, size_t b) { return a > b ? a : b; }
constexpr size_t WS_CTL = 0;
constexpr size_t WS_MOD = (size_t)1 << 20;
constexpr size_t WS_WREG = (size_t)2 << 20;
constexpr size_t O_WIN1 = WS_WREG;
constexpr size_t O_WIN2 = O_WIN1 + (size_t)N1P * D * 2;
constexpr size_t O_PM = O_WIN2 + (size_t)2 * D * D * 2;
constexpr size_t O_PR = O_PM + (size_t)D * MW * 2;
constexpr size_t O_WO = O_PR + (size_t)D * RW * 2;
constexpr size_t O_W13 = O_WO + (size_t)D * D * 2;
constexpr size_t O_W2 = O_W13 + (size_t)2 * FF * D * 2;
constexpr size_t O_G2T = O_W2 + (size_t)D * FF * 2;
constexpr size_t O_W2T = O_G2T + (size_t)RW * 128 * 2;
constexpr size_t O_A2T = O_W2T + (size_t)2 * RW * 64 * 2;
constexpr size_t WS_U1 = al256(O_A2T + (size_t)2 * RW * 64 * 2);
constexpr size_t SZ_U1 = al256(cmax((size_t)NT * PU * 2, (size_t)NT * FF * 2));
constexpr size_t WS_QKC = WS_U1 + SZ_U1;
constexpr size_t WS_RXC = WS_QKC + (size_t)NT * D * 2;
constexpr size_t WS_END = WS_RXC + al256(cmax((size_t)NT * RIN * 2, (size_t)NT * D * 2));
#ifndef SMALL_CFG
static_assert(WS_END <= ((size_t)256 << 20), "workspace map must fit 256 MiB");
#endif

typedef unsigned short bf16;
HD float bf2f(bf16 b) { unsigned u = ((unsigned)b) << 16; return __builtin_bit_cast(float, u); }
#if defined(__HIP_DEVICE_COMPILE__)
HD bf16 f2bf(float f) { return __builtin_bit_cast(bf16, (__bf16)f); }
#else
HD bf16 f2bf(float f) { unsigned u = __builtin_bit_cast(unsigned, f); u += 0x7fffu + ((u >> 16) & 1u); return (bf16)(u >> 16); }
#endif
HD float sigmoidf_(float x) { return 1.0f / (1.0f + expf(-x)); }
HD float siluf_(float x) { return x / (1.0f + expf(-x)); }
HD float softplusf_(float x) { return fmaxf(x, 0.f) + log1pf(expf(-fabsf(x))); }
HD float logsigmoidf_(float x) { return -softplusf_(-x); }
HD int prow(int c) { return (c & ~31) | (((c >> 2) & 1) << 4) | (((c >> 3) & 3) << 2) | (c & 3); }

struct Params {
    const float* in[N_IN];
    float* out;
    unsigned char* ws;
    int layer;
    int mode;
};

struct SeqInfo { int T; int base; int grid; int cond; int b; };
HD SeqInfo seqinfo(int s) {
    SeqInfo q;
    if (s < CB) { q.T = CT; q.base = s * CT; q.grid = 0; q.cond = 0; q.b = s; }
    else { q.T = LT; q.base = NC + (s - CB) * LT; q.grid = 1; q.cond = 1 + (s - CB); q.b = s - CB; }
    return q;
}
HD int seq_of_token(int m) { return m < NC ? m / CT : CB + (m - NC) / LT; }

#define WSP(T, off) ((T*)(P.ws + (off)))

DEV void k_init_x(const Params& P, long i) {
    const size_t ncd = (size_t)NC * D;
    P.out[i] = (size_t)i < ncd ? P.in[X_PROMPT][i] : P.in[X_SAMPLE][i - ncd];
}
DEV void k_mod(const Params& P, long i) {
    const int j = (int)(i % (6 * D)); const int ci = (int)((i / (6 * D)) % NCOND); const int l = (int)(i / ((long)6 * D * NCOND));
    const float* cv = ci == 0 ? P.in[C_CTX] : P.in[C_LAT] + (size_t)(ci - 1) * D;
    const float* w = P.in[ADA_W] + (size_t)l * D * 6 * D;
    float acc = P.in[ADA_B][(size_t)l * 6 * D + j];
    for (int k = 0; k < D; ++k) acc += siluf_(cv[k]) * w[(size_t)k * 6 * D + j];
    WSP(float, WS_MOD)[i] = acc;
}
constexpr long WC_N0 = (long)N1P * D, WC_N1 = WC_N0 + (long)2 * D * D, WC_N2 = WC_N1 + (long)D * MW, WC_N3 = WC_N2 + (long)D * RW,
               WC_N4 = WC_N3 + (long)D * D, WC_N5 = WC_N4 + (long)2 * FF * D, WC_N6 = WC_N5 + (long)D * FF;
HD int unprow(int r) { return (r & ~31) | (((r >> 2) & 3) << 3) | (((r >> 4) & 1) << 2) | (r & 3); }
DEV void k_wconv(const Params& P, long i) {
    const int l = P.layer;
    if (i < WC_N0) { const int r = (int)(i / D), k = (int)(i % D); const int c = unprow(r);
        WSP(bf16, O_WIN1)[i] = c < N1 ? f2bf(P.in[W_IN][((size_t)l * D + k) * PIN + c]) : (bf16)0; return; }
    if (i < WC_N1) { const long j = i - WC_N0; const int r = (int)(j / D), k = (int)(j % D); const int c = unprow(r);
        WSP(bf16, O_WIN2)[j] = f2bf(P.in[W_IN][((size_t)l * D + k) * PIN + N1 + c]); return; }
    if (i < WC_N2) { const long j = i - WC_N1; const int r = (int)(j / MW), k = (int)(j % MW); const int c = unprow(r);
        WSP(bf16, O_PM)[j] = f2bf(P.in[PROJ_M][((size_t)l * MW + k) * D + c]); return; }
    if (i < WC_N3) { const long j = i - WC_N2; const int r = (int)(j / RW), k = (int)(j % RW); const int c = unprow(r);
        WSP(bf16, O_PR)[j] = f2bf(P.in[PROJ_R][((size_t)l * RW + k) * D + c]); return; }
    if (i < WC_N4) { const long j = i - WC_N3; const int r = (int)(j / D), k = (int)(j % D);
        WSP(bf16, O_WO)[j] = f2bf(P.in[W_OUT][((size_t)l * D + k) * D + r]); return; }
    if (i < WC_N5) { const long j = i - WC_N4; const int r = (int)(j / D), k = (int)(j % D);
        const int pn = r >> 8, rl = r & 255, which = rl >> 7, rho = rl & 127; const int jj = pn * 128 + unprow(rho);
        const float* W = which ? P.in[FFN_W3] : P.in[FFN_W1];
        WSP(bf16, O_W13)[j] = f2bf(W[((size_t)l * D + k) * FF + jj]); return; }
    { const long j = i - WC_N5; const int r = (int)(j / FF), k = (int)(j % FF);
        WSP(bf16, O_W2)[j] = f2bf(P.in[FFN_W2][((size_t)l * FF + k) * D + r]); }
}
DEV void k_norm(const Params& P, long m) {
    const int l = P.layer; const int second = (P.mode == 2);
    const float* x = P.out + (size_t)m * D;
    const float* g = P.in[second ? NORM2 : NORM1] + (size_t)l * D;
    const int cond = seqinfo(seq_of_token((int)m)).cond;
    const float* mod = WSP(float, WS_MOD) + ((size_t)l * NCOND + cond) * 6 * D + (second ? 3 * D : 0);
    float ss = 0.f;
    for (int k = 0; k < D; ++k) ss += x[k] * x[k];
    const float rs = 1.0f / sqrtf(ss / D + RMS_EPS);
    bf16* o = WSP(bf16, P.mode == 1 ? WS_RXC : WS_QKC) + (size_t)m * D;
    for (int k = 0; k < D; ++k) o[k] = f2bf(x[k] * rs * g[k] * (1.0f + mod[D + k]) + mod[k]);
}
DEV float dot_bf(const bf16* a, const bf16* b, int K) { float s = 0.f; for (int k = 0; k < K; ++k) s += bf2f(a[k]) * bf2f(b[k]); return s; }
DEV void k_gemm_a1(const Params& P, long i) {
    const int n = (int)(i % N1); const long m = i / N1;
    WSP(bf16, WS_U1)[(size_t)m * PU + n] = f2bf(dot_bf(WSP(bf16, WS_QKC) + (size_t)m * D, WSP(bf16, O_WIN1) + (size_t)prow(n) * D, D));
}
DEV void k_gemm_a2(const Params& P, long i) {
    const int n = (int)(i % (2 * D)); const long m = i / (2 * D);
    WSP(bf16, WS_U1)[(size_t)m * PU + D + n] = f2bf(sigmoidf_(dot_bf(WSP(bf16, WS_RXC) + (size_t)m * D, WSP(bf16, O_WIN2) + (size_t)prow(n) * D, D)));
}
DEV void k_gemm_pj(const Params& P, long i) {
    const int n = (int)(i % D); const long m = i / D;
    const bf16* hmr = WSP(bf16, WS_QKC) + (size_t)m * D; bf16* u = WSP(bf16, WS_U1) + (size_t)m * PU;
    const float a = dot_bf(hmr, WSP(bf16, O_PM) + (size_t)prow(n) * MW, MW), b = dot_bf(hmr + MW, WSP(bf16, O_PR) + (size_t)prow(n) * RW, RW);
    const float first = bf2f(f2bf(bf2f(u[D + n]) * a));
    u[n] = f2bf(first + bf2f(u[2 * D + n]) * b);
}
DEV void k_gemm_wo(const Params& P, long i) {
    const int n = (int)(i % D); const long m = i / D; const int l = P.layer;
    const int cond = seqinfo(seq_of_token((int)m)).cond;
    const float g1 = WSP(float, WS_MOD)[((size_t)l * NCOND + cond) * 6 * D + 2 * D + n];
    P.out[(size_t)m * D + n] += g1 * dot_bf(WSP(bf16, WS_U1) + (size_t)m * PU, WSP(bf16, O_WO) + (size_t)n * D, D);
}
DEV void k_gemm_f1(const Params& P, long i) {
    const int j = (int)(i % FF); const long m = i / FF;
    const int pn = j >> 7, rho = prow(j & 127);
    const bf16* h = WSP(bf16, WS_QKC) + (size_t)m * D;
    const float a = dot_bf(h, WSP(bf16, O_W13) + (size_t)(pn * 256 + rho) * D, D), b = dot_bf(h, WSP(bf16, O_W13) + (size_t)(pn * 256 + 128 + rho) * D, D);
    WSP(bf16, WS_U1)[(size_t)m * FF + j] = f2bf(siluf_(a) * b);
}
DEV void k_gemm_f2(const Params& P, long i) {
    const int n = (int)(i % D); const long m = i / D; const int l = P.layer;
    const int cond = seqinfo(seq_of_token((int)m)).cond;
    const float g2 = WSP(float, WS_MOD)[((size_t)l * NCOND + cond) * 6 * D + 5 * D + n];
    P.out[(size_t)m * D + n] += g2 * dot_bf(WSP(bf16, WS_U1) + (size_t)m * FF, WSP(bf16, O_W2) + (size_t)n * FF, FF);
}
DEV void k_conv(const Params& P, long i) {
    constexpr int NCH = 2 * MW + RIN;
    const int ch = (int)(i % NCH); const int m = (int)(i / NCH); const int l = P.layer;
    const int s = seq_of_token(m); const SeqInfo q = seqinfo(s); const int t = m - q.base;
    const bool isqk = ch < 2 * MW; const int c = isqk ? ch : ch - 2 * MW;
    const int ucol = isqk ? OFF_QK + c : OFF_R + c;
    const int CH = isqk ? 2 * MW : RIN;
    const float* w = (isqk ? P.in[M_CONV] : P.in[R_CONV]) + (size_t)l * 9 * CH;
    const bf16* U = WSP(bf16, WS_U1);
    float acc = 0.f;
    if (q.grid) {
        const int r = t / GW, cc = t % GW, rows = q.T / GW;
        for (int a = 0; a < 3; ++a) for (int b = 0; b < 3; ++b) {
            const int rr = r + a - 1, c2 = cc + b - 1;
            if (rr >= 0 && rr < rows && c2 >= 0 && c2 < GW) acc += w[(a * 3 + b) * CH + c] * bf2f(U[(size_t)(q.base + rr * GW + c2) * PU + ucol]);
        }
    } else {
        for (int b = 0; b < 3; ++b) { const int t2 = t + b - 1; if (t2 >= 0 && t2 < q.T) acc += w[(3 + b) * CH + c] * bf2f(U[(size_t)(q.base + t2) * PU + ucol]); }
    }
    if (isqk) { float v = siluf_(acc); if (c < MW) v *= 0.08838834764831845f; WSP(bf16, WS_QKC)[(size_t)m * (2 * MW) + c] = f2bf(v); }
    else { float v = acc; if (c >= RX_WL && c < RX_AL) v = tanhf(v); else if (c >= RX_GL) v = sigmoidf_(v); WSP(bf16, WS_RXC)[(size_t)m * RIN + c] = f2bf(v); }
}
DEV void k_mlstm(const Params& P, long i) {
    const int e = (int)(i % 128); const int chain = (int)(i / 128); const int dir = chain & 1, head = (chain >> 1) % MH, s = chain / (2 * MH);
    const int l = P.layer; const SeqInfo q = seqinfo(s);
    float C[128], n[128]; float m;
    if (!q.grid) {
#pragma unroll
        for (int d = 0; d < 128; ++d) { C[d] = 0.f; n[d] = 0.f; }
        m = 0.f;
    } else {
        const size_t sb = (((size_t)q.b * DEPTH + l) * 2 + dir) * MH + head;
#pragma unroll
        for (int d = 0; d < 128; ++d) { C[d] = P.in[ST_C][(sb * 128 + d) * 128 + e]; n[d] = P.in[ST_N][sb * 128 + d]; }
        m = P.in[ST_M][sb];
    }
    const float bi = P.in[M_GATE_B][(size_t)l * 4 * MH + (2 * dir) * MH + head], bfg = P.in[M_GATE_B][(size_t)l * 4 * MH + (2 * dir + 1) * MH + head];
    bf16* U = WSP(bf16, WS_U1); const bf16* QK = WSP(bf16, WS_QKC);
    float nsel = 0.f;
    for (int p = 0; p < q.T; ++p) {
        const int t = dir ? q.T - 1 - p : p; const size_t tok = (size_t)(q.base + t);
        const bf16* qk = QK + tok * (2 * MW); bf16* u = U + tok * PU;
        const float gi = bf2f(u[OFF_G + (2 * dir) * MH + head]) + bi, gf = bf2f(u[OFF_G + (2 * dir + 1) * MH + head]) + bfg;
        const float lf = logsigmoidf_(gf);
        const float mn = fmaxf(lf + m, gi); const float fw = expf(lf + m - mn), iw = expf(gi - mn);
        const float v = bf2f(u[OFF_V + head * 128 + e]);
        float num = 0.f, den = 0.f;
#pragma unroll
        for (int d = 0; d < 128; ++d) {
            const float kd = bf2f(qk[MW + head * 128 + d]), qd = bf2f(qk[head * 128 + d]);
            C[d] = fw * C[d] + iw * kd * v; n[d] = fw * n[d] + iw * kd; num += qd * C[d]; den += qd * n[d];
        }
        m = mn;
        u[dir * MW + head * 128 + e] = f2bf(num / fmaxf(fabsf(den), expf(-m)));
    }
    if (!q.grid) {
        const size_t sb = (((size_t)q.b * DEPTH + l) * 2 + dir) * MH + head;
#pragma unroll
        for (int d = 0; d < 128; ++d) { P.out[OUT_C + (sb * 128 + d) * 128 + e] = C[d]; if (d == e) nsel = n[d]; }
        P.out[OUT_N + sb * 128 + e] = nsel;
        if (e == 0) P.out[OUT_M + sb] = m;
    }
}
DEV void k_rwkv_prep(const Params& P, long i) {
    const int c = (int)(i % RW); const size_t tok = (size_t)(i / RW); const int l = P.layer, dir = P.mode;
    const bf16* rx = WSP(bf16, WS_RXC) + tok * RIN;
    const float* w2 = P.in[R_W2] + ((size_t)l * 2 + dir) * 64 * RW + c; const float* a2 = P.in[R_A2] + ((size_t)l * 2 + dir) * 64 * RW + c;
    float wr = P.in[R_W0][((size_t)l * 2 + dir) * RW + c], ar = P.in[R_A0][((size_t)l * 2 + dir) * RW + c];
    for (int j = 0; j < 64; ++j) { wr += bf2f(rx[RX_WL + dir * 64 + j]) * w2[(size_t)j * RW]; ar += bf2f(rx[RX_AL + dir * 64 + j]) * a2[(size_t)j * RW]; }
    bf16* o = WSP(bf16, WS_QKC) + tok * (2 * RW);
    o[c] = f2bf(wr); o[RW + c] = f2bf(ar);
}
DEV void k_rwkv(const Params& P, long i) {
    const int row = (int)(i % 64); const int chain = (int)(i / 64); const int dir = P.mode, head = chain % RH, s = chain / RH;
    const int l = P.layer; const SeqInfo q = seqinfo(s); const int hc = head * 64;
    float S[64];
    if (!q.grid) {
#pragma unroll
        for (int c = 0; c < 64; ++c) S[c] = 0.f;
    } else {
        const size_t sb = (((size_t)q.b * DEPTH + l) * 2 + dir) * RH + head;
#pragma unroll
        for (int c = 0; c < 64; ++c) S[c] = P.in[ST_R][(sb * 64 + row) * 64 + c];
    }
    const float* rkk = P.in[R_KK] + (size_t)l * RW + hc; const float* rka = P.in[R_KA] + (size_t)l * RW + hc;
    bf16* U = WSP(bf16, WS_U1); const bf16* RX = WSP(bf16, WS_RXC); const bf16* WA = WSP(bf16, WS_QKC);
    for (int p = 0; p < q.T; ++p) {
        const int t = dir ? q.T - 1 - p : p; const size_t tok = (size_t)(q.base + t);
        const bf16* rx = RX + tok * RIN; const bf16* wa = WA + tok * (2 * RW);
        float ss = 0.f;
        for (int c = 0; c < 64; ++c) { const float kc = bf2f(rx[RX_K + hc + c]) * rkk[c]; ss += kc * kc; }
        const float inv = 1.0f / fmaxf(sqrtf(ss), 1e-12f);
        float sa = 0.f;
#pragma unroll
        for (int c = 0; c < 64; ++c) sa -= S[c] * (bf2f(rx[RX_K + hc + c]) * rkk[c] * inv);
        const float v = bf2f(rx[RX_V + hc + row]);
        float y = 0.f;
#pragma unroll
        for (int c = 0; c < 64; ++c) {
            const float wr = bf2f(wa[hc + c]), ar = bf2f(wa[RW + hc + c]);
            const float decay = expf(-0.6065306597126334f * sigmoidf_(wr));
            const float alpha = sigmoidf_(ar);
            const float kr = bf2f(rx[RX_K + hc + c]);
            const float kt = kr * (1.0f + (alpha - 1.0f) * rka[c]);
            const float bb = kr * rkk[c] * inv * alpha;
            S[c] = S[c] * decay + sa * bb + v * kt;
            y += S[c] * bf2f(rx[RX_R + hc + c]);
        }
        U[tok * PU + OFF_R + dir * RW + hc + row] = f2bf(y);
    }
    if (!q.grid) {
        const size_t sb = (((size_t)q.b * DEPTH + l) * 2 + dir) * RH + head;
#pragma unroll
        for (int c = 0; c < 64; ++c) P.out[OUT_S + (sb * 64 + row) * 64 + c] = S[c];
    }
}
DEV void k_post(const Params& P, long i) {
    const int ch = (int)(i % D); const size_t m = (size_t)(i / D); const int l = P.layer;
    const bf16* u = WSP(bf16, WS_U1) + m * PU; const bf16* rx = WSP(bf16, WS_RXC) + m * RIN;
    bf16* o = WSP(bf16, WS_QKC) + m * D;
    if (ch < MW) {
        const int h0 = (ch / 128) * 128; float ss = 0.f;
        for (int d = 0; d < 128; ++d) { const float x = bf2f(u[h0 + d]) + bf2f(u[MW + h0 + d]); ss += x * x; }
        const float x = bf2f(u[ch]) + bf2f(u[MW + ch]);
        o[ch] = f2bf(x / sqrtf(ss / 128.f + RMS_EPS) * P.in[M_NORM_G][(size_t)l * MW + ch] * sigmoidf_(bf2f(u[OFF_O + ch])));
    } else {
        const int c = ch - MW; const int h0 = (c / 64) * 64;
        float mu = 0.f, bsum = 0.f;
        for (int d = 0; d < 64; ++d) { mu += bf2f(u[OFF_R + h0 + d]) + bf2f(u[OFF_R + RW + h0 + d]);
            bsum += bf2f(rx[RX_R + h0 + d]) * bf2f(rx[RX_K + h0 + d]) * P.in[R_RK][(size_t)l * RW + h0 + d]; }
        mu *= (1.0f / 64.f); float var = 0.f;
        for (int d = 0; d < 64; ++d) { const float x = bf2f(u[OFF_R + h0 + d]) + bf2f(u[OFF_R + RW + h0 + d]) - mu; var += x * x; }
        var *= (1.0f / 64.f);
        const float y = bf2f(u[OFF_R + c]) + bf2f(u[OFF_R + RW + c]);
        const float yn = (y - mu) / sqrtf(var + GN_EPS) * P.in[R_GN_W][(size_t)l * RW + c] + P.in[R_GN_B][(size_t)l * RW + c];
        float gate = 0.f;
        for (int j = 0; j < 128; ++j) gate += bf2f(rx[RX_GL + j]) * P.in[R_G2][((size_t)l * 128 + j) * RW + c];
        o[ch] = f2bf((yn + bsum * bf2f(rx[RX_V + c])) * gate);
    }
}
DEV void k_final(const Params& P, long m) {
    float* x = P.out + (size_t)m * D; float ss = 0.f;
    for (int k = 0; k < D; ++k) ss += x[k] * x[k];
    const float rs = 1.0f / sqrtf(ss / D + RMS_EPS);
    for (int k = 0; k < D; ++k) x[k] = x[k] * rs * P.in[FINAL_G][k];
}


#ifndef HOST_EMU
typedef const __attribute__((address_space(4))) Params CParams;
namespace pg8 {
#define PG8_LAS __attribute__((address_space(3)))
typedef short bf16x8 __attribute__((ext_vector_type(8)));
typedef float f32x4 __attribute__((ext_vector_type(4)));
typedef unsigned u32x4 __attribute__((ext_vector_type(4)));
constexpr int BM = 256, BK = 64, HALF = 128, HTB = HALF * BK * 2, STAGE_BYTES = 8 * HTB, NXCD = 8, WGM = 8;
__device__ __forceinline__ int lds_byte(int r, int c) { const int st = (r >> 4) * 2 + (c >> 5), rr = r & 15, cc = c & 31, ob = rr * 64 + cc * 2; return st * 1024 + (ob ^ (((ob >> 9) & 1) << 5)); }
__device__ __forceinline__ void stage_rc(int b, int& R, int& C) { const int st = b / 1024, sb = b % 1024, swz = sb ^ (((sb >> 9) & 1) << 5); R = (st >> 1) * 16 + swz / 64; C = (st & 1) * 32 + (swz % 64) / 2; }
struct Unit { int pm, pn, aoff; };
struct Gemm { const bf16* A; const bf16* Bt; int K, lda; };
struct StaticOrder {
    int nM, nN, nwg, G, c;
    __device__ __forceinline__ void init(int M, int N, int G_, int c_) { nM = M / BM; nN = N / BM; nwg = nM * nN; G = G_; c = c_; }
    __device__ __forceinline__ bool next(int i, Unit& u) const {
        const long L = (long)i * G + c; if (L >= nwg) return false;
        int wgid = (int)L; { const int q = nwg / NXCD, r = nwg % NXCD, xcd = wgid % NXCD, off = wgid / NXCD; wgid = (xcd < r ? xcd * (q + 1) : r * (q + 1) + (xcd - r) * q) + off; }
        const int nig = WGM * nN, gid = wgid / nig, fm = gid * WGM, gsz = (nM - fm) < WGM ? (nM - fm) : WGM;
        u.pm = fm + ((wgid % nig) % gsz); u.pn = (wgid % nig) / gsz; u.aoff = 0; return true;
    }
};
struct PairOrder {
    int nbase, G, v, nct;
    __device__ __forceinline__ void init(int M, int G_, int c_) { nct = D / BM; nbase = (M / BM) * nct; G = G_; v = (G_ % 8 == 0) ? (c_ % 8) * (G_ / 8) + c_ / 8 : c_; }
    __device__ __forceinline__ bool next(int i, Unit& u) const {
        const int j = v + (i >> 1) * G; if (j >= nbase) return false;
        const int half = i & 1; u.pm = j / nct; u.pn = half * nct + (j % nct); u.aoff = half * MW; return true;
    }
};
typedef float f32x2_t __attribute__((ext_vector_type(2)));
typedef __bf16 bf16x2_t __attribute__((ext_vector_type(2)));
__device__ __forceinline__ unsigned cvt_pk_bf16(float lo, float hi) { f32x2_t v = {lo, hi}; bf16x2_t b = __builtin_convertvector(v, bf16x2_t); return __builtin_bit_cast(unsigned, b); }
__device__ __forceinline__ float fsigmoid(float x) { return __builtin_amdgcn_rcpf(1.0f + __expf(-x)); }
__device__ __forceinline__ float bflo(unsigned w) { return __builtin_bit_cast(float, w << 16); }
__device__ __forceinline__ float bfhi(unsigned w) { return __builtin_bit_cast(float, w & 0xffff0000u); }

struct EpiA1 {
    bf16* U;
    __device__ __forceinline__ void operator()(const f32x4 (&acc)[2][2][4][2], const Unit& u, int wr, int wc, int fr, int fq) const {
        const int row0 = u.pm * BM + wr * 64 + fr, col0 = u.pn * BM + wc * 32 + 8 * fq;
#pragma unroll
        for (int ai = 0; ai < 2; ++ai)
#pragma unroll
            for (int m = 0; m < 4; ++m) { bf16* rowp = U + (size_t)(row0 + ai * HALF + m * 16) * PU + col0;
#pragma unroll
                for (int bj = 0; bj < 2; ++bj) { if (col0 + bj * HALF < N1) { const f32x4 v0 = acc[ai][bj][m][0], v1 = acc[ai][bj][m][1];
                    u32x4 w; w.x = cvt_pk_bf16(v0[0], v0[1]); w.y = cvt_pk_bf16(v0[2], v0[3]); w.z = cvt_pk_bf16(v1[0], v1[1]); w.w = cvt_pk_bf16(v1[2], v1[3]);
                    *(u32x4*)(rowp + bj * HALF) = w; } } }
    }
};
struct EpiA2 {
    bf16* U;
    __device__ __forceinline__ void operator()(const f32x4 (&acc)[2][2][4][2], const Unit& u, int wr, int wc, int fr, int fq) const {
        const int row0 = u.pm * BM + wr * 64 + fr, col0 = D + u.pn * BM + wc * 32 + 8 * fq;
#pragma unroll
        for (int ai = 0; ai < 2; ++ai)
#pragma unroll
            for (int m = 0; m < 4; ++m) { bf16* rowp = U + (size_t)(row0 + ai * HALF + m * 16) * PU + col0;
#pragma unroll
                for (int bj = 0; bj < 2; ++bj) { const f32x4 v0 = acc[ai][bj][m][0], v1 = acc[ai][bj][m][1];
                    u32x4 w; w.x = cvt_pk_bf16(fsigmoid(v0[0]), fsigmoid(v0[1])); w.y = cvt_pk_bf16(fsigmoid(v0[2]), fsigmoid(v0[3]));
                    w.z = cvt_pk_bf16(fsigmoid(v1[0]), fsigmoid(v1[1])); w.w = cvt_pk_bf16(fsigmoid(v1[2]), fsigmoid(v1[3]));
                    *(u32x4*)(rowp + bj * HALF) = w; } }
    }
};
struct EpiPJ {
    bf16* U;
    __device__ __forceinline__ void operator()(const f32x4 (&acc)[2][2][4][2], const Unit& u, int wr, int wc, int fr, int fq) const {
        const int nct = D / BM, half = u.pn >= nct ? 1 : 0, ct = u.pn - half * nct;
        const int row0 = u.pm * BM + wr * 64 + fr, col0 = ct * BM + wc * 32 + 8 * fq;
#pragma unroll
        for (int ai = 0; ai < 2; ++ai)
#pragma unroll
            for (int m = 0; m < 4; ++m) { bf16* rowp = U + (size_t)(row0 + ai * HALF + m * 16) * PU + col0;
#pragma unroll
                for (int bj = 0; bj < 2; ++bj) { const f32x4 v0 = acc[ai][bj][m][0], v1 = acc[ai][bj][m][1];
                    const u32x4 g = *(const u32x4*)(rowp + (1 + half) * D + bj * HALF);
                    float o[8] = { bflo(g.x) * v0[0], bfhi(g.x) * v0[1], bflo(g.y) * v0[2], bfhi(g.y) * v0[3], bflo(g.z) * v1[0], bfhi(g.z) * v1[1], bflo(g.w) * v1[2], bfhi(g.w) * v1[3] };
                    if (half) { const u32x4 p = *(const u32x4*)(rowp + bj * HALF);
                        o[0] += bflo(p.x); o[1] += bfhi(p.x); o[2] += bflo(p.y); o[3] += bfhi(p.y); o[4] += bflo(p.z); o[5] += bfhi(p.z); o[6] += bflo(p.w); o[7] += bfhi(p.w); }
                    u32x4 w; w.x = cvt_pk_bf16(o[0], o[1]); w.y = cvt_pk_bf16(o[2], o[3]); w.z = cvt_pk_bf16(o[4], o[5]); w.w = cvt_pk_bf16(o[6], o[7]);
                    *(u32x4*)(rowp + bj * HALF) = w; }
                asm volatile("" ::: "memory"); }
    }
};
struct EpiRes {
    float* X; const float* gate;
    __device__ __forceinline__ void operator()(const f32x4 (&acc)[2][2][4][2], const Unit& u, int wr, int wc, int fr, int fq) const {
        const int row0 = u.pm * BM + wr * 64 + fr, col0 = u.pn * BM + wc * 32 + 4 * fq;
        const int cond = seqinfo(seq_of_token(u.pm * BM)).cond;
        const float* gp = gate + (size_t)cond * 6 * D + col0;
        f32x4 gv[2][2];
#pragma unroll
        for (int bj = 0; bj < 2; ++bj)
#pragma unroll
            for (int n = 0; n < 2; ++n) gv[bj][n] = *(const f32x4*)(gp + bj * HALF + n * 16);
#pragma unroll
        for (int ai = 0; ai < 2; ++ai)
#pragma unroll
            for (int m = 0; m < 4; ++m) { float* rowp = X + (size_t)(row0 + ai * HALF + m * 16) * D + col0;
#pragma unroll
                for (int bj = 0; bj < 2; ++bj)
#pragma unroll
                    for (int n = 0; n < 2; ++n) { f32x4* p = (f32x4*)(rowp + bj * HALF + n * 16); *p = *p + gv[bj][n] * acc[ai][bj][m][n]; }
                asm volatile("" ::: "memory"); }
    }
};
struct EpiF1 {
    bf16* Hd;
    __device__ __forceinline__ void operator()(const f32x4 (&acc)[2][2][4][2], const Unit& u, int wr, int wc, int fr, int fq) const {
        const int row0 = u.pm * BM + wr * 64 + fr, col0 = u.pn * HALF + wc * 32 + 8 * fq;
#pragma unroll
        for (int ai = 0; ai < 2; ++ai)
#pragma unroll
            for (int m = 0; m < 4; ++m) { bf16* rowp = Hd + (size_t)(row0 + ai * HALF + m * 16) * FF + col0;
                float o[8];
#pragma unroll
                for (int n = 0; n < 2; ++n)
#pragma unroll
                    for (int e = 0; e < 4; ++e) { const float a = acc[ai][0][m][n][e], b = acc[ai][1][m][n][e]; o[n * 4 + e] = a * fsigmoid(a) * b; }
                u32x4 w; w.x = cvt_pk_bf16(o[0], o[1]); w.y = cvt_pk_bf16(o[2], o[3]); w.z = cvt_pk_bf16(o[4], o[5]); w.w = cvt_pk_bf16(o[6], o[7]);
                *(u32x4*)rowp = w; }
    }
};

template <class Epi, class Sched, bool ALIGN_EPI = true, bool SP2 = true>
__device__ __forceinline__ void gemm_phase(PG8_LAS unsigned char* lds, const Gemm g, const Sched& S, const Epi& E) {
    const int tid = threadIdx.x, wid = __builtin_amdgcn_readfirstlane(tid >> 6), lane = tid & 63, wr = wid >> 2, wc = wid & 3, fr = lane & 15, fq = lane >> 4;
    const int K = g.K, nt = K / BK;
    unsigned voffA[2], voffB[2];
#pragma unroll
    for (int i = 0; i < 2; ++i) { int R, C; stage_rc(tid * 16 + i * 8192, R, C);
        voffA[i] = (unsigned)(R * g.lda + C) * 2u; voffB[i] = (unsigned)(R * K + C) * 2u; }
    const size_t kstep = (size_t)(BK * 2);
    const size_t hstepA = (size_t)HALF * g.lda * 2, hstepB = (size_t)HALF * K * 2;
    const size_t tstepA = 2 * hstepA, tstepB = 2 * hstepB;
    const unsigned ldsw = (unsigned)wid * 1024u;
    const int aoff = lds_byte(wr * 64 + fr, fq * 8), boff = lds_byte(wc * 32 + fr, fq * 8);
#define PG8_SA(b, h) (((b) * 2 + (h)) * HTB)
#define PG8_SB(b, h) ((4 + (b) * 2 + (h)) * HTB)
#define PG8_STAGE(bufoff, gbase, voff) do { _Pragma("unroll") for (int _i = 0; _i < 2; ++_i) \
        __builtin_amdgcn_global_load_lds((const unsigned*)((const char*)(gbase) + (voff)[_i]), (PG8_LAS unsigned*)(lds + (bufoff) + ldsw + _i * 8192), 16, 0, 0); } while (0)
#define PG8_LDA(dst, b, h) do { _Pragma("unroll") for (int m = 0; m < 4; ++m) _Pragma("unroll") for (int k = 0; k < 2; ++k) dst[m][k] = *(const PG8_LAS bf16x8*)(lds + PG8_SA(b, h) + aoff + m * 2048 + k * 1024); } while (0)
#define PG8_LDB(dst, b, h) do { _Pragma("unroll") for (int n = 0; n < 2; ++n) _Pragma("unroll") for (int k = 0; k < 2; ++k) dst[n][k] = *(const PG8_LAS bf16x8*)(lds + PG8_SB(b, h) + boff + n * 2048 + k * 1024); } while (0)
#define PG8_MMA(ai, bj, At, Bt) do { __builtin_amdgcn_s_setprio(1); _Pragma("unroll") for (int m = 0; m < 4; ++m) _Pragma("unroll") for (int n = 0; n < 2; ++n) _Pragma("unroll") for (int k = 0; k < 2; ++k) \
        acc[ai][bj][m][n] = __builtin_amdgcn_mfma_f32_16x16x32_bf16(Bt[n][k], At[m][k], acc[ai][bj][m][n], 0, 0, 0); __builtin_amdgcn_s_setprio(0); } while (0)
#define PG8_WAIT_V(n) asm volatile("s_waitcnt vmcnt(" #n ")" ::: "memory")
#define PG8_WAIT_L(n) asm volatile("s_waitcnt lgkmcnt(" #n ")" ::: "memory")
#define PG8_BAR __builtin_amdgcn_s_barrier()
#define PG8_SCHED __builtin_amdgcn_sched_barrier(0)
    Unit cur, nxt; int ui = 0;
    if (!S.next(0, cur)) return;
    f32x4 acc[2][2][4][2];
#pragma unroll
    for (int a = 0; a < 2; ++a)
#pragma unroll
        for (int b = 0; b < 2; ++b)
#pragma unroll
            for (int m = 0; m < 4; ++m)
#pragma unroll
                for (int n = 0; n < 2; ++n) acc[a][b][m][n] = (f32x4){0.f, 0.f, 0.f, 0.f};
    bf16x8 At[4][2], B0[2][2], B1[2][2];
    const char* cA = (const char*)g.A + (size_t)cur.pm * tstepA + (size_t)cur.aoff * 2; const char* cB = (const char*)g.Bt + (size_t)cur.pn * tstepB;
    if constexpr (SP2) {
        PG8_STAGE(PG8_SB(0, 0), cB, voffB); PG8_STAGE(PG8_SB(0, 1), cB + hstepB, voffB); PG8_STAGE(PG8_SA(0, 0), cA, voffA); PG8_STAGE(PG8_SA(0, 1), cA + hstepA, voffA);
        if (wr == 1) PG8_BAR;
        PG8_WAIT_V(2); PG8_BAR;
        PG8_STAGE(PG8_SB(1, 0), cB + kstep, voffB); PG8_STAGE(PG8_SA(1, 0), cA + kstep, voffA); PG8_STAGE(PG8_SB(1, 1), cB + hstepB + kstep, voffB);
        PG8_WAIT_V(6); PG8_BAR;
    } else {
        PG8_STAGE(PG8_SB(0, 0), cB, voffB); PG8_STAGE(PG8_SA(0, 0), cA, voffA); PG8_STAGE(PG8_SB(0, 1), cB + hstepB, voffB); PG8_STAGE(PG8_SA(0, 1), cA + hstepA, voffA);
        if (wr == 1) PG8_BAR;
        PG8_WAIT_V(4); PG8_BAR;
        PG8_STAGE(PG8_SB(1, 0), cB + kstep, voffB); PG8_STAGE(PG8_SA(1, 0), cA + kstep, voffA); PG8_STAGE(PG8_SB(1, 1), cB + hstepB + kstep, voffB);
        PG8_WAIT_V(6); PG8_BAR;
    }
    for (;;) {
        const bool has_next = S.next(ui + 1, nxt);
        const char* nA = has_next ? (const char*)g.A + (size_t)nxt.pm * tstepA + (size_t)nxt.aoff * 2 : cA; const char* nB = has_next ? (const char*)g.Bt + (size_t)nxt.pn * tstepB : cB;
        for (int t = 0; t < nt; t += 2) {
            const bool last = (t == nt - 2);
            const char* a1 = cA + (size_t)(t + 1) * kstep;
            const char* a2 = last ? nA : cA + (size_t)(t + 2) * kstep; const char* b2 = last ? nB : cB + (size_t)(t + 2) * kstep;
            const char* a3 = a2 + kstep; const char* b3 = b2 + kstep;
            if constexpr (SP2) {
            PG8_LDB(B0, 0, 0); PG8_LDB(B1, 0, 1); PG8_SCHED; PG8_LDA(At, 0, 0); PG8_STAGE(PG8_SA(1, 1), a1 + hstepA, voffA);
            PG8_WAIT_V(8); PG8_WAIT_L(0); PG8_BAR; PG8_MMA(0, 0, At, B0); PG8_MMA(0, 1, At, B1); PG8_BAR; PG8_SCHED;
            PG8_LDA(At, 0, 1); PG8_STAGE(PG8_SB(0, 0), b2, voffB); PG8_STAGE(PG8_SB(0, 1), b2 + hstepB, voffB); PG8_STAGE(PG8_SA(0, 0), a2, voffA);
            PG8_WAIT_V(8); PG8_WAIT_L(0); PG8_BAR; PG8_MMA(1, 0, At, B0); PG8_MMA(1, 1, At, B1); PG8_BAR; PG8_SCHED;
            PG8_LDB(B0, 1, 0); PG8_LDB(B1, 1, 1); PG8_SCHED; PG8_LDA(At, 1, 0); PG8_STAGE(PG8_SA(0, 1), a2 + hstepA, voffA);
            PG8_WAIT_V(8); PG8_WAIT_L(0); PG8_BAR; PG8_MMA(0, 0, At, B0); PG8_MMA(0, 1, At, B1); PG8_BAR; PG8_SCHED;
            PG8_LDA(At, 1, 1); PG8_STAGE(PG8_SB(1, 0), b3, voffB); PG8_STAGE(PG8_SB(1, 1), b3 + hstepB, voffB); PG8_STAGE(PG8_SA(1, 0), a3, voffA);
            PG8_WAIT_V(8); PG8_WAIT_L(0); PG8_BAR; PG8_MMA(1, 0, At, B0); PG8_MMA(1, 1, At, B1); PG8_BAR; PG8_SCHED;
            } else {
            PG8_LDB(B0, 0, 0); PG8_SCHED; PG8_LDA(At, 0, 0); PG8_STAGE(PG8_SA(1, 1), a1 + hstepA, voffA);
            PG8_WAIT_L(8); PG8_BAR; PG8_WAIT_L(0); PG8_MMA(0, 0, At, B0); PG8_BAR; PG8_SCHED;
            PG8_LDB(B1, 0, 1); PG8_STAGE(PG8_SB(0, 0), b2, voffB);
            PG8_BAR; PG8_WAIT_L(0); PG8_MMA(0, 1, At, B1); PG8_BAR;
            PG8_LDA(At, 0, 1); PG8_STAGE(PG8_SA(0, 0), a2, voffA);
            PG8_BAR; PG8_WAIT_L(0); PG8_MMA(1, 0, At, B0); PG8_BAR; PG8_SCHED;
            PG8_STAGE(PG8_SB(0, 1), b2 + hstepB, voffB);
            PG8_WAIT_V(6); PG8_BAR; PG8_MMA(1, 1, At, B1); PG8_BAR;
            PG8_LDB(B0, 1, 0); PG8_SCHED; PG8_LDA(At, 1, 0); PG8_STAGE(PG8_SA(0, 1), a2 + hstepA, voffA);
            PG8_WAIT_L(8); PG8_BAR; PG8_WAIT_L(0); PG8_MMA(0, 0, At, B0); PG8_BAR; PG8_SCHED;
            PG8_LDB(B1, 1, 1); PG8_STAGE(PG8_SB(1, 0), b3, voffB);
            PG8_BAR; PG8_WAIT_L(0); PG8_MMA(0, 1, At, B1); PG8_BAR;
            PG8_LDA(At, 1, 1); PG8_STAGE(PG8_SA(1, 0), a3, voffA);
            PG8_BAR; PG8_WAIT_L(0); PG8_MMA(1, 0, At, B0); PG8_BAR; PG8_SCHED;
            PG8_STAGE(PG8_SB(1, 1), b3 + hstepB, voffB);
            PG8_WAIT_V(6); PG8_BAR; PG8_MMA(1, 1, At, B1); PG8_BAR;
            }
        }
        if constexpr (ALIGN_EPI) { if (wr == 0) PG8_BAR; }
        E(acc, cur, wr, wc, fr, fq);
        if (!has_next) break;
#pragma unroll
        for (int a = 0; a < 2; ++a)
#pragma unroll
            for (int b = 0; b < 2; ++b)
#pragma unroll
                for (int m = 0; m < 4; ++m)
#pragma unroll
                    for (int n = 0; n < 2; ++n) acc[a][b][m][n] = (f32x4){0.f, 0.f, 0.f, 0.f};
        cur = nxt; cA = nA; cB = nB; ++ui;
        if constexpr (ALIGN_EPI) { if (wr == 1) PG8_BAR; }
    }
    PG8_WAIT_V(0);
    if constexpr (!ALIGN_EPI) { if (wr == 0) PG8_BAR; }
    PG8_BAR;
#undef PG8_SA
#undef PG8_SB
#undef PG8_STAGE
#undef PG8_LDA
#undef PG8_LDB
#undef PG8_MMA
#undef PG8_WAIT_V
#undef PG8_WAIT_L
#undef PG8_BAR
#undef PG8_SCHED
}
}


#define LDS_BARRIER() do { asm volatile("s_waitcnt lgkmcnt(0)" ::: "memory"); __builtin_amdgcn_s_barrier(); asm volatile("" ::: "memory"); } while (0)
namespace ml {
#define LAS __attribute__((address_space(3)))
typedef short bf16x8 __attribute__((ext_vector_type(8)));
typedef float f32x4 __attribute__((ext_vector_type(4)));
typedef unsigned u32x4 __attribute__((ext_vector_type(4)));
constexpr int NVB = 4, EV = MD / NVB;
constexpr int PQ = 272, PT = 144;
constexpr int L_QS = 0, L_KS = L_QS + 64 * PQ, L_KT = L_KS + 64 * PQ, L_VT = L_KT + 128 * PT, L_SB = L_VT + 48 * PT, L_CT = L_SB + 64 * PT,
              L_HS = L_CT + 48 * PQ, L_SC = L_HS + 64 * 80, L_END = L_SC + 4096;
static_assert(L_END <= 131072, "mLSTM LDS map");
enum { SC_A = 0, SC_PM = 64, SC_WI = 128, SC_EMT = 192, SC_WE = 256, SC_DEN = 320, SC_MISC = 384 };
__device__ __forceinline__ f32x4 mma(bf16x8 a, bf16x8 b, f32x4 c) { return __builtin_amdgcn_mfma_f32_16x16x32_bf16(a, b, c, 0, 0, 0); }
__device__ __forceinline__ bf16x8 frag(LAS unsigned char* lds, int base, int pitch, int row0, int k0, int lane) {
    return *(const LAS bf16x8*)(lds + base + (row0 + (lane & 15)) * pitch + (k0 + 8 * (lane >> 4)) * 2);
}
template <int N> __device__ __forceinline__ float dpp_row_shr(float x, float ident) {
    return __builtin_bit_cast(float, __builtin_amdgcn_update_dpp(__builtin_bit_cast(int, ident), __builtin_bit_cast(int, x), 0x110 + N, 0xf, 0xf, false));
}
__device__ __forceinline__ float lane_get(float x, int l) { return __builtin_bit_cast(float, __builtin_amdgcn_readlane(__builtin_bit_cast(int, x), l)); }
__device__ __forceinline__ float wave_scan_add(float x, int lane) {
    x += dpp_row_shr<1>(x, 0.f); x += dpp_row_shr<2>(x, 0.f); x += dpp_row_shr<4>(x, 0.f); x += dpp_row_shr<8>(x, 0.f);
    const float t0 = lane_get(x, 15), t1 = lane_get(x, 31), t2 = lane_get(x, 47); const int row = lane >> 4;
    return x + ((row >= 1 ? t0 : 0.f) + (row >= 2 ? t1 : 0.f) + (row >= 3 ? t2 : 0.f));
}
__device__ __forceinline__ float wave_scan_max(float x, int lane) {
    constexpr float NI = -3.0e38f;
    x = fmaxf(x, dpp_row_shr<1>(x, NI)); x = fmaxf(x, dpp_row_shr<2>(x, NI)); x = fmaxf(x, dpp_row_shr<4>(x, NI)); x = fmaxf(x, dpp_row_shr<8>(x, NI));
    const float t0 = lane_get(x, 15), t1 = lane_get(x, 31), t2 = lane_get(x, 47); const int row = lane >> 4;
    return fmaxf(fmaxf(x, row >= 1 ? t0 : NI), fmaxf(row >= 2 ? t1 : NI, row >= 3 ? t2 : NI));
}
__device__ __forceinline__ void mlstm_item(LAS unsigned char* lds, CParams& P, int l, int s, int head, int dir, int vb) {
    const int tid = threadIdx.x, w = __builtin_amdgcn_readfirstlane(tid >> 6), lane = tid & 63, fr = lane & 15, fq = lane >> 4;
    const int rt = w & 3, half = w >> 2;
    const SeqInfo q = seqinfo(s); const int nchunk = q.T / 64;
    const bf16* QK = WSP(bf16, WS_QKC); bf16* U = WSP(bf16, WS_U1);
    LAS float* SC = (LAS float*)(lds + L_SC);
    f32x4 cacc[3];
    float m_prev;
    if (!q.grid) { cacc[0] = cacc[1] = cacc[2] = (f32x4){0.f, 0.f, 0.f, 0.f}; m_prev = 0.f; }
    else {
        const size_t sb = (((size_t)q.b * DEPTH + l) * 2 + dir) * MH + head; const int d = 16 * w + fr;
#pragma unroll
        for (int et = 0; et < 2; ++et)
#pragma unroll
            for (int r = 0; r < 4; ++r) cacc[et][r] = P.in[ST_C][(sb * 128 + d) * 128 + vb * EV + 16 * et + 4 * fq + r];
        cacc[2] = (f32x4){0.f, 0.f, 0.f, 0.f}; if (fq == 0) cacc[2][0] = P.in[ST_N][sb * 128 + d];
        m_prev = P.in[ST_M][sb];
    }
    const float bi = P.in[M_GATE_B][(size_t)l * 4 * MH + (2 * dir) * MH + head], bfg = P.in[M_GATE_B][(size_t)l * 4 * MH + (2 * dir + 1) * MH + head];
    for (int i = tid; i < 16 * 64; i += 512) { const int r = i >> 6, c = i & 63; *(LAS bf16*)(lds + L_VT + (32 + r) * PT + c * 2) = (r == 0) ? (bf16)0x3f80 : (bf16)0; }
    u32x4 pqk[4]; u32x4 pv; bf16 pgi = 0, pgf = 0;
#define ML_TOK(c, j) ((size_t)(q.base + (dir ? q.T - 1 - ((c) * 64 + (j)) : ((c) * 64 + (j)))))
#define ML_PREFETCH(c) do { _Pragma("unroll") for (int i = 0; i < 4; ++i) { const int id = tid + 512 * i, j = id >> 5, pc = id & 31; \
            pqk[i] = *(const u32x4*)(QK + ML_TOK(c, j) * (2 * MW) + (pc < 16 ? head * 128 + 8 * pc : MW + head * 128 + 8 * (pc - 16))); } \
        if (tid < 256) { const int j = tid >> 2, pc = tid & 3; pv = *(const u32x4*)(U + ML_TOK(c, j) * PU + OFF_V + head * 128 + vb * EV + 8 * pc); } \
        if (w == 0) { const bf16* g = U + ML_TOK(c, lane) * PU + OFF_G; pgi = g[(2 * dir) * MH + head]; pgf = g[(2 * dir + 1) * MH + head]; } } while (0)
    ML_PREFETCH(0);
    for (int c = 0; c < nchunk; ++c) {
#pragma unroll
        for (int i = 0; i < 4; ++i) { const int id = tid + 512 * i, j = id >> 5, pc = id & 31;
            *(LAS u32x4*)(lds + (pc < 16 ? L_QS : L_KS) + j * PQ + (pc & 15) * 16) = pqk[i]; }
        if (tid < 256) { const int j = tid >> 2, pc = tid & 3; const unsigned wv[4] = {pv.x, pv.y, pv.z, pv.w};
#pragma unroll
            for (int e = 0; e < 8; ++e) *(LAS bf16*)(lds + L_VT + (8 * pc + e) * PT + j * 2) = (bf16)((wv[e >> 1] >> ((e & 1) * 16)) & 0xffffu); }
#pragma unroll
        for (int et = 0; et < 3; ++et)
#pragma unroll
            for (int r = 0; r < 4; ++r) *(LAS bf16*)(lds + L_CT + (16 * et + 4 * fq + r) * PQ + (16 * w + fr) * 2) = f2bf(cacc[et][r]);
        float wie = 1.f;
        if (w == 0) {
            const float gi = bf2f(pgi) + bi, gf = bf2f(pgf) + bfg;
            const float lf = fminf(gf, 0.f) - log1pf(__expf(-fabsf(gf)));
            const float b = wave_scan_add(lf, lane);
            const float a = gi - b; float pm = wave_scan_max(a, lane);
            pm = fmaxf(pm, m_prev);
            const float pm63 = lane_get(pm, 63), b63 = lane_get(b, 63);
            SC[SC_A + lane] = a; SC[SC_PM + lane] = pm; SC[SC_WI + lane] = __expf(m_prev - pm); SC[SC_EMT + lane] = __expf(-(b + pm)); SC[SC_WE + lane] = __expf(a - pm63);
            if (lane == 0) { SC[SC_MISC] = __expf(m_prev - pm63); SC[SC_MISC + 1] = b63 + pm63; }
        }
        LDS_BARRIER();
        if (c + 1 < nchunk) ML_PREFETCH(c + 1);
        wie = SC[SC_MISC]; m_prev = SC[SC_MISC + 1];
#pragma unroll
        for (int i = 0; i < 2; ++i) { const int id = tid + 512 * i, j = id & 63, pc = id >> 6; const float we = SC[SC_WE + j];
            const u32x4 kv = *(const LAS u32x4*)(lds + L_KS + j * PQ + pc * 16); const unsigned wv[4] = {kv.x, kv.y, kv.z, kv.w};
#pragma unroll
            for (int e = 0; e < 8; ++e) { const float kf = __builtin_bit_cast(float, (e & 1) ? (wv[e >> 1] & 0xffff0000u) : (wv[e >> 1] << 16));
                *(LAS bf16*)(lds + L_KT + (8 * pc + e) * PT + j * 2) = f2bf(kf * we); } }
#pragma unroll
        for (int cc = 0; cc < 2; ++cc) { const int ct = 2 * half + cc;
            f32x4 acc = (f32x4){0.f, 0.f, 0.f, 0.f};
            if (ct <= rt) {
#pragma unroll
                for (int k = 0; k < 4; ++k) acc = mma(frag(lds, L_QS, PQ, 16 * rt, 32 * k, lane), frag(lds, L_KS, PQ, 16 * ct, 32 * k, lane), acc);
            }
            const int sp = 16 * ct + fr; const float as = SC[SC_A + sp];
#pragma unroll
            for (int r = 0; r < 4; ++r) { const int t = 16 * rt + 4 * fq + r; const float v = (sp <= t) ? acc[r] * __expf(as - SC[SC_PM + t]) : 0.f;
                *(LAS bf16*)(lds + L_SB + t * PT + sp * 2) = f2bf(v); } }
        LDS_BARRIER();
        f32x4 nacc[2]; const int nct = half ? 1 : 2;
#pragma unroll
        for (int cc = 0; cc < 2; ++cc) { if (cc < nct) { const int ct = half ? 2 : cc;
            f32x4 a1 = (f32x4){0.f, 0.f, 0.f, 0.f}, a2 = (f32x4){0.f, 0.f, 0.f, 0.f};
#pragma unroll
            for (int k = 0; k < 2; ++k) a1 = mma(frag(lds, L_SB, PT, 16 * rt, 32 * k, lane), frag(lds, L_VT, PT, 16 * ct, 32 * k, lane), a1);
#pragma unroll
            for (int k = 0; k < 4; ++k) a2 = mma(frag(lds, L_QS, PQ, 16 * rt, 32 * k, lane), frag(lds, L_CT, PQ, 16 * ct, 32 * k, lane), a2);
#pragma unroll
            for (int r = 0; r < 4; ++r) a1[r] += SC[SC_WI + 16 * rt + 4 * fq + r] * a2[r];
            nacc[cc] = a1; } }
        if (half && fr == 0) {
#pragma unroll
            for (int r = 0; r < 4; ++r) SC[SC_DEN + 16 * rt + 4 * fq + r] = nacc[0][r];
        }
#pragma unroll
        for (int et = 0; et < 3; ++et) { cacc[et] = cacc[et] * wie;
#pragma unroll
            for (int k = 0; k < 2; ++k) cacc[et] = mma(frag(lds, L_VT, PT, 16 * et, 32 * k, lane), frag(lds, L_KT, PT, 16 * w, 32 * k, lane), cacc[et]); }
        LDS_BARRIER();
        if (!half) {
#pragma unroll
            for (int cc = 0; cc < 2; ++cc)
#pragma unroll
                for (int r = 0; r < 4; ++r) { const int t = 16 * rt + 4 * fq + r; const float den = fmaxf(fabsf(SC[SC_DEN + t]), SC[SC_EMT + t]);
                    *(LAS bf16*)(lds + L_HS + t * 80 + (16 * cc + fr) * 2) = f2bf(nacc[cc][r] * __builtin_amdgcn_rcpf(den)); }
        }
        LDS_BARRIER();
        if (tid < 256) { const int j = tid >> 2, pc = tid & 3;
            *(u32x4*)(U + ML_TOK(c, j) * PU + dir * MW + head * 128 + vb * EV + 8 * pc) = *(const LAS u32x4*)(lds + L_HS + j * 80 + pc * 16); }
    }
    if (!q.grid) {
        const size_t sb = (((size_t)q.b * DEPTH + l) * 2 + dir) * MH + head; const int d = 16 * w + fr;
#pragma unroll
        for (int et = 0; et < 2; ++et)
#pragma unroll
            for (int r = 0; r < 4; ++r) P.out[OUT_C + (sb * 128 + d) * 128 + vb * EV + 16 * et + 4 * fq + r] = cacc[et][r];
        if (vb == 0) { if (fq == 0) P.out[OUT_N + sb * 128 + d] = cacc[2][0]; if (tid == 0) P.out[OUT_M + sb] = m_prev; }
    }
    LDS_BARRIER();
#undef ML_TOK
#undef ML_PREFETCH
}
constexpr int M_QS = 0, M_KS = M_QS + 2 * 64 * PQ, M_KT = M_KS + 64 * PQ, M_VT = M_KT + 128 * PT, M_SB = M_VT + 2 * 48 * PT, M_CT = M_SB + 64 * PT, M_HS = M_CT + 48 * PQ, M_SC = M_HS + 64 * 80, M_END = M_SC + 2 * 4096;
static_assert(M_END <= 131072, "pipelined mLSTM LDS map");
__device__ __forceinline__ void mlstm_item2(LAS unsigned char* lds, CParams& P, int l, int s, int head, int dir, int vb) {
    const int tid = threadIdx.x, w = __builtin_amdgcn_readfirstlane(tid >> 6), lane = tid & 63, fr = lane & 15, fq = lane >> 4;
    const int rt = w & 3, half = w >> 2;
    const SeqInfo q = seqinfo(s); const int nchunk = q.T / 64;
    const bf16* QK = WSP(bf16, WS_QKC); bf16* U = WSP(bf16, WS_U1);
    f32x4 cacc[3];
    float m_prev;
    const size_t sb = (((size_t)q.b * DEPTH + l) * 2 + dir) * MH + head;
    if (!q.grid) { cacc[0] = cacc[1] = cacc[2] = (f32x4){0.f, 0.f, 0.f, 0.f}; m_prev = 0.f; }
    else {
        const int d = 16 * w + fr;
#pragma unroll
        for (int et = 0; et < 2; ++et)
#pragma unroll
            for (int r = 0; r < 4; ++r) cacc[et][r] = P.in[ST_C][(sb * 128 + d) * 128 + vb * EV + 16 * et + 4 * fq + r];
        cacc[2] = (f32x4){0.f, 0.f, 0.f, 0.f}; if (fq == 0) cacc[2][0] = P.in[ST_N][sb * 128 + d];
        m_prev = P.in[ST_M][sb];
    }
    const float bi = P.in[M_GATE_B][(size_t)l * 4 * MH + (2 * dir) * MH + head], bfg = P.in[M_GATE_B][(size_t)l * 4 * MH + (2 * dir + 1) * MH + head];
    for (int i = tid; i < 2 * 16 * 64; i += 512) { const int b = i >> 10, r = (i >> 6) & 15, c = i & 63; *(LAS bf16*)(lds + M_VT + b * 48 * PT + (32 + r) * PT + c * 2) = (r == 0) ? (bf16)0x3f80 : (bf16)0; }
    u32x4 pqk[4]; u32x4 pv; bf16 pgi = 0, pgf = 0;
#define ML_TOK(c, j) ((size_t)(q.base + (dir ? q.T - 1 - ((c) * 64 + (j)) : ((c) * 64 + (j)))))
#define ML_PREFETCH(c) do { _Pragma("unroll") for (int i = 0; i < 4; ++i) { const int id = tid + 512 * i, j = id >> 5, pc = id & 31; \
            pqk[i] = *(const u32x4*)(QK + ML_TOK(c, j) * (2 * MW) + (pc < 16 ? head * 128 + 8 * pc : MW + head * 128 + 8 * (pc - 16))); } \
        if (tid < 256) { const int j = tid >> 2, pc = tid & 3; pv = *(const u32x4*)(U + ML_TOK(c, j) * PU + OFF_V + head * 128 + vb * EV + 8 * pc); } \
        if (w == 4) { const bf16* g = U + ML_TOK(c, lane) * PU + OFF_G; pgi = g[(2 * dir) * MH + head]; pgf = g[(2 * dir + 1) * MH + head]; } } while (0)
#define ML_STAGE_A(pb) do { \
        _Pragma("unroll") for (int i = 0; i < 4; ++i) { const int id = tid + 512 * i, j = id >> 5, pc = id & 31; \
            *(LAS u32x4*)(lds + (pc < 16 ? M_QS + (pb) * 64 * PQ : M_KS) + j * PQ + (pc & 15) * 16) = pqk[i]; } \
        if (tid < 256) { const int j = tid >> 2, pc = tid & 3; const unsigned wv[4] = {pv.x, pv.y, pv.z, pv.w}; \
            _Pragma("unroll") for (int e = 0; e < 8; ++e) *(LAS bf16*)(lds + M_VT + (pb) * 48 * PT + (8 * pc + e) * PT + j * 2) = (bf16)((wv[e >> 1] >> ((e & 1) * 16)) & 0xffffu); } \
        if (w == 4) { LAS float* SCn = (LAS float*)(lds + M_SC + (pb) * 4096); \
            const float gi = bf2f(pgi) + bi, gf = bf2f(pgf) + bfg; \
            const float lf = fminf(gf, 0.f) - log1pf(__expf(-fabsf(gf))); \
            const float b = wave_scan_add(lf, lane); \
            const float a = gi - b; float pm = wave_scan_max(a, lane); \
            pm = fmaxf(pm, m_prev); \
            const float pm63 = lane_get(pm, 63), b63 = lane_get(b, 63); \
            SCn[SC_A + lane] = a; SCn[SC_PM + lane] = pm; SCn[SC_WI + lane] = __expf(m_prev - pm); SCn[SC_EMT + lane] = __expf(-(b + pm)); SCn[SC_WE + lane] = __expf(a - pm63); \
            if (lane == 0) SCn[SC_MISC] = __expf(m_prev - pm63); \
            m_prev = b63 + pm63; } } while (0)
#define ML_STAGE_D(pb) do { const LAS float* SCn = (const LAS float*)(lds + M_SC + (pb) * 4096); \
        _Pragma("unroll") for (int i = 0; i < 2; ++i) { const int id = tid + 512 * i, j = id & 63, pc = id >> 6; const float we = SCn[SC_WE + j]; \
            const u32x4 kv = *(const LAS u32x4*)(lds + M_KS + j * PQ + pc * 16); const unsigned wv[4] = {kv.x, kv.y, kv.z, kv.w}; \
            _Pragma("unroll") for (int e = 0; e < 8; ++e) { const float kf = __builtin_bit_cast(float, (e & 1) ? (wv[e >> 1] & 0xffff0000u) : (wv[e >> 1] << 16)); \
                *(LAS bf16*)(lds + M_KT + (8 * pc + e) * PT + j * 2) = f2bf(kf * we); } } \
        _Pragma("unroll") for (int cc = 0; cc < 2; ++cc) { const int ct = 2 * half + cc; \
            f32x4 acc = (f32x4){0.f, 0.f, 0.f, 0.f}; \
            if (ct <= rt) { \
                _Pragma("unroll") for (int k = 0; k < 4; ++k) acc = mma(frag(lds, M_QS + (pb) * 64 * PQ, PQ, 16 * rt, 32 * k, lane), frag(lds, M_KS, PQ, 16 * ct, 32 * k, lane), acc); } \
            const int sp = 16 * ct + fr; const float as = SCn[SC_A + sp]; \
            _Pragma("unroll") for (int r = 0; r < 4; ++r) { const int t = 16 * rt + 4 * fq + r; const float v = (sp <= t) ? acc[r] * __expf(as - SCn[SC_PM + t]) : 0.f; \
                *(LAS bf16*)(lds + M_SB + t * PT + sp * 2) = f2bf(v); } } \
        _Pragma("unroll") for (int et = 0; et < 3; ++et) \
            _Pragma("unroll") for (int r = 0; r < 4; ++r) *(LAS bf16*)(lds + M_CT + (16 * et + 4 * fq + r) * PQ + (16 * w + fr) * 2) = f2bf(cacc[et][r]); } while (0)
#define ML_STORE(c) do { if (tid < 256) { const int j = tid >> 2, pc = tid & 3; \
            *(u32x4*)(U + ML_TOK(c, j) * PU + dir * MW + head * 128 + vb * EV + 8 * pc) = *(const LAS u32x4*)(lds + M_HS + j * 80 + pc * 16); } } while (0)
    ML_PREFETCH(0);
    ML_STAGE_A(0);
    LDS_BARRIER();
    if (nchunk > 1) ML_PREFETCH(1);
    ML_STAGE_D(0);
    LDS_BARRIER();
    for (int c = 0; c < nchunk; ++c) {
        const int pb = c & 1;
        if (c + 1 < nchunk) { ML_STAGE_A(pb ^ 1); if (c + 2 < nchunk) ML_PREFETCH(c + 2); }
        if (c >= 1) ML_STORE(c - 1);
        LAS float* SC = (LAS float*)(lds + M_SC + pb * 4096);
        const float wie = SC[SC_MISC];
        f32x4 nacc[2]; const int nct = half ? 1 : 2;
#pragma unroll
        for (int cc = 0; cc < 2; ++cc) { if (cc < nct) { const int ct = half ? 2 : cc;
            f32x4 a1 = (f32x4){0.f, 0.f, 0.f, 0.f}, a2 = (f32x4){0.f, 0.f, 0.f, 0.f};
#pragma unroll
            for (int k = 0; k < 2; ++k) a1 = mma(frag(lds, M_SB, PT, 16 * rt, 32 * k, lane), frag(lds, M_VT + pb * 48 * PT, PT, 16 * ct, 32 * k, lane), a1);
#pragma unroll
            for (int k = 0; k < 4; ++k) a2 = mma(frag(lds, M_QS + pb * 64 * PQ, PQ, 16 * rt, 32 * k, lane), frag(lds, M_CT, PQ, 16 * ct, 32 * k, lane), a2);
#pragma unroll
            for (int r = 0; r < 4; ++r) a1[r] += SC[SC_WI + 16 * rt + 4 * fq + r] * a2[r];
            nacc[cc] = a1; } }
        if (half && fr == 0) {
#pragma unroll
            for (int r = 0; r < 4; ++r) SC[SC_DEN + 16 * rt + 4 * fq + r] = nacc[0][r];
        }
#pragma unroll
        for (int et = 0; et < 3; ++et) { cacc[et] = cacc[et] * wie;
#pragma unroll
            for (int k = 0; k < 2; ++k) cacc[et] = mma(frag(lds, M_VT + pb * 48 * PT, PT, 16 * et, 32 * k, lane), frag(lds, M_KT, PT, 16 * w, 32 * k, lane), cacc[et]); }
        LDS_BARRIER();
        if (!half) {
#pragma unroll
            for (int cc = 0; cc < 2; ++cc)
#pragma unroll
                for (int r = 0; r < 4; ++r) { const int t = 16 * rt + 4 * fq + r; const float den = fmaxf(fabsf(SC[SC_DEN + t]), SC[SC_EMT + t]);
                    *(LAS bf16*)(lds + M_HS + t * 80 + (16 * cc + fr) * 2) = f2bf(nacc[cc][r] * __builtin_amdgcn_rcpf(den)); }
        }
        if (c + 1 < nchunk) ML_STAGE_D(pb ^ 1);
        LDS_BARRIER();
    }
    ML_STORE(nchunk - 1);
    if (!q.grid) {
        const int d = 16 * w + fr;
#pragma unroll
        for (int et = 0; et < 2; ++et)
#pragma unroll
            for (int r = 0; r < 4; ++r) P.out[OUT_C + (sb * 128 + d) * 128 + vb * EV + 16 * et + 4 * fq + r] = cacc[et][r];
        if (vb == 0) { if (fq == 0) P.out[OUT_N + sb * 128 + d] = cacc[2][0]; if (tid == 256) P.out[OUT_M + sb] = m_prev; }
    }
    LDS_BARRIER();
#undef ML_TOK
#undef ML_PREFETCH
#undef ML_STAGE_A
#undef ML_STAGE_D
#undef ML_STORE
}
constexpr int N_ITEMS = NSEQ * MH * 2 * NVB;
__device__ __forceinline__ void decode_item(int it, int& s, int& head, int& dir, int& vb) {
    vb = it % NVB; int ch = it / NVB; dir = ch & 1; ch >>= 1; head = ch % MH; const int sq = ch / MH;
    s = sq < LB ? CB + sq : sq - LB;
}
}


namespace rw {
typedef short bf16x8 __attribute__((ext_vector_type(8)));
typedef float f32x4 __attribute__((ext_vector_type(4)));
typedef unsigned u32x4 __attribute__((ext_vector_type(4)));
enum { V_A = 0, V_W, V_B, V_K, V_R, NVEC };
constexpr int REC = NVEC * 64 * 4;
constexpr int PT = 144;
constexpr int L_SBUF = 0, L_VT = L_SBUF + 64 * REC, L_TW = L_VT + 64 * 256, L_AL = L_TW + 64 * PT, L_YS = L_AL + 64 * PT, L_INV = L_YS + 64 * 16 * 4, L_END = L_INV + 256;
__device__ __forceinline__ int vt_off(int row, int tt) { return row * 256 + ((tt ^ (((row >> 3) & 7) << 2)) << 2); }
static_assert(L_END <= 131072, "RWKV LDS map");
__device__ __forceinline__ float dpp_xor1(float x) { return __builtin_bit_cast(float, __builtin_amdgcn_update_dpp(0, __builtin_bit_cast(int, x), 0xB1, 0xF, 0xF, true)); }
__device__ __forceinline__ float dpp_xor2(float x) { return __builtin_bit_cast(float, __builtin_amdgcn_update_dpp(0, __builtin_bit_cast(int, x), 0x4E, 0xF, 0xF, true)); }
__device__ __forceinline__ float dpp_ror4(float x) { return __builtin_bit_cast(float, __builtin_amdgcn_update_dpp(0, __builtin_bit_cast(int, x), 0x124, 0xF, 0xF, true)); }
__device__ __forceinline__ float dpp_ror8(float x) { return __builtin_bit_cast(float, __builtin_amdgcn_update_dpp(0, __builtin_bit_cast(int, x), 0x128, 0xF, 0xF, true)); }
__device__ __forceinline__ float allsum16(float x) { x += dpp_xor1(x); x += dpp_xor2(x); x += dpp_ror4(x); x += dpp_ror8(x); return x; }
__device__ __forceinline__ f32x4 cvt_lo4(unsigned a, unsigned b) { return (f32x4){__builtin_bit_cast(float, a << 16), __builtin_bit_cast(float, a & 0xffff0000u), __builtin_bit_cast(float, b << 16), __builtin_bit_cast(float, b & 0xffff0000u)}; }
__device__ __forceinline__ float allsum32(float x) {
    x = allsum16(x);
    float xa = x, xb = x;
    asm volatile("v_mov_b32 %1, %0\n\ts_nop 1\n\tv_permlane32_swap_b32 %0, %1\n\ts_nop 1" : "+v"(xa), "=&v"(xb));
    return xa + xb;
}
__device__ __forceinline__ void rwkv_item(LAS unsigned char* lds, CParams& P, int l, int s, int head, int dir, int rh) {
    const int tid = threadIdx.x, w = __builtin_amdgcn_readfirstlane(tid >> 6), lane = tid & 63, fr = lane & 15, fq = lane >> 4;
    const int rt = w & 3, half = w >> 2, hc = head * 64;
    const SeqInfo q = seqinfo(s); const int nchunk = q.T / 64;
    const bf16* RX = WSP(bf16, WS_RXC); bf16* U = WSP(bf16, WS_U1);
    const int pj = tid >> 3, psub = tid & 7;
    const int hh = lane >> 5, rsel = (lane >> 4) & 1, cg = lane & 15;
    const int row = 16 * rh + 2 * w + rsel, col0 = 32 * hh + 2 * cg;
    typedef float f32x2 __attribute__((ext_vector_type(2)));
    f32x2 S2;
    if (!q.grid) S2 = (f32x2){0.f, 0.f};
    else { const size_t sb = (((size_t)q.b * DEPTH + l) * 2 + dir) * RH + head; S2 = *(const f32x2*)(P.in[ST_R] + (sb * 64 + row) * 64 + col0); }
    float rkk8[8];
#pragma unroll
    for (int e = 0; e < 8; ++e) rkk8[e] = P.in[R_KK][(size_t)l * RW + hc + 8 * psub + e];
    float c_w0[2], c_a0[2], c_kk[2], c_ka[2];
    bf16x8 bw[2][2], ba[2][2];
#pragma unroll
    for (int cc = 0; cc < 2; ++cc) { const int c = 16 * (2 * half + cc) + fr;
        c_w0[cc] = P.in[R_W0][((size_t)l * 2 + dir) * RW + hc + c]; c_a0[cc] = P.in[R_A0][((size_t)l * 2 + dir) * RW + hc + c];
        c_kk[cc] = P.in[R_KK][(size_t)l * RW + hc + c]; c_ka[cc] = P.in[R_KA][(size_t)l * RW + hc + c];
#pragma unroll
        for (int ks = 0; ks < 2; ++ks)
#pragma unroll
            for (int e = 0; e < 8; ++e) { const int j = 32 * ks + 8 * fq + e;
                bw[cc][ks][e] = (short)f2bf(P.in[R_W2][(((size_t)l * 2 + dir) * 64 + j) * RW + hc + c]);
                ba[cc][ks][e] = (short)f2bf(P.in[R_A2][(((size_t)l * 2 + dir) * 64 + j) * RW + hc + c]); } }
    u32x4 pf[5];
#define RW_TOK(c, j) ((size_t)(q.base + (dir ? q.T - 1 - ((c) * 64 + (j)) : ((c) * 64 + (j)))))
#define RW_PREFETCH(c) do { const bf16* rx = RX + RW_TOK(c, pj) * RIN + 8 * psub; \
        pf[0] = *(const u32x4*)(rx + RX_R + hc); pf[1] = *(const u32x4*)(rx + RX_K + hc); pf[2] = *(const u32x4*)(rx + RX_V + hc); \
        pf[3] = *(const u32x4*)(rx + RX_WL + dir * 64); pf[4] = *(const u32x4*)(rx + RX_AL + dir * 64); } while (0)
    RW_PREFETCH(0);
    for (int c = 0; c < nchunk; ++c) {
        { LAS unsigned char* rec = lds + L_SBUF + pj * REC + psub * 32;
          *(LAS f32x4*)(rec + V_R * 256) = cvt_lo4(pf[0].x, pf[0].y); *(LAS f32x4*)(rec + V_R * 256 + 16) = cvt_lo4(pf[0].z, pf[0].w);
          { const f32x4 v0 = cvt_lo4(pf[2].x, pf[2].y), v1 = cvt_lo4(pf[2].z, pf[2].w);
#pragma unroll
            for (int e = 0; e < 4; ++e) { *(LAS float*)(lds + L_VT + vt_off(8 * psub + e, pj)) = v0[e]; *(LAS float*)(lds + L_VT + vt_off(8 * psub + 4 + e, pj)) = v1[e]; } }
          const f32x4 k0 = cvt_lo4(pf[1].x, pf[1].y), k1 = cvt_lo4(pf[1].z, pf[1].w);
          *(LAS f32x4*)(rec + V_K * 256) = k0; *(LAS f32x4*)(rec + V_K * 256 + 16) = k1;
          float ss = 0.f;
#pragma unroll
          for (int e = 0; e < 4; ++e) { const float x0 = k0[e] * rkk8[e], x1 = k1[e] * rkk8[4 + e]; ss += x0 * x0 + x1 * x1; }
          ss += dpp_xor1(ss); ss += dpp_xor2(ss); ss += __shfl_xor(ss, 4);
          if (psub == 0) *(LAS float*)(lds + L_INV + pj * 4) = 1.0f / fmaxf(sqrtf(ss), 1e-12f);
          *(LAS u32x4*)(lds + L_TW + pj * PT + psub * 16) = pf[3]; *(LAS u32x4*)(lds + L_AL + pj * PT + psub * 16) = pf[4]; }
        __syncthreads();
        if (c + 1 < nchunk) RW_PREFETCH(c + 1);
#pragma unroll
        for (int cc = 0; cc < 2; ++cc) { const int ct = 2 * half + cc; const int cidx = 16 * ct + fr;
            f32x4 aw = (f32x4){0.f, 0.f, 0.f, 0.f}, aa = (f32x4){0.f, 0.f, 0.f, 0.f};
#pragma unroll
            for (int ks = 0; ks < 2; ++ks) { aw = ml::mma(ml::frag(lds, L_TW, PT, 16 * rt, 32 * ks, lane), bw[cc][ks], aw); aa = ml::mma(ml::frag(lds, L_AL, PT, 16 * rt, 32 * ks, lane), ba[cc][ks], aa); }
#pragma unroll
            for (int r = 0; r < 4; ++r) { const int tok = 16 * rt + 4 * fq + r; LAS float* rec = (LAS float*)(lds + L_SBUF + tok * REC) + cidx;
                const float decay = __expf(-0.6065306597126334f * pg8::fsigmoid(c_w0[cc] + aw[r])); const float alpha = pg8::fsigmoid(c_a0[cc] + aa[r]);
                const float kraw = rec[V_K * 64]; const float kkn = kraw * c_kk[cc] * *(LAS float*)(lds + L_INV + tok * 4);
                rec[V_A * 64] = -kkn; rec[V_W * 64] = decay; rec[V_B * 64] = kkn * alpha; rec[V_K * 64] = kraw * (1.0f + (alpha - 1.0f) * c_ka[cc]); } }
        __syncthreads();
        {
            const LAS unsigned char* rbase = lds + L_SBUF + col0 * 4;
            f32x2 ca = *(const LAS f32x2*)(rbase + V_A * 256), cw = *(const LAS f32x2*)(rbase + V_W * 256), cb = *(const LAS f32x2*)(rbase + V_B * 256),
                  ck = *(const LAS f32x2*)(rbase + V_K * 256), cr = *(const LAS f32x2*)(rbase + V_R * 256);
#pragma unroll 1
            for (int blk = 0; blk < 4; ++blk) {
                float ykeep = 0.f;
#pragma unroll
                for (int g4 = 0; g4 < 4; ++g4) {
                    const f32x4 v4 = *(const LAS f32x4*)(lds + L_VT + vt_off(row, 16 * blk + 4 * g4));
#pragma unroll
                    for (int i4 = 0; i4 < 4; ++i4) {
                        const int i = 4 * g4 + i4, tt = 16 * blk + i, tn = tt < 63 ? tt + 1 : 63;
                        const LAS unsigned char* rn = rbase + tn * REC;
                        const f32x2 na = *(const LAS f32x2*)(rn + V_A * 256), nw = *(const LAS f32x2*)(rn + V_W * 256), nb = *(const LAS f32x2*)(rn + V_B * 256),
                                    nk = *(const LAS f32x2*)(rn + V_K * 256), nr = *(const LAS f32x2*)(rn + V_R * 256);
                        const float vv = v4[i4];
                        const f32x2 p = S2 * ca;
                        const float sa = allsum32(p.x + p.y);
                        S2 = S2 * cw + ck * vv;
                        S2 = cb * sa + S2;
                        const f32x2 yq = S2 * cr;
                        const float y = allsum32(yq.x + yq.y);
                        ykeep = (cg == i) ? y : ykeep;
                        ca = na; cw = nw; cb = nb; ck = nk; cr = nr;
                    }
                }
                if (hh == 0) *(LAS float*)(lds + L_YS + ((16 * blk + cg) * 16 + 2 * w + rsel) * 4) = ykeep;
            }
        }
        __syncthreads();
        if (tid < 128) { const int j = tid >> 1, pc = tid & 1; const LAS float* ys = (const LAS float*)(lds + L_YS) + j * 16 + 8 * pc;
            u32x4 o; o.x = pg8::cvt_pk_bf16(ys[0], ys[1]); o.y = pg8::cvt_pk_bf16(ys[2], ys[3]); o.z = pg8::cvt_pk_bf16(ys[4], ys[5]); o.w = pg8::cvt_pk_bf16(ys[6], ys[7]);
            *(u32x4*)(U + RW_TOK(c, j) * PU + OFF_R + dir * RW + hc + 16 * rh + 8 * pc) = o; }
    }
    if (!q.grid) { const size_t sb = (((size_t)q.b * DEPTH + l) * 2 + dir) * RH + head; *(f32x2*)(P.out + OUT_S + (sb * 64 + row) * 64 + col0) = S2; }
    __syncthreads();
#undef RW_TOK
#undef RW_PREFETCH
}
constexpr int N_ITEMS = NSEQ * RH * 2 * 4;
__device__ __forceinline__ void decode_item(int it, int& s, int& head, int& dir, int& rh) {
    rh = it & 3; int ch = it >> 2; dir = ch & 1; ch >>= 1; head = ch % RH; const int sq = ch / RH;
    s = sq < LB ? CB + sq : sq - LB;
}
}


namespace wy {
typedef short bf16x8 __attribute__((ext_vector_type(8)));
typedef float f32x4 __attribute__((ext_vector_type(4)));
typedef unsigned u32x4 __attribute__((ext_vector_type(4)));
constexpr int PV = 144, PS = 48;
constexpr int L_AH = 0, L_RH = L_AH + 64 * PV, L_BT = L_RH + 64 * PV, L_KT = L_BT + 64 * PV, L_VS = L_KT + 64 * PV, L_NAKT = L_VS + 64 * PV, L_NRKT = L_NAKT + 4 * 16 * PS,
              L_NRBT = L_NRKT + 4 * 16 * PS, L_TT = L_NRBT + 4 * 16 * PS, L_GL = L_TT + 4 * 16 * PS, PACK_BYTES = L_GL + 1024,
              L_BH = PACK_BYTES, L_KH = L_BH + 64 * PV, L_YS = L_KH + 64 * PV, L_TW = L_YS + 64 * PV, L_AL = L_TW + 64 * PV, L_NAB = L_AL + 64 * PV, L_INV = L_NAB + 4096, L_END = L_INV + 256;
constexpr int RING = 6, PACK_U = PACK_BYTES / 16, N_LAT = LB * RH * 2, RING_A = 22;
static_assert(PACK_BYTES % 16 == 0 && PACK_U <= 8 * 512 && (size_t)RING_A * RING * PACK_BYTES <= (size_t)N1P * D * 2 && WS_END + (size_t)(N_LAT - RING_A) * RING * PACK_BYTES <= ((size_t)256 << 20), "ring placement");
static_assert(L_END <= 131072, "WY LDS map");
__device__ __forceinline__ bf16x8 fragk16(LAS unsigned char* lds, int base, int pitch, int row0, int k0, int lane) {
    const bf16x8 v = *(const LAS bf16x8*)(lds + base + (row0 + (lane & 15)) * pitch + (k0 + 8 * ((lane >> 4) & 1)) * 2);
    const bf16x8 z = {0, 0, 0, 0, 0, 0, 0, 0};
    return (lane < 32) ? v : z;
}
__device__ __forceinline__ void stb(LAS unsigned char* lds, int off, float v) { *(LAS bf16*)(lds + off) = f2bf(v); }
typedef unsigned u32x2 __attribute__((ext_vector_type(2)));
__device__ __forceinline__ bf16x8 pack_k16(const f32x4 v) { u32x4 o; o.x = pg8::cvt_pk_bf16(v[0], v[1]); o.y = pg8::cvt_pk_bf16(v[2], v[3]); o.z = 0u; o.w = 0u; return __builtin_bit_cast(bf16x8, o); }
__device__ __forceinline__ bf16x8 pack_k32(const f32x4 a, const f32x4 b) { u32x4 o; o.x = pg8::cvt_pk_bf16(a[0], a[1]); o.y = pg8::cvt_pk_bf16(a[2], a[3]); o.z = pg8::cvt_pk_bf16(b[0], b[1]); o.w = pg8::cvt_pk_bf16(b[2], b[3]);
    return __builtin_bit_cast(bf16x8, o); }
__device__ __forceinline__ bf16x8 ld_k16(LAS unsigned char* lds, int base, int pitch, int row0, int col0, int lane) {
    const u32x2 v = *(const LAS u32x2*)(lds + base + (row0 + (lane & 15)) * pitch + (col0 + 4 * (lane >> 4)) * 2); u32x4 o; o.x = v.x; o.y = v.y; o.z = 0u; o.w = 0u; return __builtin_bit_cast(bf16x8, o); }
__device__ __forceinline__ bf16x8 ld_k32(LAS unsigned char* lds, int base, int pitch, int row0, int col0, int lane) {
    const LAS unsigned char* p = lds + base + (row0 + (lane & 15)) * pitch + (col0 + 4 * (lane >> 4)) * 2;
    const u32x2 v0 = *(const LAS u32x2*)p, v1 = *(const LAS u32x2*)(p + 32); u32x4 o; o.x = v0.x; o.y = v0.y; o.z = v1.x; o.w = v1.y; return __builtin_bit_cast(bf16x8, o); }
__device__ __forceinline__ void rwkv_item(LAS unsigned char* lds, CParams& P, int l, int s, int head, int dir) {
    const int tid = threadIdx.x, w = __builtin_amdgcn_readfirstlane(tid >> 6), lane = tid & 63, fr = lane & 15, fq = lane >> 4;
    const int rt = w & 3, half = w >> 2, hc = head * 64;
    const SeqInfo q = seqinfo(s); const int nchunk = q.T / 64;
    const bf16* RX = WSP(bf16, WS_RXC); bf16* U = WSP(bf16, WS_U1);
    const int pj = tid >> 3, psub = tid & 7;
    f32x4 sacc[4];
#pragma unroll
    for (int ct = 0; ct < 4; ++ct) sacc[ct] = (f32x4){0.f, 0.f, 0.f, 0.f};
    if (w < 4 && q.grid) { const size_t sb = (((size_t)q.b * DEPTH + l) * 2 + dir) * RH + head;
#pragma unroll
        for (int ct = 0; ct < 4; ++ct) sacc[ct] = *(const f32x4*)(P.in[ST_R] + (sb * 64 + 16 * w + fr) * 64 + 16 * ct + 4 * fq); }
    float rkk8[8];
#pragma unroll
    for (int e = 0; e < 8; ++e) rkk8[e] = P.in[R_KK][(size_t)l * RW + hc + 8 * psub + e];
    float c_w0[2], c_a0[2], c_kk[2], c_ka[2];
#pragma unroll
    for (int cc = 0; cc < 2; ++cc) { const int c = 16 * (2 * half + cc) + fr;
        c_w0[cc] = P.in[R_W0][((size_t)l * 2 + dir) * RW + hc + c]; c_a0[cc] = P.in[R_A0][((size_t)l * 2 + dir) * RW + hc + c];
        c_kk[cc] = P.in[R_KK][(size_t)l * RW + hc + c]; c_ka[cc] = P.in[R_KA][(size_t)l * RW + hc + c]; }
    const bf16* w2t = WSP(bf16, O_W2T) + ((size_t)dir * RW + hc) * 64; const bf16* a2t = WSP(bf16, O_A2T) + ((size_t)dir * RW + hc) * 64;
    u32x4 pf[5];
#define WY_TOK(c, j) ((size_t)(q.base + (dir ? q.T - 1 - ((c) * 64 + (j)) : ((c) * 64 + (j)))))
#define WY_PREFETCH(c) do { const bf16* rx = RX + WY_TOK(c, pj) * RIN + 8 * psub; \
        pf[0] = *(const u32x4*)(rx + RX_R + hc); pf[1] = *(const u32x4*)(rx + RX_K + hc); pf[2] = *(const u32x4*)(rx + RX_V + hc); \
        pf[3] = *(const u32x4*)(rx + RX_WL + dir * 64); pf[4] = *(const u32x4*)(rx + RX_AL + dir * 64); } while (0)
    WY_PREFETCH(0);
    for (int c = 0; c < nchunk; ++c) {
        { *(LAS u32x4*)(lds + L_RH + pj * PV + psub * 16) = pf[0]; *(LAS u32x4*)(lds + L_KH + pj * PV + psub * 16) = pf[1];
          const unsigned kw[4] = {pf[1].x, pf[1].y, pf[1].z, pf[1].w}, vw[4] = {pf[2].x, pf[2].y, pf[2].z, pf[2].w};
          float ss = 0.f;
#pragma unroll
          for (int e = 0; e < 8; ++e) { const float kf = __builtin_bit_cast(float, (e & 1) ? (kw[e >> 1] & 0xffff0000u) : (kw[e >> 1] << 16)) * rkk8[e]; ss += kf * kf;
              *(LAS bf16*)(lds + L_VS + (8 * psub + e) * PV + pj * 2) = (bf16)((vw[e >> 1] >> ((e & 1) * 16)) & 0xffffu); }
          ss += rw::dpp_xor1(ss); ss += rw::dpp_xor2(ss); ss += __shfl_xor(ss, 4);
          if (psub == 0) *(LAS float*)(lds + L_INV + pj * 4) = 1.0f / fmaxf(sqrtf(ss), 1e-12f);
          *(LAS u32x4*)(lds + L_TW + pj * PV + psub * 16) = pf[3]; *(LAS u32x4*)(lds + L_AL + pj * PV + psub * 16) = pf[4]; }
        LDS_BARRIER();
        if (c + 1 < nchunk) WY_PREFETCH(c + 1);
#pragma unroll
        for (int cc = 0; cc < 2; ++cc) { const int ct = 2 * half + cc; const int cidx = 16 * ct + fr;
            f32x4 aw = (f32x4){0.f, 0.f, 0.f, 0.f}, aa = (f32x4){0.f, 0.f, 0.f, 0.f};
#pragma unroll
            for (int ks = 0; ks < 2; ++ks) { const size_t bo = (size_t)cidx * 64 + 32 * ks + 8 * fq;
                aw = ml::mma(ml::frag(lds, L_TW, PV, 16 * rt, 32 * ks, lane), *(const bf16x8*)(w2t + bo), aw); aa = ml::mma(ml::frag(lds, L_AL, PV, 16 * rt, 32 * ks, lane), *(const bf16x8*)(a2t + bo), aa); }
            float kr4[4], rr4[4], iv4[4];
#pragma unroll
            for (int r = 0; r < 4; ++r) { const int tok = 16 * rt + 4 * fq + r; kr4[r] = bf2f(*(const LAS bf16*)(lds + L_KH + tok * PV + cidx * 2)); rr4[r] = bf2f(*(const LAS bf16*)(lds + L_RH + tok * PV + cidx * 2));
                iv4[r] = *(const LAS float*)(lds + L_INV + tok * 4); }
            float lw[4], cum[4];
#pragma unroll
            for (int r = 0; r < 4; ++r) { lw[r] = -0.6065306597126334f * pg8::fsigmoid(c_w0[cc] + aw[r]); cum[r] = (r ? cum[r - 1] : 0.f) + lw[r]; }
            const float tot = cum[3]; const float p1 = __shfl_up(tot, 16), p2 = __shfl_up(tot, 32), p3 = __shfl_up(tot, 48);
            const float off = (fq >= 1 ? p1 : 0.f) + (fq >= 2 ? p2 : 0.f) + (fq >= 3 ? p3 : 0.f);
            float gprev = __expf(off);
#pragma unroll
            for (int r = 0; r < 4; ++r) { const int tok = 16 * rt + 4 * fq + r; const float lam = off + cum[r]; const float g = __expf(lam), gi = __builtin_amdgcn_rcpf(g);
                const float alpha = pg8::fsigmoid(c_a0[cc] + aa[r]);
                const float kraw = kr4[r], rraw = rr4[r];
                const float kkn = kraw * c_kk[cc] * iv4[r];
                const bf16 bh = f2bf(kkn * alpha * gi), kh = f2bf(kraw * (1.0f + (alpha - 1.0f) * c_ka[cc]) * gi);
                stb(lds, L_AH + tok * PV + cidx * 2, -kkn * gprev); stb(lds, L_RH + tok * PV + cidx * 2, rraw * g);
                *(LAS bf16*)(lds + L_BH + tok * PV + cidx * 2) = bh; *(LAS bf16*)(lds + L_KH + tok * PV + cidx * 2) = kh;
                *(LAS bf16*)(lds + L_BT + cidx * PV + tok * 2) = bh; *(LAS bf16*)(lds + L_KT + cidx * PV + tok * 2) = kh;
                if (fq == 3 && r == 3) *(LAS float*)(lds + L_GL + (rt * 64 + cidx) * 4) = g;
                gprev = g; } }
        LDS_BARRIER();
        { const int sc = w >> 1, side = w & 1; f32x4 gB = (f32x4){0.f, 0.f, 0.f, 0.f}, gK = (f32x4){0.f, 0.f, 0.f, 0.f};
#pragma unroll
          for (int ks = 0; ks < 2; ++ks) { const bf16x8 af = ml::frag(lds, side ? L_RH : L_AH, PV, 16 * sc, 32 * ks, lane);
              gB = ml::mma(af, ml::frag(lds, L_BH, PV, 16 * sc, 32 * ks, lane), gB); gK = ml::mma(af, ml::frag(lds, L_KH, PV, 16 * sc, 32 * ks, lane), gK); }
#pragma unroll
          for (int r = 0; r < 4; ++r) { const int t = 4 * fq + r; const bool keep = side ? (fr <= t) : (fr < t); const float vB = keep ? gB[r] : 0.f, vK = keep ? gK[r] : 0.f;
              if (side == 0) { *(LAS float*)(lds + L_NAB + ((sc * 16 + t) * 16 + fr) * 4) = vB; stb(lds, L_NAKT + (sc * 16 + t) * PS + fr * 2, vK); }
              else { stb(lds, L_NRBT + (sc * 16 + t) * PS + fr * 2, vB); stb(lds, L_NRKT + (sc * 16 + t) * PS + fr * 2, vK); } } }
        if ((w & 1) == 0 && lane < 16) { const int sc = w >> 1; float Tr[16];
            asm volatile("" ::: "memory");
#pragma unroll
            for (int ph = 0; ph < 4; ++ph) { f32x4 nv[4][4];
#pragma unroll
                for (int tq = 0; tq < 4; ++tq)
#pragma unroll
                    for (int u4 = 0; u4 <= ph; ++u4) nv[tq][u4] = *(const LAS f32x4*)(lds + L_NAB + ((sc * 16 + 4 * ph + tq) * 16 + 4 * u4) * 4);
#pragma unroll
                for (int tq = 0; tq < 4; ++tq) { const int t = 4 * ph + tq; float x0 = (lane == t) ? 1.f : 0.f, x1 = 0.f;
#pragma unroll
                    for (int u = 0; u < 16; ++u) if (u < t) { if (u & 1) x1 += Tr[u] * nv[tq][u >> 2][u & 3]; else x0 += Tr[u] * nv[tq][u >> 2][u & 3]; }
                    Tr[t] = x0 + x1; stb(lds, L_TT + (sc * 16 + t) * PS + lane * 2, Tr[t]); } } }
        LDS_BARRIER();
        if (w < 4) {
#pragma unroll 1
            for (int sc = 0; sc < 4; ++sc) {
                const bf16x8 ah0 = ld_k32(lds, L_AH, PV, 16 * sc, 0, lane), ah1 = ld_k32(lds, L_AH, PV, 16 * sc, 32, lane), rh0 = ld_k32(lds, L_RH, PV, 16 * sc, 0, lane), rh1 = ld_k32(lds, L_RH, PV, 16 * sc, 32, lane);
                const bf16x8 nak = ld_k16(lds, L_NAKT, PS, 16 * sc, 0, lane), nrk = ld_k16(lds, L_NRKT, PS, 16 * sc, 0, lane), ttf = ld_k16(lds, L_TT, PS, 16 * sc, 0, lane), nrb = ld_k16(lds, L_NRBT, PS, 16 * sc, 0, lane);
                const bf16x8 vsf = ld_k16(lds, L_VS, PV, 16 * w, 16 * sc, lane);
                bf16x8 btf[4], ktf[4]; f32x4 glv[4];
#pragma unroll
                for (int ct = 0; ct < 4; ++ct) { btf[ct] = ld_k16(lds, L_BT, PV, 16 * ct, 16 * sc, lane); ktf[ct] = ld_k16(lds, L_KT, PV, 16 * ct, 16 * sc, lane);
                    glv[ct] = *(const LAS f32x4*)(lds + L_GL + (sc * 64 + 16 * ct + 4 * fq) * 4); }
                const bf16x8 sb0 = pack_k32(sacc[0], sacc[1]), sb1 = pack_k32(sacc[2], sacc[3]);
                f32x4 XT = (f32x4){0.f, 0.f, 0.f, 0.f}, YT = (f32x4){0.f, 0.f, 0.f, 0.f};
                XT = ml::mma(ah0, sb0, XT); XT = ml::mma(ah1, sb1, XT); XT = ml::mma(nak, vsf, XT);
                YT = ml::mma(rh0, sb0, YT); YT = ml::mma(rh1, sb1, YT); YT = ml::mma(nrk, vsf, YT);
                f32x4 UT = (f32x4){0.f, 0.f, 0.f, 0.f};
                UT = ml::mma(ttf, pack_k16(XT), UT);
                const bf16x8 ub = pack_k16(UT);
                YT = ml::mma(nrb, ub, YT);
#pragma unroll
                for (int r = 0; r < 4; ++r) stb(lds, L_YS + (16 * sc + 4 * fq + r) * PV + (16 * w + fr) * 2, YT[r]);
#pragma unroll
                for (int ct = 0; ct < 4; ++ct) { sacc[ct] = ml::mma(btf[ct], ub, sacc[ct]); sacc[ct] = ml::mma(ktf[ct], vsf, sacc[ct]); sacc[ct] = sacc[ct] * glv[ct]; }
            }
        }
        LDS_BARRIER();
        *(u32x4*)(U + WY_TOK(c, pj) * PU + OFF_R + dir * RW + hc + 8 * psub) = *(const LAS u32x4*)(lds + L_YS + pj * PV + psub * 16);
    }
    if (!q.grid && w < 4) { const size_t sb = (((size_t)q.b * DEPTH + l) * 2 + dir) * RH + head;
#pragma unroll
        for (int ct = 0; ct < 4; ++ct) *(f32x4*)(P.out + OUT_S + (sb * 64 + 16 * w + fr) * 64 + 16 * ct + 4 * fq) = sacc[ct]; }
    LDS_BARRIER();
#undef WY_TOK
#undef WY_PREFETCH
}
__device__ __forceinline__ int tid_opaque() { int t = threadIdx.x; asm volatile("" : "+v"(t)); return t; }
constexpr int CW_F = 16384, FL_STRIDE = 64, NPROD = 2;
static_assert(RING % NPROD == 0 && NPROD + 1 <= 4 && CW_F + DEPTH * N_LAT * 4 * FL_STRIDE <= 32768, "flag block");
constexpr unsigned FL_SPIN_CAP = 1u << 18;
__device__ __forceinline__ unsigned fl_ld(unsigned* p) { return __hip_atomic_load(p, __ATOMIC_RELAXED, __HIP_MEMORY_SCOPE_AGENT); }
__device__ __forceinline__ unsigned fl_wait_ge(unsigned* p, unsigned want, unsigned* tmo) {
    unsigned sp = 0, v;
    while ((v = fl_ld(p)) < want) { __builtin_amdgcn_s_sleep(1); if ((++sp & 255u) == 0u) { if (fl_ld(tmo)) break; if (sp > FL_SPIN_CAP) { atomicAdd(tmo, 1u); break; } } }
    return v;
}
__device__ __forceinline__ void rwkv_prod(LAS unsigned char* lds, CParams& P, int l, int s, int head, int dir, int chain, int pp, unsigned* ctl) {
    const int tid = tid_opaque(), w = __builtin_amdgcn_readfirstlane(tid >> 6), lane = tid & 63, fr = lane & 15, fq = lane >> 4;
    const int rt = w & 3, half = w >> 2, hc = head * 64;
    const SeqInfo q = seqinfo(s); const int nchunk = q.T / 64;
    const bf16* RX = WSP(bf16, WS_RXC);
    const int pj = tid >> 3, psub = tid & 7;
    unsigned char* ring = P.ws + (chain < RING_A ? O_WIN1 + (size_t)chain * RING * PACK_BYTES : WS_END + (size_t)(chain - RING_A) * RING * PACK_BYTES);
    unsigned* f_base = ctl + CW_F + (size_t)((l * N_LAT + chain) * 4) * FL_STRIDE; unsigned* f_ready = f_base + pp * FL_STRIDE; unsigned* f_ack = f_base + NPROD * FL_STRIDE; unsigned* tmo = ctl + 4096 + 128;
    float rkk8[8];
#pragma unroll
    for (int e = 0; e < 8; ++e) rkk8[e] = P.in[R_KK][(size_t)l * RW + hc + 8 * psub + e];
    float c_w0[2], c_a0[2], c_kk[2], c_ka[2];
#pragma unroll
    for (int cc = 0; cc < 2; ++cc) { const int c = 16 * (2 * half + cc) + fr;
        c_w0[cc] = P.in[R_W0][((size_t)l * 2 + dir) * RW + hc + c]; c_a0[cc] = P.in[R_A0][((size_t)l * 2 + dir) * RW + hc + c];
        c_kk[cc] = P.in[R_KK][(size_t)l * RW + hc + c]; c_ka[cc] = P.in[R_KA][(size_t)l * RW + hc + c]; }
    const bf16* w2t = WSP(bf16, O_W2T) + ((size_t)dir * RW + hc) * 64; const bf16* a2t = WSP(bf16, O_A2T) + ((size_t)dir * RW + hc) * 64;
    u32x4 pf[5];
#define WY_TOK(c, j) ((size_t)(q.base + (dir ? q.T - 1 - ((c) * 64 + (j)) : ((c) * 64 + (j)))))
#define WY_PREFETCH(c) do { const bf16* rx = RX + WY_TOK(c, pj) * RIN + 8 * psub; \
        pf[0] = *(const u32x4*)(rx + RX_R + hc); pf[1] = *(const u32x4*)(rx + RX_K + hc); pf[2] = *(const u32x4*)(rx + RX_V + hc); \
        pf[3] = *(const u32x4*)(rx + RX_WL + dir * 64); pf[4] = *(const u32x4*)(rx + RX_AL + dir * 64); } while (0)
    WY_PREFETCH(pp);
    asm volatile("" :: "v"(pf[0]), "v"(pf[1]), "v"(pf[2]), "v"(pf[3]), "v"(pf[4]) : "memory");
    unsigned acked = 0u;
    for (int c = pp; c < nchunk; c += NPROD) {
        { *(LAS u32x4*)(lds + L_RH + pj * PV + psub * 16) = pf[0]; *(LAS u32x4*)(lds + L_KH + pj * PV + psub * 16) = pf[1];
          const unsigned kw[4] = {pf[1].x, pf[1].y, pf[1].z, pf[1].w}, vw[4] = {pf[2].x, pf[2].y, pf[2].z, pf[2].w};
          float ss = 0.f;
#pragma unroll
          for (int e = 0; e < 8; ++e) { const float kf = __builtin_bit_cast(float, (e & 1) ? (kw[e >> 1] & 0xffff0000u) : (kw[e >> 1] << 16)) * rkk8[e]; ss += kf * kf;
              *(LAS bf16*)(lds + L_VS + (8 * psub + e) * PV + pj * 2) = (bf16)((vw[e >> 1] >> ((e & 1) * 16)) & 0xffffu); }
          ss += rw::dpp_xor1(ss); ss += rw::dpp_xor2(ss); ss += __shfl_xor(ss, 4);
          if (psub == 0) *(LAS float*)(lds + L_INV + pj * 4) = 1.0f / fmaxf(sqrtf(ss), 1e-12f);
          *(LAS u32x4*)(lds + L_TW + pj * PV + psub * 16) = pf[3]; *(LAS u32x4*)(lds + L_AL + pj * PV + psub * 16) = pf[4]; }
        LDS_BARRIER();
        if (c + NPROD < nchunk) WY_PREFETCH(c + NPROD);
#pragma unroll
        for (int cc = 0; cc < 2; ++cc) { const int ct = 2 * half + cc; const int cidx = 16 * ct + fr;
            f32x4 aw = (f32x4){0.f, 0.f, 0.f, 0.f}, aa = (f32x4){0.f, 0.f, 0.f, 0.f};
#pragma unroll
            for (int ks = 0; ks < 2; ++ks) { const size_t bo = (size_t)cidx * 64 + 32 * ks + 8 * fq;
                aw = ml::mma(ml::frag(lds, L_TW, PV, 16 * rt, 32 * ks, lane), *(const bf16x8*)(w2t + bo), aw); aa = ml::mma(ml::frag(lds, L_AL, PV, 16 * rt, 32 * ks, lane), *(const bf16x8*)(a2t + bo), aa); }
            float kr4[4], rr4[4], iv4[4];
#pragma unroll
            for (int r = 0; r < 4; ++r) { const int tok = 16 * rt + 4 * fq + r; kr4[r] = bf2f(*(const LAS bf16*)(lds + L_KH + tok * PV + cidx * 2)); rr4[r] = bf2f(*(const LAS bf16*)(lds + L_RH + tok * PV + cidx * 2));
                iv4[r] = *(const LAS float*)(lds + L_INV + tok * 4); }
            float lw[4], cum[4];
#pragma unroll
            for (int r = 0; r < 4; ++r) { lw[r] = -0.6065306597126334f * pg8::fsigmoid(c_w0[cc] + aw[r]); cum[r] = (r ? cum[r - 1] : 0.f) + lw[r]; }
            const float tot = cum[3]; const float p1 = __shfl_up(tot, 16), p2 = __shfl_up(tot, 32), p3 = __shfl_up(tot, 48);
            const float off = (fq >= 1 ? p1 : 0.f) + (fq >= 2 ? p2 : 0.f) + (fq >= 3 ? p3 : 0.f);
            float gprev = __expf(off);
#pragma unroll
            for (int r = 0; r < 4; ++r) { const int tok = 16 * rt + 4 * fq + r; const float lam = off + cum[r]; const float g = __expf(lam), gi = __builtin_amdgcn_rcpf(g);
                const float alpha = pg8::fsigmoid(c_a0[cc] + aa[r]);
                const float kraw = kr4[r], rraw = rr4[r];
                const float kkn = kraw * c_kk[cc] * iv4[r];
                const bf16 bh = f2bf(kkn * alpha * gi), kh = f2bf(kraw * (1.0f + (alpha - 1.0f) * c_ka[cc]) * gi);
                stb(lds, L_AH + tok * PV + cidx * 2, -kkn * gprev); stb(lds, L_RH + tok * PV + cidx * 2, rraw * g);
                *(LAS bf16*)(lds + L_BH + tok * PV + cidx * 2) = bh; *(LAS bf16*)(lds + L_KH + tok * PV + cidx * 2) = kh;
                *(LAS bf16*)(lds + L_BT + cidx * PV + tok * 2) = bh; *(LAS bf16*)(lds + L_KT + cidx * PV + tok * 2) = kh;
                if (fq == 3 && r == 3) *(LAS float*)(lds + L_GL + (rt * 64 + cidx) * 4) = g;
                gprev = g; } }
        asm volatile("s_waitcnt vmcnt(0)" ::: "memory");
        LDS_BARRIER();
        if (tid == 0 && c > pp) __hip_atomic_store(f_ready, (unsigned)((c - pp) / NPROD), __ATOMIC_RELAXED, __HIP_MEMORY_SCOPE_AGENT);
        { const int sc = w >> 1, side = w & 1; f32x4 gB = (f32x4){0.f, 0.f, 0.f, 0.f}, gK = (f32x4){0.f, 0.f, 0.f, 0.f};
#pragma unroll
          for (int ks = 0; ks < 2; ++ks) { const bf16x8 af = ml::frag(lds, side ? L_RH : L_AH, PV, 16 * sc, 32 * ks, lane);
              gB = ml::mma(af, ml::frag(lds, L_BH, PV, 16 * sc, 32 * ks, lane), gB); gK = ml::mma(af, ml::frag(lds, L_KH, PV, 16 * sc, 32 * ks, lane), gK); }
#pragma unroll
          for (int r = 0; r < 4; ++r) { const int t = 4 * fq + r; const bool keep = side ? (fr <= t) : (fr < t); const float vB = keep ? gB[r] : 0.f, vK = keep ? gK[r] : 0.f;
              if (side == 0) { *(LAS float*)(lds + L_NAB + ((sc * 16 + t) * 16 + fr) * 4) = vB; stb(lds, L_NAKT + (sc * 16 + t) * PS + fr * 2, vK); }
              else { stb(lds, L_NRBT + (sc * 16 + t) * PS + fr * 2, vB); stb(lds, L_NRKT + (sc * 16 + t) * PS + fr * 2, vK); } } }
        if ((w & 1) == 0 && lane < 16) { const int sc = w >> 1; float Tr[16];
            asm volatile("" ::: "memory");
#pragma unroll
            for (int ph = 0; ph < 4; ++ph) { f32x4 nv[4][4];
#pragma unroll
                for (int tq = 0; tq < 4; ++tq)
#pragma unroll
                    for (int u4 = 0; u4 <= ph; ++u4) nv[tq][u4] = *(const LAS f32x4*)(lds + L_NAB + ((sc * 16 + 4 * ph + tq) * 16 + 4 * u4) * 4);
#pragma unroll
                for (int tq = 0; tq < 4; ++tq) { const int t = 4 * ph + tq; float x0 = (lane == t) ? 1.f : 0.f, x1 = 0.f;
#pragma unroll
                    for (int u = 0; u < 16; ++u) if (u < t) { if (u & 1) x1 += Tr[u] * nv[tq][u >> 2][u & 3]; else x0 += Tr[u] * nv[tq][u >> 2][u & 3]; }
                    Tr[t] = x0 + x1; stb(lds, L_TT + (sc * 16 + t) * PS + lane * 2, Tr[t]); } } }
        if (tid == 0 && c >= RING && acked < (unsigned)(c - RING + 1)) acked = fl_wait_ge(f_ack, (unsigned)(c - RING + 1), tmo);
        LDS_BARRIER();
        asm volatile("" :: "v"(pf[0]), "v"(pf[1]), "v"(pf[2]), "v"(pf[3]), "v"(pf[4]) : "memory");
        { unsigned char* slot = ring + (size_t)(c % RING) * PACK_BYTES;
#pragma unroll
          for (int k = 0; k < 8; ++k) { const int u = tid + 512 * k;
              if (u < PACK_U) { const u32x4 v = *(const LAS u32x4*)(lds + 16 * u); const u32x4* gp = (const u32x4*)(slot + (size_t)16 * u);
                  asm volatile("global_store_dwordx4 %0, %1, off sc1" :: "v"(gp), "v"(v) : "memory"); } } }
        LDS_BARRIER();
    }
    asm volatile("s_waitcnt vmcnt(0)" ::: "memory");
    __syncthreads();
    if (tid == 0) __hip_atomic_store(f_ready, (unsigned)((nchunk - pp + NPROD - 1) / NPROD), __ATOMIC_RELAXED, __HIP_MEMORY_SCOPE_AGENT);
    LDS_BARRIER();
#undef WY_TOK
#undef WY_PREFETCH
}
__device__ __forceinline__ void rwkv_cons(LAS unsigned char* lds, CParams& P, int l, int s, int head, int dir, int chain, unsigned* ctl) {
    const int tid = tid_opaque(), w = __builtin_amdgcn_readfirstlane(tid >> 6), lane = tid & 63, fr = lane & 15, fq = lane >> 4;
    const int hc = head * 64;
    const SeqInfo q = seqinfo(s); const int nchunk = q.T / 64;
    bf16* U = WSP(bf16, WS_U1);
    const unsigned char* ring = P.ws + (chain < RING_A ? O_WIN1 + (size_t)chain * RING * PACK_BYTES : WS_END + (size_t)(chain - RING_A) * RING * PACK_BYTES);
    unsigned* f_base = ctl + CW_F + (size_t)((l * N_LAT + chain) * 4) * FL_STRIDE; unsigned* f_ack = f_base + NPROD * FL_STRIDE; unsigned* tmo = ctl + 4096 + 128;
    constexpr int C_YS = 2 * PACK_BYTES;
    static_assert(C_YS + 64 * PV <= 131072, "consumer LDS map");
    f32x4 sacc[4];
#pragma unroll
    for (int ct = 0; ct < 4; ++ct) sacc[ct] = (f32x4){0.f, 0.f, 0.f, 0.f};
    if (w < 4 && q.grid) { const size_t sb = (((size_t)q.b * DEPTH + l) * 2 + dir) * RH + head;
#pragma unroll
        for (int ct = 0; ct < 4; ++ct) sacc[ct] = *(const f32x4*)(P.in[ST_R] + (sb * 64 + 16 * w + fr) * 64 + 16 * ct + 4 * fq); }
#define WY_TOK(c, j) ((size_t)(q.base + (dir ? q.T - 1 - ((c) * 64 + (j)) : ((c) * 64 + (j)))))
    unsigned seen0 = 0u, seen1 = 0u;
#define CONS_FETCH(c, boff) do { const int p_ = (c) % NPROD; const unsigned need_ = (unsigned)((c) / NPROD + 1); \
        if ((p_ ? seen1 : seen0) < need_) { unsigned v_ = 0u; if (lane == 0) v_ = fl_wait_ge(f_base + p_ * FL_STRIDE, need_, tmo); v_ = __builtin_amdgcn_readfirstlane(v_); \
            if (p_) seen1 = v_; else seen0 = v_; __builtin_amdgcn_fence(__ATOMIC_ACQUIRE, "agent"); } \
        const unsigned char* slot = ring + (size_t)((c) % RING) * PACK_BYTES; \
        for (int k = w - 4; k < PACK_BYTES / 1024; k += 4) \
            __builtin_amdgcn_global_load_lds((const unsigned*)(slot + (size_t)k * 1024 + lane * 16), (LAS unsigned*)(lds + (boff) + k * 1024), 16, 0, 0); \
        asm volatile("s_waitcnt vmcnt(0)" ::: "memory"); } while (0)
    if (w >= 4) CONS_FETCH(0, 0);
    LDS_BARRIER();
    if (tid == 256) __hip_atomic_store(f_ack, 1u, __ATOMIC_RELAXED, __HIP_MEMORY_SCOPE_AGENT);
    for (int c = 0; c < nchunk; ++c) {
        const int boff = (c & 1) * PACK_BYTES;
        if (w >= 4) { if (c + 1 < nchunk) CONS_FETCH(c + 1, PACK_BYTES - boff); }
        else {
            LAS unsigned char* pb = lds + boff;
#pragma unroll 1
            for (int sc = 0; sc < 4; ++sc) {
                const bf16x8 ah0 = ld_k32(pb, L_AH, PV, 16 * sc, 0, lane), ah1 = ld_k32(pb, L_AH, PV, 16 * sc, 32, lane), rh0 = ld_k32(pb, L_RH, PV, 16 * sc, 0, lane), rh1 = ld_k32(pb, L_RH, PV, 16 * sc, 32, lane);
                const bf16x8 nak = ld_k16(pb, L_NAKT, PS, 16 * sc, 0, lane), nrk = ld_k16(pb, L_NRKT, PS, 16 * sc, 0, lane), ttf = ld_k16(pb, L_TT, PS, 16 * sc, 0, lane), nrb = ld_k16(pb, L_NRBT, PS, 16 * sc, 0, lane);
                const bf16x8 vsf = ld_k16(pb, L_VS, PV, 16 * w, 16 * sc, lane);
                bf16x8 btf[4], ktf[4]; f32x4 glv[4];
#pragma unroll
                for (int ct = 0; ct < 4; ++ct) { btf[ct] = ld_k16(pb, L_BT, PV, 16 * ct, 16 * sc, lane); ktf[ct] = ld_k16(pb, L_KT, PV, 16 * ct, 16 * sc, lane);
                    glv[ct] = *(const LAS f32x4*)(pb + L_GL + (sc * 64 + 16 * ct + 4 * fq) * 4); }
                const bf16x8 sb0 = pack_k32(sacc[0], sacc[1]), sb1 = pack_k32(sacc[2], sacc[3]);
                f32x4 XT = (f32x4){0.f, 0.f, 0.f, 0.f}, YT = (f32x4){0.f, 0.f, 0.f, 0.f};
                XT = ml::mma(ah0, sb0, XT); XT = ml::mma(ah1, sb1, XT); XT = ml::mma(nak, vsf, XT);
                YT = ml::mma(rh0, sb0, YT); YT = ml::mma(rh1, sb1, YT); YT = ml::mma(nrk, vsf, YT);
                f32x4 UT = (f32x4){0.f, 0.f, 0.f, 0.f};
                UT = ml::mma(ttf, pack_k16(XT), UT);
                const bf16x8 ub = pack_k16(UT);
                YT = ml::mma(nrb, ub, YT);
#pragma unroll
                for (int r = 0; r < 4; ++r) stb(lds, C_YS + (16 * sc + 4 * fq + r) * PV + (16 * w + fr) * 2, YT[r]);
#pragma unroll
                for (int ct = 0; ct < 4; ++ct) { sacc[ct] = ml::mma(btf[ct], ub, sacc[ct]); sacc[ct] = ml::mma(ktf[ct], vsf, sacc[ct]); sacc[ct] = sacc[ct] * glv[ct]; }
            }
            { const LAS unsigned char* yp = lds + C_YS + lane * PV + 32 * w; const u32x4 y0 = *(const LAS u32x4*)yp, y1 = *(const LAS u32x4*)(yp + 16);
              bf16* up = U + WY_TOK(c, lane) * PU + OFF_R + dir * RW + hc + 16 * w; *(u32x4*)up = y0; *(u32x4*)(up + 8) = y1; }
        }
        LDS_BARRIER();
        if (tid == 256 && c + 1 < nchunk) __hip_atomic_store(f_ack, (unsigned)(c + 2), __ATOMIC_RELAXED, __HIP_MEMORY_SCOPE_AGENT);
    }
    if (!q.grid && w < 4) { const size_t sb = (((size_t)q.b * DEPTH + l) * 2 + dir) * RH + head;
#pragma unroll
        for (int ct = 0; ct < 4; ++ct) *(f32x4*)(P.out + OUT_S + (sb * 64 + 16 * w + fr) * 64 + 16 * ct + 4 * fq) = sacc[ct]; }
    LDS_BARRIER();
#undef WY_TOK
#undef CONS_FETCH
}
constexpr int N_ITEMS = NSEQ * RH * 2;
__device__ __forceinline__ void decode_item(int it, int& s, int& head, int& dir) {
    dir = it & 1; int ch = it >> 1; head = ch % RH; const int sq = ch / RH;
    s = sq < LB ? CB + sq : sq - LB;
}
}

namespace ms {
using ml::PQ; using ml::PT; using ml::mma; using ml::frag; using wy::bf16x8; using wy::f32x4; using wy::u32x4;
constexpr int P_QS = 0, P_KT = P_QS + 64 * PQ, P_SB = P_KT + 128 * PT, P_SC = P_SB + 64 * PT, P_VT = P_SC + 4096, VT_BYTES = 21504, ML_PACK = P_VT + VT_BYTES, P_KS = ML_PACK, P_END = P_KS + 64 * PQ;
constexpr int ML_RING = 4, ML_PACK_U = ML_PACK / 16, N_MLAT = LB * MH * 2, CW_MF = 32768, MLPROD = 2;
static_assert(MLPROD == 2 && ML_RING % MLPROD == 0, "two producers per chain: even / odd chunks");
static_assert(ML_PACK % 1024 == 0 && ML_PACK_U <= 9 * 512 && 145 * PT <= VT_BYTES && P_END <= 131072 && 2 * ML_PACK <= 146432, "mLSTM pack layout");
static_assert(WS_END + (size_t)N_MLAT * ML_RING * ML_PACK <= ((size_t)256 << 20), "mLSTM ring fits behind the activations");
__device__ __forceinline__ void ml_prod(LAS unsigned char* lds, CParams& P, int l, int s, int head, int dir, int chain, int pp, unsigned* ctl) {
    const int tid = wy::tid_opaque(), w = __builtin_amdgcn_readfirstlane(tid >> 6), lane = tid & 63, fr = lane & 15, fq = lane >> 4;
    const int rt = w & 3, half = w >> 2;
    const SeqInfo q = seqinfo(s); const int nchunk = q.T / 64;
    const bf16* QK = WSP(bf16, WS_QKC); const bf16* U = WSP(bf16, WS_U1);
    LAS float* SC = (LAS float*)(lds + P_SC);
    unsigned char* ring = P.ws + WS_END + (size_t)chain * ML_RING * ML_PACK;
    unsigned* f_base = ctl + CW_MF + (size_t)((l * N_MLAT + chain) * 4) * wy::FL_STRIDE; unsigned* f_ready = f_base + pp * wy::FL_STRIDE; unsigned* f_ack = f_base + MLPROD * wy::FL_STRIDE; unsigned* tmo = ctl + 4096 + 128;
    float m_prev = 0.f;
    if (q.grid) m_prev = P.in[ST_M][(((size_t)q.b * DEPTH + l) * 2 + dir) * MH + head];
    const float bi = P.in[M_GATE_B][(size_t)l * 4 * MH + (2 * dir) * MH + head], bfg = P.in[M_GATE_B][(size_t)l * 4 * MH + (2 * dir + 1) * MH + head];
    for (int i = tid; i < (VT_BYTES - 128 * PT) / 2; i += 512) *(LAS bf16*)(lds + P_VT + 128 * PT + i * 2) = (i < 64) ? (bf16)0x3f80 : (bf16)0;
    u32x4 pqk[4]; u32x4 pv[2]; bf16 pgi = 0, pgf = 0, sgi = 0, sgf = 0;
#define ML_TOK(c, j) ((size_t)(q.base + (dir ? q.T - 1 - ((c) * 64 + (j)) : ((c) * 64 + (j)))))
#define ML_PREFETCH(c) do { _Pragma("unroll") for (int i = 0; i < 4; ++i) { const int id = tid + 512 * i, j = id >> 5, pc = id & 31; \
            pqk[i] = *(const u32x4*)(QK + ML_TOK(c, j) * (2 * MW) + (pc < 16 ? head * 128 + 8 * pc : MW + head * 128 + 8 * (pc - 16))); } \
        _Pragma("unroll") for (int i = 0; i < 2; ++i) { const int id = tid + 512 * i, j = id >> 4, pc = id & 15; pv[i] = *(const u32x4*)(U + ML_TOK(c, j) * PU + OFF_V + head * 128 + 8 * pc); } \
        if (w == 0) { const bf16* g = U + ML_TOK(c, lane) * PU + OFF_G; pgi = g[(2 * dir) * MH + head]; pgf = g[(2 * dir + 1) * MH + head]; \
            if ((c) >= 1) { const bf16* g2 = U + ML_TOK((c) - 1, lane) * PU + OFF_G; sgi = g2[(2 * dir) * MH + head]; sgf = g2[(2 * dir + 1) * MH + head]; } } } while (0)
#define ML_TOUCH() asm volatile("" :: "v"(pqk[0]), "v"(pqk[1]), "v"(pqk[2]), "v"(pqk[3]), "v"(pv[0]), "v"(pv[1]), "v"((unsigned)pgi), "v"((unsigned)pgf), "v"((unsigned)sgi), "v"((unsigned)sgf) : "memory")
#define ML_SCAN(gi_, gf_) \
            const float gi = bf2f(gi_) + bi, gf = bf2f(gf_) + bfg; \
            const float lf = fminf(gf, 0.f) - log1pf(__expf(-fabsf(gf))); \
            float b = lf; \
            _Pragma("unroll") for (int o = 1; o < 64; o <<= 1) { const float t = __shfl_up(b, o); if (lane >= o) b += t; } \
            const float a = gi - b; float pm = a; \
            _Pragma("unroll") for (int o = 1; o < 64; o <<= 1) { const float t = __shfl_up(pm, o); if (lane >= o) pm = fmaxf(pm, t); } \
            pm = fmaxf(pm, m_prev); \
            const float pm63 = __shfl(pm, 63), b63 = __shfl(b, 63);
    ML_PREFETCH(pp);
    ML_TOUCH();
    unsigned acked = 0u;
    for (int c = pp; c < nchunk; c += MLPROD) {
        if (w == 0 && c >= 1) { ML_SCAN(sgi, sgf) m_prev = b63 + pm63; }
#pragma unroll
        for (int i = 0; i < 4; ++i) { const int id = tid + 512 * i, j = id >> 5, pc = id & 31;
            *(LAS u32x4*)(lds + (pc < 16 ? P_QS : P_KS) + j * PQ + (pc & 15) * 16) = pqk[i]; }
#pragma unroll
        for (int i = 0; i < 2; ++i) { const int id = tid + 512 * i, j = id >> 4, pc = id & 15; const unsigned wv[4] = {pv[i].x, pv[i].y, pv[i].z, pv[i].w};
#pragma unroll
            for (int e = 0; e < 8; ++e) *(LAS bf16*)(lds + P_VT + (8 * pc + e) * PT + j * 2) = (bf16)((wv[e >> 1] >> ((e & 1) * 16)) & 0xffffu); }
        if (w == 0) {
            ML_SCAN(pgi, pgf)
            SC[ml::SC_A + lane] = a; SC[ml::SC_PM + lane] = pm; SC[ml::SC_WI + lane] = __expf(m_prev - pm); SC[ml::SC_EMT + lane] = __expf(-(b + pm)); SC[ml::SC_WE + lane] = __expf(a - pm63);
            if (lane == 0) { SC[ml::SC_MISC] = __expf(m_prev - pm63); SC[ml::SC_MISC + 1] = b63 + pm63; }
            m_prev = b63 + pm63;
        }
        LDS_BARRIER();
        if (c + MLPROD < nchunk) ML_PREFETCH(c + MLPROD);
#pragma unroll
        for (int i = 0; i < 2; ++i) { const int id = tid + 512 * i, j = id & 63, pc = id >> 6; const float we = SC[ml::SC_WE + j];
            const u32x4 kv = *(const LAS u32x4*)(lds + P_KS + j * PQ + pc * 16); const unsigned wv[4] = {kv.x, kv.y, kv.z, kv.w};
#pragma unroll
            for (int e = 0; e < 8; ++e) { const float kf = __builtin_bit_cast(float, (e & 1) ? (wv[e >> 1] & 0xffff0000u) : (wv[e >> 1] << 16));
                *(LAS bf16*)(lds + P_KT + (8 * pc + e) * PT + j * 2) = f2bf(kf * we); } }
#pragma unroll
        for (int cc = 0; cc < 2; ++cc) { const int ct = 2 * half + cc;
            f32x4 acc = (f32x4){0.f, 0.f, 0.f, 0.f};
            if (ct <= rt) {
#pragma unroll
                for (int k = 0; k < 4; ++k) acc = mma(frag(lds, P_QS, PQ, 16 * rt, 32 * k, lane), frag(lds, P_KS, PQ, 16 * ct, 32 * k, lane), acc);
            }
            const int sp = 16 * ct + fr; const float as = SC[ml::SC_A + sp];
#pragma unroll
            for (int r = 0; r < 4; ++r) { const int t = 16 * rt + 4 * fq + r; const float v = (sp <= t) ? acc[r] * __expf(as - SC[ml::SC_PM + t]) : 0.f;
                *(LAS bf16*)(lds + P_SB + t * PT + sp * 2) = f2bf(v); } }
        asm volatile("s_waitcnt vmcnt(0)" ::: "memory");
        if (tid == 0 && c >= ML_RING && acked < (unsigned)(c - ML_RING + 1)) acked = wy::fl_wait_ge(f_ack, (unsigned)(c - ML_RING + 1), tmo);
        LDS_BARRIER();
        if (tid == 0 && c > pp) __hip_atomic_store(f_ready, (unsigned)((c - pp) / MLPROD), __ATOMIC_RELAXED, __HIP_MEMORY_SCOPE_AGENT);
        ML_TOUCH();
        { unsigned char* slot = ring + (size_t)(c % ML_RING) * ML_PACK;
#pragma unroll
          for (int k = 0; k < 9; ++k) { const int u = tid + 512 * k;
              if (u < ML_PACK_U) { const u32x4 v = *(const LAS u32x4*)(lds + 16 * u); const u32x4* gp = (const u32x4*)(slot + (size_t)16 * u);
                  asm volatile("global_store_dwordx4 %0, %1, off sc1" :: "v"(gp), "v"(v) : "memory"); } } }
        LDS_BARRIER();
    }
    asm volatile("s_waitcnt vmcnt(0)" ::: "memory");
    __syncthreads();
    if (tid == 0) __hip_atomic_store(f_ready, (unsigned)((nchunk - pp + MLPROD - 1) / MLPROD), __ATOMIC_RELAXED, __HIP_MEMORY_SCOPE_AGENT);
    LDS_BARRIER();
#undef ML_TOK
#undef ML_PREFETCH
#undef ML_TOUCH
#undef ML_SCAN
}
__device__ __forceinline__ void ml_cons(LAS unsigned char* lds, CParams& P, int l, int s, int head, int dir, int chain, unsigned* ctl) {
    const int tid = wy::tid_opaque(), w = __builtin_amdgcn_readfirstlane(tid >> 6), lane = tid & 63, fr = lane & 15, fq = lane >> 4;
    const SeqInfo q = seqinfo(s); const int nchunk = q.T / 64;
    bf16* U = WSP(bf16, WS_U1);
    const unsigned char* ring = P.ws + WS_END + (size_t)chain * ML_RING * ML_PACK;
    unsigned* f_base = ctl + CW_MF + (size_t)((l * N_MLAT + chain) * 4) * wy::FL_STRIDE; unsigned* f_ack = f_base + MLPROD * wy::FL_STRIDE; unsigned* tmo = ctl + 4096 + 128;
    f32x4 cst[8][3];
#pragma unroll
    for (int kt = 0; kt < 8; ++kt)
#pragma unroll
        for (int j = 0; j < 3; ++j) cst[kt][j] = (f32x4){0.f, 0.f, 0.f, 0.f};
    if (w < 4 && q.grid) { const size_t sb = (((size_t)q.b * DEPTH + l) * 2 + dir) * MH + head;
#pragma unroll
        for (int kt = 0; kt < 8; ++kt)
#pragma unroll
            for (int r = 0; r < 4; ++r) { const int d = 16 * kt + 4 * fq + r;
                cst[kt][0][r] = P.in[ST_C][(sb * 128 + d) * 128 + 32 * w + fr]; cst[kt][1][r] = P.in[ST_C][(sb * 128 + d) * 128 + 32 * w + 16 + fr];
                cst[kt][2][r] = (fr == 0) ? P.in[ST_N][sb * 128 + d] : 0.f; } }
#define ML_TOK(c, j) ((size_t)(q.base + (dir ? q.T - 1 - ((c) * 64 + (j)) : ((c) * 64 + (j)))))
    unsigned seen0 = 0u, seen1 = 0u;
#define MLC_FETCH(c, boff) do { const int p_ = (c) % MLPROD; const unsigned need_ = (unsigned)((c) / MLPROD + 1); \
        if ((p_ ? seen1 : seen0) < need_) { unsigned v_ = 0u; if (lane == 0) v_ = wy::fl_wait_ge(f_base + p_ * wy::FL_STRIDE, need_, tmo); v_ = __builtin_amdgcn_readfirstlane(v_); \
            if (p_) seen1 = v_; else seen0 = v_; __builtin_amdgcn_fence(__ATOMIC_ACQUIRE, "agent"); } \
        const unsigned char* slot = ring + (size_t)((c) % ML_RING) * ML_PACK; \
        for (int k = w - 4; k < ML_PACK / 1024; k += 4) \
            __builtin_amdgcn_global_load_lds((const unsigned*)(slot + (size_t)k * 1024 + lane * 16), (LAS unsigned*)(lds + (boff) + k * 1024), 16, 0, 0); \
        asm volatile("s_waitcnt vmcnt(0)" ::: "memory"); } while (0)
    if (w >= 4) MLC_FETCH(0, 0);
    LDS_BARRIER();
    if (tid == 256) __hip_atomic_store(f_ack, 1u, __ATOMIC_RELAXED, __HIP_MEMORY_SCOPE_AGENT);
    for (int c = 0; c < nchunk; ++c) {
        const int boff = (c & 1) * ML_PACK;
        if (w >= 4) { if (c + 1 < nchunk) MLC_FETCH(c + 1, ML_PACK - boff); }
        else {
            LAS unsigned char* pb = lds + boff; const LAS float* SC = (const LAS float*)(pb + P_SC);
            const float wie = SC[ml::SC_MISC];
            bf16x8 vf[3][2];
#pragma unroll
            for (int j = 0; j < 3; ++j)
#pragma unroll
                for (int k = 0; k < 2; ++k) vf[j][k] = frag(pb, P_VT, PT, j < 2 ? 32 * w + 16 * j : 128, 32 * k, lane);
            asm volatile("s_waitcnt lgkmcnt(0)" ::: "memory");
            LAS unsigned char* hp = pb + P_VT + 32 * w * PT;
#pragma unroll
            for (int rt = 0; rt < 4; ++rt) {
                f32x4 num[3];
#pragma unroll
                for (int j = 0; j < 3; ++j) { f32x4 a1 = (f32x4){0.f, 0.f, 0.f, 0.f}, a2 = (f32x4){0.f, 0.f, 0.f, 0.f};
#pragma unroll
                    for (int k = 0; k < 2; ++k) a1 = mma(frag(pb, P_SB, PT, 16 * rt, 32 * k, lane), vf[j][k], a1);
#pragma unroll
                    for (int kb = 0; kb < 4; ++kb) a2 = mma(wy::ld_k32(pb, P_QS, PQ, 16 * rt, 32 * kb, lane), wy::pack_k32(cst[2 * kb][j], cst[2 * kb + 1][j]), a2);
#pragma unroll
                    for (int r = 0; r < 4; ++r) a1[r] += SC[ml::SC_WI + 16 * rt + 4 * fq + r] * a2[r];
                    num[j] = a1; }
#pragma unroll
                for (int r = 0; r < 4; ++r) { const int t = 16 * rt + 4 * fq + r; const float dn = __shfl(num[2][r], lane & 48);
                    const float rden = __builtin_amdgcn_rcpf(fmaxf(fabsf(dn), SC[ml::SC_EMT + t]));
                    *(LAS bf16*)(hp + t * 64 + fr * 2) = f2bf(num[0][r] * rden); *(LAS bf16*)(hp + t * 64 + (16 + fr) * 2) = f2bf(num[1][r] * rden); }
            }
#pragma unroll
            for (int kt = 0; kt < 8; ++kt) { const bf16x8 k0 = frag(pb, P_KT, PT, 16 * kt, 0, lane), k1 = frag(pb, P_KT, PT, 16 * kt, 32, lane);
#pragma unroll
                for (int j = 0; j < 3; ++j) { cst[kt][j] = cst[kt][j] * wie; cst[kt][j] = mma(k0, vf[j][0], cst[kt][j]); cst[kt][j] = mma(k1, vf[j][1], cst[kt][j]); } }
            { const LAS unsigned char* yp = hp + lane * 64; bf16* up = U + ML_TOK(c, lane) * PU + dir * MW + head * 128 + 32 * w;
#pragma unroll
              for (int i = 0; i < 4; ++i) *(u32x4*)(up + 8 * i) = *(const LAS u32x4*)(yp + 16 * i); }
        }
        LDS_BARRIER();
        if (tid == 256 && c + 1 < nchunk) __hip_atomic_store(f_ack, (unsigned)(c + 2), __ATOMIC_RELAXED, __HIP_MEMORY_SCOPE_AGENT);
    }
    LDS_BARRIER();
#undef ML_TOK
#undef MLC_FETCH
}
}

namespace el {
typedef float f32x4 __attribute__((ext_vector_type(4)));
typedef unsigned u32x4 __attribute__((ext_vector_type(4)));
typedef unsigned u32x2 __attribute__((ext_vector_type(2)));
typedef short bf16x8 __attribute__((ext_vector_type(8)));
__device__ __forceinline__ float wave_sum(float v) {
#pragma unroll
    for (int o = 1; o < 64; o <<= 1) v += __shfl_xor(v, o);
    return v;
}
__device__ __forceinline__ void unpack8(const u32x4 p, float (&f)[8]) {
    f[0] = pg8::bflo(p.x); f[1] = pg8::bfhi(p.x); f[2] = pg8::bflo(p.y); f[3] = pg8::bfhi(p.y); f[4] = pg8::bflo(p.z); f[5] = pg8::bfhi(p.z); f[6] = pg8::bflo(p.w); f[7] = pg8::bfhi(p.w);
}
__device__ __forceinline__ u32x4 pack8(const float (&f)[8]) {
    u32x4 o; o.x = pg8::cvt_pk_bf16(f[0], f[1]); o.y = pg8::cvt_pk_bf16(f[2], f[3]); o.z = pg8::cvt_pk_bf16(f[4], f[5]); o.w = pg8::cvt_pk_bf16(f[6], f[7]); return o;
}
__device__ __forceinline__ void init_phase(LAS unsigned char* lds, CParams& P, int vb, int G) {
    const int tid = threadIdx.x, w = tid >> 6, lane = tid & 63;
    { const size_t n4 = (size_t)NT * D / 4, nc4 = (size_t)NC * D / 4; f32x4* o = (f32x4*)P.out; const f32x4* a = (const f32x4*)P.in[X_PROMPT]; const f32x4* b = (const f32x4*)P.in[X_SAMPLE];
      for (size_t i = (size_t)vb * 512 + tid; i < n4; i += (size_t)G * 512) o[i] = i < nc4 ? a[i] : b[i - nc4]; }
    LAS float* red = (LAS float*)lds;
    constexpr int KW = D / 8;
    for (int it = vb; it < DEPTH * (6 * D / 64); it += G) {
        const int l = it / (6 * D / 64), j = (it % (6 * D / 64)) * 64 + lane;
        const float* wp = P.in[ADA_W] + ((size_t)l * D + w * KW) * 6 * D + j;
        float acc[NCOND];
#pragma unroll
        for (int ci = 0; ci < NCOND; ++ci) acc[ci] = 0.f;
        for (int k = 0; k < KW; ++k) { const float wv = wp[(size_t)k * 6 * D];
#pragma unroll
            for (int ci = 0; ci < NCOND; ++ci) { const float cv = ci == 0 ? P.in[C_CTX][w * KW + k] : P.in[C_LAT][(size_t)(ci - 1) * D + w * KW + k]; acc[ci] += cv * pg8::fsigmoid(cv) * wv; } }
#pragma unroll
        for (int ci = 0; ci < NCOND; ++ci) red[(w * NCOND + ci) * 64 + lane] = acc[ci];
        __syncthreads();
        if (w < NCOND) { float sum = P.in[ADA_B][(size_t)l * 6 * D + j];
#pragma unroll
            for (int ww = 0; ww < 8; ++ww) sum += red[(ww * NCOND + w) * 64 + lane];
            WSP(float, WS_MOD)[((size_t)l * NCOND + w) * 6 * D + j] = sum; }
        __syncthreads();
    }
}
__device__ __forceinline__ int perm5(int n) { return (((n >> 2) & 1) << 4) | (((n >> 3) & 3) << 2) | (n & 3); }
__device__ __forceinline__ void transpose_item(const float* W, int ldw, int nvalid, bf16* dst, int K, int k0, int drow0, bool perm, LAS float* scr, int lane) {
#pragma unroll 8
    for (int i = 0; i < 32; ++i) { const int kk = 2 * i + (lane >> 5), n = lane & 31; scr[kk * 33 + n] = n < nvalid ? W[(size_t)kk * ldw + n] : 0.f; }
    asm volatile("s_waitcnt lgkmcnt(0)" ::: "memory");
    const int c = lane & 7;
#pragma unroll
    for (int j = 0; j < 4; ++j) { const int n = (lane >> 3) + 8 * j; const LAS float* sp = scr + (8 * c) * 33 + n;
        u32x4 o; o.x = pg8::cvt_pk_bf16(sp[0 * 33], sp[1 * 33]); o.y = pg8::cvt_pk_bf16(sp[2 * 33], sp[3 * 33]); o.z = pg8::cvt_pk_bf16(sp[4 * 33], sp[5 * 33]); o.w = pg8::cvt_pk_bf16(sp[6 * 33], sp[7 * 33]);
        *(u32x4*)(dst + (size_t)(drow0 + (perm ? perm5(n) : n)) * K + k0 + 8 * c) = o; }
    asm volatile("s_waitcnt lgkmcnt(0)" ::: "memory");
}
constexpr int WI_0 = (N1P / 32) * (D / 64), WI_1 = WI_0 + (2 * D / 32) * (D / 64), WI_2 = WI_1 + (D / 32) * (MW / 64), WI_3 = WI_2 + (D / 32) * (RW / 64),
              WI_4 = WI_3 + (D / 32) * (D / 64), WI_5 = WI_4 + 2 * (FF / 32) * (D / 64), WI_6 = WI_5 + (D / 32) * (FF / 64), WI_7 = WI_6 + (RW / 32) * (128 / 64), WI_8 = WI_7 + 4 * (RW / 32);
__device__ __forceinline__ void wconv_phase(LAS unsigned char* lds, CParams& P, int l, int vb, int G) {
    const int tid = threadIdx.x, w = tid >> 6, lane = tid & 63;
    LAS float* scr = (LAS float*)(lds + w * 8704);
    for (int it = vb * 8 + w; it < WI_8; it += G * 8) {
        if (it < WI_0) { const int nb = it / (D / 64), kb = it % (D / 64); const int n0 = nb * 32; const int nv = n0 >= N1 ? 0 : (N1 - n0 < 32 ? N1 - n0 : 32);
            transpose_item(P.in[W_IN] + ((size_t)l * D + kb * 64) * PIN + n0, PIN, nv, WSP(bf16, O_WIN1), D, kb * 64, n0, true, scr, lane); }
        else if (it < WI_1) { const int r = it - WI_0, nb = r / (D / 64), kb = r % (D / 64);
            transpose_item(P.in[W_IN] + ((size_t)l * D + kb * 64) * PIN + N1 + nb * 32, PIN, 32, WSP(bf16, O_WIN2), D, kb * 64, nb * 32, true, scr, lane); }
        else if (it < WI_2) { const int r = it - WI_1, nb = r / (MW / 64), kb = r % (MW / 64);
            transpose_item(P.in[PROJ_M] + ((size_t)l * MW + kb * 64) * D + nb * 32, D, 32, WSP(bf16, O_PM), MW, kb * 64, nb * 32, true, scr, lane); }
        else if (it < WI_3) { const int r = it - WI_2, nb = r / (RW / 64), kb = r % (RW / 64);
            transpose_item(P.in[PROJ_R] + ((size_t)l * RW + kb * 64) * D + nb * 32, D, 32, WSP(bf16, O_PR), RW, kb * 64, nb * 32, true, scr, lane); }
        else if (it < WI_4) { const int r = it - WI_3, nb = r / (D / 64), kb = r % (D / 64);
            transpose_item(P.in[W_OUT] + ((size_t)l * D + kb * 64) * D + nb * 32, D, 32, WSP(bf16, O_WO), D, kb * 64, nb * 32, false, scr, lane); }
        else if (it < WI_5) { const int r = it - WI_4, which = r / ((FF / 32) * (D / 64)), r2 = r % ((FF / 32) * (D / 64)), nb = r2 / (D / 64), kb = r2 % (D / 64);
            const int j0 = nb * 32, pn = j0 >> 7, drow0 = pn * 256 + which * 128 + (j0 & 127);
            transpose_item((which ? P.in[FFN_W3] : P.in[FFN_W1]) + ((size_t)l * D + kb * 64) * FF + j0, FF, 32, WSP(bf16, O_W13), D, kb * 64, drow0, true, scr, lane); }
        else if (it < WI_6) { const int r = it - WI_5, nb = r / (FF / 64), kb = r % (FF / 64);
            transpose_item(P.in[FFN_W2] + ((size_t)l * FF + kb * 64) * D + nb * 32, D, 32, WSP(bf16, O_W2), FF, kb * 64, nb * 32, false, scr, lane); }
        else if (it < WI_7) { const int r = it - WI_6, nb = r / 2, kb = r % 2;
            transpose_item(P.in[R_G2] + ((size_t)l * 128 + kb * 64) * RW + nb * 32, RW, 32, WSP(bf16, O_G2T), 128, kb * 64, nb * 32, false, scr, lane); }
        else { const int r = it - WI_7, which = r / (2 * (RW / 32)), d = (r / (RW / 32)) & 1, nb = r % (RW / 32);
            transpose_item((which ? P.in[R_A2] : P.in[R_W2]) + ((size_t)l * 2 + d) * 64 * RW + nb * 32, RW, 32, WSP(bf16, which ? O_A2T : O_W2T) + (size_t)d * RW * 64, 64, 0, nb * 32, false, scr, lane); }
    }
}
__device__ __forceinline__ void norm_phase(CParams& P, int l, int mode, int vb, int G) {
    const int tid = threadIdx.x, w = tid >> 6, lane = tid & 63;
    for (int m = vb * 8 + w; m < NT; m += G * 8) {
        float* xr = P.out + (size_t)m * D;
        f32x4 v[D / 256]; float ss = 0.f;
#pragma unroll
        for (int j = 0; j < D / 256; ++j) { v[j] = *(const f32x4*)(xr + 256 * j + 4 * lane); ss += (v[j][0] * v[j][0] + v[j][1] * v[j][1]) + (v[j][2] * v[j][2] + v[j][3] * v[j][3]); }
        const float rs = 1.0f / sqrtf(wave_sum(ss) * (1.0f / D) + RMS_EPS);
        if (mode == 3) {
#pragma unroll
            for (int j = 0; j < D / 256; ++j) { const f32x4 g = *(const f32x4*)(P.in[FINAL_G] + 256 * j + 4 * lane); *(f32x4*)(xr + 256 * j + 4 * lane) = v[j] * rs * g; }
        } else {
            const int second = (mode == 2); const int cond = seqinfo(seq_of_token(m)).cond;
            const float* gp = P.in[second ? NORM2 : NORM1] + (size_t)l * D; const float* mod = WSP(float, WS_MOD) + ((size_t)l * NCOND + cond) * 6 * D + (second ? 3 * D : 0);
            bf16* o = WSP(bf16, mode == 1 ? WS_RXC : WS_QKC) + (size_t)m * D;
#pragma unroll
            for (int j = 0; j < D / 256; ++j) { const int c = 256 * j + 4 * lane; const f32x4 g = *(const f32x4*)(gp + c), sh = *(const f32x4*)(mod + c), sc = *(const f32x4*)(mod + D + c);
                const f32x4 y = v[j] * rs * g * (sc + 1.0f) + sh; u32x2 pk; pk.x = pg8::cvt_pk_bf16(y[0], y[1]); pk.y = pg8::cvt_pk_bf16(y[2], y[3]); *(u32x2*)(o + c) = pk; }
        }
    }
}
constexpr int CV_NCH = 2 * MW + RIN, CV_NG = CV_NCH / 4, CV_NCHUNK = (CV_NG + 63) / 64, CV_SEG = 16, CV_PAIRS = NC / (2 * CV_SEG);
static_assert(CV_NCHUNK == 12 && NC == NT - NC && GW % CV_SEG == 0 && CT % CV_SEG == 0 && 2 * MW == 1024 && RX_WL == 1536, "conv item layout");
typedef float f32x2 __attribute__((ext_vector_type(2)));
struct CvAct { float alpha, cA, cB, cC, cD; bool any; };
template <int NR> struct CvState { f32x2 wt[NR * 3][2]; f32x2 fw[NR][3][2]; u32x2 p[3][NR]; };
__device__ __forceinline__ void cv_unpk(const u32x2 p, f32x2 (&f)[2]) { f[0].x = pg8::bflo(p.x); f[0].y = pg8::bfhi(p.x); f[1].x = pg8::bflo(p.y); f[1].y = pg8::bfhi(p.y); }
template <int NR> __device__ __forceinline__ u32x2 cv_ld(const bf16* const (&rowp)[NR], const bool (&rok)[NR], int a, int col, int W) {
    const u32x2 zero2 = {0u, 0u};
    return (rok[a] && col >= 0 && col < W) ? *(const u32x2*)(rowp[a] + (size_t)col * PU) : zero2;
}
template <int NR, int S> __device__ __forceinline__ void cv_col(CvState<NR>& st, const bf16* const (&rowp)[NR], const bool (&rok)[NR], int cs, int W, int o, const CvAct& act, bf16* dst) {
#pragma unroll
    for (int a = 0; a < NR; ++a) { cv_unpk(st.p[S][a], st.fw[a][(S + 2) % 3]); const u32x2 zero2 = {0u, 0u}; st.p[S][a] = (o + 4 <= CV_SEG) ? cv_ld<NR>(rowp, rok, a, cs + o + 4, W) : zero2; }
    f32x2 acc[2];
#pragma unroll
    for (int e = 0; e < 2; ++e) acc[e] = st.wt[0][e] * st.fw[0][S][e];
#pragma unroll
    for (int a = 0; a < NR; ++a)
#pragma unroll
        for (int b = 0; b < 3; ++b) if (a + b > 0) {
#pragma unroll
            for (int e = 0; e < 2; ++e) acc[e] = __builtin_elementwise_fma(st.wt[a * 3 + b][e], st.fw[a][(S + b) % 3][e], acc[e]); }
    float v[4] = {acc[0].x, acc[0].y, acc[1].x, acc[1].y};
    if (act.any) {
#pragma unroll
        for (int e = 0; e < 4; ++e) { const float t = __builtin_amdgcn_rcpf(__builtin_amdgcn_exp2f(act.alpha * v[e]) + 1.0f); v[e] = (act.cA * v[e] + act.cB) * t + (act.cC * v[e] + act.cD); }
    }
    u32x2 pk; pk.x = pg8::cvt_pk_bf16(v[0], v[1]); pk.y = pg8::cvt_pk_bf16(v[2], v[3]);
    *(u32x2*)dst = pk;
}
template <int NR> __device__ __forceinline__ void conv_item(const bf16* const (&rowp)[NR], const bool (&rok)[NR], int cs, int W, const float* wsrc, int CH, const CvAct& act, bf16* dst, int dpitch) {
    CvState<NR> st;
#pragma unroll
    for (int a = 0; a < NR * 3; ++a) { const int tap = NR == 3 ? a : 3 + a; const f32x4 w0 = *(const f32x4*)(wsrc + (size_t)tap * CH);
        st.wt[a][0].x = w0[0]; st.wt[a][0].y = w0[1]; st.wt[a][1].x = w0[2]; st.wt[a][1].y = w0[3]; }
#pragma unroll
    for (int a = 0; a < NR; ++a) { cv_unpk(cv_ld<NR>(rowp, rok, a, cs - 1, W), st.fw[a][0]); cv_unpk(cv_ld<NR>(rowp, rok, a, cs, W), st.fw[a][1]); }
#pragma unroll
    for (int s3 = 0; s3 < 3; ++s3)
#pragma unroll
        for (int a = 0; a < NR; ++a) st.p[s3][a] = cv_ld<NR>(rowp, rok, a, cs + 1 + s3, W);
#pragma unroll 1
    for (int o = 0; o < CV_SEG - 1; o += 3) {
        cv_col<NR, 0>(st, rowp, rok, cs, W, o, act, dst + (size_t)o * dpitch);
        cv_col<NR, 1>(st, rowp, rok, cs, W, o + 1, act, dst + (size_t)(o + 1) * dpitch);
        cv_col<NR, 2>(st, rowp, rok, cs, W, o + 2, act, dst + (size_t)(o + 2) * dpitch);
    }
    cv_col<NR, 0>(st, rowp, rok, cs, W, CV_SEG - 1, act, dst + (size_t)(CV_SEG - 1) * dpitch);
}
__device__ __forceinline__ void conv_phase(LAS unsigned char* lds, CParams& P, int l, int vb, int G) {
    const int tid = threadIdx.x, lane = tid & 63;
    const bf16* U = WSP(bf16, WS_U1);
    LAS unsigned* cnt = (LAS unsigned*)lds;
    for (int sp = vb; sp < CV_PAIRS; sp += G) {
        __syncthreads();
        if (tid == 0) *cnt = 0u;
        __syncthreads();
        for (;;) {
            unsigned j = 0; if (lane == 0) j = __hip_atomic_fetch_add(cnt, 1u, __ATOMIC_RELAXED, __HIP_MEMORY_SCOPE_WORKGROUP);
            j = __builtin_amdgcn_readfirstlane(j);
            if (j >= 48u) break;
            const int cls = j / 12, jj = j % 12, lat = (cls & 1) == 0, heavy = cls < 2, ci = jj >> 1, chunk = heavy ? (ci >= 4 ? 6 + ci : ci) : 4 + ci;
            const int seg = (lat ? NC / CV_SEG : 0) + 2 * sp + (jj & 1), g = chunk * 64 + lane;
            if (g >= CV_NG) continue;
            const int ch = 4 * g; const bool isqk = ch < 2 * MW; const int c = isqk ? ch : ch - 2 * MW;
            const int ucol = isqk ? OFF_QK + c : OFF_R + c, CH = isqk ? 2 * MW : RIN;
            const float* wsrc = (isqk ? P.in[M_CONV] : P.in[R_CONV]) + (size_t)l * 9 * CH + c;
            const int kind = isqk ? (c < MW ? 0 : 1) : (c >= RX_GL ? 4 : (c >= RX_AL ? 2 : (c >= RX_WL ? 3 : 2)));
            CvAct act; act.alpha = kind == 3 ? 2.8853900817779268f : -1.4426950408889634f;
            act.cA = kind == 0 ? 0.08838834764831845f : (kind == 1 ? 1.0f : 0.0f); act.cB = kind == 3 ? -2.0f : (kind == 4 ? 1.0f : 0.0f); act.cC = kind == 2 ? 1.0f : 0.0f; act.cD = kind == 3 ? 1.0f : 0.0f;
            act.any = heavy;
            const int m0 = seg * CV_SEG; const SeqInfo q = seqinfo(seq_of_token(m0)); const int t0 = m0 - q.base;
            bf16* dst = isqk ? WSP(bf16, WS_QKC) + (size_t)m0 * (2 * MW) + c : WSP(bf16, WS_RXC) + (size_t)m0 * RIN + c; const int dpitch = isqk ? 2 * MW : RIN;
            if (q.grid) {
                const int r = t0 / GW, cs = t0 % GW, rows = q.T / GW;
                const bf16* rowp[3]; bool rok[3];
#pragma unroll
                for (int a = 0; a < 3; ++a) { const int rr = r + a - 1; rok[a] = rr >= 0 && rr < rows; rowp[a] = U + (size_t)(q.base + (rok[a] ? rr : r) * GW) * PU + ucol; }
                conv_item<3>(rowp, rok, cs, GW, wsrc, CH, act, dst, dpitch);
            } else {
                const bf16* rowp[1] = {U + (size_t)q.base * PU + ucol}; const bool rok[1] = {true};
                conv_item<1>(rowp, rok, t0, q.T, wsrc, CH, act, dst, dpitch);
            }
        }
    }
}
constexpr int PO_ITEMS = (NT / 16) * 2, PO_HC = RW / 2;
__device__ __forceinline__ void post_phase(LAS unsigned char* lds, CParams& P, int l, int vb, int G) {
    const int tid = threadIdx.x, w = tid >> 6, lane = tid & 63, fr = lane & 15, fq = lane >> 4, l32 = lane & 31, th = lane >> 5;
    constexpr int GP = PO_HC * 2 + 16;
    LAS unsigned char* gt = lds + w * (16 * GP);
    const bf16* U = WSP(bf16, WS_U1); const bf16* RX = WSP(bf16, WS_RXC); const bf16* G2T = WSP(bf16, O_G2T); bf16* O = WSP(bf16, WS_QKC);
    for (int it = vb * 8 + w; it < PO_ITEMS; it += G * 8) {
        const int tile = it >> 1, h = it & 1; const size_t tok0 = (size_t)tile * 16;
        bf16x8 af[4];
#pragma unroll
        for (int ks = 0; ks < 4; ++ks) af[ks] = *(const bf16x8*)(RX + (tok0 + fr) * RIN + RX_GL + 32 * ks + 8 * fq);
        for (int ct = 0; ct < PO_HC / 16; ++ct) { f32x4 acc = (f32x4){0.f, 0.f, 0.f, 0.f};
#pragma unroll
            for (int ks = 0; ks < 4; ++ks) acc = ml::mma(af[ks], *(const bf16x8*)(G2T + (size_t)(h * PO_HC + 16 * ct + fr) * 128 + 32 * ks + 8 * fq), acc);
#pragma unroll
            for (int r = 0; r < 4; ++r) *(LAS bf16*)(gt + (4 * fq + r) * GP + (16 * ct + fr) * 2) = f2bf(acc[r]); }
        asm volatile("s_waitcnt lgkmcnt(0)" ::: "memory");
        const int cb = h * PO_HC + 8 * l32;
        float gn[8], gw[8], gb[8], rk[8];
        { const f32x4 a0 = *(const f32x4*)(P.in[M_NORM_G] + (size_t)l * MW + cb), a1 = *(const f32x4*)(P.in[M_NORM_G] + (size_t)l * MW + cb + 4);
          const f32x4 b0 = *(const f32x4*)(P.in[R_GN_W] + (size_t)l * RW + cb), b1 = *(const f32x4*)(P.in[R_GN_W] + (size_t)l * RW + cb + 4);
          const f32x4 c0 = *(const f32x4*)(P.in[R_GN_B] + (size_t)l * RW + cb), c1 = *(const f32x4*)(P.in[R_GN_B] + (size_t)l * RW + cb + 4);
          const f32x4 d0 = *(const f32x4*)(P.in[R_RK] + (size_t)l * RW + cb), d1 = *(const f32x4*)(P.in[R_RK] + (size_t)l * RW + cb + 4);
#pragma unroll
          for (int e = 0; e < 4; ++e) { gn[e] = a0[e]; gn[4 + e] = a1[e]; gw[e] = b0[e]; gw[4 + e] = b1[e]; gb[e] = c0[e]; gb[4 + e] = c1[e]; rk[e] = d0[e]; rk[4 + e] = d1[e]; } }
        for (int tp = 0; tp < 8; ++tp) { const int tl = 2 * tp + th; const size_t m = tok0 + tl; const bf16* u = U + m * PU; const bf16* rx = RX + m * RIN;
            float hf[8], hb[8], ov[8], x[8]; unpack8(*(const u32x4*)(u + cb), hf); unpack8(*(const u32x4*)(u + MW + cb), hb); unpack8(*(const u32x4*)(u + OFF_O + cb), ov);
            float ss = 0.f;
#pragma unroll
            for (int e = 0; e < 8; ++e) { x[e] = hf[e] + hb[e]; ss += x[e] * x[e]; }
            ss = rw::allsum16(ss); const float rs = 1.0f / sqrtf(ss * (1.0f / 128.f) + RMS_EPS);
#pragma unroll
            for (int e = 0; e < 8; ++e) x[e] = x[e] * rs * gn[e] * pg8::fsigmoid(ov[e]);
            *(u32x4*)(O + m * D + cb) = pack8(x);
            float yf[8], yb[8], rr[8], kk[8], vv[8], gg[8], y[8]; unpack8(*(const u32x4*)(u + OFF_R + cb), yf); unpack8(*(const u32x4*)(u + OFF_R + RW + cb), yb);
            unpack8(*(const u32x4*)(rx + RX_R + cb), rr); unpack8(*(const u32x4*)(rx + RX_K + cb), kk); unpack8(*(const u32x4*)(rx + RX_V + cb), vv);
            unpack8(*(const LAS u32x4*)(gt + tl * GP + l32 * 16), gg);
            float mu = 0.f, bs = 0.f;
#pragma unroll
            for (int e = 0; e < 8; ++e) { y[e] = yf[e] + yb[e]; mu += y[e]; bs += rr[e] * kk[e] * rk[e]; }
            mu += rw::dpp_xor1(mu); mu += rw::dpp_xor2(mu); mu += __shfl_xor(mu, 4); mu *= (1.0f / 64.f);
            bs += rw::dpp_xor1(bs); bs += rw::dpp_xor2(bs); bs += __shfl_xor(bs, 4);
            float var = 0.f;
#pragma unroll
            for (int e = 0; e < 8; ++e) { y[e] -= mu; var += y[e] * y[e]; }
            var += rw::dpp_xor1(var); var += rw::dpp_xor2(var); var += __shfl_xor(var, 4); var *= (1.0f / 64.f);
            const float rsd = 1.0f / sqrtf(var + GN_EPS);
#pragma unroll
            for (int e = 0; e < 8; ++e) y[e] = (y[e] * rsd * gw[e] + gb[e] + bs * vv[e]) * gg[e];
            *(u32x4*)(O + m * D + MW + cb) = pack8(y);
        }
        asm volatile("s_waitcnt lgkmcnt(0)" ::: "memory");
    }
}
}

constexpr int LDS_BYTES = 147456;
constexpr int LDS_MISC = 147456 - 1024;
constexpr size_t CTL_ZERO_BYTES = 262144;
constexpr int CW_BAR = 4096, CW_Q = 8192;

#define XB_TMO      128
#define XB_XCNT(j)  (256  + 64 * (j))
#define XB_XSUB(j)  (1280 + 64 * (j))
#define XB_XGEN(j)  (2304 + 64 * (j))
#define XB_TOP      3328
#define XB_TOPGEN   3392
#define XCD_BAR_WORDS 3456
#define XB_SPIN_CAP (1u << 18)
__device__ __forceinline__ unsigned xb_ld(unsigned* p)              { return __hip_atomic_load(p, __ATOMIC_RELAXED, __HIP_MEMORY_SCOPE_AGENT); }
__device__ __forceinline__ unsigned xb_add(unsigned* p, unsigned v) { return __hip_atomic_fetch_add(p, v, __ATOMIC_RELAXED, __HIP_MEMORY_SCOPE_AGENT); }
__device__ __forceinline__ unsigned xb_xcc_id() { return (unsigned)__builtin_amdgcn_s_getreg((3 << 11) | 20) & 0xFu; }
#define XB_SPIN(cond, bar) do { unsigned _sp = 0; while (cond) { __builtin_amdgcn_s_sleep(1); \
    if ((++_sp & 255u) == 0u) { if (xb_ld(&(bar)[XB_TMO])) break; if (_sp > XB_SPIN_CAP) { atomicAdd(&(bar)[XB_TMO], 1u); break; } } } } while (0)
struct XcdBarrier { unsigned* bar; unsigned x; volatile LAS unsigned* st; };
__device__ __forceinline__ XcdBarrier xcd_barrier_post(unsigned* bar, volatile LAS unsigned* st) {
    XcdBarrier b; b.bar = bar; b.x = xb_xcc_id(); b.st = st;
    if (threadIdx.x == 0) (void)xb_add(&bar[XB_XCNT(b.x)], 1u);
    return b;
}
__device__ __forceinline__ void xcd_barrier_complete(unsigned* bar, unsigned x, unsigned& nloc, unsigned& nx) {
    const unsigned G = gridDim.x * gridDim.y * gridDim.z;
    unsigned sum, cnt, mine, sp = 0u;
    for (;;) {
        sum = 0u; cnt = 0u; mine = 0u;
#pragma unroll
        for (unsigned j = 0; j < 16; ++j) { const unsigned c = xb_ld(&bar[XB_XCNT(j)]); sum += c; cnt += (c > 0u) ? 1u : 0u; mine = (j == x) ? c : mine; }
        if (sum == G) break;
        __builtin_amdgcn_s_sleep(1);
        if ((++sp & 255u) == 0u) { if (xb_ld(&bar[XB_TMO])) break; if (sp > XB_SPIN_CAP) { atomicAdd(&bar[XB_TMO], 1u); break; } }
    }
    nloc = mine > 0u ? mine : 1u; nx = cnt > 0u ? cnt : 1u;
}
__device__ __forceinline__ void xcd_barrier(const XcdBarrier& b) {
    asm volatile("s_waitcnt vmcnt(0)" ::: "memory");
    __syncthreads();
    if (threadIdx.x == 0) {
        unsigned* bar = b.bar;
        __builtin_amdgcn_s_waitcnt(0);
        unsigned nloc = b.st[0], nx = b.st[1];
        if (nloc == 0u) { xcd_barrier_complete(bar, b.x, nloc, nx); b.st[0] = nloc; b.st[1] = nx; }
        const unsigned old = xb_add(&bar[XB_XSUB(b.x)], 1u);
        const unsigned gen = old / nloc;
        if (old + 1u == (gen + 1u) * nloc) {
            __builtin_amdgcn_fence(__ATOMIC_RELEASE, "agent");
            asm volatile("s_waitcnt vmcnt(0)" ::: "memory");
            const unsigned og = xb_add(&bar[XB_TOP], 1u);
            const unsigned tg = og / nx;
            if (og + 1u == (tg + 1u) * nx) xb_add(&bar[XB_TOPGEN], 1u);
            else XB_SPIN(xb_ld(&bar[XB_TOPGEN]) == tg, bar);
            __builtin_amdgcn_fence(__ATOMIC_ACQUIRE, "agent");
            xb_add(&bar[XB_XGEN(b.x)], 1u);
            asm volatile("s_waitcnt vmcnt(0)" ::: "memory");
        } else {
            XB_SPIN(xb_ld(&bar[XB_XGEN(b.x)]) == gen, bar);
            __builtin_amdgcn_fence(__ATOMIC_ACQUIRE, "agent");
            asm volatile("s_waitcnt vmcnt(0)" ::: "memory");
        }
    }
    __syncthreads();
}

constexpr int MX_RL = LB * RH * 2 * 4, MX_ML = LB * MH * 2 * ml::NVB, MX_RC = CB * RH * 2 * 4, MX_MC = CB * MH * 2 * ml::NVB;
constexpr int MX_ITEMS = MX_RL + MX_ML + MX_RC + MX_MC;

constexpr int ML_SPLIT = 0;
__device__ __forceinline__ void scan_phase(LAS unsigned char* lds, CParams& P, int l, unsigned* ctl) {
    unsigned* qhead = ctl + CW_Q + 64 * l;
    volatile LAS unsigned* bc = (volatile LAS unsigned*)(lds + LDS_MISC) + 16;
    for (;;) {
        if (threadIdx.x == 0) bc[0] = xb_add(qhead, 1u);
        __syncthreads();
        const int it = (int)bc[0];
        __syncthreads();
        if (it >= wy::N_LAT) break;
        int s_, head, dir; wy::decode_item(it, s_, head, dir);
        wy::rwkv_cons(lds, P, l, s_, head, dir, it, ctl);
    }
    for (;;) {
        if (threadIdx.x == 0) bc[0] = xb_add(qhead + 8, 1u);
        __syncthreads();
        const int it = (int)bc[0];
        __syncthreads();
        if (it >= ML_SPLIT * ms::N_MLAT) break;
        int s_, head, dir, sub; ml::decode_item(it * ml::NVB, s_, head, dir, sub);
        ms::ml_cons(lds, P, l, s_, head, dir, it, ctl);
    }
    for (;;) {
        if (threadIdx.x == 0) bc[0] = xb_add(qhead + 48, 1u);
        __syncthreads();
        const int it = (int)bc[0];
        __syncthreads();
        if (it >= wy::N_LAT * wy::NPROD) break;
        const int chain = it % wy::N_LAT;
        int s_, head, dir; wy::decode_item(chain, s_, head, dir);
        wy::rwkv_prod(lds, P, l, s_, head, dir, chain, it / wy::N_LAT, ctl);
    }
    for (;;) {
        if (threadIdx.x == 0) bc[0] = xb_add(qhead + 24, 1u);
        __syncthreads();
        const int it = (int)bc[0];
        __syncthreads();
        if (it >= ML_SPLIT * ms::N_MLAT * ms::MLPROD) break;
        const int chain = it % ms::N_MLAT;
        int s_, head, dir, sub; ml::decode_item(chain * ml::NVB, s_, head, dir, sub);
        ms::ml_prod(lds, P, l, s_, head, dir, chain, it / ms::N_MLAT, ctl);
    }
    for (;;) {
        if (threadIdx.x == 0) bc[0] = xb_add(qhead + 16, 1u);
        __syncthreads();
        const int it = (int)bc[0] + ML_SPLIT * ms::N_MLAT * ml::NVB;
        __syncthreads();
        if (it >= ml::N_ITEMS) break;
        int s_, head, dir, sub; ml::decode_item(it, s_, head, dir, sub);
        ml::mlstm_item2(lds, P, l, s_, head, dir, sub);
    }
    for (;;) {
        if (threadIdx.x == 0) bc[0] = xb_add(qhead + 32, 1u);
        __syncthreads();
        const int it = (int)bc[0] + LB * RH * 2;
        __syncthreads();
        if (it >= wy::N_ITEMS) break;
        int s_, head, dir; wy::decode_item(it, s_, head, dir);
        wy::rwkv_item(lds, P, l, s_, head, dir);
    }
}

enum { ST_N0 = 0, ST_A1, ST_CV, ST_MX, ST_PO, ST_N1, ST_A2, ST_PJ, ST_WO, ST_N2, ST_F1, ST_F2, ST_PER_LAYER };
constexpr int N_STEPS = 1 + DEPTH * ST_PER_LAYER + 1;
struct MkArgs { Params P; int ph_lo, ph_hi; };
__global__ void __launch_bounds__(512, 2) mk(MkArgs a) {
    extern __shared__ __attribute__((aligned(16))) unsigned char lds_raw[];
    LAS unsigned char* lds = (LAS unsigned char*)lds_raw;
    const int G = gridDim.x, vb = (int)blockIdx.x;
    unsigned* ctl = (unsigned*)(a.P.ws + WS_CTL);
    volatile LAS unsigned* MISC = (volatile LAS unsigned*)(lds + LDS_MISC);
    for (int u = threadIdx.x; u < 64; u += 512) MISC[u] = 0u;
    __syncthreads();
    const bool multi = a.ph_hi - a.ph_lo > 1;
    XcdBarrier bar; bar.bar = ctl + CW_BAR; bar.x = 0; bar.st = nullptr;
    if (multi) bar = xcd_barrier_post(ctl + CW_BAR, MISC + 8);
    const int lo = a.ph_lo, hi = a.ph_hi;
#define STEP_BEGIN(id) if (lo <= (id) && (id) < hi) { unsigned long long kp_ = (unsigned long long)__builtin_amdgcn_kernarg_segment_ptr(); asm volatile("" : "+s"(kp_)); CParams& P = *(CParams*)kp_;
#define STEP_END(id) if ((id) + 1 < hi) xcd_barrier(bar); }
    STEP_BEGIN(0) el::init_phase(lds, P, vb, G); el::wconv_phase(lds, P, 0, vb, G); STEP_END(0)
#define LAYER(l) { \
        const int base = 1 + (l) * ST_PER_LAYER; \
        STEP_BEGIN(base + ST_N0) if ((l) > 0) el::wconv_phase(lds, P, (l), vb, G); el::norm_phase(P, (l), 0, vb, G); STEP_END(base + ST_N0) \
        STEP_BEGIN(base + ST_A1) { pg8::Gemm g{WSP(bf16, WS_QKC), WSP(bf16, O_WIN1), D, D}; pg8::StaticOrder S; S.init(NT, N1P, G, vb); \
            pg8::EpiA1 E{WSP(bf16, WS_U1)}; pg8::gemm_phase(lds, g, S, E); } STEP_END(base + ST_A1) \
        STEP_BEGIN(base + ST_CV) el::conv_phase(lds, P, (l), vb, G); STEP_END(base + ST_CV) \
        STEP_BEGIN(base + ST_MX) scan_phase(lds, P, (l), ctl); STEP_END(base + ST_MX) \
        STEP_BEGIN(base + ST_PO) el::post_phase(lds, P, (l), vb, G); STEP_END(base + ST_PO) \
        STEP_BEGIN(base + ST_N1) el::norm_phase(P, (l), 1, vb, G); STEP_END(base + ST_N1) \
        STEP_BEGIN(base + ST_A2) { pg8::Gemm g{WSP(bf16, WS_RXC), WSP(bf16, O_WIN2), D, D}; pg8::StaticOrder S; S.init(NT, 2 * D, G, vb); \
            pg8::EpiA2 E{WSP(bf16, WS_U1)}; pg8::gemm_phase(lds, g, S, E); } STEP_END(base + ST_A2) \
        STEP_BEGIN(base + ST_PJ) { pg8::Gemm g{WSP(bf16, WS_QKC), WSP(bf16, O_PM), MW, D}; pg8::PairOrder S; S.init(NT, G, vb); \
            pg8::EpiPJ E{WSP(bf16, WS_U1)}; pg8::gemm_phase(lds, g, S, E); } STEP_END(base + ST_PJ) \
        STEP_BEGIN(base + ST_WO) { pg8::Gemm g{WSP(bf16, WS_U1), WSP(bf16, O_WO), D, PU}; pg8::StaticOrder S; S.init(NT, D, G, vb); \
            pg8::EpiRes E{P.out, WSP(float, WS_MOD) + (size_t)(l) * NCOND * 6 * D + 2 * D}; pg8::gemm_phase(lds, g, S, E); } STEP_END(base + ST_WO) \
        STEP_BEGIN(base + ST_N2) el::norm_phase(P, (l), 2, vb, G); STEP_END(base + ST_N2) \
        STEP_BEGIN(base + ST_F1) { pg8::Gemm g{WSP(bf16, WS_QKC), WSP(bf16, O_W13), D, D}; pg8::StaticOrder S; S.init(NT, 2 * FF, G, vb); \
            pg8::EpiF1 E{WSP(bf16, WS_U1)}; pg8::gemm_phase(lds, g, S, E); } STEP_END(base + ST_F1) \
        STEP_BEGIN(base + ST_F2) { pg8::Gemm g{WSP(bf16, WS_U1), WSP(bf16, O_W2), FF, FF}; pg8::StaticOrder S; S.init(NT, D, G, vb); \
            pg8::EpiRes E{P.out, WSP(float, WS_MOD) + (size_t)(l) * NCOND * 6 * D + 5 * D}; pg8::gemm_phase(lds, g, S, E); } STEP_END(base + ST_F2) \
    }
    static_assert(DEPTH == 2, "layers are unrolled by hand");
    LAYER(0)
    LAYER(1)
#undef LAYER
    STEP_BEGIN(N_STEPS - 1) el::norm_phase(P, 0, 3, vb, G); STEP_END(N_STEPS - 1)
#undef STEP_BEGIN
#undef STEP_END
}
#endif

typedef void (*BodyFn)(const Params&, long);
#ifndef HOST_EMU
template <BodyFn F, int BLOCK> __global__ void __launch_bounds__(BLOCK) run_k(Params P, long n) {
    const long i = (long)blockIdx.x * BLOCK + threadIdx.x;
    if (i < n) F(P, i);
}
#define RUN(F, BLOCK, n) do { const long n_ = (n); run_k<F, BLOCK><<<dim3((unsigned)((n_ + BLOCK - 1) / BLOCK)), dim3(BLOCK), 0, stream>>>(P, n_); } while (0)
static int g_grid = 0;
#else
#define RUN(F, BLOCK, n) do { const long n_ = (n); for (long i_ = 0; i_ < n_; ++i_) F(P, i_); } while (0)
typedef void* hipStream_t;
#endif

static void forward(Params P, hipStream_t stream) {
    (void)stream;
#ifndef HOST_EMU
    if (hipMemsetAsync(P.ws + WS_CTL, 0, CTL_ZERO_BYTES, stream) != hipSuccess) return;
#ifdef MK_PER_STEP
    for (int st = 0; st < N_STEPS; ++st) { MkArgs a_{}; a_.P = P; a_.ph_lo = st; a_.ph_hi = st + 1; mk<<<dim3(g_grid), dim3(512), LDS_BYTES, stream>>>(a_); }
#else
    { MkArgs a_{}; a_.P = P; a_.ph_lo = 0; a_.ph_hi = N_STEPS; mk<<<dim3(g_grid), dim3(512), LDS_BYTES, stream>>>(a_); }
#endif
#else
    RUN(k_init_x, 256, (long)NT * D);
    RUN(k_mod, 256, (long)DEPTH * NCOND * 6 * D);
    for (int l = 0; l < DEPTH; ++l) {
        P.layer = l;
        RUN(k_wconv, 256, WC_N6);
        P.mode = 0; RUN(k_norm, 64, (long)NT);
        RUN(k_gemm_a1, 256, (long)NT * N1);
        RUN(k_conv, 256, (long)NT * (2 * MW + RIN));
        RUN(k_mlstm, 128, (long)NSEQ * MH * 2 * 128);
        for (int dir = 0; dir < 2; ++dir) { P.mode = dir; RUN(k_rwkv_prep, 256, (long)NT * RW); RUN(k_rwkv, 64, (long)NSEQ * RH * 64); }
        RUN(k_post, 256, (long)NT * D);
        P.mode = 1; RUN(k_norm, 64, (long)NT);
        RUN(k_gemm_a2, 256, (long)NT * 2 * D);
        RUN(k_gemm_pj, 256, (long)NT * D);
        RUN(k_gemm_wo, 256, (long)NT * D);
        P.mode = 2; RUN(k_norm, 64, (long)NT);
        RUN(k_gemm_f1, 256, (long)NT * FF);
        RUN(k_gemm_f2, 256, (long)NT * D);
    }
    RUN(k_final, 64, (long)NT);
#endif
}

#ifndef HOST_EMU
extern "C" void kernel_launch(void* const* d_in, const int* in_sizes, int n_in, void* d_out, int out_size, void* d_ws, size_t ws_size, hipStream_t stream) {
    if (n_in != N_IN || (size_t)out_size != OUT_END || ws_size < WS_END) return;
    if (g_grid == 0) {
        int dev = 0, cus = 0;
        if (hipGetDevice(&dev) != hipSuccess || hipDeviceGetAttribute(&cus, hipDeviceAttributeMultiprocessorCount, dev) != hipSuccess) { g_grid = -1; return; }
        if (hipFuncSetAttribute((const void*)mk, hipFuncAttributeMaxDynamicSharedMemorySize, LDS_BYTES) != hipSuccess) { g_grid = -1; return; }
        g_grid = cus;
    }
    if (g_grid < 0) return;
    Params P{};
    for (int i = 0; i < N_IN; ++i) P.in[i] = (const float*)d_in[i];
    P.out = (float*)d_out; P.ws = (unsigned char*)d_ws; P.layer = 0; P.mode = 0;
    forward(P, stream);
}
#endif
```

```cpp
#ifndef HOST_EMU
#include <hip/hip_runtime.h>
#define HD __host__ __device__ __forceinline__
#define DEV __device__ __forceinline__
#else
#include <cmath>
#include <cstring>
#include <cstdio>
#include <cstdlib>
#define HD inline
#define DEV inline
#endif
#include <cstddef>

#ifdef SMALL_CFG
constexpr int D = 256, CB = 2, CT = 128, DEPTH = 2, LB = 1, LT = 256, GW = 16;
#else
constexpr int D = 1024, CB = 32, CT = 256, DEPTH = 2, LB = 2, LT = 4096, GW = 64;
#endif
constexpr int MW = D / 2, MD = 128, MH = MW / MD, RW = D / 2, RD = 64, RH = RW / RD;
constexpr int RIN = 3 * RW + 384, FF = ((8 * D + 767) / 768) * 256, PIN = 2 * MW + MW + MW + 4 * MH + RIN + 2 * D;
constexpr int NC = CB * CT, NL = LB * LT, NT = NC + NL, NSEQ = CB + LB, NCOND = 1 + LB;
constexpr int N1 = PIN - 2 * D;
constexpr int N1P = ((N1 + 255) / 256) * 256;
constexpr int PU = N1;
constexpr int OFF_QK = 0, OFF_V = 2 * MW, OFF_O = 3 * MW, OFF_G = 4 * MW, OFF_R = 4 * MW + 4 * MH;
constexpr int RX_R = 0, RX_K = RW, RX_V = 2 * RW, RX_WL = 3 * RW, RX_AL = 3 * RW + 128, RX_GL = 3 * RW + 256;
constexpr float RMS_EPS = 1e-6f, GN_EPS = 64e-5f;
static_assert(3 * D <= N1, "G + merged must fit the dead columns of U1");

enum { X_PROMPT = 0, X_SAMPLE, ST_C, ST_N, ST_M, ST_R, C_LAT, C_CTX, ADA_W, ADA_B, NORM1, NORM2, W_IN, M_CONV, M_GATE_B, M_NORM_G,
       R_CONV, R_W0, R_W2, R_A0, R_A2, R_G2, R_KK, R_KA, R_RK, R_GN_W, R_GN_B, PROJ_M, PROJ_R, W_OUT, FFN_W1, FFN_W3, FFN_W2, FINAL_G, N_IN };

constexpr size_t OUT_X = 0;
constexpr size_t OUT_C = (size_t)NT * D;
constexpr size_t OUT_N = OUT_C + (size_t)CB * DEPTH * 2 * MH * 128 * 128;
constexpr size_t OUT_M = OUT_N + (size_t)CB * DEPTH * 2 * MH * 128;
constexpr size_t OUT_S = OUT_M + (size_t)CB * DEPTH * 2 * MH;
constexpr size_t OUT_END = OUT_S + (size_t)CB * DEPTH * 2 * RH * 64 * 64;

constexpr size_t al256(size_t x) { return (x + 255) & ~(size_t)255; }
constexpr size_t cmax(size_t a, size_t b) { return a > b ? a : b; }
constexpr size_t WS_CTL = 0;
constexpr size_t WS_MOD = (size_t)1 << 20;
constexpr size_t WS_WREG = (size_t)2 << 20;
constexpr size_t O_WIN1 = WS_WREG;
constexpr size_t O_WIN2 = O_WIN1 + (size_t)N1P * D * 2;
constexpr size_t O_PM = O_WIN2 + (size_t)2 * D * D * 2;
constexpr size_t O_PR = O_PM + (size_t)D * MW * 2;
constexpr size_t O_WO = O_PR + (size_t)D * RW * 2;
constexpr size_t O_W13 = O_WO + (size_t)D * D * 2;
constexpr size_t O_W2 = O_W13 + (size_t)2 * FF * D * 2;
constexpr size_t O_G2T = O_W2 + (size_t)D * FF * 2;
constexpr size_t O_W2T = O_G2T + (size_t)RW * 128 * 2;
constexpr size_t O_A2T = O_W2T + (size_t)2 * RW * 64 * 2;
constexpr size_t WS_U1 = al256(O_A2T + (size_t)2 * RW * 64 * 2);
constexpr size_t SZ_U1 = al256(cmax((size_t)NT * PU * 2, (size_t)NT * FF * 2));
constexpr size_t WS_QKC = WS_U1 + SZ_U1;
constexpr size_t WS_RXC = WS_QKC + (size_t)NT * D * 2;
constexpr size_t WS_END = WS_RXC + al256(cmax((size_t)NT * RIN * 2, (size_t)NT * D * 2));
#ifndef SMALL_CFG
static_assert(WS_END <= ((size_t)256 << 20), "workspace map must fit 256 MiB");
#endif

typedef unsigned short bf16;
HD float bf2f(bf16 b) { unsigned u = ((unsigned)b) << 16; return __builtin_bit_cast(float, u); }
#if defined(__HIP_DEVICE_COMPILE__)
HD bf16 f2bf(float f) { return __builtin_bit_cast(bf16, (__bf16)f); }
#else
HD bf16 f2bf(float f) { unsigned u = __builtin_bit_cast(unsigned, f); u += 0x7fffu + ((u >> 16) & 1u); return (bf16)(u >> 16); }
#endif
HD float sigmoidf_(float x) { return 1.0f / (1.0f + expf(-x)); }
HD float siluf_(float x) { return x / (1.0f + expf(-x)); }
HD float softplusf_(float x) { return fmaxf(x, 0.f) + log1pf(expf(-fabsf(x))); }
HD float logsigmoidf_(float x) { return -softplusf_(-x); }
HD int prow(int c) { return (c & ~31) | (((c >> 2) & 1) << 4) | (((c >> 3) & 3) << 2) | (c & 3); }

struct Params {
    const float* in[N_IN];
    float* out;
    unsigned char* ws;
    int layer;
    int mode;
};

struct SeqInfo { int T; int base; int grid; int cond; int b; };
HD SeqInfo seqinfo(int s) {
    SeqInfo q;
    if (s < CB) { q.T = CT; q.base = s * CT; q.grid = 0; q.cond = 0; q.b = s; }
    else { q.T = LT; q.base = NC + (s - CB) * LT; q.grid = 1; q.cond = 1 + (s - CB); q.b = s - CB; }
    return q;
}
HD int seq_of_token(int m) { return m < NC ? m / CT : CB + (m - NC) / LT; }

#define WSP(T, off) ((T*)(P.ws + (off)))

DEV void k_init_x(const Params& P, long i) {
    const size_t ncd = (size_t)NC * D;
    P.out[i] = (size_t)i < ncd ? P.in[X_PROMPT][i] : P.in[X_SAMPLE][i - ncd];
}
DEV void k_mod(const Params& P, long i) {
    const int j = (int)(i % (6 * D)); const int ci = (int)((i / (6 * D)) % NCOND); const int l = (int)(i / ((long)6 * D * NCOND));
    const float* cv = ci == 0 ? P.in[C_CTX] : P.in[C_LAT] + (size_t)(ci - 1) * D;
    const float* w = P.in[ADA_W] + (size_t)l * D * 6 * D;
    float acc = P.in[ADA_B][(size_t)l * 6 * D + j];
    for (int k = 0; k < D; ++k) acc += siluf_(cv[k]) * w[(size_t)k * 6 * D + j];
    WSP(float, WS_MOD)[i] = acc;
}
constexpr long WC_N0 = (long)N1P * D, WC_N1 = WC_N0 + (long)2 * D * D, WC_N2 = WC_N1 + (long)D * MW, WC_N3 = WC_N2 + (long)D * RW,
               WC_N4 = WC_N3 + (long)D * D, WC_N5 = WC_N4 + (long)2 * FF * D, WC_N6 = WC_N5 + (long)D * FF;
HD int unprow(int r) { return (r & ~31) | (((r >> 2) & 3) << 3) | (((r >> 4) & 1) << 2) | (r & 3); }
DEV void k_wconv(const Params& P, long i) {
    const int l = P.layer;
    if (i < WC_N0) { const int r = (int)(i / D), k = (int)(i % D); const int c = unprow(r);
        WSP(bf16, O_WIN1)[i] = c < N1 ? f2bf(P.in[W_IN][((size_t)l * D + k) * PIN + c]) : (bf16)0; return; }
    if (i < WC_N1) { const long j = i - WC_N0; const int r = (int)(j / D), k = (int)(j % D); const int c = unprow(r);
        WSP(bf16, O_WIN2)[j] = f2bf(P.in[W_IN][((size_t)l * D + k) * PIN + N1 + c]); return; }
    if (i < WC_N2) { const long j = i - WC_N1; const int r = (int)(j / MW), k = (int)(j % MW); const int c = unprow(r);
        WSP(bf16, O_PM)[j] = f2bf(P.in[PROJ_M][((size_t)l * MW + k) * D + c]); return; }
    if (i < WC_N3) { const long j = i - WC_N2; const int r = (int)(j / RW), k = (int)(j % RW); const int c = unprow(r);
        WSP(bf16, O_PR)[j] = f2bf(P.in[PROJ_R][((size_t)l * RW + k) * D + c]); return; }
    if (i < WC_N4) { const long j = i - WC_N3; const int r = (int)(j / D), k = (int)(j % D);
        WSP(bf16, O_WO)[j] = f2bf(P.in[W_OUT][((size_t)l * D + k) * D + r]); return; }
    if (i < WC_N5) { const long j = i - WC_N4; const int r = (int)(j / D), k = (int)(j % D);
        const int pn = r >> 8, rl = r & 255, which = rl >> 7, rho = rl & 127; const int jj = pn * 128 + unprow(rho);
        const float* W = which ? P.in[FFN_W3] : P.in[FFN_W1];
        WSP(bf16, O_W13)[j] = f2bf(W[((size_t)l * D + k) * FF + jj]); return; }
    { const long j = i - WC_N5; const int r = (int)(j / FF), k = (int)(j % FF);
        WSP(bf16, O_W2)[j] = f2bf(P.in[FFN_W2][((size_t)l * FF + k) * D + r]); }
}
DEV void k_norm(const Params& P, long m) {
    const int l = P.layer; const int second = (P.mode == 2);
    const float* x = P.out + (size_t)m * D;
    const float* g = P.in[second ? NORM2 : NORM1] + (size_t)l * D;
    const int cond = seqinfo(seq_of_token((int)m)).cond;
    const float* mod = WSP(float, WS_MOD) + ((size_t)l * NCOND + cond) * 6 * D + (second ? 3 * D : 0);
    float ss = 0.f;
    for (int k = 0; k < D; ++k) ss += x[k] * x[k];
    const float rs = 1.0f / sqrtf(ss / D + RMS_EPS);
    bf16* o = WSP(bf16, P.mode == 1 ? WS_RXC : WS_QKC) + (size_t)m * D;
    for (int k = 0; k < D; ++k) o[k] = f2bf(x[k] * rs * g[k] * (1.0f + mod[D + k]) + mod[k]);
}
DEV float dot_bf(const bf16* a, const bf16* b, int K) { float s = 0.f; for (int k = 0; k < K; ++k) s += bf2f(a[k]) * bf2f(b[k]); return s; }
DEV void k_gemm_a1(const Params& P, long i) {
    const int n = (int)(i % N1); const long m = i / N1;
    WSP(bf16, WS_U1)[(size_t)m * PU + n] = f2bf(dot_bf(WSP(bf16, WS_QKC) + (size_t)m * D, WSP(bf16, O_WIN1) + (size_t)prow(n) * D, D));
}
DEV void k_gemm_a2(const Params& P, long i) {
    const int n = (int)(i % (2 * D)); const long m = i / (2 * D);
    WSP(bf16, WS_U1)[(size_t)m * PU + D + n] = f2bf(sigmoidf_(dot_bf(WSP(bf16, WS_RXC) + (size_t)m * D, WSP(bf16, O_WIN2) + (size_t)prow(n) * D, D)));
}
DEV void k_gemm_pj(const Params& P, long i) {
    const int n = (int)(i % D); const long m = i / D;
    const bf16* hmr = WSP(bf16, WS_QKC) + (size_t)m * D; bf16* u = WSP(bf16, WS_U1) + (size_t)m * PU;
    const float a = dot_bf(hmr, WSP(bf16, O_PM) + (size_t)prow(n) * MW, MW), b = dot_bf(hmr + MW, WSP(bf16, O_PR) + (size_t)prow(n) * RW, RW);
    const float first = bf2f(f2bf(bf2f(u[D + n]) * a));
    u[n] = f2bf(first + bf2f(u[2 * D + n]) * b);
}
DEV void k_gemm_wo(const Params& P, long i) {
    const int n = (int)(i % D); const long m = i / D; const int l = P.layer;
    const int cond = seqinfo(seq_of_token((int)m)).cond;
    const float g1 = WSP(float, WS_MOD)[((size_t)l * NCOND + cond) * 6 * D + 2 * D + n];
    P.out[(size_t)m * D + n] += g1 * dot_bf(WSP(bf16, WS_U1) + (size_t)m * PU, WSP(bf16, O_WO) + (size_t)n * D, D);
}
DEV void k_gemm_f1(const Params& P, long i) {
    const int j = (int)(i % FF); const long m = i / FF;
    const int pn = j >> 7, rho = prow(j & 127);
    const bf16* h = WSP(bf16, WS_QKC) + (size_t)m * D;
    const float a = dot_bf(h, WSP(bf16, O_W13) + (size_t)(pn * 256 + rho) * D, D), b = dot_bf(h, WSP(bf16, O_W13) + (size_t)(pn * 256 + 128 + rho) * D, D);
    WSP(bf16, WS_U1)[(size_t)m * FF + j] = f2bf(siluf_(a) * b);
}
DEV void k_gemm_f2(const Params& P, long i) {
    const int n = (int)(i % D); const long m = i / D; const int l = P.layer;
    const int cond = seqinfo(seq_of_token((int)m)).cond;
    const float g2 = WSP(float, WS_MOD)[((size_t)l * NCOND + cond) * 6 * D + 5 * D + n];
    P.out[(size_t)m * D + n] += g2 * dot_bf(WSP(bf16, WS_U1) + (size_t)m * FF, WSP(bf16, O_W2) + (size_t)n * FF, FF);
}
DEV void k_conv(const Params& P, long i) {
    constexpr int NCH = 2 * MW + RIN;
    const int ch = (int)(i % NCH); const int m = (int)(i / NCH); const int l = P.layer;
    const int s = seq_of_token(m); const SeqInfo q = seqinfo(s); const int t = m - q.base;
    const bool isqk = ch < 2 * MW; const int c = isqk ? ch : ch - 2 * MW;
    const int ucol = isqk ? OFF_QK + c : OFF_R + c;
    const int CH = isqk ? 2 * MW : RIN;
    const float* w = (isqk ? P.in[M_CONV] : P.in[R_CONV]) + (size_t)l * 9 * CH;
    const bf16* U = WSP(bf16, WS_U1);
    float acc = 0.f;
    if (q.grid) {
        const int r = t / GW, cc = t % GW, rows = q.T / GW;
        for (int a = 0; a < 3; ++a) for (int b = 0; b < 3; ++b) {
            const int rr = r + a - 1, c2 = cc + b - 1;
            if (rr >= 0 && rr < rows && c2 >= 0 && c2 < GW) acc += w[(a * 3 + b) * CH + c] * bf2f(U[(size_t)(q.base + rr * GW + c2) * PU + ucol]);
        }
    } else {
        for (int b = 0; b < 3; ++b) { const int t2 = t + b - 1; if (t2 >= 0 && t2 < q.T) acc += w[(3 + b) * CH + c] * bf2f(U[(size_t)(q.base + t2) * PU + ucol]); }
    }
    if (isqk) { float v = siluf_(acc); if (c < MW) v *= 0.08838834764831845f; WSP(bf16, WS_QKC)[(size_t)m * (2 * MW) + c] = f2bf(v); }
    else { float v = acc; if (c >= RX_WL && c < RX_AL) v = tanhf(v); else if (c >= RX_GL) v = sigmoidf_(v); WSP(bf16, WS_RXC)[(size_t)m * RIN + c] = f2bf(v); }
}
DEV void k_mlstm(const Params& P, long i) {
    const int e = (int)(i % 128); const int chain = (int)(i / 128); const int dir = chain & 1, head = (chain >> 1) % MH, s = chain / (2 * MH);
    const int l = P.layer; const SeqInfo q = seqinfo(s);
    float C[128], n[128]; float m;
    if (!q.grid) {
#pragma unroll
        for (int d = 0; d < 128; ++d) { C[d] = 0.f; n[d] = 0.f; }
        m = 0.f;
    } else {
        const size_t sb = (((size_t)q.b * DEPTH + l) * 2 + dir) * MH + head;
#pragma unroll
        for (int d = 0; d < 128; ++d) { C[d] = P.in[ST_C][(sb * 128 + d) * 128 + e]; n[d] = P.in[ST_N][sb * 128 + d]; }
        m = P.in[ST_M][sb];
    }
    const float bi = P.in[M_GATE_B][(size_t)l * 4 * MH + (2 * dir) * MH + head], bfg = P.in[M_GATE_B][(size_t)l * 4 * MH + (2 * dir + 1) * MH + head];
    bf16* U = WSP(bf16, WS_U1); const bf16* QK = WSP(bf16, WS_QKC);
    float nsel = 0.f;
    for (int p = 0; p < q.T; ++p) {
        const int t = dir ? q.T - 1 - p : p; const size_t tok = (size_t)(q.base + t);
        const bf16* qk = QK + tok * (2 * MW); bf16* u = U + tok * PU;
        const float gi = bf2f(u[OFF_G + (2 * dir) * MH + head]) + bi, gf = bf2f(u[OFF_G + (2 * dir + 1) * MH + head]) + bfg;
        const float lf = logsigmoidf_(gf);
        const float mn = fmaxf(lf + m, gi); const float fw = expf(lf + m - mn), iw = expf(gi - mn);
        const float v = bf2f(u[OFF_V + head * 128 + e]);
        float num = 0.f, den = 0.f;
#pragma unroll
        for (int d = 0; d < 128; ++d) {
            const float kd = bf2f(qk[MW + head * 128 + d]), qd = bf2f(qk[head * 128 + d]);
            C[d] = fw * C[d] + iw * kd * v; n[d] = fw * n[d] + iw * kd; num += qd * C[d]; den += qd * n[d];
        }
        m = mn;
        u[dir * MW + head * 128 + e] = f2bf(num / fmaxf(fabsf(den), expf(-m)));
    }
    if (!q.grid) {
        const size_t sb = (((size_t)q.b * DEPTH + l) * 2 + dir) * MH + head;
#pragma unroll
        for (int d = 0; d < 128; ++d) { P.out[OUT_C + (sb * 128 + d) * 128 + e] = C[d]; if (d == e) nsel = n[d]; }
        P.out[OUT_N + sb * 128 + e] = nsel;
        if (e == 0) P.out[OUT_M + sb] = m;
    }
}
DEV void k_rwkv_prep(const Params& P, long i) {
    const int c = (int)(i % RW); const size_t tok = (size_t)(i / RW); const int l = P.layer, dir = P.mode;
    const bf16* rx = WSP(bf16, WS_RXC) + tok * RIN;
    const float* w2 = P.in[R_W2] + ((size_t)l * 2 + dir) * 64 * RW + c; const float* a2 = P.in[R_A2] + ((size_t)l * 2 + dir) * 64 * RW + c;
    float wr = P.in[R_W0][((size_t)l * 2 + dir) * RW + c], ar = P.in[R_A0][((size_t)l * 2 + dir) * RW + c];
    for (int j = 0; j < 64; ++j) { wr += bf2f(rx[RX_WL + dir * 64 + j]) * w2[(size_t)j * RW]; ar += bf2f(rx[RX_AL + dir * 64 + j]) * a2[(size_t)j * RW]; }
    bf16* o = WSP(bf16, WS_QKC) + tok * (2 * RW);
    o[c] = f2bf(wr); o[RW + c] = f2bf(ar);
}
DEV void k_rwkv(const Params& P, long i) {
    const int row = (int)(i % 64); const int chain = (int)(i / 64); const int dir = P.mode, head = chain % RH, s = chain / RH;
    const int l = P.layer; const SeqInfo q = seqinfo(s); const int hc = head * 64;
    float S[64];
    if (!q.grid) {
#pragma unroll
        for (int c = 0; c < 64; ++c) S[c] = 0.f;
    } else {
        const size_t sb = (((size_t)q.b * DEPTH + l) * 2 + dir) * RH + head;
#pragma unroll
        for (int c = 0; c < 64; ++c) S[c] = P.in[ST_R][(sb * 64 + row) * 64 + c];
    }
    const float* rkk = P.in[R_KK] + (size_t)l * RW + hc; const float* rka = P.in[R_KA] + (size_t)l * RW + hc;
    bf16* U = WSP(bf16, WS_U1); const bf16* RX = WSP(bf16, WS_RXC); const bf16* WA = WSP(bf16, WS_QKC);
    for (int p = 0; p < q.T; ++p) {
        const int t = dir ? q.T - 1 - p : p; const size_t tok = (size_t)(q.base + t);
        const bf16* rx = RX + tok * RIN; const bf16* wa = WA + tok * (2 * RW);
        float ss = 0.f;
        for (int c = 0; c < 64; ++c) { const float kc = bf2f(rx[RX_K + hc + c]) * rkk[c]; ss += kc * kc; }
        const float inv = 1.0f / fmaxf(sqrtf(ss), 1e-12f);
        float sa = 0.f;
#pragma unroll
        for (int c = 0; c < 64; ++c) sa -= S[c] * (bf2f(rx[RX_K + hc + c]) * rkk[c] * inv);
        const float v = bf2f(rx[RX_V + hc + row]);
        float y = 0.f;
#pragma unroll
        for (int c = 0; c < 64; ++c) {
            const float wr = bf2f(wa[hc + c]), ar = bf2f(wa[RW + hc + c]);
            const float decay = expf(-0.6065306597126334f * sigmoidf_(wr));
            const float alpha = sigmoidf_(ar);
            const float kr = bf2f(rx[RX_K + hc + c]);
            const float kt = kr * (1.0f + (alpha - 1.0f) * rka[c]);
            const float bb = kr * rkk[c] * inv * alpha;
            S[c] = S[c] * decay + sa * bb + v * kt;
            y += S[c] * bf2f(rx[RX_R + hc + c]);
        }
        U[tok * PU + OFF_R + dir * RW + hc + row] = f2bf(y);
    }
    if (!q.grid) {
        const size_t sb = (((size_t)q.b * DEPTH + l) * 2 + dir) * RH + head;
#pragma unroll
        for (int c = 0; c < 64; ++c) P.out[OUT_S + (sb * 64 + row) * 64 + c] = S[c];
    }
}
DEV void k_post(const Params& P, long i) {
    const int ch = (int)(i % D); const size_t m = (size_t)(i / D); const int l = P.layer;
    const bf16* u = WSP(bf16, WS_U1) + m * PU; const bf16* rx = WSP(bf16, WS_RXC) + m * RIN;
    bf16* o = WSP(bf16, WS_QKC) + m * D;
    if (ch < MW) {
        const int h0 = (ch / 128) * 128; float ss = 0.f;
        for (int d = 0; d < 128; ++d) { const float x = bf2f(u[h0 + d]) + bf2f(u[MW + h0 + d]); ss += x * x; }
        const float x = bf2f(u[ch]) + bf2f(u[MW + ch]);
        o[ch] = f2bf(x / sqrtf(ss / 128.f + RMS_EPS) * P.in[M_NORM_G][(size_t)l * MW + ch] * sigmoidf_(bf2f(u[OFF_O + ch])));
    } else {
        const int c = ch - MW; const int h0 = (c / 64) * 64;
        float mu = 0.f, bsum = 0.f;
        for (int d = 0; d < 64; ++d) { mu += bf2f(u[OFF_R + h0 + d]) + bf2f(u[OFF_R + RW + h0 + d]);
            bsum += bf2f(rx[RX_R + h0 + d]) * bf2f(rx[RX_K + h0 + d]) * P.in[R_RK][(size_t)l * RW + h0 + d]; }
        mu *= (1.0f / 64.f); float var = 0.f;
        for (int d = 0; d < 64; ++d) { const float x = bf2f(u[OFF_R + h0 + d]) + bf2f(u[OFF_R + RW + h0 + d]) - mu; var += x * x; }
        var *= (1.0f / 64.f);
        const float y = bf2f(u[OFF_R + c]) + bf2f(u[OFF_R + RW + c]);
        const float yn = (y - mu) / sqrtf(var + GN_EPS) * P.in[R_GN_W][(size_t)l * RW + c] + P.in[R_GN_B][(size_t)l * RW + c];
        float gate = 0.f;
        for (int j = 0; j < 128; ++j) gate += bf2f(rx[RX_GL + j]) * P.in[R_G2][((size_t)l * 128 + j) * RW + c];
        o[ch] = f2bf((yn + bsum * bf2f(rx[RX_V + c])) * gate);
    }
}
DEV void k_final(const Params& P, long m) {
    float* x = P.out + (size_t)m * D; float ss = 0.f;
    for (int k = 0; k < D; ++k) ss += x[k] * x[k];
    const float rs = 1.0f / sqrtf(ss / D + RMS_EPS);
    for (int k = 0; k < D; ++k) x[k] = x[k] * rs * P.in[FINAL_G][k];
}


#ifndef HOST_EMU
typedef const __attribute__((address_space(4))) Params CParams;
namespace pg8 {
#define PG8_LAS __attribute__((address_space(3)))
typedef short bf16x8 __attribute__((ext_vector_type(8)));
typedef float f32x4 __attribute__((ext_vector_type(4)));
typedef unsigned u32x4 __attribute__((ext_vector_type(4)));
constexpr int BM = 256, BK = 64, HALF = 128, HTB = HALF * BK * 2, STAGE_BYTES = 8 * HTB, NXCD = 8, WGM = 8;
__device__ __forceinline__ int lds_byte(int r, int c) { const int st = (r >> 4) * 2 + (c >> 5), rr = r & 15, cc = c & 31, ob = rr * 64 + cc * 2; return st * 1024 + (ob ^ (((ob >> 9) & 1) << 5)); }
__device__ __forceinline__ void stage_rc(int b, int& R, int& C) { const int st = b / 1024, sb = b % 1024, swz = sb ^ (((sb >> 9) & 1) << 5); R = (st >> 1) * 16 + swz / 64; C = (st & 1) * 32 + (swz % 64) / 2; }
struct Unit { int pm, pn, aoff; };
struct Gemm { const bf16* A; const bf16* Bt; int K, lda; };
struct StaticOrder {
    int nM, nN, nwg, G, c;
    __device__ __forceinline__ void init(int M, int N, int G_, int c_) { nM = M / BM; nN = N / BM; nwg = nM * nN; G = G_; c = c_; }
    __device__ __forceinline__ bool next(int i, Unit& u) const {
        const long L = (long)i * G + c; if (L >= nwg) return false;
        int wgid = (int)L; { const int q = nwg / NXCD, r = nwg % NXCD, xcd = wgid % NXCD, off = wgid / NXCD; wgid = (xcd < r ? xcd * (q + 1) : r * (q + 1) + (xcd - r) * q) + off; }
        const int nig = WGM * nN, gid = wgid / nig, fm = gid * WGM, gsz = (nM - fm) < WGM ? (nM - fm) : WGM;
        u.pm = fm + ((wgid % nig) % gsz); u.pn = (wgid % nig) / gsz; u.aoff = 0; return true;
    }
};
struct PairOrder {
    int nbase, G, v, nct;
    __device__ __forceinline__ void init(int M, int G_, int c_) { nct = D / BM; nbase = (M / BM) * nct; G = G_; v = (G_ % 8 == 0) ? (c_ % 8) * (G_ / 8) + c_ / 8 : c_; }
    __device__ __forceinline__ bool next(int i, Unit& u) const {
        const int j = v + (i >> 1) * G; if (j >= nbase) return false;
        const int half = i & 1; u.pm = j / nct; u.pn = half * nct + (j % nct); u.aoff = half * MW; return true;
    }
};
typedef float f32x2_t __attribute__((ext_vector_type(2)));
typedef __bf16 bf16x2_t __attribute__((ext_vector_type(2)));
__device__ __forceinline__ unsigned cvt_pk_bf16(float lo, float hi) { f32x2_t v = {lo, hi}; bf16x2_t b = __builtin_convertvector(v, bf16x2_t); return __builtin_bit_cast(unsigned, b); }
__device__ __forceinline__ float fsigmoid(float x) { return __builtin_amdgcn_rcpf(1.0f + __expf(-x)); }
__device__ __forceinline__ float bflo(unsigned w) { return __builtin_bit_cast(float, w << 16); }
__device__ __forceinline__ float bfhi(unsigned w) { return __builtin_bit_cast(float, w & 0xffff0000u); }

struct EpiA1 {
    bf16* U;
    __device__ __forceinline__ void operator()(const f32x4 (&acc)[2][2][4][2], const Unit& u, int wr, int wc, int fr, int fq) const {
        const int row0 = u.pm * BM + wr * 64 + fr, col0 = u.pn * BM + wc * 32 + 8 * fq;
#pragma unroll
        for (int ai = 0; ai < 2; ++ai)
#pragma unroll
            for (int m = 0; m < 4; ++m) { bf16* rowp = U + (size_t)(row0 + ai * HALF + m * 16) * PU + col0;
#pragma unroll
                for (int bj = 0; bj < 2; ++bj) { if (col0 + bj * HALF < N1) { const f32x4 v0 = acc[ai][bj][m][0], v1 = acc[ai][bj][m][1];
                    u32x4 w; w.x = cvt_pk_bf16(v0[0], v0[1]); w.y = cvt_pk_bf16(v0[2], v0[3]); w.z = cvt_pk_bf16(v1[0], v1[1]); w.w = cvt_pk_bf16(v1[2], v1[3]);
                    *(u32x4*)(rowp + bj * HALF) = w; } } }
    }
};
struct EpiA2 {
    bf16* U;
    __device__ __forceinline__ void operator()(const f32x4 (&acc)[2][2][4][2], const Unit& u, int wr, int wc, int fr, int fq) const {
        const int row0 = u.pm * BM + wr * 64 + fr, col0 = D + u.pn * BM + wc * 32 + 8 * fq;
#pragma unroll
        for (int ai = 0; ai < 2; ++ai)
#pragma unroll
            for (int m = 0; m < 4; ++m) { bf16* rowp = U + (size_t)(row0 + ai * HALF + m * 16) * PU + col0;
#pragma unroll
                for (int bj = 0; bj < 2; ++bj) { const f32x4 v0 = acc[ai][bj][m][0], v1 = acc[ai][bj][m][1];
                    u32x4 w; w.x = cvt_pk_bf16(fsigmoid(v0[0]), fsigmoid(v0[1])); w.y = cvt_pk_bf16(fsigmoid(v0[2]), fsigmoid(v0[3]));
                    w.z = cvt_pk_bf16(fsigmoid(v1[0]), fsigmoid(v1[1])); w.w = cvt_pk_bf16(fsigmoid(v1[2]), fsigmoid(v1[3]));
                    *(u32x4*)(rowp + bj * HALF) = w; } }
    }
};
struct EpiPJ {
    bf16* U;
    __device__ __forceinline__ void operator()(const f32x4 (&acc)[2][2][4][2], const Unit& u, int wr, int wc, int fr, int fq) const {
        const int nct = D / BM, half = u.pn >= nct ? 1 : 0, ct = u.pn - half * nct;
        const int row0 = u.pm * BM + wr * 64 + fr, col0 = ct * BM + wc * 32 + 8 * fq;
#pragma unroll
        for (int ai = 0; ai < 2; ++ai)
#pragma unroll
            for (int m = 0; m < 4; ++m) { bf16* rowp = U + (size_t)(row0 + ai * HALF + m * 16) * PU + col0;
#pragma unroll
                for (int bj = 0; bj < 2; ++bj) { const f32x4 v0 = acc[ai][bj][m][0], v1 = acc[ai][bj][m][1];
                    const u32x4 g = *(const u32x4*)(rowp + (1 + half) * D + bj * HALF);
                    float o[8] = { bflo(g.x) * v0[0], bfhi(g.x) * v0[1], bflo(g.y) * v0[2], bfhi(g.y) * v0[3], bflo(g.z) * v1[0], bfhi(g.z) * v1[1], bflo(g.w) * v1[2], bfhi(g.w) * v1[3] };
                    if (half) { const u32x4 p = *(const u32x4*)(rowp + bj * HALF);
                        o[0] += bflo(p.x); o[1] += bfhi(p.x); o[2] += bflo(p.y); o[3] += bfhi(p.y); o[4] += bflo(p.z); o[5] += bfhi(p.z); o[6] += bflo(p.w); o[7] += bfhi(p.w); }
                    u32x4 w; w.x = cvt_pk_bf16(o[0], o[1]); w.y = cvt_pk_bf16(o[2], o[3]); w.z = cvt_pk_bf16(o[4], o[5]); w.w = cvt_pk_bf16(o[6], o[7]);
                    *(u32x4*)(rowp + bj * HALF) = w; }
                asm volatile("" ::: "memory"); }
    }
};
struct EpiRes {
    float* X; const float* gate;
    const float* sa; const float* sb;
    __device__ __forceinline__ void operator()(const f32x4 (&acc)[2][2][4][2], const Unit& u, int wr, int wc, int fr, int fq) const {
        const int row0 = u.pm * BM + wr * 64 + fr, col0 = u.pn * BM + wc * 32 + 4 * fq;
        const float* S = sa ? (u.pm * BM < NC ? sa : sb - (size_t)NC * D) : X;
        const int cond = seqinfo(seq_of_token(u.pm * BM)).cond;
        const float* gp = gate + (size_t)cond * 6 * D + col0;
        f32x4 gv[2][2];
#pragma unroll
        for (int bj = 0; bj < 2; ++bj)
#pragma unroll
            for (int n = 0; n < 2; ++n) gv[bj][n] = *(const f32x4*)(gp + bj * HALF + n * 16);
#pragma unroll
        for (int ai = 0; ai < 2; ++ai)
#pragma unroll
            for (int m = 0; m < 4; ++m) { const size_t ro = (size_t)(row0 + ai * HALF + m * 16) * D + col0; float* rowp = X + ro; const float* srow = S + ro;
#pragma unroll
                for (int bj = 0; bj < 2; ++bj)
#pragma unroll
                    for (int n = 0; n < 2; ++n) { *(f32x4*)(rowp + bj * HALF + n * 16) = *(const f32x4*)(srow + bj * HALF + n * 16) + gv[bj][n] * acc[ai][bj][m][n]; }
                asm volatile("" ::: "memory"); }
    }
};
struct EpiF1 {
    bf16* Hd;
    __device__ __forceinline__ void operator()(const f32x4 (&acc)[2][2][4][2], const Unit& u, int wr, int wc, int fr, int fq) const {
        const int row0 = u.pm * BM + wr * 64 + fr, col0 = u.pn * HALF + wc * 32 + 8 * fq;
#pragma unroll
        for (int ai = 0; ai < 2; ++ai)
#pragma unroll
            for (int m = 0; m < 4; ++m) { bf16* rowp = Hd + (size_t)(row0 + ai * HALF + m * 16) * FF + col0;
                float o[8];
#pragma unroll
                for (int n = 0; n < 2; ++n)
#pragma unroll
                    for (int e = 0; e < 4; ++e) { const float a = acc[ai][0][m][n][e], b = acc[ai][1][m][n][e]; o[n * 4 + e] = a * fsigmoid(a) * b; }
                u32x4 w; w.x = cvt_pk_bf16(o[0], o[1]); w.y = cvt_pk_bf16(o[2], o[3]); w.z = cvt_pk_bf16(o[4], o[5]); w.w = cvt_pk_bf16(o[6], o[7]);
                *(u32x4*)rowp = w; }
    }
};

template <class Epi, class Sched, bool ALIGN_EPI = true, bool SP2 = true>
__device__ __forceinline__ void gemm_phase(PG8_LAS unsigned char* lds, const Gemm g, const Sched& S, const Epi& E) {
    const int tid = threadIdx.x, wid = __builtin_amdgcn_readfirstlane(tid >> 6), lane = tid & 63, wr = wid >> 2, wc = wid & 3, fr = lane & 15, fq = lane >> 4;
    const int K = g.K, nt = K / BK;
    unsigned voffA[2], voffB[2];
#pragma unroll
    for (int i = 0; i < 2; ++i) { int R, C; stage_rc(tid * 16 + i * 8192, R, C);
        voffA[i] = (unsigned)(R * g.lda + C) * 2u; voffB[i] = (unsigned)(R * K + C) * 2u; }
    const size_t kstep = (size_t)(BK * 2);
    const size_t hstepA = (size_t)HALF * g.lda * 2, hstepB = (size_t)HALF * K * 2;
    const size_t tstepA = 2 * hstepA, tstepB = 2 * hstepB;
    const unsigned ldsw = (unsigned)wid * 1024u;
    const int aoff = lds_byte(wr * 64 + fr, fq * 8), boff = lds_byte(wc * 32 + fr, fq * 8);
#define PG8_SA(b, h) (((b) * 2 + (h)) * HTB)
#define PG8_SB(b, h) ((4 + (b) * 2 + (h)) * HTB)
#define PG8_STAGE(bufoff, gbase, voff) do { _Pragma("unroll") for (int _i = 0; _i < 2; ++_i) \
        __builtin_amdgcn_global_load_lds((const unsigned*)((const char*)(gbase) + (voff)[_i]), (PG8_LAS unsigned*)(lds + (bufoff) + ldsw + _i * 8192), 16, 0, 0); } while (0)
#define PG8_LDA(dst, b, h) do { _Pragma("unroll") for (int m = 0; m < 4; ++m) _Pragma("unroll") for (int k = 0; k < 2; ++k) dst[m][k] = *(const PG8_LAS bf16x8*)(lds + PG8_SA(b, h) + aoff + m * 2048 + k * 1024); } while (0)
#define PG8_LDB(dst, b, h) do { _Pragma("unroll") for (int n = 0; n < 2; ++n) _Pragma("unroll") for (int k = 0; k < 2; ++k) dst[n][k] = *(const PG8_LAS bf16x8*)(lds + PG8_SB(b, h) + boff + n * 2048 + k * 1024); } while (0)
#define PG8_MMA(ai, bj, At, Bt) do { __builtin_amdgcn_s_setprio(1); _Pragma("unroll") for (int m = 0; m < 4; ++m) _Pragma("unroll") for (int n = 0; n < 2; ++n) _Pragma("unroll") for (int k = 0; k < 2; ++k) \
        acc[ai][bj][m][n] = __builtin_amdgcn_mfma_f32_16x16x32_bf16(Bt[n][k], At[m][k], acc[ai][bj][m][n], 0, 0, 0); __builtin_amdgcn_s_setprio(0); } while (0)
#define PG8_WAIT_V(n) asm volatile("s_waitcnt vmcnt(" #n ")" ::: "memory")
#define PG8_WAIT_L(n) asm volatile("s_waitcnt lgkmcnt(" #n ")" ::: "memory")
#define PG8_BAR __builtin_amdgcn_s_barrier()
#define PG8_SCHED __builtin_amdgcn_sched_barrier(0)
    Unit cur, nxt; int ui = 0;
    if (!S.next(0, cur)) return;
    f32x4 acc[2][2][4][2];
#pragma unroll
    for (int a = 0; a < 2; ++a)
#pragma unroll
        for (int b = 0; b < 2; ++b)
#pragma unroll
            for (int m = 0; m < 4; ++m)
#pragma unroll
                for (int n = 0; n < 2; ++n) acc[a][b][m][n] = (f32x4){0.f, 0.f, 0.f, 0.f};
    bf16x8 At[4][2], B0[2][2], B1[2][2];
    const char* cA = (const char*)g.A + (size_t)cur.pm * tstepA + (size_t)cur.aoff * 2; const char* cB = (const char*)g.Bt + (size_t)cur.pn * tstepB;
    if constexpr (SP2) {
        PG8_STAGE(PG8_SB(0, 0), cB, voffB); PG8_STAGE(PG8_SB(0, 1), cB + hstepB, voffB); PG8_STAGE(PG8_SA(0, 0), cA, voffA); PG8_STAGE(PG8_SA(0, 1), cA + hstepA, voffA);
        if (wr == 1) PG8_BAR;
        PG8_WAIT_V(2); PG8_BAR;
        PG8_STAGE(PG8_SB(1, 0), cB + kstep, voffB); PG8_STAGE(PG8_SA(1, 0), cA + kstep, voffA); PG8_STAGE(PG8_SB(1, 1), cB + hstepB + kstep, voffB);
        PG8_WAIT_V(6); PG8_BAR;
    } else {
        PG8_STAGE(PG8_SB(0, 0), cB, voffB); PG8_STAGE(PG8_SA(0, 0), cA, voffA); PG8_STAGE(PG8_SB(0, 1), cB + hstepB, voffB); PG8_STAGE(PG8_SA(0, 1), cA + hstepA, voffA);
        if (wr == 1) PG8_BAR;
        PG8_WAIT_V(4); PG8_BAR;
        PG8_STAGE(PG8_SB(1, 0), cB + kstep, voffB); PG8_STAGE(PG8_SA(1, 0), cA + kstep, voffA); PG8_STAGE(PG8_SB(1, 1), cB + hstepB + kstep, voffB);
        PG8_WAIT_V(6); PG8_BAR;
    }
    for (;;) {
        const bool has_next = S.next(ui + 1, nxt);
        const char* nA = has_next ? (const char*)g.A + (size_t)nxt.pm * tstepA + (size_t)nxt.aoff * 2 : cA; const char* nB = has_next ? (const char*)g.Bt + (size_t)nxt.pn * tstepB : cB;
        for (int t = 0; t < nt; t += 2) {
            const bool last = (t == nt - 2);
            const char* a1 = cA + (size_t)(t + 1) * kstep;
            const char* a2 = last ? nA : cA + (size_t)(t + 2) * kstep; const char* b2 = last ? nB : cB + (size_t)(t + 2) * kstep;
            const char* a3 = a2 + kstep; const char* b3 = b2 + kstep;
            if constexpr (SP2) {
            PG8_LDB(B0, 0, 0); PG8_LDB(B1, 0, 1); PG8_SCHED; PG8_LDA(At, 0, 0); PG8_STAGE(PG8_SA(1, 1), a1 + hstepA, voffA);
            PG8_WAIT_V(8); PG8_WAIT_L(0); PG8_BAR; PG8_MMA(0, 0, At, B0); PG8_MMA(0, 1, At, B1); PG8_BAR; PG8_SCHED;
            PG8_LDA(At, 0, 1); PG8_STAGE(PG8_SB(0, 0), b2, voffB); PG8_STAGE(PG8_SB(0, 1), b2 + hstepB, voffB); PG8_STAGE(PG8_SA(0, 0), a2, voffA);
            PG8_WAIT_V(8); PG8_WAIT_L(0); PG8_BAR; PG8_MMA(1, 0, At, B0); PG8_MMA(1, 1, At, B1); PG8_BAR; PG8_SCHED;
            PG8_LDB(B0, 1, 0); PG8_LDB(B1, 1, 1); PG8_SCHED; PG8_LDA(At, 1, 0); PG8_STAGE(PG8_SA(0, 1), a2 + hstepA, voffA);
            PG8_WAIT_V(8); PG8_WAIT_L(0); PG8_BAR; PG8_MMA(0, 0, At, B0); PG8_MMA(0, 1, At, B1); PG8_BAR; PG8_SCHED;
            PG8_LDA(At, 1, 1); PG8_STAGE(PG8_SB(1, 0), b3, voffB); PG8_STAGE(PG8_SB(1, 1), b3 + hstepB, voffB); PG8_STAGE(PG8_SA(1, 0), a3, voffA);
            PG8_WAIT_V(8); PG8_WAIT_L(0); PG8_BAR; PG8_MMA(1, 0, At, B0); PG8_MMA(1, 1, At, B1); PG8_BAR; PG8_SCHED;
            } else {
            PG8_LDB(B0, 0, 0); PG8_SCHED; PG8_LDA(At, 0, 0); PG8_STAGE(PG8_SA(1, 1), a1 + hstepA, voffA);
            PG8_WAIT_L(8); PG8_BAR; PG8_WAIT_L(0); PG8_MMA(0, 0, At, B0); PG8_BAR; PG8_SCHED;
            PG8_LDB(B1, 0, 1); PG8_STAGE(PG8_SB(0, 0), b2, voffB);
            PG8_BAR; PG8_WAIT_L(0); PG8_MMA(0, 1, At, B1); PG8_BAR;
            PG8_LDA(At, 0, 1); PG8_STAGE(PG8_SA(0, 0), a2, voffA);
            PG8_BAR; PG8_WAIT_L(0); PG8_MMA(1, 0, At, B0); PG8_BAR; PG8_SCHED;
            PG8_STAGE(PG8_SB(0, 1), b2 + hstepB, voffB);
            PG8_WAIT_V(6); PG8_BAR; PG8_MMA(1, 1, At, B1); PG8_BAR;
            PG8_LDB(B0, 1, 0); PG8_SCHED; PG8_LDA(At, 1, 0); PG8_STAGE(PG8_SA(0, 1), a2 + hstepA, voffA);
            PG8_WAIT_L(8); PG8_BAR; PG8_WAIT_L(0); PG8_MMA(0, 0, At, B0); PG8_BAR; PG8_SCHED;
            PG8_LDB(B1, 1, 1); PG8_STAGE(PG8_SB(1, 0), b3, voffB);
            PG8_BAR; PG8_WAIT_L(0); PG8_MMA(0, 1, At, B1); PG8_BAR;
            PG8_LDA(At, 1, 1); PG8_STAGE(PG8_SA(1, 0), a3, voffA);
            PG8_BAR; PG8_WAIT_L(0); PG8_MMA(1, 0, At, B0); PG8_BAR; PG8_SCHED;
            PG8_STAGE(PG8_SB(1, 1), b3 + hstepB, voffB);
            PG8_WAIT_V(6); PG8_BAR; PG8_MMA(1, 1, At, B1); PG8_BAR;
            }
        }
        if constexpr (ALIGN_EPI) { if (wr == 0) PG8_BAR; }
        E(acc, cur, wr, wc, fr, fq);
        if (!has_next) break;
#pragma unroll
        for (int a = 0; a < 2; ++a)
#pragma unroll
            for (int b = 0; b < 2; ++b)
#pragma unroll
                for (int m = 0; m < 4; ++m)
#pragma unroll
                    for (int n = 0; n < 2; ++n) acc[a][b][m][n] = (f32x4){0.f, 0.f, 0.f, 0.f};
        cur = nxt; cA = nA; cB = nB; ++ui;
        if constexpr (ALIGN_EPI) { if (wr == 1) PG8_BAR; }
    }
    PG8_WAIT_V(0);
    if constexpr (!ALIGN_EPI) { if (wr == 0) PG8_BAR; }
    PG8_BAR;
#undef PG8_SA
#undef PG8_SB
#undef PG8_STAGE
#undef PG8_LDA
#undef PG8_LDB
#undef PG8_MMA
#undef PG8_WAIT_V
#undef PG8_WAIT_L
#undef PG8_BAR
#undef PG8_SCHED
}
}


#define LDS_BARRIER() do { asm volatile("s_waitcnt lgkmcnt(0)" ::: "memory"); __builtin_amdgcn_s_barrier(); asm volatile("" ::: "memory"); } while (0)
namespace ml {
#define LAS __attribute__((address_space(3)))
typedef short bf16x8 __attribute__((ext_vector_type(8)));
typedef float f32x4 __attribute__((ext_vector_type(4)));
typedef unsigned u32x4 __attribute__((ext_vector_type(4)));
constexpr int NVB = 4, EV = MD / NVB;
constexpr int PQ = 272, PT = 144;
constexpr int L_QS = 0, L_KS = L_QS + 64 * PQ, L_KT = L_KS + 64 * PQ, L_VT = L_KT + 128 * PT, L_SB = L_VT + 48 * PT, L_CT = L_SB + 64 * PT,
              L_HS = L_CT + 48 * PQ, L_SC = L_HS + 64 * 80, L_END = L_SC + 4096;
static_assert(L_END <= 131072, "mLSTM LDS map");
enum { SC_A = 0, SC_PM = 64, SC_WI = 128, SC_EMT = 192, SC_WE = 256, SC_DEN = 320, SC_MISC = 384 };
__device__ __forceinline__ f32x4 mma(bf16x8 a, bf16x8 b, f32x4 c) { return __builtin_amdgcn_mfma_f32_16x16x32_bf16(a, b, c, 0, 0, 0); }
__device__ __forceinline__ bf16x8 frag(LAS unsigned char* lds, int base, int pitch, int row0, int k0, int lane) {
    return *(const LAS bf16x8*)(lds + base + (row0 + (lane & 15)) * pitch + (k0 + 8 * (lane >> 4)) * 2);
}
template <int N> __device__ __forceinline__ float dpp_row_shr(float x, float ident) {
    return __builtin_bit_cast(float, __builtin_amdgcn_update_dpp(__builtin_bit_cast(int, ident), __builtin_bit_cast(int, x), 0x110 + N, 0xf, 0xf, false));
}
__device__ __forceinline__ float lane_get(float x, int l) { return __builtin_bit_cast(float, __builtin_amdgcn_readlane(__builtin_bit_cast(int, x), l)); }
__device__ __forceinline__ float wave_scan_add(float x, int lane) {
    x += dpp_row_shr<1>(x, 0.f); x += dpp_row_shr<2>(x, 0.f); x += dpp_row_shr<4>(x, 0.f); x += dpp_row_shr<8>(x, 0.f);
    const float t0 = lane_get(x, 15), t1 = lane_get(x, 31), t2 = lane_get(x, 47); const int row = lane >> 4;
    return x + ((row >= 1 ? t0 : 0.f) + (row >= 2 ? t1 : 0.f) + (row >= 3 ? t2 : 0.f));
}
__device__ __forceinline__ float wave_scan_max(float x, int lane) {
    constexpr float NI = -3.0e38f;
    x = fmaxf(x, dpp_row_shr<1>(x, NI)); x = fmaxf(x, dpp_row_shr<2>(x, NI)); x = fmaxf(x, dpp_row_shr<4>(x, NI)); x = fmaxf(x, dpp_row_shr<8>(x, NI));
    const float t0 = lane_get(x, 15), t1 = lane_get(x, 31), t2 = lane_get(x, 47); const int row = lane >> 4;
    return fmaxf(fmaxf(x, row >= 1 ? t0 : NI), fmaxf(row >= 2 ? t1 : NI, row >= 3 ? t2 : NI));
}
__device__ __forceinline__ void mlstm_item(LAS unsigned char* lds, CParams& P, int l, int s, int head, int dir, int vb) {
    const int tid = threadIdx.x, w = __builtin_amdgcn_readfirstlane(tid >> 6), lane = tid & 63, fr = lane & 15, fq = lane >> 4;
    const int rt = w & 3, half = w >> 2;
    const SeqInfo q = seqinfo(s); const int nchunk = q.T / 64;
    const bf16* QK = WSP(bf16, WS_QKC); bf16* U = WSP(bf16, WS_U1);
    LAS float* SC = (LAS float*)(lds + L_SC);
    f32x4 cacc[3];
    float m_prev;
    if (!q.grid) { cacc[0] = cacc[1] = cacc[2] = (f32x4){0.f, 0.f, 0.f, 0.f}; m_prev = 0.f; }
    else {
        const size_t sb = (((size_t)q.b * DEPTH + l) * 2 + dir) * MH + head; const int d = 16 * w + fr;
#pragma unroll
        for (int et = 0; et < 2; ++et)
#pragma unroll
            for (int r = 0; r < 4; ++r) cacc[et][r] = P.in[ST_C][(sb * 128 + d) * 128 + vb * EV + 16 * et + 4 * fq + r];
        cacc[2] = (f32x4){0.f, 0.f, 0.f, 0.f}; if (fq == 0) cacc[2][0] = P.in[ST_N][sb * 128 + d];
        m_prev = P.in[ST_M][sb];
    }
    const float bi = P.in[M_GATE_B][(size_t)l * 4 * MH + (2 * dir) * MH + head], bfg = P.in[M_GATE_B][(size_t)l * 4 * MH + (2 * dir + 1) * MH + head];
    for (int i = tid; i < 16 * 64; i += 512) { const int r = i >> 6, c = i & 63; *(LAS bf16*)(lds + L_VT + (32 + r) * PT + c * 2) = (r == 0) ? (bf16)0x3f80 : (bf16)0; }
    u32x4 pqk[4]; u32x4 pv; bf16 pgi = 0, pgf = 0;
#define ML_TOK(c, j) ((size_t)(q.base + (dir ? q.T - 1 - ((c) * 64 + (j)) : ((c) * 64 + (j)))))
#define ML_PREFETCH(c) do { _Pragma("unroll") for (int i = 0; i < 4; ++i) { const int id = tid + 512 * i, j = id >> 5, pc = id & 31; \
            pqk[i] = *(const u32x4*)(QK + ML_TOK(c, j) * (2 * MW) + (pc < 16 ? head * 128 + 8 * pc : MW + head * 128 + 8 * (pc - 16))); } \
        if (tid < 256) { const int j = tid >> 2, pc = tid & 3; pv = *(const u32x4*)(U + ML_TOK(c, j) * PU + OFF_V + head * 128 + vb * EV + 8 * pc); } \
        if (w == 0) { const bf16* g = U + ML_TOK(c, lane) * PU + OFF_G; pgi = g[(2 * dir) * MH + head]; pgf = g[(2 * dir + 1) * MH + head]; } } while (0)
    ML_PREFETCH(0);
    for (int c = 0; c < nchunk; ++c) {
#pragma unroll
        for (int i = 0; i < 4; ++i) { const int id = tid + 512 * i, j = id >> 5, pc = id & 31;
            *(LAS u32x4*)(lds + (pc < 16 ? L_QS : L_KS) + j * PQ + (pc & 15) * 16) = pqk[i]; }
        if (tid < 256) { const int j = tid >> 2, pc = tid & 3; const unsigned wv[4] = {pv.x, pv.y, pv.z, pv.w};
#pragma unroll
            for (int e = 0; e < 8; ++e) *(LAS bf16*)(lds + L_VT + (8 * pc + e) * PT + j * 2) = (bf16)((wv[e >> 1] >> ((e & 1) * 16)) & 0xffffu); }
#pragma unroll
        for (int et = 0; et < 3; ++et)
#pragma unroll
            for (int r = 0; r < 4; ++r) *(LAS bf16*)(lds + L_CT + (16 * et + 4 * fq + r) * PQ + (16 * w + fr) * 2) = f2bf(cacc[et][r]);
        float wie = 1.f;
        if (w == 0) {
            const float gi = bf2f(pgi) + bi, gf = bf2f(pgf) + bfg;
            const float lf = fminf(gf, 0.f) - log1pf(__expf(-fabsf(gf)));
            const float b = wave_scan_add(lf, lane);
            const float a = gi - b; float pm = wave_scan_max(a, lane);
            pm = fmaxf(pm, m_prev);
            const float pm63 = lane_get(pm, 63), b63 = lane_get(b, 63);
            SC[SC_A + lane] = a; SC[SC_PM + lane] = pm; SC[SC_WI + lane] = __expf(m_prev - pm); SC[SC_EMT + lane] = __expf(-(b + pm)); SC[SC_WE + lane] = __expf(a - pm63);
            if (lane == 0) { SC[SC_MISC] = __expf(m_prev - pm63); SC[SC_MISC + 1] = b63 + pm63; }
        }
        LDS_BARRIER();
        if (c + 1 < nchunk) ML_PREFETCH(c + 1);
        wie = SC[SC_MISC]; m_prev = SC[SC_MISC + 1];
#pragma unroll
        for (int i = 0; i < 2; ++i) { const int id = tid + 512 * i, j = id & 63, pc = id >> 6; const float we = SC[SC_WE + j];
            const u32x4 kv = *(const LAS u32x4*)(lds + L_KS + j * PQ + pc * 16); const unsigned wv[4] = {kv.x, kv.y, kv.z, kv.w};
#pragma unroll
            for (int e = 0; e < 8; ++e) { const float kf = __builtin_bit_cast(float, (e & 1) ? (wv[e >> 1] & 0xffff0000u) : (wv[e >> 1] << 16));
                *(LAS bf16*)(lds + L_KT + (8 * pc + e) * PT + j * 2) = f2bf(kf * we); } }
#pragma unroll
        for (int cc = 0; cc < 2; ++cc) { const int ct = 2 * half + cc;
            f32x4 acc = (f32x4){0.f, 0.f, 0.f, 0.f};
            if (ct <= rt) {
#pragma unroll
                for (int k = 0; k < 4; ++k) acc = mma(frag(lds, L_QS, PQ, 16 * rt, 32 * k, lane), frag(lds, L_KS, PQ, 16 * ct, 32 * k, lane), acc);
            }
            const int sp = 16 * ct + fr; const float as = SC[SC_A + sp];
#pragma unroll
            for (int r = 0; r < 4; ++r) { const int t = 16 * rt + 4 * fq + r; const float v = (sp <= t) ? acc[r] * __expf(as - SC[SC_PM + t]) : 0.f;
                *(LAS bf16*)(lds + L_SB + t * PT + sp * 2) = f2bf(v); } }
        LDS_BARRIER();
        f32x4 nacc[2]; const int nct = half ? 1 : 2;
#pragma unroll
        for (int cc = 0; cc < 2; ++cc) { if (cc < nct) { const int ct = half ? 2 : cc;
            f32x4 a1 = (f32x4){0.f, 0.f, 0.f, 0.f}, a2 = (f32x4){0.f, 0.f, 0.f, 0.f};
#pragma unroll
            for (int k = 0; k < 2; ++k) a1 = mma(frag(lds, L_SB, PT, 16 * rt, 32 * k, lane), frag(lds, L_VT, PT, 16 * ct, 32 * k, lane), a1);
#pragma unroll
            for (int k = 0; k < 4; ++k) a2 = mma(frag(lds, L_QS, PQ, 16 * rt, 32 * k, lane), frag(lds, L_CT, PQ, 16 * ct, 32 * k, lane), a2);
#pragma unroll
            for (int r = 0; r < 4; ++r) a1[r] += SC[SC_WI + 16 * rt + 4 * fq + r] * a2[r];
            nacc[cc] = a1; } }
        if (half && fr == 0) {
#pragma unroll
            for (int r = 0; r < 4; ++r) SC[SC_DEN + 16 * rt + 4 * fq + r] = nacc[0][r];
        }
#pragma unroll
        for (int et = 0; et < 3; ++et) { cacc[et] = cacc[et] * wie;
#pragma unroll
            for (int k = 0; k < 2; ++k) cacc[et] = mma(frag(lds, L_VT, PT, 16 * et, 32 * k, lane), frag(lds, L_KT, PT, 16 * w, 32 * k, lane), cacc[et]); }
        LDS_BARRIER();
        if (!half) {
#pragma unroll
            for (int cc = 0; cc < 2; ++cc)
#pragma unroll
                for (int r = 0; r < 4; ++r) { const int t = 16 * rt + 4 * fq + r; const float den = fmaxf(fabsf(SC[SC_DEN + t]), SC[SC_EMT + t]);
                    *(LAS bf16*)(lds + L_HS + t * 80 + (16 * cc + fr) * 2) = f2bf(nacc[cc][r] * __builtin_amdgcn_rcpf(den)); }
        }
        LDS_BARRIER();
        if (tid < 256) { const int j = tid >> 2, pc = tid & 3;
            *(u32x4*)(U + ML_TOK(c, j) * PU + dir * MW + head * 128 + vb * EV + 8 * pc) = *(const LAS u32x4*)(lds + L_HS + j * 80 + pc * 16); }
    }
    if (!q.grid) {
        const size_t sb = (((size_t)q.b * DEPTH + l) * 2 + dir) * MH + head; const int d = 16 * w + fr;
#pragma unroll
        for (int et = 0; et < 2; ++et)
#pragma unroll
            for (int r = 0; r < 4; ++r) P.out[OUT_C + (sb * 128 + d) * 128 + vb * EV + 16 * et + 4 * fq + r] = cacc[et][r];
        if (vb == 0) { if (fq == 0) P.out[OUT_N + sb * 128 + d] = cacc[2][0]; if (tid == 0) P.out[OUT_M + sb] = m_prev; }
    }
    LDS_BARRIER();
#undef ML_TOK
#undef ML_PREFETCH
}
constexpr int M_QS = 0, M_KS = M_QS + 2 * 64 * PQ, M_KT = M_KS + 64 * PQ, M_VT = M_KT + 128 * PT, M_SB = M_VT + 2 * 48 * PT, M_CT = M_SB + 64 * PT, M_HS = M_CT + 48 * PQ, M_SC = M_HS + 64 * 80, M_END = M_SC + 2 * 4096;
static_assert(M_END <= 131072, "pipelined mLSTM LDS map");
__device__ __forceinline__ void mlstm_item2(LAS unsigned char* lds, CParams& P, int l, int s, int head, int dir, int vb) {
    const int tid = threadIdx.x, w = __builtin_amdgcn_readfirstlane(tid >> 6), lane = tid & 63, fr = lane & 15, fq = lane >> 4;
    const int rt = w & 3, half = w >> 2;
    const SeqInfo q = seqinfo(s); const int nchunk = q.T / 64;
    const bf16* QK = WSP(bf16, WS_QKC); bf16* U = WSP(bf16, WS_U1);
    f32x4 cacc[3];
    float m_prev;
    const size_t sb = (((size_t)q.b * DEPTH + l) * 2 + dir) * MH + head;
    if (!q.grid) { cacc[0] = cacc[1] = cacc[2] = (f32x4){0.f, 0.f, 0.f, 0.f}; m_prev = 0.f; }
    else {
        const int d = 16 * w + fr;
#pragma unroll
        for (int et = 0; et < 2; ++et)
#pragma unroll
            for (int r = 0; r < 4; ++r) cacc[et][r] = P.in[ST_C][(sb * 128 + d) * 128 + vb * EV + 16 * et + 4 * fq + r];
        cacc[2] = (f32x4){0.f, 0.f, 0.f, 0.f}; if (fq == 0) cacc[2][0] = P.in[ST_N][sb * 128 + d];
        m_prev = P.in[ST_M][sb];
    }
    const float bi = P.in[M_GATE_B][(size_t)l * 4 * MH + (2 * dir) * MH + head], bfg = P.in[M_GATE_B][(size_t)l * 4 * MH + (2 * dir + 1) * MH + head];
    for (int i = tid; i < 2 * 16 * 64; i += 512) { const int b = i >> 10, r = (i >> 6) & 15, c = i & 63; *(LAS bf16*)(lds + M_VT + b * 48 * PT + (32 + r) * PT + c * 2) = (r == 0) ? (bf16)0x3f80 : (bf16)0; }
    u32x4 pqk[4]; u32x4 pv; bf16 pgi = 0, pgf = 0;
#define ML_TOK(c, j) ((size_t)(q.base + (dir ? q.T - 1 - ((c) * 64 + (j)) : ((c) * 64 + (j)))))
#define ML_PREFETCH(c) do { _Pragma("unroll") for (int i = 0; i < 4; ++i) { const int id = tid + 512 * i, j = id >> 5, pc = id & 31; \
            pqk[i] = *(const u32x4*)(QK + ML_TOK(c, j) * (2 * MW) + (pc < 16 ? head * 128 + 8 * pc : MW + head * 128 + 8 * (pc - 16))); } \
        if (tid < 256) { const int j = tid >> 2, pc = tid & 3; pv = *(const u32x4*)(U + ML_TOK(c, j) * PU + OFF_V + head * 128 + vb * EV + 8 * pc); } \
        if (w == 4) { const bf16* g = U + ML_TOK(c, lane) * PU + OFF_G; pgi = g[(2 * dir) * MH + head]; pgf = g[(2 * dir + 1) * MH + head]; } } while (0)
#define ML_STAGE_A(pb) do { \
        _Pragma("unroll") for (int i = 0; i < 4; ++i) { const int id = tid + 512 * i, j = id >> 5, pc = id & 31; \
            *(LAS u32x4*)(lds + (pc < 16 ? M_QS + (pb) * 64 * PQ : M_KS) + j * PQ + (pc & 15) * 16) = pqk[i]; } \
        if (tid < 256) { const int j = tid >> 2, pc = tid & 3; const unsigned wv[4] = {pv.x, pv.y, pv.z, pv.w}; \
            _Pragma("unroll") for (int e = 0; e < 8; ++e) *(LAS bf16*)(lds + M_VT + (pb) * 48 * PT + (8 * pc + e) * PT + j * 2) = (bf16)((wv[e >> 1] >> ((e & 1) * 16)) & 0xffffu); } \
        if (w == 4) { LAS float* SCn = (LAS float*)(lds + M_SC + (pb) * 4096); \
            const float gi = bf2f(pgi) + bi, gf = bf2f(pgf) + bfg; \
            const float lf = fminf(gf, 0.f) - log1pf(__expf(-fabsf(gf))); \
            const float b = wave_scan_add(lf, lane); \
            const float a = gi - b; float pm = wave_scan_max(a, lane); \
            pm = fmaxf(pm, m_prev); \
            const float pm63 = lane_get(pm, 63), b63 = lane_get(b, 63); \
            SCn[SC_A + lane] = a; SCn[SC_PM + lane] = pm; SCn[SC_WI + lane] = __expf(m_prev - pm); SCn[SC_EMT + lane] = __expf(-(b + pm)); SCn[SC_WE + lane] = __expf(a - pm63); \
            if (lane == 0) SCn[SC_MISC] = __expf(m_prev - pm63); \
            m_prev = b63 + pm63; } } while (0)
#define ML_STAGE_D(pb) do { const LAS float* SCn = (const LAS float*)(lds + M_SC + (pb) * 4096); \
        _Pragma("unroll") for (int i = 0; i < 2; ++i) { const int id = tid + 512 * i, j = id & 63, pc = id >> 6; const float we = SCn[SC_WE + j]; \
            const u32x4 kv = *(const LAS u32x4*)(lds + M_KS + j * PQ + pc * 16); const unsigned wv[4] = {kv.x, kv.y, kv.z, kv.w}; \
            _Pragma("unroll") for (int e = 0; e < 8; ++e) { const float kf = __builtin_bit_cast(float, (e & 1) ? (wv[e >> 1] & 0xffff0000u) : (wv[e >> 1] << 16)); \
                *(LAS bf16*)(lds + M_KT + (8 * pc + e) * PT + j * 2) = f2bf(kf * we); } } \
        _Pragma("unroll") for (int cc = 0; cc < 2; ++cc) { const int ct = 2 * half + cc; \
            f32x4 acc = (f32x4){0.f, 0.f, 0.f, 0.f}; \
            if (ct <= rt) { \
                _Pragma("unroll") for (int k = 0; k < 4; ++k) acc = mma(frag(lds, M_QS + (pb) * 64 * PQ, PQ, 16 * rt, 32 * k, lane), frag(lds, M_KS, PQ, 16 * ct, 32 * k, lane), acc); } \
            const int sp = 16 * ct + fr; const float as = SCn[SC_A + sp]; \
            _Pragma("unroll") for (int r = 0; r < 4; ++r) { const int t = 16 * rt + 4 * fq + r; const float v = (sp <= t) ? acc[r] * __expf(as - SCn[SC_PM + t]) : 0.f; \
                *(LAS bf16*)(lds + M_SB + t * PT + sp * 2) = f2bf(v); } } \
        _Pragma("unroll") for (int et = 0; et < 3; ++et) \
            _Pragma("unroll") for (int r = 0; r < 4; ++r) *(LAS bf16*)(lds + M_CT + (16 * et + 4 * fq + r) * PQ + (16 * w + fr) * 2) = f2bf(cacc[et][r]); } while (0)
#define ML_STORE(c) do { if (tid < 256) { const int j = tid >> 2, pc = tid & 3; \
            *(u32x4*)(U + ML_TOK(c, j) * PU + dir * MW + head * 128 + vb * EV + 8 * pc) = *(const LAS u32x4*)(lds + M_HS + j * 80 + pc * 16); } } while (0)
    ML_PREFETCH(0);
    ML_STAGE_A(0);
    LDS_BARRIER();
    if (nchunk > 1) ML_PREFETCH(1);
    ML_STAGE_D(0);
    LDS_BARRIER();
    for (int c = 0; c < nchunk; ++c) {
        const int pb = c & 1;
        if (c + 1 < nchunk) { ML_STAGE_A(pb ^ 1); if (c + 2 < nchunk) ML_PREFETCH(c + 2); }
        if (c >= 1) ML_STORE(c - 1);
        LAS float* SC = (LAS float*)(lds + M_SC + pb * 4096);
        const float wie = SC[SC_MISC];
        f32x4 nacc[2]; const int nct = half ? 1 : 2;
#pragma unroll
        for (int cc = 0; cc < 2; ++cc) { if (cc < nct) { const int ct = half ? 2 : cc;
            f32x4 a1 = (f32x4){0.f, 0.f, 0.f, 0.f}, a2 = (f32x4){0.f, 0.f, 0.f, 0.f};
#pragma unroll
            for (int k = 0; k < 2; ++k) a1 = mma(frag(lds, M_SB, PT, 16 * rt, 32 * k, lane), frag(lds, M_VT + pb * 48 * PT, PT, 16 * ct, 32 * k, lane), a1);
#pragma unroll
            for (int k = 0; k < 4; ++k) a2 = mma(frag(lds, M_QS + pb * 64 * PQ, PQ, 16 * rt, 32 * k, lane), frag(lds, M_CT, PQ, 16 * ct, 32 * k, lane), a2);
#pragma unroll
            for (int r = 0; r < 4; ++r) a1[r] += SC[SC_WI + 16 * rt + 4 * fq + r] * a2[r];
            nacc[cc] = a1; } }
        if (half && fr == 0) {
#pragma unroll
            for (int r = 0; r < 4; ++r) SC[SC_DEN + 16 * rt + 4 * fq + r] = nacc[0][r];
        }
#pragma unroll
        for (int et = 0; et < 3; ++et) { cacc[et] = cacc[et] * wie;
#pragma unroll
            for (int k = 0; k < 2; ++k) cacc[et] = mma(frag(lds, M_VT + pb * 48 * PT, PT, 16 * et, 32 * k, lane), frag(lds, M_KT, PT, 16 * w, 32 * k, lane), cacc[et]); }
        LDS_BARRIER();
        if (!half) {
#pragma unroll
            for (int cc = 0; cc < 2; ++cc)
#pragma unroll
                for (int r = 0; r < 4; ++r) { const int t = 16 * rt + 4 * fq + r; const float den = fmaxf(fabsf(SC[SC_DEN + t]), SC[SC_EMT + t]);
                    *(LAS bf16*)(lds + M_HS + t * 80 + (16 * cc + fr) * 2) = f2bf(nacc[cc][r] * __builtin_amdgcn_rcpf(den)); }
        }
        if (c + 1 < nchunk) ML_STAGE_D(pb ^ 1);
        LDS_BARRIER();
    }
    ML_STORE(nchunk - 1);
    if (!q.grid) {
        const int d = 16 * w + fr;
#pragma unroll
        for (int et = 0; et < 2; ++et)
#pragma unroll
            for (int r = 0; r < 4; ++r) P.out[OUT_C + (sb * 128 + d) * 128 + vb * EV + 16 * et + 4 * fq + r] = cacc[et][r];
        if (vb == 0) { if (fq == 0) P.out[OUT_N + sb * 128 + d] = cacc[2][0]; if (tid == 256) P.out[OUT_M + sb] = m_prev; }
    }
    LDS_BARRIER();
#undef ML_TOK
#undef ML_PREFETCH
#undef ML_STAGE_A
#undef ML_STAGE_D
#undef ML_STORE
}
constexpr int N_ITEMS = NSEQ * MH * 2 * NVB;
__device__ __forceinline__ void decode_item(int it, int& s, int& head, int& dir, int& vb) {
    vb = it % NVB; int ch = it / NVB; dir = ch & 1; ch >>= 1; head = ch % MH; const int sq = ch / MH;
    s = sq < LB ? CB + sq : sq - LB;
}
}


namespace rw {
typedef short bf16x8 __attribute__((ext_vector_type(8)));
typedef float f32x4 __attribute__((ext_vector_type(4)));
typedef unsigned u32x4 __attribute__((ext_vector_type(4)));
enum { V_A = 0, V_W, V_B, V_K, V_R, NVEC };
constexpr int REC = NVEC * 64 * 4;
constexpr int PT = 144;
constexpr int L_SBUF = 0, L_VT = L_SBUF + 64 * REC, L_TW = L_VT + 64 * 256, L_AL = L_TW + 64 * PT, L_YS = L_AL + 64 * PT, L_INV = L_YS + 64 * 16 * 4, L_END = L_INV + 256;
__device__ __forceinline__ int vt_off(int row, int tt) { return row * 256 + ((tt ^ (((row >> 3) & 7) << 2)) << 2); }
static_assert(L_END <= 131072, "RWKV LDS map");
__device__ __forceinline__ float dpp_xor1(float x) { return __builtin_bit_cast(float, __builtin_amdgcn_update_dpp(0, __builtin_bit_cast(int, x), 0xB1, 0xF, 0xF, true)); }
__device__ __forceinline__ float dpp_xor2(float x) { return __builtin_bit_cast(float, __builtin_amdgcn_update_dpp(0, __builtin_bit_cast(int, x), 0x4E, 0xF, 0xF, true)); }
__device__ __forceinline__ float dpp_ror4(float x) { return __builtin_bit_cast(float, __builtin_amdgcn_update_dpp(0, __builtin_bit_cast(int, x), 0x124, 0xF, 0xF, true)); }
__device__ __forceinline__ float dpp_ror8(float x) { return __builtin_bit_cast(float, __builtin_amdgcn_update_dpp(0, __builtin_bit_cast(int, x), 0x128, 0xF, 0xF, true)); }
__device__ __forceinline__ float allsum16(float x) { x += dpp_xor1(x); x += dpp_xor2(x); x += dpp_ror4(x); x += dpp_ror8(x); return x; }
__device__ __forceinline__ f32x4 cvt_lo4(unsigned a, unsigned b) { return (f32x4){__builtin_bit_cast(float, a << 16), __builtin_bit_cast(float, a & 0xffff0000u), __builtin_bit_cast(float, b << 16), __builtin_bit_cast(float, b & 0xffff0000u)}; }
__device__ __forceinline__ float allsum32(float x) {
    x = allsum16(x);
    float xa = x, xb = x;
    asm volatile("v_mov_b32 %1, %0\n\ts_nop 1\n\tv_permlane32_swap_b32 %0, %1\n\ts_nop 1" : "+v"(xa), "=&v"(xb));
    return xa + xb;
}
__device__ __forceinline__ void rwkv_item(LAS unsigned char* lds, CParams& P, int l, int s, int head, int dir, int rh) {
    const int tid = threadIdx.x, w = __builtin_amdgcn_readfirstlane(tid >> 6), lane = tid & 63, fr = lane & 15, fq = lane >> 4;
    const int rt = w & 3, half = w >> 2, hc = head * 64;
    const SeqInfo q = seqinfo(s); const int nchunk = q.T / 64;
    const bf16* RX = WSP(bf16, WS_RXC); bf16* U = WSP(bf16, WS_U1);
    const int pj = tid >> 3, psub = tid & 7;
    const int hh = lane >> 5, rsel = (lane >> 4) & 1, cg = lane & 15;
    const int row = 16 * rh + 2 * w + rsel, col0 = 32 * hh + 2 * cg;
    typedef float f32x2 __attribute__((ext_vector_type(2)));
    f32x2 S2;
    if (!q.grid) S2 = (f32x2){0.f, 0.f};
    else { const size_t sb = (((size_t)q.b * DEPTH + l) * 2 + dir) * RH + head; S2 = *(const f32x2*)(P.in[ST_R] + (sb * 64 + row) * 64 + col0); }
    float rkk8[8];
#pragma unroll
    for (int e = 0; e < 8; ++e) rkk8[e] = P.in[R_KK][(size_t)l * RW + hc + 8 * psub + e];
    float c_w0[2], c_a0[2], c_kk[2], c_ka[2];
    bf16x8 bw[2][2], ba[2][2];
#pragma unroll
    for (int cc = 0; cc < 2; ++cc) { const int c = 16 * (2 * half + cc) + fr;
        c_w0[cc] = P.in[R_W0][((size_t)l * 2 + dir) * RW + hc + c]; c_a0[cc] = P.in[R_A0][((size_t)l * 2 + dir) * RW + hc + c];
        c_kk[cc] = P.in[R_KK][(size_t)l * RW + hc + c]; c_ka[cc] = P.in[R_KA][(size_t)l * RW + hc + c];
#pragma unroll
        for (int ks = 0; ks < 2; ++ks)
#pragma unroll
            for (int e = 0; e < 8; ++e) { const int j = 32 * ks + 8 * fq + e;
                bw[cc][ks][e] = (short)f2bf(P.in[R_W2][(((size_t)l * 2 + dir) * 64 + j) * RW + hc + c]);
                ba[cc][ks][e] = (short)f2bf(P.in[R_A2][(((size_t)l * 2 + dir) * 64 + j) * RW + hc + c]); } }
    u32x4 pf[5];
#define RW_TOK(c, j) ((size_t)(q.base + (dir ? q.T - 1 - ((c) * 64 + (j)) : ((c) * 64 + (j)))))
#define RW_PREFETCH(c) do { const bf16* rx = RX + RW_TOK(c, pj) * RIN + 8 * psub; \
        pf[0] = *(const u32x4*)(rx + RX_R + hc); pf[1] = *(const u32x4*)(rx + RX_K + hc); pf[2] = *(const u32x4*)(rx + RX_V + hc); \
        pf[3] = *(const u32x4*)(rx + RX_WL + dir * 64); pf[4] = *(const u32x4*)(rx + RX_AL + dir * 64); } while (0)
    RW_PREFETCH(0);
    for (int c = 0; c < nchunk; ++c) {
        { LAS unsigned char* rec = lds + L_SBUF + pj * REC + psub * 32;
          *(LAS f32x4*)(rec + V_R * 256) = cvt_lo4(pf[0].x, pf[0].y); *(LAS f32x4*)(rec + V_R * 256 + 16) = cvt_lo4(pf[0].z, pf[0].w);
          { const f32x4 v0 = cvt_lo4(pf[2].x, pf[2].y), v1 = cvt_lo4(pf[2].z, pf[2].w);
#pragma unroll
            for (int e = 0; e < 4; ++e) { *(LAS float*)(lds + L_VT + vt_off(8 * psub + e, pj)) = v0[e]; *(LAS float*)(lds + L_VT + vt_off(8 * psub + 4 + e, pj)) = v1[e]; } }
          const f32x4 k0 = cvt_lo4(pf[1].x, pf[1].y), k1 = cvt_lo4(pf[1].z, pf[1].w);
          *(LAS f32x4*)(rec + V_K * 256) = k0; *(LAS f32x4*)(rec + V_K * 256 + 16) = k1;
          float ss = 0.f;
#pragma unroll
          for (int e = 0; e < 4; ++e) { const float x0 = k0[e] * rkk8[e], x1 = k1[e] * rkk8[4 + e]; ss += x0 * x0 + x1 * x1; }
          ss += dpp_xor1(ss); ss += dpp_xor2(ss); ss += __shfl_xor(ss, 4);
          if (psub == 0) *(LAS float*)(lds + L_INV + pj * 4) = 1.0f / fmaxf(sqrtf(ss), 1e-12f);
          *(LAS u32x4*)(lds + L_TW + pj * PT + psub * 16) = pf[3]; *(LAS u32x4*)(lds + L_AL + pj * PT + psub * 16) = pf[4]; }
        __syncthreads();
        if (c + 1 < nchunk) RW_PREFETCH(c + 1);
#pragma unroll
        for (int cc = 0; cc < 2; ++cc) { const int ct = 2 * half + cc; const int cidx = 16 * ct + fr;
            f32x4 aw = (f32x4){0.f, 0.f, 0.f, 0.f}, aa = (f32x4){0.f, 0.f, 0.f, 0.f};
#pragma unroll
            for (int ks = 0; ks < 2; ++ks) { aw = ml::mma(ml::frag(lds, L_TW, PT, 16 * rt, 32 * ks, lane), bw[cc][ks], aw); aa = ml::mma(ml::frag(lds, L_AL, PT, 16 * rt, 32 * ks, lane), ba[cc][ks], aa); }
#pragma unroll
            for (int r = 0; r < 4; ++r) { const int tok = 16 * rt + 4 * fq + r; LAS float* rec = (LAS float*)(lds + L_SBUF + tok * REC) + cidx;
                const float decay = __expf(-0.6065306597126334f * pg8::fsigmoid(c_w0[cc] + aw[r])); const float alpha = pg8::fsigmoid(c_a0[cc] + aa[r]);
                const float kraw = rec[V_K * 64]; const float kkn = kraw * c_kk[cc] * *(LAS float*)(lds + L_INV + tok * 4);
                rec[V_A * 64] = -kkn; rec[V_W * 64] = decay; rec[V_B * 64] = kkn * alpha; rec[V_K * 64] = kraw * (1.0f + (alpha - 1.0f) * c_ka[cc]); } }
        __syncthreads();
        {
            const LAS unsigned char* rbase = lds + L_SBUF + col0 * 4;
            f32x2 ca = *(const LAS f32x2*)(rbase + V_A * 256), cw = *(const LAS f32x2*)(rbase + V_W * 256), cb = *(const LAS f32x2*)(rbase + V_B * 256),
                  ck = *(const LAS f32x2*)(rbase + V_K * 256), cr = *(const LAS f32x2*)(rbase + V_R * 256);
#pragma unroll 1
            for (int blk = 0; blk < 4; ++blk) {
                float ykeep = 0.f;
#pragma unroll
                for (int g4 = 0; g4 < 4; ++g4) {
                    const f32x4 v4 = *(const LAS f32x4*)(lds + L_VT + vt_off(row, 16 * blk + 4 * g4));
#pragma unroll
                    for (int i4 = 0; i4 < 4; ++i4) {
                        const int i = 4 * g4 + i4, tt = 16 * blk + i, tn = tt < 63 ? tt + 1 : 63;
                        const LAS unsigned char* rn = rbase + tn * REC;
                        const f32x2 na = *(const LAS f32x2*)(rn + V_A * 256), nw = *(const LAS f32x2*)(rn + V_W * 256), nb = *(const LAS f32x2*)(rn + V_B * 256),
                                    nk = *(const LAS f32x2*)(rn + V_K * 256), nr = *(const LAS f32x2*)(rn + V_R * 256);
                        const float vv = v4[i4];
                        const f32x2 p = S2 * ca;
                        const float sa = allsum32(p.x + p.y);
                        S2 = S2 * cw + ck * vv;
                        S2 = cb * sa + S2;
                        const f32x2 yq = S2 * cr;
                        const float y = allsum32(yq.x + yq.y);
                        ykeep = (cg == i) ? y : ykeep;
                        ca = na; cw = nw; cb = nb; ck = nk; cr = nr;
                    }
                }
                if (hh == 0) *(LAS float*)(lds + L_YS + ((16 * blk + cg) * 16 + 2 * w + rsel) * 4) = ykeep;
            }
        }
        __syncthreads();
        if (tid < 128) { const int j = tid >> 1, pc = tid & 1; const LAS float* ys = (const LAS float*)(lds + L_YS) + j * 16 + 8 * pc;
            u32x4 o; o.x = pg8::cvt_pk_bf16(ys[0], ys[1]); o.y = pg8::cvt_pk_bf16(ys[2], ys[3]); o.z = pg8::cvt_pk_bf16(ys[4], ys[5]); o.w = pg8::cvt_pk_bf16(ys[6], ys[7]);
            *(u32x4*)(U + RW_TOK(c, j) * PU + OFF_R + dir * RW + hc + 16 * rh + 8 * pc) = o; }
    }
    if (!q.grid) { const size_t sb = (((size_t)q.b * DEPTH + l) * 2 + dir) * RH + head; *(f32x2*)(P.out + OUT_S + (sb * 64 + row) * 64 + col0) = S2; }
    __syncthreads();
#undef RW_TOK
#undef RW_PREFETCH
}
constexpr int N_ITEMS = NSEQ * RH * 2 * 4;
__device__ __forceinline__ void decode_item(int it, int& s, int& head, int& dir, int& rh) {
    rh = it & 3; int ch = it >> 2; dir = ch & 1; ch >>= 1; head = ch % RH; const int sq = ch / RH;
    s = sq < LB ? CB + sq : sq - LB;
}
}


namespace wy {
typedef short bf16x8 __attribute__((ext_vector_type(8)));
typedef float f32x4 __attribute__((ext_vector_type(4)));
typedef unsigned u32x4 __attribute__((ext_vector_type(4)));
constexpr int PV = 144, PS = 48, PVS = 136;
constexpr int L_AH = 0, L_RH = L_AH + 64 * PV, L_BT = L_RH + 64 * PV, L_KT = L_BT + 64 * PV, L_VS = L_KT + 64 * PV, L_NAKT = L_VS + 64 * PV, L_NRKT = L_NAKT + 4 * 16 * PS,
              L_NRBT = L_NRKT + 4 * 16 * PS, L_TT = L_NRBT + 4 * 16 * PS, L_GL = L_TT + 4 * 16 * PS, PACK_BYTES = L_GL + 1024,
              L_BH = PACK_BYTES, L_KH = L_BH + 64 * PV, L_YS = L_KH + 64 * PV, L_TW = L_YS + 64 * PV, L_AL = L_TW + 64 * PV, L_NAB = L_AL + 64 * PV, L_INV = L_NAB + 4096, L_END = L_INV + 256;
constexpr int RING = 6, PACK_U = PACK_BYTES / 16, N_LAT = LB * RH * 2, RING_A = 22;
static_assert(PACK_BYTES % 16 == 0 && PACK_U <= 8 * 512 && (size_t)RING_A * RING * PACK_BYTES <= (size_t)N1P * D * 2 && WS_END + (size_t)(N_LAT - RING_A) * RING * PACK_BYTES <= ((size_t)256 << 20), "ring placement");
static_assert(L_END <= 131072, "WY LDS map");
__device__ __forceinline__ bf16x8 fragk16(LAS unsigned char* lds, int base, int pitch, int row0, int k0, int lane) {
    const bf16x8 v = *(const LAS bf16x8*)(lds + base + (row0 + (lane & 15)) * pitch + (k0 + 8 * ((lane >> 4) & 1)) * 2);
    const bf16x8 z = {0, 0, 0, 0, 0, 0, 0, 0};
    return (lane < 32) ? v : z;
}
__device__ __forceinline__ void stb(LAS unsigned char* lds, int off, float v) { *(LAS bf16*)(lds + off) = f2bf(v); }
typedef unsigned u32x2 __attribute__((ext_vector_type(2)));
__device__ __forceinline__ bf16x8 pack_k16(const f32x4 v) { u32x4 o; o.x = pg8::cvt_pk_bf16(v[0], v[1]); o.y = pg8::cvt_pk_bf16(v[2], v[3]); o.z = 0u; o.w = 0u; return __builtin_bit_cast(bf16x8, o); }
__device__ __forceinline__ bf16x8 pack_k32(const f32x4 a, const f32x4 b) { u32x4 o; o.x = pg8::cvt_pk_bf16(a[0], a[1]); o.y = pg8::cvt_pk_bf16(a[2], a[3]); o.z = pg8::cvt_pk_bf16(b[0], b[1]); o.w = pg8::cvt_pk_bf16(b[2], b[3]);
    return __builtin_bit_cast(bf16x8, o); }
__device__ __forceinline__ bf16x8 ld_k16(LAS unsigned char* lds, int base, int pitch, int row0, int col0, int lane) {
    const u32x2 v = *(const LAS u32x2*)(lds + base + (row0 + (lane & 15)) * pitch + (col0 + 4 * (lane >> 4)) * 2); u32x4 o; o.x = v.x; o.y = v.y; o.z = 0u; o.w = 0u; return __builtin_bit_cast(bf16x8, o); }
__device__ __forceinline__ bf16x8 ld_k32(LAS unsigned char* lds, int base, int pitch, int row0, int col0, int lane) {
    const LAS unsigned char* p = lds + base + (row0 + (lane & 15)) * pitch + (col0 + 4 * (lane >> 4)) * 2;
    const u32x2 v0 = *(const LAS u32x2*)p, v1 = *(const LAS u32x2*)(p + 32); u32x4 o; o.x = v0.x; o.y = v0.y; o.z = v1.x; o.w = v1.y; return __builtin_bit_cast(bf16x8, o); }
__device__ __forceinline__ void rwkv_item(LAS unsigned char* lds, CParams& P, int l, int s, int head, int dir) {
    const int tid = threadIdx.x, w = __builtin_amdgcn_readfirstlane(tid >> 6), lane = tid & 63, fr = lane & 15, fq = lane >> 4;
    const int rt = w & 3, half = w >> 2, hc = head * 64;
    const SeqInfo q = seqinfo(s); const int nchunk = q.T / 64;
    const bf16* RX = WSP(bf16, WS_RXC); bf16* U = WSP(bf16, WS_U1);
    const int pj = tid >> 3, psub = tid & 7;
    f32x4 sacc[4];
#pragma unroll
    for (int ct = 0; ct < 4; ++ct) sacc[ct] = (f32x4){0.f, 0.f, 0.f, 0.f};
    if (w < 4 && q.grid) { const size_t sb = (((size_t)q.b * DEPTH + l) * 2 + dir) * RH + head;
#pragma unroll
        for (int ct = 0; ct < 4; ++ct) sacc[ct] = *(const f32x4*)(P.in[ST_R] + (sb * 64 + 16 * w + fr) * 64 + 16 * ct + 4 * fq); }
    float rkk8[8];
#pragma unroll
    for (int e = 0; e < 8; ++e) rkk8[e] = P.in[R_KK][(size_t)l * RW + hc + 8 * psub + e];
    float c_w0[2], c_a0[2], c_kk[2], c_ka[2];
#pragma unroll
    for (int cc = 0; cc < 2; ++cc) { const int c = 16 * (2 * half + cc) + fr;
        c_w0[cc] = P.in[R_W0][((size_t)l * 2 + dir) * RW + hc + c]; c_a0[cc] = P.in[R_A0][((size_t)l * 2 + dir) * RW + hc + c];
        c_kk[cc] = P.in[R_KK][(size_t)l * RW + hc + c]; c_ka[cc] = P.in[R_KA][(size_t)l * RW + hc + c]; }
    const bf16* w2t = WSP(bf16, O_W2T) + ((size_t)dir * RW + hc) * 64; const bf16* a2t = WSP(bf16, O_A2T) + ((size_t)dir * RW + hc) * 64;
    u32x4 pf[5];
#define WY_TOK(c, j) ((size_t)(q.base + (dir ? q.T - 1 - ((c) * 64 + (j)) : ((c) * 64 + (j)))))
#define WY_PREFETCH(c) do { const bf16* rx = RX + WY_TOK(c, pj) * RIN + 8 * psub; \
        pf[0] = *(const u32x4*)(rx + RX_R + hc); pf[1] = *(const u32x4*)(rx + RX_K + hc); pf[2] = *(const u32x4*)(rx + RX_V + hc); \
        pf[3] = *(const u32x4*)(rx + RX_WL + dir * 64); pf[4] = *(const u32x4*)(rx + RX_AL + dir * 64); } while (0)
    WY_PREFETCH(0);
    for (int c = 0; c < nchunk; ++c) {
        { *(LAS u32x4*)(lds + L_RH + pj * PV + psub * 16) = pf[0]; *(LAS u32x4*)(lds + L_KH + pj * PV + psub * 16) = pf[1];
          const unsigned kw[4] = {pf[1].x, pf[1].y, pf[1].z, pf[1].w}, vw[4] = {pf[2].x, pf[2].y, pf[2].z, pf[2].w};
          float ss = 0.f;
#pragma unroll
          for (int e = 0; e < 8; ++e) { const float kf = __builtin_bit_cast(float, (e & 1) ? (kw[e >> 1] & 0xffff0000u) : (kw[e >> 1] << 16)) * rkk8[e]; ss += kf * kf;
              *(LAS bf16*)(lds + L_VS + (8 * psub + e) * PVS + pj * 2) = (bf16)((vw[e >> 1] >> ((e & 1) * 16)) & 0xffffu); }
          ss += rw::dpp_xor1(ss); ss += rw::dpp_xor2(ss); ss += __shfl_xor(ss, 4);
          if (psub == 0) *(LAS float*)(lds + L_INV + pj * 4) = 1.0f / fmaxf(sqrtf(ss), 1e-12f);
          *(LAS u32x4*)(lds + L_TW + pj * PV + psub * 16) = pf[3]; *(LAS u32x4*)(lds + L_AL + pj * PV + psub * 16) = pf[4]; }
        LDS_BARRIER();
        if (c + 1 < nchunk) WY_PREFETCH(c + 1);
#pragma unroll
        for (int cc = 0; cc < 2; ++cc) { const int ct = 2 * half + cc; const int cidx = 16 * ct + fr;
            f32x4 aw = (f32x4){0.f, 0.f, 0.f, 0.f}, aa = (f32x4){0.f, 0.f, 0.f, 0.f};
#pragma unroll
            for (int ks = 0; ks < 2; ++ks) { const size_t bo = (size_t)cidx * 64 + 32 * ks + 8 * fq;
                aw = ml::mma(ml::frag(lds, L_TW, PV, 16 * rt, 32 * ks, lane), *(const bf16x8*)(w2t + bo), aw); aa = ml::mma(ml::frag(lds, L_AL, PV, 16 * rt, 32 * ks, lane), *(const bf16x8*)(a2t + bo), aa); }
            float kr4[4], rr4[4], iv4[4];
#pragma unroll
            for (int r = 0; r < 4; ++r) { const int tok = 16 * rt + 4 * fq + r; kr4[r] = bf2f(*(const LAS bf16*)(lds + L_KH + tok * PV + cidx * 2)); rr4[r] = bf2f(*(const LAS bf16*)(lds + L_RH + tok * PV + cidx * 2));
                iv4[r] = *(const LAS float*)(lds + L_INV + tok * 4); }
            float lw[4], cum[4];
#pragma unroll
            for (int r = 0; r < 4; ++r) { lw[r] = -0.6065306597126334f * pg8::fsigmoid(c_w0[cc] + aw[r]); cum[r] = (r ? cum[r - 1] : 0.f) + lw[r]; }
            const float tot = cum[3]; const float p1 = __shfl_up(tot, 16), p2 = __shfl_up(tot, 32), p3 = __shfl_up(tot, 48);
            const float off = (fq >= 1 ? p1 : 0.f) + (fq >= 2 ? p2 : 0.f) + (fq >= 3 ? p3 : 0.f);
            float gprev = __expf(off);
#pragma unroll
            for (int r = 0; r < 4; ++r) { const int tok = 16 * rt + 4 * fq + r; const float lam = off + cum[r]; const float g = __expf(lam), gi = __builtin_amdgcn_rcpf(g);
                const float alpha = pg8::fsigmoid(c_a0[cc] + aa[r]);
                const float kraw = kr4[r], rraw = rr4[r];
                const float kkn = kraw * c_kk[cc] * iv4[r];
                const bf16 bh = f2bf(kkn * alpha * gi), kh = f2bf(kraw * (1.0f + (alpha - 1.0f) * c_ka[cc]) * gi);
                stb(lds, L_AH + tok * PV + cidx * 2, -kkn * gprev); stb(lds, L_RH + tok * PV + cidx * 2, rraw * g);
                *(LAS bf16*)(lds + L_BH + tok * PV + cidx * 2) = bh; *(LAS bf16*)(lds + L_KH + tok * PV + cidx * 2) = kh;
                *(LAS bf16*)(lds + L_BT + cidx * PV + tok * 2) = bh; *(LAS bf16*)(lds + L_KT + cidx * PV + tok * 2) = kh;
                if (fq == 3 && r == 3) *(LAS float*)(lds + L_GL + (rt * 64 + cidx) * 4) = g;
                gprev = g; } }
        LDS_BARRIER();
        { const int sc = w >> 1, side = w & 1; f32x4 gB = (f32x4){0.f, 0.f, 0.f, 0.f}, gK = (f32x4){0.f, 0.f, 0.f, 0.f};
#pragma unroll
          for (int ks = 0; ks < 2; ++ks) { const bf16x8 af = ml::frag(lds, side ? L_RH : L_AH, PV, 16 * sc, 32 * ks, lane);
              gB = ml::mma(af, ml::frag(lds, L_BH, PV, 16 * sc, 32 * ks, lane), gB); gK = ml::mma(af, ml::frag(lds, L_KH, PV, 16 * sc, 32 * ks, lane), gK); }
#pragma unroll
          for (int r = 0; r < 4; ++r) { const int t = 4 * fq + r; const bool keep = side ? (fr <= t) : (fr < t); const float vB = keep ? gB[r] : 0.f, vK = keep ? gK[r] : 0.f;
              if (side == 0) { *(LAS float*)(lds + L_NAB + ((sc * 16 + t) * 16 + fr) * 4) = vB; stb(lds, L_NAKT + (sc * 16 + t) * PS + fr * 2, vK); }
              else { stb(lds, L_NRBT + (sc * 16 + t) * PS + fr * 2, vB); stb(lds, L_NRKT + (sc * 16 + t) * PS + fr * 2, vK); } } }
        if ((w & 1) == 0 && lane < 16) { const int sc = w >> 1; float Tr[16];
            asm volatile("" ::: "memory");
#pragma unroll
            for (int ph = 0; ph < 4; ++ph) { f32x4 nv[4][4];
#pragma unroll
                for (int tq = 0; tq < 4; ++tq)
#pragma unroll
                    for (int u4 = 0; u4 <= ph; ++u4) nv[tq][u4] = *(const LAS f32x4*)(lds + L_NAB + ((sc * 16 + 4 * ph + tq) * 16 + 4 * u4) * 4);
#pragma unroll
                for (int tq = 0; tq < 4; ++tq) { const int t = 4 * ph + tq; float x0 = (lane == t) ? 1.f : 0.f, x1 = 0.f;
#pragma unroll
                    for (int u = 0; u < 16; ++u) if (u < t) { if (u & 1) x1 += Tr[u] * nv[tq][u >> 2][u & 3]; else x0 += Tr[u] * nv[tq][u >> 2][u & 3]; }
                    Tr[t] = x0 + x1; stb(lds, L_TT + (sc * 16 + t) * PS + lane * 2, Tr[t]); } } }
        LDS_BARRIER();
        if (w < 4) {
#pragma unroll 1
            for (int sc = 0; sc < 4; ++sc) {
                const bf16x8 ah0 = ld_k32(lds, L_AH, PV, 16 * sc, 0, lane), ah1 = ld_k32(lds, L_AH, PV, 16 * sc, 32, lane), rh0 = ld_k32(lds, L_RH, PV, 16 * sc, 0, lane), rh1 = ld_k32(lds, L_RH, PV, 16 * sc, 32, lane);
                const bf16x8 nak = ld_k16(lds, L_NAKT, PS, 16 * sc, 0, lane), nrk = ld_k16(lds, L_NRKT, PS, 16 * sc, 0, lane), ttf = ld_k16(lds, L_TT, PS, 16 * sc, 0, lane), nrb = ld_k16(lds, L_NRBT, PS, 16 * sc, 0, lane);
                const bf16x8 vsf = ld_k16(lds, L_VS, PVS, 16 * w, 16 * sc, lane);
                bf16x8 btf[4], ktf[4]; f32x4 glv[4];
#pragma unroll
                for (int ct = 0; ct < 4; ++ct) { btf[ct] = ld_k16(lds, L_BT, PV, 16 * ct, 16 * sc, lane); ktf[ct] = ld_k16(lds, L_KT, PV, 16 * ct, 16 * sc, lane);
                    glv[ct] = *(const LAS f32x4*)(lds + L_GL + (sc * 64 + 16 * ct + 4 * fq) * 4); }
                const bf16x8 sb0 = pack_k32(sacc[0], sacc[1]), sb1 = pack_k32(sacc[2], sacc[3]);
                f32x4 XT = (f32x4){0.f, 0.f, 0.f, 0.f}, YT = (f32x4){0.f, 0.f, 0.f, 0.f};
                XT = ml::mma(ah0, sb0, XT); XT = ml::mma(ah1, sb1, XT); XT = ml::mma(nak, vsf, XT);
                YT = ml::mma(rh0, sb0, YT); YT = ml::mma(rh1, sb1, YT); YT = ml::mma(nrk, vsf, YT);
                f32x4 UT = (f32x4){0.f, 0.f, 0.f, 0.f};
                UT = ml::mma(ttf, pack_k16(XT), UT);
                const bf16x8 ub = pack_k16(UT);
                YT = ml::mma(nrb, ub, YT);
#pragma unroll
                for (int r = 0; r < 4; ++r) stb(lds, L_YS + (16 * sc + 4 * fq + r) * PV + (16 * w + fr) * 2, YT[r]);
#pragma unroll
                for (int ct = 0; ct < 4; ++ct) { sacc[ct] = ml::mma(btf[ct], ub, sacc[ct]); sacc[ct] = ml::mma(ktf[ct], vsf, sacc[ct]); sacc[ct] = sacc[ct] * glv[ct]; }
            }
        }
        LDS_BARRIER();
        *(u32x4*)(U + WY_TOK(c, pj) * PU + OFF_R + dir * RW + hc + 8 * psub) = *(const LAS u32x4*)(lds + L_YS + pj * PV + psub * 16);
    }
    if (!q.grid && w < 4) { const size_t sb = (((size_t)q.b * DEPTH + l) * 2 + dir) * RH + head;
#pragma unroll
        for (int ct = 0; ct < 4; ++ct) *(f32x4*)(P.out + OUT_S + (sb * 64 + 16 * w + fr) * 64 + 16 * ct + 4 * fq) = sacc[ct]; }
    LDS_BARRIER();
#undef WY_TOK
#undef WY_PREFETCH
}
__device__ __forceinline__ int tid_opaque() { int t = threadIdx.x; asm volatile("" : "+v"(t)); return t; }
constexpr int CW_F = 16384, FL_STRIDE = 64, NPROD = 2;
static_assert(RING % NPROD == 0 && NPROD + 1 <= 4 && CW_F + DEPTH * N_LAT * 4 * FL_STRIDE <= 32768, "flag block");
constexpr unsigned FL_SPIN_CAP = 1u << 18;
__device__ __forceinline__ unsigned fl_ld(unsigned* p) { return __hip_atomic_load(p, __ATOMIC_RELAXED, __HIP_MEMORY_SCOPE_AGENT); }
__device__ __forceinline__ unsigned fl_wait_ge(unsigned* p, unsigned want, unsigned* tmo) {
    unsigned sp = 0, v;
    while ((v = fl_ld(p)) < want) { __builtin_amdgcn_s_sleep(1); if ((++sp & 255u) == 0u) { if (fl_ld(tmo)) break; if (sp > FL_SPIN_CAP) { atomicAdd(tmo, 1u); break; } } }
    return v;
}
__device__ __forceinline__ void rwkv_prod(LAS unsigned char* lds, CParams& P, int l, int s, int head, int dir, int chain, int pp, unsigned* ctl) {
    const int tid = tid_opaque(), w = __builtin_amdgcn_readfirstlane(tid >> 6), lane = tid & 63, fr = lane & 15, fq = lane >> 4;
    const int rt = w & 3, half = w >> 2, hc = head * 64;
    const SeqInfo q = seqinfo(s); const int nchunk = q.T / 64;
    const bf16* RX = WSP(bf16, WS_RXC);
    const int pj = tid >> 3, psub = tid & 7;
    unsigned char* ring = P.ws + (chain < RING_A ? O_WIN1 + (size_t)chain * RING * PACK_BYTES : WS_END + (size_t)(chain - RING_A) * RING * PACK_BYTES);
    unsigned* f_base = ctl + CW_F + (size_t)((l * N_LAT + chain) * 4) * FL_STRIDE; unsigned* f_ready = f_base + pp * FL_STRIDE; unsigned* f_ack = f_base + NPROD * FL_STRIDE; unsigned* tmo = ctl + 4096 + 128;
    float rkk8[8];
#pragma unroll
    for (int e = 0; e < 8; ++e) rkk8[e] = P.in[R_KK][(size_t)l * RW + hc + 8 * psub + e];
    float c_w0[2], c_a0[2], c_kk[2], c_ka[2];
#pragma unroll
    for (int cc = 0; cc < 2; ++cc) { const int c = 16 * (2 * half + cc) + fr;
        c_w0[cc] = P.in[R_W0][((size_t)l * 2 + dir) * RW + hc + c]; c_a0[cc] = P.in[R_A0][((size_t)l * 2 + dir) * RW + hc + c];
        c_kk[cc] = P.in[R_KK][(size_t)l * RW + hc + c]; c_ka[cc] = P.in[R_KA][(size_t)l * RW + hc + c]; }
    const bf16* w2t = WSP(bf16, O_W2T) + ((size_t)dir * RW + hc) * 64; const bf16* a2t = WSP(bf16, O_A2T) + ((size_t)dir * RW + hc) * 64;
    u32x4 pf[5];
#define WY_TOK(c, j) ((size_t)(q.base + (dir ? q.T - 1 - ((c) * 64 + (j)) : ((c) * 64 + (j)))))
#define WY_PREFETCH(c) do { const bf16* rx = RX + WY_TOK(c, pj) * RIN + 8 * psub; \
        pf[0] = *(const u32x4*)(rx + RX_R + hc); pf[1] = *(const u32x4*)(rx + RX_K + hc); pf[2] = *(const u32x4*)(rx + RX_V + hc); \
        pf[3] = *(const u32x4*)(rx + RX_WL + dir * 64); pf[4] = *(const u32x4*)(rx + RX_AL + dir * 64); } while (0)
    WY_PREFETCH(pp);
    asm volatile("" :: "v"(pf[0]), "v"(pf[1]), "v"(pf[2]), "v"(pf[3]), "v"(pf[4]) : "memory");
    unsigned acked = 0u;
    for (int c = pp; c < nchunk; c += NPROD) {
        { *(LAS u32x4*)(lds + L_RH + pj * PV + psub * 16) = pf[0]; *(LAS u32x4*)(lds + L_KH + pj * PV + psub * 16) = pf[1];
          const unsigned kw[4] = {pf[1].x, pf[1].y, pf[1].z, pf[1].w}, vw[4] = {pf[2].x, pf[2].y, pf[2].z, pf[2].w};
          float ss = 0.f;
#pragma unroll
          for (int e = 0; e < 8; ++e) { const float kf = __builtin_bit_cast(float, (e & 1) ? (kw[e >> 1] & 0xffff0000u) : (kw[e >> 1] << 16)) * rkk8[e]; ss += kf * kf;
              *(LAS bf16*)(lds + L_VS + (8 * psub + e) * PVS + pj * 2) = (bf16)((vw[e >> 1] >> ((e & 1) * 16)) & 0xffffu); }
          ss += rw::dpp_xor1(ss); ss += rw::dpp_xor2(ss); ss += __shfl_xor(ss, 4);
          if (psub == 0) *(LAS float*)(lds + L_INV + pj * 4) = 1.0f / fmaxf(sqrtf(ss), 1e-12f);
          *(LAS u32x4*)(lds + L_TW + pj * PV + psub * 16) = pf[3]; *(LAS u32x4*)(lds + L_AL + pj * PV + psub * 16) = pf[4]; }
        LDS_BARRIER();
        if (c + NPROD < nchunk) WY_PREFETCH(c + NPROD);
#pragma unroll
        for (int cc = 0; cc < 2; ++cc) { const int ct = 2 * half + cc; const int cidx = 16 * ct + fr;
            f32x4 aw = (f32x4){0.f, 0.f, 0.f, 0.f}, aa = (f32x4){0.f, 0.f, 0.f, 0.f};
#pragma unroll
            for (int ks = 0; ks < 2; ++ks) { const size_t bo = (size_t)cidx * 64 + 32 * ks + 8 * fq;
                aw = ml::mma(ml::frag(lds, L_TW, PV, 16 * rt, 32 * ks, lane), *(const bf16x8*)(w2t + bo), aw); aa = ml::mma(ml::frag(lds, L_AL, PV, 16 * rt, 32 * ks, lane), *(const bf16x8*)(a2t + bo), aa); }
            float kr4[4], rr4[4], iv4[4];
#pragma unroll
            for (int r = 0; r < 4; ++r) { const int tok = 16 * rt + 4 * fq + r; kr4[r] = bf2f(*(const LAS bf16*)(lds + L_KH + tok * PV + cidx * 2)); rr4[r] = bf2f(*(const LAS bf16*)(lds + L_RH + tok * PV + cidx * 2));
                iv4[r] = *(const LAS float*)(lds + L_INV + tok * 4); }
            float lw[4], cum[4];
#pragma unroll
            for (int r = 0; r < 4; ++r) { lw[r] = -0.6065306597126334f * pg8::fsigmoid(c_w0[cc] + aw[r]); cum[r] = (r ? cum[r - 1] : 0.f) + lw[r]; }
            const float tot = cum[3]; const float p1 = __shfl_up(tot, 16), p2 = __shfl_up(tot, 32), p3 = __shfl_up(tot, 48);
            const float off = (fq >= 1 ? p1 : 0.f) + (fq >= 2 ? p2 : 0.f) + (fq >= 3 ? p3 : 0.f);
            float gprev = __expf(off);
#pragma unroll
            for (int r = 0; r < 4; ++r) { const int tok = 16 * rt + 4 * fq + r; const float lam = off + cum[r]; const float g = __expf(lam), gi = __builtin_amdgcn_rcpf(g);
                const float alpha = pg8::fsigmoid(c_a0[cc] + aa[r]);
                const float kraw = kr4[r], rraw = rr4[r];
                const float kkn = kraw * c_kk[cc] * iv4[r];
                const bf16 bh = f2bf(kkn * alpha * gi), kh = f2bf(kraw * (1.0f + (alpha - 1.0f) * c_ka[cc]) * gi);
                stb(lds, L_AH + tok * PV + cidx * 2, -kkn * gprev); stb(lds, L_RH + tok * PV + cidx * 2, rraw * g);
                *(LAS bf16*)(lds + L_BH + tok * PV + cidx * 2) = bh; *(LAS bf16*)(lds + L_KH + tok * PV + cidx * 2) = kh;
                *(LAS bf16*)(lds + L_BT + cidx * PV + tok * 2) = bh; *(LAS bf16*)(lds + L_KT + cidx * PV + tok * 2) = kh;
                if (fq == 3 && r == 3) *(LAS float*)(lds + L_GL + (rt * 64 + cidx) * 4) = g;
                gprev = g; } }
        asm volatile("s_waitcnt vmcnt(0)" ::: "memory");
        LDS_BARRIER();
        if (tid == 0 && c > pp) __hip_atomic_store(f_ready, (unsigned)((c - pp) / NPROD), __ATOMIC_RELAXED, __HIP_MEMORY_SCOPE_AGENT);
        { const int sc = w >> 1, side = w & 1; f32x4 gB = (f32x4){0.f, 0.f, 0.f, 0.f}, gK = (f32x4){0.f, 0.f, 0.f, 0.f};
#pragma unroll
          for (int ks = 0; ks < 2; ++ks) { const bf16x8 af = ml::frag(lds, side ? L_RH : L_AH, PV, 16 * sc, 32 * ks, lane);
              gB = ml::mma(af, ml::frag(lds, L_BH, PV, 16 * sc, 32 * ks, lane), gB); gK = ml::mma(af, ml::frag(lds, L_KH, PV, 16 * sc, 32 * ks, lane), gK); }
#pragma unroll
          for (int r = 0; r < 4; ++r) { const int t = 4 * fq + r; const bool keep = side ? (fr <= t) : (fr < t); const float vB = keep ? gB[r] : 0.f, vK = keep ? gK[r] : 0.f;
              if (side == 0) { *(LAS float*)(lds + L_NAB + ((sc * 16 + t) * 16 + fr) * 4) = vB; stb(lds, L_NAKT + (sc * 16 + t) * PS + fr * 2, vK); }
              else { stb(lds, L_NRBT + (sc * 16 + t) * PS + fr * 2, vB); stb(lds, L_NRKT + (sc * 16 + t) * PS + fr * 2, vK); } } }
        if ((w & 1) == 0 && lane < 16) { const int sc = w >> 1; float Tr[16];
            asm volatile("" ::: "memory");
#pragma unroll
            for (int ph = 0; ph < 4; ++ph) { f32x4 nv[4][4];
#pragma unroll
                for (int tq = 0; tq < 4; ++tq)
#pragma unroll
                    for (int u4 = 0; u4 <= ph; ++u4) nv[tq][u4] = *(const LAS f32x4*)(lds + L_NAB + ((sc * 16 + 4 * ph + tq) * 16 + 4 * u4) * 4);
#pragma unroll
                for (int tq = 0; tq < 4; ++tq) { const int t = 4 * ph + tq; float x0 = (lane == t) ? 1.f : 0.f, x1 = 0.f;
#pragma unroll
                    for (int u = 0; u < 16; ++u) if (u < t) { if (u & 1) x1 += Tr[u] * nv[tq][u >> 2][u & 3]; else x0 += Tr[u] * nv[tq][u >> 2][u & 3]; }
                    Tr[t] = x0 + x1; stb(lds, L_TT + (sc * 16 + t) * PS + lane * 2, Tr[t]); } } }
        if (tid == 0 && c >= RING && acked < (unsigned)(c - RING + 1)) acked = fl_wait_ge(f_ack, (unsigned)(c - RING + 1), tmo);
        LDS_BARRIER();
        asm volatile("" :: "v"(pf[0]), "v"(pf[1]), "v"(pf[2]), "v"(pf[3]), "v"(pf[4]) : "memory");
        { unsigned char* slot = ring + (size_t)(c % RING) * PACK_BYTES;
#pragma unroll
          for (int k = 0; k < 8; ++k) { const int u = tid + 512 * k;
              if (u < PACK_U) { const u32x4 v = *(const LAS u32x4*)(lds + 16 * u); const u32x4* gp = (const u32x4*)(slot + (size_t)16 * u);
                  asm volatile("global_store_dwordx4 %0, %1, off sc1" :: "v"(gp), "v"(v) : "memory"); } } }
        LDS_BARRIER();
    }
    asm volatile("s_waitcnt vmcnt(0)" ::: "memory");
    __syncthreads();
    if (tid == 0) __hip_atomic_store(f_ready, (unsigned)((nchunk - pp + NPROD - 1) / NPROD), __ATOMIC_RELAXED, __HIP_MEMORY_SCOPE_AGENT);
    LDS_BARRIER();
#undef WY_TOK
#undef WY_PREFETCH
}
__device__ __forceinline__ void rwkv_cons(LAS unsigned char* lds, CParams& P, int l, int s, int head, int dir, int chain, unsigned* ctl) {
    const int tid = tid_opaque(), w = __builtin_amdgcn_readfirstlane(tid >> 6), lane = tid & 63, fr = lane & 15, fq = lane >> 4;
    const int hc = head * 64;
    const SeqInfo q = seqinfo(s); const int nchunk = q.T / 64;
    bf16* U = WSP(bf16, WS_U1);
    const unsigned char* ring = P.ws + (chain < RING_A ? O_WIN1 + (size_t)chain * RING * PACK_BYTES : WS_END + (size_t)(chain - RING_A) * RING * PACK_BYTES);
    unsigned* f_base = ctl + CW_F + (size_t)((l * N_LAT + chain) * 4) * FL_STRIDE; unsigned* f_ack = f_base + NPROD * FL_STRIDE; unsigned* tmo = ctl + 4096 + 128;
    constexpr int C_YS = 2 * PACK_BYTES;
    static_assert(C_YS + 64 * PV <= 131072, "consumer LDS map");
    f32x4 sacc[4];
#pragma unroll
    for (int ct = 0; ct < 4; ++ct) sacc[ct] = (f32x4){0.f, 0.f, 0.f, 0.f};
    if (w < 4 && q.grid) { const size_t sb = (((size_t)q.b * DEPTH + l) * 2 + dir) * RH + head;
#pragma unroll
        for (int ct = 0; ct < 4; ++ct) sacc[ct] = *(const f32x4*)(P.in[ST_R] + (sb * 64 + 16 * w + fr) * 64 + 16 * ct + 4 * fq); }
#define WY_TOK(c, j) ((size_t)(q.base + (dir ? q.T - 1 - ((c) * 64 + (j)) : ((c) * 64 + (j)))))
    unsigned seen0 = 0u, seen1 = 0u;
#define CONS_FETCH(c, boff) do { const int p_ = (c) % NPROD; const unsigned need_ = (unsigned)((c) / NPROD + 1); \
        if ((p_ ? seen1 : seen0) < need_) { unsigned v_ = 0u; if (lane == 0) v_ = fl_wait_ge(f_base + p_ * FL_STRIDE, need_, tmo); v_ = __builtin_amdgcn_readfirstlane(v_); \
            if (p_) seen1 = v_; else seen0 = v_; __builtin_amdgcn_fence(__ATOMIC_ACQUIRE, "agent"); } \
        const unsigned char* slot = ring + (size_t)((c) % RING) * PACK_BYTES; \
        for (int k = w - 4; k < PACK_BYTES / 1024; k += 4) \
            __builtin_amdgcn_global_load_lds((const unsigned*)(slot + (size_t)k * 1024 + lane * 16), (LAS unsigned*)(lds + (boff) + k * 1024), 16, 0, 0); \
        asm volatile("s_waitcnt vmcnt(0)" ::: "memory"); } while (0)
    if (w >= 4) CONS_FETCH(0, 0);
    LDS_BARRIER();
    if (tid == 256) __hip_atomic_store(f_ack, 1u, __ATOMIC_RELAXED, __HIP_MEMORY_SCOPE_AGENT);
    for (int c = 0; c < nchunk; ++c) {
        const int boff = (c & 1) * PACK_BYTES;
        if (w >= 4) { if (c + 1 < nchunk) CONS_FETCH(c + 1, PACK_BYTES - boff); }
        else {
            LAS unsigned char* pb = lds + boff;
#pragma unroll 1
            for (int sc = 0; sc < 4; ++sc) {
                const bf16x8 ah0 = ld_k32(pb, L_AH, PV, 16 * sc, 0, lane), ah1 = ld_k32(pb, L_AH, PV, 16 * sc, 32, lane), rh0 = ld_k32(pb, L_RH, PV, 16 * sc, 0, lane), rh1 = ld_k32(pb, L_RH, PV, 16 * sc, 32, lane);
                const bf16x8 nak = ld_k16(pb, L_NAKT, PS, 16 * sc, 0, lane), nrk = ld_k16(pb, L_NRKT, PS, 16 * sc, 0, lane), ttf = ld_k16(pb, L_TT, PS, 16 * sc, 0, lane), nrb = ld_k16(pb, L_NRBT, PS, 16 * sc, 0, lane);
                const bf16x8 vsf = ld_k16(pb, L_VS, PVS, 16 * w, 16 * sc, lane);
                bf16x8 btf[4], ktf[4]; f32x4 glv[4];
#pragma unroll
                for (int ct = 0; ct < 4; ++ct) { btf[ct] = ld_k16(pb, L_BT, PV, 16 * ct, 16 * sc, lane); ktf[ct] = ld_k16(pb, L_KT, PV, 16 * ct, 16 * sc, lane);
                    glv[ct] = *(const LAS f32x4*)(pb + L_GL + (sc * 64 + 16 * ct + 4 * fq) * 4); }
                const bf16x8 sb0 = pack_k32(sacc[0], sacc[1]), sb1 = pack_k32(sacc[2], sacc[3]);
                f32x4 XT = (f32x4){0.f, 0.f, 0.f, 0.f}, YT = (f32x4){0.f, 0.f, 0.f, 0.f};
                XT = ml::mma(ah0, sb0, XT); XT = ml::mma(ah1, sb1, XT); XT = ml::mma(nak, vsf, XT);
                YT = ml::mma(rh0, sb0, YT); YT = ml::mma(rh1, sb1, YT); YT = ml::mma(nrk, vsf, YT);
                f32x4 UT = (f32x4){0.f, 0.f, 0.f, 0.f};
                UT = ml::mma(ttf, pack_k16(XT), UT);
                const bf16x8 ub = pack_k16(UT);
                YT = ml::mma(nrb, ub, YT);
#pragma unroll
                for (int r = 0; r < 4; ++r) stb(lds, C_YS + (16 * sc + 4 * fq + r) * PV + (16 * w + fr) * 2, YT[r]);
#pragma unroll
                for (int ct = 0; ct < 4; ++ct) { sacc[ct] = ml::mma(btf[ct], ub, sacc[ct]); sacc[ct] = ml::mma(ktf[ct], vsf, sacc[ct]); sacc[ct] = sacc[ct] * glv[ct]; }
            }
            { const LAS unsigned char* yp = lds + C_YS + lane * PV + 32 * w; const u32x4 y0 = *(const LAS u32x4*)yp, y1 = *(const LAS u32x4*)(yp + 16);
              bf16* up = U + WY_TOK(c, lane) * PU + OFF_R + dir * RW + hc + 16 * w; *(u32x4*)up = y0; *(u32x4*)(up + 8) = y1; }
        }
        LDS_BARRIER();
        if (tid == 256 && c + 1 < nchunk) __hip_atomic_store(f_ack, (unsigned)(c + 2), __ATOMIC_RELAXED, __HIP_MEMORY_SCOPE_AGENT);
    }
    if (!q.grid && w < 4) { const size_t sb = (((size_t)q.b * DEPTH + l) * 2 + dir) * RH + head;
#pragma unroll
        for (int ct = 0; ct < 4; ++ct) *(f32x4*)(P.out + OUT_S + (sb * 64 + 16 * w + fr) * 64 + 16 * ct + 4 * fq) = sacc[ct]; }
    LDS_BARRIER();
#undef WY_TOK
#undef CONS_FETCH
}
constexpr int N_ITEMS = NSEQ * RH * 2;
__device__ __forceinline__ void decode_item(int it, int& s, int& head, int& dir) {
    dir = it & 1; int ch = it >> 1; head = ch % RH; const int sq = ch / RH;
    s = sq < LB ? CB + sq : sq - LB;
}
}

namespace ms {
using ml::PQ; using ml::PT; using ml::mma; using ml::frag; using wy::bf16x8; using wy::f32x4; using wy::u32x4;
constexpr int P_QS = 0, P_KT = P_QS + 64 * PQ, P_SB = P_KT + 128 * PT, P_SC = P_SB + 64 * PT, P_VT = P_SC + 4096, VT_BYTES = 21504, ML_PACK = P_VT + VT_BYTES, P_KS = ML_PACK, P_END = P_KS + 64 * PQ;
constexpr int ML_RING = 4, ML_PACK_U = ML_PACK / 16, N_MLAT = LB * MH * 2, CW_MF = 32768, MLPROD = 2;
static_assert(MLPROD == 2 && ML_RING % MLPROD == 0, "two producers per chain: even / odd chunks");
static_assert(ML_PACK % 1024 == 0 && ML_PACK_U <= 9 * 512 && 145 * PT <= VT_BYTES && P_END <= 131072 && 2 * ML_PACK <= 146432, "mLSTM pack layout");
static_assert(WS_END + (size_t)N_MLAT * ML_RING * ML_PACK <= ((size_t)256 << 20), "mLSTM ring fits behind the activations");
__device__ __forceinline__ void ml_prod(LAS unsigned char* lds, CParams& P, int l, int s, int head, int dir, int chain, int pp, unsigned* ctl) {
    const int tid = wy::tid_opaque(), w = __builtin_amdgcn_readfirstlane(tid >> 6), lane = tid & 63, fr = lane & 15, fq = lane >> 4;
    const int rt = w & 3, half = w >> 2;
    const SeqInfo q = seqinfo(s); const int nchunk = q.T / 64;
    const bf16* QK = WSP(bf16, WS_QKC); const bf16* U = WSP(bf16, WS_U1);
    LAS float* SC = (LAS float*)(lds + P_SC);
    unsigned char* ring = P.ws + WS_END + (size_t)chain * ML_RING * ML_PACK;
    unsigned* f_base = ctl + CW_MF + (size_t)((l * N_MLAT + chain) * 4) * wy::FL_STRIDE; unsigned* f_ready = f_base + pp * wy::FL_STRIDE; unsigned* f_ack = f_base + MLPROD * wy::FL_STRIDE; unsigned* tmo = ctl + 4096 + 128;
    float m_prev = 0.f;
    if (q.grid) m_prev = P.in[ST_M][(((size_t)q.b * DEPTH + l) * 2 + dir) * MH + head];
    const float bi = P.in[M_GATE_B][(size_t)l * 4 * MH + (2 * dir) * MH + head], bfg = P.in[M_GATE_B][(size_t)l * 4 * MH + (2 * dir + 1) * MH + head];
    for (int i = tid; i < (VT_BYTES - 128 * PT) / 2; i += 512) *(LAS bf16*)(lds + P_VT + 128 * PT + i * 2) = (i < 64) ? (bf16)0x3f80 : (bf16)0;
    u32x4 pqk[4]; u32x4 pv[2]; bf16 pgi = 0, pgf = 0, sgi = 0, sgf = 0;
#define ML_TOK(c, j) ((size_t)(q.base + (dir ? q.T - 1 - ((c) * 64 + (j)) : ((c) * 64 + (j)))))
#define ML_PREFETCH(c) do { _Pragma("unroll") for (int i = 0; i < 4; ++i) { const int id = tid + 512 * i, j = id >> 5, pc = id & 31; \
            pqk[i] = *(const u32x4*)(QK + ML_TOK(c, j) * (2 * MW) + (pc < 16 ? head * 128 + 8 * pc : MW + head * 128 + 8 * (pc - 16))); } \
        _Pragma("unroll") for (int i = 0; i < 2; ++i) { const int id = tid + 512 * i, j = id >> 4, pc = id & 15; pv[i] = *(const u32x4*)(U + ML_TOK(c, j) * PU + OFF_V + head * 128 + 8 * pc); } \
        if (w == 0) { const bf16* g = U + ML_TOK(c, lane) * PU + OFF_G; pgi = g[(2 * dir) * MH + head]; pgf = g[(2 * dir + 1) * MH + head]; \
            if ((c) >= 1) { const bf16* g2 = U + ML_TOK((c) - 1, lane) * PU + OFF_G; sgi = g2[(2 * dir) * MH + head]; sgf = g2[(2 * dir + 1) * MH + head]; } } } while (0)
#define ML_TOUCH() asm volatile("" :: "v"(pqk[0]), "v"(pqk[1]), "v"(pqk[2]), "v"(pqk[3]), "v"(pv[0]), "v"(pv[1]), "v"((unsigned)pgi), "v"((unsigned)pgf), "v"((unsigned)sgi), "v"((unsigned)sgf) : "memory")
#define ML_SCAN(gi_, gf_) \
            const float gi = bf2f(gi_) + bi, gf = bf2f(gf_) + bfg; \
            const float lf = fminf(gf, 0.f) - log1pf(__expf(-fabsf(gf))); \
            float b = lf; \
            _Pragma("unroll") for (int o = 1; o < 64; o <<= 1) { const float t = __shfl_up(b, o); if (lane >= o) b += t; } \
            const float a = gi - b; float pm = a; \
            _Pragma("unroll") for (int o = 1; o < 64; o <<= 1) { const float t = __shfl_up(pm, o); if (lane >= o) pm = fmaxf(pm, t); } \
            pm = fmaxf(pm, m_prev); \
            const float pm63 = __shfl(pm, 63), b63 = __shfl(b, 63);
    ML_PREFETCH(pp);
    ML_TOUCH();
    unsigned acked = 0u;
    for (int c = pp; c < nchunk; c += MLPROD) {
        if (w == 0 && c >= 1) { ML_SCAN(sgi, sgf) m_prev = b63 + pm63; }
#pragma unroll
        for (int i = 0; i < 4; ++i) { const int id = tid + 512 * i, j = id >> 5, pc = id & 31;
            *(LAS u32x4*)(lds + (pc < 16 ? P_QS : P_KS) + j * PQ + (pc & 15) * 16) = pqk[i]; }
#pragma unroll
        for (int i = 0; i < 2; ++i) { const int id = tid + 512 * i, j = id >> 4, pc = id & 15; const unsigned wv[4] = {pv[i].x, pv[i].y, pv[i].z, pv[i].w};
#pragma unroll
            for (int e = 0; e < 8; ++e) *(LAS bf16*)(lds + P_VT + (8 * pc + e) * PT + j * 2) = (bf16)((wv[e >> 1] >> ((e & 1) * 16)) & 0xffffu); }
        if (w == 0) {
            ML_SCAN(pgi, pgf)
            SC[ml::SC_A + lane] = a; SC[ml::SC_PM + lane] = pm; SC[ml::SC_WI + lane] = __expf(m_prev - pm); SC[ml::SC_EMT + lane] = __expf(-(b + pm)); SC[ml::SC_WE + lane] = __expf(a - pm63);
            if (lane == 0) { SC[ml::SC_MISC] = __expf(m_prev - pm63); SC[ml::SC_MISC + 1] = b63 + pm63; }
            m_prev = b63 + pm63;
        }
        LDS_BARRIER();
        if (c + MLPROD < nchunk) ML_PREFETCH(c + MLPROD);
#pragma unroll
        for (int i = 0; i < 2; ++i) { const int id = tid + 512 * i, j = id & 63, pc = id >> 6; const float we = SC[ml::SC_WE + j];
            const u32x4 kv = *(const LAS u32x4*)(lds + P_KS + j * PQ + pc * 16); const unsigned wv[4] = {kv.x, kv.y, kv.z, kv.w};
#pragma unroll
            for (int e = 0; e < 8; ++e) { const float kf = __builtin_bit_cast(float, (e & 1) ? (wv[e >> 1] & 0xffff0000u) : (wv[e >> 1] << 16));
                *(LAS bf16*)(lds + P_KT + (8 * pc + e) * PT + j * 2) = f2bf(kf * we); } }
#pragma unroll
        for (int cc = 0; cc < 2; ++cc) { const int ct = 2 * half + cc;
            f32x4 acc = (f32x4){0.f, 0.f, 0.f, 0.f};
            if (ct <= rt) {
#pragma unroll
                for (int k = 0; k < 4; ++k) acc = mma(frag(lds, P_QS, PQ, 16 * rt, 32 * k, lane), frag(lds, P_KS, PQ, 16 * ct, 32 * k, lane), acc);
            }
            const int sp = 16 * ct + fr; const float as = SC[ml::SC_A + sp];
#pragma unroll
            for (int r = 0; r < 4; ++r) { const int t = 16 * rt + 4 * fq + r; const float v = (sp <= t) ? acc[r] * __expf(as - SC[ml::SC_PM + t]) : 0.f;
                *(LAS bf16*)(lds + P_SB + t * PT + sp * 2) = f2bf(v); } }
        asm volatile("s_waitcnt vmcnt(0)" ::: "memory");
        if (tid == 0 && c >= ML_RING && acked < (unsigned)(c - ML_RING + 1)) acked = wy::fl_wait_ge(f_ack, (unsigned)(c - ML_RING + 1), tmo);
        LDS_BARRIER();
        if (tid == 0 && c > pp) __hip_atomic_store(f_ready, (unsigned)((c - pp) / MLPROD), __ATOMIC_RELAXED, __HIP_MEMORY_SCOPE_AGENT);
        ML_TOUCH();
        { unsigned char* slot = ring + (size_t)(c % ML_RING) * ML_PACK;
#pragma unroll
          for (int k = 0; k < 9; ++k) { const int u = tid + 512 * k;
              if (u < ML_PACK_U) { const u32x4 v = *(const LAS u32x4*)(lds + 16 * u); const u32x4* gp = (const u32x4*)(slot + (size_t)16 * u);
                  asm volatile("global_store_dwordx4 %0, %1, off sc1" :: "v"(gp), "v"(v) : "memory"); } } }
        LDS_BARRIER();
    }
    asm volatile("s_waitcnt vmcnt(0)" ::: "memory");
    __syncthreads();
    if (tid == 0) __hip_atomic_store(f_ready, (unsigned)((nchunk - pp + MLPROD - 1) / MLPROD), __ATOMIC_RELAXED, __HIP_MEMORY_SCOPE_AGENT);
    LDS_BARRIER();
#undef ML_TOK
#undef ML_PREFETCH
#undef ML_TOUCH
#undef ML_SCAN
}
__device__ __forceinline__ void ml_cons(LAS unsigned char* lds, CParams& P, int l, int s, int head, int dir, int chain, unsigned* ctl) {
    const int tid = wy::tid_opaque(), w = __builtin_amdgcn_readfirstlane(tid >> 6), lane = tid & 63, fr = lane & 15, fq = lane >> 4;
    const SeqInfo q = seqinfo(s); const int nchunk = q.T / 64;
    bf16* U = WSP(bf16, WS_U1);
    const unsigned char* ring = P.ws + WS_END + (size_t)chain * ML_RING * ML_PACK;
    unsigned* f_base = ctl + CW_MF + (size_t)((l * N_MLAT + chain) * 4) * wy::FL_STRIDE; unsigned* f_ack = f_base + MLPROD * wy::FL_STRIDE; unsigned* tmo = ctl + 4096 + 128;
    f32x4 cst[8][3];
#pragma unroll
    for (int kt = 0; kt < 8; ++kt)
#pragma unroll
        for (int j = 0; j < 3; ++j) cst[kt][j] = (f32x4){0.f, 0.f, 0.f, 0.f};
    if (w < 4 && q.grid) { const size_t sb = (((size_t)q.b * DEPTH + l) * 2 + dir) * MH + head;
#pragma unroll
        for (int kt = 0; kt < 8; ++kt)
#pragma unroll
            for (int r = 0; r < 4; ++r) { const int d = 16 * kt + 4 * fq + r;
                cst[kt][0][r] = P.in[ST_C][(sb * 128 + d) * 128 + 32 * w + fr]; cst[kt][1][r] = P.in[ST_C][(sb * 128 + d) * 128 + 32 * w + 16 + fr];
                cst[kt][2][r] = (fr == 0) ? P.in[ST_N][sb * 128 + d] : 0.f; } }
#define ML_TOK(c, j) ((size_t)(q.base + (dir ? q.T - 1 - ((c) * 64 + (j)) : ((c) * 64 + (j)))))
    unsigned seen0 = 0u, seen1 = 0u;
#define MLC_FETCH(c, boff) do { const int p_ = (c) % MLPROD; const unsigned need_ = (unsigned)((c) / MLPROD + 1); \
        if ((p_ ? seen1 : seen0) < need_) { unsigned v_ = 0u; if (lane == 0) v_ = wy::fl_wait_ge(f_base + p_ * wy::FL_STRIDE, need_, tmo); v_ = __builtin_amdgcn_readfirstlane(v_); \
            if (p_) seen1 = v_; else seen0 = v_; __builtin_amdgcn_fence(__ATOMIC_ACQUIRE, "agent"); } \
        const unsigned char* slot = ring + (size_t)((c) % ML_RING) * ML_PACK; \
        for (int k = w - 4; k < ML_PACK / 1024; k += 4) \
            __builtin_amdgcn_global_load_lds((const unsigned*)(slot + (size_t)k * 1024 + lane * 16), (LAS unsigned*)(lds + (boff) + k * 1024), 16, 0, 0); \
        asm volatile("s_waitcnt vmcnt(0)" ::: "memory"); } while (0)
    if (w >= 4) MLC_FETCH(0, 0);
    LDS_BARRIER();
    if (tid == 256) __hip_atomic_store(f_ack, 1u, __ATOMIC_RELAXED, __HIP_MEMORY_SCOPE_AGENT);
    for (int c = 0; c < nchunk; ++c) {
        const int boff = (c & 1) * ML_PACK;
        if (w >= 4) { if (c + 1 < nchunk) MLC_FETCH(c + 1, ML_PACK - boff); }
        else {
            LAS unsigned char* pb = lds + boff; const LAS float* SC = (const LAS float*)(pb + P_SC);
            const float wie = SC[ml::SC_MISC];
            bf16x8 vf[3][2];
#pragma unroll
            for (int j = 0; j < 3; ++j)
#pragma unroll
                for (int k = 0; k < 2; ++k) vf[j][k] = frag(pb, P_VT, PT, j < 2 ? 32 * w + 16 * j : 128, 32 * k, lane);
            asm volatile("s_waitcnt lgkmcnt(0)" ::: "memory");
            LAS unsigned char* hp = pb + P_VT + 32 * w * PT;
#pragma unroll
            for (int rt = 0; rt < 4; ++rt) {
                f32x4 num[3];
#pragma unroll
                for (int j = 0; j < 3; ++j) { f32x4 a1 = (f32x4){0.f, 0.f, 0.f, 0.f}, a2 = (f32x4){0.f, 0.f, 0.f, 0.f};
#pragma unroll
                    for (int k = 0; k < 2; ++k) a1 = mma(frag(pb, P_SB, PT, 16 * rt, 32 * k, lane), vf[j][k], a1);
#pragma unroll
                    for (int kb = 0; kb < 4; ++kb) a2 = mma(wy::ld_k32(pb, P_QS, PQ, 16 * rt, 32 * kb, lane), wy::pack_k32(cst[2 * kb][j], cst[2 * kb + 1][j]), a2);
#pragma unroll
                    for (int r = 0; r < 4; ++r) a1[r] += SC[ml::SC_WI + 16 * rt + 4 * fq + r] * a2[r];
                    num[j] = a1; }
#pragma unroll
                for (int r = 0; r < 4; ++r) { const int t = 16 * rt + 4 * fq + r; const float dn = __shfl(num[2][r], lane & 48);
                    const float rden = __builtin_amdgcn_rcpf(fmaxf(fabsf(dn), SC[ml::SC_EMT + t]));
                    *(LAS bf16*)(hp + t * 64 + fr * 2) = f2bf(num[0][r] * rden); *(LAS bf16*)(hp + t * 64 + (16 + fr) * 2) = f2bf(num[1][r] * rden); }
            }
#pragma unroll
            for (int kt = 0; kt < 8; ++kt) { const bf16x8 k0 = frag(pb, P_KT, PT, 16 * kt, 0, lane), k1 = frag(pb, P_KT, PT, 16 * kt, 32, lane);
#pragma unroll
                for (int j = 0; j < 3; ++j) { cst[kt][j] = cst[kt][j] * wie; cst[kt][j] = mma(k0, vf[j][0], cst[kt][j]); cst[kt][j] = mma(k1, vf[j][1], cst[kt][j]); } }
            { const LAS unsigned char* yp = hp + lane * 64; bf16* up = U + ML_TOK(c, lane) * PU + dir * MW + head * 128 + 32 * w;
#pragma unroll
              for (int i = 0; i < 4; ++i) *(u32x4*)(up + 8 * i) = *(const LAS u32x4*)(yp + 16 * i); }
        }
        LDS_BARRIER();
        if (tid == 256 && c + 1 < nchunk) __hip_atomic_store(f_ack, (unsigned)(c + 2), __ATOMIC_RELAXED, __HIP_MEMORY_SCOPE_AGENT);
    }
    LDS_BARRIER();
#undef ML_TOK
#undef MLC_FETCH
}
}

namespace el {
typedef float f32x4 __attribute__((ext_vector_type(4)));
typedef unsigned u32x4 __attribute__((ext_vector_type(4)));
typedef unsigned u32x2 __attribute__((ext_vector_type(2)));
typedef short bf16x8 __attribute__((ext_vector_type(8)));
__device__ __forceinline__ float wave_sum(float v) {
#pragma unroll
    for (int o = 1; o < 64; o <<= 1) v += __shfl_xor(v, o);
    return v;
}
__device__ __forceinline__ void unpack8(const u32x4 p, float (&f)[8]) {
    f[0] = pg8::bflo(p.x); f[1] = pg8::bfhi(p.x); f[2] = pg8::bflo(p.y); f[3] = pg8::bfhi(p.y); f[4] = pg8::bflo(p.z); f[5] = pg8::bfhi(p.z); f[6] = pg8::bflo(p.w); f[7] = pg8::bfhi(p.w);
}
__device__ __forceinline__ u32x4 pack8(const float (&f)[8]) {
    u32x4 o; o.x = pg8::cvt_pk_bf16(f[0], f[1]); o.y = pg8::cvt_pk_bf16(f[2], f[3]); o.z = pg8::cvt_pk_bf16(f[4], f[5]); o.w = pg8::cvt_pk_bf16(f[6], f[7]); return o;
}
__device__ __forceinline__ void init_phase(LAS unsigned char* lds, CParams& P, int vb, int G) {
    const int tid = threadIdx.x, w = tid >> 6, lane = tid & 63;
    LAS float* red = (LAS float*)lds;
    constexpr int KW = D / 8;
    for (int it = vb; it < DEPTH * (6 * D / 64); it += G) {
        const int l = it / (6 * D / 64), j = (it % (6 * D / 64)) * 64 + lane;
        const float* wp = P.in[ADA_W] + ((size_t)l * D + w * KW) * 6 * D + j;
        float acc[NCOND];
#pragma unroll
        for (int ci = 0; ci < NCOND; ++ci) acc[ci] = 0.f;
        for (int k = 0; k < KW; ++k) { const float wv = wp[(size_t)k * 6 * D];
#pragma unroll
            for (int ci = 0; ci < NCOND; ++ci) { const float cv = ci == 0 ? P.in[C_CTX][w * KW + k] : P.in[C_LAT][(size_t)(ci - 1) * D + w * KW + k]; acc[ci] += cv * pg8::fsigmoid(cv) * wv; } }
#pragma unroll
        for (int ci = 0; ci < NCOND; ++ci) red[(w * NCOND + ci) * 64 + lane] = acc[ci];
        __syncthreads();
        if (w < NCOND) { float sum = P.in[ADA_B][(size_t)l * 6 * D + j];
#pragma unroll
            for (int ww = 0; ww < 8; ++ww) sum += red[(ww * NCOND + w) * 64 + lane];
            WSP(float, WS_MOD)[((size_t)l * NCOND + w) * 6 * D + j] = sum; }
        __syncthreads();
    }
}
__device__ __forceinline__ int perm5(int n) { return (((n >> 2) & 1) << 4) | (((n >> 3) & 3) << 2) | (n & 3); }
__device__ __forceinline__ void transpose_item(const float* W, int ldw, int nvalid, bf16* dst, int K, int k0, int drow0, bool perm, LAS float* scr, int lane) {
#pragma unroll 8
    for (int i = 0; i < 32; ++i) { const int kk = 2 * i + (lane >> 5), n = lane & 31; scr[kk * 33 + n] = n < nvalid ? W[(size_t)kk * ldw + n] : 0.f; }
    asm volatile("s_waitcnt lgkmcnt(0)" ::: "memory");
    const int c = lane & 7;
#pragma unroll
    for (int j = 0; j < 4; ++j) { const int n = (lane >> 3) + 8 * j; const LAS float* sp = scr + (8 * c) * 33 + n;
        u32x4 o; o.x = pg8::cvt_pk_bf16(sp[0 * 33], sp[1 * 33]); o.y = pg8::cvt_pk_bf16(sp[2 * 33], sp[3 * 33]); o.z = pg8::cvt_pk_bf16(sp[4 * 33], sp[5 * 33]); o.w = pg8::cvt_pk_bf16(sp[6 * 33], sp[7 * 33]);
        *(u32x4*)(dst + (size_t)(drow0 + (perm ? perm5(n) : n)) * K + k0 + 8 * c) = o; }
    asm volatile("s_waitcnt lgkmcnt(0)" ::: "memory");
}
constexpr int WI_0 = (N1P / 32) * (D / 64), WI_1 = WI_0 + (2 * D / 32) * (D / 64), WI_2 = WI_1 + (D / 32) * (MW / 64), WI_3 = WI_2 + (D / 32) * (RW / 64),
              WI_4 = WI_3 + (D / 32) * (D / 64), WI_5 = WI_4 + 2 * (FF / 32) * (D / 64), WI_6 = WI_5 + (D / 32) * (FF / 64), WI_7 = WI_6 + (RW / 32) * (128 / 64), WI_8 = WI_7 + 4 * (RW / 32);
__device__ __forceinline__ void wconv_phase(LAS unsigned char* lds, CParams& P, int l, int vb, int G) {
    const int tid = threadIdx.x, w = tid >> 6, lane = tid & 63;
    LAS float* scr = (LAS float*)(lds + w * 8704);
    for (int it = vb * 8 + w; it < WI_8; it += G * 8) {
        if (it < WI_0) { const int nb = it / (D / 64), kb = it % (D / 64); const int n0 = nb * 32; const int nv = n0 >= N1 ? 0 : (N1 - n0 < 32 ? N1 - n0 : 32);
            transpose_item(P.in[W_IN] + ((size_t)l * D + kb * 64) * PIN + n0, PIN, nv, WSP(bf16, O_WIN1), D, kb * 64, n0, true, scr, lane); }
        else if (it < WI_1) { const int r = it - WI_0, nb = r / (D / 64), kb = r % (D / 64);
            transpose_item(P.in[W_IN] + ((size_t)l * D + kb * 64) * PIN + N1 + nb * 32, PIN, 32, WSP(bf16, O_WIN2), D, kb * 64, nb * 32, true, scr, lane); }
        else if (it < WI_2) { const int r = it - WI_1, nb = r / (MW / 64), kb = r % (MW / 64);
            transpose_item(P.in[PROJ_M] + ((size_t)l * MW + kb * 64) * D + nb * 32, D, 32, WSP(bf16, O_PM), MW, kb * 64, nb * 32, true, scr, lane); }
        else if (it < WI_3) { const int r = it - WI_2, nb = r / (RW / 64), kb = r % (RW / 64);
            transpose_item(P.in[PROJ_R] + ((size_t)l * RW + kb * 64) * D + nb * 32, D, 32, WSP(bf16, O_PR), RW, kb * 64, nb * 32, true, scr, lane); }
        else if (it < WI_4) { const int r = it - WI_3, nb = r / (D / 64), kb = r % (D / 64);
            transpose_item(P.in[W_OUT] + ((size_t)l * D + kb * 64) * D + nb * 32, D, 32, WSP(bf16, O_WO), D, kb * 64, nb * 32, false, scr, lane); }
        else if (it < WI_5) { const int r = it - WI_4, which = r / ((FF / 32) * (D / 64)), r2 = r % ((FF / 32) * (D / 64)), nb = r2 / (D / 64), kb = r2 % (D / 64);
            const int j0 = nb * 32, pn = j0 >> 7, drow0 = pn * 256 + which * 128 + (j0 & 127);
            transpose_item((which ? P.in[FFN_W3] : P.in[FFN_W1]) + ((size_t)l * D + kb * 64) * FF + j0, FF, 32, WSP(bf16, O_W13), D, kb * 64, drow0, true, scr, lane); }
        else if (it < WI_6) { const int r = it - WI_5, nb = r / (FF / 64), kb = r % (FF / 64);
            transpose_item(P.in[FFN_W2] + ((size_t)l * FF + kb * 64) * D + nb * 32, D, 32, WSP(bf16, O_W2), FF, kb * 64, nb * 32, false, scr, lane); }
        else if (it < WI_7) { const int r = it - WI_6, nb = r / 2, kb = r % 2;
            transpose_item(P.in[R_G2] + ((size_t)l * 128 + kb * 64) * RW + nb * 32, RW, 32, WSP(bf16, O_G2T), 128, kb * 64, nb * 32, false, scr, lane); }
        else { const int r = it - WI_7, which = r / (2 * (RW / 32)), d = (r / (RW / 32)) & 1, nb = r % (RW / 32);
            transpose_item((which ? P.in[R_A2] : P.in[R_W2]) + ((size_t)l * 2 + d) * 64 * RW + nb * 32, RW, 32, WSP(bf16, which ? O_A2T : O_W2T) + (size_t)d * RW * 64, 64, 0, nb * 32, false, scr, lane); }
    }
}
__device__ __forceinline__ void norm_phase(CParams& P, int l, int mode, int vb, int G) {
    const int tid = threadIdx.x, w = tid >> 6, lane = tid & 63;
    for (int m = vb * 8 + w; m < NT; m += G * 8) {
        float* xr = P.out + (size_t)m * D;
        const float* xs = (l == 0 && mode < 2) ? (m < NC ? P.in[X_PROMPT] + (size_t)m * D : P.in[X_SAMPLE] + (size_t)(m - NC) * D) : xr;
        f32x4 v[D / 256]; float ss = 0.f;
#pragma unroll
        for (int j = 0; j < D / 256; ++j) { v[j] = *(const f32x4*)(xs + 256 * j + 4 * lane); ss += (v[j][0] * v[j][0] + v[j][1] * v[j][1]) + (v[j][2] * v[j][2] + v[j][3] * v[j][3]); }
        const float rs = 1.0f / sqrtf(wave_sum(ss) * (1.0f / D) + RMS_EPS);
        if (mode == 3) {
#pragma unroll
            for (int j = 0; j < D / 256; ++j) { const f32x4 g = *(const f32x4*)(P.in[FINAL_G] + 256 * j + 4 * lane); *(f32x4*)(xr + 256 * j + 4 * lane) = v[j] * rs * g; }
        } else {
            const int second = (mode == 2); const int cond = seqinfo(seq_of_token(m)).cond;
            const float* gp = P.in[second ? NORM2 : NORM1] + (size_t)l * D; const float* mod = WSP(float, WS_MOD) + ((size_t)l * NCOND + cond) * 6 * D + (second ? 3 * D : 0);
            bf16* o = WSP(bf16, mode == 1 ? WS_RXC : WS_QKC) + (size_t)m * D;
#pragma unroll
            for (int j = 0; j < D / 256; ++j) { const int c = 256 * j + 4 * lane; const f32x4 g = *(const f32x4*)(gp + c), sh = *(const f32x4*)(mod + c), sc = *(const f32x4*)(mod + D + c);
                const f32x4 y = v[j] * rs * g * (sc + 1.0f) + sh; u32x2 pk; pk.x = pg8::cvt_pk_bf16(y[0], y[1]); pk.y = pg8::cvt_pk_bf16(y[2], y[3]); *(u32x2*)(o + c) = pk; }
        }
    }
}
constexpr int CV_NCH = 2 * MW + RIN, CV_NG = CV_NCH / 4, CV_NCHUNK = (CV_NG + 63) / 64, CV_SEG = 16, CV_PAIRS = NC / (2 * CV_SEG);
static_assert(CV_NCHUNK == 12 && NC == NT - NC && GW % CV_SEG == 0 && CT % CV_SEG == 0 && 2 * MW == 1024 && RX_WL == 1536, "conv item layout");
typedef float f32x2 __attribute__((ext_vector_type(2)));
struct CvAct { float alpha, cA, cB, cC, cD; bool any; };
template <int NR> struct CvState { f32x2 wt[NR * 3][2]; f32x2 fw[NR][3][2]; u32x2 p[3][NR]; };
__device__ __forceinline__ void cv_unpk(const u32x2 p, f32x2 (&f)[2]) { f[0].x = pg8::bflo(p.x); f[0].y = pg8::bfhi(p.x); f[1].x = pg8::bflo(p.y); f[1].y = pg8::bfhi(p.y); }
template <int NR> __device__ __forceinline__ u32x2 cv_ld(const bf16* const (&rowp)[NR], const bool (&rok)[NR], int a, int col, int W) {
    const u32x2 zero2 = {0u, 0u};
    return (rok[a] && col >= 0 && col < W) ? *(const u32x2*)(rowp[a] + (size_t)col * PU) : zero2;
}
template <int NR, int S> __device__ __forceinline__ void cv_col(CvState<NR>& st, const bf16* const (&rowp)[NR], const bool (&rok)[NR], int cs, int W, int o, const CvAct& act, bf16* dst) {
#pragma unroll
    for (int a = 0; a < NR; ++a) { cv_unpk(st.p[S][a], st.fw[a][(S + 2) % 3]); const u32x2 zero2 = {0u, 0u}; st.p[S][a] = (o + 4 <= CV_SEG) ? cv_ld<NR>(rowp, rok, a, cs + o + 4, W) : zero2; }
    f32x2 acc[2];
#pragma unroll
    for (int e = 0; e < 2; ++e) acc[e] = st.wt[0][e] * st.fw[0][S][e];
#pragma unroll
    for (int a = 0; a < NR; ++a)
#pragma unroll
        for (int b = 0; b < 3; ++b) if (a + b > 0) {
#pragma unroll
            for (int e = 0; e < 2; ++e) acc[e] = __builtin_elementwise_fma(st.wt[a * 3 + b][e], st.fw[a][(S + b) % 3][e], acc[e]); }
    float v[4] = {acc[0].x, acc[0].y, acc[1].x, acc[1].y};
    if (act.any) {
#pragma unroll
        for (int e = 0; e < 4; ++e) { const float t = __builtin_amdgcn_rcpf(__builtin_amdgcn_exp2f(act.alpha * v[e]) + 1.0f); v[e] = (act.cA * v[e] + act.cB) * t + (act.cC * v[e] + act.cD); }
    }
    u32x2 pk; pk.x = pg8::cvt_pk_bf16(v[0], v[1]); pk.y = pg8::cvt_pk_bf16(v[2], v[3]);
    *(u32x2*)dst = pk;
}
template <int NR> __device__ __forceinline__ void conv_item(const bf16* const (&rowp)[NR], const bool (&rok)[NR], int cs, int W, const float* wsrc, int CH, const CvAct& act, bf16* dst, int dpitch) {
    CvState<NR> st;
#pragma unroll
    for (int a = 0; a < NR * 3; ++a) { const int tap = NR == 3 ? a : 3 + a; const f32x4 w0 = *(const f32x4*)(wsrc + (size_t)tap * CH);
        st.wt[a][0].x = w0[0]; st.wt[a][0].y = w0[1]; st.wt[a][1].x = w0[2]; st.wt[a][1].y = w0[3]; }
#pragma unroll
    for (int a = 0; a < NR; ++a) { cv_unpk(cv_ld<NR>(rowp, rok, a, cs - 1, W), st.fw[a][0]); cv_unpk(cv_ld<NR>(rowp, rok, a, cs, W), st.fw[a][1]); }
#pragma unroll
    for (int s3 = 0; s3 < 3; ++s3)
#pragma unroll
        for (int a = 0; a < NR; ++a) st.p[s3][a] = cv_ld<NR>(rowp, rok, a, cs + 1 + s3, W);
#pragma unroll 1
    for (int o = 0; o < CV_SEG - 1; o += 3) {
        cv_col<NR, 0>(st, rowp, rok, cs, W, o, act, dst + (size_t)o * dpitch);
        cv_col<NR, 1>(st, rowp, rok, cs, W, o + 1, act, dst + (size_t)(o + 1) * dpitch);
        cv_col<NR, 2>(st, rowp, rok, cs, W, o + 2, act, dst + (size_t)(o + 2) * dpitch);
    }
    cv_col<NR, 0>(st, rowp, rok, cs, W, CV_SEG - 1, act, dst + (size_t)(CV_SEG - 1) * dpitch);
}
__device__ __forceinline__ void conv_phase(LAS unsigned char* lds, CParams& P, int l, int vb, int G) {
    const int tid = threadIdx.x, lane = tid & 63;
    const bf16* U = WSP(bf16, WS_U1);
    LAS unsigned* cnt = (LAS unsigned*)lds;
    for (int sp = vb; sp < CV_PAIRS; sp += G) {
        __syncthreads();
        if (tid == 0) *cnt = 0u;
        __syncthreads();
        for (;;) {
            unsigned j = 0; if (lane == 0) j = __hip_atomic_fetch_add(cnt, 1u, __ATOMIC_RELAXED, __HIP_MEMORY_SCOPE_WORKGROUP);
            j = __builtin_amdgcn_readfirstlane(j);
            if (j >= 48u) break;
            const int cls = j / 12, jj = j % 12, lat = (cls & 1) == 0, heavy = cls < 2, ci = jj >> 1, chunk = heavy ? (ci >= 4 ? 6 + ci : ci) : 4 + ci;
            const int seg = (lat ? NC / CV_SEG : 0) + 2 * sp + (jj & 1), g = chunk * 64 + lane;
            if (g >= CV_NG) continue;
            const int ch = 4 * g; const bool isqk = ch < 2 * MW; const int c = isqk ? ch : ch - 2 * MW;
            const int ucol = isqk ? OFF_QK + c : OFF_R + c, CH = isqk ? 2 * MW : RIN;
            const float* wsrc = (isqk ? P.in[M_CONV] : P.in[R_CONV]) + (size_t)l * 9 * CH + c;
            const int kind = isqk ? (c < MW ? 0 : 1) : (c >= RX_GL ? 4 : (c >= RX_AL ? 2 : (c >= RX_WL ? 3 : 2)));
            CvAct act; act.alpha = kind == 3 ? 2.8853900817779268f : -1.4426950408889634f;
            act.cA = kind == 0 ? 0.08838834764831845f : (kind == 1 ? 1.0f : 0.0f); act.cB = kind == 3 ? -2.0f : (kind == 4 ? 1.0f : 0.0f); act.cC = kind == 2 ? 1.0f : 0.0f; act.cD = kind == 3 ? 1.0f : 0.0f;
            act.any = heavy;
            const int m0 = seg * CV_SEG; const SeqInfo q = seqinfo(seq_of_token(m0)); const int t0 = m0 - q.base;
            bf16* dst = isqk ? WSP(bf16, WS_QKC) + (size_t)m0 * (2 * MW) + c : WSP(bf16, WS_RXC) + (size_t)m0 * RIN + c; const int dpitch = isqk ? 2 * MW : RIN;
            if (q.grid) {
                const int r = t0 / GW, cs = t0 % GW, rows = q.T / GW;
                const bf16* rowp[3]; bool rok[3];
#pragma unroll
                for (int a = 0; a < 3; ++a) { const int rr = r + a - 1; rok[a] = rr >= 0 && rr < rows; rowp[a] = U + (size_t)(q.base + (rok[a] ? rr : r) * GW) * PU + ucol; }
                conv_item<3>(rowp, rok, cs, GW, wsrc, CH, act, dst, dpitch);
            } else {
                const bf16* rowp[1] = {U + (size_t)q.base * PU + ucol}; const bool rok[1] = {true};
                conv_item<1>(rowp, rok, t0, q.T, wsrc, CH, act, dst, dpitch);
            }
        }
    }
}
constexpr int PO_ITEMS = (NT / 16) * 2, PO_HC = RW / 2;
__device__ __forceinline__ void post_phase(LAS unsigned char* lds, CParams& P, int l, int vb, int G) {
    const int tid = threadIdx.x, w = tid >> 6, lane = tid & 63, fr = lane & 15, fq = lane >> 4, l32 = lane & 31, th = lane >> 5;
    constexpr int GP = PO_HC * 2 + 16;
    LAS unsigned char* gt = lds + w * (16 * GP);
    const bf16* U = WSP(bf16, WS_U1); const bf16* RX = WSP(bf16, WS_RXC); const bf16* G2T = WSP(bf16, O_G2T); bf16* O = WSP(bf16, WS_QKC);
    for (int it = vb * 8 + w; it < PO_ITEMS; it += G * 8) {
        const int tile = it >> 1, h = it & 1; const size_t tok0 = (size_t)tile * 16;
        bf16x8 af[4];
#pragma unroll
        for (int ks = 0; ks < 4; ++ks) af[ks] = *(const bf16x8*)(RX + (tok0 + fr) * RIN + RX_GL + 32 * ks + 8 * fq);
        for (int ct = 0; ct < PO_HC / 16; ++ct) { f32x4 acc = (f32x4){0.f, 0.f, 0.f, 0.f};
#pragma unroll
            for (int ks = 0; ks < 4; ++ks) acc = ml::mma(af[ks], *(const bf16x8*)(G2T + (size_t)(h * PO_HC + 16 * ct + fr) * 128 + 32 * ks + 8 * fq), acc);
#pragma unroll
            for (int r = 0; r < 4; ++r) *(LAS bf16*)(gt + (4 * fq + r) * GP + (16 * ct + fr) * 2) = f2bf(acc[r]); }
        asm volatile("s_waitcnt lgkmcnt(0)" ::: "memory");
        const int cb = h * PO_HC + 8 * l32;
        float gn[8], gw[8], gb[8], rk[8];
        { const f32x4 a0 = *(const f32x4*)(P.in[M_NORM_G] + (size_t)l * MW + cb), a1 = *(const f32x4*)(P.in[M_NORM_G] + (size_t)l * MW + cb + 4);
          const f32x4 b0 = *(const f32x4*)(P.in[R_GN_W] + (size_t)l * RW + cb), b1 = *(const f32x4*)(P.in[R_GN_W] + (size_t)l * RW + cb + 4);
          const f32x4 c0 = *(const f32x4*)(P.in[R_GN_B] + (size_t)l * RW + cb), c1 = *(const f32x4*)(P.in[R_GN_B] + (size_t)l * RW + cb + 4);
          const f32x4 d0 = *(const f32x4*)(P.in[R_RK] + (size_t)l * RW + cb), d1 = *(const f32x4*)(P.in[R_RK] + (size_t)l * RW + cb + 4);
#pragma unroll
          for (int e = 0; e < 4; ++e) { gn[e] = a0[e]; gn[4 + e] = a1[e]; gw[e] = b0[e]; gw[4 + e] = b1[e]; gb[e] = c0[e]; gb[4 + e] = c1[e]; rk[e] = d0[e]; rk[4 + e] = d1[e]; } }
        for (int tp = 0; tp < 8; ++tp) { const int tl = 2 * tp + th; const size_t m = tok0 + tl; const bf16* u = U + m * PU; const bf16* rx = RX + m * RIN;
            float hf[8], hb[8], ov[8], x[8]; unpack8(*(const u32x4*)(u + cb), hf); unpack8(*(const u32x4*)(u + MW + cb), hb); unpack8(*(const u32x4*)(u + OFF_O + cb), ov);
            float ss = 0.f;
#pragma unroll
            for (int e = 0; e < 8; ++e) { x[e] = hf[e] + hb[e]; ss += x[e] * x[e]; }
            ss = rw::allsum16(ss); const float rs = 1.0f / sqrtf(ss * (1.0f / 128.f) + RMS_EPS);
#pragma unroll
            for (int e = 0; e < 8; ++e) x[e] = x[e] * rs * gn[e] * pg8::fsigmoid(ov[e]);
            *(u32x4*)(O + m * D + cb) = pack8(x);
            float yf[8], yb[8], rr[8], kk[8], vv[8], gg[8], y[8]; unpack8(*(const u32x4*)(u + OFF_R + cb), yf); unpack8(*(const u32x4*)(u + OFF_R + RW + cb), yb);
            unpack8(*(const u32x4*)(rx + RX_R + cb), rr); unpack8(*(const u32x4*)(rx + RX_K + cb), kk); unpack8(*(const u32x4*)(rx + RX_V + cb), vv);
            unpack8(*(const LAS u32x4*)(gt + tl * GP + l32 * 16), gg);
            float mu = 0.f, bs = 0.f;
#pragma unroll
            for (int e = 0; e < 8; ++e) { y[e] = yf[e] + yb[e]; mu += y[e]; bs += rr[e] * kk[e] * rk[e]; }
            mu += rw::dpp_xor1(mu); mu += rw::dpp_xor2(mu); mu += __shfl_xor(mu, 4); mu *= (1.0f / 64.f);
            bs += rw::dpp_xor1(bs); bs += rw::dpp_xor2(bs); bs += __shfl_xor(bs, 4);
            float var = 0.f;
#pragma unroll
            for (int e = 0; e < 8; ++e) { y[e] -= mu; var += y[e] * y[e]; }
            var += rw::dpp_xor1(var); var += rw::dpp_xor2(var); var += __shfl_xor(var, 4); var *= (1.0f / 64.f);
            const float rsd = 1.0f / sqrtf(var + GN_EPS);
#pragma unroll
            for (int e = 0; e < 8; ++e) y[e] = (y[e] * rsd * gw[e] + gb[e] + bs * vv[e]) * gg[e];
            *(u32x4*)(O + m * D + MW + cb) = pack8(y);
        }
        asm volatile("s_waitcnt lgkmcnt(0)" ::: "memory");
    }
}
}

constexpr int LDS_BYTES = 147456;
constexpr int LDS_MISC = 147456 - 1024;
constexpr size_t CTL_ZERO_BYTES = 262144;
constexpr int CW_BAR = 4096, CW_Q = 8192;

#define XB_TMO      128
#define XB_XCNT(j)  (256  + 64 * (j))
#define XB_XSUB(j)  (1280 + 64 * (j))
#define XB_XGEN(j)  (2304 + 64 * (j))
#define XB_TOP      3328
#define XB_TOPGEN   3392
#define XCD_BAR_WORDS 3456
#define XB_SPIN_CAP (1u << 18)
__device__ __forceinline__ unsigned xb_ld(unsigned* p)              { return __hip_atomic_load(p, __ATOMIC_RELAXED, __HIP_MEMORY_SCOPE_AGENT); }
__device__ __forceinline__ unsigned xb_add(unsigned* p, unsigned v) { return __hip_atomic_fetch_add(p, v, __ATOMIC_RELAXED, __HIP_MEMORY_SCOPE_AGENT); }
__device__ __forceinline__ unsigned xb_xcc_id() { return (unsigned)__builtin_amdgcn_s_getreg((3 << 11) | 20) & 0xFu; }
#define XB_SPIN(cond, bar) do { unsigned _sp = 0; while (cond) { __builtin_amdgcn_s_sleep(1); \
    if ((++_sp & 255u) == 0u) { if (xb_ld(&(bar)[XB_TMO])) break; if (_sp > XB_SPIN_CAP) { atomicAdd(&(bar)[XB_TMO], 1u); break; } } } } while (0)
struct XcdBarrier { unsigned* bar; unsigned x; volatile LAS unsigned* st; };
__device__ __forceinline__ XcdBarrier xcd_barrier_post(unsigned* bar, volatile LAS unsigned* st) {
    XcdBarrier b; b.bar = bar; b.x = xb_xcc_id(); b.st = st;
    if (threadIdx.x == 0) (void)xb_add(&bar[XB_XCNT(b.x)], 1u);
    return b;
}
__device__ __forceinline__ void xcd_barrier_complete(unsigned* bar, unsigned x, unsigned& nloc, unsigned& nx) {
    const unsigned G = gridDim.x * gridDim.y * gridDim.z;
    unsigned sum, cnt, mine, sp = 0u;
    for (;;) {
        sum = 0u; cnt = 0u; mine = 0u;
#pragma unroll
        for (unsigned j = 0; j < 16; ++j) { const unsigned c = xb_ld(&bar[XB_XCNT(j)]); sum += c; cnt += (c > 0u) ? 1u : 0u; mine = (j == x) ? c : mine; }
        if (sum == G) break;
        __builtin_amdgcn_s_sleep(1);
        if ((++sp & 255u) == 0u) { if (xb_ld(&bar[XB_TMO])) break; if (sp > XB_SPIN_CAP) { atomicAdd(&bar[XB_TMO], 1u); break; } }
    }
    nloc = mine > 0u ? mine : 1u; nx = cnt > 0u ? cnt : 1u;
}
__device__ __forceinline__ void xcd_barrier(const XcdBarrier& b) {
    asm volatile("s_waitcnt vmcnt(0)" ::: "memory");
    __syncthreads();
    if (threadIdx.x == 0) {
        unsigned* bar = b.bar;
        __builtin_amdgcn_s_waitcnt(0);
        unsigned nloc = b.st[0], nx = b.st[1];
        if (nloc == 0u) { xcd_barrier_complete(bar, b.x, nloc, nx); b.st[0] = nloc; b.st[1] = nx; }
        const unsigned old = xb_add(&bar[XB_XSUB(b.x)], 1u);
        const unsigned gen = old / nloc;
        if (old + 1u == (gen + 1u) * nloc) {
            __builtin_amdgcn_fence(__ATOMIC_RELEASE, "agent");
            asm volatile("s_waitcnt vmcnt(0)" ::: "memory");
            const unsigned og = xb_add(&bar[XB_TOP], 1u);
            const unsigned tg = og / nx;
            if (og + 1u == (tg + 1u) * nx) xb_add(&bar[XB_TOPGEN], 1u);
            else XB_SPIN(xb_ld(&bar[XB_TOPGEN]) == tg, bar);
            __builtin_amdgcn_fence(__ATOMIC_ACQUIRE, "agent");
            xb_add(&bar[XB_XGEN(b.x)], 1u);
            asm volatile("s_waitcnt vmcnt(0)" ::: "memory");
        } else {
            XB_SPIN(xb_ld(&bar[XB_XGEN(b.x)]) == gen, bar);
            __builtin_amdgcn_fence(__ATOMIC_ACQUIRE, "agent");
            asm volatile("s_waitcnt vmcnt(0)" ::: "memory");
        }
    }
    __syncthreads();
}

constexpr int MX_RL = LB * RH * 2 * 4, MX_ML = LB * MH * 2 * ml::NVB, MX_RC = CB * RH * 2 * 4, MX_MC = CB * MH * 2 * ml::NVB;
constexpr int MX_ITEMS = MX_RL + MX_ML + MX_RC + MX_MC;

constexpr int ML_SPLIT = 0;
__device__ __forceinline__ void scan_phase(LAS unsigned char* lds, CParams& P, int l, unsigned* ctl) {
    unsigned* qhead = ctl + CW_Q + 64 * l;
    volatile LAS unsigned* bc = (volatile LAS unsigned*)(lds + LDS_MISC) + 16;
    for (;;) {
        if (threadIdx.x == 0) bc[0] = xb_add(qhead, 1u);
        __syncthreads();
        const int it = (int)bc[0];
        __syncthreads();
        if (it >= wy::N_LAT) break;
        int s_, head, dir; wy::decode_item(it, s_, head, dir);
        wy::rwkv_cons(lds, P, l, s_, head, dir, it, ctl);
    }
    for (;;) {
        if (threadIdx.x == 0) bc[0] = xb_add(qhead + 8, 1u);
        __syncthreads();
        const int it = (int)bc[0];
        __syncthreads();
        if (it >= ML_SPLIT * ms::N_MLAT) break;
        int s_, head, dir, sub; ml::decode_item(it * ml::NVB, s_, head, dir, sub);
        ms::ml_cons(lds, P, l, s_, head, dir, it, ctl);
    }
    for (;;) {
        if (threadIdx.x == 0) bc[0] = xb_add(qhead + 48, 1u);
        __syncthreads();
        const int it = (int)bc[0];
        __syncthreads();
        if (it >= wy::N_LAT * wy::NPROD) break;
        const int chain = it % wy::N_LAT;
        int s_, head, dir; wy::decode_item(chain, s_, head, dir);
        wy::rwkv_prod(lds, P, l, s_, head, dir, chain, it / wy::N_LAT, ctl);
    }
    for (;;) {
        if (threadIdx.x == 0) bc[0] = xb_add(qhead + 24, 1u);
        __syncthreads();
        const int it = (int)bc[0];
        __syncthreads();
        if (it >= ML_SPLIT * ms::N_MLAT * ms::MLPROD) break;
        const int chain = it % ms::N_MLAT;
        int s_, head, dir, sub; ml::decode_item(chain * ml::NVB, s_, head, dir, sub);
        ms::ml_prod(lds, P, l, s_, head, dir, chain, it / ms::N_MLAT, ctl);
    }
    for (;;) {
        if (threadIdx.x == 0) bc[0] = xb_add(qhead + 16, 1u);
        __syncthreads();
        const int it = (int)bc[0] + ML_SPLIT * ms::N_MLAT * ml::NVB;
        __syncthreads();
        if (it >= ml::N_ITEMS) break;
        int s_, head, dir, sub; ml::decode_item(it, s_, head, dir, sub);
        ml::mlstm_item2(lds, P, l, s_, head, dir, sub);
    }
    for (;;) {
        if (threadIdx.x == 0) bc[0] = xb_add(qhead + 32, 1u);
        __syncthreads();
        const int it = (int)bc[0] + LB * RH * 2;
        __syncthreads();
        if (it >= wy::N_ITEMS) break;
        int s_, head, dir; wy::decode_item(it, s_, head, dir);
        wy::rwkv_item(lds, P, l, s_, head, dir);
    }
}

enum { ST_N0 = 0, ST_A1, ST_CV, ST_MX, ST_PO, ST_N1, ST_A2, ST_PJ, ST_WO, ST_N2, ST_F1, ST_F2, ST_PER_LAYER };
constexpr int N_STEPS = 1 + DEPTH * ST_PER_LAYER + 1;
struct MkArgs { Params P; int ph_lo, ph_hi; };
__global__ void __launch_bounds__(512, 2) mk(MkArgs a) {
    extern __shared__ __attribute__((aligned(16))) unsigned char lds_raw[];
    LAS unsigned char* lds = (LAS unsigned char*)lds_raw;
    const int G = gridDim.x, vb = (int)blockIdx.x;
    unsigned* ctl = (unsigned*)(a.P.ws + WS_CTL);
    volatile LAS unsigned* MISC = (volatile LAS unsigned*)(lds + LDS_MISC);
    for (int u = threadIdx.x; u < 64; u += 512) MISC[u] = 0u;
    __syncthreads();
    const bool multi = a.ph_hi - a.ph_lo > 1;
    XcdBarrier bar; bar.bar = ctl + CW_BAR; bar.x = 0; bar.st = nullptr;
    if (multi) bar = xcd_barrier_post(ctl + CW_BAR, MISC + 8);
    const int lo = a.ph_lo, hi = a.ph_hi;
#define STEP_BEGIN(id) if (lo <= (id) && (id) < hi) { unsigned long long kp_ = (unsigned long long)__builtin_amdgcn_kernarg_segment_ptr(); asm volatile("" : "+s"(kp_)); CParams& P = *(CParams*)kp_;
#define STEP_END(id) if ((id) + 1 < hi) xcd_barrier(bar); }
    STEP_BEGIN(0) el::init_phase(lds, P, vb, G); el::wconv_phase(lds, P, 0, vb, G); STEP_END(0)
#define LAYER(l) { \
        const int base = 1 + (l) * ST_PER_LAYER; \
        STEP_BEGIN(base + ST_N0) if ((l) > 0) el::wconv_phase(lds, P, (l), vb, G); el::norm_phase(P, (l), 0, vb, G); STEP_END(base + ST_N0) \
        STEP_BEGIN(base + ST_A1) { pg8::Gemm g{WSP(bf16, WS_QKC), WSP(bf16, O_WIN1), D, D}; pg8::StaticOrder S; S.init(NT, N1P, G, vb); \
            pg8::EpiA1 E{WSP(bf16, WS_U1)}; pg8::gemm_phase(lds, g, S, E); } STEP_END(base + ST_A1) \
        STEP_BEGIN(base + ST_CV) el::conv_phase(lds, P, (l), vb, G); STEP_END(base + ST_CV) \
        STEP_BEGIN(base + ST_MX) scan_phase(lds, P, (l), ctl); STEP_END(base + ST_MX) \
        STEP_BEGIN(base + ST_PO) el::post_phase(lds, P, (l), vb, G); STEP_END(base + ST_PO) \
        STEP_BEGIN(base + ST_N1) el::norm_phase(P, (l), 1, vb, G); STEP_END(base + ST_N1) \
        STEP_BEGIN(base + ST_A2) { pg8::Gemm g{WSP(bf16, WS_RXC), WSP(bf16, O_WIN2), D, D}; pg8::StaticOrder S; S.init(NT, 2 * D, G, vb); \
            pg8::EpiA2 E{WSP(bf16, WS_U1)}; pg8::gemm_phase(lds, g, S, E); } STEP_END(base + ST_A2) \
        STEP_BEGIN(base + ST_PJ) { pg8::Gemm g{WSP(bf16, WS_QKC), WSP(bf16, O_PM), MW, D}; pg8::PairOrder S; S.init(NT, G, vb); \
            pg8::EpiPJ E{WSP(bf16, WS_U1)}; pg8::gemm_phase(lds, g, S, E); } STEP_END(base + ST_PJ) \
        STEP_BEGIN(base + ST_WO) { pg8::Gemm g{WSP(bf16, WS_U1), WSP(bf16, O_WO), D, PU}; pg8::StaticOrder S; S.init(NT, D, G, vb); \
            pg8::EpiRes E{P.out, WSP(float, WS_MOD) + (size_t)(l) * NCOND * 6 * D + 2 * D, (l) == 0 ? P.in[X_PROMPT] : nullptr, (l) == 0 ? P.in[X_SAMPLE] : nullptr}; pg8::gemm_phase(lds, g, S, E); } STEP_END(base + ST_WO) \
        STEP_BEGIN(base + ST_N2) el::norm_phase(P, (l), 2, vb, G); STEP_END(base + ST_N2) \
        STEP_BEGIN(base + ST_F1) { pg8::Gemm g{WSP(bf16, WS_QKC), WSP(bf16, O_W13), D, D}; pg8::StaticOrder S; S.init(NT, 2 * FF, G, vb); \
            pg8::EpiF1 E{WSP(bf16, WS_U1)}; pg8::gemm_phase(lds, g, S, E); } STEP_END(base + ST_F1) \
        STEP_BEGIN(base + ST_F2) { pg8::Gemm g{WSP(bf16, WS_U1), WSP(bf16, O_W2), FF, FF}; pg8::StaticOrder S; S.init(NT, D, G, vb); \
            pg8::EpiRes E{P.out, WSP(float, WS_MOD) + (size_t)(l) * NCOND * 6 * D + 5 * D, nullptr, nullptr}; pg8::gemm_phase(lds, g, S, E); } STEP_END(base + ST_F2) \
    }
    static_assert(DEPTH == 2, "layers are unrolled by hand");
    LAYER(0)
    LAYER(1)
#undef LAYER
    STEP_BEGIN(N_STEPS - 1) el::norm_phase(P, 0, 3, vb, G); STEP_END(N_STEPS - 1)
#undef STEP_BEGIN
#undef STEP_END
}
#endif

typedef void (*BodyFn)(const Params&, long);
#ifndef HOST_EMU
template <BodyFn F, int BLOCK> __global__ void __launch_bounds__(BLOCK) run_k(Params P, long n) {
    const long i = (long)blockIdx.x * BLOCK + threadIdx.x;
    if (i < n) F(P, i);
}
#define RUN(F, BLOCK, n) do { const long n_ = (n); run_k<F, BLOCK><<<dim3((unsigned)((n_ + BLOCK - 1) / BLOCK)), dim3(BLOCK), 0, stream>>>(P, n_); } while (0)
static int g_grid = 0;
#else
#define RUN(F, BLOCK, n) do { const long n_ = (n); for (long i_ = 0; i_ < n_; ++i_) F(P, i_); } while (0)
typedef void* hipStream_t;
#endif

static void forward(Params P, hipStream_t stream) {
    (void)stream;
#ifndef HOST_EMU
    if (hipMemsetAsync(P.ws + WS_CTL, 0, CTL_ZERO_BYTES, stream) != hipSuccess) return;
#ifdef MK_PER_STEP
    for (int st = 0; st < N_STEPS; ++st) { MkArgs a_{}; a_.P = P; a_.ph_lo = st; a_.ph_hi = st + 1; mk<<<dim3(g_grid), dim3(512), LDS_BYTES, stream>>>(a_); }
#else
    { MkArgs a_{}; a_.P = P; a_.ph_lo = 0; a_.ph_hi = N_STEPS; mk<<<dim3(g_grid), dim3(512), LDS_BYTES, stream>>>(a_); }
#endif
#else
    RUN(k_init_x, 256, (long)NT * D);
    RUN(k_mod, 256, (long)DEPTH * NCOND * 6 * D);
    for (int l = 0; l < DEPTH; ++l) {
        P.layer = l;
        RUN(k_wconv, 256, WC_N6);
        P.mode = 0; RUN(k_norm, 64, (long)NT);
        RUN(k_gemm_a1, 256, (long)NT * N1);
        RUN(k_conv, 256, (long)NT * (2 * MW + RIN));
        RUN(k_mlstm, 128, (long)NSEQ * MH * 2 * 128);
        for (int dir = 0; dir < 2; ++dir) { P.mode = dir; RUN(k_rwkv_prep, 256, (long)NT * RW); RUN(k_rwkv, 64, (long)NSEQ * RH * 64); }
        RUN(k_post, 256, (long)NT * D);
        P.mode = 1; RUN(k_norm, 64, (long)NT);
        RUN(k_gemm_a2, 256, (long)NT * 2 * D);
        RUN(k_gemm_pj, 256, (long)NT * D);
        RUN(k_gemm_wo, 256, (long)NT * D);
        P.mode = 2; RUN(k_norm, 64, (long)NT);
        RUN(k_gemm_f1, 256, (long)NT * FF);
        RUN(k_gemm_f2, 256, (long)NT * D);
    }
    RUN(k_final, 64, (long)NT);
#endif
}

#ifndef HOST_EMU
extern "C" void kernel_launch(void* const* d_in, const int* in_sizes, int n_in, void* d_out, int out_size, void* d_ws, size_t ws_size, hipStream_t stream) {
    if (n_in != N_IN || (size_t)out_size != OUT_END || ws_size < WS_END) return;
    if (g_grid == 0) {
        int dev = 0, cus = 0;
        if (hipGetDevice(&dev) != hipSuccess || hipDeviceGetAttribute(&cus, hipDeviceAttributeMultiprocessorCount, dev) != hipSuccess) { g_grid = -1; return; }
        if (hipFuncSetAttribute((const void*)mk, hipFuncAttributeMaxDynamicSharedMemorySize, LDS_BYTES) != hipSuccess) { g_grid = -1; return; }
        g_grid = cus;
    }
    if (g_grid < 0) return;
    Params P{};
    for (int i = 0; i < N_IN; ++i) P.in[i] = (const float*)d_in[i];
    P.out = (float*)d_out; P.ws = (unsigned char*)d_ws; P.layer = 0; P.mode = 0;
    forward(P, stream);
}
#endif
```

```cpp
#ifndef HOST_EMU
#include <hip/hip_runtime.h>
#define HD __host__ __device__ __forceinline__
#define DEV __device__ __forceinline__
#else
#include <cmath>
#include <cstring>
#include <cstdio>
#include <cstdlib>
#define HD inline
#define DEV inline
#endif
#include <cstddef>

#ifdef SMALL_CFG
constexpr int D = 256, CB = 2, CT = 128, DEPTH = 2, LB = 1, LT = 256, GW = 16;
#else
constexpr int D = 1024, CB = 32, CT = 256, DEPTH = 2, LB = 2, LT = 4096, GW = 64;
#endif
constexpr int MW = D / 2, MD = 128, MH = MW / MD, RW = D / 2, RD = 64, RH = RW / RD;
constexpr int RIN = 3 * RW + 384, FF = ((8 * D + 767) / 768) * 256, PIN = 2 * MW + MW + MW + 4 * MH + RIN + 2 * D;
constexpr int NC = CB * CT, NL = LB * LT, NT = NC + NL, NSEQ = CB + LB, NCOND = 1 + LB;
constexpr int N1 = PIN - 2 * D;
constexpr int N1P = ((N1 + 255) / 256) * 256;
constexpr int PU = N1;
constexpr int OFF_QK = 0, OFF_V = 2 * MW, OFF_O = 3 * MW, OFF_G = 4 * MW, OFF_R = 4 * MW + 4 * MH;
constexpr int RX_R = 0, RX_K = RW, RX_V = 2 * RW, RX_WL = 3 * RW, RX_AL = 3 * RW + 128, RX_GL = 3 * RW + 256;
constexpr float RMS_EPS = 1e-6f, GN_EPS = 64e-5f;
static_assert(3 * D <= N1, "G + merged must fit the dead columns of U1");

enum { X_PROMPT = 0, X_SAMPLE, ST_C, ST_N, ST_M, ST_R, C_LAT, C_CTX, ADA_W, ADA_B, NORM1, NORM2, W_IN, M_CONV, M_GATE_B, M_NORM_G,
       R_CONV, R_W0, R_W2, R_A0, R_A2, R_G2, R_KK, R_KA, R_RK, R_GN_W, R_GN_B, PROJ_M, PROJ_R, W_OUT, FFN_W1, FFN_W3, FFN_W2, FINAL_G, N_IN };

constexpr size_t OUT_X = 0;
constexpr size_t OUT_C = (size_t)NT * D;
constexpr size_t OUT_N = OUT_C + (size_t)CB * DEPTH * 2 * MH * 128 * 128;
constexpr size_t OUT_M = OUT_N + (size_t)CB * DEPTH * 2 * MH * 128;
constexpr size_t OUT_S = OUT_M + (size_t)CB * DEPTH * 2 * MH;
constexpr size_t OUT_END = OUT_S + (size_t)CB * DEPTH * 2 * RH * 64 * 64;

constexpr size_t al256(size_t x) { return (x + 255) & ~(size_t)255; }
constexpr size_t cmax(size_t a, size_t b) { return a > b ? a : b; }
constexpr size_t WS_CTL = 0;
constexpr size_t WS_MOD = (size_t)1 << 20;
constexpr size_t WS_WREG = (size_t)2 << 20;
constexpr size_t O_WIN1 = WS_WREG;
constexpr size_t O_WIN2 = O_WIN1 + (size_t)N1P * D * 2;
constexpr size_t O_PM = O_WIN2 + (size_t)2 * D * D * 2;
constexpr size_t O_PR = O_PM + (size_t)D * MW * 2;
constexpr size_t O_WO = O_PR + (size_t)D * RW * 2;
constexpr size_t O_W13 = O_WO + (size_t)D * D * 2;
constexpr size_t O_W2 = O_W13 + (size_t)2 * FF * D * 2;
constexpr size_t O_G2T = O_W2 + (size_t)D * FF * 2;
constexpr size_t O_W2T = O_G2T + (size_t)RW * 128 * 2;
constexpr size_t O_A2T = O_W2T + (size_t)2 * RW * 64 * 2;
constexpr size_t WS_U1 = al256(O_A2T + (size_t)2 * RW * 64 * 2);
constexpr size_t SZ_U1 = al256(cmax((size_t)NT * PU * 2, (size_t)NT * FF * 2));
constexpr size_t WS_QKC = WS_U1 + SZ_U1;
constexpr size_t WS_RXC = WS_QKC + (size_t)NT * D * 2;
constexpr size_t WS_END = WS_RXC + al256(cmax((size_t)NT * RIN * 2, (size_t)NT * D * 2));
#ifndef SMALL_CFG
static_assert(WS_END <= ((size_t)256 << 20), "workspace map must fit 256 MiB");
#endif

typedef unsigned short bf16;
HD float bf2f(bf16 b) { unsigned u = ((unsigned)b) << 16; return __builtin_bit_cast(float, u); }
#if defined(__HIP_DEVICE_COMPILE__)
HD bf16 f2bf(float f) { return __builtin_bit_cast(bf16, (__bf16)f); }
#else
HD bf16 f2bf(float f) { unsigned u = __builtin_bit_cast(unsigned, f); u += 0x7fffu + ((u >> 16) & 1u); return (bf16)(u >> 16); }
#endif
HD float sigmoidf_(float x) { return 1.0f / (1.0f + expf(-x)); }
HD float siluf_(float x) { return x / (1.0f + expf(-x)); }
HD float softplusf_(float x) { return fmaxf(x, 0.f) + log1pf(expf(-fabsf(x))); }
HD float logsigmoidf_(float x) { return -softplusf_(-x); }
HD int prow(int c) { return (c & ~31) | (((c >> 2) & 1) << 4) | (((c >> 3) & 3) << 2) | (c & 3); }

struct Params {
    const float* in[N_IN];
    float* out;
    unsigned char* ws;
    int layer;
    int mode;
};

struct SeqInfo { int T; int base; int grid; int cond; int b; };
HD SeqInfo seqinfo(int s) {
    SeqInfo q;
    if (s < CB) { q.T = CT; q.base = s * CT; q.grid = 0; q.cond = 0; q.b = s; }
    else { q.T = LT; q.base = NC + (s - CB) * LT; q.grid = 1; q.cond = 1 + (s - CB); q.b = s - CB; }
    return q;
}
HD int seq_of_token(int m) { return m < NC ? m / CT : CB + (m - NC) / LT; }

#define WSP(T, off) ((T*)(P.ws + (off)))

DEV void k_init_x(const Params& P, long i) {
    const size_t ncd = (size_t)NC * D;
    P.out[i] = (size_t)i < ncd ? P.in[X_PROMPT][i] : P.in[X_SAMPLE][i - ncd];
}
DEV void k_mod(const Params& P, long i) {
    const int j = (int)(i % (6 * D)); const int ci = (int)((i / (6 * D)) % NCOND); const int l = (int)(i / ((long)6 * D * NCOND));
    const float* cv = ci == 0 ? P.in[C_CTX] : P.in[C_LAT] + (size_t)(ci - 1) * D;
    const float* w = P.in[ADA_W] + (size_t)l * D * 6 * D;
    float acc = P.in[ADA_B][(size_t)l * 6 * D + j];
    for (int k = 0; k < D; ++k) acc += siluf_(cv[k]) * w[(size_t)k * 6 * D + j];
    WSP(float, WS_MOD)[i] = acc;
}
constexpr long WC_N0 = (long)N1P * D, WC_N1 = WC_N0 + (long)2 * D * D, WC_N2 = WC_N1 + (long)D * MW, WC_N3 = WC_N2 + (long)D * RW,
               WC_N4 = WC_N3 + (long)D * D, WC_N5 = WC_N4 + (long)2 * FF * D, WC_N6 = WC_N5 + (long)D * FF;
HD int unprow(int r) { return (r & ~31) | (((r >> 2) & 3) << 3) | (((r >> 4) & 1) << 2) | (r & 3); }
DEV void k_wconv(const Params& P, long i) {
    const int l = P.layer;
    if (i < WC_N0) { const int r = (int)(i / D), k = (int)(i % D); const int c = unprow(r);
        WSP(bf16, O_WIN1)[i] = c < N1 ? f2bf(P.in[W_IN][((size_t)l * D + k) * PIN + c]) : (bf16)0; return; }
    if (i < WC_N1) { const long j = i - WC_N0; const int r = (int)(j / D), k = (int)(j % D); const int c = unprow(r);
        WSP(bf16, O_WIN2)[j] = f2bf(P.in[W_IN][((size_t)l * D + k) * PIN + N1 + c]); return; }
    if (i < WC_N2) { const long j = i - WC_N1; const int r = (int)(j / MW), k = (int)(j % MW); const int c = unprow(r);
        WSP(bf16, O_PM)[j] = f2bf(P.in[PROJ_M][((size_t)l * MW + k) * D + c]); return; }
    if (i < WC_N3) { const long j = i - WC_N2; const int r = (int)(j / RW), k = (int)(j % RW); const int c = unprow(r);
        WSP(bf16, O_PR)[j] = f2bf(P.in[PROJ_R][((size_t)l * RW + k) * D + c]); return; }
    if (i < WC_N4) { const long j = i - WC_N3; const int r = (int)(j / D), k = (int)(j % D);
        WSP(bf16, O_WO)[j] = f2bf(P.in[W_OUT][((size_t)l * D + k) * D + r]); return; }
    if (i < WC_N5) { const long j = i - WC_N4; const int r = (int)(j / D), k = (int)(j % D);
        const int pn = r >> 8, rl = r & 255, which = rl >> 7, rho = rl & 127; const int jj = pn * 128 + unprow(rho);
        const float* W = which ? P.in[FFN_W3] : P.in[FFN_W1];
        WSP(bf16, O_W13)[j] = f2bf(W[((size_t)l * D + k) * FF + jj]); return; }
    { const long j = i - WC_N5; const int r = (int)(j / FF), k = (int)(j % FF);
        WSP(bf16, O_W2)[j] = f2bf(P.in[FFN_W2][((size_t)l * FF + k) * D + r]); }
}
DEV void k_norm(const Params& P, long m) {
    const int l = P.layer; const int second = (P.mode == 2);
    const float* x = P.out + (size_t)m * D;
    const float* g = P.in[second ? NORM2 : NORM1] + (size_t)l * D;
    const int cond = seqinfo(seq_of_token((int)m)).cond;
    const float* mod = WSP(float, WS_MOD) + ((size_t)l * NCOND + cond) * 6 * D + (second ? 3 * D : 0);
    float ss = 0.f;
    for (int k = 0; k < D; ++k) ss += x[k] * x[k];
    const float rs = 1.0f / sqrtf(ss / D + RMS_EPS);
    bf16* o = WSP(bf16, P.mode == 1 ? WS_RXC : WS_QKC) + (size_t)m * D;
    for (int k = 0; k < D; ++k) o[k] = f2bf(x[k] * rs * g[k] * (1.0f + mod[D + k]) + mod[k]);
}
DEV float dot_bf(const bf16* a, const bf16* b, int K) { float s = 0.f; for (int k = 0; k < K; ++k) s += bf2f(a[k]) * bf2f(b[k]); return s; }
DEV void k_gemm_a1(const Params& P, long i) {
    const int n = (int)(i % N1); const long m = i / N1;
    WSP(bf16, WS_U1)[(size_t)m * PU + n] = f2bf(dot_bf(WSP(bf16, WS_QKC) + (size_t)m * D, WSP(bf16, O_WIN1) + (size_t)prow(n) * D, D));
}
DEV void k_gemm_a2(const Params& P, long i) {
    const int n = (int)(i % (2 * D)); const long m = i / (2 * D);
    WSP(bf16, WS_U1)[(size_t)m * PU + D + n] = f2bf(sigmoidf_(dot_bf(WSP(bf16, WS_RXC) + (size_t)m * D, WSP(bf16, O_WIN2) + (size_t)prow(n) * D, D)));
}
DEV void k_gemm_pj(const Params& P, long i) {
    const int n = (int)(i % D); const long m = i / D;
    const bf16* hmr = WSP(bf16, WS_QKC) + (size_t)m * D; bf16* u = WSP(bf16, WS_U1) + (size_t)m * PU;
    const float a = dot_bf(hmr, WSP(bf16, O_PM) + (size_t)prow(n) * MW, MW), b = dot_bf(hmr + MW, WSP(bf16, O_PR) + (size_t)prow(n) * RW, RW);
    const float first = bf2f(f2bf(bf2f(u[D + n]) * a));
    u[n] = f2bf(first + bf2f(u[2 * D + n]) * b);
}
DEV void k_gemm_wo(const Params& P, long i) {
    const int n = (int)(i % D); const long m = i / D; const int l = P.layer;
    const int cond = seqinfo(seq_of_token((int)m)).cond;
    const float g1 = WSP(float, WS_MOD)[((size_t)l * NCOND + cond) * 6 * D + 2 * D + n];
    P.out[(size_t)m * D + n] += g1 * dot_bf(WSP(bf16, WS_U1) + (size_t)m * PU, WSP(bf16, O_WO) + (size_t)n * D, D);
}
DEV void k_gemm_f1(const Params& P, long i) {
    const int j = (int)(i % FF); const long m = i / FF;
    const int pn = j >> 7, rho = prow(j & 127);
    const bf16* h = WSP(bf16, WS_QKC) + (size_t)m * D;
    const float a = dot_bf(h, WSP(bf16, O_W13) + (size_t)(pn * 256 + rho) * D, D), b = dot_bf(h, WSP(bf16, O_W13) + (size_t)(pn * 256 + 128 + rho) * D, D);
    WSP(bf16, WS_U1)[(size_t)m * FF + j] = f2bf(siluf_(a) * b);
}
DEV void k_gemm_f2(const Params& P, long i) {
    const int n = (int)(i % D); const long m = i / D; const int l = P.layer;
    const int cond = seqinfo(seq_of_token((int)m)).cond;
    const float g2 = WSP(float, WS_MOD)[((size_t)l * NCOND + cond) * 6 * D + 5 * D + n];
    P.out[(size_t)m * D + n] += g2 * dot_bf(WSP(bf16, WS_U1) + (size_t)m * FF, WSP(bf16, O_W2) + (size_t)n * FF, FF);
}
DEV void k_conv(const Params& P, long i) {
    constexpr int NCH = 2 * MW + RIN;
    const int ch = (int)(i % NCH); const int m = (int)(i / NCH); const int l = P.layer;
    const int s = seq_of_token(m); const SeqInfo q = seqinfo(s); const int t = m - q.base;
    const bool isqk = ch < 2 * MW; const int c = isqk ? ch : ch - 2 * MW;
    const int ucol = isqk ? OFF_QK + c : OFF_R + c;
    const int CH = isqk ? 2 * MW : RIN;
    const float* w = (isqk ? P.in[M_CONV] : P.in[R_CONV]) + (size_t)l * 9 * CH;
    const bf16* U = WSP(bf16, WS_U1);
    float acc = 0.f;
    if (q.grid) {
        const int r = t / GW, cc = t % GW, rows = q.T / GW;
        for (int a = 0; a < 3; ++a) for (int b = 0; b < 3; ++b) {
            const int rr = r + a - 1, c2 = cc + b - 1;
            if (rr >= 0 && rr < rows && c2 >= 0 && c2 < GW) acc += w[(a * 3 + b) * CH + c] * bf2f(U[(size_t)(q.base + rr * GW + c2) * PU + ucol]);
        }
    } else {
        for (int b = 0; b < 3; ++b) { const int t2 = t + b - 1; if (t2 >= 0 && t2 < q.T) acc += w[(3 + b) * CH + c] * bf2f(U[(size_t)(q.base + t2) * PU + ucol]); }
    }
    if (isqk) { float v = siluf_(acc); if (c < MW) v *= 0.08838834764831845f; WSP(bf16, WS_QKC)[(size_t)m * (2 * MW) + c] = f2bf(v); }
    else { float v = acc; if (c >= RX_WL && c < RX_AL) v = tanhf(v); else if (c >= RX_GL) v = sigmoidf_(v); WSP(bf16, WS_RXC)[(size_t)m * RIN + c] = f2bf(v); }
}
DEV void k_mlstm(const Params& P, long i) {
    const int e = (int)(i % 128); const int chain = (int)(i / 128); const int dir = chain & 1, head = (chain >> 1) % MH, s = chain / (2 * MH);
    const int l = P.layer; const SeqInfo q = seqinfo(s);
    float C[128], n[128]; float m;
    if (!q.grid) {
#pragma unroll
        for (int d = 0; d < 128; ++d) { C[d] = 0.f; n[d] = 0.f; }
        m = 0.f;
    } else {
        const size_t sb = (((size_t)q.b * DEPTH + l) * 2 + dir) * MH + head;
#pragma unroll
        for (int d = 0; d < 128; ++d) { C[d] = P.in[ST_C][(sb * 128 + d) * 128 + e]; n[d] = P.in[ST_N][sb * 128 + d]; }
        m = P.in[ST_M][sb];
    }
    const float bi = P.in[M_GATE_B][(size_t)l * 4 * MH + (2 * dir) * MH + head], bfg = P.in[M_GATE_B][(size_t)l * 4 * MH + (2 * dir + 1) * MH + head];
    bf16* U = WSP(bf16, WS_U1); const bf16* QK = WSP(bf16, WS_QKC);
    float nsel = 0.f;
    for (int p = 0; p < q.T; ++p) {
        const int t = dir ? q.T - 1 - p : p; const size_t tok = (size_t)(q.base + t);
        const bf16* qk = QK + tok * (2 * MW); bf16* u = U + tok * PU;
        const float gi = bf2f(u[OFF_G + (2 * dir) * MH + head]) + bi, gf = bf2f(u[OFF_G + (2 * dir + 1) * MH + head]) + bfg;
        const float lf = logsigmoidf_(gf);
        const float mn = fmaxf(lf + m, gi); const float fw = expf(lf + m - mn), iw = expf(gi - mn);
        const float v = bf2f(u[OFF_V + head * 128 + e]);
        float num = 0.f, den = 0.f;
#pragma unroll
        for (int d = 0; d < 128; ++d) {
            const float kd = bf2f(qk[MW + head * 128 + d]), qd = bf2f(qk[head * 128 + d]);
            C[d] = fw * C[d] + iw * kd * v; n[d] = fw * n[d] + iw * kd; num += qd * C[d]; den += qd * n[d];
        }
        m = mn;
        u[dir * MW + head * 128 + e] = f2bf(num / fmaxf(fabsf(den), expf(-m)));
    }
    if (!q.grid) {
        const size_t sb = (((size_t)q.b * DEPTH + l) * 2 + dir) * MH + head;
#pragma unroll
        for (int d = 0; d < 128; ++d) { P.out[OUT_C + (sb * 128 + d) * 128 + e] = C[d]; if (d == e) nsel = n[d]; }
        P.out[OUT_N + sb * 128 + e] = nsel;
        if (e == 0) P.out[OUT_M + sb] = m;
    }
}
DEV void k_rwkv_prep(const Params& P, long i) {
    const int c = (int)(i % RW); const size_t tok = (size_t)(i / RW); const int l = P.layer, dir = P.mode;
    const bf16* rx = WSP(bf16, WS_RXC) + tok * RIN;
    const float* w2 = P.in[R_W2] + ((size_t)l * 2 + dir) * 64 * RW + c; const float* a2 = P.in[R_A2] + ((size_t)l * 2 + dir) * 64 * RW + c;
    float wr = P.in[R_W0][((size_t)l * 2 + dir) * RW + c], ar = P.in[R_A0][((size_t)l * 2 + dir) * RW + c];
    for (int j = 0; j < 64; ++j) { wr += bf2f(rx[RX_WL + dir * 64 + j]) * w2[(size_t)j * RW]; ar += bf2f(rx[RX_AL + dir * 64 + j]) * a2[(size_t)j * RW]; }
    bf16* o = WSP(bf16, WS_QKC) + tok * (2 * RW);
    o[c] = f2bf(wr); o[RW + c] = f2bf(ar);
}
DEV void k_rwkv(const Params& P, long i) {
    const int row = (int)(i % 64); const int chain = (int)(i / 64); const int dir = P.mode, head = chain % RH, s = chain / RH;
    const int l = P.layer; const SeqInfo q = seqinfo(s); const int hc = head * 64;
    float S[64];
    if (!q.grid) {
#pragma unroll
        for (int c = 0; c < 64; ++c) S[c] = 0.f;
    } else {
        const size_t sb = (((size_t)q.b * DEPTH + l) * 2 + dir) * RH + head;
#pragma unroll
        for (int c = 0; c < 64; ++c) S[c] = P.in[ST_R][(sb * 64 + row) * 64 + c];
    }
    const float* rkk = P.in[R_KK] + (size_t)l * RW + hc; const float* rka = P.in[R_KA] + (size_t)l * RW + hc;
    bf16* U = WSP(bf16, WS_U1); const bf16* RX = WSP(bf16, WS_RXC); const bf16* WA = WSP(bf16, WS_QKC);
    for (int p = 0; p < q.T; ++p) {
        const int t = dir ? q.T - 1 - p : p; const size_t tok = (size_t)(q.base + t);
        const bf16* rx = RX + tok * RIN; const bf16* wa = WA + tok * (2 * RW);
        float ss = 0.f;
        for (int c = 0; c < 64; ++c) { const float kc = bf2f(rx[RX_K + hc + c]) * rkk[c]; ss += kc * kc; }
        const float inv = 1.0f / fmaxf(sqrtf(ss), 1e-12f);
        float sa = 0.f;
#pragma unroll
        for (int c = 0; c < 64; ++c) sa -= S[c] * (bf2f(rx[RX_K + hc + c]) * rkk[c] * inv);
        const float v = bf2f(rx[RX_V + hc + row]);
        float y = 0.f;
#pragma unroll
        for (int c = 0; c < 64; ++c) {
            const float wr = bf2f(wa[hc + c]), ar = bf2f(wa[RW + hc + c]);
            const float decay = expf(-0.6065306597126334f * sigmoidf_(wr));
            const float alpha = sigmoidf_(ar);
            const float kr = bf2f(rx[RX_K + hc + c]);
            const float kt = kr * (1.0f + (alpha - 1.0f) * rka[c]);
            const float bb = kr * rkk[c] * inv * alpha;
            S[c] = S[c] * decay + sa * bb + v * kt;
            y += S[c] * bf2f(rx[RX_R + hc + c]);
        }
        U[tok * PU + OFF_R + dir * RW + hc + row] = f2bf(y);
    }
    if (!q.grid) {
        const size_t sb = (((size_t)q.b * DEPTH + l) * 2 + dir) * RH + head;
#pragma unroll
        for (int c = 0; c < 64; ++c) P.out[OUT_S + (sb * 64 + row) * 64 + c] = S[c];
    }
}
DEV void k_post(const Params& P, long i) {
    const int ch = (int)(i % D); const size_t m = (size_t)(i / D); const int l = P.layer;
    const bf16* u = WSP(bf16, WS_U1) + m * PU; const bf16* rx = WSP(bf16, WS_RXC) + m * RIN;
    bf16* o = WSP(bf16, WS_QKC) + m * D;
    if (ch < MW) {
        const int h0 = (ch / 128) * 128; float ss = 0.f;
        for (int d = 0; d < 128; ++d) { const float x = bf2f(u[h0 + d]) + bf2f(u[MW + h0 + d]); ss += x * x; }
        const float x = bf2f(u[ch]) + bf2f(u[MW + ch]);
        o[ch] = f2bf(x / sqrtf(ss / 128.f + RMS_EPS) * P.in[M_NORM_G][(size_t)l * MW + ch] * sigmoidf_(bf2f(u[OFF_O + ch])));
    } else {
        const int c = ch - MW; const int h0 = (c / 64) * 64;
        float mu = 0.f, bsum = 0.f;
        for (int d = 0; d < 64; ++d) { mu += bf2f(u[OFF_R + h0 + d]) + bf2f(u[OFF_R + RW + h0 + d]);
            bsum += bf2f(rx[RX_R + h0 + d]) * bf2f(rx[RX_K + h0 + d]) * P.in[R_RK][(size_t)l * RW + h0 + d]; }
        mu *= (1.0f / 64.f); float var = 0.f;
        for (int d = 0; d < 64; ++d) { const float x = bf2f(u[OFF_R + h0 + d]) + bf2f(u[OFF_R + RW + h0 + d]) - mu; var += x * x; }
        var *= (1.0f / 64.f);
        const float y = bf2f(u[OFF_R + c]) + bf2f(u[OFF_R + RW + c]);
        const float yn = (y - mu) / sqrtf(var + GN_EPS) * P.in[R_GN_W][(size_t)l * RW + c] + P.in[R_GN_B][(size_t)l * RW + c];
        float gate = 0.f;
        for (int j = 0; j < 128; ++j) gate += bf2f(rx[RX_GL + j]) * P.in[R_G2][((size_t)l * 128 + j) * RW + c];
        o[ch] = f2bf((yn + bsum * bf2f(rx[RX_V + c])) * gate);
    }
}
DEV void k_final(const Params& P, long m) {
    float* x = P.out + (size_t)m * D; float ss = 0.f;
    for (int k = 0; k < D; ++k) ss += x[k] * x[k];
    const float rs = 1.0f / sqrtf(ss / D + RMS_EPS);
    for (int k = 0; k < D; ++k) x[k] = x[k] * rs * P.in[FINAL_G][k];
}


#ifndef HOST_EMU
typedef const __attribute__((address_space(4))) Params CParams;
namespace pg8 {
#define PG8_LAS __attribute__((address_space(3)))
typedef short bf16x8 __attribute__((ext_vector_type(8)));
typedef float f32x4 __attribute__((ext_vector_type(4)));
typedef unsigned u32x4 __attribute__((ext_vector_type(4)));
constexpr int BM = 256, BK = 64, HALF = 128, HTB = HALF * BK * 2, STAGE_BYTES = 8 * HTB, NXCD = 8, WGM = 8;
__device__ __forceinline__ int lds_byte(int r, int c) { const int st = (r >> 4) * 2 + (c >> 5), rr = r & 15, cc = c & 31, ob = rr * 64 + cc * 2; return st * 1024 + (ob ^ (((ob >> 9) & 1) << 5)); }
__device__ __forceinline__ void stage_rc(int b, int& R, int& C) { const int st = b / 1024, sb = b % 1024, swz = sb ^ (((sb >> 9) & 1) << 5); R = (st >> 1) * 16 + swz / 64; C = (st & 1) * 32 + (swz % 64) / 2; }
struct Unit { int pm, pn, aoff; };
struct Gemm { const bf16* A; const bf16* Bt; int K, lda; };
struct StaticOrder {
    int nM, nN, nwg, G, c;
    __device__ __forceinline__ void init(int M, int N, int G_, int c_) { nM = M / BM; nN = N / BM; nwg = nM * nN; G = G_; c = c_; }
    __device__ __forceinline__ bool next(int i, Unit& u) const {
        const long L = (long)i * G + c; if (L >= nwg) return false;
        int wgid = (int)L; { const int q = nwg / NXCD, r = nwg % NXCD, xcd = wgid % NXCD, off = wgid / NXCD; wgid = (xcd < r ? xcd * (q + 1) : r * (q + 1) + (xcd - r) * q) + off; }
        const int nig = WGM * nN, gid = wgid / nig, fm = gid * WGM, gsz = (nM - fm) < WGM ? (nM - fm) : WGM;
        u.pm = fm + ((wgid % nig) % gsz); u.pn = (wgid % nig) / gsz; u.aoff = 0; return true;
    }
};
struct PairOrder {
    int nbase, G, v, nct;
    __device__ __forceinline__ void init(int M, int G_, int c_) { nct = D / BM; nbase = (M / BM) * nct; G = G_; v = (G_ % 8 == 0) ? (c_ % 8) * (G_ / 8) + c_ / 8 : c_; }
    __device__ __forceinline__ bool next(int i, Unit& u) const {
        const int j = v + (i >> 1) * G; if (j >= nbase) return false;
        const int half = i & 1; u.pm = j / nct; u.pn = half * nct + (j % nct); u.aoff = half * MW; return true;
    }
};
typedef float f32x2_t __attribute__((ext_vector_type(2)));
typedef __bf16 bf16x2_t __attribute__((ext_vector_type(2)));
__device__ __forceinline__ unsigned cvt_pk_bf16(float lo, float hi) { f32x2_t v = {lo, hi}; bf16x2_t b = __builtin_convertvector(v, bf16x2_t); return __builtin_bit_cast(unsigned, b); }
__device__ __forceinline__ float fsigmoid(float x) { return __builtin_amdgcn_rcpf(1.0f + __expf(-x)); }
__device__ __forceinline__ float bflo(unsigned w) { return __builtin_bit_cast(float, w << 16); }
__device__ __forceinline__ float bfhi(unsigned w) { return __builtin_bit_cast(float, w & 0xffff0000u); }

struct EpiA1 {
    bf16* U;
    __device__ __forceinline__ void operator()(const f32x4 (&acc)[2][2][4][2], const Unit& u, int wr, int wc, int fr, int fq) const {
        const int row0 = u.pm * BM + wr * 64 + fr, col0 = u.pn * BM + wc * 32 + 8 * fq;
#pragma unroll
        for (int ai = 0; ai < 2; ++ai)
#pragma unroll
            for (int m = 0; m < 4; ++m) { bf16* rowp = U + (size_t)(row0 + ai * HALF + m * 16) * PU + col0;
#pragma unroll
                for (int bj = 0; bj < 2; ++bj) { if (col0 + bj * HALF < N1) { const f32x4 v0 = acc[ai][bj][m][0], v1 = acc[ai][bj][m][1];
                    u32x4 w; w.x = cvt_pk_bf16(v0[0], v0[1]); w.y = cvt_pk_bf16(v0[2], v0[3]); w.z = cvt_pk_bf16(v1[0], v1[1]); w.w = cvt_pk_bf16(v1[2], v1[3]);
                    *(u32x4*)(rowp + bj * HALF) = w; } } }
    }
};
struct EpiA2 {
    bf16* U;
    __device__ __forceinline__ void operator()(const f32x4 (&acc)[2][2][4][2], const Unit& u, int wr, int wc, int fr, int fq) const {
        const int row0 = u.pm * BM + wr * 64 + fr, col0 = D + u.pn * BM + wc * 32 + 8 * fq;
#pragma unroll
        for (int ai = 0; ai < 2; ++ai)
#pragma unroll
            for (int m = 0; m < 4; ++m) { bf16* rowp = U + (size_t)(row0 + ai * HALF + m * 16) * PU + col0;
#pragma unroll
                for (int bj = 0; bj < 2; ++bj) { const f32x4 v0 = acc[ai][bj][m][0], v1 = acc[ai][bj][m][1];
                    u32x4 w; w.x = cvt_pk_bf16(fsigmoid(v0[0]), fsigmoid(v0[1])); w.y = cvt_pk_bf16(fsigmoid(v0[2]), fsigmoid(v0[3]));
                    w.z = cvt_pk_bf16(fsigmoid(v1[0]), fsigmoid(v1[1])); w.w = cvt_pk_bf16(fsigmoid(v1[2]), fsigmoid(v1[3]));
                    *(u32x4*)(rowp + bj * HALF) = w; } }
    }
};
struct EpiPJ {
    bf16* U;
    __device__ __forceinline__ void operator()(const f32x4 (&acc)[2][2][4][2], const Unit& u, int wr, int wc, int fr, int fq) const {
        const int nct = D / BM, half = u.pn >= nct ? 1 : 0, ct = u.pn - half * nct;
        const int row0 = u.pm * BM + wr * 64 + fr, col0 = ct * BM + wc * 32 + 8 * fq;
#pragma unroll
        for (int ai = 0; ai < 2; ++ai)
#pragma unroll
            for (int m = 0; m < 4; ++m) { bf16* rowp = U + (size_t)(row0 + ai * HALF + m * 16) * PU + col0;
#pragma unroll
                for (int bj = 0; bj < 2; ++bj) { const f32x4 v0 = acc[ai][bj][m][0], v1 = acc[ai][bj][m][1];
                    const u32x4 g = *(const u32x4*)(rowp + (1 + half) * D + bj * HALF);
                    float o[8] = { bflo(g.x) * v0[0], bfhi(g.x) * v0[1], bflo(g.y) * v0[2], bfhi(g.y) * v0[3], bflo(g.z) * v1[0], bfhi(g.z) * v1[1], bflo(g.w) * v1[2], bfhi(g.w) * v1[3] };
                    if (half) { const u32x4 p = *(const u32x4*)(rowp + bj * HALF);
                        o[0] += bflo(p.x); o[1] += bfhi(p.x); o[2] += bflo(p.y); o[3] += bfhi(p.y); o[4] += bflo(p.z); o[5] += bfhi(p.z); o[6] += bflo(p.w); o[7] += bfhi(p.w); }
                    u32x4 w; w.x = cvt_pk_bf16(o[0], o[1]); w.y = cvt_pk_bf16(o[2], o[3]); w.z = cvt_pk_bf16(o[4], o[5]); w.w = cvt_pk_bf16(o[6], o[7]);
                    *(u32x4*)(rowp + bj * HALF) = w; }
                asm volatile("" ::: "memory"); }
    }
};
struct EpiRes {
    float* X; const float* gate;
    const float* sa; const float* sb;
    __device__ __forceinline__ void operator()(const f32x4 (&acc)[2][2][4][2], const Unit& u, int wr, int wc, int fr, int fq) const {
        const int row0 = u.pm * BM + wr * 64 + fr, col0 = u.pn * BM + wc * 32 + 4 * fq;
        const float* S = sa ? (u.pm * BM < NC ? sa : sb - (size_t)NC * D) : X;
        const int cond = seqinfo(seq_of_token(u.pm * BM)).cond;
        const float* gp = gate + (size_t)cond * 6 * D + col0;
        f32x4 gv[2][2];
#pragma unroll
        for (int bj = 0; bj < 2; ++bj)
#pragma unroll
            for (int n = 0; n < 2; ++n) gv[bj][n] = *(const f32x4*)(gp + bj * HALF + n * 16);
#pragma unroll
        for (int ai = 0; ai < 2; ++ai)
#pragma unroll
            for (int m = 0; m < 4; ++m) { const size_t ro = (size_t)(row0 + ai * HALF + m * 16) * D + col0; float* rowp = X + ro; const float* srow = S + ro;
#pragma unroll
                for (int bj = 0; bj < 2; ++bj)
#pragma unroll
                    for (int n = 0; n < 2; ++n) { *(f32x4*)(rowp + bj * HALF + n * 16) = *(const f32x4*)(srow + bj * HALF + n * 16) + gv[bj][n] * acc[ai][bj][m][n]; }
                asm volatile("" ::: "memory"); }
    }
};
struct EpiF1 {
    bf16* Hd;
    __device__ __forceinline__ void operator()(const f32x4 (&acc)[2][2][4][2], const Unit& u, int wr, int wc, int fr, int fq) const {
        const int row0 = u.pm * BM + wr * 64 + fr, col0 = u.pn * HALF + wc * 32 + 8 * fq;
#pragma unroll
        for (int ai = 0; ai < 2; ++ai)
#pragma unroll
            for (int m = 0; m < 4; ++m) { bf16* rowp = Hd + (size_t)(row0 + ai * HALF + m * 16) * FF + col0;
                float o[8];
#pragma unroll
                for (int n = 0; n < 2; ++n)
#pragma unroll
                    for (int e = 0; e < 4; ++e) { const float a = acc[ai][0][m][n][e], b = acc[ai][1][m][n][e]; o[n * 4 + e] = a * fsigmoid(a) * b; }
                u32x4 w; w.x = cvt_pk_bf16(o[0], o[1]); w.y = cvt_pk_bf16(o[2], o[3]); w.z = cvt_pk_bf16(o[4], o[5]); w.w = cvt_pk_bf16(o[6], o[7]);
                *(u32x4*)rowp = w; }
    }
};

template <class Epi, class Sched, bool ALIGN_EPI = true, bool SP2 = true>
__device__ __forceinline__ void gemm_phase(PG8_LAS unsigned char* lds, const Gemm g, const Sched& S, const Epi& E) {
    const int tid = threadIdx.x, wid = __builtin_amdgcn_readfirstlane(tid >> 6), lane = tid & 63, wr = wid >> 2, wc = wid & 3, fr = lane & 15, fq = lane >> 4;
    const int K = g.K, nt = K / BK;
    unsigned voffA[2], voffB[2];
#pragma unroll
    for (int i = 0; i < 2; ++i) { int R, C; stage_rc(tid * 16 + i * 8192, R, C);
        voffA[i] = (unsigned)(R * g.lda + C) * 2u; voffB[i] = (unsigned)(R * K + C) * 2u; }
    const size_t kstep = (size_t)(BK * 2);
    const size_t hstepA = (size_t)HALF * g.lda * 2, hstepB = (size_t)HALF * K * 2;
    const size_t tstepA = 2 * hstepA, tstepB = 2 * hstepB;
    const unsigned ldsw = (unsigned)wid * 1024u;
    const int aoff = lds_byte(wr * 64 + fr, fq * 8), boff = lds_byte(wc * 32 + fr, fq * 8);
#define PG8_SA(b, h) (((b) * 2 + (h)) * HTB)
#define PG8_SB(b, h) ((4 + (b) * 2 + (h)) * HTB)
#define PG8_STAGE(bufoff, gbase, voff) do { _Pragma("unroll") for (int _i = 0; _i < 2; ++_i) \
        __builtin_amdgcn_global_load_lds((const unsigned*)((const char*)(gbase) + (voff)[_i]), (PG8_LAS unsigned*)(lds + (bufoff) + ldsw + _i * 8192), 16, 0, 0); } while (0)
#define PG8_LDA(dst, b, h) do { _Pragma("unroll") for (int m = 0; m < 4; ++m) _Pragma("unroll") for (int k = 0; k < 2; ++k) dst[m][k] = *(const PG8_LAS bf16x8*)(lds + PG8_SA(b, h) + aoff + m * 2048 + k * 1024); } while (0)
#define PG8_LDB(dst, b, h) do { _Pragma("unroll") for (int n = 0; n < 2; ++n) _Pragma("unroll") for (int k = 0; k < 2; ++k) dst[n][k] = *(const PG8_LAS bf16x8*)(lds + PG8_SB(b, h) + boff + n * 2048 + k * 1024); } while (0)
#define PG8_MMA(ai, bj, At, Bt) do { __builtin_amdgcn_s_setprio(1); _Pragma("unroll") for (int m = 0; m < 4; ++m) _Pragma("unroll") for (int n = 0; n < 2; ++n) _Pragma("unroll") for (int k = 0; k < 2; ++k) \
        acc[ai][bj][m][n] = __builtin_amdgcn_mfma_f32_16x16x32_bf16(Bt[n][k], At[m][k], acc[ai][bj][m][n], 0, 0, 0); __builtin_amdgcn_s_setprio(0); } while (0)
#define PG8_WAIT_V(n) asm volatile("s_waitcnt vmcnt(" #n ")" ::: "memory")
#define PG8_WAIT_L(n) asm volatile("s_waitcnt lgkmcnt(" #n ")" ::: "memory")
#define PG8_BAR __builtin_amdgcn_s_barrier()
#define PG8_SCHED __builtin_amdgcn_sched_barrier(0)
    Unit cur, nxt; int ui = 0;
    if (!S.next(0, cur)) return;
    f32x4 acc[2][2][4][2];
#pragma unroll
    for (int a = 0; a < 2; ++a)
#pragma unroll
        for (int b = 0; b < 2; ++b)
#pragma unroll
            for (int m = 0; m < 4; ++m)
#pragma unroll
                for (int n = 0; n < 2; ++n) acc[a][b][m][n] = (f32x4){0.f, 0.f, 0.f, 0.f};
    bf16x8 At[4][2], B0[2][2], B1[2][2];
    const char* cA = (const char*)g.A + (size_t)cur.pm * tstepA + (size_t)cur.aoff * 2; const char* cB = (const char*)g.Bt + (size_t)cur.pn * tstepB;
    if constexpr (SP2) {
        PG8_STAGE(PG8_SB(0, 0), cB, voffB); PG8_STAGE(PG8_SB(0, 1), cB + hstepB, voffB); PG8_STAGE(PG8_SA(0, 0), cA, voffA); PG8_STAGE(PG8_SA(0, 1), cA + hstepA, voffA);
        if (wr == 1) PG8_BAR;
        PG8_WAIT_V(2); PG8_BAR;
        PG8_STAGE(PG8_SB(1, 0), cB + kstep, voffB); PG8_STAGE(PG8_SA(1, 0), cA + kstep, voffA); PG8_STAGE(PG8_SB(1, 1), cB + hstepB + kstep, voffB);
        PG8_WAIT_V(6); PG8_BAR;
    } else {
        PG8_STAGE(PG8_SB(0, 0), cB, voffB); PG8_STAGE(PG8_SA(0, 0), cA, voffA); PG8_STAGE(PG8_SB(0, 1), cB + hstepB, voffB); PG8_STAGE(PG8_SA(0, 1), cA + hstepA, voffA);
        if (wr == 1) PG8_BAR;
        PG8_WAIT_V(4); PG8_BAR;
        PG8_STAGE(PG8_SB(1, 0), cB + kstep, voffB); PG8_STAGE(PG8_SA(1, 0), cA + kstep, voffA); PG8_STAGE(PG8_SB(1, 1), cB + hstepB + kstep, voffB);
        PG8_WAIT_V(6); PG8_BAR;
    }
    for (;;) {
        const bool has_next = S.next(ui + 1, nxt);
        const char* nA = has_next ? (const char*)g.A + (size_t)nxt.pm * tstepA + (size_t)nxt.aoff * 2 : cA; const char* nB = has_next ? (const char*)g.Bt + (size_t)nxt.pn * tstepB : cB;
        for (int t = 0; t < nt; t += 2) {
            const bool last = (t == nt - 2);
            const char* a1 = cA + (size_t)(t + 1) * kstep;
            const char* a2 = last ? nA : cA + (size_t)(t + 2) * kstep; const char* b2 = last ? nB : cB + (size_t)(t + 2) * kstep;
            const char* a3 = a2 + kstep; const char* b3 = b2 + kstep;
            if constexpr (SP2) {
            PG8_LDB(B0, 0, 0); PG8_LDB(B1, 0, 1); PG8_SCHED; PG8_LDA(At, 0, 0); PG8_STAGE(PG8_SA(1, 1), a1 + hstepA, voffA);
            PG8_WAIT_V(8); PG8_WAIT_L(0); PG8_BAR; PG8_MMA(0, 0, At, B0); PG8_MMA(0, 1, At, B1); PG8_BAR; PG8_SCHED;
            PG8_LDA(At, 0, 1); PG8_STAGE(PG8_SB(0, 0), b2, voffB); PG8_STAGE(PG8_SB(0, 1), b2 + hstepB, voffB); PG8_STAGE(PG8_SA(0, 0), a2, voffA);
            PG8_WAIT_V(8); PG8_WAIT_L(0); PG8_BAR; PG8_MMA(1, 0, At, B0); PG8_MMA(1, 1, At, B1); PG8_BAR; PG8_SCHED;
            PG8_LDB(B0, 1, 0); PG8_LDB(B1, 1, 1); PG8_SCHED; PG8_LDA(At, 1, 0); PG8_STAGE(PG8_SA(0, 1), a2 + hstepA, voffA);
            PG8_WAIT_V(8); PG8_WAIT_L(0); PG8_BAR; PG8_MMA(0, 0, At, B0); PG8_MMA(0, 1, At, B1); PG8_BAR; PG8_SCHED;
            PG8_LDA(At, 1, 1); PG8_STAGE(PG8_SB(1, 0), b3, voffB); PG8_STAGE(PG8_SB(1, 1), b3 + hstepB, voffB); PG8_STAGE(PG8_SA(1, 0), a3, voffA);
            PG8_WAIT_V(8); PG8_WAIT_L(0); PG8_BAR; PG8_MMA(1, 0, At, B0); PG8_MMA(1, 1, At, B1); PG8_BAR; PG8_SCHED;
            } else {
            PG8_LDB(B0, 0, 0); PG8_SCHED; PG8_LDA(At, 0, 0); PG8_STAGE(PG8_SA(1, 1), a1 + hstepA, voffA);
            PG8_WAIT_L(8); PG8_BAR; PG8_WAIT_L(0); PG8_MMA(0, 0, At, B0); PG8_BAR; PG8_SCHED;
            PG8_LDB(B1, 0, 1); PG8_STAGE(PG8_SB(0, 0), b2, voffB);
            PG8_BAR; PG8_WAIT_L(0); PG8_MMA(0, 1, At, B1); PG8_BAR;
            PG8_LDA(At, 0, 1); PG8_STAGE(PG8_SA(0, 0), a2, voffA);
            PG8_BAR; PG8_WAIT_L(0); PG8_MMA(1, 0, At, B0); PG8_BAR; PG8_SCHED;
            PG8_STAGE(PG8_SB(0, 1), b2 + hstepB, voffB);
            PG8_WAIT_V(6); PG8_BAR; PG8_MMA(1, 1, At, B1); PG8_BAR;
            PG8_LDB(B0, 1, 0); PG8_SCHED; PG8_LDA(At, 1, 0); PG8_STAGE(PG8_SA(0, 1), a2 + hstepA, voffA);
            PG8_WAIT_L(8); PG8_BAR; PG8_WAIT_L(0); PG8_MMA(0, 0, At, B0); PG8_BAR; PG8_SCHED;
            PG8_LDB(B1, 1, 1); PG8_STAGE(PG8_SB(1, 0), b3, voffB);
            PG8_BAR; PG8_WAIT_L(0); PG8_MMA(0, 1, At, B1); PG8_BAR;
            PG8_LDA(At, 1, 1); PG8_STAGE(PG8_SA(1, 0), a3, voffA);
            PG8_BAR; PG8_WAIT_L(0); PG8_MMA(1, 0, At, B0); PG8_BAR; PG8_SCHED;
            PG8_STAGE(PG8_SB(1, 1), b3 + hstepB, voffB);
            PG8_WAIT_V(6); PG8_BAR; PG8_MMA(1, 1, At, B1); PG8_BAR;
            }
        }
        if constexpr (ALIGN_EPI) { if (wr == 0) PG8_BAR; }
        E(acc, cur, wr, wc, fr, fq);
        if (!has_next) break;
#pragma unroll
        for (int a = 0; a < 2; ++a)
#pragma unroll
            for (int b = 0; b < 2; ++b)
#pragma unroll
                for (int m = 0; m < 4; ++m)
#pragma unroll
                    for (int n = 0; n < 2; ++n) acc[a][b][m][n] = (f32x4){0.f, 0.f, 0.f, 0.f};
        cur = nxt; cA = nA; cB = nB; ++ui;
        if constexpr (ALIGN_EPI) { if (wr == 1) PG8_BAR; }
    }
    PG8_WAIT_V(0);
    if constexpr (!ALIGN_EPI) { if (wr == 0) PG8_BAR; }
    PG8_BAR;
#undef PG8_SA
#undef PG8_SB
#undef PG8_STAGE
#undef PG8_LDA
#undef PG8_LDB
#undef PG8_MMA
#undef PG8_WAIT_V
#undef PG8_WAIT_L
#undef PG8_BAR
#undef PG8_SCHED
}
}


#define LDS_BARRIER() do { asm volatile("s_waitcnt lgkmcnt(0)" ::: "memory"); __builtin_amdgcn_s_barrier(); asm volatile("" ::: "memory"); } while (0)
namespace ml {
#define LAS __attribute__((address_space(3)))
typedef short bf16x8 __attribute__((ext_vector_type(8)));
typedef float f32x4 __attribute__((ext_vector_type(4)));
typedef unsigned u32x4 __attribute__((ext_vector_type(4)));
constexpr int NVB = 4, EV = MD / NVB;
constexpr int PQ = 272, PT = 144;
constexpr int L_QS = 0, L_KS = L_QS + 64 * PQ, L_KT = L_KS + 64 * PQ, L_VT = L_KT + 128 * PT, L_SB = L_VT + 48 * PT, L_CT = L_SB + 64 * PT,
              L_HS = L_CT + 48 * PQ, L_SC = L_HS + 64 * 80, L_END = L_SC + 4096;
static_assert(L_END <= 131072, "mLSTM LDS map");
enum { SC_A = 0, SC_PM = 64, SC_WI = 128, SC_EMT = 192, SC_WE = 256, SC_DEN = 320, SC_MISC = 384 };
__device__ __forceinline__ f32x4 mma(bf16x8 a, bf16x8 b, f32x4 c) { return __builtin_amdgcn_mfma_f32_16x16x32_bf16(a, b, c, 0, 0, 0); }
__device__ __forceinline__ bf16x8 frag(LAS unsigned char* lds, int base, int pitch, int row0, int k0, int lane) {
    return *(const LAS bf16x8*)(lds + base + (row0 + (lane & 15)) * pitch + (k0 + 8 * (lane >> 4)) * 2);
}
template <int N> __device__ __forceinline__ float dpp_row_shr(float x, float ident) {
    return __builtin_bit_cast(float, __builtin_amdgcn_update_dpp(__builtin_bit_cast(int, ident), __builtin_bit_cast(int, x), 0x110 + N, 0xf, 0xf, false));
}
__device__ __forceinline__ float lane_get(float x, int l) { return __builtin_bit_cast(float, __builtin_amdgcn_readlane(__builtin_bit_cast(int, x), l)); }
__device__ __forceinline__ float wave_scan_add(float x, int lane) {
    x += dpp_row_shr<1>(x, 0.f); x += dpp_row_shr<2>(x, 0.f); x += dpp_row_shr<4>(x, 0.f); x += dpp_row_shr<8>(x, 0.f);
    const float t0 = lane_get(x, 15), t1 = lane_get(x, 31), t2 = lane_get(x, 47); const int row = lane >> 4;
    return x + ((row >= 1 ? t0 : 0.f) + (row >= 2 ? t1 : 0.f) + (row >= 3 ? t2 : 0.f));
}
__device__ __forceinline__ float wave_scan_max(float x, int lane) {
    constexpr float NI = -3.0e38f;
    x = fmaxf(x, dpp_row_shr<1>(x, NI)); x = fmaxf(x, dpp_row_shr<2>(x, NI)); x = fmaxf(x, dpp_row_shr<4>(x, NI)); x = fmaxf(x, dpp_row_shr<8>(x, NI));
    const float t0 = lane_get(x, 15), t1 = lane_get(x, 31), t2 = lane_get(x, 47); const int row = lane >> 4;
    return fmaxf(fmaxf(x, row >= 1 ? t0 : NI), fmaxf(row >= 2 ? t1 : NI, row >= 3 ? t2 : NI));
}
__device__ __forceinline__ void mlstm_item(LAS unsigned char* lds, CParams& P, int l, int s, int head, int dir, int vb) {
    const int tid = threadIdx.x, w = __builtin_amdgcn_readfirstlane(tid >> 6), lane = tid & 63, fr = lane & 15, fq = lane >> 4;
    const int rt = w & 3, half = w >> 2;
    const SeqInfo q = seqinfo(s); const int nchunk = q.T / 64;
    const bf16* QK = WSP(bf16, WS_QKC); bf16* U = WSP(bf16, WS_U1);
    LAS float* SC = (LAS float*)(lds + L_SC);
    f32x4 cacc[3];
    float m_prev;
    if (!q.grid) { cacc[0] = cacc[1] = cacc[2] = (f32x4){0.f, 0.f, 0.f, 0.f}; m_prev = 0.f; }
    else {
        const size_t sb = (((size_t)q.b * DEPTH + l) * 2 + dir) * MH + head; const int d = 16 * w + fr;
#pragma unroll
        for (int et = 0; et < 2; ++et)
#pragma unroll
            for (int r = 0; r < 4; ++r) cacc[et][r] = P.in[ST_C][(sb * 128 + d) * 128 + vb * EV + 16 * et + 4 * fq + r];
        cacc[2] = (f32x4){0.f, 0.f, 0.f, 0.f}; if (fq == 0) cacc[2][0] = P.in[ST_N][sb * 128 + d];
        m_prev = P.in[ST_M][sb];
    }
    const float bi = P.in[M_GATE_B][(size_t)l * 4 * MH + (2 * dir) * MH + head], bfg = P.in[M_GATE_B][(size_t)l * 4 * MH + (2 * dir + 1) * MH + head];
    for (int i = tid; i < 16 * 64; i += 512) { const int r = i >> 6, c = i & 63; *(LAS bf16*)(lds + L_VT + (32 + r) * PT + c * 2) = (r == 0) ? (bf16)0x3f80 : (bf16)0; }
    u32x4 pqk[4]; u32x4 pv; bf16 pgi = 0, pgf = 0;
#define ML_TOK(c, j) ((size_t)(q.base + (dir ? q.T - 1 - ((c) * 64 + (j)) : ((c) * 64 + (j)))))
#define ML_PREFETCH(c) do { _Pragma("unroll") for (int i = 0; i < 4; ++i) { const int id = tid + 512 * i, j = id >> 5, pc = id & 31; \
            pqk[i] = *(const u32x4*)(QK + ML_TOK(c, j) * (2 * MW) + (pc < 16 ? head * 128 + 8 * pc : MW + head * 128 + 8 * (pc - 16))); } \
        if (tid < 256) { const int j = tid >> 2, pc = tid & 3; pv = *(const u32x4*)(U + ML_TOK(c, j) * PU + OFF_V + head * 128 + vb * EV + 8 * pc); } \
        if (w == 0) { const bf16* g = U + ML_TOK(c, lane) * PU + OFF_G; pgi = g[(2 * dir) * MH + head]; pgf = g[(2 * dir + 1) * MH + head]; } } while (0)
    ML_PREFETCH(0);
    for (int c = 0; c < nchunk; ++c) {
#pragma unroll
        for (int i = 0; i < 4; ++i) { const int id = tid + 512 * i, j = id >> 5, pc = id & 31;
            *(LAS u32x4*)(lds + (pc < 16 ? L_QS : L_KS) + j * PQ + (pc & 15) * 16) = pqk[i]; }
        if (tid < 256) { const int j = tid >> 2, pc = tid & 3; const unsigned wv[4] = {pv.x, pv.y, pv.z, pv.w};
#pragma unroll
            for (int e = 0; e < 8; ++e) *(LAS bf16*)(lds + L_VT + (8 * pc + e) * PT + j * 2) = (bf16)((wv[e >> 1] >> ((e & 1) * 16)) & 0xffffu); }
#pragma unroll
        for (int et = 0; et < 3; ++et)
#pragma unroll
            for (int r = 0; r < 4; ++r) *(LAS bf16*)(lds + L_CT + (16 * et + 4 * fq + r) * PQ + (16 * w + fr) * 2) = f2bf(cacc[et][r]);
        float wie = 1.f;
        if (w == 0) {
            const float gi = bf2f(pgi) + bi, gf = bf2f(pgf) + bfg;
            const float lf = fminf(gf, 0.f) - log1pf(__expf(-fabsf(gf)));
            const float b = wave_scan_add(lf, lane);
            const float a = gi - b; float pm = wave_scan_max(a, lane);
            pm = fmaxf(pm, m_prev);
            const float pm63 = lane_get(pm, 63), b63 = lane_get(b, 63);
            SC[SC_A + lane] = a; SC[SC_PM + lane] = pm; SC[SC_WI + lane] = __expf(m_prev - pm); SC[SC_EMT + lane] = __expf(-(b + pm)); SC[SC_WE + lane] = __expf(a - pm63);
            if (lane == 0) { SC[SC_MISC] = __expf(m_prev - pm63); SC[SC_MISC + 1] = b63 + pm63; }
        }
        LDS_BARRIER();
        if (c + 1 < nchunk) ML_PREFETCH(c + 1);
        wie = SC[SC_MISC]; m_prev = SC[SC_MISC + 1];
#pragma unroll
        for (int i = 0; i < 2; ++i) { const int id = tid + 512 * i, j = id & 63, pc = id >> 6; const float we = SC[SC_WE + j];
            const u32x4 kv = *(const LAS u32x4*)(lds + L_KS + j * PQ + pc * 16); const unsigned wv[4] = {kv.x, kv.y, kv.z, kv.w};
#pragma unroll
            for (int e = 0; e < 8; ++e) { const float kf = __builtin_bit_cast(float, (e & 1) ? (wv[e >> 1] & 0xffff0000u) : (wv[e >> 1] << 16));
                *(LAS bf16*)(lds + L_KT + (8 * pc + e) * PT + j * 2) = f2bf(kf * we); } }
#pragma unroll
        for (int cc = 0; cc < 2; ++cc) { const int ct = 2 * half + cc;
            f32x4 acc = (f32x4){0.f, 0.f, 0.f, 0.f};
            if (ct <= rt) {
#pragma unroll
                for (int k = 0; k < 4; ++k) acc = mma(frag(lds, L_QS, PQ, 16 * rt, 32 * k, lane), frag(lds, L_KS, PQ, 16 * ct, 32 * k, lane), acc);
            }
            const int sp = 16 * ct + fr; const float as = SC[SC_A + sp];
#pragma unroll
            for (int r = 0; r < 4; ++r) { const int t = 16 * rt + 4 * fq + r; const float v = (sp <= t) ? acc[r] * __expf(as - SC[SC_PM + t]) : 0.f;
                *(LAS bf16*)(lds + L_SB + t * PT + sp * 2) = f2bf(v); } }
        LDS_BARRIER();
        f32x4 nacc[2]; const int nct = half ? 1 : 2;
#pragma unroll
        for (int cc = 0; cc < 2; ++cc) { if (cc < nct) { const int ct = half ? 2 : cc;
            f32x4 a1 = (f32x4){0.f, 0.f, 0.f, 0.f}, a2 = (f32x4){0.f, 0.f, 0.f, 0.f};
#pragma unroll
            for (int k = 0; k < 2; ++k) a1 = mma(frag(lds, L_SB, PT, 16 * rt, 32 * k, lane), frag(lds, L_VT, PT, 16 * ct, 32 * k, lane), a1);
#pragma unroll
            for (int k = 0; k < 4; ++k) a2 = mma(frag(lds, L_QS, PQ, 16 * rt, 32 * k, lane), frag(lds, L_CT, PQ, 16 * ct, 32 * k, lane), a2);
#pragma unroll
            for (int r = 0; r < 4; ++r) a1[r] += SC[SC_WI + 16 * rt + 4 * fq + r] * a2[r];
            nacc[cc] = a1; } }
        if (half && fr == 0) {
#pragma unroll
            for (int r = 0; r < 4; ++r) SC[SC_DEN + 16 * rt + 4 * fq + r] = nacc[0][r];
        }
#pragma unroll
        for (int et = 0; et < 3; ++et) { cacc[et] = cacc[et] * wie;
#pragma unroll
            for (int k = 0; k < 2; ++k) cacc[et] = mma(frag(lds, L_VT, PT, 16 * et, 32 * k, lane), frag(lds, L_KT, PT, 16 * w, 32 * k, lane), cacc[et]); }
        LDS_BARRIER();
        if (!half) {
#pragma unroll
            for (int cc = 0; cc < 2; ++cc)
#pragma unroll
                for (int r = 0; r < 4; ++r) { const int t = 16 * rt + 4 * fq + r; const float den = fmaxf(fabsf(SC[SC_DEN + t]), SC[SC_EMT + t]);
                    *(LAS bf16*)(lds + L_HS + t * 80 + (16 * cc + fr) * 2) = f2bf(nacc[cc][r] * __builtin_amdgcn_rcpf(den)); }
        }
        LDS_BARRIER();
        if (tid < 256) { const int j = tid >> 2, pc = tid & 3;
            *(u32x4*)(U + ML_TOK(c, j) * PU + dir * MW + head * 128 + vb * EV + 8 * pc) = *(const LAS u32x4*)(lds + L_HS + j * 80 + pc * 16); }
    }
    if (!q.grid) {
        const size_t sb = (((size_t)q.b * DEPTH + l) * 2 + dir) * MH + head; const int d = 16 * w + fr;
#pragma unroll
        for (int et = 0; et < 2; ++et)
#pragma unroll
            for (int r = 0; r < 4; ++r) P.out[OUT_C + (sb * 128 + d) * 128 + vb * EV + 16 * et + 4 * fq + r] = cacc[et][r];
        if (vb == 0) { if (fq == 0) P.out[OUT_N + sb * 128 + d] = cacc[2][0]; if (tid == 0) P.out[OUT_M + sb] = m_prev; }
    }
    LDS_BARRIER();
#undef ML_TOK
#undef ML_PREFETCH
}
constexpr int M_QS = 0, M_KS = M_QS + 2 * 64 * PQ, M_KT = M_KS + 64 * PQ, M_VT = M_KT + 128 * PT, M_SB = M_VT + 2 * 48 * PT, M_CT = M_SB + 64 * PT, M_HS = M_CT + 48 * PQ, M_SC = M_HS + 64 * 80, M_END = M_SC + 2 * 4096;
static_assert(M_END <= 131072, "pipelined mLSTM LDS map");
__device__ __forceinline__ void mlstm_item2(LAS unsigned char* lds, CParams& P, int l, int s, int head, int dir, int vb) {
    const int tid = threadIdx.x, w = __builtin_amdgcn_readfirstlane(tid >> 6), lane = tid & 63, fr = lane & 15, fq = lane >> 4;
    const int rt = w & 3, half = w >> 2;
    const SeqInfo q = seqinfo(s); const int nchunk = q.T / 64;
    const bf16* QK = WSP(bf16, WS_QKC); bf16* U = WSP(bf16, WS_U1);
    f32x4 cacc[3];
    float m_prev;
    const size_t sb = (((size_t)q.b * DEPTH + l) * 2 + dir) * MH + head;
    if (!q.grid) { cacc[0] = cacc[1] = cacc[2] = (f32x4){0.f, 0.f, 0.f, 0.f}; m_prev = 0.f; }
    else {
        const int d = 16 * w + fr;
#pragma unroll
        for (int et = 0; et < 2; ++et)
#pragma unroll
            for (int r = 0; r < 4; ++r) cacc[et][r] = P.in[ST_C][(sb * 128 + d) * 128 + vb * EV + 16 * et + 4 * fq + r];
        cacc[2] = (f32x4){0.f, 0.f, 0.f, 0.f}; if (fq == 0) cacc[2][0] = P.in[ST_N][sb * 128 + d];
        m_prev = P.in[ST_M][sb];
    }
    const float bi = P.in[M_GATE_B][(size_t)l * 4 * MH + (2 * dir) * MH + head], bfg = P.in[M_GATE_B][(size_t)l * 4 * MH + (2 * dir + 1) * MH + head];
    for (int i = tid; i < 2 * 16 * 64; i += 512) { const int b = i >> 10, r = (i >> 6) & 15, c = i & 63; *(LAS bf16*)(lds + M_VT + b * 48 * PT + (32 + r) * PT + c * 2) = (r == 0) ? (bf16)0x3f80 : (bf16)0; }
    u32x4 pqk[4]; u32x4 pv; bf16 pgi = 0, pgf = 0;
#define ML_TOK(c, j) ((size_t)(q.base + (dir ? q.T - 1 - ((c) * 64 + (j)) : ((c) * 64 + (j)))))
#define ML_PREFETCH(c) do { _Pragma("unroll") for (int i = 0; i < 4; ++i) { const int id = tid + 512 * i, j = id >> 5, pc = id & 31; \
            pqk[i] = *(const u32x4*)(QK + ML_TOK(c, j) * (2 * MW) + (pc < 16 ? head * 128 + 8 * pc : MW + head * 128 + 8 * (pc - 16))); } \
        if (tid < 256) { const int j = tid >> 2, pc = tid & 3; pv = *(const u32x4*)(U + ML_TOK(c, j) * PU + OFF_V + head * 128 + vb * EV + 8 * pc); } \
        if (w == 4) { const bf16* g = U + ML_TOK(c, lane) * PU + OFF_G; pgi = g[(2 * dir) * MH + head]; pgf = g[(2 * dir + 1) * MH + head]; } } while (0)
#define ML_STAGE_A(pb) do { \
        _Pragma("unroll") for (int i = 0; i < 4; ++i) { const int id = tid + 512 * i, j = id >> 5, pc = id & 31; \
            *(LAS u32x4*)(lds + (pc < 16 ? M_QS + (pb) * 64 * PQ : M_KS) + j * PQ + (pc & 15) * 16) = pqk[i]; } \
        if (tid < 256) { const int j = tid >> 2, pc = tid & 3; const unsigned wv[4] = {pv.x, pv.y, pv.z, pv.w}; \
            _Pragma("unroll") for (int e = 0; e < 8; ++e) *(LAS bf16*)(lds + M_VT + (pb) * 48 * PT + (8 * pc + e) * PT + j * 2) = (bf16)((wv[e >> 1] >> ((e & 1) * 16)) & 0xffffu); } \
        if (w == 4) { LAS float* SCn = (LAS float*)(lds + M_SC + (pb) * 4096); \
            const float gi = bf2f(pgi) + bi, gf = bf2f(pgf) + bfg; \
            const float lf = fminf(gf, 0.f) - log1pf(__expf(-fabsf(gf))); \
            const float b = wave_scan_add(lf, lane); \
            const float a = gi - b; float pm = wave_scan_max(a, lane); \
            pm = fmaxf(pm, m_prev); \
            const float pm63 = lane_get(pm, 63), b63 = lane_get(b, 63); \
            SCn[SC_A + lane] = a; SCn[SC_PM + lane] = pm; SCn[SC_WI + lane] = __expf(m_prev - pm); SCn[SC_EMT + lane] = __expf(-(b + pm)); SCn[SC_WE + lane] = __expf(a - pm63); \
            if (lane == 0) SCn[SC_MISC] = __expf(m_prev - pm63); \
            m_prev = b63 + pm63; } } while (0)
#define ML_STAGE_D(pb) do { const LAS float* SCn = (const LAS float*)(lds + M_SC + (pb) * 4096); \
        _Pragma("unroll") for (int i = 0; i < 2; ++i) { const int id = tid + 512 * i, j = id & 63, pc = id >> 6; const float we = SCn[SC_WE + j]; \
            const u32x4 kv = *(const LAS u32x4*)(lds + M_KS + j * PQ + pc * 16); const unsigned wv[4] = {kv.x, kv.y, kv.z, kv.w}; \
            _Pragma("unroll") for (int e = 0; e < 8; ++e) { const float kf = __builtin_bit_cast(float, (e & 1) ? (wv[e >> 1] & 0xffff0000u) : (wv[e >> 1] << 16)); \
                *(LAS bf16*)(lds + M_KT + (8 * pc + e) * PT + j * 2) = f2bf(kf * we); } } \
        _Pragma("unroll") for (int cc = 0; cc < 2; ++cc) { const int ct = 2 * half + cc; \
            f32x4 acc = (f32x4){0.f, 0.f, 0.f, 0.f}; \
            if (ct <= rt) { \
                _Pragma("unroll") for (int k = 0; k < 4; ++k) acc = mma(frag(lds, M_QS + (pb) * 64 * PQ, PQ, 16 * rt, 32 * k, lane), frag(lds, M_KS, PQ, 16 * ct, 32 * k, lane), acc); } \
            const int sp = 16 * ct + fr; const float as = SCn[SC_A + sp]; \
            _Pragma("unroll") for (int r = 0; r < 4; ++r) { const int t = 16 * rt + 4 * fq + r; const float v = (sp <= t) ? acc[r] * __expf(as - SCn[SC_PM + t]) : 0.f; \
                *(LAS bf16*)(lds + M_SB + t * PT + sp * 2) = f2bf(v); } } \
        _Pragma("unroll") for (int et = 0; et < 3; ++et) \
            _Pragma("unroll") for (int r = 0; r < 4; ++r) *(LAS bf16*)(lds + M_CT + (16 * et + 4 * fq + r) * PQ + (16 * w + fr) * 2) = f2bf(cacc[et][r]); } while (0)
#define ML_STORE(c) do { if (tid < 256) { const int j = tid >> 2, pc = tid & 3; \
            *(u32x4*)(U + ML_TOK(c, j) * PU + dir * MW + head * 128 + vb * EV + 8 * pc) = *(const LAS u32x4*)(lds + M_HS + j * 80 + pc * 16); } } while (0)
    ML_PREFETCH(0);
    ML_STAGE_A(0);
    LDS_BARRIER();
    if (nchunk > 1) ML_PREFETCH(1);
    ML_STAGE_D(0);
    LDS_BARRIER();
    for (int c = 0; c < nchunk; ++c) {
        const int pb = c & 1;
        if (c + 1 < nchunk) { ML_STAGE_A(pb ^ 1); if (c + 2 < nchunk) ML_PREFETCH(c + 2); }
        if (c >= 1) ML_STORE(c - 1);
        LAS float* SC = (LAS float*)(lds + M_SC + pb * 4096);
        const float wie = SC[SC_MISC];
        f32x4 nacc[2]; const int nct = half ? 1 : 2;
#pragma unroll
        for (int cc = 0; cc < 2; ++cc) { if (cc < nct) { const int ct = half ? 2 : cc;
            f32x4 a1 = (f32x4){0.f, 0.f, 0.f, 0.f}, a2 = (f32x4){0.f, 0.f, 0.f, 0.f};
#pragma unroll
            for (int k = 0; k < 2; ++k) a1 = mma(frag(lds, M_SB, PT, 16 * rt, 32 * k, lane), frag(lds, M_VT + pb * 48 * PT, PT, 16 * ct, 32 * k, lane), a1);
#pragma unroll
            for (int k = 0; k < 4; ++k) a2 = mma(frag(lds, M_QS + pb * 64 * PQ, PQ, 16 * rt, 32 * k, lane), frag(lds, M_CT, PQ, 16 * ct, 32 * k, lane), a2);
#pragma unroll
            for (int r = 0; r < 4; ++r) a1[r] += SC[SC_WI + 16 * rt + 4 * fq + r] * a2[r];
            nacc[cc] = a1; } }
        if (half && fr == 0) {
#pragma unroll
            for (int r = 0; r < 4; ++r) SC[SC_DEN + 16 * rt + 4 * fq + r] = nacc[0][r];
        }
#pragma unroll
        for (int et = 0; et < 3; ++et) { cacc[et] = cacc[et] * wie;
#pragma unroll
            for (int k = 0; k < 2; ++k) cacc[et] = mma(frag(lds, M_VT + pb * 48 * PT, PT, 16 * et, 32 * k, lane), frag(lds, M_KT, PT, 16 * w, 32 * k, lane), cacc[et]); }
        LDS_BARRIER();
        if (!half) {
#pragma unroll
            for (int cc = 0; cc < 2; ++cc)
#pragma unroll
                for (int r = 0; r < 4; ++r) { const int t = 16 * rt + 4 * fq + r; const float den = fmaxf(fabsf(SC[SC_DEN + t]), SC[SC_EMT + t]);
                    *(LAS bf16*)(lds + M_HS + t * 80 + (16 * cc + fr) * 2) = f2bf(nacc[cc][r] * __builtin_amdgcn_rcpf(den)); }
        }
        if (c + 1 < nchunk) ML_STAGE_D(pb ^ 1);
        LDS_BARRIER();
    }
    ML_STORE(nchunk - 1);
    if (!q.grid) {
        const int d = 16 * w + fr;
#pragma unroll
        for (int et = 0; et < 2; ++et)
#pragma unroll
            for (int r = 0; r < 4; ++r) P.out[OUT_C + (sb * 128 + d) * 128 + vb * EV + 16 * et + 4 * fq + r] = cacc[et][r];
        if (vb == 0) { if (fq == 0) P.out[OUT_N + sb * 128 + d] = cacc[2][0]; if (tid == 256) P.out[OUT_M + sb] = m_prev; }
    }
    LDS_BARRIER();
#undef ML_TOK
#undef ML_PREFETCH
#undef ML_STAGE_A
#undef ML_STAGE_D
#undef ML_STORE
}
constexpr int N_ITEMS = NSEQ * MH * 2 * NVB;
__device__ __forceinline__ void decode_item(int it, int& s, int& head, int& dir, int& vb) {
    vb = it % NVB; int ch = it / NVB; dir = ch & 1; ch >>= 1; head = ch % MH; const int sq = ch / MH;
    s = sq < LB ? CB + sq : sq - LB;
}
}


namespace rw {
typedef short bf16x8 __attribute__((ext_vector_type(8)));
typedef float f32x4 __attribute__((ext_vector_type(4)));
typedef unsigned u32x4 __attribute__((ext_vector_type(4)));
enum { V_A = 0, V_W, V_B, V_K, V_R, NVEC };
constexpr int REC = NVEC * 64 * 4;
constexpr int PT = 144;
constexpr int L_SBUF = 0, L_VT = L_SBUF + 64 * REC, L_TW = L_VT + 64 * 256, L_AL = L_TW + 64 * PT, L_YS = L_AL + 64 * PT, L_INV = L_YS + 64 * 16 * 4, L_END = L_INV + 256;
__device__ __forceinline__ int vt_off(int row, int tt) { return row * 256 + ((tt ^ (((row >> 3) & 7) << 2)) << 2); }
static_assert(L_END <= 131072, "RWKV LDS map");
__device__ __forceinline__ float dpp_xor1(float x) { return __builtin_bit_cast(float, __builtin_amdgcn_update_dpp(0, __builtin_bit_cast(int, x), 0xB1, 0xF, 0xF, true)); }
__device__ __forceinline__ float dpp_xor2(float x) { return __builtin_bit_cast(float, __builtin_amdgcn_update_dpp(0, __builtin_bit_cast(int, x), 0x4E, 0xF, 0xF, true)); }
__device__ __forceinline__ float dpp_ror4(float x) { return __builtin_bit_cast(float, __builtin_amdgcn_update_dpp(0, __builtin_bit_cast(int, x), 0x124, 0xF, 0xF, true)); }
__device__ __forceinline__ float dpp_ror8(float x) { return __builtin_bit_cast(float, __builtin_amdgcn_update_dpp(0, __builtin_bit_cast(int, x), 0x128, 0xF, 0xF, true)); }
__device__ __forceinline__ float allsum16(float x) { x += dpp_xor1(x); x += dpp_xor2(x); x += dpp_ror4(x); x += dpp_ror8(x); return x; }
__device__ __forceinline__ f32x4 cvt_lo4(unsigned a, unsigned b) { return (f32x4){__builtin_bit_cast(float, a << 16), __builtin_bit_cast(float, a & 0xffff0000u), __builtin_bit_cast(float, b << 16), __builtin_bit_cast(float, b & 0xffff0000u)}; }
__device__ __forceinline__ float allsum32(float x) {
    x = allsum16(x);
    float xa = x, xb = x;
    asm volatile("v_mov_b32 %1, %0\n\ts_nop 1\n\tv_permlane32_swap_b32 %0, %1\n\ts_nop 1" : "+v"(xa), "=&v"(xb));
    return xa + xb;
}
__device__ __forceinline__ void rwkv_item(LAS unsigned char* lds, CParams& P, int l, int s, int head, int dir, int rh) {
    const int tid = threadIdx.x, w = __builtin_amdgcn_readfirstlane(tid >> 6), lane = tid & 63, fr = lane & 15, fq = lane >> 4;
    const int rt = w & 3, half = w >> 2, hc = head * 64;
    const SeqInfo q = seqinfo(s); const int nchunk = q.T / 64;
    const bf16* RX = WSP(bf16, WS_RXC); bf16* U = WSP(bf16, WS_U1);
    const int pj = tid >> 3, psub = tid & 7;
    const int hh = lane >> 5, rsel = (lane >> 4) & 1, cg = lane & 15;
    const int row = 16 * rh + 2 * w + rsel, col0 = 32 * hh + 2 * cg;
    typedef float f32x2 __attribute__((ext_vector_type(2)));
    f32x2 S2;
    if (!q.grid) S2 = (f32x2){0.f, 0.f};
    else { const size_t sb = (((size_t)q.b * DEPTH + l) * 2 + dir) * RH + head; S2 = *(const f32x2*)(P.in[ST_R] + (sb * 64 + row) * 64 + col0); }
    float rkk8[8];
#pragma unroll
    for (int e = 0; e < 8; ++e) rkk8[e] = P.in[R_KK][(size_t)l * RW + hc + 8 * psub + e];
    float c_w0[2], c_a0[2], c_kk[2], c_ka[2];
    bf16x8 bw[2][2], ba[2][2];
#pragma unroll
    for (int cc = 0; cc < 2; ++cc) { const int c = 16 * (2 * half + cc) + fr;
        c_w0[cc] = P.in[R_W0][((size_t)l * 2 + dir) * RW + hc + c]; c_a0[cc] = P.in[R_A0][((size_t)l * 2 + dir) * RW + hc + c];
        c_kk[cc] = P.in[R_KK][(size_t)l * RW + hc + c]; c_ka[cc] = P.in[R_KA][(size_t)l * RW + hc + c];
#pragma unroll
        for (int ks = 0; ks < 2; ++ks)
#pragma unroll
            for (int e = 0; e < 8; ++e) { const int j = 32 * ks + 8 * fq + e;
                bw[cc][ks][e] = (short)f2bf(P.in[R_W2][(((size_t)l * 2 + dir) * 64 + j) * RW + hc + c]);
                ba[cc][ks][e] = (short)f2bf(P.in[R_A2][(((size_t)l * 2 + dir) * 64 + j) * RW + hc + c]); } }
    u32x4 pf[5];
#define RW_TOK(c, j) ((size_t)(q.base + (dir ? q.T - 1 - ((c) * 64 + (j)) : ((c) * 64 + (j)))))
#define RW_PREFETCH(c) do { const bf16* rx = RX + RW_TOK(c, pj) * RIN + 8 * psub; \
        pf[0] = *(const u32x4*)(rx + RX_R + hc); pf[1] = *(const u32x4*)(rx + RX_K + hc); pf[2] = *(const u32x4*)(rx + RX_V + hc); \
        pf[3] = *(const u32x4*)(rx + RX_WL + dir * 64); pf[4] = *(const u32x4*)(rx + RX_AL + dir * 64); } while (0)
    RW_PREFETCH(0);
    for (int c = 0; c < nchunk; ++c) {
        { LAS unsigned char* rec = lds + L_SBUF + pj * REC + psub * 32;
          *(LAS f32x4*)(rec + V_R * 256) = cvt_lo4(pf[0].x, pf[0].y); *(LAS f32x4*)(rec + V_R * 256 + 16) = cvt_lo4(pf[0].z, pf[0].w);
          { const f32x4 v0 = cvt_lo4(pf[2].x, pf[2].y), v1 = cvt_lo4(pf[2].z, pf[2].w);
#pragma unroll
            for (int e = 0; e < 4; ++e) { *(LAS float*)(lds + L_VT + vt_off(8 * psub + e, pj)) = v0[e]; *(LAS float*)(lds + L_VT + vt_off(8 * psub + 4 + e, pj)) = v1[e]; } }
          const f32x4 k0 = cvt_lo4(pf[1].x, pf[1].y), k1 = cvt_lo4(pf[1].z, pf[1].w);
          *(LAS f32x4*)(rec + V_K * 256) = k0; *(LAS f32x4*)(rec + V_K * 256 + 16) = k1;
          float ss = 0.f;
#pragma unroll
          for (int e = 0; e < 4; ++e) { const float x0 = k0[e] * rkk8[e], x1 = k1[e] * rkk8[4 + e]; ss += x0 * x0 + x1 * x1; }
          ss += dpp_xor1(ss); ss += dpp_xor2(ss); ss += __shfl_xor(ss, 4);
          if (psub == 0) *(LAS float*)(lds + L_INV + pj * 4) = 1.0f / fmaxf(sqrtf(ss), 1e-12f);
          *(LAS u32x4*)(lds + L_TW + pj * PT + psub * 16) = pf[3]; *(LAS u32x4*)(lds + L_AL + pj * PT + psub * 16) = pf[4]; }
        __syncthreads();
        if (c + 1 < nchunk) RW_PREFETCH(c + 1);
#pragma unroll
        for (int cc = 0; cc < 2; ++cc) { const int ct = 2 * half + cc; const int cidx = 16 * ct + fr;
            f32x4 aw = (f32x4){0.f, 0.f, 0.f, 0.f}, aa = (f32x4){0.f, 0.f, 0.f, 0.f};
#pragma unroll
            for (int ks = 0; ks < 2; ++ks) { aw = ml::mma(ml::frag(lds, L_TW, PT, 16 * rt, 32 * ks, lane), bw[cc][ks], aw); aa = ml::mma(ml::frag(lds, L_AL, PT, 16 * rt, 32 * ks, lane), ba[cc][ks], aa); }
#pragma unroll
            for (int r = 0; r < 4; ++r) { const int tok = 16 * rt + 4 * fq + r; LAS float* rec = (LAS float*)(lds + L_SBUF + tok * REC) + cidx;
                const float decay = __expf(-0.6065306597126334f * pg8::fsigmoid(c_w0[cc] + aw[r])); const float alpha = pg8::fsigmoid(c_a0[cc] + aa[r]);
                const float kraw = rec[V_K * 64]; const float kkn = kraw * c_kk[cc] * *(LAS float*)(lds + L_INV + tok * 4);
                rec[V_A * 64] = -kkn; rec[V_W * 64] = decay; rec[V_B * 64] = kkn * alpha; rec[V_K * 64] = kraw * (1.0f + (alpha - 1.0f) * c_ka[cc]); } }
        __syncthreads();
        {
            const LAS unsigned char* rbase = lds + L_SBUF + col0 * 4;
            f32x2 ca = *(const LAS f32x2*)(rbase + V_A * 256), cw = *(const LAS f32x2*)(rbase + V_W * 256), cb = *(const LAS f32x2*)(rbase + V_B * 256),
                  ck = *(const LAS f32x2*)(rbase + V_K * 256), cr = *(const LAS f32x2*)(rbase + V_R * 256);
#pragma unroll 1
            for (int blk = 0; blk < 4; ++blk) {
                float ykeep = 0.f;
#pragma unroll
                for (int g4 = 0; g4 < 4; ++g4) {
                    const f32x4 v4 = *(const LAS f32x4*)(lds + L_VT + vt_off(row, 16 * blk + 4 * g4));
#pragma unroll
                    for (int i4 = 0; i4 < 4; ++i4) {
                        const int i = 4 * g4 + i4, tt = 16 * blk + i, tn = tt < 63 ? tt + 1 : 63;
                        const LAS unsigned char* rn = rbase + tn * REC;
                        const f32x2 na = *(const LAS f32x2*)(rn + V_A * 256), nw = *(const LAS f32x2*)(rn + V_W * 256), nb = *(const LAS f32x2*)(rn + V_B * 256),
                                    nk = *(const LAS f32x2*)(rn + V_K * 256), nr = *(const LAS f32x2*)(rn + V_R * 256);
                        const float vv = v4[i4];
                        const f32x2 p = S2 * ca;
                        const float sa = allsum32(p.x + p.y);
                        S2 = S2 * cw + ck * vv;
                        S2 = cb * sa + S2;
                        const f32x2 yq = S2 * cr;
                        const float y = allsum32(yq.x + yq.y);
                        ykeep = (cg == i) ? y : ykeep;
                        ca = na; cw = nw; cb = nb; ck = nk; cr = nr;
                    }
                }
                if (hh == 0) *(LAS float*)(lds + L_YS + ((16 * blk + cg) * 16 + 2 * w + rsel) * 4) = ykeep;
            }
        }
        __syncthreads();
        if (tid < 128) { const int j = tid >> 1, pc = tid & 1; const LAS float* ys = (const LAS float*)(lds + L_YS) + j * 16 + 8 * pc;
            u32x4 o; o.x = pg8::cvt_pk_bf16(ys[0], ys[1]); o.y = pg8::cvt_pk_bf16(ys[2], ys[3]); o.z = pg8::cvt_pk_bf16(ys[4], ys[5]); o.w = pg8::cvt_pk_bf16(ys[6], ys[7]);
            *(u32x4*)(U + RW_TOK(c, j) * PU + OFF_R + dir * RW + hc + 16 * rh + 8 * pc) = o; }
    }
    if (!q.grid) { const size_t sb = (((size_t)q.b * DEPTH + l) * 2 + dir) * RH + head; *(f32x2*)(P.out + OUT_S + (sb * 64 + row) * 64 + col0) = S2; }
    __syncthreads();
#undef RW_TOK
#undef RW_PREFETCH
}
constexpr int N_ITEMS = NSEQ * RH * 2 * 4;
__device__ __forceinline__ void decode_item(int it, int& s, int& head, int& dir, int& rh) {
    rh = it & 3; int ch = it >> 2; dir = ch & 1; ch >>= 1; head = ch % RH; const int sq = ch / RH;
    s = sq < LB ? CB + sq : sq - LB;
}
}


namespace wy {
typedef short bf16x8 __attribute__((ext_vector_type(8)));
typedef float f32x4 __attribute__((ext_vector_type(4)));
typedef unsigned u32x4 __attribute__((ext_vector_type(4)));
constexpr int PV = 144, PS = 48, PVS = 136;
constexpr int L_AH = 0, L_RH = L_AH + 64 * PV, L_BT = L_RH + 64 * PV, L_KT = L_BT + 64 * PV, L_NAKT = L_KT + 64 * PV, L_NRKT = L_NAKT + 4 * 16 * PS,
              L_NRBT = L_NRKT + 4 * 16 * PS, L_TT = L_NRBT + 4 * 16 * PS, L_GL = L_TT + 4 * 16 * PS, PACK_BYTES = L_GL + 1024,
              L_VS = PACK_BYTES, L_BH = L_VS + 64 * PV, L_KH = L_BH + 64 * PV, L_YS = L_KH + 64 * PV, L_TW = L_YS + 64 * PV, L_AL = L_TW + 64 * PV, L_NAB = L_AL + 64 * PV, L_INV = L_NAB + 4096, L_END = L_INV + 256;
constexpr int RING = 8, PACK_U = PACK_BYTES / 16, N_LAT = LB * RH * 2, RING_A = 20;
static_assert(PACK_BYTES % 1024 == 0 && PACK_U <= 8 * 512 && (size_t)RING_A * RING * PACK_BYTES <= (size_t)N1P * D * 2 && WS_END + (size_t)(N_LAT - RING_A) * RING * PACK_BYTES <= ((size_t)256 << 20), "ring placement");
static_assert(L_END <= 131072, "WY LDS map");
__device__ __forceinline__ bf16x8 fragk16(LAS unsigned char* lds, int base, int pitch, int row0, int k0, int lane) {
    const bf16x8 v = *(const LAS bf16x8*)(lds + base + (row0 + (lane & 15)) * pitch + (k0 + 8 * ((lane >> 4) & 1)) * 2);
    const bf16x8 z = {0, 0, 0, 0, 0, 0, 0, 0};
    return (lane < 32) ? v : z;
}
__device__ __forceinline__ void stb(LAS unsigned char* lds, int off, float v) { *(LAS bf16*)(lds + off) = f2bf(v); }
typedef unsigned u32x2 __attribute__((ext_vector_type(2)));
__device__ __forceinline__ bf16x8 pack_k16(const f32x4 v) { u32x4 o; o.x = pg8::cvt_pk_bf16(v[0], v[1]); o.y = pg8::cvt_pk_bf16(v[2], v[3]); o.z = 0u; o.w = 0u; return __builtin_bit_cast(bf16x8, o); }
__device__ __forceinline__ bf16x8 pack_k32(const f32x4 a, const f32x4 b) { u32x4 o; o.x = pg8::cvt_pk_bf16(a[0], a[1]); o.y = pg8::cvt_pk_bf16(a[2], a[3]); o.z = pg8::cvt_pk_bf16(b[0], b[1]); o.w = pg8::cvt_pk_bf16(b[2], b[3]);
    return __builtin_bit_cast(bf16x8, o); }
__device__ __forceinline__ bf16x8 ld_k16(LAS unsigned char* lds, int base, int pitch, int row0, int col0, int lane) {
    const u32x2 v = *(const LAS u32x2*)(lds + base + (row0 + (lane & 15)) * pitch + (col0 + 4 * (lane >> 4)) * 2); u32x4 o; o.x = v.x; o.y = v.y; o.z = 0u; o.w = 0u; return __builtin_bit_cast(bf16x8, o); }
__device__ __forceinline__ bf16x8 ld_k32(LAS unsigned char* lds, int base, int pitch, int row0, int col0, int lane) {
    const LAS unsigned char* p = lds + base + (row0 + (lane & 15)) * pitch + (col0 + 4 * (lane >> 4)) * 2;
    const u32x2 v0 = *(const LAS u32x2*)p, v1 = *(const LAS u32x2*)(p + 32); u32x4 o; o.x = v0.x; o.y = v0.y; o.z = v1.x; o.w = v1.y; return __builtin_bit_cast(bf16x8, o); }
__device__ __forceinline__ void rwkv_item(LAS unsigned char* lds, CParams& P, int l, int s, int head, int dir) {
    const int tid = threadIdx.x, w = __builtin_amdgcn_readfirstlane(tid >> 6), lane = tid & 63, fr = lane & 15, fq = lane >> 4;
    const int rt = w & 3, half = w >> 2, hc = head * 64;
    const SeqInfo q = seqinfo(s); const int nchunk = q.T / 64;
    const bf16* RX = WSP(bf16, WS_RXC); bf16* U = WSP(bf16, WS_U1);
    const int pj = tid >> 3, psub = tid & 7;
    f32x4 sacc[4];
#pragma unroll
    for (int ct = 0; ct < 4; ++ct) sacc[ct] = (f32x4){0.f, 0.f, 0.f, 0.f};
    if (w < 4 && q.grid) { const size_t sb = (((size_t)q.b * DEPTH + l) * 2 + dir) * RH + head;
#pragma unroll
        for (int ct = 0; ct < 4; ++ct) sacc[ct] = *(const f32x4*)(P.in[ST_R] + (sb * 64 + 16 * w + fr) * 64 + 16 * ct + 4 * fq); }
    float rkk8[8];
#pragma unroll
    for (int e = 0; e < 8; ++e) rkk8[e] = P.in[R_KK][(size_t)l * RW + hc + 8 * psub + e];
    float c_w0[2], c_a0[2], c_kk[2], c_ka[2];
#pragma unroll
    for (int cc = 0; cc < 2; ++cc) { const int c = 16 * (2 * half + cc) + fr;
        c_w0[cc] = P.in[R_W0][((size_t)l * 2 + dir) * RW + hc + c]; c_a0[cc] = P.in[R_A0][((size_t)l * 2 + dir) * RW + hc + c];
        c_kk[cc] = P.in[R_KK][(size_t)l * RW + hc + c]; c_ka[cc] = P.in[R_KA][(size_t)l * RW + hc + c]; }
    const bf16* w2t = WSP(bf16, O_W2T) + ((size_t)dir * RW + hc) * 64; const bf16* a2t = WSP(bf16, O_A2T) + ((size_t)dir * RW + hc) * 64;
    u32x4 pf[5];
#define WY_TOK(c, j) ((size_t)(q.base + (dir ? q.T - 1 - ((c) * 64 + (j)) : ((c) * 64 + (j)))))
#define WY_PREFETCH(c) do { const bf16* rx = RX + WY_TOK(c, pj) * RIN + 8 * psub; \
        pf[0] = *(const u32x4*)(rx + RX_R + hc); pf[1] = *(const u32x4*)(rx + RX_K + hc); pf[2] = *(const u32x4*)(rx + RX_V + hc); \
        pf[3] = *(const u32x4*)(rx + RX_WL + dir * 64); pf[4] = *(const u32x4*)(rx + RX_AL + dir * 64); } while (0)
    WY_PREFETCH(0);
    for (int c = 0; c < nchunk; ++c) {
        { *(LAS u32x4*)(lds + L_RH + pj * PV + psub * 16) = pf[0]; *(LAS u32x4*)(lds + L_KH + pj * PV + psub * 16) = pf[1];
          const unsigned kw[4] = {pf[1].x, pf[1].y, pf[1].z, pf[1].w}, vw[4] = {pf[2].x, pf[2].y, pf[2].z, pf[2].w};
          float ss = 0.f;
#pragma unroll
          for (int e = 0; e < 8; ++e) { const float kf = __builtin_bit_cast(float, (e & 1) ? (kw[e >> 1] & 0xffff0000u) : (kw[e >> 1] << 16)) * rkk8[e]; ss += kf * kf;
              *(LAS bf16*)(lds + L_VS + (8 * psub + e) * PVS + pj * 2) = (bf16)((vw[e >> 1] >> ((e & 1) * 16)) & 0xffffu); }
          ss += rw::dpp_xor1(ss); ss += rw::dpp_xor2(ss); ss += __shfl_xor(ss, 4);
          if (psub == 0) *(LAS float*)(lds + L_INV + pj * 4) = 1.0f / fmaxf(sqrtf(ss), 1e-12f);
          *(LAS u32x4*)(lds + L_TW + pj * PV + psub * 16) = pf[3]; *(LAS u32x4*)(lds + L_AL + pj * PV + psub * 16) = pf[4]; }
        LDS_BARRIER();
        if (c + 1 < nchunk) WY_PREFETCH(c + 1);
#pragma unroll
        for (int cc = 0; cc < 2; ++cc) { const int ct = 2 * half + cc; const int cidx = 16 * ct + fr;
            f32x4 aw = (f32x4){0.f, 0.f, 0.f, 0.f}, aa = (f32x4){0.f, 0.f, 0.f, 0.f};
#pragma unroll
            for (int ks = 0; ks < 2; ++ks) { const size_t bo = (size_t)cidx * 64 + 32 * ks + 8 * fq;
                aw = ml::mma(ml::frag(lds, L_TW, PV, 16 * rt, 32 * ks, lane), *(const bf16x8*)(w2t + bo), aw); aa = ml::mma(ml::frag(lds, L_AL, PV, 16 * rt, 32 * ks, lane), *(const bf16x8*)(a2t + bo), aa); }
            float kr4[4], rr4[4], iv4[4];
#pragma unroll
            for (int r = 0; r < 4; ++r) { const int tok = 16 * rt + 4 * fq + r; kr4[r] = bf2f(*(const LAS bf16*)(lds + L_KH + tok * PV + cidx * 2)); rr4[r] = bf2f(*(const LAS bf16*)(lds + L_RH + tok * PV + cidx * 2));
                iv4[r] = *(const LAS float*)(lds + L_INV + tok * 4); }
            float lw[4], cum[4];
#pragma unroll
            for (int r = 0; r < 4; ++r) { lw[r] = -0.6065306597126334f * pg8::fsigmoid(c_w0[cc] + aw[r]); cum[r] = (r ? cum[r - 1] : 0.f) + lw[r]; }
            const float tot = cum[3]; const float p1 = __shfl_up(tot, 16), p2 = __shfl_up(tot, 32), p3 = __shfl_up(tot, 48);
            const float off = (fq >= 1 ? p1 : 0.f) + (fq >= 2 ? p2 : 0.f) + (fq >= 3 ? p3 : 0.f);
            float gprev = __expf(off);
#pragma unroll
            for (int r = 0; r < 4; ++r) { const int tok = 16 * rt + 4 * fq + r; const float lam = off + cum[r]; const float g = __expf(lam), gi = __builtin_amdgcn_rcpf(g);
                const float alpha = pg8::fsigmoid(c_a0[cc] + aa[r]);
                const float kraw = kr4[r], rraw = rr4[r];
                const float kkn = kraw * c_kk[cc] * iv4[r];
                const bf16 bh = f2bf(kkn * alpha * gi), kh = f2bf(kraw * (1.0f + (alpha - 1.0f) * c_ka[cc]) * gi);
                stb(lds, L_AH + tok * PV + cidx * 2, -kkn * gprev); stb(lds, L_RH + tok * PV + cidx * 2, rraw * g);
                *(LAS bf16*)(lds + L_BH + tok * PV + cidx * 2) = bh; *(LAS bf16*)(lds + L_KH + tok * PV + cidx * 2) = kh;
                *(LAS bf16*)(lds + L_BT + cidx * PV + tok * 2) = bh; *(LAS bf16*)(lds + L_KT + cidx * PV + tok * 2) = kh;
                if (fq == 3 && r == 3) *(LAS float*)(lds + L_GL + (rt * 64 + cidx) * 4) = g;
                gprev = g; } }
        LDS_BARRIER();
        { const int sc = w >> 1, side = w & 1; f32x4 gB = (f32x4){0.f, 0.f, 0.f, 0.f}, gK = (f32x4){0.f, 0.f, 0.f, 0.f};
#pragma unroll
          for (int ks = 0; ks < 2; ++ks) { const bf16x8 af = ml::frag(lds, side ? L_RH : L_AH, PV, 16 * sc, 32 * ks, lane);
              gB = ml::mma(af, ml::frag(lds, L_BH, PV, 16 * sc, 32 * ks, lane), gB); gK = ml::mma(af, ml::frag(lds, L_KH, PV, 16 * sc, 32 * ks, lane), gK); }
#pragma unroll
          for (int r = 0; r < 4; ++r) { const int t = 4 * fq + r; const bool keep = side ? (fr <= t) : (fr < t); const float vB = keep ? gB[r] : 0.f, vK = keep ? gK[r] : 0.f;
              if (side == 0) { *(LAS float*)(lds + L_NAB + ((sc * 16 + t) * 16 + fr) * 4) = vB; stb(lds, L_NAKT + (sc * 16 + t) * PS + fr * 2, vK); }
              else { stb(lds, L_NRBT + (sc * 16 + t) * PS + fr * 2, vB); stb(lds, L_NRKT + (sc * 16 + t) * PS + fr * 2, vK); } } }
        if ((w & 1) == 0 && lane < 16) { const int sc = w >> 1; float Tr[16];
            asm volatile("" ::: "memory");
#pragma unroll
            for (int ph = 0; ph < 4; ++ph) { f32x4 nv[4][4];
#pragma unroll
                for (int tq = 0; tq < 4; ++tq)
#pragma unroll
                    for (int u4 = 0; u4 <= ph; ++u4) nv[tq][u4] = *(const LAS f32x4*)(lds + L_NAB + ((sc * 16 + 4 * ph + tq) * 16 + 4 * u4) * 4);
#pragma unroll
                for (int tq = 0; tq < 4; ++tq) { const int t = 4 * ph + tq; float x0 = (lane == t) ? 1.f : 0.f, x1 = 0.f;
#pragma unroll
                    for (int u = 0; u < 16; ++u) if (u < t) { if (u & 1) x1 += Tr[u] * nv[tq][u >> 2][u & 3]; else x0 += Tr[u] * nv[tq][u >> 2][u & 3]; }
                    Tr[t] = x0 + x1; stb(lds, L_TT + (sc * 16 + t) * PS + lane * 2, Tr[t]); } } }
        LDS_BARRIER();
        if (w < 4) {
#pragma unroll 1
            for (int sc = 0; sc < 4; ++sc) {
                const bf16x8 ah0 = ld_k32(lds, L_AH, PV, 16 * sc, 0, lane), ah1 = ld_k32(lds, L_AH, PV, 16 * sc, 32, lane), rh0 = ld_k32(lds, L_RH, PV, 16 * sc, 0, lane), rh1 = ld_k32(lds, L_RH, PV, 16 * sc, 32, lane);
                const bf16x8 nak = ld_k16(lds, L_NAKT, PS, 16 * sc, 0, lane), nrk = ld_k16(lds, L_NRKT, PS, 16 * sc, 0, lane), ttf = ld_k16(lds, L_TT, PS, 16 * sc, 0, lane), nrb = ld_k16(lds, L_NRBT, PS, 16 * sc, 0, lane);
                const bf16x8 vsf = ld_k16(lds, L_VS, PVS, 16 * w, 16 * sc, lane);
                bf16x8 btf[4], ktf[4]; f32x4 glv[4];
#pragma unroll
                for (int ct = 0; ct < 4; ++ct) { btf[ct] = ld_k16(lds, L_BT, PV, 16 * ct, 16 * sc, lane); ktf[ct] = ld_k16(lds, L_KT, PV, 16 * ct, 16 * sc, lane);
                    glv[ct] = *(const LAS f32x4*)(lds + L_GL + (sc * 64 + 16 * ct + 4 * fq) * 4); }
                const bf16x8 sb0 = pack_k32(sacc[0], sacc[1]), sb1 = pack_k32(sacc[2], sacc[3]);
                f32x4 XT = (f32x4){0.f, 0.f, 0.f, 0.f}, YT = (f32x4){0.f, 0.f, 0.f, 0.f};
                XT = ml::mma(ah0, sb0, XT); XT = ml::mma(ah1, sb1, XT); XT = ml::mma(nak, vsf, XT);
                YT = ml::mma(rh0, sb0, YT); YT = ml::mma(rh1, sb1, YT); YT = ml::mma(nrk, vsf, YT);
                f32x4 UT = (f32x4){0.f, 0.f, 0.f, 0.f};
                UT = ml::mma(ttf, pack_k16(XT), UT);
                const bf16x8 ub = pack_k16(UT);
                YT = ml::mma(nrb, ub, YT);
#pragma unroll
                for (int r = 0; r < 4; ++r) stb(lds, L_YS + (16 * sc + 4 * fq + r) * PV + (16 * w + fr) * 2, YT[r]);
#pragma unroll
                for (int ct = 0; ct < 4; ++ct) { sacc[ct] = ml::mma(btf[ct], ub, sacc[ct]); sacc[ct] = ml::mma(ktf[ct], vsf, sacc[ct]); sacc[ct] = sacc[ct] * glv[ct]; }
            }
        }
        LDS_BARRIER();
        *(u32x4*)(U + WY_TOK(c, pj) * PU + OFF_R + dir * RW + hc + 8 * psub) = *(const LAS u32x4*)(lds + L_YS + pj * PV + psub * 16);
    }
    if (!q.grid && w < 4) { const size_t sb = (((size_t)q.b * DEPTH + l) * 2 + dir) * RH + head;
#pragma unroll
        for (int ct = 0; ct < 4; ++ct) *(f32x4*)(P.out + OUT_S + (sb * 64 + 16 * w + fr) * 64 + 16 * ct + 4 * fq) = sacc[ct]; }
    LDS_BARRIER();
#undef WY_TOK
#undef WY_PREFETCH
}
__device__ __forceinline__ int tid_opaque() { int t = threadIdx.x; asm volatile("" : "+v"(t)); return t; }
constexpr int CW_F = 16384, FL_STRIDE = 64, NPROD = 2;
static_assert(RING % NPROD == 0 && NPROD + 1 <= 4 && CW_F + DEPTH * N_LAT * 4 * FL_STRIDE <= 32768, "flag block");
constexpr unsigned FL_SPIN_CAP = 1u << 18;
__device__ __forceinline__ unsigned fl_ld(unsigned* p) { return __hip_atomic_load(p, __ATOMIC_RELAXED, __HIP_MEMORY_SCOPE_AGENT); }
__device__ __forceinline__ unsigned fl_wait_ge(unsigned* p, unsigned want, unsigned* tmo) {
    unsigned sp = 0, v;
    while ((v = fl_ld(p)) < want) { __builtin_amdgcn_s_sleep(1); if ((++sp & 255u) == 0u) { if (fl_ld(tmo)) break; if (sp > FL_SPIN_CAP) { atomicAdd(tmo, 1u); break; } } }
    return v;
}
__device__ __forceinline__ void rwkv_prod(LAS unsigned char* lds, CParams& P, int l, int s, int head, int dir, int chain, int pp, unsigned* ctl) {
    const int tid = tid_opaque(), w = __builtin_amdgcn_readfirstlane(tid >> 6), lane = tid & 63, fr = lane & 15, fq = lane >> 4;
    const int rt = w & 3, half = w >> 2, hc = head * 64;
    const SeqInfo q = seqinfo(s); const int nchunk = q.T / 64;
    const bf16* RX = WSP(bf16, WS_RXC);
    const int pj = tid >> 3, psub = tid & 7;
    unsigned char* ring = P.ws + (chain < RING_A ? O_WIN1 + (size_t)chain * RING * PACK_BYTES : WS_END + (size_t)(chain - RING_A) * RING * PACK_BYTES);
    unsigned* f_base = ctl + CW_F + (size_t)((l * N_LAT + chain) * 4) * FL_STRIDE; unsigned* f_ready = f_base + pp * FL_STRIDE; unsigned* f_ack = f_base + NPROD * FL_STRIDE; unsigned* tmo = ctl + 4096 + 128;
    float rkk8[8];
#pragma unroll
    for (int e = 0; e < 8; ++e) rkk8[e] = P.in[R_KK][(size_t)l * RW + hc + 8 * psub + e];
    float c_w0[2], c_a0[2], c_kk[2], c_ka[2];
#pragma unroll
    for (int cc = 0; cc < 2; ++cc) { const int c = 16 * (2 * half + cc) + fr;
        c_w0[cc] = P.in[R_W0][((size_t)l * 2 + dir) * RW + hc + c]; c_a0[cc] = P.in[R_A0][((size_t)l * 2 + dir) * RW + hc + c];
        c_kk[cc] = P.in[R_KK][(size_t)l * RW + hc + c]; c_ka[cc] = P.in[R_KA][(size_t)l * RW + hc + c]; }
    const bf16* w2t = WSP(bf16, O_W2T) + ((size_t)dir * RW + hc) * 64; const bf16* a2t = WSP(bf16, O_A2T) + ((size_t)dir * RW + hc) * 64;
    u32x4 pf[5];
#define WY_TOK(c, j) ((size_t)(q.base + (dir ? q.T - 1 - ((c) * 64 + (j)) : ((c) * 64 + (j)))))
#define WY_PREFETCH(c) do { const bf16* rx = RX + WY_TOK(c, pj) * RIN + 8 * psub; \
        pf[0] = *(const u32x4*)(rx + RX_R + hc); pf[1] = *(const u32x4*)(rx + RX_K + hc); pf[2] = pf[0]; \
        pf[3] = *(const u32x4*)(rx + RX_WL + dir * 64); pf[4] = *(const u32x4*)(rx + RX_AL + dir * 64); } while (0)
    WY_PREFETCH(pp);
    asm volatile("" :: "v"(pf[0]), "v"(pf[1]), "v"(pf[2]), "v"(pf[3]), "v"(pf[4]) : "memory");
    unsigned acked = 0u;
    for (int c = pp; c < nchunk; c += NPROD) {
        { *(LAS u32x4*)(lds + L_RH + pj * PV + psub * 16) = pf[0]; *(LAS u32x4*)(lds + L_KH + pj * PV + psub * 16) = pf[1];
          const unsigned kw[4] = {pf[1].x, pf[1].y, pf[1].z, pf[1].w};
          float ss = 0.f;
#pragma unroll
          for (int e = 0; e < 8; ++e) { const float kf = __builtin_bit_cast(float, (e & 1) ? (kw[e >> 1] & 0xffff0000u) : (kw[e >> 1] << 16)) * rkk8[e]; ss += kf * kf; }
          ss += rw::dpp_xor1(ss); ss += rw::dpp_xor2(ss); ss += __shfl_xor(ss, 4);
          if (psub == 0) *(LAS float*)(lds + L_INV + pj * 4) = 1.0f / fmaxf(sqrtf(ss), 1e-12f);
          *(LAS u32x4*)(lds + L_TW + pj * PV + psub * 16) = pf[3]; *(LAS u32x4*)(lds + L_AL + pj * PV + psub * 16) = pf[4]; }
        LDS_BARRIER();
        if (c + NPROD < nchunk) WY_PREFETCH(c + NPROD);
#pragma unroll
        for (int cc = 0; cc < 2; ++cc) { const int ct = 2 * half + cc; const int cidx = 16 * ct + fr;
            f32x4 aw = (f32x4){0.f, 0.f, 0.f, 0.f}, aa = (f32x4){0.f, 0.f, 0.f, 0.f};
#pragma unroll
            for (int ks = 0; ks < 2; ++ks) { const size_t bo = (size_t)cidx * 64 + 32 * ks + 8 * fq;
                aw = ml::mma(ml::frag(lds, L_TW, PV, 16 * rt, 32 * ks, lane), *(const bf16x8*)(w2t + bo), aw); aa = ml::mma(ml::frag(lds, L_AL, PV, 16 * rt, 32 * ks, lane), *(const bf16x8*)(a2t + bo), aa); }
            float kr4[4], rr4[4], iv4[4];
#pragma unroll
            for (int r = 0; r < 4; ++r) { const int tok = 16 * rt + 4 * fq + r; kr4[r] = bf2f(*(const LAS bf16*)(lds + L_KH + tok * PV + cidx * 2)); rr4[r] = bf2f(*(const LAS bf16*)(lds + L_RH + tok * PV + cidx * 2));
                iv4[r] = *(const LAS float*)(lds + L_INV + tok * 4); }
            float lw[4], cum[4];
#pragma unroll
            for (int r = 0; r < 4; ++r) { lw[r] = -0.6065306597126334f * pg8::fsigmoid(c_w0[cc] + aw[r]); cum[r] = (r ? cum[r - 1] : 0.f) + lw[r]; }
            const float tot = cum[3]; const float p1 = __shfl_up(tot, 16), p2 = __shfl_up(tot, 32), p3 = __shfl_up(tot, 48);
            const float off = (fq >= 1 ? p1 : 0.f) + (fq >= 2 ? p2 : 0.f) + (fq >= 3 ? p3 : 0.f);
            float gprev = __expf(off);
#pragma unroll
            for (int r = 0; r < 4; ++r) { const int tok = 16 * rt + 4 * fq + r; const float lam = off + cum[r]; const float g = __expf(lam), gi = __builtin_amdgcn_rcpf(g);
                const float alpha = pg8::fsigmoid(c_a0[cc] + aa[r]);
                const float kraw = kr4[r], rraw = rr4[r];
                const float kkn = kraw * c_kk[cc] * iv4[r];
                const bf16 bh = f2bf(kkn * alpha * gi), kh = f2bf(kraw * (1.0f + (alpha - 1.0f) * c_ka[cc]) * gi);
                stb(lds, L_AH + tok * PV + cidx * 2, -kkn * gprev); stb(lds, L_RH + tok * PV + cidx * 2, rraw * g);
                *(LAS bf16*)(lds + L_BH + tok * PV + cidx * 2) = bh; *(LAS bf16*)(lds + L_KH + tok * PV + cidx * 2) = kh;
                *(LAS bf16*)(lds + L_BT + cidx * PV + tok * 2) = bh; *(LAS bf16*)(lds + L_KT + cidx * PV + tok * 2) = kh;
                if (fq == 3 && r == 3) *(LAS float*)(lds + L_GL + (rt * 64 + cidx) * 4) = g;
                gprev = g; } }
        asm volatile("s_waitcnt vmcnt(0)" ::: "memory");
        LDS_BARRIER();
        if (tid == 0 && c > pp) __hip_atomic_store(f_ready, (unsigned)((c - pp) / NPROD), __ATOMIC_RELAXED, __HIP_MEMORY_SCOPE_AGENT);
        { const int sc = w >> 1, side = w & 1; f32x4 gB = (f32x4){0.f, 0.f, 0.f, 0.f}, gK = (f32x4){0.f, 0.f, 0.f, 0.f};
#pragma unroll
          for (int ks = 0; ks < 2; ++ks) { const bf16x8 af = ml::frag(lds, side ? L_RH : L_AH, PV, 16 * sc, 32 * ks, lane);
              gB = ml::mma(af, ml::frag(lds, L_BH, PV, 16 * sc, 32 * ks, lane), gB); gK = ml::mma(af, ml::frag(lds, L_KH, PV, 16 * sc, 32 * ks, lane), gK); }
#pragma unroll
          for (int r = 0; r < 4; ++r) { const int t = 4 * fq + r; const bool keep = side ? (fr <= t) : (fr < t); const float vB = keep ? gB[r] : 0.f, vK = keep ? gK[r] : 0.f;
              if (side == 0) { *(LAS float*)(lds + L_NAB + ((sc * 16 + t) * 16 + fr) * 4) = vB; stb(lds, L_NAKT + (sc * 16 + t) * PS + fr * 2, vK); }
              else { stb(lds, L_NRBT + (sc * 16 + t) * PS + fr * 2, vB); stb(lds, L_NRKT + (sc * 16 + t) * PS + fr * 2, vK); } } }
        if ((w & 1) == 0 && lane < 16) { const int sc = w >> 1; float Tr[16];
            asm volatile("" ::: "memory");
#pragma unroll
            for (int ph = 0; ph < 4; ++ph) { f32x4 nv[4][4];
#pragma unroll
                for (int tq = 0; tq < 4; ++tq)
#pragma unroll
                    for (int u4 = 0; u4 <= ph; ++u4) nv[tq][u4] = *(const LAS f32x4*)(lds + L_NAB + ((sc * 16 + 4 * ph + tq) * 16 + 4 * u4) * 4);
#pragma unroll
                for (int tq = 0; tq < 4; ++tq) { const int t = 4 * ph + tq; float x0 = (lane == t) ? 1.f : 0.f, x1 = 0.f;
#pragma unroll
                    for (int u = 0; u < 16; ++u) if (u < t) { if (u & 1) x1 += Tr[u] * nv[tq][u >> 2][u & 3]; else x0 += Tr[u] * nv[tq][u >> 2][u & 3]; }
                    Tr[t] = x0 + x1; stb(lds, L_TT + (sc * 16 + t) * PS + lane * 2, Tr[t]); } } }
        if (tid == 0 && c >= RING && acked < (unsigned)(c - RING + 1)) acked = fl_wait_ge(f_ack, (unsigned)(c - RING + 1), tmo);
        LDS_BARRIER();
        asm volatile("" :: "v"(pf[0]), "v"(pf[1]), "v"(pf[2]), "v"(pf[3]), "v"(pf[4]) : "memory");
        { unsigned char* slot = ring + (size_t)(c % RING) * PACK_BYTES;
#pragma unroll
          for (int k = 0; k < 8; ++k) { const int u = tid + 512 * k;
              if (u < PACK_U) { const u32x4 v = *(const LAS u32x4*)(lds + 16 * u); const u32x4* gp = (const u32x4*)(slot + (size_t)16 * u);
                  asm volatile("global_store_dwordx4 %0, %1, off sc1" :: "v"(gp), "v"(v) : "memory"); } } }
        LDS_BARRIER();
    }
    asm volatile("s_waitcnt vmcnt(0)" ::: "memory");
    __syncthreads();
    if (tid == 0) __hip_atomic_store(f_ready, (unsigned)((nchunk - pp + NPROD - 1) / NPROD), __ATOMIC_RELAXED, __HIP_MEMORY_SCOPE_AGENT);
    LDS_BARRIER();
#undef WY_TOK
#undef WY_PREFETCH
}
__device__ __forceinline__ void rwkv_cons(LAS unsigned char* lds, CParams& P, int l, int s, int head, int dir, int chain, unsigned* ctl) {
    const int tid = tid_opaque(), w = __builtin_amdgcn_readfirstlane(tid >> 6), lane = tid & 63, fr = lane & 15, fq = lane >> 4;
    const int hc = head * 64;
    const SeqInfo q = seqinfo(s); const int nchunk = q.T / 64;
    bf16* U = WSP(bf16, WS_U1);
    const unsigned char* ring = P.ws + (chain < RING_A ? O_WIN1 + (size_t)chain * RING * PACK_BYTES : WS_END + (size_t)(chain - RING_A) * RING * PACK_BYTES);
    unsigned* f_base = ctl + CW_F + (size_t)((l * N_LAT + chain) * 4) * FL_STRIDE; unsigned* f_ack = f_base + NPROD * FL_STRIDE; unsigned* tmo = ctl + 4096 + 128;
    constexpr int C_IMG = PACK_BYTES + 64 * PV, C_YS = 2 * C_IMG;
    const bf16* RX = WSP(bf16, WS_RXC);
    static_assert(C_YS + 64 * PV <= 131072, "consumer LDS map");
    f32x4 sacc[4];
#pragma unroll
    for (int ct = 0; ct < 4; ++ct) sacc[ct] = (f32x4){0.f, 0.f, 0.f, 0.f};
    if (w < 4 && q.grid) { const size_t sb = (((size_t)q.b * DEPTH + l) * 2 + dir) * RH + head;
#pragma unroll
        for (int ct = 0; ct < 4; ++ct) sacc[ct] = *(const f32x4*)(P.in[ST_R] + (sb * 64 + 16 * w + fr) * 64 + 16 * ct + 4 * fq); }
#define WY_TOK(c, j) ((size_t)(q.base + (dir ? q.T - 1 - ((c) * 64 + (j)) : ((c) * 64 + (j)))))
    unsigned seen0 = 0u, seen1 = 0u;
#define CONS_FETCH(c, boff) do { const int p_ = (c) % NPROD; const unsigned need_ = (unsigned)((c) / NPROD + 1); \
        u32x4 vv_[2];   \
        _Pragma("unroll") for (int i_ = 0; i_ < 2; ++i_) vv_[i_] = *(const u32x4*)(RX + WY_TOK(c, lane) * RIN + RX_V + hc + 8 * (2 * (w - 4) + i_)); \
        if ((p_ ? seen1 : seen0) < need_) { unsigned v_ = 0u; if (lane == 0) v_ = fl_wait_ge(f_base + p_ * FL_STRIDE, need_, tmo); v_ = __builtin_amdgcn_readfirstlane(v_); \
            if (p_) seen1 = v_; else seen0 = v_; __builtin_amdgcn_fence(__ATOMIC_ACQUIRE, "agent"); } \
        _Pragma("unroll") for (int i_ = 0; i_ < 2; ++i_) { const unsigned wv_[4] = {vv_[i_].x, vv_[i_].y, vv_[i_].z, vv_[i_].w}; \
            _Pragma("unroll") for (int e_ = 0; e_ < 8; ++e_) *(LAS bf16*)(lds + (boff) + L_VS + (8 * (2 * (w - 4) + i_) + e_) * PVS + lane * 2) = (bf16)((wv_[e_ >> 1] >> ((e_ & 1) * 16)) & 0xffffu); } \
        const unsigned char* slot = ring + (size_t)((c) % RING) * PACK_BYTES; \
        for (int k = w - 4; k < PACK_BYTES / 1024; k += 4) \
            __builtin_amdgcn_global_load_lds((const unsigned*)(slot + (size_t)k * 1024 + lane * 16), (LAS unsigned*)(lds + (boff) + k * 1024), 16, 0, 0); \
        asm volatile("s_waitcnt vmcnt(0)" ::: "memory"); } while (0)
    if (w >= 4) CONS_FETCH(0, 0);
    LDS_BARRIER();
    if (tid == 256) __hip_atomic_store(f_ack, 1u, __ATOMIC_RELAXED, __HIP_MEMORY_SCOPE_AGENT);
    for (int c = 0; c < nchunk; ++c) {
        const int boff = (c & 1) * C_IMG;
        if (w >= 4) { if (c + 1 < nchunk) CONS_FETCH(c + 1, C_IMG - boff); }
        else {
            LAS unsigned char* pb = lds + boff;
#pragma unroll 1
            for (int sc = 0; sc < 4; ++sc) {
                const bf16x8 ah0 = ld_k32(pb, L_AH, PV, 16 * sc, 0, lane), ah1 = ld_k32(pb, L_AH, PV, 16 * sc, 32, lane), rh0 = ld_k32(pb, L_RH, PV, 16 * sc, 0, lane), rh1 = ld_k32(pb, L_RH, PV, 16 * sc, 32, lane);
                const bf16x8 nak = ld_k16(pb, L_NAKT, PS, 16 * sc, 0, lane), nrk = ld_k16(pb, L_NRKT, PS, 16 * sc, 0, lane), ttf = ld_k16(pb, L_TT, PS, 16 * sc, 0, lane), nrb = ld_k16(pb, L_NRBT, PS, 16 * sc, 0, lane);
                const bf16x8 vsf = ld_k16(pb, L_VS, PVS, 16 * w, 16 * sc, lane);
                bf16x8 btf[4], ktf[4]; f32x4 glv[4];
#pragma unroll
                for (int ct = 0; ct < 4; ++ct) { btf[ct] = ld_k16(pb, L_BT, PV, 16 * ct, 16 * sc, lane); ktf[ct] = ld_k16(pb, L_KT, PV, 16 * ct, 16 * sc, lane);
                    glv[ct] = *(const LAS f32x4*)(pb + L_GL + (sc * 64 + 16 * ct + 4 * fq) * 4); }
                const bf16x8 sb0 = pack_k32(sacc[0], sacc[1]), sb1 = pack_k32(sacc[2], sacc[3]);
                f32x4 XT = (f32x4){0.f, 0.f, 0.f, 0.f}, YT = (f32x4){0.f, 0.f, 0.f, 0.f};
                XT = ml::mma(ah0, sb0, XT); XT = ml::mma(ah1, sb1, XT); XT = ml::mma(nak, vsf, XT);
                YT = ml::mma(rh0, sb0, YT); YT = ml::mma(rh1, sb1, YT); YT = ml::mma(nrk, vsf, YT);
                f32x4 UT = (f32x4){0.f, 0.f, 0.f, 0.f};
                UT = ml::mma(ttf, pack_k16(XT), UT);
                const bf16x8 ub = pack_k16(UT);
                YT = ml::mma(nrb, ub, YT);
#pragma unroll
                for (int r = 0; r < 4; ++r) stb(lds, C_YS + (16 * sc + 4 * fq + r) * PV + (16 * w + fr) * 2, YT[r]);
#pragma unroll
                for (int ct = 0; ct < 4; ++ct) { sacc[ct] = ml::mma(btf[ct], ub, sacc[ct]); sacc[ct] = ml::mma(ktf[ct], vsf, sacc[ct]); sacc[ct] = sacc[ct] * glv[ct]; }
            }
            { const LAS unsigned char* yp = lds + C_YS + lane * PV + 32 * w; const u32x4 y0 = *(const LAS u32x4*)yp, y1 = *(const LAS u32x4*)(yp + 16);
              bf16* up = U + WY_TOK(c, lane) * PU + OFF_R + dir * RW + hc + 16 * w; *(u32x4*)up = y0; *(u32x4*)(up + 8) = y1; }
        }
        LDS_BARRIER();
        if (tid == 256 && c + 1 < nchunk) __hip_atomic_store(f_ack, (unsigned)(c + 2), __ATOMIC_RELAXED, __HIP_MEMORY_SCOPE_AGENT);
    }
    if (!q.grid && w < 4) { const size_t sb = (((size_t)q.b * DEPTH + l) * 2 + dir) * RH + head;
#pragma unroll
        for (int ct = 0; ct < 4; ++ct) *(f32x4*)(P.out + OUT_S + (sb * 64 + 16 * w + fr) * 64 + 16 * ct + 4 * fq) = sacc[ct]; }
    LDS_BARRIER();
#undef WY_TOK
#undef CONS_FETCH
}
constexpr int N_ITEMS = NSEQ * RH * 2;
__device__ __forceinline__ void decode_item(int it, int& s, int& head, int& dir) {
    dir = it & 1; int ch = it >> 1; head = ch % RH; const int sq = ch / RH;
    s = sq < LB ? CB + sq : sq - LB;
}
}

namespace ms {
using ml::PQ; using ml::PT; using ml::mma; using ml::frag; using wy::bf16x8; using wy::f32x4; using wy::u32x4;
constexpr int P_QS = 0, P_KT = P_QS + 64 * PQ, P_SB = P_KT + 128 * PT, P_SC = P_SB + 64 * PT, P_VT = P_SC + 4096, VT_BYTES = 21504, ML_PACK = P_VT + VT_BYTES, P_KS = ML_PACK, P_END = P_KS + 64 * PQ;
constexpr int ML_RING = 4, ML_PACK_U = ML_PACK / 16, N_MLAT = LB * MH * 2, CW_MF = 32768, MLPROD = 2;
static_assert(MLPROD == 2 && ML_RING % MLPROD == 0, "two producers per chain: even / odd chunks");
static_assert(ML_PACK % 1024 == 0 && ML_PACK_U <= 9 * 512 && 145 * PT <= VT_BYTES && P_END <= 131072 && 2 * ML_PACK <= 146432, "mLSTM pack layout");
static_assert(WS_END + (size_t)N_MLAT * ML_RING * ML_PACK <= ((size_t)256 << 20), "mLSTM ring fits behind the activations");
__device__ __forceinline__ void ml_prod(LAS unsigned char* lds, CParams& P, int l, int s, int head, int dir, int chain, int pp, unsigned* ctl) {
    const int tid = wy::tid_opaque(), w = __builtin_amdgcn_readfirstlane(tid >> 6), lane = tid & 63, fr = lane & 15, fq = lane >> 4;
    const int rt = w & 3, half = w >> 2;
    const SeqInfo q = seqinfo(s); const int nchunk = q.T / 64;
    const bf16* QK = WSP(bf16, WS_QKC); const bf16* U = WSP(bf16, WS_U1);
    LAS float* SC = (LAS float*)(lds + P_SC);
    unsigned char* ring = P.ws + WS_END + (size_t)chain * ML_RING * ML_PACK;
    unsigned* f_base = ctl + CW_MF + (size_t)((l * N_MLAT + chain) * 4) * wy::FL_STRIDE; unsigned* f_ready = f_base + pp * wy::FL_STRIDE; unsigned* f_ack = f_base + MLPROD * wy::FL_STRIDE; unsigned* tmo = ctl + 4096 + 128;
    float m_prev = 0.f;
    if (q.grid) m_prev = P.in[ST_M][(((size_t)q.b * DEPTH + l) * 2 + dir) * MH + head];
    const float bi = P.in[M_GATE_B][(size_t)l * 4 * MH + (2 * dir) * MH + head], bfg = P.in[M_GATE_B][(size_t)l * 4 * MH + (2 * dir + 1) * MH + head];
    for (int i = tid; i < (VT_BYTES - 128 * PT) / 2; i += 512) *(LAS bf16*)(lds + P_VT + 128 * PT + i * 2) = (i < 64) ? (bf16)0x3f80 : (bf16)0;
    u32x4 pqk[4]; u32x4 pv[2]; bf16 pgi = 0, pgf = 0, sgi = 0, sgf = 0;
#define ML_TOK(c, j) ((size_t)(q.base + (dir ? q.T - 1 - ((c) * 64 + (j)) : ((c) * 64 + (j)))))
#define ML_PREFETCH(c) do { _Pragma("unroll") for (int i = 0; i < 4; ++i) { const int id = tid + 512 * i, j = id >> 5, pc = id & 31; \
            pqk[i] = *(const u32x4*)(QK + ML_TOK(c, j) * (2 * MW) + (pc < 16 ? head * 128 + 8 * pc : MW + head * 128 + 8 * (pc - 16))); } \
        _Pragma("unroll") for (int i = 0; i < 2; ++i) { const int id = tid + 512 * i, j = id >> 4, pc = id & 15; pv[i] = *(const u32x4*)(U + ML_TOK(c, j) * PU + OFF_V + head * 128 + 8 * pc); } \
        if (w == 0) { const bf16* g = U + ML_TOK(c, lane) * PU + OFF_G; pgi = g[(2 * dir) * MH + head]; pgf = g[(2 * dir + 1) * MH + head]; \
            if ((c) >= 1) { const bf16* g2 = U + ML_TOK((c) - 1, lane) * PU + OFF_G; sgi = g2[(2 * dir) * MH + head]; sgf = g2[(2 * dir + 1) * MH + head]; } } } while (0)
#define ML_TOUCH() asm volatile("" :: "v"(pqk[0]), "v"(pqk[1]), "v"(pqk[2]), "v"(pqk[3]), "v"(pv[0]), "v"(pv[1]), "v"((unsigned)pgi), "v"((unsigned)pgf), "v"((unsigned)sgi), "v"((unsigned)sgf) : "memory")
#define ML_SCAN(gi_, gf_) \
            const float gi = bf2f(gi_) + bi, gf = bf2f(gf_) + bfg; \
            const float lf = fminf(gf, 0.f) - log1pf(__expf(-fabsf(gf))); \
            float b = lf; \
            _Pragma("unroll") for (int o = 1; o < 64; o <<= 1) { const float t = __shfl_up(b, o); if (lane >= o) b += t; } \
            const float a = gi - b; float pm = a; \
            _Pragma("unroll") for (int o = 1; o < 64; o <<= 1) { const float t = __shfl_up(pm, o); if (lane >= o) pm = fmaxf(pm, t); } \
            pm = fmaxf(pm, m_prev); \
            const float pm63 = __shfl(pm, 63), b63 = __shfl(b, 63);
    ML_PREFETCH(pp);
    ML_TOUCH();
    unsigned acked = 0u;
    for (int c = pp; c < nchunk; c += MLPROD) {
        if (w == 0 && c >= 1) { ML_SCAN(sgi, sgf) m_prev = b63 + pm63; }
#pragma unroll
        for (int i = 0; i < 4; ++i) { const int id = tid + 512 * i, j = id >> 5, pc = id & 31;
            *(LAS u32x4*)(lds + (pc < 16 ? P_QS : P_KS) + j * PQ + (pc & 15) * 16) = pqk[i]; }
#pragma unroll
        for (int i = 0; i < 2; ++i) { const int id = tid + 512 * i, j = id >> 4, pc = id & 15; const unsigned wv[4] = {pv[i].x, pv[i].y, pv[i].z, pv[i].w};
#pragma unroll
            for (int e = 0; e < 8; ++e) *(LAS bf16*)(lds + P_VT + (8 * pc + e) * PT + j * 2) = (bf16)((wv[e >> 1] >> ((e & 1) * 16)) & 0xffffu); }
        if (w == 0) {
            ML_SCAN(pgi, pgf)
            SC[ml::SC_A + lane] = a; SC[ml::SC_PM + lane] = pm; SC[ml::SC_WI + lane] = __expf(m_prev - pm); SC[ml::SC_EMT + lane] = __expf(-(b + pm)); SC[ml::SC_WE + lane] = __expf(a - pm63);
            if (lane == 0) { SC[ml::SC_MISC] = __expf(m_prev - pm63); SC[ml::SC_MISC + 1] = b63 + pm63; }
            m_prev = b63 + pm63;
        }
        LDS_BARRIER();
        if (c + MLPROD < nchunk) ML_PREFETCH(c + MLPROD);
#pragma unroll
        for (int i = 0; i < 2; ++i) { const int id = tid + 512 * i, j = id & 63, pc = id >> 6; const float we = SC[ml::SC_WE + j];
            const u32x4 kv = *(const LAS u32x4*)(lds + P_KS + j * PQ + pc * 16); const unsigned wv[4] = {kv.x, kv.y, kv.z, kv.w};
#pragma unroll
            for (int e = 0; e < 8; ++e) { const float kf = __builtin_bit_cast(float, (e & 1) ? (wv[e >> 1] & 0xffff0000u) : (wv[e >> 1] << 16));
                *(LAS bf16*)(lds + P_KT + (8 * pc + e) * PT + j * 2) = f2bf(kf * we); } }
#pragma unroll
        for (int cc = 0; cc < 2; ++cc) { const int ct = 2 * half + cc;
            f32x4 acc = (f32x4){0.f, 0.f, 0.f, 0.f};
            if (ct <= rt) {
#pragma unroll
                for (int k = 0; k < 4; ++k) acc = mma(frag(lds, P_QS, PQ, 16 * rt, 32 * k, lane), frag(lds, P_KS, PQ, 16 * ct, 32 * k, lane), acc);
            }
            const int sp = 16 * ct + fr; const float as = SC[ml::SC_A + sp];
#pragma unroll
            for (int r = 0; r < 4; ++r) { const int t = 16 * rt + 4 * fq + r; const float v = (sp <= t) ? acc[r] * __expf(as - SC[ml::SC_PM + t]) : 0.f;
                *(LAS bf16*)(lds + P_SB + t * PT + sp * 2) = f2bf(v); } }
        asm volatile("s_waitcnt vmcnt(0)" ::: "memory");
        if (tid == 0 && c >= ML_RING && acked < (unsigned)(c - ML_RING + 1)) acked = wy::fl_wait_ge(f_ack, (unsigned)(c - ML_RING + 1), tmo);
        LDS_BARRIER();
        if (tid == 0 && c > pp) __hip_atomic_store(f_ready, (unsigned)((c - pp) / MLPROD), __ATOMIC_RELAXED, __HIP_MEMORY_SCOPE_AGENT);
        ML_TOUCH();
        { unsigned char* slot = ring + (size_t)(c % ML_RING) * ML_PACK;
#pragma unroll
          for (int k = 0; k < 9; ++k) { const int u = tid + 512 * k;
              if (u < ML_PACK_U) { const u32x4 v = *(const LAS u32x4*)(lds + 16 * u); const u32x4* gp = (const u32x4*)(slot + (size_t)16 * u);
                  asm volatile("global_store_dwordx4 %0, %1, off sc1" :: "v"(gp), "v"(v) : "memory"); } } }
        LDS_BARRIER();
    }
    asm volatile("s_waitcnt vmcnt(0)" ::: "memory");
    __syncthreads();
    if (tid == 0) __hip_atomic_store(f_ready, (unsigned)((nchunk - pp + MLPROD - 1) / MLPROD), __ATOMIC_RELAXED, __HIP_MEMORY_SCOPE_AGENT);
    LDS_BARRIER();
#undef ML_TOK
#undef ML_PREFETCH
#undef ML_TOUCH
#undef ML_SCAN
}
__device__ __forceinline__ void ml_cons(LAS unsigned char* lds, CParams& P, int l, int s, int head, int dir, int chain, unsigned* ctl) {
    const int tid = wy::tid_opaque(), w = __builtin_amdgcn_readfirstlane(tid >> 6), lane = tid & 63, fr = lane & 15, fq = lane >> 4;
    const SeqInfo q = seqinfo(s); const int nchunk = q.T / 64;
    bf16* U = WSP(bf16, WS_U1);
    const unsigned char* ring = P.ws + WS_END + (size_t)chain * ML_RING * ML_PACK;
    unsigned* f_base = ctl + CW_MF + (size_t)((l * N_MLAT + chain) * 4) * wy::FL_STRIDE; unsigned* f_ack = f_base + MLPROD * wy::FL_STRIDE; unsigned* tmo = ctl + 4096 + 128;
    f32x4 cst[8][3];
#pragma unroll
    for (int kt = 0; kt < 8; ++kt)
#pragma unroll
        for (int j = 0; j < 3; ++j) cst[kt][j] = (f32x4){0.f, 0.f, 0.f, 0.f};
    if (w < 4 && q.grid) { const size_t sb = (((size_t)q.b * DEPTH + l) * 2 + dir) * MH + head;
#pragma unroll
        for (int kt = 0; kt < 8; ++kt)
#pragma unroll
            for (int r = 0; r < 4; ++r) { const int d = 16 * kt + 4 * fq + r;
                cst[kt][0][r] = P.in[ST_C][(sb * 128 + d) * 128 + 32 * w + fr]; cst[kt][1][r] = P.in[ST_C][(sb * 128 + d) * 128 + 32 * w + 16 + fr];
                cst[kt][2][r] = (fr == 0) ? P.in[ST_N][sb * 128 + d] : 0.f; } }
#define ML_TOK(c, j) ((size_t)(q.base + (dir ? q.T - 1 - ((c) * 64 + (j)) : ((c) * 64 + (j)))))
    unsigned seen0 = 0u, seen1 = 0u;
#define MLC_FETCH(c, boff) do { const int p_ = (c) % MLPROD; const unsigned need_ = (unsigned)((c) / MLPROD + 1); \
        if ((p_ ? seen1 : seen0) < need_) { unsigned v_ = 0u; if (lane == 0) v_ = wy::fl_wait_ge(f_base + p_ * wy::FL_STRIDE, need_, tmo); v_ = __builtin_amdgcn_readfirstlane(v_); \
            if (p_) seen1 = v_; else seen0 = v_; __builtin_amdgcn_fence(__ATOMIC_ACQUIRE, "agent"); } \
        const unsigned char* slot = ring + (size_t)((c) % ML_RING) * ML_PACK; \
        for (int k = w - 4; k < ML_PACK / 1024; k += 4) \
            __builtin_amdgcn_global_load_lds((const unsigned*)(slot + (size_t)k * 1024 + lane * 16), (LAS unsigned*)(lds + (boff) + k * 1024), 16, 0, 0); \
        asm volatile("s_waitcnt vmcnt(0)" ::: "memory"); } while (0)
    if (w >= 4) MLC_FETCH(0, 0);
    LDS_BARRIER();
    if (tid == 256) __hip_atomic_store(f_ack, 1u, __ATOMIC_RELAXED, __HIP_MEMORY_SCOPE_AGENT);
    for (int c = 0; c < nchunk; ++c) {
        const int boff = (c & 1) * ML_PACK;
        if (w >= 4) { if (c + 1 < nchunk) MLC_FETCH(c + 1, ML_PACK - boff); }
        else {
            LAS unsigned char* pb = lds + boff; const LAS float* SC = (const LAS float*)(pb + P_SC);
            const float wie = SC[ml::SC_MISC];
            bf16x8 vf[3][2];
#pragma unroll
            for (int j = 0; j < 3; ++j)
#pragma unroll
                for (int k = 0; k < 2; ++k) vf[j][k] = frag(pb, P_VT, PT, j < 2 ? 32 * w + 16 * j : 128, 32 * k, lane);
            asm volatile("s_waitcnt lgkmcnt(0)" ::: "memory");
            LAS unsigned char* hp = pb + P_VT + 32 * w * PT;
#pragma unroll
            for (int rt = 0; rt < 4; ++rt) {
                f32x4 num[3];
#pragma unroll
                for (int j = 0; j < 3; ++j) { f32x4 a1 = (f32x4){0.f, 0.f, 0.f, 0.f}, a2 = (f32x4){0.f, 0.f, 0.f, 0.f};
#pragma unroll
                    for (int k = 0; k < 2; ++k) a1 = mma(frag(pb, P_SB, PT, 16 * rt, 32 * k, lane), vf[j][k], a1);
#pragma unroll
                    for (int kb = 0; kb < 4; ++kb) a2 = mma(wy::ld_k32(pb, P_QS, PQ, 16 * rt, 32 * kb, lane), wy::pack_k32(cst[2 * kb][j], cst[2 * kb + 1][j]), a2);
#pragma unroll
                    for (int r = 0; r < 4; ++r) a1[r] += SC[ml::SC_WI + 16 * rt + 4 * fq + r] * a2[r];
                    num[j] = a1; }
#pragma unroll
                for (int r = 0; r < 4; ++r) { const int t = 16 * rt + 4 * fq + r; const float dn = __shfl(num[2][r], lane & 48);
                    const float rden = __builtin_amdgcn_rcpf(fmaxf(fabsf(dn), SC[ml::SC_EMT + t]));
                    *(LAS bf16*)(hp + t * 64 + fr * 2) = f2bf(num[0][r] * rden); *(LAS bf16*)(hp + t * 64 + (16 + fr) * 2) = f2bf(num[1][r] * rden); }
            }
#pragma unroll
            for (int kt = 0; kt < 8; ++kt) { const bf16x8 k0 = frag(pb, P_KT, PT, 16 * kt, 0, lane), k1 = frag(pb, P_KT, PT, 16 * kt, 32, lane);
#pragma unroll
                for (int j = 0; j < 3; ++j) { cst[kt][j] = cst[kt][j] * wie; cst[kt][j] = mma(k0, vf[j][0], cst[kt][j]); cst[kt][j] = mma(k1, vf[j][1], cst[kt][j]); } }
            { const LAS unsigned char* yp = hp + lane * 64; bf16* up = U + ML_TOK(c, lane) * PU + dir * MW + head * 128 + 32 * w;
#pragma unroll
              for (int i = 0; i < 4; ++i) *(u32x4*)(up + 8 * i) = *(const LAS u32x4*)(yp + 16 * i); }
        }
        LDS_BARRIER();
        if (tid == 256 && c + 1 < nchunk) __hip_atomic_store(f_ack, (unsigned)(c + 2), __ATOMIC_RELAXED, __HIP_MEMORY_SCOPE_AGENT);
    }
    LDS_BARRIER();
#undef ML_TOK
#undef MLC_FETCH
}
}

namespace el {
typedef float f32x4 __attribute__((ext_vector_type(4)));
typedef unsigned u32x4 __attribute__((ext_vector_type(4)));
typedef unsigned u32x2 __attribute__((ext_vector_type(2)));
typedef short bf16x8 __attribute__((ext_vector_type(8)));
__device__ __forceinline__ float wave_sum(float v) {
#pragma unroll
    for (int o = 1; o < 64; o <<= 1) v += __shfl_xor(v, o);
    return v;
}
__device__ __forceinline__ void unpack8(const u32x4 p, float (&f)[8]) {
    f[0] = pg8::bflo(p.x); f[1] = pg8::bfhi(p.x); f[2] = pg8::bflo(p.y); f[3] = pg8::bfhi(p.y); f[4] = pg8::bflo(p.z); f[5] = pg8::bfhi(p.z); f[6] = pg8::bflo(p.w); f[7] = pg8::bfhi(p.w);
}
__device__ __forceinline__ u32x4 pack8(const float (&f)[8]) {
    u32x4 o; o.x = pg8::cvt_pk_bf16(f[0], f[1]); o.y = pg8::cvt_pk_bf16(f[2], f[3]); o.z = pg8::cvt_pk_bf16(f[4], f[5]); o.w = pg8::cvt_pk_bf16(f[6], f[7]); return o;
}
__device__ __forceinline__ void init_phase(LAS unsigned char* lds, CParams& P, int vb, int G) {
    const int tid = threadIdx.x, w = tid >> 6, lane = tid & 63;
    LAS float* red = (LAS float*)lds;
    constexpr int KW = D / 8;
    for (int it = vb; it < DEPTH * (6 * D / 64); it += G) {
        const int l = it / (6 * D / 64), j = (it % (6 * D / 64)) * 64 + lane;
        const float* wp = P.in[ADA_W] + ((size_t)l * D + w * KW) * 6 * D + j;
        float acc[NCOND];
#pragma unroll
        for (int ci = 0; ci < NCOND; ++ci) acc[ci] = 0.f;
        for (int k = 0; k < KW; ++k) { const float wv = wp[(size_t)k * 6 * D];
#pragma unroll
            for (int ci = 0; ci < NCOND; ++ci) { const float cv = ci == 0 ? P.in[C_CTX][w * KW + k] : P.in[C_LAT][(size_t)(ci - 1) * D + w * KW + k]; acc[ci] += cv * pg8::fsigmoid(cv) * wv; } }
#pragma unroll
        for (int ci = 0; ci < NCOND; ++ci) red[(w * NCOND + ci) * 64 + lane] = acc[ci];
        __syncthreads();
        if (w < NCOND) { float sum = P.in[ADA_B][(size_t)l * 6 * D + j];
#pragma unroll
            for (int ww = 0; ww < 8; ++ww) sum += red[(ww * NCOND + w) * 64 + lane];
            WSP(float, WS_MOD)[((size_t)l * NCOND + w) * 6 * D + j] = sum; }
        __syncthreads();
    }
}
__device__ __forceinline__ int perm5(int n) { return (((n >> 2) & 1) << 4) | (((n >> 3) & 3) << 2) | (n & 3); }
__device__ __forceinline__ void transpose_item(const float* W, int ldw, int nvalid, bf16* dst, int K, int k0, int drow0, bool perm, LAS float* scr, int lane) {
#pragma unroll 8
    for (int i = 0; i < 32; ++i) { const int kk = 2 * i + (lane >> 5), n = lane & 31; scr[kk * 33 + n] = n < nvalid ? W[(size_t)kk * ldw + n] : 0.f; }
    asm volatile("s_waitcnt lgkmcnt(0)" ::: "memory");
    const int c = lane & 7;
#pragma unroll
    for (int j = 0; j < 4; ++j) { const int n = (lane >> 3) + 8 * j; const LAS float* sp = scr + (8 * c) * 33 + n;
        u32x4 o; o.x = pg8::cvt_pk_bf16(sp[0 * 33], sp[1 * 33]); o.y = pg8::cvt_pk_bf16(sp[2 * 33], sp[3 * 33]); o.z = pg8::cvt_pk_bf16(sp[4 * 33], sp[5 * 33]); o.w = pg8::cvt_pk_bf16(sp[6 * 33], sp[7 * 33]);
        *(u32x4*)(dst + (size_t)(drow0 + (perm ? perm5(n) : n)) * K + k0 + 8 * c) = o; }
    asm volatile("s_waitcnt lgkmcnt(0)" ::: "memory");
}
constexpr int WI_0 = (N1P / 32) * (D / 64), WI_1 = WI_0 + (2 * D / 32) * (D / 64), WI_2 = WI_1 + (D / 32) * (MW / 64), WI_3 = WI_2 + (D / 32) * (RW / 64),
              WI_4 = WI_3 + (D / 32) * (D / 64), WI_5 = WI_4 + 2 * (FF / 32) * (D / 64), WI_6 = WI_5 + (D / 32) * (FF / 64), WI_7 = WI_6 + (RW / 32) * (128 / 64), WI_8 = WI_7 + 4 * (RW / 32);
__device__ __forceinline__ void wconv_phase(LAS unsigned char* lds, CParams& P, int l, int vb, int G) {
    const int tid = threadIdx.x, w = tid >> 6, lane = tid & 63;
    LAS float* scr = (LAS float*)(lds + w * 8704);
    for (int it = vb * 8 + w; it < WI_8; it += G * 8) {
        if (it < WI_0) { const int nb = it / (D / 64), kb = it % (D / 64); const int n0 = nb * 32; const int nv = n0 >= N1 ? 0 : (N1 - n0 < 32 ? N1 - n0 : 32);
            transpose_item(P.in[W_IN] + ((size_t)l * D + kb * 64) * PIN + n0, PIN, nv, WSP(bf16, O_WIN1), D, kb * 64, n0, true, scr, lane); }
        else if (it < WI_1) { const int r = it - WI_0, nb = r / (D / 64), kb = r % (D / 64);
            transpose_item(P.in[W_IN] + ((size_t)l * D + kb * 64) * PIN + N1 + nb * 32, PIN, 32, WSP(bf16, O_WIN2), D, kb * 64, nb * 32, true, scr, lane); }
        else if (it < WI_2) { const int r = it - WI_1, nb = r / (MW / 64), kb = r % (MW / 64);
            transpose_item(P.in[PROJ_M] + ((size_t)l * MW + kb * 64) * D + nb * 32, D, 32, WSP(bf16, O_PM), MW, kb * 64, nb * 32, true, scr, lane); }
        else if (it < WI_3) { const int r = it - WI_2, nb = r / (RW / 64), kb = r % (RW / 64);
            transpose_item(P.in[PROJ_R] + ((size_t)l * RW + kb * 64) * D + nb * 32, D, 32, WSP(bf16, O_PR), RW, kb * 64, nb * 32, true, scr, lane); }
        else if (it < WI_4) { const int r = it - WI_3, nb = r / (D / 64), kb = r % (D / 64);
            transpose_item(P.in[W_OUT] + ((size_t)l * D + kb * 64) * D + nb * 32, D, 32, WSP(bf16, O_WO), D, kb * 64, nb * 32, false, scr, lane); }
        else if (it < WI_5) { const int r = it - WI_4, which = r / ((FF / 32) * (D / 64)), r2 = r % ((FF / 32) * (D / 64)), nb = r2 / (D / 64), kb = r2 % (D / 64);
            const int j0 = nb * 32, pn = j0 >> 7, drow0 = pn * 256 + which * 128 + (j0 & 127);
            transpose_item((which ? P.in[FFN_W3] : P.in[FFN_W1]) + ((size_t)l * D + kb * 64) * FF + j0, FF, 32, WSP(bf16, O_W13), D, kb * 64, drow0, true, scr, lane); }
        else if (it < WI_6) { const int r = it - WI_5, nb = r / (FF / 64), kb = r % (FF / 64);
            transpose_item(P.in[FFN_W2] + ((size_t)l * FF + kb * 64) * D + nb * 32, D, 32, WSP(bf16, O_W2), FF, kb * 64, nb * 32, false, scr, lane); }
        else if (it < WI_7) { const int r = it - WI_6, nb = r / 2, kb = r % 2;
            transpose_item(P.in[R_G2] + ((size_t)l * 128 + kb * 64) * RW + nb * 32, RW, 32, WSP(bf16, O_G2T), 128, kb * 64, nb * 32, false, scr, lane); }
        else { const int r = it - WI_7, which = r / (2 * (RW / 32)), d = (r / (RW / 32)) & 1, nb = r % (RW / 32);
            transpose_item((which ? P.in[R_A2] : P.in[R_W2]) + ((size_t)l * 2 + d) * 64 * RW + nb * 32, RW, 32, WSP(bf16, which ? O_A2T : O_W2T) + (size_t)d * RW * 64, 64, 0, nb * 32, false, scr, lane); }
    }
}
__device__ __forceinline__ void norm_phase(CParams& P, int l, int mode, int vb, int G) {
    const int tid = threadIdx.x, w = tid >> 6, lane = tid & 63;
    for (int m = vb * 8 + w; m < NT; m += G * 8) {
        float* xr = P.out + (size_t)m * D;
        const float* xs = (l == 0 && mode < 2) ? (m < NC ? P.in[X_PROMPT] + (size_t)m * D : P.in[X_SAMPLE] + (size_t)(m - NC) * D) : xr;
        f32x4 v[D / 256]; float ss = 0.f;
#pragma unroll
        for (int j = 0; j < D / 256; ++j) { v[j] = *(const f32x4*)(xs + 256 * j + 4 * lane); ss += (v[j][0] * v[j][0] + v[j][1] * v[j][1]) + (v[j][2] * v[j][2] + v[j][3] * v[j][3]); }
        const float rs = 1.0f / sqrtf(wave_sum(ss) * (1.0f / D) + RMS_EPS);
        if (mode == 3) {
#pragma unroll
            for (int j = 0; j < D / 256; ++j) { const f32x4 g = *(const f32x4*)(P.in[FINAL_G] + 256 * j + 4 * lane); *(f32x4*)(xr + 256 * j + 4 * lane) = v[j] * rs * g; }
        } else {
            const int second = (mode == 2); const int cond = seqinfo(seq_of_token(m)).cond;
            const float* gp = P.in[second ? NORM2 : NORM1] + (size_t)l * D; const float* mod = WSP(float, WS_MOD) + ((size_t)l * NCOND + cond) * 6 * D + (second ? 3 * D : 0);
            bf16* o = WSP(bf16, mode == 1 ? WS_RXC : WS_QKC) + (size_t)m * D;
#pragma unroll
            for (int j = 0; j < D / 256; ++j) { const int c = 256 * j + 4 * lane; const f32x4 g = *(const f32x4*)(gp + c), sh = *(const f32x4*)(mod + c), sc = *(const f32x4*)(mod + D + c);
                const f32x4 y = v[j] * rs * g * (sc + 1.0f) + sh; u32x2 pk; pk.x = pg8::cvt_pk_bf16(y[0], y[1]); pk.y = pg8::cvt_pk_bf16(y[2], y[3]); *(u32x2*)(o + c) = pk; }
        }
    }
}
constexpr int CV_NCH = 2 * MW + RIN, CV_NG = CV_NCH / 4, CV_NCHUNK = (CV_NG + 63) / 64, CV_SEG = 16, CV_PAIRS = NC / (2 * CV_SEG);
static_assert(CV_NCHUNK == 12 && NC == NT - NC && GW % CV_SEG == 0 && CT % CV_SEG == 0 && 2 * MW == 1024 && RX_WL == 1536, "conv item layout");
typedef float f32x2 __attribute__((ext_vector_type(2)));
struct CvAct { float alpha, cA, cB, cC, cD; bool any; };
template <int NR> struct CvState { f32x2 wt[NR * 3][2]; f32x2 fw[NR][3][2]; u32x2 p[3][NR]; };
__device__ __forceinline__ void cv_unpk(const u32x2 p, f32x2 (&f)[2]) { f[0].x = pg8::bflo(p.x); f[0].y = pg8::bfhi(p.x); f[1].x = pg8::bflo(p.y); f[1].y = pg8::bfhi(p.y); }
template <int NR> __device__ __forceinline__ u32x2 cv_ld(const bf16* const (&rowp)[NR], const bool (&rok)[NR], int a, int col, int W) {
    const u32x2 zero2 = {0u, 0u};
    return (rok[a] && col >= 0 && col < W) ? *(const u32x2*)(rowp[a] + (size_t)col * PU) : zero2;
}
template <int NR, int S> __device__ __forceinline__ void cv_col(CvState<NR>& st, const bf16* const (&rowp)[NR], const bool (&rok)[NR], int cs, int W, int o, const CvAct& act, bf16* dst) {
#pragma unroll
    for (int a = 0; a < NR; ++a) { cv_unpk(st.p[S][a], st.fw[a][(S + 2) % 3]); const u32x2 zero2 = {0u, 0u}; st.p[S][a] = (o + 4 <= CV_SEG) ? cv_ld<NR>(rowp, rok, a, cs + o + 4, W) : zero2; }
    f32x2 acc[2];
#pragma unroll
    for (int e = 0; e < 2; ++e) acc[e] = st.wt[0][e] * st.fw[0][S][e];
#pragma unroll
    for (int a = 0; a < NR; ++a)
#pragma unroll
        for (int b = 0; b < 3; ++b) if (a + b > 0) {
#pragma unroll
            for (int e = 0; e < 2; ++e) acc[e] = __builtin_elementwise_fma(st.wt[a * 3 + b][e], st.fw[a][(S + b) % 3][e], acc[e]); }
    float v[4] = {acc[0].x, acc[0].y, acc[1].x, acc[1].y};
    if (act.any) {
#pragma unroll
        for (int e = 0; e < 4; ++e) { const float t = __builtin_amdgcn_rcpf(__builtin_amdgcn_exp2f(act.alpha * v[e]) + 1.0f); v[e] = (act.cA * v[e] + act.cB) * t + (act.cC * v[e] + act.cD); }
    }
    u32x2 pk; pk.x = pg8::cvt_pk_bf16(v[0], v[1]); pk.y = pg8::cvt_pk_bf16(v[2], v[3]);
    *(u32x2*)dst = pk;
}
template <int NR> __device__ __forceinline__ void conv_item(const bf16* const (&rowp)[NR], const bool (&rok)[NR], int cs, int W, const float* wsrc, int CH, const CvAct& act, bf16* dst, int dpitch) {
    CvState<NR> st;
#pragma unroll
    for (int a = 0; a < NR * 3; ++a) { const int tap = NR == 3 ? a : 3 + a; const f32x4 w0 = *(const f32x4*)(wsrc + (size_t)tap * CH);
        st.wt[a][0].x = w0[0]; st.wt[a][0].y = w0[1]; st.wt[a][1].x = w0[2]; st.wt[a][1].y = w0[3]; }
#pragma unroll
    for (int a = 0; a < NR; ++a) { cv_unpk(cv_ld<NR>(rowp, rok, a, cs - 1, W), st.fw[a][0]); cv_unpk(cv_ld<NR>(rowp, rok, a, cs, W), st.fw[a][1]); }
#pragma unroll
    for (int s3 = 0; s3 < 3; ++s3)
#pragma unroll
        for (int a = 0; a < NR; ++a) st.p[s3][a] = cv_ld<NR>(rowp, rok, a, cs + 1 + s3, W);
#pragma unroll 1
    for (int o = 0; o < CV_SEG - 1; o += 3) {
        cv_col<NR, 0>(st, rowp, rok, cs, W, o, act, dst + (size_t)o * dpitch);
        cv_col<NR, 1>(st, rowp, rok, cs, W, o + 1, act, dst + (size_t)(o + 1) * dpitch);
        cv_col<NR, 2>(st, rowp, rok, cs, W, o + 2, act, dst + (size_t)(o + 2) * dpitch);
    }
    cv_col<NR, 0>(st, rowp, rok, cs, W, CV_SEG - 1, act, dst + (size_t)(CV_SEG - 1) * dpitch);
}
__device__ __forceinline__ void conv_phase(LAS unsigned char* lds, CParams& P, int l, int vb, int G) {
    const int tid = threadIdx.x, lane = tid & 63;
    const bf16* U = WSP(bf16, WS_U1);
    LAS unsigned* cnt = (LAS unsigned*)lds;
    for (int sp = vb; sp < CV_PAIRS; sp += G) {
        __syncthreads();
        if (tid == 0) *cnt = 0u;
        __syncthreads();
        for (;;) {
            unsigned j = 0; if (lane == 0) j = __hip_atomic_fetch_add(cnt, 1u, __ATOMIC_RELAXED, __HIP_MEMORY_SCOPE_WORKGROUP);
            j = __builtin_amdgcn_readfirstlane(j);
            if (j >= 48u) break;
            const int cls = j / 12, jj = j % 12, lat = (cls & 1) == 0, heavy = cls < 2, ci = jj >> 1, chunk = heavy ? (ci >= 4 ? 6 + ci : ci) : 4 + ci;
            const int seg = (lat ? NC / CV_SEG : 0) + 2 * sp + (jj & 1), g = chunk * 64 + lane;
            if (g >= CV_NG) continue;
            const int ch = 4 * g; const bool isqk = ch < 2 * MW; const int c = isqk ? ch : ch - 2 * MW;
            const int ucol = isqk ? OFF_QK + c : OFF_R + c, CH = isqk ? 2 * MW : RIN;
            const float* wsrc = (isqk ? P.in[M_CONV] : P.in[R_CONV]) + (size_t)l * 9 * CH + c;
            const int kind = isqk ? (c < MW ? 0 : 1) : (c >= RX_GL ? 4 : (c >= RX_AL ? 2 : (c >= RX_WL ? 3 : 2)));
            CvAct act; act.alpha = kind == 3 ? 2.8853900817779268f : -1.4426950408889634f;
            act.cA = kind == 0 ? 0.08838834764831845f : (kind == 1 ? 1.0f : 0.0f); act.cB = kind == 3 ? -2.0f : (kind == 4 ? 1.0f : 0.0f); act.cC = kind == 2 ? 1.0f : 0.0f; act.cD = kind == 3 ? 1.0f : 0.0f;
            act.any = heavy;
            const int m0 = seg * CV_SEG; const SeqInfo q = seqinfo(seq_of_token(m0)); const int t0 = m0 - q.base;
            bf16* dst = isqk ? WSP(bf16, WS_QKC) + (size_t)m0 * (2 * MW) + c : WSP(bf16, WS_RXC) + (size_t)m0 * RIN + c; const int dpitch = isqk ? 2 * MW : RIN;
            if (q.grid) {
                const int r = t0 / GW, cs = t0 % GW, rows = q.T / GW;
                const bf16* rowp[3]; bool rok[3];
#pragma unroll
                for (int a = 0; a < 3; ++a) { const int rr = r + a - 1; rok[a] = rr >= 0 && rr < rows; rowp[a] = U + (size_t)(q.base + (rok[a] ? rr : r) * GW) * PU + ucol; }
                conv_item<3>(rowp, rok, cs, GW, wsrc, CH, act, dst, dpitch);
            } else {
                const bf16* rowp[1] = {U + (size_t)q.base * PU + ucol}; const bool rok[1] = {true};
                conv_item<1>(rowp, rok, t0, q.T, wsrc, CH, act, dst, dpitch);
            }
        }
    }
}
constexpr int PO_ITEMS = (NT / 16) * 2, PO_HC = RW / 2;
__device__ __forceinline__ void post_phase(LAS unsigned char* lds, CParams& P, int l, int vb, int G) {
    const int tid = threadIdx.x, w = tid >> 6, lane = tid & 63, fr = lane & 15, fq = lane >> 4, l32 = lane & 31, th = lane >> 5;
    constexpr int GP = PO_HC * 2 + 16;
    LAS unsigned char* gt = lds + w * (16 * GP);
    const bf16* U = WSP(bf16, WS_U1); const bf16* RX = WSP(bf16, WS_RXC); const bf16* G2T = WSP(bf16, O_G2T); bf16* O = WSP(bf16, WS_QKC);
    for (int it = vb * 8 + w; it < PO_ITEMS; it += G * 8) {
        const int tile = it >> 1, h = it & 1; const size_t tok0 = (size_t)tile * 16;
        bf16x8 af[4];
#pragma unroll
        for (int ks = 0; ks < 4; ++ks) af[ks] = *(const bf16x8*)(RX + (tok0 + fr) * RIN + RX_GL + 32 * ks + 8 * fq);
        for (int ct = 0; ct < PO_HC / 16; ++ct) { f32x4 acc = (f32x4){0.f, 0.f, 0.f, 0.f};
#pragma unroll
            for (int ks = 0; ks < 4; ++ks) acc = ml::mma(af[ks], *(const bf16x8*)(G2T + (size_t)(h * PO_HC + 16 * ct + fr) * 128 + 32 * ks + 8 * fq), acc);
#pragma unroll
            for (int r = 0; r < 4; ++r) *(LAS bf16*)(gt + (4 * fq + r) * GP + (16 * ct + fr) * 2) = f2bf(acc[r]); }
        asm volatile("s_waitcnt lgkmcnt(0)" ::: "memory");
        const int cb = h * PO_HC + 8 * l32;
        float gn[8], gw[8], gb[8], rk[8];
        { const f32x4 a0 = *(const f32x4*)(P.in[M_NORM_G] + (size_t)l * MW + cb), a1 = *(const f32x4*)(P.in[M_NORM_G] + (size_t)l * MW + cb + 4);
          const f32x4 b0 = *(const f32x4*)(P.in[R_GN_W] + (size_t)l * RW + cb), b1 = *(const f32x4*)(P.in[R_GN_W] + (size_t)l * RW + cb + 4);
          const f32x4 c0 = *(const f32x4*)(P.in[R_GN_B] + (size_t)l * RW + cb), c1 = *(const f32x4*)(P.in[R_GN_B] + (size_t)l * RW + cb + 4);
          const f32x4 d0 = *(const f32x4*)(P.in[R_RK] + (size_t)l * RW + cb), d1 = *(const f32x4*)(P.in[R_RK] + (size_t)l * RW + cb + 4);
#pragma unroll
          for (int e = 0; e < 4; ++e) { gn[e] = a0[e]; gn[4 + e] = a1[e]; gw[e] = b0[e]; gw[4 + e] = b1[e]; gb[e] = c0[e]; gb[4 + e] = c1[e]; rk[e] = d0[e]; rk[4 + e] = d1[e]; } }
        for (int tp = 0; tp < 8; ++tp) { const int tl = 2 * tp + th; const size_t m = tok0 + tl; const bf16* u = U + m * PU; const bf16* rx = RX + m * RIN;
            float hf[8], hb[8], ov[8], x[8]; unpack8(*(const u32x4*)(u + cb), hf); unpack8(*(const u32x4*)(u + MW + cb), hb); unpack8(*(const u32x4*)(u + OFF_O + cb), ov);
            float ss = 0.f;
#pragma unroll
            for (int e = 0; e < 8; ++e) { x[e] = hf[e] + hb[e]; ss += x[e] * x[e]; }
            ss = rw::allsum16(ss); const float rs = 1.0f / sqrtf(ss * (1.0f / 128.f) + RMS_EPS);
#pragma unroll
            for (int e = 0; e < 8; ++e) x[e] = x[e] * rs * gn[e] * pg8::fsigmoid(ov[e]);
            *(u32x4*)(O + m * D + cb) = pack8(x);
            float yf[8], yb[8], rr[8], kk[8], vv[8], gg[8], y[8]; unpack8(*(const u32x4*)(u + OFF_R + cb), yf); unpack8(*(const u32x4*)(u + OFF_R + RW + cb), yb);
            unpack8(*(const u32x4*)(rx + RX_R + cb), rr); unpack8(*(const u32x4*)(rx + RX_K + cb), kk); unpack8(*(const u32x4*)(rx + RX_V + cb), vv);
            unpack8(*(const LAS u32x4*)(gt + tl * GP + l32 * 16), gg);
            float mu = 0.f, bs = 0.f;
#pragma unroll
            for (int e = 0; e < 8; ++e) { y[e] = yf[e] + yb[e]; mu += y[e]; bs += rr[e] * kk[e] * rk[e]; }
            mu += rw::dpp_xor1(mu); mu += rw::dpp_xor2(mu); mu += __shfl_xor(mu, 4); mu *= (1.0f / 64.f);
            bs += rw::dpp_xor1(bs); bs += rw::dpp_xor2(bs); bs += __shfl_xor(bs, 4);
            float var = 0.f;
#pragma unroll
            for (int e = 0; e < 8; ++e) { y[e] -= mu; var += y[e] * y[e]; }
            var += rw::dpp_xor1(var); var += rw::dpp_xor2(var); var += __shfl_xor(var, 4); var *= (1.0f / 64.f);
            const float rsd = 1.0f / sqrtf(var + GN_EPS);
#pragma unroll
            for (int e = 0; e < 8; ++e) y[e] = (y[e] * rsd * gw[e] + gb[e] + bs * vv[e]) * gg[e];
            *(u32x4*)(O + m * D + MW + cb) = pack8(y);
        }
        asm volatile("s_waitcnt lgkmcnt(0)" ::: "memory");
    }
}
}

constexpr int LDS_BYTES = 147456;
constexpr int LDS_MISC = 147456 - 1024;
constexpr size_t CTL_ZERO_BYTES = 262144;
constexpr int CW_BAR = 4096, CW_Q = 8192;

#define XB_TMO      128
#define XB_XCNT(j)  (256  + 64 * (j))
#define XB_XSUB(j)  (1280 + 64 * (j))
#define XB_XGEN(j)  (2304 + 64 * (j))
#define XB_TOP      3328
#define XB_TOPGEN   3392
#define XCD_BAR_WORDS 3456
#define XB_SPIN_CAP (1u << 18)
__device__ __forceinline__ unsigned xb_ld(unsigned* p)              { return __hip_atomic_load(p, __ATOMIC_RELAXED, __HIP_MEMORY_SCOPE_AGENT); }
__device__ __forceinline__ unsigned xb_add(unsigned* p, unsigned v) { return __hip_atomic_fetch_add(p, v, __ATOMIC_RELAXED, __HIP_MEMORY_SCOPE_AGENT); }
__device__ __forceinline__ unsigned xb_xcc_id() { return (unsigned)__builtin_amdgcn_s_getreg((3 << 11) | 20) & 0xFu; }
#define XB_SPIN(cond, bar) do { unsigned _sp = 0; while (cond) { __builtin_amdgcn_s_sleep(1); \
    if ((++_sp & 255u) == 0u) { if (xb_ld(&(bar)[XB_TMO])) break; if (_sp > XB_SPIN_CAP) { atomicAdd(&(bar)[XB_TMO], 1u); break; } } } } while (0)
struct XcdBarrier { unsigned* bar; unsigned x; volatile LAS unsigned* st; };
__device__ __forceinline__ XcdBarrier xcd_barrier_post(unsigned* bar, volatile LAS unsigned* st) {
    XcdBarrier b; b.bar = bar; b.x = xb_xcc_id(); b.st = st;
    if (threadIdx.x == 0) (void)xb_add(&bar[XB_XCNT(b.x)], 1u);
    return b;
}
__device__ __forceinline__ void xcd_barrier_complete(unsigned* bar, unsigned x, unsigned& nloc, unsigned& nx) {
    const unsigned G = gridDim.x * gridDim.y * gridDim.z;
    unsigned sum, cnt, mine, sp = 0u;
    for (;;) {
        sum = 0u; cnt = 0u; mine = 0u;
#pragma unroll
        for (unsigned j = 0; j < 16; ++j) { const unsigned c = xb_ld(&bar[XB_XCNT(j)]); sum += c; cnt += (c > 0u) ? 1u : 0u; mine = (j == x) ? c : mine; }
        if (sum == G) break;
        __builtin_amdgcn_s_sleep(1);
        if ((++sp & 255u) == 0u) { if (xb_ld(&bar[XB_TMO])) break; if (sp > XB_SPIN_CAP) { atomicAdd(&bar[XB_TMO], 1u); break; } }
    }
    nloc = mine > 0u ? mine : 1u; nx = cnt > 0u ? cnt : 1u;
}
__device__ __forceinline__ void xcd_barrier(const XcdBarrier& b) {
    asm volatile("s_waitcnt vmcnt(0)" ::: "memory");
    __syncthreads();
    if (threadIdx.x == 0) {
        unsigned* bar = b.bar;
        __builtin_amdgcn_s_waitcnt(0);
        unsigned nloc = b.st[0], nx = b.st[1];
        if (nloc == 0u) { xcd_barrier_complete(bar, b.x, nloc, nx); b.st[0] = nloc; b.st[1] = nx; }
        const unsigned old = xb_add(&bar[XB_XSUB(b.x)], 1u);
        const unsigned gen = old / nloc;
        if (old + 1u == (gen + 1u) * nloc) {
            __builtin_amdgcn_fence(__ATOMIC_RELEASE, "agent");
            asm volatile("s_waitcnt vmcnt(0)" ::: "memory");
            const unsigned og = xb_add(&bar[XB_TOP], 1u);
            const unsigned tg = og / nx;
            if (og + 1u == (tg + 1u) * nx) xb_add(&bar[XB_TOPGEN], 1u);
            else XB_SPIN(xb_ld(&bar[XB_TOPGEN]) == tg, bar);
            __builtin_amdgcn_fence(__ATOMIC_ACQUIRE, "agent");
            xb_add(&bar[XB_XGEN(b.x)], 1u);
            asm volatile("s_waitcnt vmcnt(0)" ::: "memory");
        } else {
            XB_SPIN(xb_ld(&bar[XB_XGEN(b.x)]) == gen, bar);
            __builtin_amdgcn_fence(__ATOMIC_ACQUIRE, "agent");
            asm volatile("s_waitcnt vmcnt(0)" ::: "memory");
        }
    }
    __syncthreads();
}

constexpr int MX_RL = LB * RH * 2 * 4, MX_ML = LB * MH * 2 * ml::NVB, MX_RC = CB * RH * 2 * 4, MX_MC = CB * MH * 2 * ml::NVB;
constexpr int MX_ITEMS = MX_RL + MX_ML + MX_RC + MX_MC;

constexpr int ML_SPLIT = 0;
__device__ __forceinline__ void scan_phase(LAS unsigned char* lds, CParams& P, int l, unsigned* ctl) {
    unsigned* qhead = ctl + CW_Q + 64 * l;
    const bool split = gridDim.x >= 4 * wy::N_LAT * (1 + wy::NPROD) / 2;
    volatile LAS unsigned* bc = (volatile LAS unsigned*)(lds + LDS_MISC) + 16;
    for (;;) {
        if (threadIdx.x == 0) bc[0] = xb_add(qhead, 1u);
        __syncthreads();
        const int it = (int)bc[0];
        __syncthreads();
        if (!split || it >= wy::N_LAT) break;
        int s_, head, dir; wy::decode_item(it, s_, head, dir);
        wy::rwkv_cons(lds, P, l, s_, head, dir, it, ctl);
    }
    for (;;) {
        if (threadIdx.x == 0) bc[0] = xb_add(qhead + 8, 1u);
        __syncthreads();
        const int it = (int)bc[0];
        __syncthreads();
        if (it >= ML_SPLIT * ms::N_MLAT) break;
        int s_, head, dir, sub; ml::decode_item(it * ml::NVB, s_, head, dir, sub);
        ms::ml_cons(lds, P, l, s_, head, dir, it, ctl);
    }
    for (;;) {
        if (threadIdx.x == 0) bc[0] = xb_add(qhead + 48, 1u);
        __syncthreads();
        const int it = (int)bc[0];
        __syncthreads();
        if (!split || it >= wy::N_LAT * wy::NPROD) break;
        const int chain = it % wy::N_LAT;
        int s_, head, dir; wy::decode_item(chain, s_, head, dir);
        wy::rwkv_prod(lds, P, l, s_, head, dir, chain, it / wy::N_LAT, ctl);
    }
    for (;;) {
        if (threadIdx.x == 0) bc[0] = xb_add(qhead + 24, 1u);
        __syncthreads();
        const int it = (int)bc[0];
        __syncthreads();
        if (it >= ML_SPLIT * ms::N_MLAT * ms::MLPROD) break;
        const int chain = it % ms::N_MLAT;
        int s_, head, dir, sub; ml::decode_item(chain * ml::NVB, s_, head, dir, sub);
        ms::ml_prod(lds, P, l, s_, head, dir, chain, it / ms::N_MLAT, ctl);
    }
    for (;;) {
        if (threadIdx.x == 0) bc[0] = xb_add(qhead + 16, 1u);
        __syncthreads();
        const int it = (int)bc[0] + ML_SPLIT * ms::N_MLAT * ml::NVB;
        __syncthreads();
        if (it >= ml::N_ITEMS) break;
        int s_, head, dir, sub; ml::decode_item(it, s_, head, dir, sub);
        ml::mlstm_item2(lds, P, l, s_, head, dir, sub);
    }
    for (;;) {
        if (threadIdx.x == 0) bc[0] = xb_add(qhead + 32, 1u);
        __syncthreads();
        const int it = (int)bc[0] + (split ? LB * RH * 2 : 0);
        __syncthreads();
        if (it >= wy::N_ITEMS) break;
        int s_, head, dir; wy::decode_item(it, s_, head, dir);
        wy::rwkv_item(lds, P, l, s_, head, dir);
    }
}

enum { ST_N0 = 0, ST_A1, ST_CV, ST_MX, ST_PO, ST_N1, ST_A2, ST_PJ, ST_WO, ST_N2, ST_F1, ST_F2, ST_PER_LAYER };
constexpr int N_STEPS = 1 + DEPTH * ST_PER_LAYER + 1;
struct MkArgs { Params P; int ph_lo, ph_hi; };
__global__ void __launch_bounds__(512, 2) mk(MkArgs a) {
    extern __shared__ __attribute__((aligned(16))) unsigned char lds_raw[];
    LAS unsigned char* lds = (LAS unsigned char*)lds_raw;
    const int G = gridDim.x, vb = (int)blockIdx.x;
    unsigned* ctl = (unsigned*)(a.P.ws + WS_CTL);
    volatile LAS unsigned* MISC = (volatile LAS unsigned*)(lds + LDS_MISC);
    for (int u = threadIdx.x; u < 64; u += 512) MISC[u] = 0u;
    __syncthreads();
    const bool multi = a.ph_hi - a.ph_lo > 1;
    XcdBarrier bar; bar.bar = ctl + CW_BAR; bar.x = 0; bar.st = nullptr;
    if (multi) bar = xcd_barrier_post(ctl + CW_BAR, MISC + 8);
    const int lo = a.ph_lo, hi = a.ph_hi;
#define STEP_BEGIN(id) if (lo <= (id) && (id) < hi) { unsigned long long kp_ = (unsigned long long)__builtin_amdgcn_kernarg_segment_ptr(); asm volatile("" : "+s"(kp_)); CParams& P = *(CParams*)kp_;
#define STEP_END(id) if ((id) + 1 < hi) xcd_barrier(bar); }
    STEP_BEGIN(0) el::init_phase(lds, P, vb, G); el::wconv_phase(lds, P, 0, vb, G); STEP_END(0)
#define LAYER(l) { \
        const int base = 1 + (l) * ST_PER_LAYER; \
        STEP_BEGIN(base + ST_N0) if ((l) > 0) el::wconv_phase(lds, P, (l), vb, G); el::norm_phase(P, (l), 0, vb, G); STEP_END(base + ST_N0) \
        STEP_BEGIN(base + ST_A1) { pg8::Gemm g{WSP(bf16, WS_QKC), WSP(bf16, O_WIN1), D, D}; pg8::StaticOrder S; S.init(NT, N1P, G, vb); \
            pg8::EpiA1 E{WSP(bf16, WS_U1)}; pg8::gemm_phase(lds, g, S, E); } STEP_END(base + ST_A1) \
        STEP_BEGIN(base + ST_CV) el::conv_phase(lds, P, (l), vb, G); STEP_END(base + ST_CV) \
        STEP_BEGIN(base + ST_MX) scan_phase(lds, P, (l), ctl); STEP_END(base + ST_MX) \
        STEP_BEGIN(base + ST_PO) el::post_phase(lds, P, (l), vb, G); STEP_END(base + ST_PO) \
        STEP_BEGIN(base + ST_N1) el::norm_phase(P, (l), 1, vb, G); STEP_END(base + ST_N1) \
        STEP_BEGIN(base + ST_A2) { pg8::Gemm g{WSP(bf16, WS_RXC), WSP(bf16, O_WIN2), D, D}; pg8::StaticOrder S; S.init(NT, 2 * D, G, vb); \
            pg8::EpiA2 E{WSP(bf16, WS_U1)}; pg8::gemm_phase(lds, g, S, E); } STEP_END(base + ST_A2) \
        STEP_BEGIN(base + ST_PJ) { pg8::Gemm g{WSP(bf16, WS_QKC), WSP(bf16, O_PM), MW, D}; pg8::PairOrder S; S.init(NT, G, vb); \
            pg8::EpiPJ E{WSP(bf16, WS_U1)}; pg8::gemm_phase(lds, g, S, E); } STEP_END(base + ST_PJ) \
        STEP_BEGIN(base + ST_WO) { pg8::Gemm g{WSP(bf16, WS_U1), WSP(bf16, O_WO), D, PU}; pg8::StaticOrder S; S.init(NT, D, G, vb); \
            pg8::EpiRes E{P.out, WSP(float, WS_MOD) + (size_t)(l) * NCOND * 6 * D + 2 * D, (l) == 0 ? P.in[X_PROMPT] : nullptr, (l) == 0 ? P.in[X_SAMPLE] : nullptr}; pg8::gemm_phase(lds, g, S, E); } STEP_END(base + ST_WO) \
        STEP_BEGIN(base + ST_N2) el::norm_phase(P, (l), 2, vb, G); STEP_END(base + ST_N2) \
        STEP_BEGIN(base + ST_F1) { pg8::Gemm g{WSP(bf16, WS_QKC), WSP(bf16, O_W13), D, D}; pg8::StaticOrder S; S.init(NT, 2 * FF, G, vb); \
            pg8::EpiF1 E{WSP(bf16, WS_U1)}; pg8::gemm_phase(lds, g, S, E); } STEP_END(base + ST_F1) \
        STEP_BEGIN(base + ST_F2) { pg8::Gemm g{WSP(bf16, WS_U1), WSP(bf16, O_W2), FF, FF}; pg8::StaticOrder S; S.init(NT, D, G, vb); \
            pg8::EpiRes E{P.out, WSP(float, WS_MOD) + (size_t)(l) * NCOND * 6 * D + 5 * D, nullptr, nullptr}; pg8::gemm_phase(lds, g, S, E); } STEP_END(base + ST_F2) \
    }
    static_assert(DEPTH == 2, "layers are unrolled by hand");
    LAYER(0)
    LAYER(1)
#undef LAYER
    STEP_BEGIN(N_STEPS - 1) el::norm_phase(P, 0, 3, vb, G); STEP_END(N_STEPS - 1)
#undef STEP_BEGIN
#undef STEP_END
}
#endif

typedef void (*BodyFn)(const Params&, long);
#ifndef HOST_EMU
template <BodyFn F, int BLOCK> __global__ void __launch_bounds__(BLOCK) run_k(Params P, long n) {
    const long i = (long)blockIdx.x * BLOCK + threadIdx.x;
    if (i < n) F(P, i);
}
#define RUN(F, BLOCK, n) do { const long n_ = (n); run_k<F, BLOCK><<<dim3((unsigned)((n_ + BLOCK - 1) / BLOCK)), dim3(BLOCK), 0, stream>>>(P, n_); } while (0)
static int g_grid = 0;
#else
#define RUN(F, BLOCK, n) do { const long n_ = (n); for (long i_ = 0; i_ < n_; ++i_) F(P, i_); } while (0)
typedef void* hipStream_t;
#endif

static void forward(Params P, hipStream_t stream) {
    (void)stream;
#ifndef HOST_EMU
    if (hipMemsetAsync(P.ws + WS_CTL, 0, CTL_ZERO_BYTES, stream) != hipSuccess) return;
#ifdef MK_PER_STEP
    for (int st = 0; st < N_STEPS; ++st) { MkArgs a_{}; a_.P = P; a_.ph_lo = st; a_.ph_hi = st + 1; mk<<<dim3(g_grid), dim3(512), LDS_BYTES, stream>>>(a_); }
#else
    { MkArgs a_{}; a_.P = P; a_.ph_lo = 0; a_.ph_hi = N_STEPS; mk<<<dim3(g_grid), dim3(512), LDS_BYTES, stream>>>(a_); }
#endif
#else
    RUN(k_init_x, 256, (long)NT * D);
    RUN(k_mod, 256, (long)DEPTH * NCOND * 6 * D);
    for (int l = 0; l < DEPTH; ++l) {
        P.layer = l;
        RUN(k_wconv, 256, WC_N6);
        P.mode = 0; RUN(k_norm, 64, (long)NT);
        RUN(k_gemm_a1, 256, (long)NT * N1);
        RUN(k_conv, 256, (long)NT * (2 * MW + RIN));
        RUN(k_mlstm, 128, (long)NSEQ * MH * 2 * 128);
        for (int dir = 0; dir < 2; ++dir) { P.mode = dir; RUN(k_rwkv_prep, 256, (long)NT * RW); RUN(k_rwkv, 64, (long)NSEQ * RH * 64); }
        RUN(k_post, 256, (long)NT * D);
        P.mode = 1; RUN(k_norm, 64, (long)NT);
        RUN(k_gemm_a2, 256, (long)NT * 2 * D);
        RUN(k_gemm_pj, 256, (long)NT * D);
        RUN(k_gemm_wo, 256, (long)NT * D);
        P.mode = 2; RUN(k_norm, 64, (long)NT);
        RUN(k_gemm_f1, 256, (long)NT * FF);
        RUN(k_gemm_f2, 256, (long)NT * D);
    }
    RUN(k_final, 64, (long)NT);
#endif
}

#ifndef HOST_EMU
extern "C" void kernel_launch(void* const* d_in, const int* in_sizes, int n_in, void* d_out, int out_size, void* d_ws, size_t ws_size, hipStream_t stream) {
    if (n_in != N_IN || (size_t)out_size != OUT_END || ws_size < WS_END) return;
    if (g_grid == 0) {
        int dev = 0, cus = 0;
        if (hipGetDevice(&dev) != hipSuccess || hipDeviceGetAttribute(&cus, hipDeviceAttributeMultiprocessorCount, dev) != hipSuccess) { g_grid = -1; return; }
        if (hipFuncSetAttribute((const void*)mk, hipFuncAttributeMaxDynamicSharedMemorySize, LDS_BYTES) != hipSuccess) { g_grid = -1; return; }
        g_grid = cus;
    }
    if (g_grid < 0) return;
    Params P{};
    for (int i = 0; i < N_IN; ++i) P.in[i] = (const float*)d_in[i];
    P.out = (float*)d_out; P.ws = (unsigned char*)d_ws; P.layer = 0; P.mode = 0;
    forward(P, stream);
}
#endif
```

```cpp
#ifndef HOST_EMU
#include <hip/hip_runtime.h>
#define HD __host__ __device__ __forceinline__
#define DEV __device__ __forceinline__
#else
#include <cmath>
#include <cstring>
#include <cstdio>
#include <cstdlib>
#define HD inline
#define DEV inline
#endif
#include <cstddef>

#ifdef SMALL_CFG
constexpr int D = 256, CB = 2, CT = 128, DEPTH = 2, LB = 1, LT = 256, GW = 16;
#else
constexpr int D = 1024, CB = 32, CT = 256, DEPTH = 2, LB = 2, LT = 4096, GW = 64;
#endif
constexpr int MW = D / 2, MD = 128, MH = MW / MD, RW = D / 2, RD = 64, RH = RW / RD;
constexpr int RIN = 3 * RW + 384, FF = ((8 * D + 767) / 768) * 256, PIN = 2 * MW + MW + MW + 4 * MH + RIN + 2 * D;
constexpr int NC = CB * CT, NL = LB * LT, NT = NC + NL, NSEQ = CB + LB, NCOND = 1 + LB;
constexpr int N1 = PIN - 2 * D;
constexpr int N1P = ((N1 + 255) / 256) * 256;
constexpr int PU = N1;
constexpr int OFF_QK = 0, OFF_V = 2 * MW, OFF_O = 3 * MW, OFF_G = 4 * MW, OFF_R = 4 * MW + 4 * MH;
constexpr int RX_R = 0, RX_K = RW, RX_V = 2 * RW, RX_WL = 3 * RW, RX_AL = 3 * RW + 128, RX_GL = 3 * RW + 256;
constexpr float RMS_EPS = 1e-6f, GN_EPS = 64e-5f;
static_assert(3 * D <= N1, "G + merged must fit the dead columns of U1");

enum { X_PROMPT = 0, X_SAMPLE, ST_C, ST_N, ST_M, ST_R, C_LAT, C_CTX, ADA_W, ADA_B, NORM1, NORM2, W_IN, M_CONV, M_GATE_B, M_NORM_G,
       R_CONV, R_W0, R_W2, R_A0, R_A2, R_G2, R_KK, R_KA, R_RK, R_GN_W, R_GN_B, PROJ_M, PROJ_R, W_OUT, FFN_W1, FFN_W3, FFN_W2, FINAL_G, N_IN };

constexpr size_t OUT_X = 0;
constexpr size_t OUT_C = (size_t)NT * D;
constexpr size_t OUT_N = OUT_C + (size_t)CB * DEPTH * 2 * MH * 128 * 128;
constexpr size_t OUT_M = OUT_N + (size_t)CB * DEPTH * 2 * MH * 128;
constexpr size_t OUT_S = OUT_M + (size_t)CB * DEPTH * 2 * MH;
constexpr size_t OUT_END = OUT_S + (size_t)CB * DEPTH * 2 * RH * 64 * 64;

constexpr size_t al256(size_t x) { return (x + 255) & ~(size_t)255; }
constexpr size_t cmax(size_t a, size_t b) { return a > b ? a : b; }
constexpr size_t WS_CTL = 0;
constexpr size_t WS_MOD = (size_t)1 << 20;
constexpr size_t WS_WREG = (size_t)2 << 20;
constexpr size_t O_WIN1 = WS_WREG;
constexpr size_t O_WIN2 = O_WIN1 + (size_t)N1P * D * 2;
constexpr size_t O_PM = O_WIN2 + (size_t)2 * D * D * 2;
constexpr size_t O_PR = O_PM + (size_t)D * MW * 2;
constexpr size_t O_WO = O_PR + (size_t)D * RW * 2;
constexpr size_t O_W13 = O_WO + (size_t)D * D * 2;
constexpr size_t O_W2 = O_W13 + (size_t)2 * FF * D * 2;
constexpr size_t O_G2T = O_W2 + (size_t)D * FF * 2;
constexpr size_t O_W2T = O_G2T + (size_t)RW * 128 * 2;
constexpr size_t O_A2T = O_W2T + (size_t)2 * RW * 64 * 2;
constexpr size_t WS_U1 = al256(O_A2T + (size_t)2 * RW * 64 * 2);
constexpr size_t SZ_U1 = al256(cmax((size_t)NT * PU * 2, (size_t)NT * FF * 2));
constexpr size_t WS_QKC = WS_U1 + SZ_U1;
constexpr size_t WS_RXC = WS_QKC + (size_t)NT * D * 2;
constexpr size_t WS_END = WS_RXC + al256(cmax((size_t)NT * RIN * 2, (size_t)NT * D * 2));
#ifndef SMALL_CFG
static_assert(WS_END <= ((size_t)256 << 20), "workspace map must fit 256 MiB");
#endif

typedef unsigned short bf16;
HD float bf2f(bf16 b) { unsigned u = ((unsigned)b) << 16; return __builtin_bit_cast(float, u); }
#if defined(__HIP_DEVICE_COMPILE__)
HD bf16 f2bf(float f) { return __builtin_bit_cast(bf16, (__bf16)f); }
#else
HD bf16 f2bf(float f) { unsigned u = __builtin_bit_cast(unsigned, f); u += 0x7fffu + ((u >> 16) & 1u); return (bf16)(u >> 16); }
#endif
HD float sigmoidf_(float x) { return 1.0f / (1.0f + expf(-x)); }
HD float siluf_(float x) { return x / (1.0f + expf(-x)); }
HD float softplusf_(float x) { return fmaxf(x, 0.f) + log1pf(expf(-fabsf(x))); }
HD float logsigmoidf_(float x) { return -softplusf_(-x); }
HD int prow(int c) { return (c & ~31) | (((c >> 2) & 1) << 4) | (((c >> 3) & 3) << 2) | (c & 3); }

struct Params {
    const float* in[N_IN];
    float* out;
    unsigned char* ws;
    int layer;
    int mode;
};

struct SeqInfo { int T; int base; int grid; int cond; int b; };
HD SeqInfo seqinfo(int s) {
    SeqInfo q;
    if (s < CB) { q.T = CT; q.base = s * CT; q.grid = 0; q.cond = 0; q.b = s; }
    else { q.T = LT; q.base = NC + (s - CB) * LT; q.grid = 1; q.cond = 1 + (s - CB); q.b = s - CB; }
    return q;
}
HD int seq_of_token(int m) { return m < NC ? m / CT : CB + (m - NC) / LT; }

#define WSP(T, off) ((T*)(P.ws + (off)))

DEV void k_init_x(const Params& P, long i) {
    const size_t ncd = (size_t)NC * D;
    P.out[i] = (size_t)i < ncd ? P.in[X_PROMPT][i] : P.in[X_SAMPLE][i - ncd];
}
DEV void k_mod(const Params& P, long i) {
    const int j = (int)(i % (6 * D)); const int ci = (int)((i / (6 * D)) % NCOND); const int l = (int)(i / ((long)6 * D * NCOND));
    const float* cv = ci == 0 ? P.in[C_CTX] : P.in[C_LAT] + (size_t)(ci - 1) * D;
    const float* w = P.in[ADA_W] + (size_t)l * D * 6 * D;
    float acc = P.in[ADA_B][(size_t)l * 6 * D + j];
    for (int k = 0; k < D; ++k) acc += siluf_(cv[k]) * w[(size_t)k * 6 * D + j];
    WSP(float, WS_MOD)[i] = acc;
}
constexpr long WC_N0 = (long)N1P * D, WC_N1 = WC_N0 + (long)2 * D * D, WC_N2 = WC_N1 + (long)D * MW, WC_N3 = WC_N2 + (long)D * RW,
               WC_N4 = WC_N3 + (long)D * D, WC_N5 = WC_N4 + (long)2 * FF * D, WC_N6 = WC_N5 + (long)D * FF;
HD int unprow(int r) { return (r & ~31) | (((r >> 2) & 3) << 3) | (((r >> 4) & 1) << 2) | (r & 3); }
DEV void k_wconv(const Params& P, long i) {
    const int l = P.layer;
    if (i < WC_N0) { const int r = (int)(i / D), k = (int)(i % D); const int c = unprow(r);
        WSP(bf16, O_WIN1)[i] = c < N1 ? f2bf(P.in[W_IN][((size_t)l * D + k) * PIN + c]) : (bf16)0; return; }
    if (i < WC_N1) { const long j = i - WC_N0; const int r = (int)(j / D), k = (int)(j % D); const int c = unprow(r);
        WSP(bf16, O_WIN2)[j] = f2bf(P.in[W_IN][((size_t)l * D + k) * PIN + N1 + c]); return; }
    if (i < WC_N2) { const long j = i - WC_N1; const int r = (int)(j / MW), k = (int)(j % MW); const int c = unprow(r);
        WSP(bf16, O_PM)[j] = f2bf(P.in[PROJ_M][((size_t)l * MW + k) * D + c]); return; }
    if (i < WC_N3) { const long j = i - WC_N2; const int r = (int)(j / RW), k = (int)(j % RW); const int c = unprow(r);
        WSP(bf16, O_PR)[j] = f2bf(P.in[PROJ_R][((size_t)l * RW + k) * D + c]); return; }
    if (i < WC_N4) { const long j = i - WC_N3; const int r = (int)(j / D), k = (int)(j % D);
        WSP(bf16, O_WO)[j] = f2bf(P.in[W_OUT][((size_t)l * D + k) * D + r]); return; }
    if (i < WC_N5) { const long j = i - WC_N4; const int r = (int)(j / D), k = (int)(j % D);
        const int pn = r >> 8, rl = r & 255, which = rl >> 7, rho = rl & 127; const int jj = pn * 128 + unprow(rho);
        const float* W = which ? P.in[FFN_W3] : P.in[FFN_W1];
        WSP(bf16, O_W13)[j] = f2bf(W[((size_t)l * D + k) * FF + jj]); return; }
    { const long j = i - WC_N5; const int r = (int)(j / FF), k = (int)(j % FF);
        WSP(bf16, O_W2)[j] = f2bf(P.in[FFN_W2][((size_t)l * FF + k) * D + r]); }
}
DEV void k_norm(const Params& P, long m) {
    const int l = P.layer; const int second = (P.mode == 2);
    const float* x = P.out + (size_t)m * D;
    const float* g = P.in[second ? NORM2 : NORM1] + (size_t)l * D;
    const int cond = seqinfo(seq_of_token((int)m)).cond;
    const float* mod = WSP(float, WS_MOD) + ((size_t)l * NCOND + cond) * 6 * D + (second ? 3 * D : 0);
    float ss = 0.f;
    for (int k = 0; k < D; ++k) ss += x[k] * x[k];
    const float rs = 1.0f / sqrtf(ss / D + RMS_EPS);
    bf16* o = WSP(bf16, P.mode == 1 ? WS_RXC : WS_QKC) + (size_t)m * D;
    for (int k = 0; k < D; ++k) o[k] = f2bf(x[k] * rs * g[k] * (1.0f + mod[D + k]) + mod[k]);
}
DEV float dot_bf(const bf16* a, const bf16* b, int K) { float s = 0.f; for (int k = 0; k < K; ++k) s += bf2f(a[k]) * bf2f(b[k]); return s; }
DEV void k_gemm_a1(const Params& P, long i) {
    const int n = (int)(i % N1); const long m = i / N1;
    WSP(bf16, WS_U1)[(size_t)m * PU + n] = f2bf(dot_bf(WSP(bf16, WS_QKC) + (size_t)m * D, WSP(bf16, O_WIN1) + (size_t)prow(n) * D, D));
}
DEV void k_gemm_a2(const Params& P, long i) {
    const int n = (int)(i % (2 * D)); const long m = i / (2 * D);
    WSP(bf16, WS_U1)[(size_t)m * PU + D + n] = f2bf(sigmoidf_(dot_bf(WSP(bf16, WS_RXC) + (size_t)m * D, WSP(bf16, O_WIN2) + (size_t)prow(n) * D, D)));
}
DEV void k_gemm_pj(const Params& P, long i) {
    const int n = (int)(i % D); const long m = i / D;
    const bf16* hmr = WSP(bf16, WS_QKC) + (size_t)m * D; bf16* u = WSP(bf16, WS_U1) + (size_t)m * PU;
    const float a = dot_bf(hmr, WSP(bf16, O_PM) + (size_t)prow(n) * MW, MW), b = dot_bf(hmr + MW, WSP(bf16, O_PR) + (size_t)prow(n) * RW, RW);
    const float first = bf2f(f2bf(bf2f(u[D + n]) * a));
    u[n] = f2bf(first + bf2f(u[2 * D + n]) * b);
}
DEV void k_gemm_wo(const Params& P, long i) {
    const int n = (int)(i % D); const long m = i / D; const int l = P.layer;
    const int cond = seqinfo(seq_of_token((int)m)).cond;
    const float g1 = WSP(float, WS_MOD)[((size_t)l * NCOND + cond) * 6 * D + 2 * D + n];
    P.out[(size_t)m * D + n] += g1 * dot_bf(WSP(bf16, WS_U1) + (size_t)m * PU, WSP(bf16, O_WO) + (size_t)n * D, D);
}
DEV void k_gemm_f1(const Params& P, long i) {
    const int j = (int)(i % FF); const long m = i / FF;
    const int pn = j >> 7, rho = prow(j & 127);
    const bf16* h = WSP(bf16, WS_QKC) + (size_t)m * D;
    const float a = dot_bf(h, WSP(bf16, O_W13) + (size_t)(pn * 256 + rho) * D, D), b = dot_bf(h, WSP(bf16, O_W13) + (size_t)(pn * 256 + 128 + rho) * D, D);
    WSP(bf16, WS_U1)[(size_t)m * FF + j] = f2bf(siluf_(a) * b);
}
DEV void k_gemm_f2(const Params& P, long i) {
    const int n = (int)(i % D); const long m = i / D; const int l = P.layer;
    const int cond = seqinfo(seq_of_token((int)m)).cond;
    const float g2 = WSP(float, WS_MOD)[((size_t)l * NCOND + cond) * 6 * D + 5 * D + n];
    P.out[(size_t)m * D + n] += g2 * dot_bf(WSP(bf16, WS_U1) + (size_t)m * FF, WSP(bf16, O_W2) + (size_t)n * FF, FF);
}
DEV void k_conv(const Params& P, long i) {
    constexpr int NCH = 2 * MW + RIN;
    const int ch = (int)(i % NCH); const int m = (int)(i / NCH); const int l = P.layer;
    const int s = seq_of_token(m); const SeqInfo q = seqinfo(s); const int t = m - q.base;
    const bool isqk = ch < 2 * MW; const int c = isqk ? ch : ch - 2 * MW;
    const int ucol = isqk ? OFF_QK + c : OFF_R + c;
    const int CH = isqk ? 2 * MW : RIN;
    const float* w = (isqk ? P.in[M_CONV] : P.in[R_CONV]) + (size_t)l * 9 * CH;
    const bf16* U = WSP(bf16, WS_U1);
    float acc = 0.f;
    if (q.grid) {
        const int r = t / GW, cc = t % GW, rows = q.T / GW;
        for (int a = 0; a < 3; ++a) for (int b = 0; b < 3; ++b) {
            const int rr = r + a - 1, c2 = cc + b - 1;
            if (rr >= 0 && rr < rows && c2 >= 0 && c2 < GW) acc += w[(a * 3 + b) * CH + c] * bf2f(U[(size_t)(q.base + rr * GW + c2) * PU + ucol]);
        }
    } else {
        for (int b = 0; b < 3; ++b) { const int t2 = t + b - 1; if (t2 >= 0 && t2 < q.T) acc += w[(3 + b) * CH + c] * bf2f(U[(size_t)(q.base + t2) * PU + ucol]); }
    }
    if (isqk) { float v = siluf_(acc); if (c < MW) v *= 0.08838834764831845f; WSP(bf16, WS_QKC)[(size_t)m * (2 * MW) + c] = f2bf(v); }
    else { float v = acc; if (c >= RX_WL && c < RX_AL) v = tanhf(v); else if (c >= RX_GL) v = sigmoidf_(v); WSP(bf16, WS_RXC)[(size_t)m * RIN + c] = f2bf(v); }
}
DEV void k_mlstm(const Params& P, long i) {
    const int e = (int)(i % 128); const int chain = (int)(i / 128); const int dir = chain & 1, head = (chain >> 1) % MH, s = chain / (2 * MH);
    const int l = P.layer; const SeqInfo q = seqinfo(s);
    float C[128], n[128]; float m;
    if (!q.grid) {
#pragma unroll
        for (int d = 0; d < 128; ++d) { C[d] = 0.f; n[d] = 0.f; }
        m = 0.f;
    } else {
        const size_t sb = (((size_t)q.b * DEPTH + l) * 2 + dir) * MH + head;
#pragma unroll
        for (int d = 0; d < 128; ++d) { C[d] = P.in[ST_C][(sb * 128 + d) * 128 + e]; n[d] = P.in[ST_N][sb * 128 + d]; }
        m = P.in[ST_M][sb];
    }
    const float bi = P.in[M_GATE_B][(size_t)l * 4 * MH + (2 * dir) * MH + head], bfg = P.in[M_GATE_B][(size_t)l * 4 * MH + (2 * dir + 1) * MH + head];
    bf16* U = WSP(bf16, WS_U1); const bf16* QK = WSP(bf16, WS_QKC);
    float nsel = 0.f;
    for (int p = 0; p < q.T; ++p) {
        const int t = dir ? q.T - 1 - p : p; const size_t tok = (size_t)(q.base + t);
        const bf16* qk = QK + tok * (2 * MW); bf16* u = U + tok * PU;
        const float gi = bf2f(u[OFF_G + (2 * dir) * MH + head]) + bi, gf = bf2f(u[OFF_G + (2 * dir + 1) * MH + head]) + bfg;
        const float lf = logsigmoidf_(gf);
        const float mn = fmaxf(lf + m, gi); const float fw = expf(lf + m - mn), iw = expf(gi - mn);
        const float v = bf2f(u[OFF_V + head * 128 + e]);
        float num = 0.f, den = 0.f;
#pragma unroll
        for (int d = 0; d < 128; ++d) {
            const float kd = bf2f(qk[MW + head * 128 + d]), qd = bf2f(qk[head * 128 + d]);
            C[d] = fw * C[d] + iw * kd * v; n[d] = fw * n[d] + iw * kd; num += qd * C[d]; den += qd * n[d];
        }
        m = mn;
        u[dir * MW + head * 128 + e] = f2bf(num / fmaxf(fabsf(den), expf(-m)));
    }
    if (!q.grid) {
        const size_t sb = (((size_t)q.b * DEPTH + l) * 2 + dir) * MH + head;
#pragma unroll
        for (int d = 0; d < 128; ++d) { P.out[OUT_C + (sb * 128 + d) * 128 + e] = C[d]; if (d == e) nsel = n[d]; }
        P.out[OUT_N + sb * 128 + e] = nsel;
        if (e == 0) P.out[OUT_M + sb] = m;
    }
}
DEV void k_rwkv_prep(const Params& P, long i) {
    const int c = (int)(i % RW); const size_t tok = (size_t)(i / RW); const int l = P.layer, dir = P.mode;
    const bf16* rx = WSP(bf16, WS_RXC) + tok * RIN;
    const float* w2 = P.in[R_W2] + ((size_t)l * 2 + dir) * 64 * RW + c; const float* a2 = P.in[R_A2] + ((size_t)l * 2 + dir) * 64 * RW + c;
    float wr = P.in[R_W0][((size_t)l * 2 + dir) * RW + c], ar = P.in[R_A0][((size_t)l * 2 + dir) * RW + c];
    for (int j = 0; j < 64; ++j) { wr += bf2f(rx[RX_WL + dir * 64 + j]) * w2[(size_t)j * RW]; ar += bf2f(rx[RX_AL + dir * 64 + j]) * a2[(size_t)j * RW]; }
    bf16* o = WSP(bf16, WS_QKC) + tok * (2 * RW);
    o[c] = f2bf(wr); o[RW + c] = f2bf(ar);
}
DEV void k_rwkv(const Params& P, long i) {
    const int row = (int)(i % 64); const int chain = (int)(i / 64); const int dir = P.mode, head = chain % RH, s = chain / RH;
    const int l = P.layer; const SeqInfo q = seqinfo(s); const int hc = head * 64;
    float S[64];
    if (!q.grid) {
#pragma unroll
        for (int c = 0; c < 64; ++c) S[c] = 0.f;
    } else {
        const size_t sb = (((size_t)q.b * DEPTH + l) * 2 + dir) * RH + head;
#pragma unroll
        for (int c = 0; c < 64; ++c) S[c] = P.in[ST_R][(sb * 64 + row) * 64 + c];
    }
    const float* rkk = P.in[R_KK] + (size_t)l * RW + hc; const float* rka = P.in[R_KA] + (size_t)l * RW + hc;
    bf16* U = WSP(bf16, WS_U1); const bf16* RX = WSP(bf16, WS_RXC); const bf16* WA = WSP(bf16, WS_QKC);
    for (int p = 0; p < q.T; ++p) {
        const int t = dir ? q.T - 1 - p : p; const size_t tok = (size_t)(q.base + t);
        const bf16* rx = RX + tok * RIN; const bf16* wa = WA + tok * (2 * RW);
        float ss = 0.f;
        for (int c = 0; c < 64; ++c) { const float kc = bf2f(rx[RX_K + hc + c]) * rkk[c]; ss += kc * kc; }
        const float inv = 1.0f / fmaxf(sqrtf(ss), 1e-12f);
        float sa = 0.f;
#pragma unroll
        for (int c = 0; c < 64; ++c) sa -= S[c] * (bf2f(rx[RX_K + hc + c]) * rkk[c] * inv);
        const float v = bf2f(rx[RX_V + hc + row]);
        float y = 0.f;
#pragma unroll
        for (int c = 0; c < 64; ++c) {
            const float wr = bf2f(wa[hc + c]), ar = bf2f(wa[RW + hc + c]);
            const float decay = expf(-0.6065306597126334f * sigmoidf_(wr));
            const float alpha = sigmoidf_(ar);
            const float kr = bf2f(rx[RX_K + hc + c]);
            const float kt = kr * (1.0f + (alpha - 1.0f) * rka[c]);
            const float bb = kr * rkk[c] * inv * alpha;
            S[c] = S[c] * decay + sa * bb + v * kt;
            y += S[c] * bf2f(rx[RX_R + hc + c]);
        }
        U[tok * PU + OFF_R + dir * RW + hc + row] = f2bf(y);
    }
    if (!q.grid) {
        const size_t sb = (((size_t)q.b * DEPTH + l) * 2 + dir) * RH + head;
#pragma unroll
        for (int c = 0; c < 64; ++c) P.out[OUT_S + (sb * 64 + row) * 64 + c] = S[c];
    }
}
DEV void k_post(const Params& P, long i) {
    const int ch = (int)(i % D); const size_t m = (size_t)(i / D); const int l = P.layer;
    const bf16* u = WSP(bf16, WS_U1) + m * PU; const bf16* rx = WSP(bf16, WS_RXC) + m * RIN;
    bf16* o = WSP(bf16, WS_QKC) + m * D;
    if (ch < MW) {
        const int h0 = (ch / 128) * 128; float ss = 0.f;
        for (int d = 0; d < 128; ++d) { const float x = bf2f(u[h0 + d]) + bf2f(u[MW + h0 + d]); ss += x * x; }
        const float x = bf2f(u[ch]) + bf2f(u[MW + ch]);
        o[ch] = f2bf(x / sqrtf(ss / 128.f + RMS_EPS) * P.in[M_NORM_G][(size_t)l * MW + ch] * sigmoidf_(bf2f(u[OFF_O + ch])));
    } else {
        const int c = ch - MW; const int h0 = (c / 64) * 64;
        float mu = 0.f, bsum = 0.f;
        for (int d = 0; d < 64; ++d) { mu += bf2f(u[OFF_R + h0 + d]) + bf2f(u[OFF_R + RW + h0 + d]);
            bsum += bf2f(rx[RX_R + h0 + d]) * bf2f(rx[RX_K + h0 + d]) * P.in[R_RK][(size_t)l * RW + h0 + d]; }
        mu *= (1.0f / 64.f); float var = 0.f;
        for (int d = 0; d < 64; ++d) { const float x = bf2f(u[OFF_R + h0 + d]) + bf2f(u[OFF_R + RW + h0 + d]) - mu; var += x * x; }
        var *= (1.0f / 64.f);
        const float y = bf2f(u[OFF_R + c]) + bf2f(u[OFF_R + RW + c]);
        const float yn = (y - mu) / sqrtf(var + GN_EPS) * P.in[R_GN_W][(size_t)l * RW + c] + P.in[R_GN_B][(size_t)l * RW + c];
        float gate = 0.f;
        for (int j = 0; j < 128; ++j) gate += bf2f(rx[RX_GL + j]) * P.in[R_G2][((size_t)l * 128 + j) * RW + c];
        o[ch] = f2bf((yn + bsum * bf2f(rx[RX_V + c])) * gate);
    }
}
DEV void k_final(const Params& P, long m) {
    float* x = P.out + (size_t)m * D; float ss = 0.f;
    for (int k = 0; k < D; ++k) ss += x[k] * x[k];
    const float rs = 1.0f / sqrtf(ss / D + RMS_EPS);
    for (int k = 0; k < D; ++k) x[k] = x[k] * rs * P.in[FINAL_G][k];
}


#ifndef HOST_EMU
typedef const __attribute__((address_space(4))) Params CParams;
namespace pg8 {
#define PG8_LAS __attribute__((address_space(3)))
typedef short bf16x8 __attribute__((ext_vector_type(8)));
typedef float f32x4 __attribute__((ext_vector_type(4)));
typedef unsigned u32x4 __attribute__((ext_vector_type(4)));
constexpr int BM = 256, BK = 64, HALF = 128, HTB = HALF * BK * 2, STAGE_BYTES = 8 * HTB, NXCD = 8, WGM = 8;
__device__ __forceinline__ int lds_byte(int r, int c) { const int st = (r >> 4) * 2 + (c >> 5), rr = r & 15, cc = c & 31, ob = rr * 64 + cc * 2; return st * 1024 + (ob ^ (((ob >> 9) & 1) << 5)); }
__device__ __forceinline__ void stage_rc(int b, int& R, int& C) { const int st = b / 1024, sb = b % 1024, swz = sb ^ (((sb >> 9) & 1) << 5); R = (st >> 1) * 16 + swz / 64; C = (st & 1) * 32 + (swz % 64) / 2; }
struct Unit { int pm, pn, aoff; };
struct Gemm { const bf16* A; const bf16* Bt; int K, lda; };
struct StaticOrder {
    int nM, nN, nwg, G, c;
    __device__ __forceinline__ void init(int M, int N, int G_, int c_) { nM = M / BM; nN = N / BM; nwg = nM * nN; G = G_; c = c_; }
    __device__ __forceinline__ bool next(int i, Unit& u) const {
        const long L = (long)i * G + c; if (L >= nwg) return false;
        int wgid = (int)L; { const int q = nwg / NXCD, r = nwg % NXCD, xcd = wgid % NXCD, off = wgid / NXCD; wgid = (xcd < r ? xcd * (q + 1) : r * (q + 1) + (xcd - r) * q) + off; }
        const int nig = WGM * nN, gid = wgid / nig, fm = gid * WGM, gsz = (nM - fm) < WGM ? (nM - fm) : WGM;
        u.pm = fm + ((wgid % nig) % gsz); u.pn = (wgid % nig) / gsz; u.aoff = 0; return true;
    }
};
struct PairOrder {
    int nbase, G, v, nct;
    __device__ __forceinline__ void init(int M, int G_, int c_) { nct = D / BM; nbase = (M / BM) * nct; G = G_; v = (G_ % 8 == 0) ? (c_ % 8) * (G_ / 8) + c_ / 8 : c_; }
    __device__ __forceinline__ bool next(int i, Unit& u) const {
        const int j = v + (i >> 1) * G; if (j >= nbase) return false;
        const int half = i & 1; u.pm = j / nct; u.pn = half * nct + (j % nct); u.aoff = half * MW; return true;
    }
};
typedef float f32x2_t __attribute__((ext_vector_type(2)));
typedef __bf16 bf16x2_t __attribute__((ext_vector_type(2)));
__device__ __forceinline__ unsigned cvt_pk_bf16(float lo, float hi) { f32x2_t v = {lo, hi}; bf16x2_t b = __builtin_convertvector(v, bf16x2_t); return __builtin_bit_cast(unsigned, b); }
__device__ __forceinline__ float fsigmoid(float x) { return __builtin_amdgcn_rcpf(1.0f + __expf(-x)); }
__device__ __forceinline__ float bflo(unsigned w) { return __builtin_bit_cast(float, w << 16); }
__device__ __forceinline__ float bfhi(unsigned w) { return __builtin_bit_cast(float, w & 0xffff0000u); }

struct EpiA1 {
    bf16* U;
    __device__ __forceinline__ void operator()(const f32x4 (&acc)[2][2][4][2], const Unit& u, int wr, int wc, int fr, int fq) const {
        const int row0 = u.pm * BM + wr * 64 + fr, col0 = u.pn * BM + wc * 32 + 8 * fq;
#pragma unroll
        for (int ai = 0; ai < 2; ++ai)
#pragma unroll
            for (int m = 0; m < 4; ++m) { bf16* rowp = U + (size_t)(row0 + ai * HALF + m * 16) * PU + col0;
#pragma unroll
                for (int bj = 0; bj < 2; ++bj) { if (col0 + bj * HALF < N1) { const f32x4 v0 = acc[ai][bj][m][0], v1 = acc[ai][bj][m][1];
                    u32x4 w; w.x = cvt_pk_bf16(v0[0], v0[1]); w.y = cvt_pk_bf16(v0[2], v0[3]); w.z = cvt_pk_bf16(v1[0], v1[1]); w.w = cvt_pk_bf16(v1[2], v1[3]);
                    *(u32x4*)(rowp + bj * HALF) = w; } } }
    }
};
struct EpiA2 {
    bf16* U;
    __device__ __forceinline__ void operator()(const f32x4 (&acc)[2][2][4][2], const Unit& u, int wr, int wc, int fr, int fq) const {
        const int row0 = u.pm * BM + wr * 64 + fr, col0 = D + u.pn * BM + wc * 32 + 8 * fq;
#pragma unroll
        for (int ai = 0; ai < 2; ++ai)
#pragma unroll
            for (int m = 0; m < 4; ++m) { bf16* rowp = U + (size_t)(row0 + ai * HALF + m * 16) * PU + col0;
#pragma unroll
                for (int bj = 0; bj < 2; ++bj) { const f32x4 v0 = acc[ai][bj][m][0], v1 = acc[ai][bj][m][1];
                    u32x4 w; w.x = cvt_pk_bf16(fsigmoid(v0[0]), fsigmoid(v0[1])); w.y = cvt_pk_bf16(fsigmoid(v0[2]), fsigmoid(v0[3]));
                    w.z = cvt_pk_bf16(fsigmoid(v1[0]), fsigmoid(v1[1])); w.w = cvt_pk_bf16(fsigmoid(v1[2]), fsigmoid(v1[3]));
                    *(u32x4*)(rowp + bj * HALF) = w; } }
    }
};
struct EpiPJ {
    bf16* U;
    __device__ __forceinline__ void operator()(const f32x4 (&acc)[2][2][4][2], const Unit& u, int wr, int wc, int fr, int fq) const {
        const int nct = D / BM, half = u.pn >= nct ? 1 : 0, ct = u.pn - half * nct;
        const int row0 = u.pm * BM + wr * 64 + fr, col0 = ct * BM + wc * 32 + 8 * fq;
#pragma unroll
        for (int ai = 0; ai < 2; ++ai)
#pragma unroll
            for (int m = 0; m < 4; ++m) { bf16* rowp = U + (size_t)(row0 + ai * HALF + m * 16) * PU + col0;
#pragma unroll
                for (int bj = 0; bj < 2; ++bj) { const f32x4 v0 = acc[ai][bj][m][0], v1 = acc[ai][bj][m][1];
                    const u32x4 g = *(const u32x4*)(rowp + (1 + half) * D + bj * HALF);
                    float o[8] = { bflo(g.x) * v0[0], bfhi(g.x) * v0[1], bflo(g.y) * v0[2], bfhi(g.y) * v0[3], bflo(g.z) * v1[0], bfhi(g.z) * v1[1], bflo(g.w) * v1[2], bfhi(g.w) * v1[3] };
                    if (half) { const u32x4 p = *(const u32x4*)(rowp + bj * HALF);
                        o[0] += bflo(p.x); o[1] += bfhi(p.x); o[2] += bflo(p.y); o[3] += bfhi(p.y); o[4] += bflo(p.z); o[5] += bfhi(p.z); o[6] += bflo(p.w); o[7] += bfhi(p.w); }
                    u32x4 w; w.x = cvt_pk_bf16(o[0], o[1]); w.y = cvt_pk_bf16(o[2], o[3]); w.z = cvt_pk_bf16(o[4], o[5]); w.w = cvt_pk_bf16(o[6], o[7]);
                    *(u32x4*)(rowp + bj * HALF) = w; }
                asm volatile("" ::: "memory"); }
    }
};
struct EpiRes {
    float* X; const float* gate;
    const float* sa; const float* sb;
    __device__ __forceinline__ void operator()(const f32x4 (&acc)[2][2][4][2], const Unit& u, int wr, int wc, int fr, int fq) const {
        const int row0 = u.pm * BM + wr * 64 + fr, col0 = u.pn * BM + wc * 32 + 4 * fq;
        const float* S = sa ? (u.pm * BM < NC ? sa : sb - (size_t)NC * D) : X;
        const int cond = seqinfo(seq_of_token(u.pm * BM)).cond;
        const float* gp = gate + (size_t)cond * 6 * D + col0;
        f32x4 gv[2][2];
#pragma unroll
        for (int bj = 0; bj < 2; ++bj)
#pragma unroll
            for (int n = 0; n < 2; ++n) gv[bj][n] = *(const f32x4*)(gp + bj * HALF + n * 16);
#pragma unroll
        for (int ai = 0; ai < 2; ++ai)
#pragma unroll
            for (int m = 0; m < 4; ++m) { const size_t ro = (size_t)(row0 + ai * HALF + m * 16) * D + col0; float* rowp = X + ro; const float* srow = S + ro;
#pragma unroll
                for (int bj = 0; bj < 2; ++bj)
#pragma unroll
                    for (int n = 0; n < 2; ++n) { *(f32x4*)(rowp + bj * HALF + n * 16) = *(const f32x4*)(srow + bj * HALF + n * 16) + gv[bj][n] * acc[ai][bj][m][n]; }
                asm volatile("" ::: "memory"); }
    }
};
typedef unsigned u32x2 __attribute__((ext_vector_type(2)));
constexpr int CW_NX = 45056, CW_NX_STRIDE = 16, NX_EXCH_BYTE = 512 * 1024, NX_LDS = 131072;
struct EpiResNorm {
    float* X; const float* gate; const float* sa; const float* sb;
    int fuse;
    const float* ng; const float* nmod;
    bf16* H;
    unsigned char* ctlb; unsigned epoch; PG8_LAS unsigned char* lds;
    __device__ __forceinline__ void operator()(const f32x4 (&acc_)[2][2][4][2], const Unit& u, int wr, int wc, int fr, int fq) const {
        f32x4 (&acc)[2][2][4][2] = const_cast<f32x4 (&)[2][2][4][2]>(acc_);
        const int tid = threadIdx.x;
        const int row0 = u.pm * BM + wr * 64 + fr, col0 = u.pn * BM + wc * 32 + 4 * fq;
        const int cond = seqinfo(seq_of_token(u.pm * BM)).cond;
        const float* S = sa ? (u.pm * BM < NC ? sa : sb - (size_t)NC * D) : X;
        { const float* gp = gate + (size_t)cond * 6 * D + col0;
          f32x4 gv[2][2];
#pragma unroll
          for (int bj = 0; bj < 2; ++bj)
#pragma unroll
              for (int n = 0; n < 2; ++n) gv[bj][n] = *(const f32x4*)(gp + bj * HALF + n * 16);
#pragma unroll
          for (int ai = 0; ai < 2; ++ai)
#pragma unroll
              for (int m = 0; m < 4; ++m) { const size_t ro = (size_t)(row0 + ai * HALF + m * 16) * D + col0; float* rowp = X + ro; const float* srow = S + ro;
#pragma unroll
                  for (int bj = 0; bj < 2; ++bj)
#pragma unroll
                      for (int n = 0; n < 2; ++n) { const f32x4 xn = *(const f32x4*)(srow + bj * HALF + n * 16) + gv[bj][n] * acc[ai][bj][m][n]; acc[ai][bj][m][n] = xn;
                          if (!fuse || H) *(f32x4*)(rowp + bj * HALF + n * 16) = xn; }
                  asm volatile("" ::: "memory"); } }
        if (!fuse) return;
        PG8_LAS float* red = (PG8_LAS float*)(lds + NX_LDS); PG8_LAS float* rsl = red + 1024;
#pragma unroll
        for (int ai = 0; ai < 2; ++ai)
#pragma unroll
            for (int m = 0; m < 4; ++m) { float sacc = 0.f;
#pragma unroll
                for (int bj = 0; bj < 2; ++bj)
#pragma unroll
                    for (int n = 0; n < 2; ++n) { const f32x4 v = acc[ai][bj][m][n]; sacc += (v[0] * v[0] + v[1] * v[1]) + (v[2] * v[2] + v[3] * v[3]); }
                sacc += __shfl_xor(sacc, 16); sacc += __shfl_xor(sacc, 32);
                if (fq == 0) red[(ai * HALF + wr * 64 + m * 16 + fr) * 4 + wc] = sacc; }
        __syncthreads();
        unsigned* flags = (unsigned*)ctlb + CW_NX; float* exch = (float*)(ctlb + NX_EXCH_BYTE);
        float mine = 0.f;
        if (tid < BM) { const f32x4 r4 = *(const PG8_LAS f32x4*)(red + tid * 4); mine = (r4[0] + r4[1]) + (r4[2] + r4[3]);
            float* gp = exch + ((size_t)(u.pm * 4 + u.pn) * BM + tid);
            asm volatile("global_store_dword %0, %1, off sc1" :: "v"(gp), "v"(mine) : "memory"); }
        asm volatile("s_waitcnt vmcnt(0)" ::: "memory");
        __syncthreads();
        if (tid == 0) {
            __hip_atomic_store(flags + (u.pm * 4 + u.pn) * CW_NX_STRIDE, epoch, __ATOMIC_RELAXED, __HIP_MEMORY_SCOPE_AGENT);
            unsigned* tmo = (unsigned*)ctlb + 4096 + 128;
#pragma unroll 1
            for (int q = 0; q < 4; ++q) { if (q == u.pn) continue; unsigned sp = 0;
                while (__hip_atomic_load(flags + (u.pm * 4 + q) * CW_NX_STRIDE, __ATOMIC_RELAXED, __HIP_MEMORY_SCOPE_AGENT) < epoch) { __builtin_amdgcn_s_sleep(1);
                    if ((++sp & 255u) == 0u) { if (__hip_atomic_load(tmo, __ATOMIC_RELAXED, __HIP_MEMORY_SCOPE_AGENT)) break; if (sp > (1u << 18)) { atomicAdd(tmo, 1u); break; } } } }
            __builtin_amdgcn_fence(__ATOMIC_ACQUIRE, "agent");
        }
        asm volatile("s_waitcnt vmcnt(0)" ::: "memory");
        __syncthreads();
        if (tid < BM) { float tot = mine;
#pragma unroll
            for (int q = 0; q < 4; ++q) if (q != u.pn) tot += exch[(size_t)(u.pm * 4 + q) * BM + tid];
            rsl[tid] = 1.0f / sqrtf(tot * (1.0f / D) + 1e-6f); }
        __syncthreads();
        f32x4 g4[2][2], sc4[2][2], sh4[2][2];
#pragma unroll
        for (int bj = 0; bj < 2; ++bj)
#pragma unroll
            for (int n = 0; n < 2; ++n) { const int c = col0 + bj * HALF + n * 16; g4[bj][n] = *(const f32x4*)(ng + c);
                if (nmod) { sh4[bj][n] = *(const f32x4*)(nmod + (size_t)cond * 6 * D + c); sc4[bj][n] = *(const f32x4*)(nmod + (size_t)cond * 6 * D + D + c) + 1.0f; g4[bj][n] = g4[bj][n] * sc4[bj][n]; }
                else sh4[bj][n] = (f32x4){0.f, 0.f, 0.f, 0.f}; }
#pragma unroll
        for (int ai = 0; ai < 2; ++ai)
#pragma unroll
            for (int m = 0; m < 4; ++m) { const int rl = ai * HALF + wr * 64 + m * 16 + fr; const float r = rsl[rl]; const size_t ro = (size_t)(u.pm * BM + rl) * D + col0;
#pragma unroll
                for (int bj = 0; bj < 2; ++bj)
#pragma unroll
                    for (int n = 0; n < 2; ++n) { const f32x4 y = acc[ai][bj][m][n] * r * g4[bj][n] + sh4[bj][n];
                        if (H) { u32x2 pk; pk.x = cvt_pk_bf16(y[0], y[1]); pk.y = cvt_pk_bf16(y[2], y[3]); *(u32x2*)(H + ro + bj * HALF + n * 16) = pk; }
                        else *(f32x4*)(X + ro + bj * HALF + n * 16) = y; } }
    }
};
struct EpiF1 {
    bf16* Hd;
    __device__ __forceinline__ void operator()(const f32x4 (&acc)[2][2][4][2], const Unit& u, int wr, int wc, int fr, int fq) const {
        const int row0 = u.pm * BM + wr * 64 + fr, col0 = u.pn * HALF + wc * 32 + 8 * fq;
#pragma unroll
        for (int ai = 0; ai < 2; ++ai)
#pragma unroll
            for (int m = 0; m < 4; ++m) { bf16* rowp = Hd + (size_t)(row0 + ai * HALF + m * 16) * FF + col0;
                float o[8];
#pragma unroll
                for (int n = 0; n < 2; ++n)
#pragma unroll
                    for (int e = 0; e < 4; ++e) { const float a = acc[ai][0][m][n][e], b = acc[ai][1][m][n][e]; o[n * 4 + e] = a * fsigmoid(a) * b; }
                u32x4 w; w.x = cvt_pk_bf16(o[0], o[1]); w.y = cvt_pk_bf16(o[2], o[3]); w.z = cvt_pk_bf16(o[4], o[5]); w.w = cvt_pk_bf16(o[6], o[7]);
                *(u32x4*)rowp = w; }
    }
};

template <class Epi, class Sched, bool ALIGN_EPI = true, bool SP2 = true>
__device__ __forceinline__ void gemm_phase(PG8_LAS unsigned char* lds, const Gemm g, const Sched& S, const Epi& E) {
    const int tid = threadIdx.x, wid = __builtin_amdgcn_readfirstlane(tid >> 6), lane = tid & 63, wr = wid >> 2, wc = wid & 3, fr = lane & 15, fq = lane >> 4;
    const int K = g.K, nt = K / BK;
    unsigned voffA[2], voffB[2];
#pragma unroll
    for (int i = 0; i < 2; ++i) { int R, C; stage_rc(tid * 16 + i * 8192, R, C);
        voffA[i] = (unsigned)(R * g.lda + C) * 2u; voffB[i] = (unsigned)(R * K + C) * 2u; }
    const size_t kstep = (size_t)(BK * 2);
    const size_t hstepA = (size_t)HALF * g.lda * 2, hstepB = (size_t)HALF * K * 2;
    const size_t tstepA = 2 * hstepA, tstepB = 2 * hstepB;
    const unsigned ldsw = (unsigned)wid * 1024u;
    const int aoff = lds_byte(wr * 64 + fr, fq * 8), boff = lds_byte(wc * 32 + fr, fq * 8);
#define PG8_SA(b, h) (((b) * 2 + (h)) * HTB)
#define PG8_SB(b, h) ((4 + (b) * 2 + (h)) * HTB)
#define PG8_STAGE(bufoff, gbase, voff) do { _Pragma("unroll") for (int _i = 0; _i < 2; ++_i) \
        __builtin_amdgcn_global_load_lds((const unsigned*)((const char*)(gbase) + (voff)[_i]), (PG8_LAS unsigned*)(lds + (bufoff) + ldsw + _i * 8192), 16, 0, 0); } while (0)
#define PG8_LDA(dst, b, h) do { _Pragma("unroll") for (int m = 0; m < 4; ++m) _Pragma("unroll") for (int k = 0; k < 2; ++k) dst[m][k] = *(const PG8_LAS bf16x8*)(lds + PG8_SA(b, h) + aoff + m * 2048 + k * 1024); } while (0)
#define PG8_LDB(dst, b, h) do { _Pragma("unroll") for (int n = 0; n < 2; ++n) _Pragma("unroll") for (int k = 0; k < 2; ++k) dst[n][k] = *(const PG8_LAS bf16x8*)(lds + PG8_SB(b, h) + boff + n * 2048 + k * 1024); } while (0)
#define PG8_MMA(ai, bj, At, Bt) do { __builtin_amdgcn_s_setprio(1); _Pragma("unroll") for (int m = 0; m < 4; ++m) _Pragma("unroll") for (int n = 0; n < 2; ++n) _Pragma("unroll") for (int k = 0; k < 2; ++k) \
        acc[ai][bj][m][n] = __builtin_amdgcn_mfma_f32_16x16x32_bf16(Bt[n][k], At[m][k], acc[ai][bj][m][n], 0, 0, 0); __builtin_amdgcn_s_setprio(0); } while (0)
#define PG8_WAIT_V(n) asm volatile("s_waitcnt vmcnt(" #n ")" ::: "memory")
#define PG8_WAIT_L(n) asm volatile("s_waitcnt lgkmcnt(" #n ")" ::: "memory")
#define PG8_BAR __builtin_amdgcn_s_barrier()
#define PG8_SCHED __builtin_amdgcn_sched_barrier(0)
    Unit cur, nxt; int ui = 0;
    if (!S.next(0, cur)) return;
    f32x4 acc[2][2][4][2];
#pragma unroll
    for (int a = 0; a < 2; ++a)
#pragma unroll
        for (int b = 0; b < 2; ++b)
#pragma unroll
            for (int m = 0; m < 4; ++m)
#pragma unroll
                for (int n = 0; n < 2; ++n) acc[a][b][m][n] = (f32x4){0.f, 0.f, 0.f, 0.f};
    bf16x8 At[4][2], B0[2][2], B1[2][2];
    const char* cA = (const char*)g.A + (size_t)cur.pm * tstepA + (size_t)cur.aoff * 2; const char* cB = (const char*)g.Bt + (size_t)cur.pn * tstepB;
    if constexpr (SP2) {
        PG8_STAGE(PG8_SB(0, 0), cB, voffB); PG8_STAGE(PG8_SB(0, 1), cB + hstepB, voffB); PG8_STAGE(PG8_SA(0, 0), cA, voffA); PG8_STAGE(PG8_SA(0, 1), cA + hstepA, voffA);
        if (wr == 1) PG8_BAR;
        PG8_WAIT_V(2); PG8_BAR;
        PG8_STAGE(PG8_SB(1, 0), cB + kstep, voffB); PG8_STAGE(PG8_SA(1, 0), cA + kstep, voffA); PG8_STAGE(PG8_SB(1, 1), cB + hstepB + kstep, voffB);
        PG8_WAIT_V(6); PG8_BAR;
    } else {
        PG8_STAGE(PG8_SB(0, 0), cB, voffB); PG8_STAGE(PG8_SA(0, 0), cA, voffA); PG8_STAGE(PG8_SB(0, 1), cB + hstepB, voffB); PG8_STAGE(PG8_SA(0, 1), cA + hstepA, voffA);
        if (wr == 1) PG8_BAR;
        PG8_WAIT_V(4); PG8_BAR;
        PG8_STAGE(PG8_SB(1, 0), cB + kstep, voffB); PG8_STAGE(PG8_SA(1, 0), cA + kstep, voffA); PG8_STAGE(PG8_SB(1, 1), cB + hstepB + kstep, voffB);
        PG8_WAIT_V(6); PG8_BAR;
    }
    for (;;) {
        const bool has_next = S.next(ui + 1, nxt);
        const char* nA = has_next ? (const char*)g.A + (size_t)nxt.pm * tstepA + (size_t)nxt.aoff * 2 : cA; const char* nB = has_next ? (const char*)g.Bt + (size_t)nxt.pn * tstepB : cB;
        for (int t = 0; t < nt; t += 2) {
            const bool last = (t == nt - 2);
            const char* a1 = cA + (size_t)(t + 1) * kstep;
            const char* a2 = last ? nA : cA + (size_t)(t + 2) * kstep; const char* b2 = last ? nB : cB + (size_t)(t + 2) * kstep;
            const char* a3 = a2 + kstep; const char* b3 = b2 + kstep;
            if constexpr (SP2) {
            PG8_LDB(B0, 0, 0); PG8_LDB(B1, 0, 1); PG8_SCHED; PG8_LDA(At, 0, 0); PG8_STAGE(PG8_SA(1, 1), a1 + hstepA, voffA);
            PG8_WAIT_V(8); PG8_WAIT_L(0); PG8_BAR; PG8_MMA(0, 0, At, B0); PG8_MMA(0, 1, At, B1); PG8_BAR; PG8_SCHED;
            PG8_LDA(At, 0, 1); PG8_STAGE(PG8_SB(0, 0), b2, voffB); PG8_STAGE(PG8_SB(0, 1), b2 + hstepB, voffB); PG8_STAGE(PG8_SA(0, 0), a2, voffA);
            PG8_WAIT_V(8); PG8_WAIT_L(0); PG8_BAR; PG8_MMA(1, 0, At, B0); PG8_MMA(1, 1, At, B1); PG8_BAR; PG8_SCHED;
            PG8_LDB(B0, 1, 0); PG8_LDB(B1, 1, 1); PG8_SCHED; PG8_LDA(At, 1, 0); PG8_STAGE(PG8_SA(0, 1), a2 + hstepA, voffA);
            PG8_WAIT_V(8); PG8_WAIT_L(0); PG8_BAR; PG8_MMA(0, 0, At, B0); PG8_MMA(0, 1, At, B1); PG8_BAR; PG8_SCHED;
            PG8_LDA(At, 1, 1); PG8_STAGE(PG8_SB(1, 0), b3, voffB); PG8_STAGE(PG8_SB(1, 1), b3 + hstepB, voffB); PG8_STAGE(PG8_SA(1, 0), a3, voffA);
            PG8_WAIT_V(8); PG8_WAIT_L(0); PG8_BAR; PG8_MMA(1, 0, At, B0); PG8_MMA(1, 1, At, B1); PG8_BAR; PG8_SCHED;
            } else {
            PG8_LDB(B0, 0, 0); PG8_SCHED; PG8_LDA(At, 0, 0); PG8_STAGE(PG8_SA(1, 1), a1 + hstepA, voffA);
            PG8_WAIT_L(8); PG8_BAR; PG8_WAIT_L(0); PG8_MMA(0, 0, At, B0); PG8_BAR; PG8_SCHED;
            PG8_LDB(B1, 0, 1); PG8_STAGE(PG8_SB(0, 0), b2, voffB);
            PG8_BAR; PG8_WAIT_L(0); PG8_MMA(0, 1, At, B1); PG8_BAR;
            PG8_LDA(At, 0, 1); PG8_STAGE(PG8_SA(0, 0), a2, voffA);
            PG8_BAR; PG8_WAIT_L(0); PG8_MMA(1, 0, At, B0); PG8_BAR; PG8_SCHED;
            PG8_STAGE(PG8_SB(0, 1), b2 + hstepB, voffB);
            PG8_WAIT_V(6); PG8_BAR; PG8_MMA(1, 1, At, B1); PG8_BAR;
            PG8_LDB(B0, 1, 0); PG8_SCHED; PG8_LDA(At, 1, 0); PG8_STAGE(PG8_SA(0, 1), a2 + hstepA, voffA);
            PG8_WAIT_L(8); PG8_BAR; PG8_WAIT_L(0); PG8_MMA(0, 0, At, B0); PG8_BAR; PG8_SCHED;
            PG8_LDB(B1, 1, 1); PG8_STAGE(PG8_SB(1, 0), b3, voffB);
            PG8_BAR; PG8_WAIT_L(0); PG8_MMA(0, 1, At, B1); PG8_BAR;
            PG8_LDA(At, 1, 1); PG8_STAGE(PG8_SA(1, 0), a3, voffA);
            PG8_BAR; PG8_WAIT_L(0); PG8_MMA(1, 0, At, B0); PG8_BAR; PG8_SCHED;
            PG8_STAGE(PG8_SB(1, 1), b3 + hstepB, voffB);
            PG8_WAIT_V(6); PG8_BAR; PG8_MMA(1, 1, At, B1); PG8_BAR;
            }
        }
        if constexpr (ALIGN_EPI) { if (wr == 0) PG8_BAR; }
        E(acc, cur, wr, wc, fr, fq);
        if (!has_next) break;
#pragma unroll
        for (int a = 0; a < 2; ++a)
#pragma unroll
            for (int b = 0; b < 2; ++b)
#pragma unroll
                for (int m = 0; m < 4; ++m)
#pragma unroll
                    for (int n = 0; n < 2; ++n) acc[a][b][m][n] = (f32x4){0.f, 0.f, 0.f, 0.f};
        cur = nxt; cA = nA; cB = nB; ++ui;
        if constexpr (ALIGN_EPI) { if (wr == 1) PG8_BAR; }
    }
    PG8_WAIT_V(0);
    if constexpr (!ALIGN_EPI) { if (wr == 0) PG8_BAR; }
    PG8_BAR;
#undef PG8_SA
#undef PG8_SB
#undef PG8_STAGE
#undef PG8_LDA
#undef PG8_LDB
#undef PG8_MMA
#undef PG8_WAIT_V
#undef PG8_WAIT_L
#undef PG8_BAR
#undef PG8_SCHED
}
}


#define LDS_BARRIER() do { asm volatile("s_waitcnt lgkmcnt(0)" ::: "memory"); __builtin_amdgcn_s_barrier(); asm volatile("" ::: "memory"); } while (0)
namespace ml {
#define LAS __attribute__((address_space(3)))
typedef short bf16x8 __attribute__((ext_vector_type(8)));
typedef float f32x4 __attribute__((ext_vector_type(4)));
typedef unsigned u32x4 __attribute__((ext_vector_type(4)));
constexpr int NVB = 4, EV = MD / NVB;
constexpr int PQ = 272, PT = 144;
constexpr int L_QS = 0, L_KS = L_QS + 64 * PQ, L_KT = L_KS + 64 * PQ, L_VT = L_KT + 128 * PT, L_SB = L_VT + 48 * PT, L_CT = L_SB + 64 * PT,
              L_HS = L_CT + 48 * PQ, L_SC = L_HS + 64 * 80, L_END = L_SC + 4096;
static_assert(L_END <= 131072, "mLSTM LDS map");
enum { SC_A = 0, SC_PM = 64, SC_WI = 128, SC_EMT = 192, SC_WE = 256, SC_DEN = 320, SC_MISC = 384 };
__device__ __forceinline__ f32x4 mma(bf16x8 a, bf16x8 b, f32x4 c) { return __builtin_amdgcn_mfma_f32_16x16x32_bf16(a, b, c, 0, 0, 0); }
__device__ __forceinline__ bf16x8 frag(LAS unsigned char* lds, int base, int pitch, int row0, int k0, int lane) {
    return *(const LAS bf16x8*)(lds + base + (row0 + (lane & 15)) * pitch + (k0 + 8 * (lane >> 4)) * 2);
}
template <int N> __device__ __forceinline__ float dpp_row_shr(float x, float ident) {
    return __builtin_bit_cast(float, __builtin_amdgcn_update_dpp(__builtin_bit_cast(int, ident), __builtin_bit_cast(int, x), 0x110 + N, 0xf, 0xf, false));
}
__device__ __forceinline__ float lane_get(float x, int l) { return __builtin_bit_cast(float, __builtin_amdgcn_readlane(__builtin_bit_cast(int, x), l)); }
__device__ __forceinline__ float wave_scan_add(float x, int lane) {
    x += dpp_row_shr<1>(x, 0.f); x += dpp_row_shr<2>(x, 0.f); x += dpp_row_shr<4>(x, 0.f); x += dpp_row_shr<8>(x, 0.f);
    const float t0 = lane_get(x, 15), t1 = lane_get(x, 31), t2 = lane_get(x, 47); const int row = lane >> 4;
    return x + ((row >= 1 ? t0 : 0.f) + (row >= 2 ? t1 : 0.f) + (row >= 3 ? t2 : 0.f));
}
__device__ __forceinline__ float wave_scan_max(float x, int lane) {
    constexpr float NI = -3.0e38f;
    x = fmaxf(x, dpp_row_shr<1>(x, NI)); x = fmaxf(x, dpp_row_shr<2>(x, NI)); x = fmaxf(x, dpp_row_shr<4>(x, NI)); x = fmaxf(x, dpp_row_shr<8>(x, NI));
    const float t0 = lane_get(x, 15), t1 = lane_get(x, 31), t2 = lane_get(x, 47); const int row = lane >> 4;
    return fmaxf(fmaxf(x, row >= 1 ? t0 : NI), fmaxf(row >= 2 ? t1 : NI, row >= 3 ? t2 : NI));
}
__device__ __forceinline__ void mlstm_item(LAS unsigned char* lds, CParams& P, int l, int s, int head, int dir, int vb) {
    const int tid = threadIdx.x, w = __builtin_amdgcn_readfirstlane(tid >> 6), lane = tid & 63, fr = lane & 15, fq = lane >> 4;
    const int rt = w & 3, half = w >> 2;
    const SeqInfo q = seqinfo(s); const int nchunk = q.T / 64;
    const bf16* QK = WSP(bf16, WS_QKC); bf16* U = WSP(bf16, WS_U1);
    LAS float* SC = (LAS float*)(lds + L_SC);
    f32x4 cacc[3];
    float m_prev;
    if (!q.grid) { cacc[0] = cacc[1] = cacc[2] = (f32x4){0.f, 0.f, 0.f, 0.f}; m_prev = 0.f; }
    else {
        const size_t sb = (((size_t)q.b * DEPTH + l) * 2 + dir) * MH + head; const int d = 16 * w + fr;
#pragma unroll
        for (int et = 0; et < 2; ++et)
#pragma unroll
            for (int r = 0; r < 4; ++r) cacc[et][r] = P.in[ST_C][(sb * 128 + d) * 128 + vb * EV + 16 * et + 4 * fq + r];
        cacc[2] = (f32x4){0.f, 0.f, 0.f, 0.f}; if (fq == 0) cacc[2][0] = P.in[ST_N][sb * 128 + d];
        m_prev = P.in[ST_M][sb];
    }
    const float bi = P.in[M_GATE_B][(size_t)l * 4 * MH + (2 * dir) * MH + head], bfg = P.in[M_GATE_B][(size_t)l * 4 * MH + (2 * dir + 1) * MH + head];
    for (int i = tid; i < 16 * 64; i += 512) { const int r = i >> 6, c = i & 63; *(LAS bf16*)(lds + L_VT + (32 + r) * PT + c * 2) = (r == 0) ? (bf16)0x3f80 : (bf16)0; }
    u32x4 pqk[4]; u32x4 pv; bf16 pgi = 0, pgf = 0;
#define ML_TOK(c, j) ((size_t)(q.base + (dir ? q.T - 1 - ((c) * 64 + (j)) : ((c) * 64 + (j)))))
#define ML_PREFETCH(c) do { _Pragma("unroll") for (int i = 0; i < 4; ++i) { const int id = tid + 512 * i, j = id >> 5, pc = id & 31; \
            pqk[i] = *(const u32x4*)(QK + ML_TOK(c, j) * (2 * MW) + (pc < 16 ? head * 128 + 8 * pc : MW + head * 128 + 8 * (pc - 16))); } \
        if (tid < 256) { const int j = tid >> 2, pc = tid & 3; pv = *(const u32x4*)(U + ML_TOK(c, j) * PU + OFF_V + head * 128 + vb * EV + 8 * pc); } \
        if (w == 0) { const bf16* g = U + ML_TOK(c, lane) * PU + OFF_G; pgi = g[(2 * dir) * MH + head]; pgf = g[(2 * dir + 1) * MH + head]; } } while (0)
    ML_PREFETCH(0);
    for (int c = 0; c < nchunk; ++c) {
#pragma unroll
        for (int i = 0; i < 4; ++i) { const int id = tid + 512 * i, j = id >> 5, pc = id & 31;
            *(LAS u32x4*)(lds + (pc < 16 ? L_QS : L_KS) + j * PQ + (pc & 15) * 16) = pqk[i]; }
        if (tid < 256) { const int j = tid >> 2, pc = tid & 3; const unsigned wv[4] = {pv.x, pv.y, pv.z, pv.w};
#pragma unroll
            for (int e = 0; e < 8; ++e) *(LAS bf16*)(lds + L_VT + (8 * pc + e) * PT + j * 2) = (bf16)((wv[e >> 1] >> ((e & 1) * 16)) & 0xffffu); }
#pragma unroll
        for (int et = 0; et < 3; ++et)
#pragma unroll
            for (int r = 0; r < 4; ++r) *(LAS bf16*)(lds + L_CT + (16 * et + 4 * fq + r) * PQ + (16 * w + fr) * 2) = f2bf(cacc[et][r]);
        float wie = 1.f;
        if (w == 0) {
            const float gi = bf2f(pgi) + bi, gf = bf2f(pgf) + bfg;
            const float lf = fminf(gf, 0.f) - log1pf(__expf(-fabsf(gf)));
            const float b = wave_scan_add(lf, lane);
            const float a = gi - b; float pm = wave_scan_max(a, lane);
            pm = fmaxf(pm, m_prev);
            const float pm63 = lane_get(pm, 63), b63 = lane_get(b, 63);
            SC[SC_A + lane] = a; SC[SC_PM + lane] = pm; SC[SC_WI + lane] = __expf(m_prev - pm); SC[SC_EMT + lane] = __expf(-(b + pm)); SC[SC_WE + lane] = __expf(a - pm63);
            if (lane == 0) { SC[SC_MISC] = __expf(m_prev - pm63); SC[SC_MISC + 1] = b63 + pm63; }
        }
        LDS_BARRIER();
        if (c + 1 < nchunk) ML_PREFETCH(c + 1);
        wie = SC[SC_MISC]; m_prev = SC[SC_MISC + 1];
#pragma unroll
        for (int i = 0; i < 2; ++i) { const int id = tid + 512 * i, j = id & 63, pc = id >> 6; const float we = SC[SC_WE + j];
            const u32x4 kv = *(const LAS u32x4*)(lds + L_KS + j * PQ + pc * 16); const unsigned wv[4] = {kv.x, kv.y, kv.z, kv.w};
#pragma unroll
            for (int e = 0; e < 8; ++e) { const float kf = __builtin_bit_cast(float, (e & 1) ? (wv[e >> 1] & 0xffff0000u) : (wv[e >> 1] << 16));
                *(LAS bf16*)(lds + L_KT + (8 * pc + e) * PT + j * 2) = f2bf(kf * we); } }
#pragma unroll
        for (int cc = 0; cc < 2; ++cc) { const int ct = 2 * half + cc;
            f32x4 acc = (f32x4){0.f, 0.f, 0.f, 0.f};
            if (ct <= rt) {
#pragma unroll
                for (int k = 0; k < 4; ++k) acc = mma(frag(lds, L_QS, PQ, 16 * rt, 32 * k, lane), frag(lds, L_KS, PQ, 16 * ct, 32 * k, lane), acc);
            }
            const int sp = 16 * ct + fr; const float as = SC[SC_A + sp];
#pragma unroll
            for (int r = 0; r < 4; ++r) { const int t = 16 * rt + 4 * fq + r; const float v = (sp <= t) ? acc[r] * __expf(as - SC[SC_PM + t]) : 0.f;
                *(LAS bf16*)(lds + L_SB + t * PT + sp * 2) = f2bf(v); } }
        LDS_BARRIER();
        f32x4 nacc[2]; const int nct = half ? 1 : 2;
#pragma unroll
        for (int cc = 0; cc < 2; ++cc) { if (cc < nct) { const int ct = half ? 2 : cc;
            f32x4 a1 = (f32x4){0.f, 0.f, 0.f, 0.f}, a2 = (f32x4){0.f, 0.f, 0.f, 0.f};
#pragma unroll
            for (int k = 0; k < 2; ++k) a1 = mma(frag(lds, L_SB, PT, 16 * rt, 32 * k, lane), frag(lds, L_VT, PT, 16 * ct, 32 * k, lane), a1);
#pragma unroll
            for (int k = 0; k < 4; ++k) a2 = mma(frag(lds, L_QS, PQ, 16 * rt, 32 * k, lane), frag(lds, L_CT, PQ, 16 * ct, 32 * k, lane), a2);
#pragma unroll
            for (int r = 0; r < 4; ++r) a1[r] += SC[SC_WI + 16 * rt + 4 * fq + r] * a2[r];
            nacc[cc] = a1; } }
        if (half && fr == 0) {
#pragma unroll
            for (int r = 0; r < 4; ++r) SC[SC_DEN + 16 * rt + 4 * fq + r] = nacc[0][r];
        }
#pragma unroll
        for (int et = 0; et < 3; ++et) { cacc[et] = cacc[et] * wie;
#pragma unroll
            for (int k = 0; k < 2; ++k) cacc[et] = mma(frag(lds, L_VT, PT, 16 * et, 32 * k, lane), frag(lds, L_KT, PT, 16 * w, 32 * k, lane), cacc[et]); }
        LDS_BARRIER();
        if (!half) {
#pragma unroll
            for (int cc = 0; cc < 2; ++cc)
#pragma unroll
                for (int r = 0; r < 4; ++r) { const int t = 16 * rt + 4 * fq + r; const float den = fmaxf(fabsf(SC[SC_DEN + t]), SC[SC_EMT + t]);
                    *(LAS bf16*)(lds + L_HS + t * 80 + (16 * cc + fr) * 2) = f2bf(nacc[cc][r] * __builtin_amdgcn_rcpf(den)); }
        }
        LDS_BARRIER();
        if (tid < 256) { const int j = tid >> 2, pc = tid & 3;
            *(u32x4*)(U + ML_TOK(c, j) * PU + dir * MW + head * 128 + vb * EV + 8 * pc) = *(const LAS u32x4*)(lds + L_HS + j * 80 + pc * 16); }
    }
    if (!q.grid) {
        const size_t sb = (((size_t)q.b * DEPTH + l) * 2 + dir) * MH + head; const int d = 16 * w + fr;
#pragma unroll
        for (int et = 0; et < 2; ++et)
#pragma unroll
            for (int r = 0; r < 4; ++r) P.out[OUT_C + (sb * 128 + d) * 128 + vb * EV + 16 * et + 4 * fq + r] = cacc[et][r];
        if (vb == 0) { if (fq == 0) P.out[OUT_N + sb * 128 + d] = cacc[2][0]; if (tid == 0) P.out[OUT_M + sb] = m_prev; }
    }
    LDS_BARRIER();
#undef ML_TOK
#undef ML_PREFETCH
}
constexpr int M_QS = 0, M_KS = M_QS + 2 * 64 * PQ, M_KT = M_KS + 64 * PQ, M_VT = M_KT + 128 * PT, M_SB = M_VT + 2 * 48 * PT, M_CT = M_SB + 64 * PT, M_HS = M_CT + 48 * PQ, M_SC = M_HS + 64 * 80, M_END = M_SC + 2 * 4096;
static_assert(M_END <= 131072, "pipelined mLSTM LDS map");
__device__ __forceinline__ void mlstm_item2(LAS unsigned char* lds, CParams& P, int l, int s, int head, int dir, int vb) {
    const int tid = threadIdx.x, w = __builtin_amdgcn_readfirstlane(tid >> 6), lane = tid & 63, fr = lane & 15, fq = lane >> 4;
    const int rt = w & 3, half = w >> 2;
    const SeqInfo q = seqinfo(s); const int nchunk = q.T / 64;
    const bf16* QK = WSP(bf16, WS_QKC); bf16* U = WSP(bf16, WS_U1);
    f32x4 cacc[3];
    float m_prev;
    const size_t sb = (((size_t)q.b * DEPTH + l) * 2 + dir) * MH + head;
    if (!q.grid) { cacc[0] = cacc[1] = cacc[2] = (f32x4){0.f, 0.f, 0.f, 0.f}; m_prev = 0.f; }
    else {
        const int d = 16 * w + fr;
#pragma unroll
        for (int et = 0; et < 2; ++et)
#pragma unroll
            for (int r = 0; r < 4; ++r) cacc[et][r] = P.in[ST_C][(sb * 128 + d) * 128 + vb * EV + 16 * et + 4 * fq + r];
        cacc[2] = (f32x4){0.f, 0.f, 0.f, 0.f}; if (fq == 0) cacc[2][0] = P.in[ST_N][sb * 128 + d];
        m_prev = P.in[ST_M][sb];
    }
    const float bi = P.in[M_GATE_B][(size_t)l * 4 * MH + (2 * dir) * MH + head], bfg = P.in[M_GATE_B][(size_t)l * 4 * MH + (2 * dir + 1) * MH + head];
    for (int i = tid; i < 2 * 16 * 64; i += 512) { const int b = i >> 10, r = (i >> 6) & 15, c = i & 63; *(LAS bf16*)(lds + M_VT + b * 48 * PT + (32 + r) * PT + c * 2) = (r == 0) ? (bf16)0x3f80 : (bf16)0; }
    u32x4 pqk[4]; u32x4 pv; bf16 pgi = 0, pgf = 0;
#define ML_TOK(c, j) ((size_t)(q.base + (dir ? q.T - 1 - ((c) * 64 + (j)) : ((c) * 64 + (j)))))
#define ML_PREFETCH(c) do { _Pragma("unroll") for (int i = 0; i < 4; ++i) { const int id = tid + 512 * i, j = id >> 5, pc = id & 31; \
            pqk[i] = *(const u32x4*)(QK + ML_TOK(c, j) * (2 * MW) + (pc < 16 ? head * 128 + 8 * pc : MW + head * 128 + 8 * (pc - 16))); } \
        if (tid < 256) { const int j = tid >> 2, pc = tid & 3; pv = *(const u32x4*)(U + ML_TOK(c, j) * PU + OFF_V + head * 128 + vb * EV + 8 * pc); } \
        if (w == 4) { const bf16* g = U + ML_TOK(c, lane) * PU + OFF_G; pgi = g[(2 * dir) * MH + head]; pgf = g[(2 * dir + 1) * MH + head]; } } while (0)
#define ML_STAGE_A(pb) do { \
        _Pragma("unroll") for (int i = 0; i < 4; ++i) { const int id = tid + 512 * i, j = id >> 5, pc = id & 31; \
            *(LAS u32x4*)(lds + (pc < 16 ? M_QS + (pb) * 64 * PQ : M_KS) + j * PQ + (pc & 15) * 16) = pqk[i]; } \
        if (tid < 256) { const int j = tid >> 2, pc = tid & 3; const unsigned wv[4] = {pv.x, pv.y, pv.z, pv.w}; \
            _Pragma("unroll") for (int e = 0; e < 8; ++e) *(LAS bf16*)(lds + M_VT + (pb) * 48 * PT + (8 * pc + e) * PT + j * 2) = (bf16)((wv[e >> 1] >> ((e & 1) * 16)) & 0xffffu); } \
        if (w == 4) { LAS float* SCn = (LAS float*)(lds + M_SC + (pb) * 4096); \
            const float gi = bf2f(pgi) + bi, gf = bf2f(pgf) + bfg; \
            const float lf = fminf(gf, 0.f) - log1pf(__expf(-fabsf(gf))); \
            const float b = wave_scan_add(lf, lane); \
            const float a = gi - b; float pm = wave_scan_max(a, lane); \
            pm = fmaxf(pm, m_prev); \
            const float pm63 = lane_get(pm, 63), b63 = lane_get(b, 63); \
            SCn[SC_A + lane] = a; SCn[SC_PM + lane] = pm; SCn[SC_WI + lane] = __expf(m_prev - pm); SCn[SC_EMT + lane] = __expf(-(b + pm)); SCn[SC_WE + lane] = __expf(a - pm63); \
            if (lane == 0) SCn[SC_MISC] = __expf(m_prev - pm63); \
            m_prev = b63 + pm63; } } while (0)
#define ML_STAGE_D(pb) do { const LAS float* SCn = (const LAS float*)(lds + M_SC + (pb) * 4096); \
        _Pragma("unroll") for (int i = 0; i < 2; ++i) { const int id = tid + 512 * i, j = id & 63, pc = id >> 6; const float we = SCn[SC_WE + j]; \
            const u32x4 kv = *(const LAS u32x4*)(lds + M_KS + j * PQ + pc * 16); const unsigned wv[4] = {kv.x, kv.y, kv.z, kv.w}; \
            _Pragma("unroll") for (int e = 0; e < 8; ++e) { const float kf = __builtin_bit_cast(float, (e & 1) ? (wv[e >> 1] & 0xffff0000u) : (wv[e >> 1] << 16)); \
                *(LAS bf16*)(lds + M_KT + (8 * pc + e) * PT + j * 2) = f2bf(kf * we); } } \
        _Pragma("unroll") for (int cc = 0; cc < 2; ++cc) { const int ct = 2 * half + cc; \
            f32x4 acc = (f32x4){0.f, 0.f, 0.f, 0.f}; \
            if (ct <= rt) { \
                _Pragma("unroll") for (int k = 0; k < 4; ++k) acc = mma(frag(lds, M_QS + (pb) * 64 * PQ, PQ, 16 * rt, 32 * k, lane), frag(lds, M_KS, PQ, 16 * ct, 32 * k, lane), acc); } \
            const int sp = 16 * ct + fr; const float as = SCn[SC_A + sp]; \
            _Pragma("unroll") for (int r = 0; r < 4; ++r) { const int t = 16 * rt + 4 * fq + r; const float v = (sp <= t) ? acc[r] * __expf(as - SCn[SC_PM + t]) : 0.f; \
                *(LAS bf16*)(lds + M_SB + t * PT + sp * 2) = f2bf(v); } } \
        _Pragma("unroll") for (int et = 0; et < 3; ++et) \
            _Pragma("unroll") for (int r = 0; r < 4; ++r) *(LAS bf16*)(lds + M_CT + (16 * et + 4 * fq + r) * PQ + (16 * w + fr) * 2) = f2bf(cacc[et][r]); } while (0)
#define ML_STORE(c) do { if (tid < 256) { const int j = tid >> 2, pc = tid & 3; \
            *(u32x4*)(U + ML_TOK(c, j) * PU + dir * MW + head * 128 + vb * EV + 8 * pc) = *(const LAS u32x4*)(lds + M_HS + j * 80 + pc * 16); } } while (0)
    ML_PREFETCH(0);
    ML_STAGE_A(0);
    LDS_BARRIER();
    if (nchunk > 1) ML_PREFETCH(1);
    ML_STAGE_D(0);
    LDS_BARRIER();
    for (int c = 0; c < nchunk; ++c) {
        const int pb = c & 1;
        if (c + 1 < nchunk) { ML_STAGE_A(pb ^ 1); if (c + 2 < nchunk) ML_PREFETCH(c + 2); }
        if (c >= 1) ML_STORE(c - 1);
        LAS float* SC = (LAS float*)(lds + M_SC + pb * 4096);
        const float wie = SC[SC_MISC];
        f32x4 nacc[2]; const int nct = half ? 1 : 2;
#pragma unroll
        for (int cc = 0; cc < 2; ++cc) { if (cc < nct) { const int ct = half ? 2 : cc;
            f32x4 a1 = (f32x4){0.f, 0.f, 0.f, 0.f}, a2 = (f32x4){0.f, 0.f, 0.f, 0.f};
#pragma unroll
            for (int k = 0; k < 2; ++k) a1 = mma(frag(lds, M_SB, PT, 16 * rt, 32 * k, lane), frag(lds, M_VT + pb * 48 * PT, PT, 16 * ct, 32 * k, lane), a1);
#pragma unroll
            for (int k = 0; k < 4; ++k) a2 = mma(frag(lds, M_QS + pb * 64 * PQ, PQ, 16 * rt, 32 * k, lane), frag(lds, M_CT, PQ, 16 * ct, 32 * k, lane), a2);
#pragma unroll
            for (int r = 0; r < 4; ++r) a1[r] += SC[SC_WI + 16 * rt + 4 * fq + r] * a2[r];
            nacc[cc] = a1; } }
        if (half && fr == 0) {
#pragma unroll
            for (int r = 0; r < 4; ++r) SC[SC_DEN + 16 * rt + 4 * fq + r] = nacc[0][r];
        }
#pragma unroll
        for (int et = 0; et < 3; ++et) { cacc[et] = cacc[et] * wie;
#pragma unroll
            for (int k = 0; k < 2; ++k) cacc[et] = mma(frag(lds, M_VT + pb * 48 * PT, PT, 16 * et, 32 * k, lane), frag(lds, M_KT, PT, 16 * w, 32 * k, lane), cacc[et]); }
        LDS_BARRIER();
        if (!half) {
#pragma unroll
            for (int cc = 0; cc < 2; ++cc)
#pragma unroll
                for (int r = 0; r < 4; ++r) { const int t = 16 * rt + 4 * fq + r; const float den = fmaxf(fabsf(SC[SC_DEN + t]), SC[SC_EMT + t]);
                    *(LAS bf16*)(lds + M_HS + t * 80 + (16 * cc + fr) * 2) = f2bf(nacc[cc][r] * __builtin_amdgcn_rcpf(den)); }
        }
        if (c + 1 < nchunk) ML_STAGE_D(pb ^ 1);
        LDS_BARRIER();
    }
    ML_STORE(nchunk - 1);
    if (!q.grid) {
        const int d = 16 * w + fr;
#pragma unroll
        for (int et = 0; et < 2; ++et)
#pragma unroll
            for (int r = 0; r < 4; ++r) P.out[OUT_C + (sb * 128 + d) * 128 + vb * EV + 16 * et + 4 * fq + r] = cacc[et][r];
        if (vb == 0) { if (fq == 0) P.out[OUT_N + sb * 128 + d] = cacc[2][0]; if (tid == 256) P.out[OUT_M + sb] = m_prev; }
    }
    LDS_BARRIER();
#undef ML_TOK
#undef ML_PREFETCH
#undef ML_STAGE_A
#undef ML_STAGE_D
#undef ML_STORE
}
constexpr int N_ITEMS = NSEQ * MH * 2 * NVB;
__device__ __forceinline__ void decode_item(int it, int& s, int& head, int& dir, int& vb) {
    vb = it % NVB; int ch = it / NVB; dir = ch & 1; ch >>= 1; head = ch % MH; const int sq = ch / MH;
    s = sq < LB ? CB + sq : sq - LB;
}
}


namespace rw {
typedef short bf16x8 __attribute__((ext_vector_type(8)));
typedef float f32x4 __attribute__((ext_vector_type(4)));
typedef unsigned u32x4 __attribute__((ext_vector_type(4)));
enum { V_A = 0, V_W, V_B, V_K, V_R, NVEC };
constexpr int REC = NVEC * 64 * 4;
constexpr int PT = 144;
constexpr int L_SBUF = 0, L_VT = L_SBUF + 64 * REC, L_TW = L_VT + 64 * 256, L_AL = L_TW + 64 * PT, L_YS = L_AL + 64 * PT, L_INV = L_YS + 64 * 16 * 4, L_END = L_INV + 256;
__device__ __forceinline__ int vt_off(int row, int tt) { return row * 256 + ((tt ^ (((row >> 3) & 7) << 2)) << 2); }
static_assert(L_END <= 131072, "RWKV LDS map");
__device__ __forceinline__ float dpp_xor1(float x) { return __builtin_bit_cast(float, __builtin_amdgcn_update_dpp(0, __builtin_bit_cast(int, x), 0xB1, 0xF, 0xF, true)); }
__device__ __forceinline__ float dpp_xor2(float x) { return __builtin_bit_cast(float, __builtin_amdgcn_update_dpp(0, __builtin_bit_cast(int, x), 0x4E, 0xF, 0xF, true)); }
__device__ __forceinline__ float dpp_ror4(float x) { return __builtin_bit_cast(float, __builtin_amdgcn_update_dpp(0, __builtin_bit_cast(int, x), 0x124, 0xF, 0xF, true)); }
__device__ __forceinline__ float dpp_ror8(float x) { return __builtin_bit_cast(float, __builtin_amdgcn_update_dpp(0, __builtin_bit_cast(int, x), 0x128, 0xF, 0xF, true)); }
__device__ __forceinline__ float allsum16(float x) { x += dpp_xor1(x); x += dpp_xor2(x); x += dpp_ror4(x); x += dpp_ror8(x); return x; }
__device__ __forceinline__ f32x4 cvt_lo4(unsigned a, unsigned b) { return (f32x4){__builtin_bit_cast(float, a << 16), __builtin_bit_cast(float, a & 0xffff0000u), __builtin_bit_cast(float, b << 16), __builtin_bit_cast(float, b & 0xffff0000u)}; }
__device__ __forceinline__ float allsum32(float x) {
    x = allsum16(x);
    float xa = x, xb = x;
    asm volatile("v_mov_b32 %1, %0\n\ts_nop 1\n\tv_permlane32_swap_b32 %0, %1\n\ts_nop 1" : "+v"(xa), "=&v"(xb));
    return xa + xb;
}
__device__ __forceinline__ void rwkv_item(LAS unsigned char* lds, CParams& P, int l, int s, int head, int dir, int rh) {
    const int tid = threadIdx.x, w = __builtin_amdgcn_readfirstlane(tid >> 6), lane = tid & 63, fr = lane & 15, fq = lane >> 4;
    const int rt = w & 3, half = w >> 2, hc = head * 64;
    const SeqInfo q = seqinfo(s); const int nchunk = q.T / 64;
    const bf16* RX = WSP(bf16, WS_RXC); bf16* U = WSP(bf16, WS_U1);
    const int pj = tid >> 3, psub = tid & 7;
    const int hh = lane >> 5, rsel = (lane >> 4) & 1, cg = lane & 15;
    const int row = 16 * rh + 2 * w + rsel, col0 = 32 * hh + 2 * cg;
    typedef float f32x2 __attribute__((ext_vector_type(2)));
    f32x2 S2;
    if (!q.grid) S2 = (f32x2){0.f, 0.f};
    else { const size_t sb = (((size_t)q.b * DEPTH + l) * 2 + dir) * RH + head; S2 = *(const f32x2*)(P.in[ST_R] + (sb * 64 + row) * 64 + col0); }
    float rkk8[8];
#pragma unroll
    for (int e = 0; e < 8; ++e) rkk8[e] = P.in[R_KK][(size_t)l * RW + hc + 8 * psub + e];
    float c_w0[2], c_a0[2], c_kk[2], c_ka[2];
    bf16x8 bw[2][2], ba[2][2];
#pragma unroll
    for (int cc = 0; cc < 2; ++cc) { const int c = 16 * (2 * half + cc) + fr;
        c_w0[cc] = P.in[R_W0][((size_t)l * 2 + dir) * RW + hc + c]; c_a0[cc] = P.in[R_A0][((size_t)l * 2 + dir) * RW + hc + c];
        c_kk[cc] = P.in[R_KK][(size_t)l * RW + hc + c]; c_ka[cc] = P.in[R_KA][(size_t)l * RW + hc + c];
#pragma unroll
        for (int ks = 0; ks < 2; ++ks)
#pragma unroll
            for (int e = 0; e < 8; ++e) { const int j = 32 * ks + 8 * fq + e;
                bw[cc][ks][e] = (short)f2bf(P.in[R_W2][(((size_t)l * 2 + dir) * 64 + j) * RW + hc + c]);
                ba[cc][ks][e] = (short)f2bf(P.in[R_A2][(((size_t)l * 2 + dir) * 64 + j) * RW + hc + c]); } }
    u32x4 pf[5];
#define RW_TOK(c, j) ((size_t)(q.base + (dir ? q.T - 1 - ((c) * 64 + (j)) : ((c) * 64 + (j)))))
#define RW_PREFETCH(c) do { const bf16* rx = RX + RW_TOK(c, pj) * RIN + 8 * psub; \
        pf[0] = *(const u32x4*)(rx + RX_R + hc); pf[1] = *(const u32x4*)(rx + RX_K + hc); pf[2] = *(const u32x4*)(rx + RX_V + hc); \
        pf[3] = *(const u32x4*)(rx + RX_WL + dir * 64); pf[4] = *(const u32x4*)(rx + RX_AL + dir * 64); } while (0)
    RW_PREFETCH(0);
    for (int c = 0; c < nchunk; ++c) {
        { LAS unsigned char* rec = lds + L_SBUF + pj * REC + psub * 32;
          *(LAS f32x4*)(rec + V_R * 256) = cvt_lo4(pf[0].x, pf[0].y); *(LAS f32x4*)(rec + V_R * 256 + 16) = cvt_lo4(pf[0].z, pf[0].w);
          { const f32x4 v0 = cvt_lo4(pf[2].x, pf[2].y), v1 = cvt_lo4(pf[2].z, pf[2].w);
#pragma unroll
            for (int e = 0; e < 4; ++e) { *(LAS float*)(lds + L_VT + vt_off(8 * psub + e, pj)) = v0[e]; *(LAS float*)(lds + L_VT + vt_off(8 * psub + 4 + e, pj)) = v1[e]; } }
          const f32x4 k0 = cvt_lo4(pf[1].x, pf[1].y), k1 = cvt_lo4(pf[1].z, pf[1].w);
          *(LAS f32x4*)(rec + V_K * 256) = k0; *(LAS f32x4*)(rec + V_K * 256 + 16) = k1;
          float ss = 0.f;
#pragma unroll
          for (int e = 0; e < 4; ++e) { const float x0 = k0[e] * rkk8[e], x1 = k1[e] * rkk8[4 + e]; ss += x0 * x0 + x1 * x1; }
          ss += dpp_xor1(ss); ss += dpp_xor2(ss); ss += __shfl_xor(ss, 4);
          if (psub == 0) *(LAS float*)(lds + L_INV + pj * 4) = 1.0f / fmaxf(sqrtf(ss), 1e-12f);
          *(LAS u32x4*)(lds + L_TW + pj * PT + psub * 16) = pf[3]; *(LAS u32x4*)(lds + L_AL + pj * PT + psub * 16) = pf[4]; }
        __syncthreads();
        if (c + 1 < nchunk) RW_PREFETCH(c + 1);
#pragma unroll
        for (int cc = 0; cc < 2; ++cc) { const int ct = 2 * half + cc; const int cidx = 16 * ct + fr;
            f32x4 aw = (f32x4){0.f, 0.f, 0.f, 0.f}, aa = (f32x4){0.f, 0.f, 0.f, 0.f};
#pragma unroll
            for (int ks = 0; ks < 2; ++ks) { aw = ml::mma(ml::frag(lds, L_TW, PT, 16 * rt, 32 * ks, lane), bw[cc][ks], aw); aa = ml::mma(ml::frag(lds, L_AL, PT, 16 * rt, 32 * ks, lane), ba[cc][ks], aa); }
#pragma unroll
            for (int r = 0; r < 4; ++r) { const int tok = 16 * rt + 4 * fq + r; LAS float* rec = (LAS float*)(lds + L_SBUF + tok * REC) + cidx;
                const float decay = __expf(-0.6065306597126334f * pg8::fsigmoid(c_w0[cc] + aw[r])); const float alpha = pg8::fsigmoid(c_a0[cc] + aa[r]);
                const float kraw = rec[V_K * 64]; const float kkn = kraw * c_kk[cc] * *(LAS float*)(lds + L_INV + tok * 4);
                rec[V_A * 64] = -kkn; rec[V_W * 64] = decay; rec[V_B * 64] = kkn * alpha; rec[V_K * 64] = kraw * (1.0f + (alpha - 1.0f) * c_ka[cc]); } }
        __syncthreads();
        {
            const LAS unsigned char* rbase = lds + L_SBUF + col0 * 4;
            f32x2 ca = *(const LAS f32x2*)(rbase + V_A * 256), cw = *(const LAS f32x2*)(rbase + V_W * 256), cb = *(const LAS f32x2*)(rbase + V_B * 256),
                  ck = *(const LAS f32x2*)(rbase + V_K * 256), cr = *(const LAS f32x2*)(rbase + V_R * 256);
#pragma unroll 1
            for (int blk = 0; blk < 4; ++blk) {
                float ykeep = 0.f;
#pragma unroll
                for (int g4 = 0; g4 < 4; ++g4) {
                    const f32x4 v4 = *(const LAS f32x4*)(lds + L_VT + vt_off(row, 16 * blk + 4 * g4));
#pragma unroll
                    for (int i4 = 0; i4 < 4; ++i4) {
                        const int i = 4 * g4 + i4, tt = 16 * blk + i, tn = tt < 63 ? tt + 1 : 63;
                        const LAS unsigned char* rn = rbase + tn * REC;
                        const f32x2 na = *(const LAS f32x2*)(rn + V_A * 256), nw = *(const LAS f32x2*)(rn + V_W * 256), nb = *(const LAS f32x2*)(rn + V_B * 256),
                                    nk = *(const LAS f32x2*)(rn + V_K * 256), nr = *(const LAS f32x2*)(rn + V_R * 256);
                        const float vv = v4[i4];
                        const f32x2 p = S2 * ca;
                        const float sa = allsum32(p.x + p.y);
                        S2 = S2 * cw + ck * vv;
                        S2 = cb * sa + S2;
                        const f32x2 yq = S2 * cr;
                        const float y = allsum32(yq.x + yq.y);
                        ykeep = (cg == i) ? y : ykeep;
                        ca = na; cw = nw; cb = nb; ck = nk; cr = nr;
                    }
                }
                if (hh == 0) *(LAS float*)(lds + L_YS + ((16 * blk + cg) * 16 + 2 * w + rsel) * 4) = ykeep;
            }
        }
        __syncthreads();
        if (tid < 128) { const int j = tid >> 1, pc = tid & 1; const LAS float* ys = (const LAS float*)(lds + L_YS) + j * 16 + 8 * pc;
            u32x4 o; o.x = pg8::cvt_pk_bf16(ys[0], ys[1]); o.y = pg8::cvt_pk_bf16(ys[2], ys[3]); o.z = pg8::cvt_pk_bf16(ys[4], ys[5]); o.w = pg8::cvt_pk_bf16(ys[6], ys[7]);
            *(u32x4*)(U + RW_TOK(c, j) * PU + OFF_R + dir * RW + hc + 16 * rh + 8 * pc) = o; }
    }
    if (!q.grid) { const size_t sb = (((size_t)q.b * DEPTH + l) * 2 + dir) * RH + head; *(f32x2*)(P.out + OUT_S + (sb * 64 + row) * 64 + col0) = S2; }
    __syncthreads();
#undef RW_TOK
#undef RW_PREFETCH
}
constexpr int N_ITEMS = NSEQ * RH * 2 * 4;
__device__ __forceinline__ void decode_item(int it, int& s, int& head, int& dir, int& rh) {
    rh = it & 3; int ch = it >> 2; dir = ch & 1; ch >>= 1; head = ch % RH; const int sq = ch / RH;
    s = sq < LB ? CB + sq : sq - LB;
}
}


namespace wy {
typedef short bf16x8 __attribute__((ext_vector_type(8)));
typedef float f32x4 __attribute__((ext_vector_type(4)));
typedef unsigned u32x4 __attribute__((ext_vector_type(4)));
constexpr int PV = 144, PS = 48, PVS = 136;
constexpr int L_AH = 0, L_RH = L_AH + 64 * PV, L_BT = L_RH + 64 * PV, L_KT = L_BT + 64 * PV, L_NAKT = L_KT + 64 * PV, L_NRKT = L_NAKT + 4 * 16 * PS,
              L_NRBT = L_NRKT + 4 * 16 * PS, L_TT = L_NRBT + 4 * 16 * PS, L_GL = L_TT + 4 * 16 * PS, PACK_BYTES = L_GL + 1024,
              L_VS = PACK_BYTES, L_BH = L_VS + 64 * PV, L_KH = L_BH + 64 * PV, L_YS = L_KH + 64 * PV, L_TW = L_YS + 64 * PV, L_AL = L_TW + 64 * PV, L_NAB = L_AL + 64 * PV, L_INV = L_NAB + 4096, L_END = L_INV + 256;
constexpr int RING = 8, PACK_U = PACK_BYTES / 16, N_LAT = LB * RH * 2, RING_A = 20;
static_assert(PACK_BYTES % 1024 == 0 && PACK_U <= 8 * 512 && (size_t)RING_A * RING * PACK_BYTES <= (size_t)N1P * D * 2 && WS_END + (size_t)(N_LAT - RING_A) * RING * PACK_BYTES <= ((size_t)256 << 20), "ring placement");
static_assert(L_END <= 131072, "WY LDS map");
__device__ __forceinline__ bf16x8 fragk16(LAS unsigned char* lds, int base, int pitch, int row0, int k0, int lane) {
    const bf16x8 v = *(const LAS bf16x8*)(lds + base + (row0 + (lane & 15)) * pitch + (k0 + 8 * ((lane >> 4) & 1)) * 2);
    const bf16x8 z = {0, 0, 0, 0, 0, 0, 0, 0};
    return (lane < 32) ? v : z;
}
__device__ __forceinline__ void stb(LAS unsigned char* lds, int off, float v) { *(LAS bf16*)(lds + off) = f2bf(v); }
typedef unsigned u32x2 __attribute__((ext_vector_type(2)));
__device__ __forceinline__ bf16x8 pack_k16(const f32x4 v) { u32x4 o; o.x = pg8::cvt_pk_bf16(v[0], v[1]); o.y = pg8::cvt_pk_bf16(v[2], v[3]); o.z = 0u; o.w = 0u; return __builtin_bit_cast(bf16x8, o); }
__device__ __forceinline__ bf16x8 pack_k32(const f32x4 a, const f32x4 b) { u32x4 o; o.x = pg8::cvt_pk_bf16(a[0], a[1]); o.y = pg8::cvt_pk_bf16(a[2], a[3]); o.z = pg8::cvt_pk_bf16(b[0], b[1]); o.w = pg8::cvt_pk_bf16(b[2], b[3]);
    return __builtin_bit_cast(bf16x8, o); }
__device__ __forceinline__ bf16x8 ld_k16(LAS unsigned char* lds, int base, int pitch, int row0, int col0, int lane) {
    const u32x2 v = *(const LAS u32x2*)(lds + base + (row0 + (lane & 15)) * pitch + (col0 + 4 * (lane >> 4)) * 2); u32x4 o; o.x = v.x; o.y = v.y; o.z = 0u; o.w = 0u; return __builtin_bit_cast(bf16x8, o); }
__device__ __forceinline__ bf16x8 ld_k32(LAS unsigned char* lds, int base, int pitch, int row0, int col0, int lane) {
    const LAS unsigned char* p = lds + base + (row0 + (lane & 15)) * pitch + (col0 + 4 * (lane >> 4)) * 2;
    const u32x2 v0 = *(const LAS u32x2*)p, v1 = *(const LAS u32x2*)(p + 32); u32x4 o; o.x = v0.x; o.y = v0.y; o.z = v1.x; o.w = v1.y; return __builtin_bit_cast(bf16x8, o); }
__device__ __forceinline__ void rwkv_item(LAS unsigned char* lds, CParams& P, int l, int s, int head, int dir) {
    const int tid = threadIdx.x, w = __builtin_amdgcn_readfirstlane(tid >> 6), lane = tid & 63, fr = lane & 15, fq = lane >> 4;
    const int rt = w & 3, half = w >> 2, hc = head * 64;
    const SeqInfo q = seqinfo(s); const int nchunk = q.T / 64;
    const bf16* RX = WSP(bf16, WS_RXC); bf16* U = WSP(bf16, WS_U1);
    const int pj = tid >> 3, psub = tid & 7;
    f32x4 sacc[4];
#pragma unroll
    for (int ct = 0; ct < 4; ++ct) sacc[ct] = (f32x4){0.f, 0.f, 0.f, 0.f};
    if (w < 4 && q.grid) { const size_t sb = (((size_t)q.b * DEPTH + l) * 2 + dir) * RH + head;
#pragma unroll
        for (int ct = 0; ct < 4; ++ct) sacc[ct] = *(const f32x4*)(P.in[ST_R] + (sb * 64 + 16 * w + fr) * 64 + 16 * ct + 4 * fq); }
    float rkk8[8];
#pragma unroll
    for (int e = 0; e < 8; ++e) rkk8[e] = P.in[R_KK][(size_t)l * RW + hc + 8 * psub + e];
    float c_w0[2], c_a0[2], c_kk[2], c_ka[2];
#pragma unroll
    for (int cc = 0; cc < 2; ++cc) { const int c = 16 * (2 * half + cc) + fr;
        c_w0[cc] = P.in[R_W0][((size_t)l * 2 + dir) * RW + hc + c]; c_a0[cc] = P.in[R_A0][((size_t)l * 2 + dir) * RW + hc + c];
        c_kk[cc] = P.in[R_KK][(size_t)l * RW + hc + c]; c_ka[cc] = P.in[R_KA][(size_t)l * RW + hc + c]; }
    const bf16* w2t = WSP(bf16, O_W2T) + ((size_t)dir * RW + hc) * 64; const bf16* a2t = WSP(bf16, O_A2T) + ((size_t)dir * RW + hc) * 64;
    u32x4 pf[5];
#define WY_TOK(c, j) ((size_t)(q.base + (dir ? q.T - 1 - ((c) * 64 + (j)) : ((c) * 64 + (j)))))
#define WY_PREFETCH(c) do { const bf16* rx = RX + WY_TOK(c, pj) * RIN + 8 * psub; \
        pf[0] = *(const u32x4*)(rx + RX_R + hc); pf[1] = *(const u32x4*)(rx + RX_K + hc); pf[2] = *(const u32x4*)(rx + RX_V + hc); \
        pf[3] = *(const u32x4*)(rx + RX_WL + dir * 64); pf[4] = *(const u32x4*)(rx + RX_AL + dir * 64); } while (0)
    WY_PREFETCH(0);
    for (int c = 0; c < nchunk; ++c) {
        { *(LAS u32x4*)(lds + L_RH + pj * PV + psub * 16) = pf[0]; *(LAS u32x4*)(lds + L_KH + pj * PV + psub * 16) = pf[1];
          const unsigned kw[4] = {pf[1].x, pf[1].y, pf[1].z, pf[1].w}, vw[4] = {pf[2].x, pf[2].y, pf[2].z, pf[2].w};
          float ss = 0.f;
#pragma unroll
          for (int e = 0; e < 8; ++e) { const float kf = __builtin_bit_cast(float, (e & 1) ? (kw[e >> 1] & 0xffff0000u) : (kw[e >> 1] << 16)) * rkk8[e]; ss += kf * kf;
              *(LAS bf16*)(lds + L_VS + (8 * psub + e) * PVS + pj * 2) = (bf16)((vw[e >> 1] >> ((e & 1) * 16)) & 0xffffu); }
          ss += rw::dpp_xor1(ss); ss += rw::dpp_xor2(ss); ss += __shfl_xor(ss, 4);
          if (psub == 0) *(LAS float*)(lds + L_INV + pj * 4) = 1.0f / fmaxf(sqrtf(ss), 1e-12f);
          *(LAS u32x4*)(lds + L_TW + pj * PV + psub * 16) = pf[3]; *(LAS u32x4*)(lds + L_AL + pj * PV + psub * 16) = pf[4]; }
        LDS_BARRIER();
        if (c + 1 < nchunk) WY_PREFETCH(c + 1);
#pragma unroll
        for (int cc = 0; cc < 2; ++cc) { const int ct = 2 * half + cc; const int cidx = 16 * ct + fr;
            f32x4 aw = (f32x4){0.f, 0.f, 0.f, 0.f}, aa = (f32x4){0.f, 0.f, 0.f, 0.f};
#pragma unroll
            for (int ks = 0; ks < 2; ++ks) { const size_t bo = (size_t)cidx * 64 + 32 * ks + 8 * fq;
                aw = ml::mma(ml::frag(lds, L_TW, PV, 16 * rt, 32 * ks, lane), *(const bf16x8*)(w2t + bo), aw); aa = ml::mma(ml::frag(lds, L_AL, PV, 16 * rt, 32 * ks, lane), *(const bf16x8*)(a2t + bo), aa); }
            float kr4[4], rr4[4], iv4[4];
#pragma unroll
            for (int r = 0; r < 4; ++r) { const int tok = 16 * rt + 4 * fq + r; kr4[r] = bf2f(*(const LAS bf16*)(lds + L_KH + tok * PV + cidx * 2)); rr4[r] = bf2f(*(const LAS bf16*)(lds + L_RH + tok * PV + cidx * 2));
                iv4[r] = *(const LAS float*)(lds + L_INV + tok * 4); }
            float lw[4], cum[4];
#pragma unroll
            for (int r = 0; r < 4; ++r) { lw[r] = -0.6065306597126334f * pg8::fsigmoid(c_w0[cc] + aw[r]); cum[r] = (r ? cum[r - 1] : 0.f) + lw[r]; }
            const float tot = cum[3]; const float p1 = __shfl_up(tot, 16), p2 = __shfl_up(tot, 32), p3 = __shfl_up(tot, 48);
            const float off = (fq >= 1 ? p1 : 0.f) + (fq >= 2 ? p2 : 0.f) + (fq >= 3 ? p3 : 0.f);
            float gprev = __expf(off);
#pragma unroll
            for (int r = 0; r < 4; ++r) { const int tok = 16 * rt + 4 * fq + r; const float lam = off + cum[r]; const float g = __expf(lam), gi = __builtin_amdgcn_rcpf(g);
                const float alpha = pg8::fsigmoid(c_a0[cc] + aa[r]);
                const float kraw = kr4[r], rraw = rr4[r];
                const float kkn = kraw * c_kk[cc] * iv4[r];
                const bf16 bh = f2bf(kkn * alpha * gi), kh = f2bf(kraw * (1.0f + (alpha - 1.0f) * c_ka[cc]) * gi);
                stb(lds, L_AH + tok * PV + cidx * 2, -kkn * gprev); stb(lds, L_RH + tok * PV + cidx * 2, rraw * g);
                *(LAS bf16*)(lds + L_BH + tok * PV + cidx * 2) = bh; *(LAS bf16*)(lds + L_KH + tok * PV + cidx * 2) = kh;
                *(LAS bf16*)(lds + L_BT + cidx * PV + tok * 2) = bh; *(LAS bf16*)(lds + L_KT + cidx * PV + tok * 2) = kh;
                if (fq == 3 && r == 3) *(LAS float*)(lds + L_GL + (rt * 64 + cidx) * 4) = g;
                gprev = g; } }
        LDS_BARRIER();
        { const int sc = w >> 1, side = w & 1; f32x4 gB = (f32x4){0.f, 0.f, 0.f, 0.f}, gK = (f32x4){0.f, 0.f, 0.f, 0.f};
#pragma unroll
          for (int ks = 0; ks < 2; ++ks) { const bf16x8 af = ml::frag(lds, side ? L_RH : L_AH, PV, 16 * sc, 32 * ks, lane);
              gB = ml::mma(af, ml::frag(lds, L_BH, PV, 16 * sc, 32 * ks, lane), gB); gK = ml::mma(af, ml::frag(lds, L_KH, PV, 16 * sc, 32 * ks, lane), gK); }
#pragma unroll
          for (int r = 0; r < 4; ++r) { const int t = 4 * fq + r; const bool keep = side ? (fr <= t) : (fr < t); const float vB = keep ? gB[r] : 0.f, vK = keep ? gK[r] : 0.f;
              if (side == 0) { *(LAS float*)(lds + L_NAB + ((sc * 16 + t) * 16 + fr) * 4) = vB; stb(lds, L_NAKT + (sc * 16 + t) * PS + fr * 2, vK); }
              else { stb(lds, L_NRBT + (sc * 16 + t) * PS + fr * 2, vB); stb(lds, L_NRKT + (sc * 16 + t) * PS + fr * 2, vK); } } }
        if ((w & 1) == 0 && lane < 16) { const int sc = w >> 1; float Tr[16];
            asm volatile("" ::: "memory");
#pragma unroll
            for (int ph = 0; ph < 4; ++ph) { f32x4 nv[4][4];
#pragma unroll
                for (int tq = 0; tq < 4; ++tq)
#pragma unroll
                    for (int u4 = 0; u4 <= ph; ++u4) nv[tq][u4] = *(const LAS f32x4*)(lds + L_NAB + ((sc * 16 + 4 * ph + tq) * 16 + 4 * u4) * 4);
#pragma unroll
                for (int tq = 0; tq < 4; ++tq) { const int t = 4 * ph + tq; float x0 = (lane == t) ? 1.f : 0.f, x1 = 0.f;
#pragma unroll
                    for (int u = 0; u < 16; ++u) if (u < t) { if (u & 1) x1 += Tr[u] * nv[tq][u >> 2][u & 3]; else x0 += Tr[u] * nv[tq][u >> 2][u & 3]; }
                    Tr[t] = x0 + x1; stb(lds, L_TT + (sc * 16 + t) * PS + lane * 2, Tr[t]); } } }
        LDS_BARRIER();
        if (w < 4) {
#pragma unroll 1
            for (int sc = 0; sc < 4; ++sc) {
                const bf16x8 ah0 = ld_k32(lds, L_AH, PV, 16 * sc, 0, lane), ah1 = ld_k32(lds, L_AH, PV, 16 * sc, 32, lane), rh0 = ld_k32(lds, L_RH, PV, 16 * sc, 0, lane), rh1 = ld_k32(lds, L_RH, PV, 16 * sc, 32, lane);
                const bf16x8 nak = ld_k16(lds, L_NAKT, PS, 16 * sc, 0, lane), nrk = ld_k16(lds, L_NRKT, PS, 16 * sc, 0, lane), ttf = ld_k16(lds, L_TT, PS, 16 * sc, 0, lane), nrb = ld_k16(lds, L_NRBT, PS, 16 * sc, 0, lane);
                const bf16x8 vsf = ld_k16(lds, L_VS, PVS, 16 * w, 16 * sc, lane);
                bf16x8 btf[4], ktf[4]; f32x4 glv[4];
#pragma unroll
                for (int ct = 0; ct < 4; ++ct) { btf[ct] = ld_k16(lds, L_BT, PV, 16 * ct, 16 * sc, lane); ktf[ct] = ld_k16(lds, L_KT, PV, 16 * ct, 16 * sc, lane);
                    glv[ct] = *(const LAS f32x4*)(lds + L_GL + (sc * 64 + 16 * ct + 4 * fq) * 4); }
                const bf16x8 sb0 = pack_k32(sacc[0], sacc[1]), sb1 = pack_k32(sacc[2], sacc[3]);
                f32x4 XT = (f32x4){0.f, 0.f, 0.f, 0.f}, YT = (f32x4){0.f, 0.f, 0.f, 0.f};
                XT = ml::mma(ah0, sb0, XT); XT = ml::mma(ah1, sb1, XT); XT = ml::mma(nak, vsf, XT);
                YT = ml::mma(rh0, sb0, YT); YT = ml::mma(rh1, sb1, YT); YT = ml::mma(nrk, vsf, YT);
                f32x4 UT = (f32x4){0.f, 0.f, 0.f, 0.f};
                UT = ml::mma(ttf, pack_k16(XT), UT);
                const bf16x8 ub = pack_k16(UT);
                YT = ml::mma(nrb, ub, YT);
#pragma unroll
                for (int r = 0; r < 4; ++r) stb(lds, L_YS + (16 * sc + 4 * fq + r) * PV + (16 * w + fr) * 2, YT[r]);
#pragma unroll
                for (int ct = 0; ct < 4; ++ct) { sacc[ct] = ml::mma(btf[ct], ub, sacc[ct]); sacc[ct] = ml::mma(ktf[ct], vsf, sacc[ct]); sacc[ct] = sacc[ct] * glv[ct]; }
            }
        }
        LDS_BARRIER();
        *(u32x4*)(U + WY_TOK(c, pj) * PU + OFF_R + dir * RW + hc + 8 * psub) = *(const LAS u32x4*)(lds + L_YS + pj * PV + psub * 16);
    }
    if (!q.grid && w < 4) { const size_t sb = (((size_t)q.b * DEPTH + l) * 2 + dir) * RH + head;
#pragma unroll
        for (int ct = 0; ct < 4; ++ct) *(f32x4*)(P.out + OUT_S + (sb * 64 + 16 * w + fr) * 64 + 16 * ct + 4 * fq) = sacc[ct]; }
    LDS_BARRIER();
#undef WY_TOK
#undef WY_PREFETCH
}
__device__ __forceinline__ int tid_opaque() { int t = threadIdx.x; asm volatile("" : "+v"(t)); return t; }
constexpr int CW_F = 16384, FL_STRIDE = 64, NPROD = 2;
static_assert(RING % NPROD == 0 && NPROD + 1 <= 4 && CW_F + DEPTH * N_LAT * 4 * FL_STRIDE <= 32768, "flag block");
constexpr unsigned FL_SPIN_CAP = 1u << 18;
__device__ __forceinline__ unsigned fl_ld(unsigned* p) { return __hip_atomic_load(p, __ATOMIC_RELAXED, __HIP_MEMORY_SCOPE_AGENT); }
__device__ __forceinline__ unsigned fl_wait_ge(unsigned* p, unsigned want, unsigned* tmo) {
    unsigned sp = 0, v;
    while ((v = fl_ld(p)) < want) { __builtin_amdgcn_s_sleep(1); if ((++sp & 255u) == 0u) { if (fl_ld(tmo)) break; if (sp > FL_SPIN_CAP) { atomicAdd(tmo, 1u); break; } } }
    return v;
}
__device__ __forceinline__ void rwkv_prod(LAS unsigned char* lds, CParams& P, int l, int s, int head, int dir, int chain, int pp, unsigned* ctl) {
    const int tid = tid_opaque(), w = __builtin_amdgcn_readfirstlane(tid >> 6), lane = tid & 63, fr = lane & 15, fq = lane >> 4;
    const int rt = w & 3, half = w >> 2, hc = head * 64;
    const SeqInfo q = seqinfo(s); const int nchunk = q.T / 64;
    const bf16* RX = WSP(bf16, WS_RXC);
    const int pj = tid >> 3, psub = tid & 7;
    unsigned char* ring = P.ws + (chain < RING_A ? O_WIN1 + (size_t)chain * RING * PACK_BYTES : WS_END + (size_t)(chain - RING_A) * RING * PACK_BYTES);
    unsigned* f_base = ctl + CW_F + (size_t)((l * N_LAT + chain) * 4) * FL_STRIDE; unsigned* f_ready = f_base + pp * FL_STRIDE; unsigned* f_ack = f_base + NPROD * FL_STRIDE; unsigned* tmo = ctl + 4096 + 128;
    float rkk8[8];
#pragma unroll
    for (int e = 0; e < 8; ++e) rkk8[e] = P.in[R_KK][(size_t)l * RW + hc + 8 * psub + e];
    float c_w0[2], c_a0[2], c_kk[2], c_ka[2];
#pragma unroll
    for (int cc = 0; cc < 2; ++cc) { const int c = 16 * (2 * half + cc) + fr;
        c_w0[cc] = P.in[R_W0][((size_t)l * 2 + dir) * RW + hc + c]; c_a0[cc] = P.in[R_A0][((size_t)l * 2 + dir) * RW + hc + c];
        c_kk[cc] = P.in[R_KK][(size_t)l * RW + hc + c]; c_ka[cc] = P.in[R_KA][(size_t)l * RW + hc + c]; }
    const bf16* w2t = WSP(bf16, O_W2T) + ((size_t)dir * RW + hc) * 64; const bf16* a2t = WSP(bf16, O_A2T) + ((size_t)dir * RW + hc) * 64;
    u32x4 pf[5];
#define WY_TOK(c, j) ((size_t)(q.base + (dir ? q.T - 1 - ((c) * 64 + (j)) : ((c) * 64 + (j)))))
#define WY_PREFETCH(c) do { const bf16* rx = RX + WY_TOK(c, pj) * RIN + 8 * psub; \
        pf[0] = *(const u32x4*)(rx + RX_R + hc); pf[1] = *(const u32x4*)(rx + RX_K + hc); pf[2] = pf[0]; \
        pf[3] = *(const u32x4*)(rx + RX_WL + dir * 64); pf[4] = *(const u32x4*)(rx + RX_AL + dir * 64); } while (0)
    WY_PREFETCH(pp);
    asm volatile("" :: "v"(pf[0]), "v"(pf[1]), "v"(pf[2]), "v"(pf[3]), "v"(pf[4]) : "memory");
    unsigned acked = 0u;
    for (int c = pp; c < nchunk; c += NPROD) {
        { *(LAS u32x4*)(lds + L_RH + pj * PV + psub * 16) = pf[0]; *(LAS u32x4*)(lds + L_KH + pj * PV + psub * 16) = pf[1];
          const unsigned kw[4] = {pf[1].x, pf[1].y, pf[1].z, pf[1].w};
          float ss = 0.f;
#pragma unroll
          for (int e = 0; e < 8; ++e) { const float kf = __builtin_bit_cast(float, (e & 1) ? (kw[e >> 1] & 0xffff0000u) : (kw[e >> 1] << 16)) * rkk8[e]; ss += kf * kf; }
          ss += rw::dpp_xor1(ss); ss += rw::dpp_xor2(ss); ss += __shfl_xor(ss, 4);
          if (psub == 0) *(LAS float*)(lds + L_INV + pj * 4) = 1.0f / fmaxf(sqrtf(ss), 1e-12f);
          *(LAS u32x4*)(lds + L_TW + pj * PV + psub * 16) = pf[3]; *(LAS u32x4*)(lds + L_AL + pj * PV + psub * 16) = pf[4]; }
        LDS_BARRIER();
        if (c + NPROD < nchunk) WY_PREFETCH(c + NPROD);
#pragma unroll
        for (int cc = 0; cc < 2; ++cc) { const int ct = 2 * half + cc; const int cidx = 16 * ct + fr;
            f32x4 aw = (f32x4){0.f, 0.f, 0.f, 0.f}, aa = (f32x4){0.f, 0.f, 0.f, 0.f};
#pragma unroll
            for (int ks = 0; ks < 2; ++ks) { const size_t bo = (size_t)cidx * 64 + 32 * ks + 8 * fq;
                aw = ml::mma(ml::frag(lds, L_TW, PV, 16 * rt, 32 * ks, lane), *(const bf16x8*)(w2t + bo), aw); aa = ml::mma(ml::frag(lds, L_AL, PV, 16 * rt, 32 * ks, lane), *(const bf16x8*)(a2t + bo), aa); }
            float kr4[4], rr4[4], iv4[4];
#pragma unroll
            for (int r = 0; r < 4; ++r) { const int tok = 16 * rt + 4 * fq + r; kr4[r] = bf2f(*(const LAS bf16*)(lds + L_KH + tok * PV + cidx * 2)); rr4[r] = bf2f(*(const LAS bf16*)(lds + L_RH + tok * PV + cidx * 2));
                iv4[r] = *(const LAS float*)(lds + L_INV + tok * 4); }
            float lw[4], cum[4];
#pragma unroll
            for (int r = 0; r < 4; ++r) { lw[r] = -0.6065306597126334f * pg8::fsigmoid(c_w0[cc] + aw[r]); cum[r] = (r ? cum[r - 1] : 0.f) + lw[r]; }
            const float tot = cum[3]; const float p1 = __shfl_up(tot, 16), p2 = __shfl_up(tot, 32), p3 = __shfl_up(tot, 48);
            const float off = (fq >= 1 ? p1 : 0.f) + (fq >= 2 ? p2 : 0.f) + (fq >= 3 ? p3 : 0.f);
            float gprev = __expf(off);
#pragma unroll
            for (int r = 0; r < 4; ++r) { const int tok = 16 * rt + 4 * fq + r; const float lam = off + cum[r]; const float g = __expf(lam), gi = __builtin_amdgcn_rcpf(g);
                const float alpha = pg8::fsigmoid(c_a0[cc] + aa[r]);
                const float kraw = kr4[r], rraw = rr4[r];
                const float kkn = kraw * c_kk[cc] * iv4[r];
                const bf16 bh = f2bf(kkn * alpha * gi), kh = f2bf(kraw * (1.0f + (alpha - 1.0f) * c_ka[cc]) * gi);
                stb(lds, L_AH + tok * PV + cidx * 2, -kkn * gprev); stb(lds, L_RH + tok * PV + cidx * 2, rraw * g);
                *(LAS bf16*)(lds + L_BH + tok * PV + cidx * 2) = bh; *(LAS bf16*)(lds + L_KH + tok * PV + cidx * 2) = kh;
                *(LAS bf16*)(lds + L_BT + cidx * PV + tok * 2) = bh; *(LAS bf16*)(lds + L_KT + cidx * PV + tok * 2) = kh;
                if (fq == 3 && r == 3) *(LAS float*)(lds + L_GL + (rt * 64 + cidx) * 4) = g;
                gprev = g; } }
        asm volatile("s_waitcnt vmcnt(0)" ::: "memory");
        LDS_BARRIER();
        if (tid == 0 && c > pp) __hip_atomic_store(f_ready, (unsigned)((c - pp) / NPROD), __ATOMIC_RELAXED, __HIP_MEMORY_SCOPE_AGENT);
        { const int sc = w >> 1, side = w & 1; f32x4 gB = (f32x4){0.f, 0.f, 0.f, 0.f}, gK = (f32x4){0.f, 0.f, 0.f, 0.f};
#pragma unroll
          for (int ks = 0; ks < 2; ++ks) { const bf16x8 af = ml::frag(lds, side ? L_RH : L_AH, PV, 16 * sc, 32 * ks, lane);
              gB = ml::mma(af, ml::frag(lds, L_BH, PV, 16 * sc, 32 * ks, lane), gB); gK = ml::mma(af, ml::frag(lds, L_KH, PV, 16 * sc, 32 * ks, lane), gK); }
#pragma unroll
          for (int r = 0; r < 4; ++r) { const int t = 4 * fq + r; const bool keep = side ? (fr <= t) : (fr < t); const float vB = keep ? gB[r] : 0.f, vK = keep ? gK[r] : 0.f;
              if (side == 0) { *(LAS float*)(lds + L_NAB + ((sc * 16 + t) * 16 + fr) * 4) = vB; stb(lds, L_NAKT + (sc * 16 + t) * PS + fr * 2, vK); }
              else { stb(lds, L_NRBT + (sc * 16 + t) * PS + fr * 2, vB); stb(lds, L_NRKT + (sc * 16 + t) * PS + fr * 2, vK); } } }
        if ((w & 1) == 0 && lane < 16) { const int sc = w >> 1; float Tr[16];
            asm volatile("" ::: "memory");
#pragma unroll
            for (int ph = 0; ph < 4; ++ph) { f32x4 nv[4][4];
#pragma unroll
                for (int tq = 0; tq < 4; ++tq)
#pragma unroll
                    for (int u4 = 0; u4 <= ph; ++u4) nv[tq][u4] = *(const LAS f32x4*)(lds + L_NAB + ((sc * 16 + 4 * ph + tq) * 16 + 4 * u4) * 4);
#pragma unroll
                for (int tq = 0; tq < 4; ++tq) { const int t = 4 * ph + tq; float x0 = (lane == t) ? 1.f : 0.f, x1 = 0.f;
#pragma unroll
                    for (int u = 0; u < 16; ++u) if (u < t) { if (u & 1) x1 += Tr[u] * nv[tq][u >> 2][u & 3]; else x0 += Tr[u] * nv[tq][u >> 2][u & 3]; }
                    Tr[t] = x0 + x1; stb(lds, L_TT + (sc * 16 + t) * PS + lane * 2, Tr[t]); } } }
        if (tid == 0 && c >= RING && acked < (unsigned)(c - RING + 1)) acked = fl_wait_ge(f_ack, (unsigned)(c - RING + 1), tmo);
        LDS_BARRIER();
        asm volatile("" :: "v"(pf[0]), "v"(pf[1]), "v"(pf[2]), "v"(pf[3]), "v"(pf[4]) : "memory");
        { unsigned char* slot = ring + (size_t)(c % RING) * PACK_BYTES;
#pragma unroll
          for (int k = 0; k < 8; ++k) { const int u = tid + 512 * k;
              if (u < PACK_U) { const u32x4 v = *(const LAS u32x4*)(lds + 16 * u); const u32x4* gp = (const u32x4*)(slot + (size_t)16 * u);
                  asm volatile("global_store_dwordx4 %0, %1, off sc1" :: "v"(gp), "v"(v) : "memory"); } } }
        LDS_BARRIER();
    }
    asm volatile("s_waitcnt vmcnt(0)" ::: "memory");
    __syncthreads();
    if (tid == 0) __hip_atomic_store(f_ready, (unsigned)((nchunk - pp + NPROD - 1) / NPROD), __ATOMIC_RELAXED, __HIP_MEMORY_SCOPE_AGENT);
    LDS_BARRIER();
#undef WY_TOK
#undef WY_PREFETCH
}
__device__ __forceinline__ void rwkv_cons(LAS unsigned char* lds, CParams& P, int l, int s, int head, int dir, int chain, unsigned* ctl) {
    const int tid = tid_opaque(), w = __builtin_amdgcn_readfirstlane(tid >> 6), lane = tid & 63, fr = lane & 15, fq = lane >> 4;
    const int hc = head * 64;
    const SeqInfo q = seqinfo(s); const int nchunk = q.T / 64;
    bf16* U = WSP(bf16, WS_U1);
    const unsigned char* ring = P.ws + (chain < RING_A ? O_WIN1 + (size_t)chain * RING * PACK_BYTES : WS_END + (size_t)(chain - RING_A) * RING * PACK_BYTES);
    unsigned* f_base = ctl + CW_F + (size_t)((l * N_LAT + chain) * 4) * FL_STRIDE; unsigned* f_ack = f_base + NPROD * FL_STRIDE; unsigned* tmo = ctl + 4096 + 128;
    constexpr int C_IMG = PACK_BYTES + 64 * PV, C_YS = 2 * C_IMG;
    const bf16* RX = WSP(bf16, WS_RXC);
    static_assert(C_YS + 64 * PV <= 131072, "consumer LDS map");
    f32x4 sacc[4];
#pragma unroll
    for (int ct = 0; ct < 4; ++ct) sacc[ct] = (f32x4){0.f, 0.f, 0.f, 0.f};
    if (w < 4 && q.grid) { const size_t sb = (((size_t)q.b * DEPTH + l) * 2 + dir) * RH + head;
#pragma unroll
        for (int ct = 0; ct < 4; ++ct) sacc[ct] = *(const f32x4*)(P.in[ST_R] + (sb * 64 + 16 * w + fr) * 64 + 16 * ct + 4 * fq); }
#define WY_TOK(c, j) ((size_t)(q.base + (dir ? q.T - 1 - ((c) * 64 + (j)) : ((c) * 64 + (j)))))
    unsigned seen0 = 0u, seen1 = 0u;
#define CONS_FETCH(c, boff) do { const int p_ = (c) % NPROD; const unsigned need_ = (unsigned)((c) / NPROD + 1); \
        u32x4 vv_[2];   \
        _Pragma("unroll") for (int i_ = 0; i_ < 2; ++i_) vv_[i_] = *(const u32x4*)(RX + WY_TOK(c, lane) * RIN + RX_V + hc + 8 * (2 * (w - 4) + i_)); \
        if ((p_ ? seen1 : seen0) < need_) { unsigned v_ = 0u; if (lane == 0) v_ = fl_wait_ge(f_base + p_ * FL_STRIDE, need_, tmo); v_ = __builtin_amdgcn_readfirstlane(v_); \
            if (p_) seen1 = v_; else seen0 = v_; __builtin_amdgcn_fence(__ATOMIC_ACQUIRE, "agent"); } \
        _Pragma("unroll") for (int i_ = 0; i_ < 2; ++i_) { const unsigned wv_[4] = {vv_[i_].x, vv_[i_].y, vv_[i_].z, vv_[i_].w}; \
            _Pragma("unroll") for (int e_ = 0; e_ < 8; ++e_) *(LAS bf16*)(lds + (boff) + L_VS + (8 * (2 * (w - 4) + i_) + e_) * PVS + lane * 2) = (bf16)((wv_[e_ >> 1] >> ((e_ & 1) * 16)) & 0xffffu); } \
        const unsigned char* slot = ring + (size_t)((c) % RING) * PACK_BYTES; \
        for (int k = w - 4; k < PACK_BYTES / 1024; k += 4) \
            __builtin_amdgcn_global_load_lds((const unsigned*)(slot + (size_t)k * 1024 + lane * 16), (LAS unsigned*)(lds + (boff) + k * 1024), 16, 0, 0); \
        asm volatile("s_waitcnt vmcnt(0)" ::: "memory"); } while (0)
    if (w >= 4) CONS_FETCH(0, 0);
    LDS_BARRIER();
    if (tid == 256) __hip_atomic_store(f_ack, 1u, __ATOMIC_RELAXED, __HIP_MEMORY_SCOPE_AGENT);
    for (int c = 0; c < nchunk; ++c) {
        const int boff = (c & 1) * C_IMG;
        if (w >= 4) { if (c + 1 < nchunk) CONS_FETCH(c + 1, C_IMG - boff); }
        else {
            LAS unsigned char* pb = lds + boff;
#pragma unroll 1
            for (int sc = 0; sc < 4; ++sc) {
                const bf16x8 ah0 = ld_k32(pb, L_AH, PV, 16 * sc, 0, lane), ah1 = ld_k32(pb, L_AH, PV, 16 * sc, 32, lane), rh0 = ld_k32(pb, L_RH, PV, 16 * sc, 0, lane), rh1 = ld_k32(pb, L_RH, PV, 16 * sc, 32, lane);
                const bf16x8 nak = ld_k16(pb, L_NAKT, PS, 16 * sc, 0, lane), nrk = ld_k16(pb, L_NRKT, PS, 16 * sc, 0, lane), ttf = ld_k16(pb, L_TT, PS, 16 * sc, 0, lane), nrb = ld_k16(pb, L_NRBT, PS, 16 * sc, 0, lane);
                const bf16x8 vsf = ld_k16(pb, L_VS, PVS, 16 * w, 16 * sc, lane);
                bf16x8 btf[4], ktf[4]; f32x4 glv[4];
#pragma unroll
                for (int ct = 0; ct < 4; ++ct) { btf[ct] = ld_k16(pb, L_BT, PV, 16 * ct, 16 * sc, lane); ktf[ct] = ld_k16(pb, L_KT, PV, 16 * ct, 16 * sc, lane);
                    glv[ct] = *(const LAS f32x4*)(pb + L_GL + (sc * 64 + 16 * ct + 4 * fq) * 4); }
                const bf16x8 sb0 = pack_k32(sacc[0], sacc[1]), sb1 = pack_k32(sacc[2], sacc[3]);
                f32x4 XT = (f32x4){0.f, 0.f, 0.f, 0.f}, YT = (f32x4){0.f, 0.f, 0.f, 0.f};
                XT = ml::mma(ah0, sb0, XT); XT = ml::mma(ah1, sb1, XT); XT = ml::mma(nak, vsf, XT);
                YT = ml::mma(rh0, sb0, YT); YT = ml::mma(rh1, sb1, YT); YT = ml::mma(nrk, vsf, YT);
                f32x4 UT = (f32x4){0.f, 0.f, 0.f, 0.f};
                UT = ml::mma(ttf, pack_k16(XT), UT);
                const bf16x8 ub = pack_k16(UT);
                YT = ml::mma(nrb, ub, YT);
#pragma unroll
                for (int r = 0; r < 4; ++r) stb(lds, C_YS + (16 * sc + 4 * fq + r) * PV + (16 * w + fr) * 2, YT[r]);
#pragma unroll
                for (int ct = 0; ct < 4; ++ct) { sacc[ct] = ml::mma(btf[ct], ub, sacc[ct]); sacc[ct] = ml::mma(ktf[ct], vsf, sacc[ct]); sacc[ct] = sacc[ct] * glv[ct]; }
            }
            { const LAS unsigned char* yp = lds + C_YS + lane * PV + 32 * w; const u32x4 y0 = *(const LAS u32x4*)yp, y1 = *(const LAS u32x4*)(yp + 16);
              bf16* up = U + WY_TOK(c, lane) * PU + OFF_R + dir * RW + hc + 16 * w; *(u32x4*)up = y0; *(u32x4*)(up + 8) = y1; }
        }
        LDS_BARRIER();
        if (tid == 256 && c + 1 < nchunk) __hip_atomic_store(f_ack, (unsigned)(c + 2), __ATOMIC_RELAXED, __HIP_MEMORY_SCOPE_AGENT);
    }
    if (!q.grid && w < 4) { const size_t sb = (((size_t)q.b * DEPTH + l) * 2 + dir) * RH + head;
#pragma unroll
        for (int ct = 0; ct < 4; ++ct) *(f32x4*)(P.out + OUT_S + (sb * 64 + 16 * w + fr) * 64 + 16 * ct + 4 * fq) = sacc[ct]; }
    LDS_BARRIER();
#undef WY_TOK
#undef CONS_FETCH
}
constexpr int N_ITEMS = NSEQ * RH * 2;
__device__ __forceinline__ void decode_item(int it, int& s, int& head, int& dir) {
    dir = it & 1; int ch = it >> 1; head = ch % RH; const int sq = ch / RH;
    s = sq < LB ? CB + sq : sq - LB;
}
}

namespace ms {
using ml::PQ; using ml::PT; using ml::mma; using ml::frag; using wy::bf16x8; using wy::f32x4; using wy::u32x4;
constexpr int P_QS = 0, P_KT = P_QS + 64 * PQ, P_SB = P_KT + 128 * PT, P_SC = P_SB + 64 * PT, P_VT = P_SC + 4096, VT_BYTES = 21504, ML_PACK = P_VT + VT_BYTES, P_KS = ML_PACK, P_END = P_KS + 64 * PQ;
constexpr int ML_RING = 4, ML_PACK_U = ML_PACK / 16, N_MLAT = LB * MH * 2, CW_MF = 32768, MLPROD = 2;
static_assert(MLPROD == 2 && ML_RING % MLPROD == 0, "two producers per chain: even / odd chunks");
static_assert(ML_PACK % 1024 == 0 && ML_PACK_U <= 9 * 512 && 145 * PT <= VT_BYTES && P_END <= 131072 && 2 * ML_PACK <= 146432, "mLSTM pack layout");
static_assert(WS_END + (size_t)N_MLAT * ML_RING * ML_PACK <= ((size_t)256 << 20), "mLSTM ring fits behind the activations");
__device__ __forceinline__ void ml_prod(LAS unsigned char* lds, CParams& P, int l, int s, int head, int dir, int chain, int pp, unsigned* ctl) {
    const int tid = wy::tid_opaque(), w = __builtin_amdgcn_readfirstlane(tid >> 6), lane = tid & 63, fr = lane & 15, fq = lane >> 4;
    const int rt = w & 3, half = w >> 2;
    const SeqInfo q = seqinfo(s); const int nchunk = q.T / 64;
    const bf16* QK = WSP(bf16, WS_QKC); const bf16* U = WSP(bf16, WS_U1);
    LAS float* SC = (LAS float*)(lds + P_SC);
    unsigned char* ring = P.ws + WS_END + (size_t)chain * ML_RING * ML_PACK;
    unsigned* f_base = ctl + CW_MF + (size_t)((l * N_MLAT + chain) * 4) * wy::FL_STRIDE; unsigned* f_ready = f_base + pp * wy::FL_STRIDE; unsigned* f_ack = f_base + MLPROD * wy::FL_STRIDE; unsigned* tmo = ctl + 4096 + 128;
    float m_prev = 0.f;
    if (q.grid) m_prev = P.in[ST_M][(((size_t)q.b * DEPTH + l) * 2 + dir) * MH + head];
    const float bi = P.in[M_GATE_B][(size_t)l * 4 * MH + (2 * dir) * MH + head], bfg = P.in[M_GATE_B][(size_t)l * 4 * MH + (2 * dir + 1) * MH + head];
    for (int i = tid; i < (VT_BYTES - 128 * PT) / 2; i += 512) *(LAS bf16*)(lds + P_VT + 128 * PT + i * 2) = (i < 64) ? (bf16)0x3f80 : (bf16)0;
    u32x4 pqk[4]; u32x4 pv[2]; bf16 pgi = 0, pgf = 0, sgi = 0, sgf = 0;
#define ML_TOK(c, j) ((size_t)(q.base + (dir ? q.T - 1 - ((c) * 64 + (j)) : ((c) * 64 + (j)))))
#define ML_PREFETCH(c) do { _Pragma("unroll") for (int i = 0; i < 4; ++i) { const int id = tid + 512 * i, j = id >> 5, pc = id & 31; \
            pqk[i] = *(const u32x4*)(QK + ML_TOK(c, j) * (2 * MW) + (pc < 16 ? head * 128 + 8 * pc : MW + head * 128 + 8 * (pc - 16))); } \
        _Pragma("unroll") for (int i = 0; i < 2; ++i) { const int id = tid + 512 * i, j = id >> 4, pc = id & 15; pv[i] = *(const u32x4*)(U + ML_TOK(c, j) * PU + OFF_V + head * 128 + 8 * pc); } \
        if (w == 0) { const bf16* g = U + ML_TOK(c, lane) * PU + OFF_G; pgi = g[(2 * dir) * MH + head]; pgf = g[(2 * dir + 1) * MH + head]; \
            if ((c) >= 1) { const bf16* g2 = U + ML_TOK((c) - 1, lane) * PU + OFF_G; sgi = g2[(2 * dir) * MH + head]; sgf = g2[(2 * dir + 1) * MH + head]; } } } while (0)
#define ML_TOUCH() asm volatile("" :: "v"(pqk[0]), "v"(pqk[1]), "v"(pqk[2]), "v"(pqk[3]), "v"(pv[0]), "v"(pv[1]), "v"((unsigned)pgi), "v"((unsigned)pgf), "v"((unsigned)sgi), "v"((unsigned)sgf) : "memory")
#define ML_SCAN(gi_, gf_) \
            const float gi = bf2f(gi_) + bi, gf = bf2f(gf_) + bfg; \
            const float lf = fminf(gf, 0.f) - log1pf(__expf(-fabsf(gf))); \
            float b = lf; \
            _Pragma("unroll") for (int o = 1; o < 64; o <<= 1) { const float t = __shfl_up(b, o); if (lane >= o) b += t; } \
            const float a = gi - b; float pm = a; \
            _Pragma("unroll") for (int o = 1; o < 64; o <<= 1) { const float t = __shfl_up(pm, o); if (lane >= o) pm = fmaxf(pm, t); } \
            pm = fmaxf(pm, m_prev); \
            const float pm63 = __shfl(pm, 63), b63 = __shfl(b, 63);
    ML_PREFETCH(pp);
    ML_TOUCH();
    unsigned acked = 0u;
    for (int c = pp; c < nchunk; c += MLPROD) {
        if (w == 0 && c >= 1) { ML_SCAN(sgi, sgf) m_prev = b63 + pm63; }
#pragma unroll
        for (int i = 0; i < 4; ++i) { const int id = tid + 512 * i, j = id >> 5, pc = id & 31;
            *(LAS u32x4*)(lds + (pc < 16 ? P_QS : P_KS) + j * PQ + (pc & 15) * 16) = pqk[i]; }
#pragma unroll
        for (int i = 0; i < 2; ++i) { const int id = tid + 512 * i, j = id >> 4, pc = id & 15; const unsigned wv[4] = {pv[i].x, pv[i].y, pv[i].z, pv[i].w};
#pragma unroll
            for (int e = 0; e < 8; ++e) *(LAS bf16*)(lds + P_VT + (8 * pc + e) * PT + j * 2) = (bf16)((wv[e >> 1] >> ((e & 1) * 16)) & 0xffffu); }
        if (w == 0) {
            ML_SCAN(pgi, pgf)
            SC[ml::SC_A + lane] = a; SC[ml::SC_PM + lane] = pm; SC[ml::SC_WI + lane] = __expf(m_prev - pm); SC[ml::SC_EMT + lane] = __expf(-(b + pm)); SC[ml::SC_WE + lane] = __expf(a - pm63);
            if (lane == 0) { SC[ml::SC_MISC] = __expf(m_prev - pm63); SC[ml::SC_MISC + 1] = b63 + pm63; }
            m_prev = b63 + pm63;
        }
        LDS_BARRIER();
        if (c + MLPROD < nchunk) ML_PREFETCH(c + MLPROD);
#pragma unroll
        for (int i = 0; i < 2; ++i) { const int id = tid + 512 * i, j = id & 63, pc = id >> 6; const float we = SC[ml::SC_WE + j];
            const u32x4 kv = *(const LAS u32x4*)(lds + P_KS + j * PQ + pc * 16); const unsigned wv[4] = {kv.x, kv.y, kv.z, kv.w};
#pragma unroll
            for (int e = 0; e < 8; ++e) { const float kf = __builtin_bit_cast(float, (e & 1) ? (wv[e >> 1] & 0xffff0000u) : (wv[e >> 1] << 16));
                *(LAS bf16*)(lds + P_KT + (8 * pc + e) * PT + j * 2) = f2bf(kf * we); } }
#pragma unroll
        for (int cc = 0; cc < 2; ++cc) { const int ct = 2 * half + cc;
            f32x4 acc = (f32x4){0.f, 0.f, 0.f, 0.f};
            if (ct <= rt) {
#pragma unroll
                for (int k = 0; k < 4; ++k) acc = mma(frag(lds, P_QS, PQ, 16 * rt, 32 * k, lane), frag(lds, P_KS, PQ, 16 * ct, 32 * k, lane), acc);
            }
            const int sp = 16 * ct + fr; const float as = SC[ml::SC_A + sp];
#pragma unroll
            for (int r = 0; r < 4; ++r) { const int t = 16 * rt + 4 * fq + r; const float v = (sp <= t) ? acc[r] * __expf(as - SC[ml::SC_PM + t]) : 0.f;
                *(LAS bf16*)(lds + P_SB + t * PT + sp * 2) = f2bf(v); } }
        asm volatile("s_waitcnt vmcnt(0)" ::: "memory");
        if (tid == 0 && c >= ML_RING && acked < (unsigned)(c - ML_RING + 1)) acked = wy::fl_wait_ge(f_ack, (unsigned)(c - ML_RING + 1), tmo);
        LDS_BARRIER();
        if (tid == 0 && c > pp) __hip_atomic_store(f_ready, (unsigned)((c - pp) / MLPROD), __ATOMIC_RELAXED, __HIP_MEMORY_SCOPE_AGENT);
        ML_TOUCH();
        { unsigned char* slot = ring + (size_t)(c % ML_RING) * ML_PACK;
#pragma unroll
          for (int k = 0; k < 9; ++k) { const int u = tid + 512 * k;
              if (u < ML_PACK_U) { const u32x4 v = *(const LAS u32x4*)(lds + 16 * u); const u32x4* gp = (const u32x4*)(slot + (size_t)16 * u);
                  asm volatile("global_store_dwordx4 %0, %1, off sc1" :: "v"(gp), "v"(v) : "memory"); } } }
        LDS_BARRIER();
    }
    asm volatile("s_waitcnt vmcnt(0)" ::: "memory");
    __syncthreads();
    if (tid == 0) __hip_atomic_store(f_ready, (unsigned)((nchunk - pp + MLPROD - 1) / MLPROD), __ATOMIC_RELAXED, __HIP_MEMORY_SCOPE_AGENT);
    LDS_BARRIER();
#undef ML_TOK
#undef ML_PREFETCH
#undef ML_TOUCH
#undef ML_SCAN
}
__device__ __forceinline__ void ml_cons(LAS unsigned char* lds, CParams& P, int l, int s, int head, int dir, int chain, unsigned* ctl) {
    const int tid = wy::tid_opaque(), w = __builtin_amdgcn_readfirstlane(tid >> 6), lane = tid & 63, fr = lane & 15, fq = lane >> 4;
    const SeqInfo q = seqinfo(s); const int nchunk = q.T / 64;
    bf16* U = WSP(bf16, WS_U1);
    const unsigned char* ring = P.ws + WS_END + (size_t)chain * ML_RING * ML_PACK;
    unsigned* f_base = ctl + CW_MF + (size_t)((l * N_MLAT + chain) * 4) * wy::FL_STRIDE; unsigned* f_ack = f_base + MLPROD * wy::FL_STRIDE; unsigned* tmo = ctl + 4096 + 128;
    f32x4 cst[8][3];
#pragma unroll
    for (int kt = 0; kt < 8; ++kt)
#pragma unroll
        for (int j = 0; j < 3; ++j) cst[kt][j] = (f32x4){0.f, 0.f, 0.f, 0.f};
    if (w < 4 && q.grid) { const size_t sb = (((size_t)q.b * DEPTH + l) * 2 + dir) * MH + head;
#pragma unroll
        for (int kt = 0; kt < 8; ++kt)
#pragma unroll
            for (int r = 0; r < 4; ++r) { const int d = 16 * kt + 4 * fq + r;
                cst[kt][0][r] = P.in[ST_C][(sb * 128 + d) * 128 + 32 * w + fr]; cst[kt][1][r] = P.in[ST_C][(sb * 128 + d) * 128 + 32 * w + 16 + fr];
                cst[kt][2][r] = (fr == 0) ? P.in[ST_N][sb * 128 + d] : 0.f; } }
#define ML_TOK(c, j) ((size_t)(q.base + (dir ? q.T - 1 - ((c) * 64 + (j)) : ((c) * 64 + (j)))))
    unsigned seen0 = 0u, seen1 = 0u;
#define MLC_FETCH(c, boff) do { const int p_ = (c) % MLPROD; const unsigned need_ = (unsigned)((c) / MLPROD + 1); \
        if ((p_ ? seen1 : seen0) < need_) { unsigned v_ = 0u; if (lane == 0) v_ = wy::fl_wait_ge(f_base + p_ * wy::FL_STRIDE, need_, tmo); v_ = __builtin_amdgcn_readfirstlane(v_); \
            if (p_) seen1 = v_; else seen0 = v_; __builtin_amdgcn_fence(__ATOMIC_ACQUIRE, "agent"); } \
        const unsigned char* slot = ring + (size_t)((c) % ML_RING) * ML_PACK; \
        for (int k = w - 4; k < ML_PACK / 1024; k += 4) \
            __builtin_amdgcn_global_load_lds((const unsigned*)(slot + (size_t)k * 1024 + lane * 16), (LAS unsigned*)(lds + (boff) + k * 1024), 16, 0, 0); \
        asm volatile("s_waitcnt vmcnt(0)" ::: "memory"); } while (0)
    if (w >= 4) MLC_FETCH(0, 0);
    LDS_BARRIER();
    if (tid == 256) __hip_atomic_store(f_ack, 1u, __ATOMIC_RELAXED, __HIP_MEMORY_SCOPE_AGENT);
    for (int c = 0; c < nchunk; ++c) {
        const int boff = (c & 1) * ML_PACK;
        if (w >= 4) { if (c + 1 < nchunk) MLC_FETCH(c + 1, ML_PACK - boff); }
        else {
            LAS unsigned char* pb = lds + boff; const LAS float* SC = (const LAS float*)(pb + P_SC);
            const float wie = SC[ml::SC_MISC];
            bf16x8 vf[3][2];
#pragma unroll
            for (int j = 0; j < 3; ++j)
#pragma unroll
                for (int k = 0; k < 2; ++k) vf[j][k] = frag(pb, P_VT, PT, j < 2 ? 32 * w + 16 * j : 128, 32 * k, lane);
            asm volatile("s_waitcnt lgkmcnt(0)" ::: "memory");
            LAS unsigned char* hp = pb + P_VT + 32 * w * PT;
#pragma unroll
            for (int rt = 0; rt < 4; ++rt) {
                f32x4 num[3];
#pragma unroll
                for (int j = 0; j < 3; ++j) { f32x4 a1 = (f32x4){0.f, 0.f, 0.f, 0.f}, a2 = (f32x4){0.f, 0.f, 0.f, 0.f};
#pragma unroll
                    for (int k = 0; k < 2; ++k) a1 = mma(frag(pb, P_SB, PT, 16 * rt, 32 * k, lane), vf[j][k], a1);
#pragma unroll
                    for (int kb = 0; kb < 4; ++kb) a2 = mma(wy::ld_k32(pb, P_QS, PQ, 16 * rt, 32 * kb, lane), wy::pack_k32(cst[2 * kb][j], cst[2 * kb + 1][j]), a2);
#pragma unroll
                    for (int r = 0; r < 4; ++r) a1[r] += SC[ml::SC_WI + 16 * rt + 4 * fq + r] * a2[r];
                    num[j] = a1; }
#pragma unroll
                for (int r = 0; r < 4; ++r) { const int t = 16 * rt + 4 * fq + r; const float dn = __shfl(num[2][r], lane & 48);
                    const float rden = __builtin_amdgcn_rcpf(fmaxf(fabsf(dn), SC[ml::SC_EMT + t]));
                    *(LAS bf16*)(hp + t * 64 + fr * 2) = f2bf(num[0][r] * rden); *(LAS bf16*)(hp + t * 64 + (16 + fr) * 2) = f2bf(num[1][r] * rden); }
            }
#pragma unroll
            for (int kt = 0; kt < 8; ++kt) { const bf16x8 k0 = frag(pb, P_KT, PT, 16 * kt, 0, lane), k1 = frag(pb, P_KT, PT, 16 * kt, 32, lane);
#pragma unroll
                for (int j = 0; j < 3; ++j) { cst[kt][j] = cst[kt][j] * wie; cst[kt][j] = mma(k0, vf[j][0], cst[kt][j]); cst[kt][j] = mma(k1, vf[j][1], cst[kt][j]); } }
            { const LAS unsigned char* yp = hp + lane * 64; bf16* up = U + ML_TOK(c, lane) * PU + dir * MW + head * 128 + 32 * w;
#pragma unroll
              for (int i = 0; i < 4; ++i) *(u32x4*)(up + 8 * i) = *(const LAS u32x4*)(yp + 16 * i); }
        }
        LDS_BARRIER();
        if (tid == 256 && c + 1 < nchunk) __hip_atomic_store(f_ack, (unsigned)(c + 2), __ATOMIC_RELAXED, __HIP_MEMORY_SCOPE_AGENT);
    }
    LDS_BARRIER();
#undef ML_TOK
#undef MLC_FETCH
}
}

namespace el {
typedef float f32x4 __attribute__((ext_vector_type(4)));
typedef unsigned u32x4 __attribute__((ext_vector_type(4)));
typedef unsigned u32x2 __attribute__((ext_vector_type(2)));
typedef short bf16x8 __attribute__((ext_vector_type(8)));
__device__ __forceinline__ float wave_sum(float v) {
#pragma unroll
    for (int o = 1; o < 64; o <<= 1) v += __shfl_xor(v, o);
    return v;
}
__device__ __forceinline__ void unpack8(const u32x4 p, float (&f)[8]) {
    f[0] = pg8::bflo(p.x); f[1] = pg8::bfhi(p.x); f[2] = pg8::bflo(p.y); f[3] = pg8::bfhi(p.y); f[4] = pg8::bflo(p.z); f[5] = pg8::bfhi(p.z); f[6] = pg8::bflo(p.w); f[7] = pg8::bfhi(p.w);
}
__device__ __forceinline__ u32x4 pack8(const float (&f)[8]) {
    u32x4 o; o.x = pg8::cvt_pk_bf16(f[0], f[1]); o.y = pg8::cvt_pk_bf16(f[2], f[3]); o.z = pg8::cvt_pk_bf16(f[4], f[5]); o.w = pg8::cvt_pk_bf16(f[6], f[7]); return o;
}
__device__ __forceinline__ void init_phase(LAS unsigned char* lds, CParams& P, int vb, int G) {
    const int tid = threadIdx.x, w = tid >> 6, lane = tid & 63;
    LAS float* red = (LAS float*)lds;
    constexpr int KW = D / 8;
    for (int it = vb; it < DEPTH * (6 * D / 64); it += G) {
        const int l = it / (6 * D / 64), j = (it % (6 * D / 64)) * 64 + lane;
        const float* wp = P.in[ADA_W] + ((size_t)l * D + w * KW) * 6 * D + j;
        float acc[NCOND];
#pragma unroll
        for (int ci = 0; ci < NCOND; ++ci) acc[ci] = 0.f;
        for (int k = 0; k < KW; ++k) { const float wv = wp[(size_t)k * 6 * D];
#pragma unroll
            for (int ci = 0; ci < NCOND; ++ci) { const float cv = ci == 0 ? P.in[C_CTX][w * KW + k] : P.in[C_LAT][(size_t)(ci - 1) * D + w * KW + k]; acc[ci] += cv * pg8::fsigmoid(cv) * wv; } }
#pragma unroll
        for (int ci = 0; ci < NCOND; ++ci) red[(w * NCOND + ci) * 64 + lane] = acc[ci];
        __syncthreads();
        if (w < NCOND) { float sum = P.in[ADA_B][(size_t)l * 6 * D + j];
#pragma unroll
            for (int ww = 0; ww < 8; ++ww) sum += red[(ww * NCOND + w) * 64 + lane];
            WSP(float, WS_MOD)[((size_t)l * NCOND + w) * 6 * D + j] = sum; }
        __syncthreads();
    }
}
__device__ __forceinline__ int perm5(int n) { return (((n >> 2) & 1) << 4) | (((n >> 3) & 3) << 2) | (n & 3); }
__device__ __forceinline__ void transpose_item(const float* W, int ldw, int nvalid, bf16* dst, int K, int k0, int drow0, bool perm, LAS float* scr, int lane) {
#pragma unroll 8
    for (int i = 0; i < 32; ++i) { const int kk = 2 * i + (lane >> 5), n = lane & 31; scr[kk * 33 + n] = n < nvalid ? W[(size_t)kk * ldw + n] : 0.f; }
    asm volatile("s_waitcnt lgkmcnt(0)" ::: "memory");
    const int c = lane & 7;
#pragma unroll
    for (int j = 0; j < 4; ++j) { const int n = (lane >> 3) + 8 * j; const LAS float* sp = scr + (8 * c) * 33 + n;
        u32x4 o; o.x = pg8::cvt_pk_bf16(sp[0 * 33], sp[1 * 33]); o.y = pg8::cvt_pk_bf16(sp[2 * 33], sp[3 * 33]); o.z = pg8::cvt_pk_bf16(sp[4 * 33], sp[5 * 33]); o.w = pg8::cvt_pk_bf16(sp[6 * 33], sp[7 * 33]);
        *(u32x4*)(dst + (size_t)(drow0 + (perm ? perm5(n) : n)) * K + k0 + 8 * c) = o; }
    asm volatile("s_waitcnt lgkmcnt(0)" ::: "memory");
}
constexpr int WI_0 = (N1P / 32) * (D / 64), WI_1 = WI_0 + (2 * D / 32) * (D / 64), WI_2 = WI_1 + (D / 32) * (MW / 64), WI_3 = WI_2 + (D / 32) * (RW / 64),
              WI_4 = WI_3 + (D / 32) * (D / 64), WI_5 = WI_4 + 2 * (FF / 32) * (D / 64), WI_6 = WI_5 + (D / 32) * (FF / 64), WI_7 = WI_6 + (RW / 32) * (128 / 64), WI_8 = WI_7 + 4 * (RW / 32);
__device__ __forceinline__ void wconv_phase(LAS unsigned char* lds, CParams& P, int l, int vb, int G) {
    const int tid = threadIdx.x, w = tid >> 6, lane = tid & 63;
    LAS float* scr = (LAS float*)(lds + w * 8704);
    for (int it = vb * 8 + w; it < WI_8; it += G * 8) {
        if (it < WI_0) { const int nb = it / (D / 64), kb = it % (D / 64); const int n0 = nb * 32; const int nv = n0 >= N1 ? 0 : (N1 - n0 < 32 ? N1 - n0 : 32);
            transpose_item(P.in[W_IN] + ((size_t)l * D + kb * 64) * PIN + n0, PIN, nv, WSP(bf16, O_WIN1), D, kb * 64, n0, true, scr, lane); }
        else if (it < WI_1) { const int r = it - WI_0, nb = r / (D / 64), kb = r % (D / 64);
            transpose_item(P.in[W_IN] + ((size_t)l * D + kb * 64) * PIN + N1 + nb * 32, PIN, 32, WSP(bf16, O_WIN2), D, kb * 64, nb * 32, true, scr, lane); }
        else if (it < WI_2) { const int r = it - WI_1, nb = r / (MW / 64), kb = r % (MW / 64);
            transpose_item(P.in[PROJ_M] + ((size_t)l * MW + kb * 64) * D + nb * 32, D, 32, WSP(bf16, O_PM), MW, kb * 64, nb * 32, true, scr, lane); }
        else if (it < WI_3) { const int r = it - WI_2, nb = r / (RW / 64), kb = r % (RW / 64);
            transpose_item(P.in[PROJ_R] + ((size_t)l * RW + kb * 64) * D + nb * 32, D, 32, WSP(bf16, O_PR), RW, kb * 64, nb * 32, true, scr, lane); }
        else if (it < WI_4) { const int r = it - WI_3, nb = r / (D / 64), kb = r % (D / 64);
            transpose_item(P.in[W_OUT] + ((size_t)l * D + kb * 64) * D + nb * 32, D, 32, WSP(bf16, O_WO), D, kb * 64, nb * 32, false, scr, lane); }
        else if (it < WI_5) { const int r = it - WI_4, which = r / ((FF / 32) * (D / 64)), r2 = r % ((FF / 32) * (D / 64)), nb = r2 / (D / 64), kb = r2 % (D / 64);
            const int j0 = nb * 32, pn = j0 >> 7, drow0 = pn * 256 + which * 128 + (j0 & 127);
            transpose_item((which ? P.in[FFN_W3] : P.in[FFN_W1]) + ((size_t)l * D + kb * 64) * FF + j0, FF, 32, WSP(bf16, O_W13), D, kb * 64, drow0, true, scr, lane); }
        else if (it < WI_6) { const int r = it - WI_5, nb = r / (FF / 64), kb = r % (FF / 64);
            transpose_item(P.in[FFN_W2] + ((size_t)l * FF + kb * 64) * D + nb * 32, D, 32, WSP(bf16, O_W2), FF, kb * 64, nb * 32, false, scr, lane); }
        else if (it < WI_7) { const int r = it - WI_6, nb = r / 2, kb = r % 2;
            transpose_item(P.in[R_G2] + ((size_t)l * 128 + kb * 64) * RW + nb * 32, RW, 32, WSP(bf16, O_G2T), 128, kb * 64, nb * 32, false, scr, lane); }
        else { const int r = it - WI_7, which = r / (2 * (RW / 32)), d = (r / (RW / 32)) & 1, nb = r % (RW / 32);
            transpose_item((which ? P.in[R_A2] : P.in[R_W2]) + ((size_t)l * 2 + d) * 64 * RW + nb * 32, RW, 32, WSP(bf16, which ? O_A2T : O_W2T) + (size_t)d * RW * 64, 64, 0, nb * 32, false, scr, lane); }
    }
}
__device__ __forceinline__ void norm_phase(CParams& P, int l, int mode, int vb, int G) {
    const int tid = threadIdx.x, w = tid >> 6, lane = tid & 63;
    for (int m = vb * 8 + w; m < NT; m += G * 8) {
        float* xr = P.out + (size_t)m * D;
        const float* xs = (l == 0 && mode < 2) ? (m < NC ? P.in[X_PROMPT] + (size_t)m * D : P.in[X_SAMPLE] + (size_t)(m - NC) * D) : xr;
        f32x4 v[D / 256]; float ss = 0.f;
#pragma unroll
        for (int j = 0; j < D / 256; ++j) { v[j] = *(const f32x4*)(xs + 256 * j + 4 * lane); ss += (v[j][0] * v[j][0] + v[j][1] * v[j][1]) + (v[j][2] * v[j][2] + v[j][3] * v[j][3]); }
        const float rs = 1.0f / sqrtf(wave_sum(ss) * (1.0f / D) + RMS_EPS);
        if (mode == 3) {
#pragma unroll
            for (int j = 0; j < D / 256; ++j) { const f32x4 g = *(const f32x4*)(P.in[FINAL_G] + 256 * j + 4 * lane); *(f32x4*)(xr + 256 * j + 4 * lane) = v[j] * rs * g; }
        } else {
            const int second = (mode == 2); const int cond = seqinfo(seq_of_token(m)).cond;
            const float* gp = P.in[second ? NORM2 : NORM1] + (size_t)l * D; const float* mod = WSP(float, WS_MOD) + ((size_t)l * NCOND + cond) * 6 * D + (second ? 3 * D : 0);
            bf16* o = WSP(bf16, mode == 1 ? WS_RXC : WS_QKC) + (size_t)m * D;
#pragma unroll
            for (int j = 0; j < D / 256; ++j) { const int c = 256 * j + 4 * lane; const f32x4 g = *(const f32x4*)(gp + c), sh = *(const f32x4*)(mod + c), sc = *(const f32x4*)(mod + D + c);
                const f32x4 y = v[j] * rs * g * (sc + 1.0f) + sh; u32x2 pk; pk.x = pg8::cvt_pk_bf16(y[0], y[1]); pk.y = pg8::cvt_pk_bf16(y[2], y[3]); *(u32x2*)(o + c) = pk; }
        }
    }
}
constexpr int CV_NCH = 2 * MW + RIN, CV_NG = CV_NCH / 4, CV_NCHUNK = (CV_NG + 63) / 64, CV_SEG = 16, CV_PAIRS = NC / (2 * CV_SEG);
static_assert(CV_NCHUNK == 12 && NC == NT - NC && GW % CV_SEG == 0 && CT % CV_SEG == 0 && 2 * MW == 1024 && RX_WL == 1536, "conv item layout");
typedef float f32x2 __attribute__((ext_vector_type(2)));
struct CvAct { float alpha, cA, cB, cC, cD; bool any; };
template <int NR> struct CvState { f32x2 wt[NR * 3][2]; f32x2 fw[NR][3][2]; u32x2 p[3][NR]; };
__device__ __forceinline__ void cv_unpk(const u32x2 p, f32x2 (&f)[2]) { f[0].x = pg8::bflo(p.x); f[0].y = pg8::bfhi(p.x); f[1].x = pg8::bflo(p.y); f[1].y = pg8::bfhi(p.y); }
template <int NR> __device__ __forceinline__ u32x2 cv_ld(const bf16* const (&rowp)[NR], const bool (&rok)[NR], int a, int col, int W) {
    const u32x2 zero2 = {0u, 0u};
    return (rok[a] && col >= 0 && col < W) ? *(const u32x2*)(rowp[a] + (size_t)col * PU) : zero2;
}
template <int NR, int S> __device__ __forceinline__ void cv_col(CvState<NR>& st, const bf16* const (&rowp)[NR], const bool (&rok)[NR], int cs, int W, int o, const CvAct& act, bf16* dst) {
#pragma unroll
    for (int a = 0; a < NR; ++a) { cv_unpk(st.p[S][a], st.fw[a][(S + 2) % 3]); const u32x2 zero2 = {0u, 0u}; st.p[S][a] = (o + 4 <= CV_SEG) ? cv_ld<NR>(rowp, rok, a, cs + o + 4, W) : zero2; }
    f32x2 acc[2];
#pragma unroll
    for (int e = 0; e < 2; ++e) acc[e] = st.wt[0][e] * st.fw[0][S][e];
#pragma unroll
    for (int a = 0; a < NR; ++a)
#pragma unroll
        for (int b = 0; b < 3; ++b) if (a + b > 0) {
#pragma unroll
            for (int e = 0; e < 2; ++e) acc[e] = __builtin_elementwise_fma(st.wt[a * 3 + b][e], st.fw[a][(S + b) % 3][e], acc[e]); }
    float v[4] = {acc[0].x, acc[0].y, acc[1].x, acc[1].y};
    if (act.any) {
#pragma unroll
        for (int e = 0; e < 4; ++e) { const float t = __builtin_amdgcn_rcpf(__builtin_amdgcn_exp2f(act.alpha * v[e]) + 1.0f); v[e] = (act.cA * v[e] + act.cB) * t + (act.cC * v[e] + act.cD); }
    }
    u32x2 pk; pk.x = pg8::cvt_pk_bf16(v[0], v[1]); pk.y = pg8::cvt_pk_bf16(v[2], v[3]);
    *(u32x2*)dst = pk;
}
template <int NR> __device__ __forceinline__ void conv_item(const bf16* const (&rowp)[NR], const bool (&rok)[NR], int cs, int W, const float* wsrc, int CH, const CvAct& act, bf16* dst, int dpitch) {
    CvState<NR> st;
#pragma unroll
    for (int a = 0; a < NR * 3; ++a) { const int tap = NR == 3 ? a : 3 + a; const f32x4 w0 = *(const f32x4*)(wsrc + (size_t)tap * CH);
        st.wt[a][0].x = w0[0]; st.wt[a][0].y = w0[1]; st.wt[a][1].x = w0[2]; st.wt[a][1].y = w0[3]; }
#pragma unroll
    for (int a = 0; a < NR; ++a) { cv_unpk(cv_ld<NR>(rowp, rok, a, cs - 1, W), st.fw[a][0]); cv_unpk(cv_ld<NR>(rowp, rok, a, cs, W), st.fw[a][1]); }
#pragma unroll
    for (int s3 = 0; s3 < 3; ++s3)
#pragma unroll
        for (int a = 0; a < NR; ++a) st.p[s3][a] = cv_ld<NR>(rowp, rok, a, cs + 1 + s3, W);
#pragma unroll 1
    for (int o = 0; o < CV_SEG - 1; o += 3) {
        cv_col<NR, 0>(st, rowp, rok, cs, W, o, act, dst + (size_t)o * dpitch);
        cv_col<NR, 1>(st, rowp, rok, cs, W, o + 1, act, dst + (size_t)(o + 1) * dpitch);
        cv_col<NR, 2>(st, rowp, rok, cs, W, o + 2, act, dst + (size_t)(o + 2) * dpitch);
    }
    cv_col<NR, 0>(st, rowp, rok, cs, W, CV_SEG - 1, act, dst + (size_t)(CV_SEG - 1) * dpitch);
}
__device__ __forceinline__ void conv_phase(LAS unsigned char* lds, CParams& P, int l, int vb, int G) {
    const int tid = threadIdx.x, lane = tid & 63;
    const bf16* U = WSP(bf16, WS_U1);
    LAS unsigned* cnt = (LAS unsigned*)lds;
    for (int sp = vb; sp < CV_PAIRS; sp += G) {
        __syncthreads();
        if (tid == 0) *cnt = 0u;
        __syncthreads();
        for (;;) {
            unsigned j = 0; if (lane == 0) j = __hip_atomic_fetch_add(cnt, 1u, __ATOMIC_RELAXED, __HIP_MEMORY_SCOPE_WORKGROUP);
            j = __builtin_amdgcn_readfirstlane(j);
            if (j >= 48u) break;
            const int cls = j / 12, jj = j % 12, lat = (cls & 1) == 0, heavy = cls < 2, ci = jj >> 1, chunk = heavy ? (ci >= 4 ? 6 + ci : ci) : 4 + ci;
            const int seg = (lat ? NC / CV_SEG : 0) + 2 * sp + (jj & 1), g = chunk * 64 + lane;
            if (g >= CV_NG) continue;
            const int ch = 4 * g; const bool isqk = ch < 2 * MW; const int c = isqk ? ch : ch - 2 * MW;
            const int ucol = isqk ? OFF_QK + c : OFF_R + c, CH = isqk ? 2 * MW : RIN;
            const float* wsrc = (isqk ? P.in[M_CONV] : P.in[R_CONV]) + (size_t)l * 9 * CH + c;
            const int kind = isqk ? (c < MW ? 0 : 1) : (c >= RX_GL ? 4 : (c >= RX_AL ? 2 : (c >= RX_WL ? 3 : 2)));
            CvAct act; act.alpha = kind == 3 ? 2.8853900817779268f : -1.4426950408889634f;
            act.cA = kind == 0 ? 0.08838834764831845f : (kind == 1 ? 1.0f : 0.0f); act.cB = kind == 3 ? -2.0f : (kind == 4 ? 1.0f : 0.0f); act.cC = kind == 2 ? 1.0f : 0.0f; act.cD = kind == 3 ? 1.0f : 0.0f;
            act.any = heavy;
            const int m0 = seg * CV_SEG; const SeqInfo q = seqinfo(seq_of_token(m0)); const int t0 = m0 - q.base;
            bf16* dst = isqk ? WSP(bf16, WS_QKC) + (size_t)m0 * (2 * MW) + c : WSP(bf16, WS_RXC) + (size_t)m0 * RIN + c; const int dpitch = isqk ? 2 * MW : RIN;
            if (q.grid) {
                const int r = t0 / GW, cs = t0 % GW, rows = q.T / GW;
                const bf16* rowp[3]; bool rok[3];
#pragma unroll
                for (int a = 0; a < 3; ++a) { const int rr = r + a - 1; rok[a] = rr >= 0 && rr < rows; rowp[a] = U + (size_t)(q.base + (rok[a] ? rr : r) * GW) * PU + ucol; }
                conv_item<3>(rowp, rok, cs, GW, wsrc, CH, act, dst, dpitch);
            } else {
                const bf16* rowp[1] = {U + (size_t)q.base * PU + ucol}; const bool rok[1] = {true};
                conv_item<1>(rowp, rok, t0, q.T, wsrc, CH, act, dst, dpitch);
            }
        }
    }
}
constexpr int PO_ITEMS = (NT / 16) * 2, PO_HC = RW / 2;
__device__ __forceinline__ void post_phase(LAS unsigned char* lds, CParams& P, int l, int vb, int G) {
    const int tid = threadIdx.x, w = tid >> 6, lane = tid & 63, fr = lane & 15, fq = lane >> 4, l32 = lane & 31, th = lane >> 5;
    constexpr int GP = PO_HC * 2 + 16;
    LAS unsigned char* gt = lds + w * (16 * GP);
    const bf16* U = WSP(bf16, WS_U1); const bf16* RX = WSP(bf16, WS_RXC); const bf16* G2T = WSP(bf16, O_G2T); bf16* O = WSP(bf16, WS_QKC);
    for (int it = vb * 8 + w; it < PO_ITEMS; it += G * 8) {
        const int tile = it >> 1, h = it & 1; const size_t tok0 = (size_t)tile * 16;
        bf16x8 af[4];
#pragma unroll
        for (int ks = 0; ks < 4; ++ks) af[ks] = *(const bf16x8*)(RX + (tok0 + fr) * RIN + RX_GL + 32 * ks + 8 * fq);
        for (int ct = 0; ct < PO_HC / 16; ++ct) { f32x4 acc = (f32x4){0.f, 0.f, 0.f, 0.f};
#pragma unroll
            for (int ks = 0; ks < 4; ++ks) acc = ml::mma(af[ks], *(const bf16x8*)(G2T + (size_t)(h * PO_HC + 16 * ct + fr) * 128 + 32 * ks + 8 * fq), acc);
#pragma unroll
            for (int r = 0; r < 4; ++r) *(LAS bf16*)(gt + (4 * fq + r) * GP + (16 * ct + fr) * 2) = f2bf(acc[r]); }
        asm volatile("s_waitcnt lgkmcnt(0)" ::: "memory");
        const int cb = h * PO_HC + 8 * l32;
        float gn[8], gw[8], gb[8], rk[8];
        { const f32x4 a0 = *(const f32x4*)(P.in[M_NORM_G] + (size_t)l * MW + cb), a1 = *(const f32x4*)(P.in[M_NORM_G] + (size_t)l * MW + cb + 4);
          const f32x4 b0 = *(const f32x4*)(P.in[R_GN_W] + (size_t)l * RW + cb), b1 = *(const f32x4*)(P.in[R_GN_W] + (size_t)l * RW + cb + 4);
          const f32x4 c0 = *(const f32x4*)(P.in[R_GN_B] + (size_t)l * RW + cb), c1 = *(const f32x4*)(P.in[R_GN_B] + (size_t)l * RW + cb + 4);
          const f32x4 d0 = *(const f32x4*)(P.in[R_RK] + (size_t)l * RW + cb), d1 = *(const f32x4*)(P.in[R_RK] + (size_t)l * RW + cb + 4);
#pragma unroll
          for (int e = 0; e < 4; ++e) { gn[e] = a0[e]; gn[4 + e] = a1[e]; gw[e] = b0[e]; gw[4 + e] = b1[e]; gb[e] = c0[e]; gb[4 + e] = c1[e]; rk[e] = d0[e]; rk[4 + e] = d1[e]; } }
        for (int tp = 0; tp < 8; ++tp) { const int tl = 2 * tp + th; const size_t m = tok0 + tl; const bf16* u = U + m * PU; const bf16* rx = RX + m * RIN;
            float hf[8], hb[8], ov[8], x[8]; unpack8(*(const u32x4*)(u + cb), hf); unpack8(*(const u32x4*)(u + MW + cb), hb); unpack8(*(const u32x4*)(u + OFF_O + cb), ov);
            float ss = 0.f;
#pragma unroll
            for (int e = 0; e < 8; ++e) { x[e] = hf[e] + hb[e]; ss += x[e] * x[e]; }
            ss = rw::allsum16(ss); const float rs = 1.0f / sqrtf(ss * (1.0f / 128.f) + RMS_EPS);
#pragma unroll
            for (int e = 0; e < 8; ++e) x[e] = x[e] * rs * gn[e] * pg8::fsigmoid(ov[e]);
            *(u32x4*)(O + m * D + cb) = pack8(x);
            float yf[8], yb[8], rr[8], kk[8], vv[8], gg[8], y[8]; unpack8(*(const u32x4*)(u + OFF_R + cb), yf); unpack8(*(const u32x4*)(u + OFF_R + RW + cb), yb);
            unpack8(*(const u32x4*)(rx + RX_R + cb), rr); unpack8(*(const u32x4*)(rx + RX_K + cb), kk); unpack8(*(const u32x4*)(rx + RX_V + cb), vv);
            unpack8(*(const LAS u32x4*)(gt + tl * GP + l32 * 16), gg);
            float mu = 0.f, bs = 0.f;
#pragma unroll
            for (int e = 0; e < 8; ++e) { y[e] = yf[e] + yb[e]; mu += y[e]; bs += rr[e] * kk[e] * rk[e]; }
            mu += rw::dpp_xor1(mu); mu += rw::dpp_xor2(mu); mu += __shfl_xor(mu, 4); mu *= (1.0f / 64.f);
            bs += rw::dpp_xor1(bs); bs += rw::dpp_xor2(bs); bs += __shfl_xor(bs, 4);
            float var = 0.f;
#pragma unroll
            for (int e = 0; e < 8; ++e) { y[e] -= mu; var += y[e] * y[e]; }
            var += rw::dpp_xor1(var); var += rw::dpp_xor2(var); var += __shfl_xor(var, 4); var *= (1.0f / 64.f);
            const float rsd = 1.0f / sqrtf(var + GN_EPS);
#pragma unroll
            for (int e = 0; e < 8; ++e) y[e] = (y[e] * rsd * gw[e] + gb[e] + bs * vv[e]) * gg[e];
            *(u32x4*)(O + m * D + MW + cb) = pack8(y);
        }
        asm volatile("s_waitcnt lgkmcnt(0)" ::: "memory");
    }
}
}

constexpr int LDS_BYTES = 147456;
constexpr int LDS_MISC = 147456 - 1024;
constexpr size_t CTL_ZERO_BYTES = 262144;
constexpr int CW_BAR = 4096, CW_Q = 8192;

#define XB_TMO      128
#define XB_XCNT(j)  (256  + 64 * (j))
#define XB_XSUB(j)  (1280 + 64 * (j))
#define XB_XGEN(j)  (2304 + 64 * (j))
#define XB_TOP      3328
#define XB_TOPGEN   3392
#define XCD_BAR_WORDS 3456
#define XB_SPIN_CAP (1u << 18)
__device__ __forceinline__ unsigned xb_ld(unsigned* p)              { return __hip_atomic_load(p, __ATOMIC_RELAXED, __HIP_MEMORY_SCOPE_AGENT); }
__device__ __forceinline__ unsigned xb_add(unsigned* p, unsigned v) { return __hip_atomic_fetch_add(p, v, __ATOMIC_RELAXED, __HIP_MEMORY_SCOPE_AGENT); }
__device__ __forceinline__ unsigned xb_xcc_id() { return (unsigned)__builtin_amdgcn_s_getreg((3 << 11) | 20) & 0xFu; }
#define XB_SPIN(cond, bar) do { unsigned _sp = 0; while (cond) { __builtin_amdgcn_s_sleep(1); \
    if ((++_sp & 255u) == 0u) { if (xb_ld(&(bar)[XB_TMO])) break; if (_sp > XB_SPIN_CAP) { atomicAdd(&(bar)[XB_TMO], 1u); break; } } } } while (0)
struct XcdBarrier { unsigned* bar; unsigned x; volatile LAS unsigned* st; };
__device__ __forceinline__ XcdBarrier xcd_barrier_post(unsigned* bar, volatile LAS unsigned* st) {
    XcdBarrier b; b.bar = bar; b.x = xb_xcc_id(); b.st = st;
    if (threadIdx.x == 0) (void)xb_add(&bar[XB_XCNT(b.x)], 1u);
    return b;
}
__device__ __forceinline__ void xcd_barrier_complete(unsigned* bar, unsigned x, unsigned& nloc, unsigned& nx) {
    const unsigned G = gridDim.x * gridDim.y * gridDim.z;
    unsigned sum, cnt, mine, sp = 0u;
    for (;;) {
        sum = 0u; cnt = 0u; mine = 0u;
#pragma unroll
        for (unsigned j = 0; j < 16; ++j) { const unsigned c = xb_ld(&bar[XB_XCNT(j)]); sum += c; cnt += (c > 0u) ? 1u : 0u; mine = (j == x) ? c : mine; }
        if (sum == G) break;
        __builtin_amdgcn_s_sleep(1);
        if ((++sp & 255u) == 0u) { if (xb_ld(&bar[XB_TMO])) break; if (sp > XB_SPIN_CAP) { atomicAdd(&bar[XB_TMO], 1u); break; } }
    }
    nloc = mine > 0u ? mine : 1u; nx = cnt > 0u ? cnt : 1u;
}
__device__ __forceinline__ void xcd_barrier(const XcdBarrier& b) {
    asm volatile("s_waitcnt vmcnt(0)" ::: "memory");
    __syncthreads();
    if (threadIdx.x == 0) {
        unsigned* bar = b.bar;
        __builtin_amdgcn_s_waitcnt(0);
        unsigned nloc = b.st[0], nx = b.st[1];
        if (nloc == 0u) { xcd_barrier_complete(bar, b.x, nloc, nx); b.st[0] = nloc; b.st[1] = nx; }
        const unsigned old = xb_add(&bar[XB_XSUB(b.x)], 1u);
        const unsigned gen = old / nloc;
        if (old + 1u == (gen + 1u) * nloc) {
            __builtin_amdgcn_fence(__ATOMIC_RELEASE, "agent");
            asm volatile("s_waitcnt vmcnt(0)" ::: "memory");
            const unsigned og = xb_add(&bar[XB_TOP], 1u);
            const unsigned tg = og / nx;
            if (og + 1u == (tg + 1u) * nx) xb_add(&bar[XB_TOPGEN], 1u);
            else XB_SPIN(xb_ld(&bar[XB_TOPGEN]) == tg, bar);
            __builtin_amdgcn_fence(__ATOMIC_ACQUIRE, "agent");
            xb_add(&bar[XB_XGEN(b.x)], 1u);
            asm volatile("s_waitcnt vmcnt(0)" ::: "memory");
        } else {
            XB_SPIN(xb_ld(&bar[XB_XGEN(b.x)]) == gen, bar);
            __builtin_amdgcn_fence(__ATOMIC_ACQUIRE, "agent");
            asm volatile("s_waitcnt vmcnt(0)" ::: "memory");
        }
    }
    __syncthreads();
}

constexpr int MX_RL = LB * RH * 2 * 4, MX_ML = LB * MH * 2 * ml::NVB, MX_RC = CB * RH * 2 * 4, MX_MC = CB * MH * 2 * ml::NVB;
constexpr int MX_ITEMS = MX_RL + MX_ML + MX_RC + MX_MC;

constexpr int ML_SPLIT = 0;
__device__ __forceinline__ void scan_phase(LAS unsigned char* lds, CParams& P, int l, unsigned* ctl) {
    unsigned* qhead = ctl + CW_Q + 64 * l;
    const bool split = gridDim.x >= 4 * wy::N_LAT * (1 + wy::NPROD) / 2;
    volatile LAS unsigned* bc = (volatile LAS unsigned*)(lds + LDS_MISC) + 16;
    for (;;) {
        if (threadIdx.x == 0) bc[0] = xb_add(qhead, 1u);
        __syncthreads();
        const int it = (int)bc[0];
        __syncthreads();
        if (!split || it >= wy::N_LAT) break;
        int s_, head, dir; wy::decode_item(it, s_, head, dir);
        wy::rwkv_cons(lds, P, l, s_, head, dir, it, ctl);
    }
    for (;;) {
        if (threadIdx.x == 0) bc[0] = xb_add(qhead + 8, 1u);
        __syncthreads();
        const int it = (int)bc[0];
        __syncthreads();
        if (it >= ML_SPLIT * ms::N_MLAT) break;
        int s_, head, dir, sub; ml::decode_item(it * ml::NVB, s_, head, dir, sub);
        ms::ml_cons(lds, P, l, s_, head, dir, it, ctl);
    }
    for (;;) {
        if (threadIdx.x == 0) bc[0] = xb_add(qhead + 48, 1u);
        __syncthreads();
        const int it = (int)bc[0];
        __syncthreads();
        if (!split || it >= wy::N_LAT * wy::NPROD) break;
        const int chain = it % wy::N_LAT;
        int s_, head, dir; wy::decode_item(chain, s_, head, dir);
        wy::rwkv_prod(lds, P, l, s_, head, dir, chain, it / wy::N_LAT, ctl);
    }
    for (;;) {
        if (threadIdx.x == 0) bc[0] = xb_add(qhead + 24, 1u);
        __syncthreads();
        const int it = (int)bc[0];
        __syncthreads();
        if (it >= ML_SPLIT * ms::N_MLAT * ms::MLPROD) break;
        const int chain = it % ms::N_MLAT;
        int s_, head, dir, sub; ml::decode_item(chain * ml::NVB, s_, head, dir, sub);
        ms::ml_prod(lds, P, l, s_, head, dir, chain, it / ms::N_MLAT, ctl);
    }
    for (;;) {
        if (threadIdx.x == 0) bc[0] = xb_add(qhead + 16, 1u);
        __syncthreads();
        const int it = (int)bc[0] + ML_SPLIT * ms::N_MLAT * ml::NVB;
        __syncthreads();
        if (it >= ml::N_ITEMS) break;
        int s_, head, dir, sub; ml::decode_item(it, s_, head, dir, sub);
        ml::mlstm_item2(lds, P, l, s_, head, dir, sub);
    }
    for (;;) {
        if (threadIdx.x == 0) bc[0] = xb_add(qhead + 32, 1u);
        __syncthreads();
        const int it = (int)bc[0] + (split ? LB * RH * 2 : 0);
        __syncthreads();
        if (it >= wy::N_ITEMS) break;
        int s_, head, dir; wy::decode_item(it, s_, head, dir);
        wy::rwkv_item(lds, P, l, s_, head, dir);
    }
}

enum { ST_N0 = 0, ST_A1, ST_CV, ST_MX, ST_PO, ST_N1, ST_A2, ST_PJ, ST_WO, ST_N2, ST_F1, ST_F2, ST_PER_LAYER };
constexpr int N_STEPS = 1 + DEPTH * ST_PER_LAYER + 1;
struct MkArgs { Params P; int ph_lo, ph_hi; };
__global__ void __launch_bounds__(512, 2) mk(MkArgs a) {
    extern __shared__ __attribute__((aligned(16))) unsigned char lds_raw[];
    LAS unsigned char* lds = (LAS unsigned char*)lds_raw;
    const int G = gridDim.x, vb = (int)blockIdx.x;
    unsigned* ctl = (unsigned*)(a.P.ws + WS_CTL);
    volatile LAS unsigned* MISC = (volatile LAS unsigned*)(lds + LDS_MISC);
    for (int u = threadIdx.x; u < 64; u += 512) MISC[u] = 0u;
    __syncthreads();
    const bool multi = a.ph_hi - a.ph_lo > 1;
    XcdBarrier bar; bar.bar = ctl + CW_BAR; bar.x = 0; bar.st = nullptr;
    if (multi) bar = xcd_barrier_post(ctl + CW_BAR, MISC + 8);
    const int lo = a.ph_lo, hi = a.ph_hi;
    const int fuse = (multi && lo == 0 && hi == N_STEPS && G == (NT / pg8::BM) * (D / pg8::BM)) ? 1 : 0;
#define STEP_BEGIN(id) if (lo <= (id) && (id) < hi) { unsigned long long kp_ = (unsigned long long)__builtin_amdgcn_kernarg_segment_ptr(); asm volatile("" : "+s"(kp_)); CParams& P = *(CParams*)kp_;
#define STEP_END(id) if ((id) + 1 < hi) xcd_barrier(bar); }
    STEP_BEGIN(0) el::init_phase(lds, P, vb, G); el::wconv_phase(lds, P, 0, vb, G); STEP_END(0)
#define LAYER(l) { \
        const int base = 1 + (l) * ST_PER_LAYER; \
        STEP_BEGIN(base + ST_N0) if ((l) > 0) el::wconv_phase(lds, P, (l), vb, G); if ((l) == 0 || !fuse) el::norm_phase(P, (l), 0, vb, G); STEP_END(base + ST_N0) \
        STEP_BEGIN(base + ST_A1) { pg8::Gemm g{WSP(bf16, WS_QKC), WSP(bf16, O_WIN1), D, D}; pg8::StaticOrder S; S.init(NT, N1P, G, vb); \
            pg8::EpiA1 E{WSP(bf16, WS_U1)}; pg8::gemm_phase(lds, g, S, E); } STEP_END(base + ST_A1) \
        STEP_BEGIN(base + ST_CV) el::conv_phase(lds, P, (l), vb, G); STEP_END(base + ST_CV) \
        STEP_BEGIN(base + ST_MX) scan_phase(lds, P, (l), ctl); STEP_END(base + ST_MX) \
        STEP_BEGIN(base + ST_PO) el::post_phase(lds, P, (l), vb, G); STEP_END(base + ST_PO) \
        STEP_BEGIN(base + ST_N1) el::norm_phase(P, (l), 1, vb, G); STEP_END(base + ST_N1) \
        STEP_BEGIN(base + ST_A2) { pg8::Gemm g{WSP(bf16, WS_RXC), WSP(bf16, O_WIN2), D, D}; pg8::StaticOrder S; S.init(NT, 2 * D, G, vb); \
            pg8::EpiA2 E{WSP(bf16, WS_U1)}; pg8::gemm_phase(lds, g, S, E); } STEP_END(base + ST_A2) \
        STEP_BEGIN(base + ST_PJ) { pg8::Gemm g{WSP(bf16, WS_QKC), WSP(bf16, O_PM), MW, D}; pg8::PairOrder S; S.init(NT, G, vb); \
            pg8::EpiPJ E{WSP(bf16, WS_U1)}; pg8::gemm_phase(lds, g, S, E); } STEP_END(base + ST_PJ) \
        STEP_BEGIN(base + ST_WO) { pg8::Gemm g{WSP(bf16, WS_U1), WSP(bf16, O_WO), D, PU}; pg8::StaticOrder S; S.init(NT, D, G, vb); \
            pg8::EpiResNorm E{P.out, WSP(float, WS_MOD) + (size_t)(l) * NCOND * 6 * D + 2 * D, (l) == 0 ? P.in[X_PROMPT] : nullptr, (l) == 0 ? P.in[X_SAMPLE] : nullptr, \
                fuse, P.in[NORM2] + (size_t)(l) * D, WSP(float, WS_MOD) + (size_t)(l) * NCOND * 6 * D + 3 * D, WSP(bf16, WS_QKC), P.ws, 1u + 2u * (l), lds}; pg8::gemm_phase(lds, g, S, E); } STEP_END(base + ST_WO) \
        if (!fuse) { STEP_BEGIN(base + ST_N2) el::norm_phase(P, (l), 2, vb, G); STEP_END(base + ST_N2) } \
        STEP_BEGIN(base + ST_F1) { pg8::Gemm g{WSP(bf16, WS_QKC), WSP(bf16, O_W13), D, D}; pg8::StaticOrder S; S.init(NT, 2 * FF, G, vb); \
            pg8::EpiF1 E{WSP(bf16, WS_U1)}; pg8::gemm_phase(lds, g, S, E); } STEP_END(base + ST_F1) \
        STEP_BEGIN(base + ST_F2) { pg8::Gemm g{WSP(bf16, WS_U1), WSP(bf16, O_W2), FF, FF}; pg8::StaticOrder S; S.init(NT, D, G, vb); \
            pg8::EpiResNorm E{P.out, WSP(float, WS_MOD) + (size_t)(l) * NCOND * 6 * D + 5 * D, nullptr, nullptr, fuse, \
                (l) + 1 < DEPTH ? P.in[NORM1] + (size_t)((l) + 1) * D : P.in[FINAL_G], (l) + 1 < DEPTH ? WSP(float, WS_MOD) + (size_t)((l) + 1) * NCOND * 6 * D : nullptr, \
                (l) + 1 < DEPTH ? WSP(bf16, WS_QKC) : nullptr, P.ws, 2u + 2u * (l), lds}; pg8::gemm_phase(lds, g, S, E); } \
            if ((l) + 1 < DEPTH || !fuse) { if (base + ST_F2 + 1 < hi) xcd_barrier(bar); } } \
    }
    static_assert(DEPTH == 2, "layers are unrolled by hand");
    LAYER(0)
    LAYER(1)
#undef LAYER
    if (!fuse) { STEP_BEGIN(N_STEPS - 1) el::norm_phase(P, 0, 3, vb, G); STEP_END(N_STEPS - 1) }
#undef STEP_BEGIN
#undef STEP_END
}
#endif

typedef void (*BodyFn)(const Params&, long);
#ifndef HOST_EMU
template <BodyFn F, int BLOCK> __global__ void __launch_bounds__(BLOCK) run_k(Params P, long n) {
    const long i = (long)blockIdx.x * BLOCK + threadIdx.x;
    if (i < n) F(P, i);
}
#define RUN(F, BLOCK, n) do { const long n_ = (n); run_k<F, BLOCK><<<dim3((unsigned)((n_ + BLOCK - 1) / BLOCK)), dim3(BLOCK), 0, stream>>>(P, n_); } while (0)
static int g_grid = 0;
#else
#define RUN(F, BLOCK, n) do { const long n_ = (n); for (long i_ = 0; i_ < n_; ++i_) F(P, i_); } while (0)
typedef void* hipStream_t;
#endif

static void forward(Params P, hipStream_t stream) {
    (void)stream;
#ifndef HOST_EMU
    if (hipMemsetAsync(P.ws + WS_CTL, 0, CTL_ZERO_BYTES, stream) != hipSuccess) return;
#ifdef MK_PER_STEP
    for (int st = 0; st < N_STEPS; ++st) { MkArgs a_{}; a_.P = P; a_.ph_lo = st; a_.ph_hi = st + 1; mk<<<dim3(g_grid), dim3(512), LDS_BYTES, stream>>>(a_); }
#else
    { MkArgs a_{}; a_.P = P; a_.ph_lo = 0; a_.ph_hi = N_STEPS; mk<<<dim3(g_grid), dim3(512), LDS_BYTES, stream>>>(a_); }
#endif
#else
    RUN(k_init_x, 256, (long)NT * D);
    RUN(k_mod, 256, (long)DEPTH * NCOND * 6 * D);
    for (int l = 0; l < DEPTH; ++l) {
        P.layer = l;
        RUN(k_wconv, 256, WC_N6);
        P.mode = 0; RUN(k_norm, 64, (long)NT);
        RUN(k_gemm_a1, 256, (long)NT * N1);
        RUN(k_conv, 256, (long)NT * (2 * MW + RIN));
        RUN(k_mlstm, 128, (long)NSEQ * MH * 2 * 128);
        for (int dir = 0; dir < 2; ++dir) { P.mode = dir; RUN(k_rwkv_prep, 256, (long)NT * RW); RUN(k_rwkv, 64, (long)NSEQ * RH * 64); }
        RUN(k_post, 256, (long)NT * D);
        P.mode = 1; RUN(k_norm, 64, (long)NT);
        RUN(k_gemm_a2, 256, (long)NT * 2 * D);
        RUN(k_gemm_pj, 256, (long)NT * D);
        RUN(k_gemm_wo, 256, (long)NT * D);
        P.mode = 2; RUN(k_norm, 64, (long)NT);
        RUN(k_gemm_f1, 256, (long)NT * FF);
        RUN(k_gemm_f2, 256, (long)NT * D);
    }
    RUN(k_final, 64, (long)NT);
#endif
}

#ifndef HOST_EMU
extern "C" void kernel_launch(void* const* d_in, const int* in_sizes, int n_in, void* d_out, int out_size, void* d_ws, size_t ws_size, hipStream_t stream) {
    if (n_in != N_IN || (size_t)out_size != OUT_END || ws_size < WS_END) return;
    if (g_grid == 0) {
        int dev = 0, cus = 0;
        if (hipGetDevice(&dev) != hipSuccess || hipDeviceGetAttribute(&cus, hipDeviceAttributeMultiprocessorCount, dev) != hipSuccess) { g_grid = -1; return; }
        if (hipFuncSetAttribute((const void*)mk, hipFuncAttributeMaxDynamicSharedMemorySize, LDS_BYTES) != hipSuccess) { g_grid = -1; return; }
        g_grid = cus;
    }
    if (g_grid < 0) return;
    Params P{};
    for (int i = 0; i < N_IN; ++i) P.in[i] = (const float*)d_in[i];
    P.out = (float*)d_out; P.ws = (unsigned char*)d_ws; P.layer = 0; P.mode = 0;
    forward(P, stream);
}
#endif
```

```cpp
#ifndef HOST_EMU
#include <hip/hip_runtime.h>
#define HD __host__ __device__ __forceinline__
#define DEV __device__ __forceinline__
#else
#include <cmath>
#include <cstring>
#include <cstdio>
#include <cstdlib>
#define HD inline
#define DEV inline
#endif
#include <cstddef>

#ifdef SMALL_CFG
constexpr int D = 256, CB = 2, CT = 128, DEPTH = 2, LB = 1, LT = 256, GW = 16;
#else
constexpr int D = 1024, CB = 32, CT = 256, DEPTH = 2, LB = 2, LT = 4096, GW = 64;
#endif
constexpr int MW = D / 2, MD = 128, MH = MW / MD, RW = D / 2, RD = 64, RH = RW / RD;
constexpr int RIN = 3 * RW + 384, FF = ((8 * D + 767) / 768) * 256, PIN = 2 * MW + MW + MW + 4 * MH + RIN + 2 * D;
constexpr int NC = CB * CT, NL = LB * LT, NT = NC + NL, NSEQ = CB + LB, NCOND = 1 + LB;
constexpr int N1 = PIN - 2 * D;
constexpr int N1P = ((N1 + 255) / 256) * 256;
constexpr int PU = N1;
constexpr int OFF_QK = 0, OFF_V = 2 * MW, OFF_O = 3 * MW, OFF_G = 4 * MW, OFF_R = 4 * MW + 4 * MH;
constexpr int RX_R = 0, RX_K = RW, RX_V = 2 * RW, RX_WL = 3 * RW, RX_AL = 3 * RW + 128, RX_GL = 3 * RW + 256;
constexpr float RMS_EPS = 1e-6f, GN_EPS = 64e-5f;
static_assert(3 * D <= N1, "G + merged must fit the dead columns of U1");

enum { X_PROMPT = 0, X_SAMPLE, ST_C, ST_N, ST_M, ST_R, C_LAT, C_CTX, ADA_W, ADA_B, NORM1, NORM2, W_IN, M_CONV, M_GATE_B, M_NORM_G,
       R_CONV, R_W0, R_W2, R_A0, R_A2, R_G2, R_KK, R_KA, R_RK, R_GN_W, R_GN_B, PROJ_M, PROJ_R, W_OUT, FFN_W1, FFN_W3, FFN_W2, FINAL_G, N_IN };

constexpr size_t OUT_X = 0;
constexpr size_t OUT_C = (size_t)NT * D;
constexpr size_t OUT_N = OUT_C + (size_t)CB * DEPTH * 2 * MH * 128 * 128;
constexpr size_t OUT_M = OUT_N + (size_t)CB * DEPTH * 2 * MH * 128;
constexpr size_t OUT_S = OUT_M + (size_t)CB * DEPTH * 2 * MH;
constexpr size_t OUT_END = OUT_S + (size_t)CB * DEPTH * 2 * RH * 64 * 64;

constexpr size_t al256(size_t x) { return (x + 255) & ~(size_t)255; }
constexpr size_t cmax(size_t a, size_t b) { return a > b ? a : b; }
constexpr size_t WS_CTL = 0;
constexpr size_t WS_MOD = (size_t)1 << 20;
constexpr size_t WS_WREG = (size_t)2 << 20;
constexpr size_t O_WIN1 = WS_WREG;
constexpr size_t O_WIN2 = O_WIN1 + (size_t)N1P * D * 2;
constexpr size_t O_PM = O_WIN2 + (size_t)2 * D * D * 2;
constexpr size_t O_PR = O_PM + (size_t)D * MW * 2;
constexpr size_t O_WO = O_PR + (size_t)D * RW * 2;
constexpr size_t O_W13 = O_WO + (size_t)D * D * 2;
constexpr size_t O_W2 = O_W13 + (size_t)2 * FF * D * 2;
constexpr size_t O_G2T = O_W2 + (size_t)D * FF * 2;
constexpr size_t O_W2T = O_G2T + (size_t)RW * 128 * 2;
constexpr size_t O_A2T = O_W2T + (size_t)2 * RW * 64 * 2;
constexpr size_t WS_U1 = al256(O_A2T + (size_t)2 * RW * 64 * 2);
constexpr size_t SZ_U1 = al256(cmax((size_t)NT * PU * 2, (size_t)NT * FF * 2));
constexpr size_t WS_QKC = WS_U1 + SZ_U1;
constexpr size_t WS_RXC = WS_QKC + (size_t)NT * D * 2;
constexpr size_t WS_END = WS_RXC + al256(cmax((size_t)NT * RIN * 2, (size_t)NT * D * 2));
#ifndef SMALL_CFG
static_assert(WS_END <= ((size_t)256 << 20), "workspace map must fit 256 MiB");
#endif

typedef unsigned short bf16;
HD float bf2f(bf16 b) { unsigned u = ((unsigned)b) << 16; return __builtin_bit_cast(float, u); }
#if defined(__HIP_DEVICE_COMPILE__)
HD bf16 f2bf(float f) { return __builtin_bit_cast(bf16, (__bf16)f); }
#else
HD bf16 f2bf(float f) { unsigned u = __builtin_bit_cast(unsigned, f); u += 0x7fffu + ((u >> 16) & 1u); return (bf16)(u >> 16); }
#endif
HD float sigmoidf_(float x) { return 1.0f / (1.0f + expf(-x)); }
HD float siluf_(float x) { return x / (1.0f + expf(-x)); }
HD float softplusf_(float x) { return fmaxf(x, 0.f) + log1pf(expf(-fabsf(x))); }
HD float logsigmoidf_(float x) { return -softplusf_(-x); }
HD int prow(int c) { return (c & ~31) | (((c >> 2) & 1) << 4) | (((c >> 3) & 3) << 2) | (c & 3); }

struct Params {
    const float* in[N_IN];
    float* out;
    unsigned char* ws;
    int layer;
    int mode;
};

struct SeqInfo { int T; int base; int grid; int cond; int b; };
HD SeqInfo seqinfo(int s) {
    SeqInfo q;
    if (s < CB) { q.T = CT; q.base = s * CT; q.grid = 0; q.cond = 0; q.b = s; }
    else { q.T = LT; q.base = NC + (s - CB) * LT; q.grid = 1; q.cond = 1 + (s - CB); q.b = s - CB; }
    return q;
}
HD int seq_of_token(int m) { return m < NC ? m / CT : CB + (m - NC) / LT; }

#define WSP(T, off) ((T*)(P.ws + (off)))

DEV void k_init_x(const Params& P, long i) {
    const size_t ncd = (size_t)NC * D;
    P.out[i] = (size_t)i < ncd ? P.in[X_PROMPT][i] : P.in[X_SAMPLE][i - ncd];
}
DEV void k_mod(const Params& P, long i) {
    const int j = (int)(i % (6 * D)); const int ci = (int)((i / (6 * D)) % NCOND); const int l = (int)(i / ((long)6 * D * NCOND));
    const float* cv = ci == 0 ? P.in[C_CTX] : P.in[C_LAT] + (size_t)(ci - 1) * D;
    const float* w = P.in[ADA_W] + (size_t)l * D * 6 * D;
    float acc = P.in[ADA_B][(size_t)l * 6 * D + j];
    for (int k = 0; k < D; ++k) acc += siluf_(cv[k]) * w[(size_t)k * 6 * D + j];
    WSP(float, WS_MOD)[i] = acc;
}
constexpr long WC_N0 = (long)N1P * D, WC_N1 = WC_N0 + (long)2 * D * D, WC_N2 = WC_N1 + (long)D * MW, WC_N3 = WC_N2 + (long)D * RW,
               WC_N4 = WC_N3 + (long)D * D, WC_N5 = WC_N4 + (long)2 * FF * D, WC_N6 = WC_N5 + (long)D * FF;
HD int unprow(int r) { return (r & ~31) | (((r >> 2) & 3) << 3) | (((r >> 4) & 1) << 2) | (r & 3); }
DEV void k_wconv(const Params& P, long i) {
    const int l = P.layer;
    if (i < WC_N0) { const int r = (int)(i / D), k = (int)(i % D); const int c = unprow(r);
        WSP(bf16, O_WIN1)[i] = c < N1 ? f2bf(P.in[W_IN][((size_t)l * D + k) * PIN + c]) : (bf16)0; return; }
    if (i < WC_N1) { const long j = i - WC_N0; const int r = (int)(j / D), k = (int)(j % D); const int c = unprow(r);
        WSP(bf16, O_WIN2)[j] = f2bf(P.in[W_IN][((size_t)l * D + k) * PIN + N1 + c]); return; }
    if (i < WC_N2) { const long j = i - WC_N1; const int r = (int)(j / MW), k = (int)(j % MW); const int c = unprow(r);
        WSP(bf16, O_PM)[j] = f2bf(P.in[PROJ_M][((size_t)l * MW + k) * D + c]); return; }
    if (i < WC_N3) { const long j = i - WC_N2; const int r = (int)(j / RW), k = (int)(j % RW); const int c = unprow(r);
        WSP(bf16, O_PR)[j] = f2bf(P.in[PROJ_R][((size_t)l * RW + k) * D + c]); return; }
    if (i < WC_N4) { const long j = i - WC_N3; const int r = (int)(j / D), k = (int)(j % D);
        WSP(bf16, O_WO)[j] = f2bf(P.in[W_OUT][((size_t)l * D + k) * D + r]); return; }
    if (i < WC_N5) { const long j = i - WC_N4; const int r = (int)(j / D), k = (int)(j % D);
        const int pn = r >> 8, rl = r & 255, which = rl >> 7, rho = rl & 127; const int jj = pn * 128 + unprow(rho);
        const float* W = which ? P.in[FFN_W3] : P.in[FFN_W1];
        WSP(bf16, O_W13)[j] = f2bf(W[((size_t)l * D + k) * FF + jj]); return; }
    { const long j = i - WC_N5; const int r = (int)(j / FF), k = (int)(j % FF);
        WSP(bf16, O_W2)[j] = f2bf(P.in[FFN_W2][((size_t)l * FF + k) * D + r]); }
}
DEV void k_norm(const Params& P, long m) {
    const int l = P.layer; const int second = (P.mode == 2);
    const float* x = P.out + (size_t)m * D;
    const float* g = P.in[second ? NORM2 : NORM1] + (size_t)l * D;
    const int cond = seqinfo(seq_of_token((int)m)).cond;
    const float* mod = WSP(float, WS_MOD) + ((size_t)l * NCOND + cond) * 6 * D + (second ? 3 * D : 0);
    float ss = 0.f;
    for (int k = 0; k < D; ++k) ss += x[k] * x[k];
    const float rs = 1.0f / sqrtf(ss / D + RMS_EPS);
    bf16* o = WSP(bf16, P.mode == 1 ? WS_RXC : WS_QKC) + (size_t)m * D;
    for (int k = 0; k < D; ++k) o[k] = f2bf(x[k] * rs * g[k] * (1.0f + mod[D + k]) + mod[k]);
}
DEV float dot_bf(const bf16* a, const bf16* b, int K) { float s = 0.f; for (int k = 0; k < K; ++k) s += bf2f(a[k]) * bf2f(b[k]); return s; }
DEV void k_gemm_a1(const Params& P, long i) {
    const int n = (int)(i % N1); const long m = i / N1;
    WSP(bf16, WS_U1)[(size_t)m * PU + n] = f2bf(dot_bf(WSP(bf16, WS_QKC) + (size_t)m * D, WSP(bf16, O_WIN1) + (size_t)prow(n) * D, D));
}
DEV void k_gemm_a2(const Params& P, long i) {
    const int n = (int)(i % (2 * D)); const long m = i / (2 * D);
    WSP(bf16, WS_U1)[(size_t)m * PU + D + n] = f2bf(sigmoidf_(dot_bf(WSP(bf16, WS_RXC) + (size_t)m * D, WSP(bf16, O_WIN2) + (size_t)prow(n) * D, D)));
}
DEV void k_gemm_pj(const Params& P, long i) {
    const int n = (int)(i % D); const long m = i / D;
    const bf16* hmr = WSP(bf16, WS_QKC) + (size_t)m * D; bf16* u = WSP(bf16, WS_U1) + (size_t)m * PU;
    const float a = dot_bf(hmr, WSP(bf16, O_PM) + (size_t)prow(n) * MW, MW), b = dot_bf(hmr + MW, WSP(bf16, O_PR) + (size_t)prow(n) * RW, RW);
    const float first = bf2f(f2bf(bf2f(u[D + n]) * a));
    u[n] = f2bf(first + bf2f(u[2 * D + n]) * b);
}
DEV void k_gemm_wo(const Params& P, long i) {
    const int n = (int)(i % D); const long m = i / D; const int l = P.layer;
    const int cond = seqinfo(seq_of_token((int)m)).cond;
    const float g1 = WSP(float, WS_MOD)[((size_t)l * NCOND + cond) * 6 * D + 2 * D + n];
    P.out[(size_t)m * D + n] += g1 * dot_bf(WSP(bf16, WS_U1) + (size_t)m * PU, WSP(bf16, O_WO) + (size_t)n * D, D);
}
DEV void k_gemm_f1(const Params& P, long i) {
    const int j = (int)(i % FF); const long m = i / FF;
    const int pn = j >> 7, rho = prow(j & 127);
    const bf16* h = WSP(bf16, WS_QKC) + (size_t)m * D;
    const float a = dot_bf(h, WSP(bf16, O_W13) + (size_t)(pn * 256 + rho) * D, D), b = dot_bf(h, WSP(bf16, O_W13) + (size_t)(pn * 256 + 128 + rho) * D, D);
    WSP(bf16, WS_U1)[(size_t)m * FF + j] = f2bf(siluf_(a) * b);
}
DEV void k_gemm_f2(const Params& P, long i) {
    const int n = (int)(i % D); const long m = i / D; const int l = P.layer;
    const int cond = seqinfo(seq_of_token((int)m)).cond;
    const float g2 = WSP(float, WS_MOD)[((size_t)l * NCOND + cond) * 6 * D + 5 * D + n];
    P.out[(size_t)m * D + n] += g2 * dot_bf(WSP(bf16, WS_U1) + (size_t)m * FF, WSP(bf16, O_W2) + (size_t)n * FF, FF);
}
DEV void k_conv(const Params& P, long i) {
    constexpr int NCH = 2 * MW + RIN;
    const int ch = (int)(i % NCH); const int m = (int)(i / NCH); const int l = P.layer;
    const int s = seq_of_token(m); const SeqInfo q = seqinfo(s); const int t = m - q.base;
    const bool isqk = ch < 2 * MW; const int c = isqk ? ch : ch - 2 * MW;
    const int ucol = isqk ? OFF_QK + c : OFF_R + c;
    const int CH = isqk ? 2 * MW : RIN;
    const float* w = (isqk ? P.in[M_CONV] : P.in[R_CONV]) + (size_t)l * 9 * CH;
    const bf16* U = WSP(bf16, WS_U1);
    float acc = 0.f;
    if (q.grid) {
        const int r = t / GW, cc = t % GW, rows = q.T / GW;
        for (int a = 0; a < 3; ++a) for (int b = 0; b < 3; ++b) {
            const int rr = r + a - 1, c2 = cc + b - 1;
            if (rr >= 0 && rr < rows && c2 >= 0 && c2 < GW) acc += w[(a * 3 + b) * CH + c] * bf2f(U[(size_t)(q.base + rr * GW + c2) * PU + ucol]);
        }
    } else {
        for (int b = 0; b < 3; ++b) { const int t2 = t + b - 1; if (t2 >= 0 && t2 < q.T) acc += w[(3 + b) * CH + c] * bf2f(U[(size_t)(q.base + t2) * PU + ucol]); }
    }
    if (isqk) { float v = siluf_(acc); if (c < MW) v *= 0.08838834764831845f; WSP(bf16, WS_QKC)[(size_t)m * (2 * MW) + c] = f2bf(v); }
    else { float v = acc; if (c >= RX_WL && c < RX_AL) v = tanhf(v); else if (c >= RX_GL) v = sigmoidf_(v); WSP(bf16, WS_RXC)[(size_t)m * RIN + c] = f2bf(v); }
}
DEV void k_mlstm(const Params& P, long i) {
    const int e = (int)(i % 128); const int chain = (int)(i / 128); const int dir = chain & 1, head = (chain >> 1) % MH, s = chain / (2 * MH);
    const int l = P.layer; const SeqInfo q = seqinfo(s);
    float C[128], n[128]; float m;
    if (!q.grid) {
#pragma unroll
        for (int d = 0; d < 128; ++d) { C[d] = 0.f; n[d] = 0.f; }
        m = 0.f;
    } else {
        const size_t sb = (((size_t)q.b * DEPTH + l) * 2 + dir) * MH + head;
#pragma unroll
        for (int d = 0; d < 128; ++d) { C[d] = P.in[ST_C][(sb * 128 + d) * 128 + e]; n[d] = P.in[ST_N][sb * 128 + d]; }
        m = P.in[ST_M][sb];
    }
    const float bi = P.in[M_GATE_B][(size_t)l * 4 * MH + (2 * dir) * MH + head], bfg = P.in[M_GATE_B][(size_t)l * 4 * MH + (2 * dir + 1) * MH + head];
    bf16* U = WSP(bf16, WS_U1); const bf16* QK = WSP(bf16, WS_QKC);
    float nsel = 0.f;
    for (int p = 0; p < q.T; ++p) {
        const int t = dir ? q.T - 1 - p : p; const size_t tok = (size_t)(q.base + t);
        const bf16* qk = QK + tok * (2 * MW); bf16* u = U + tok * PU;
        const float gi = bf2f(u[OFF_G + (2 * dir) * MH + head]) + bi, gf = bf2f(u[OFF_G + (2 * dir + 1) * MH + head]) + bfg;
        const float lf = logsigmoidf_(gf);
        const float mn = fmaxf(lf + m, gi); const float fw = expf(lf + m - mn), iw = expf(gi - mn);
        const float v = bf2f(u[OFF_V + head * 128 + e]);
        float num = 0.f, den = 0.f;
#pragma unroll
        for (int d = 0; d < 128; ++d) {
            const float kd = bf2f(qk[MW + head * 128 + d]), qd = bf2f(qk[head * 128 + d]);
            C[d] = fw * C[d] + iw * kd * v; n[d] = fw * n[d] + iw * kd; num += qd * C[d]; den += qd * n[d];
        }
        m = mn;
        u[dir * MW + head * 128 + e] = f2bf(num / fmaxf(fabsf(den), expf(-m)));
    }
    if (!q.grid) {
        const size_t sb = (((size_t)q.b * DEPTH + l) * 2 + dir) * MH + head;
#pragma unroll
        for (int d = 0; d < 128; ++d) { P.out[OUT_C + (sb * 128 + d) * 128 + e] = C[d]; if (d == e) nsel = n[d]; }
        P.out[OUT_N + sb * 128 + e] = nsel;
        if (e == 0) P.out[OUT_M + sb] = m;
    }
}
DEV void k_rwkv_prep(const Params& P, long i) {
    const int c = (int)(i % RW); const size_t tok = (size_t)(i / RW); const int l = P.layer, dir = P.mode;
    const bf16* rx = WSP(bf16, WS_RXC) + tok * RIN;
    const float* w2 = P.in[R_W2] + ((size_t)l * 2 + dir) * 64 * RW + c; const float* a2 = P.in[R_A2] + ((size_t)l * 2 + dir) * 64 * RW + c;
    float wr = P.in[R_W0][((size_t)l * 2 + dir) * RW + c], ar = P.in[R_A0][((size_t)l * 2 + dir) * RW + c];
    for (int j = 0; j < 64; ++j) { wr += bf2f(rx[RX_WL + dir * 64 + j]) * w2[(size_t)j * RW]; ar += bf2f(rx[RX_AL + dir * 64 + j]) * a2[(size_t)j * RW]; }
    bf16* o = WSP(bf16, WS_QKC) + tok * (2 * RW);
    o[c] = f2bf(wr); o[RW + c] = f2bf(ar);
}
DEV void k_rwkv(const Params& P, long i) {
    const int row = (int)(i % 64); const int chain = (int)(i / 64); const int dir = P.mode, head = chain % RH, s = chain / RH;
    const int l = P.layer; const SeqInfo q = seqinfo(s); const int hc = head * 64;
    float S[64];
    if (!q.grid) {
#pragma unroll
        for (int c = 0; c < 64; ++c) S[c] = 0.f;
    } else {
        const size_t sb = (((size_t)q.b * DEPTH + l) * 2 + dir) * RH + head;
#pragma unroll
        for (int c = 0; c < 64; ++c) S[c] = P.in[ST_R][(sb * 64 + row) * 64 + c];
    }
    const float* rkk = P.in[R_KK] + (size_t)l * RW + hc; const float* rka = P.in[R_KA] + (size_t)l * RW + hc;
    bf16* U = WSP(bf16, WS_U1); const bf16* RX = WSP(bf16, WS_RXC); const bf16* WA = WSP(bf16, WS_QKC);
    for (int p = 0; p < q.T; ++p) {
        const int t = dir ? q.T - 1 - p : p; const size_t tok = (size_t)(q.base + t);
        const bf16* rx = RX + tok * RIN; const bf16* wa = WA + tok * (2 * RW);
        float ss = 0.f;
        for (int c = 0; c < 64; ++c) { const float kc = bf2f(rx[RX_K + hc + c]) * rkk[c]; ss += kc * kc; }
        const float inv = 1.0f / fmaxf(sqrtf(ss), 1e-12f);
        float sa = 0.f;
#pragma unroll
        for (int c = 0; c < 64; ++c) sa -= S[c] * (bf2f(rx[RX_K + hc + c]) * rkk[c] * inv);
        const float v = bf2f(rx[RX_V + hc + row]);
        float y = 0.f;
#pragma unroll
        for (int c = 0; c < 64; ++c) {
            const float wr = bf2f(wa[hc + c]), ar = bf2f(wa[RW + hc + c]);
            const float decay = expf(-0.6065306597126334f * sigmoidf_(wr));
            const float alpha = sigmoidf_(ar);
            const float kr = bf2f(rx[RX_K + hc + c]);
            const float kt = kr * (1.0f + (alpha - 1.0f) * rka[c]);
            const float bb = kr * rkk[c] * inv * alpha;
            S[c] = S[c] * decay + sa * bb + v * kt;
            y += S[c] * bf2f(rx[RX_R + hc + c]);
        }
        U[tok * PU + OFF_R + dir * RW + hc + row] = f2bf(y);
    }
    if (!q.grid) {
        const size_t sb = (((size_t)q.b * DEPTH + l) * 2 + dir) * RH + head;
#pragma unroll
        for (int c = 0; c < 64; ++c) P.out[OUT_S + (sb * 64 + row) * 64 + c] = S[c];
    }
}
DEV void k_post(const Params& P, long i) {
    const int ch = (int)(i % D); const size_t m = (size_t)(i / D); const int l = P.layer;
    const bf16* u = WSP(bf16, WS_U1) + m * PU; const bf16* rx = WSP(bf16, WS_RXC) + m * RIN;
    bf16* o = WSP(bf16, WS_QKC) + m * D;
    if (ch < MW) {
        const int h0 = (ch / 128) * 128; float ss = 0.f;
        for (int d = 0; d < 128; ++d) { const float x = bf2f(u[h0 + d]) + bf2f(u[MW + h0 + d]); ss += x * x; }
        const float x = bf2f(u[ch]) + bf2f(u[MW + ch]);
        o[ch] = f2bf(x / sqrtf(ss / 128.f + RMS_EPS) * P.in[M_NORM_G][(size_t)l * MW + ch] * sigmoidf_(bf2f(u[OFF_O + ch])));
    } else {
        const int c = ch - MW; const int h0 = (c / 64) * 64;
        float mu = 0.f, bsum = 0.f;
        for (int d = 0; d < 64; ++d) { mu += bf2f(u[OFF_R + h0 + d]) + bf2f(u[OFF_R + RW + h0 + d]);
            bsum += bf2f(rx[RX_R + h0 + d]) * bf2f(rx[RX_K + h0 + d]) * P.in[R_RK][(size_t)l * RW + h0 + d]; }
        mu *= (1.0f / 64.f); float var = 0.f;
        for (int d = 0; d < 64; ++d) { const float x = bf2f(u[OFF_R + h0 + d]) + bf2f(u[OFF_R + RW + h0 + d]) - mu; var += x * x; }
        var *= (1.0f / 64.f);
        const float y = bf2f(u[OFF_R + c]) + bf2f(u[OFF_R + RW + c]);
        const float yn = (y - mu) / sqrtf(var + GN_EPS) * P.in[R_GN_W][(size_t)l * RW + c] + P.in[R_GN_B][(size_t)l * RW + c];
        float gate = 0.f;
        for (int j = 0; j < 128; ++j) gate += bf2f(rx[RX_GL + j]) * P.in[R_G2][((size_t)l * 128 + j) * RW + c];
        o[ch] = f2bf((yn + bsum * bf2f(rx[RX_V + c])) * gate);
    }
}
DEV void k_final(const Params& P, long m) {
    float* x = P.out + (size_t)m * D; float ss = 0.f;
    for (int k = 0; k < D; ++k) ss += x[k] * x[k];
    const float rs = 1.0f / sqrtf(ss / D + RMS_EPS);
    for (int k = 0; k < D; ++k) x[k] = x[k] * rs * P.in[FINAL_G][k];
}


#ifndef HOST_EMU
typedef const __attribute__((address_space(4))) Params CParams;
namespace pg8 {
#define PG8_LAS __attribute__((address_space(3)))
typedef short bf16x8 __attribute__((ext_vector_type(8)));
typedef float f32x4 __attribute__((ext_vector_type(4)));
typedef unsigned u32x4 __attribute__((ext_vector_type(4)));
constexpr int BM = 256, BK = 64, HALF = 128, HTB = HALF * BK * 2, STAGE_BYTES = 8 * HTB, NXCD = 8, WGM = 8;
__device__ __forceinline__ int lds_byte(int r, int c) { const int st = (r >> 4) * 2 + (c >> 5), rr = r & 15, cc = c & 31, ob = rr * 64 + cc * 2; return st * 1024 + (ob ^ (((ob >> 9) & 1) << 5)); }
__device__ __forceinline__ void stage_rc(int b, int& R, int& C) { const int st = b / 1024, sb = b % 1024, swz = sb ^ (((sb >> 9) & 1) << 5); R = (st >> 1) * 16 + swz / 64; C = (st & 1) * 32 + (swz % 64) / 2; }
struct Unit { int pm, pn, aoff; };
struct Gemm { const bf16* A; const bf16* Bt; int K, lda; };
struct StaticOrder {
    int nM, nN, nwg, G, c;
    __device__ __forceinline__ void init(int M, int N, int G_, int c_) { nM = M / BM; nN = N / BM; nwg = nM * nN; G = G_; c = c_; }
    __device__ __forceinline__ bool next(int i, Unit& u) const {
        const long L = (long)i * G + c; if (L >= nwg) return false;
        int wgid = (int)L; { const int q = nwg / NXCD, r = nwg % NXCD, xcd = wgid % NXCD, off = wgid / NXCD; wgid = (xcd < r ? xcd * (q + 1) : r * (q + 1) + (xcd - r) * q) + off; }
        const int nig = WGM * nN, gid = wgid / nig, fm = gid * WGM, gsz = (nM - fm) < WGM ? (nM - fm) : WGM;
        u.pm = fm + ((wgid % nig) % gsz); u.pn = (wgid % nig) / gsz; u.aoff = 0; return true;
    }
};
struct PairOrder {
    int nbase, G, v, nct;
    __device__ __forceinline__ void init(int M, int G_, int c_) { nct = D / BM; nbase = (M / BM) * nct; G = G_; v = (G_ % 8 == 0) ? (c_ % 8) * (G_ / 8) + c_ / 8 : c_; }
    __device__ __forceinline__ bool next(int i, Unit& u) const {
        const int j = v + (i >> 1) * G; if (j >= nbase) return false;
        const int half = i & 1; u.pm = j / nct; u.pn = half * nct + (j % nct); u.aoff = half * MW; return true;
    }
};
typedef float f32x2_t __attribute__((ext_vector_type(2)));
typedef __bf16 bf16x2_t __attribute__((ext_vector_type(2)));
__device__ __forceinline__ unsigned cvt_pk_bf16(float lo, float hi) { f32x2_t v = {lo, hi}; bf16x2_t b = __builtin_convertvector(v, bf16x2_t); return __builtin_bit_cast(unsigned, b); }
__device__ __forceinline__ float fsigmoid(float x) { return __builtin_amdgcn_rcpf(1.0f + __expf(-x)); }
__device__ __forceinline__ float bflo(unsigned w) { return __builtin_bit_cast(float, w << 16); }
__device__ __forceinline__ float bfhi(unsigned w) { return __builtin_bit_cast(float, w & 0xffff0000u); }

struct EpiA1 {
    bf16* U;
    __device__ __forceinline__ void operator()(const f32x4 (&acc)[2][2][4][2], const Unit& u, int wr, int wc, int fr, int fq) const {
        const int row0 = u.pm * BM + wr * 64 + fr, col0 = u.pn * BM + wc * 32 + 8 * fq;
#pragma unroll
        for (int ai = 0; ai < 2; ++ai)
#pragma unroll
            for (int m = 0; m < 4; ++m) { bf16* rowp = U + (size_t)(row0 + ai * HALF + m * 16) * PU + col0;
#pragma unroll
                for (int bj = 0; bj < 2; ++bj) { if (col0 + bj * HALF < N1) { const f32x4 v0 = acc[ai][bj][m][0], v1 = acc[ai][bj][m][1];
                    u32x4 w; w.x = cvt_pk_bf16(v0[0], v0[1]); w.y = cvt_pk_bf16(v0[2], v0[3]); w.z = cvt_pk_bf16(v1[0], v1[1]); w.w = cvt_pk_bf16(v1[2], v1[3]);
                    *(u32x4*)(rowp + bj * HALF) = w; } } }
    }
};
struct EpiA2 {
    bf16* U;
    __device__ __forceinline__ void operator()(const f32x4 (&acc)[2][2][4][2], const Unit& u, int wr, int wc, int fr, int fq) const {
        const int row0 = u.pm * BM + wr * 64 + fr, col0 = D + u.pn * BM + wc * 32 + 8 * fq;
#pragma unroll
        for (int ai = 0; ai < 2; ++ai)
#pragma unroll
            for (int m = 0; m < 4; ++m) { bf16* rowp = U + (size_t)(row0 + ai * HALF + m * 16) * PU + col0;
#pragma unroll
                for (int bj = 0; bj < 2; ++bj) { const f32x4 v0 = acc[ai][bj][m][0], v1 = acc[ai][bj][m][1];
                    u32x4 w; w.x = cvt_pk_bf16(fsigmoid(v0[0]), fsigmoid(v0[1])); w.y = cvt_pk_bf16(fsigmoid(v0[2]), fsigmoid(v0[3]));
                    w.z = cvt_pk_bf16(fsigmoid(v1[0]), fsigmoid(v1[1])); w.w = cvt_pk_bf16(fsigmoid(v1[2]), fsigmoid(v1[3]));
                    *(u32x4*)(rowp + bj * HALF) = w; } }
    }
};
struct EpiPJ {
    bf16* U;
    __device__ __forceinline__ void operator()(const f32x4 (&acc)[2][2][4][2], const Unit& u, int wr, int wc, int fr, int fq) const {
        const int nct = D / BM, half = u.pn >= nct ? 1 : 0, ct = u.pn - half * nct;
        const int row0 = u.pm * BM + wr * 64 + fr, col0 = ct * BM + wc * 32 + 8 * fq;
#pragma unroll
        for (int ai = 0; ai < 2; ++ai)
#pragma unroll
            for (int m = 0; m < 4; ++m) { bf16* rowp = U + (size_t)(row0 + ai * HALF + m * 16) * PU + col0;
#pragma unroll
                for (int bj = 0; bj < 2; ++bj) { const f32x4 v0 = acc[ai][bj][m][0], v1 = acc[ai][bj][m][1];
                    const u32x4 g = *(const u32x4*)(rowp + (1 + half) * D + bj * HALF);
                    float o[8] = { bflo(g.x) * v0[0], bfhi(g.x) * v0[1], bflo(g.y) * v0[2], bfhi(g.y) * v0[3], bflo(g.z) * v1[0], bfhi(g.z) * v1[1], bflo(g.w) * v1[2], bfhi(g.w) * v1[3] };
                    if (half) { const u32x4 p = *(const u32x4*)(rowp + bj * HALF);
                        o[0] += bflo(p.x); o[1] += bfhi(p.x); o[2] += bflo(p.y); o[3] += bfhi(p.y); o[4] += bflo(p.z); o[5] += bfhi(p.z); o[6] += bflo(p.w); o[7] += bfhi(p.w); }
                    u32x4 w; w.x = cvt_pk_bf16(o[0], o[1]); w.y = cvt_pk_bf16(o[2], o[3]); w.z = cvt_pk_bf16(o[4], o[5]); w.w = cvt_pk_bf16(o[6], o[7]);
                    *(u32x4*)(rowp + bj * HALF) = w; }
                asm volatile("" ::: "memory"); }
    }
};
struct EpiRes {
    float* X; const float* gate;
    const float* sa; const float* sb;
    __device__ __forceinline__ void operator()(const f32x4 (&acc)[2][2][4][2], const Unit& u, int wr, int wc, int fr, int fq) const {
        const int row0 = u.pm * BM + wr * 64 + fr, col0 = u.pn * BM + wc * 32 + 4 * fq;
        const float* S = sa ? (u.pm * BM < NC ? sa : sb - (size_t)NC * D) : X;
        const int cond = seqinfo(seq_of_token(u.pm * BM)).cond;
        const float* gp = gate + (size_t)cond * 6 * D + col0;
        f32x4 gv[2][2];
#pragma unroll
        for (int bj = 0; bj < 2; ++bj)
#pragma unroll
            for (int n = 0; n < 2; ++n) gv[bj][n] = *(const f32x4*)(gp + bj * HALF + n * 16);
#pragma unroll
        for (int ai = 0; ai < 2; ++ai)
#pragma unroll
            for (int m = 0; m < 4; ++m) { const size_t ro = (size_t)(row0 + ai * HALF + m * 16) * D + col0; float* rowp = X + ro; const float* srow = S + ro;
#pragma unroll
                for (int bj = 0; bj < 2; ++bj)
#pragma unroll
                    for (int n = 0; n < 2; ++n) { *(f32x4*)(rowp + bj * HALF + n * 16) = *(const f32x4*)(srow + bj * HALF + n * 16) + gv[bj][n] * acc[ai][bj][m][n]; }
                asm volatile("" ::: "memory"); }
    }
};
typedef unsigned u32x2 __attribute__((ext_vector_type(2)));
constexpr int CW_NX = 45056, CW_NX_STRIDE = 16, NX_EXCH_BYTE = 512 * 1024, NX_LDS = 131072;
struct EpiResNorm {
    float* X; const float* gate; const float* sa; const float* sb;
    int fuse;
    const float* ng; const float* nmod;
    bf16* H;
    unsigned char* ctlb; unsigned epoch; PG8_LAS unsigned char* lds;
    __device__ __forceinline__ void operator()(const f32x4 (&acc_)[2][2][4][2], const Unit& u, int wr, int wc, int fr, int fq) const {
        f32x4 (&acc)[2][2][4][2] = const_cast<f32x4 (&)[2][2][4][2]>(acc_);
        const int tid = threadIdx.x;
        const int row0 = u.pm * BM + wr * 64 + fr, col0 = u.pn * BM + wc * 32 + 4 * fq;
        const int cond = seqinfo(seq_of_token(u.pm * BM)).cond;
        const float* S = sa ? (u.pm * BM < NC ? sa : sb - (size_t)NC * D) : X;
        { const float* gp = gate + (size_t)cond * 6 * D + col0;
          f32x4 gv[2][2];
#pragma unroll
          for (int bj = 0; bj < 2; ++bj)
#pragma unroll
              for (int n = 0; n < 2; ++n) gv[bj][n] = *(const f32x4*)(gp + bj * HALF + n * 16);
#pragma unroll
          for (int ai = 0; ai < 2; ++ai)
#pragma unroll
              for (int m = 0; m < 4; ++m) { const size_t ro = (size_t)(row0 + ai * HALF + m * 16) * D + col0; float* rowp = X + ro; const float* srow = S + ro;
#pragma unroll
                  for (int bj = 0; bj < 2; ++bj)
#pragma unroll
                      for (int n = 0; n < 2; ++n) { const f32x4 xn = *(const f32x4*)(srow + bj * HALF + n * 16) + gv[bj][n] * acc[ai][bj][m][n]; acc[ai][bj][m][n] = xn;
                          if (!fuse || H) *(f32x4*)(rowp + bj * HALF + n * 16) = xn; }
                  asm volatile("" ::: "memory"); } }
        if (!fuse) return;
        PG8_LAS float* red = (PG8_LAS float*)(lds + NX_LDS); PG8_LAS float* rsl = red + 1024;
#pragma unroll
        for (int ai = 0; ai < 2; ++ai)
#pragma unroll
            for (int m = 0; m < 4; ++m) { float sacc = 0.f;
#pragma unroll
                for (int bj = 0; bj < 2; ++bj)
#pragma unroll
                    for (int n = 0; n < 2; ++n) { const f32x4 v = acc[ai][bj][m][n]; sacc += (v[0] * v[0] + v[1] * v[1]) + (v[2] * v[2] + v[3] * v[3]); }
                sacc += __shfl_xor(sacc, 16); sacc += __shfl_xor(sacc, 32);
                if (fq == 0) red[(ai * HALF + wr * 64 + m * 16 + fr) * 4 + wc] = sacc; }
        __syncthreads();
        unsigned* flags = (unsigned*)ctlb + CW_NX; float* exch = (float*)(ctlb + NX_EXCH_BYTE);
        float mine = 0.f;
        if (tid < BM) { const f32x4 r4 = *(const PG8_LAS f32x4*)(red + tid * 4); mine = (r4[0] + r4[1]) + (r4[2] + r4[3]);
            float* gp = exch + ((size_t)(u.pm * 4 + u.pn) * BM + tid);
            asm volatile("global_store_dword %0, %1, off sc1" :: "v"(gp), "v"(mine) : "memory"); }
        asm volatile("s_waitcnt vmcnt(0)" ::: "memory");
        __syncthreads();
        if (tid == 0) {
            __hip_atomic_store(flags + (u.pm * 4 + u.pn) * CW_NX_STRIDE, epoch, __ATOMIC_RELAXED, __HIP_MEMORY_SCOPE_AGENT);
            unsigned* tmo = (unsigned*)ctlb + 4096 + 128;
#pragma unroll 1
            for (int q = 0; q < 4; ++q) { if (q == u.pn) continue; unsigned sp = 0;
                while (__hip_atomic_load(flags + (u.pm * 4 + q) * CW_NX_STRIDE, __ATOMIC_RELAXED, __HIP_MEMORY_SCOPE_AGENT) < epoch) { __builtin_amdgcn_s_sleep(1);
                    if ((++sp & 255u) == 0u) { if (__hip_atomic_load(tmo, __ATOMIC_RELAXED, __HIP_MEMORY_SCOPE_AGENT)) break; if (sp > (1u << 18)) { atomicAdd(tmo, 1u); break; } } } }
            __builtin_amdgcn_fence(__ATOMIC_ACQUIRE, "agent");
        }
        asm volatile("s_waitcnt vmcnt(0)" ::: "memory");
        __syncthreads();
        if (tid < BM) { float tot = mine;
#pragma unroll
            for (int q = 0; q < 4; ++q) if (q != u.pn) tot += exch[(size_t)(u.pm * 4 + q) * BM + tid];
            rsl[tid] = 1.0f / sqrtf(tot * (1.0f / D) + 1e-6f); }
        __syncthreads();
        f32x4 g4[2][2], sc4[2][2], sh4[2][2];
#pragma unroll
        for (int bj = 0; bj < 2; ++bj)
#pragma unroll
            for (int n = 0; n < 2; ++n) { const int c = col0 + bj * HALF + n * 16; g4[bj][n] = *(const f32x4*)(ng + c);
                if (nmod) { sh4[bj][n] = *(const f32x4*)(nmod + (size_t)cond * 6 * D + c); sc4[bj][n] = *(const f32x4*)(nmod + (size_t)cond * 6 * D + D + c) + 1.0f; g4[bj][n] = g4[bj][n] * sc4[bj][n]; }
                else sh4[bj][n] = (f32x4){0.f, 0.f, 0.f, 0.f}; }
#pragma unroll
        for (int ai = 0; ai < 2; ++ai)
#pragma unroll
            for (int m = 0; m < 4; ++m) { const int rl = ai * HALF + wr * 64 + m * 16 + fr; const float r = rsl[rl]; const size_t ro = (size_t)(u.pm * BM + rl) * D + col0;
#pragma unroll
                for (int bj = 0; bj < 2; ++bj)
#pragma unroll
                    for (int n = 0; n < 2; ++n) { const f32x4 y = acc[ai][bj][m][n] * r * g4[bj][n] + sh4[bj][n];
                        if (H) { u32x2 pk; pk.x = cvt_pk_bf16(y[0], y[1]); pk.y = cvt_pk_bf16(y[2], y[3]); *(u32x2*)(H + ro + bj * HALF + n * 16) = pk; }
                        else *(f32x4*)(X + ro + bj * HALF + n * 16) = y; } }
    }
};
struct EpiF1 {
    bf16* Hd;
    __device__ __forceinline__ void operator()(const f32x4 (&acc)[2][2][4][2], const Unit& u, int wr, int wc, int fr, int fq) const {
        const int row0 = u.pm * BM + wr * 64 + fr, col0 = u.pn * HALF + wc * 32 + 8 * fq;
#pragma unroll
        for (int ai = 0; ai < 2; ++ai)
#pragma unroll
            for (int m = 0; m < 4; ++m) { bf16* rowp = Hd + (size_t)(row0 + ai * HALF + m * 16) * FF + col0;
                float o[8];
#pragma unroll
                for (int n = 0; n < 2; ++n)
#pragma unroll
                    for (int e = 0; e < 4; ++e) { const float a = acc[ai][0][m][n][e], b = acc[ai][1][m][n][e]; o[n * 4 + e] = a * fsigmoid(a) * b; }
                u32x4 w; w.x = cvt_pk_bf16(o[0], o[1]); w.y = cvt_pk_bf16(o[2], o[3]); w.z = cvt_pk_bf16(o[4], o[5]); w.w = cvt_pk_bf16(o[6], o[7]);
                *(u32x4*)rowp = w; }
    }
};

template <class Epi, class Sched, bool ALIGN_EPI = true, bool SP2 = true>
__device__ __forceinline__ void gemm_phase(PG8_LAS unsigned char* lds, const Gemm g, const Sched& S, const Epi& E) {
    const int tid = threadIdx.x, wid = __builtin_amdgcn_readfirstlane(tid >> 6), lane = tid & 63, wr = wid >> 2, wc = wid & 3, fr = lane & 15, fq = lane >> 4;
    const int K = g.K, nt = K / BK;
    unsigned voffA[2], voffB[2];
#pragma unroll
    for (int i = 0; i < 2; ++i) { int R, C; stage_rc(tid * 16 + i * 8192, R, C);
        voffA[i] = (unsigned)(R * g.lda + C) * 2u; voffB[i] = (unsigned)(R * K + C) * 2u; }
    const size_t kstep = (size_t)(BK * 2);
    const size_t hstepA = (size_t)HALF * g.lda * 2, hstepB = (size_t)HALF * K * 2;
    const size_t tstepA = 2 * hstepA, tstepB = 2 * hstepB;
    const unsigned ldsw = (unsigned)wid * 1024u;
    const int aoff = lds_byte(wr * 64 + fr, fq * 8), boff = lds_byte(wc * 32 + fr, fq * 8);
#define PG8_SA(b, h) (((b) * 2 + (h)) * HTB)
#define PG8_SB(b, h) ((4 + (b) * 2 + (h)) * HTB)
#define PG8_STAGE(bufoff, gbase, voff) do { _Pragma("unroll") for (int _i = 0; _i < 2; ++_i) \
        __builtin_amdgcn_global_load_lds((const unsigned*)((const char*)(gbase) + (voff)[_i]), (PG8_LAS unsigned*)(lds + (bufoff) + ldsw + _i * 8192), 16, 0, 0); } while (0)
#define PG8_LDA(dst, b, h) do { _Pragma("unroll") for (int m = 0; m < 4; ++m) _Pragma("unroll") for (int k = 0; k < 2; ++k) dst[m][k] = *(const PG8_LAS bf16x8*)(lds + PG8_SA(b, h) + aoff + m * 2048 + k * 1024); } while (0)
#define PG8_LDB(dst, b, h) do { _Pragma("unroll") for (int n = 0; n < 2; ++n) _Pragma("unroll") for (int k = 0; k < 2; ++k) dst[n][k] = *(const PG8_LAS bf16x8*)(lds + PG8_SB(b, h) + boff + n * 2048 + k * 1024); } while (0)
#define PG8_MMA(ai, bj, At, Bt) do { __builtin_amdgcn_s_setprio(1); _Pragma("unroll") for (int m = 0; m < 4; ++m) _Pragma("unroll") for (int n = 0; n < 2; ++n) _Pragma("unroll") for (int k = 0; k < 2; ++k) \
        acc[ai][bj][m][n] = __builtin_amdgcn_mfma_f32_16x16x32_bf16(Bt[n][k], At[m][k], acc[ai][bj][m][n], 0, 0, 0); __builtin_amdgcn_s_setprio(0); } while (0)
#define PG8_WAIT_V(n) asm volatile("s_waitcnt vmcnt(" #n ")" ::: "memory")
#define PG8_WAIT_L(n) asm volatile("s_waitcnt lgkmcnt(" #n ")" ::: "memory")
#define PG8_BAR __builtin_amdgcn_s_barrier()
#define PG8_SCHED __builtin_amdgcn_sched_barrier(0)
    Unit cur, nxt; int ui = 0;
    if (!S.next(0, cur)) return;
    f32x4 acc[2][2][4][2];
#pragma unroll
    for (int a = 0; a < 2; ++a)
#pragma unroll
        for (int b = 0; b < 2; ++b)
#pragma unroll
            for (int m = 0; m < 4; ++m)
#pragma unroll
                for (int n = 0; n < 2; ++n) acc[a][b][m][n] = (f32x4){0.f, 0.f, 0.f, 0.f};
    bf16x8 At[4][2], B0[2][2], B1[2][2];
    const char* cA = (const char*)g.A + (size_t)cur.pm * tstepA + (size_t)cur.aoff * 2; const char* cB = (const char*)g.Bt + (size_t)cur.pn * tstepB;
    if constexpr (SP2) {
        PG8_STAGE(PG8_SB(0, 0), cB, voffB); PG8_STAGE(PG8_SB(0, 1), cB + hstepB, voffB); PG8_STAGE(PG8_SA(0, 0), cA, voffA); PG8_STAGE(PG8_SA(0, 1), cA + hstepA, voffA);
        if (wr == 1) PG8_BAR;
        PG8_WAIT_V(2); PG8_BAR;
        PG8_STAGE(PG8_SB(1, 0), cB + kstep, voffB); PG8_STAGE(PG8_SA(1, 0), cA + kstep, voffA); PG8_STAGE(PG8_SB(1, 1), cB + hstepB + kstep, voffB);
        PG8_WAIT_V(6); PG8_BAR;
    } else {
        PG8_STAGE(PG8_SB(0, 0), cB, voffB); PG8_STAGE(PG8_SA(0, 0), cA, voffA); PG8_STAGE(PG8_SB(0, 1), cB + hstepB, voffB); PG8_STAGE(PG8_SA(0, 1), cA + hstepA, voffA);
        if (wr == 1) PG8_BAR;
        PG8_WAIT_V(4); PG8_BAR;
        PG8_STAGE(PG8_SB(1, 0), cB + kstep, voffB); PG8_STAGE(PG8_SA(1, 0), cA + kstep, voffA); PG8_STAGE(PG8_SB(1, 1), cB + hstepB + kstep, voffB);
        PG8_WAIT_V(6); PG8_BAR;
    }
    for (;;) {
        const bool has_next = S.next(ui + 1, nxt);
        const char* nA = has_next ? (const char*)g.A + (size_t)nxt.pm * tstepA + (size_t)nxt.aoff * 2 : cA; const char* nB = has_next ? (const char*)g.Bt + (size_t)nxt.pn * tstepB : cB;
        for (int t = 0; t < nt; t += 2) {
            const bool last = (t == nt - 2);
            const char* a1 = cA + (size_t)(t + 1) * kstep;
            const char* a2 = last ? nA : cA + (size_t)(t + 2) * kstep; const char* b2 = last ? nB : cB + (size_t)(t + 2) * kstep;
            const char* a3 = a2 + kstep; const char* b3 = b2 + kstep;
            if constexpr (SP2) {
            PG8_LDB(B0, 0, 0); PG8_LDB(B1, 0, 1); PG8_SCHED; PG8_LDA(At, 0, 0); PG8_STAGE(PG8_SA(1, 1), a1 + hstepA, voffA);
            PG8_WAIT_V(8); PG8_WAIT_L(0); PG8_BAR; PG8_MMA(0, 0, At, B0); PG8_MMA(0, 1, At, B1); PG8_BAR; PG8_SCHED;
            PG8_LDA(At, 0, 1); PG8_STAGE(PG8_SB(0, 0), b2, voffB); PG8_STAGE(PG8_SB(0, 1), b2 + hstepB, voffB); PG8_STAGE(PG8_SA(0, 0), a2, voffA);
            PG8_WAIT_V(8); PG8_WAIT_L(0); PG8_BAR; PG8_MMA(1, 0, At, B0); PG8_MMA(1, 1, At, B1); PG8_BAR; PG8_SCHED;
            PG8_LDB(B0, 1, 0); PG8_LDB(B1, 1, 1); PG8_SCHED; PG8_LDA(At, 1, 0); PG8_STAGE(PG8_SA(0, 1), a2 + hstepA, voffA);
            PG8_WAIT_V(8); PG8_WAIT_L(0); PG8_BAR; PG8_MMA(0, 0, At, B0); PG8_MMA(0, 1, At, B1); PG8_BAR; PG8_SCHED;
            PG8_LDA(At, 1, 1); PG8_STAGE(PG8_SB(1, 0), b3, voffB); PG8_STAGE(PG8_SB(1, 1), b3 + hstepB, voffB); PG8_STAGE(PG8_SA(1, 0), a3, voffA);
            PG8_WAIT_V(8); PG8_WAIT_L(0); PG8_BAR; PG8_MMA(1, 0, At, B0); PG8_MMA(1, 1, At, B1); PG8_BAR; PG8_SCHED;
            } else {
            PG8_LDB(B0, 0, 0); PG8_SCHED; PG8_LDA(At, 0, 0); PG8_STAGE(PG8_SA(1, 1), a1 + hstepA, voffA);
            PG8_WAIT_L(8); PG8_BAR; PG8_WAIT_L(0); PG8_MMA(0, 0, At, B0); PG8_BAR; PG8_SCHED;
            PG8_LDB(B1, 0, 1); PG8_STAGE(PG8_SB(0, 0), b2, voffB);
            PG8_BAR; PG8_WAIT_L(0); PG8_MMA(0, 1, At, B1); PG8_BAR;
            PG8_LDA(At, 0, 1); PG8_STAGE(PG8_SA(0, 0), a2, voffA);
            PG8_BAR; PG8_WAIT_L(0); PG8_MMA(1, 0, At, B0); PG8_BAR; PG8_SCHED;
            PG8_STAGE(PG8_SB(0, 1), b2 + hstepB, voffB);
            PG8_WAIT_V(6); PG8_BAR; PG8_MMA(1, 1, At, B1); PG8_BAR;
            PG8_LDB(B0, 1, 0); PG8_SCHED; PG8_LDA(At, 1, 0); PG8_STAGE(PG8_SA(0, 1), a2 + hstepA, voffA);
            PG8_WAIT_L(8); PG8_BAR; PG8_WAIT_L(0); PG8_MMA(0, 0, At, B0); PG8_BAR; PG8_SCHED;
            PG8_LDB(B1, 1, 1); PG8_STAGE(PG8_SB(1, 0), b3, voffB);
            PG8_BAR; PG8_WAIT_L(0); PG8_MMA(0, 1, At, B1); PG8_BAR;
            PG8_LDA(At, 1, 1); PG8_STAGE(PG8_SA(1, 0), a3, voffA);
            PG8_BAR; PG8_WAIT_L(0); PG8_MMA(1, 0, At, B0); PG8_BAR; PG8_SCHED;
            PG8_STAGE(PG8_SB(1, 1), b3 + hstepB, voffB);
            PG8_WAIT_V(6); PG8_BAR; PG8_MMA(1, 1, At, B1); PG8_BAR;
            }
        }
        if constexpr (ALIGN_EPI) { if (wr == 0) PG8_BAR; }
        E(acc, cur, wr, wc, fr, fq);
        if (!has_next) break;
#pragma unroll
        for (int a = 0; a < 2; ++a)
#pragma unroll
            for (int b = 0; b < 2; ++b)
#pragma unroll
                for (int m = 0; m < 4; ++m)
#pragma unroll
                    for (int n = 0; n < 2; ++n) acc[a][b][m][n] = (f32x4){0.f, 0.f, 0.f, 0.f};
        cur = nxt; cA = nA; cB = nB; ++ui;
        if constexpr (ALIGN_EPI) { if (wr == 1) PG8_BAR; }
    }
    PG8_WAIT_V(0);
    if constexpr (!ALIGN_EPI) { if (wr == 0) PG8_BAR; }
    PG8_BAR;
#undef PG8_SA
#undef PG8_SB
#undef PG8_STAGE
#undef PG8_LDA
#undef PG8_LDB
#undef PG8_MMA
#undef PG8_WAIT_V
#undef PG8_WAIT_L
#undef PG8_BAR
#undef PG8_SCHED
}
}


#define LDS_BARRIER() do { asm volatile("s_waitcnt lgkmcnt(0)" ::: "memory"); __builtin_amdgcn_s_barrier(); asm volatile("" ::: "memory"); } while (0)
namespace ml {
#define LAS __attribute__((address_space(3)))
typedef short bf16x8 __attribute__((ext_vector_type(8)));
typedef float f32x4 __attribute__((ext_vector_type(4)));
typedef unsigned u32x4 __attribute__((ext_vector_type(4)));
constexpr int NVB = 4, EV = MD / NVB;
constexpr int PQ = 272, PT = 144;
constexpr int L_QS = 0, L_KS = L_QS + 64 * PQ, L_KT = L_KS + 64 * PQ, L_VT = L_KT + 128 * PT, L_SB = L_VT + 48 * PT, L_CT = L_SB + 64 * PT,
              L_HS = L_CT + 48 * PQ, L_SC = L_HS + 64 * 80, L_END = L_SC + 4096;
static_assert(L_END <= 131072, "mLSTM LDS map");
enum { SC_A = 0, SC_PM = 64, SC_WI = 128, SC_EMT = 192, SC_WE = 256, SC_DEN = 320, SC_MISC = 384 };
__device__ __forceinline__ f32x4 mma(bf16x8 a, bf16x8 b, f32x4 c) { return __builtin_amdgcn_mfma_f32_16x16x32_bf16(a, b, c, 0, 0, 0); }
__device__ __forceinline__ bf16x8 frag(LAS unsigned char* lds, int base, int pitch, int row0, int k0, int lane) {
    return *(const LAS bf16x8*)(lds + base + (row0 + (lane & 15)) * pitch + (k0 + 8 * (lane >> 4)) * 2);
}
template <int N> __device__ __forceinline__ float dpp_row_shr(float x, float ident) {
    return __builtin_bit_cast(float, __builtin_amdgcn_update_dpp(__builtin_bit_cast(int, ident), __builtin_bit_cast(int, x), 0x110 + N, 0xf, 0xf, false));
}
__device__ __forceinline__ float lane_get(float x, int l) { return __builtin_bit_cast(float, __builtin_amdgcn_readlane(__builtin_bit_cast(int, x), l)); }
__device__ __forceinline__ float wave_scan_add(float x, int lane) {
    x += dpp_row_shr<1>(x, 0.f); x += dpp_row_shr<2>(x, 0.f); x += dpp_row_shr<4>(x, 0.f); x += dpp_row_shr<8>(x, 0.f);
    const float t0 = lane_get(x, 15), t1 = lane_get(x, 31), t2 = lane_get(x, 47); const int row = lane >> 4;
    return x + ((row >= 1 ? t0 : 0.f) + (row >= 2 ? t1 : 0.f) + (row >= 3 ? t2 : 0.f));
}
__device__ __forceinline__ float wave_scan_max(float x, int lane) {
    constexpr float NI = -3.0e38f;
    x = fmaxf(x, dpp_row_shr<1>(x, NI)); x = fmaxf(x, dpp_row_shr<2>(x, NI)); x = fmaxf(x, dpp_row_shr<4>(x, NI)); x = fmaxf(x, dpp_row_shr<8>(x, NI));
    const float t0 = lane_get(x, 15), t1 = lane_get(x, 31), t2 = lane_get(x, 47); const int row = lane >> 4;
    return fmaxf(fmaxf(x, row >= 1 ? t0 : NI), fmaxf(row >= 2 ? t1 : NI, row >= 3 ? t2 : NI));
}
__device__ __forceinline__ void mlstm_item(LAS unsigned char* lds, CParams& P, int l, int s, int head, int dir, int vb) {
    const int tid = threadIdx.x, w = __builtin_amdgcn_readfirstlane(tid >> 6), lane = tid & 63, fr = lane & 15, fq = lane >> 4;
    const int rt = w & 3, half = w >> 2;
    const SeqInfo q = seqinfo(s); const int nchunk = q.T / 64;
    const bf16* QK = WSP(bf16, WS_QKC); bf16* U = WSP(bf16, WS_U1);
    LAS float* SC = (LAS float*)(lds + L_SC);
    f32x4 cacc[3];
    float m_prev;
    if (!q.grid) { cacc[0] = cacc[1] = cacc[2] = (f32x4){0.f, 0.f, 0.f, 0.f}; m_prev = 0.f; }
    else {
        const size_t sb = (((size_t)q.b * DEPTH + l) * 2 + dir) * MH + head; const int d = 16 * w + fr;
#pragma unroll
        for (int et = 0; et < 2; ++et)
#pragma unroll
            for (int r = 0; r < 4; ++r) cacc[et][r] = P.in[ST_C][(sb * 128 + d) * 128 + vb * EV + 16 * et + 4 * fq + r];
        cacc[2] = (f32x4){0.f, 0.f, 0.f, 0.f}; if (fq == 0) cacc[2][0] = P.in[ST_N][sb * 128 + d];
        m_prev = P.in[ST_M][sb];
    }
    const float bi = P.in[M_GATE_B][(size_t)l * 4 * MH + (2 * dir) * MH + head], bfg = P.in[M_GATE_B][(size_t)l * 4 * MH + (2 * dir + 1) * MH + head];
    for (int i = tid; i < 16 * 64; i += 512) { const int r = i >> 6, c = i & 63; *(LAS bf16*)(lds + L_VT + (32 + r) * PT + c * 2) = (r == 0) ? (bf16)0x3f80 : (bf16)0; }
    u32x4 pqk[4]; u32x4 pv; bf16 pgi = 0, pgf = 0;
#define ML_TOK(c, j) ((size_t)(q.base + (dir ? q.T - 1 - ((c) * 64 + (j)) : ((c) * 64 + (j)))))
#define ML_PREFETCH(c) do { _Pragma("unroll") for (int i = 0; i < 4; ++i) { const int id = tid + 512 * i, j = id >> 5, pc = id & 31; \
            pqk[i] = *(const u32x4*)(QK + ML_TOK(c, j) * (2 * MW) + (pc < 16 ? head * 128 + 8 * pc : MW + head * 128 + 8 * (pc - 16))); } \
        if (tid < 256) { const int j = tid >> 2, pc = tid & 3; pv = *(const u32x4*)(U + ML_TOK(c, j) * PU + OFF_V + head * 128 + vb * EV + 8 * pc); } \
        if (w == 0) { const bf16* g = U + ML_TOK(c, lane) * PU + OFF_G; pgi = g[(2 * dir) * MH + head]; pgf = g[(2 * dir + 1) * MH + head]; } } while (0)
    ML_PREFETCH(0);
    for (int c = 0; c < nchunk; ++c) {
#pragma unroll
        for (int i = 0; i < 4; ++i) { const int id = tid + 512 * i, j = id >> 5, pc = id & 31;
            *(LAS u32x4*)(lds + (pc < 16 ? L_QS : L_KS) + j * PQ + (pc & 15) * 16) = pqk[i]; }
        if (tid < 256) { const int j = tid >> 2, pc = tid & 3; const unsigned wv[4] = {pv.x, pv.y, pv.z, pv.w};
#pragma unroll
            for (int e = 0; e < 8; ++e) *(LAS bf16*)(lds + L_VT + (8 * pc + e) * PT + j * 2) = (bf16)((wv[e >> 1] >> ((e & 1) * 16)) & 0xffffu); }
#pragma unroll
        for (int et = 0; et < 3; ++et)
#pragma unroll
            for (int r = 0; r < 4; ++r) *(LAS bf16*)(lds + L_CT + (16 * et + 4 * fq + r) * PQ + (16 * w + fr) * 2) = f2bf(cacc[et][r]);
        float wie = 1.f;
        if (w == 0) {
            const float gi = bf2f(pgi) + bi, gf = bf2f(pgf) + bfg;
            const float lf = fminf(gf, 0.f) - log1pf(__expf(-fabsf(gf)));
            const float b = wave_scan_add(lf, lane);
            const float a = gi - b; float pm = wave_scan_max(a, lane);
            pm = fmaxf(pm, m_prev);
            const float pm63 = lane_get(pm, 63), b63 = lane_get(b, 63);
            SC[SC_A + lane] = a; SC[SC_PM + lane] = pm; SC[SC_WI + lane] = __expf(m_prev - pm); SC[SC_EMT + lane] = __expf(-(b + pm)); SC[SC_WE + lane] = __expf(a - pm63);
            if (lane == 0) { SC[SC_MISC] = __expf(m_prev - pm63); SC[SC_MISC + 1] = b63 + pm63; }
        }
        LDS_BARRIER();
        if (c + 1 < nchunk) ML_PREFETCH(c + 1);
        wie = SC[SC_MISC]; m_prev = SC[SC_MISC + 1];
#pragma unroll
        for (int i = 0; i < 2; ++i) { const int id = tid + 512 * i, j = id & 63, pc = id >> 6; const float we = SC[SC_WE + j];
            const u32x4 kv = *(const LAS u32x4*)(lds + L_KS + j * PQ + pc * 16); const unsigned wv[4] = {kv.x, kv.y, kv.z, kv.w};
#pragma unroll
            for (int e = 0; e < 8; ++e) { const float kf = __builtin_bit_cast(float, (e & 1) ? (wv[e >> 1] & 0xffff0000u) : (wv[e >> 1] << 16));
                *(LAS bf16*)(lds + L_KT + (8 * pc + e) * PT + j * 2) = f2bf(kf * we); } }
#pragma unroll
        for (int cc = 0; cc < 2; ++cc) { const int ct = 2 * half + cc;
            f32x4 acc = (f32x4){0.f, 0.f, 0.f, 0.f};
            if (ct <= rt) {
#pragma unroll
                for (int k = 0; k < 4; ++k) acc = mma(frag(lds, L_QS, PQ, 16 * rt, 32 * k, lane), frag(lds, L_KS, PQ, 16 * ct, 32 * k, lane), acc);
            }
            const int sp = 16 * ct + fr; const float as = SC[SC_A + sp];
#pragma unroll
            for (int r = 0; r < 4; ++r) { const int t = 16 * rt + 4 * fq + r; const float v = (sp <= t) ? acc[r] * __expf(as - SC[SC_PM + t]) : 0.f;
                *(LAS bf16*)(lds + L_SB + t * PT + sp * 2) = f2bf(v); } }
        LDS_BARRIER();
        f32x4 nacc[2]; const int nct = half ? 1 : 2;
#pragma unroll
        for (int cc = 0; cc < 2; ++cc) { if (cc < nct) { const int ct = half ? 2 : cc;
            f32x4 a1 = (f32x4){0.f, 0.f, 0.f, 0.f}, a2 = (f32x4){0.f, 0.f, 0.f, 0.f};
#pragma unroll
            for (int k = 0; k < 2; ++k) a1 = mma(frag(lds, L_SB, PT, 16 * rt, 32 * k, lane), frag(lds, L_VT, PT, 16 * ct, 32 * k, lane), a1);
#pragma unroll
            for (int k = 0; k < 4; ++k) a2 = mma(frag(lds, L_QS, PQ, 16 * rt, 32 * k, lane), frag(lds, L_CT, PQ, 16 * ct, 32 * k, lane), a2);
#pragma unroll
            for (int r = 0; r < 4; ++r) a1[r] += SC[SC_WI + 16 * rt + 4 * fq + r] * a2[r];
            nacc[cc] = a1; } }
        if (half && fr == 0) {
#pragma unroll
            for (int r = 0; r < 4; ++r) SC[SC_DEN + 16 * rt + 4 * fq + r] = nacc[0][r];
        }
#pragma unroll
        for (int et = 0; et < 3; ++et) { cacc[et] = cacc[et] * wie;
#pragma unroll
            for (int k = 0; k < 2; ++k) cacc[et] = mma(frag(lds, L_VT, PT, 16 * et, 32 * k, lane), frag(lds, L_KT, PT, 16 * w, 32 * k, lane), cacc[et]); }
        LDS_BARRIER();
        if (!half) {
#pragma unroll
            for (int cc = 0; cc < 2; ++cc)
#pragma unroll
                for (int r = 0; r < 4; ++r) { const int t = 16 * rt + 4 * fq + r; const float den = fmaxf(fabsf(SC[SC_DEN + t]), SC[SC_EMT + t]);
                    *(LAS bf16*)(lds + L_HS + t * 80 + (16 * cc + fr) * 2) = f2bf(nacc[cc][r] * __builtin_amdgcn_rcpf(den)); }
        }
        LDS_BARRIER();
        if (tid < 256) { const int j = tid >> 2, pc = tid & 3;
            *(u32x4*)(U + ML_TOK(c, j) * PU + dir * MW + head * 128 + vb * EV + 8 * pc) = *(const LAS u32x4*)(lds + L_HS + j * 80 + pc * 16); }
    }
    if (!q.grid) {
        const size_t sb = (((size_t)q.b * DEPTH + l) * 2 + dir) * MH + head; const int d = 16 * w + fr;
#pragma unroll
        for (int et = 0; et < 2; ++et)
#pragma unroll
            for (int r = 0; r < 4; ++r) P.out[OUT_C + (sb * 128 + d) * 128 + vb * EV + 16 * et + 4 * fq + r] = cacc[et][r];
        if (vb == 0) { if (fq == 0) P.out[OUT_N + sb * 128 + d] = cacc[2][0]; if (tid == 0) P.out[OUT_M + sb] = m_prev; }
    }
    LDS_BARRIER();
#undef ML_TOK
#undef ML_PREFETCH
}
constexpr int M_QS = 0, M_KS = M_QS + 2 * 64 * PQ, M_KT = M_KS + 64 * PQ, M_VT = M_KT + 128 * PT, M_SB = M_VT + 2 * 48 * PT, M_CT = M_SB + 64 * PT, M_HS = M_CT + 48 * PQ, M_SC = M_HS + 64 * 80, M_END = M_SC + 2 * 4096;
static_assert(M_END <= 131072, "pipelined mLSTM LDS map");
__device__ __forceinline__ void mlstm_item2(LAS unsigned char* lds, CParams& P, int l, int s, int head, int dir, int vb) {
    const int tid = threadIdx.x, w = __builtin_amdgcn_readfirstlane(tid >> 6), lane = tid & 63, fr = lane & 15, fq = lane >> 4;
    const int rt = w & 3, half = w >> 2;
    const SeqInfo q = seqinfo(s); const int nchunk = q.T / 64;
    const bf16* QK = WSP(bf16, WS_QKC); bf16* U = WSP(bf16, WS_U1);
    f32x4 cacc[3];
    float m_prev;
    const size_t sb = (((size_t)q.b * DEPTH + l) * 2 + dir) * MH + head;
    if (!q.grid) { cacc[0] = cacc[1] = cacc[2] = (f32x4){0.f, 0.f, 0.f, 0.f}; m_prev = 0.f; }
    else {
        const int d = 16 * w + fr;
#pragma unroll
        for (int et = 0; et < 2; ++et)
#pragma unroll
            for (int r = 0; r < 4; ++r) cacc[et][r] = P.in[ST_C][(sb * 128 + d) * 128 + vb * EV + 16 * et + 4 * fq + r];
        cacc[2] = (f32x4){0.f, 0.f, 0.f, 0.f}; if (fq == 0) cacc[2][0] = P.in[ST_N][sb * 128 + d];
        m_prev = P.in[ST_M][sb];
    }
    const float bi = P.in[M_GATE_B][(size_t)l * 4 * MH + (2 * dir) * MH + head], bfg = P.in[M_GATE_B][(size_t)l * 4 * MH + (2 * dir + 1) * MH + head];
    for (int i = tid; i < 2 * 16 * 64; i += 512) { const int b = i >> 10, r = (i >> 6) & 15, c = i & 63; *(LAS bf16*)(lds + M_VT + b * 48 * PT + (32 + r) * PT + c * 2) = (r == 0) ? (bf16)0x3f80 : (bf16)0; }
    u32x4 pqk[4]; u32x4 pv; bf16 pgi = 0, pgf = 0;
#define ML_TOK(c, j) ((size_t)(q.base + (dir ? q.T - 1 - ((c) * 64 + (j)) : ((c) * 64 + (j)))))
#define ML_PREFETCH(c) do { _Pragma("unroll") for (int i = 0; i < 4; ++i) { const int id = tid + 512 * i, j = id >> 5, pc = id & 31; \
            pqk[i] = *(const u32x4*)(QK + ML_TOK(c, j) * (2 * MW) + (pc < 16 ? head * 128 + 8 * pc : MW + head * 128 + 8 * (pc - 16))); } \
        if (tid < 256) { const int j = tid >> 2, pc = tid & 3; pv = *(const u32x4*)(U + ML_TOK(c, j) * PU + OFF_V + head * 128 + vb * EV + 8 * pc); } \
        if (w == 4) { const bf16* g = U + ML_TOK(c, lane) * PU + OFF_G; pgi = g[(2 * dir) * MH + head]; pgf = g[(2 * dir + 1) * MH + head]; } } while (0)
#define ML_STAGE_A(pb) do { \
        _Pragma("unroll") for (int i = 0; i < 4; ++i) { const int id = tid + 512 * i, j = id >> 5, pc = id & 31; \
            *(LAS u32x4*)(lds + (pc < 16 ? M_QS + (pb) * 64 * PQ : M_KS) + j * PQ + (pc & 15) * 16) = pqk[i]; } \
        if (tid < 256) { const int j = tid >> 2, pc = tid & 3; const unsigned wv[4] = {pv.x, pv.y, pv.z, pv.w}; \
            _Pragma("unroll") for (int e = 0; e < 8; ++e) *(LAS bf16*)(lds + M_VT + (pb) * 48 * PT + (8 * pc + e) * PT + j * 2) = (bf16)((wv[e >> 1] >> ((e & 1) * 16)) & 0xffffu); } \
        if (w == 4) { LAS float* SCn = (LAS float*)(lds + M_SC + (pb) * 4096); \
            const float gi = bf2f(pgi) + bi, gf = bf2f(pgf) + bfg; \
            const float lf = fminf(gf, 0.f) - log1pf(__expf(-fabsf(gf))); \
            const float b = wave_scan_add(lf, lane); \
            const float a = gi - b; float pm = wave_scan_max(a, lane); \
            pm = fmaxf(pm, m_prev); \
            const float pm63 = lane_get(pm, 63), b63 = lane_get(b, 63); \
            SCn[SC_A + lane] = a; SCn[SC_PM + lane] = pm; SCn[SC_WI + lane] = __expf(m_prev - pm); SCn[SC_EMT + lane] = __expf(-(b + pm)); SCn[SC_WE + lane] = __expf(a - pm63); \
            if (lane == 0) SCn[SC_MISC] = __expf(m_prev - pm63); \
            m_prev = b63 + pm63; } } while (0)
#define ML_STAGE_D(pb) do { const LAS float* SCn = (const LAS float*)(lds + M_SC + (pb) * 4096); \
        _Pragma("unroll") for (int i = 0; i < 2; ++i) { const int id = tid + 512 * i, j = id & 63, pc = id >> 6; const float we = SCn[SC_WE + j]; \
            const u32x4 kv = *(const LAS u32x4*)(lds + M_KS + j * PQ + pc * 16); const unsigned wv[4] = {kv.x, kv.y, kv.z, kv.w}; \
            _Pragma("unroll") for (int e = 0; e < 8; ++e) { const float kf = __builtin_bit_cast(float, (e & 1) ? (wv[e >> 1] & 0xffff0000u) : (wv[e >> 1] << 16)); \
                *(LAS bf16*)(lds + M_KT + (8 * pc + e) * PT + j * 2) = f2bf(kf * we); } } \
        _Pragma("unroll") for (int cc = 0; cc < 2; ++cc) { const int ct = 2 * half + cc; \
            f32x4 acc = (f32x4){0.f, 0.f, 0.f, 0.f}; \
            if (ct <= rt) { \
                _Pragma("unroll") for (int k = 0; k < 4; ++k) acc = mma(frag(lds, M_QS + (pb) * 64 * PQ, PQ, 16 * rt, 32 * k, lane), frag(lds, M_KS, PQ, 16 * ct, 32 * k, lane), acc); } \
            const int sp = 16 * ct + fr; const float as = SCn[SC_A + sp]; \
            _Pragma("unroll") for (int r = 0; r < 4; ++r) { const int t = 16 * rt + 4 * fq + r; const float v = (sp <= t) ? acc[r] * __expf(as - SCn[SC_PM + t]) : 0.f; \
                *(LAS bf16*)(lds + M_SB + t * PT + sp * 2) = f2bf(v); } } \
        _Pragma("unroll") for (int et = 0; et < 3; ++et) \
            _Pragma("unroll") for (int r = 0; r < 4; ++r) *(LAS bf16*)(lds + M_CT + (16 * et + 4 * fq + r) * PQ + (16 * w + fr) * 2) = f2bf(cacc[et][r]); } while (0)
#define ML_STORE(c) do { if (tid < 256) { const int j = tid >> 2, pc = tid & 3; \
            *(u32x4*)(U + ML_TOK(c, j) * PU + dir * MW + head * 128 + vb * EV + 8 * pc) = *(const LAS u32x4*)(lds + M_HS + j * 80 + pc * 16); } } while (0)
    ML_PREFETCH(0);
    ML_STAGE_A(0);
    LDS_BARRIER();
    if (nchunk > 1) ML_PREFETCH(1);
    ML_STAGE_D(0);
    LDS_BARRIER();
    for (int c = 0; c < nchunk; ++c) {
        const int pb = c & 1;
        if (c + 1 < nchunk) { ML_STAGE_A(pb ^ 1); if (c + 2 < nchunk) ML_PREFETCH(c + 2); }
        if (c >= 1) ML_STORE(c - 1);
        LAS float* SC = (LAS float*)(lds + M_SC + pb * 4096);
        const float wie = SC[SC_MISC];
        f32x4 nacc[2]; const int nct = half ? 1 : 2;
#pragma unroll
        for (int cc = 0; cc < 2; ++cc) { if (cc < nct) { const int ct = half ? 2 : cc;
            f32x4 a1 = (f32x4){0.f, 0.f, 0.f, 0.f}, a2 = (f32x4){0.f, 0.f, 0.f, 0.f};
#pragma unroll
            for (int k = 0; k < 2; ++k) a1 = mma(frag(lds, M_SB, PT, 16 * rt, 32 * k, lane), frag(lds, M_VT + pb * 48 * PT, PT, 16 * ct, 32 * k, lane), a1);
#pragma unroll
            for (int k = 0; k < 4; ++k) a2 = mma(frag(lds, M_QS + pb * 64 * PQ, PQ, 16 * rt, 32 * k, lane), frag(lds, M_CT, PQ, 16 * ct, 32 * k, lane), a2);
#pragma unroll
            for (int r = 0; r < 4; ++r) a1[r] += SC[SC_WI + 16 * rt + 4 * fq + r] * a2[r];
            nacc[cc] = a1; } }
        if (half && fr == 0) {
#pragma unroll
            for (int r = 0; r < 4; ++r) SC[SC_DEN + 16 * rt + 4 * fq + r] = nacc[0][r];
        }
#pragma unroll
        for (int et = 0; et < 3; ++et) { cacc[et] = cacc[et] * wie;
#pragma unroll
            for (int k = 0; k < 2; ++k) cacc[et] = mma(frag(lds, M_VT + pb * 48 * PT, PT, 16 * et, 32 * k, lane), frag(lds, M_KT, PT, 16 * w, 32 * k, lane), cacc[et]); }
        LDS_BARRIER();
        if (!half) {
#pragma unroll
            for (int cc = 0; cc < 2; ++cc)
#pragma unroll
                for (int r = 0; r < 4; ++r) { const int t = 16 * rt + 4 * fq + r; const float den = fmaxf(fabsf(SC[SC_DEN + t]), SC[SC_EMT + t]);
                    *(LAS bf16*)(lds + M_HS + t * 80 + (16 * cc + fr) * 2) = f2bf(nacc[cc][r] * __builtin_amdgcn_rcpf(den)); }
        }
        if (c + 1 < nchunk) ML_STAGE_D(pb ^ 1);
        LDS_BARRIER();
    }
    ML_STORE(nchunk - 1);
    if (!q.grid) {
        const int d = 16 * w + fr;
#pragma unroll
        for (int et = 0; et < 2; ++et)
#pragma unroll
            for (int r = 0; r < 4; ++r) P.out[OUT_C + (sb * 128 + d) * 128 + vb * EV + 16 * et + 4 * fq + r] = cacc[et][r];
        if (vb == 0) { if (fq == 0) P.out[OUT_N + sb * 128 + d] = cacc[2][0]; if (tid == 256) P.out[OUT_M + sb] = m_prev; }
    }
    LDS_BARRIER();
#undef ML_TOK
#undef ML_PREFETCH
#undef ML_STAGE_A
#undef ML_STAGE_D
#undef ML_STORE
}
constexpr int N_ITEMS = NSEQ * MH * 2 * NVB;
__device__ __forceinline__ void decode_item(int it, int& s, int& head, int& dir, int& vb) {
    vb = it % NVB; int ch = it / NVB; dir = ch & 1; ch >>= 1; head = ch % MH; const int sq = ch / MH;
    s = sq < LB ? CB + sq : sq - LB;
}
}


namespace rw {
typedef short bf16x8 __attribute__((ext_vector_type(8)));
typedef float f32x4 __attribute__((ext_vector_type(4)));
typedef unsigned u32x4 __attribute__((ext_vector_type(4)));
enum { V_A = 0, V_W, V_B, V_K, V_R, NVEC };
constexpr int REC = NVEC * 64 * 4;
constexpr int PT = 144;
constexpr int L_SBUF = 0, L_VT = L_SBUF + 64 * REC, L_TW = L_VT + 64 * 256, L_AL = L_TW + 64 * PT, L_YS = L_AL + 64 * PT, L_INV = L_YS + 64 * 16 * 4, L_END = L_INV + 256;
__device__ __forceinline__ int vt_off(int row, int tt) { return row * 256 + ((tt ^ (((row >> 3) & 7) << 2)) << 2); }
static_assert(L_END <= 131072, "RWKV LDS map");
__device__ __forceinline__ float dpp_xor1(float x) { return __builtin_bit_cast(float, __builtin_amdgcn_update_dpp(0, __builtin_bit_cast(int, x), 0xB1, 0xF, 0xF, true)); }
__device__ __forceinline__ float dpp_xor2(float x) { return __builtin_bit_cast(float, __builtin_amdgcn_update_dpp(0, __builtin_bit_cast(int, x), 0x4E, 0xF, 0xF, true)); }
__device__ __forceinline__ float dpp_ror4(float x) { return __builtin_bit_cast(float, __builtin_amdgcn_update_dpp(0, __builtin_bit_cast(int, x), 0x124, 0xF, 0xF, true)); }
__device__ __forceinline__ float dpp_ror8(float x) { return __builtin_bit_cast(float, __builtin_amdgcn_update_dpp(0, __builtin_bit_cast(int, x), 0x128, 0xF, 0xF, true)); }
__device__ __forceinline__ float allsum16(float x) { x += dpp_xor1(x); x += dpp_xor2(x); x += dpp_ror4(x); x += dpp_ror8(x); return x; }
__device__ __forceinline__ f32x4 cvt_lo4(unsigned a, unsigned b) { return (f32x4){__builtin_bit_cast(float, a << 16), __builtin_bit_cast(float, a & 0xffff0000u), __builtin_bit_cast(float, b << 16), __builtin_bit_cast(float, b & 0xffff0000u)}; }
__device__ __forceinline__ float allsum32(float x) {
    x = allsum16(x);
    float xa = x, xb = x;
    asm volatile("v_mov_b32 %1, %0\n\ts_nop 1\n\tv_permlane32_swap_b32 %0, %1\n\ts_nop 1" : "+v"(xa), "=&v"(xb));
    return xa + xb;
}
__device__ __forceinline__ void rwkv_item(LAS unsigned char* lds, CParams& P, int l, int s, int head, int dir, int rh) {
    const int tid = threadIdx.x, w = __builtin_amdgcn_readfirstlane(tid >> 6), lane = tid & 63, fr = lane & 15, fq = lane >> 4;
    const int rt = w & 3, half = w >> 2, hc = head * 64;
    const SeqInfo q = seqinfo(s); const int nchunk = q.T / 64;
    const bf16* RX = WSP(bf16, WS_RXC); bf16* U = WSP(bf16, WS_U1);
    const int pj = tid >> 3, psub = tid & 7;
    const int hh = lane >> 5, rsel = (lane >> 4) & 1, cg = lane & 15;
    const int row = 16 * rh + 2 * w + rsel, col0 = 32 * hh + 2 * cg;
    typedef float f32x2 __attribute__((ext_vector_type(2)));
    f32x2 S2;
    if (!q.grid) S2 = (f32x2){0.f, 0.f};
    else { const size_t sb = (((size_t)q.b * DEPTH + l) * 2 + dir) * RH + head; S2 = *(const f32x2*)(P.in[ST_R] + (sb * 64 + row) * 64 + col0); }
    float rkk8[8];
#pragma unroll
    for (int e = 0; e < 8; ++e) rkk8[e] = P.in[R_KK][(size_t)l * RW + hc + 8 * psub + e];
    float c_w0[2], c_a0[2], c_kk[2], c_ka[2];
    bf16x8 bw[2][2], ba[2][2];
#pragma unroll
    for (int cc = 0; cc < 2; ++cc) { const int c = 16 * (2 * half + cc) + fr;
        c_w0[cc] = P.in[R_W0][((size_t)l * 2 + dir) * RW + hc + c]; c_a0[cc] = P.in[R_A0][((size_t)l * 2 + dir) * RW + hc + c];
        c_kk[cc] = P.in[R_KK][(size_t)l * RW + hc + c]; c_ka[cc] = P.in[R_KA][(size_t)l * RW + hc + c];
#pragma unroll
        for (int ks = 0; ks < 2; ++ks)
#pragma unroll
            for (int e = 0; e < 8; ++e) { const int j = 32 * ks + 8 * fq + e;
                bw[cc][ks][e] = (short)f2bf(P.in[R_W2][(((size_t)l * 2 + dir) * 64 + j) * RW + hc + c]);
                ba[cc][ks][e] = (short)f2bf(P.in[R_A2][(((size_t)l * 2 + dir) * 64 + j) * RW + hc + c]); } }
    u32x4 pf[5];
#define RW_TOK(c, j) ((size_t)(q.base + (dir ? q.T - 1 - ((c) * 64 + (j)) : ((c) * 64 + (j)))))
#define RW_PREFETCH(c) do { const bf16* rx = RX + RW_TOK(c, pj) * RIN + 8 * psub; \
        pf[0] = *(const u32x4*)(rx + RX_R + hc); pf[1] = *(const u32x4*)(rx + RX_K + hc); pf[2] = *(const u32x4*)(rx + RX_V + hc); \
        pf[3] = *(const u32x4*)(rx + RX_WL + dir * 64); pf[4] = *(const u32x4*)(rx + RX_AL + dir * 64); } while (0)
    RW_PREFETCH(0);
    for (int c = 0; c < nchunk; ++c) {
        { LAS unsigned char* rec = lds + L_SBUF + pj * REC + psub * 32;
          *(LAS f32x4*)(rec + V_R * 256) = cvt_lo4(pf[0].x, pf[0].y); *(LAS f32x4*)(rec + V_R * 256 + 16) = cvt_lo4(pf[0].z, pf[0].w);
          { const f32x4 v0 = cvt_lo4(pf[2].x, pf[2].y), v1 = cvt_lo4(pf[2].z, pf[2].w);
#pragma unroll
            for (int e = 0; e < 4; ++e) { *(LAS float*)(lds + L_VT + vt_off(8 * psub + e, pj)) = v0[e]; *(LAS float*)(lds + L_VT + vt_off(8 * psub + 4 + e, pj)) = v1[e]; } }
          const f32x4 k0 = cvt_lo4(pf[1].x, pf[1].y), k1 = cvt_lo4(pf[1].z, pf[1].w);
          *(LAS f32x4*)(rec + V_K * 256) = k0; *(LAS f32x4*)(rec + V_K * 256 + 16) = k1;
          float ss = 0.f;
#pragma unroll
          for (int e = 0; e < 4; ++e) { const float x0 = k0[e] * rkk8[e], x1 = k1[e] * rkk8[4 + e]; ss += x0 * x0 + x1 * x1; }
          ss += dpp_xor1(ss); ss += dpp_xor2(ss); ss += __shfl_xor(ss, 4);
          if (psub == 0) *(LAS float*)(lds + L_INV + pj * 4) = 1.0f / fmaxf(sqrtf(ss), 1e-12f);
          *(LAS u32x4*)(lds + L_TW + pj * PT + psub * 16) = pf[3]; *(LAS u32x4*)(lds + L_AL + pj * PT + psub * 16) = pf[4]; }
        __syncthreads();
        if (c + 1 < nchunk) RW_PREFETCH(c + 1);
#pragma unroll
        for (int cc = 0; cc < 2; ++cc) { const int ct = 2 * half + cc; const int cidx = 16 * ct + fr;
            f32x4 aw = (f32x4){0.f, 0.f, 0.f, 0.f}, aa = (f32x4){0.f, 0.f, 0.f, 0.f};
#pragma unroll
            for (int ks = 0; ks < 2; ++ks) { aw = ml::mma(ml::frag(lds, L_TW, PT, 16 * rt, 32 * ks, lane), bw[cc][ks], aw); aa = ml::mma(ml::frag(lds, L_AL, PT, 16 * rt, 32 * ks, lane), ba[cc][ks], aa); }
#pragma unroll
            for (int r = 0; r < 4; ++r) { const int tok = 16 * rt + 4 * fq + r; LAS float* rec = (LAS float*)(lds + L_SBUF + tok * REC) + cidx;
                const float decay = __expf(-0.6065306597126334f * pg8::fsigmoid(c_w0[cc] + aw[r])); const float alpha = pg8::fsigmoid(c_a0[cc] + aa[r]);
                const float kraw = rec[V_K * 64]; const float kkn = kraw * c_kk[cc] * *(LAS float*)(lds + L_INV + tok * 4);
                rec[V_A * 64] = -kkn; rec[V_W * 64] = decay; rec[V_B * 64] = kkn * alpha; rec[V_K * 64] = kraw * (1.0f + (alpha - 1.0f) * c_ka[cc]); } }
        __syncthreads();
        {
            const LAS unsigned char* rbase = lds + L_SBUF + col0 * 4;
            f32x2 ca = *(const LAS f32x2*)(rbase + V_A * 256), cw = *(const LAS f32x2*)(rbase + V_W * 256), cb = *(const LAS f32x2*)(rbase + V_B * 256),
                  ck = *(const LAS f32x2*)(rbase + V_K * 256), cr = *(const LAS f32x2*)(rbase + V_R * 256);
#pragma unroll 1
            for (int blk = 0; blk < 4; ++blk) {
                float ykeep = 0.f;
#pragma unroll
                for (int g4 = 0; g4 < 4; ++g4) {
                    const f32x4 v4 = *(const LAS f32x4*)(lds + L_VT + vt_off(row, 16 * blk + 4 * g4));
#pragma unroll
                    for (int i4 = 0; i4 < 4; ++i4) {
                        const int i = 4 * g4 + i4, tt = 16 * blk + i, tn = tt < 63 ? tt + 1 : 63;
                        const LAS unsigned char* rn = rbase + tn * REC;
                        const f32x2 na = *(const LAS f32x2*)(rn + V_A * 256), nw = *(const LAS f32x2*)(rn + V_W * 256), nb = *(const LAS f32x2*)(rn + V_B * 256),
                                    nk = *(const LAS f32x2*)(rn + V_K * 256), nr = *(const LAS f32x2*)(rn + V_R * 256);
                        const float vv = v4[i4];
                        const f32x2 p = S2 * ca;
                        const float sa = allsum32(p.x + p.y);
                        S2 = S2 * cw + ck * vv;
                        S2 = cb * sa + S2;
                        const f32x2 yq = S2 * cr;
                        const float y = allsum32(yq.x + yq.y);
                        ykeep = (cg == i) ? y : ykeep;
                        ca = na; cw = nw; cb = nb; ck = nk; cr = nr;
                    }
                }
                if (hh == 0) *(LAS float*)(lds + L_YS + ((16 * blk + cg) * 16 + 2 * w + rsel) * 4) = ykeep;
            }
        }
        __syncthreads();
        if (tid < 128) { const int j = tid >> 1, pc = tid & 1; const LAS float* ys = (const LAS float*)(lds + L_YS) + j * 16 + 8 * pc;
            u32x4 o; o.x = pg8::cvt_pk_bf16(ys[0], ys[1]); o.y = pg8::cvt_pk_bf16(ys[2], ys[3]); o.z = pg8::cvt_pk_bf16(ys[4], ys[5]); o.w = pg8::cvt_pk_bf16(ys[6], ys[7]);
            *(u32x4*)(U + RW_TOK(c, j) * PU + OFF_R + dir * RW + hc + 16 * rh + 8 * pc) = o; }
    }
    if (!q.grid) { const size_t sb = (((size_t)q.b * DEPTH + l) * 2 + dir) * RH + head; *(f32x2*)(P.out + OUT_S + (sb * 64 + row) * 64 + col0) = S2; }
    __syncthreads();
#undef RW_TOK
#undef RW_PREFETCH
}
constexpr int N_ITEMS = NSEQ * RH * 2 * 4;
__device__ __forceinline__ void decode_item(int it, int& s, int& head, int& dir, int& rh) {
    rh = it & 3; int ch = it >> 2; dir = ch & 1; ch >>= 1; head = ch % RH; const int sq = ch / RH;
    s = sq < LB ? CB + sq : sq - LB;
}
}


namespace wy {
typedef short bf16x8 __attribute__((ext_vector_type(8)));
typedef float f32x4 __attribute__((ext_vector_type(4)));
typedef unsigned u32x4 __attribute__((ext_vector_type(4)));
constexpr int PV = 144, PS = 48, PVS = 136;
constexpr int L_AH = 0, L_RH = L_AH + 64 * PV, L_BT = L_RH + 64 * PV, L_KT = L_BT + 64 * PV, L_NAKT = L_KT + 64 * PV, L_NRKT = L_NAKT + 4 * 16 * PS,
              L_NRBT = L_NRKT + 4 * 16 * PS, L_TT = L_NRBT + 4 * 16 * PS, L_GL = L_TT + 4 * 16 * PS, PACK_BYTES = L_GL + 1024,
              L_VS = PACK_BYTES, L_BH = L_VS + 64 * PV, L_KH = L_BH + 64 * PV, L_YS = L_KH + 64 * PV, L_TW = L_YS + 64 * PV, L_AL = L_TW + 64 * PV, L_NAB = L_AL + 64 * PV, L_INV = L_NAB + 4096, L_END = L_INV + 256;
constexpr int RING = 8, PACK_U = PACK_BYTES / 16, N_LAT = LB * RH * 2, RING_A = 20;
static_assert(PACK_BYTES % 1024 == 0 && PACK_U <= 8 * 512 && (size_t)RING_A * RING * PACK_BYTES <= (size_t)N1P * D * 2 && WS_END + (size_t)(N_LAT - RING_A) * RING * PACK_BYTES <= ((size_t)256 << 20), "ring placement");
static_assert(L_END <= 131072, "WY LDS map");
__device__ __forceinline__ bf16x8 fragk16(LAS unsigned char* lds, int base, int pitch, int row0, int k0, int lane) {
    const bf16x8 v = *(const LAS bf16x8*)(lds + base + (row0 + (lane & 15)) * pitch + (k0 + 8 * ((lane >> 4) & 1)) * 2);
    const bf16x8 z = {0, 0, 0, 0, 0, 0, 0, 0};
    return (lane < 32) ? v : z;
}
__device__ __forceinline__ void stb(LAS unsigned char* lds, int off, float v) { *(LAS bf16*)(lds + off) = f2bf(v); }
typedef unsigned u32x2 __attribute__((ext_vector_type(2)));
__device__ __forceinline__ bf16x8 pack_k16(const f32x4 v) { u32x4 o; o.x = pg8::cvt_pk_bf16(v[0], v[1]); o.y = pg8::cvt_pk_bf16(v[2], v[3]); o.z = 0u; o.w = 0u; return __builtin_bit_cast(bf16x8, o); }
__device__ __forceinline__ bf16x8 pack_k32(const f32x4 a, const f32x4 b) { u32x4 o; o.x = pg8::cvt_pk_bf16(a[0], a[1]); o.y = pg8::cvt_pk_bf16(a[2], a[3]); o.z = pg8::cvt_pk_bf16(b[0], b[1]); o.w = pg8::cvt_pk_bf16(b[2], b[3]);
    return __builtin_bit_cast(bf16x8, o); }
__device__ __forceinline__ bf16x8 ld_k16(LAS unsigned char* lds, int base, int pitch, int row0, int col0, int lane) {
    const u32x2 v = *(const LAS u32x2*)(lds + base + (row0 + (lane & 15)) * pitch + (col0 + 4 * (lane >> 4)) * 2); u32x4 o; o.x = v.x; o.y = v.y; o.z = 0u; o.w = 0u; return __builtin_bit_cast(bf16x8, o); }
__device__ __forceinline__ bf16x8 ld_k32(LAS unsigned char* lds, int base, int pitch, int row0, int col0, int lane) {
    const LAS unsigned char* p = lds + base + (row0 + (lane & 15)) * pitch + (col0 + 4 * (lane >> 4)) * 2;
    const u32x2 v0 = *(const LAS u32x2*)p, v1 = *(const LAS u32x2*)(p + 32); u32x4 o; o.x = v0.x; o.y = v0.y; o.z = v1.x; o.w = v1.y; return __builtin_bit_cast(bf16x8, o); }
__device__ __forceinline__ void rwkv_item(LAS unsigned char* lds, CParams& P, int l, int s, int head, int dir) {
    const int tid = threadIdx.x, w = __builtin_amdgcn_readfirstlane(tid >> 6), lane = tid & 63, fr = lane & 15, fq = lane >> 4;
    const int rt = w & 3, half = w >> 2, hc = head * 64;
    const SeqInfo q = seqinfo(s); const int nchunk = q.T / 64;
    const bf16* RX = WSP(bf16, WS_RXC); bf16* U = WSP(bf16, WS_U1);
    const int pj = tid >> 3, psub = tid & 7;
    f32x4 sacc[4];
#pragma unroll
    for (int ct = 0; ct < 4; ++ct) sacc[ct] = (f32x4){0.f, 0.f, 0.f, 0.f};
    if (w < 4 && q.grid) { const size_t sb = (((size_t)q.b * DEPTH + l) * 2 + dir) * RH + head;
#pragma unroll
        for (int ct = 0; ct < 4; ++ct) sacc[ct] = *(const f32x4*)(P.in[ST_R] + (sb * 64 + 16 * w + fr) * 64 + 16 * ct + 4 * fq); }
    float rkk8[8];
#pragma unroll
    for (int e = 0; e < 8; ++e) rkk8[e] = P.in[R_KK][(size_t)l * RW + hc + 8 * psub + e];
    float c_w0[2], c_a0[2], c_kk[2], c_ka[2];
#pragma unroll
    for (int cc = 0; cc < 2; ++cc) { const int c = 16 * (2 * half + cc) + fr;
        c_w0[cc] = P.in[R_W0][((size_t)l * 2 + dir) * RW + hc + c]; c_a0[cc] = P.in[R_A0][((size_t)l * 2 + dir) * RW + hc + c];
        c_kk[cc] = P.in[R_KK][(size_t)l * RW + hc + c]; c_ka[cc] = P.in[R_KA][(size_t)l * RW + hc + c]; }
    const bf16* w2t = WSP(bf16, O_W2T) + ((size_t)dir * RW + hc) * 64; const bf16* a2t = WSP(bf16, O_A2T) + ((size_t)dir * RW + hc) * 64;
    u32x4 pf[5];
#define WY_TOK(c, j) ((size_t)(q.base + (dir ? q.T - 1 - ((c) * 64 + (j)) : ((c) * 64 + (j)))))
#define WY_PREFETCH(c) do { const bf16* rx = RX + WY_TOK(c, pj) * RIN + 8 * psub; \
        pf[0] = *(const u32x4*)(rx + RX_R + hc); pf[1] = *(const u32x4*)(rx + RX_K + hc); pf[2] = *(const u32x4*)(rx + RX_V + hc); \
        pf[3] = *(const u32x4*)(rx + RX_WL + dir * 64); pf[4] = *(const u32x4*)(rx + RX_AL + dir * 64); } while (0)
    WY_PREFETCH(0);
    for (int c = 0; c < nchunk; ++c) {
        { *(LAS u32x4*)(lds + L_RH + pj * PV + psub * 16) = pf[0]; *(LAS u32x4*)(lds + L_KH + pj * PV + psub * 16) = pf[1];
          const unsigned kw[4] = {pf[1].x, pf[1].y, pf[1].z, pf[1].w}, vw[4] = {pf[2].x, pf[2].y, pf[2].z, pf[2].w};
          float ss = 0.f;
#pragma unroll
          for (int e = 0; e < 8; ++e) { const float kf = __builtin_bit_cast(float, (e & 1) ? (kw[e >> 1] & 0xffff0000u) : (kw[e >> 1] << 16)) * rkk8[e]; ss += kf * kf;
              *(LAS bf16*)(lds + L_VS + (8 * psub + e) * PVS + pj * 2) = (bf16)((vw[e >> 1] >> ((e & 1) * 16)) & 0xffffu); }
          ss += rw::dpp_xor1(ss); ss += rw::dpp_xor2(ss); ss += __shfl_xor(ss, 4);
          if (psub == 0) *(LAS float*)(lds + L_INV + pj * 4) = 1.0f / fmaxf(sqrtf(ss), 1e-12f);
          *(LAS u32x4*)(lds + L_TW + pj * PV + psub * 16) = pf[3]; *(LAS u32x4*)(lds + L_AL + pj * PV + psub * 16) = pf[4]; }
        LDS_BARRIER();
        if (c + 1 < nchunk) WY_PREFETCH(c + 1);
#pragma unroll
        for (int cc = 0; cc < 2; ++cc) { const int ct = 2 * half + cc; const int cidx = 16 * ct + fr;
            f32x4 aw = (f32x4){0.f, 0.f, 0.f, 0.f}, aa = (f32x4){0.f, 0.f, 0.f, 0.f};
#pragma unroll
            for (int ks = 0; ks < 2; ++ks) { const size_t bo = (size_t)cidx * 64 + 32 * ks + 8 * fq;
                aw = ml::mma(ml::frag(lds, L_TW, PV, 16 * rt, 32 * ks, lane), *(const bf16x8*)(w2t + bo), aw); aa = ml::mma(ml::frag(lds, L_AL, PV, 16 * rt, 32 * ks, lane), *(const bf16x8*)(a2t + bo), aa); }
            float kr4[4], rr4[4], iv4[4];
#pragma unroll
            for (int r = 0; r < 4; ++r) { const int tok = 16 * rt + 4 * fq + r; kr4[r] = bf2f(*(const LAS bf16*)(lds + L_KH + tok * PV + cidx * 2)); rr4[r] = bf2f(*(const LAS bf16*)(lds + L_RH + tok * PV + cidx * 2));
                iv4[r] = *(const LAS float*)(lds + L_INV + tok * 4); }
            float lw[4], cum[4];
#pragma unroll
            for (int r = 0; r < 4; ++r) { lw[r] = -0.6065306597126334f * pg8::fsigmoid(c_w0[cc] + aw[r]); cum[r] = (r ? cum[r - 1] : 0.f) + lw[r]; }
            const float tot = cum[3]; const float p1 = __shfl_up(tot, 16), p2 = __shfl_up(tot, 32), p3 = __shfl_up(tot, 48);
            const float off = (fq >= 1 ? p1 : 0.f) + (fq >= 2 ? p2 : 0.f) + (fq >= 3 ? p3 : 0.f);
            float gprev = __expf(off);
#pragma unroll
            for (int r = 0; r < 4; ++r) { const int tok = 16 * rt + 4 * fq + r; const float lam = off + cum[r]; const float g = __expf(lam), gi = __builtin_amdgcn_rcpf(g);
                const float alpha = pg8::fsigmoid(c_a0[cc] + aa[r]);
                const float kraw = kr4[r], rraw = rr4[r];
                const float kkn = kraw * c_kk[cc] * iv4[r];
                const bf16 bh = f2bf(kkn * alpha * gi), kh = f2bf(kraw * (1.0f + (alpha - 1.0f) * c_ka[cc]) * gi);
                stb(lds, L_AH + tok * PV + cidx * 2, -kkn * gprev); stb(lds, L_RH + tok * PV + cidx * 2, rraw * g);
                *(LAS bf16*)(lds + L_BH + tok * PV + cidx * 2) = bh; *(LAS bf16*)(lds + L_KH + tok * PV + cidx * 2) = kh;
                *(LAS bf16*)(lds + L_BT + cidx * PV + tok * 2) = bh; *(LAS bf16*)(lds + L_KT + cidx * PV + tok * 2) = kh;
                if (fq == 3 && r == 3) *(LAS float*)(lds + L_GL + (rt * 64 + cidx) * 4) = g;
                gprev = g; } }
        LDS_BARRIER();
        { const int sc = w >> 1, side = w & 1; f32x4 gB = (f32x4){0.f, 0.f, 0.f, 0.f}, gK = (f32x4){0.f, 0.f, 0.f, 0.f};
#pragma unroll
          for (int ks = 0; ks < 2; ++ks) { const bf16x8 af = ml::frag(lds, side ? L_RH : L_AH, PV, 16 * sc, 32 * ks, lane);
              gB = ml::mma(af, ml::frag(lds, L_BH, PV, 16 * sc, 32 * ks, lane), gB); gK = ml::mma(af, ml::frag(lds, L_KH, PV, 16 * sc, 32 * ks, lane), gK); }
#pragma unroll
          for (int r = 0; r < 4; ++r) { const int t = 4 * fq + r; const bool keep = side ? (fr <= t) : (fr < t); const float vB = keep ? gB[r] : 0.f, vK = keep ? gK[r] : 0.f;
              if (side == 0) { *(LAS float*)(lds + L_NAB + ((sc * 16 + t) * 16 + fr) * 4) = vB; stb(lds, L_NAKT + (sc * 16 + t) * PS + fr * 2, vK); }
              else { stb(lds, L_NRBT + (sc * 16 + t) * PS + fr * 2, vB); stb(lds, L_NRKT + (sc * 16 + t) * PS + fr * 2, vK); } } }
        if ((w & 1) == 0 && lane < 16) { const int sc = w >> 1; float Tr[16];
            asm volatile("" ::: "memory");
#pragma unroll
            for (int ph = 0; ph < 4; ++ph) { f32x4 nv[4][4];
#pragma unroll
                for (int tq = 0; tq < 4; ++tq)
#pragma unroll
                    for (int u4 = 0; u4 <= ph; ++u4) nv[tq][u4] = *(const LAS f32x4*)(lds + L_NAB + ((sc * 16 + 4 * ph + tq) * 16 + 4 * u4) * 4);
#pragma unroll
                for (int tq = 0; tq < 4; ++tq) { const int t = 4 * ph + tq; float x0 = (lane == t) ? 1.f : 0.f, x1 = 0.f;
#pragma unroll
                    for (int u = 0; u < 16; ++u) if (u < t) { if (u & 1) x1 += Tr[u] * nv[tq][u >> 2][u & 3]; else x0 += Tr[u] * nv[tq][u >> 2][u & 3]; }
                    Tr[t] = x0 + x1; stb(lds, L_TT + (sc * 16 + t) * PS + lane * 2, Tr[t]); } } }
        LDS_BARRIER();
        if (w < 4) {
#pragma unroll 1
            for (int sc = 0; sc < 4; ++sc) {
                const bf16x8 ah0 = ld_k32(lds, L_AH, PV, 16 * sc, 0, lane), ah1 = ld_k32(lds, L_AH, PV, 16 * sc, 32, lane), rh0 = ld_k32(lds, L_RH, PV, 16 * sc, 0, lane), rh1 = ld_k32(lds, L_RH, PV, 16 * sc, 32, lane);
                const bf16x8 nak = ld_k16(lds, L_NAKT, PS, 16 * sc, 0, lane), nrk = ld_k16(lds, L_NRKT, PS, 16 * sc, 0, lane), ttf = ld_k16(lds, L_TT, PS, 16 * sc, 0, lane), nrb = ld_k16(lds, L_NRBT, PS, 16 * sc, 0, lane);
                const bf16x8 vsf = ld_k16(lds, L_VS, PVS, 16 * w, 16 * sc, lane);
                bf16x8 btf[4], ktf[4]; f32x4 glv[4];
#pragma unroll
                for (int ct = 0; ct < 4; ++ct) { btf[ct] = ld_k16(lds, L_BT, PV, 16 * ct, 16 * sc, lane); ktf[ct] = ld_k16(lds, L_KT, PV, 16 * ct, 16 * sc, lane);
                    glv[ct] = *(const LAS f32x4*)(lds + L_GL + (sc * 64 + 16 * ct + 4 * fq) * 4); }
                const bf16x8 sb0 = pack_k32(sacc[0], sacc[1]), sb1 = pack_k32(sacc[2], sacc[3]);
                f32x4 XT = (f32x4){0.f, 0.f, 0.f, 0.f}, YT = (f32x4){0.f, 0.f, 0.f, 0.f};
                XT = ml::mma(ah0, sb0, XT); XT = ml::mma(ah1, sb1, XT); XT = ml::mma(nak, vsf, XT);
                YT = ml::mma(rh0, sb0, YT); YT = ml::mma(rh1, sb1, YT); YT = ml::mma(nrk, vsf, YT);
                f32x4 UT = (f32x4){0.f, 0.f, 0.f, 0.f};
                UT = ml::mma(ttf, pack_k16(XT), UT);
                const bf16x8 ub = pack_k16(UT);
                YT = ml::mma(nrb, ub, YT);
#pragma unroll
                for (int r = 0; r < 4; ++r) stb(lds, L_YS + (16 * sc + 4 * fq + r) * PV + (16 * w + fr) * 2, YT[r]);
#pragma unroll
                for (int ct = 0; ct < 4; ++ct) { sacc[ct] = ml::mma(btf[ct], ub, sacc[ct]); sacc[ct] = ml::mma(ktf[ct], vsf, sacc[ct]); sacc[ct] = sacc[ct] * glv[ct]; }
            }
        }
        LDS_BARRIER();
        *(u32x4*)(U + WY_TOK(c, pj) * PU + OFF_R + dir * RW + hc + 8 * psub) = *(const LAS u32x4*)(lds + L_YS + pj * PV + psub * 16);
    }
    if (!q.grid && w < 4) { const size_t sb = (((size_t)q.b * DEPTH + l) * 2 + dir) * RH + head;
#pragma unroll
        for (int ct = 0; ct < 4; ++ct) *(f32x4*)(P.out + OUT_S + (sb * 64 + 16 * w + fr) * 64 + 16 * ct + 4 * fq) = sacc[ct]; }
    LDS_BARRIER();
#undef WY_TOK
#undef WY_PREFETCH
}
__device__ __forceinline__ int tid_opaque() { int t = threadIdx.x; asm volatile("" : "+v"(t)); return t; }
constexpr int CW_F = 16384, FL_STRIDE = 64, NPROD = 2;
static_assert(RING % NPROD == 0 && NPROD + 1 <= 4 && CW_F + DEPTH * N_LAT * 4 * FL_STRIDE <= 32768, "flag block");
constexpr unsigned FL_SPIN_CAP = 1u << 18;
__device__ __forceinline__ unsigned fl_ld(unsigned* p) { return __hip_atomic_load(p, __ATOMIC_RELAXED, __HIP_MEMORY_SCOPE_AGENT); }
__device__ __forceinline__ unsigned fl_wait_ge(unsigned* p, unsigned want, unsigned* tmo) {
    unsigned sp = 0, v;
    while ((v = fl_ld(p)) < want) { __builtin_amdgcn_s_sleep(1); if ((++sp & 255u) == 0u) { if (fl_ld(tmo)) break; if (sp > FL_SPIN_CAP) { atomicAdd(tmo, 1u); break; } } }
    return v;
}
__device__ __forceinline__ void rwkv_prod(LAS unsigned char* lds, CParams& P, int l, int s, int head, int dir, int chain, int pp, unsigned* ctl) {
    const int tid = tid_opaque(), w = __builtin_amdgcn_readfirstlane(tid >> 6), lane = tid & 63, fr = lane & 15, fq = lane >> 4;
    const int rt = w & 3, half = w >> 2, hc = head * 64;
    const SeqInfo q = seqinfo(s); const int nchunk = q.T / 64;
    const bf16* RX = WSP(bf16, WS_RXC);
    const int pj = tid >> 3, psub = tid & 7;
    unsigned char* ring = P.ws + (chain < RING_A ? O_WIN1 + (size_t)chain * RING * PACK_BYTES : WS_END + (size_t)(chain - RING_A) * RING * PACK_BYTES);
    unsigned* f_base = ctl + CW_F + (size_t)((l * N_LAT + chain) * 4) * FL_STRIDE; unsigned* f_ready = f_base + pp * FL_STRIDE; unsigned* f_ack = f_base + NPROD * FL_STRIDE; unsigned* tmo = ctl + 4096 + 128;
    float rkk8[8];
#pragma unroll
    for (int e = 0; e < 8; ++e) rkk8[e] = P.in[R_KK][(size_t)l * RW + hc + 8 * psub + e];
    float c_w0[2], c_a0[2], c_kk[2], c_ka[2];
#pragma unroll
    for (int cc = 0; cc < 2; ++cc) { const int c = 16 * (2 * half + cc) + fr;
        c_w0[cc] = P.in[R_W0][((size_t)l * 2 + dir) * RW + hc + c]; c_a0[cc] = P.in[R_A0][((size_t)l * 2 + dir) * RW + hc + c];
        c_kk[cc] = P.in[R_KK][(size_t)l * RW + hc + c]; c_ka[cc] = P.in[R_KA][(size_t)l * RW + hc + c]; }
    const bf16* w2t = WSP(bf16, O_W2T) + ((size_t)dir * RW + hc) * 64; const bf16* a2t = WSP(bf16, O_A2T) + ((size_t)dir * RW + hc) * 64;
    u32x4 pf[5];
#define WY_TOK(c, j) ((size_t)(q.base + (dir ? q.T - 1 - ((c) * 64 + (j)) : ((c) * 64 + (j)))))
#define WY_PREFETCH(c) do { const bf16* rx = RX + WY_TOK(c, pj) * RIN + 8 * psub; \
        pf[0] = *(const u32x4*)(rx + RX_R + hc); pf[1] = *(const u32x4*)(rx + RX_K + hc); pf[2] = pf[0]; \
        pf[3] = *(const u32x4*)(rx + RX_WL + dir * 64); pf[4] = *(const u32x4*)(rx + RX_AL + dir * 64); } while (0)
    WY_PREFETCH(pp);
    asm volatile("" :: "v"(pf[0]), "v"(pf[1]), "v"(pf[2]), "v"(pf[3]), "v"(pf[4]) : "memory");
    unsigned acked = 0u;
    for (int c = pp; c < nchunk; c += NPROD) {
        { *(LAS u32x4*)(lds + L_RH + pj * PV + psub * 16) = pf[0]; *(LAS u32x4*)(lds + L_KH + pj * PV + psub * 16) = pf[1];
          const unsigned kw[4] = {pf[1].x, pf[1].y, pf[1].z, pf[1].w};
          float ss = 0.f;
#pragma unroll
          for (int e = 0; e < 8; ++e) { const float kf = __builtin_bit_cast(float, (e & 1) ? (kw[e >> 1] & 0xffff0000u) : (kw[e >> 1] << 16)) * rkk8[e]; ss += kf * kf; }
          ss += rw::dpp_xor1(ss); ss += rw::dpp_xor2(ss); ss += __shfl_xor(ss, 4);
          if (psub == 0) *(LAS float*)(lds + L_INV + pj * 4) = 1.0f / fmaxf(sqrtf(ss), 1e-12f);
          *(LAS u32x4*)(lds + L_TW + pj * PV + psub * 16) = pf[3]; *(LAS u32x4*)(lds + L_AL + pj * PV + psub * 16) = pf[4]; }
        LDS_BARRIER();
        if (c + NPROD < nchunk) WY_PREFETCH(c + NPROD);
#pragma unroll
        for (int cc = 0; cc < 2; ++cc) { const int ct = 2 * half + cc; const int cidx = 16 * ct + fr;
            f32x4 aw = (f32x4){0.f, 0.f, 0.f, 0.f}, aa = (f32x4){0.f, 0.f, 0.f, 0.f};
#pragma unroll
            for (int ks = 0; ks < 2; ++ks) { const size_t bo = (size_t)cidx * 64 + 32 * ks + 8 * fq;
                aw = ml::mma(ml::frag(lds, L_TW, PV, 16 * rt, 32 * ks, lane), *(const bf16x8*)(w2t + bo), aw); aa = ml::mma(ml::frag(lds, L_AL, PV, 16 * rt, 32 * ks, lane), *(const bf16x8*)(a2t + bo), aa); }
            float kr4[4], rr4[4], iv4[4];
#pragma unroll
            for (int r = 0; r < 4; ++r) { const int tok = 16 * rt + 4 * fq + r; kr4[r] = bf2f(*(const LAS bf16*)(lds + L_KH + tok * PV + cidx * 2)); rr4[r] = bf2f(*(const LAS bf16*)(lds + L_RH + tok * PV + cidx * 2));
                iv4[r] = *(const LAS float*)(lds + L_INV + tok * 4); }
            float lw[4], cum[4];
#pragma unroll
            for (int r = 0; r < 4; ++r) { lw[r] = -0.6065306597126334f * pg8::fsigmoid(c_w0[cc] + aw[r]); cum[r] = (r ? cum[r - 1] : 0.f) + lw[r]; }
            const float tot = cum[3]; const float p1 = __shfl_up(tot, 16), p2 = __shfl_up(tot, 32), p3 = __shfl_up(tot, 48);
            const float off = (fq >= 1 ? p1 : 0.f) + (fq >= 2 ? p2 : 0.f) + (fq >= 3 ? p3 : 0.f);
            float gprev = __expf(off);
#pragma unroll
            for (int r = 0; r < 4; ++r) { const int tok = 16 * rt + 4 * fq + r; const float lam = off + cum[r]; const float g = __expf(lam), gi = __builtin_amdgcn_rcpf(g);
                const float alpha = pg8::fsigmoid(c_a0[cc] + aa[r]);
                const float kraw = kr4[r], rraw = rr4[r];
                const float kkn = kraw * c_kk[cc] * iv4[r];
                const bf16 bh = f2bf(kkn * alpha * gi), kh = f2bf(kraw * (1.0f + (alpha - 1.0f) * c_ka[cc]) * gi);
                stb(lds, L_AH + tok * PV + cidx * 2, -kkn * gprev); stb(lds, L_RH + tok * PV + cidx * 2, rraw * g);
                *(LAS bf16*)(lds + L_BH + tok * PV + cidx * 2) = bh; *(LAS bf16*)(lds + L_KH + tok * PV + cidx * 2) = kh;
                *(LAS bf16*)(lds + L_BT + cidx * PV + tok * 2) = bh; *(LAS bf16*)(lds + L_KT + cidx * PV + tok * 2) = kh;
                if (fq == 3 && r == 3) *(LAS float*)(lds + L_GL + (rt * 64 + cidx) * 4) = g;
                gprev = g; } }
        asm volatile("s_waitcnt vmcnt(0)" ::: "memory");
        LDS_BARRIER();
        if (tid == 0 && c > pp) __hip_atomic_store(f_ready, (unsigned)((c - pp) / NPROD), __ATOMIC_RELAXED, __HIP_MEMORY_SCOPE_AGENT);
        { const int sc = w >> 1, side = w & 1; f32x4 gB = (f32x4){0.f, 0.f, 0.f, 0.f}, gK = (f32x4){0.f, 0.f, 0.f, 0.f};
#pragma unroll
          for (int ks = 0; ks < 2; ++ks) { const bf16x8 af = ml::frag(lds, side ? L_RH : L_AH, PV, 16 * sc, 32 * ks, lane);
              gB = ml::mma(af, ml::frag(lds, L_BH, PV, 16 * sc, 32 * ks, lane), gB); gK = ml::mma(af, ml::frag(lds, L_KH, PV, 16 * sc, 32 * ks, lane), gK); }
#pragma unroll
          for (int r = 0; r < 4; ++r) { const int t = 4 * fq + r; const bool keep = side ? (fr <= t) : (fr < t); const float vB = keep ? gB[r] : 0.f, vK = keep ? gK[r] : 0.f;
              if (side == 0) { *(LAS float*)(lds + L_NAB + ((sc * 16 + t) * 16 + fr) * 4) = vB; stb(lds, L_NAKT + (sc * 16 + t) * PS + fr * 2, vK); }
              else { stb(lds, L_NRBT + (sc * 16 + t) * PS + fr * 2, vB); stb(lds, L_NRKT + (sc * 16 + t) * PS + fr * 2, vK); } } }
        if ((w & 1) == 0 && lane < 16) { const int sc = w >> 1; float Tr[16];
            asm volatile("" ::: "memory");
#pragma unroll
            for (int ph = 0; ph < 4; ++ph) { f32x4 nv[4][4];
#pragma unroll
                for (int tq = 0; tq < 4; ++tq)
#pragma unroll
                    for (int u4 = 0; u4 <= ph; ++u4) nv[tq][u4] = *(const LAS f32x4*)(lds + L_NAB + ((sc * 16 + 4 * ph + tq) * 16 + 4 * u4) * 4);
#pragma unroll
                for (int tq = 0; tq < 4; ++tq) { const int t = 4 * ph + tq; float x0 = (lane == t) ? 1.f : 0.f, x1 = 0.f;
#pragma unroll
                    for (int u = 0; u < 16; ++u) if (u < t) { if (u & 1) x1 += Tr[u] * nv[tq][u >> 2][u & 3]; else x0 += Tr[u] * nv[tq][u >> 2][u & 3]; }
                    Tr[t] = x0 + x1; stb(lds, L_TT + (sc * 16 + t) * PS + lane * 2, Tr[t]); } } }
        if (tid == 0 && c >= RING && acked < (unsigned)(c - RING + 1)) acked = fl_wait_ge(f_ack, (unsigned)(c - RING + 1), tmo);
        LDS_BARRIER();
        asm volatile("" :: "v"(pf[0]), "v"(pf[1]), "v"(pf[2]), "v"(pf[3]), "v"(pf[4]) : "memory");
        { unsigned char* slot = ring + (size_t)(c % RING) * PACK_BYTES;
#pragma unroll
          for (int k = 0; k < 8; ++k) { const int u = tid + 512 * k;
              if (u < PACK_U) { const u32x4 v = *(const LAS u32x4*)(lds + 16 * u); const u32x4* gp = (const u32x4*)(slot + (size_t)16 * u);
                  asm volatile("global_store_dwordx4 %0, %1, off sc1" :: "v"(gp), "v"(v) : "memory"); } } }
        LDS_BARRIER();
    }
    asm volatile("s_waitcnt vmcnt(0)" ::: "memory");
    __syncthreads();
    if (tid == 0) __hip_atomic_store(f_ready, (unsigned)((nchunk - pp + NPROD - 1) / NPROD), __ATOMIC_RELAXED, __HIP_MEMORY_SCOPE_AGENT);
    LDS_BARRIER();
#undef WY_TOK
#undef WY_PREFETCH
}
__device__ __forceinline__ void rwkv_cons(LAS unsigned char* lds, CParams& P, int l, int s, int head, int dir, int chain, unsigned* ctl) {
    const int tid = tid_opaque(), w = __builtin_amdgcn_readfirstlane(tid >> 6), lane = tid & 63, fr = lane & 15, fq = lane >> 4;
    const int hc = head * 64;
    const SeqInfo q = seqinfo(s); const int nchunk = q.T / 64;
    bf16* U = WSP(bf16, WS_U1);
    const unsigned char* ring = P.ws + (chain < RING_A ? O_WIN1 + (size_t)chain * RING * PACK_BYTES : WS_END + (size_t)(chain - RING_A) * RING * PACK_BYTES);
    unsigned* f_base = ctl + CW_F + (size_t)((l * N_LAT + chain) * 4) * FL_STRIDE; unsigned* f_ack = f_base + NPROD * FL_STRIDE; unsigned* tmo = ctl + 4096 + 128;
    constexpr int C_IMG = PACK_BYTES + 64 * PV, C_YS = 2 * C_IMG;
    const bf16* RX = WSP(bf16, WS_RXC);
    static_assert(C_YS + 64 * PV <= 131072, "consumer LDS map");
    f32x4 sacc[4];
#pragma unroll
    for (int ct = 0; ct < 4; ++ct) sacc[ct] = (f32x4){0.f, 0.f, 0.f, 0.f};
    if (w < 4 && q.grid) { const size_t sb = (((size_t)q.b * DEPTH + l) * 2 + dir) * RH + head;
#pragma unroll
        for (int ct = 0; ct < 4; ++ct) sacc[ct] = *(const f32x4*)(P.in[ST_R] + (sb * 64 + 16 * w + fr) * 64 + 16 * ct + 4 * fq); }
#define WY_TOK(c, j) ((size_t)(q.base + (dir ? q.T - 1 - ((c) * 64 + (j)) : ((c) * 64 + (j)))))
    unsigned seen0 = 0u, seen1 = 0u;
#define CONS_FETCH(c, boff) do { const int p_ = (c) % NPROD; const unsigned need_ = (unsigned)((c) / NPROD + 1); \
        u32x4 vv_[2];   \
        _Pragma("unroll") for (int i_ = 0; i_ < 2; ++i_) vv_[i_] = *(const u32x4*)(RX + WY_TOK(c, lane) * RIN + RX_V + hc + 8 * (2 * (w - 4) + i_)); \
        if ((p_ ? seen1 : seen0) < need_) { unsigned v_ = 0u; if (lane == 0) v_ = fl_wait_ge(f_base + p_ * FL_STRIDE, need_, tmo); v_ = __builtin_amdgcn_readfirstlane(v_); \
            if (p_) seen1 = v_; else seen0 = v_; __builtin_amdgcn_fence(__ATOMIC_ACQUIRE, "agent"); } \
        _Pragma("unroll") for (int i_ = 0; i_ < 2; ++i_) { const unsigned wv_[4] = {vv_[i_].x, vv_[i_].y, vv_[i_].z, vv_[i_].w}; \
            _Pragma("unroll") for (int e_ = 0; e_ < 8; ++e_) *(LAS bf16*)(lds + (boff) + L_VS + (8 * (2 * (w - 4) + i_) + e_) * PVS + lane * 2) = (bf16)((wv_[e_ >> 1] >> ((e_ & 1) * 16)) & 0xffffu); } \
        const unsigned char* slot = ring + (size_t)((c) % RING) * PACK_BYTES; \
        for (int k = w - 4; k < PACK_BYTES / 1024; k += 4) \
            __builtin_amdgcn_global_load_lds((const unsigned*)(slot + (size_t)k * 1024 + lane * 16), (LAS unsigned*)(lds + (boff) + k * 1024), 16, 0, 0); \
        asm volatile("s_waitcnt vmcnt(0)" ::: "memory"); } while (0)
    if (w >= 4) CONS_FETCH(0, 0);
    LDS_BARRIER();
    if (tid == 256) __hip_atomic_store(f_ack, 1u, __ATOMIC_RELAXED, __HIP_MEMORY_SCOPE_AGENT);
    for (int c = 0; c < nchunk; ++c) {
        const int boff = (c & 1) * C_IMG;
        if (w >= 4) { if (c + 1 < nchunk) CONS_FETCH(c + 1, C_IMG - boff); }
        else {
            LAS unsigned char* pb = lds + boff;
#pragma unroll 1
            for (int sc = 0; sc < 4; ++sc) {
                const bf16x8 ah0 = ld_k32(pb, L_AH, PV, 16 * sc, 0, lane), ah1 = ld_k32(pb, L_AH, PV, 16 * sc, 32, lane), rh0 = ld_k32(pb, L_RH, PV, 16 * sc, 0, lane), rh1 = ld_k32(pb, L_RH, PV, 16 * sc, 32, lane);
                const bf16x8 nak = ld_k16(pb, L_NAKT, PS, 16 * sc, 0, lane), nrk = ld_k16(pb, L_NRKT, PS, 16 * sc, 0, lane), ttf = ld_k16(pb, L_TT, PS, 16 * sc, 0, lane), nrb = ld_k16(pb, L_NRBT, PS, 16 * sc, 0, lane);
                const bf16x8 vsf = ld_k16(pb, L_VS, PVS, 16 * w, 16 * sc, lane);
                bf16x8 btf[4], ktf[4]; f32x4 glv[4];
#pragma unroll
                for (int ct = 0; ct < 4; ++ct) { btf[ct] = ld_k16(pb, L_BT, PV, 16 * ct, 16 * sc, lane); ktf[ct] = ld_k16(pb, L_KT, PV, 16 * ct, 16 * sc, lane);
                    glv[ct] = *(const LAS f32x4*)(pb + L_GL + (sc * 64 + 16 * ct + 4 * fq) * 4); }
                const bf16x8 sb0 = pack_k32(sacc[0], sacc[1]), sb1 = pack_k32(sacc[2], sacc[3]);
                f32x4 XT = (f32x4){0.f, 0.f, 0.f, 0.f}, YT = (f32x4){0.f, 0.f, 0.f, 0.f};
                XT = ml::mma(ah0, sb0, XT); XT = ml::mma(ah1, sb1, XT); XT = ml::mma(nak, vsf, XT);
                YT = ml::mma(rh0, sb0, YT); YT = ml::mma(rh1, sb1, YT); YT = ml::mma(nrk, vsf, YT);
                f32x4 UT = (f32x4){0.f, 0.f, 0.f, 0.f};
                UT = ml::mma(ttf, pack_k16(XT), UT);
                const bf16x8 ub = pack_k16(UT);
                YT = ml::mma(nrb, ub, YT);
#pragma unroll
                for (int r = 0; r < 4; ++r) stb(lds, C_YS + (16 * sc + 4 * fq + r) * PV + (16 * w + fr) * 2, YT[r]);
#pragma unroll
                for (int ct = 0; ct < 4; ++ct) { sacc[ct] = ml::mma(btf[ct], ub, sacc[ct]); sacc[ct] = ml::mma(ktf[ct], vsf, sacc[ct]); sacc[ct] = sacc[ct] * glv[ct]; }
            }
            { const LAS unsigned char* yp = lds + C_YS + lane * PV + 32 * w; const u32x4 y0 = *(const LAS u32x4*)yp, y1 = *(const LAS u32x4*)(yp + 16);
              bf16* up = U + WY_TOK(c, lane) * PU + OFF_R + dir * RW + hc + 16 * w; *(u32x4*)up = y0; *(u32x4*)(up + 8) = y1; }
        }
        LDS_BARRIER();
        if (tid == 256 && c + 1 < nchunk) __hip_atomic_store(f_ack, (unsigned)(c + 2), __ATOMIC_RELAXED, __HIP_MEMORY_SCOPE_AGENT);
    }
    if (!q.grid && w < 4) { const size_t sb = (((size_t)q.b * DEPTH + l) * 2 + dir) * RH + head;
#pragma unroll
        for (int ct = 0; ct < 4; ++ct) *(f32x4*)(P.out + OUT_S + (sb * 64 + 16 * w + fr) * 64 + 16 * ct + 4 * fq) = sacc[ct]; }
    LDS_BARRIER();
#undef WY_TOK
#undef CONS_FETCH
}
constexpr int N_ITEMS = NSEQ * RH * 2;
__device__ __forceinline__ void decode_item(int it, int& s, int& head, int& dir) {
    dir = it & 1; int ch = it >> 1; head = ch % RH; const int sq = ch / RH;
    s = sq < LB ? CB + sq : sq - LB;
}
}

namespace ms {
using ml::PQ; using ml::PT; using ml::mma; using ml::frag; using wy::bf16x8; using wy::f32x4; using wy::u32x4;
constexpr int P_QS = 0, P_KT = P_QS + 64 * PQ, P_SB = P_KT + 128 * PT, P_SC = P_SB + 64 * PT, P_VT = P_SC + 4096, VT_BYTES = 21504, ML_PACK = P_VT + VT_BYTES, P_KS = ML_PACK, P_END = P_KS + 64 * PQ;
constexpr int ML_RING = 4, ML_PACK_U = ML_PACK / 16, N_MLAT = LB * MH * 2, CW_MF = 32768, MLPROD = 2;
static_assert(MLPROD == 2 && ML_RING % MLPROD == 0, "two producers per chain: even / odd chunks");
static_assert(ML_PACK % 1024 == 0 && ML_PACK_U <= 9 * 512 && 145 * PT <= VT_BYTES && P_END <= 131072 && 2 * ML_PACK <= 146432, "mLSTM pack layout");
static_assert(WS_END + (size_t)N_MLAT * ML_RING * ML_PACK <= ((size_t)256 << 20), "mLSTM ring fits behind the activations");
__device__ __forceinline__ void ml_prod(LAS unsigned char* lds, CParams& P, int l, int s, int head, int dir, int chain, int pp, unsigned* ctl) {
    const int tid = wy::tid_opaque(), w = __builtin_amdgcn_readfirstlane(tid >> 6), lane = tid & 63, fr = lane & 15, fq = lane >> 4;
    const int rt = w & 3, half = w >> 2;
    const SeqInfo q = seqinfo(s); const int nchunk = q.T / 64;
    const bf16* QK = WSP(bf16, WS_QKC); const bf16* U = WSP(bf16, WS_U1);
    LAS float* SC = (LAS float*)(lds + P_SC);
    unsigned char* ring = P.ws + WS_END + (size_t)chain * ML_RING * ML_PACK;
    unsigned* f_base = ctl + CW_MF + (size_t)((l * N_MLAT + chain) * 4) * wy::FL_STRIDE; unsigned* f_ready = f_base + pp * wy::FL_STRIDE; unsigned* f_ack = f_base + MLPROD * wy::FL_STRIDE; unsigned* tmo = ctl + 4096 + 128;
    float m_prev = 0.f;
    if (q.grid) m_prev = P.in[ST_M][(((size_t)q.b * DEPTH + l) * 2 + dir) * MH + head];
    const float bi = P.in[M_GATE_B][(size_t)l * 4 * MH + (2 * dir) * MH + head], bfg = P.in[M_GATE_B][(size_t)l * 4 * MH + (2 * dir + 1) * MH + head];
    for (int i = tid; i < (VT_BYTES - 128 * PT) / 2; i += 512) *(LAS bf16*)(lds + P_VT + 128 * PT + i * 2) = (i < 64) ? (bf16)0x3f80 : (bf16)0;
    u32x4 pqk[4]; u32x4 pv[2]; bf16 pgi = 0, pgf = 0, sgi = 0, sgf = 0;
#define ML_TOK(c, j) ((size_t)(q.base + (dir ? q.T - 1 - ((c) * 64 + (j)) : ((c) * 64 + (j)))))
#define ML_PREFETCH(c) do { _Pragma("unroll") for (int i = 0; i < 4; ++i) { const int id = tid + 512 * i, j = id >> 5, pc = id & 31; \
            pqk[i] = *(const u32x4*)(QK + ML_TOK(c, j) * (2 * MW) + (pc < 16 ? head * 128 + 8 * pc : MW + head * 128 + 8 * (pc - 16))); } \
        _Pragma("unroll") for (int i = 0; i < 2; ++i) { const int id = tid + 512 * i, j = id >> 4, pc = id & 15; pv[i] = *(const u32x4*)(U + ML_TOK(c, j) * PU + OFF_V + head * 128 + 8 * pc); } \
        if (w == 0) { const bf16* g = U + ML_TOK(c, lane) * PU + OFF_G; pgi = g[(2 * dir) * MH + head]; pgf = g[(2 * dir + 1) * MH + head]; \
            if ((c) >= 1) { const bf16* g2 = U + ML_TOK((c) - 1, lane) * PU + OFF_G; sgi = g2[(2 * dir) * MH + head]; sgf = g2[(2 * dir + 1) * MH + head]; } } } while (0)
#define ML_TOUCH() asm volatile("" :: "v"(pqk[0]), "v"(pqk[1]), "v"(pqk[2]), "v"(pqk[3]), "v"(pv[0]), "v"(pv[1]), "v"((unsigned)pgi), "v"((unsigned)pgf), "v"((unsigned)sgi), "v"((unsigned)sgf) : "memory")
#define ML_SCAN(gi_, gf_) \
            const float gi = bf2f(gi_) + bi, gf = bf2f(gf_) + bfg; \
            const float lf = fminf(gf, 0.f) - log1pf(__expf(-fabsf(gf))); \
            float b = lf; \
            _Pragma("unroll") for (int o = 1; o < 64; o <<= 1) { const float t = __shfl_up(b, o); if (lane >= o) b += t; } \
            const float a = gi - b; float pm = a; \
            _Pragma("unroll") for (int o = 1; o < 64; o <<= 1) { const float t = __shfl_up(pm, o); if (lane >= o) pm = fmaxf(pm, t); } \
            pm = fmaxf(pm, m_prev); \
            const float pm63 = __shfl(pm, 63), b63 = __shfl(b, 63);
    ML_PREFETCH(pp);
    ML_TOUCH();
    unsigned acked = 0u;
    for (int c = pp; c < nchunk; c += MLPROD) {
        if (w == 0 && c >= 1) { ML_SCAN(sgi, sgf) m_prev = b63 + pm63; }
#pragma unroll
        for (int i = 0; i < 4; ++i) { const int id = tid + 512 * i, j = id >> 5, pc = id & 31;
            *(LAS u32x4*)(lds + (pc < 16 ? P_QS : P_KS) + j * PQ + (pc & 15) * 16) = pqk[i]; }
#pragma unroll
        for (int i = 0; i < 2; ++i) { const int id = tid + 512 * i, j = id >> 4, pc = id & 15; const unsigned wv[4] = {pv[i].x, pv[i].y, pv[i].z, pv[i].w};
#pragma unroll
            for (int e = 0; e < 8; ++e) *(LAS bf16*)(lds + P_VT + (8 * pc + e) * PT + j * 2) = (bf16)((wv[e >> 1] >> ((e & 1) * 16)) & 0xffffu); }
        if (w == 0) {
            ML_SCAN(pgi, pgf)
            SC[ml::SC_A + lane] = a; SC[ml::SC_PM + lane] = pm; SC[ml::SC_WI + lane] = __expf(m_prev - pm); SC[ml::SC_EMT + lane] = __expf(-(b + pm)); SC[ml::SC_WE + lane] = __expf(a - pm63);
            if (lane == 0) { SC[ml::SC_MISC] = __expf(m_prev - pm63); SC[ml::SC_MISC + 1] = b63 + pm63; }
            m_prev = b63 + pm63;
        }
        LDS_BARRIER();
        if (c + MLPROD < nchunk) ML_PREFETCH(c + MLPROD);
#pragma unroll
        for (int i = 0; i < 2; ++i) { const int id = tid + 512 * i, j = id & 63, pc = id >> 6; const float we = SC[ml::SC_WE + j];
            const u32x4 kv = *(const LAS u32x4*)(lds + P_KS + j * PQ + pc * 16); const unsigned wv[4] = {kv.x, kv.y, kv.z, kv.w};
#pragma unroll
            for (int e = 0; e < 8; ++e) { const float kf = __builtin_bit_cast(float, (e & 1) ? (wv[e >> 1] & 0xffff0000u) : (wv[e >> 1] << 16));
                *(LAS bf16*)(lds + P_KT + (8 * pc + e) * PT + j * 2) = f2bf(kf * we); } }
#pragma unroll
        for (int cc = 0; cc < 2; ++cc) { const int ct = 2 * half + cc;
            f32x4 acc = (f32x4){0.f, 0.f, 0.f, 0.f};
            if (ct <= rt) {
#pragma unroll
                for (int k = 0; k < 4; ++k) acc = mma(frag(lds, P_QS, PQ, 16 * rt, 32 * k, lane), frag(lds, P_KS, PQ, 16 * ct, 32 * k, lane), acc);
            }
            const int sp = 16 * ct + fr; const float as = SC[ml::SC_A + sp];
#pragma unroll
            for (int r = 0; r < 4; ++r) { const int t = 16 * rt + 4 * fq + r; const float v = (sp <= t) ? acc[r] * __expf(as - SC[ml::SC_PM + t]) : 0.f;
                *(LAS bf16*)(lds + P_SB + t * PT + sp * 2) = f2bf(v); } }
        asm volatile("s_waitcnt vmcnt(0)" ::: "memory");
        if (tid == 0 && c >= ML_RING && acked < (unsigned)(c - ML_RING + 1)) acked = wy::fl_wait_ge(f_ack, (unsigned)(c - ML_RING + 1), tmo);
        LDS_BARRIER();
        if (tid == 0 && c > pp) __hip_atomic_store(f_ready, (unsigned)((c - pp) / MLPROD), __ATOMIC_RELAXED, __HIP_MEMORY_SCOPE_AGENT);
        ML_TOUCH();
        { unsigned char* slot = ring + (size_t)(c % ML_RING) * ML_PACK;
#pragma unroll
          for (int k = 0; k < 9; ++k) { const int u = tid + 512 * k;
              if (u < ML_PACK_U) { const u32x4 v = *(const LAS u32x4*)(lds + 16 * u); const u32x4* gp = (const u32x4*)(slot + (size_t)16 * u);
                  asm volatile("global_store_dwordx4 %0, %1, off sc1" :: "v"(gp), "v"(v) : "memory"); } } }
        LDS_BARRIER();
    }
    asm volatile("s_waitcnt vmcnt(0)" ::: "memory");
    __syncthreads();
    if (tid == 0) __hip_atomic_store(f_ready, (unsigned)((nchunk - pp + MLPROD - 1) / MLPROD), __ATOMIC_RELAXED, __HIP_MEMORY_SCOPE_AGENT);
    LDS_BARRIER();
#undef ML_TOK
#undef ML_PREFETCH
#undef ML_TOUCH
#undef ML_SCAN
}
__device__ __forceinline__ void ml_cons(LAS unsigned char* lds, CParams& P, int l, int s, int head, int dir, int chain, unsigned* ctl) {
    const int tid = wy::tid_opaque(), w = __builtin_amdgcn_readfirstlane(tid >> 6), lane = tid & 63, fr = lane & 15, fq = lane >> 4;
    const SeqInfo q = seqinfo(s); const int nchunk = q.T / 64;
    bf16* U = WSP(bf16, WS_U1);
    const unsigned char* ring = P.ws + WS_END + (size_t)chain * ML_RING * ML_PACK;
    unsigned* f_base = ctl + CW_MF + (size_t)((l * N_MLAT + chain) * 4) * wy::FL_STRIDE; unsigned* f_ack = f_base + MLPROD * wy::FL_STRIDE; unsigned* tmo = ctl + 4096 + 128;
    f32x4 cst[8][3];
#pragma unroll
    for (int kt = 0; kt < 8; ++kt)
#pragma unroll
        for (int j = 0; j < 3; ++j) cst[kt][j] = (f32x4){0.f, 0.f, 0.f, 0.f};
    if (w < 4 && q.grid) { const size_t sb = (((size_t)q.b * DEPTH + l) * 2 + dir) * MH + head;
#pragma unroll
        for (int kt = 0; kt < 8; ++kt)
#pragma unroll
            for (int r = 0; r < 4; ++r) { const int d = 16 * kt + 4 * fq + r;
                cst[kt][0][r] = P.in[ST_C][(sb * 128 + d) * 128 + 32 * w + fr]; cst[kt][1][r] = P.in[ST_C][(sb * 128 + d) * 128 + 32 * w + 16 + fr];
                cst[kt][2][r] = (fr == 0) ? P.in[ST_N][sb * 128 + d] : 0.f; } }
#define ML_TOK(c, j) ((size_t)(q.base + (dir ? q.T - 1 - ((c) * 64 + (j)) : ((c) * 64 + (j)))))
    unsigned seen0 = 0u, seen1 = 0u;
#define MLC_FETCH(c, boff) do { const int p_ = (c) % MLPROD; const unsigned need_ = (unsigned)((c) / MLPROD + 1); \
        if ((p_ ? seen1 : seen0) < need_) { unsigned v_ = 0u; if (lane == 0) v_ = wy::fl_wait_ge(f_base + p_ * wy::FL_STRIDE, need_, tmo); v_ = __builtin_amdgcn_readfirstlane(v_); \
            if (p_) seen1 = v_; else seen0 = v_; __builtin_amdgcn_fence(__ATOMIC_ACQUIRE, "agent"); } \
        const unsigned char* slot = ring + (size_t)((c) % ML_RING) * ML_PACK; \
        for (int k = w - 4; k < ML_PACK / 1024; k += 4) \
            __builtin_amdgcn_global_load_lds((const unsigned*)(slot + (size_t)k * 1024 + lane * 16), (LAS unsigned*)(lds + (boff) + k * 1024), 16, 0, 0); \
        asm volatile("s_waitcnt vmcnt(0)" ::: "memory"); } while (0)
    if (w >= 4) MLC_FETCH(0, 0);
    LDS_BARRIER();
    if (tid == 256) __hip_atomic_store(f_ack, 1u, __ATOMIC_RELAXED, __HIP_MEMORY_SCOPE_AGENT);
    for (int c = 0; c < nchunk; ++c) {
        const int boff = (c & 1) * ML_PACK;
        if (w >= 4) { if (c + 1 < nchunk) MLC_FETCH(c + 1, ML_PACK - boff); }
        else {
            LAS unsigned char* pb = lds + boff; const LAS float* SC = (const LAS float*)(pb + P_SC);
            const float wie = SC[ml::SC_MISC];
            bf16x8 vf[3][2];
#pragma unroll
            for (int j = 0; j < 3; ++j)
#pragma unroll
                for (int k = 0; k < 2; ++k) vf[j][k] = frag(pb, P_VT, PT, j < 2 ? 32 * w + 16 * j : 128, 32 * k, lane);
            asm volatile("s_waitcnt lgkmcnt(0)" ::: "memory");
            LAS unsigned char* hp = pb + P_VT + 32 * w * PT;
#pragma unroll
            for (int rt = 0; rt < 4; ++rt) {
                f32x4 num[3];
#pragma unroll
                for (int j = 0; j < 3; ++j) { f32x4 a1 = (f32x4){0.f, 0.f, 0.f, 0.f}, a2 = (f32x4){0.f, 0.f, 0.f, 0.f};
#pragma unroll
                    for (int k = 0; k < 2; ++k) a1 = mma(frag(pb, P_SB, PT, 16 * rt, 32 * k, lane), vf[j][k], a1);
#pragma unroll
                    for (int kb = 0; kb < 4; ++kb) a2 = mma(wy::ld_k32(pb, P_QS, PQ, 16 * rt, 32 * kb, lane), wy::pack_k32(cst[2 * kb][j], cst[2 * kb + 1][j]), a2);
#pragma unroll
                    for (int r = 0; r < 4; ++r) a1[r] += SC[ml::SC_WI + 16 * rt + 4 * fq + r] * a2[r];
                    num[j] = a1; }
#pragma unroll
                for (int r = 0; r < 4; ++r) { const int t = 16 * rt + 4 * fq + r; const float dn = __shfl(num[2][r], lane & 48);
                    const float rden = __builtin_amdgcn_rcpf(fmaxf(fabsf(dn), SC[ml::SC_EMT + t]));
                    *(LAS bf16*)(hp + t * 64 + fr * 2) = f2bf(num[0][r] * rden); *(LAS bf16*)(hp + t * 64 + (16 + fr) * 2) = f2bf(num[1][r] * rden); }
            }
#pragma unroll
            for (int kt = 0; kt < 8; ++kt) { const bf16x8 k0 = frag(pb, P_KT, PT, 16 * kt, 0, lane), k1 = frag(pb, P_KT, PT, 16 * kt, 32, lane);
#pragma unroll
                for (int j = 0; j < 3; ++j) { cst[kt][j] = cst[kt][j] * wie; cst[kt][j] = mma(k0, vf[j][0], cst[kt][j]); cst[kt][j] = mma(k1, vf[j][1], cst[kt][j]); } }
            { const LAS unsigned char* yp = hp + lane * 64; bf16* up = U + ML_TOK(c, lane) * PU + dir * MW + head * 128 + 32 * w;
#pragma unroll
              for (int i = 0; i < 4; ++i) *(u32x4*)(up + 8 * i) = *(const LAS u32x4*)(yp + 16 * i); }
        }
        LDS_BARRIER();
        if (tid == 256 && c + 1 < nchunk) __hip_atomic_store(f_ack, (unsigned)(c + 2), __ATOMIC_RELAXED, __HIP_MEMORY_SCOPE_AGENT);
    }
    LDS_BARRIER();
#undef ML_TOK
#undef MLC_FETCH
}
}

namespace el {
typedef float f32x4 __attribute__((ext_vector_type(4)));
typedef unsigned u32x4 __attribute__((ext_vector_type(4)));
typedef unsigned u32x2 __attribute__((ext_vector_type(2)));
typedef short bf16x8 __attribute__((ext_vector_type(8)));
__device__ __forceinline__ float wave_sum(float v) {
#pragma unroll
    for (int o = 1; o < 64; o <<= 1) v += __shfl_xor(v, o);
    return v;
}
__device__ __forceinline__ void unpack8(const u32x4 p, float (&f)[8]) {
    f[0] = pg8::bflo(p.x); f[1] = pg8::bfhi(p.x); f[2] = pg8::bflo(p.y); f[3] = pg8::bfhi(p.y); f[4] = pg8::bflo(p.z); f[5] = pg8::bfhi(p.z); f[6] = pg8::bflo(p.w); f[7] = pg8::bfhi(p.w);
}
__device__ __forceinline__ u32x4 pack8(const float (&f)[8]) {
    u32x4 o; o.x = pg8::cvt_pk_bf16(f[0], f[1]); o.y = pg8::cvt_pk_bf16(f[2], f[3]); o.z = pg8::cvt_pk_bf16(f[4], f[5]); o.w = pg8::cvt_pk_bf16(f[6], f[7]); return o;
}
__device__ __forceinline__ void init_phase(LAS unsigned char* lds, CParams& P, int vb, int G) {
    const int tid = threadIdx.x, w = tid >> 6, lane = tid & 63;
    LAS float* red = (LAS float*)lds;
    constexpr int KW = D / 8;
    for (int it = vb; it < DEPTH * (6 * D / 64); it += G) {
        const int l = it / (6 * D / 64), j = (it % (6 * D / 64)) * 64 + lane;
        const float* wp = P.in[ADA_W] + ((size_t)l * D + w * KW) * 6 * D + j;
        float acc[NCOND];
#pragma unroll
        for (int ci = 0; ci < NCOND; ++ci) acc[ci] = 0.f;
        for (int k = 0; k < KW; ++k) { const float wv = wp[(size_t)k * 6 * D];
#pragma unroll
            for (int ci = 0; ci < NCOND; ++ci) { const float cv = ci == 0 ? P.in[C_CTX][w * KW + k] : P.in[C_LAT][(size_t)(ci - 1) * D + w * KW + k]; acc[ci] += cv * pg8::fsigmoid(cv) * wv; } }
#pragma unroll
        for (int ci = 0; ci < NCOND; ++ci) red[(w * NCOND + ci) * 64 + lane] = acc[ci];
        __syncthreads();
        if (w < NCOND) { float sum = P.in[ADA_B][(size_t)l * 6 * D + j];
#pragma unroll
            for (int ww = 0; ww < 8; ++ww) sum += red[(ww * NCOND + w) * 64 + lane];
            WSP(float, WS_MOD)[((size_t)l * NCOND + w) * 6 * D + j] = sum; }
        __syncthreads();
    }
}
__device__ __forceinline__ int perm5(int n) { return (((n >> 2) & 1) << 4) | (((n >> 3) & 3) << 2) | (n & 3); }
__device__ __forceinline__ void transpose_item(const float* W, int ldw, int nvalid, bf16* dst, int K, int k0, int drow0, bool perm, LAS float* scr, int lane) {
    f32x4 tv[8];
#pragma unroll
    for (int i = 0; i < 8; ++i) { const int kk = 8 * i + (lane >> 3), n4 = (lane & 7) * 4; tv[i] = n4 < nvalid ? *(const f32x4*)(W + (size_t)kk * ldw + n4) : (f32x4){0.f, 0.f, 0.f, 0.f}; }
#pragma unroll
    for (int i = 0; i < 8; ++i) { const int kk = 8 * i + (lane >> 3), n4 = (lane & 7) * 4;
#pragma unroll
        for (int e = 0; e < 4; ++e) scr[kk * 33 + n4 + e] = tv[i][e]; }
    asm volatile("s_waitcnt lgkmcnt(0)" ::: "memory");
    const int c = lane & 7;
#pragma unroll
    for (int j = 0; j < 4; ++j) { const int n = (lane >> 3) + 8 * j; const LAS float* sp = scr + (8 * c) * 33 + n;
        u32x4 o; o.x = pg8::cvt_pk_bf16(sp[0 * 33], sp[1 * 33]); o.y = pg8::cvt_pk_bf16(sp[2 * 33], sp[3 * 33]); o.z = pg8::cvt_pk_bf16(sp[4 * 33], sp[5 * 33]); o.w = pg8::cvt_pk_bf16(sp[6 * 33], sp[7 * 33]);
        *(u32x4*)(dst + (size_t)(drow0 + (perm ? perm5(n) : n)) * K + k0 + 8 * c) = o; }
    asm volatile("s_waitcnt lgkmcnt(0)" ::: "memory");
}
constexpr int WI_0 = (N1P / 32) * (D / 64), WI_1 = WI_0 + (2 * D / 32) * (D / 64), WI_2 = WI_1 + (D / 32) * (MW / 64), WI_3 = WI_2 + (D / 32) * (RW / 64),
              WI_4 = WI_3 + (D / 32) * (D / 64), WI_5 = WI_4 + 2 * (FF / 32) * (D / 64), WI_6 = WI_5 + (D / 32) * (FF / 64), WI_7 = WI_6 + (RW / 32) * (128 / 64), WI_8 = WI_7 + 4 * (RW / 32);
__device__ __forceinline__ void wconv_phase(LAS unsigned char* lds, CParams& P, int l, int vb, int G) {
    const int tid = threadIdx.x, w = tid >> 6, lane = tid & 63;
    LAS float* scr = (LAS float*)(lds + w * 8704);
    for (int it = vb * 8 + w; it < WI_8; it += G * 8) {
        if (it < WI_0) { const int nb = it / (D / 64), kb = it % (D / 64); const int n0 = nb * 32; const int nv = n0 >= N1 ? 0 : (N1 - n0 < 32 ? N1 - n0 : 32);
            transpose_item(P.in[W_IN] + ((size_t)l * D + kb * 64) * PIN + n0, PIN, nv, WSP(bf16, O_WIN1), D, kb * 64, n0, true, scr, lane); }
        else if (it < WI_1) { const int r = it - WI_0, nb = r / (D / 64), kb = r % (D / 64);
            transpose_item(P.in[W_IN] + ((size_t)l * D + kb * 64) * PIN + N1 + nb * 32, PIN, 32, WSP(bf16, O_WIN2), D, kb * 64, nb * 32, true, scr, lane); }
        else if (it < WI_2) { const int r = it - WI_1, nb = r / (MW / 64), kb = r % (MW / 64);
            transpose_item(P.in[PROJ_M] + ((size_t)l * MW + kb * 64) * D + nb * 32, D, 32, WSP(bf16, O_PM), MW, kb * 64, nb * 32, true, scr, lane); }
        else if (it < WI_3) { const int r = it - WI_2, nb = r / (RW / 64), kb = r % (RW / 64);
            transpose_item(P.in[PROJ_R] + ((size_t)l * RW + kb * 64) * D + nb * 32, D, 32, WSP(bf16, O_PR), RW, kb * 64, nb * 32, true, scr, lane); }
        else if (it < WI_4) { const int r = it - WI_3, nb = r / (D / 64), kb = r % (D / 64);
            transpose_item(P.in[W_OUT] + ((size_t)l * D + kb * 64) * D + nb * 32, D, 32, WSP(bf16, O_WO), D, kb * 64, nb * 32, false, scr, lane); }
        else if (it < WI_5) { const int r = it - WI_4, which = r / ((FF / 32) * (D / 64)), r2 = r % ((FF / 32) * (D / 64)), nb = r2 / (D / 64), kb = r2 % (D / 64);
            const int j0 = nb * 32, pn = j0 >> 7, drow0 = pn * 256 + which * 128 + (j0 & 127);
            transpose_item((which ? P.in[FFN_W3] : P.in[FFN_W1]) + ((size_t)l * D + kb * 64) * FF + j0, FF, 32, WSP(bf16, O_W13), D, kb * 64, drow0, true, scr, lane); }
        else if (it < WI_6) { const int r = it - WI_5, nb = r / (FF / 64), kb = r % (FF / 64);
            transpose_item(P.in[FFN_W2] + ((size_t)l * FF + kb * 64) * D + nb * 32, D, 32, WSP(bf16, O_W2), FF, kb * 64, nb * 32, false, scr, lane); }
        else if (it < WI_7) { const int r = it - WI_6, nb = r / 2, kb = r % 2;
            transpose_item(P.in[R_G2] + ((size_t)l * 128 + kb * 64) * RW + nb * 32, RW, 32, WSP(bf16, O_G2T), 128, kb * 64, nb * 32, false, scr, lane); }
        else { const int r = it - WI_7, which = r / (2 * (RW / 32)), d = (r / (RW / 32)) & 1, nb = r % (RW / 32);
            transpose_item((which ? P.in[R_A2] : P.in[R_W2]) + ((size_t)l * 2 + d) * 64 * RW + nb * 32, RW, 32, WSP(bf16, which ? O_A2T : O_W2T) + (size_t)d * RW * 64, 64, 0, nb * 32, false, scr, lane); }
    }
}
__device__ __forceinline__ void norm_phase(CParams& P, int l, int mode, int vb, int G) {
    const int tid = threadIdx.x, w = tid >> 6, lane = tid & 63;
    for (int m = vb * 8 + w; m < NT; m += G * 8) {
        float* xr = P.out + (size_t)m * D;
        const float* xs = (l == 0 && mode < 2) ? (m < NC ? P.in[X_PROMPT] + (size_t)m * D : P.in[X_SAMPLE] + (size_t)(m - NC) * D) : xr;
        f32x4 v[D / 256]; float ss = 0.f;
#pragma unroll
        for (int j = 0; j < D / 256; ++j) { v[j] = *(const f32x4*)(xs + 256 * j + 4 * lane); ss += (v[j][0] * v[j][0] + v[j][1] * v[j][1]) + (v[j][2] * v[j][2] + v[j][3] * v[j][3]); }
        const float rs = 1.0f / sqrtf(wave_sum(ss) * (1.0f / D) + RMS_EPS);
        if (mode == 3) {
#pragma unroll
            for (int j = 0; j < D / 256; ++j) { const f32x4 g = *(const f32x4*)(P.in[FINAL_G] + 256 * j + 4 * lane); *(f32x4*)(xr + 256 * j + 4 * lane) = v[j] * rs * g; }
        } else {
            const int second = (mode == 2); const int cond = seqinfo(seq_of_token(m)).cond;
            const float* gp = P.in[second ? NORM2 : NORM1] + (size_t)l * D; const float* mod = WSP(float, WS_MOD) + ((size_t)l * NCOND + cond) * 6 * D + (second ? 3 * D : 0);
            bf16* o = WSP(bf16, mode == 1 ? WS_RXC : WS_QKC) + (size_t)m * D;
#pragma unroll
            for (int j = 0; j < D / 256; ++j) { const int c = 256 * j + 4 * lane; const f32x4 g = *(const f32x4*)(gp + c), sh = *(const f32x4*)(mod + c), sc = *(const f32x4*)(mod + D + c);
                const f32x4 y = v[j] * rs * g * (sc + 1.0f) + sh; u32x2 pk; pk.x = pg8::cvt_pk_bf16(y[0], y[1]); pk.y = pg8::cvt_pk_bf16(y[2], y[3]); *(u32x2*)(o + c) = pk; }
        }
    }
}
constexpr int CV_NCH = 2 * MW + RIN, CV_NG = CV_NCH / 4, CV_NCHUNK = (CV_NG + 63) / 64, CV_SEG = 16, CV_PAIRS = NC / (2 * CV_SEG);
static_assert(CV_NCHUNK == 12 && NC == NT - NC && GW % CV_SEG == 0 && CT % CV_SEG == 0 && 2 * MW == 1024 && RX_WL == 1536, "conv item layout");
typedef float f32x2 __attribute__((ext_vector_type(2)));
struct CvAct { float alpha, cA, cB, cC, cD; bool any; };
template <int NR> struct CvState { f32x2 wt[NR * 3][2]; f32x2 fw[NR][3][2]; u32x2 p[3][NR]; };
__device__ __forceinline__ void cv_unpk(const u32x2 p, f32x2 (&f)[2]) { f[0].x = pg8::bflo(p.x); f[0].y = pg8::bfhi(p.x); f[1].x = pg8::bflo(p.y); f[1].y = pg8::bfhi(p.y); }
template <int NR> __device__ __forceinline__ u32x2 cv_ld(const bf16* const (&rowp)[NR], const bool (&rok)[NR], int a, int col, int W) {
    const u32x2 zero2 = {0u, 0u};
    return (rok[a] && col >= 0 && col < W) ? *(const u32x2*)(rowp[a] + (size_t)col * PU) : zero2;
}
template <int NR, int S> __device__ __forceinline__ void cv_col(CvState<NR>& st, const bf16* const (&rowp)[NR], const bool (&rok)[NR], int cs, int W, int o, const CvAct& act, bf16* dst) {
#pragma unroll
    for (int a = 0; a < NR; ++a) { cv_unpk(st.p[S][a], st.fw[a][(S + 2) % 3]); const u32x2 zero2 = {0u, 0u}; st.p[S][a] = (o + 4 <= CV_SEG) ? cv_ld<NR>(rowp, rok, a, cs + o + 4, W) : zero2; }
    f32x2 acc[2];
#pragma unroll
    for (int e = 0; e < 2; ++e) acc[e] = st.wt[0][e] * st.fw[0][S][e];
#pragma unroll
    for (int a = 0; a < NR; ++a)
#pragma unroll
        for (int b = 0; b < 3; ++b) if (a + b > 0) {
#pragma unroll
            for (int e = 0; e < 2; ++e) acc[e] = __builtin_elementwise_fma(st.wt[a * 3 + b][e], st.fw[a][(S + b) % 3][e], acc[e]); }
    float v[4] = {acc[0].x, acc[0].y, acc[1].x, acc[1].y};
    if (act.any) {
#pragma unroll
        for (int e = 0; e < 4; ++e) { const float t = __builtin_amdgcn_rcpf(__builtin_amdgcn_exp2f(act.alpha * v[e]) + 1.0f); v[e] = (act.cA * v[e] + act.cB) * t + (act.cC * v[e] + act.cD); }
    }
    u32x2 pk; pk.x = pg8::cvt_pk_bf16(v[0], v[1]); pk.y = pg8::cvt_pk_bf16(v[2], v[3]);
    *(u32x2*)dst = pk;
}
template <int NR> __device__ __forceinline__ void conv_item(const bf16* const (&rowp)[NR], const bool (&rok)[NR], int cs, int W, const float* wsrc, int CH, const CvAct& act, bf16* dst, int dpitch) {
    CvState<NR> st;
#pragma unroll
    for (int a = 0; a < NR * 3; ++a) { const int tap = NR == 3 ? a : 3 + a; const f32x4 w0 = *(const f32x4*)(wsrc + (size_t)tap * CH);
        st.wt[a][0].x = w0[0]; st.wt[a][0].y = w0[1]; st.wt[a][1].x = w0[2]; st.wt[a][1].y = w0[3]; }
#pragma unroll
    for (int a = 0; a < NR; ++a) { cv_unpk(cv_ld<NR>(rowp, rok, a, cs - 1, W), st.fw[a][0]); cv_unpk(cv_ld<NR>(rowp, rok, a, cs, W), st.fw[a][1]); }
#pragma unroll
    for (int s3 = 0; s3 < 3; ++s3)
#pragma unroll
        for (int a = 0; a < NR; ++a) st.p[s3][a] = cv_ld<NR>(rowp, rok, a, cs + 1 + s3, W);
#pragma unroll 1
    for (int o = 0; o < CV_SEG - 1; o += 3) {
        cv_col<NR, 0>(st, rowp, rok, cs, W, o, act, dst + (size_t)o * dpitch);
        cv_col<NR, 1>(st, rowp, rok, cs, W, o + 1, act, dst + (size_t)(o + 1) * dpitch);
        cv_col<NR, 2>(st, rowp, rok, cs, W, o + 2, act, dst + (size_t)(o + 2) * dpitch);
    }
    cv_col<NR, 0>(st, rowp, rok, cs, W, CV_SEG - 1, act, dst + (size_t)(CV_SEG - 1) * dpitch);
}
__device__ __forceinline__ void conv_phase(LAS unsigned char* lds, CParams& P, int l, int vb, int G) {
    const int tid = threadIdx.x, lane = tid & 63;
    const bf16* U = WSP(bf16, WS_U1);
    LAS unsigned* cnt = (LAS unsigned*)lds;
    for (int sp = vb; sp < CV_PAIRS; sp += G) {
        __syncthreads();
        if (tid == 0) *cnt = 0u;
        __syncthreads();
        for (;;) {
            unsigned j = 0; if (lane == 0) j = __hip_atomic_fetch_add(cnt, 1u, __ATOMIC_RELAXED, __HIP_MEMORY_SCOPE_WORKGROUP);
            j = __builtin_amdgcn_readfirstlane(j);
            if (j >= 48u) break;
            const int cls = j / 12, jj = j % 12, lat = (cls & 1) == 0, heavy = cls < 2, ci = jj >> 1, chunk = heavy ? (ci >= 4 ? 6 + ci : ci) : 4 + ci;
            const int seg = (lat ? NC / CV_SEG : 0) + 2 * sp + (jj & 1), g = chunk * 64 + lane;
            if (g >= CV_NG) continue;
            const int ch = 4 * g; const bool isqk = ch < 2 * MW; const int c = isqk ? ch : ch - 2 * MW;
            const int ucol = isqk ? OFF_QK + c : OFF_R + c, CH = isqk ? 2 * MW : RIN;
            const float* wsrc = (isqk ? P.in[M_CONV] : P.in[R_CONV]) + (size_t)l * 9 * CH + c;
            const int kind = isqk ? (c < MW ? 0 : 1) : (c >= RX_GL ? 4 : (c >= RX_AL ? 2 : (c >= RX_WL ? 3 : 2)));
            CvAct act; act.alpha = kind == 3 ? 2.8853900817779268f : -1.4426950408889634f;
            act.cA = kind == 0 ? 0.08838834764831845f : (kind == 1 ? 1.0f : 0.0f); act.cB = kind == 3 ? -2.0f : (kind == 4 ? 1.0f : 0.0f); act.cC = kind == 2 ? 1.0f : 0.0f; act.cD = kind == 3 ? 1.0f : 0.0f;
            act.any = heavy;
            const int m0 = seg * CV_SEG; const SeqInfo q = seqinfo(seq_of_token(m0)); const int t0 = m0 - q.base;
            bf16* dst = isqk ? WSP(bf16, WS_QKC) + (size_t)m0 * (2 * MW) + c : WSP(bf16, WS_RXC) + (size_t)m0 * RIN + c; const int dpitch = isqk ? 2 * MW : RIN;
            if (q.grid) {
                const int r = t0 / GW, cs = t0 % GW, rows = q.T / GW;
                const bf16* rowp[3]; bool rok[3];
#pragma unroll
                for (int a = 0; a < 3; ++a) { const int rr = r + a - 1; rok[a] = rr >= 0 && rr < rows; rowp[a] = U + (size_t)(q.base + (rok[a] ? rr : r) * GW) * PU + ucol; }
                conv_item<3>(rowp, rok, cs, GW, wsrc, CH, act, dst, dpitch);
            } else {
                const bf16* rowp[1] = {U + (size_t)q.base * PU + ucol}; const bool rok[1] = {true};
                conv_item<1>(rowp, rok, t0, q.T, wsrc, CH, act, dst, dpitch);
            }
        }
    }
}
constexpr int PO_ITEMS = (NT / 16) * 2, PO_HC = RW / 2;
__device__ __forceinline__ void post_phase(LAS unsigned char* lds, CParams& P, int l, int vb, int G) {
    const int tid = threadIdx.x, w = tid >> 6, lane = tid & 63, fr = lane & 15, fq = lane >> 4, l32 = lane & 31, th = lane >> 5;
    constexpr int GP = PO_HC * 2 + 16;
    LAS unsigned char* gt = lds + w * (16 * GP);
    const bf16* U = WSP(bf16, WS_U1); const bf16* RX = WSP(bf16, WS_RXC); const bf16* G2T = WSP(bf16, O_G2T); bf16* O = WSP(bf16, WS_QKC);
    for (int it = vb * 8 + w; it < PO_ITEMS; it += G * 8) {
        const int tile = it >> 1, h = it & 1; const size_t tok0 = (size_t)tile * 16;
        bf16x8 af[4];
#pragma unroll
        for (int ks = 0; ks < 4; ++ks) af[ks] = *(const bf16x8*)(RX + (tok0 + fr) * RIN + RX_GL + 32 * ks + 8 * fq);
        for (int ct = 0; ct < PO_HC / 16; ++ct) { f32x4 acc = (f32x4){0.f, 0.f, 0.f, 0.f};
#pragma unroll
            for (int ks = 0; ks < 4; ++ks) acc = ml::mma(af[ks], *(const bf16x8*)(G2T + (size_t)(h * PO_HC + 16 * ct + fr) * 128 + 32 * ks + 8 * fq), acc);
#pragma unroll
            for (int r = 0; r < 4; ++r) *(LAS bf16*)(gt + (4 * fq + r) * GP + (16 * ct + fr) * 2) = f2bf(acc[r]); }
        asm volatile("s_waitcnt lgkmcnt(0)" ::: "memory");
        const int cb = h * PO_HC + 8 * l32;
        float gn[8], gw[8], gb[8], rk[8];
        { const f32x4 a0 = *(const f32x4*)(P.in[M_NORM_G] + (size_t)l * MW + cb), a1 = *(const f32x4*)(P.in[M_NORM_G] + (size_t)l * MW + cb + 4);
          const f32x4 b0 = *(const f32x4*)(P.in[R_GN_W] + (size_t)l * RW + cb), b1 = *(const f32x4*)(P.in[R_GN_W] + (size_t)l * RW + cb + 4);
          const f32x4 c0 = *(const f32x4*)(P.in[R_GN_B] + (size_t)l * RW + cb), c1 = *(const f32x4*)(P.in[R_GN_B] + (size_t)l * RW + cb + 4);
          const f32x4 d0 = *(const f32x4*)(P.in[R_RK] + (size_t)l * RW + cb), d1 = *(const f32x4*)(P.in[R_RK] + (size_t)l * RW + cb + 4);
#pragma unroll
          for (int e = 0; e < 4; ++e) { gn[e] = a0[e]; gn[4 + e] = a1[e]; gw[e] = b0[e]; gw[4 + e] = b1[e]; gb[e] = c0[e]; gb[4 + e] = c1[e]; rk[e] = d0[e]; rk[4 + e] = d1[e]; } }
        for (int tp = 0; tp < 8; ++tp) { const int tl = 2 * tp + th; const size_t m = tok0 + tl; const bf16* u = U + m * PU; const bf16* rx = RX + m * RIN;
            float hf[8], hb[8], ov[8], x[8]; unpack8(*(const u32x4*)(u + cb), hf); unpack8(*(const u32x4*)(u + MW + cb), hb); unpack8(*(const u32x4*)(u + OFF_O + cb), ov);
            float ss = 0.f;
#pragma unroll
            for (int e = 0; e < 8; ++e) { x[e] = hf[e] + hb[e]; ss += x[e] * x[e]; }
            ss = rw::allsum16(ss); const float rs = 1.0f / sqrtf(ss * (1.0f / 128.f) + RMS_EPS);
#pragma unroll
            for (int e = 0; e < 8; ++e) x[e] = x[e] * rs * gn[e] * pg8::fsigmoid(ov[e]);
            *(u32x4*)(O + m * D + cb) = pack8(x);
            float yf[8], yb[8], rr[8], kk[8], vv[8], gg[8], y[8]; unpack8(*(const u32x4*)(u + OFF_R + cb), yf); unpack8(*(const u32x4*)(u + OFF_R + RW + cb), yb);
            unpack8(*(const u32x4*)(rx + RX_R + cb), rr); unpack8(*(const u32x4*)(rx + RX_K + cb), kk); unpack8(*(const u32x4*)(rx + RX_V + cb), vv);
            unpack8(*(const LAS u32x4*)(gt + tl * GP + l32 * 16), gg);
            float mu = 0.f, bs = 0.f;
#pragma unroll
            for (int e = 0; e < 8; ++e) { y[e] = yf[e] + yb[e]; mu += y[e]; bs += rr[e] * kk[e] * rk[e]; }
            mu += rw::dpp_xor1(mu); mu += rw::dpp_xor2(mu); mu += __shfl_xor(mu, 4); mu *= (1.0f / 64.f);
            bs += rw::dpp_xor1(bs); bs += rw::dpp_xor2(bs); bs += __shfl_xor(bs, 4);
            float var = 0.f;
#pragma unroll
            for (int e = 0; e < 8; ++e) { y[e] -= mu; var += y[e] * y[e]; }
            var += rw::dpp_xor1(var); var += rw::dpp_xor2(var); var += __shfl_xor(var, 4); var *= (1.0f / 64.f);
            const float rsd = 1.0f / sqrtf(var + GN_EPS);
#pragma unroll
            for (int e = 0; e < 8; ++e) y[e] = (y[e] * rsd * gw[e] + gb[e] + bs * vv[e]) * gg[e];
            *(u32x4*)(O + m * D + MW + cb) = pack8(y);
        }
        asm volatile("s_waitcnt lgkmcnt(0)" ::: "memory");
    }
}
}

constexpr int LDS_BYTES = 147456;
constexpr int LDS_MISC = 147456 - 1024;
constexpr size_t CTL_ZERO_BYTES = 262144;
constexpr int CW_BAR = 4096, CW_Q = 8192;

#define XB_TMO      128
#define XB_XCNT(j)  (256  + 64 * (j))
#define XB_XSUB(j)  (1280 + 64 * (j))
#define XB_XGEN(j)  (2304 + 64 * (j))
#define XB_TOP      3328
#define XB_TOPGEN   3392
#define XCD_BAR_WORDS 3456
#define XB_SPIN_CAP (1u << 18)
__device__ __forceinline__ unsigned xb_ld(unsigned* p)              { return __hip_atomic_load(p, __ATOMIC_RELAXED, __HIP_MEMORY_SCOPE_AGENT); }
__device__ __forceinline__ unsigned xb_add(unsigned* p, unsigned v) { return __hip_atomic_fetch_add(p, v, __ATOMIC_RELAXED, __HIP_MEMORY_SCOPE_AGENT); }
__device__ __forceinline__ unsigned xb_xcc_id() { return (unsigned)__builtin_amdgcn_s_getreg((3 << 11) | 20) & 0xFu; }
#define XB_SPIN(cond, bar) do { unsigned _sp = 0; while (cond) { __builtin_amdgcn_s_sleep(1); \
    if ((++_sp & 255u) == 0u) { if (xb_ld(&(bar)[XB_TMO])) break; if (_sp > XB_SPIN_CAP) { atomicAdd(&(bar)[XB_TMO], 1u); break; } } } } while (0)
struct XcdBarrier { unsigned* bar; unsigned x; volatile LAS unsigned* st; };
__device__ __forceinline__ XcdBarrier xcd_barrier_post(unsigned* bar, volatile LAS unsigned* st) {
    XcdBarrier b; b.bar = bar; b.x = xb_xcc_id(); b.st = st;
    if (threadIdx.x == 0) (void)xb_add(&bar[XB_XCNT(b.x)], 1u);
    return b;
}
__device__ __forceinline__ void xcd_barrier_complete(unsigned* bar, unsigned x, unsigned& nloc, unsigned& nx) {
    const unsigned G = gridDim.x * gridDim.y * gridDim.z;
    unsigned sum, cnt, mine, sp = 0u;
    for (;;) {
        sum = 0u; cnt = 0u; mine = 0u;
#pragma unroll
        for (unsigned j = 0; j < 16; ++j) { const unsigned c = xb_ld(&bar[XB_XCNT(j)]); sum += c; cnt += (c > 0u) ? 1u : 0u; mine = (j == x) ? c : mine; }
        if (sum == G) break;
        __builtin_amdgcn_s_sleep(1);
        if ((++sp & 255u) == 0u) { if (xb_ld(&bar[XB_TMO])) break; if (sp > XB_SPIN_CAP) { atomicAdd(&bar[XB_TMO], 1u); break; } }
    }
    nloc = mine > 0u ? mine : 1u; nx = cnt > 0u ? cnt : 1u;
}
__device__ __forceinline__ void xcd_barrier(const XcdBarrier& b) {
    asm volatile("s_waitcnt vmcnt(0)" ::: "memory");
    __syncthreads();
    if (threadIdx.x == 0) {
        unsigned* bar = b.bar;
        __builtin_amdgcn_s_waitcnt(0);
        unsigned nloc = b.st[0], nx = b.st[1];
        if (nloc == 0u) { xcd_barrier_complete(bar, b.x, nloc, nx); b.st[0] = nloc; b.st[1] = nx; }
        const unsigned old = xb_add(&bar[XB_XSUB(b.x)], 1u);
        const unsigned gen = old / nloc;
        if (old + 1u == (gen + 1u) * nloc) {
            __builtin_amdgcn_fence(__ATOMIC_RELEASE, "agent");
            asm volatile("s_waitcnt vmcnt(0)" ::: "memory");
            const unsigned og = xb_add(&bar[XB_TOP], 1u);
            const unsigned tg = og / nx;
            if (og + 1u == (tg + 1u) * nx) xb_add(&bar[XB_TOPGEN], 1u);
            else XB_SPIN(xb_ld(&bar[XB_TOPGEN]) == tg, bar);
            __builtin_amdgcn_fence(__ATOMIC_ACQUIRE, "agent");
            xb_add(&bar[XB_XGEN(b.x)], 1u);
            asm volatile("s_waitcnt vmcnt(0)" ::: "memory");
        } else {
            XB_SPIN(xb_ld(&bar[XB_XGEN(b.x)]) == gen, bar);
            __builtin_amdgcn_fence(__ATOMIC_ACQUIRE, "agent");
            asm volatile("s_waitcnt vmcnt(0)" ::: "memory");
        }
    }
    __syncthreads();
}

constexpr int MX_RL = LB * RH * 2 * 4, MX_ML = LB * MH * 2 * ml::NVB, MX_RC = CB * RH * 2 * 4, MX_MC = CB * MH * 2 * ml::NVB;
constexpr int MX_ITEMS = MX_RL + MX_ML + MX_RC + MX_MC;

constexpr int ML_SPLIT = 0;
__device__ __forceinline__ void scan_phase(LAS unsigned char* lds, CParams& P, int l, unsigned* ctl) {
    unsigned* qhead = ctl + CW_Q + 64 * l;
    const bool split = gridDim.x >= 4 * wy::N_LAT * (1 + wy::NPROD) / 2;
    volatile LAS unsigned* bc = (volatile LAS unsigned*)(lds + LDS_MISC) + 16;
    for (;;) {
        if (threadIdx.x == 0) bc[0] = xb_add(qhead, 1u);
        __syncthreads();
        const int it = (int)bc[0];
        __syncthreads();
        if (!split || it >= wy::N_LAT) break;
        int s_, head, dir; wy::decode_item(it, s_, head, dir);
        wy::rwkv_cons(lds, P, l, s_, head, dir, it, ctl);
    }
    for (;;) {
        if (threadIdx.x == 0) bc[0] = xb_add(qhead + 8, 1u);
        __syncthreads();
        const int it = (int)bc[0];
        __syncthreads();
        if (it >= ML_SPLIT * ms::N_MLAT) break;
        int s_, head, dir, sub; ml::decode_item(it * ml::NVB, s_, head, dir, sub);
        ms::ml_cons(lds, P, l, s_, head, dir, it, ctl);
    }
    for (;;) {
        if (threadIdx.x == 0) bc[0] = xb_add(qhead + 48, 1u);
        __syncthreads();
        const int it = (int)bc[0];
        __syncthreads();
        if (!split || it >= wy::N_LAT * wy::NPROD) break;
        const int chain = it % wy::N_LAT;
        int s_, head, dir; wy::decode_item(chain, s_, head, dir);
        wy::rwkv_prod(lds, P, l, s_, head, dir, chain, it / wy::N_LAT, ctl);
    }
    for (;;) {
        if (threadIdx.x == 0) bc[0] = xb_add(qhead + 24, 1u);
        __syncthreads();
        const int it = (int)bc[0];
        __syncthreads();
        if (it >= ML_SPLIT * ms::N_MLAT * ms::MLPROD) break;
        const int chain = it % ms::N_MLAT;
        int s_, head, dir, sub; ml::decode_item(chain * ml::NVB, s_, head, dir, sub);
        ms::ml_prod(lds, P, l, s_, head, dir, chain, it / ms::N_MLAT, ctl);
    }
    for (;;) {
        if (threadIdx.x == 0) bc[0] = xb_add(qhead + 16, 1u);
        __syncthreads();
        const int it = (int)bc[0] + ML_SPLIT * ms::N_MLAT * ml::NVB;
        __syncthreads();
        if (it >= ml::N_ITEMS) break;
        int s_, head, dir, sub; ml::decode_item(it, s_, head, dir, sub);
        ml::mlstm_item2(lds, P, l, s_, head, dir, sub);
    }
    for (;;) {
        if (threadIdx.x == 0) bc[0] = xb_add(qhead + 32, 1u);
        __syncthreads();
        const int it = (int)bc[0] + (split ? LB * RH * 2 : 0);
        __syncthreads();
        if (it >= wy::N_ITEMS) break;
        int s_, head, dir; wy::decode_item(it, s_, head, dir);
        wy::rwkv_item(lds, P, l, s_, head, dir);
    }
}

enum { ST_N0 = 0, ST_A1, ST_CV, ST_MX, ST_PO, ST_N1, ST_A2, ST_PJ, ST_WO, ST_N2, ST_F1, ST_F2, ST_PER_LAYER };
constexpr int N_STEPS = 1 + DEPTH * ST_PER_LAYER + 1;
struct MkArgs { Params P; int ph_lo, ph_hi; };
__global__ void __launch_bounds__(512, 2) mk(MkArgs a) {
    extern __shared__ __attribute__((aligned(16))) unsigned char lds_raw[];
    LAS unsigned char* lds = (LAS unsigned char*)lds_raw;
    const int G = gridDim.x, vb = (int)blockIdx.x;
    unsigned* ctl = (unsigned*)(a.P.ws + WS_CTL);
    volatile LAS unsigned* MISC = (volatile LAS unsigned*)(lds + LDS_MISC);
    for (int u = threadIdx.x; u < 64; u += 512) MISC[u] = 0u;
    __syncthreads();
    const bool multi = a.ph_hi - a.ph_lo > 1;
    XcdBarrier bar; bar.bar = ctl + CW_BAR; bar.x = 0; bar.st = nullptr;
    if (multi) bar = xcd_barrier_post(ctl + CW_BAR, MISC + 8);
    const int lo = a.ph_lo, hi = a.ph_hi;
    const int fuse = (multi && lo == 0 && hi == N_STEPS && G == (NT / pg8::BM) * (D / pg8::BM)) ? 1 : 0;
#define STEP_BEGIN(id) if (lo <= (id) && (id) < hi) { unsigned long long kp_ = (unsigned long long)__builtin_amdgcn_kernarg_segment_ptr(); asm volatile("" : "+s"(kp_)); CParams& P = *(CParams*)kp_;
#define STEP_END(id) if ((id) + 1 < hi) xcd_barrier(bar); }
    STEP_BEGIN(0) el::init_phase(lds, P, vb, G); el::wconv_phase(lds, P, 0, vb, G); STEP_END(0)
#define LAYER(l) { \
        const int base = 1 + (l) * ST_PER_LAYER; \
        STEP_BEGIN(base + ST_N0) if ((l) > 0) el::wconv_phase(lds, P, (l), vb, G); if ((l) == 0 || !fuse) el::norm_phase(P, (l), 0, vb, G); STEP_END(base + ST_N0) \
        STEP_BEGIN(base + ST_A1) { pg8::Gemm g{WSP(bf16, WS_QKC), WSP(bf16, O_WIN1), D, D}; pg8::StaticOrder S; S.init(NT, N1P, G, vb); \
            pg8::EpiA1 E{WSP(bf16, WS_U1)}; pg8::gemm_phase(lds, g, S, E); } STEP_END(base + ST_A1) \
        STEP_BEGIN(base + ST_CV) el::conv_phase(lds, P, (l), vb, G); STEP_END(base + ST_CV) \
        STEP_BEGIN(base + ST_MX) scan_phase(lds, P, (l), ctl); STEP_END(base + ST_MX) \
        STEP_BEGIN(base + ST_PO) el::post_phase(lds, P, (l), vb, G); STEP_END(base + ST_PO) \
        STEP_BEGIN(base + ST_N1) el::norm_phase(P, (l), 1, vb, G); STEP_END(base + ST_N1) \
        STEP_BEGIN(base + ST_A2) { pg8::Gemm g{WSP(bf16, WS_RXC), WSP(bf16, O_WIN2), D, D}; pg8::StaticOrder S; S.init(NT, 2 * D, G, vb); \
            pg8::EpiA2 E{WSP(bf16, WS_U1)}; pg8::gemm_phase(lds, g, S, E); } STEP_END(base + ST_A2) \
        STEP_BEGIN(base + ST_PJ) { pg8::Gemm g{WSP(bf16, WS_QKC), WSP(bf16, O_PM), MW, D}; pg8::PairOrder S; S.init(NT, G, vb); \
            pg8::EpiPJ E{WSP(bf16, WS_U1)}; pg8::gemm_phase(lds, g, S, E); } STEP_END(base + ST_PJ) \
        STEP_BEGIN(base + ST_WO) { pg8::Gemm g{WSP(bf16, WS_U1), WSP(bf16, O_WO), D, PU}; pg8::StaticOrder S; S.init(NT, D, G, vb); \
            pg8::EpiResNorm E{P.out, WSP(float, WS_MOD) + (size_t)(l) * NCOND * 6 * D + 2 * D, (l) == 0 ? P.in[X_PROMPT] : nullptr, (l) == 0 ? P.in[X_SAMPLE] : nullptr, \
                fuse, P.in[NORM2] + (size_t)(l) * D, WSP(float, WS_MOD) + (size_t)(l) * NCOND * 6 * D + 3 * D, WSP(bf16, WS_QKC), P.ws, 1u + 2u * (l), lds}; pg8::gemm_phase(lds, g, S, E); } STEP_END(base + ST_WO) \
        if (!fuse) { STEP_BEGIN(base + ST_N2) el::norm_phase(P, (l), 2, vb, G); STEP_END(base + ST_N2) } \
        STEP_BEGIN(base + ST_F1) { pg8::Gemm g{WSP(bf16, WS_QKC), WSP(bf16, O_W13), D, D}; pg8::StaticOrder S; S.init(NT, 2 * FF, G, vb); \
            pg8::EpiF1 E{WSP(bf16, WS_U1)}; pg8::gemm_phase(lds, g, S, E); } STEP_END(base + ST_F1) \
        STEP_BEGIN(base + ST_F2) { pg8::Gemm g{WSP(bf16, WS_U1), WSP(bf16, O_W2), FF, FF}; pg8::StaticOrder S; S.init(NT, D, G, vb); \
            pg8::EpiResNorm E{P.out, WSP(float, WS_MOD) + (size_t)(l) * NCOND * 6 * D + 5 * D, nullptr, nullptr, fuse, \
                (l) + 1 < DEPTH ? P.in[NORM1] + (size_t)((l) + 1) * D : P.in[FINAL_G], (l) + 1 < DEPTH ? WSP(float, WS_MOD) + (size_t)((l) + 1) * NCOND * 6 * D : nullptr, \
                (l) + 1 < DEPTH ? WSP(bf16, WS_QKC) : nullptr, P.ws, 2u + 2u * (l), lds}; pg8::gemm_phase(lds, g, S, E); } \
            if ((l) + 1 < DEPTH || !fuse) { if (base + ST_F2 + 1 < hi) xcd_barrier(bar); } } \
    }
    static_assert(DEPTH == 2, "layers are unrolled by hand");
    LAYER(0)
    LAYER(1)
#undef LAYER
    if (!fuse) { STEP_BEGIN(N_STEPS - 1) el::norm_phase(P, 0, 3, vb, G); STEP_END(N_STEPS - 1) }
#undef STEP_BEGIN
#undef STEP_END
}
#endif

typedef void (*BodyFn)(const Params&, long);
#ifndef HOST_EMU
template <BodyFn F, int BLOCK> __global__ void __launch_bounds__(BLOCK) run_k(Params P, long n) {
    const long i = (long)blockIdx.x * BLOCK + threadIdx.x;
    if (i < n) F(P, i);
}
#define RUN(F, BLOCK, n) do { const long n_ = (n); run_k<F, BLOCK><<<dim3((unsigned)((n_ + BLOCK - 1) / BLOCK)), dim3(BLOCK), 0, stream>>>(P, n_); } while (0)
static int g_grid = 0;
#else
#define RUN(F, BLOCK, n) do { const long n_ = (n); for (long i_ = 0; i_ < n_; ++i_) F(P, i_); } while (0)
typedef void* hipStream_t;
#endif

static void forward(Params P, hipStream_t stream) {
    (void)stream;
#ifndef HOST_EMU
    if (hipMemsetAsync(P.ws + WS_CTL, 0, CTL_ZERO_BYTES, stream) != hipSuccess) return;
#ifdef MK_PER_STEP
    for (int st = 0; st < N_STEPS; ++st) { MkArgs a_{}; a_.P = P; a_.ph_lo = st; a_.ph_hi = st + 1; mk<<<dim3(g_grid), dim3(512), LDS_BYTES, stream>>>(a_); }
#else
    { MkArgs a_{}; a_.P = P; a_.ph_lo = 0; a_.ph_hi = N_STEPS; mk<<<dim3(g_grid), dim3(512), LDS_BYTES, stream>>>(a_); }
#endif
#else
    RUN(k_init_x, 256, (long)NT * D);
    RUN(k_mod, 256, (long)DEPTH * NCOND * 6 * D);
    for (int l = 0; l < DEPTH; ++l) {
        P.layer = l;
        RUN(k_wconv, 256, WC_N6);
        P.mode = 0; RUN(k_norm, 64, (long)NT);
        RUN(k_gemm_a1, 256, (long)NT * N1);
        RUN(k_conv, 256, (long)NT * (2 * MW + RIN));
        RUN(k_mlstm, 128, (long)NSEQ * MH * 2 * 128);
        for (int dir = 0; dir < 2; ++dir) { P.mode = dir; RUN(k_rwkv_prep, 256, (long)NT * RW); RUN(k_rwkv, 64, (long)NSEQ * RH * 64); }
        RUN(k_post, 256, (long)NT * D);
        P.mode = 1; RUN(k_norm, 64, (long)NT);
        RUN(k_gemm_a2, 256, (long)NT * 2 * D);
        RUN(k_gemm_pj, 256, (long)NT * D);
        RUN(k_gemm_wo, 256, (long)NT * D);
        P.mode = 2; RUN(k_norm, 64, (long)NT);
        RUN(k_gemm_f1, 256, (long)NT * FF);
        RUN(k_gemm_f2, 256, (long)NT * D);
    }
    RUN(k_final, 64, (long)NT);
#endif
}

#ifndef HOST_EMU
extern "C" void kernel_launch(void* const* d_in, const int* in_sizes, int n_in, void* d_out, int out_size, void* d_ws, size_t ws_size, hipStream_t stream) {
    if (n_in != N_IN || (size_t)out_size != OUT_END || ws_size < WS_END) return;
    if (g_grid == 0) {
        int dev = 0, cus = 0;
        if (hipGetDevice(&dev) != hipSuccess || hipDeviceGetAttribute(&cus, hipDeviceAttributeMultiprocessorCount, dev) != hipSuccess) { g_grid = -1; return; }
        if (hipFuncSetAttribute((const void*)mk, hipFuncAttributeMaxDynamicSharedMemorySize, LDS_BYTES) != hipSuccess) { g_grid = -1; return; }
        g_grid = cus;
    }
    if (g_grid < 0) return;
    Params P{};
    for (int i = 0; i < N_IN; ++i) P.in[i] = (const float*)d_in[i];
    P.out = (float*)d_out; P.ws = (unsigned char*)d_ws; P.layer = 0; P.mode = 0;
    forward(P, stream);
}
#endif
```

```cpp
#ifndef HOST_EMU
#include <hip/hip_runtime.h>
#define HD __host__ __device__ __forceinline__
#define DEV __device__ __forceinline__
#else
#include <cmath>
#include <cstring>
#include <cstdio>
#include <cstdlib>
#define HD inline
#define DEV inline
#endif
#include <cstddef>

#ifdef SMALL_CFG
constexpr int D = 256, CB = 2, CT = 128, DEPTH = 2, LB = 1, LT = 256, GW = 16;
#else
constexpr int D = 1024, CB = 32, CT = 256, DEPTH = 2, LB = 2, LT = 4096, GW = 64;
#endif
constexpr int MW = D / 2, MD = 128, MH = MW / MD, RW = D / 2, RD = 64, RH = RW / RD;
constexpr int RIN = 3 * RW + 384, FF = ((8 * D + 767) / 768) * 256, PIN = 2 * MW + MW + MW + 4 * MH + RIN + 2 * D;
constexpr int NC = CB * CT, NL = LB * LT, NT = NC + NL, NSEQ = CB + LB, NCOND = 1 + LB;
constexpr int N1 = PIN - 2 * D;
constexpr int N1P = ((N1 + 255) / 256) * 256;
constexpr int PU = N1;
constexpr int OFF_QK = 0, OFF_V = 2 * MW, OFF_O = 3 * MW, OFF_G = 4 * MW, OFF_R = 4 * MW + 4 * MH;
constexpr int RX_R = 0, RX_K = RW, RX_V = 2 * RW, RX_WL = 3 * RW, RX_AL = 3 * RW + 128, RX_GL = 3 * RW + 256;
constexpr float RMS_EPS = 1e-6f, GN_EPS = 64e-5f;
static_assert(3 * D <= N1, "G + merged must fit the dead columns of U1");

enum { X_PROMPT = 0, X_SAMPLE, ST_C, ST_N, ST_M, ST_R, C_LAT, C_CTX, ADA_W, ADA_B, NORM1, NORM2, W_IN, M_CONV, M_GATE_B, M_NORM_G,
       R_CONV, R_W0, R_W2, R_A0, R_A2, R_G2, R_KK, R_KA, R_RK, R_GN_W, R_GN_B, PROJ_M, PROJ_R, W_OUT, FFN_W1, FFN_W3, FFN_W2, FINAL_G, N_IN };

constexpr size_t OUT_X = 0;
constexpr size_t OUT_C = (size_t)NT * D;
constexpr size_t OUT_N = OUT_C + (size_t)CB * DEPTH * 2 * MH * 128 * 128;
constexpr size_t OUT_M = OUT_N + (size_t)CB * DEPTH * 2 * MH * 128;
constexpr size_t OUT_S = OUT_M + (size_t)CB * DEPTH * 2 * MH;
constexpr size_t OUT_END = OUT_S + (size_t)CB * DEPTH * 2 * RH * 64 * 64;

constexpr size_t al256(size_t x) { return (x + 255) & ~(size_t)255; }
constexpr size_t cmax(size_t a, size_t b) { return a > b ? a : b; }
constexpr size_t WS_CTL = 0;
constexpr size_t WS_MOD = (size_t)1 << 20;
constexpr size_t WS_WREG = (size_t)2 << 20;
constexpr size_t O_WIN1 = WS_WREG;
constexpr size_t O_WIN2 = O_WIN1 + (size_t)N1P * D * 2;
constexpr size_t O_PM = O_WIN2 + (size_t)2 * D * D * 2;
constexpr size_t O_PR = O_PM + (size_t)D * MW * 2;
constexpr size_t O_WO = O_PR + (size_t)D * RW * 2;
constexpr size_t O_W13 = O_WO + (size_t)D * D * 2;
constexpr size_t O_W2 = O_W13 + (size_t)2 * FF * D * 2;
constexpr size_t O_G2T = O_W2 + (size_t)D * FF * 2;
constexpr size_t O_W2T = O_G2T + (size_t)RW * 128 * 2;
constexpr size_t O_A2T = O_W2T + (size_t)2 * RW * 64 * 2;
constexpr size_t WS_U1 = al256(O_A2T + (size_t)2 * RW * 64 * 2);
constexpr size_t SZ_U1 = al256(cmax((size_t)NT * PU * 2, (size_t)NT * FF * 2));
constexpr size_t WS_QKC = WS_U1 + SZ_U1;
constexpr size_t WS_RXC = WS_QKC + (size_t)NT * D * 2;
constexpr size_t WS_END = WS_RXC + al256(cmax((size_t)NT * RIN * 2, (size_t)NT * D * 2));
#ifndef SMALL_CFG
static_assert(WS_END <= ((size_t)256 << 20), "workspace map must fit 256 MiB");
#endif

typedef unsigned short bf16;
HD float bf2f(bf16 b) { unsigned u = ((unsigned)b) << 16; return __builtin_bit_cast(float, u); }
#if defined(__HIP_DEVICE_COMPILE__)
HD bf16 f2bf(float f) { return __builtin_bit_cast(bf16, (__bf16)f); }
#else
HD bf16 f2bf(float f) { unsigned u = __builtin_bit_cast(unsigned, f); u += 0x7fffu + ((u >> 16) & 1u); return (bf16)(u >> 16); }
#endif
HD float sigmoidf_(float x) { return 1.0f / (1.0f + expf(-x)); }
HD float siluf_(float x) { return x / (1.0f + expf(-x)); }
HD float softplusf_(float x) { return fmaxf(x, 0.f) + log1pf(expf(-fabsf(x))); }
HD float logsigmoidf_(float x) { return -softplusf_(-x); }
HD int prow(int c) { return (c & ~31) | (((c >> 2) & 1) << 4) | (((c >> 3) & 3) << 2) | (c & 3); }

struct Params {
    const float* in[N_IN];
    float* out;
    unsigned char* ws;
    int layer;
    int mode;
};

struct SeqInfo { int T; int base; int grid; int cond; int b; };
HD SeqInfo seqinfo(int s) {
    SeqInfo q;
    if (s < CB) { q.T = CT; q.base = s * CT; q.grid = 0; q.cond = 0; q.b = s; }
    else { q.T = LT; q.base = NC + (s - CB) * LT; q.grid = 1; q.cond = 1 + (s - CB); q.b = s - CB; }
    return q;
}
HD int seq_of_token(int m) { return m < NC ? m / CT : CB + (m - NC) / LT; }

#define WSP(T, off) ((T*)(P.ws + (off)))

DEV void k_init_x(const Params& P, long i) {
    const size_t ncd = (size_t)NC * D;
    P.out[i] = (size_t)i < ncd ? P.in[X_PROMPT][i] : P.in[X_SAMPLE][i - ncd];
}
DEV void k_mod(const Params& P, long i) {
    const int j = (int)(i % (6 * D)); const int ci = (int)((i / (6 * D)) % NCOND); const int l = (int)(i / ((long)6 * D * NCOND));
    const float* cv = ci == 0 ? P.in[C_CTX] : P.in[C_LAT] + (size_t)(ci - 1) * D;
    const float* w = P.in[ADA_W] + (size_t)l * D * 6 * D;
    float acc = P.in[ADA_B][(size_t)l * 6 * D + j];
    for (int k = 0; k < D; ++k) acc += siluf_(cv[k]) * w[(size_t)k * 6 * D + j];
    WSP(float, WS_MOD)[i] = acc;
}
constexpr long WC_N0 = (long)N1P * D, WC_N1 = WC_N0 + (long)2 * D * D, WC_N2 = WC_N1 + (long)D * MW, WC_N3 = WC_N2 + (long)D * RW,
               WC_N4 = WC_N3 + (long)D * D, WC_N5 = WC_N4 + (long)2 * FF * D, WC_N6 = WC_N5 + (long)D * FF;
HD int unprow(int r) { return (r & ~31) | (((r >> 2) & 3) << 3) | (((r >> 4) & 1) << 2) | (r & 3); }
DEV void k_wconv(const Params& P, long i) {
    const int l = P.layer;
    if (i < WC_N0) { const int r = (int)(i / D), k = (int)(i % D); const int c = unprow(r);
        WSP(bf16, O_WIN1)[i] = c < N1 ? f2bf(P.in[W_IN][((size_t)l * D + k) * PIN + c]) : (bf16)0; return; }
    if (i < WC_N1) { const long j = i - WC_N0; const int r = (int)(j / D), k = (int)(j % D); const int c = unprow(r);
        WSP(bf16, O_WIN2)[j] = f2bf(P.in[W_IN][((size_t)l * D + k) * PIN + N1 + c]); return; }
    if (i < WC_N2) { const long j = i - WC_N1; const int r = (int)(j / MW), k = (int)(j % MW); const int c = unprow(r);
        WSP(bf16, O_PM)[j] = f2bf(P.in[PROJ_M][((size_t)l * MW + k) * D + c]); return; }
    if (i < WC_N3) { const long j = i - WC_N2; const int r = (int)(j / RW), k = (int)(j % RW); const int c = unprow(r);
        WSP(bf16, O_PR)[j] = f2bf(P.in[PROJ_R][((size_t)l * RW + k) * D + c]); return; }
    if (i < WC_N4) { const long j = i - WC_N3; const int r = (int)(j / D), k = (int)(j % D);
        WSP(bf16, O_WO)[j] = f2bf(P.in[W_OUT][((size_t)l * D + k) * D + r]); return; }
    if (i < WC_N5) { const long j = i - WC_N4; const int r = (int)(j / D), k = (int)(j % D);
        const int pn = r >> 8, rl = r & 255, which = rl >> 7, rho = rl & 127; const int jj = pn * 128 + unprow(rho);
        const float* W = which ? P.in[FFN_W3] : P.in[FFN_W1];
        WSP(bf16, O_W13)[j] = f2bf(W[((size_t)l * D + k) * FF + jj]); return; }
    { const long j = i - WC_N5; const int r = (int)(j / FF), k = (int)(j % FF);
        WSP(bf16, O_W2)[j] = f2bf(P.in[FFN_W2][((size_t)l * FF + k) * D + r]); }
}
DEV void k_norm(const Params& P, long m) {
    const int l = P.layer; const int second = (P.mode == 2);
    const float* x = P.out + (size_t)m * D;
    const float* g = P.in[second ? NORM2 : NORM1] + (size_t)l * D;
    const int cond = seqinfo(seq_of_token((int)m)).cond;
    const float* mod = WSP(float, WS_MOD) + ((size_t)l * NCOND + cond) * 6 * D + (second ? 3 * D : 0);
    float ss = 0.f;
    for (int k = 0; k < D; ++k) ss += x[k] * x[k];
    const float rs = 1.0f / sqrtf(ss / D + RMS_EPS);
    bf16* o = WSP(bf16, P.mode == 1 ? WS_RXC : WS_QKC) + (size_t)m * D;
    for (int k = 0; k < D; ++k) o[k] = f2bf(x[k] * rs * g[k] * (1.0f + mod[D + k]) + mod[k]);
}
DEV float dot_bf(const bf16* a, const bf16* b, int K) { float s = 0.f; for (int k = 0; k < K; ++k) s += bf2f(a[k]) * bf2f(b[k]); return s; }
DEV void k_gemm_a1(const Params& P, long i) {
    const int n = (int)(i % N1); const long m = i / N1;
    WSP(bf16, WS_U1)[(size_t)m * PU + n] = f2bf(dot_bf(WSP(bf16, WS_QKC) + (size_t)m * D, WSP(bf16, O_WIN1) + (size_t)prow(n) * D, D));
}
DEV void k_gemm_a2(const Params& P, long i) {
    const int n = (int)(i % (2 * D)); const long m = i / (2 * D);
    WSP(bf16, WS_U1)[(size_t)m * PU + D + n] = f2bf(sigmoidf_(dot_bf(WSP(bf16, WS_RXC) + (size_t)m * D, WSP(bf16, O_WIN2) + (size_t)prow(n) * D, D)));
}
DEV void k_gemm_pj(const Params& P, long i) {
    const int n = (int)(i % D); const long m = i / D;
    const bf16* hmr = WSP(bf16, WS_QKC) + (size_t)m * D; bf16* u = WSP(bf16, WS_U1) + (size_t)m * PU;
    const float a = dot_bf(hmr, WSP(bf16, O_PM) + (size_t)prow(n) * MW, MW), b = dot_bf(hmr + MW, WSP(bf16, O_PR) + (size_t)prow(n) * RW, RW);
    const float first = bf2f(f2bf(bf2f(u[D + n]) * a));
    u[n] = f2bf(first + bf2f(u[2 * D + n]) * b);
}
DEV void k_gemm_wo(const Params& P, long i) {
    const int n = (int)(i % D); const long m = i / D; const int l = P.layer;
    const int cond = seqinfo(seq_of_token((int)m)).cond;
    const float g1 = WSP(float, WS_MOD)[((size_t)l * NCOND + cond) * 6 * D + 2 * D + n];
    P.out[(size_t)m * D + n] += g1 * dot_bf(WSP(bf16, WS_U1) + (size_t)m * PU, WSP(bf16, O_WO) + (size_t)n * D, D);
}
DEV void k_gemm_f1(const Params& P, long i) {
    const int j = (int)(i % FF); const long m = i / FF;
    const int pn = j >> 7, rho = prow(j & 127);
    const bf16* h = WSP(bf16, WS_QKC) + (size_t)m * D;
    const float a = dot_bf(h, WSP(bf16, O_W13) + (size_t)(pn * 256 + rho) * D, D), b = dot_bf(h, WSP(bf16, O_W13) + (size_t)(pn * 256 + 128 + rho) * D, D);
    WSP(bf16, WS_U1)[(size_t)m * FF + j] = f2bf(siluf_(a) * b);
}
DEV void k_gemm_f2(const Params& P, long i) {
    const int n = (int)(i % D); const long m = i / D; const int l = P.layer;
    const int cond = seqinfo(seq_of_token((int)m)).cond;
    const float g2 = WSP(float, WS_MOD)[((size_t)l * NCOND + cond) * 6 * D + 5 * D + n];
    P.out[(size_t)m * D + n] += g2 * dot_bf(WSP(bf16, WS_U1) + (size_t)m * FF, WSP(bf16, O_W2) + (size_t)n * FF, FF);
}
DEV void k_conv(const Params& P, long i) {
    constexpr int NCH = 2 * MW + RIN;
    const int ch = (int)(i % NCH); const int m = (int)(i / NCH); const int l = P.layer;
    const int s = seq_of_token(m); const SeqInfo q = seqinfo(s); const int t = m - q.base;
    const bool isqk = ch < 2 * MW; const int c = isqk ? ch : ch - 2 * MW;
    const int ucol = isqk ? OFF_QK + c : OFF_R + c;
    const int CH = isqk ? 2 * MW : RIN;
    const float* w = (isqk ? P.in[M_CONV] : P.in[R_CONV]) + (size_t)l * 9 * CH;
    const bf16* U = WSP(bf16, WS_U1);
    float acc = 0.f;
    if (q.grid) {
        const int r = t / GW, cc = t % GW, rows = q.T / GW;
        for (int a = 0; a < 3; ++a) for (int b = 0; b < 3; ++b) {
            const int rr = r + a - 1, c2 = cc + b - 1;
            if (rr >= 0 && rr < rows && c2 >= 0 && c2 < GW) acc += w[(a * 3 + b) * CH + c] * bf2f(U[(size_t)(q.base + rr * GW + c2) * PU + ucol]);
        }
    } else {
        for (int b = 0; b < 3; ++b) { const int t2 = t + b - 1; if (t2 >= 0 && t2 < q.T) acc += w[(3 + b) * CH + c] * bf2f(U[(size_t)(q.base + t2) * PU + ucol]); }
    }
    if (isqk) { float v = siluf_(acc); if (c < MW) v *= 0.08838834764831845f; WSP(bf16, WS_QKC)[(size_t)m * (2 * MW) + c] = f2bf(v); }
    else { float v = acc; if (c >= RX_WL && c < RX_AL) v = tanhf(v); else if (c >= RX_GL) v = sigmoidf_(v); WSP(bf16, WS_RXC)[(size_t)m * RIN + c] = f2bf(v); }
}
DEV void k_mlstm(const Params& P, long i) {
    const int e = (int)(i % 128); const int chain = (int)(i / 128); const int dir = chain & 1, head = (chain >> 1) % MH, s = chain / (2 * MH);
    const int l = P.layer; const SeqInfo q = seqinfo(s);
    float C[128], n[128]; float m;
    if (!q.grid) {
#pragma unroll
        for (int d = 0; d < 128; ++d) { C[d] = 0.f; n[d] = 0.f; }
        m = 0.f;
    } else {
        const size_t sb = (((size_t)q.b * DEPTH + l) * 2 + dir) * MH + head;
#pragma unroll
        for (int d = 0; d < 128; ++d) { C[d] = P.in[ST_C][(sb * 128 + d) * 128 + e]; n[d] = P.in[ST_N][sb * 128 + d]; }
        m = P.in[ST_M][sb];
    }
    const float bi = P.in[M_GATE_B][(size_t)l * 4 * MH + (2 * dir) * MH + head], bfg = P.in[M_GATE_B][(size_t)l * 4 * MH + (2 * dir + 1) * MH + head];
    bf16* U = WSP(bf16, WS_U1); const bf16* QK = WSP(bf16, WS_QKC);
    float nsel = 0.f;
    for (int p = 0; p < q.T; ++p) {
        const int t = dir ? q.T - 1 - p : p; const size_t tok = (size_t)(q.base + t);
        const bf16* qk = QK + tok * (2 * MW); bf16* u = U + tok * PU;
        const float gi = bf2f(u[OFF_G + (2 * dir) * MH + head]) + bi, gf = bf2f(u[OFF_G + (2 * dir + 1) * MH + head]) + bfg;
        const float lf = logsigmoidf_(gf);
        const float mn = fmaxf(lf + m, gi); const float fw = expf(lf + m - mn), iw = expf(gi - mn);
        const float v = bf2f(u[OFF_V + head * 128 + e]);
        float num = 0.f, den = 0.f;
#pragma unroll
        for (int d = 0; d < 128; ++d) {
            const float kd = bf2f(qk[MW + head * 128 + d]), qd = bf2f(qk[head * 128 + d]);
            C[d] = fw * C[d] + iw * kd * v; n[d] = fw * n[d] + iw * kd; num += qd * C[d]; den += qd * n[d];
        }
        m = mn;
        u[dir * MW + head * 128 + e] = f2bf(num / fmaxf(fabsf(den), expf(-m)));
    }
    if (!q.grid) {
        const size_t sb = (((size_t)q.b * DEPTH + l) * 2 + dir) * MH + head;
#pragma unroll
        for (int d = 0; d < 128; ++d) { P.out[OUT_C + (sb * 128 + d) * 128 + e] = C[d]; if (d == e) nsel = n[d]; }
        P.out[OUT_N + sb * 128 + e] = nsel;
        if (e == 0) P.out[OUT_M + sb] = m;
    }
}
DEV void k_rwkv_prep(const Params& P, long i) {
    const int c = (int)(i % RW); const size_t tok = (size_t)(i / RW); const int l = P.layer, dir = P.mode;
    const bf16* rx = WSP(bf16, WS_RXC) + tok * RIN;
    const float* w2 = P.in[R_W2] + ((size_t)l * 2 + dir) * 64 * RW + c; const float* a2 = P.in[R_A2] + ((size_t)l * 2 + dir) * 64 * RW + c;
    float wr = P.in[R_W0][((size_t)l * 2 + dir) * RW + c], ar = P.in[R_A0][((size_t)l * 2 + dir) * RW + c];
    for (int j = 0; j < 64; ++j) { wr += bf2f(rx[RX_WL + dir * 64 + j]) * w2[(size_t)j * RW]; ar += bf2f(rx[RX_AL + dir * 64 + j]) * a2[(size_t)j * RW]; }
    bf16* o = WSP(bf16, WS_QKC) + tok * (2 * RW);
    o[c] = f2bf(wr); o[RW + c] = f2bf(ar);
}
DEV void k_rwkv(const Params& P, long i) {
    const int row = (int)(i % 64); const int chain = (int)(i / 64); const int dir = P.mode, head = chain % RH, s = chain / RH;
    const int l = P.layer; const SeqInfo q = seqinfo(s); const int hc = head * 64;
    float S[64];
    if (!q.grid) {
#pragma unroll
        for (int c = 0; c < 64; ++c) S[c] = 0.f;
    } else {
        const size_t sb = (((size_t)q.b * DEPTH + l) * 2 + dir) * RH + head;
#pragma unroll
        for (int c = 0; c < 64; ++c) S[c] = P.in[ST_R][(sb * 64 + row) * 64 + c];
    }
    const float* rkk = P.in[R_KK] + (size_t)l * RW + hc; const float* rka = P.in[R_KA] + (size_t)l * RW + hc;
    bf16* U = WSP(bf16, WS_U1); const bf16* RX = WSP(bf16, WS_RXC); const bf16* WA = WSP(bf16, WS_QKC);
    for (int p = 0; p < q.T; ++p) {
        const int t = dir ? q.T - 1 - p : p; const size_t tok = (size_t)(q.base + t);
        const bf16* rx = RX + tok * RIN; const bf16* wa = WA + tok * (2 * RW);
        float ss = 0.f;
        for (int c = 0; c < 64; ++c) { const float kc = bf2f(rx[RX_K + hc + c]) * rkk[c]; ss += kc * kc; }
        const float inv = 1.0f / fmaxf(sqrtf(ss), 1e-12f);
        float sa = 0.f;
#pragma unroll
        for (int c = 0; c < 64; ++c) sa -= S[c] * (bf2f(rx[RX_K + hc + c]) * rkk[c] * inv);
        const float v = bf2f(rx[RX_V + hc + row]);
        float y = 0.f;
#pragma unroll
        for (int c = 0; c < 64; ++c) {
            const float wr = bf2f(wa[hc + c]), ar = bf2f(wa[RW + hc + c]);
            const float decay = expf(-0.6065306597126334f * sigmoidf_(wr));
            const float alpha = sigmoidf_(ar);
            const float kr = bf2f(rx[RX_K + hc + c]);
            const float kt = kr * (1.0f + (alpha - 1.0f) * rka[c]);
            const float bb = kr * rkk[c] * inv * alpha;
            S[c] = S[c] * decay + sa * bb + v * kt;
            y += S[c] * bf2f(rx[RX_R + hc + c]);
        }
        U[tok * PU + OFF_R + dir * RW + hc + row] = f2bf(y);
    }
    if (!q.grid) {
        const size_t sb = (((size_t)q.b * DEPTH + l) * 2 + dir) * RH + head;
#pragma unroll
        for (int c = 0; c < 64; ++c) P.out[OUT_S + (sb * 64 + row) * 64 + c] = S[c];
    }
}
DEV void k_post(const Params& P, long i) {
    const int ch = (int)(i % D); const size_t m = (size_t)(i / D); const int l = P.layer;
    const bf16* u = WSP(bf16, WS_U1) + m * PU; const bf16* rx = WSP(bf16, WS_RXC) + m * RIN;
    bf16* o = WSP(bf16, WS_QKC) + m * D;
    if (ch < MW) {
        const int h0 = (ch / 128) * 128; float ss = 0.f;
        for (int d = 0; d < 128; ++d) { const float x = bf2f(u[h0 + d]) + bf2f(u[MW + h0 + d]); ss += x * x; }
        const float x = bf2f(u[ch]) + bf2f(u[MW + ch]);
        o[ch] = f2bf(x / sqrtf(ss / 128.f + RMS_EPS) * P.in[M_NORM_G][(size_t)l * MW + ch] * sigmoidf_(bf2f(u[OFF_O + ch])));
    } else {
        const int c = ch - MW; const int h0 = (c / 64) * 64;
        float mu = 0.f, bsum = 0.f;
        for (int d = 0; d < 64; ++d) { mu += bf2f(u[OFF_R + h0 + d]) + bf2f(u[OFF_R + RW + h0 + d]);
            bsum += bf2f(rx[RX_R + h0 + d]) * bf2f(rx[RX_K + h0 + d]) * P.in[R_RK][(size_t)l * RW + h0 + d]; }
        mu *= (1.0f / 64.f); float var = 0.f;
        for (int d = 0; d < 64; ++d) { const float x = bf2f(u[OFF_R + h0 + d]) + bf2f(u[OFF_R + RW + h0 + d]) - mu; var += x * x; }
        var *= (1.0f / 64.f);
        const float y = bf2f(u[OFF_R + c]) + bf2f(u[OFF_R + RW + c]);
        const float yn = (y - mu) / sqrtf(var + GN_EPS) * P.in[R_GN_W][(size_t)l * RW + c] + P.in[R_GN_B][(size_t)l * RW + c];
        float gate = 0.f;
        for (int j = 0; j < 128; ++j) gate += bf2f(rx[RX_GL + j]) * P.in[R_G2][((size_t)l * 128 + j) * RW + c];
        o[ch] = f2bf((yn + bsum * bf2f(rx[RX_V + c])) * gate);
    }
}
DEV void k_final(const Params& P, long m) {
    float* x = P.out + (size_t)m * D; float ss = 0.f;
    for (int k = 0; k < D; ++k) ss += x[k] * x[k];
    const float rs = 1.0f / sqrtf(ss / D + RMS_EPS);
    for (int k = 0; k < D; ++k) x[k] = x[k] * rs * P.in[FINAL_G][k];
}


#ifndef HOST_EMU
typedef const __attribute__((address_space(4))) Params CParams;
namespace pg8 {
#define PG8_LAS __attribute__((address_space(3)))
typedef short bf16x8 __attribute__((ext_vector_type(8)));
typedef float f32x4 __attribute__((ext_vector_type(4)));
typedef unsigned u32x4 __attribute__((ext_vector_type(4)));
constexpr int BM = 256, BK = 64, HALF = 128, HTB = HALF * BK * 2, STAGE_BYTES = 8 * HTB, NXCD = 8, WGM = 8;
__device__ __forceinline__ int lds_byte(int r, int c) { const int st = (r >> 4) * 2 + (c >> 5), rr = r & 15, cc = c & 31, ob = rr * 64 + cc * 2; return st * 1024 + (ob ^ (((ob >> 9) & 1) << 5)); }
__device__ __forceinline__ void stage_rc(int b, int& R, int& C) { const int st = b / 1024, sb = b % 1024, swz = sb ^ (((sb >> 9) & 1) << 5); R = (st >> 1) * 16 + swz / 64; C = (st & 1) * 32 + (swz % 64) / 2; }
struct Unit { int pm, pn, aoff; };
struct Gemm { const bf16* A; const bf16* Bt; int K, lda; };
struct StaticOrder {
    int nM, nN, nwg, G, c;
    __device__ __forceinline__ void init(int M, int N, int G_, int c_) { nM = M / BM; nN = N / BM; nwg = nM * nN; G = G_; c = c_; }
    __device__ __forceinline__ bool next(int i, Unit& u) const {
        const long L = (long)i * G + c; if (L >= nwg) return false;
        int wgid = (int)L; { const int q = nwg / NXCD, r = nwg % NXCD, xcd = wgid % NXCD, off = wgid / NXCD; wgid = (xcd < r ? xcd * (q + 1) : r * (q + 1) + (xcd - r) * q) + off; }
        const int nig = WGM * nN, gid = wgid / nig, fm = gid * WGM, gsz = (nM - fm) < WGM ? (nM - fm) : WGM;
        u.pm = fm + ((wgid % nig) % gsz); u.pn = (wgid % nig) / gsz; u.aoff = 0; return true;
    }
};
struct PairOrder {
    int nbase, G, v, nct;
    __device__ __forceinline__ void init(int M, int G_, int c_) { nct = D / BM; nbase = (M / BM) * nct; G = G_; v = (G_ % 8 == 0) ? (c_ % 8) * (G_ / 8) + c_ / 8 : c_; }
    __device__ __forceinline__ bool next(int i, Unit& u) const {
        const int j = v + (i >> 1) * G; if (j >= nbase) return false;
        const int half = i & 1; u.pm = j / nct; u.pn = half * nct + (j % nct); u.aoff = half * MW; return true;
    }
};
typedef float f32x2_t __attribute__((ext_vector_type(2)));
typedef __bf16 bf16x2_t __attribute__((ext_vector_type(2)));
__device__ __forceinline__ unsigned cvt_pk_bf16(float lo, float hi) { f32x2_t v = {lo, hi}; bf16x2_t b = __builtin_convertvector(v, bf16x2_t); return __builtin_bit_cast(unsigned, b); }
__device__ __forceinline__ float fsigmoid(float x) { return __builtin_amdgcn_rcpf(1.0f + __expf(-x)); }
__device__ __forceinline__ float bflo(unsigned w) { return __builtin_bit_cast(float, w << 16); }
__device__ __forceinline__ float bfhi(unsigned w) { return __builtin_bit_cast(float, w & 0xffff0000u); }

struct EpiA1 {
    bf16* U;
    __device__ __forceinline__ void operator()(const f32x4 (&acc)[2][2][4][2], const Unit& u, int wr, int wc, int fr, int fq) const {
        const int row0 = u.pm * BM + wr * 64 + fr, col0 = u.pn * BM + wc * 32 + 8 * fq;
#pragma unroll
        for (int ai = 0; ai < 2; ++ai)
#pragma unroll
            for (int m = 0; m < 4; ++m) { bf16* rowp = U + (size_t)(row0 + ai * HALF + m * 16) * PU + col0;
#pragma unroll
                for (int bj = 0; bj < 2; ++bj) { if (col0 + bj * HALF < N1) { const f32x4 v0 = acc[ai][bj][m][0], v1 = acc[ai][bj][m][1];
                    u32x4 w; w.x = cvt_pk_bf16(v0[0], v0[1]); w.y = cvt_pk_bf16(v0[2], v0[3]); w.z = cvt_pk_bf16(v1[0], v1[1]); w.w = cvt_pk_bf16(v1[2], v1[3]);
                    *(u32x4*)(rowp + bj * HALF) = w; } } }
    }
};
struct EpiA2 {
    bf16* U;
    __device__ __forceinline__ void operator()(const f32x4 (&acc)[2][2][4][2], const Unit& u, int wr, int wc, int fr, int fq) const {
        const int row0 = u.pm * BM + wr * 64 + fr, col0 = D + u.pn * BM + wc * 32 + 8 * fq;
#pragma unroll
        for (int ai = 0; ai < 2; ++ai)
#pragma unroll
            for (int m = 0; m < 4; ++m) { bf16* rowp = U + (size_t)(row0 + ai * HALF + m * 16) * PU + col0;
#pragma unroll
                for (int bj = 0; bj < 2; ++bj) { const f32x4 v0 = acc[ai][bj][m][0], v1 = acc[ai][bj][m][1];
                    u32x4 w; w.x = cvt_pk_bf16(fsigmoid(v0[0]), fsigmoid(v0[1])); w.y = cvt_pk_bf16(fsigmoid(v0[2]), fsigmoid(v0[3]));
                    w.z = cvt_pk_bf16(fsigmoid(v1[0]), fsigmoid(v1[1])); w.w = cvt_pk_bf16(fsigmoid(v1[2]), fsigmoid(v1[3]));
                    *(u32x4*)(rowp + bj * HALF) = w; } }
    }
};
struct EpiPJ {
    bf16* U;
    __device__ __forceinline__ void operator()(const f32x4 (&acc)[2][2][4][2], const Unit& u, int wr, int wc, int fr, int fq) const {
        const int nct = D / BM, half = u.pn >= nct ? 1 : 0, ct = u.pn - half * nct;
        const int row0 = u.pm * BM + wr * 64 + fr, col0 = ct * BM + wc * 32 + 8 * fq;
#pragma unroll
        for (int ai = 0; ai < 2; ++ai)
#pragma unroll
            for (int m = 0; m < 4; ++m) { bf16* rowp = U + (size_t)(row0 + ai * HALF + m * 16) * PU + col0;
#pragma unroll
                for (int bj = 0; bj < 2; ++bj) { const f32x4 v0 = acc[ai][bj][m][0], v1 = acc[ai][bj][m][1];
                    const u32x4 g = *(const u32x4*)(rowp + (1 + half) * D + bj * HALF);
                    float o[8] = { bflo(g.x) * v0[0], bfhi(g.x) * v0[1], bflo(g.y) * v0[2], bfhi(g.y) * v0[3], bflo(g.z) * v1[0], bfhi(g.z) * v1[1], bflo(g.w) * v1[2], bfhi(g.w) * v1[3] };
                    if (half) { const u32x4 p = *(const u32x4*)(rowp + bj * HALF);
                        o[0] += bflo(p.x); o[1] += bfhi(p.x); o[2] += bflo(p.y); o[3] += bfhi(p.y); o[4] += bflo(p.z); o[5] += bfhi(p.z); o[6] += bflo(p.w); o[7] += bfhi(p.w); }
                    u32x4 w; w.x = cvt_pk_bf16(o[0], o[1]); w.y = cvt_pk_bf16(o[2], o[3]); w.z = cvt_pk_bf16(o[4], o[5]); w.w = cvt_pk_bf16(o[6], o[7]);
                    *(u32x4*)(rowp + bj * HALF) = w; }
                asm volatile("" ::: "memory"); }
    }
};
struct EpiRes {
    float* X; const float* gate;
    const float* sa; const float* sb;
    __device__ __forceinline__ void operator()(const f32x4 (&acc)[2][2][4][2], const Unit& u, int wr, int wc, int fr, int fq) const {
        const int row0 = u.pm * BM + wr * 64 + fr, col0 = u.pn * BM + wc * 32 + 4 * fq;
        const float* S = sa ? (u.pm * BM < NC ? sa : sb - (size_t)NC * D) : X;
        const int cond = seqinfo(seq_of_token(u.pm * BM)).cond;
        const float* gp = gate + (size_t)cond * 6 * D + col0;
        f32x4 gv[2][2];
#pragma unroll
        for (int bj = 0; bj < 2; ++bj)
#pragma unroll
            for (int n = 0; n < 2; ++n) gv[bj][n] = *(const f32x4*)(gp + bj * HALF + n * 16);
#pragma unroll
        for (int ai = 0; ai < 2; ++ai)
#pragma unroll
            for (int m = 0; m < 4; ++m) { const size_t ro = (size_t)(row0 + ai * HALF + m * 16) * D + col0; float* rowp = X + ro; const float* srow = S + ro;
#pragma unroll
                for (int bj = 0; bj < 2; ++bj)
#pragma unroll
                    for (int n = 0; n < 2; ++n) { *(f32x4*)(rowp + bj * HALF + n * 16) = *(const f32x4*)(srow + bj * HALF + n * 16) + gv[bj][n] * acc[ai][bj][m][n]; }
                asm volatile("" ::: "memory"); }
    }
};
typedef unsigned u32x2 __attribute__((ext_vector_type(2)));
constexpr int CW_NX = 45056, CW_NX_STRIDE = 16, NX_EXCH_BYTE = 512 * 1024, NX_LDS = 131072;
struct EpiResNorm {
    float* X; const float* gate; const float* sa; const float* sb;
    int fuse;
    const float* ng; const float* nmod;
    bf16* H;
    unsigned char* ctlb; unsigned epoch; PG8_LAS unsigned char* lds;
    __device__ __forceinline__ void operator()(const f32x4 (&acc_)[2][2][4][2], const Unit& u, int wr, int wc, int fr, int fq) const {
        f32x4 (&acc)[2][2][4][2] = const_cast<f32x4 (&)[2][2][4][2]>(acc_);
        const int tid = threadIdx.x;
        const int row0 = u.pm * BM + wr * 64 + fr, col0 = u.pn * BM + wc * 32 + 4 * fq;
        const int cond = seqinfo(seq_of_token(u.pm * BM)).cond;
        const float* S = sa ? (u.pm * BM < NC ? sa : sb - (size_t)NC * D) : X;
        { const float* gp = gate + (size_t)cond * 6 * D + col0;
          f32x4 gv[2][2];
#pragma unroll
          for (int bj = 0; bj < 2; ++bj)
#pragma unroll
              for (int n = 0; n < 2; ++n) gv[bj][n] = *(const f32x4*)(gp + bj * HALF + n * 16);
#pragma unroll
          for (int ai = 0; ai < 2; ++ai)
#pragma unroll
              for (int m = 0; m < 4; ++m) { const size_t ro = (size_t)(row0 + ai * HALF + m * 16) * D + col0; float* rowp = X + ro; const float* srow = S + ro;
#pragma unroll
                  for (int bj = 0; bj < 2; ++bj)
#pragma unroll
                      for (int n = 0; n < 2; ++n) { const f32x4 xn = *(const f32x4*)(srow + bj * HALF + n * 16) + gv[bj][n] * acc[ai][bj][m][n]; acc[ai][bj][m][n] = xn;
                          if (!fuse || H) *(f32x4*)(rowp + bj * HALF + n * 16) = xn; }
                  asm volatile("" ::: "memory"); } }
        if (!fuse) return;
        PG8_LAS float* red = (PG8_LAS float*)(lds + NX_LDS); PG8_LAS float* rsl = red + 1024;
#pragma unroll
        for (int ai = 0; ai < 2; ++ai)
#pragma unroll
            for (int m = 0; m < 4; ++m) { float sacc = 0.f;
#pragma unroll
                for (int bj = 0; bj < 2; ++bj)
#pragma unroll
                    for (int n = 0; n < 2; ++n) { const f32x4 v = acc[ai][bj][m][n]; sacc += (v[0] * v[0] + v[1] * v[1]) + (v[2] * v[2] + v[3] * v[3]); }
                sacc += __shfl_xor(sacc, 16); sacc += __shfl_xor(sacc, 32);
                if (fq == 0) red[(ai * HALF + wr * 64 + m * 16 + fr) * 4 + wc] = sacc; }
        __syncthreads();
        unsigned* flags = (unsigned*)ctlb + CW_NX; float* exch = (float*)(ctlb + NX_EXCH_BYTE);
        float mine = 0.f;
        if (tid < BM) { const f32x4 r4 = *(const PG8_LAS f32x4*)(red + tid * 4); mine = (r4[0] + r4[1]) + (r4[2] + r4[3]);
            float* gp = exch + ((size_t)(u.pm * 4 + u.pn) * BM + tid);
            asm volatile("global_store_dword %0, %1, off sc1" :: "v"(gp), "v"(mine) : "memory"); }
        asm volatile("s_waitcnt vmcnt(0)" ::: "memory");
        __syncthreads();
        if (tid == 0) {
            __hip_atomic_store(flags + (u.pm * 4 + u.pn) * CW_NX_STRIDE, epoch, __ATOMIC_RELAXED, __HIP_MEMORY_SCOPE_AGENT);
            unsigned* tmo = (unsigned*)ctlb + 4096 + 128;
#pragma unroll 1
            for (int q = 0; q < 4; ++q) { if (q == u.pn) continue; unsigned sp = 0;
                while (__hip_atomic_load(flags + (u.pm * 4 + q) * CW_NX_STRIDE, __ATOMIC_RELAXED, __HIP_MEMORY_SCOPE_AGENT) < epoch) { __builtin_amdgcn_s_sleep(1);
                    if ((++sp & 255u) == 0u) { if (__hip_atomic_load(tmo, __ATOMIC_RELAXED, __HIP_MEMORY_SCOPE_AGENT)) break; if (sp > (1u << 18)) { atomicAdd(tmo, 1u); break; } } } }
            __builtin_amdgcn_fence(__ATOMIC_ACQUIRE, "agent");
        }
        asm volatile("s_waitcnt vmcnt(0)" ::: "memory");
        __syncthreads();
        if (tid < BM) { float tot = mine;
#pragma unroll
            for (int q = 0; q < 4; ++q) if (q != u.pn) tot += exch[(size_t)(u.pm * 4 + q) * BM + tid];
            rsl[tid] = 1.0f / sqrtf(tot * (1.0f / D) + 1e-6f); }
        __syncthreads();
        f32x4 g4[2][2], sc4[2][2], sh4[2][2];
#pragma unroll
        for (int bj = 0; bj < 2; ++bj)
#pragma unroll
            for (int n = 0; n < 2; ++n) { const int c = col0 + bj * HALF + n * 16; g4[bj][n] = *(const f32x4*)(ng + c);
                if (nmod) { sh4[bj][n] = *(const f32x4*)(nmod + (size_t)cond * 6 * D + c); sc4[bj][n] = *(const f32x4*)(nmod + (size_t)cond * 6 * D + D + c) + 1.0f; g4[bj][n] = g4[bj][n] * sc4[bj][n]; }
                else sh4[bj][n] = (f32x4){0.f, 0.f, 0.f, 0.f}; }
#pragma unroll
        for (int ai = 0; ai < 2; ++ai)
#pragma unroll
            for (int m = 0; m < 4; ++m) { const int rl = ai * HALF + wr * 64 + m * 16 + fr; const float r = rsl[rl]; const size_t ro = (size_t)(u.pm * BM + rl) * D + col0;
#pragma unroll
                for (int bj = 0; bj < 2; ++bj)
#pragma unroll
                    for (int n = 0; n < 2; ++n) { const f32x4 y = acc[ai][bj][m][n] * r * g4[bj][n] + sh4[bj][n];
                        if (H) { u32x2 pk; pk.x = cvt_pk_bf16(y[0], y[1]); pk.y = cvt_pk_bf16(y[2], y[3]); *(u32x2*)(H + ro + bj * HALF + n * 16) = pk; }
                        else *(f32x4*)(X + ro + bj * HALF + n * 16) = y; } }
    }
};
struct EpiF1 {
    bf16* Hd;
    __device__ __forceinline__ void operator()(const f32x4 (&acc)[2][2][4][2], const Unit& u, int wr, int wc, int fr, int fq) const {
        const int row0 = u.pm * BM + wr * 64 + fr, col0 = u.pn * HALF + wc * 32 + 8 * fq;
#pragma unroll
        for (int ai = 0; ai < 2; ++ai)
#pragma unroll
            for (int m = 0; m < 4; ++m) { bf16* rowp = Hd + (size_t)(row0 + ai * HALF + m * 16) * FF + col0;
                float o[8];
#pragma unroll
                for (int n = 0; n < 2; ++n)
#pragma unroll
                    for (int e = 0; e < 4; ++e) { const float a = acc[ai][0][m][n][e], b = acc[ai][1][m][n][e]; o[n * 4 + e] = a * fsigmoid(a) * b; }
                u32x4 w; w.x = cvt_pk_bf16(o[0], o[1]); w.y = cvt_pk_bf16(o[2], o[3]); w.z = cvt_pk_bf16(o[4], o[5]); w.w = cvt_pk_bf16(o[6], o[7]);
                *(u32x4*)rowp = w; }
    }
};

template <class Epi, class Sched, bool ALIGN_EPI = true, bool SP2 = true>
__device__ __forceinline__ void gemm_phase(PG8_LAS unsigned char* lds, const Gemm g, const Sched& S, const Epi& E) {
    const int tid = threadIdx.x, wid = __builtin_amdgcn_readfirstlane(tid >> 6), lane = tid & 63, wr = wid >> 2, wc = wid & 3, fr = lane & 15, fq = lane >> 4;
    const int K = g.K, nt = K / BK;
    unsigned voffA[2], voffB[2];
#pragma unroll
    for (int i = 0; i < 2; ++i) { int R, C; stage_rc(tid * 16 + i * 8192, R, C);
        voffA[i] = (unsigned)(R * g.lda + C) * 2u; voffB[i] = (unsigned)(R * K + C) * 2u; }
    const size_t kstep = (size_t)(BK * 2);
    const size_t hstepA = (size_t)HALF * g.lda * 2, hstepB = (size_t)HALF * K * 2;
    const size_t tstepA = 2 * hstepA, tstepB = 2 * hstepB;
    const unsigned ldsw = (unsigned)wid * 1024u;
    const int aoff = lds_byte(wr * 64 + fr, fq * 8), boff = lds_byte(wc * 32 + fr, fq * 8);
#define PG8_SA(b, h) (((b) * 2 + (h)) * HTB)
#define PG8_SB(b, h) ((4 + (b) * 2 + (h)) * HTB)
#define PG8_STAGE(bufoff, gbase, voff) do { _Pragma("unroll") for (int _i = 0; _i < 2; ++_i) \
        __builtin_amdgcn_global_load_lds((const unsigned*)((const char*)(gbase) + (voff)[_i]), (PG8_LAS unsigned*)(lds + (bufoff) + ldsw + _i * 8192), 16, 0, 0); } while (0)
#define PG8_LDA(dst, b, h) do { _Pragma("unroll") for (int m = 0; m < 4; ++m) _Pragma("unroll") for (int k = 0; k < 2; ++k) dst[m][k] = *(const PG8_LAS bf16x8*)(lds + PG8_SA(b, h) + aoff + m * 2048 + k * 1024); } while (0)
#define PG8_LDB(dst, b, h) do { _Pragma("unroll") for (int n = 0; n < 2; ++n) _Pragma("unroll") for (int k = 0; k < 2; ++k) dst[n][k] = *(const PG8_LAS bf16x8*)(lds + PG8_SB(b, h) + boff + n * 2048 + k * 1024); } while (0)
#define PG8_MMA(ai, bj, At, Bt) do { __builtin_amdgcn_s_setprio(1); _Pragma("unroll") for (int m = 0; m < 4; ++m) _Pragma("unroll") for (int n = 0; n < 2; ++n) _Pragma("unroll") for (int k = 0; k < 2; ++k) \
        acc[ai][bj][m][n] = __builtin_amdgcn_mfma_f32_16x16x32_bf16(Bt[n][k], At[m][k], acc[ai][bj][m][n], 0, 0, 0); __builtin_amdgcn_s_setprio(0); } while (0)
#define PG8_WAIT_V(n) asm volatile("s_waitcnt vmcnt(" #n ")" ::: "memory")
#define PG8_WAIT_L(n) asm volatile("s_waitcnt lgkmcnt(" #n ")" ::: "memory")
#define PG8_BAR __builtin_amdgcn_s_barrier()
#define PG8_SCHED __builtin_amdgcn_sched_barrier(0)
    Unit cur, nxt; int ui = 0;
    if (!S.next(0, cur)) return;
    f32x4 acc[2][2][4][2];
#pragma unroll
    for (int a = 0; a < 2; ++a)
#pragma unroll
        for (int b = 0; b < 2; ++b)
#pragma unroll
            for (int m = 0; m < 4; ++m)
#pragma unroll
                for (int n = 0; n < 2; ++n) acc[a][b][m][n] = (f32x4){0.f, 0.f, 0.f, 0.f};
    bf16x8 At[4][2], B0[2][2], B1[2][2];
    const char* cA = (const char*)g.A + (size_t)cur.pm * tstepA + (size_t)cur.aoff * 2; const char* cB = (const char*)g.Bt + (size_t)cur.pn * tstepB;
    if constexpr (SP2) {
        PG8_STAGE(PG8_SB(0, 0), cB, voffB); PG8_STAGE(PG8_SB(0, 1), cB + hstepB, voffB); PG8_STAGE(PG8_SA(0, 0), cA, voffA); PG8_STAGE(PG8_SA(0, 1), cA + hstepA, voffA);
        if (wr == 1) PG8_BAR;
        PG8_WAIT_V(2); PG8_BAR;
        PG8_STAGE(PG8_SB(1, 0), cB + kstep, voffB); PG8_STAGE(PG8_SA(1, 0), cA + kstep, voffA); PG8_STAGE(PG8_SB(1, 1), cB + hstepB + kstep, voffB);
        PG8_WAIT_V(6); PG8_BAR;
    } else {
        PG8_STAGE(PG8_SB(0, 0), cB, voffB); PG8_STAGE(PG8_SA(0, 0), cA, voffA); PG8_STAGE(PG8_SB(0, 1), cB + hstepB, voffB); PG8_STAGE(PG8_SA(0, 1), cA + hstepA, voffA);
        if (wr == 1) PG8_BAR;
        PG8_WAIT_V(4); PG8_BAR;
        PG8_STAGE(PG8_SB(1, 0), cB + kstep, voffB); PG8_STAGE(PG8_SA(1, 0), cA + kstep, voffA); PG8_STAGE(PG8_SB(1, 1), cB + hstepB + kstep, voffB);
        PG8_WAIT_V(6); PG8_BAR;
    }
    for (;;) {
        const bool has_next = S.next(ui + 1, nxt);
        const char* nA = has_next ? (const char*)g.A + (size_t)nxt.pm * tstepA + (size_t)nxt.aoff * 2 : cA; const char* nB = has_next ? (const char*)g.Bt + (size_t)nxt.pn * tstepB : cB;
        for (int t = 0; t < nt; t += 2) {
            const bool last = (t == nt - 2);
            const char* a1 = cA + (size_t)(t + 1) * kstep;
            const char* a2 = last ? nA : cA + (size_t)(t + 2) * kstep; const char* b2 = last ? nB : cB + (size_t)(t + 2) * kstep;
            const char* a3 = a2 + kstep; const char* b3 = b2 + kstep;
            if constexpr (SP2) {
            PG8_LDB(B0, 0, 0); PG8_LDB(B1, 0, 1); PG8_SCHED; PG8_LDA(At, 0, 0); PG8_STAGE(PG8_SA(1, 1), a1 + hstepA, voffA);
            PG8_WAIT_V(8); PG8_WAIT_L(0); PG8_BAR; PG8_MMA(0, 0, At, B0); PG8_MMA(0, 1, At, B1); PG8_BAR; PG8_SCHED;
            PG8_LDA(At, 0, 1); PG8_STAGE(PG8_SB(0, 0), b2, voffB); PG8_STAGE(PG8_SB(0, 1), b2 + hstepB, voffB); PG8_STAGE(PG8_SA(0, 0), a2, voffA);
            PG8_WAIT_V(8); PG8_WAIT_L(0); PG8_BAR; PG8_MMA(1, 0, At, B0); PG8_MMA(1, 1, At, B1); PG8_BAR; PG8_SCHED;
            PG8_LDB(B0, 1, 0); PG8_LDB(B1, 1, 1); PG8_SCHED; PG8_LDA(At, 1, 0); PG8_STAGE(PG8_SA(0, 1), a2 + hstepA, voffA);
            PG8_WAIT_V(8); PG8_WAIT_L(0); PG8_BAR; PG8_MMA(0, 0, At, B0); PG8_MMA(0, 1, At, B1); PG8_BAR; PG8_SCHED;
            PG8_LDA(At, 1, 1); PG8_STAGE(PG8_SB(1, 0), b3, voffB); PG8_STAGE(PG8_SB(1, 1), b3 + hstepB, voffB); PG8_STAGE(PG8_SA(1, 0), a3, voffA);
            PG8_WAIT_V(8); PG8_WAIT_L(0); PG8_BAR; PG8_MMA(1, 0, At, B0); PG8_MMA(1, 1, At, B1); PG8_BAR; PG8_SCHED;
            } else {
            PG8_LDB(B0, 0, 0); PG8_SCHED; PG8_LDA(At, 0, 0); PG8_STAGE(PG8_SA(1, 1), a1 + hstepA, voffA);
            PG8_WAIT_L(8); PG8_BAR; PG8_WAIT_L(0); PG8_MMA(0, 0, At, B0); PG8_BAR; PG8_SCHED;
            PG8_LDB(B1, 0, 1); PG8_STAGE(PG8_SB(0, 0), b2, voffB);
            PG8_BAR; PG8_WAIT_L(0); PG8_MMA(0, 1, At, B1); PG8_BAR;
            PG8_LDA(At, 0, 1); PG8_STAGE(PG8_SA(0, 0), a2, voffA);
            PG8_BAR; PG8_WAIT_L(0); PG8_MMA(1, 0, At, B0); PG8_BAR; PG8_SCHED;
            PG8_STAGE(PG8_SB(0, 1), b2 + hstepB, voffB);
            PG8_WAIT_V(6); PG8_BAR; PG8_MMA(1, 1, At, B1); PG8_BAR;
            PG8_LDB(B0, 1, 0); PG8_SCHED; PG8_LDA(At, 1, 0); PG8_STAGE(PG8_SA(0, 1), a2 + hstepA, voffA);
            PG8_WAIT_L(8); PG8_BAR; PG8_WAIT_L(0); PG8_MMA(0, 0, At, B0); PG8_BAR; PG8_SCHED;
            PG8_LDB(B1, 1, 1); PG8_STAGE(PG8_SB(1, 0), b3, voffB);
            PG8_BAR; PG8_WAIT_L(0); PG8_MMA(0, 1, At, B1); PG8_BAR;
            PG8_LDA(At, 1, 1); PG8_STAGE(PG8_SA(1, 0), a3, voffA);
            PG8_BAR; PG8_WAIT_L(0); PG8_MMA(1, 0, At, B0); PG8_BAR; PG8_SCHED;
            PG8_STAGE(PG8_SB(1, 1), b3 + hstepB, voffB);
            PG8_WAIT_V(6); PG8_BAR; PG8_MMA(1, 1, At, B1); PG8_BAR;
            }
        }
        if constexpr (ALIGN_EPI) { if (wr == 0) PG8_BAR; }
        E(acc, cur, wr, wc, fr, fq);
        if (!has_next) break;
#pragma unroll
        for (int a = 0; a < 2; ++a)
#pragma unroll
            for (int b = 0; b < 2; ++b)
#pragma unroll
                for (int m = 0; m < 4; ++m)
#pragma unroll
                    for (int n = 0; n < 2; ++n) acc[a][b][m][n] = (f32x4){0.f, 0.f, 0.f, 0.f};
        cur = nxt; cA = nA; cB = nB; ++ui;
        if constexpr (ALIGN_EPI) { if (wr == 1) PG8_BAR; }
    }
    PG8_WAIT_V(0);
    if constexpr (!ALIGN_EPI) { if (wr == 0) PG8_BAR; }
    PG8_BAR;
#undef PG8_SA
#undef PG8_SB
#undef PG8_STAGE
#undef PG8_LDA
#undef PG8_LDB
#undef PG8_MMA
#undef PG8_WAIT_V
#undef PG8_WAIT_L
#undef PG8_BAR
#undef PG8_SCHED
}
}


#define LDS_BARRIER() do { asm volatile("s_waitcnt lgkmcnt(0)" ::: "memory"); __builtin_amdgcn_s_barrier(); asm volatile("" ::: "memory"); } while (0)
namespace ml {
#define LAS __attribute__((address_space(3)))
typedef short bf16x8 __attribute__((ext_vector_type(8)));
typedef float f32x4 __attribute__((ext_vector_type(4)));
typedef unsigned u32x4 __attribute__((ext_vector_type(4)));
constexpr int NVB = 4, EV = MD / NVB;
constexpr int PQ = 272, PT = 144;
constexpr int L_QS = 0, L_KS = L_QS + 64 * PQ, L_KT = L_KS + 64 * PQ, L_VT = L_KT + 128 * PT, L_SB = L_VT + 48 * PT, L_CT = L_SB + 64 * PT,
              L_HS = L_CT + 48 * PQ, L_SC = L_HS + 64 * 80, L_END = L_SC + 4096;
static_assert(L_END <= 131072, "mLSTM LDS map");
enum { SC_A = 0, SC_PM = 64, SC_WI = 128, SC_EMT = 192, SC_WE = 256, SC_DEN = 320, SC_MISC = 384 };
__device__ __forceinline__ f32x4 mma(bf16x8 a, bf16x8 b, f32x4 c) { return __builtin_amdgcn_mfma_f32_16x16x32_bf16(a, b, c, 0, 0, 0); }
__device__ __forceinline__ bf16x8 frag(LAS unsigned char* lds, int base, int pitch, int row0, int k0, int lane) {
    return *(const LAS bf16x8*)(lds + base + (row0 + (lane & 15)) * pitch + (k0 + 8 * (lane >> 4)) * 2);
}
template <int N> __device__ __forceinline__ float dpp_row_shr(float x, float ident) {
    return __builtin_bit_cast(float, __builtin_amdgcn_update_dpp(__builtin_bit_cast(int, ident), __builtin_bit_cast(int, x), 0x110 + N, 0xf, 0xf, false));
}
__device__ __forceinline__ float lane_get(float x, int l) { return __builtin_bit_cast(float, __builtin_amdgcn_readlane(__builtin_bit_cast(int, x), l)); }
__device__ __forceinline__ float wave_scan_add(float x, int lane) {
    x += dpp_row_shr<1>(x, 0.f); x += dpp_row_shr<2>(x, 0.f); x += dpp_row_shr<4>(x, 0.f); x += dpp_row_shr<8>(x, 0.f);
    const float t0 = lane_get(x, 15), t1 = lane_get(x, 31), t2 = lane_get(x, 47); const int row = lane >> 4;
    return x + ((row >= 1 ? t0 : 0.f) + (row >= 2 ? t1 : 0.f) + (row >= 3 ? t2 : 0.f));
}
__device__ __forceinline__ float wave_scan_max(float x, int lane) {
    constexpr float NI = -3.0e38f;
    x = fmaxf(x, dpp_row_shr<1>(x, NI)); x = fmaxf(x, dpp_row_shr<2>(x, NI)); x = fmaxf(x, dpp_row_shr<4>(x, NI)); x = fmaxf(x, dpp_row_shr<8>(x, NI));
    const float t0 = lane_get(x, 15), t1 = lane_get(x, 31), t2 = lane_get(x, 47); const int row = lane >> 4;
    return fmaxf(fmaxf(x, row >= 1 ? t0 : NI), fmaxf(row >= 2 ? t1 : NI, row >= 3 ? t2 : NI));
}
__device__ __forceinline__ void mlstm_item(LAS unsigned char* lds, CParams& P, int l, int s, int head, int dir, int vb) {
    const int tid = threadIdx.x, w = __builtin_amdgcn_readfirstlane(tid >> 6), lane = tid & 63, fr = lane & 15, fq = lane >> 4;
    const int rt = w & 3, half = w >> 2;
    const SeqInfo q = seqinfo(s); const int nchunk = q.T / 64;
    const bf16* QK = WSP(bf16, WS_QKC); bf16* U = WSP(bf16, WS_U1);
    LAS float* SC = (LAS float*)(lds + L_SC);
    f32x4 cacc[3];
    float m_prev;
    if (!q.grid) { cacc[0] = cacc[1] = cacc[2] = (f32x4){0.f, 0.f, 0.f, 0.f}; m_prev = 0.f; }
    else {
        const size_t sb = (((size_t)q.b * DEPTH + l) * 2 + dir) * MH + head; const int d = 16 * w + fr;
#pragma unroll
        for (int et = 0; et < 2; ++et)
#pragma unroll
            for (int r = 0; r < 4; ++r) cacc[et][r] = P.in[ST_C][(sb * 128 + d) * 128 + vb * EV + 16 * et + 4 * fq + r];
        cacc[2] = (f32x4){0.f, 0.f, 0.f, 0.f}; if (fq == 0) cacc[2][0] = P.in[ST_N][sb * 128 + d];
        m_prev = P.in[ST_M][sb];
    }
    const float bi = P.in[M_GATE_B][(size_t)l * 4 * MH + (2 * dir) * MH + head], bfg = P.in[M_GATE_B][(size_t)l * 4 * MH + (2 * dir + 1) * MH + head];
    for (int i = tid; i < 16 * 64; i += 512) { const int r = i >> 6, c = i & 63; *(LAS bf16*)(lds + L_VT + (32 + r) * PT + c * 2) = (r == 0) ? (bf16)0x3f80 : (bf16)0; }
    u32x4 pqk[4]; u32x4 pv; bf16 pgi = 0, pgf = 0;
#define ML_TOK(c, j) ((size_t)(q.base + (dir ? q.T - 1 - ((c) * 64 + (j)) : ((c) * 64 + (j)))))
#define ML_PREFETCH(c) do { _Pragma("unroll") for (int i = 0; i < 4; ++i) { const int id = tid + 512 * i, j = id >> 5, pc = id & 31; \
            pqk[i] = *(const u32x4*)(QK + ML_TOK(c, j) * (2 * MW) + (pc < 16 ? head * 128 + 8 * pc : MW + head * 128 + 8 * (pc - 16))); } \
        if (tid < 256) { const int j = tid >> 2, pc = tid & 3; pv = *(const u32x4*)(U + ML_TOK(c, j) * PU + OFF_V + head * 128 + vb * EV + 8 * pc); } \
        if (w == 0) { const bf16* g = U + ML_TOK(c, lane) * PU + OFF_G; pgi = g[(2 * dir) * MH + head]; pgf = g[(2 * dir + 1) * MH + head]; } } while (0)
    ML_PREFETCH(0);
    for (int c = 0; c < nchunk; ++c) {
#pragma unroll
        for (int i = 0; i < 4; ++i) { const int id = tid + 512 * i, j = id >> 5, pc = id & 31;
            *(LAS u32x4*)(lds + (pc < 16 ? L_QS : L_KS) + j * PQ + (pc & 15) * 16) = pqk[i]; }
        if (tid < 256) { const int j = tid >> 2, pc = tid & 3; const unsigned wv[4] = {pv.x, pv.y, pv.z, pv.w};
#pragma unroll
            for (int e = 0; e < 8; ++e) *(LAS bf16*)(lds + L_VT + (8 * pc + e) * PT + j * 2) = (bf16)((wv[e >> 1] >> ((e & 1) * 16)) & 0xffffu); }
#pragma unroll
        for (int et = 0; et < 3; ++et)
#pragma unroll
            for (int r = 0; r < 4; ++r) *(LAS bf16*)(lds + L_CT + (16 * et + 4 * fq + r) * PQ + (16 * w + fr) * 2) = f2bf(cacc[et][r]);
        float wie = 1.f;
        if (w == 0) {
            const float gi = bf2f(pgi) + bi, gf = bf2f(pgf) + bfg;
            const float lf = fminf(gf, 0.f) - log1pf(__expf(-fabsf(gf)));
            const float b = wave_scan_add(lf, lane);
            const float a = gi - b; float pm = wave_scan_max(a, lane);
            pm = fmaxf(pm, m_prev);
            const float pm63 = lane_get(pm, 63), b63 = lane_get(b, 63);
            SC[SC_A + lane] = a; SC[SC_PM + lane] = pm; SC[SC_WI + lane] = __expf(m_prev - pm); SC[SC_EMT + lane] = __expf(-(b + pm)); SC[SC_WE + lane] = __expf(a - pm63);
            if (lane == 0) { SC[SC_MISC] = __expf(m_prev - pm63); SC[SC_MISC + 1] = b63 + pm63; }
        }
        LDS_BARRIER();
        if (c + 1 < nchunk) ML_PREFETCH(c + 1);
        wie = SC[SC_MISC]; m_prev = SC[SC_MISC + 1];
#pragma unroll
        for (int i = 0; i < 2; ++i) { const int id = tid + 512 * i, j = id & 63, pc = id >> 6; const float we = SC[SC_WE + j];
            const u32x4 kv = *(const LAS u32x4*)(lds + L_KS + j * PQ + pc * 16); const unsigned wv[4] = {kv.x, kv.y, kv.z, kv.w};
#pragma unroll
            for (int e = 0; e < 8; ++e) { const float kf = __builtin_bit_cast(float, (e & 1) ? (wv[e >> 1] & 0xffff0000u) : (wv[e >> 1] << 16));
                *(LAS bf16*)(lds + L_KT + (8 * pc + e) * PT + j * 2) = f2bf(kf * we); } }
#pragma unroll
        for (int cc = 0; cc < 2; ++cc) { const int ct = 2 * half + cc;
            f32x4 acc = (f32x4){0.f, 0.f, 0.f, 0.f};
            if (ct <= rt) {
#pragma unroll
                for (int k = 0; k < 4; ++k) acc = mma(frag(lds, L_QS, PQ, 16 * rt, 32 * k, lane), frag(lds, L_KS, PQ, 16 * ct, 32 * k, lane), acc);
            }
            const int sp = 16 * ct + fr; const float as = SC[SC_A + sp];
#pragma unroll
            for (int r = 0; r < 4; ++r) { const int t = 16 * rt + 4 * fq + r; const float v = (sp <= t) ? acc[r] * __expf(as - SC[SC_PM + t]) : 0.f;
                *(LAS bf16*)(lds + L_SB + t * PT + sp * 2) = f2bf(v); } }
        LDS_BARRIER();
        f32x4 nacc[2]; const int nct = half ? 1 : 2;
#pragma unroll
        for (int cc = 0; cc < 2; ++cc) { if (cc < nct) { const int ct = half ? 2 : cc;
            f32x4 a1 = (f32x4){0.f, 0.f, 0.f, 0.f}, a2 = (f32x4){0.f, 0.f, 0.f, 0.f};
#pragma unroll
            for (int k = 0; k < 2; ++k) a1 = mma(frag(lds, L_SB, PT, 16 * rt, 32 * k, lane), frag(lds, L_VT, PT, 16 * ct, 32 * k, lane), a1);
#pragma unroll
            for (int k = 0; k < 4; ++k) a2 = mma(frag(lds, L_QS, PQ, 16 * rt, 32 * k, lane), frag(lds, L_CT, PQ, 16 * ct, 32 * k, lane), a2);
#pragma unroll
            for (int r = 0; r < 4; ++r) a1[r] += SC[SC_WI + 16 * rt + 4 * fq + r] * a2[r];
            nacc[cc] = a1; } }
        if (half && fr == 0) {
#pragma unroll
            for (int r = 0; r < 4; ++r) SC[SC_DEN + 16 * rt + 4 * fq + r] = nacc[0][r];
        }
#pragma unroll
        for (int et = 0; et < 3; ++et) { cacc[et] = cacc[et] * wie;
#pragma unroll
            for (int k = 0; k < 2; ++k) cacc[et] = mma(frag(lds, L_VT, PT, 16 * et, 32 * k, lane), frag(lds, L_KT, PT, 16 * w, 32 * k, lane), cacc[et]); }
        LDS_BARRIER();
        if (!half) {
#pragma unroll
            for (int cc = 0; cc < 2; ++cc)
#pragma unroll
                for (int r = 0; r < 4; ++r) { const int t = 16 * rt + 4 * fq + r; const float den = fmaxf(fabsf(SC[SC_DEN + t]), SC[SC_EMT + t]);
                    *(LAS bf16*)(lds + L_HS + t * 80 + (16 * cc + fr) * 2) = f2bf(nacc[cc][r] * __builtin_amdgcn_rcpf(den)); }
        }
        LDS_BARRIER();
        if (tid < 256) { const int j = tid >> 2, pc = tid & 3;
            *(u32x4*)(U + ML_TOK(c, j) * PU + dir * MW + head * 128 + vb * EV + 8 * pc) = *(const LAS u32x4*)(lds + L_HS + j * 80 + pc * 16); }
    }
    if (!q.grid) {
        const size_t sb = (((size_t)q.b * DEPTH + l) * 2 + dir) * MH + head; const int d = 16 * w + fr;
#pragma unroll
        for (int et = 0; et < 2; ++et)
#pragma unroll
            for (int r = 0; r < 4; ++r) P.out[OUT_C + (sb * 128 + d) * 128 + vb * EV + 16 * et + 4 * fq + r] = cacc[et][r];
        if (vb == 0) { if (fq == 0) P.out[OUT_N + sb * 128 + d] = cacc[2][0]; if (tid == 0) P.out[OUT_M + sb] = m_prev; }
    }
    LDS_BARRIER();
#undef ML_TOK
#undef ML_PREFETCH
}
constexpr int M_QS = 0, M_KS = M_QS + 2 * 64 * PQ, M_KT = M_KS + 64 * PQ, M_VT = M_KT + 128 * PT, M_SB = M_VT + 2 * 48 * PT, M_CT = M_SB + 64 * PT, M_HS = M_CT + 48 * PQ, M_SC = M_HS + 64 * 80, M_END = M_SC + 2 * 4096;
static_assert(M_END <= 131072, "pipelined mLSTM LDS map");
__device__ __forceinline__ void mlstm_item2(LAS unsigned char* lds, CParams& P, int l, int s, int head, int dir, int vb) {
    const int tid = threadIdx.x, w = __builtin_amdgcn_readfirstlane(tid >> 6), lane = tid & 63, fr = lane & 15, fq = lane >> 4;
    const int rt = w & 3, half = w >> 2;
    const SeqInfo q = seqinfo(s); const int nchunk = q.T / 64;
    const bf16* QK = WSP(bf16, WS_QKC); bf16* U = WSP(bf16, WS_U1);
    f32x4 cacc[3];
    float m_prev;
    const size_t sb = (((size_t)q.b * DEPTH + l) * 2 + dir) * MH + head;
    if (!q.grid) { cacc[0] = cacc[1] = cacc[2] = (f32x4){0.f, 0.f, 0.f, 0.f}; m_prev = 0.f; }
    else {
        const int d = 16 * w + fr;
#pragma unroll
        for (int et = 0; et < 2; ++et)
#pragma unroll
            for (int r = 0; r < 4; ++r) cacc[et][r] = P.in[ST_C][(sb * 128 + d) * 128 + vb * EV + 16 * et + 4 * fq + r];
        cacc[2] = (f32x4){0.f, 0.f, 0.f, 0.f}; if (fq == 0) cacc[2][0] = P.in[ST_N][sb * 128 + d];
        m_prev = P.in[ST_M][sb];
    }
    const float bi = P.in[M_GATE_B][(size_t)l * 4 * MH + (2 * dir) * MH + head], bfg = P.in[M_GATE_B][(size_t)l * 4 * MH + (2 * dir + 1) * MH + head];
    for (int i = tid; i < 2 * 16 * 64; i += 512) { const int b = i >> 10, r = (i >> 6) & 15, c = i & 63; *(LAS bf16*)(lds + M_VT + b * 48 * PT + (32 + r) * PT + c * 2) = (r == 0) ? (bf16)0x3f80 : (bf16)0; }
    u32x4 pqk[4]; u32x4 pv; bf16 pgi = 0, pgf = 0;
#define ML_TOK(c, j) ((size_t)(q.base + (dir ? q.T - 1 - ((c) * 64 + (j)) : ((c) * 64 + (j)))))
#define ML_PREFETCH(c) do { _Pragma("unroll") for (int i = 0; i < 4; ++i) { const int id = tid + 512 * i, j = id >> 5, pc = id & 31; \
            pqk[i] = *(const u32x4*)(QK + ML_TOK(c, j) * (2 * MW) + (pc < 16 ? head * 128 + 8 * pc : MW + head * 128 + 8 * (pc - 16))); } \
        if (tid < 256) { const int j = tid >> 2, pc = tid & 3; pv = *(const u32x4*)(U + ML_TOK(c, j) * PU + OFF_V + head * 128 + vb * EV + 8 * pc); } \
        if (w == 4) { const bf16* g = U + ML_TOK(c, lane) * PU + OFF_G; pgi = g[(2 * dir) * MH + head]; pgf = g[(2 * dir + 1) * MH + head]; } } while (0)
#define ML_STAGE_A(pb) do { \
        _Pragma("unroll") for (int i = 0; i < 4; ++i) { const int id = tid + 512 * i, j = id >> 5, pc = id & 31; \
            *(LAS u32x4*)(lds + (pc < 16 ? M_QS + (pb) * 64 * PQ : M_KS) + j * PQ + (pc & 15) * 16) = pqk[i]; } \
        if (tid < 256) { const int j = tid >> 2, pc = tid & 3; const unsigned wv[4] = {pv.x, pv.y, pv.z, pv.w}; \
            _Pragma("unroll") for (int e = 0; e < 8; ++e) *(LAS bf16*)(lds + M_VT + (pb) * 48 * PT + (8 * pc + e) * PT + j * 2) = (bf16)((wv[e >> 1] >> ((e & 1) * 16)) & 0xffffu); } \
        if (w == 4) { LAS float* SCn = (LAS float*)(lds + M_SC + (pb) * 4096); \
            const float gi = bf2f(pgi) + bi, gf = bf2f(pgf) + bfg; \
            const float lf = fminf(gf, 0.f) - log1pf(__expf(-fabsf(gf))); \
            const float b = wave_scan_add(lf, lane); \
            const float a = gi - b; float pm = wave_scan_max(a, lane); \
            pm = fmaxf(pm, m_prev); \
            const float pm63 = lane_get(pm, 63), b63 = lane_get(b, 63); \
            SCn[SC_A + lane] = a; SCn[SC_PM + lane] = pm; SCn[SC_WI + lane] = __expf(m_prev - pm); SCn[SC_EMT + lane] = __expf(-(b + pm)); SCn[SC_WE + lane] = __expf(a - pm63); \
            if (lane == 0) SCn[SC_MISC] = __expf(m_prev - pm63); \
            m_prev = b63 + pm63; } } while (0)
#define ML_STAGE_D(pb) do { const LAS float* SCn = (const LAS float*)(lds + M_SC + (pb) * 4096); \
        _Pragma("unroll") for (int i = 0; i < 2; ++i) { const int id = tid + 512 * i, j = id & 63, pc = id >> 6; const float we = SCn[SC_WE + j]; \
            const u32x4 kv = *(const LAS u32x4*)(lds + M_KS + j * PQ + pc * 16); const unsigned wv[4] = {kv.x, kv.y, kv.z, kv.w}; \
            _Pragma("unroll") for (int e = 0; e < 8; ++e) { const float kf = __builtin_bit_cast(float, (e & 1) ? (wv[e >> 1] & 0xffff0000u) : (wv[e >> 1] << 16)); \
                *(LAS bf16*)(lds + M_KT + (8 * pc + e) * PT + j * 2) = f2bf(kf * we); } } \
        _Pragma("unroll") for (int cc = 0; cc < 2; ++cc) { const int ct = 2 * half + cc; \
            f32x4 acc = (f32x4){0.f, 0.f, 0.f, 0.f}; \
            if (ct <= rt) { \
                _Pragma("unroll") for (int k = 0; k < 4; ++k) acc = mma(frag(lds, M_QS + (pb) * 64 * PQ, PQ, 16 * rt, 32 * k, lane), frag(lds, M_KS, PQ, 16 * ct, 32 * k, lane), acc); } \
            const int sp = 16 * ct + fr; const float as = SCn[SC_A + sp]; \
            _Pragma("unroll") for (int r = 0; r < 4; ++r) { const int t = 16 * rt + 4 * fq + r; const float v = (sp <= t) ? acc[r] * __expf(as - SCn[SC_PM + t]) : 0.f; \
                *(LAS bf16*)(lds + M_SB + t * PT + sp * 2) = f2bf(v); } } \
        _Pragma("unroll") for (int et = 0; et < 3; ++et) \
            _Pragma("unroll") for (int r = 0; r < 4; ++r) *(LAS bf16*)(lds + M_CT + (16 * et + 4 * fq + r) * PQ + (16 * w + fr) * 2) = f2bf(cacc[et][r]); } while (0)
#define ML_STORE(c) do { if (tid < 256) { const int j = tid >> 2, pc = tid & 3; \
            *(u32x4*)(U + ML_TOK(c, j) * PU + dir * MW + head * 128 + vb * EV + 8 * pc) = *(const LAS u32x4*)(lds + M_HS + j * 80 + pc * 16); } } while (0)
    ML_PREFETCH(0);
    ML_STAGE_A(0);
    LDS_BARRIER();
    if (nchunk > 1) ML_PREFETCH(1);
    ML_STAGE_D(0);
    LDS_BARRIER();
    for (int c = 0; c < nchunk; ++c) {
        const int pb = c & 1;
        if (c + 1 < nchunk) { ML_STAGE_A(pb ^ 1); if (c + 2 < nchunk) ML_PREFETCH(c + 2); }
        if (c >= 1) ML_STORE(c - 1);
        LAS float* SC = (LAS float*)(lds + M_SC + pb * 4096);
        const float wie = SC[SC_MISC];
        f32x4 nacc[2]; const int nct = half ? 1 : 2;
#pragma unroll
        for (int cc = 0; cc < 2; ++cc) { if (cc < nct) { const int ct = half ? 2 : cc;
            f32x4 a1 = (f32x4){0.f, 0.f, 0.f, 0.f}, a2 = (f32x4){0.f, 0.f, 0.f, 0.f};
#pragma unroll
            for (int k = 0; k < 2; ++k) a1 = mma(frag(lds, M_SB, PT, 16 * rt, 32 * k, lane), frag(lds, M_VT + pb * 48 * PT, PT, 16 * ct, 32 * k, lane), a1);
#pragma unroll
            for (int k = 0; k < 4; ++k) a2 = mma(frag(lds, M_QS + pb * 64 * PQ, PQ, 16 * rt, 32 * k, lane), frag(lds, M_CT, PQ, 16 * ct, 32 * k, lane), a2);
#pragma unroll
            for (int r = 0; r < 4; ++r) a1[r] += SC[SC_WI + 16 * rt + 4 * fq + r] * a2[r];
            nacc[cc] = a1; } }
        if (half && fr == 0) {
#pragma unroll
            for (int r = 0; r < 4; ++r) SC[SC_DEN + 16 * rt + 4 * fq + r] = nacc[0][r];
        }
#pragma unroll
        for (int et = 0; et < 3; ++et) { cacc[et] = cacc[et] * wie;
#pragma unroll
            for (int k = 0; k < 2; ++k) cacc[et] = mma(frag(lds, M_VT + pb * 48 * PT, PT, 16 * et, 32 * k, lane), frag(lds, M_KT, PT, 16 * w, 32 * k, lane), cacc[et]); }
        LDS_BARRIER();
        if (!half) {
#pragma unroll
            for (int cc = 0; cc < 2; ++cc)
#pragma unroll
                for (int r = 0; r < 4; ++r) { const int t = 16 * rt + 4 * fq + r; const float den = fmaxf(fabsf(SC[SC_DEN + t]), SC[SC_EMT + t]);
                    *(LAS bf16*)(lds + M_HS + t * 80 + (16 * cc + fr) * 2) = f2bf(nacc[cc][r] * __builtin_amdgcn_rcpf(den)); }
        }
        if (c + 1 < nchunk) ML_STAGE_D(pb ^ 1);
        LDS_BARRIER();
    }
    ML_STORE(nchunk - 1);
    if (!q.grid) {
        const int d = 16 * w + fr;
#pragma unroll
        for (int et = 0; et < 2; ++et)
#pragma unroll
            for (int r = 0; r < 4; ++r) P.out[OUT_C + (sb * 128 + d) * 128 + vb * EV + 16 * et + 4 * fq + r] = cacc[et][r];
        if (vb == 0) { if (fq == 0) P.out[OUT_N + sb * 128 + d] = cacc[2][0]; if (tid == 256) P.out[OUT_M + sb] = m_prev; }
    }
    LDS_BARRIER();
#undef ML_TOK
#undef ML_PREFETCH
#undef ML_STAGE_A
#undef ML_STAGE_D
#undef ML_STORE
}
constexpr int N_ITEMS = NSEQ * MH * 2 * NVB;
__device__ __forceinline__ void decode_item(int it, int& s, int& head, int& dir, int& vb) {
    vb = it % NVB; int ch = it / NVB; dir = ch & 1; ch >>= 1; head = ch % MH; const int sq = ch / MH;
    s = sq < LB ? CB + sq : sq - LB;
}
}


namespace rw {
typedef short bf16x8 __attribute__((ext_vector_type(8)));
typedef float f32x4 __attribute__((ext_vector_type(4)));
typedef unsigned u32x4 __attribute__((ext_vector_type(4)));
enum { V_A = 0, V_W, V_B, V_K, V_R, NVEC };
constexpr int REC = NVEC * 64 * 4;
constexpr int PT = 144;
constexpr int L_SBUF = 0, L_VT = L_SBUF + 64 * REC, L_TW = L_VT + 64 * 256, L_AL = L_TW + 64 * PT, L_YS = L_AL + 64 * PT, L_INV = L_YS + 64 * 16 * 4, L_END = L_INV + 256;
__device__ __forceinline__ int vt_off(int row, int tt) { return row * 256 + ((tt ^ (((row >> 3) & 7) << 2)) << 2); }
static_assert(L_END <= 131072, "RWKV LDS map");
__device__ __forceinline__ float dpp_xor1(float x) { return __builtin_bit_cast(float, __builtin_amdgcn_update_dpp(0, __builtin_bit_cast(int, x), 0xB1, 0xF, 0xF, true)); }
__device__ __forceinline__ float dpp_xor2(float x) { return __builtin_bit_cast(float, __builtin_amdgcn_update_dpp(0, __builtin_bit_cast(int, x), 0x4E, 0xF, 0xF, true)); }
__device__ __forceinline__ float dpp_ror4(float x) { return __builtin_bit_cast(float, __builtin_amdgcn_update_dpp(0, __builtin_bit_cast(int, x), 0x124, 0xF, 0xF, true)); }
__device__ __forceinline__ float dpp_ror8(float x) { return __builtin_bit_cast(float, __builtin_amdgcn_update_dpp(0, __builtin_bit_cast(int, x), 0x128, 0xF, 0xF, true)); }
__device__ __forceinline__ float allsum16(float x) { x += dpp_xor1(x); x += dpp_xor2(x); x += dpp_ror4(x); x += dpp_ror8(x); return x; }
__device__ __forceinline__ f32x4 cvt_lo4(unsigned a, unsigned b) { return (f32x4){__builtin_bit_cast(float, a << 16), __builtin_bit_cast(float, a & 0xffff0000u), __builtin_bit_cast(float, b << 16), __builtin_bit_cast(float, b & 0xffff0000u)}; }
__device__ __forceinline__ float allsum32(float x) {
    x = allsum16(x);
    float xa = x, xb = x;
    asm volatile("v_mov_b32 %1, %0\n\ts_nop 1\n\tv_permlane32_swap_b32 %0, %1\n\ts_nop 1" : "+v"(xa), "=&v"(xb));
    return xa + xb;
}
__device__ __forceinline__ void rwkv_item(LAS unsigned char* lds, CParams& P, int l, int s, int head, int dir, int rh) {
    const int tid = threadIdx.x, w = __builtin_amdgcn_readfirstlane(tid >> 6), lane = tid & 63, fr = lane & 15, fq = lane >> 4;
    const int rt = w & 3, half = w >> 2, hc = head * 64;
    const SeqInfo q = seqinfo(s); const int nchunk = q.T / 64;
    const bf16* RX = WSP(bf16, WS_RXC); bf16* U = WSP(bf16, WS_U1);
    const int pj = tid >> 3, psub = tid & 7;
    const int hh = lane >> 5, rsel = (lane >> 4) & 1, cg = lane & 15;
    const int row = 16 * rh + 2 * w + rsel, col0 = 32 * hh + 2 * cg;
    typedef float f32x2 __attribute__((ext_vector_type(2)));
    f32x2 S2;
    if (!q.grid) S2 = (f32x2){0.f, 0.f};
    else { const size_t sb = (((size_t)q.b * DEPTH + l) * 2 + dir) * RH + head; S2 = *(const f32x2*)(P.in[ST_R] + (sb * 64 + row) * 64 + col0); }
    float rkk8[8];
#pragma unroll
    for (int e = 0; e < 8; ++e) rkk8[e] = P.in[R_KK][(size_t)l * RW + hc + 8 * psub + e];
    float c_w0[2], c_a0[2], c_kk[2], c_ka[2];
    bf16x8 bw[2][2], ba[2][2];
#pragma unroll
    for (int cc = 0; cc < 2; ++cc) { const int c = 16 * (2 * half + cc) + fr;
        c_w0[cc] = P.in[R_W0][((size_t)l * 2 + dir) * RW + hc + c]; c_a0[cc] = P.in[R_A0][((size_t)l * 2 + dir) * RW + hc + c];
        c_kk[cc] = P.in[R_KK][(size_t)l * RW + hc + c]; c_ka[cc] = P.in[R_KA][(size_t)l * RW + hc + c];
#pragma unroll
        for (int ks = 0; ks < 2; ++ks)
#pragma unroll
            for (int e = 0; e < 8; ++e) { const int j = 32 * ks + 8 * fq + e;
                bw[cc][ks][e] = (short)f2bf(P.in[R_W2][(((size_t)l * 2 + dir) * 64 + j) * RW + hc + c]);
                ba[cc][ks][e] = (short)f2bf(P.in[R_A2][(((size_t)l * 2 + dir) * 64 + j) * RW + hc + c]); } }
    u32x4 pf[5];
#define RW_TOK(c, j) ((size_t)(q.base + (dir ? q.T - 1 - ((c) * 64 + (j)) : ((c) * 64 + (j)))))
#define RW_PREFETCH(c) do { const bf16* rx = RX + RW_TOK(c, pj) * RIN + 8 * psub; \
        pf[0] = *(const u32x4*)(rx + RX_R + hc); pf[1] = *(const u32x4*)(rx + RX_K + hc); pf[2] = *(const u32x4*)(rx + RX_V + hc); \
        pf[3] = *(const u32x4*)(rx + RX_WL + dir * 64); pf[4] = *(const u32x4*)(rx + RX_AL + dir * 64); } while (0)
    RW_PREFETCH(0);
    for (int c = 0; c < nchunk; ++c) {
        { LAS unsigned char* rec = lds + L_SBUF + pj * REC + psub * 32;
          *(LAS f32x4*)(rec + V_R * 256) = cvt_lo4(pf[0].x, pf[0].y); *(LAS f32x4*)(rec + V_R * 256 + 16) = cvt_lo4(pf[0].z, pf[0].w);
          { const f32x4 v0 = cvt_lo4(pf[2].x, pf[2].y), v1 = cvt_lo4(pf[2].z, pf[2].w);
#pragma unroll
            for (int e = 0; e < 4; ++e) { *(LAS float*)(lds + L_VT + vt_off(8 * psub + e, pj)) = v0[e]; *(LAS float*)(lds + L_VT + vt_off(8 * psub + 4 + e, pj)) = v1[e]; } }
          const f32x4 k0 = cvt_lo4(pf[1].x, pf[1].y), k1 = cvt_lo4(pf[1].z, pf[1].w);
          *(LAS f32x4*)(rec + V_K * 256) = k0; *(LAS f32x4*)(rec + V_K * 256 + 16) = k1;
          float ss = 0.f;
#pragma unroll
          for (int e = 0; e < 4; ++e) { const float x0 = k0[e] * rkk8[e], x1 = k1[e] * rkk8[4 + e]; ss += x0 * x0 + x1 * x1; }
          ss += dpp_xor1(ss); ss += dpp_xor2(ss); ss += __shfl_xor(ss, 4);
          if (psub == 0) *(LAS float*)(lds + L_INV + pj * 4) = 1.0f / fmaxf(sqrtf(ss), 1e-12f);
          *(LAS u32x4*)(lds + L_TW + pj * PT + psub * 16) = pf[3]; *(LAS u32x4*)(lds + L_AL + pj * PT + psub * 16) = pf[4]; }
        __syncthreads();
        if (c + 1 < nchunk) RW_PREFETCH(c + 1);
#pragma unroll
        for (int cc = 0; cc < 2; ++cc) { const int ct = 2 * half + cc; const int cidx = 16 * ct + fr;
            f32x4 aw = (f32x4){0.f, 0.f, 0.f, 0.f}, aa = (f32x4){0.f, 0.f, 0.f, 0.f};
#pragma unroll
            for (int ks = 0; ks < 2; ++ks) { aw = ml::mma(ml::frag(lds, L_TW, PT, 16 * rt, 32 * ks, lane), bw[cc][ks], aw); aa = ml::mma(ml::frag(lds, L_AL, PT, 16 * rt, 32 * ks, lane), ba[cc][ks], aa); }
#pragma unroll
            for (int r = 0; r < 4; ++r) { const int tok = 16 * rt + 4 * fq + r; LAS float* rec = (LAS float*)(lds + L_SBUF + tok * REC) + cidx;
                const float decay = __expf(-0.6065306597126334f * pg8::fsigmoid(c_w0[cc] + aw[r])); const float alpha = pg8::fsigmoid(c_a0[cc] + aa[r]);
                const float kraw = rec[V_K * 64]; const float kkn = kraw * c_kk[cc] * *(LAS float*)(lds + L_INV + tok * 4);
                rec[V_A * 64] = -kkn; rec[V_W * 64] = decay; rec[V_B * 64] = kkn * alpha; rec[V_K * 64] = kraw * (1.0f + (alpha - 1.0f) * c_ka[cc]); } }
        __syncthreads();
        {
            const LAS unsigned char* rbase = lds + L_SBUF + col0 * 4;
            f32x2 ca = *(const LAS f32x2*)(rbase + V_A * 256), cw = *(const LAS f32x2*)(rbase + V_W * 256), cb = *(const LAS f32x2*)(rbase + V_B * 256),
                  ck = *(const LAS f32x2*)(rbase + V_K * 256), cr = *(const LAS f32x2*)(rbase + V_R * 256);
#pragma unroll 1
            for (int blk = 0; blk < 4; ++blk) {
                float ykeep = 0.f;
#pragma unroll
                for (int g4 = 0; g4 < 4; ++g4) {
                    const f32x4 v4 = *(const LAS f32x4*)(lds + L_VT + vt_off(row, 16 * blk + 4 * g4));
#pragma unroll
                    for (int i4 = 0; i4 < 4; ++i4) {
                        const int i = 4 * g4 + i4, tt = 16 * blk + i, tn = tt < 63 ? tt + 1 : 63;
                        const LAS unsigned char* rn = rbase + tn * REC;
                        const f32x2 na = *(const LAS f32x2*)(rn + V_A * 256), nw = *(const LAS f32x2*)(rn + V_W * 256), nb = *(const LAS f32x2*)(rn + V_B * 256),
                                    nk = *(const LAS f32x2*)(rn + V_K * 256), nr = *(const LAS f32x2*)(rn + V_R * 256);
                        const float vv = v4[i4];
                        const f32x2 p = S2 * ca;
                        const float sa = allsum32(p.x + p.y);
                        S2 = S2 * cw + ck * vv;
                        S2 = cb * sa + S2;
                        const f32x2 yq = S2 * cr;
                        const float y = allsum32(yq.x + yq.y);
                        ykeep = (cg == i) ? y : ykeep;
                        ca = na; cw = nw; cb = nb; ck = nk; cr = nr;
                    }
                }
                if (hh == 0) *(LAS float*)(lds + L_YS + ((16 * blk + cg) * 16 + 2 * w + rsel) * 4) = ykeep;
            }
        }
        __syncthreads();
        if (tid < 128) { const int j = tid >> 1, pc = tid & 1; const LAS float* ys = (const LAS float*)(lds + L_YS) + j * 16 + 8 * pc;
            u32x4 o; o.x = pg8::cvt_pk_bf16(ys[0], ys[1]); o.y = pg8::cvt_pk_bf16(ys[2], ys[3]); o.z = pg8::cvt_pk_bf16(ys[4], ys[5]); o.w = pg8::cvt_pk_bf16(ys[6], ys[7]);
            *(u32x4*)(U + RW_TOK(c, j) * PU + OFF_R + dir * RW + hc + 16 * rh + 8 * pc) = o; }
    }
    if (!q.grid) { const size_t sb = (((size_t)q.b * DEPTH + l) * 2 + dir) * RH + head; *(f32x2*)(P.out + OUT_S + (sb * 64 + row) * 64 + col0) = S2; }
    __syncthreads();
#undef RW_TOK
#undef RW_PREFETCH
}
constexpr int N_ITEMS = NSEQ * RH * 2 * 4;
__device__ __forceinline__ void decode_item(int it, int& s, int& head, int& dir, int& rh) {
    rh = it & 3; int ch = it >> 2; dir = ch & 1; ch >>= 1; head = ch % RH; const int sq = ch / RH;
    s = sq < LB ? CB + sq : sq - LB;
}
}


namespace wy {
typedef short bf16x8 __attribute__((ext_vector_type(8)));
typedef float f32x4 __attribute__((ext_vector_type(4)));
typedef unsigned u32x4 __attribute__((ext_vector_type(4)));
constexpr int PV = 144, PS = 48, PVS = 136;
constexpr int L_AH = 0, L_RH = L_AH + 64 * PV, L_BT = L_RH + 64 * PV, L_KT = L_BT + 64 * PV, L_NAKT = L_KT + 64 * PV, L_NRKT = L_NAKT + 4 * 16 * PS,
              L_NRBT = L_NRKT + 4 * 16 * PS, L_TT = L_NRBT + 4 * 16 * PS, L_GL = L_TT + 4 * 16 * PS, PACK_BYTES = L_GL + 1024,
              L_VS = PACK_BYTES, L_BH = L_VS + 64 * PV, L_KH = L_BH + 64 * PV, L_YS = L_KH + 64 * PV, L_TW = L_YS + 64 * PV, L_AL = L_TW + 64 * PV, L_NAB = L_AL + 64 * PV, L_INV = L_NAB + 4096, L_END = L_INV + 256;
constexpr int RING = 8, PACK_U = PACK_BYTES / 16, N_LAT = LB * RH * 2, RING_A = 20;
static_assert(PACK_BYTES % 1024 == 0 && PACK_U <= 8 * 512 && (size_t)RING_A * RING * PACK_BYTES <= (size_t)N1P * D * 2 && WS_END + (size_t)(N_LAT - RING_A) * RING * PACK_BYTES <= ((size_t)256 << 20), "ring placement");
static_assert(L_END <= 131072, "WY LDS map");
__device__ __forceinline__ bf16x8 fragk16(LAS unsigned char* lds, int base, int pitch, int row0, int k0, int lane) {
    const bf16x8 v = *(const LAS bf16x8*)(lds + base + (row0 + (lane & 15)) * pitch + (k0 + 8 * ((lane >> 4) & 1)) * 2);
    const bf16x8 z = {0, 0, 0, 0, 0, 0, 0, 0};
    return (lane < 32) ? v : z;
}
__device__ __forceinline__ void stb(LAS unsigned char* lds, int off, float v) { *(LAS bf16*)(lds + off) = f2bf(v); }
typedef unsigned u32x2 __attribute__((ext_vector_type(2)));
__device__ __forceinline__ bf16x8 pack_k16(const f32x4 v) { u32x4 o; o.x = pg8::cvt_pk_bf16(v[0], v[1]); o.y = pg8::cvt_pk_bf16(v[2], v[3]); o.z = 0u; o.w = 0u; return __builtin_bit_cast(bf16x8, o); }
__device__ __forceinline__ bf16x8 pack_k32(const f32x4 a, const f32x4 b) { u32x4 o; o.x = pg8::cvt_pk_bf16(a[0], a[1]); o.y = pg8::cvt_pk_bf16(a[2], a[3]); o.z = pg8::cvt_pk_bf16(b[0], b[1]); o.w = pg8::cvt_pk_bf16(b[2], b[3]);
    return __builtin_bit_cast(bf16x8, o); }
__device__ __forceinline__ bf16x8 ld_k16(LAS unsigned char* lds, int base, int pitch, int row0, int col0, int lane) {
    const u32x2 v = *(const LAS u32x2*)(lds + base + (row0 + (lane & 15)) * pitch + (col0 + 4 * (lane >> 4)) * 2); u32x4 o; o.x = v.x; o.y = v.y; o.z = 0u; o.w = 0u; return __builtin_bit_cast(bf16x8, o); }
__device__ __forceinline__ bf16x8 ld_k32(LAS unsigned char* lds, int base, int pitch, int row0, int col0, int lane) {
    const LAS unsigned char* p = lds + base + (row0 + (lane & 15)) * pitch + (col0 + 4 * (lane >> 4)) * 2;
    const u32x2 v0 = *(const LAS u32x2*)p, v1 = *(const LAS u32x2*)(p + 32); u32x4 o; o.x = v0.x; o.y = v0.y; o.z = v1.x; o.w = v1.y; return __builtin_bit_cast(bf16x8, o); }
__device__ __forceinline__ void rwkv_item(LAS unsigned char* lds, CParams& P, int l, int s, int head, int dir) {
    const int tid = threadIdx.x, w = __builtin_amdgcn_readfirstlane(tid >> 6), lane = tid & 63, fr = lane & 15, fq = lane >> 4;
    const int rt = w & 3, half = w >> 2, hc = head * 64;
    const SeqInfo q = seqinfo(s); const int nchunk = q.T / 64;
    const bf16* RX = WSP(bf16, WS_RXC); bf16* U = WSP(bf16, WS_U1);
    const int pj = tid >> 3, psub = tid & 7;
    f32x4 sacc[4];
#pragma unroll
    for (int ct = 0; ct < 4; ++ct) sacc[ct] = (f32x4){0.f, 0.f, 0.f, 0.f};
    if (w < 4 && q.grid) { const size_t sb = (((size_t)q.b * DEPTH + l) * 2 + dir) * RH + head;
#pragma unroll
        for (int ct = 0; ct < 4; ++ct) sacc[ct] = *(const f32x4*)(P.in[ST_R] + (sb * 64 + 16 * w + fr) * 64 + 16 * ct + 4 * fq); }
    float rkk8[8];
#pragma unroll
    for (int e = 0; e < 8; ++e) rkk8[e] = P.in[R_KK][(size_t)l * RW + hc + 8 * psub + e];
    float c_w0[2], c_a0[2], c_kk[2], c_ka[2];
#pragma unroll
    for (int cc = 0; cc < 2; ++cc) { const int c = 16 * (2 * half + cc) + fr;
        c_w0[cc] = P.in[R_W0][((size_t)l * 2 + dir) * RW + hc + c]; c_a0[cc] = P.in[R_A0][((size_t)l * 2 + dir) * RW + hc + c];
        c_kk[cc] = P.in[R_KK][(size_t)l * RW + hc + c]; c_ka[cc] = P.in[R_KA][(size_t)l * RW + hc + c]; }
    const bf16* w2t = WSP(bf16, O_W2T) + ((size_t)dir * RW + hc) * 64; const bf16* a2t = WSP(bf16, O_A2T) + ((size_t)dir * RW + hc) * 64;
    u32x4 pf[5];
#define WY_TOK(c, j) ((size_t)(q.base + (dir ? q.T - 1 - ((c) * 64 + (j)) : ((c) * 64 + (j)))))
#define WY_PREFETCH(c) do { const bf16* rx = RX + WY_TOK(c, pj) * RIN + 8 * psub; \
        pf[0] = *(const u32x4*)(rx + RX_R + hc); pf[1] = *(const u32x4*)(rx + RX_K + hc); pf[2] = *(const u32x4*)(rx + RX_V + hc); \
        pf[3] = *(const u32x4*)(rx + RX_WL + dir * 64); pf[4] = *(const u32x4*)(rx + RX_AL + dir * 64); } while (0)
    WY_PREFETCH(0);
    for (int c = 0; c < nchunk; ++c) {
        { *(LAS u32x4*)(lds + L_RH + pj * PV + psub * 16) = pf[0]; *(LAS u32x4*)(lds + L_KH + pj * PV + psub * 16) = pf[1];
          const unsigned kw[4] = {pf[1].x, pf[1].y, pf[1].z, pf[1].w}, vw[4] = {pf[2].x, pf[2].y, pf[2].z, pf[2].w};
          float ss = 0.f;
#pragma unroll
          for (int e = 0; e < 8; ++e) { const float kf = __builtin_bit_cast(float, (e & 1) ? (kw[e >> 1] & 0xffff0000u) : (kw[e >> 1] << 16)) * rkk8[e]; ss += kf * kf;
              *(LAS bf16*)(lds + L_VS + (8 * psub + e) * PVS + pj * 2) = (bf16)((vw[e >> 1] >> ((e & 1) * 16)) & 0xffffu); }
          ss += rw::dpp_xor1(ss); ss += rw::dpp_xor2(ss); ss += __shfl_xor(ss, 4);
          if (psub == 0) *(LAS float*)(lds + L_INV + pj * 4) = 1.0f / fmaxf(sqrtf(ss), 1e-12f);
          *(LAS u32x4*)(lds + L_TW + pj * PV + psub * 16) = pf[3]; *(LAS u32x4*)(lds + L_AL + pj * PV + psub * 16) = pf[4]; }
        LDS_BARRIER();
        if (c + 1 < nchunk) WY_PREFETCH(c + 1);
#pragma unroll
        for (int cc = 0; cc < 2; ++cc) { const int ct = 2 * half + cc; const int cidx = 16 * ct + fr;
            f32x4 aw = (f32x4){0.f, 0.f, 0.f, 0.f}, aa = (f32x4){0.f, 0.f, 0.f, 0.f};
#pragma unroll
            for (int ks = 0; ks < 2; ++ks) { const size_t bo = (size_t)cidx * 64 + 32 * ks + 8 * fq;
                aw = ml::mma(ml::frag(lds, L_TW, PV, 16 * rt, 32 * ks, lane), *(const bf16x8*)(w2t + bo), aw); aa = ml::mma(ml::frag(lds, L_AL, PV, 16 * rt, 32 * ks, lane), *(const bf16x8*)(a2t + bo), aa); }
            float kr4[4], rr4[4], iv4[4];
#pragma unroll
            for (int r = 0; r < 4; ++r) { const int tok = 16 * rt + 4 * fq + r; kr4[r] = bf2f(*(const LAS bf16*)(lds + L_KH + tok * PV + cidx * 2)); rr4[r] = bf2f(*(const LAS bf16*)(lds + L_RH + tok * PV + cidx * 2));
                iv4[r] = *(const LAS float*)(lds + L_INV + tok * 4); }
            float lw[4], cum[4];
#pragma unroll
            for (int r = 0; r < 4; ++r) { lw[r] = -0.6065306597126334f * pg8::fsigmoid(c_w0[cc] + aw[r]); cum[r] = (r ? cum[r - 1] : 0.f) + lw[r]; }
            const float tot = cum[3]; const float p1 = __shfl_up(tot, 16), p2 = __shfl_up(tot, 32), p3 = __shfl_up(tot, 48);
            const float off = (fq >= 1 ? p1 : 0.f) + (fq >= 2 ? p2 : 0.f) + (fq >= 3 ? p3 : 0.f);
            float gprev = __expf(off);
#pragma unroll
            for (int r = 0; r < 4; ++r) { const int tok = 16 * rt + 4 * fq + r; const float lam = off + cum[r]; const float g = __expf(lam), gi = __builtin_amdgcn_rcpf(g);
                const float alpha = pg8::fsigmoid(c_a0[cc] + aa[r]);
                const float kraw = kr4[r], rraw = rr4[r];
                const float kkn = kraw * c_kk[cc] * iv4[r];
                const bf16 bh = f2bf(kkn * alpha * gi), kh = f2bf(kraw * (1.0f + (alpha - 1.0f) * c_ka[cc]) * gi);
                stb(lds, L_AH + tok * PV + cidx * 2, -kkn * gprev); stb(lds, L_RH + tok * PV + cidx * 2, rraw * g);
                *(LAS bf16*)(lds + L_BH + tok * PV + cidx * 2) = bh; *(LAS bf16*)(lds + L_KH + tok * PV + cidx * 2) = kh;
                *(LAS bf16*)(lds + L_BT + cidx * PV + tok * 2) = bh; *(LAS bf16*)(lds + L_KT + cidx * PV + tok * 2) = kh;
                if (fq == 3 && r == 3) *(LAS float*)(lds + L_GL + (rt * 64 + cidx) * 4) = g;
                gprev = g; } }
        LDS_BARRIER();
        { const int sc = w >> 1, side = w & 1; f32x4 gB = (f32x4){0.f, 0.f, 0.f, 0.f}, gK = (f32x4){0.f, 0.f, 0.f, 0.f};
#pragma unroll
          for (int ks = 0; ks < 2; ++ks) { const bf16x8 af = ml::frag(lds, side ? L_RH : L_AH, PV, 16 * sc, 32 * ks, lane);
              gB = ml::mma(af, ml::frag(lds, L_BH, PV, 16 * sc, 32 * ks, lane), gB); gK = ml::mma(af, ml::frag(lds, L_KH, PV, 16 * sc, 32 * ks, lane), gK); }
#pragma unroll
          for (int r = 0; r < 4; ++r) { const int t = 4 * fq + r; const bool keep = side ? (fr <= t) : (fr < t); const float vB = keep ? gB[r] : 0.f, vK = keep ? gK[r] : 0.f;
              if (side == 0) { *(LAS float*)(lds + L_NAB + ((sc * 16 + t) * 16 + fr) * 4) = vB; stb(lds, L_NAKT + (sc * 16 + t) * PS + fr * 2, vK); }
              else { stb(lds, L_NRBT + (sc * 16 + t) * PS + fr * 2, vB); stb(lds, L_NRKT + (sc * 16 + t) * PS + fr * 2, vK); } } }
        if ((w & 1) == 0 && lane < 16) { const int sc = w >> 1; float Tr[16];
            asm volatile("" ::: "memory");
#pragma unroll
            for (int ph = 0; ph < 4; ++ph) { f32x4 nv[4][4];
#pragma unroll
                for (int tq = 0; tq < 4; ++tq)
#pragma unroll
                    for (int u4 = 0; u4 <= ph; ++u4) nv[tq][u4] = *(const LAS f32x4*)(lds + L_NAB + ((sc * 16 + 4 * ph + tq) * 16 + 4 * u4) * 4);
#pragma unroll
                for (int tq = 0; tq < 4; ++tq) { const int t = 4 * ph + tq; float x0 = (lane == t) ? 1.f : 0.f, x1 = 0.f;
#pragma unroll
                    for (int u = 0; u < 16; ++u) if (u < t) { if (u & 1) x1 += Tr[u] * nv[tq][u >> 2][u & 3]; else x0 += Tr[u] * nv[tq][u >> 2][u & 3]; }
                    Tr[t] = x0 + x1; stb(lds, L_TT + (sc * 16 + t) * PS + lane * 2, Tr[t]); } } }
        LDS_BARRIER();
        if (w < 4) {
#pragma unroll 1
            for (int sc = 0; sc < 4; ++sc) {
                const bf16x8 ah0 = ld_k32(lds, L_AH, PV, 16 * sc, 0, lane), ah1 = ld_k32(lds, L_AH, PV, 16 * sc, 32, lane), rh0 = ld_k32(lds, L_RH, PV, 16 * sc, 0, lane), rh1 = ld_k32(lds, L_RH, PV, 16 * sc, 32, lane);
                const bf16x8 nak = ld_k16(lds, L_NAKT, PS, 16 * sc, 0, lane), nrk = ld_k16(lds, L_NRKT, PS, 16 * sc, 0, lane), ttf = ld_k16(lds, L_TT, PS, 16 * sc, 0, lane), nrb = ld_k16(lds, L_NRBT, PS, 16 * sc, 0, lane);
                const bf16x8 vsf = ld_k16(lds, L_VS, PVS, 16 * w, 16 * sc, lane);
                bf16x8 btf[4], ktf[4]; f32x4 glv[4];
#pragma unroll
                for (int ct = 0; ct < 4; ++ct) { btf[ct] = ld_k16(lds, L_BT, PV, 16 * ct, 16 * sc, lane); ktf[ct] = ld_k16(lds, L_KT, PV, 16 * ct, 16 * sc, lane);
                    glv[ct] = *(const LAS f32x4*)(lds + L_GL + (sc * 64 + 16 * ct + 4 * fq) * 4); }
                const bf16x8 sb0 = pack_k32(sacc[0], sacc[1]), sb1 = pack_k32(sacc[2], sacc[3]);
                f32x4 XT = (f32x4){0.f, 0.f, 0.f, 0.f}, YT = (f32x4){0.f, 0.f, 0.f, 0.f};
                XT = ml::mma(ah0, sb0, XT); XT = ml::mma(ah1, sb1, XT); XT = ml::mma(nak, vsf, XT);
                YT = ml::mma(rh0, sb0, YT); YT = ml::mma(rh1, sb1, YT); YT = ml::mma(nrk, vsf, YT);
                f32x4 UT = (f32x4){0.f, 0.f, 0.f, 0.f};
                UT = ml::mma(ttf, pack_k16(XT), UT);
                const bf16x8 ub = pack_k16(UT);
                YT = ml::mma(nrb, ub, YT);
#pragma unroll
                for (int r = 0; r < 4; ++r) stb(lds, L_YS + (16 * sc + 4 * fq + r) * PV + (16 * w + fr) * 2, YT[r]);
#pragma unroll
                for (int ct = 0; ct < 4; ++ct) { sacc[ct] = ml::mma(btf[ct], ub, sacc[ct]); sacc[ct] = ml::mma(ktf[ct], vsf, sacc[ct]); sacc[ct] = sacc[ct] * glv[ct]; }
            }
        }
        LDS_BARRIER();
        *(u32x4*)(U + WY_TOK(c, pj) * PU + OFF_R + dir * RW + hc + 8 * psub) = *(const LAS u32x4*)(lds + L_YS + pj * PV + psub * 16);
    }
    if (!q.grid && w < 4) { const size_t sb = (((size_t)q.b * DEPTH + l) * 2 + dir) * RH + head;
#pragma unroll
        for (int ct = 0; ct < 4; ++ct) *(f32x4*)(P.out + OUT_S + (sb * 64 + 16 * w + fr) * 64 + 16 * ct + 4 * fq) = sacc[ct]; }
    LDS_BARRIER();
#undef WY_TOK
#undef WY_PREFETCH
}
__device__ __forceinline__ int tid_opaque() { int t = threadIdx.x; asm volatile("" : "+v"(t)); return t; }
constexpr int CW_F = 16384, FL_STRIDE = 64, NPROD = 2;
static_assert(RING % NPROD == 0 && NPROD + 1 <= 4 && CW_F + DEPTH * N_LAT * 4 * FL_STRIDE <= 32768, "flag block");
constexpr unsigned FL_SPIN_CAP = 1u << 18;
__device__ __forceinline__ unsigned fl_ld(unsigned* p) { return __hip_atomic_load(p, __ATOMIC_RELAXED, __HIP_MEMORY_SCOPE_AGENT); }
__device__ __forceinline__ unsigned fl_wait_ge(unsigned* p, unsigned want, unsigned* tmo) {
    unsigned sp = 0, v;
    while ((v = fl_ld(p)) < want) { __builtin_amdgcn_s_sleep(1); if ((++sp & 255u) == 0u) { if (fl_ld(tmo)) break; if (sp > FL_SPIN_CAP) { atomicAdd(tmo, 1u); break; } } }
    return v;
}
__device__ __forceinline__ void rwkv_prod(LAS unsigned char* lds, CParams& P, int l, int s, int head, int dir, int chain, int pp, unsigned* ctl) {
    const int tid = tid_opaque(), w = __builtin_amdgcn_readfirstlane(tid >> 6), lane = tid & 63, fr = lane & 15, fq = lane >> 4;
    const int rt = w & 3, half = w >> 2, hc = head * 64;
    const SeqInfo q = seqinfo(s); const int nchunk = q.T / 64;
    const bf16* RX = WSP(bf16, WS_RXC);
    const int pj = tid >> 3, psub = tid & 7;
    unsigned char* ring = P.ws + (chain < RING_A ? O_WIN1 + (size_t)chain * RING * PACK_BYTES : WS_END + (size_t)(chain - RING_A) * RING * PACK_BYTES);
    unsigned* f_base = ctl + CW_F + (size_t)((l * N_LAT + chain) * 4) * FL_STRIDE; unsigned* f_ready = f_base + pp * FL_STRIDE; unsigned* f_ack = f_base + NPROD * FL_STRIDE; unsigned* tmo = ctl + 4096 + 128;
    float rkk8[8];
#pragma unroll
    for (int e = 0; e < 8; ++e) rkk8[e] = P.in[R_KK][(size_t)l * RW + hc + 8 * psub + e];
    float c_w0[2], c_a0[2], c_kk[2], c_ka[2];
#pragma unroll
    for (int cc = 0; cc < 2; ++cc) { const int c = 16 * (2 * half + cc) + fr;
        c_w0[cc] = P.in[R_W0][((size_t)l * 2 + dir) * RW + hc + c]; c_a0[cc] = P.in[R_A0][((size_t)l * 2 + dir) * RW + hc + c];
        c_kk[cc] = P.in[R_KK][(size_t)l * RW + hc + c]; c_ka[cc] = P.in[R_KA][(size_t)l * RW + hc + c]; }
    const bf16* w2t = WSP(bf16, O_W2T) + ((size_t)dir * RW + hc) * 64; const bf16* a2t = WSP(bf16, O_A2T) + ((size_t)dir * RW + hc) * 64;
    u32x4 pf[5];
#define WY_TOK(c, j) ((size_t)(q.base + (dir ? q.T - 1 - ((c) * 64 + (j)) : ((c) * 64 + (j)))))
#define WY_PREFETCH(c) do { const bf16* rx = RX + WY_TOK(c, pj) * RIN + 8 * psub; \
        pf[0] = *(const u32x4*)(rx + RX_R + hc); pf[1] = *(const u32x4*)(rx + RX_K + hc); pf[2] = pf[0]; \
        pf[3] = *(const u32x4*)(rx + RX_WL + dir * 64); pf[4] = *(const u32x4*)(rx + RX_AL + dir * 64); } while (0)
    WY_PREFETCH(pp);
    asm volatile("" :: "v"(pf[0]), "v"(pf[1]), "v"(pf[2]), "v"(pf[3]), "v"(pf[4]) : "memory");
    unsigned acked = 0u;
    for (int c = pp; c < nchunk; c += NPROD) {
        { *(LAS u32x4*)(lds + L_RH + pj * PV + psub * 16) = pf[0]; *(LAS u32x4*)(lds + L_KH + pj * PV + psub * 16) = pf[1];
          const unsigned kw[4] = {pf[1].x, pf[1].y, pf[1].z, pf[1].w};
          float ss = 0.f;
#pragma unroll
          for (int e = 0; e < 8; ++e) { const float kf = __builtin_bit_cast(float, (e & 1) ? (kw[e >> 1] & 0xffff0000u) : (kw[e >> 1] << 16)) * rkk8[e]; ss += kf * kf; }
          ss += rw::dpp_xor1(ss); ss += rw::dpp_xor2(ss); ss += __shfl_xor(ss, 4);
          if (psub == 0) *(LAS float*)(lds + L_INV + pj * 4) = 1.0f / fmaxf(sqrtf(ss), 1e-12f);
          *(LAS u32x4*)(lds + L_TW + pj * PV + psub * 16) = pf[3]; *(LAS u32x4*)(lds + L_AL + pj * PV + psub * 16) = pf[4]; }
        LDS_BARRIER();
        if (c + NPROD < nchunk) WY_PREFETCH(c + NPROD);
#pragma unroll
        for (int cc = 0; cc < 2; ++cc) { const int ct = 2 * half + cc; const int cidx = 16 * ct + fr;
            f32x4 aw = (f32x4){0.f, 0.f, 0.f, 0.f}, aa = (f32x4){0.f, 0.f, 0.f, 0.f};
#pragma unroll
            for (int ks = 0; ks < 2; ++ks) { const size_t bo = (size_t)cidx * 64 + 32 * ks + 8 * fq;
                aw = ml::mma(ml::frag(lds, L_TW, PV, 16 * rt, 32 * ks, lane), *(const bf16x8*)(w2t + bo), aw); aa = ml::mma(ml::frag(lds, L_AL, PV, 16 * rt, 32 * ks, lane), *(const bf16x8*)(a2t + bo), aa); }
            float kr4[4], rr4[4], iv4[4];
#pragma unroll
            for (int r = 0; r < 4; ++r) { const int tok = 16 * rt + 4 * fq + r; kr4[r] = bf2f(*(const LAS bf16*)(lds + L_KH + tok * PV + cidx * 2)); rr4[r] = bf2f(*(const LAS bf16*)(lds + L_RH + tok * PV + cidx * 2));
                iv4[r] = *(const LAS float*)(lds + L_INV + tok * 4); }
            float lw[4], cum[4];
#pragma unroll
            for (int r = 0; r < 4; ++r) { lw[r] = -0.6065306597126334f * pg8::fsigmoid(c_w0[cc] + aw[r]); cum[r] = (r ? cum[r - 1] : 0.f) + lw[r]; }
            const float tot = cum[3]; const float p1 = __shfl_up(tot, 16), p2 = __shfl_up(tot, 32), p3 = __shfl_up(tot, 48);
            const float off = (fq >= 1 ? p1 : 0.f) + (fq >= 2 ? p2 : 0.f) + (fq >= 3 ? p3 : 0.f);
            float gprev = __expf(off);
#pragma unroll
            for (int r = 0; r < 4; ++r) { const int tok = 16 * rt + 4 * fq + r; const float lam = off + cum[r]; const float g = __expf(lam), gi = __builtin_amdgcn_rcpf(g);
                const float alpha = pg8::fsigmoid(c_a0[cc] + aa[r]);
                const float kraw = kr4[r], rraw = rr4[r];
                const float kkn = kraw * c_kk[cc] * iv4[r];
                const bf16 bh = f2bf(kkn * alpha * gi), kh = f2bf(kraw * (1.0f + (alpha - 1.0f) * c_ka[cc]) * gi);
                stb(lds, L_AH + tok * PV + cidx * 2, -kkn * gprev); stb(lds, L_RH + tok * PV + cidx * 2, rraw * g);
                *(LAS bf16*)(lds + L_BH + tok * PV + cidx * 2) = bh; *(LAS bf16*)(lds + L_KH + tok * PV + cidx * 2) = kh;
                *(LAS bf16*)(lds + L_BT + cidx * PV + tok * 2) = bh; *(LAS bf16*)(lds + L_KT + cidx * PV + tok * 2) = kh;
                if (fq == 3 && r == 3) *(LAS float*)(lds + L_GL + (rt * 64 + cidx) * 4) = g;
                gprev = g; } }
        asm volatile("s_waitcnt vmcnt(0)" ::: "memory");
        LDS_BARRIER();
        if (tid == 0 && c > pp) __hip_atomic_store(f_ready, (unsigned)((c - pp) / NPROD), __ATOMIC_RELAXED, __HIP_MEMORY_SCOPE_AGENT);
        { const int sc = w >> 1, side = w & 1; f32x4 gB = (f32x4){0.f, 0.f, 0.f, 0.f}, gK = (f32x4){0.f, 0.f, 0.f, 0.f};
#pragma unroll
          for (int ks = 0; ks < 2; ++ks) { const bf16x8 af = ml::frag(lds, side ? L_RH : L_AH, PV, 16 * sc, 32 * ks, lane);
              gB = ml::mma(af, ml::frag(lds, L_BH, PV, 16 * sc, 32 * ks, lane), gB); gK = ml::mma(af, ml::frag(lds, L_KH, PV, 16 * sc, 32 * ks, lane), gK); }
#pragma unroll
          for (int r = 0; r < 4; ++r) { const int t = 4 * fq + r; const bool keep = side ? (fr <= t) : (fr < t); const float vB = keep ? gB[r] : 0.f, vK = keep ? gK[r] : 0.f;
              if (side == 0) { *(LAS float*)(lds + L_NAB + ((sc * 16 + t) * 16 + fr) * 4) = vB; stb(lds, L_NAKT + (sc * 16 + t) * PS + fr * 2, vK); }
              else { stb(lds, L_NRBT + (sc * 16 + t) * PS + fr * 2, vB); stb(lds, L_NRKT + (sc * 16 + t) * PS + fr * 2, vK); } } }
        if ((w & 1) == 0 && lane < 16) { const int sc = w >> 1; float Tr[16];
            asm volatile("" ::: "memory");
#pragma unroll
            for (int ph = 0; ph < 4; ++ph) { f32x4 nv[4][4];
#pragma unroll
                for (int tq = 0; tq < 4; ++tq)
#pragma unroll
                    for (int u4 = 0; u4 <= ph; ++u4) nv[tq][u4] = *(const LAS f32x4*)(lds + L_NAB + ((sc * 16 + 4 * ph + tq) * 16 + 4 * u4) * 4);
#pragma unroll
                for (int tq = 0; tq < 4; ++tq) { const int t = 4 * ph + tq; float x0 = (lane == t) ? 1.f : 0.f, x1 = 0.f;
#pragma unroll
                    for (int u = 0; u < 16; ++u) if (u < t) { if (u & 1) x1 += Tr[u] * nv[tq][u >> 2][u & 3]; else x0 += Tr[u] * nv[tq][u >> 2][u & 3]; }
                    Tr[t] = x0 + x1; stb(lds, L_TT + (sc * 16 + t) * PS + lane * 2, Tr[t]); } } }
        if (tid == 0 && c >= RING && acked < (unsigned)(c - RING + 1)) acked = fl_wait_ge(f_ack, (unsigned)(c - RING + 1), tmo);
        LDS_BARRIER();
        asm volatile("" :: "v"(pf[0]), "v"(pf[1]), "v"(pf[2]), "v"(pf[3]), "v"(pf[4]) : "memory");
        { unsigned char* slot = ring + (size_t)(c % RING) * PACK_BYTES;
#pragma unroll
          for (int k = 0; k < 8; ++k) { const int u = tid + 512 * k;
              if (u < PACK_U) { const u32x4 v = *(const LAS u32x4*)(lds + 16 * u); const u32x4* gp = (const u32x4*)(slot + (size_t)16 * u);
                  asm volatile("global_store_dwordx4 %0, %1, off sc1" :: "v"(gp), "v"(v) : "memory"); } } }
        LDS_BARRIER();
    }
    asm volatile("s_waitcnt vmcnt(0)" ::: "memory");
    __syncthreads();
    if (tid == 0) __hip_atomic_store(f_ready, (unsigned)((nchunk - pp + NPROD - 1) / NPROD), __ATOMIC_RELAXED, __HIP_MEMORY_SCOPE_AGENT);
    LDS_BARRIER();
#undef WY_TOK
#undef WY_PREFETCH
}
__device__ __forceinline__ void rwkv_cons(LAS unsigned char* lds, CParams& P, int l, int s, int head, int dir, int chain, unsigned* ctl) {
    const int tid = tid_opaque(), w = __builtin_amdgcn_readfirstlane(tid >> 6), lane = tid & 63, fr = lane & 15, fq = lane >> 4;
    const int hc = head * 64;
    const SeqInfo q = seqinfo(s); const int nchunk = q.T / 64;
    bf16* U = WSP(bf16, WS_U1);
    const unsigned char* ring = P.ws + (chain < RING_A ? O_WIN1 + (size_t)chain * RING * PACK_BYTES : WS_END + (size_t)(chain - RING_A) * RING * PACK_BYTES);
    unsigned* f_base = ctl + CW_F + (size_t)((l * N_LAT + chain) * 4) * FL_STRIDE; unsigned* f_ack = f_base + NPROD * FL_STRIDE; unsigned* tmo = ctl + 4096 + 128;
    constexpr int C_IMG = PACK_BYTES + 64 * PV, C_YS = 2 * C_IMG;
    const bf16* RX = WSP(bf16, WS_RXC);
    static_assert(C_YS + 64 * PV <= 131072, "consumer LDS map");
    f32x4 sacc[4];
#pragma unroll
    for (int ct = 0; ct < 4; ++ct) sacc[ct] = (f32x4){0.f, 0.f, 0.f, 0.f};
    if (w < 4 && q.grid) { const size_t sb = (((size_t)q.b * DEPTH + l) * 2 + dir) * RH + head;
#pragma unroll
        for (int ct = 0; ct < 4; ++ct) sacc[ct] = *(const f32x4*)(P.in[ST_R] + (sb * 64 + 16 * w + fr) * 64 + 16 * ct + 4 * fq); }
#define WY_TOK(c, j) ((size_t)(q.base + (dir ? q.T - 1 - ((c) * 64 + (j)) : ((c) * 64 + (j)))))
    unsigned seen0 = 0u, seen1 = 0u;
#define CONS_FETCH(c, boff) do { const int p_ = (c) % NPROD; const unsigned need_ = (unsigned)((c) / NPROD + 1); \
        u32x4 vv_[2];   \
        _Pragma("unroll") for (int i_ = 0; i_ < 2; ++i_) vv_[i_] = *(const u32x4*)(RX + WY_TOK(c, lane) * RIN + RX_V + hc + 8 * (2 * (w - 4) + i_)); \
        if ((p_ ? seen1 : seen0) < need_) { unsigned v_ = 0u; if (lane == 0) v_ = fl_wait_ge(f_base + p_ * FL_STRIDE, need_, tmo); v_ = __builtin_amdgcn_readfirstlane(v_); \
            if (p_) seen1 = v_; else seen0 = v_; __builtin_amdgcn_fence(__ATOMIC_ACQUIRE, "agent"); } \
        _Pragma("unroll") for (int i_ = 0; i_ < 2; ++i_) { const unsigned wv_[4] = {vv_[i_].x, vv_[i_].y, vv_[i_].z, vv_[i_].w}; \
            _Pragma("unroll") for (int e_ = 0; e_ < 8; ++e_) *(LAS bf16*)(lds + (boff) + L_VS + (8 * (2 * (w - 4) + i_) + e_) * PVS + lane * 2) = (bf16)((wv_[e_ >> 1] >> ((e_ & 1) * 16)) & 0xffffu); } \
        const unsigned char* slot = ring + (size_t)((c) % RING) * PACK_BYTES; \
        for (int k = w - 4; k < PACK_BYTES / 1024; k += 4) \
            __builtin_amdgcn_global_load_lds((const unsigned*)(slot + (size_t)k * 1024 + lane * 16), (LAS unsigned*)(lds + (boff) + k * 1024), 16, 0, 0); \
        asm volatile("s_waitcnt vmcnt(0)" ::: "memory"); } while (0)
    if (w >= 4) CONS_FETCH(0, 0);
    LDS_BARRIER();
    if (tid == 256) __hip_atomic_store(f_ack, 1u, __ATOMIC_RELAXED, __HIP_MEMORY_SCOPE_AGENT);
    for (int c = 0; c < nchunk; ++c) {
        const int boff = (c & 1) * C_IMG;
        if (w >= 4) { if (c + 1 < nchunk) CONS_FETCH(c + 1, C_IMG - boff); }
        else {
            LAS unsigned char* pb = lds + boff;
#pragma unroll 1
            for (int sc = 0; sc < 4; ++sc) {
                const bf16x8 ah0 = ld_k32(pb, L_AH, PV, 16 * sc, 0, lane), ah1 = ld_k32(pb, L_AH, PV, 16 * sc, 32, lane), rh0 = ld_k32(pb, L_RH, PV, 16 * sc, 0, lane), rh1 = ld_k32(pb, L_RH, PV, 16 * sc, 32, lane);
                const bf16x8 nak = ld_k16(pb, L_NAKT, PS, 16 * sc, 0, lane), nrk = ld_k16(pb, L_NRKT, PS, 16 * sc, 0, lane), ttf = ld_k16(pb, L_TT, PS, 16 * sc, 0, lane), nrb = ld_k16(pb, L_NRBT, PS, 16 * sc, 0, lane);
                const bf16x8 vsf = ld_k16(pb, L_VS, PVS, 16 * w, 16 * sc, lane);
                bf16x8 btf[4], ktf[4]; f32x4 glv[4];
#pragma unroll
                for (int ct = 0; ct < 4; ++ct) { btf[ct] = ld_k16(pb, L_BT, PV, 16 * ct, 16 * sc, lane); ktf[ct] = ld_k16(pb, L_KT, PV, 16 * ct, 16 * sc, lane);
                    glv[ct] = *(const LAS f32x4*)(pb + L_GL + (sc * 64 + 16 * ct + 4 * fq) * 4); }
                const bf16x8 sb0 = pack_k32(sacc[0], sacc[1]), sb1 = pack_k32(sacc[2], sacc[3]);
                f32x4 XT = (f32x4){0.f, 0.f, 0.f, 0.f}, YT = (f32x4){0.f, 0.f, 0.f, 0.f};
                XT = ml::mma(ah0, sb0, XT); XT = ml::mma(ah1, sb1, XT); XT = ml::mma(nak, vsf, XT);
                YT = ml::mma(rh0, sb0, YT); YT = ml::mma(rh1, sb1, YT); YT = ml::mma(nrk, vsf, YT);
                f32x4 UT = (f32x4){0.f, 0.f, 0.f, 0.f};
                UT = ml::mma(ttf, pack_k16(XT), UT);
                const bf16x8 ub = pack_k16(UT);
                YT = ml::mma(nrb, ub, YT);
#pragma unroll
                for (int r = 0; r < 4; ++r) stb(lds, C_YS + (16 * sc + 4 * fq + r) * PV + (16 * w + fr) * 2, YT[r]);
#pragma unroll
                for (int ct = 0; ct < 4; ++ct) { sacc[ct] = ml::mma(btf[ct], ub, sacc[ct]); sacc[ct] = ml::mma(ktf[ct], vsf, sacc[ct]); sacc[ct] = sacc[ct] * glv[ct]; }
            }
            { const LAS unsigned char* yp = lds + C_YS + lane * PV + 32 * w; const u32x4 y0 = *(const LAS u32x4*)yp, y1 = *(const LAS u32x4*)(yp + 16);
              bf16* up = U + WY_TOK(c, lane) * PU + OFF_R + dir * RW + hc + 16 * w; *(u32x4*)up = y0; *(u32x4*)(up + 8) = y1; }
        }
        LDS_BARRIER();
        if (tid == 256 && c + 1 < nchunk) __hip_atomic_store(f_ack, (unsigned)(c + 2), __ATOMIC_RELAXED, __HIP_MEMORY_SCOPE_AGENT);
    }
    if (!q.grid && w < 4) { const size_t sb = (((size_t)q.b * DEPTH + l) * 2 + dir) * RH + head;
#pragma unroll
        for (int ct = 0; ct < 4; ++ct) *(f32x4*)(P.out + OUT_S + (sb * 64 + 16 * w + fr) * 64 + 16 * ct + 4 * fq) = sacc[ct]; }
    LDS_BARRIER();
#undef WY_TOK
#undef CONS_FETCH
}
constexpr int N_ITEMS = NSEQ * RH * 2;
__device__ __forceinline__ void decode_item(int it, int& s, int& head, int& dir) {
    dir = it & 1; int ch = it >> 1; head = ch % RH; const int sq = ch / RH;
    s = sq < LB ? CB + sq : sq - LB;
}
}

namespace ms {
using ml::PQ; using ml::PT; using ml::mma; using ml::frag; using wy::bf16x8; using wy::f32x4; using wy::u32x4;
constexpr int P_QS = 0, P_KT = P_QS + 64 * PQ, P_SB = P_KT + 128 * PT, P_SC = P_SB + 64 * PT, P_VT = P_SC + 4096, VT_BYTES = 21504, ML_PACK = P_VT + VT_BYTES, P_KS = ML_PACK, P_END = P_KS + 64 * PQ;
constexpr int ML_RING = 4, ML_PACK_U = ML_PACK / 16, N_MLAT = LB * MH * 2, CW_MF = 32768, MLPROD = 2;
static_assert(MLPROD == 2 && ML_RING % MLPROD == 0, "two producers per chain: even / odd chunks");
static_assert(ML_PACK % 1024 == 0 && ML_PACK_U <= 9 * 512 && 145 * PT <= VT_BYTES && P_END <= 131072 && 2 * ML_PACK <= 146432, "mLSTM pack layout");
static_assert(WS_END + (size_t)N_MLAT * ML_RING * ML_PACK <= ((size_t)256 << 20), "mLSTM ring fits behind the activations");
__device__ __forceinline__ void ml_prod(LAS unsigned char* lds, CParams& P, int l, int s, int head, int dir, int chain, int pp, unsigned* ctl) {
    const int tid = wy::tid_opaque(), w = __builtin_amdgcn_readfirstlane(tid >> 6), lane = tid & 63, fr = lane & 15, fq = lane >> 4;
    const int rt = w & 3, half = w >> 2;
    const SeqInfo q = seqinfo(s); const int nchunk = q.T / 64;
    const bf16* QK = WSP(bf16, WS_QKC); const bf16* U = WSP(bf16, WS_U1);
    LAS float* SC = (LAS float*)(lds + P_SC);
    unsigned char* ring = P.ws + WS_END + (size_t)chain * ML_RING * ML_PACK;
    unsigned* f_base = ctl + CW_MF + (size_t)((l * N_MLAT + chain) * 4) * wy::FL_STRIDE; unsigned* f_ready = f_base + pp * wy::FL_STRIDE; unsigned* f_ack = f_base + MLPROD * wy::FL_STRIDE; unsigned* tmo = ctl + 4096 + 128;
    float m_prev = 0.f;
    if (q.grid) m_prev = P.in[ST_M][(((size_t)q.b * DEPTH + l) * 2 + dir) * MH + head];
    const float bi = P.in[M_GATE_B][(size_t)l * 4 * MH + (2 * dir) * MH + head], bfg = P.in[M_GATE_B][(size_t)l * 4 * MH + (2 * dir + 1) * MH + head];
    for (int i = tid; i < (VT_BYTES - 128 * PT) / 2; i += 512) *(LAS bf16*)(lds + P_VT + 128 * PT + i * 2) = (i < 64) ? (bf16)0x3f80 : (bf16)0;
    u32x4 pqk[4]; u32x4 pv[2]; bf16 pgi = 0, pgf = 0, sgi = 0, sgf = 0;
#define ML_TOK(c, j) ((size_t)(q.base + (dir ? q.T - 1 - ((c) * 64 + (j)) : ((c) * 64 + (j)))))
#define ML_PREFETCH(c) do { _Pragma("unroll") for (int i = 0; i < 4; ++i) { const int id = tid + 512 * i, j = id >> 5, pc = id & 31; \
            pqk[i] = *(const u32x4*)(QK + ML_TOK(c, j) * (2 * MW) + (pc < 16 ? head * 128 + 8 * pc : MW + head * 128 + 8 * (pc - 16))); } \
        _Pragma("unroll") for (int i = 0; i < 2; ++i) { const int id = tid + 512 * i, j = id >> 4, pc = id & 15; pv[i] = *(const u32x4*)(U + ML_TOK(c, j) * PU + OFF_V + head * 128 + 8 * pc); } \
        if (w == 0) { const bf16* g = U + ML_TOK(c, lane) * PU + OFF_G; pgi = g[(2 * dir) * MH + head]; pgf = g[(2 * dir + 1) * MH + head]; \
            if ((c) >= 1) { const bf16* g2 = U + ML_TOK((c) - 1, lane) * PU + OFF_G; sgi = g2[(2 * dir) * MH + head]; sgf = g2[(2 * dir + 1) * MH + head]; } } } while (0)
#define ML_TOUCH() asm volatile("" :: "v"(pqk[0]), "v"(pqk[1]), "v"(pqk[2]), "v"(pqk[3]), "v"(pv[0]), "v"(pv[1]), "v"((unsigned)pgi), "v"((unsigned)pgf), "v"((unsigned)sgi), "v"((unsigned)sgf) : "memory")
#define ML_SCAN(gi_, gf_) \
            const float gi = bf2f(gi_) + bi, gf = bf2f(gf_) + bfg; \
            const float lf = fminf(gf, 0.f) - log1pf(__expf(-fabsf(gf))); \
            float b = lf; \
            _Pragma("unroll") for (int o = 1; o < 64; o <<= 1) { const float t = __shfl_up(b, o); if (lane >= o) b += t; } \
            const float a = gi - b; float pm = a; \
            _Pragma("unroll") for (int o = 1; o < 64; o <<= 1) { const float t = __shfl_up(pm, o); if (lane >= o) pm = fmaxf(pm, t); } \
            pm = fmaxf(pm, m_prev); \
            const float pm63 = __shfl(pm, 63), b63 = __shfl(b, 63);
    ML_PREFETCH(pp);
    ML_TOUCH();
    unsigned acked = 0u;
    for (int c = pp; c < nchunk; c += MLPROD) {
        if (w == 0 && c >= 1) { ML_SCAN(sgi, sgf) m_prev = b63 + pm63; }
#pragma unroll
        for (int i = 0; i < 4; ++i) { const int id = tid + 512 * i, j = id >> 5, pc = id & 31;
            *(LAS u32x4*)(lds + (pc < 16 ? P_QS : P_KS) + j * PQ + (pc & 15) * 16) = pqk[i]; }
#pragma unroll
        for (int i = 0; i < 2; ++i) { const int id = tid + 512 * i, j = id >> 4, pc = id & 15; const unsigned wv[4] = {pv[i].x, pv[i].y, pv[i].z, pv[i].w};
#pragma unroll
            for (int e = 0; e < 8; ++e) *(LAS bf16*)(lds + P_VT + (8 * pc + e) * PT + j * 2) = (bf16)((wv[e >> 1] >> ((e & 1) * 16)) & 0xffffu); }
        if (w == 0) {
            ML_SCAN(pgi, pgf)
            SC[ml::SC_A + lane] = a; SC[ml::SC_PM + lane] = pm; SC[ml::SC_WI + lane] = __expf(m_prev - pm); SC[ml::SC_EMT + lane] = __expf(-(b + pm)); SC[ml::SC_WE + lane] = __expf(a - pm63);
            if (lane == 0) { SC[ml::SC_MISC] = __expf(m_prev - pm63); SC[ml::SC_MISC + 1] = b63 + pm63; }
            m_prev = b63 + pm63;
        }
        LDS_BARRIER();
        if (c + MLPROD < nchunk) ML_PREFETCH(c + MLPROD);
#pragma unroll
        for (int i = 0; i < 2; ++i) { const int id = tid + 512 * i, j = id & 63, pc = id >> 6; const float we = SC[ml::SC_WE + j];
            const u32x4 kv = *(const LAS u32x4*)(lds + P_KS + j * PQ + pc * 16); const unsigned wv[4] = {kv.x, kv.y, kv.z, kv.w};
#pragma unroll
            for (int e = 0; e < 8; ++e) { const float kf = __builtin_bit_cast(float, (e & 1) ? (wv[e >> 1] & 0xffff0000u) : (wv[e >> 1] << 16));
                *(LAS bf16*)(lds + P_KT + (8 * pc + e) * PT + j * 2) = f2bf(kf * we); } }
#pragma unroll
        for (int cc = 0; cc < 2; ++cc) { const int ct = 2 * half + cc;
            f32x4 acc = (f32x4){0.f, 0.f, 0.f, 0.f};
            if (ct <= rt) {
#pragma unroll
                for (int k = 0; k < 4; ++k) acc = mma(frag(lds, P_QS, PQ, 16 * rt, 32 * k, lane), frag(lds, P_KS, PQ, 16 * ct, 32 * k, lane), acc);
            }
            const int sp = 16 * ct + fr; const float as = SC[ml::SC_A + sp];
#pragma unroll
            for (int r = 0; r < 4; ++r) { const int t = 16 * rt + 4 * fq + r; const float v = (sp <= t) ? acc[r] * __expf(as - SC[ml::SC_PM + t]) : 0.f;
                *(LAS bf16*)(lds + P_SB + t * PT + sp * 2) = f2bf(v); } }
        asm volatile("s_waitcnt vmcnt(0)" ::: "memory");
        if (tid == 0 && c >= ML_RING && acked < (unsigned)(c - ML_RING + 1)) acked = wy::fl_wait_ge(f_ack, (unsigned)(c - ML_RING + 1), tmo);
        LDS_BARRIER();
        if (tid == 0 && c > pp) __hip_atomic_store(f_ready, (unsigned)((c - pp) / MLPROD), __ATOMIC_RELAXED, __HIP_MEMORY_SCOPE_AGENT);
        ML_TOUCH();
        { unsigned char* slot = ring + (size_t)(c % ML_RING) * ML_PACK;
#pragma unroll
          for (int k = 0; k < 9; ++k) { const int u = tid + 512 * k;
              if (u < ML_PACK_U) { const u32x4 v = *(const LAS u32x4*)(lds + 16 * u); const u32x4* gp = (const u32x4*)(slot + (size_t)16 * u);
                  asm volatile("global_store_dwordx4 %0, %1, off sc1" :: "v"(gp), "v"(v) : "memory"); } } }
        LDS_BARRIER();
    }
    asm volatile("s_waitcnt vmcnt(0)" ::: "memory");
    __syncthreads();
    if (tid == 0) __hip_atomic_store(f_ready, (unsigned)((nchunk - pp + MLPROD - 1) / MLPROD), __ATOMIC_RELAXED, __HIP_MEMORY_SCOPE_AGENT);
    LDS_BARRIER();
#undef ML_TOK
#undef ML_PREFETCH
#undef ML_TOUCH
#undef ML_SCAN
}
__device__ __forceinline__ void ml_cons(LAS unsigned char* lds, CParams& P, int l, int s, int head, int dir, int chain, unsigned* ctl) {
    const int tid = wy::tid_opaque(), w = __builtin_amdgcn_readfirstlane(tid >> 6), lane = tid & 63, fr = lane & 15, fq = lane >> 4;
    const SeqInfo q = seqinfo(s); const int nchunk = q.T / 64;
    bf16* U = WSP(bf16, WS_U1);
    const unsigned char* ring = P.ws + WS_END + (size_t)chain * ML_RING * ML_PACK;
    unsigned* f_base = ctl + CW_MF + (size_t)((l * N_MLAT + chain) * 4) * wy::FL_STRIDE; unsigned* f_ack = f_base + MLPROD * wy::FL_STRIDE; unsigned* tmo = ctl + 4096 + 128;
    f32x4 cst[8][3];
#pragma unroll
    for (int kt = 0; kt < 8; ++kt)
#pragma unroll
        for (int j = 0; j < 3; ++j) cst[kt][j] = (f32x4){0.f, 0.f, 0.f, 0.f};
    if (w < 4 && q.grid) { const size_t sb = (((size_t)q.b * DEPTH + l) * 2 + dir) * MH + head;
#pragma unroll
        for (int kt = 0; kt < 8; ++kt)
#pragma unroll
            for (int r = 0; r < 4; ++r) { const int d = 16 * kt + 4 * fq + r;
                cst[kt][0][r] = P.in[ST_C][(sb * 128 + d) * 128 + 32 * w + fr]; cst[kt][1][r] = P.in[ST_C][(sb * 128 + d) * 128 + 32 * w + 16 + fr];
                cst[kt][2][r] = (fr == 0) ? P.in[ST_N][sb * 128 + d] : 0.f; } }
#define ML_TOK(c, j) ((size_t)(q.base + (dir ? q.T - 1 - ((c) * 64 + (j)) : ((c) * 64 + (j)))))
    unsigned seen0 = 0u, seen1 = 0u;
#define MLC_FETCH(c, boff) do { const int p_ = (c) % MLPROD; const unsigned need_ = (unsigned)((c) / MLPROD + 1); \
        if ((p_ ? seen1 : seen0) < need_) { unsigned v_ = 0u; if (lane == 0) v_ = wy::fl_wait_ge(f_base + p_ * wy::FL_STRIDE, need_, tmo); v_ = __builtin_amdgcn_readfirstlane(v_); \
            if (p_) seen1 = v_; else seen0 = v_; __builtin_amdgcn_fence(__ATOMIC_ACQUIRE, "agent"); } \
        const unsigned char* slot = ring + (size_t)((c) % ML_RING) * ML_PACK; \
        for (int k = w - 4; k < ML_PACK / 1024; k += 4) \
            __builtin_amdgcn_global_load_lds((const unsigned*)(slot + (size_t)k * 1024 + lane * 16), (LAS unsigned*)(lds + (boff) + k * 1024), 16, 0, 0); \
        asm volatile("s_waitcnt vmcnt(0)" ::: "memory"); } while (0)
    if (w >= 4) MLC_FETCH(0, 0);
    LDS_BARRIER();
    if (tid == 256) __hip_atomic_store(f_ack, 1u, __ATOMIC_RELAXED, __HIP_MEMORY_SCOPE_AGENT);
    for (int c = 0; c < nchunk; ++c) {
        const int boff = (c & 1) * ML_PACK;
        if (w >= 4) { if (c + 1 < nchunk) MLC_FETCH(c + 1, ML_PACK - boff); }
        else {
            LAS unsigned char* pb = lds + boff; const LAS float* SC = (const LAS float*)(pb + P_SC);
            const float wie = SC[ml::SC_MISC];
            bf16x8 vf[3][2];
#pragma unroll
            for (int j = 0; j < 3; ++j)
#pragma unroll
                for (int k = 0; k < 2; ++k) vf[j][k] = frag(pb, P_VT, PT, j < 2 ? 32 * w + 16 * j : 128, 32 * k, lane);
            asm volatile("s_waitcnt lgkmcnt(0)" ::: "memory");
            LAS unsigned char* hp = pb + P_VT + 32 * w * PT;
#pragma unroll
            for (int rt = 0; rt < 4; ++rt) {
                f32x4 num[3];
#pragma unroll
                for (int j = 0; j < 3; ++j) { f32x4 a1 = (f32x4){0.f, 0.f, 0.f, 0.f}, a2 = (f32x4){0.f, 0.f, 0.f, 0.f};
#pragma unroll
                    for (int k = 0; k < 2; ++k) a1 = mma(frag(pb, P_SB, PT, 16 * rt, 32 * k, lane), vf[j][k], a1);
#pragma unroll
                    for (int kb = 0; kb < 4; ++kb) a2 = mma(wy::ld_k32(pb, P_QS, PQ, 16 * rt, 32 * kb, lane), wy::pack_k32(cst[2 * kb][j], cst[2 * kb + 1][j]), a2);
#pragma unroll
                    for (int r = 0; r < 4; ++r) a1[r] += SC[ml::SC_WI + 16 * rt + 4 * fq + r] * a2[r];
                    num[j] = a1; }
#pragma unroll
                for (int r = 0; r < 4; ++r) { const int t = 16 * rt + 4 * fq + r; const float dn = __shfl(num[2][r], lane & 48);
                    const float rden = __builtin_amdgcn_rcpf(fmaxf(fabsf(dn), SC[ml::SC_EMT + t]));
                    *(LAS bf16*)(hp + t * 64 + fr * 2) = f2bf(num[0][r] * rden); *(LAS bf16*)(hp + t * 64 + (16 + fr) * 2) = f2bf(num[1][r] * rden); }
            }
#pragma unroll
            for (int kt = 0; kt < 8; ++kt) { const bf16x8 k0 = frag(pb, P_KT, PT, 16 * kt, 0, lane), k1 = frag(pb, P_KT, PT, 16 * kt, 32, lane);
#pragma unroll
                for (int j = 0; j < 3; ++j) { cst[kt][j] = cst[kt][j] * wie; cst[kt][j] = mma(k0, vf[j][0], cst[kt][j]); cst[kt][j] = mma(k1, vf[j][1], cst[kt][j]); } }
            { const LAS unsigned char* yp = hp + lane * 64; bf16* up = U + ML_TOK(c, lane) * PU + dir * MW + head * 128 + 32 * w;
#pragma unroll
              for (int i = 0; i < 4; ++i) *(u32x4*)(up + 8 * i) = *(const LAS u32x4*)(yp + 16 * i); }
        }
        LDS_BARRIER();
        if (tid == 256 && c + 1 < nchunk) __hip_atomic_store(f_ack, (unsigned)(c + 2), __ATOMIC_RELAXED, __HIP_MEMORY_SCOPE_AGENT);
    }
    LDS_BARRIER();
#undef ML_TOK
#undef MLC_FETCH
}
}

namespace el {
typedef float f32x4 __attribute__((ext_vector_type(4)));
typedef unsigned u32x4 __attribute__((ext_vector_type(4)));
typedef unsigned u32x2 __attribute__((ext_vector_type(2)));
typedef short bf16x8 __attribute__((ext_vector_type(8)));
__device__ __forceinline__ float wave_sum(float v) {
#pragma unroll
    for (int o = 1; o < 64; o <<= 1) v += __shfl_xor(v, o);
    return v;
}
__device__ __forceinline__ void unpack8(const u32x4 p, float (&f)[8]) {
    f[0] = pg8::bflo(p.x); f[1] = pg8::bfhi(p.x); f[2] = pg8::bflo(p.y); f[3] = pg8::bfhi(p.y); f[4] = pg8::bflo(p.z); f[5] = pg8::bfhi(p.z); f[6] = pg8::bflo(p.w); f[7] = pg8::bfhi(p.w);
}
__device__ __forceinline__ u32x4 pack8(const float (&f)[8]) {
    u32x4 o; o.x = pg8::cvt_pk_bf16(f[0], f[1]); o.y = pg8::cvt_pk_bf16(f[2], f[3]); o.z = pg8::cvt_pk_bf16(f[4], f[5]); o.w = pg8::cvt_pk_bf16(f[6], f[7]); return o;
}
__device__ __forceinline__ void init_phase(LAS unsigned char* lds, CParams& P, int vb, int G) {
    const int tid = threadIdx.x, w = tid >> 6, lane = tid & 63;
    LAS float* red = (LAS float*)lds;
    constexpr int KW = D / 8;
    for (int it = vb; it < DEPTH * (6 * D / 64); it += G) {
        const int l = it / (6 * D / 64), j = (it % (6 * D / 64)) * 64 + lane;
        const float* wp = P.in[ADA_W] + ((size_t)l * D + w * KW) * 6 * D + j;
        float acc[NCOND];
#pragma unroll
        for (int ci = 0; ci < NCOND; ++ci) acc[ci] = 0.f;
        for (int k = 0; k < KW; ++k) { const float wv = wp[(size_t)k * 6 * D];
#pragma unroll
            for (int ci = 0; ci < NCOND; ++ci) { const float cv = ci == 0 ? P.in[C_CTX][w * KW + k] : P.in[C_LAT][(size_t)(ci - 1) * D + w * KW + k]; acc[ci] += cv * pg8::fsigmoid(cv) * wv; } }
#pragma unroll
        for (int ci = 0; ci < NCOND; ++ci) red[(w * NCOND + ci) * 64 + lane] = acc[ci];
        __syncthreads();
        if (w < NCOND) { float sum = P.in[ADA_B][(size_t)l * 6 * D + j];
#pragma unroll
            for (int ww = 0; ww < 8; ++ww) sum += red[(ww * NCOND + w) * 64 + lane];
            WSP(float, WS_MOD)[((size_t)l * NCOND + w) * 6 * D + j] = sum; }
        __syncthreads();
    }
}
__device__ __forceinline__ int perm5(int n) { return (((n >> 2) & 1) << 4) | (((n >> 3) & 3) << 2) | (n & 3); }
__device__ __forceinline__ void transpose_item(const float* W, int ldw, int nvalid, bf16* dst, int K, int k0, int drow0, bool perm, LAS float* scr, int lane) {
    f32x4 tv[8];
#pragma unroll
    for (int i = 0; i < 8; ++i) { const int kk = 8 * i + (lane >> 3), n4 = (lane & 7) * 4; tv[i] = n4 < nvalid ? *(const f32x4*)(W + (size_t)kk * ldw + n4) : (f32x4){0.f, 0.f, 0.f, 0.f}; }
#pragma unroll
    for (int i = 0; i < 8; ++i) { const int kk = 8 * i + (lane >> 3), n4 = (lane & 7) * 4;
#pragma unroll
        for (int e = 0; e < 4; ++e) scr[kk * 33 + n4 + e] = tv[i][e]; }
    asm volatile("s_waitcnt lgkmcnt(0)" ::: "memory");
    const int c = lane & 7;
#pragma unroll
    for (int j = 0; j < 4; ++j) { const int n = (lane >> 3) + 8 * j; const LAS float* sp = scr + (8 * c) * 33 + n;
        u32x4 o; o.x = pg8::cvt_pk_bf16(sp[0 * 33], sp[1 * 33]); o.y = pg8::cvt_pk_bf16(sp[2 * 33], sp[3 * 33]); o.z = pg8::cvt_pk_bf16(sp[4 * 33], sp[5 * 33]); o.w = pg8::cvt_pk_bf16(sp[6 * 33], sp[7 * 33]);
        *(u32x4*)(dst + (size_t)(drow0 + (perm ? perm5(n) : n)) * K + k0 + 8 * c) = o; }
    asm volatile("s_waitcnt lgkmcnt(0)" ::: "memory");
}
constexpr int WI_0 = (N1P / 32) * (D / 64), WI_1 = WI_0 + (2 * D / 32) * (D / 64), WI_2 = WI_1 + (D / 32) * (MW / 64), WI_3 = WI_2 + (D / 32) * (RW / 64),
              WI_4 = WI_3 + (D / 32) * (D / 64), WI_5 = WI_4 + 2 * (FF / 32) * (D / 64), WI_6 = WI_5 + (D / 32) * (FF / 64), WI_7 = WI_6 + (RW / 32) * (128 / 64), WI_8 = WI_7 + 4 * (RW / 32);
__device__ __forceinline__ void wconv_phase(LAS unsigned char* lds, CParams& P, int l, int vb, int G) {
    const int tid = threadIdx.x, w = tid >> 6, lane = tid & 63;
    LAS float* scr = (LAS float*)(lds + w * 8704);
    for (int it = vb * 8 + w; it < WI_8; it += G * 8) {
        if (it < WI_0) { const int nb = it / (D / 64), kb = it % (D / 64); const int n0 = nb * 32; const int nv = n0 >= N1 ? 0 : (N1 - n0 < 32 ? N1 - n0 : 32);
            transpose_item(P.in[W_IN] + ((size_t)l * D + kb * 64) * PIN + n0, PIN, nv, WSP(bf16, O_WIN1), D, kb * 64, n0, true, scr, lane); }
        else if (it < WI_1) { const int r = it - WI_0, nb = r / (D / 64), kb = r % (D / 64);
            transpose_item(P.in[W_IN] + ((size_t)l * D + kb * 64) * PIN + N1 + nb * 32, PIN, 32, WSP(bf16, O_WIN2), D, kb * 64, nb * 32, true, scr, lane); }
        else if (it < WI_2) { const int r = it - WI_1, nb = r / (MW / 64), kb = r % (MW / 64);
            transpose_item(P.in[PROJ_M] + ((size_t)l * MW + kb * 64) * D + nb * 32, D, 32, WSP(bf16, O_PM), MW, kb * 64, nb * 32, true, scr, lane); }
        else if (it < WI_3) { const int r = it - WI_2, nb = r / (RW / 64), kb = r % (RW / 64);
            transpose_item(P.in[PROJ_R] + ((size_t)l * RW + kb * 64) * D + nb * 32, D, 32, WSP(bf16, O_PR), RW, kb * 64, nb * 32, true, scr, lane); }
        else if (it < WI_4) { const int r = it - WI_3, nb = r / (D / 64), kb = r % (D / 64);
            transpose_item(P.in[W_OUT] + ((size_t)l * D + kb * 64) * D + nb * 32, D, 32, WSP(bf16, O_WO), D, kb * 64, nb * 32, false, scr, lane); }
        else if (it < WI_5) { const int r = it - WI_4, which = r / ((FF / 32) * (D / 64)), r2 = r % ((FF / 32) * (D / 64)), nb = r2 / (D / 64), kb = r2 % (D / 64);
            const int j0 = nb * 32, pn = j0 >> 7, drow0 = pn * 256 + which * 128 + (j0 & 127);
            transpose_item((which ? P.in[FFN_W3] : P.in[FFN_W1]) + ((size_t)l * D + kb * 64) * FF + j0, FF, 32, WSP(bf16, O_W13), D, kb * 64, drow0, true, scr, lane); }
        else if (it < WI_6) { const int r = it - WI_5, nb = r / (FF / 64), kb = r % (FF / 64);
            transpose_item(P.in[FFN_W2] + ((size_t)l * FF + kb * 64) * D + nb * 32, D, 32, WSP(bf16, O_W2), FF, kb * 64, nb * 32, false, scr, lane); }
        else if (it < WI_7) { const int r = it - WI_6, nb = r / 2, kb = r % 2;
            transpose_item(P.in[R_G2] + ((size_t)l * 128 + kb * 64) * RW + nb * 32, RW, 32, WSP(bf16, O_G2T), 128, kb * 64, nb * 32, false, scr, lane); }
        else { const int r = it - WI_7, which = r / (2 * (RW / 32)), d = (r / (RW / 32)) & 1, nb = r % (RW / 32);
            transpose_item((which ? P.in[R_A2] : P.in[R_W2]) + ((size_t)l * 2 + d) * 64 * RW + nb * 32, RW, 32, WSP(bf16, which ? O_A2T : O_W2T) + (size_t)d * RW * 64, 64, 0, nb * 32, false, scr, lane); }
    }
}
__device__ __forceinline__ void norm_phase(CParams& P, int l, int mode, int vb, int G) {
    const int tid = threadIdx.x, w = tid >> 6, lane = tid & 63;
#define NORM_SRC(m_) ((l == 0 && mode < 2) ? ((m_) < NC ? P.in[X_PROMPT] + (size_t)(m_) * D : P.in[X_SAMPLE] + (size_t)((m_) - NC) * D) : P.out + (size_t)(m_) * D)
    f32x4 vn[D / 256];
    { const int m0 = vb * 8 + w; if (m0 < NT) { const float* xs = NORM_SRC(m0);
#pragma unroll
        for (int j = 0; j < D / 256; ++j) vn[j] = *(const f32x4*)(xs + 256 * j + 4 * lane); } }
    for (int m = vb * 8 + w; m < NT; m += G * 8) {
        float* xr = P.out + (size_t)m * D;
        f32x4 v[D / 256]; float ss = 0.f;
#pragma unroll
        for (int j = 0; j < D / 256; ++j) v[j] = vn[j];
        if (m + G * 8 < NT) { const float* xs = NORM_SRC(m + G * 8);
#pragma unroll
            for (int j = 0; j < D / 256; ++j) vn[j] = *(const f32x4*)(xs + 256 * j + 4 * lane); }
#pragma unroll
        for (int j = 0; j < D / 256; ++j) ss += (v[j][0] * v[j][0] + v[j][1] * v[j][1]) + (v[j][2] * v[j][2] + v[j][3] * v[j][3]);
        const float rs = 1.0f / sqrtf(wave_sum(ss) * (1.0f / D) + RMS_EPS);
        if (mode == 3) {
#pragma unroll
            for (int j = 0; j < D / 256; ++j) { const f32x4 g = *(const f32x4*)(P.in[FINAL_G] + 256 * j + 4 * lane); *(f32x4*)(xr + 256 * j + 4 * lane) = v[j] * rs * g; }
        } else {
            const int second = (mode == 2); const int cond = seqinfo(seq_of_token(m)).cond;
            const float* gp = P.in[second ? NORM2 : NORM1] + (size_t)l * D; const float* mod = WSP(float, WS_MOD) + ((size_t)l * NCOND + cond) * 6 * D + (second ? 3 * D : 0);
            bf16* o = WSP(bf16, mode == 1 ? WS_RXC : WS_QKC) + (size_t)m * D;
#pragma unroll
            for (int j = 0; j < D / 256; ++j) { const int c = 256 * j + 4 * lane; const f32x4 g = *(const f32x4*)(gp + c), sh = *(const f32x4*)(mod + c), sc = *(const f32x4*)(mod + D + c);
                const f32x4 y = v[j] * rs * g * (sc + 1.0f) + sh; u32x2 pk; pk.x = pg8::cvt_pk_bf16(y[0], y[1]); pk.y = pg8::cvt_pk_bf16(y[2], y[3]); *(u32x2*)(o + c) = pk; }
        }
    }
#undef NORM_SRC
}
constexpr int CV_NCH = 2 * MW + RIN, CV_NG = CV_NCH / 4, CV_NCHUNK = (CV_NG + 63) / 64, CV_SEG = 16, CV_PAIRS = NC / (2 * CV_SEG);
static_assert(CV_NCHUNK == 12 && NC == NT - NC && GW % CV_SEG == 0 && CT % CV_SEG == 0 && 2 * MW == 1024 && RX_WL == 1536, "conv item layout");
typedef float f32x2 __attribute__((ext_vector_type(2)));
struct CvAct { float alpha, cA, cB, cC, cD; bool any; };
template <int NR> struct CvState { f32x2 wt[NR * 3][2]; f32x2 fw[NR][3][2]; u32x2 p[3][NR]; };
__device__ __forceinline__ void cv_unpk(const u32x2 p, f32x2 (&f)[2]) { f[0].x = pg8::bflo(p.x); f[0].y = pg8::bfhi(p.x); f[1].x = pg8::bflo(p.y); f[1].y = pg8::bfhi(p.y); }
template <int NR> __device__ __forceinline__ u32x2 cv_ld(const bf16* const (&rowp)[NR], const bool (&rok)[NR], int a, int col, int W) {
    const u32x2 zero2 = {0u, 0u};
    return (rok[a] && col >= 0 && col < W) ? *(const u32x2*)(rowp[a] + (size_t)col * PU) : zero2;
}
template <int NR, int S> __device__ __forceinline__ void cv_col(CvState<NR>& st, const bf16* const (&rowp)[NR], const bool (&rok)[NR], int cs, int W, int o, const CvAct& act, bf16* dst) {
#pragma unroll
    for (int a = 0; a < NR; ++a) { cv_unpk(st.p[S][a], st.fw[a][(S + 2) % 3]); const u32x2 zero2 = {0u, 0u}; st.p[S][a] = (o + 4 <= CV_SEG) ? cv_ld<NR>(rowp, rok, a, cs + o + 4, W) : zero2; }
    f32x2 acc[2];
#pragma unroll
    for (int e = 0; e < 2; ++e) acc[e] = st.wt[0][e] * st.fw[0][S][e];
#pragma unroll
    for (int a = 0; a < NR; ++a)
#pragma unroll
        for (int b = 0; b < 3; ++b) if (a + b > 0) {
#pragma unroll
            for (int e = 0; e < 2; ++e) acc[e] = __builtin_elementwise_fma(st.wt[a * 3 + b][e], st.fw[a][(S + b) % 3][e], acc[e]); }
    float v[4] = {acc[0].x, acc[0].y, acc[1].x, acc[1].y};
    if (act.any) {
#pragma unroll
        for (int e = 0; e < 4; ++e) { const float t = __builtin_amdgcn_rcpf(__builtin_amdgcn_exp2f(act.alpha * v[e]) + 1.0f); v[e] = (act.cA * v[e] + act.cB) * t + (act.cC * v[e] + act.cD); }
    }
    u32x2 pk; pk.x = pg8::cvt_pk_bf16(v[0], v[1]); pk.y = pg8::cvt_pk_bf16(v[2], v[3]);
    *(u32x2*)dst = pk;
}
template <int NR> __device__ __forceinline__ void conv_item(const bf16* const (&rowp)[NR], const bool (&rok)[NR], int cs, int W, const float* wsrc, int CH, const CvAct& act, bf16* dst, int dpitch) {
    CvState<NR> st;
#pragma unroll
    for (int a = 0; a < NR * 3; ++a) { const int tap = NR == 3 ? a : 3 + a; const f32x4 w0 = *(const f32x4*)(wsrc + (size_t)tap * CH);
        st.wt[a][0].x = w0[0]; st.wt[a][0].y = w0[1]; st.wt[a][1].x = w0[2]; st.wt[a][1].y = w0[3]; }
#pragma unroll
    for (int a = 0; a < NR; ++a) { cv_unpk(cv_ld<NR>(rowp, rok, a, cs - 1, W), st.fw[a][0]); cv_unpk(cv_ld<NR>(rowp, rok, a, cs, W), st.fw[a][1]); }
#pragma unroll
    for (int s3 = 0; s3 < 3; ++s3)
#pragma unroll
        for (int a = 0; a < NR; ++a) st.p[s3][a] = cv_ld<NR>(rowp, rok, a, cs + 1 + s3, W);
#pragma unroll 1
    for (int o = 0; o < CV_SEG - 1; o += 3) {
        cv_col<NR, 0>(st, rowp, rok, cs, W, o, act, dst + (size_t)o * dpitch);
        cv_col<NR, 1>(st, rowp, rok, cs, W, o + 1, act, dst + (size_t)(o + 1) * dpitch);
        cv_col<NR, 2>(st, rowp, rok, cs, W, o + 2, act, dst + (size_t)(o + 2) * dpitch);
    }
    cv_col<NR, 0>(st, rowp, rok, cs, W, CV_SEG - 1, act, dst + (size_t)(CV_SEG - 1) * dpitch);
}
__device__ __forceinline__ void conv_phase(LAS unsigned char* lds, CParams& P, int l, int vb, int G) {
    const int tid = threadIdx.x, lane = tid & 63;
    const bf16* U = WSP(bf16, WS_U1);
    LAS unsigned* cnt = (LAS unsigned*)lds;
    for (int sp = vb; sp < CV_PAIRS; sp += G) {
        __syncthreads();
        if (tid == 0) *cnt = 0u;
        __syncthreads();
        for (;;) {
            unsigned j = 0; if (lane == 0) j = __hip_atomic_fetch_add(cnt, 1u, __ATOMIC_RELAXED, __HIP_MEMORY_SCOPE_WORKGROUP);
            j = __builtin_amdgcn_readfirstlane(j);
            if (j >= 48u) break;
            const int cls = j / 12, jj = j % 12, lat = (cls & 1) == 0, heavy = cls < 2, ci = jj >> 1, chunk = heavy ? (ci >= 4 ? 6 + ci : ci) : 4 + ci;
            const int seg = (lat ? NC / CV_SEG : 0) + 2 * sp + (jj & 1), g = chunk * 64 + lane;
            if (g >= CV_NG) continue;
            const int ch = 4 * g; const bool isqk = ch < 2 * MW; const int c = isqk ? ch : ch - 2 * MW;
            const int ucol = isqk ? OFF_QK + c : OFF_R + c, CH = isqk ? 2 * MW : RIN;
            const float* wsrc = (isqk ? P.in[M_CONV] : P.in[R_CONV]) + (size_t)l * 9 * CH + c;
            const int kind = isqk ? (c < MW ? 0 : 1) : (c >= RX_GL ? 4 : (c >= RX_AL ? 2 : (c >= RX_WL ? 3 : 2)));
            CvAct act; act.alpha = kind == 3 ? 2.8853900817779268f : -1.4426950408889634f;
            act.cA = kind == 0 ? 0.08838834764831845f : (kind == 1 ? 1.0f : 0.0f); act.cB = kind == 3 ? -2.0f : (kind == 4 ? 1.0f : 0.0f); act.cC = kind == 2 ? 1.0f : 0.0f; act.cD = kind == 3 ? 1.0f : 0.0f;
            act.any = heavy;
            const int m0 = seg * CV_SEG; const SeqInfo q = seqinfo(seq_of_token(m0)); const int t0 = m0 - q.base;
            bf16* dst = isqk ? WSP(bf16, WS_QKC) + (size_t)m0 * (2 * MW) + c : WSP(bf16, WS_RXC) + (size_t)m0 * RIN + c; const int dpitch = isqk ? 2 * MW : RIN;
            if (q.grid) {
                const int r = t0 / GW, cs = t0 % GW, rows = q.T / GW;
                const bf16* rowp[3]; bool rok[3];
#pragma unroll
                for (int a = 0; a < 3; ++a) { const int rr = r + a - 1; rok[a] = rr >= 0 && rr < rows; rowp[a] = U + (size_t)(q.base + (rok[a] ? rr : r) * GW) * PU + ucol; }
                conv_item<3>(rowp, rok, cs, GW, wsrc, CH, act, dst, dpitch);
            } else {
                const bf16* rowp[1] = {U + (size_t)q.base * PU + ucol}; const bool rok[1] = {true};
                conv_item<1>(rowp, rok, t0, q.T, wsrc, CH, act, dst, dpitch);
            }
        }
    }
}
constexpr int PO_ITEMS = (NT / 16) * 2, PO_HC = RW / 2;
__device__ __forceinline__ void post_phase(LAS unsigned char* lds, CParams& P, int l, int vb, int G) {
    const int tid = threadIdx.x, w = tid >> 6, lane = tid & 63, fr = lane & 15, fq = lane >> 4, l32 = lane & 31, th = lane >> 5;
    constexpr int GP = PO_HC * 2 + 16;
    LAS unsigned char* gt = lds + w * (16 * GP);
    const bf16* U = WSP(bf16, WS_U1); const bf16* RX = WSP(bf16, WS_RXC); const bf16* G2T = WSP(bf16, O_G2T); bf16* O = WSP(bf16, WS_QKC);
    for (int it = vb * 8 + w; it < PO_ITEMS; it += G * 8) {
        const int tile = it >> 1, h = it & 1; const size_t tok0 = (size_t)tile * 16;
        bf16x8 af[4];
#pragma unroll
        for (int ks = 0; ks < 4; ++ks) af[ks] = *(const bf16x8*)(RX + (tok0 + fr) * RIN + RX_GL + 32 * ks + 8 * fq);
        for (int ct = 0; ct < PO_HC / 16; ++ct) { f32x4 acc = (f32x4){0.f, 0.f, 0.f, 0.f};
#pragma unroll
            for (int ks = 0; ks < 4; ++ks) acc = ml::mma(af[ks], *(const bf16x8*)(G2T + (size_t)(h * PO_HC + 16 * ct + fr) * 128 + 32 * ks + 8 * fq), acc);
#pragma unroll
            for (int r = 0; r < 4; ++r) *(LAS bf16*)(gt + (4 * fq + r) * GP + (16 * ct + fr) * 2) = f2bf(acc[r]); }
        asm volatile("s_waitcnt lgkmcnt(0)" ::: "memory");
        const int cb = h * PO_HC + 8 * l32;
        float gn[8], gw[8], gb[8], rk[8];
        { const f32x4 a0 = *(const f32x4*)(P.in[M_NORM_G] + (size_t)l * MW + cb), a1 = *(const f32x4*)(P.in[M_NORM_G] + (size_t)l * MW + cb + 4);
          const f32x4 b0 = *(const f32x4*)(P.in[R_GN_W] + (size_t)l * RW + cb), b1 = *(const f32x4*)(P.in[R_GN_W] + (size_t)l * RW + cb + 4);
          const f32x4 c0 = *(const f32x4*)(P.in[R_GN_B] + (size_t)l * RW + cb), c1 = *(const f32x4*)(P.in[R_GN_B] + (size_t)l * RW + cb + 4);
          const f32x4 d0 = *(const f32x4*)(P.in[R_RK] + (size_t)l * RW + cb), d1 = *(const f32x4*)(P.in[R_RK] + (size_t)l * RW + cb + 4);
#pragma unroll
          for (int e = 0; e < 4; ++e) { gn[e] = a0[e]; gn[4 + e] = a1[e]; gw[e] = b0[e]; gw[4 + e] = b1[e]; gb[e] = c0[e]; gb[4 + e] = c1[e]; rk[e] = d0[e]; rk[4 + e] = d1[e]; } }
        for (int tp = 0; tp < 8; ++tp) { const int tl = 2 * tp + th; const size_t m = tok0 + tl; const bf16* u = U + m * PU; const bf16* rx = RX + m * RIN;
            float hf[8], hb[8], ov[8], x[8]; unpack8(*(const u32x4*)(u + cb), hf); unpack8(*(const u32x4*)(u + MW + cb), hb); unpack8(*(const u32x4*)(u + OFF_O + cb), ov);
            float ss = 0.f;
#pragma unroll
            for (int e = 0; e < 8; ++e) { x[e] = hf[e] + hb[e]; ss += x[e] * x[e]; }
            ss = rw::allsum16(ss); const float rs = 1.0f / sqrtf(ss * (1.0f / 128.f) + RMS_EPS);
#pragma unroll
            for (int e = 0; e < 8; ++e) x[e] = x[e] * rs * gn[e] * pg8::fsigmoid(ov[e]);
            *(u32x4*)(O + m * D + cb) = pack8(x);
            float yf[8], yb[8], rr[8], kk[8], vv[8], gg[8], y[8]; unpack8(*(const u32x4*)(u + OFF_R + cb), yf); unpack8(*(const u32x4*)(u + OFF_R + RW + cb), yb);
            unpack8(*(const u32x4*)(rx + RX_R + cb), rr); unpack8(*(const u32x4*)(rx + RX_K + cb), kk); unpack8(*(const u32x4*)(rx + RX_V + cb), vv);
            unpack8(*(const LAS u32x4*)(gt + tl * GP + l32 * 16), gg);
            float mu = 0.f, bs = 0.f;
#pragma unroll
            for (int e = 0; e < 8; ++e) { y[e] = yf[e] + yb[e]; mu += y[e]; bs += rr[e] * kk[e] * rk[e]; }
            mu += rw::dpp_xor1(mu); mu += rw::dpp_xor2(mu); mu += __shfl_xor(mu, 4); mu *= (1.0f / 64.f);
            bs += rw::dpp_xor1(bs); bs += rw::dpp_xor2(bs); bs += __shfl_xor(bs, 4);
            float var = 0.f;
#pragma unroll
            for (int e = 0; e < 8; ++e) { y[e] -= mu; var += y[e] * y[e]; }
            var += rw::dpp_xor1(var); var += rw::dpp_xor2(var); var += __shfl_xor(var, 4); var *= (1.0f / 64.f);
            const float rsd = 1.0f / sqrtf(var + GN_EPS);
#pragma unroll
            for (int e = 0; e < 8; ++e) y[e] = (y[e] * rsd * gw[e] + gb[e] + bs * vv[e]) * gg[e];
            *(u32x4*)(O + m * D + MW + cb) = pack8(y);
        }
        asm volatile("s_waitcnt lgkmcnt(0)" ::: "memory");
    }
}
}

constexpr int LDS_BYTES = 147456;
constexpr int LDS_MISC = 147456 - 1024;
constexpr size_t CTL_ZERO_BYTES = 262144;
constexpr int CW_BAR = 4096, CW_Q = 8192;

#define XB_TMO      128
#define XB_XCNT(j)  (256  + 64 * (j))
#define XB_XSUB(j)  (1280 + 64 * (j))
#define XB_XGEN(j)  (2304 + 64 * (j))
#define XB_TOP      3328
#define XB_TOPGEN   3392
#define XCD_BAR_WORDS 3456
#define XB_SPIN_CAP (1u << 18)
__device__ __forceinline__ unsigned xb_ld(unsigned* p)              { return __hip_atomic_load(p, __ATOMIC_RELAXED, __HIP_MEMORY_SCOPE_AGENT); }
__device__ __forceinline__ unsigned xb_add(unsigned* p, unsigned v) { return __hip_atomic_fetch_add(p, v, __ATOMIC_RELAXED, __HIP_MEMORY_SCOPE_AGENT); }
__device__ __forceinline__ unsigned xb_xcc_id() { return (unsigned)__builtin_amdgcn_s_getreg((3 << 11) | 20) & 0xFu; }
#define XB_SPIN(cond, bar) do { unsigned _sp = 0; while (cond) { __builtin_amdgcn_s_sleep(1); \
    if ((++_sp & 255u) == 0u) { if (xb_ld(&(bar)[XB_TMO])) break; if (_sp > XB_SPIN_CAP) { atomicAdd(&(bar)[XB_TMO], 1u); break; } } } } while (0)
struct XcdBarrier { unsigned* bar; unsigned x; volatile LAS unsigned* st; };
__device__ __forceinline__ XcdBarrier xcd_barrier_post(unsigned* bar, volatile LAS unsigned* st) {
    XcdBarrier b; b.bar = bar; b.x = xb_xcc_id(); b.st = st;
    if (threadIdx.x == 0) (void)xb_add(&bar[XB_XCNT(b.x)], 1u);
    return b;
}
__device__ __forceinline__ void xcd_barrier_complete(unsigned* bar, unsigned x, unsigned& nloc, unsigned& nx) {
    const unsigned G = gridDim.x * gridDim.y * gridDim.z;
    unsigned sum, cnt, mine, sp = 0u;
    for (;;) {
        sum = 0u; cnt = 0u; mine = 0u;
#pragma unroll
        for (unsigned j = 0; j < 16; ++j) { const unsigned c = xb_ld(&bar[XB_XCNT(j)]); sum += c; cnt += (c > 0u) ? 1u : 0u; mine = (j == x) ? c : mine; }
        if (sum == G) break;
        __builtin_amdgcn_s_sleep(1);
        if ((++sp & 255u) == 0u) { if (xb_ld(&bar[XB_TMO])) break; if (sp > XB_SPIN_CAP) { atomicAdd(&bar[XB_TMO], 1u); break; } }
    }
    nloc = mine > 0u ? mine : 1u; nx = cnt > 0u ? cnt : 1u;
}
__device__ __forceinline__ void xcd_barrier(const XcdBarrier& b) {
    asm volatile("s_waitcnt vmcnt(0)" ::: "memory");
    __syncthreads();
    if (threadIdx.x == 0) {
        unsigned* bar = b.bar;
        __builtin_amdgcn_s_waitcnt(0);
        unsigned nloc = b.st[0], nx = b.st[1];
        if (nloc == 0u) { xcd_barrier_complete(bar, b.x, nloc, nx); b.st[0] = nloc; b.st[1] = nx; }
        const unsigned old = xb_add(&bar[XB_XSUB(b.x)], 1u);
        const unsigned gen = old / nloc;
        if (old + 1u == (gen + 1u) * nloc) {
            __builtin_amdgcn_fence(__ATOMIC_RELEASE, "agent");
            asm volatile("s_waitcnt vmcnt(0)" ::: "memory");
            const unsigned og = xb_add(&bar[XB_TOP], 1u);
            const unsigned tg = og / nx;
            if (og + 1u == (tg + 1u) * nx) xb_add(&bar[XB_TOPGEN], 1u);
            else XB_SPIN(xb_ld(&bar[XB_TOPGEN]) == tg, bar);
            __builtin_amdgcn_fence(__ATOMIC_ACQUIRE, "agent");
            xb_add(&bar[XB_XGEN(b.x)], 1u);
            asm volatile("s_waitcnt vmcnt(0)" ::: "memory");
        } else {
            XB_SPIN(xb_ld(&bar[XB_XGEN(b.x)]) == gen, bar);
            __builtin_amdgcn_fence(__ATOMIC_ACQUIRE, "agent");
            asm volatile("s_waitcnt vmcnt(0)" ::: "memory");
        }
    }
    __syncthreads();
}

constexpr int MX_RL = LB * RH * 2 * 4, MX_ML = LB * MH * 2 * ml::NVB, MX_RC = CB * RH * 2 * 4, MX_MC = CB * MH * 2 * ml::NVB;
constexpr int MX_ITEMS = MX_RL + MX_ML + MX_RC + MX_MC;

constexpr int ML_SPLIT = 0;
__device__ __forceinline__ void scan_phase(LAS unsigned char* lds, CParams& P, int l, unsigned* ctl) {
    unsigned* qhead = ctl + CW_Q + 64 * l;
    const bool split = gridDim.x >= 4 * wy::N_LAT * (1 + wy::NPROD) / 2;
    volatile LAS unsigned* bc = (volatile LAS unsigned*)(lds + LDS_MISC) + 16;
    for (;;) {
        if (threadIdx.x == 0) bc[0] = xb_add(qhead, 1u);
        __syncthreads();
        const int it = (int)bc[0];
        __syncthreads();
        if (!split || it >= wy::N_LAT) break;
        int s_, head, dir; wy::decode_item(it, s_, head, dir);
        wy::rwkv_cons(lds, P, l, s_, head, dir, it, ctl);
    }
    for (;;) {
        if (threadIdx.x == 0) bc[0] = xb_add(qhead + 8, 1u);
        __syncthreads();
        const int it = (int)bc[0];
        __syncthreads();
        if (it >= ML_SPLIT * ms::N_MLAT) break;
        int s_, head, dir, sub; ml::decode_item(it * ml::NVB, s_, head, dir, sub);
        ms::ml_cons(lds, P, l, s_, head, dir, it, ctl);
    }
    for (;;) {
        if (threadIdx.x == 0) bc[0] = xb_add(qhead + 48, 1u);
        __syncthreads();
        const int it = (int)bc[0];
        __syncthreads();
        if (!split || it >= wy::N_LAT * wy::NPROD) break;
        const int chain = it % wy::N_LAT;
        int s_, head, dir; wy::decode_item(chain, s_, head, dir);
        wy::rwkv_prod(lds, P, l, s_, head, dir, chain, it / wy::N_LAT, ctl);
    }
    for (;;) {
        if (threadIdx.x == 0) bc[0] = xb_add(qhead + 24, 1u);
        __syncthreads();
        const int it = (int)bc[0];
        __syncthreads();
        if (it >= ML_SPLIT * ms::N_MLAT * ms::MLPROD) break;
        const int chain = it % ms::N_MLAT;
        int s_, head, dir, sub; ml::decode_item(chain * ml::NVB, s_, head, dir, sub);
        ms::ml_prod(lds, P, l, s_, head, dir, chain, it / ms::N_MLAT, ctl);
    }
    for (;;) {
        if (threadIdx.x == 0) bc[0] = xb_add(qhead + 16, 1u);
        __syncthreads();
        const int it = (int)bc[0] + ML_SPLIT * ms::N_MLAT * ml::NVB;
        __syncthreads();
        if (it >= ml::N_ITEMS) break;
        int s_, head, dir, sub; ml::decode_item(it, s_, head, dir, sub);
        ml::mlstm_item2(lds, P, l, s_, head, dir, sub);
    }
    for (;;) {
        if (threadIdx.x == 0) bc[0] = xb_add(qhead + 32, 1u);
        __syncthreads();
        const int it = (int)bc[0] + (split ? LB * RH * 2 : 0);
        __syncthreads();
        if (it >= wy::N_ITEMS) break;
        int s_, head, dir; wy::decode_item(it, s_, head, dir);
        wy::rwkv_item(lds, P, l, s_, head, dir);
    }
}

enum { ST_N0 = 0, ST_A1, ST_CV, ST_MX, ST_PO, ST_N1, ST_A2, ST_PJ, ST_WO, ST_N2, ST_F1, ST_F2, ST_PER_LAYER };
constexpr int N_STEPS = 1 + DEPTH * ST_PER_LAYER + 1;
struct MkArgs { Params P; int ph_lo, ph_hi; };
__global__ void __launch_bounds__(512, 2) mk(MkArgs a) {
    extern __shared__ __attribute__((aligned(16))) unsigned char lds_raw[];
    LAS unsigned char* lds = (LAS unsigned char*)lds_raw;
    const int G = gridDim.x, vb = (int)blockIdx.x;
    unsigned* ctl = (unsigned*)(a.P.ws + WS_CTL);
    volatile LAS unsigned* MISC = (volatile LAS unsigned*)(lds + LDS_MISC);
    for (int u = threadIdx.x; u < 64; u += 512) MISC[u] = 0u;
    __syncthreads();
    const bool multi = a.ph_hi - a.ph_lo > 1;
    XcdBarrier bar; bar.bar = ctl + CW_BAR; bar.x = 0; bar.st = nullptr;
    if (multi) bar = xcd_barrier_post(ctl + CW_BAR, MISC + 8);
    const int lo = a.ph_lo, hi = a.ph_hi;
    const int fuse = (multi && lo == 0 && hi == N_STEPS && G == (NT / pg8::BM) * (D / pg8::BM)) ? 1 : 0;
#define STEP_BEGIN(id) if (lo <= (id) && (id) < hi) { unsigned long long kp_ = (unsigned long long)__builtin_amdgcn_kernarg_segment_ptr(); asm volatile("" : "+s"(kp_)); CParams& P = *(CParams*)kp_;
#define STEP_END(id) if ((id) + 1 < hi) xcd_barrier(bar); }
    STEP_BEGIN(0) el::init_phase(lds, P, vb, G); el::wconv_phase(lds, P, 0, vb, G); STEP_END(0)
#define LAYER(l) { \
        const int base = 1 + (l) * ST_PER_LAYER; \
        STEP_BEGIN(base + ST_N0) if ((l) > 0) el::wconv_phase(lds, P, (l), vb, G); if ((l) == 0 || !fuse) el::norm_phase(P, (l), 0, vb, G); STEP_END(base + ST_N0) \
        STEP_BEGIN(base + ST_A1) { pg8::Gemm g{WSP(bf16, WS_QKC), WSP(bf16, O_WIN1), D, D}; pg8::StaticOrder S; S.init(NT, N1P, G, vb); \
            pg8::EpiA1 E{WSP(bf16, WS_U1)}; pg8::gemm_phase(lds, g, S, E); } STEP_END(base + ST_A1) \
        STEP_BEGIN(base + ST_CV) el::conv_phase(lds, P, (l), vb, G); STEP_END(base + ST_CV) \
        STEP_BEGIN(base + ST_MX) scan_phase(lds, P, (l), ctl); STEP_END(base + ST_MX) \
        STEP_BEGIN(base + ST_PO) el::post_phase(lds, P, (l), vb, G); STEP_END(base + ST_PO) \
        STEP_BEGIN(base + ST_N1) el::norm_phase(P, (l), 1, vb, G); STEP_END(base + ST_N1) \
        STEP_BEGIN(base + ST_A2) { pg8::Gemm g{WSP(bf16, WS_RXC), WSP(bf16, O_WIN2), D, D}; pg8::StaticOrder S; S.init(NT, 2 * D, G, vb); \
            pg8::EpiA2 E{WSP(bf16, WS_U1)}; pg8::gemm_phase(lds, g, S, E); } STEP_END(base + ST_A2) \
        STEP_BEGIN(base + ST_PJ) { pg8::Gemm g{WSP(bf16, WS_QKC), WSP(bf16, O_PM), MW, D}; pg8::PairOrder S; S.init(NT, G, vb); \
            pg8::EpiPJ E{WSP(bf16, WS_U1)}; pg8::gemm_phase(lds, g, S, E); } STEP_END(base + ST_PJ) \
        STEP_BEGIN(base + ST_WO) { pg8::Gemm g{WSP(bf16, WS_U1), WSP(bf16, O_WO), D, PU}; pg8::StaticOrder S; S.init(NT, D, G, vb); \
            pg8::EpiResNorm E{P.out, WSP(float, WS_MOD) + (size_t)(l) * NCOND * 6 * D + 2 * D, (l) == 0 ? P.in[X_PROMPT] : nullptr, (l) == 0 ? P.in[X_SAMPLE] : nullptr, \
                fuse, P.in[NORM2] + (size_t)(l) * D, WSP(float, WS_MOD) + (size_t)(l) * NCOND * 6 * D + 3 * D, WSP(bf16, WS_QKC), P.ws, 1u + 2u * (l), lds}; pg8::gemm_phase(lds, g, S, E); } STEP_END(base + ST_WO) \
        if (!fuse) { STEP_BEGIN(base + ST_N2) el::norm_phase(P, (l), 2, vb, G); STEP_END(base + ST_N2) } \
        STEP_BEGIN(base + ST_F1) { pg8::Gemm g{WSP(bf16, WS_QKC), WSP(bf16, O_W13), D, D}; pg8::StaticOrder S; S.init(NT, 2 * FF, G, vb); \
            pg8::EpiF1 E{WSP(bf16, WS_U1)}; pg8::gemm_phase(lds, g, S, E); } STEP_END(base + ST_F1) \
        STEP_BEGIN(base + ST_F2) { pg8::Gemm g{WSP(bf16, WS_U1), WSP(bf16, O_W2), FF, FF}; pg8::StaticOrder S; S.init(NT, D, G, vb); \
            pg8::EpiResNorm E{P.out, WSP(float, WS_MOD) + (size_t)(l) * NCOND * 6 * D + 5 * D, nullptr, nullptr, fuse, \
                (l) + 1 < DEPTH ? P.in[NORM1] + (size_t)((l) + 1) * D : P.in[FINAL_G], (l) + 1 < DEPTH ? WSP(float, WS_MOD) + (size_t)((l) + 1) * NCOND * 6 * D : nullptr, \
                (l) + 1 < DEPTH ? WSP(bf16, WS_QKC) : nullptr, P.ws, 2u + 2u * (l), lds}; pg8::gemm_phase(lds, g, S, E); } \
            if ((l) + 1 < DEPTH || !fuse) { if (base + ST_F2 + 1 < hi) xcd_barrier(bar); } } \
    }
    static_assert(DEPTH == 2, "layers are unrolled by hand");
    LAYER(0)
    LAYER(1)
#undef LAYER
    if (!fuse) { STEP_BEGIN(N_STEPS - 1) el::norm_phase(P, 0, 3, vb, G); STEP_END(N_STEPS - 1) }
#undef STEP_BEGIN
#undef STEP_END
}
#endif

typedef void (*BodyFn)(const Params&, long);
#ifndef HOST_EMU
template <BodyFn F, int BLOCK> __global__ void __launch_bounds__(BLOCK) run_k(Params P, long n) {
    const long i = (long)blockIdx.x * BLOCK + threadIdx.x;
    if (i < n) F(P, i);
}
#define RUN(F, BLOCK, n) do { const long n_ = (n); run_k<F, BLOCK><<<dim3((unsigned)((n_ + BLOCK - 1) / BLOCK)), dim3(BLOCK), 0, stream>>>(P, n_); } while (0)
static int g_grid = 0;
#else
#define RUN(F, BLOCK, n) do { const long n_ = (n); for (long i_ = 0; i_ < n_; ++i_) F(P, i_); } while (0)
typedef void* hipStream_t;
#endif

static void forward(Params P, hipStream_t stream) {
    (void)stream;
#ifndef HOST_EMU
    if (hipMemsetAsync(P.ws + WS_CTL, 0, CTL_ZERO_BYTES, stream) != hipSuccess) return;
#ifdef MK_PER_STEP
    for (int st = 0; st < N_STEPS; ++st) { MkArgs a_{}; a_.P = P; a_.ph_lo = st; a_.ph_hi = st + 1; mk<<<dim3(g_grid), dim3(512), LDS_BYTES, stream>>>(a_); }
#else
    { MkArgs a_{}; a_.P = P; a_.ph_lo = 0; a_.ph_hi = N_STEPS; mk<<<dim3(g_grid), dim3(512), LDS_BYTES, stream>>>(a_); }
#endif
#else
    RUN(k_init_x, 256, (long)NT * D);
    RUN(k_mod, 256, (long)DEPTH * NCOND * 6 * D);
    for (int l = 0; l < DEPTH; ++l) {
        P.layer = l;
        RUN(k_wconv, 256, WC_N6);
        P.mode = 0; RUN(k_norm, 64, (long)NT);
        RUN(k_gemm_a1, 256, (long)NT * N1);
        RUN(k_conv, 256, (long)NT * (2 * MW + RIN));
        RUN(k_mlstm, 128, (long)NSEQ * MH * 2 * 128);
        for (int dir = 0; dir < 2; ++dir) { P.mode = dir; RUN(k_rwkv_prep, 256, (long)NT * RW); RUN(k_rwkv, 64, (long)NSEQ * RH * 64); }
        RUN(k_post, 256, (long)NT * D);
        P.mode = 1; RUN(k_norm, 64, (long)NT);
        RUN(k_gemm_a2, 256, (long)NT * 2 * D);
        RUN(k_gemm_pj, 256, (long)NT * D);
        RUN(k_gemm_wo, 256, (long)NT * D);
        P.mode = 2; RUN(k_norm, 64, (long)NT);
        RUN(k_gemm_f1, 256, (long)NT * FF);
        RUN(k_gemm_f2, 256, (long)NT * D);
    }
    RUN(k_final, 64, (long)NT);
#endif
}

#ifndef HOST_EMU
extern "C" void kernel_launch(void* const* d_in, const int* in_sizes, int n_in, void* d_out, int out_size, void* d_ws, size_t ws_size, hipStream_t stream) {
    if (n_in != N_IN || (size_t)out_size != OUT_END || ws_size < WS_END) return;
    if (g_grid == 0) {
        int dev = 0, cus = 0;
        if (hipGetDevice(&dev) != hipSuccess || hipDeviceGetAttribute(&cus, hipDeviceAttributeMultiprocessorCount, dev) != hipSuccess) { g_grid = -1; return; }
        if (hipFuncSetAttribute((const void*)mk, hipFuncAttributeMaxDynamicSharedMemorySize, LDS_BYTES) != hipSuccess) { g_grid = -1; return; }
        g_grid = cus;
    }
    if (g_grid < 0) return;
    Params P{};
    for (int i = 0; i < N_IN; ++i) P.in[i] = (const float*)d_in[i];
    P.out = (float*)d_out; P.ws = (unsigned char*)d_ws; P.layer = 0; P.mode = 0;
    forward(P, stream);
}
#endif
```

```cpp
#ifndef HOST_EMU
#include <hip/hip_runtime.h>
#define HD __host__ __device__ __forceinline__
#define DEV __device__ __forceinline__
#else
#include <cmath>
#include <cstring>
#include <cstdio>
#include <cstdlib>
#define HD inline
#define DEV inline
#endif
#include <cstddef>

#ifdef SMALL_CFG
constexpr int D = 256, CB = 2, CT = 128, DEPTH = 2, LB = 1, LT = 256, GW = 16;
#else
constexpr int D = 1024, CB = 32, CT = 256, DEPTH = 2, LB = 2, LT = 4096, GW = 64;
#endif
constexpr int MW = D / 2, MD = 128, MH = MW / MD, RW = D / 2, RD = 64, RH = RW / RD;
constexpr int RIN = 3 * RW + 384, FF = ((8 * D + 767) / 768) * 256, PIN = 2 * MW + MW + MW + 4 * MH + RIN + 2 * D;
constexpr int NC = CB * CT, NL = LB * LT, NT = NC + NL, NSEQ = CB + LB, NCOND = 1 + LB;
constexpr int N1 = PIN - 2 * D;
constexpr int N1P = ((N1 + 255) / 256) * 256;
constexpr int PU = N1;
constexpr int OFF_QK = 0, OFF_V = 2 * MW, OFF_O = 3 * MW, OFF_G = 4 * MW, OFF_R = 4 * MW + 4 * MH;
constexpr int RX_R = 0, RX_K = RW, RX_V = 2 * RW, RX_WL = 3 * RW, RX_AL = 3 * RW + 128, RX_GL = 3 * RW + 256;
constexpr float RMS_EPS = 1e-6f, GN_EPS = 64e-5f;
static_assert(3 * D <= N1, "G + merged must fit the dead columns of U1");

enum { X_PROMPT = 0, X_SAMPLE, ST_C, ST_N, ST_M, ST_R, C_LAT, C_CTX, ADA_W, ADA_B, NORM1, NORM2, W_IN, M_CONV, M_GATE_B, M_NORM_G,
       R_CONV, R_W0, R_W2, R_A0, R_A2, R_G2, R_KK, R_KA, R_RK, R_GN_W, R_GN_B, PROJ_M, PROJ_R, W_OUT, FFN_W1, FFN_W3, FFN_W2, FINAL_G, N_IN };

constexpr size_t OUT_X = 0;
constexpr size_t OUT_C = (size_t)NT * D;
constexpr size_t OUT_N = OUT_C + (size_t)CB * DEPTH * 2 * MH * 128 * 128;
constexpr size_t OUT_M = OUT_N + (size_t)CB * DEPTH * 2 * MH * 128;
constexpr size_t OUT_S = OUT_M + (size_t)CB * DEPTH * 2 * MH;
constexpr size_t OUT_END = OUT_S + (size_t)CB * DEPTH * 2 * RH * 64 * 64;

constexpr size_t al256(size_t x) { return (x + 255) & ~(size_t)255; }
constexpr size_t cmax(size_t a, size_t b) { return a > b ? a : b; }
constexpr size_t WS_CTL = 0;
constexpr size_t WS_MOD = (size_t)1 << 20;
constexpr size_t WS_WREG = (size_t)2 << 20;
constexpr size_t O_WIN1 = WS_WREG;
constexpr size_t O_WIN2 = O_WIN1 + (size_t)N1P * D * 2;
constexpr size_t O_PM = O_WIN2 + (size_t)2 * D * D * 2;
constexpr size_t O_PR = O_PM + (size_t)D * MW * 2;
constexpr size_t O_WO = O_PR + (size_t)D * RW * 2;
constexpr size_t O_W13 = O_WO + (size_t)D * D * 2;
constexpr size_t O_W2 = O_W13 + (size_t)2 * FF * D * 2;
constexpr size_t O_G2T = O_W2 + (size_t)D * FF * 2;
constexpr size_t O_W2T = O_G2T + (size_t)RW * 128 * 2;
constexpr size_t O_A2T = O_W2T + (size_t)2 * RW * 64 * 2;
constexpr size_t WS_U1 = al256(O_A2T + (size_t)2 * RW * 64 * 2);
constexpr size_t SZ_U1 = al256(cmax((size_t)NT * PU * 2, (size_t)NT * FF * 2));
constexpr size_t WS_QKC = WS_U1 + SZ_U1;
constexpr size_t WS_RXC = WS_QKC + (size_t)NT * D * 2;
constexpr size_t WS_END = WS_RXC + al256(cmax((size_t)NT * RIN * 2, (size_t)NT * D * 2));
#ifndef SMALL_CFG
static_assert(WS_END <= ((size_t)256 << 20), "workspace map must fit 256 MiB");
#endif

typedef unsigned short bf16;
HD float bf2f(bf16 b) { unsigned u = ((unsigned)b) << 16; return __builtin_bit_cast(float, u); }
#if defined(__HIP_DEVICE_COMPILE__)
HD bf16 f2bf(float f) { return __builtin_bit_cast(bf16, (__bf16)f); }
#else
HD bf16 f2bf(float f) { unsigned u = __builtin_bit_cast(unsigned, f); u += 0x7fffu + ((u >> 16) & 1u); return (bf16)(u >> 16); }
#endif
HD float sigmoidf_(float x) { return 1.0f / (1.0f + expf(-x)); }
HD float siluf_(float x) { return x / (1.0f + expf(-x)); }
HD float softplusf_(float x) { return fmaxf(x, 0.f) + log1pf(expf(-fabsf(x))); }
HD float logsigmoidf_(float x) { return -softplusf_(-x); }
HD int prow(int c) { return (c & ~31) | (((c >> 2) & 1) << 4) | (((c >> 3) & 3) << 2) | (c & 3); }

struct Params {
    const float* in[N_IN];
    float* out;
    unsigned char* ws;
    int layer;
    int mode;
};

struct SeqInfo { int T; int base; int grid; int cond; int b; };
HD SeqInfo seqinfo(int s) {
    SeqInfo q;
    if (s < CB) { q.T = CT; q.base = s * CT; q.grid = 0; q.cond = 0; q.b = s; }
    else { q.T = LT; q.base = NC + (s - CB) * LT; q.grid = 1; q.cond = 1 + (s - CB); q.b = s - CB; }
    return q;
}
HD int seq_of_token(int m) { return m < NC ? m / CT : CB + (m - NC) / LT; }

#define WSP(T, off) ((T*)(P.ws + (off)))

DEV void k_init_x(const Params& P, long i) {
    const size_t ncd = (size_t)NC * D;
    P.out[i] = (size_t)i < ncd ? P.in[X_PROMPT][i] : P.in[X_SAMPLE][i - ncd];
}
DEV void k_mod(const Params& P, long i) {
    const int j = (int)(i % (6 * D)); const int ci = (int)((i / (6 * D)) % NCOND); const int l = (int)(i / ((long)6 * D * NCOND));
    const float* cv = ci == 0 ? P.in[C_CTX] : P.in[C_LAT] + (size_t)(ci - 1) * D;
    const float* w = P.in[ADA_W] + (size_t)l * D * 6 * D;
    float acc = P.in[ADA_B][(size_t)l * 6 * D + j];
    for (int k = 0; k < D; ++k) acc += siluf_(cv[k]) * w[(size_t)k * 6 * D + j];
    WSP(float, WS_MOD)[i] = acc;
}
constexpr long WC_N0 = (long)N1P * D, WC_N1 = WC_N0 + (long)2 * D * D, WC_N2 = WC_N1 + (long)D * MW, WC_N3 = WC_N2 + (long)D * RW,
               WC_N4 = WC_N3 + (long)D * D, WC_N5 = WC_N4 + (long)2 * FF * D, WC_N6 = WC_N5 + (long)D * FF;
HD int unprow(int r) { return (r & ~31) | (((r >> 2) & 3) << 3) | (((r >> 4) & 1) << 2) | (r & 3); }
DEV void k_wconv(const Params& P, long i) {
    const int l = P.layer;
    if (i < WC_N0) { const int r = (int)(i / D), k = (int)(i % D); const int c = unprow(r);
        WSP(bf16, O_WIN1)[i] = c < N1 ? f2bf(P.in[W_IN][((size_t)l * D + k) * PIN + c]) : (bf16)0; return; }
    if (i < WC_N1) { const long j = i - WC_N0; const int r = (int)(j / D), k = (int)(j % D); const int c = unprow(r);
        WSP(bf16, O_WIN2)[j] = f2bf(P.in[W_IN][((size_t)l * D + k) * PIN + N1 + c]); return; }
    if (i < WC_N2) { const long j = i - WC_N1; const int r = (int)(j / MW), k = (int)(j % MW); const int c = unprow(r);
        WSP(bf16, O_PM)[j] = f2bf(P.in[PROJ_M][((size_t)l * MW + k) * D + c]); return; }
    if (i < WC_N3) { const long j = i - WC_N2; const int r = (int)(j / RW), k = (int)(j % RW); const int c = unprow(r);
        WSP(bf16, O_PR)[j] = f2bf(P.in[PROJ_R][((size_t)l * RW + k) * D + c]); return; }
    if (i < WC_N4) { const long j = i - WC_N3; const int r = (int)(j / D), k = (int)(j % D);
        WSP(bf16, O_WO)[j] = f2bf(P.in[W_OUT][((size_t)l * D + k) * D + r]); return; }
    if (i < WC_N5) { const long j = i - WC_N4; const int r = (int)(j / D), k = (int)(j % D);
        const int pn = r >> 8, rl = r & 255, which = rl >> 7, rho = rl & 127; const int jj = pn * 128 + unprow(rho);
        const float* W = which ? P.in[FFN_W3] : P.in[FFN_W1];
        WSP(bf16, O_W13)[j] = f2bf(W[((size_t)l * D + k) * FF + jj]); return; }
    { const long j = i - WC_N5; const int r = (int)(j / FF), k = (int)(j % FF);
        WSP(bf16, O_W2)[j] = f2bf(P.in[FFN_W2][((size_t)l * FF + k) * D + r]); }
}
DEV void k_norm(const Params& P, long m) {
    const int l = P.layer; const int second = (P.mode == 2);
    const float* x = P.out + (size_t)m * D;
    const float* g = P.in[second ? NORM2 : NORM1] + (size_t)l * D;
    const int cond = seqinfo(seq_of_token((int)m)).cond;
    const float* mod = WSP(float, WS_MOD) + ((size_t)l * NCOND + cond) * 6 * D + (second ? 3 * D : 0);
    float ss = 0.f;
    for (int k = 0; k < D; ++k) ss += x[k] * x[k];
    const float rs = 1.0f / sqrtf(ss / D + RMS_EPS);
    bf16* o = WSP(bf16, P.mode == 1 ? WS_RXC : WS_QKC) + (size_t)m * D;
    for (int k = 0; k < D; ++k) o[k] = f2bf(x[k] * rs * g[k] * (1.0f + mod[D + k]) + mod[k]);
}
DEV float dot_bf(const bf16* a, const bf16* b, int K) { float s = 0.f; for (int k = 0; k < K; ++k) s += bf2f(a[k]) * bf2f(b[k]); return s; }
DEV void k_gemm_a1(const Params& P, long i) {
    const int n = (int)(i % N1); const long m = i / N1;
    WSP(bf16, WS_U1)[(size_t)m * PU + n] = f2bf(dot_bf(WSP(bf16, WS_QKC) + (size_t)m * D, WSP(bf16, O_WIN1) + (size_t)prow(n) * D, D));
}
DEV void k_gemm_a2(const Params& P, long i) {
    const int n = (int)(i % (2 * D)); const long m = i / (2 * D);
    WSP(bf16, WS_U1)[(size_t)m * PU + D + n] = f2bf(sigmoidf_(dot_bf(WSP(bf16, WS_RXC) + (size_t)m * D, WSP(bf16, O_WIN2) + (size_t)prow(n) * D, D)));
}
DEV void k_gemm_pj(const Params& P, long i) {
    const int n = (int)(i % D); const long m = i / D;
    const bf16* hmr = WSP(bf16, WS_QKC) + (size_t)m * D; bf16* u = WSP(bf16, WS_U1) + (size_t)m * PU;
    const float a = dot_bf(hmr, WSP(bf16, O_PM) + (size_t)prow(n) * MW, MW), b = dot_bf(hmr + MW, WSP(bf16, O_PR) + (size_t)prow(n) * RW, RW);
    const float first = bf2f(f2bf(bf2f(u[D + n]) * a));
    u[n] = f2bf(first + bf2f(u[2 * D + n]) * b);
}
DEV void k_gemm_wo(const Params& P, long i) {
    const int n = (int)(i % D); const long m = i / D; const int l = P.layer;
    const int cond = seqinfo(seq_of_token((int)m)).cond;
    const float g1 = WSP(float, WS_MOD)[((size_t)l * NCOND + cond) * 6 * D + 2 * D + n];
    P.out[(size_t)m * D + n] += g1 * dot_bf(WSP(bf16, WS_U1) + (size_t)m * PU, WSP(bf16, O_WO) + (size_t)n * D, D);
}
DEV void k_gemm_f1(const Params& P, long i) {
    const int j = (int)(i % FF); const long m = i / FF;
    const int pn = j >> 7, rho = prow(j & 127);
    const bf16* h = WSP(bf16, WS_QKC) + (size_t)m * D;
    const float a = dot_bf(h, WSP(bf16, O_W13) + (size_t)(pn * 256 + rho) * D, D), b = dot_bf(h, WSP(bf16, O_W13) + (size_t)(pn * 256 + 128 + rho) * D, D);
    WSP(bf16, WS_U1)[(size_t)m * FF + j] = f2bf(siluf_(a) * b);
}
DEV void k_gemm_f2(const Params& P, long i) {
    const int n = (int)(i % D); const long m = i / D; const int l = P.layer;
    const int cond = seqinfo(seq_of_token((int)m)).cond;
    const float g2 = WSP(float, WS_MOD)[((size_t)l * NCOND + cond) * 6 * D + 5 * D + n];
    P.out[(size_t)m * D + n] += g2 * dot_bf(WSP(bf16, WS_U1) + (size_t)m * FF, WSP(bf16, O_W2) + (size_t)n * FF, FF);
}
DEV void k_conv(const Params& P, long i) {
    constexpr int NCH = 2 * MW + RIN;
    const int ch = (int)(i % NCH); const int m = (int)(i / NCH); const int l = P.layer;
    const int s = seq_of_token(m); const SeqInfo q = seqinfo(s); const int t = m - q.base;
    const bool isqk = ch < 2 * MW; const int c = isqk ? ch : ch - 2 * MW;
    const int ucol = isqk ? OFF_QK + c : OFF_R + c;
    const int CH = isqk ? 2 * MW : RIN;
    const float* w = (isqk ? P.in[M_CONV] : P.in[R_CONV]) + (size_t)l * 9 * CH;
    const bf16* U = WSP(bf16, WS_U1);
    float acc = 0.f;
    if (q.grid) {
        const int r = t / GW, cc = t % GW, rows = q.T / GW;
        for (int a = 0; a < 3; ++a) for (int b = 0; b < 3; ++b) {
            const int rr = r + a - 1, c2 = cc + b - 1;
            if (rr >= 0 && rr < rows && c2 >= 0 && c2 < GW) acc += w[(a * 3 + b) * CH + c] * bf2f(U[(size_t)(q.base + rr * GW + c2) * PU + ucol]);
        }
    } else {
        for (int b = 0; b < 3; ++b) { const int t2 = t + b - 1; if (t2 >= 0 && t2 < q.T) acc += w[(3 + b) * CH + c] * bf2f(U[(size_t)(q.base + t2) * PU + ucol]); }
    }
    if (isqk) { float v = siluf_(acc); if (c < MW) v *= 0.08838834764831845f; WSP(bf16, WS_QKC)[(size_t)m * (2 * MW) + c] = f2bf(v); }
    else { float v = acc; if (c >= RX_WL && c < RX_AL) v = tanhf(v); else if (c >= RX_GL) v = sigmoidf_(v); WSP(bf16, WS_RXC)[(size_t)m * RIN + c] = f2bf(v); }
}
DEV void k_mlstm(const Params& P, long i) {
    const int e = (int)(i % 128); const int chain = (int)(i / 128); const int dir = chain & 1, head = (chain >> 1) % MH, s = chain / (2 * MH);
    const int l = P.layer; const SeqInfo q = seqinfo(s);
    float C[128], n[128]; float m;
    if (!q.grid) {
#pragma unroll
        for (int d = 0; d < 128; ++d) { C[d] = 0.f; n[d] = 0.f; }
        m = 0.f;
    } else {
        const size_t sb = (((size_t)q.b * DEPTH + l) * 2 + dir) * MH + head;
#pragma unroll
        for (int d = 0; d < 128; ++d) { C[d] = P.in[ST_C][(sb * 128 + d) * 128 + e]; n[d] = P.in[ST_N][sb * 128 + d]; }
        m = P.in[ST_M][sb];
    }
    const float bi = P.in[M_GATE_B][(size_t)l * 4 * MH + (2 * dir) * MH + head], bfg = P.in[M_GATE_B][(size_t)l * 4 * MH + (2 * dir + 1) * MH + head];
    bf16* U = WSP(bf16, WS_U1); const bf16* QK = WSP(bf16, WS_QKC);
    float nsel = 0.f;
    for (int p = 0; p < q.T; ++p) {
        const int t = dir ? q.T - 1 - p : p; const size_t tok = (size_t)(q.base + t);
        const bf16* qk = QK + tok * (2 * MW); bf16* u = U + tok * PU;
        const float gi = bf2f(u[OFF_G + (2 * dir) * MH + head]) + bi, gf = bf2f(u[OFF_G + (2 * dir + 1) * MH + head]) + bfg;
        const float lf = logsigmoidf_(gf);
        const float mn = fmaxf(lf + m, gi); const float fw = expf(lf + m - mn), iw = expf(gi - mn);
        const float v = bf2f(u[OFF_V + head * 128 + e]);
        float num = 0.f, den = 0.f;
#pragma unroll
        for (int d = 0; d < 128; ++d) {
            const float kd = bf2f(qk[MW + head * 128 + d]), qd = bf2f(qk[head * 128 + d]);
            C[d] = fw * C[d] + iw * kd * v; n[d] = fw * n[d] + iw * kd; num += qd * C[d]; den += qd * n[d];
        }
        m = mn;
        u[dir * MW + head * 128 + e] = f2bf(num / fmaxf(fabsf(den), expf(-m)));
    }
    if (!q.grid) {
        const size_t sb = (((size_t)q.b * DEPTH + l) * 2 + dir) * MH + head;
#pragma unroll
        for (int d = 0; d < 128; ++d) { P.out[OUT_C + (sb * 128 + d) * 128 + e] = C[d]; if (d == e) nsel = n[d]; }
        P.out[OUT_N + sb * 128 + e] = nsel;
        if (e == 0) P.out[OUT_M + sb] = m;
    }
}
DEV void k_rwkv_prep(const Params& P, long i) {
    const int c = (int)(i % RW); const size_t tok = (size_t)(i / RW); const int l = P.layer, dir = P.mode;
    const bf16* rx = WSP(bf16, WS_RXC) + tok * RIN;
    const float* w2 = P.in[R_W2] + ((size_t)l * 2 + dir) * 64 * RW + c; const float* a2 = P.in[R_A2] + ((size_t)l * 2 + dir) * 64 * RW + c;
    float wr = P.in[R_W0][((size_t)l * 2 + dir) * RW + c], ar = P.in[R_A0][((size_t)l * 2 + dir) * RW + c];
    for (int j = 0; j < 64; ++j) { wr += bf2f(rx[RX_WL + dir * 64 + j]) * w2[(size_t)j * RW]; ar += bf2f(rx[RX_AL + dir * 64 + j]) * a2[(size_t)j * RW]; }
    bf16* o = WSP(bf16, WS_QKC) + tok * (2 * RW);
    o[c] = f2bf(wr); o[RW + c] = f2bf(ar);
}
DEV void k_rwkv(const Params& P, long i) {
    const int row = (int)(i % 64); const int chain = (int)(i / 64); const int dir = P.mode, head = chain % RH, s = chain / RH;
    const int l = P.layer; const SeqInfo q = seqinfo(s); const int hc = head * 64;
    float S[64];
    if (!q.grid) {
#pragma unroll
        for (int c = 0; c < 64; ++c) S[c] = 0.f;
    } else {
        const size_t sb = (((size_t)q.b * DEPTH + l) * 2 + dir) * RH + head;
#pragma unroll
        for (int c = 0; c < 64; ++c) S[c] = P.in[ST_R][(sb * 64 + row) * 64 + c];
    }
    const float* rkk = P.in[R_KK] + (size_t)l * RW + hc; const float* rka = P.in[R_KA] + (size_t)l * RW + hc;
    bf16* U = WSP(bf16, WS_U1); const bf16* RX = WSP(bf16, WS_RXC); const bf16* WA = WSP(bf16, WS_QKC);
    for (int p = 0; p < q.T; ++p) {
        const int t = dir ? q.T - 1 - p : p; const size_t tok = (size_t)(q.base + t);
        const bf16* rx = RX + tok * RIN; const bf16* wa = WA + tok * (2 * RW);
        float ss = 0.f;
        for (int c = 0; c < 64; ++c) { const float kc = bf2f(rx[RX_K + hc + c]) * rkk[c]; ss += kc * kc; }
        const float inv = 1.0f / fmaxf(sqrtf(ss), 1e-12f);
        float sa = 0.f;
#pragma unroll
        for (int c = 0; c < 64; ++c) sa -= S[c] * (bf2f(rx[RX_K + hc + c]) * rkk[c] * inv);
        const float v = bf2f(rx[RX_V + hc + row]);
        float y = 0.f;
#pragma unroll
        for (int c = 0; c < 64; ++c) {
            const float wr = bf2f(wa[hc + c]), ar = bf2f(wa[RW + hc + c]);
            const float decay = expf(-0.6065306597126334f * sigmoidf_(wr));
            const float alpha = sigmoidf_(ar);
            const float kr = bf2f(rx[RX_K + hc + c]);
            const float kt = kr * (1.0f + (alpha - 1.0f) * rka[c]);
            const float bb = kr * rkk[c] * inv * alpha;
            S[c] = S[c] * decay + sa * bb + v * kt;
            y += S[c] * bf2f(rx[RX_R + hc + c]);
        }
        U[tok * PU + OFF_R + dir * RW + hc + row] = f2bf(y);
    }
    if (!q.grid) {
        const size_t sb = (((size_t)q.b * DEPTH + l) * 2 + dir) * RH + head;
#pragma unroll
        for (int c = 0; c < 64; ++c) P.out[OUT_S + (sb * 64 + row) * 64 + c] = S[c];
    }
}
DEV void k_post(const Params& P, long i) {
    const int ch = (int)(i % D); const size_t m = (size_t)(i / D); const int l = P.layer;
    const bf16* u = WSP(bf16, WS_U1) + m * PU; const bf16* rx = WSP(bf16, WS_RXC) + m * RIN;
    bf16* o = WSP(bf16, WS_QKC) + m * D;
    if (ch < MW) {
        const int h0 = (ch / 128) * 128; float ss = 0.f;
        for (int d = 0; d < 128; ++d) { const float x = bf2f(u[h0 + d]) + bf2f(u[MW + h0 + d]); ss += x * x; }
        const float x = bf2f(u[ch]) + bf2f(u[MW + ch]);
        o[ch] = f2bf(x / sqrtf(ss / 128.f + RMS_EPS) * P.in[M_NORM_G][(size_t)l * MW + ch] * sigmoidf_(bf2f(u[OFF_O + ch])));
    } else {
        const int c = ch - MW; const int h0 = (c / 64) * 64;
        float mu = 0.f, bsum = 0.f;
        for (int d = 0; d < 64; ++d) { mu += bf2f(u[OFF_R + h0 + d]) + bf2f(u[OFF_R + RW + h0 + d]);
            bsum += bf2f(rx[RX_R + h0 + d]) * bf2f(rx[RX_K + h0 + d]) * P.in[R_RK][(size_t)l * RW + h0 + d]; }
        mu *= (1.0f / 64.f); float var = 0.f;
        for (int d = 0; d < 64; ++d) { const float x = bf2f(u[OFF_R + h0 + d]) + bf2f(u[OFF_R + RW + h0 + d]) - mu; var += x * x; }
        var *= (1.0f / 64.f);
        const float y = bf2f(u[OFF_R + c]) + bf2f(u[OFF_R + RW + c]);
        const float yn = (y - mu) / sqrtf(var + GN_EPS) * P.in[R_GN_W][(size_t)l * RW + c] + P.in[R_GN_B][(size_t)l * RW + c];
        float gate = 0.f;
        for (int j = 0; j < 128; ++j) gate += bf2f(rx[RX_GL + j]) * P.in[R_G2][((size_t)l * 128 + j) * RW + c];
        o[ch] = f2bf((yn + bsum * bf2f(rx[RX_V + c])) * gate);
    }
}
DEV void k_final(const Params& P, long m) {
    float* x = P.out + (size_t)m * D; float ss = 0.f;
    for (int k = 0; k < D; ++k) ss += x[k] * x[k];
    const float rs = 1.0f / sqrtf(ss / D + RMS_EPS);
    for (int k = 0; k < D; ++k) x[k] = x[k] * rs * P.in[FINAL_G][k];
}


#ifndef HOST_EMU
typedef const __attribute__((address_space(4))) Params CParams;
namespace pg8 {
#define PG8_LAS __attribute__((address_space(3)))
typedef short bf16x8 __attribute__((ext_vector_type(8)));
typedef float f32x4 __attribute__((ext_vector_type(4)));
typedef unsigned u32x4 __attribute__((ext_vector_type(4)));
constexpr int BM = 256, BK = 64, HALF = 128, HTB = HALF * BK * 2, STAGE_BYTES = 8 * HTB, NXCD = 8, WGM = 8;
__device__ __forceinline__ int lds_byte(int r, int c) { const int st = (r >> 4) * 2 + (c >> 5), rr = r & 15, cc = c & 31, ob = rr * 64 + cc * 2; return st * 1024 + (ob ^ (((ob >> 9) & 1) << 5)); }
__device__ __forceinline__ void stage_rc(int b, int& R, int& C) { const int st = b / 1024, sb = b % 1024, swz = sb ^ (((sb >> 9) & 1) << 5); R = (st >> 1) * 16 + swz / 64; C = (st & 1) * 32 + (swz % 64) / 2; }
struct Unit { int pm, pn, aoff; };
struct Gemm { const bf16* A; const bf16* Bt; int K, lda; };
struct StaticOrder {
    int nM, nN, nwg, G, c;
    __device__ __forceinline__ void init(int M, int N, int G_, int c_) { nM = M / BM; nN = N / BM; nwg = nM * nN; G = G_; c = c_; }
    __device__ __forceinline__ bool next(int i, Unit& u) const {
        const long L = (long)i * G + c; if (L >= nwg) return false;
        int wgid = (int)L; { const int q = nwg / NXCD, r = nwg % NXCD, xcd = wgid % NXCD, off = wgid / NXCD; wgid = (xcd < r ? xcd * (q + 1) : r * (q + 1) + (xcd - r) * q) + off; }
        const int nig = WGM * nN, gid = wgid / nig, fm = gid * WGM, gsz = (nM - fm) < WGM ? (nM - fm) : WGM;
        u.pm = fm + ((wgid % nig) % gsz); u.pn = (wgid % nig) / gsz; u.aoff = 0; return true;
    }
};
struct PairOrder {
    int nbase, G, v, nct;
    __device__ __forceinline__ void init(int M, int G_, int c_) { nct = D / BM; nbase = (M / BM) * nct; G = G_; v = (G_ % 8 == 0) ? (c_ % 8) * (G_ / 8) + c_ / 8 : c_; }
    __device__ __forceinline__ bool next(int i, Unit& u) const {
        const int j = v + (i >> 1) * G; if (j >= nbase) return false;
        const int half = i & 1; u.pm = j / nct; u.pn = half * nct + (j % nct); u.aoff = half * MW; return true;
    }
};
typedef float f32x2_t __attribute__((ext_vector_type(2)));
typedef __bf16 bf16x2_t __attribute__((ext_vector_type(2)));
__device__ __forceinline__ unsigned cvt_pk_bf16(float lo, float hi) { f32x2_t v = {lo, hi}; bf16x2_t b = __builtin_convertvector(v, bf16x2_t); return __builtin_bit_cast(unsigned, b); }
__device__ __forceinline__ float fsigmoid(float x) { return __builtin_amdgcn_rcpf(1.0f + __expf(-x)); }
__device__ __forceinline__ float bflo(unsigned w) { return __builtin_bit_cast(float, w << 16); }
__device__ __forceinline__ float bfhi(unsigned w) { return __builtin_bit_cast(float, w & 0xffff0000u); }

struct EpiA1 {
    bf16* U;
    __device__ __forceinline__ void operator()(const f32x4 (&acc)[2][2][4][2], const Unit& u, int wr, int wc, int fr, int fq) const {
        const int row0 = u.pm * BM + wr * 64 + fr, col0 = u.pn * BM + wc * 32 + 8 * fq;
#pragma unroll
        for (int ai = 0; ai < 2; ++ai)
#pragma unroll
            for (int m = 0; m < 4; ++m) { bf16* rowp = U + (size_t)(row0 + ai * HALF + m * 16) * PU + col0;
#pragma unroll
                for (int bj = 0; bj < 2; ++bj) { if (col0 + bj * HALF < N1) { const f32x4 v0 = acc[ai][bj][m][0], v1 = acc[ai][bj][m][1];
                    u32x4 w; w.x = cvt_pk_bf16(v0[0], v0[1]); w.y = cvt_pk_bf16(v0[2], v0[3]); w.z = cvt_pk_bf16(v1[0], v1[1]); w.w = cvt_pk_bf16(v1[2], v1[3]);
                    *(u32x4*)(rowp + bj * HALF) = w; } } }
    }
};
struct EpiA2 {
    bf16* U;
    __device__ __forceinline__ void operator()(const f32x4 (&acc)[2][2][4][2], const Unit& u, int wr, int wc, int fr, int fq) const {
        const int row0 = u.pm * BM + wr * 64 + fr, col0 = D + u.pn * BM + wc * 32 + 8 * fq;
#pragma unroll
        for (int ai = 0; ai < 2; ++ai)
#pragma unroll
            for (int m = 0; m < 4; ++m) { bf16* rowp = U + (size_t)(row0 + ai * HALF + m * 16) * PU + col0;
#pragma unroll
                for (int bj = 0; bj < 2; ++bj) { const f32x4 v0 = acc[ai][bj][m][0], v1 = acc[ai][bj][m][1];
                    u32x4 w; w.x = cvt_pk_bf16(fsigmoid(v0[0]), fsigmoid(v0[1])); w.y = cvt_pk_bf16(fsigmoid(v0[2]), fsigmoid(v0[3]));
                    w.z = cvt_pk_bf16(fsigmoid(v1[0]), fsigmoid(v1[1])); w.w = cvt_pk_bf16(fsigmoid(v1[2]), fsigmoid(v1[3]));
                    *(u32x4*)(rowp + bj * HALF) = w; } }
    }
};
struct EpiPJ {
    bf16* U;
    __device__ __forceinline__ void operator()(const f32x4 (&acc)[2][2][4][2], const Unit& u, int wr, int wc, int fr, int fq) const {
        const int nct = D / BM, half = u.pn >= nct ? 1 : 0, ct = u.pn - half * nct;
        const int row0 = u.pm * BM + wr * 64 + fr, col0 = ct * BM + wc * 32 + 8 * fq;
#pragma unroll
        for (int ai = 0; ai < 2; ++ai)
#pragma unroll
            for (int mp = 0; mp < 4; mp += 2) { u32x4 gq[2][2], pq[2][2];
#pragma unroll
                for (int mm = 0; mm < 2; ++mm) { const bf16* rowp = U + (size_t)(row0 + ai * HALF + (mp + mm) * 16) * PU + col0;
#pragma unroll
                    for (int bj = 0; bj < 2; ++bj) { gq[mm][bj] = *(const u32x4*)(rowp + (1 + half) * D + bj * HALF); if (half) pq[mm][bj] = *(const u32x4*)(rowp + bj * HALF); } }
#pragma unroll
                for (int mm = 0; mm < 2; ++mm) { const int m = mp + mm; bf16* rowp = U + (size_t)(row0 + ai * HALF + m * 16) * PU + col0;
#pragma unroll
                    for (int bj = 0; bj < 2; ++bj) { const f32x4 v0 = acc[ai][bj][m][0], v1 = acc[ai][bj][m][1]; const u32x4 g = gq[mm][bj];
                        float o[8] = { bflo(g.x) * v0[0], bfhi(g.x) * v0[1], bflo(g.y) * v0[2], bfhi(g.y) * v0[3], bflo(g.z) * v1[0], bfhi(g.z) * v1[1], bflo(g.w) * v1[2], bfhi(g.w) * v1[3] };
                        if (half) { const u32x4 p = pq[mm][bj];
                            o[0] += bflo(p.x); o[1] += bfhi(p.x); o[2] += bflo(p.y); o[3] += bfhi(p.y); o[4] += bflo(p.z); o[5] += bfhi(p.z); o[6] += bflo(p.w); o[7] += bfhi(p.w); }
                        u32x4 w; w.x = cvt_pk_bf16(o[0], o[1]); w.y = cvt_pk_bf16(o[2], o[3]); w.z = cvt_pk_bf16(o[4], o[5]); w.w = cvt_pk_bf16(o[6], o[7]);
                        *(u32x4*)(rowp + bj * HALF) = w; } }
                asm volatile("" ::: "memory"); }
    }
};
struct EpiRes {
    float* X; const float* gate;
    const float* sa; const float* sb;
    __device__ __forceinline__ void operator()(const f32x4 (&acc)[2][2][4][2], const Unit& u, int wr, int wc, int fr, int fq) const {
        const int row0 = u.pm * BM + wr * 64 + fr, col0 = u.pn * BM + wc * 32 + 4 * fq;
        const float* S = sa ? (u.pm * BM < NC ? sa : sb - (size_t)NC * D) : X;
        const int cond = seqinfo(seq_of_token(u.pm * BM)).cond;
        const float* gp = gate + (size_t)cond * 6 * D + col0;
        f32x4 gv[2][2];
#pragma unroll
        for (int bj = 0; bj < 2; ++bj)
#pragma unroll
            for (int n = 0; n < 2; ++n) gv[bj][n] = *(const f32x4*)(gp + bj * HALF + n * 16);
#pragma unroll
        for (int ai = 0; ai < 2; ++ai)
#pragma unroll
            for (int m = 0; m < 4; ++m) { const size_t ro = (size_t)(row0 + ai * HALF + m * 16) * D + col0; float* rowp = X + ro; const float* srow = S + ro;
#pragma unroll
                for (int bj = 0; bj < 2; ++bj)
#pragma unroll
                    for (int n = 0; n < 2; ++n) { *(f32x4*)(rowp + bj * HALF + n * 16) = *(const f32x4*)(srow + bj * HALF + n * 16) + gv[bj][n] * acc[ai][bj][m][n]; }
                asm volatile("" ::: "memory"); }
    }
};
typedef unsigned u32x2 __attribute__((ext_vector_type(2)));
constexpr int CW_NX = 45056, CW_NX_STRIDE = 16, NX_EXCH_BYTE = 512 * 1024, NX_LDS = 131072;
struct EpiResNorm {
    float* X; const float* gate; const float* sa; const float* sb;
    int fuse;
    const float* ng; const float* nmod;
    bf16* H;
    unsigned char* ctlb; unsigned epoch; PG8_LAS unsigned char* lds;
    __device__ __forceinline__ void operator()(const f32x4 (&acc_)[2][2][4][2], const Unit& u, int wr, int wc, int fr, int fq) const {
        f32x4 (&acc)[2][2][4][2] = const_cast<f32x4 (&)[2][2][4][2]>(acc_);
        const int tid = threadIdx.x;
        const int row0 = u.pm * BM + wr * 64 + fr, col0 = u.pn * BM + wc * 32 + 4 * fq;
        const int cond = seqinfo(seq_of_token(u.pm * BM)).cond;
        const float* S = sa ? (u.pm * BM < NC ? sa : sb - (size_t)NC * D) : X;
        { const float* gp = gate + (size_t)cond * 6 * D + col0;
          f32x4 gv[2][2];
#pragma unroll
          for (int bj = 0; bj < 2; ++bj)
#pragma unroll
              for (int n = 0; n < 2; ++n) gv[bj][n] = *(const f32x4*)(gp + bj * HALF + n * 16);
#pragma unroll
          for (int ai = 0; ai < 2; ++ai)
#pragma unroll
              for (int mp = 0; mp < 4; mp += 2) { f32x4 xr[2][2][2];
#pragma unroll
                  for (int mm = 0; mm < 2; ++mm) { const float* srow = S + (size_t)(row0 + ai * HALF + (mp + mm) * 16) * D + col0;
#pragma unroll
                      for (int bj = 0; bj < 2; ++bj)
#pragma unroll
                          for (int n = 0; n < 2; ++n) xr[mm][bj][n] = *(const f32x4*)(srow + bj * HALF + n * 16); }
#pragma unroll
                  for (int mm = 0; mm < 2; ++mm) { const int m = mp + mm; float* rowp = X + (size_t)(row0 + ai * HALF + m * 16) * D + col0;
#pragma unroll
                      for (int bj = 0; bj < 2; ++bj)
#pragma unroll
                          for (int n = 0; n < 2; ++n) { const f32x4 xn = xr[mm][bj][n] + gv[bj][n] * acc[ai][bj][m][n]; acc[ai][bj][m][n] = xn;
                              if (!fuse || H) *(f32x4*)(rowp + bj * HALF + n * 16) = xn; } }
                  asm volatile("" ::: "memory"); } }
        if (!fuse) return;
        PG8_LAS float* red = (PG8_LAS float*)(lds + NX_LDS); PG8_LAS float* rsl = red + 1024;
#pragma unroll
        for (int ai = 0; ai < 2; ++ai)
#pragma unroll
            for (int m = 0; m < 4; ++m) { float sacc = 0.f;
#pragma unroll
                for (int bj = 0; bj < 2; ++bj)
#pragma unroll
                    for (int n = 0; n < 2; ++n) { const f32x4 v = acc[ai][bj][m][n]; sacc += (v[0] * v[0] + v[1] * v[1]) + (v[2] * v[2] + v[3] * v[3]); }
                sacc += __shfl_xor(sacc, 16); sacc += __shfl_xor(sacc, 32);
                if (fq == 0) red[(ai * HALF + wr * 64 + m * 16 + fr) * 4 + wc] = sacc; }
        __syncthreads();
        unsigned* flags = (unsigned*)ctlb + CW_NX; float* exch = (float*)(ctlb + NX_EXCH_BYTE);
        float mine = 0.f;
        if (tid < BM) { const f32x4 r4 = *(const PG8_LAS f32x4*)(red + tid * 4); mine = (r4[0] + r4[1]) + (r4[2] + r4[3]);
            float* gp = exch + ((size_t)(u.pm * 4 + u.pn) * BM + tid);
            asm volatile("global_store_dword %0, %1, off sc1" :: "v"(gp), "v"(mine) : "memory"); }
        asm volatile("s_waitcnt vmcnt(0)" ::: "memory");
        __syncthreads();
        if (tid == 0) {
            __hip_atomic_store(flags + (u.pm * 4 + u.pn) * CW_NX_STRIDE, epoch, __ATOMIC_RELAXED, __HIP_MEMORY_SCOPE_AGENT);
            unsigned* tmo = (unsigned*)ctlb + 4096 + 128;
#pragma unroll 1
            for (int q = 0; q < 4; ++q) { if (q == u.pn) continue; unsigned sp = 0;
                while (__hip_atomic_load(flags + (u.pm * 4 + q) * CW_NX_STRIDE, __ATOMIC_RELAXED, __HIP_MEMORY_SCOPE_AGENT) < epoch) { __builtin_amdgcn_s_sleep(1);
                    if ((++sp & 255u) == 0u) { if (__hip_atomic_load(tmo, __ATOMIC_RELAXED, __HIP_MEMORY_SCOPE_AGENT)) break; if (sp > (1u << 18)) { atomicAdd(tmo, 1u); break; } } } }
            __builtin_amdgcn_fence(__ATOMIC_ACQUIRE, "agent");
        }
        asm volatile("s_waitcnt vmcnt(0)" ::: "memory");
        __syncthreads();
        if (tid < BM) { float tot = mine;
#pragma unroll
            for (int q = 0; q < 4; ++q) if (q != u.pn) tot += exch[(size_t)(u.pm * 4 + q) * BM + tid];
            rsl[tid] = 1.0f / sqrtf(tot * (1.0f / D) + 1e-6f); }
        __syncthreads();
        f32x4 g4[2][2], sc4[2][2], sh4[2][2];
#pragma unroll
        for (int bj = 0; bj < 2; ++bj)
#pragma unroll
            for (int n = 0; n < 2; ++n) { const int c = col0 + bj * HALF + n * 16; g4[bj][n] = *(const f32x4*)(ng + c);
                if (nmod) { sh4[bj][n] = *(const f32x4*)(nmod + (size_t)cond * 6 * D + c); sc4[bj][n] = *(const f32x4*)(nmod + (size_t)cond * 6 * D + D + c) + 1.0f; g4[bj][n] = g4[bj][n] * sc4[bj][n]; }
                else sh4[bj][n] = (f32x4){0.f, 0.f, 0.f, 0.f}; }
#pragma unroll
        for (int ai = 0; ai < 2; ++ai)
#pragma unroll
            for (int m = 0; m < 4; ++m) { const int rl = ai * HALF + wr * 64 + m * 16 + fr; const float r = rsl[rl]; const size_t ro = (size_t)(u.pm * BM + rl) * D + col0;
#pragma unroll
                for (int bj = 0; bj < 2; ++bj)
#pragma unroll
                    for (int n = 0; n < 2; ++n) { const f32x4 y = acc[ai][bj][m][n] * r * g4[bj][n] + sh4[bj][n];
                        if (H) { u32x2 pk; pk.x = cvt_pk_bf16(y[0], y[1]); pk.y = cvt_pk_bf16(y[2], y[3]); *(u32x2*)(H + ro + bj * HALF + n * 16) = pk; }
                        else *(f32x4*)(X + ro + bj * HALF + n * 16) = y; } }
    }
};
struct EpiF1 {
    bf16* Hd;
    __device__ __forceinline__ void operator()(const f32x4 (&acc)[2][2][4][2], const Unit& u, int wr, int wc, int fr, int fq) const {
        const int row0 = u.pm * BM + wr * 64 + fr, col0 = u.pn * HALF + wc * 32 + 8 * fq;
#pragma unroll
        for (int ai = 0; ai < 2; ++ai)
#pragma unroll
            for (int m = 0; m < 4; ++m) { bf16* rowp = Hd + (size_t)(row0 + ai * HALF + m * 16) * FF + col0;
                float o[8];
#pragma unroll
                for (int n = 0; n < 2; ++n)
#pragma unroll
                    for (int e = 0; e < 4; ++e) { const float a = acc[ai][0][m][n][e], b = acc[ai][1][m][n][e]; o[n * 4 + e] = a * fsigmoid(a) * b; }
                u32x4 w; w.x = cvt_pk_bf16(o[0], o[1]); w.y = cvt_pk_bf16(o[2], o[3]); w.z = cvt_pk_bf16(o[4], o[5]); w.w = cvt_pk_bf16(o[6], o[7]);
                *(u32x4*)rowp = w; }
    }
};

template <class Epi, class Sched, bool ALIGN_EPI = true, bool SP2 = true>
__device__ __forceinline__ void gemm_phase(PG8_LAS unsigned char* lds, const Gemm g, const Sched& S, const Epi& E) {
    const int tid = threadIdx.x, wid = __builtin_amdgcn_readfirstlane(tid >> 6), lane = tid & 63, wr = wid >> 2, wc = wid & 3, fr = lane & 15, fq = lane >> 4;
    const int K = g.K, nt = K / BK;
    unsigned voffA[2], voffB[2];
#pragma unroll
    for (int i = 0; i < 2; ++i) { int R, C; stage_rc(tid * 16 + i * 8192, R, C);
        voffA[i] = (unsigned)(R * g.lda + C) * 2u; voffB[i] = (unsigned)(R * K + C) * 2u; }
    const size_t kstep = (size_t)(BK * 2);
    const size_t hstepA = (size_t)HALF * g.lda * 2, hstepB = (size_t)HALF * K * 2;
    const size_t tstepA = 2 * hstepA, tstepB = 2 * hstepB;
    const unsigned ldsw = (unsigned)wid * 1024u;
    const int aoff = lds_byte(wr * 64 + fr, fq * 8), boff = lds_byte(wc * 32 + fr, fq * 8);
#define PG8_SA(b, h) (((b) * 2 + (h)) * HTB)
#define PG8_SB(b, h) ((4 + (b) * 2 + (h)) * HTB)
#define PG8_STAGE(bufoff, gbase, voff) do { _Pragma("unroll") for (int _i = 0; _i < 2; ++_i) \
        __builtin_amdgcn_global_load_lds((const unsigned*)((const char*)(gbase) + (voff)[_i]), (PG8_LAS unsigned*)(lds + (bufoff) + ldsw + _i * 8192), 16, 0, 0); } while (0)
#define PG8_LDA(dst, b, h) do { _Pragma("unroll") for (int m = 0; m < 4; ++m) _Pragma("unroll") for (int k = 0; k < 2; ++k) dst[m][k] = *(const PG8_LAS bf16x8*)(lds + PG8_SA(b, h) + aoff + m * 2048 + k * 1024); } while (0)
#define PG8_LDB(dst, b, h) do { _Pragma("unroll") for (int n = 0; n < 2; ++n) _Pragma("unroll") for (int k = 0; k < 2; ++k) dst[n][k] = *(const PG8_LAS bf16x8*)(lds + PG8_SB(b, h) + boff + n * 2048 + k * 1024); } while (0)
#define PG8_MMA(ai, bj, At, Bt) do { __builtin_amdgcn_s_setprio(1); _Pragma("unroll") for (int m = 0; m < 4; ++m) _Pragma("unroll") for (int n = 0; n < 2; ++n) _Pragma("unroll") for (int k = 0; k < 2; ++k) \
        acc[ai][bj][m][n] = __builtin_amdgcn_mfma_f32_16x16x32_bf16(Bt[n][k], At[m][k], acc[ai][bj][m][n], 0, 0, 0); __builtin_amdgcn_s_setprio(0); } while (0)
#define PG8_WAIT_V(n) asm volatile("s_waitcnt vmcnt(" #n ")" ::: "memory")
#define PG8_WAIT_L(n) asm volatile("s_waitcnt lgkmcnt(" #n ")" ::: "memory")
#define PG8_BAR __builtin_amdgcn_s_barrier()
#define PG8_SCHED __builtin_amdgcn_sched_barrier(0)
    Unit cur, nxt; int ui = 0;
    if (!S.next(0, cur)) return;
    f32x4 acc[2][2][4][2];
#pragma unroll
    for (int a = 0; a < 2; ++a)
#pragma unroll
        for (int b = 0; b < 2; ++b)
#pragma unroll
            for (int m = 0; m < 4; ++m)
#pragma unroll
                for (int n = 0; n < 2; ++n) acc[a][b][m][n] = (f32x4){0.f, 0.f, 0.f, 0.f};
    bf16x8 At[4][2], B0[2][2], B1[2][2];
    const char* cA = (const char*)g.A + (size_t)cur.pm * tstepA + (size_t)cur.aoff * 2; const char* cB = (const char*)g.Bt + (size_t)cur.pn * tstepB;
    if constexpr (SP2) {
        PG8_STAGE(PG8_SB(0, 0), cB, voffB); PG8_STAGE(PG8_SB(0, 1), cB + hstepB, voffB); PG8_STAGE(PG8_SA(0, 0), cA, voffA); PG8_STAGE(PG8_SA(0, 1), cA + hstepA, voffA);
        if (wr == 1) PG8_BAR;
        PG8_WAIT_V(2); PG8_BAR;
        PG8_STAGE(PG8_SB(1, 0), cB + kstep, voffB); PG8_STAGE(PG8_SA(1, 0), cA + kstep, voffA); PG8_STAGE(PG8_SB(1, 1), cB + hstepB + kstep, voffB);
        PG8_WAIT_V(6); PG8_BAR;
    } else {
        PG8_STAGE(PG8_SB(0, 0), cB, voffB); PG8_STAGE(PG8_SA(0, 0), cA, voffA); PG8_STAGE(PG8_SB(0, 1), cB + hstepB, voffB); PG8_STAGE(PG8_SA(0, 1), cA + hstepA, voffA);
        if (wr == 1) PG8_BAR;
        PG8_WAIT_V(4); PG8_BAR;
        PG8_STAGE(PG8_SB(1, 0), cB + kstep, voffB); PG8_STAGE(PG8_SA(1, 0), cA + kstep, voffA); PG8_STAGE(PG8_SB(1, 1), cB + hstepB + kstep, voffB);
        PG8_WAIT_V(6); PG8_BAR;
    }
    for (;;) {
        const bool has_next = S.next(ui + 1, nxt);
        const char* nA = has_next ? (const char*)g.A + (size_t)nxt.pm * tstepA + (size_t)nxt.aoff * 2 : cA; const char* nB = has_next ? (const char*)g.Bt + (size_t)nxt.pn * tstepB : cB;
        for (int t = 0; t < nt; t += 2) {
            const bool last = (t == nt - 2);
            const char* a1 = cA + (size_t)(t + 1) * kstep;
            const char* a2 = last ? nA : cA + (size_t)(t + 2) * kstep; const char* b2 = last ? nB : cB + (size_t)(t + 2) * kstep;
            const char* a3 = a2 + kstep; const char* b3 = b2 + kstep;
            if constexpr (SP2) {
            PG8_LDB(B0, 0, 0); PG8_LDB(B1, 0, 1); PG8_SCHED; PG8_LDA(At, 0, 0); PG8_STAGE(PG8_SA(1, 1), a1 + hstepA, voffA);
            PG8_WAIT_V(8); PG8_WAIT_L(0); PG8_BAR; PG8_MMA(0, 0, At, B0); PG8_MMA(0, 1, At, B1); PG8_BAR; PG8_SCHED;
            PG8_LDA(At, 0, 1); PG8_STAGE(PG8_SB(0, 0), b2, voffB); PG8_STAGE(PG8_SB(0, 1), b2 + hstepB, voffB); PG8_STAGE(PG8_SA(0, 0), a2, voffA);
            PG8_WAIT_V(8); PG8_WAIT_L(0); PG8_BAR; PG8_MMA(1, 0, At, B0); PG8_MMA(1, 1, At, B1); PG8_BAR; PG8_SCHED;
            PG8_LDB(B0, 1, 0); PG8_LDB(B1, 1, 1); PG8_SCHED; PG8_LDA(At, 1, 0); PG8_STAGE(PG8_SA(0, 1), a2 + hstepA, voffA);
            PG8_WAIT_V(8); PG8_WAIT_L(0); PG8_BAR; PG8_MMA(0, 0, At, B0); PG8_MMA(0, 1, At, B1); PG8_BAR; PG8_SCHED;
            PG8_LDA(At, 1, 1); PG8_STAGE(PG8_SB(1, 0), b3, voffB); PG8_STAGE(PG8_SB(1, 1), b3 + hstepB, voffB); PG8_STAGE(PG8_SA(1, 0), a3, voffA);
            PG8_WAIT_V(8); PG8_WAIT_L(0); PG8_BAR; PG8_MMA(1, 0, At, B0); PG8_MMA(1, 1, At, B1); PG8_BAR; PG8_SCHED;
            } else {
            PG8_LDB(B0, 0, 0); PG8_SCHED; PG8_LDA(At, 0, 0); PG8_STAGE(PG8_SA(1, 1), a1 + hstepA, voffA);
            PG8_WAIT_L(8); PG8_BAR; PG8_WAIT_L(0); PG8_MMA(0, 0, At, B0); PG8_BAR; PG8_SCHED;
            PG8_LDB(B1, 0, 1); PG8_STAGE(PG8_SB(0, 0), b2, voffB);
            PG8_BAR; PG8_WAIT_L(0); PG8_MMA(0, 1, At, B1); PG8_BAR;
            PG8_LDA(At, 0, 1); PG8_STAGE(PG8_SA(0, 0), a2, voffA);
            PG8_BAR; PG8_WAIT_L(0); PG8_MMA(1, 0, At, B0); PG8_BAR; PG8_SCHED;
            PG8_STAGE(PG8_SB(0, 1), b2 + hstepB, voffB);
            PG8_WAIT_V(6); PG8_BAR; PG8_MMA(1, 1, At, B1); PG8_BAR;
            PG8_LDB(B0, 1, 0); PG8_SCHED; PG8_LDA(At, 1, 0); PG8_STAGE(PG8_SA(0, 1), a2 + hstepA, voffA);
            PG8_WAIT_L(8); PG8_BAR; PG8_WAIT_L(0); PG8_MMA(0, 0, At, B0); PG8_BAR; PG8_SCHED;
            PG8_LDB(B1, 1, 1); PG8_STAGE(PG8_SB(1, 0), b3, voffB);
            PG8_BAR; PG8_WAIT_L(0); PG8_MMA(0, 1, At, B1); PG8_BAR;
            PG8_LDA(At, 1, 1); PG8_STAGE(PG8_SA(1, 0), a3, voffA);
            PG8_BAR; PG8_WAIT_L(0); PG8_MMA(1, 0, At, B0); PG8_BAR; PG8_SCHED;
            PG8_STAGE(PG8_SB(1, 1), b3 + hstepB, voffB);
            PG8_WAIT_V(6); PG8_BAR; PG8_MMA(1, 1, At, B1); PG8_BAR;
            }
        }
        if constexpr (ALIGN_EPI) { if (wr == 0) PG8_BAR; }
        E(acc, cur, wr, wc, fr, fq);
        if (!has_next) break;
#pragma unroll
        for (int a = 0; a < 2; ++a)
#pragma unroll
            for (int b = 0; b < 2; ++b)
#pragma unroll
                for (int m = 0; m < 4; ++m)
#pragma unroll
                    for (int n = 0; n < 2; ++n) acc[a][b][m][n] = (f32x4){0.f, 0.f, 0.f, 0.f};
        cur = nxt; cA = nA; cB = nB; ++ui;
        if constexpr (ALIGN_EPI) { if (wr == 1) PG8_BAR; }
    }
    PG8_WAIT_V(0);
    if constexpr (!ALIGN_EPI) { if (wr == 0) PG8_BAR; }
    PG8_BAR;
#undef PG8_SA
#undef PG8_SB
#undef PG8_STAGE
#undef PG8_LDA
#undef PG8_LDB
#undef PG8_MMA
#undef PG8_WAIT_V
#undef PG8_WAIT_L
#undef PG8_BAR
#undef PG8_SCHED
}
}


#define LDS_BARRIER() do { asm volatile("s_waitcnt lgkmcnt(0)" ::: "memory"); __builtin_amdgcn_s_barrier(); asm volatile("" ::: "memory"); } while (0)
namespace ml {
#define LAS __attribute__((address_space(3)))
typedef short bf16x8 __attribute__((ext_vector_type(8)));
typedef float f32x4 __attribute__((ext_vector_type(4)));
typedef unsigned u32x4 __attribute__((ext_vector_type(4)));
constexpr int NVB = 4, EV = MD / NVB;
constexpr int PQ = 272, PT = 144;
constexpr int L_QS = 0, L_KS = L_QS + 64 * PQ, L_KT = L_KS + 64 * PQ, L_VT = L_KT + 128 * PT, L_SB = L_VT + 48 * PT, L_CT = L_SB + 64 * PT,
              L_HS = L_CT + 48 * PQ, L_SC = L_HS + 64 * 80, L_END = L_SC + 4096;
static_assert(L_END <= 131072, "mLSTM LDS map");
enum { SC_A = 0, SC_PM = 64, SC_WI = 128, SC_EMT = 192, SC_WE = 256, SC_DEN = 320, SC_MISC = 384 };
__device__ __forceinline__ f32x4 mma(bf16x8 a, bf16x8 b, f32x4 c) { return __builtin_amdgcn_mfma_f32_16x16x32_bf16(a, b, c, 0, 0, 0); }
__device__ __forceinline__ bf16x8 frag(LAS unsigned char* lds, int base, int pitch, int row0, int k0, int lane) {
    return *(const LAS bf16x8*)(lds + base + (row0 + (lane & 15)) * pitch + (k0 + 8 * (lane >> 4)) * 2);
}
template <int N> __device__ __forceinline__ float dpp_row_shr(float x, float ident) {
    return __builtin_bit_cast(float, __builtin_amdgcn_update_dpp(__builtin_bit_cast(int, ident), __builtin_bit_cast(int, x), 0x110 + N, 0xf, 0xf, false));
}
__device__ __forceinline__ float lane_get(float x, int l) { return __builtin_bit_cast(float, __builtin_amdgcn_readlane(__builtin_bit_cast(int, x), l)); }
__device__ __forceinline__ float wave_scan_add(float x, int lane) {
    x += dpp_row_shr<1>(x, 0.f); x += dpp_row_shr<2>(x, 0.f); x += dpp_row_shr<4>(x, 0.f); x += dpp_row_shr<8>(x, 0.f);
    const float t0 = lane_get(x, 15), t1 = lane_get(x, 31), t2 = lane_get(x, 47); const int row = lane >> 4;
    return x + ((row >= 1 ? t0 : 0.f) + (row >= 2 ? t1 : 0.f) + (row >= 3 ? t2 : 0.f));
}
__device__ __forceinline__ float wave_scan_max(float x, int lane) {
    constexpr float NI = -3.0e38f;
    x = fmaxf(x, dpp_row_shr<1>(x, NI)); x = fmaxf(x, dpp_row_shr<2>(x, NI)); x = fmaxf(x, dpp_row_shr<4>(x, NI)); x = fmaxf(x, dpp_row_shr<8>(x, NI));
    const float t0 = lane_get(x, 15), t1 = lane_get(x, 31), t2 = lane_get(x, 47); const int row = lane >> 4;
    return fmaxf(fmaxf(x, row >= 1 ? t0 : NI), fmaxf(row >= 2 ? t1 : NI, row >= 3 ? t2 : NI));
}
__device__ __forceinline__ void mlstm_item(LAS unsigned char* lds, CParams& P, int l, int s, int head, int dir, int vb) {
    const int tid = threadIdx.x, w = __builtin_amdgcn_readfirstlane(tid >> 6), lane = tid & 63, fr = lane & 15, fq = lane >> 4;
    const int rt = w & 3, half = w >> 2;
    const SeqInfo q = seqinfo(s); const int nchunk = q.T / 64;
    const bf16* QK = WSP(bf16, WS_QKC); bf16* U = WSP(bf16, WS_U1);
    LAS float* SC = (LAS float*)(lds + L_SC);
    f32x4 cacc[3];
    float m_prev;
    if (!q.grid) { cacc[0] = cacc[1] = cacc[2] = (f32x4){0.f, 0.f, 0.f, 0.f}; m_prev = 0.f; }
    else {
        const size_t sb = (((size_t)q.b * DEPTH + l) * 2 + dir) * MH + head; const int d = 16 * w + fr;
#pragma unroll
        for (int et = 0; et < 2; ++et)
#pragma unroll
            for (int r = 0; r < 4; ++r) cacc[et][r] = P.in[ST_C][(sb * 128 + d) * 128 + vb * EV + 16 * et + 4 * fq + r];
        cacc[2] = (f32x4){0.f, 0.f, 0.f, 0.f}; if (fq == 0) cacc[2][0] = P.in[ST_N][sb * 128 + d];
        m_prev = P.in[ST_M][sb];
    }
    const float bi = P.in[M_GATE_B][(size_t)l * 4 * MH + (2 * dir) * MH + head], bfg = P.in[M_GATE_B][(size_t)l * 4 * MH + (2 * dir + 1) * MH + head];
    for (int i = tid; i < 16 * 64; i += 512) { const int r = i >> 6, c = i & 63; *(LAS bf16*)(lds + L_VT + (32 + r) * PT + c * 2) = (r == 0) ? (bf16)0x3f80 : (bf16)0; }
    u32x4 pqk[4]; u32x4 pv; bf16 pgi = 0, pgf = 0;
#define ML_TOK(c, j) ((size_t)(q.base + (dir ? q.T - 1 - ((c) * 64 + (j)) : ((c) * 64 + (j)))))
#define ML_PREFETCH(c) do { _Pragma("unroll") for (int i = 0; i < 4; ++i) { const int id = tid + 512 * i, j = id >> 5, pc = id & 31; \
            pqk[i] = *(const u32x4*)(QK + ML_TOK(c, j) * (2 * MW) + (pc < 16 ? head * 128 + 8 * pc : MW + head * 128 + 8 * (pc - 16))); } \
        if (tid < 256) { const int j = tid >> 2, pc = tid & 3; pv = *(const u32x4*)(U + ML_TOK(c, j) * PU + OFF_V + head * 128 + vb * EV + 8 * pc); } \
        if (w == 0) { const bf16* g = U + ML_TOK(c, lane) * PU + OFF_G; pgi = g[(2 * dir) * MH + head]; pgf = g[(2 * dir + 1) * MH + head]; } } while (0)
    ML_PREFETCH(0);
    for (int c = 0; c < nchunk; ++c) {
#pragma unroll
        for (int i = 0; i < 4; ++i) { const int id = tid + 512 * i, j = id >> 5, pc = id & 31;
            *(LAS u32x4*)(lds + (pc < 16 ? L_QS : L_KS) + j * PQ + (pc & 15) * 16) = pqk[i]; }
        if (tid < 256) { const int j = tid >> 2, pc = tid & 3; const unsigned wv[4] = {pv.x, pv.y, pv.z, pv.w};
#pragma unroll
            for (int e = 0; e < 8; ++e) *(LAS bf16*)(lds + L_VT + (8 * pc + e) * PT + j * 2) = (bf16)((wv[e >> 1] >> ((e & 1) * 16)) & 0xffffu); }
#pragma unroll
        for (int et = 0; et < 3; ++et)
#pragma unroll
            for (int r = 0; r < 4; ++r) *(LAS bf16*)(lds + L_CT + (16 * et + 4 * fq + r) * PQ + (16 * w + fr) * 2) = f2bf(cacc[et][r]);
        float wie = 1.f;
        if (w == 0) {
            const float gi = bf2f(pgi) + bi, gf = bf2f(pgf) + bfg;
            const float lf = fminf(gf, 0.f) - log1pf(__expf(-fabsf(gf)));
            const float b = wave_scan_add(lf, lane);
            const float a = gi - b; float pm = wave_scan_max(a, lane);
            pm = fmaxf(pm, m_prev);
            const float pm63 = lane_get(pm, 63), b63 = lane_get(b, 63);
            SC[SC_A + lane] = a; SC[SC_PM + lane] = pm; SC[SC_WI + lane] = __expf(m_prev - pm); SC[SC_EMT + lane] = __expf(-(b + pm)); SC[SC_WE + lane] = __expf(a - pm63);
            if (lane == 0) { SC[SC_MISC] = __expf(m_prev - pm63); SC[SC_MISC + 1] = b63 + pm63; }
        }
        LDS_BARRIER();
        if (c + 1 < nchunk) ML_PREFETCH(c + 1);
        wie = SC[SC_MISC]; m_prev = SC[SC_MISC + 1];
#pragma unroll
        for (int i = 0; i < 2; ++i) { const int id = tid + 512 * i, j = id & 63, pc = id >> 6; const float we = SC[SC_WE + j];
            const u32x4 kv = *(const LAS u32x4*)(lds + L_KS + j * PQ + pc * 16); const unsigned wv[4] = {kv.x, kv.y, kv.z, kv.w};
#pragma unroll
            for (int e = 0; e < 8; ++e) { const float kf = __builtin_bit_cast(float, (e & 1) ? (wv[e >> 1] & 0xffff0000u) : (wv[e >> 1] << 16));
                *(LAS bf16*)(lds + L_KT + (8 * pc + e) * PT + j * 2) = f2bf(kf * we); } }
#pragma unroll
        for (int cc = 0; cc < 2; ++cc) { const int ct = 2 * half + cc;
            f32x4 acc = (f32x4){0.f, 0.f, 0.f, 0.f};
            if (ct <= rt) {
#pragma unroll
                for (int k = 0; k < 4; ++k) acc = mma(frag(lds, L_QS, PQ, 16 * rt, 32 * k, lane), frag(lds, L_KS, PQ, 16 * ct, 32 * k, lane), acc);
            }
            const int sp = 16 * ct + fr; const float as = SC[SC_A + sp];
#pragma unroll
            for (int r = 0; r < 4; ++r) { const int t = 16 * rt + 4 * fq + r; const float v = (sp <= t) ? acc[r] * __expf(as - SC[SC_PM + t]) : 0.f;
                *(LAS bf16*)(lds + L_SB + t * PT + sp * 2) = f2bf(v); } }
        LDS_BARRIER();
        f32x4 nacc[2]; const int nct = half ? 1 : 2;
#pragma unroll
        for (int cc = 0; cc < 2; ++cc) { if (cc < nct) { const int ct = half ? 2 : cc;
            f32x4 a1 = (f32x4){0.f, 0.f, 0.f, 0.f}, a2 = (f32x4){0.f, 0.f, 0.f, 0.f};
#pragma unroll
            for (int k = 0; k < 2; ++k) a1 = mma(frag(lds, L_SB, PT, 16 * rt, 32 * k, lane), frag(lds, L_VT, PT, 16 * ct, 32 * k, lane), a1);
#pragma unroll
            for (int k = 0; k < 4; ++k) a2 = mma(frag(lds, L_QS, PQ, 16 * rt, 32 * k, lane), frag(lds, L_CT, PQ, 16 * ct, 32 * k, lane), a2);
#pragma unroll
            for (int r = 0; r < 4; ++r) a1[r] += SC[SC_WI + 16 * rt + 4 * fq + r] * a2[r];
            nacc[cc] = a1; } }
        if (half && fr == 0) {
#pragma unroll
            for (int r = 0; r < 4; ++r) SC[SC_DEN + 16 * rt + 4 * fq + r] = nacc[0][r];
        }
#pragma unroll
        for (int et = 0; et < 3; ++et) { cacc[et] = cacc[et] * wie;
#pragma unroll
            for (int k = 0; k < 2; ++k) cacc[et] = mma(frag(lds, L_VT, PT, 16 * et, 32 * k, lane), frag(lds, L_KT, PT, 16 * w, 32 * k, lane), cacc[et]); }
        LDS_BARRIER();
        if (!half) {
#pragma unroll
            for (int cc = 0; cc < 2; ++cc)
#pragma unroll
                for (int r = 0; r < 4; ++r) { const int t = 16 * rt + 4 * fq + r; const float den = fmaxf(fabsf(SC[SC_DEN + t]), SC[SC_EMT + t]);
                    *(LAS bf16*)(lds + L_HS + t * 80 + (16 * cc + fr) * 2) = f2bf(nacc[cc][r] * __builtin_amdgcn_rcpf(den)); }
        }
        LDS_BARRIER();
        if (tid < 256) { const int j = tid >> 2, pc = tid & 3;
            *(u32x4*)(U + ML_TOK(c, j) * PU + dir * MW + head * 128 + vb * EV + 8 * pc) = *(const LAS u32x4*)(lds + L_HS + j * 80 + pc * 16); }
    }
    if (!q.grid) {
        const size_t sb = (((size_t)q.b * DEPTH + l) * 2 + dir) * MH + head; const int d = 16 * w + fr;
#pragma unroll
        for (int et = 0; et < 2; ++et)
#pragma unroll
            for (int r = 0; r < 4; ++r) P.out[OUT_C + (sb * 128 + d) * 128 + vb * EV + 16 * et + 4 * fq + r] = cacc[et][r];
        if (vb == 0) { if (fq == 0) P.out[OUT_N + sb * 128 + d] = cacc[2][0]; if (tid == 0) P.out[OUT_M + sb] = m_prev; }
    }
    LDS_BARRIER();
#undef ML_TOK
#undef ML_PREFETCH
}
constexpr int M_QS = 0, M_KS = M_QS + 2 * 64 * PQ, M_KT = M_KS + 64 * PQ, M_VT = M_KT + 128 * PT, M_SB = M_VT + 2 * 48 * PT, M_CT = M_SB + 64 * PT, M_HS = M_CT + 48 * PQ, M_SC = M_HS + 64 * 80, M_END = M_SC + 2 * 4096;
static_assert(M_END <= 131072, "pipelined mLSTM LDS map");
__device__ __forceinline__ void mlstm_item2(LAS unsigned char* lds, CParams& P, int l, int s, int head, int dir, int vb) {
    const int tid = threadIdx.x, w = __builtin_amdgcn_readfirstlane(tid >> 6), lane = tid & 63, fr = lane & 15, fq = lane >> 4;
    const int rt = w & 3, half = w >> 2;
    const SeqInfo q = seqinfo(s); const int nchunk = q.T / 64;
    const bf16* QK = WSP(bf16, WS_QKC); bf16* U = WSP(bf16, WS_U1);
    f32x4 cacc[3];
    float m_prev;
    const size_t sb = (((size_t)q.b * DEPTH + l) * 2 + dir) * MH + head;
    if (!q.grid) { cacc[0] = cacc[1] = cacc[2] = (f32x4){0.f, 0.f, 0.f, 0.f}; m_prev = 0.f; }
    else {
        const int d = 16 * w + fr;
#pragma unroll
        for (int et = 0; et < 2; ++et)
#pragma unroll
            for (int r = 0; r < 4; ++r) cacc[et][r] = P.in[ST_C][(sb * 128 + d) * 128 + vb * EV + 16 * et + 4 * fq + r];
        cacc[2] = (f32x4){0.f, 0.f, 0.f, 0.f}; if (fq == 0) cacc[2][0] = P.in[ST_N][sb * 128 + d];
        m_prev = P.in[ST_M][sb];
    }
    const float bi = P.in[M_GATE_B][(size_t)l * 4 * MH + (2 * dir) * MH + head], bfg = P.in[M_GATE_B][(size_t)l * 4 * MH + (2 * dir + 1) * MH + head];
    for (int i = tid; i < 2 * 16 * 64; i += 512) { const int b = i >> 10, r = (i >> 6) & 15, c = i & 63; *(LAS bf16*)(lds + M_VT + b * 48 * PT + (32 + r) * PT + c * 2) = (r == 0) ? (bf16)0x3f80 : (bf16)0; }
    u32x4 pqk[4]; u32x4 pv; bf16 pgi = 0, pgf = 0;
#define ML_TOK(c, j) ((size_t)(q.base + (dir ? q.T - 1 - ((c) * 64 + (j)) : ((c) * 64 + (j)))))
#define ML_PREFETCH(c) do { _Pragma("unroll") for (int i = 0; i < 4; ++i) { const int id = tid + 512 * i, j = id >> 5, pc = id & 31; \
            pqk[i] = *(const u32x4*)(QK + ML_TOK(c, j) * (2 * MW) + (pc < 16 ? head * 128 + 8 * pc : MW + head * 128 + 8 * (pc - 16))); } \
        if (tid < 256) { const int j = tid >> 2, pc = tid & 3; pv = *(const u32x4*)(U + ML_TOK(c, j) * PU + OFF_V + head * 128 + vb * EV + 8 * pc); } \
        if (w == 4) { const bf16* g = U + ML_TOK(c, lane) * PU + OFF_G; pgi = g[(2 * dir) * MH + head]; pgf = g[(2 * dir + 1) * MH + head]; } } while (0)
#define ML_STAGE_A(pb) do { \
        _Pragma("unroll") for (int i = 0; i < 4; ++i) { const int id = tid + 512 * i, j = id >> 5, pc = id & 31; \
            *(LAS u32x4*)(lds + (pc < 16 ? M_QS + (pb) * 64 * PQ : M_KS) + j * PQ + (pc & 15) * 16) = pqk[i]; } \
        if (tid < 256) { const int j = tid >> 2, pc = tid & 3; const unsigned wv[4] = {pv.x, pv.y, pv.z, pv.w}; \
            _Pragma("unroll") for (int e = 0; e < 8; ++e) *(LAS bf16*)(lds + M_VT + (pb) * 48 * PT + (8 * pc + e) * PT + j * 2) = (bf16)((wv[e >> 1] >> ((e & 1) * 16)) & 0xffffu); } \
        if (w == 4) { LAS float* SCn = (LAS float*)(lds + M_SC + (pb) * 4096); \
            const float gi = bf2f(pgi) + bi, gf = bf2f(pgf) + bfg; \
            const float lf = fminf(gf, 0.f) - log1pf(__expf(-fabsf(gf))); \
            const float b = wave_scan_add(lf, lane); \
            const float a = gi - b; float pm = wave_scan_max(a, lane); \
            pm = fmaxf(pm, m_prev); \
            const float pm63 = lane_get(pm, 63), b63 = lane_get(b, 63); \
            SCn[SC_A + lane] = a; SCn[SC_PM + lane] = pm; SCn[SC_WI + lane] = __expf(m_prev - pm); SCn[SC_EMT + lane] = __expf(-(b + pm)); SCn[SC_WE + lane] = __expf(a - pm63); \
            if (lane == 0) SCn[SC_MISC] = __expf(m_prev - pm63); \
            m_prev = b63 + pm63; } } while (0)
#define ML_STAGE_D(pb) do { const LAS float* SCn = (const LAS float*)(lds + M_SC + (pb) * 4096); \
        _Pragma("unroll") for (int i = 0; i < 2; ++i) { const int id = tid + 512 * i, j = id & 63, pc = id >> 6; const float we = SCn[SC_WE + j]; \
            const u32x4 kv = *(const LAS u32x4*)(lds + M_KS + j * PQ + pc * 16); const unsigned wv[4] = {kv.x, kv.y, kv.z, kv.w}; \
            _Pragma("unroll") for (int e = 0; e < 8; ++e) { const float kf = __builtin_bit_cast(float, (e & 1) ? (wv[e >> 1] & 0xffff0000u) : (wv[e >> 1] << 16)); \
                *(LAS bf16*)(lds + M_KT + (8 * pc + e) * PT + j * 2) = f2bf(kf * we); } } \
        _Pragma("unroll") for (int cc = 0; cc < 2; ++cc) { const int ct = 2 * half + cc; \
            f32x4 acc = (f32x4){0.f, 0.f, 0.f, 0.f}; \
            if (ct <= rt) { \
                _Pragma("unroll") for (int k = 0; k < 4; ++k) acc = mma(frag(lds, M_QS + (pb) * 64 * PQ, PQ, 16 * rt, 32 * k, lane), frag(lds, M_KS, PQ, 16 * ct, 32 * k, lane), acc); } \
            const int sp = 16 * ct + fr; const float as = SCn[SC_A + sp]; \
            _Pragma("unroll") for (int r = 0; r < 4; ++r) { const int t = 16 * rt + 4 * fq + r; const float v = (sp <= t) ? acc[r] * __expf(as - SCn[SC_PM + t]) : 0.f; \
                *(LAS bf16*)(lds + M_SB + t * PT + sp * 2) = f2bf(v); } } \
        _Pragma("unroll") for (int et = 0; et < 3; ++et) \
            _Pragma("unroll") for (int r = 0; r < 4; ++r) *(LAS bf16*)(lds + M_CT + (16 * et + 4 * fq + r) * PQ + (16 * w + fr) * 2) = f2bf(cacc[et][r]); } while (0)
#define ML_STORE(c) do { if (tid < 256) { const int j = tid >> 2, pc = tid & 3; \
            *(u32x4*)(U + ML_TOK(c, j) * PU + dir * MW + head * 128 + vb * EV + 8 * pc) = *(const LAS u32x4*)(lds + M_HS + j * 80 + pc * 16); } } while (0)
    ML_PREFETCH(0);
    ML_STAGE_A(0);
    LDS_BARRIER();
    if (nchunk > 1) ML_PREFETCH(1);
    ML_STAGE_D(0);
    LDS_BARRIER();
    for (int c = 0; c < nchunk; ++c) {
        const int pb = c & 1;
        if (c + 1 < nchunk) { ML_STAGE_A(pb ^ 1); if (c + 2 < nchunk) ML_PREFETCH(c + 2); }
        if (c >= 1) ML_STORE(c - 1);
        LAS float* SC = (LAS float*)(lds + M_SC + pb * 4096);
        const float wie = SC[SC_MISC];
        f32x4 nacc[2]; const int nct = half ? 1 : 2;
#pragma unroll
        for (int cc = 0; cc < 2; ++cc) { if (cc < nct) { const int ct = half ? 2 : cc;
            f32x4 a1 = (f32x4){0.f, 0.f, 0.f, 0.f}, a2 = (f32x4){0.f, 0.f, 0.f, 0.f};
#pragma unroll
            for (int k = 0; k < 2; ++k) a1 = mma(frag(lds, M_SB, PT, 16 * rt, 32 * k, lane), frag(lds, M_VT + pb * 48 * PT, PT, 16 * ct, 32 * k, lane), a1);
#pragma unroll
            for (int k = 0; k < 4; ++k) a2 = mma(frag(lds, M_QS + pb * 64 * PQ, PQ, 16 * rt, 32 * k, lane), frag(lds, M_CT, PQ, 16 * ct, 32 * k, lane), a2);
#pragma unroll
            for (int r = 0; r < 4; ++r) a1[r] += SC[SC_WI + 16 * rt + 4 * fq + r] * a2[r];
            nacc[cc] = a1; } }
        if (half && fr == 0) {
#pragma unroll
            for (int r = 0; r < 4; ++r) SC[SC_DEN + 16 * rt + 4 * fq + r] = nacc[0][r];
        }
#pragma unroll
        for (int et = 0; et < 3; ++et) { cacc[et] = cacc[et] * wie;
#pragma unroll
            for (int k = 0; k < 2; ++k) cacc[et] = mma(frag(lds, M_VT + pb * 48 * PT, PT, 16 * et, 32 * k, lane), frag(lds, M_KT, PT, 16 * w, 32 * k, lane), cacc[et]); }
        LDS_BARRIER();
        if (!half) {
#pragma unroll
            for (int cc = 0; cc < 2; ++cc)
#pragma unroll
                for (int r = 0; r < 4; ++r) { const int t = 16 * rt + 4 * fq + r; const float den = fmaxf(fabsf(SC[SC_DEN + t]), SC[SC_EMT + t]);
                    *(LAS bf16*)(lds + M_HS + t * 80 + (16 * cc + fr) * 2) = f2bf(nacc[cc][r] * __builtin_amdgcn_rcpf(den)); }
        }
        if (c + 1 < nchunk) ML_STAGE_D(pb ^ 1);
        LDS_BARRIER();
    }
    ML_STORE(nchunk - 1);
    if (!q.grid) {
        const int d = 16 * w + fr;
#pragma unroll
        for (int et = 0; et < 2; ++et)
#pragma unroll
            for (int r = 0; r < 4; ++r) P.out[OUT_C + (sb * 128 + d) * 128 + vb * EV + 16 * et + 4 * fq + r] = cacc[et][r];
        if (vb == 0) { if (fq == 0) P.out[OUT_N + sb * 128 + d] = cacc[2][0]; if (tid == 256) P.out[OUT_M + sb] = m_prev; }
    }
    LDS_BARRIER();
#undef ML_TOK
#undef ML_PREFETCH
#undef ML_STAGE_A
#undef ML_STAGE_D
#undef ML_STORE
}
constexpr int N_ITEMS = NSEQ * MH * 2 * NVB;
__device__ __forceinline__ void decode_item(int it, int& s, int& head, int& dir, int& vb) {
    vb = it % NVB; int ch = it / NVB; dir = ch & 1; ch >>= 1; head = ch % MH; const int sq = ch / MH;
    s = sq < LB ? CB + sq : sq - LB;
}
}


namespace rw {
typedef short bf16x8 __attribute__((ext_vector_type(8)));
typedef float f32x4 __attribute__((ext_vector_type(4)));
typedef unsigned u32x4 __attribute__((ext_vector_type(4)));
enum { V_A = 0, V_W, V_B, V_K, V_R, NVEC };
constexpr int REC = NVEC * 64 * 4;
constexpr int PT = 144;
constexpr int L_SBUF = 0, L_VT = L_SBUF + 64 * REC, L_TW = L_VT + 64 * 256, L_AL = L_TW + 64 * PT, L_YS = L_AL + 64 * PT, L_INV = L_YS + 64 * 16 * 4, L_END = L_INV + 256;
__device__ __forceinline__ int vt_off(int row, int tt) { return row * 256 + ((tt ^ (((row >> 3) & 7) << 2)) << 2); }
static_assert(L_END <= 131072, "RWKV LDS map");
__device__ __forceinline__ float dpp_xor1(float x) { return __builtin_bit_cast(float, __builtin_amdgcn_update_dpp(0, __builtin_bit_cast(int, x), 0xB1, 0xF, 0xF, true)); }
__device__ __forceinline__ float dpp_xor2(float x) { return __builtin_bit_cast(float, __builtin_amdgcn_update_dpp(0, __builtin_bit_cast(int, x), 0x4E, 0xF, 0xF, true)); }
__device__ __forceinline__ float dpp_ror4(float x) { return __builtin_bit_cast(float, __builtin_amdgcn_update_dpp(0, __builtin_bit_cast(int, x), 0x124, 0xF, 0xF, true)); }
__device__ __forceinline__ float dpp_ror8(float x) { return __builtin_bit_cast(float, __builtin_amdgcn_update_dpp(0, __builtin_bit_cast(int, x), 0x128, 0xF, 0xF, true)); }
__device__ __forceinline__ float allsum16(float x) { x += dpp_xor1(x); x += dpp_xor2(x); x += dpp_ror4(x); x += dpp_ror8(x); return x; }
__device__ __forceinline__ f32x4 cvt_lo4(unsigned a, unsigned b) { return (f32x4){__builtin_bit_cast(float, a << 16), __builtin_bit_cast(float, a & 0xffff0000u), __builtin_bit_cast(float, b << 16), __builtin_bit_cast(float, b & 0xffff0000u)}; }
__device__ __forceinline__ float allsum32(float x) {
    x = allsum16(x);
    float xa = x, xb = x;
    asm volatile("v_mov_b32 %1, %0\n\ts_nop 1\n\tv_permlane32_swap_b32 %0, %1\n\ts_nop 1" : "+v"(xa), "=&v"(xb));
    return xa + xb;
}
__device__ __forceinline__ void rwkv_item(LAS unsigned char* lds, CParams& P, int l, int s, int head, int dir, int rh) {
    const int tid = threadIdx.x, w = __builtin_amdgcn_readfirstlane(tid >> 6), lane = tid & 63, fr = lane & 15, fq = lane >> 4;
    const int rt = w & 3, half = w >> 2, hc = head * 64;
    const SeqInfo q = seqinfo(s); const int nchunk = q.T / 64;
    const bf16* RX = WSP(bf16, WS_RXC); bf16* U = WSP(bf16, WS_U1);
    const int pj = tid >> 3, psub = tid & 7;
    const int hh = lane >> 5, rsel = (lane >> 4) & 1, cg = lane & 15;
    const int row = 16 * rh + 2 * w + rsel, col0 = 32 * hh + 2 * cg;
    typedef float f32x2 __attribute__((ext_vector_type(2)));
    f32x2 S2;
    if (!q.grid) S2 = (f32x2){0.f, 0.f};
    else { const size_t sb = (((size_t)q.b * DEPTH + l) * 2 + dir) * RH + head; S2 = *(const f32x2*)(P.in[ST_R] + (sb * 64 + row) * 64 + col0); }
    float rkk8[8];
#pragma unroll
    for (int e = 0; e < 8; ++e) rkk8[e] = P.in[R_KK][(size_t)l * RW + hc + 8 * psub + e];
    float c_w0[2], c_a0[2], c_kk[2], c_ka[2];
    bf16x8 bw[2][2], ba[2][2];
#pragma unroll
    for (int cc = 0; cc < 2; ++cc) { const int c = 16 * (2 * half + cc) + fr;
        c_w0[cc] = P.in[R_W0][((size_t)l * 2 + dir) * RW + hc + c]; c_a0[cc] = P.in[R_A0][((size_t)l * 2 + dir) * RW + hc + c];
        c_kk[cc] = P.in[R_KK][(size_t)l * RW + hc + c]; c_ka[cc] = P.in[R_KA][(size_t)l * RW + hc + c];
#pragma unroll
        for (int ks = 0; ks < 2; ++ks)
#pragma unroll
            for (int e = 0; e < 8; ++e) { const int j = 32 * ks + 8 * fq + e;
                bw[cc][ks][e] = (short)f2bf(P.in[R_W2][(((size_t)l * 2 + dir) * 64 + j) * RW + hc + c]);
                ba[cc][ks][e] = (short)f2bf(P.in[R_A2][(((size_t)l * 2 + dir) * 64 + j) * RW + hc + c]); } }
    u32x4 pf[5];
#define RW_TOK(c, j) ((size_t)(q.base + (dir ? q.T - 1 - ((c) * 64 + (j)) : ((c) * 64 + (j)))))
#define RW_PREFETCH(c) do { const bf16* rx = RX + RW_TOK(c, pj) * RIN + 8 * psub; \
        pf[0] = *(const u32x4*)(rx + RX_R + hc); pf[1] = *(const u32x4*)(rx + RX_K + hc); pf[2] = *(const u32x4*)(rx + RX_V + hc); \
        pf[3] = *(const u32x4*)(rx + RX_WL + dir * 64); pf[4] = *(const u32x4*)(rx + RX_AL + dir * 64); } while (0)
    RW_PREFETCH(0);
    for (int c = 0; c < nchunk; ++c) {
        { LAS unsigned char* rec = lds + L_SBUF + pj * REC + psub * 32;
          *(LAS f32x4*)(rec + V_R * 256) = cvt_lo4(pf[0].x, pf[0].y); *(LAS f32x4*)(rec + V_R * 256 + 16) = cvt_lo4(pf[0].z, pf[0].w);
          { const f32x4 v0 = cvt_lo4(pf[2].x, pf[2].y), v1 = cvt_lo4(pf[2].z, pf[2].w);
#pragma unroll
            for (int e = 0; e < 4; ++e) { *(LAS float*)(lds + L_VT + vt_off(8 * psub + e, pj)) = v0[e]; *(LAS float*)(lds + L_VT + vt_off(8 * psub + 4 + e, pj)) = v1[e]; } }
          const f32x4 k0 = cvt_lo4(pf[1].x, pf[1].y), k1 = cvt_lo4(pf[1].z, pf[1].w);
          *(LAS f32x4*)(rec + V_K * 256) = k0; *(LAS f32x4*)(rec + V_K * 256 + 16) = k1;
          float ss = 0.f;
#pragma unroll
          for (int e = 0; e < 4; ++e) { const float x0 = k0[e] * rkk8[e], x1 = k1[e] * rkk8[4 + e]; ss += x0 * x0 + x1 * x1; }
          ss += dpp_xor1(ss); ss += dpp_xor2(ss); ss += __shfl_xor(ss, 4);
          if (psub == 0) *(LAS float*)(lds + L_INV + pj * 4) = 1.0f / fmaxf(sqrtf(ss), 1e-12f);
          *(LAS u32x4*)(lds + L_TW + pj * PT + psub * 16) = pf[3]; *(LAS u32x4*)(lds + L_AL + pj * PT + psub * 16) = pf[4]; }
        __syncthreads();
        if (c + 1 < nchunk) RW_PREFETCH(c + 1);
#pragma unroll
        for (int cc = 0; cc < 2; ++cc) { const int ct = 2 * half + cc; const int cidx = 16 * ct + fr;
            f32x4 aw = (f32x4){0.f, 0.f, 0.f, 0.f}, aa = (f32x4){0.f, 0.f, 0.f, 0.f};
#pragma unroll
            for (int ks = 0; ks < 2; ++ks) { aw = ml::mma(ml::frag(lds, L_TW, PT, 16 * rt, 32 * ks, lane), bw[cc][ks], aw); aa = ml::mma(ml::frag(lds, L_AL, PT, 16 * rt, 32 * ks, lane), ba[cc][ks], aa); }
#pragma unroll
            for (int r = 0; r < 4; ++r) { const int tok = 16 * rt + 4 * fq + r; LAS float* rec = (LAS float*)(lds + L_SBUF + tok * REC) + cidx;
                const float decay = __expf(-0.6065306597126334f * pg8::fsigmoid(c_w0[cc] + aw[r])); const float alpha = pg8::fsigmoid(c_a0[cc] + aa[r]);
                const float kraw = rec[V_K * 64]; const float kkn = kraw * c_kk[cc] * *(LAS float*)(lds + L_INV + tok * 4);
                rec[V_A * 64] = -kkn; rec[V_W * 64] = decay; rec[V_B * 64] = kkn * alpha; rec[V_K * 64] = kraw * (1.0f + (alpha - 1.0f) * c_ka[cc]); } }
        __syncthreads();
        {
            const LAS unsigned char* rbase = lds + L_SBUF + col0 * 4;
            f32x2 ca = *(const LAS f32x2*)(rbase + V_A * 256), cw = *(const LAS f32x2*)(rbase + V_W * 256), cb = *(const LAS f32x2*)(rbase + V_B * 256),
                  ck = *(const LAS f32x2*)(rbase + V_K * 256), cr = *(const LAS f32x2*)(rbase + V_R * 256);
#pragma unroll 1
            for (int blk = 0; blk < 4; ++blk) {
                float ykeep = 0.f;
#pragma unroll
                for (int g4 = 0; g4 < 4; ++g4) {
                    const f32x4 v4 = *(const LAS f32x4*)(lds + L_VT + vt_off(row, 16 * blk + 4 * g4));
#pragma unroll
                    for (int i4 = 0; i4 < 4; ++i4) {
                        const int i = 4 * g4 + i4, tt = 16 * blk + i, tn = tt < 63 ? tt + 1 : 63;
                        const LAS unsigned char* rn = rbase + tn * REC;
                        const f32x2 na = *(const LAS f32x2*)(rn + V_A * 256), nw = *(const LAS f32x2*)(rn + V_W * 256), nb = *(const LAS f32x2*)(rn + V_B * 256),
                                    nk = *(const LAS f32x2*)(rn + V_K * 256), nr = *(const LAS f32x2*)(rn + V_R * 256);
                        const float vv = v4[i4];
                        const f32x2 p = S2 * ca;
                        const float sa = allsum32(p.x + p.y);
                        S2 = S2 * cw + ck * vv;
                        S2 = cb * sa + S2;
                        const f32x2 yq = S2 * cr;
                        const float y = allsum32(yq.x + yq.y);
                        ykeep = (cg == i) ? y : ykeep;
                        ca = na; cw = nw; cb = nb; ck = nk; cr = nr;
                    }
                }
                if (hh == 0) *(LAS float*)(lds + L_YS + ((16 * blk + cg) * 16 + 2 * w + rsel) * 4) = ykeep;
            }
        }
        __syncthreads();
        if (tid < 128) { const int j = tid >> 1, pc = tid & 1; const LAS float* ys = (const LAS float*)(lds + L_YS) + j * 16 + 8 * pc;
            u32x4 o; o.x = pg8::cvt_pk_bf16(ys[0], ys[1]); o.y = pg8::cvt_pk_bf16(ys[2], ys[3]); o.z = pg8::cvt_pk_bf16(ys[4], ys[5]); o.w = pg8::cvt_pk_bf16(ys[6], ys[7]);
            *(u32x4*)(U + RW_TOK(c, j) * PU + OFF_R + dir * RW + hc + 16 * rh + 8 * pc) = o; }
    }
    if (!q.grid) { const size_t sb = (((size_t)q.b * DEPTH + l) * 2 + dir) * RH + head; *(f32x2*)(P.out + OUT_S + (sb * 64 + row) * 64 + col0) = S2; }
    __syncthreads();
#undef RW_TOK
#undef RW_PREFETCH
}
constexpr int N_ITEMS = NSEQ * RH * 2 * 4;
__device__ __forceinline__ void decode_item(int it, int& s, int& head, int& dir, int& rh) {
    rh = it & 3; int ch = it >> 2; dir = ch & 1; ch >>= 1; head = ch % RH; const int sq = ch / RH;
    s = sq < LB ? CB + sq : sq - LB;
}
}


namespace wy {
typedef short bf16x8 __attribute__((ext_vector_type(8)));
typedef float f32x4 __attribute__((ext_vector_type(4)));
typedef unsigned u32x4 __attribute__((ext_vector_type(4)));
constexpr int PV = 144, PS = 48, PVS = 136;
constexpr int L_AH = 0, L_RH = L_AH + 64 * PV, L_BT = L_RH + 64 * PV, L_KT = L_BT + 64 * PV, L_NAKT = L_KT + 64 * PV, L_NRKT = L_NAKT + 4 * 16 * PS,
              L_NRBT = L_NRKT + 4 * 16 * PS, L_TT = L_NRBT + 4 * 16 * PS, L_GL = L_TT + 4 * 16 * PS, PACK_BYTES = L_GL + 1024,
              L_VS = PACK_BYTES, L_BH = L_VS + 64 * PV, L_KH = L_BH + 64 * PV, L_YS = L_KH + 64 * PV, L_TW = L_YS + 64 * PV, L_AL = L_TW + 64 * PV, L_NAB = L_AL + 64 * PV, L_INV = L_NAB + 4096, L_END = L_INV + 256;
constexpr int RING = 8, PACK_U = PACK_BYTES / 16, N_LAT = LB * RH * 2, RING_A = 20;
static_assert(PACK_BYTES % 1024 == 0 && PACK_U <= 8 * 512 && (size_t)RING_A * RING * PACK_BYTES <= (size_t)N1P * D * 2 && WS_END + (size_t)(N_LAT - RING_A) * RING * PACK_BYTES <= ((size_t)256 << 20), "ring placement");
static_assert(L_END <= 131072, "WY LDS map");
__device__ __forceinline__ bf16x8 fragk16(LAS unsigned char* lds, int base, int pitch, int row0, int k0, int lane) {
    const bf16x8 v = *(const LAS bf16x8*)(lds + base + (row0 + (lane & 15)) * pitch + (k0 + 8 * ((lane >> 4) & 1)) * 2);
    const bf16x8 z = {0, 0, 0, 0, 0, 0, 0, 0};
    return (lane < 32) ? v : z;
}
__device__ __forceinline__ void stb(LAS unsigned char* lds, int off, float v) { *(LAS bf16*)(lds + off) = f2bf(v); }
typedef unsigned u32x2 __attribute__((ext_vector_type(2)));
__device__ __forceinline__ bf16x8 pack_k16(const f32x4 v) { u32x4 o; o.x = pg8::cvt_pk_bf16(v[0], v[1]); o.y = pg8::cvt_pk_bf16(v[2], v[3]); o.z = 0u; o.w = 0u; return __builtin_bit_cast(bf16x8, o); }
__device__ __forceinline__ bf16x8 pack_k32(const f32x4 a, const f32x4 b) { u32x4 o; o.x = pg8::cvt_pk_bf16(a[0], a[1]); o.y = pg8::cvt_pk_bf16(a[2], a[3]); o.z = pg8::cvt_pk_bf16(b[0], b[1]); o.w = pg8::cvt_pk_bf16(b[2], b[3]);
    return __builtin_bit_cast(bf16x8, o); }
__device__ __forceinline__ bf16x8 ld_k16(LAS unsigned char* lds, int base, int pitch, int row0, int col0, int lane) {
    const u32x2 v = *(const LAS u32x2*)(lds + base + (row0 + (lane & 15)) * pitch + (col0 + 4 * (lane >> 4)) * 2); u32x4 o; o.x = v.x; o.y = v.y; o.z = 0u; o.w = 0u; return __builtin_bit_cast(bf16x8, o); }
__device__ __forceinline__ bf16x8 ld_k32(LAS unsigned char* lds, int base, int pitch, int row0, int col0, int lane) {
    const LAS unsigned char* p = lds + base + (row0 + (lane & 15)) * pitch + (col0 + 4 * (lane >> 4)) * 2;
    const u32x2 v0 = *(const LAS u32x2*)p, v1 = *(const LAS u32x2*)(p + 32); u32x4 o; o.x = v0.x; o.y = v0.y; o.z = v1.x; o.w = v1.y; return __builtin_bit_cast(bf16x8, o); }
__device__ __forceinline__ void rwkv_item(LAS unsigned char* lds, CParams& P, int l, int s, int head, int dir) {
    const int tid = threadIdx.x, w = __builtin_amdgcn_readfirstlane(tid >> 6), lane = tid & 63, fr = lane & 15, fq = lane >> 4;
    const int rt = w & 3, half = w >> 2, hc = head * 64;
    const SeqInfo q = seqinfo(s); const int nchunk = q.T / 64;
    const bf16* RX = WSP(bf16, WS_RXC); bf16* U = WSP(bf16, WS_U1);
    const int pj = tid >> 3, psub = tid & 7;
    f32x4 sacc[4];
#pragma unroll
    for (int ct = 0; ct < 4; ++ct) sacc[ct] = (f32x4){0.f, 0.f, 0.f, 0.f};
    if (w < 4 && q.grid) { const size_t sb = (((size_t)q.b * DEPTH + l) * 2 + dir) * RH + head;
#pragma unroll
        for (int ct = 0; ct < 4; ++ct) sacc[ct] = *(const f32x4*)(P.in[ST_R] + (sb * 64 + 16 * w + fr) * 64 + 16 * ct + 4 * fq); }
    float rkk8[8];
#pragma unroll
    for (int e = 0; e < 8; ++e) rkk8[e] = P.in[R_KK][(size_t)l * RW + hc + 8 * psub + e];
    float c_w0[2], c_a0[2], c_kk[2], c_ka[2];
#pragma unroll
    for (int cc = 0; cc < 2; ++cc) { const int c = 16 * (2 * half + cc) + fr;
        c_w0[cc] = P.in[R_W0][((size_t)l * 2 + dir) * RW + hc + c]; c_a0[cc] = P.in[R_A0][((size_t)l * 2 + dir) * RW + hc + c];
        c_kk[cc] = P.in[R_KK][(size_t)l * RW + hc + c]; c_ka[cc] = P.in[R_KA][(size_t)l * RW + hc + c]; }
    const bf16* w2t = WSP(bf16, O_W2T) + ((size_t)dir * RW + hc) * 64; const bf16* a2t = WSP(bf16, O_A2T) + ((size_t)dir * RW + hc) * 64;
    u32x4 pf[5];
#define WY_TOK(c, j) ((size_t)(q.base + (dir ? q.T - 1 - ((c) * 64 + (j)) : ((c) * 64 + (j)))))
#define WY_PREFETCH(c) do { const bf16* rx = RX + WY_TOK(c, pj) * RIN + 8 * psub; \
        pf[0] = *(const u32x4*)(rx + RX_R + hc); pf[1] = *(const u32x4*)(rx + RX_K + hc); pf[2] = *(const u32x4*)(rx + RX_V + hc); \
        pf[3] = *(const u32x4*)(rx + RX_WL + dir * 64); pf[4] = *(const u32x4*)(rx + RX_AL + dir * 64); } while (0)
    WY_PREFETCH(0);
    for (int c = 0; c < nchunk; ++c) {
        { *(LAS u32x4*)(lds + L_RH + pj * PV + psub * 16) = pf[0]; *(LAS u32x4*)(lds + L_KH + pj * PV + psub * 16) = pf[1];
          const unsigned kw[4] = {pf[1].x, pf[1].y, pf[1].z, pf[1].w}, vw[4] = {pf[2].x, pf[2].y, pf[2].z, pf[2].w};
          float ss = 0.f;
#pragma unroll
          for (int e = 0; e < 8; ++e) { const float kf = __builtin_bit_cast(float, (e & 1) ? (kw[e >> 1] & 0xffff0000u) : (kw[e >> 1] << 16)) * rkk8[e]; ss += kf * kf;
              *(LAS bf16*)(lds + L_VS + (8 * psub + e) * PVS + pj * 2) = (bf16)((vw[e >> 1] >> ((e & 1) * 16)) & 0xffffu); }
          ss += rw::dpp_xor1(ss); ss += rw::dpp_xor2(ss); ss += __shfl_xor(ss, 4);
          if (psub == 0) *(LAS float*)(lds + L_INV + pj * 4) = 1.0f / fmaxf(sqrtf(ss), 1e-12f);
          *(LAS u32x4*)(lds + L_TW + pj * PV + psub * 16) = pf[3]; *(LAS u32x4*)(lds + L_AL + pj * PV + psub * 16) = pf[4]; }
        LDS_BARRIER();
        if (c + 1 < nchunk) WY_PREFETCH(c + 1);
#pragma unroll
        for (int cc = 0; cc < 2; ++cc) { const int ct = 2 * half + cc; const int cidx = 16 * ct + fr;
            f32x4 aw = (f32x4){0.f, 0.f, 0.f, 0.f}, aa = (f32x4){0.f, 0.f, 0.f, 0.f};
#pragma unroll
            for (int ks = 0; ks < 2; ++ks) { const size_t bo = (size_t)cidx * 64 + 32 * ks + 8 * fq;
                aw = ml::mma(ml::frag(lds, L_TW, PV, 16 * rt, 32 * ks, lane), *(const bf16x8*)(w2t + bo), aw); aa = ml::mma(ml::frag(lds, L_AL, PV, 16 * rt, 32 * ks, lane), *(const bf16x8*)(a2t + bo), aa); }
            float kr4[4], rr4[4], iv4[4];
#pragma unroll
            for (int r = 0; r < 4; ++r) { const int tok = 16 * rt + 4 * fq + r; kr4[r] = bf2f(*(const LAS bf16*)(lds + L_KH + tok * PV + cidx * 2)); rr4[r] = bf2f(*(const LAS bf16*)(lds + L_RH + tok * PV + cidx * 2));
                iv4[r] = *(const LAS float*)(lds + L_INV + tok * 4); }
            float lw[4], cum[4];
#pragma unroll
            for (int r = 0; r < 4; ++r) { lw[r] = -0.6065306597126334f * pg8::fsigmoid(c_w0[cc] + aw[r]); cum[r] = (r ? cum[r - 1] : 0.f) + lw[r]; }
            const float tot = cum[3]; const float p1 = __shfl_up(tot, 16), p2 = __shfl_up(tot, 32), p3 = __shfl_up(tot, 48);
            const float off = (fq >= 1 ? p1 : 0.f) + (fq >= 2 ? p2 : 0.f) + (fq >= 3 ? p3 : 0.f);
            float gprev = __expf(off);
#pragma unroll
            for (int r = 0; r < 4; ++r) { const int tok = 16 * rt + 4 * fq + r; const float lam = off + cum[r]; const float g = __expf(lam), gi = __builtin_amdgcn_rcpf(g);
                const float alpha = pg8::fsigmoid(c_a0[cc] + aa[r]);
                const float kraw = kr4[r], rraw = rr4[r];
                const float kkn = kraw * c_kk[cc] * iv4[r];
                const bf16 bh = f2bf(kkn * alpha * gi), kh = f2bf(kraw * (1.0f + (alpha - 1.0f) * c_ka[cc]) * gi);
                stb(lds, L_AH + tok * PV + cidx * 2, -kkn * gprev); stb(lds, L_RH + tok * PV + cidx * 2, rraw * g);
                *(LAS bf16*)(lds + L_BH + tok * PV + cidx * 2) = bh; *(LAS bf16*)(lds + L_KH + tok * PV + cidx * 2) = kh;
                *(LAS bf16*)(lds + L_BT + cidx * PV + tok * 2) = bh; *(LAS bf16*)(lds + L_KT + cidx * PV + tok * 2) = kh;
                if (fq == 3 && r == 3) *(LAS float*)(lds + L_GL + (rt * 64 + cidx) * 4) = g;
                gprev = g; } }
        LDS_BARRIER();
        { const int sc = w >> 1, side = w & 1; f32x4 gB = (f32x4){0.f, 0.f, 0.f, 0.f}, gK = (f32x4){0.f, 0.f, 0.f, 0.f};
#pragma unroll
          for (int ks = 0; ks < 2; ++ks) { const bf16x8 af = ml::frag(lds, side ? L_RH : L_AH, PV, 16 * sc, 32 * ks, lane);
              gB = ml::mma(af, ml::frag(lds, L_BH, PV, 16 * sc, 32 * ks, lane), gB); gK = ml::mma(af, ml::frag(lds, L_KH, PV, 16 * sc, 32 * ks, lane), gK); }
#pragma unroll
          for (int r = 0; r < 4; ++r) { const int t = 4 * fq + r; const bool keep = side ? (fr <= t) : (fr < t); const float vB = keep ? gB[r] : 0.f, vK = keep ? gK[r] : 0.f;
              if (side == 0) { *(LAS float*)(lds + L_NAB + ((sc * 16 + t) * 16 + fr) * 4) = vB; stb(lds, L_NAKT + (sc * 16 + t) * PS + fr * 2, vK); }
              else { stb(lds, L_NRBT + (sc * 16 + t) * PS + fr * 2, vB); stb(lds, L_NRKT + (sc * 16 + t) * PS + fr * 2, vK); } } }
        if ((w & 1) == 0 && lane < 16) { const int sc = w >> 1; float Tr[16];
            asm volatile("" ::: "memory");
#pragma unroll
            for (int ph = 0; ph < 4; ++ph) { f32x4 nv[4][4];
#pragma unroll
                for (int tq = 0; tq < 4; ++tq)
#pragma unroll
                    for (int u4 = 0; u4 <= ph; ++u4) nv[tq][u4] = *(const LAS f32x4*)(lds + L_NAB + ((sc * 16 + 4 * ph + tq) * 16 + 4 * u4) * 4);
#pragma unroll
                for (int tq = 0; tq < 4; ++tq) { const int t = 4 * ph + tq; float x0 = (lane == t) ? 1.f : 0.f, x1 = 0.f;
#pragma unroll
                    for (int u = 0; u < 16; ++u) if (u < t) { if (u & 1) x1 += Tr[u] * nv[tq][u >> 2][u & 3]; else x0 += Tr[u] * nv[tq][u >> 2][u & 3]; }
                    Tr[t] = x0 + x1; stb(lds, L_TT + (sc * 16 + t) * PS + lane * 2, Tr[t]); } } }
        LDS_BARRIER();
        if (w < 4) {
#pragma unroll 1
            for (int sc = 0; sc < 4; ++sc) {
                const bf16x8 ah0 = ld_k32(lds, L_AH, PV, 16 * sc, 0, lane), ah1 = ld_k32(lds, L_AH, PV, 16 * sc, 32, lane), rh0 = ld_k32(lds, L_RH, PV, 16 * sc, 0, lane), rh1 = ld_k32(lds, L_RH, PV, 16 * sc, 32, lane);
                const bf16x8 nak = ld_k16(lds, L_NAKT, PS, 16 * sc, 0, lane), nrk = ld_k16(lds, L_NRKT, PS, 16 * sc, 0, lane), ttf = ld_k16(lds, L_TT, PS, 16 * sc, 0, lane), nrb = ld_k16(lds, L_NRBT, PS, 16 * sc, 0, lane);
                const bf16x8 vsf = ld_k16(lds, L_VS, PVS, 16 * w, 16 * sc, lane);
                bf16x8 btf[4], ktf[4]; f32x4 glv[4];
#pragma unroll
                for (int ct = 0; ct < 4; ++ct) { btf[ct] = ld_k16(lds, L_BT, PV, 16 * ct, 16 * sc, lane); ktf[ct] = ld_k16(lds, L_KT, PV, 16 * ct, 16 * sc, lane);
                    glv[ct] = *(const LAS f32x4*)(lds + L_GL + (sc * 64 + 16 * ct + 4 * fq) * 4); }
                const bf16x8 sb0 = pack_k32(sacc[0], sacc[1]), sb1 = pack_k32(sacc[2], sacc[3]);
                f32x4 XT = (f32x4){0.f, 0.f, 0.f, 0.f}, YT = (f32x4){0.f, 0.f, 0.f, 0.f};
                XT = ml::mma(ah0, sb0, XT); XT = ml::mma(ah1, sb1, XT); XT = ml::mma(nak, vsf, XT);
                YT = ml::mma(rh0, sb0, YT); YT = ml::mma(rh1, sb1, YT); YT = ml::mma(nrk, vsf, YT);
                f32x4 UT = (f32x4){0.f, 0.f, 0.f, 0.f};
                UT = ml::mma(ttf, pack_k16(XT), UT);
                const bf16x8 ub = pack_k16(UT);
                YT = ml::mma(nrb, ub, YT);
#pragma unroll
                for (int r = 0; r < 4; ++r) stb(lds, L_YS + (16 * sc + 4 * fq + r) * PV + (16 * w + fr) * 2, YT[r]);
#pragma unroll
                for (int ct = 0; ct < 4; ++ct) { sacc[ct] = ml::mma(btf[ct], ub, sacc[ct]); sacc[ct] = ml::mma(ktf[ct], vsf, sacc[ct]); sacc[ct] = sacc[ct] * glv[ct]; }
            }
        }
        LDS_BARRIER();
        *(u32x4*)(U + WY_TOK(c, pj) * PU + OFF_R + dir * RW + hc + 8 * psub) = *(const LAS u32x4*)(lds + L_YS + pj * PV + psub * 16);
    }
    if (!q.grid && w < 4) { const size_t sb = (((size_t)q.b * DEPTH + l) * 2 + dir) * RH + head;
#pragma unroll
        for (int ct = 0; ct < 4; ++ct) *(f32x4*)(P.out + OUT_S + (sb * 64 + 16 * w + fr) * 64 + 16 * ct + 4 * fq) = sacc[ct]; }
    LDS_BARRIER();
#undef WY_TOK
#undef WY_PREFETCH
}
__device__ __forceinline__ int tid_opaque() { int t = threadIdx.x; asm volatile("" : "+v"(t)); return t; }
constexpr int CW_F = 16384, FL_STRIDE = 64, NPROD = 2;
static_assert(RING % NPROD == 0 && NPROD + 1 <= 4 && CW_F + DEPTH * N_LAT * 4 * FL_STRIDE <= 32768, "flag block");
constexpr unsigned FL_SPIN_CAP = 1u << 18;
__device__ __forceinline__ unsigned fl_ld(unsigned* p) { return __hip_atomic_load(p, __ATOMIC_RELAXED, __HIP_MEMORY_SCOPE_AGENT); }
__device__ __forceinline__ unsigned fl_wait_ge(unsigned* p, unsigned want, unsigned* tmo) {
    unsigned sp = 0, v;
    while ((v = fl_ld(p)) < want) { __builtin_amdgcn_s_sleep(1); if ((++sp & 255u) == 0u) { if (fl_ld(tmo)) break; if (sp > FL_SPIN_CAP) { atomicAdd(tmo, 1u); break; } } }
    return v;
}
__device__ __forceinline__ void rwkv_prod(LAS unsigned char* lds, CParams& P, int l, int s, int head, int dir, int chain, int pp, unsigned* ctl) {
    const int tid = tid_opaque(), w = __builtin_amdgcn_readfirstlane(tid >> 6), lane = tid & 63, fr = lane & 15, fq = lane >> 4;
    const int rt = w & 3, half = w >> 2, hc = head * 64;
    const SeqInfo q = seqinfo(s); const int nchunk = q.T / 64;
    const bf16* RX = WSP(bf16, WS_RXC);
    const int pj = tid >> 3, psub = tid & 7;
    unsigned char* ring = P.ws + (chain < RING_A ? O_WIN1 + (size_t)chain * RING * PACK_BYTES : WS_END + (size_t)(chain - RING_A) * RING * PACK_BYTES);
    unsigned* f_base = ctl + CW_F + (size_t)((l * N_LAT + chain) * 4) * FL_STRIDE; unsigned* f_ready = f_base + pp * FL_STRIDE; unsigned* f_ack = f_base + NPROD * FL_STRIDE; unsigned* tmo = ctl + 4096 + 128;
    float rkk8[8];
#pragma unroll
    for (int e = 0; e < 8; ++e) rkk8[e] = P.in[R_KK][(size_t)l * RW + hc + 8 * psub + e];
    float c_w0[2], c_a0[2], c_kk[2], c_ka[2];
#pragma unroll
    for (int cc = 0; cc < 2; ++cc) { const int c = 16 * (2 * half + cc) + fr;
        c_w0[cc] = P.in[R_W0][((size_t)l * 2 + dir) * RW + hc + c]; c_a0[cc] = P.in[R_A0][((size_t)l * 2 + dir) * RW + hc + c];
        c_kk[cc] = P.in[R_KK][(size_t)l * RW + hc + c]; c_ka[cc] = P.in[R_KA][(size_t)l * RW + hc + c]; }
    const bf16* w2t = WSP(bf16, O_W2T) + ((size_t)dir * RW + hc) * 64; const bf16* a2t = WSP(bf16, O_A2T) + ((size_t)dir * RW + hc) * 64;
    u32x4 pf[5];
#define WY_TOK(c, j) ((size_t)(q.base + (dir ? q.T - 1 - ((c) * 64 + (j)) : ((c) * 64 + (j)))))
#define WY_PREFETCH(c) do { const bf16* rx = RX + WY_TOK(c, pj) * RIN + 8 * psub; \
        pf[0] = *(const u32x4*)(rx + RX_R + hc); pf[1] = *(const u32x4*)(rx + RX_K + hc); pf[2] = pf[0]; \
        pf[3] = *(const u32x4*)(rx + RX_WL + dir * 64); pf[4] = *(const u32x4*)(rx + RX_AL + dir * 64); } while (0)
    WY_PREFETCH(pp);
    asm volatile("" :: "v"(pf[0]), "v"(pf[1]), "v"(pf[2]), "v"(pf[3]), "v"(pf[4]) : "memory");
    unsigned acked = 0u;
    for (int c = pp; c < nchunk; c += NPROD) {
        { *(LAS u32x4*)(lds + L_RH + pj * PV + psub * 16) = pf[0]; *(LAS u32x4*)(lds + L_KH + pj * PV + psub * 16) = pf[1];
          const unsigned kw[4] = {pf[1].x, pf[1].y, pf[1].z, pf[1].w};
          float ss = 0.f;
#pragma unroll
          for (int e = 0; e < 8; ++e) { const float kf = __builtin_bit_cast(float, (e & 1) ? (kw[e >> 1] & 0xffff0000u) : (kw[e >> 1] << 16)) * rkk8[e]; ss += kf * kf; }
          ss += rw::dpp_xor1(ss); ss += rw::dpp_xor2(ss); ss += __shfl_xor(ss, 4);
          if (psub == 0) *(LAS float*)(lds + L_INV + pj * 4) = 1.0f / fmaxf(sqrtf(ss), 1e-12f);
          *(LAS u32x4*)(lds + L_TW + pj * PV + psub * 16) = pf[3]; *(LAS u32x4*)(lds + L_AL + pj * PV + psub * 16) = pf[4]; }
        LDS_BARRIER();
        if (c + NPROD < nchunk) WY_PREFETCH(c + NPROD);
#pragma unroll
        for (int cc = 0; cc < 2; ++cc) { const int ct = 2 * half + cc; const int cidx = 16 * ct + fr;
            f32x4 aw = (f32x4){0.f, 0.f, 0.f, 0.f}, aa = (f32x4){0.f, 0.f, 0.f, 0.f};
#pragma unroll
            for (int ks = 0; ks < 2; ++ks) { const size_t bo = (size_t)cidx * 64 + 32 * ks + 8 * fq;
                aw = ml::mma(ml::frag(lds, L_TW, PV, 16 * rt, 32 * ks, lane), *(const bf16x8*)(w2t + bo), aw); aa = ml::mma(ml::frag(lds, L_AL, PV, 16 * rt, 32 * ks, lane), *(const bf16x8*)(a2t + bo), aa); }
            float kr4[4], rr4[4], iv4[4];
#pragma unroll
            for (int r = 0; r < 4; ++r) { const int tok = 16 * rt + 4 * fq + r; kr4[r] = bf2f(*(const LAS bf16*)(lds + L_KH + tok * PV + cidx * 2)); rr4[r] = bf2f(*(const LAS bf16*)(lds + L_RH + tok * PV + cidx * 2));
                iv4[r] = *(const LAS float*)(lds + L_INV + tok * 4); }
            float lw[4], cum[4];
#pragma unroll
            for (int r = 0; r < 4; ++r) { lw[r] = -0.6065306597126334f * pg8::fsigmoid(c_w0[cc] + aw[r]); cum[r] = (r ? cum[r - 1] : 0.f) + lw[r]; }
            const float tot = cum[3]; const float p1 = __shfl_up(tot, 16), p2 = __shfl_up(tot, 32), p3 = __shfl_up(tot, 48);
            const float off = (fq >= 1 ? p1 : 0.f) + (fq >= 2 ? p2 : 0.f) + (fq >= 3 ? p3 : 0.f);
            float gprev = __expf(off);
#pragma unroll
            for (int r = 0; r < 4; ++r) { const int tok = 16 * rt + 4 * fq + r; const float lam = off + cum[r]; const float g = __expf(lam), gi = __builtin_amdgcn_rcpf(g);
                const float alpha = pg8::fsigmoid(c_a0[cc] + aa[r]);
                const float kraw = kr4[r], rraw = rr4[r];
                const float kkn = kraw * c_kk[cc] * iv4[r];
                const bf16 bh = f2bf(kkn * alpha * gi), kh = f2bf(kraw * (1.0f + (alpha - 1.0f) * c_ka[cc]) * gi);
                stb(lds, L_AH + tok * PV + cidx * 2, -kkn * gprev); stb(lds, L_RH + tok * PV + cidx * 2, rraw * g);
                *(LAS bf16*)(lds + L_BH + tok * PV + cidx * 2) = bh; *(LAS bf16*)(lds + L_KH + tok * PV + cidx * 2) = kh;
                *(LAS bf16*)(lds + L_BT + cidx * PV + tok * 2) = bh; *(LAS bf16*)(lds + L_KT + cidx * PV + tok * 2) = kh;
                if (fq == 3 && r == 3) *(LAS float*)(lds + L_GL + (rt * 64 + cidx) * 4) = g;
                gprev = g; } }
        asm volatile("s_waitcnt vmcnt(0)" ::: "memory");
        LDS_BARRIER();
        if (tid == 0 && c > pp) __hip_atomic_store(f_ready, (unsigned)((c - pp) / NPROD), __ATOMIC_RELAXED, __HIP_MEMORY_SCOPE_AGENT);
        { const int sc = w >> 1, side = w & 1; f32x4 gB = (f32x4){0.f, 0.f, 0.f, 0.f}, gK = (f32x4){0.f, 0.f, 0.f, 0.f};
#pragma unroll
          for (int ks = 0; ks < 2; ++ks) { const bf16x8 af = ml::frag(lds, side ? L_RH : L_AH, PV, 16 * sc, 32 * ks, lane);
              gB = ml::mma(af, ml::frag(lds, L_BH, PV, 16 * sc, 32 * ks, lane), gB); gK = ml::mma(af, ml::frag(lds, L_KH, PV, 16 * sc, 32 * ks, lane), gK); }
#pragma unroll
          for (int r = 0; r < 4; ++r) { const int t = 4 * fq + r; const bool keep = side ? (fr <= t) : (fr < t); const float vB = keep ? gB[r] : 0.f, vK = keep ? gK[r] : 0.f;
              if (side == 0) { *(LAS float*)(lds + L_NAB + ((sc * 16 + t) * 16 + fr) * 4) = vB; stb(lds, L_NAKT + (sc * 16 + t) * PS + fr * 2, vK); }
              else { stb(lds, L_NRBT + (sc * 16 + t) * PS + fr * 2, vB); stb(lds, L_NRKT + (sc * 16 + t) * PS + fr * 2, vK); } } }
        if ((w & 1) == 0 && lane < 16) { const int sc = w >> 1; float Tr[16];
            asm volatile("" ::: "memory");
#pragma unroll
            for (int ph = 0; ph < 4; ++ph) { f32x4 nv[4][4];
#pragma unroll
                for (int tq = 0; tq < 4; ++tq)
#pragma unroll
                    for (int u4 = 0; u4 <= ph; ++u4) nv[tq][u4] = *(const LAS f32x4*)(lds + L_NAB + ((sc * 16 + 4 * ph + tq) * 16 + 4 * u4) * 4);
#pragma unroll
                for (int tq = 0; tq < 4; ++tq) { const int t = 4 * ph + tq; float x0 = (lane == t) ? 1.f : 0.f, x1 = 0.f;
#pragma unroll
                    for (int u = 0; u < 16; ++u) if (u < t) { if (u & 1) x1 += Tr[u] * nv[tq][u >> 2][u & 3]; else x0 += Tr[u] * nv[tq][u >> 2][u & 3]; }
                    Tr[t] = x0 + x1; stb(lds, L_TT + (sc * 16 + t) * PS + lane * 2, Tr[t]); } } }
        if (tid == 0 && c >= RING && acked < (unsigned)(c - RING + 1)) acked = fl_wait_ge(f_ack, (unsigned)(c - RING + 1), tmo);
        LDS_BARRIER();
        asm volatile("" :: "v"(pf[0]), "v"(pf[1]), "v"(pf[2]), "v"(pf[3]), "v"(pf[4]) : "memory");
        { unsigned char* slot = ring + (size_t)(c % RING) * PACK_BYTES;
#pragma unroll
          for (int k = 0; k < 8; ++k) { const int u = tid + 512 * k;
              if (u < PACK_U) { const u32x4 v = *(const LAS u32x4*)(lds + 16 * u); const u32x4* gp = (const u32x4*)(slot + (size_t)16 * u);
                  asm volatile("global_store_dwordx4 %0, %1, off sc1" :: "v"(gp), "v"(v) : "memory"); } } }
        LDS_BARRIER();
    }
    asm volatile("s_waitcnt vmcnt(0)" ::: "memory");
    __syncthreads();
    if (tid == 0) __hip_atomic_store(f_ready, (unsigned)((nchunk - pp + NPROD - 1) / NPROD), __ATOMIC_RELAXED, __HIP_MEMORY_SCOPE_AGENT);
    LDS_BARRIER();
#undef WY_TOK
#undef WY_PREFETCH
}
__device__ __forceinline__ void rwkv_cons(LAS unsigned char* lds, CParams& P, int l, int s, int head, int dir, int chain, unsigned* ctl) {
    const int tid = tid_opaque(), w = __builtin_amdgcn_readfirstlane(tid >> 6), lane = tid & 63, fr = lane & 15, fq = lane >> 4;
    const int hc = head * 64;
    const SeqInfo q = seqinfo(s); const int nchunk = q.T / 64;
    bf16* U = WSP(bf16, WS_U1);
    const unsigned char* ring = P.ws + (chain < RING_A ? O_WIN1 + (size_t)chain * RING * PACK_BYTES : WS_END + (size_t)(chain - RING_A) * RING * PACK_BYTES);
    unsigned* f_base = ctl + CW_F + (size_t)((l * N_LAT + chain) * 4) * FL_STRIDE; unsigned* f_ack = f_base + NPROD * FL_STRIDE; unsigned* tmo = ctl + 4096 + 128;
    constexpr int C_IMG = PACK_BYTES + 64 * PV, C_YS = 2 * C_IMG;
    const bf16* RX = WSP(bf16, WS_RXC);
    static_assert(C_YS + 64 * PV <= 131072, "consumer LDS map");
    f32x4 sacc[4];
#pragma unroll
    for (int ct = 0; ct < 4; ++ct) sacc[ct] = (f32x4){0.f, 0.f, 0.f, 0.f};
    if (w < 4 && q.grid) { const size_t sb = (((size_t)q.b * DEPTH + l) * 2 + dir) * RH + head;
#pragma unroll
        for (int ct = 0; ct < 4; ++ct) sacc[ct] = *(const f32x4*)(P.in[ST_R] + (sb * 64 + 16 * w + fr) * 64 + 16 * ct + 4 * fq); }
#define WY_TOK(c, j) ((size_t)(q.base + (dir ? q.T - 1 - ((c) * 64 + (j)) : ((c) * 64 + (j)))))
    unsigned seen0 = 0u, seen1 = 0u;
#define CONS_FETCH(c, boff) do { const int p_ = (c) % NPROD; const unsigned need_ = (unsigned)((c) / NPROD + 1); \
        u32x4 vv_[2];   \
        _Pragma("unroll") for (int i_ = 0; i_ < 2; ++i_) vv_[i_] = *(const u32x4*)(RX + WY_TOK(c, lane) * RIN + RX_V + hc + 8 * (2 * (w - 4) + i_)); \
        if ((p_ ? seen1 : seen0) < need_) { unsigned v_ = 0u; if (lane == 0) v_ = fl_wait_ge(f_base + p_ * FL_STRIDE, need_, tmo); v_ = __builtin_amdgcn_readfirstlane(v_); \
            if (p_) seen1 = v_; else seen0 = v_; __builtin_amdgcn_fence(__ATOMIC_ACQUIRE, "agent"); } \
        _Pragma("unroll") for (int i_ = 0; i_ < 2; ++i_) { const unsigned wv_[4] = {vv_[i_].x, vv_[i_].y, vv_[i_].z, vv_[i_].w}; \
            _Pragma("unroll") for (int e_ = 0; e_ < 8; ++e_) *(LAS bf16*)(lds + (boff) + L_VS + (8 * (2 * (w - 4) + i_) + e_) * PVS + lane * 2) = (bf16)((wv_[e_ >> 1] >> ((e_ & 1) * 16)) & 0xffffu); } \
        const unsigned char* slot = ring + (size_t)((c) % RING) * PACK_BYTES; \
        for (int k = w - 4; k < PACK_BYTES / 1024; k += 4) \
            __builtin_amdgcn_global_load_lds((const unsigned*)(slot + (size_t)k * 1024 + lane * 16), (LAS unsigned*)(lds + (boff) + k * 1024), 16, 0, 0); \
        asm volatile("s_waitcnt vmcnt(0)" ::: "memory"); } while (0)
    if (w >= 4) CONS_FETCH(0, 0);
    LDS_BARRIER();
    if (tid == 256) __hip_atomic_store(f_ack, 1u, __ATOMIC_RELAXED, __HIP_MEMORY_SCOPE_AGENT);
    for (int c = 0; c < nchunk; ++c) {
        const int boff = (c & 1) * C_IMG;
        if (w >= 4) { if (c + 1 < nchunk) CONS_FETCH(c + 1, C_IMG - boff); }
        else {
            LAS unsigned char* pb = lds + boff;
#pragma unroll 1
            for (int sc = 0; sc < 4; ++sc) {
                const bf16x8 ah0 = ld_k32(pb, L_AH, PV, 16 * sc, 0, lane), ah1 = ld_k32(pb, L_AH, PV, 16 * sc, 32, lane), rh0 = ld_k32(pb, L_RH, PV, 16 * sc, 0, lane), rh1 = ld_k32(pb, L_RH, PV, 16 * sc, 32, lane);
                const bf16x8 nak = ld_k16(pb, L_NAKT, PS, 16 * sc, 0, lane), nrk = ld_k16(pb, L_NRKT, PS, 16 * sc, 0, lane), ttf = ld_k16(pb, L_TT, PS, 16 * sc, 0, lane), nrb = ld_k16(pb, L_NRBT, PS, 16 * sc, 0, lane);
                const bf16x8 vsf = ld_k16(pb, L_VS, PVS, 16 * w, 16 * sc, lane);
                bf16x8 btf[4], ktf[4]; f32x4 glv[4];
#pragma unroll
                for (int ct = 0; ct < 4; ++ct) { btf[ct] = ld_k16(pb, L_BT, PV, 16 * ct, 16 * sc, lane); ktf[ct] = ld_k16(pb, L_KT, PV, 16 * ct, 16 * sc, lane);
                    glv[ct] = *(const LAS f32x4*)(pb + L_GL + (sc * 64 + 16 * ct + 4 * fq) * 4); }
                const bf16x8 sb0 = pack_k32(sacc[0], sacc[1]), sb1 = pack_k32(sacc[2], sacc[3]);
                f32x4 XT = (f32x4){0.f, 0.f, 0.f, 0.f}, YT = (f32x4){0.f, 0.f, 0.f, 0.f};
                XT = ml::mma(ah0, sb0, XT); XT = ml::mma(ah1, sb1, XT); XT = ml::mma(nak, vsf, XT);
                YT = ml::mma(rh0, sb0, YT); YT = ml::mma(rh1, sb1, YT); YT = ml::mma(nrk, vsf, YT);
                f32x4 UT = (f32x4){0.f, 0.f, 0.f, 0.f};
                UT = ml::mma(ttf, pack_k16(XT), UT);
                const bf16x8 ub = pack_k16(UT);
                YT = ml::mma(nrb, ub, YT);
#pragma unroll
                for (int r = 0; r < 4; ++r) stb(lds, C_YS + (16 * sc + 4 * fq + r) * PV + (16 * w + fr) * 2, YT[r]);
#pragma unroll
                for (int ct = 0; ct < 4; ++ct) { sacc[ct] = ml::mma(btf[ct], ub, sacc[ct]); sacc[ct] = ml::mma(ktf[ct], vsf, sacc[ct]); sacc[ct] = sacc[ct] * glv[ct]; }
            }
            { const LAS unsigned char* yp = lds + C_YS + lane * PV + 32 * w; const u32x4 y0 = *(const LAS u32x4*)yp, y1 = *(const LAS u32x4*)(yp + 16);
              bf16* up = U + WY_TOK(c, lane) * PU + OFF_R + dir * RW + hc + 16 * w; *(u32x4*)up = y0; *(u32x4*)(up + 8) = y1; }
        }
        LDS_BARRIER();
        if (tid == 256 && c + 1 < nchunk) __hip_atomic_store(f_ack, (unsigned)(c + 2), __ATOMIC_RELAXED, __HIP_MEMORY_SCOPE_AGENT);
    }
    if (!q.grid && w < 4) { const size_t sb = (((size_t)q.b * DEPTH + l) * 2 + dir) * RH + head;
#pragma unroll
        for (int ct = 0; ct < 4; ++ct) *(f32x4*)(P.out + OUT_S + (sb * 64 + 16 * w + fr) * 64 + 16 * ct + 4 * fq) = sacc[ct]; }
    LDS_BARRIER();
#undef WY_TOK
#undef CONS_FETCH
}
constexpr int N_ITEMS = NSEQ * RH * 2;
__device__ __forceinline__ void decode_item(int it, int& s, int& head, int& dir) {
    dir = it & 1; int ch = it >> 1; head = ch % RH; const int sq = ch / RH;
    s = sq < LB ? CB + sq : sq - LB;
}
}

namespace ms {
using ml::PQ; using ml::PT; using ml::mma; using ml::frag; using wy::bf16x8; using wy::f32x4; using wy::u32x4;
constexpr int P_QS = 0, P_KT = P_QS + 64 * PQ, P_SB = P_KT + 128 * PT, P_SC = P_SB + 64 * PT, P_VT = P_SC + 4096, VT_BYTES = 21504, ML_PACK = P_VT + VT_BYTES, P_KS = ML_PACK, P_END = P_KS + 64 * PQ;
constexpr int ML_RING = 4, ML_PACK_U = ML_PACK / 16, N_MLAT = LB * MH * 2, CW_MF = 32768, MLPROD = 2;
static_assert(MLPROD == 2 && ML_RING % MLPROD == 0, "two producers per chain: even / odd chunks");
static_assert(ML_PACK % 1024 == 0 && ML_PACK_U <= 9 * 512 && 145 * PT <= VT_BYTES && P_END <= 131072 && 2 * ML_PACK <= 146432, "mLSTM pack layout");
static_assert(WS_END + (size_t)N_MLAT * ML_RING * ML_PACK <= ((size_t)256 << 20), "mLSTM ring fits behind the activations");
__device__ __forceinline__ void ml_prod(LAS unsigned char* lds, CParams& P, int l, int s, int head, int dir, int chain, int pp, unsigned* ctl) {
    const int tid = wy::tid_opaque(), w = __builtin_amdgcn_readfirstlane(tid >> 6), lane = tid & 63, fr = lane & 15, fq = lane >> 4;
    const int rt = w & 3, half = w >> 2;
    const SeqInfo q = seqinfo(s); const int nchunk = q.T / 64;
    const bf16* QK = WSP(bf16, WS_QKC); const bf16* U = WSP(bf16, WS_U1);
    LAS float* SC = (LAS float*)(lds + P_SC);
    unsigned char* ring = P.ws + WS_END + (size_t)chain * ML_RING * ML_PACK;
    unsigned* f_base = ctl + CW_MF + (size_t)((l * N_MLAT + chain) * 4) * wy::FL_STRIDE; unsigned* f_ready = f_base + pp * wy::FL_STRIDE; unsigned* f_ack = f_base + MLPROD * wy::FL_STRIDE; unsigned* tmo = ctl + 4096 + 128;
    float m_prev = 0.f;
    if (q.grid) m_prev = P.in[ST_M][(((size_t)q.b * DEPTH + l) * 2 + dir) * MH + head];
    const float bi = P.in[M_GATE_B][(size_t)l * 4 * MH + (2 * dir) * MH + head], bfg = P.in[M_GATE_B][(size_t)l * 4 * MH + (2 * dir + 1) * MH + head];
    for (int i = tid; i < (VT_BYTES - 128 * PT) / 2; i += 512) *(LAS bf16*)(lds + P_VT + 128 * PT + i * 2) = (i < 64) ? (bf16)0x3f80 : (bf16)0;
    u32x4 pqk[4]; u32x4 pv[2]; bf16 pgi = 0, pgf = 0, sgi = 0, sgf = 0;
#define ML_TOK(c, j) ((size_t)(q.base + (dir ? q.T - 1 - ((c) * 64 + (j)) : ((c) * 64 + (j)))))
#define ML_PREFETCH(c) do { _Pragma("unroll") for (int i = 0; i < 4; ++i) { const int id = tid + 512 * i, j = id >> 5, pc = id & 31; \
            pqk[i] = *(const u32x4*)(QK + ML_TOK(c, j) * (2 * MW) + (pc < 16 ? head * 128 + 8 * pc : MW + head * 128 + 8 * (pc - 16))); } \
        _Pragma("unroll") for (int i = 0; i < 2; ++i) { const int id = tid + 512 * i, j = id >> 4, pc = id & 15; pv[i] = *(const u32x4*)(U + ML_TOK(c, j) * PU + OFF_V + head * 128 + 8 * pc); } \
        if (w == 0) { const bf16* g = U + ML_TOK(c, lane) * PU + OFF_G; pgi = g[(2 * dir) * MH + head]; pgf = g[(2 * dir + 1) * MH + head]; \
            if ((c) >= 1) { const bf16* g2 = U + ML_TOK((c) - 1, lane) * PU + OFF_G; sgi = g2[(2 * dir) * MH + head]; sgf = g2[(2 * dir + 1) * MH + head]; } } } while (0)
#define ML_TOUCH() asm volatile("" :: "v"(pqk[0]), "v"(pqk[1]), "v"(pqk[2]), "v"(pqk[3]), "v"(pv[0]), "v"(pv[1]), "v"((unsigned)pgi), "v"((unsigned)pgf), "v"((unsigned)sgi), "v"((unsigned)sgf) : "memory")
#define ML_SCAN(gi_, gf_) \
            const float gi = bf2f(gi_) + bi, gf = bf2f(gf_) + bfg; \
            const float lf = fminf(gf, 0.f) - log1pf(__expf(-fabsf(gf))); \
            float b = lf; \
            _Pragma("unroll") for (int o = 1; o < 64; o <<= 1) { const float t = __shfl_up(b, o); if (lane >= o) b += t; } \
            const float a = gi - b; float pm = a; \
            _Pragma("unroll") for (int o = 1; o < 64; o <<= 1) { const float t = __shfl_up(pm, o); if (lane >= o) pm = fmaxf(pm, t); } \
            pm = fmaxf(pm, m_prev); \
            const float pm63 = __shfl(pm, 63), b63 = __shfl(b, 63);
    ML_PREFETCH(pp);
    ML_TOUCH();
    unsigned acked = 0u;
    for (int c = pp; c < nchunk; c += MLPROD) {
        if (w == 0 && c >= 1) { ML_SCAN(sgi, sgf) m_prev = b63 + pm63; }
#pragma unroll
        for (int i = 0; i < 4; ++i) { const int id = tid + 512 * i, j = id >> 5, pc = id & 31;
            *(LAS u32x4*)(lds + (pc < 16 ? P_QS : P_KS) + j * PQ + (pc & 15) * 16) = pqk[i]; }
#pragma unroll
        for (int i = 0; i < 2; ++i) { const int id = tid + 512 * i, j = id >> 4, pc = id & 15; const unsigned wv[4] = {pv[i].x, pv[i].y, pv[i].z, pv[i].w};
#pragma unroll
            for (int e = 0; e < 8; ++e) *(LAS bf16*)(lds + P_VT + (8 * pc + e) * PT + j * 2) = (bf16)((wv[e >> 1] >> ((e & 1) * 16)) & 0xffffu); }
        if (w == 0) {
            ML_SCAN(pgi, pgf)
            SC[ml::SC_A + lane] = a; SC[ml::SC_PM + lane] = pm; SC[ml::SC_WI + lane] = __expf(m_prev - pm); SC[ml::SC_EMT + lane] = __expf(-(b + pm)); SC[ml::SC_WE + lane] = __expf(a - pm63);
            if (lane == 0) { SC[ml::SC_MISC] = __expf(m_prev - pm63); SC[ml::SC_MISC + 1] = b63 + pm63; }
            m_prev = b63 + pm63;
        }
        LDS_BARRIER();
        if (c + MLPROD < nchunk) ML_PREFETCH(c + MLPROD);
#pragma unroll
        for (int i = 0; i < 2; ++i) { const int id = tid + 512 * i, j = id & 63, pc = id >> 6; const float we = SC[ml::SC_WE + j];
            const u32x4 kv = *(const LAS u32x4*)(lds + P_KS + j * PQ + pc * 16); const unsigned wv[4] = {kv.x, kv.y, kv.z, kv.w};
#pragma unroll
            for (int e = 0; e < 8; ++e) { const float kf = __builtin_bit_cast(float, (e & 1) ? (wv[e >> 1] & 0xffff0000u) : (wv[e >> 1] << 16));
                *(LAS bf16*)(lds + P_KT + (8 * pc + e) * PT + j * 2) = f2bf(kf * we); } }
#pragma unroll
        for (int cc = 0; cc < 2; ++cc) { const int ct = 2 * half + cc;
            f32x4 acc = (f32x4){0.f, 0.f, 0.f, 0.f};
            if (ct <= rt) {
#pragma unroll
                for (int k = 0; k < 4; ++k) acc = mma(frag(lds, P_QS, PQ, 16 * rt, 32 * k, lane), frag(lds, P_KS, PQ, 16 * ct, 32 * k, lane), acc);
            }
            const int sp = 16 * ct + fr; const float as = SC[ml::SC_A + sp];
#pragma unroll
            for (int r = 0; r < 4; ++r) { const int t = 16 * rt + 4 * fq + r; const float v = (sp <= t) ? acc[r] * __expf(as - SC[ml::SC_PM + t]) : 0.f;
                *(LAS bf16*)(lds + P_SB + t * PT + sp * 2) = f2bf(v); } }
        asm volatile("s_waitcnt vmcnt(0)" ::: "memory");
        if (tid == 0 && c >= ML_RING && acked < (unsigned)(c - ML_RING + 1)) acked = wy::fl_wait_ge(f_ack, (unsigned)(c - ML_RING + 1), tmo);
        LDS_BARRIER();
        if (tid == 0 && c > pp) __hip_atomic_store(f_ready, (unsigned)((c - pp) / MLPROD), __ATOMIC_RELAXED, __HIP_MEMORY_SCOPE_AGENT);
        ML_TOUCH();
        { unsigned char* slot = ring + (size_t)(c % ML_RING) * ML_PACK;
#pragma unroll
          for (int k = 0; k < 9; ++k) { const int u = tid + 512 * k;
              if (u < ML_PACK_U) { const u32x4 v = *(const LAS u32x4*)(lds + 16 * u); const u32x4* gp = (const u32x4*)(slot + (size_t)16 * u);
                  asm volatile("global_store_dwordx4 %0, %1, off sc1" :: "v"(gp), "v"(v) : "memory"); } } }
        LDS_BARRIER();
    }
    asm volatile("s_waitcnt vmcnt(0)" ::: "memory");
    __syncthreads();
    if (tid == 0) __hip_atomic_store(f_ready, (unsigned)((nchunk - pp + MLPROD - 1) / MLPROD), __ATOMIC_RELAXED, __HIP_MEMORY_SCOPE_AGENT);
    LDS_BARRIER();
#undef ML_TOK
#undef ML_PREFETCH
#undef ML_TOUCH
#undef ML_SCAN
}
__device__ __forceinline__ void ml_cons(LAS unsigned char* lds, CParams& P, int l, int s, int head, int dir, int chain, unsigned* ctl) {
    const int tid = wy::tid_opaque(), w = __builtin_amdgcn_readfirstlane(tid >> 6), lane = tid & 63, fr = lane & 15, fq = lane >> 4;
    const SeqInfo q = seqinfo(s); const int nchunk = q.T / 64;
    bf16* U = WSP(bf16, WS_U1);
    const unsigned char* ring = P.ws + WS_END + (size_t)chain * ML_RING * ML_PACK;
    unsigned* f_base = ctl + CW_MF + (size_t)((l * N_MLAT + chain) * 4) * wy::FL_STRIDE; unsigned* f_ack = f_base + MLPROD * wy::FL_STRIDE; unsigned* tmo = ctl + 4096 + 128;
    f32x4 cst[8][3];
#pragma unroll
    for (int kt = 0; kt < 8; ++kt)
#pragma unroll
        for (int j = 0; j < 3; ++j) cst[kt][j] = (f32x4){0.f, 0.f, 0.f, 0.f};
    if (w < 4 && q.grid) { const size_t sb = (((size_t)q.b * DEPTH + l) * 2 + dir) * MH + head;
#pragma unroll
        for (int kt = 0; kt < 8; ++kt)
#pragma unroll
            for (int r = 0; r < 4; ++r) { const int d = 16 * kt + 4 * fq + r;
                cst[kt][0][r] = P.in[ST_C][(sb * 128 + d) * 128 + 32 * w + fr]; cst[kt][1][r] = P.in[ST_C][(sb * 128 + d) * 128 + 32 * w + 16 + fr];
                cst[kt][2][r] = (fr == 0) ? P.in[ST_N][sb * 128 + d] : 0.f; } }
#define ML_TOK(c, j) ((size_t)(q.base + (dir ? q.T - 1 - ((c) * 64 + (j)) : ((c) * 64 + (j)))))
    unsigned seen0 = 0u, seen1 = 0u;
#define MLC_FETCH(c, boff) do { const int p_ = (c) % MLPROD; const unsigned need_ = (unsigned)((c) / MLPROD + 1); \
        if ((p_ ? seen1 : seen0) < need_) { unsigned v_ = 0u; if (lane == 0) v_ = wy::fl_wait_ge(f_base + p_ * wy::FL_STRIDE, need_, tmo); v_ = __builtin_amdgcn_readfirstlane(v_); \
            if (p_) seen1 = v_; else seen0 = v_; __builtin_amdgcn_fence(__ATOMIC_ACQUIRE, "agent"); } \
        const unsigned char* slot = ring + (size_t)((c) % ML_RING) * ML_PACK; \
        for (int k = w - 4; k < ML_PACK / 1024; k += 4) \
            __builtin_amdgcn_global_load_lds((const unsigned*)(slot + (size_t)k * 1024 + lane * 16), (LAS unsigned*)(lds + (boff) + k * 1024), 16, 0, 0); \
        asm volatile("s_waitcnt vmcnt(0)" ::: "memory"); } while (0)
    if (w >= 4) MLC_FETCH(0, 0);
    LDS_BARRIER();
    if (tid == 256) __hip_atomic_store(f_ack, 1u, __ATOMIC_RELAXED, __HIP_MEMORY_SCOPE_AGENT);
    for (int c = 0; c < nchunk; ++c) {
        const int boff = (c & 1) * ML_PACK;
        if (w >= 4) { if (c + 1 < nchunk) MLC_FETCH(c + 1, ML_PACK - boff); }
        else {
            LAS unsigned char* pb = lds + boff; const LAS float* SC = (const LAS float*)(pb + P_SC);
            const float wie = SC[ml::SC_MISC];
            bf16x8 vf[3][2];
#pragma unroll
            for (int j = 0; j < 3; ++j)
#pragma unroll
                for (int k = 0; k < 2; ++k) vf[j][k] = frag(pb, P_VT, PT, j < 2 ? 32 * w + 16 * j : 128, 32 * k, lane);
            asm volatile("s_waitcnt lgkmcnt(0)" ::: "memory");
            LAS unsigned char* hp = pb + P_VT + 32 * w * PT;
#pragma unroll
            for (int rt = 0; rt < 4; ++rt) {
                f32x4 num[3];
#pragma unroll
                for (int j = 0; j < 3; ++j) { f32x4 a1 = (f32x4){0.f, 0.f, 0.f, 0.f}, a2 = (f32x4){0.f, 0.f, 0.f, 0.f};
#pragma unroll
                    for (int k = 0; k < 2; ++k) a1 = mma(frag(pb, P_SB, PT, 16 * rt, 32 * k, lane), vf[j][k], a1);
#pragma unroll
                    for (int kb = 0; kb < 4; ++kb) a2 = mma(wy::ld_k32(pb, P_QS, PQ, 16 * rt, 32 * kb, lane), wy::pack_k32(cst[2 * kb][j], cst[2 * kb + 1][j]), a2);
#pragma unroll
                    for (int r = 0; r < 4; ++r) a1[r] += SC[ml::SC_WI + 16 * rt + 4 * fq + r] * a2[r];
                    num[j] = a1; }
#pragma unroll
                for (int r = 0; r < 4; ++r) { const int t = 16 * rt + 4 * fq + r; const float dn = __shfl(num[2][r], lane & 48);
                    const float rden = __builtin_amdgcn_rcpf(fmaxf(fabsf(dn), SC[ml::SC_EMT + t]));
                    *(LAS bf16*)(hp + t * 64 + fr * 2) = f2bf(num[0][r] * rden); *(LAS bf16*)(hp + t * 64 + (16 + fr) * 2) = f2bf(num[1][r] * rden); }
            }
#pragma unroll
            for (int kt = 0; kt < 8; ++kt) { const bf16x8 k0 = frag(pb, P_KT, PT, 16 * kt, 0, lane), k1 = frag(pb, P_KT, PT, 16 * kt, 32, lane);
#pragma unroll
                for (int j = 0; j < 3; ++j) { cst[kt][j] = cst[kt][j] * wie; cst[kt][j] = mma(k0, vf[j][0], cst[kt][j]); cst[kt][j] = mma(k1, vf[j][1], cst[kt][j]); } }
            { const LAS unsigned char* yp = hp + lane * 64; bf16* up = U + ML_TOK(c, lane) * PU + dir * MW + head * 128 + 32 * w;
#pragma unroll
              for (int i = 0; i < 4; ++i) *(u32x4*)(up + 8 * i) = *(const LAS u32x4*)(yp + 16 * i); }
        }
        LDS_BARRIER();
        if (tid == 256 && c + 1 < nchunk) __hip_atomic_store(f_ack, (unsigned)(c + 2), __ATOMIC_RELAXED, __HIP_MEMORY_SCOPE_AGENT);
    }
    LDS_BARRIER();
#undef ML_TOK
#undef MLC_FETCH
}
}

namespace el {
typedef float f32x4 __attribute__((ext_vector_type(4)));
typedef unsigned u32x4 __attribute__((ext_vector_type(4)));
typedef unsigned u32x2 __attribute__((ext_vector_type(2)));
typedef short bf16x8 __attribute__((ext_vector_type(8)));
__device__ __forceinline__ float wave_sum(float v) {
#pragma unroll
    for (int o = 1; o < 64; o <<= 1) v += __shfl_xor(v, o);
    return v;
}
__device__ __forceinline__ void unpack8(const u32x4 p, float (&f)[8]) {
    f[0] = pg8::bflo(p.x); f[1] = pg8::bfhi(p.x); f[2] = pg8::bflo(p.y); f[3] = pg8::bfhi(p.y); f[4] = pg8::bflo(p.z); f[5] = pg8::bfhi(p.z); f[6] = pg8::bflo(p.w); f[7] = pg8::bfhi(p.w);
}
__device__ __forceinline__ u32x4 pack8(const float (&f)[8]) {
    u32x4 o; o.x = pg8::cvt_pk_bf16(f[0], f[1]); o.y = pg8::cvt_pk_bf16(f[2], f[3]); o.z = pg8::cvt_pk_bf16(f[4], f[5]); o.w = pg8::cvt_pk_bf16(f[6], f[7]); return o;
}
__device__ __forceinline__ void init_phase(LAS unsigned char* lds, CParams& P, int vb, int G) {
    const int tid = threadIdx.x, w = tid >> 6, lane = tid & 63;
    LAS float* red = (LAS float*)lds;
    constexpr int KW = D / 8;
    for (int it = vb; it < DEPTH * (6 * D / 64); it += G) {
        const int l = it / (6 * D / 64), j = (it % (6 * D / 64)) * 64 + lane;
        const float* wp = P.in[ADA_W] + ((size_t)l * D + w * KW) * 6 * D + j;
        float acc[NCOND];
#pragma unroll
        for (int ci = 0; ci < NCOND; ++ci) acc[ci] = 0.f;
        for (int k = 0; k < KW; ++k) { const float wv = wp[(size_t)k * 6 * D];
#pragma unroll
            for (int ci = 0; ci < NCOND; ++ci) { const float cv = ci == 0 ? P.in[C_CTX][w * KW + k] : P.in[C_LAT][(size_t)(ci - 1) * D + w * KW + k]; acc[ci] += cv * pg8::fsigmoid(cv) * wv; } }
#pragma unroll
        for (int ci = 0; ci < NCOND; ++ci) red[(w * NCOND + ci) * 64 + lane] = acc[ci];
        __syncthreads();
        if (w < NCOND) { float sum = P.in[ADA_B][(size_t)l * 6 * D + j];
#pragma unroll
            for (int ww = 0; ww < 8; ++ww) sum += red[(ww * NCOND + w) * 64 + lane];
            WSP(float, WS_MOD)[((size_t)l * NCOND + w) * 6 * D + j] = sum; }
        __syncthreads();
    }
}
__device__ __forceinline__ int perm5(int n) { return (((n >> 2) & 1) << 4) | (((n >> 3) & 3) << 2) | (n & 3); }
__device__ __forceinline__ void transpose_item(const float* W, int ldw, int nvalid, bf16* dst, int K, int k0, int drow0, bool perm, LAS float* scr, int lane) {
    f32x4 tv[8];
#pragma unroll
    for (int i = 0; i < 8; ++i) { const int kk = 8 * i + (lane >> 3), n4 = (lane & 7) * 4; tv[i] = n4 < nvalid ? *(const f32x4*)(W + (size_t)kk * ldw + n4) : (f32x4){0.f, 0.f, 0.f, 0.f}; }
#pragma unroll
    for (int i = 0; i < 8; ++i) { const int kk = 8 * i + (lane >> 3), n4 = (lane & 7) * 4;
#pragma unroll
        for (int e = 0; e < 4; ++e) scr[kk * 33 + n4 + e] = tv[i][e]; }
    asm volatile("s_waitcnt lgkmcnt(0)" ::: "memory");
    const int c = lane & 7;
#pragma unroll
    for (int j = 0; j < 4; ++j) { const int n = (lane >> 3) + 8 * j; const LAS float* sp = scr + (8 * c) * 33 + n;
        u32x4 o; o.x = pg8::cvt_pk_bf16(sp[0 * 33], sp[1 * 33]); o.y = pg8::cvt_pk_bf16(sp[2 * 33], sp[3 * 33]); o.z = pg8::cvt_pk_bf16(sp[4 * 33], sp[5 * 33]); o.w = pg8::cvt_pk_bf16(sp[6 * 33], sp[7 * 33]);
        *(u32x4*)(dst + (size_t)(drow0 + (perm ? perm5(n) : n)) * K + k0 + 8 * c) = o; }
    asm volatile("s_waitcnt lgkmcnt(0)" ::: "memory");
}
constexpr int WI_0 = (N1P / 32) * (D / 64), WI_1 = WI_0 + (2 * D / 32) * (D / 64), WI_2 = WI_1 + (D / 32) * (MW / 64), WI_3 = WI_2 + (D / 32) * (RW / 64),
              WI_4 = WI_3 + (D / 32) * (D / 64), WI_5 = WI_4 + 2 * (FF / 32) * (D / 64), WI_6 = WI_5 + (D / 32) * (FF / 64), WI_7 = WI_6 + (RW / 32) * (128 / 64), WI_8 = WI_7 + 4 * (RW / 32);
__device__ __forceinline__ void wconv_phase(LAS unsigned char* lds, CParams& P, int l, int vb, int G) {
    const int tid = threadIdx.x, w = tid >> 6, lane = tid & 63;
    LAS float* scr = (LAS float*)(lds + w * 8704);
    for (int it = vb * 8 + w; it < WI_8; it += G * 8) {
        if (it < WI_0) { const int nb = it / (D / 64), kb = it % (D / 64); const int n0 = nb * 32; const int nv = n0 >= N1 ? 0 : (N1 - n0 < 32 ? N1 - n0 : 32);
            transpose_item(P.in[W_IN] + ((size_t)l * D + kb * 64) * PIN + n0, PIN, nv, WSP(bf16, O_WIN1), D, kb * 64, n0, true, scr, lane); }
        else if (it < WI_1) { const int r = it - WI_0, nb = r / (D / 64), kb = r % (D / 64);
            transpose_item(P.in[W_IN] + ((size_t)l * D + kb * 64) * PIN + N1 + nb * 32, PIN, 32, WSP(bf16, O_WIN2), D, kb * 64, nb * 32, true, scr, lane); }
        else if (it < WI_2) { const int r = it - WI_1, nb = r / (MW / 64), kb = r % (MW / 64);
            transpose_item(P.in[PROJ_M] + ((size_t)l * MW + kb * 64) * D + nb * 32, D, 32, WSP(bf16, O_PM), MW, kb * 64, nb * 32, true, scr, lane); }
        else if (it < WI_3) { const int r = it - WI_2, nb = r / (RW / 64), kb = r % (RW / 64);
            transpose_item(P.in[PROJ_R] + ((size_t)l * RW + kb * 64) * D + nb * 32, D, 32, WSP(bf16, O_PR), RW, kb * 64, nb * 32, true, scr, lane); }
        else if (it < WI_4) { const int r = it - WI_3, nb = r / (D / 64), kb = r % (D / 64);
            transpose_item(P.in[W_OUT] + ((size_t)l * D + kb * 64) * D + nb * 32, D, 32, WSP(bf16, O_WO), D, kb * 64, nb * 32, false, scr, lane); }
        else if (it < WI_5) { const int r = it - WI_4, which = r / ((FF / 32) * (D / 64)), r2 = r % ((FF / 32) * (D / 64)), nb = r2 / (D / 64), kb = r2 % (D / 64);
            const int j0 = nb * 32, pn = j0 >> 7, drow0 = pn * 256 + which * 128 + (j0 & 127);
            transpose_item((which ? P.in[FFN_W3] : P.in[FFN_W1]) + ((size_t)l * D + kb * 64) * FF + j0, FF, 32, WSP(bf16, O_W13), D, kb * 64, drow0, true, scr, lane); }
        else if (it < WI_6) { const int r = it - WI_5, nb = r / (FF / 64), kb = r % (FF / 64);
            transpose_item(P.in[FFN_W2] + ((size_t)l * FF + kb * 64) * D + nb * 32, D, 32, WSP(bf16, O_W2), FF, kb * 64, nb * 32, false, scr, lane); }
        else if (it < WI_7) { const int r = it - WI_6, nb = r / 2, kb = r % 2;
            transpose_item(P.in[R_G2] + ((size_t)l * 128 + kb * 64) * RW + nb * 32, RW, 32, WSP(bf16, O_G2T), 128, kb * 64, nb * 32, false, scr, lane); }
        else { const int r = it - WI_7, which = r / (2 * (RW / 32)), d = (r / (RW / 32)) & 1, nb = r % (RW / 32);
            transpose_item((which ? P.in[R_A2] : P.in[R_W2]) + ((size_t)l * 2 + d) * 64 * RW + nb * 32, RW, 32, WSP(bf16, which ? O_A2T : O_W2T) + (size_t)d * RW * 64, 64, 0, nb * 32, false, scr, lane); }
    }
}
__device__ __forceinline__ void norm_phase(CParams& P, int l, int mode, int vb, int G) {
    const int tid = threadIdx.x, w = tid >> 6, lane = tid & 63;
#define NORM_SRC(m_) ((l == 0 && mode < 2) ? ((m_) < NC ? P.in[X_PROMPT] + (size_t)(m_) * D : P.in[X_SAMPLE] + (size_t)((m_) - NC) * D) : P.out + (size_t)(m_) * D)
    f32x4 vn[D / 256];
    { const int m0 = vb * 8 + w; if (m0 < NT) { const float* xs = NORM_SRC(m0);
#pragma unroll
        for (int j = 0; j < D / 256; ++j) vn[j] = *(const f32x4*)(xs + 256 * j + 4 * lane); } }
    for (int m = vb * 8 + w; m < NT; m += G * 8) {
        float* xr = P.out + (size_t)m * D;
        f32x4 v[D / 256]; float ss = 0.f;
#pragma unroll
        for (int j = 0; j < D / 256; ++j) v[j] = vn[j];
        if (m + G * 8 < NT) { const float* xs = NORM_SRC(m + G * 8);
#pragma unroll
            for (int j = 0; j < D / 256; ++j) vn[j] = *(const f32x4*)(xs + 256 * j + 4 * lane); }
#pragma unroll
        for (int j = 0; j < D / 256; ++j) ss += (v[j][0] * v[j][0] + v[j][1] * v[j][1]) + (v[j][2] * v[j][2] + v[j][3] * v[j][3]);
        const float rs = 1.0f / sqrtf(wave_sum(ss) * (1.0f / D) + RMS_EPS);
        if (mode == 3) {
#pragma unroll
            for (int j = 0; j < D / 256; ++j) { const f32x4 g = *(const f32x4*)(P.in[FINAL_G] + 256 * j + 4 * lane); *(f32x4*)(xr + 256 * j + 4 * lane) = v[j] * rs * g; }
        } else {
            const int second = (mode == 2); const int cond = seqinfo(seq_of_token(m)).cond;
            const float* gp = P.in[second ? NORM2 : NORM1] + (size_t)l * D; const float* mod = WSP(float, WS_MOD) + ((size_t)l * NCOND + cond) * 6 * D + (second ? 3 * D : 0);
            bf16* o = WSP(bf16, mode == 1 ? WS_RXC : WS_QKC) + (size_t)m * D;
#pragma unroll
            for (int j = 0; j < D / 256; ++j) { const int c = 256 * j + 4 * lane; const f32x4 g = *(const f32x4*)(gp + c), sh = *(const f32x4*)(mod + c), sc = *(const f32x4*)(mod + D + c);
                const f32x4 y = v[j] * rs * g * (sc + 1.0f) + sh; u32x2 pk; pk.x = pg8::cvt_pk_bf16(y[0], y[1]); pk.y = pg8::cvt_pk_bf16(y[2], y[3]); *(u32x2*)(o + c) = pk; }
        }
    }
#undef NORM_SRC
}
constexpr int CV_NCH = 2 * MW + RIN, CV_NG = CV_NCH / 4, CV_NCHUNK = (CV_NG + 63) / 64, CV_SEG = 16, CV_PAIRS = NC / (2 * CV_SEG);
static_assert(CV_NCHUNK == 12 && NC == NT - NC && GW % CV_SEG == 0 && CT % CV_SEG == 0 && 2 * MW == 1024 && RX_WL == 1536, "conv item layout");
typedef float f32x2 __attribute__((ext_vector_type(2)));
struct CvAct { float alpha, cA, cB, cC, cD; bool any; };
template <int NR> struct CvState { f32x2 wt[NR * 3][2]; f32x2 fw[NR][3][2]; u32x2 p[3][NR]; };
__device__ __forceinline__ void cv_unpk(const u32x2 p, f32x2 (&f)[2]) { f[0].x = pg8::bflo(p.x); f[0].y = pg8::bfhi(p.x); f[1].x = pg8::bflo(p.y); f[1].y = pg8::bfhi(p.y); }
template <int NR> __device__ __forceinline__ u32x2 cv_ld(const bf16* const (&rowp)[NR], const bool (&rok)[NR], int a, int col, int W) {
    const u32x2 zero2 = {0u, 0u};
    return (rok[a] && col >= 0 && col < W) ? *(const u32x2*)(rowp[a] + (size_t)col * PU) : zero2;
}
template <int NR, int S> __device__ __forceinline__ void cv_col(CvState<NR>& st, const bf16* const (&rowp)[NR], const bool (&rok)[NR], int cs, int W, int o, const CvAct& act, bf16* dst) {
#pragma unroll
    for (int a = 0; a < NR; ++a) { cv_unpk(st.p[S][a], st.fw[a][(S + 2) % 3]); const u32x2 zero2 = {0u, 0u}; st.p[S][a] = (o + 4 <= CV_SEG) ? cv_ld<NR>(rowp, rok, a, cs + o + 4, W) : zero2; }
    f32x2 acc[2];
#pragma unroll
    for (int e = 0; e < 2; ++e) acc[e] = st.wt[0][e] * st.fw[0][S][e];
#pragma unroll
    for (int a = 0; a < NR; ++a)
#pragma unroll
        for (int b = 0; b < 3; ++b) if (a + b > 0) {
#pragma unroll
            for (int e = 0; e < 2; ++e) acc[e] = __builtin_elementwise_fma(st.wt[a * 3 + b][e], st.fw[a][(S + b) % 3][e], acc[e]); }
    float v[4] = {acc[0].x, acc[0].y, acc[1].x, acc[1].y};
    if (act.any) {
#pragma unroll
        for (int e = 0; e < 4; ++e) { const float t = __builtin_amdgcn_rcpf(__builtin_amdgcn_exp2f(act.alpha * v[e]) + 1.0f); v[e] = (act.cA * v[e] + act.cB) * t + (act.cC * v[e] + act.cD); }
    }
    u32x2 pk; pk.x = pg8::cvt_pk_bf16(v[0], v[1]); pk.y = pg8::cvt_pk_bf16(v[2], v[3]);
    *(u32x2*)dst = pk;
}
template <int NR> __device__ __forceinline__ void conv_item(const bf16* const (&rowp)[NR], const bool (&rok)[NR], int cs, int W, const float* wsrc, int CH, const CvAct& act, bf16* dst, int dpitch) {
    CvState<NR> st;
#pragma unroll
    for (int a = 0; a < NR * 3; ++a) { const int tap = NR == 3 ? a : 3 + a; const f32x4 w0 = *(const f32x4*)(wsrc + (size_t)tap * CH);
        st.wt[a][0].x = w0[0]; st.wt[a][0].y = w0[1]; st.wt[a][1].x = w0[2]; st.wt[a][1].y = w0[3]; }
#pragma unroll
    for (int a = 0; a < NR; ++a) { cv_unpk(cv_ld<NR>(rowp, rok, a, cs - 1, W), st.fw[a][0]); cv_unpk(cv_ld<NR>(rowp, rok, a, cs, W), st.fw[a][1]); }
#pragma unroll
    for (int s3 = 0; s3 < 3; ++s3)
#pragma unroll
        for (int a = 0; a < NR; ++a) st.p[s3][a] = cv_ld<NR>(rowp, rok, a, cs + 1 + s3, W);
#pragma unroll 1
    for (int o = 0; o < CV_SEG - 1; o += 3) {
        cv_col<NR, 0>(st, rowp, rok, cs, W, o, act, dst + (size_t)o * dpitch);
        cv_col<NR, 1>(st, rowp, rok, cs, W, o + 1, act, dst + (size_t)(o + 1) * dpitch);
        cv_col<NR, 2>(st, rowp, rok, cs, W, o + 2, act, dst + (size_t)(o + 2) * dpitch);
    }
    cv_col<NR, 0>(st, rowp, rok, cs, W, CV_SEG - 1, act, dst + (size_t)(CV_SEG - 1) * dpitch);
}
__device__ __forceinline__ void conv_phase(LAS unsigned char* lds, CParams& P, int l, int vb, int G) {
    const int tid = threadIdx.x, lane = tid & 63;
    const bf16* U = WSP(bf16, WS_U1);
    LAS unsigned* cnt = (LAS unsigned*)lds;
    for (int sp = vb; sp < CV_PAIRS; sp += G) {
        __syncthreads();
        if (tid == 0) *cnt = 0u;
        __syncthreads();
        for (;;) {
            unsigned j = 0; if (lane == 0) j = __hip_atomic_fetch_add(cnt, 1u, __ATOMIC_RELAXED, __HIP_MEMORY_SCOPE_WORKGROUP);
            j = __builtin_amdgcn_readfirstlane(j);
            if (j >= 48u) break;
            const int cls = j / 12, jj = j % 12, lat = (cls & 1) == 0, heavy = cls < 2, ci = jj >> 1, chunk = heavy ? (ci >= 4 ? 6 + ci : ci) : 4 + ci;
            const int seg = (lat ? NC / CV_SEG : 0) + 2 * sp + (jj & 1), g = chunk * 64 + lane;
            if (g >= CV_NG) continue;
            const int ch = 4 * g; const bool isqk = ch < 2 * MW; const int c = isqk ? ch : ch - 2 * MW;
            const int ucol = isqk ? OFF_QK + c : OFF_R + c, CH = isqk ? 2 * MW : RIN;
            const float* wsrc = (isqk ? P.in[M_CONV] : P.in[R_CONV]) + (size_t)l * 9 * CH + c;
            const int kind = isqk ? (c < MW ? 0 : 1) : (c >= RX_GL ? 4 : (c >= RX_AL ? 2 : (c >= RX_WL ? 3 : 2)));
            CvAct act; act.alpha = kind == 3 ? 2.8853900817779268f : -1.4426950408889634f;
            act.cA = kind == 0 ? 0.08838834764831845f : (kind == 1 ? 1.0f : 0.0f); act.cB = kind == 3 ? -2.0f : (kind == 4 ? 1.0f : 0.0f); act.cC = kind == 2 ? 1.0f : 0.0f; act.cD = kind == 3 ? 1.0f : 0.0f;
            act.any = heavy;
            const int m0 = seg * CV_SEG; const SeqInfo q = seqinfo(seq_of_token(m0)); const int t0 = m0 - q.base;
            bf16* dst = isqk ? WSP(bf16, WS_QKC) + (size_t)m0 * (2 * MW) + c : WSP(bf16, WS_RXC) + (size_t)m0 * RIN + c; const int dpitch = isqk ? 2 * MW : RIN;
            if (q.grid) {
                const int r = t0 / GW, cs = t0 % GW, rows = q.T / GW;
                const bf16* rowp[3]; bool rok[3];
#pragma unroll
                for (int a = 0; a < 3; ++a) { const int rr = r + a - 1; rok[a] = rr >= 0 && rr < rows; rowp[a] = U + (size_t)(q.base + (rok[a] ? rr : r) * GW) * PU + ucol; }
                conv_item<3>(rowp, rok, cs, GW, wsrc, CH, act, dst, dpitch);
            } else {
                const bf16* rowp[1] = {U + (size_t)q.base * PU + ucol}; const bool rok[1] = {true};
                conv_item<1>(rowp, rok, t0, q.T, wsrc, CH, act, dst, dpitch);
            }
        }
    }
}
constexpr int PO_ITEMS = (NT / 16) * 2, PO_HC = RW / 2;
__device__ __forceinline__ void post_phase(LAS unsigned char* lds, CParams& P, int l, int vb, int G) {
    const int tid = threadIdx.x, w = tid >> 6, lane = tid & 63, fr = lane & 15, fq = lane >> 4, l32 = lane & 31, th = lane >> 5;
    constexpr int GP = PO_HC * 2 + 16;
    LAS unsigned char* gt = lds + w * (16 * GP);
    const bf16* U = WSP(bf16, WS_U1); const bf16* RX = WSP(bf16, WS_RXC); const bf16* G2T = WSP(bf16, O_G2T); bf16* O = WSP(bf16, WS_QKC);
    for (int it = vb * 8 + w; it < PO_ITEMS; it += G * 8) {
        const int tile = it >> 1, h = it & 1; const size_t tok0 = (size_t)tile * 16;
        bf16x8 af[4];
#pragma unroll
        for (int ks = 0; ks < 4; ++ks) af[ks] = *(const bf16x8*)(RX + (tok0 + fr) * RIN + RX_GL + 32 * ks + 8 * fq);
        for (int ct = 0; ct < PO_HC / 16; ++ct) { f32x4 acc = (f32x4){0.f, 0.f, 0.f, 0.f};
#pragma unroll
            for (int ks = 0; ks < 4; ++ks) acc = ml::mma(af[ks], *(const bf16x8*)(G2T + (size_t)(h * PO_HC + 16 * ct + fr) * 128 + 32 * ks + 8 * fq), acc);
#pragma unroll
            for (int r = 0; r < 4; ++r) *(LAS bf16*)(gt + (4 * fq + r) * GP + (16 * ct + fr) * 2) = f2bf(acc[r]); }
        asm volatile("s_waitcnt lgkmcnt(0)" ::: "memory");
        const int cb = h * PO_HC + 8 * l32;
        float gn[8], gw[8], gb[8], rk[8];
        { const f32x4 a0 = *(const f32x4*)(P.in[M_NORM_G] + (size_t)l * MW + cb), a1 = *(const f32x4*)(P.in[M_NORM_G] + (size_t)l * MW + cb + 4);
          const f32x4 b0 = *(const f32x4*)(P.in[R_GN_W] + (size_t)l * RW + cb), b1 = *(const f32x4*)(P.in[R_GN_W] + (size_t)l * RW + cb + 4);
          const f32x4 c0 = *(const f32x4*)(P.in[R_GN_B] + (size_t)l * RW + cb), c1 = *(const f32x4*)(P.in[R_GN_B] + (size_t)l * RW + cb + 4);
          const f32x4 d0 = *(const f32x4*)(P.in[R_RK] + (size_t)l * RW + cb), d1 = *(const f32x4*)(P.in[R_RK] + (size_t)l * RW + cb + 4);
#pragma unroll
          for (int e = 0; e < 4; ++e) { gn[e] = a0[e]; gn[4 + e] = a1[e]; gw[e] = b0[e]; gw[4 + e] = b1[e]; gb[e] = c0[e]; gb[4 + e] = c1[e]; rk[e] = d0[e]; rk[4 + e] = d1[e]; } }
        for (int tp = 0; tp < 8; ++tp) { const int tl = 2 * tp + th; const size_t m = tok0 + tl; const bf16* u = U + m * PU; const bf16* rx = RX + m * RIN;
            float hf[8], hb[8], ov[8], x[8]; unpack8(*(const u32x4*)(u + cb), hf); unpack8(*(const u32x4*)(u + MW + cb), hb); unpack8(*(const u32x4*)(u + OFF_O + cb), ov);
            float ss = 0.f;
#pragma unroll
            for (int e = 0; e < 8; ++e) { x[e] = hf[e] + hb[e]; ss += x[e] * x[e]; }
            ss = rw::allsum16(ss); const float rs = 1.0f / sqrtf(ss * (1.0f / 128.f) + RMS_EPS);
#pragma unroll
            for (int e = 0; e < 8; ++e) x[e] = x[e] * rs * gn[e] * pg8::fsigmoid(ov[e]);
            *(u32x4*)(O + m * D + cb) = pack8(x);
            float yf[8], yb[8], rr[8], kk[8], vv[8], gg[8], y[8]; unpack8(*(const u32x4*)(u + OFF_R + cb), yf); unpack8(*(const u32x4*)(u + OFF_R + RW + cb), yb);
            unpack8(*(const u32x4*)(rx + RX_R + cb), rr); unpack8(*(const u32x4*)(rx + RX_K + cb), kk); unpack8(*(const u32x4*)(rx + RX_V + cb), vv);
            unpack8(*(const LAS u32x4*)(gt + tl * GP + l32 * 16), gg);
            float mu = 0.f, bs = 0.f;
#pragma unroll
            for (int e = 0; e < 8; ++e) { y[e] = yf[e] + yb[e]; mu += y[e]; bs += rr[e] * kk[e] * rk[e]; }
            mu += rw::dpp_xor1(mu); mu += rw::dpp_xor2(mu); mu += __shfl_xor(mu, 4); mu *= (1.0f / 64.f);
            bs += rw::dpp_xor1(bs); bs += rw::dpp_xor2(bs); bs += __shfl_xor(bs, 4);
            float var = 0.f;
#pragma unroll
            for (int e = 0; e < 8; ++e) { y[e] -= mu; var += y[e] * y[e]; }
            var += rw::dpp_xor1(var); var += rw::dpp_xor2(var); var += __shfl_xor(var, 4); var *= (1.0f / 64.f);
            const float rsd = 1.0f / sqrtf(var + GN_EPS);
#pragma unroll
            for (int e = 0; e < 8; ++e) y[e] = (y[e] * rsd * gw[e] + gb[e] + bs * vv[e]) * gg[e];
            *(u32x4*)(O + m * D + MW + cb) = pack8(y);
        }
        asm volatile("s_waitcnt lgkmcnt(0)" ::: "memory");
    }
}
}

constexpr int LDS_BYTES = 147456;
constexpr int LDS_MISC = 147456 - 1024;
constexpr size_t CTL_ZERO_BYTES = 262144;
constexpr int CW_BAR = 4096, CW_Q = 8192;

#define XB_TMO      128
#define XB_XCNT(j)  (256  + 64 * (j))
#define XB_XSUB(j)  (1280 + 64 * (j))
#define XB_XGEN(j)  (2304 + 64 * (j))
#define XB_TOP      3328
#define XB_TOPGEN   3392
#define XCD_BAR_WORDS 3456
#define XB_SPIN_CAP (1u << 18)
__device__ __forceinline__ unsigned xb_ld(unsigned* p)              { return __hip_atomic_load(p, __ATOMIC_RELAXED, __HIP_MEMORY_SCOPE_AGENT); }
__device__ __forceinline__ unsigned xb_add(unsigned* p, unsigned v) { return __hip_atomic_fetch_add(p, v, __ATOMIC_RELAXED, __HIP_MEMORY_SCOPE_AGENT); }
__device__ __forceinline__ unsigned xb_xcc_id() { return (unsigned)__builtin_amdgcn_s_getreg((3 << 11) | 20) & 0xFu; }
#define XB_SPIN(cond, bar) do { unsigned _sp = 0; while (cond) { __builtin_amdgcn_s_sleep(1); \
    if ((++_sp & 255u) == 0u) { if (xb_ld(&(bar)[XB_TMO])) break; if (_sp > XB_SPIN_CAP) { atomicAdd(&(bar)[XB_TMO], 1u); break; } } } } while (0)
struct XcdBarrier { unsigned* bar; unsigned x; volatile LAS unsigned* st; };
__device__ __forceinline__ XcdBarrier xcd_barrier_post(unsigned* bar, volatile LAS unsigned* st) {
    XcdBarrier b; b.bar = bar; b.x = xb_xcc_id(); b.st = st;
    if (threadIdx.x == 0) (void)xb_add(&bar[XB_XCNT(b.x)], 1u);
    return b;
}
__device__ __forceinline__ void xcd_barrier_complete(unsigned* bar, unsigned x, unsigned& nloc, unsigned& nx) {
    const unsigned G = gridDim.x * gridDim.y * gridDim.z;
    unsigned sum, cnt, mine, sp = 0u;
    for (;;) {
        sum = 0u; cnt = 0u; mine = 0u;
#pragma unroll
        for (unsigned j = 0; j < 16; ++j) { const unsigned c = xb_ld(&bar[XB_XCNT(j)]); sum += c; cnt += (c > 0u) ? 1u : 0u; mine = (j == x) ? c : mine; }
        if (sum == G) break;
        __builtin_amdgcn_s_sleep(1);
        if ((++sp & 255u) == 0u) { if (xb_ld(&bar[XB_TMO])) break; if (sp > XB_SPIN_CAP) { atomicAdd(&bar[XB_TMO], 1u); break; } }
    }
    nloc = mine > 0u ? mine : 1u; nx = cnt > 0u ? cnt : 1u;
}
__device__ __forceinline__ void xcd_barrier(const XcdBarrier& b) {
    asm volatile("s_waitcnt vmcnt(0)" ::: "memory");
    __syncthreads();
    if (threadIdx.x == 0) {
        unsigned* bar = b.bar;
        __builtin_amdgcn_s_waitcnt(0);
        unsigned nloc = b.st[0], nx = b.st[1];
        if (nloc == 0u) { xcd_barrier_complete(bar, b.x, nloc, nx); b.st[0] = nloc; b.st[1] = nx; }
        const unsigned old = xb_add(&bar[XB_XSUB(b.x)], 1u);
        const unsigned gen = old / nloc;
        if (old + 1u == (gen + 1u) * nloc) {
            __builtin_amdgcn_fence(__ATOMIC_RELEASE, "agent");
            asm volatile("s_waitcnt vmcnt(0)" ::: "memory");
            const unsigned og = xb_add(&bar[XB_TOP], 1u);
            const unsigned tg = og / nx;
            if (og + 1u == (tg + 1u) * nx) xb_add(&bar[XB_TOPGEN], 1u);
            else XB_SPIN(xb_ld(&bar[XB_TOPGEN]) == tg, bar);
            __builtin_amdgcn_fence(__ATOMIC_ACQUIRE, "agent");
            xb_add(&bar[XB_XGEN(b.x)], 1u);
            asm volatile("s_waitcnt vmcnt(0)" ::: "memory");
        } else {
            XB_SPIN(xb_ld(&bar[XB_XGEN(b.x)]) == gen, bar);
            __builtin_amdgcn_fence(__ATOMIC_ACQUIRE, "agent");
            asm volatile("s_waitcnt vmcnt(0)" ::: "memory");
        }
    }
    __syncthreads();
}

constexpr int MX_RL = LB * RH * 2 * 4, MX_ML = LB * MH * 2 * ml::NVB, MX_RC = CB * RH * 2 * 4, MX_MC = CB * MH * 2 * ml::NVB;
constexpr int MX_ITEMS = MX_RL + MX_ML + MX_RC + MX_MC;

constexpr int ML_SPLIT = 0;
__device__ __forceinline__ void scan_phase(LAS unsigned char* lds, CParams& P, int l, unsigned* ctl) {
    unsigned* qhead = ctl + CW_Q + 64 * l;
    const bool split = gridDim.x >= 4 * wy::N_LAT * (1 + wy::NPROD) / 2;
    volatile LAS unsigned* bc = (volatile LAS unsigned*)(lds + LDS_MISC) + 16;
    for (;;) {
        if (threadIdx.x == 0) bc[0] = xb_add(qhead, 1u);
        __syncthreads();
        const int it = (int)bc[0];
        __syncthreads();
        if (!split || it >= wy::N_LAT) break;
        int s_, head, dir; wy::decode_item(it, s_, head, dir);
        wy::rwkv_cons(lds, P, l, s_, head, dir, it, ctl);
    }
    for (;;) {
        if (threadIdx.x == 0) bc[0] = xb_add(qhead + 8, 1u);
        __syncthreads();
        const int it = (int)bc[0];
        __syncthreads();
        if (it >= ML_SPLIT * ms::N_MLAT) break;
        int s_, head, dir, sub; ml::decode_item(it * ml::NVB, s_, head, dir, sub);
        ms::ml_cons(lds, P, l, s_, head, dir, it, ctl);
    }
    for (;;) {
        if (threadIdx.x == 0) bc[0] = xb_add(qhead + 48, 1u);
        __syncthreads();
        const int it = (int)bc[0];
        __syncthreads();
        if (!split || it >= wy::N_LAT * wy::NPROD) break;
        const int chain = it % wy::N_LAT;
        int s_, head, dir; wy::decode_item(chain, s_, head, dir);
        wy::rwkv_prod(lds, P, l, s_, head, dir, chain, it / wy::N_LAT, ctl);
    }
    for (;;) {
        if (threadIdx.x == 0) bc[0] = xb_add(qhead + 24, 1u);
        __syncthreads();
        const int it = (int)bc[0];
        __syncthreads();
        if (it >= ML_SPLIT * ms::N_MLAT * ms::MLPROD) break;
        const int chain = it % ms::N_MLAT;
        int s_, head, dir, sub; ml::decode_item(chain * ml::NVB, s_, head, dir, sub);
        ms::ml_prod(lds, P, l, s_, head, dir, chain, it / ms::N_MLAT, ctl);
    }
    for (;;) {
        if (threadIdx.x == 0) bc[0] = xb_add(qhead + 16, 1u);
        __syncthreads();
        const int it = (int)bc[0] + ML_SPLIT * ms::N_MLAT * ml::NVB;
        __syncthreads();
        if (it >= ml::N_ITEMS) break;
        int s_, head, dir, sub; ml::decode_item(it, s_, head, dir, sub);
        ml::mlstm_item2(lds, P, l, s_, head, dir, sub);
    }
    for (;;) {
        if (threadIdx.x == 0) bc[0] = xb_add(qhead + 32, 1u);
        __syncthreads();
        const int it = (int)bc[0] + (split ? LB * RH * 2 : 0);
        __syncthreads();
        if (it >= wy::N_ITEMS) break;
        int s_, head, dir; wy::decode_item(it, s_, head, dir);
        wy::rwkv_item(lds, P, l, s_, head, dir);
    }
}

enum { ST_N0 = 0, ST_A1, ST_CV, ST_MX, ST_PO, ST_N1, ST_A2, ST_PJ, ST_WO, ST_N2, ST_F1, ST_F2, ST_PER_LAYER };
constexpr int N_STEPS = 1 + DEPTH * ST_PER_LAYER + 1;
struct MkArgs { Params P; int ph_lo, ph_hi; };
__global__ void __launch_bounds__(512, 2) mk(MkArgs a) {
    extern __shared__ __attribute__((aligned(16))) unsigned char lds_raw[];
    LAS unsigned char* lds = (LAS unsigned char*)lds_raw;
    const int G = gridDim.x, vb = (int)blockIdx.x;
    unsigned* ctl = (unsigned*)(a.P.ws + WS_CTL);
    volatile LAS unsigned* MISC = (volatile LAS unsigned*)(lds + LDS_MISC);
    for (int u = threadIdx.x; u < 64; u += 512) MISC[u] = 0u;
    __syncthreads();
    const bool multi = a.ph_hi - a.ph_lo > 1;
    XcdBarrier bar; bar.bar = ctl + CW_BAR; bar.x = 0; bar.st = nullptr;
    if (multi) bar = xcd_barrier_post(ctl + CW_BAR, MISC + 8);
    const int lo = a.ph_lo, hi = a.ph_hi;
    const int fuse = (multi && lo == 0 && hi == N_STEPS && G == (NT / pg8::BM) * (D / pg8::BM)) ? 1 : 0;
#define STEP_BEGIN(id) if (lo <= (id) && (id) < hi) { unsigned long long kp_ = (unsigned long long)__builtin_amdgcn_kernarg_segment_ptr(); asm volatile("" : "+s"(kp_)); CParams& P = *(CParams*)kp_;
#define STEP_END(id) if ((id) + 1 < hi) xcd_barrier(bar); }
    STEP_BEGIN(0) el::init_phase(lds, P, vb, G); el::wconv_phase(lds, P, 0, vb, G); STEP_END(0)
#define LAYER(l) { \
        const int base = 1 + (l) * ST_PER_LAYER; \
        STEP_BEGIN(base + ST_N0) if ((l) > 0) el::wconv_phase(lds, P, (l), vb, G); if ((l) == 0 || !fuse) el::norm_phase(P, (l), 0, vb, G); STEP_END(base + ST_N0) \
        STEP_BEGIN(base + ST_A1) { pg8::Gemm g{WSP(bf16, WS_QKC), WSP(bf16, O_WIN1), D, D}; pg8::StaticOrder S; S.init(NT, N1P, G, vb); \
            pg8::EpiA1 E{WSP(bf16, WS_U1)}; pg8::gemm_phase(lds, g, S, E); } STEP_END(base + ST_A1) \
        STEP_BEGIN(base + ST_CV) el::conv_phase(lds, P, (l), vb, G); STEP_END(base + ST_CV) \
        STEP_BEGIN(base + ST_MX) scan_phase(lds, P, (l), ctl); STEP_END(base + ST_MX) \
        STEP_BEGIN(base + ST_PO) el::post_phase(lds, P, (l), vb, G); STEP_END(base + ST_PO) \
        STEP_BEGIN(base + ST_N1) el::norm_phase(P, (l), 1, vb, G); STEP_END(base + ST_N1) \
        STEP_BEGIN(base + ST_A2) { pg8::Gemm g{WSP(bf16, WS_RXC), WSP(bf16, O_WIN2), D, D}; pg8::StaticOrder S; S.init(NT, 2 * D, G, vb); \
            pg8::EpiA2 E{WSP(bf16, WS_U1)}; pg8::gemm_phase(lds, g, S, E); } STEP_END(base + ST_A2) \
        STEP_BEGIN(base + ST_PJ) { pg8::Gemm g{WSP(bf16, WS_QKC), WSP(bf16, O_PM), MW, D}; pg8::PairOrder S; S.init(NT, G, vb); \
            pg8::EpiPJ E{WSP(bf16, WS_U1)}; pg8::gemm_phase(lds, g, S, E); } STEP_END(base + ST_PJ) \
        STEP_BEGIN(base + ST_WO) { pg8::Gemm g{WSP(bf16, WS_U1), WSP(bf16, O_WO), D, PU}; pg8::StaticOrder S; S.init(NT, D, G, vb); \
            pg8::EpiResNorm E{P.out, WSP(float, WS_MOD) + (size_t)(l) * NCOND * 6 * D + 2 * D, (l) == 0 ? P.in[X_PROMPT] : nullptr, (l) == 0 ? P.in[X_SAMPLE] : nullptr, \
                fuse, P.in[NORM2] + (size_t)(l) * D, WSP(float, WS_MOD) + (size_t)(l) * NCOND * 6 * D + 3 * D, WSP(bf16, WS_QKC), P.ws, 1u + 2u * (l), lds}; pg8::gemm_phase(lds, g, S, E); } STEP_END(base + ST_WO) \
        if (!fuse) { STEP_BEGIN(base + ST_N2) el::norm_phase(P, (l), 2, vb, G); STEP_END(base + ST_N2) } \
        STEP_BEGIN(base + ST_F1) { pg8::Gemm g{WSP(bf16, WS_QKC), WSP(bf16, O_W13), D, D}; pg8::StaticOrder S; S.init(NT, 2 * FF, G, vb); \
            pg8::EpiF1 E{WSP(bf16, WS_U1)}; pg8::gemm_phase(lds, g, S, E); } STEP_END(base + ST_F1) \
        STEP_BEGIN(base + ST_F2) { pg8::Gemm g{WSP(bf16, WS_U1), WSP(bf16, O_W2), FF, FF}; pg8::StaticOrder S; S.init(NT, D, G, vb); \
            pg8::EpiResNorm E{P.out, WSP(float, WS_MOD) + (size_t)(l) * NCOND * 6 * D + 5 * D, nullptr, nullptr, fuse, \
                (l) + 1 < DEPTH ? P.in[NORM1] + (size_t)((l) + 1) * D : P.in[FINAL_G], (l) + 1 < DEPTH ? WSP(float, WS_MOD) + (size_t)((l) + 1) * NCOND * 6 * D : nullptr, \
                (l) + 1 < DEPTH ? WSP(bf16, WS_QKC) : nullptr, P.ws, 2u + 2u * (l), lds}; pg8::gemm_phase(lds, g, S, E); } \
            if ((l) + 1 < DEPTH || !fuse) { if (base + ST_F2 + 1 < hi) xcd_barrier(bar); } } \
    }
    static_assert(DEPTH == 2, "layers are unrolled by hand");
    LAYER(0)
    LAYER(1)
#undef LAYER
    if (!fuse) { STEP_BEGIN(N_STEPS - 1) el::norm_phase(P, 0, 3, vb, G); STEP_END(N_STEPS - 1) }
#undef STEP_BEGIN
#undef STEP_END
}
#endif

typedef void (*BodyFn)(const Params&, long);
#ifndef HOST_EMU
template <BodyFn F, int BLOCK> __global__ void __launch_bounds__(BLOCK) run_k(Params P, long n) {
    const long i = (long)blockIdx.x * BLOCK + threadIdx.x;
    if (i < n) F(P, i);
}
#define RUN(F, BLOCK, n) do { const long n_ = (n); run_k<F, BLOCK><<<dim3((unsigned)((n_ + BLOCK - 1) / BLOCK)), dim3(BLOCK), 0, stream>>>(P, n_); } while (0)
static int g_grid = 0;
#else
#define RUN(F, BLOCK, n) do { const long n_ = (n); for (long i_ = 0; i_ < n_; ++i_) F(P, i_); } while (0)
typedef void* hipStream_t;
#endif

static void forward(Params P, hipStream_t stream) {
    (void)stream;
#ifndef HOST_EMU
    if (hipMemsetAsync(P.ws + WS_CTL, 0, CTL_ZERO_BYTES, stream) != hipSuccess) return;
#ifdef MK_PER_STEP
    for (int st = 0; st < N_STEPS; ++st) { MkArgs a_{}; a_.P = P; a_.ph_lo = st; a_.ph_hi = st + 1; mk<<<dim3(g_grid), dim3(512), LDS_BYTES, stream>>>(a_); }
#else
    { MkArgs a_{}; a_.P = P; a_.ph_lo = 0; a_.ph_hi = N_STEPS; mk<<<dim3(g_grid), dim3(512), LDS_BYTES, stream>>>(a_); }
#endif
#else
    RUN(k_init_x, 256, (long)NT * D);
    RUN(k_mod, 256, (long)DEPTH * NCOND * 6 * D);
    for (int l = 0; l < DEPTH; ++l) {
        P.layer = l;
        RUN(k_wconv, 256, WC_N6);
        P.mode = 0; RUN(k_norm, 64, (long)NT);
        RUN(k_gemm_a1, 256, (long)NT * N1);
        RUN(k_conv, 256, (long)NT * (2 * MW + RIN));
        RUN(k_mlstm, 128, (long)NSEQ * MH * 2 * 128);
        for (int dir = 0; dir < 2; ++dir) { P.mode = dir; RUN(k_rwkv_prep, 256, (long)NT * RW); RUN(k_rwkv, 64, (long)NSEQ * RH * 64); }
        RUN(k_post, 256, (long)NT * D);
        P.mode = 1; RUN(k_norm, 64, (long)NT);
        RUN(k_gemm_a2, 256, (long)NT * 2 * D);
        RUN(k_gemm_pj, 256, (long)NT * D);
        RUN(k_gemm_wo, 256, (long)NT * D);
        P.mode = 2; RUN(k_norm, 64, (long)NT);
        RUN(k_gemm_f1, 256, (long)NT * FF);
        RUN(k_gemm_f2, 256, (long)NT * D);
    }
    RUN(k_final, 64, (long)NT);
#endif
}

#ifndef HOST_EMU
extern "C" void kernel_launch(void* const* d_in, const int* in_sizes, int n_in, void* d_out, int out_size, void* d_ws, size_t ws_size, hipStream_t stream) {
    if (n_in != N_IN || (size_t)out_size != OUT_END || ws_size < WS_END) return;
    if (g_grid == 0) {
        int dev = 0, cus = 0;
        if (hipGetDevice(&dev) != hipSuccess || hipDeviceGetAttribute(&cus, hipDeviceAttributeMultiprocessorCount, dev) != hipSuccess) { g_grid = -1; return; }
        if (hipFuncSetAttribute((const void*)mk, hipFuncAttributeMaxDynamicSharedMemorySize, LDS_BYTES) != hipSuccess) { g_grid = -1; return; }
        g_grid = cus;
    }
    if (g_grid < 0) return;
    Params P{};
    for (int i = 0; i < N_IN; ++i) P.in[i] = (const float*)d_in[i];
    P.out = (float*)d_out; P.ws = (unsigned char*)d_ws; P.layer = 0; P.mode = 0;
    forward(P, stream);
}
#endif
```

```cpp
#ifndef HOST_EMU
#include <hip/hip_runtime.h>
#define HD __host__ __device__ __forceinline__
#define DEV __device__ __forceinline__
#else
#include <cmath>
#include <cstring>
#include <cstdio>
#include <cstdlib>
#define HD inline
#define DEV inline
#endif
#include <cstddef>

#ifdef SMALL_CFG
constexpr int D = 256, CB = 2, CT = 128, DEPTH = 2, LB = 1, LT = 256, GW = 16;
#else
constexpr int D = 1024, CB = 32, CT = 256, DEPTH = 2, LB = 2, LT = 4096, GW = 64;
#endif
constexpr int MW = D / 2, MD = 128, MH = MW / MD, RW = D / 2, RD = 64, RH = RW / RD;
constexpr int RIN = 3 * RW + 384, FF = ((8 * D + 767) / 768) * 256, PIN = 2 * MW + MW + MW + 4 * MH + RIN + 2 * D;
constexpr int NC = CB * CT, NL = LB * LT, NT = NC + NL, NSEQ = CB + LB, NCOND = 1 + LB;
constexpr int N1 = PIN - 2 * D;
constexpr int N1P = ((N1 + 255) / 256) * 256;
constexpr int PU = N1;
constexpr int OFF_QK = 0, OFF_V = 2 * MW, OFF_O = 3 * MW, OFF_G = 4 * MW, OFF_R = 4 * MW + 4 * MH;
constexpr int RX_R = 0, RX_K = RW, RX_V = 2 * RW, RX_WL = 3 * RW, RX_AL = 3 * RW + 128, RX_GL = 3 * RW + 256;
constexpr float RMS_EPS = 1e-6f, GN_EPS = 64e-5f;
static_assert(3 * D <= N1, "G + merged must fit the dead columns of U1");

enum { X_PROMPT = 0, X_SAMPLE, ST_C, ST_N, ST_M, ST_R, C_LAT, C_CTX, ADA_W, ADA_B, NORM1, NORM2, W_IN, M_CONV, M_GATE_B, M_NORM_G,
       R_CONV, R_W0, R_W2, R_A0, R_A2, R_G2, R_KK, R_KA, R_RK, R_GN_W, R_GN_B, PROJ_M, PROJ_R, W_OUT, FFN_W1, FFN_W3, FFN_W2, FINAL_G, N_IN };

constexpr size_t OUT_X = 0;
constexpr size_t OUT_C = (size_t)NT * D;
constexpr size_t OUT_N = OUT_C + (size_t)CB * DEPTH * 2 * MH * 128 * 128;
constexpr size_t OUT_M = OUT_N + (size_t)CB * DEPTH * 2 * MH * 128;
constexpr size_t OUT_S = OUT_M + (size_t)CB * DEPTH * 2 * MH;
constexpr size_t OUT_END = OUT_S + (size_t)CB * DEPTH * 2 * RH * 64 * 64;

constexpr size_t al256(size_t x) { return (x + 255) & ~(size_t)255; }
constexpr size_t cmax(size_t a, size_t b) { return a > b ? a : b; }
constexpr size_t WS_CTL = 0;
constexpr size_t WS_MOD = (size_t)1 << 20;
constexpr size_t WS_WREG = (size_t)2 << 20;
constexpr size_t O_WIN1 = WS_WREG;
constexpr size_t O_WIN2 = O_WIN1 + (size_t)N1P * D * 2;
constexpr size_t O_PM = O_WIN2 + (size_t)2 * D * D * 2;
constexpr size_t O_PR = O_PM + (size_t)D * MW * 2;
constexpr size_t O_WO = O_PR + (size_t)D * RW * 2;
constexpr size_t O_W13 = O_WO + (size_t)D * D * 2;
constexpr size_t O_W2 = O_W13 + (size_t)2 * FF * D * 2;
constexpr size_t O_G2T = O_W2 + (size_t)D * FF * 2;
constexpr size_t O_W2T = O_G2T + (size_t)RW * 128 * 2;
constexpr size_t O_A2T = O_W2T + (size_t)2 * RW * 64 * 2;
constexpr size_t WS_U1 = al256(O_A2T + (size_t)2 * RW * 64 * 2);
constexpr size_t SZ_U1 = al256(cmax((size_t)NT * PU * 2, (size_t)NT * FF * 2));
constexpr size_t WS_QKC = WS_U1 + SZ_U1;
constexpr size_t WS_RXC = WS_QKC + (size_t)NT * D * 2;
constexpr size_t WS_END = WS_RXC + al256(cmax((size_t)NT * RIN * 2, (size_t)NT * D * 2));
#ifndef SMALL_CFG
static_assert(WS_END <= ((size_t)256 << 20), "workspace map must fit 256 MiB");
#endif

typedef unsigned short bf16;
HD float bf2f(bf16 b) { unsigned u = ((unsigned)b) << 16; return __builtin_bit_cast(float, u); }
#if defined(__HIP_DEVICE_COMPILE__)
HD bf16 f2bf(float f) { return __builtin_bit_cast(bf16, (__bf16)f); }
#else
HD bf16 f2bf(float f) { unsigned u = __builtin_bit_cast(unsigned, f); u += 0x7fffu + ((u >> 16) & 1u); return (bf16)(u >> 16); }
#endif
HD float sigmoidf_(float x) { return 1.0f / (1.0f + expf(-x)); }
HD float siluf_(float x) { return x / (1.0f + expf(-x)); }
HD float softplusf_(float x) { return fmaxf(x, 0.f) + log1pf(expf(-fabsf(x))); }
HD float logsigmoidf_(float x) { return -softplusf_(-x); }
HD int prow(int c) { return (c & ~31) | (((c >> 2) & 1) << 4) | (((c >> 3) & 3) << 2) | (c & 3); }

struct Params {
    const float* in[N_IN];
    float* out;
    unsigned char* ws;
    int layer;
    int mode;
};

struct SeqInfo { int T; int base; int grid; int cond; int b; };
HD SeqInfo seqinfo(int s) {
    SeqInfo q;
    if (s < CB) { q.T = CT; q.base = s * CT; q.grid = 0; q.cond = 0; q.b = s; }
    else { q.T = LT; q.base = NC + (s - CB) * LT; q.grid = 1; q.cond = 1 + (s - CB); q.b = s - CB; }
    return q;
}
HD int seq_of_token(int m) { return m < NC ? m / CT : CB + (m - NC) / LT; }

#define WSP(T, off) ((T*)(P.ws + (off)))

DEV void k_init_x(const Params& P, long i) {
    const size_t ncd = (size_t)NC * D;
    P.out[i] = (size_t)i < ncd ? P.in[X_PROMPT][i] : P.in[X_SAMPLE][i - ncd];
}
DEV void k_mod(const Params& P, long i) {
    const int j = (int)(i % (6 * D)); const int ci = (int)((i / (6 * D)) % NCOND); const int l = (int)(i / ((long)6 * D * NCOND));
    const float* cv = ci == 0 ? P.in[C_CTX] : P.in[C_LAT] + (size_t)(ci - 1) * D;
    const float* w = P.in[ADA_W] + (size_t)l * D * 6 * D;
    float acc = P.in[ADA_B][(size_t)l * 6 * D + j];
    for (int k = 0; k < D; ++k) acc += siluf_(cv[k]) * w[(size_t)k * 6 * D + j];
    WSP(float, WS_MOD)[i] = acc;
}
constexpr long WC_N0 = (long)N1P * D, WC_N1 = WC_N0 + (long)2 * D * D, WC_N2 = WC_N1 + (long)D * MW, WC_N3 = WC_N2 + (long)D * RW,
               WC_N4 = WC_N3 + (long)D * D, WC_N5 = WC_N4 + (long)2 * FF * D, WC_N6 = WC_N5 + (long)D * FF;
HD int unprow(int r) { return (r & ~31) | (((r >> 2) & 3) << 3) | (((r >> 4) & 1) << 2) | (r & 3); }
DEV void k_wconv(const Params& P, long i) {
    const int l = P.layer;
    if (i < WC_N0) { const int r = (int)(i / D), k = (int)(i % D); const int c = unprow(r);
        WSP(bf16, O_WIN1)[i] = c < N1 ? f2bf(P.in[W_IN][((size_t)l * D + k) * PIN + c]) : (bf16)0; return; }
    if (i < WC_N1) { const long j = i - WC_N0; const int r = (int)(j / D), k = (int)(j % D); const int c = unprow(r);
        WSP(bf16, O_WIN2)[j] = f2bf(P.in[W_IN][((size_t)l * D + k) * PIN + N1 + c]); return; }
    if (i < WC_N2) { const long j = i - WC_N1; const int r = (int)(j / MW), k = (int)(j % MW); const int c = unprow(r);
        WSP(bf16, O_PM)[j] = f2bf(P.in[PROJ_M][((size_t)l * MW + k) * D + c]); return; }
    if (i < WC_N3) { const long j = i - WC_N2; const int r = (int)(j / RW), k = (int)(j % RW); const int c = unprow(r);
        WSP(bf16, O_PR)[j] = f2bf(P.in[PROJ_R][((size_t)l * RW + k) * D + c]); return; }
    if (i < WC_N4) { const long j = i - WC_N3; const int r = (int)(j / D), k = (int)(j % D);
        WSP(bf16, O_WO)[j] = f2bf(P.in[W_OUT][((size_t)l * D + k) * D + r]); return; }
    if (i < WC_N5) { const long j = i - WC_N4; const int r = (int)(j / D), k = (int)(j % D);
        const int pn = r >> 8, rl = r & 255, which = rl >> 7, rho = rl & 127; const int jj = pn * 128 + unprow(rho);
        const float* W = which ? P.in[FFN_W3] : P.in[FFN_W1];
        WSP(bf16, O_W13)[j] = f2bf(W[((size_t)l * D + k) * FF + jj]); return; }
    { const long j = i - WC_N5; const int r = (int)(j / FF), k = (int)(j % FF);
        WSP(bf16, O_W2)[j] = f2bf(P.in[FFN_W2][((size_t)l * FF + k) * D + r]); }
}
DEV void k_norm(const Params& P, long m) {
    const int l = P.layer; const int second = (P.mode == 2);
    const float* x = P.out + (size_t)m * D;
    const float* g = P.in[second ? NORM2 : NORM1] + (size_t)l * D;
    const int cond = seqinfo(seq_of_token((int)m)).cond;
    const float* mod = WSP(float, WS_MOD) + ((size_t)l * NCOND + cond) * 6 * D + (second ? 3 * D : 0);
    float ss = 0.f;
    for (int k = 0; k < D; ++k) ss += x[k] * x[k];
    const float rs = 1.0f / sqrtf(ss / D + RMS_EPS);
    bf16* o = WSP(bf16, P.mode == 1 ? WS_RXC : WS_QKC) + (size_t)m * D;
    for (int k = 0; k < D; ++k) o[k] = f2bf(x[k] * rs * g[k] * (1.0f + mod[D + k]) + mod[k]);
}
DEV float dot_bf(const bf16* a, const bf16* b, int K) { float s = 0.f; for (int k = 0; k < K; ++k) s += bf2f(a[k]) * bf2f(b[k]); return s; }
DEV void k_gemm_a1(const Params& P, long i) {
    const int n = (int)(i % N1); const long m = i / N1;
    WSP(bf16, WS_U1)[(size_t)m * PU + n] = f2bf(dot_bf(WSP(bf16, WS_QKC) + (size_t)m * D, WSP(bf16, O_WIN1) + (size_t)prow(n) * D, D));
}
DEV void k_gemm_a2(const Params& P, long i) {
    const int n = (int)(i % (2 * D)); const long m = i / (2 * D);
    WSP(bf16, WS_U1)[(size_t)m * PU + D + n] = f2bf(sigmoidf_(dot_bf(WSP(bf16, WS_RXC) + (size_t)m * D, WSP(bf16, O_WIN2) + (size_t)prow(n) * D, D)));
}
DEV void k_gemm_pj(const Params& P, long i) {
    const int n = (int)(i % D); const long m = i / D;
    const bf16* hmr = WSP(bf16, WS_QKC) + (size_t)m * D; bf16* u = WSP(bf16, WS_U1) + (size_t)m * PU;
    const float a = dot_bf(hmr, WSP(bf16, O_PM) + (size_t)prow(n) * MW, MW), b = dot_bf(hmr + MW, WSP(bf16, O_PR) + (size_t)prow(n) * RW, RW);
    const float first = bf2f(f2bf(bf2f(u[D + n]) * a));
    u[n] = f2bf(first + bf2f(u[2 * D + n]) * b);
}
DEV void k_gemm_wo(const Params& P, long i) {
    const int n = (int)(i % D); const long m = i / D; const int l = P.layer;
    const int cond = seqinfo(seq_of_token((int)m)).cond;
    const float g1 = WSP(float, WS_MOD)[((size_t)l * NCOND + cond) * 6 * D + 2 * D + n];
    P.out[(size_t)m * D + n] += g1 * dot_bf(WSP(bf16, WS_U1) + (size_t)m * PU, WSP(bf16, O_WO) + (size_t)n * D, D);
}
DEV void k_gemm_f1(const Params& P, long i) {
    const int j = (int)(i % FF); const long m = i / FF;
    const int pn = j >> 7, rho = prow(j & 127);
    const bf16* h = WSP(bf16, WS_QKC) + (size_t)m * D;
    const float a = dot_bf(h, WSP(bf16, O_W13) + (size_t)(pn * 256 + rho) * D, D), b = dot_bf(h, WSP(bf16, O_W13) + (size_t)(pn * 256 + 128 + rho) * D, D);
    WSP(bf16, WS_U1)[(size_t)m * FF + j] = f2bf(siluf_(a) * b);
}
DEV void k_gemm_f2(const Params& P, long i) {
    const int n = (int)(i % D); const long m = i / D; const int l = P.layer;
    const int cond = seqinfo(seq_of_token((int)m)).cond;
    const float g2 = WSP(float, WS_MOD)[((size_t)l * NCOND + cond) * 6 * D + 5 * D + n];
    P.out[(size_t)m * D + n] += g2 * dot_bf(WSP(bf16, WS_U1) + (size_t)m * FF, WSP(bf16, O_W2) + (size_t)n * FF, FF);
}
DEV void k_conv(const Params& P, long i) {
    constexpr int NCH = 2 * MW + RIN;
    const int ch = (int)(i % NCH); const int m = (int)(i / NCH); const int l = P.layer;
    const int s = seq_of_token(m); const SeqInfo q = seqinfo(s); const int t = m - q.base;
    const bool isqk = ch < 2 * MW; const int c = isqk ? ch : ch - 2 * MW;
    const int ucol = isqk ? OFF_QK + c : OFF_R + c;
    const int CH = isqk ? 2 * MW : RIN;
    const float* w = (isqk ? P.in[M_CONV] : P.in[R_CONV]) + (size_t)l * 9 * CH;
    const bf16* U = WSP(bf16, WS_U1);
    float acc = 0.f;
    if (q.grid) {
        const int r = t / GW, cc = t % GW, rows = q.T / GW;
        for (int a = 0; a < 3; ++a) for (int b = 0; b < 3; ++b) {
            const int rr = r + a - 1, c2 = cc + b - 1;
            if (rr >= 0 && rr < rows && c2 >= 0 && c2 < GW) acc += w[(a * 3 + b) * CH + c] * bf2f(U[(size_t)(q.base + rr * GW + c2) * PU + ucol]);
        }
    } else {
        for (int b = 0; b < 3; ++b) { const int t2 = t + b - 1; if (t2 >= 0 && t2 < q.T) acc += w[(3 + b) * CH + c] * bf2f(U[(size_t)(q.base + t2) * PU + ucol]); }
    }
    if (isqk) { float v = siluf_(acc); if (c < MW) v *= 0.08838834764831845f; WSP(bf16, WS_QKC)[(size_t)m * (2 * MW) + c] = f2bf(v); }
    else { float v = acc; if (c >= RX_WL && c < RX_AL) v = tanhf(v); else if (c >= RX_GL) v = sigmoidf_(v); WSP(bf16, WS_RXC)[(size_t)m * RIN + c] = f2bf(v); }
}
DEV void k_mlstm(const Params& P, long i) {
    const int e = (int)(i % 128); const int chain = (int)(i / 128); const int dir = chain & 1, head = (chain >> 1) % MH, s = chain / (2 * MH);
    const int l = P.layer; const SeqInfo q = seqinfo(s);
    float C[128], n[128]; float m;
    if (!q.grid) {
#pragma unroll
        for (int d = 0; d < 128; ++d) { C[d] = 0.f; n[d] = 0.f; }
        m = 0.f;
    } else {
        const size_t sb = (((size_t)q.b * DEPTH + l) * 2 + dir) * MH + head;
#pragma unroll
        for (int d = 0; d < 128; ++d) { C[d] = P.in[ST_C][(sb * 128 + d) * 128 + e]; n[d] = P.in[ST_N][sb * 128 + d]; }
        m = P.in[ST_M][sb];
    }
    const float bi = P.in[M_GATE_B][(size_t)l * 4 * MH + (2 * dir) * MH + head], bfg = P.in[M_GATE_B][(size_t)l * 4 * MH + (2 * dir + 1) * MH + head];
    bf16* U = WSP(bf16, WS_U1); const bf16* QK = WSP(bf16, WS_QKC);
    float nsel = 0.f;
    for (int p = 0; p < q.T; ++p) {
        const int t = dir ? q.T - 1 - p : p; const size_t tok = (size_t)(q.base + t);
        const bf16* qk = QK + tok * (2 * MW); bf16* u = U + tok * PU;
        const float gi = bf2f(u[OFF_G + (2 * dir) * MH + head]) + bi, gf = bf2f(u[OFF_G + (2 * dir + 1) * MH + head]) + bfg;
        const float lf = logsigmoidf_(gf);
        const float mn = fmaxf(lf + m, gi); const float fw = expf(lf + m - mn), iw = expf(gi - mn);
        const float v = bf2f(u[OFF_V + head * 128 + e]);
        float num = 0.f, den = 0.f;
#pragma unroll
        for (int d = 0; d < 128; ++d) {
            const float kd = bf2f(qk[MW + head * 128 + d]), qd = bf2f(qk[head * 128 + d]);
            C[d] = fw * C[d] + iw * kd * v; n[d] = fw * n[d] + iw * kd; num += qd * C[d]; den += qd * n[d];
        }
        m = mn;
        u[dir * MW + head * 128 + e] = f2bf(num / fmaxf(fabsf(den), expf(-m)));
    }
    if (!q.grid) {
        const size_t sb = (((size_t)q.b * DEPTH + l) * 2 + dir) * MH + head;
#pragma unroll
        for (int d = 0; d < 128; ++d) { P.out[OUT_C + (sb * 128 + d) * 128 + e] = C[d]; if (d == e) nsel = n[d]; }
        P.out[OUT_N + sb * 128 + e] = nsel;
        if (e == 0) P.out[OUT_M + sb] = m;
    }
}
DEV void k_rwkv_prep(const Params& P, long i) {
    const int c = (int)(i % RW); const size_t tok = (size_t)(i / RW); const int l = P.layer, dir = P.mode;
    const bf16* rx = WSP(bf16, WS_RXC) + tok * RIN;
    const float* w2 = P.in[R_W2] + ((size_t)l * 2 + dir) * 64 * RW + c; const float* a2 = P.in[R_A2] + ((size_t)l * 2 + dir) * 64 * RW + c;
    float wr = P.in[R_W0][((size_t)l * 2 + dir) * RW + c], ar = P.in[R_A0][((size_t)l * 2 + dir) * RW + c];
    for (int j = 0; j < 64; ++j) { wr += bf2f(rx[RX_WL + dir * 64 + j]) * w2[(size_t)j * RW]; ar += bf2f(rx[RX_AL + dir * 64 + j]) * a2[(size_t)j * RW]; }
    bf16* o = WSP(bf16, WS_QKC) + tok * (2 * RW);
    o[c] = f2bf(wr); o[RW + c] = f2bf(ar);
}
DEV void k_rwkv(const Params& P, long i) {
    const int row = (int)(i % 64); const int chain = (int)(i / 64); const int dir = P.mode, head = chain % RH, s = chain / RH;
    const int l = P.layer; const SeqInfo q = seqinfo(s); const int hc = head * 64;
    float S[64];
    if (!q.grid) {
#pragma unroll
        for (int c = 0; c < 64; ++c) S[c] = 0.f;
    } else {
        const size_t sb = (((size_t)q.b * DEPTH + l) * 2 + dir) * RH + head;
#pragma unroll
        for (int c = 0; c < 64; ++c) S[c] = P.in[ST_R][(sb * 64 + row) * 64 + c];
    }
    const float* rkk = P.in[R_KK] + (size_t)l * RW + hc; const float* rka = P.in[R_KA] + (size_t)l * RW + hc;
    bf16* U = WSP(bf16, WS_U1); const bf16* RX = WSP(bf16, WS_RXC); const bf16* WA = WSP(bf16, WS_QKC);
    for (int p = 0; p < q.T; ++p) {
        const int t = dir ? q.T - 1 - p : p; const size_t tok = (size_t)(q.base + t);
        const bf16* rx = RX + tok * RIN; const bf16* wa = WA + tok * (2 * RW);
        float ss = 0.f;
        for (int c = 0; c < 64; ++c) { const float kc = bf2f(rx[RX_K + hc + c]) * rkk[c]; ss += kc * kc; }
        const float inv = 1.0f / fmaxf(sqrtf(ss), 1e-12f);
        float sa = 0.f;
#pragma unroll
        for (int c = 0; c < 64; ++c) sa -= S[c] * (bf2f(rx[RX_K + hc + c]) * rkk[c] * inv);
        const float v = bf2f(rx[RX_V + hc + row]);
        float y = 0.f;
#pragma unroll
        for (int c = 0; c < 64; ++c) {
            const float wr = bf2f(wa[hc + c]), ar = bf2f(wa[RW + hc + c]);
            const float decay = expf(-0.6065306597126334f * sigmoidf_(wr));
            const float alpha = sigmoidf_(ar);
            const float kr = bf2f(rx[RX_K + hc + c]);
            const float kt = kr * (1.0f + (alpha - 1.0f) * rka[c]);
            const float bb = kr * rkk[c] * inv * alpha;
            S[c] = S[c] * decay + sa * bb + v * kt;
            y += S[c] * bf2f(rx[RX_R + hc + c]);
        }
        U[tok * PU + OFF_R + dir * RW + hc + row] = f2bf(y);
    }
    if (!q.grid) {
        const size_t sb = (((size_t)q.b * DEPTH + l) * 2 + dir) * RH + head;
#pragma unroll
        for (int c = 0; c < 64; ++c) P.out[OUT_S + (sb * 64 + row) * 64 + c] = S[c];
    }
}
DEV void k_post(const Params& P, long i) {
    const int ch = (int)(i % D); const size_t m = (size_t)(i / D); const int l = P.layer;
    const bf16* u = WSP(bf16, WS_U1) + m * PU; const bf16* rx = WSP(bf16, WS_RXC) + m * RIN;
    bf16* o = WSP(bf16, WS_QKC) + m * D;
    if (ch < MW) {
        const int h0 = (ch / 128) * 128; float ss = 0.f;
        for (int d = 0; d < 128; ++d) { const float x = bf2f(u[h0 + d]) + bf2f(u[MW + h0 + d]); ss += x * x; }
        const float x = bf2f(u[ch]) + bf2f(u[MW + ch]);
        o[ch] = f2bf(x / sqrtf(ss / 128.f + RMS_EPS) * P.in[M_NORM_G][(size_t)l * MW + ch] * sigmoidf_(bf2f(u[OFF_O + ch])));
    } else {
        const int c = ch - MW; const int h0 = (c / 64) * 64;
        float mu = 0.f, bsum = 0.f;
        for (int d = 0; d < 64; ++d) { mu += bf2f(u[OFF_R + h0 + d]) + bf2f(u[OFF_R + RW + h0 + d]);
            bsum += bf2f(rx[RX_R + h0 + d]) * bf2f(rx[RX_K + h0 + d]) * P.in[R_RK][(size_t)l * RW + h0 + d]; }
        mu *= (1.0f / 64.f); float var = 0.f;
        for (int d = 0; d < 64; ++d) { const float x = bf2f(u[OFF_R + h0 + d]) + bf2f(u[OFF_R + RW + h0 + d]) - mu; var += x * x; }
        var *= (1.0f / 64.f);
        const float y = bf2f(u[OFF_R + c]) + bf2f(u[OFF_R + RW + c]);
        const float yn = (y - mu) / sqrtf(var + GN_EPS) * P.in[R_GN_W][(size_t)l * RW + c] + P.in[R_GN_B][(size_t)l * RW + c];
        float gate = 0.f;
        for (int j = 0; j < 128; ++j) gate += bf2f(rx[RX_GL + j]) * P.in[R_G2][((size_t)l * 128 + j) * RW + c];
        o[ch] = f2bf((yn + bsum * bf2f(rx[RX_V + c])) * gate);
    }
}
DEV void k_final(const Params& P, long m) {
    float* x = P.out + (size_t)m * D; float ss = 0.f;
    for (int k = 0; k < D; ++k) ss += x[k] * x[k];
    const float rs = 1.0f / sqrtf(ss / D + RMS_EPS);
    for (int k = 0; k < D; ++k) x[k] = x[k] * rs * P.in[FINAL_G][k];
}


#ifndef HOST_EMU
typedef const __attribute__((address_space(4))) Params CParams;
namespace pg8 {
#define PG8_LAS __attribute__((address_space(3)))
typedef short bf16x8 __attribute__((ext_vector_type(8)));
typedef float f32x4 __attribute__((ext_vector_type(4)));
typedef unsigned u32x4 __attribute__((ext_vector_type(4)));
constexpr int BM = 256, BK = 64, HALF = 128, HTB = HALF * BK * 2, STAGE_BYTES = 8 * HTB, NXCD = 8, WGM = 8;
__device__ __forceinline__ int lds_byte(int r, int c) { const int st = (r >> 4) * 2 + (c >> 5), rr = r & 15, cc = c & 31, ob = rr * 64 + cc * 2; return st * 1024 + (ob ^ (((ob >> 9) & 1) << 5)); }
__device__ __forceinline__ void stage_rc(int b, int& R, int& C) { const int st = b / 1024, sb = b % 1024, swz = sb ^ (((sb >> 9) & 1) << 5); R = (st >> 1) * 16 + swz / 64; C = (st & 1) * 32 + (swz % 64) / 2; }
struct Unit { int pm, pn, aoff; };
struct Gemm { const bf16* A; const bf16* Bt; int K, lda; };
struct StaticOrder {
    int nM, nN, nwg, G, c;
    __device__ __forceinline__ void init(int M, int N, int G_, int c_) { nM = M / BM; nN = N / BM; nwg = nM * nN; G = G_; c = c_; }
    __device__ __forceinline__ bool next(int i, Unit& u) const {
        const long L = (long)i * G + c; if (L >= nwg) return false;
        int wgid = (int)L; { const int q = nwg / NXCD, r = nwg % NXCD, xcd = wgid % NXCD, off = wgid / NXCD; wgid = (xcd < r ? xcd * (q + 1) : r * (q + 1) + (xcd - r) * q) + off; }
        const int nig = WGM * nN, gid = wgid / nig, fm = gid * WGM, gsz = (nM - fm) < WGM ? (nM - fm) : WGM;
        u.pm = fm + ((wgid % nig) % gsz); u.pn = (wgid % nig) / gsz; u.aoff = 0; return true;
    }
};
struct PairOrder {
    int nbase, G, v, nct;
    __device__ __forceinline__ void init(int M, int G_, int c_) { nct = D / BM; nbase = (M / BM) * nct; G = G_; v = (G_ % 8 == 0) ? (c_ % 8) * (G_ / 8) + c_ / 8 : c_; }
    __device__ __forceinline__ bool next(int i, Unit& u) const {
        const int j = v + (i >> 1) * G; if (j >= nbase) return false;
        const int half = i & 1; u.pm = j / nct; u.pn = half * nct + (j % nct); u.aoff = half * MW; return true;
    }
};
typedef float f32x2_t __attribute__((ext_vector_type(2)));
typedef __bf16 bf16x2_t __attribute__((ext_vector_type(2)));
__device__ __forceinline__ unsigned cvt_pk_bf16(float lo, float hi) { f32x2_t v = {lo, hi}; bf16x2_t b = __builtin_convertvector(v, bf16x2_t); return __builtin_bit_cast(unsigned, b); }
__device__ __forceinline__ float fsigmoid(float x) { return __builtin_amdgcn_rcpf(1.0f + __expf(-x)); }
__device__ __forceinline__ float bflo(unsigned w) { return __builtin_bit_cast(float, w << 16); }
__device__ __forceinline__ float bfhi(unsigned w) { return __builtin_bit_cast(float, w & 0xffff0000u); }

struct EpiA1 {
    bf16* U;
    __device__ __forceinline__ void operator()(const f32x4 (&acc)[2][2][4][2], const Unit& u, int wr, int wc, int fr, int fq) const {
        const int row0 = u.pm * BM + wr * 64 + fr, col0 = u.pn * BM + wc * 32 + 8 * fq;
#pragma unroll
        for (int ai = 0; ai < 2; ++ai)
#pragma unroll
            for (int m = 0; m < 4; ++m) { bf16* rowp = U + (size_t)(row0 + ai * HALF + m * 16) * PU + col0;
#pragma unroll
                for (int bj = 0; bj < 2; ++bj) { if (col0 + bj * HALF < N1) { const f32x4 v0 = acc[ai][bj][m][0], v1 = acc[ai][bj][m][1];
                    u32x4 w; w.x = cvt_pk_bf16(v0[0], v0[1]); w.y = cvt_pk_bf16(v0[2], v0[3]); w.z = cvt_pk_bf16(v1[0], v1[1]); w.w = cvt_pk_bf16(v1[2], v1[3]);
                    *(u32x4*)(rowp + bj * HALF) = w; } } }
    }
};
struct EpiA2 {
    bf16* U;
    __device__ __forceinline__ void operator()(const f32x4 (&acc)[2][2][4][2], const Unit& u, int wr, int wc, int fr, int fq) const {
        const int row0 = u.pm * BM + wr * 64 + fr, col0 = D + u.pn * BM + wc * 32 + 8 * fq;
#pragma unroll
        for (int ai = 0; ai < 2; ++ai)
#pragma unroll
            for (int m = 0; m < 4; ++m) { bf16* rowp = U + (size_t)(row0 + ai * HALF + m * 16) * PU + col0;
#pragma unroll
                for (int bj = 0; bj < 2; ++bj) { const f32x4 v0 = acc[ai][bj][m][0], v1 = acc[ai][bj][m][1];
                    u32x4 w; w.x = cvt_pk_bf16(fsigmoid(v0[0]), fsigmoid(v0[1])); w.y = cvt_pk_bf16(fsigmoid(v0[2]), fsigmoid(v0[3]));
                    w.z = cvt_pk_bf16(fsigmoid(v1[0]), fsigmoid(v1[1])); w.w = cvt_pk_bf16(fsigmoid(v1[2]), fsigmoid(v1[3]));
                    *(u32x4*)(rowp + bj * HALF) = w; } }
    }
};
struct EpiPJ {
    bf16* U;
    __device__ __forceinline__ void operator()(const f32x4 (&acc)[2][2][4][2], const Unit& u, int wr, int wc, int fr, int fq) const {
        const int nct = D / BM, half = u.pn >= nct ? 1 : 0, ct = u.pn - half * nct;
        const int row0 = u.pm * BM + wr * 64 + fr, col0 = ct * BM + wc * 32 + 8 * fq;
#pragma unroll
        for (int ai = 0; ai < 2; ++ai)
#pragma unroll
            for (int mp = 0; mp < 4; mp += 2) { u32x4 gq[2][2], pq[2][2];
#pragma unroll
                for (int mm = 0; mm < 2; ++mm) { const bf16* rowp = U + (size_t)(row0 + ai * HALF + (mp + mm) * 16) * PU + col0;
#pragma unroll
                    for (int bj = 0; bj < 2; ++bj) { gq[mm][bj] = *(const u32x4*)(rowp + (1 + half) * D + bj * HALF); if (half) pq[mm][bj] = *(const u32x4*)(rowp + bj * HALF); } }
#pragma unroll
                for (int mm = 0; mm < 2; ++mm) { const int m = mp + mm; bf16* rowp = U + (size_t)(row0 + ai * HALF + m * 16) * PU + col0;
#pragma unroll
                    for (int bj = 0; bj < 2; ++bj) { const f32x4 v0 = acc[ai][bj][m][0], v1 = acc[ai][bj][m][1]; const u32x4 g = gq[mm][bj];
                        float o[8] = { bflo(g.x) * v0[0], bfhi(g.x) * v0[1], bflo(g.y) * v0[2], bfhi(g.y) * v0[3], bflo(g.z) * v1[0], bfhi(g.z) * v1[1], bflo(g.w) * v1[2], bfhi(g.w) * v1[3] };
                        if (half) { const u32x4 p = pq[mm][bj];
                            o[0] += bflo(p.x); o[1] += bfhi(p.x); o[2] += bflo(p.y); o[3] += bfhi(p.y); o[4] += bflo(p.z); o[5] += bfhi(p.z); o[6] += bflo(p.w); o[7] += bfhi(p.w); }
                        u32x4 w; w.x = cvt_pk_bf16(o[0], o[1]); w.y = cvt_pk_bf16(o[2], o[3]); w.z = cvt_pk_bf16(o[4], o[5]); w.w = cvt_pk_bf16(o[6], o[7]);
                        *(u32x4*)(rowp + bj * HALF) = w; } }
                asm volatile("" ::: "memory"); }
    }
};
struct EpiRes {
    float* X; const float* gate;
    const float* sa; const float* sb;
    __device__ __forceinline__ void operator()(const f32x4 (&acc)[2][2][4][2], const Unit& u, int wr, int wc, int fr, int fq) const {
        const int row0 = u.pm * BM + wr * 64 + fr, col0 = u.pn * BM + wc * 32 + 4 * fq;
        const float* S = sa ? (u.pm * BM < NC ? sa : sb - (size_t)NC * D) : X;
        const int cond = seqinfo(seq_of_token(u.pm * BM)).cond;
        const float* gp = gate + (size_t)cond * 6 * D + col0;
        f32x4 gv[2][2];
#pragma unroll
        for (int bj = 0; bj < 2; ++bj)
#pragma unroll
            for (int n = 0; n < 2; ++n) gv[bj][n] = *(const f32x4*)(gp + bj * HALF + n * 16);
#pragma unroll
        for (int ai = 0; ai < 2; ++ai)
#pragma unroll
            for (int m = 0; m < 4; ++m) { const size_t ro = (size_t)(row0 + ai * HALF + m * 16) * D + col0; float* rowp = X + ro; const float* srow = S + ro;
#pragma unroll
                for (int bj = 0; bj < 2; ++bj)
#pragma unroll
                    for (int n = 0; n < 2; ++n) { *(f32x4*)(rowp + bj * HALF + n * 16) = *(const f32x4*)(srow + bj * HALF + n * 16) + gv[bj][n] * acc[ai][bj][m][n]; }
                asm volatile("" ::: "memory"); }
    }
};
typedef unsigned u32x2 __attribute__((ext_vector_type(2)));
constexpr int CW_NX = 45056, CW_NX_STRIDE = 16, NX_EXCH_BYTE = 512 * 1024, NX_LDS = 131072;
struct EpiResNorm {
    float* X; const float* gate; const float* sa; const float* sb;
    int fuse;
    const float* ng; const float* nmod;
    bf16* H;
    unsigned char* ctlb; unsigned epoch; PG8_LAS unsigned char* lds;
    __device__ __forceinline__ void operator()(const f32x4 (&acc_)[2][2][4][2], const Unit& u, int wr, int wc, int fr, int fq) const {
        f32x4 (&acc)[2][2][4][2] = const_cast<f32x4 (&)[2][2][4][2]>(acc_);
        const int tid = threadIdx.x;
        const int row0 = u.pm * BM + wr * 64 + fr, col0 = u.pn * BM + wc * 32 + 4 * fq;
        const int cond = seqinfo(seq_of_token(u.pm * BM)).cond;
        const float* S = sa ? (u.pm * BM < NC ? sa : sb - (size_t)NC * D) : X;
        { const float* gp = gate + (size_t)cond * 6 * D + col0;
          f32x4 gv[2][2];
#pragma unroll
          for (int bj = 0; bj < 2; ++bj)
#pragma unroll
              for (int n = 0; n < 2; ++n) gv[bj][n] = *(const f32x4*)(gp + bj * HALF + n * 16);
#pragma unroll
          for (int ai = 0; ai < 2; ++ai)
#pragma unroll
              for (int mp = 0; mp < 4; mp += 2) { f32x4 xr[2][2][2];
#pragma unroll
                  for (int mm = 0; mm < 2; ++mm) { const float* srow = S + (size_t)(row0 + ai * HALF + (mp + mm) * 16) * D + col0;
#pragma unroll
                      for (int bj = 0; bj < 2; ++bj)
#pragma unroll
                          for (int n = 0; n < 2; ++n) xr[mm][bj][n] = *(const f32x4*)(srow + bj * HALF + n * 16); }
#pragma unroll
                  for (int mm = 0; mm < 2; ++mm) { const int m = mp + mm; float* rowp = X + (size_t)(row0 + ai * HALF + m * 16) * D + col0;
#pragma unroll
                      for (int bj = 0; bj < 2; ++bj)
#pragma unroll
                          for (int n = 0; n < 2; ++n) { const f32x4 xn = xr[mm][bj][n] + gv[bj][n] * acc[ai][bj][m][n]; acc[ai][bj][m][n] = xn;
                              if (!fuse || H) *(f32x4*)(rowp + bj * HALF + n * 16) = xn; } }
                  asm volatile("" ::: "memory"); } }
        if (!fuse) return;
        PG8_LAS float* red = (PG8_LAS float*)(lds + NX_LDS); PG8_LAS float* rsl = red + 1024;
#pragma unroll
        for (int ai = 0; ai < 2; ++ai)
#pragma unroll
            for (int m = 0; m < 4; ++m) { float sacc = 0.f;
#pragma unroll
                for (int bj = 0; bj < 2; ++bj)
#pragma unroll
                    for (int n = 0; n < 2; ++n) { const f32x4 v = acc[ai][bj][m][n]; sacc += (v[0] * v[0] + v[1] * v[1]) + (v[2] * v[2] + v[3] * v[3]); }
                sacc += __shfl_xor(sacc, 16); sacc += __shfl_xor(sacc, 32);
                if (fq == 0) red[(ai * HALF + wr * 64 + m * 16 + fr) * 4 + wc] = sacc; }
        __syncthreads();
        unsigned* flags = (unsigned*)ctlb + CW_NX; float* exch = (float*)(ctlb + NX_EXCH_BYTE);
        float mine = 0.f;
        if (tid < BM) { const f32x4 r4 = *(const PG8_LAS f32x4*)(red + tid * 4); mine = (r4[0] + r4[1]) + (r4[2] + r4[3]);
            float* gp = exch + ((size_t)(u.pm * 4 + u.pn) * BM + tid);
            asm volatile("global_store_dword %0, %1, off sc1" :: "v"(gp), "v"(mine) : "memory"); }
        asm volatile("s_waitcnt vmcnt(0)" ::: "memory");
        __syncthreads();
        if (tid == 0) {
            __hip_atomic_store(flags + (u.pm * 4 + u.pn) * CW_NX_STRIDE, epoch, __ATOMIC_RELAXED, __HIP_MEMORY_SCOPE_AGENT);
            unsigned* tmo = (unsigned*)ctlb + 4096 + 128;
#pragma unroll 1
            for (int q = 0; q < 4; ++q) { if (q == u.pn) continue; unsigned sp = 0;
                while (__hip_atomic_load(flags + (u.pm * 4 + q) * CW_NX_STRIDE, __ATOMIC_RELAXED, __HIP_MEMORY_SCOPE_AGENT) < epoch) { __builtin_amdgcn_s_sleep(1);
                    if ((++sp & 255u) == 0u) { if (__hip_atomic_load(tmo, __ATOMIC_RELAXED, __HIP_MEMORY_SCOPE_AGENT)) break; if (sp > (1u << 18)) { atomicAdd(tmo, 1u); break; } } } }
            __builtin_amdgcn_fence(__ATOMIC_ACQUIRE, "agent");
        }
        asm volatile("s_waitcnt vmcnt(0)" ::: "memory");
        __syncthreads();
        if (tid < BM) { float tot = mine;
#pragma unroll
            for (int q = 0; q < 4; ++q) if (q != u.pn) tot += exch[(size_t)(u.pm * 4 + q) * BM + tid];
            rsl[tid] = 1.0f / sqrtf(tot * (1.0f / D) + 1e-6f); }
        __syncthreads();
        f32x4 g4[2][2], sc4[2][2], sh4[2][2];
#pragma unroll
        for (int bj = 0; bj < 2; ++bj)
#pragma unroll
            for (int n = 0; n < 2; ++n) { const int c = col0 + bj * HALF + n * 16; g4[bj][n] = *(const f32x4*)(ng + c);
                if (nmod) { sh4[bj][n] = *(const f32x4*)(nmod + (size_t)cond * 6 * D + c); sc4[bj][n] = *(const f32x4*)(nmod + (size_t)cond * 6 * D + D + c) + 1.0f; g4[bj][n] = g4[bj][n] * sc4[bj][n]; }
                else sh4[bj][n] = (f32x4){0.f, 0.f, 0.f, 0.f}; }
#pragma unroll
        for (int ai = 0; ai < 2; ++ai)
#pragma unroll
            for (int m = 0; m < 4; ++m) { const int rl = ai * HALF + wr * 64 + m * 16 + fr; const float r = rsl[rl]; const size_t ro = (size_t)(u.pm * BM + rl) * D + col0;
#pragma unroll
                for (int bj = 0; bj < 2; ++bj)
#pragma unroll
                    for (int n = 0; n < 2; ++n) { const f32x4 y = acc[ai][bj][m][n] * r * g4[bj][n] + sh4[bj][n];
                        if (H) { u32x2 pk; pk.x = cvt_pk_bf16(y[0], y[1]); pk.y = cvt_pk_bf16(y[2], y[3]); *(u32x2*)(H + ro + bj * HALF + n * 16) = pk; }
                        else *(f32x4*)(X + ro + bj * HALF + n * 16) = y; } }
    }
};
struct EpiF1 {
    bf16* Hd;
    __device__ __forceinline__ void operator()(const f32x4 (&acc)[2][2][4][2], const Unit& u, int wr, int wc, int fr, int fq) const {
        const int row0 = u.pm * BM + wr * 64 + fr, col0 = u.pn * HALF + wc * 32 + 8 * fq;
#pragma unroll
        for (int ai = 0; ai < 2; ++ai)
#pragma unroll
            for (int m = 0; m < 4; ++m) { bf16* rowp = Hd + (size_t)(row0 + ai * HALF + m * 16) * FF + col0;
                float o[8];
#pragma unroll
                for (int n = 0; n < 2; ++n)
#pragma unroll
                    for (int e = 0; e < 4; ++e) { const float a = acc[ai][0][m][n][e], b = acc[ai][1][m][n][e]; o[n * 4 + e] = a * fsigmoid(a) * b; }
                u32x4 w; w.x = cvt_pk_bf16(o[0], o[1]); w.y = cvt_pk_bf16(o[2], o[3]); w.z = cvt_pk_bf16(o[4], o[5]); w.w = cvt_pk_bf16(o[6], o[7]);
                *(u32x4*)rowp = w; }
    }
};

template <class Epi, class Sched, bool ALIGN_EPI = true, bool SP2 = true>
__device__ __forceinline__ void gemm_phase(PG8_LAS unsigned char* lds, const Gemm g, const Sched& S, const Epi& E) {
    const int tid = threadIdx.x, wid = __builtin_amdgcn_readfirstlane(tid >> 6), lane = tid & 63, wr = wid >> 2, wc = wid & 3, fr = lane & 15, fq = lane >> 4;
    const int K = g.K, nt = K / BK;
    unsigned voffA[2], voffB[2];
#pragma unroll
    for (int i = 0; i < 2; ++i) { int R, C; stage_rc(tid * 16 + i * 8192, R, C);
        voffA[i] = (unsigned)(R * g.lda + C) * 2u; voffB[i] = (unsigned)(R * K + C) * 2u; }
    const size_t kstep = (size_t)(BK * 2);
    const size_t hstepA = (size_t)HALF * g.lda * 2, hstepB = (size_t)HALF * K * 2;
    const size_t tstepA = 2 * hstepA, tstepB = 2 * hstepB;
    const unsigned ldsw = (unsigned)wid * 1024u;
    const int aoff = lds_byte(wr * 64 + fr, fq * 8), boff = lds_byte(wc * 32 + fr, fq * 8);
#define PG8_SA(b, h) (((b) * 2 + (h)) * HTB)
#define PG8_SB(b, h) ((4 + (b) * 2 + (h)) * HTB)
#define PG8_STAGE(bufoff, gbase, voff) do { _Pragma("unroll") for (int _i = 0; _i < 2; ++_i) \
        __builtin_amdgcn_global_load_lds((const unsigned*)((const char*)(gbase) + (voff)[_i]), (PG8_LAS unsigned*)(lds + (bufoff) + ldsw + _i * 8192), 16, 0, 0); } while (0)
#define PG8_LDA(dst, b, h) do { _Pragma("unroll") for (int m = 0; m < 4; ++m) _Pragma("unroll") for (int k = 0; k < 2; ++k) dst[m][k] = *(const PG8_LAS bf16x8*)(lds + PG8_SA(b, h) + aoff + m * 2048 + k * 1024); } while (0)
#define PG8_LDB(dst, b, h) do { _Pragma("unroll") for (int n = 0; n < 2; ++n) _Pragma("unroll") for (int k = 0; k < 2; ++k) dst[n][k] = *(const PG8_LAS bf16x8*)(lds + PG8_SB(b, h) + boff + n * 2048 + k * 1024); } while (0)
#define PG8_MMA(ai, bj, At, Bt) do { __builtin_amdgcn_s_setprio(1); _Pragma("unroll") for (int m = 0; m < 4; ++m) _Pragma("unroll") for (int n = 0; n < 2; ++n) _Pragma("unroll") for (int k = 0; k < 2; ++k) \
        acc[ai][bj][m][n] = __builtin_amdgcn_mfma_f32_16x16x32_bf16(Bt[n][k], At[m][k], acc[ai][bj][m][n], 0, 0, 0); __builtin_amdgcn_s_setprio(0); } while (0)
#define PG8_WAIT_V(n) asm volatile("s_waitcnt vmcnt(" #n ")" ::: "memory")
#define PG8_WAIT_L(n) asm volatile("s_waitcnt lgkmcnt(" #n ")" ::: "memory")
#define PG8_BAR __builtin_amdgcn_s_barrier()
#define PG8_SCHED __builtin_amdgcn_sched_barrier(0)
    Unit cur, nxt; int ui = 0;
    if (!S.next(0, cur)) return;
    f32x4 acc[2][2][4][2];
#pragma unroll
    for (int a = 0; a < 2; ++a)
#pragma unroll
        for (int b = 0; b < 2; ++b)
#pragma unroll
            for (int m = 0; m < 4; ++m)
#pragma unroll
                for (int n = 0; n < 2; ++n) acc[a][b][m][n] = (f32x4){0.f, 0.f, 0.f, 0.f};
    bf16x8 At[4][2], B0[2][2], B1[2][2];
    const char* cA = (const char*)g.A + (size_t)cur.pm * tstepA + (size_t)cur.aoff * 2; const char* cB = (const char*)g.Bt + (size_t)cur.pn * tstepB;
    if constexpr (SP2) {
        PG8_STAGE(PG8_SB(0, 0), cB, voffB); PG8_STAGE(PG8_SB(0, 1), cB + hstepB, voffB); PG8_STAGE(PG8_SA(0, 0), cA, voffA); PG8_STAGE(PG8_SA(0, 1), cA + hstepA, voffA);
        if (wr == 1) PG8_BAR;
        PG8_WAIT_V(2); PG8_BAR;
        PG8_STAGE(PG8_SB(1, 0), cB + kstep, voffB); PG8_STAGE(PG8_SA(1, 0), cA + kstep, voffA); PG8_STAGE(PG8_SB(1, 1), cB + hstepB + kstep, voffB);
        PG8_WAIT_V(6); PG8_BAR;
    } else {
        PG8_STAGE(PG8_SB(0, 0), cB, voffB); PG8_STAGE(PG8_SA(0, 0), cA, voffA); PG8_STAGE(PG8_SB(0, 1), cB + hstepB, voffB); PG8_STAGE(PG8_SA(0, 1), cA + hstepA, voffA);
        if (wr == 1) PG8_BAR;
        PG8_WAIT_V(4); PG8_BAR;
        PG8_STAGE(PG8_SB(1, 0), cB + kstep, voffB); PG8_STAGE(PG8_SA(1, 0), cA + kstep, voffA); PG8_STAGE(PG8_SB(1, 1), cB + hstepB + kstep, voffB);
        PG8_WAIT_V(6); PG8_BAR;
    }
    for (;;) {
        const bool has_next = S.next(ui + 1, nxt);
        const char* nA = has_next ? (const char*)g.A + (size_t)nxt.pm * tstepA + (size_t)nxt.aoff * 2 : cA; const char* nB = has_next ? (const char*)g.Bt + (size_t)nxt.pn * tstepB : cB;
        for (int t = 0; t < nt; t += 2) {
            const bool last = (t == nt - 2);
            const char* a1 = cA + (size_t)(t + 1) * kstep;
            const char* a2 = last ? nA : cA + (size_t)(t + 2) * kstep; const char* b2 = last ? nB : cB + (size_t)(t + 2) * kstep;
            const char* a3 = a2 + kstep; const char* b3 = b2 + kstep;
            if constexpr (SP2) {
            PG8_LDB(B0, 0, 0); PG8_LDB(B1, 0, 1); PG8_SCHED; PG8_LDA(At, 0, 0); PG8_STAGE(PG8_SA(1, 1), a1 + hstepA, voffA);
            PG8_WAIT_V(8); PG8_WAIT_L(0); PG8_BAR; PG8_MMA(0, 0, At, B0); PG8_MMA(0, 1, At, B1); PG8_BAR; PG8_SCHED;
            PG8_LDA(At, 0, 1); PG8_STAGE(PG8_SB(0, 0), b2, voffB); PG8_STAGE(PG8_SB(0, 1), b2 + hstepB, voffB); PG8_STAGE(PG8_SA(0, 0), a2, voffA);
            PG8_WAIT_V(8); PG8_WAIT_L(0); PG8_BAR; PG8_MMA(1, 0, At, B0); PG8_MMA(1, 1, At, B1); PG8_BAR; PG8_SCHED;
            PG8_LDB(B0, 1, 0); PG8_LDB(B1, 1, 1); PG8_SCHED; PG8_LDA(At, 1, 0); PG8_STAGE(PG8_SA(0, 1), a2 + hstepA, voffA);
            PG8_WAIT_V(8); PG8_WAIT_L(0); PG8_BAR; PG8_MMA(0, 0, At, B0); PG8_MMA(0, 1, At, B1); PG8_BAR; PG8_SCHED;
            PG8_LDA(At, 1, 1); PG8_STAGE(PG8_SB(1, 0), b3, voffB); PG8_STAGE(PG8_SB(1, 1), b3 + hstepB, voffB); PG8_STAGE(PG8_SA(1, 0), a3, voffA);
            PG8_WAIT_V(8); PG8_WAIT_L(0); PG8_BAR; PG8_MMA(1, 0, At, B0); PG8_MMA(1, 1, At, B1); PG8_BAR; PG8_SCHED;
            } else {
            PG8_LDB(B0, 0, 0); PG8_SCHED; PG8_LDA(At, 0, 0); PG8_STAGE(PG8_SA(1, 1), a1 + hstepA, voffA);
            PG8_WAIT_L(8); PG8_BAR; PG8_WAIT_L(0); PG8_MMA(0, 0, At, B0); PG8_BAR; PG8_SCHED;
            PG8_LDB(B1, 0, 1); PG8_STAGE(PG8_SB(0, 0), b2, voffB);
            PG8_BAR; PG8_WAIT_L(0); PG8_MMA(0, 1, At, B1); PG8_BAR;
            PG8_LDA(At, 0, 1); PG8_STAGE(PG8_SA(0, 0), a2, voffA);
            PG8_BAR; PG8_WAIT_L(0); PG8_MMA(1, 0, At, B0); PG8_BAR; PG8_SCHED;
            PG8_STAGE(PG8_SB(0, 1), b2 + hstepB, voffB);
            PG8_WAIT_V(6); PG8_BAR; PG8_MMA(1, 1, At, B1); PG8_BAR;
            PG8_LDB(B0, 1, 0); PG8_SCHED; PG8_LDA(At, 1, 0); PG8_STAGE(PG8_SA(0, 1), a2 + hstepA, voffA);
            PG8_WAIT_L(8); PG8_BAR; PG8_WAIT_L(0); PG8_MMA(0, 0, At, B0); PG8_BAR; PG8_SCHED;
            PG8_LDB(B1, 1, 1); PG8_STAGE(PG8_SB(1, 0), b3, voffB);
            PG8_BAR; PG8_WAIT_L(0); PG8_MMA(0, 1, At, B1); PG8_BAR;
            PG8_LDA(At, 1, 1); PG8_STAGE(PG8_SA(1, 0), a3, voffA);
            PG8_BAR; PG8_WAIT_L(0); PG8_MMA(1, 0, At, B0); PG8_BAR; PG8_SCHED;
            PG8_STAGE(PG8_SB(1, 1), b3 + hstepB, voffB);
            PG8_WAIT_V(6); PG8_BAR; PG8_MMA(1, 1, At, B1); PG8_BAR;
            }
        }
        if constexpr (ALIGN_EPI) { if (wr == 0) PG8_BAR; }
        E(acc, cur, wr, wc, fr, fq);
        if (!has_next) break;
#pragma unroll
        for (int a = 0; a < 2; ++a)
#pragma unroll
            for (int b = 0; b < 2; ++b)
#pragma unroll
                for (int m = 0; m < 4; ++m)
#pragma unroll
                    for (int n = 0; n < 2; ++n) acc[a][b][m][n] = (f32x4){0.f, 0.f, 0.f, 0.f};
        cur = nxt; cA = nA; cB = nB; ++ui;
        if constexpr (ALIGN_EPI) { if (wr == 1) PG8_BAR; }
    }
    PG8_WAIT_V(0);
    if constexpr (!ALIGN_EPI) { if (wr == 0) PG8_BAR; }
    PG8_BAR;
#undef PG8_SA
#undef PG8_SB
#undef PG8_STAGE
#undef PG8_LDA
#undef PG8_LDB
#undef PG8_MMA
#undef PG8_WAIT_V
#undef PG8_WAIT_L
#undef PG8_BAR
#undef PG8_SCHED
}
}


#define LDS_BARRIER() do { asm volatile("s_waitcnt lgkmcnt(0)" ::: "memory"); __builtin_amdgcn_s_barrier(); asm volatile("" ::: "memory"); } while (0)
namespace ml {
#define LAS __attribute__((address_space(3)))
typedef short bf16x8 __attribute__((ext_vector_type(8)));
typedef float f32x4 __attribute__((ext_vector_type(4)));
typedef unsigned u32x4 __attribute__((ext_vector_type(4)));
constexpr int NVB = 4, EV = MD / NVB;
constexpr int PQ = 272, PT = 144;
constexpr int L_QS = 0, L_KS = L_QS + 64 * PQ, L_KT = L_KS + 64 * PQ, L_VT = L_KT + 128 * PT, L_SB = L_VT + 48 * PT, L_CT = L_SB + 64 * PT,
              L_HS = L_CT + 48 * PQ, L_SC = L_HS + 64 * 80, L_END = L_SC + 4096;
static_assert(L_END <= 131072, "mLSTM LDS map");
enum { SC_A = 0, SC_PM = 64, SC_WI = 128, SC_EMT = 192, SC_WE = 256, SC_DEN = 320, SC_MISC = 384 };
__device__ __forceinline__ f32x4 mma(bf16x8 a, bf16x8 b, f32x4 c) { return __builtin_amdgcn_mfma_f32_16x16x32_bf16(a, b, c, 0, 0, 0); }
__device__ __forceinline__ bf16x8 frag(LAS unsigned char* lds, int base, int pitch, int row0, int k0, int lane) {
    return *(const LAS bf16x8*)(lds + base + (row0 + (lane & 15)) * pitch + (k0 + 8 * (lane >> 4)) * 2);
}
template <int N> __device__ __forceinline__ float dpp_row_shr(float x, float ident) {
    return __builtin_bit_cast(float, __builtin_amdgcn_update_dpp(__builtin_bit_cast(int, ident), __builtin_bit_cast(int, x), 0x110 + N, 0xf, 0xf, false));
}
__device__ __forceinline__ float lane_get(float x, int l) { return __builtin_bit_cast(float, __builtin_amdgcn_readlane(__builtin_bit_cast(int, x), l)); }
__device__ __forceinline__ float wave_scan_add(float x, int lane) {
    x += dpp_row_shr<1>(x, 0.f); x += dpp_row_shr<2>(x, 0.f); x += dpp_row_shr<4>(x, 0.f); x += dpp_row_shr<8>(x, 0.f);
    const float t0 = lane_get(x, 15), t1 = lane_get(x, 31), t2 = lane_get(x, 47); const int row = lane >> 4;
    return x + ((row >= 1 ? t0 : 0.f) + (row >= 2 ? t1 : 0.f) + (row >= 3 ? t2 : 0.f));
}
__device__ __forceinline__ float wave_scan_max(float x, int lane) {
    constexpr float NI = -3.0e38f;
    x = fmaxf(x, dpp_row_shr<1>(x, NI)); x = fmaxf(x, dpp_row_shr<2>(x, NI)); x = fmaxf(x, dpp_row_shr<4>(x, NI)); x = fmaxf(x, dpp_row_shr<8>(x, NI));
    const float t0 = lane_get(x, 15), t1 = lane_get(x, 31), t2 = lane_get(x, 47); const int row = lane >> 4;
    return fmaxf(fmaxf(x, row >= 1 ? t0 : NI), fmaxf(row >= 2 ? t1 : NI, row >= 3 ? t2 : NI));
}
__device__ __forceinline__ void mlstm_item(LAS unsigned char* lds, CParams& P, int l, int s, int head, int dir, int vb) {
    const int tid = threadIdx.x, w = __builtin_amdgcn_readfirstlane(tid >> 6), lane = tid & 63, fr = lane & 15, fq = lane >> 4;
    const int rt = w & 3, half = w >> 2;
    const SeqInfo q = seqinfo(s); const int nchunk = q.T / 64;
    const bf16* QK = WSP(bf16, WS_QKC); bf16* U = WSP(bf16, WS_U1);
    LAS float* SC = (LAS float*)(lds + L_SC);
    f32x4 cacc[3];
    float m_prev;
    if (!q.grid) { cacc[0] = cacc[1] = cacc[2] = (f32x4){0.f, 0.f, 0.f, 0.f}; m_prev = 0.f; }
    else {
        const size_t sb = (((size_t)q.b * DEPTH + l) * 2 + dir) * MH + head; const int d = 16 * w + fr;
#pragma unroll
        for (int et = 0; et < 2; ++et)
#pragma unroll
            for (int r = 0; r < 4; ++r) cacc[et][r] = P.in[ST_C][(sb * 128 + d) * 128 + vb * EV + 16 * et + 4 * fq + r];
        cacc[2] = (f32x4){0.f, 0.f, 0.f, 0.f}; if (fq == 0) cacc[2][0] = P.in[ST_N][sb * 128 + d];
        m_prev = P.in[ST_M][sb];
    }
    const float bi = P.in[M_GATE_B][(size_t)l * 4 * MH + (2 * dir) * MH + head], bfg = P.in[M_GATE_B][(size_t)l * 4 * MH + (2 * dir + 1) * MH + head];
    for (int i = tid; i < 16 * 64; i += 512) { const int r = i >> 6, c = i & 63; *(LAS bf16*)(lds + L_VT + (32 + r) * PT + c * 2) = (r == 0) ? (bf16)0x3f80 : (bf16)0; }
    u32x4 pqk[4]; u32x4 pv; bf16 pgi = 0, pgf = 0;
#define ML_TOK(c, j) ((size_t)(q.base + (dir ? q.T - 1 - ((c) * 64 + (j)) : ((c) * 64 + (j)))))
#define ML_PREFETCH(c) do { _Pragma("unroll") for (int i = 0; i < 4; ++i) { const int id = tid + 512 * i, j = id >> 5, pc = id & 31; \
            pqk[i] = *(const u32x4*)(QK + ML_TOK(c, j) * (2 * MW) + (pc < 16 ? head * 128 + 8 * pc : MW + head * 128 + 8 * (pc - 16))); } \
        if (tid < 256) { const int j = tid >> 2, pc = tid & 3; pv = *(const u32x4*)(U + ML_TOK(c, j) * PU + OFF_V + head * 128 + vb * EV + 8 * pc); } \
        if (w == 0) { const bf16* g = U + ML_TOK(c, lane) * PU + OFF_G; pgi = g[(2 * dir) * MH + head]; pgf = g[(2 * dir + 1) * MH + head]; } } while (0)
    ML_PREFETCH(0);
    for (int c = 0; c < nchunk; ++c) {
#pragma unroll
        for (int i = 0; i < 4; ++i) { const int id = tid + 512 * i, j = id >> 5, pc = id & 31;
            *(LAS u32x4*)(lds + (pc < 16 ? L_QS : L_KS) + j * PQ + (pc & 15) * 16) = pqk[i]; }
        if (tid < 256) { const int j = tid >> 2, pc = tid & 3; const unsigned wv[4] = {pv.x, pv.y, pv.z, pv.w};
#pragma unroll
            for (int e = 0; e < 8; ++e) *(LAS bf16*)(lds + L_VT + (8 * pc + e) * PT + j * 2) = (bf16)((wv[e >> 1] >> ((e & 1) * 16)) & 0xffffu); }
#pragma unroll
        for (int et = 0; et < 3; ++et)
#pragma unroll
            for (int r = 0; r < 4; ++r) *(LAS bf16*)(lds + L_CT + (16 * et + 4 * fq + r) * PQ + (16 * w + fr) * 2) = f2bf(cacc[et][r]);
        float wie = 1.f;
        if (w == 0) {
            const float gi = bf2f(pgi) + bi, gf = bf2f(pgf) + bfg;
            const float lf = fminf(gf, 0.f) - log1pf(__expf(-fabsf(gf)));
            const float b = wave_scan_add(lf, lane);
            const float a = gi - b; float pm = wave_scan_max(a, lane);
            pm = fmaxf(pm, m_prev);
            const float pm63 = lane_get(pm, 63), b63 = lane_get(b, 63);
            SC[SC_A + lane] = a; SC[SC_PM + lane] = pm; SC[SC_WI + lane] = __expf(m_prev - pm); SC[SC_EMT + lane] = __expf(-(b + pm)); SC[SC_WE + lane] = __expf(a - pm63);
            if (lane == 0) { SC[SC_MISC] = __expf(m_prev - pm63); SC[SC_MISC + 1] = b63 + pm63; }
        }
        LDS_BARRIER();
        if (c + 1 < nchunk) ML_PREFETCH(c + 1);
        wie = SC[SC_MISC]; m_prev = SC[SC_MISC + 1];
#pragma unroll
        for (int i = 0; i < 2; ++i) { const int id = tid + 512 * i, j = id & 63, pc = id >> 6; const float we = SC[SC_WE + j];
            const u32x4 kv = *(const LAS u32x4*)(lds + L_KS + j * PQ + pc * 16); const unsigned wv[4] = {kv.x, kv.y, kv.z, kv.w};
#pragma unroll
            for (int e = 0; e < 8; ++e) { const float kf = __builtin_bit_cast(float, (e & 1) ? (wv[e >> 1] & 0xffff0000u) : (wv[e >> 1] << 16));
                *(LAS bf16*)(lds + L_KT + (8 * pc + e) * PT + j * 2) = f2bf(kf * we); } }
#pragma unroll
        for (int cc = 0; cc < 2; ++cc) { const int ct = 2 * half + cc;
            f32x4 acc = (f32x4){0.f, 0.f, 0.f, 0.f};
            if (ct <= rt) {
#pragma unroll
                for (int k = 0; k < 4; ++k) acc = mma(frag(lds, L_QS, PQ, 16 * rt, 32 * k, lane), frag(lds, L_KS, PQ, 16 * ct, 32 * k, lane), acc);
            }
            const int sp = 16 * ct + fr; const float as = SC[SC_A + sp];
#pragma unroll
            for (int r = 0; r < 4; ++r) { const int t = 16 * rt + 4 * fq + r; const float v = (sp <= t) ? acc[r] * __expf(as - SC[SC_PM + t]) : 0.f;
                *(LAS bf16*)(lds + L_SB + t * PT + sp * 2) = f2bf(v); } }
        LDS_BARRIER();
        f32x4 nacc[2]; const int nct = half ? 1 : 2;
#pragma unroll
        for (int cc = 0; cc < 2; ++cc) { if (cc < nct) { const int ct = half ? 2 : cc;
            f32x4 a1 = (f32x4){0.f, 0.f, 0.f, 0.f}, a2 = (f32x4){0.f, 0.f, 0.f, 0.f};
#pragma unroll
            for (int k = 0; k < 2; ++k) a1 = mma(frag(lds, L_SB, PT, 16 * rt, 32 * k, lane), frag(lds, L_VT, PT, 16 * ct, 32 * k, lane), a1);
#pragma unroll
            for (int k = 0; k < 4; ++k) a2 = mma(frag(lds, L_QS, PQ, 16 * rt, 32 * k, lane), frag(lds, L_CT, PQ, 16 * ct, 32 * k, lane), a2);
#pragma unroll
            for (int r = 0; r < 4; ++r) a1[r] += SC[SC_WI + 16 * rt + 4 * fq + r] * a2[r];
            nacc[cc] = a1; } }
        if (half && fr == 0) {
#pragma unroll
            for (int r = 0; r < 4; ++r) SC[SC_DEN + 16 * rt + 4 * fq + r] = nacc[0][r];
        }
#pragma unroll
        for (int et = 0; et < 3; ++et) { cacc[et] = cacc[et] * wie;
#pragma unroll
            for (int k = 0; k < 2; ++k) cacc[et] = mma(frag(lds, L_VT, PT, 16 * et, 32 * k, lane), frag(lds, L_KT, PT, 16 * w, 32 * k, lane), cacc[et]); }
        LDS_BARRIER();
        if (!half) {
#pragma unroll
            for (int cc = 0; cc < 2; ++cc)
#pragma unroll
                for (int r = 0; r < 4; ++r) { const int t = 16 * rt + 4 * fq + r; const float den = fmaxf(fabsf(SC[SC_DEN + t]), SC[SC_EMT + t]);
                    *(LAS bf16*)(lds + L_HS + t * 80 + (16 * cc + fr) * 2) = f2bf(nacc[cc][r] * __builtin_amdgcn_rcpf(den)); }
        }
        LDS_BARRIER();
        if (tid < 256) { const int j = tid >> 2, pc = tid & 3;
            *(u32x4*)(U + ML_TOK(c, j) * PU + dir * MW + head * 128 + vb * EV + 8 * pc) = *(const LAS u32x4*)(lds + L_HS + j * 80 + pc * 16); }
    }
    if (!q.grid) {
        const size_t sb = (((size_t)q.b * DEPTH + l) * 2 + dir) * MH + head; const int d = 16 * w + fr;
#pragma unroll
        for (int et = 0; et < 2; ++et)
#pragma unroll
            for (int r = 0; r < 4; ++r) P.out[OUT_C + (sb * 128 + d) * 128 + vb * EV + 16 * et + 4 * fq + r] = cacc[et][r];
        if (vb == 0) { if (fq == 0) P.out[OUT_N + sb * 128 + d] = cacc[2][0]; if (tid == 0) P.out[OUT_M + sb] = m_prev; }
    }
    LDS_BARRIER();
#undef ML_TOK
#undef ML_PREFETCH
}
constexpr int M_QS = 0, M_KS = M_QS + 2 * 64 * PQ, M_KT = M_KS + 64 * PQ, M_VT = M_KT + 128 * PT, M_SB = M_VT + 2 * 48 * PT, M_CT = M_SB + 64 * PT, M_HS = M_CT + 48 * PQ, M_SC = M_HS + 64 * 80, M_END = M_SC + 2 * 4096;
static_assert(M_END <= 131072, "pipelined mLSTM LDS map");
__device__ __forceinline__ void mlstm_item2(LAS unsigned char* lds, CParams& P, int l, int s, int head, int dir, int vb) {
    const int tid = threadIdx.x, w = __builtin_amdgcn_readfirstlane(tid >> 6), lane = tid & 63, fr = lane & 15, fq = lane >> 4;
    const int rt = w & 3, half = w >> 2;
    const SeqInfo q = seqinfo(s); const int nchunk = q.T / 64;
    const bf16* QK = WSP(bf16, WS_QKC); bf16* U = WSP(bf16, WS_U1);
    f32x4 cacc[3];
    float m_prev;
    const size_t sb = (((size_t)q.b * DEPTH + l) * 2 + dir) * MH + head;
    if (!q.grid) { cacc[0] = cacc[1] = cacc[2] = (f32x4){0.f, 0.f, 0.f, 0.f}; m_prev = 0.f; }
    else {
        const int d = 16 * w + fr;
#pragma unroll
        for (int et = 0; et < 2; ++et)
#pragma unroll
            for (int r = 0; r < 4; ++r) cacc[et][r] = P.in[ST_C][(sb * 128 + d) * 128 + vb * EV + 16 * et + 4 * fq + r];
        cacc[2] = (f32x4){0.f, 0.f, 0.f, 0.f}; if (fq == 0) cacc[2][0] = P.in[ST_N][sb * 128 + d];
        m_prev = P.in[ST_M][sb];
    }
    const float bi = P.in[M_GATE_B][(size_t)l * 4 * MH + (2 * dir) * MH + head], bfg = P.in[M_GATE_B][(size_t)l * 4 * MH + (2 * dir + 1) * MH + head];
    for (int i = tid; i < 2 * 16 * 64; i += 512) { const int b = i >> 10, r = (i >> 6) & 15, c = i & 63; *(LAS bf16*)(lds + M_VT + b * 48 * PT + (32 + r) * PT + c * 2) = (r == 0) ? (bf16)0x3f80 : (bf16)0; }
    u32x4 pqk[4]; u32x4 pv; bf16 pgi = 0, pgf = 0;
#define ML_TOK(c, j) ((size_t)(q.base + (dir ? q.T - 1 - ((c) * 64 + (j)) : ((c) * 64 + (j)))))
#define ML_PREFETCH(c) do { _Pragma("unroll") for (int i = 0; i < 4; ++i) { const int id = tid + 512 * i, j = id >> 5, pc = id & 31; \
            pqk[i] = *(const u32x4*)(QK + ML_TOK(c, j) * (2 * MW) + (pc < 16 ? head * 128 + 8 * pc : MW + head * 128 + 8 * (pc - 16))); } \
        if (tid < 256) { const int j = tid >> 2, pc = tid & 3; pv = *(const u32x4*)(U + ML_TOK(c, j) * PU + OFF_V + head * 128 + vb * EV + 8 * pc); } \
        if (w == 4) { const bf16* g = U + ML_TOK(c, lane) * PU + OFF_G; pgi = g[(2 * dir) * MH + head]; pgf = g[(2 * dir + 1) * MH + head]; } } while (0)
#define ML_STAGE_A(pb) do { \
        _Pragma("unroll") for (int i = 0; i < 4; ++i) { const int id = tid + 512 * i, j = id >> 5, pc = id & 31; \
            *(LAS u32x4*)(lds + (pc < 16 ? M_QS + (pb) * 64 * PQ : M_KS) + j * PQ + (pc & 15) * 16) = pqk[i]; } \
        if (tid < 256) { const int j = tid >> 2, pc = tid & 3; const unsigned wv[4] = {pv.x, pv.y, pv.z, pv.w}; \
            _Pragma("unroll") for (int e = 0; e < 8; ++e) *(LAS bf16*)(lds + M_VT + (pb) * 48 * PT + (8 * pc + e) * PT + j * 2) = (bf16)((wv[e >> 1] >> ((e & 1) * 16)) & 0xffffu); } \
        if (w == 4) { LAS float* SCn = (LAS float*)(lds + M_SC + (pb) * 4096); \
            const float gi = bf2f(pgi) + bi, gf = bf2f(pgf) + bfg; \
            const float lf = fminf(gf, 0.f) - log1pf(__expf(-fabsf(gf))); \
            const float b = wave_scan_add(lf, lane); \
            const float a = gi - b; float pm = wave_scan_max(a, lane); \
            pm = fmaxf(pm, m_prev); \
            const float pm63 = lane_get(pm, 63), b63 = lane_get(b, 63); \
            SCn[SC_A + lane] = a; SCn[SC_PM + lane] = pm; SCn[SC_WI + lane] = __expf(m_prev - pm); SCn[SC_EMT + lane] = __expf(-(b + pm)); SCn[SC_WE + lane] = __expf(a - pm63); \
            if (lane == 0) SCn[SC_MISC] = __expf(m_prev - pm63); \
            m_prev = b63 + pm63; } } while (0)
#define ML_STAGE_D(pb) do { const LAS float* SCn = (const LAS float*)(lds + M_SC + (pb) * 4096); \
        _Pragma("unroll") for (int i = 0; i < 2; ++i) { const int id = tid + 512 * i, j = id & 63, pc = id >> 6; const float we = SCn[SC_WE + j]; \
            const u32x4 kv = *(const LAS u32x4*)(lds + M_KS + j * PQ + pc * 16); const unsigned wv[4] = {kv.x, kv.y, kv.z, kv.w}; \
            _Pragma("unroll") for (int e = 0; e < 8; ++e) { const float kf = __builtin_bit_cast(float, (e & 1) ? (wv[e >> 1] & 0xffff0000u) : (wv[e >> 1] << 16)); \
                *(LAS bf16*)(lds + M_KT + (8 * pc + e) * PT + j * 2) = f2bf(kf * we); } } \
        _Pragma("unroll") for (int cc = 0; cc < 2; ++cc) { const int ct = 2 * half + cc; \
            f32x4 acc = (f32x4){0.f, 0.f, 0.f, 0.f}; \
            if (ct <= rt) { \
                _Pragma("unroll") for (int k = 0; k < 4; ++k) acc = mma(frag(lds, M_QS + (pb) * 64 * PQ, PQ, 16 * rt, 32 * k, lane), frag(lds, M_KS, PQ, 16 * ct, 32 * k, lane), acc); } \
            const int sp = 16 * ct + fr; const float as = SCn[SC_A + sp]; \
            _Pragma("unroll") for (int r = 0; r < 4; ++r) { const int t = 16 * rt + 4 * fq + r; const float v = (sp <= t) ? acc[r] * __expf(as - SCn[SC_PM + t]) : 0.f; \
                *(LAS bf16*)(lds + M_SB + t * PT + sp * 2) = f2bf(v); } } \
        _Pragma("unroll") for (int et = 0; et < 3; ++et) \
            _Pragma("unroll") for (int r = 0; r < 4; ++r) *(LAS bf16*)(lds + M_CT + (16 * et + 4 * fq + r) * PQ + (16 * w + fr) * 2) = f2bf(cacc[et][r]); } while (0)
#define ML_STORE(c) do { if (tid < 256) { const int j = tid >> 2, pc = tid & 3; \
            *(u32x4*)(U + ML_TOK(c, j) * PU + dir * MW + head * 128 + vb * EV + 8 * pc) = *(const LAS u32x4*)(lds + M_HS + j * 80 + pc * 16); } } while (0)
    ML_PREFETCH(0);
    ML_STAGE_A(0);
    LDS_BARRIER();
    if (nchunk > 1) ML_PREFETCH(1);
    ML_STAGE_D(0);
    LDS_BARRIER();
    for (int c = 0; c < nchunk; ++c) {
        const int pb = c & 1;
        if (c + 1 < nchunk) { ML_STAGE_A(pb ^ 1); if (c + 2 < nchunk) ML_PREFETCH(c + 2); }
        if (c >= 1) ML_STORE(c - 1);
        LAS float* SC = (LAS float*)(lds + M_SC + pb * 4096);
        const float wie = SC[SC_MISC];
        f32x4 nacc[2]; const int nct = half ? 1 : 2;
#pragma unroll
        for (int cc = 0; cc < 2; ++cc) { if (cc < nct) { const int ct = half ? 2 : cc;
            f32x4 a1 = (f32x4){0.f, 0.f, 0.f, 0.f}, a2 = (f32x4){0.f, 0.f, 0.f, 0.f};
#pragma unroll
            for (int k = 0; k < 2; ++k) a1 = mma(frag(lds, M_SB, PT, 16 * rt, 32 * k, lane), frag(lds, M_VT + pb * 48 * PT, PT, 16 * ct, 32 * k, lane), a1);
#pragma unroll
            for (int k = 0; k < 4; ++k) a2 = mma(frag(lds, M_QS + pb * 64 * PQ, PQ, 16 * rt, 32 * k, lane), frag(lds, M_CT, PQ, 16 * ct, 32 * k, lane), a2);
#pragma unroll
            for (int r = 0; r < 4; ++r) a1[r] += SC[SC_WI + 16 * rt + 4 * fq + r] * a2[r];
            nacc[cc] = a1; } }
        if (half && fr == 0) {
#pragma unroll
            for (int r = 0; r < 4; ++r) SC[SC_DEN + 16 * rt + 4 * fq + r] = nacc[0][r];
        }
#pragma unroll
        for (int et = 0; et < 3; ++et) { cacc[et] = cacc[et] * wie;
#pragma unroll
            for (int k = 0; k < 2; ++k) cacc[et] = mma(frag(lds, M_VT + pb * 48 * PT, PT, 16 * et, 32 * k, lane), frag(lds, M_KT, PT, 16 * w, 32 * k, lane), cacc[et]); }
        LDS_BARRIER();
        if (!half) {
#pragma unroll
            for (int cc = 0; cc < 2; ++cc)
#pragma unroll
                for (int r = 0; r < 4; ++r) { const int t = 16 * rt + 4 * fq + r; const float den = fmaxf(fabsf(SC[SC_DEN + t]), SC[SC_EMT + t]);
                    *(LAS bf16*)(lds + M_HS + t * 80 + (16 * cc + fr) * 2) = f2bf(nacc[cc][r] * __builtin_amdgcn_rcpf(den)); }
        }
        if (c + 1 < nchunk) ML_STAGE_D(pb ^ 1);
        LDS_BARRIER();
    }
    ML_STORE(nchunk - 1);
    if (!q.grid) {
        const int d = 16 * w + fr;
#pragma unroll
        for (int et = 0; et < 2; ++et)
#pragma unroll
            for (int r = 0; r < 4; ++r) P.out[OUT_C + (sb * 128 + d) * 128 + vb * EV + 16 * et + 4 * fq + r] = cacc[et][r];
        if (vb == 0) { if (fq == 0) P.out[OUT_N + sb * 128 + d] = cacc[2][0]; if (tid == 256) P.out[OUT_M + sb] = m_prev; }
    }
    LDS_BARRIER();
#undef ML_TOK
#undef ML_PREFETCH
#undef ML_STAGE_A
#undef ML_STAGE_D
#undef ML_STORE
}
constexpr int N_ITEMS = NSEQ * MH * 2 * NVB;
__device__ __forceinline__ void decode_item(int it, int& s, int& head, int& dir, int& vb) {
    vb = it % NVB; int ch = it / NVB; dir = ch & 1; ch >>= 1; head = ch % MH; const int sq = ch / MH;
    s = sq < LB ? CB + sq : sq - LB;
}
}


namespace rw {
typedef short bf16x8 __attribute__((ext_vector_type(8)));
typedef float f32x4 __attribute__((ext_vector_type(4)));
typedef unsigned u32x4 __attribute__((ext_vector_type(4)));
enum { V_A = 0, V_W, V_B, V_K, V_R, NVEC };
constexpr int REC = NVEC * 64 * 4;
constexpr int PT = 144;
constexpr int L_SBUF = 0, L_VT = L_SBUF + 64 * REC, L_TW = L_VT + 64 * 256, L_AL = L_TW + 64 * PT, L_YS = L_AL + 64 * PT, L_INV = L_YS + 64 * 16 * 4, L_END = L_INV + 256;
__device__ __forceinline__ int vt_off(int row, int tt) { return row * 256 + ((tt ^ (((row >> 3) & 7) << 2)) << 2); }
static_assert(L_END <= 131072, "RWKV LDS map");
__device__ __forceinline__ float dpp_xor1(float x) { return __builtin_bit_cast(float, __builtin_amdgcn_update_dpp(0, __builtin_bit_cast(int, x), 0xB1, 0xF, 0xF, true)); }
__device__ __forceinline__ float dpp_xor2(float x) { return __builtin_bit_cast(float, __builtin_amdgcn_update_dpp(0, __builtin_bit_cast(int, x), 0x4E, 0xF, 0xF, true)); }
__device__ __forceinline__ float dpp_ror4(float x) { return __builtin_bit_cast(float, __builtin_amdgcn_update_dpp(0, __builtin_bit_cast(int, x), 0x124, 0xF, 0xF, true)); }
__device__ __forceinline__ float dpp_ror8(float x) { return __builtin_bit_cast(float, __builtin_amdgcn_update_dpp(0, __builtin_bit_cast(int, x), 0x128, 0xF, 0xF, true)); }
__device__ __forceinline__ float allsum16(float x) { x += dpp_xor1(x); x += dpp_xor2(x); x += dpp_ror4(x); x += dpp_ror8(x); return x; }
__device__ __forceinline__ f32x4 cvt_lo4(unsigned a, unsigned b) { return (f32x4){__builtin_bit_cast(float, a << 16), __builtin_bit_cast(float, a & 0xffff0000u), __builtin_bit_cast(float, b << 16), __builtin_bit_cast(float, b & 0xffff0000u)}; }
__device__ __forceinline__ float allsum32(float x) {
    x = allsum16(x);
    float xa = x, xb = x;
    asm volatile("v_mov_b32 %1, %0\n\ts_nop 1\n\tv_permlane32_swap_b32 %0, %1\n\ts_nop 1" : "+v"(xa), "=&v"(xb));
    return xa + xb;
}
__device__ __forceinline__ void rwkv_item(LAS unsigned char* lds, CParams& P, int l, int s, int head, int dir, int rh) {
    const int tid = threadIdx.x, w = __builtin_amdgcn_readfirstlane(tid >> 6), lane = tid & 63, fr = lane & 15, fq = lane >> 4;
    const int rt = w & 3, half = w >> 2, hc = head * 64;
    const SeqInfo q = seqinfo(s); const int nchunk = q.T / 64;
    const bf16* RX = WSP(bf16, WS_RXC); bf16* U = WSP(bf16, WS_U1);
    const int pj = tid >> 3, psub = tid & 7;
    const int hh = lane >> 5, rsel = (lane >> 4) & 1, cg = lane & 15;
    const int row = 16 * rh + 2 * w + rsel, col0 = 32 * hh + 2 * cg;
    typedef float f32x2 __attribute__((ext_vector_type(2)));
    f32x2 S2;
    if (!q.grid) S2 = (f32x2){0.f, 0.f};
    else { const size_t sb = (((size_t)q.b * DEPTH + l) * 2 + dir) * RH + head; S2 = *(const f32x2*)(P.in[ST_R] + (sb * 64 + row) * 64 + col0); }
    float rkk8[8];
#pragma unroll
    for (int e = 0; e < 8; ++e) rkk8[e] = P.in[R_KK][(size_t)l * RW + hc + 8 * psub + e];
    float c_w0[2], c_a0[2], c_kk[2], c_ka[2];
    bf16x8 bw[2][2], ba[2][2];
#pragma unroll
    for (int cc = 0; cc < 2; ++cc) { const int c = 16 * (2 * half + cc) + fr;
        c_w0[cc] = P.in[R_W0][((size_t)l * 2 + dir) * RW + hc + c]; c_a0[cc] = P.in[R_A0][((size_t)l * 2 + dir) * RW + hc + c];
        c_kk[cc] = P.in[R_KK][(size_t)l * RW + hc + c]; c_ka[cc] = P.in[R_KA][(size_t)l * RW + hc + c];
#pragma unroll
        for (int ks = 0; ks < 2; ++ks)
#pragma unroll
            for (int e = 0; e < 8; ++e) { const int j = 32 * ks + 8 * fq + e;
                bw[cc][ks][e] = (short)f2bf(P.in[R_W2][(((size_t)l * 2 + dir) * 64 + j) * RW + hc + c]);
                ba[cc][ks][e] = (short)f2bf(P.in[R_A2][(((size_t)l * 2 + dir) * 64 + j) * RW + hc + c]); } }
    u32x4 pf[5];
#define RW_TOK(c, j) ((size_t)(q.base + (dir ? q.T - 1 - ((c) * 64 + (j)) : ((c) * 64 + (j)))))
#define RW_PREFETCH(c) do { const bf16* rx = RX + RW_TOK(c, pj) * RIN + 8 * psub; \
        pf[0] = *(const u32x4*)(rx + RX_R + hc); pf[1] = *(const u32x4*)(rx + RX_K + hc); pf[2] = *(const u32x4*)(rx + RX_V + hc); \
        pf[3] = *(const u32x4*)(rx + RX_WL + dir * 64); pf[4] = *(const u32x4*)(rx + RX_AL + dir * 64); } while (0)
    RW_PREFETCH(0);
    for (int c = 0; c < nchunk; ++c) {
        { LAS unsigned char* rec = lds + L_SBUF + pj * REC + psub * 32;
          *(LAS f32x4*)(rec + V_R * 256) = cvt_lo4(pf[0].x, pf[0].y); *(LAS f32x4*)(rec + V_R * 256 + 16) = cvt_lo4(pf[0].z, pf[0].w);
          { const f32x4 v0 = cvt_lo4(pf[2].x, pf[2].y), v1 = cvt_lo4(pf[2].z, pf[2].w);
#pragma unroll
            for (int e = 0; e < 4; ++e) { *(LAS float*)(lds + L_VT + vt_off(8 * psub + e, pj)) = v0[e]; *(LAS float*)(lds + L_VT + vt_off(8 * psub + 4 + e, pj)) = v1[e]; } }
          const f32x4 k0 = cvt_lo4(pf[1].x, pf[1].y), k1 = cvt_lo4(pf[1].z, pf[1].w);
          *(LAS f32x4*)(rec + V_K * 256) = k0; *(LAS f32x4*)(rec + V_K * 256 + 16) = k1;
          float ss = 0.f;
#pragma unroll
          for (int e = 0; e < 4; ++e) { const float x0 = k0[e] * rkk8[e], x1 = k1[e] * rkk8[4 + e]; ss += x0 * x0 + x1 * x1; }
          ss += dpp_xor1(ss); ss += dpp_xor2(ss); ss += __shfl_xor(ss, 4);
          if (psub == 0) *(LAS float*)(lds + L_INV + pj * 4) = 1.0f / fmaxf(sqrtf(ss), 1e-12f);
          *(LAS u32x4*)(lds + L_TW + pj * PT + psub * 16) = pf[3]; *(LAS u32x4*)(lds + L_AL + pj * PT + psub * 16) = pf[4]; }
        __syncthreads();
        if (c + 1 < nchunk) RW_PREFETCH(c + 1);
#pragma unroll
        for (int cc = 0; cc < 2; ++cc) { const int ct = 2 * half + cc; const int cidx = 16 * ct + fr;
            f32x4 aw = (f32x4){0.f, 0.f, 0.f, 0.f}, aa = (f32x4){0.f, 0.f, 0.f, 0.f};
#pragma unroll
            for (int ks = 0; ks < 2; ++ks) { aw = ml::mma(ml::frag(lds, L_TW, PT, 16 * rt, 32 * ks, lane), bw[cc][ks], aw); aa = ml::mma(ml::frag(lds, L_AL, PT, 16 * rt, 32 * ks, lane), ba[cc][ks], aa); }
#pragma unroll
            for (int r = 0; r < 4; ++r) { const int tok = 16 * rt + 4 * fq + r; LAS float* rec = (LAS float*)(lds + L_SBUF + tok * REC) + cidx;
                const float decay = __expf(-0.6065306597126334f * pg8::fsigmoid(c_w0[cc] + aw[r])); const float alpha = pg8::fsigmoid(c_a0[cc] + aa[r]);
                const float kraw = rec[V_K * 64]; const float kkn = kraw * c_kk[cc] * *(LAS float*)(lds + L_INV + tok * 4);
                rec[V_A * 64] = -kkn; rec[V_W * 64] = decay; rec[V_B * 64] = kkn * alpha; rec[V_K * 64] = kraw * (1.0f + (alpha - 1.0f) * c_ka[cc]); } }
        __syncthreads();
        {
            const LAS unsigned char* rbase = lds + L_SBUF + col0 * 4;
            f32x2 ca = *(const LAS f32x2*)(rbase + V_A * 256), cw = *(const LAS f32x2*)(rbase + V_W * 256), cb = *(const LAS f32x2*)(rbase + V_B * 256),
                  ck = *(const LAS f32x2*)(rbase + V_K * 256), cr = *(const LAS f32x2*)(rbase + V_R * 256);
#pragma unroll 1
            for (int blk = 0; blk < 4; ++blk) {
                float ykeep = 0.f;
#pragma unroll
                for (int g4 = 0; g4 < 4; ++g4) {
                    const f32x4 v4 = *(const LAS f32x4*)(lds + L_VT + vt_off(row, 16 * blk + 4 * g4));
#pragma unroll
                    for (int i4 = 0; i4 < 4; ++i4) {
                        const int i = 4 * g4 + i4, tt = 16 * blk + i, tn = tt < 63 ? tt + 1 : 63;
                        const LAS unsigned char* rn = rbase + tn * REC;
                        const f32x2 na = *(const LAS f32x2*)(rn + V_A * 256), nw = *(const LAS f32x2*)(rn + V_W * 256), nb = *(const LAS f32x2*)(rn + V_B * 256),
                                    nk = *(const LAS f32x2*)(rn + V_K * 256), nr = *(const LAS f32x2*)(rn + V_R * 256);
                        const float vv = v4[i4];
                        const f32x2 p = S2 * ca;
                        const float sa = allsum32(p.x + p.y);
                        S2 = S2 * cw + ck * vv;
                        S2 = cb * sa + S2;
                        const f32x2 yq = S2 * cr;
                        const float y = allsum32(yq.x + yq.y);
                        ykeep = (cg == i) ? y : ykeep;
                        ca = na; cw = nw; cb = nb; ck = nk; cr = nr;
                    }
                }
                if (hh == 0) *(LAS float*)(lds + L_YS + ((16 * blk + cg) * 16 + 2 * w + rsel) * 4) = ykeep;
            }
        }
        __syncthreads();
        if (tid < 128) { const int j = tid >> 1, pc = tid & 1; const LAS float* ys = (const LAS float*)(lds + L_YS) + j * 16 + 8 * pc;
            u32x4 o; o.x = pg8::cvt_pk_bf16(ys[0], ys[1]); o.y = pg8::cvt_pk_bf16(ys[2], ys[3]); o.z = pg8::cvt_pk_bf16(ys[4], ys[5]); o.w = pg8::cvt_pk_bf16(ys[6], ys[7]);
            *(u32x4*)(U + RW_TOK(c, j) * PU + OFF_R + dir * RW + hc + 16 * rh + 8 * pc) = o; }
    }
    if (!q.grid) { const size_t sb = (((size_t)q.b * DEPTH + l) * 2 + dir) * RH + head; *(f32x2*)(P.out + OUT_S + (sb * 64 + row) * 64 + col0) = S2; }
    __syncthreads();
#undef RW_TOK
#undef RW_PREFETCH
}
constexpr int N_ITEMS = NSEQ * RH * 2 * 4;
__device__ __forceinline__ void decode_item(int it, int& s, int& head, int& dir, int& rh) {
    rh = it & 3; int ch = it >> 2; dir = ch & 1; ch >>= 1; head = ch % RH; const int sq = ch / RH;
    s = sq < LB ? CB + sq : sq - LB;
}
}


namespace wy {
typedef short bf16x8 __attribute__((ext_vector_type(8)));
typedef float f32x4 __attribute__((ext_vector_type(4)));
typedef unsigned u32x4 __attribute__((ext_vector_type(4)));
constexpr int PV = 144, PS = 48, PVS = 136;
constexpr int L_AH = 0, L_RH = L_AH + 64 * PV, L_BT = L_RH + 64 * PV, L_KT = L_BT + 64 * PV, L_NAKT = L_KT + 64 * PV, L_NRKT = L_NAKT + 4 * 16 * PS,
              L_NRBT = L_NRKT + 4 * 16 * PS, L_TT = L_NRBT + 4 * 16 * PS, L_GL = L_TT + 4 * 16 * PS, PACK_BYTES = L_GL + 1024,
              L_VS = PACK_BYTES, L_BH = L_VS + 64 * PV, L_KH = L_BH + 64 * PV, L_YS = L_KH + 64 * PV, L_TW = L_YS + 64 * PV, L_AL = L_TW + 64 * PV, L_NAB = L_AL + 64 * PV, L_INV = L_NAB + 4096, L_END = L_INV + 256;
constexpr int RING = 8, PACK_U = PACK_BYTES / 16, N_LAT = LB * RH * 2, RING_A = 20;
static_assert(PACK_BYTES % 1024 == 0 && PACK_U <= 8 * 512 && (size_t)RING_A * RING * PACK_BYTES <= (size_t)N1P * D * 2 && WS_END + (size_t)(N_LAT - RING_A) * RING * PACK_BYTES <= ((size_t)256 << 20), "ring placement");
static_assert(L_END <= 131072, "WY LDS map");
__device__ __forceinline__ bf16x8 fragk16(LAS unsigned char* lds, int base, int pitch, int row0, int k0, int lane) {
    const bf16x8 v = *(const LAS bf16x8*)(lds + base + (row0 + (lane & 15)) * pitch + (k0 + 8 * ((lane >> 4) & 1)) * 2);
    const bf16x8 z = {0, 0, 0, 0, 0, 0, 0, 0};
    return (lane < 32) ? v : z;
}
__device__ __forceinline__ void stb(LAS unsigned char* lds, int off, float v) { *(LAS bf16*)(lds + off) = f2bf(v); }
typedef unsigned u32x2 __attribute__((ext_vector_type(2)));
__device__ __forceinline__ bf16x8 pack_k16(const f32x4 v) { u32x4 o; o.x = pg8::cvt_pk_bf16(v[0], v[1]); o.y = pg8::cvt_pk_bf16(v[2], v[3]); o.z = 0u; o.w = 0u; return __builtin_bit_cast(bf16x8, o); }
__device__ __forceinline__ bf16x8 pack_k32(const f32x4 a, const f32x4 b) { u32x4 o; o.x = pg8::cvt_pk_bf16(a[0], a[1]); o.y = pg8::cvt_pk_bf16(a[2], a[3]); o.z = pg8::cvt_pk_bf16(b[0], b[1]); o.w = pg8::cvt_pk_bf16(b[2], b[3]);
    return __builtin_bit_cast(bf16x8, o); }
__device__ __forceinline__ bf16x8 ld_k16(LAS unsigned char* lds, int base, int pitch, int row0, int col0, int lane) {
    const u32x2 v = *(const LAS u32x2*)(lds + base + (row0 + (lane & 15)) * pitch + (col0 + 4 * (lane >> 4)) * 2); u32x4 o; o.x = v.x; o.y = v.y; o.z = 0u; o.w = 0u; return __builtin_bit_cast(bf16x8, o); }
__device__ __forceinline__ bf16x8 ld_k32(LAS unsigned char* lds, int base, int pitch, int row0, int col0, int lane) {
    const LAS unsigned char* p = lds + base + (row0 + (lane & 15)) * pitch + (col0 + 4 * (lane >> 4)) * 2;
    const u32x2 v0 = *(const LAS u32x2*)p, v1 = *(const LAS u32x2*)(p + 32); u32x4 o; o.x = v0.x; o.y = v0.y; o.z = v1.x; o.w = v1.y; return __builtin_bit_cast(bf16x8, o); }
__device__ __forceinline__ void rwkv_item(LAS unsigned char* lds, CParams& P, int l, int s, int head, int dir) {
    const int tid = threadIdx.x, w = __builtin_amdgcn_readfirstlane(tid >> 6), lane = tid & 63, fr = lane & 15, fq = lane >> 4;
    const int rt = w & 3, half = w >> 2, hc = head * 64;
    const SeqInfo q = seqinfo(s); const int nchunk = q.T / 64;
    const bf16* RX = WSP(bf16, WS_RXC); bf16* U = WSP(bf16, WS_U1);
    const int pj = tid >> 3, psub = tid & 7;
    f32x4 sacc[4];
#pragma unroll
    for (int ct = 0; ct < 4; ++ct) sacc[ct] = (f32x4){0.f, 0.f, 0.f, 0.f};
    if (w < 4 && q.grid) { const size_t sb = (((size_t)q.b * DEPTH + l) * 2 + dir) * RH + head;
#pragma unroll
        for (int ct = 0; ct < 4; ++ct) sacc[ct] = *(const f32x4*)(P.in[ST_R] + (sb * 64 + 16 * w + fr) * 64 + 16 * ct + 4 * fq); }
    float rkk8[8];
#pragma unroll
    for (int e = 0; e < 8; ++e) rkk8[e] = P.in[R_KK][(size_t)l * RW + hc + 8 * psub + e];
    float c_w0[2], c_a0[2], c_kk[2], c_ka[2];
#pragma unroll
    for (int cc = 0; cc < 2; ++cc) { const int c = 16 * (2 * half + cc) + fr;
        c_w0[cc] = P.in[R_W0][((size_t)l * 2 + dir) * RW + hc + c]; c_a0[cc] = P.in[R_A0][((size_t)l * 2 + dir) * RW + hc + c];
        c_kk[cc] = P.in[R_KK][(size_t)l * RW + hc + c]; c_ka[cc] = P.in[R_KA][(size_t)l * RW + hc + c]; }
    const bf16* w2t = WSP(bf16, O_W2T) + ((size_t)dir * RW + hc) * 64; const bf16* a2t = WSP(bf16, O_A2T) + ((size_t)dir * RW + hc) * 64;
    u32x4 pf[5];
#define WY_TOK(c, j) ((size_t)(q.base + (dir ? q.T - 1 - ((c) * 64 + (j)) : ((c) * 64 + (j)))))
#define WY_PREFETCH(c) do { const bf16* rx = RX + WY_TOK(c, pj) * RIN + 8 * psub; \
        pf[0] = *(const u32x4*)(rx + RX_R + hc); pf[1] = *(const u32x4*)(rx + RX_K + hc); pf[2] = *(const u32x4*)(rx + RX_V + hc); \
        pf[3] = *(const u32x4*)(rx + RX_WL + dir * 64); pf[4] = *(const u32x4*)(rx + RX_AL + dir * 64); } while (0)
    WY_PREFETCH(0);
    for (int c = 0; c < nchunk; ++c) {
        { *(LAS u32x4*)(lds + L_RH + pj * PV + psub * 16) = pf[0]; *(LAS u32x4*)(lds + L_KH + pj * PV + psub * 16) = pf[1];
          const unsigned kw[4] = {pf[1].x, pf[1].y, pf[1].z, pf[1].w}, vw[4] = {pf[2].x, pf[2].y, pf[2].z, pf[2].w};
          float ss = 0.f;
#pragma unroll
          for (int e = 0; e < 8; ++e) { const float kf = __builtin_bit_cast(float, (e & 1) ? (kw[e >> 1] & 0xffff0000u) : (kw[e >> 1] << 16)) * rkk8[e]; ss += kf * kf;
              *(LAS bf16*)(lds + L_VS + (8 * psub + e) * PVS + pj * 2) = (bf16)((vw[e >> 1] >> ((e & 1) * 16)) & 0xffffu); }
          ss += rw::dpp_xor1(ss); ss += rw::dpp_xor2(ss); ss += __shfl_xor(ss, 4);
          if (psub == 0) *(LAS float*)(lds + L_INV + pj * 4) = 1.0f / fmaxf(sqrtf(ss), 1e-12f);
          *(LAS u32x4*)(lds + L_TW + pj * PV + psub * 16) = pf[3]; *(LAS u32x4*)(lds + L_AL + pj * PV + psub * 16) = pf[4]; }
        LDS_BARRIER();
        if (c + 1 < nchunk) WY_PREFETCH(c + 1);
#pragma unroll
        for (int cc = 0; cc < 2; ++cc) { const int ct = 2 * half + cc; const int cidx = 16 * ct + fr;
            f32x4 aw = (f32x4){0.f, 0.f, 0.f, 0.f}, aa = (f32x4){0.f, 0.f, 0.f, 0.f};
#pragma unroll
            for (int ks = 0; ks < 2; ++ks) { const size_t bo = (size_t)cidx * 64 + 32 * ks + 8 * fq;
                aw = ml::mma(ml::frag(lds, L_TW, PV, 16 * rt, 32 * ks, lane), *(const bf16x8*)(w2t + bo), aw); aa = ml::mma(ml::frag(lds, L_AL, PV, 16 * rt, 32 * ks, lane), *(const bf16x8*)(a2t + bo), aa); }
            float kr4[4], rr4[4], iv4[4];
#pragma unroll
            for (int r = 0; r < 4; ++r) { const int tok = 16 * rt + 4 * fq + r; kr4[r] = bf2f(*(const LAS bf16*)(lds + L_KH + tok * PV + cidx * 2)); rr4[r] = bf2f(*(const LAS bf16*)(lds + L_RH + tok * PV + cidx * 2));
                iv4[r] = *(const LAS float*)(lds + L_INV + tok * 4); }
            float lw[4], cum[4];
#pragma unroll
            for (int r = 0; r < 4; ++r) { lw[r] = -0.6065306597126334f * pg8::fsigmoid(c_w0[cc] + aw[r]); cum[r] = (r ? cum[r - 1] : 0.f) + lw[r]; }
            const float tot = cum[3]; const float p1 = __shfl_up(tot, 16), p2 = __shfl_up(tot, 32), p3 = __shfl_up(tot, 48);
            const float off = (fq >= 1 ? p1 : 0.f) + (fq >= 2 ? p2 : 0.f) + (fq >= 3 ? p3 : 0.f);
            float gprev = __expf(off);
#pragma unroll
            for (int r = 0; r < 4; ++r) { const int tok = 16 * rt + 4 * fq + r; const float lam = off + cum[r]; const float g = __expf(lam), gi = __builtin_amdgcn_rcpf(g);
                const float alpha = pg8::fsigmoid(c_a0[cc] + aa[r]);
                const float kraw = kr4[r], rraw = rr4[r];
                const float kkn = kraw * c_kk[cc] * iv4[r];
                const bf16 bh = f2bf(kkn * alpha * gi), kh = f2bf(kraw * (1.0f + (alpha - 1.0f) * c_ka[cc]) * gi);
                stb(lds, L_AH + tok * PV + cidx * 2, -kkn * gprev); stb(lds, L_RH + tok * PV + cidx * 2, rraw * g);
                *(LAS bf16*)(lds + L_BH + tok * PV + cidx * 2) = bh; *(LAS bf16*)(lds + L_KH + tok * PV + cidx * 2) = kh;
                *(LAS bf16*)(lds + L_BT + cidx * PV + tok * 2) = bh; *(LAS bf16*)(lds + L_KT + cidx * PV + tok * 2) = kh;
                if (fq == 3 && r == 3) *(LAS float*)(lds + L_GL + (rt * 64 + cidx) * 4) = g;
                gprev = g; } }
        LDS_BARRIER();
        { const int sc = w >> 1, side = w & 1; f32x4 gB = (f32x4){0.f, 0.f, 0.f, 0.f}, gK = (f32x4){0.f, 0.f, 0.f, 0.f};
#pragma unroll
          for (int ks = 0; ks < 2; ++ks) { const bf16x8 af = ml::frag(lds, side ? L_RH : L_AH, PV, 16 * sc, 32 * ks, lane);
              gB = ml::mma(af, ml::frag(lds, L_BH, PV, 16 * sc, 32 * ks, lane), gB); gK = ml::mma(af, ml::frag(lds, L_KH, PV, 16 * sc, 32 * ks, lane), gK); }
#pragma unroll
          for (int r = 0; r < 4; ++r) { const int t = 4 * fq + r; const bool keep = side ? (fr <= t) : (fr < t); const float vB = keep ? gB[r] : 0.f, vK = keep ? gK[r] : 0.f;
              if (side == 0) { *(LAS float*)(lds + L_NAB + ((sc * 16 + t) * 16 + fr) * 4) = vB; stb(lds, L_NAKT + (sc * 16 + t) * PS + fr * 2, vK); }
              else { stb(lds, L_NRBT + (sc * 16 + t) * PS + fr * 2, vB); stb(lds, L_NRKT + (sc * 16 + t) * PS + fr * 2, vK); } } }
        if ((w & 1) == 0 && lane < 16) { const int sc = w >> 1; float Tr[16];
            asm volatile("" ::: "memory");
#pragma unroll
            for (int ph = 0; ph < 4; ++ph) { f32x4 nv[4][4];
#pragma unroll
                for (int tq = 0; tq < 4; ++tq)
#pragma unroll
                    for (int u4 = 0; u4 <= ph; ++u4) nv[tq][u4] = *(const LAS f32x4*)(lds + L_NAB + ((sc * 16 + 4 * ph + tq) * 16 + 4 * u4) * 4);
#pragma unroll
                for (int tq = 0; tq < 4; ++tq) { const int t = 4 * ph + tq; float x0 = (lane == t) ? 1.f : 0.f, x1 = 0.f;
#pragma unroll
                    for (int u = 0; u < 16; ++u) if (u < t) { if (u & 1) x1 += Tr[u] * nv[tq][u >> 2][u & 3]; else x0 += Tr[u] * nv[tq][u >> 2][u & 3]; }
                    Tr[t] = x0 + x1; stb(lds, L_TT + (sc * 16 + t) * PS + lane * 2, Tr[t]); } } }
        LDS_BARRIER();
        if (w < 4) {
#pragma unroll 1
            for (int sc = 0; sc < 4; ++sc) {
                const bf16x8 ah0 = ld_k32(lds, L_AH, PV, 16 * sc, 0, lane), ah1 = ld_k32(lds, L_AH, PV, 16 * sc, 32, lane), rh0 = ld_k32(lds, L_RH, PV, 16 * sc, 0, lane), rh1 = ld_k32(lds, L_RH, PV, 16 * sc, 32, lane);
                const bf16x8 nak = ld_k16(lds, L_NAKT, PS, 16 * sc, 0, lane), nrk = ld_k16(lds, L_NRKT, PS, 16 * sc, 0, lane), ttf = ld_k16(lds, L_TT, PS, 16 * sc, 0, lane), nrb = ld_k16(lds, L_NRBT, PS, 16 * sc, 0, lane);
                const bf16x8 vsf = ld_k16(lds, L_VS, PVS, 16 * w, 16 * sc, lane);
                bf16x8 btf[4], ktf[4]; f32x4 glv[4];
#pragma unroll
                for (int ct = 0; ct < 4; ++ct) { btf[ct] = ld_k16(lds, L_BT, PV, 16 * ct, 16 * sc, lane); ktf[ct] = ld_k16(lds, L_KT, PV, 16 * ct, 16 * sc, lane);
                    glv[ct] = *(const LAS f32x4*)(lds + L_GL + (sc * 64 + 16 * ct + 4 * fq) * 4); }
                const bf16x8 sb0 = pack_k32(sacc[0], sacc[1]), sb1 = pack_k32(sacc[2], sacc[3]);
                f32x4 XT = (f32x4){0.f, 0.f, 0.f, 0.f}, YT = (f32x4){0.f, 0.f, 0.f, 0.f};
                XT = ml::mma(ah0, sb0, XT); XT = ml::mma(ah1, sb1, XT); XT = ml::mma(nak, vsf, XT);
                YT = ml::mma(rh0, sb0, YT); YT = ml::mma(rh1, sb1, YT); YT = ml::mma(nrk, vsf, YT);
                f32x4 UT = (f32x4){0.f, 0.f, 0.f, 0.f};
                UT = ml::mma(ttf, pack_k16(XT), UT);
                const bf16x8 ub = pack_k16(UT);
                YT = ml::mma(nrb, ub, YT);
#pragma unroll
                for (int r = 0; r < 4; ++r) stb(lds, L_YS + (16 * sc + 4 * fq + r) * PV + (16 * w + fr) * 2, YT[r]);
#pragma unroll
                for (int ct = 0; ct < 4; ++ct) { sacc[ct] = ml::mma(btf[ct], ub, sacc[ct]); sacc[ct] = ml::mma(ktf[ct], vsf, sacc[ct]); sacc[ct] = sacc[ct] * glv[ct]; }
            }
        }
        LDS_BARRIER();
        *(u32x4*)(U + WY_TOK(c, pj) * PU + OFF_R + dir * RW + hc + 8 * psub) = *(const LAS u32x4*)(lds + L_YS + pj * PV + psub * 16);
    }
    if (!q.grid && w < 4) { const size_t sb = (((size_t)q.b * DEPTH + l) * 2 + dir) * RH + head;
#pragma unroll
        for (int ct = 0; ct < 4; ++ct) *(f32x4*)(P.out + OUT_S + (sb * 64 + 16 * w + fr) * 64 + 16 * ct + 4 * fq) = sacc[ct]; }
    LDS_BARRIER();
#undef WY_TOK
#undef WY_PREFETCH
}
__device__ __forceinline__ int tid_opaque() { int t = threadIdx.x; asm volatile("" : "+v"(t)); return t; }
constexpr int CW_F = 16384, FL_STRIDE = 64, NPROD = 2;
static_assert(RING % NPROD == 0 && NPROD + 1 <= 4 && CW_F + DEPTH * N_LAT * 4 * FL_STRIDE <= 32768, "flag block");
constexpr unsigned FL_SPIN_CAP = 1u << 18;
__device__ __forceinline__ unsigned fl_ld(unsigned* p) { return __hip_atomic_load(p, __ATOMIC_RELAXED, __HIP_MEMORY_SCOPE_AGENT); }
__device__ __forceinline__ unsigned fl_wait_ge(unsigned* p, unsigned want, unsigned* tmo) {
    unsigned sp = 0, v;
    while ((v = fl_ld(p)) < want) { __builtin_amdgcn_s_sleep(1); if ((++sp & 255u) == 0u) { if (fl_ld(tmo)) break; if (sp > FL_SPIN_CAP) { atomicAdd(tmo, 1u); break; } } }
    return v;
}
__device__ __forceinline__ void rwkv_prod(LAS unsigned char* lds, CParams& P, int l, int s, int head, int dir, int chain, int pp, unsigned* ctl) {
    const int tid = tid_opaque(), w = __builtin_amdgcn_readfirstlane(tid >> 6), lane = tid & 63, fr = lane & 15, fq = lane >> 4;
    const int rt = w & 3, half = w >> 2, hc = head * 64;
    const SeqInfo q = seqinfo(s); const int nchunk = q.T / 64;
    const bf16* RX = WSP(bf16, WS_RXC);
    const int pj = tid >> 3, psub = tid & 7;
    unsigned char* ring = P.ws + (chain < RING_A ? O_WIN1 + (size_t)chain * RING * PACK_BYTES : WS_END + (size_t)(chain - RING_A) * RING * PACK_BYTES);
    unsigned* f_base = ctl + CW_F + (size_t)((l * N_LAT + chain) * 4) * FL_STRIDE; unsigned* f_ready = f_base + pp * FL_STRIDE; unsigned* f_ack = f_base + NPROD * FL_STRIDE; unsigned* tmo = ctl + 4096 + 128;
    float rkk8[8];
#pragma unroll
    for (int e = 0; e < 8; ++e) rkk8[e] = P.in[R_KK][(size_t)l * RW + hc + 8 * psub + e];
    float c_w0[2], c_a0[2], c_kk[2], c_ka[2];
#pragma unroll
    for (int cc = 0; cc < 2; ++cc) { const int c = 16 * (2 * half + cc) + fr;
        c_w0[cc] = P.in[R_W0][((size_t)l * 2 + dir) * RW + hc + c]; c_a0[cc] = P.in[R_A0][((size_t)l * 2 + dir) * RW + hc + c];
        c_kk[cc] = P.in[R_KK][(size_t)l * RW + hc + c]; c_ka[cc] = P.in[R_KA][(size_t)l * RW + hc + c]; }
    const bf16* w2t = WSP(bf16, O_W2T) + ((size_t)dir * RW + hc) * 64; const bf16* a2t = WSP(bf16, O_A2T) + ((size_t)dir * RW + hc) * 64;
    u32x4 pf[5];
#define WY_TOK(c, j) ((size_t)(q.base + (dir ? q.T - 1 - ((c) * 64 + (j)) : ((c) * 64 + (j)))))
#define WY_PREFETCH(c) do { const bf16* rx = RX + WY_TOK(c, pj) * RIN + 8 * psub; \
        pf[0] = *(const u32x4*)(rx + RX_R + hc); pf[1] = *(const u32x4*)(rx + RX_K + hc); pf[2] = pf[0]; \
        pf[3] = *(const u32x4*)(rx + RX_WL + dir * 64); pf[4] = *(const u32x4*)(rx + RX_AL + dir * 64); } while (0)
    WY_PREFETCH(pp);
    asm volatile("" :: "v"(pf[0]), "v"(pf[1]), "v"(pf[2]), "v"(pf[3]), "v"(pf[4]) : "memory");
    unsigned acked = 0u;
    for (int c = pp; c < nchunk; c += NPROD) {
        { *(LAS u32x4*)(lds + L_RH + pj * PV + psub * 16) = pf[0]; *(LAS u32x4*)(lds + L_KH + pj * PV + psub * 16) = pf[1];
          const unsigned kw[4] = {pf[1].x, pf[1].y, pf[1].z, pf[1].w};
          float ss = 0.f;
#pragma unroll
          for (int e = 0; e < 8; ++e) { const float kf = __builtin_bit_cast(float, (e & 1) ? (kw[e >> 1] & 0xffff0000u) : (kw[e >> 1] << 16)) * rkk8[e]; ss += kf * kf; }
          ss += rw::dpp_xor1(ss); ss += rw::dpp_xor2(ss); ss += __shfl_xor(ss, 4);
          if (psub == 0) *(LAS float*)(lds + L_INV + pj * 4) = 1.0f / fmaxf(sqrtf(ss), 1e-12f);
          *(LAS u32x4*)(lds + L_TW + pj * PV + psub * 16) = pf[3]; *(LAS u32x4*)(lds + L_AL + pj * PV + psub * 16) = pf[4]; }
        LDS_BARRIER();
        if (c + NPROD < nchunk) WY_PREFETCH(c + NPROD);
#pragma unroll
        for (int cc = 0; cc < 2; ++cc) { const int ct = 2 * half + cc; const int cidx = 16 * ct + fr;
            f32x4 aw = (f32x4){0.f, 0.f, 0.f, 0.f}, aa = (f32x4){0.f, 0.f, 0.f, 0.f};
#pragma unroll
            for (int ks = 0; ks < 2; ++ks) { const size_t bo = (size_t)cidx * 64 + 32 * ks + 8 * fq;
                aw = ml::mma(ml::frag(lds, L_TW, PV, 16 * rt, 32 * ks, lane), *(const bf16x8*)(w2t + bo), aw); aa = ml::mma(ml::frag(lds, L_AL, PV, 16 * rt, 32 * ks, lane), *(const bf16x8*)(a2t + bo), aa); }
            float kr4[4], rr4[4], iv4[4];
#pragma unroll
            for (int r = 0; r < 4; ++r) { const int tok = 16 * rt + 4 * fq + r; kr4[r] = bf2f(*(const LAS bf16*)(lds + L_KH + tok * PV + cidx * 2)); rr4[r] = bf2f(*(const LAS bf16*)(lds + L_RH + tok * PV + cidx * 2));
                iv4[r] = *(const LAS float*)(lds + L_INV + tok * 4); }
            float lw[4], cum[4];
#pragma unroll
            for (int r = 0; r < 4; ++r) { lw[r] = -0.6065306597126334f * pg8::fsigmoid(c_w0[cc] + aw[r]); cum[r] = (r ? cum[r - 1] : 0.f) + lw[r]; }
            const float tot = cum[3]; const float p1 = __shfl_up(tot, 16), p2 = __shfl_up(tot, 32), p3 = __shfl_up(tot, 48);
            const float off = (fq >= 1 ? p1 : 0.f) + (fq >= 2 ? p2 : 0.f) + (fq >= 3 ? p3 : 0.f);
            float gprev = __expf(off);
#pragma unroll
            for (int r = 0; r < 4; ++r) { const int tok = 16 * rt + 4 * fq + r; const float lam = off + cum[r]; const float g = __expf(lam), gi = __builtin_amdgcn_rcpf(g);
                const float alpha = pg8::fsigmoid(c_a0[cc] + aa[r]);
                const float kraw = kr4[r], rraw = rr4[r];
                const float kkn = kraw * c_kk[cc] * iv4[r];
                const bf16 bh = f2bf(kkn * alpha * gi), kh = f2bf(kraw * (1.0f + (alpha - 1.0f) * c_ka[cc]) * gi);
                stb(lds, L_AH + tok * PV + cidx * 2, -kkn * gprev); stb(lds, L_RH + tok * PV + cidx * 2, rraw * g);
                *(LAS bf16*)(lds + L_BH + tok * PV + cidx * 2) = bh; *(LAS bf16*)(lds + L_KH + tok * PV + cidx * 2) = kh;
                *(LAS bf16*)(lds + L_BT + cidx * PV + tok * 2) = bh; *(LAS bf16*)(lds + L_KT + cidx * PV + tok * 2) = kh;
                if (fq == 3 && r == 3) *(LAS float*)(lds + L_GL + (rt * 64 + cidx) * 4) = g;
                gprev = g; } }
        asm volatile("s_waitcnt vmcnt(0)" ::: "memory");
        LDS_BARRIER();
        if (tid == 0 && c > pp) __hip_atomic_store(f_ready, (unsigned)((c - pp) / NPROD), __ATOMIC_RELAXED, __HIP_MEMORY_SCOPE_AGENT);
        { const int sc = w >> 1, side = w & 1; f32x4 gB = (f32x4){0.f, 0.f, 0.f, 0.f}, gK = (f32x4){0.f, 0.f, 0.f, 0.f};
#pragma unroll
          for (int ks = 0; ks < 2; ++ks) { const bf16x8 af = ml::frag(lds, side ? L_RH : L_AH, PV, 16 * sc, 32 * ks, lane);
              gB = ml::mma(af, ml::frag(lds, L_BH, PV, 16 * sc, 32 * ks, lane), gB); gK = ml::mma(af, ml::frag(lds, L_KH, PV, 16 * sc, 32 * ks, lane), gK); }
#pragma unroll
          for (int r = 0; r < 4; ++r) { const int t = 4 * fq + r; const bool keep = side ? (fr <= t) : (fr < t); const float vB = keep ? gB[r] : 0.f, vK = keep ? gK[r] : 0.f;
              if (side == 0) { *(LAS float*)(lds + L_NAB + ((sc * 16 + t) * 16 + fr) * 4) = vB; stb(lds, L_NAKT + (sc * 16 + t) * PS + fr * 2, vK); }
              else { stb(lds, L_NRBT + (sc * 16 + t) * PS + fr * 2, vB); stb(lds, L_NRKT + (sc * 16 + t) * PS + fr * 2, vK); } } }
        if ((w & 1) == 0 && lane < 16) { const int sc = w >> 1; float Tr[16];
            asm volatile("" ::: "memory");
#pragma unroll
            for (int ph = 0; ph < 4; ++ph) { f32x4 nv[4][4];
#pragma unroll
                for (int tq = 0; tq < 4; ++tq)
#pragma unroll
                    for (int u4 = 0; u4 <= ph; ++u4) nv[tq][u4] = *(const LAS f32x4*)(lds + L_NAB + ((sc * 16 + 4 * ph + tq) * 16 + 4 * u4) * 4);
#pragma unroll
                for (int tq = 0; tq < 4; ++tq) { const int t = 4 * ph + tq; float x0 = (lane == t) ? 1.f : 0.f, x1 = 0.f;
#pragma unroll
                    for (int u = 0; u < 16; ++u) if (u < t) { if (u & 1) x1 += Tr[u] * nv[tq][u >> 2][u & 3]; else x0 += Tr[u] * nv[tq][u >> 2][u & 3]; }
                    Tr[t] = x0 + x1; stb(lds, L_TT + (sc * 16 + t) * PS + lane * 2, Tr[t]); } } }
        if (tid == 0 && c >= RING && acked < (unsigned)(c - RING + 1)) acked = fl_wait_ge(f_ack, (unsigned)(c - RING + 1), tmo);
        LDS_BARRIER();
        asm volatile("" :: "v"(pf[0]), "v"(pf[1]), "v"(pf[2]), "v"(pf[3]), "v"(pf[4]) : "memory");
        { unsigned char* slot = ring + (size_t)(c % RING) * PACK_BYTES;
#pragma unroll
          for (int k = 0; k < 8; ++k) { const int u = tid + 512 * k;
              if (u < PACK_U) { const u32x4 v = *(const LAS u32x4*)(lds + 16 * u); const u32x4* gp = (const u32x4*)(slot + (size_t)16 * u);
                  asm volatile("global_store_dwordx4 %0, %1, off sc1" :: "v"(gp), "v"(v) : "memory"); } } }
        LDS_BARRIER();
    }
    asm volatile("s_waitcnt vmcnt(0)" ::: "memory");
    __syncthreads();
    if (tid == 0) __hip_atomic_store(f_ready, (unsigned)((nchunk - pp + NPROD - 1) / NPROD), __ATOMIC_RELAXED, __HIP_MEMORY_SCOPE_AGENT);
    LDS_BARRIER();
#undef WY_TOK
#undef WY_PREFETCH
}
__device__ __forceinline__ void rwkv_cons(LAS unsigned char* lds, CParams& P, int l, int s, int head, int dir, int chain, unsigned* ctl) {
    const int tid = tid_opaque(), w = __builtin_amdgcn_readfirstlane(tid >> 6), lane = tid & 63, fr = lane & 15, fq = lane >> 4;
    const int hc = head * 64;
    const SeqInfo q = seqinfo(s); const int nchunk = q.T / 64;
    bf16* U = WSP(bf16, WS_U1);
    const unsigned char* ring = P.ws + (chain < RING_A ? O_WIN1 + (size_t)chain * RING * PACK_BYTES : WS_END + (size_t)(chain - RING_A) * RING * PACK_BYTES);
    unsigned* f_base = ctl + CW_F + (size_t)((l * N_LAT + chain) * 4) * FL_STRIDE; unsigned* f_ack = f_base + NPROD * FL_STRIDE; unsigned* tmo = ctl + 4096 + 128;
    constexpr int C_IMG = PACK_BYTES + 64 * PV, C_YS = 2 * C_IMG;
    const bf16* RX = WSP(bf16, WS_RXC);
    static_assert(C_YS + 64 * PV <= 131072, "consumer LDS map");
    f32x4 sacc[4];
#pragma unroll
    for (int ct = 0; ct < 4; ++ct) sacc[ct] = (f32x4){0.f, 0.f, 0.f, 0.f};
    if (w < 4 && q.grid) { const size_t sb = (((size_t)q.b * DEPTH + l) * 2 + dir) * RH + head;
#pragma unroll
        for (int ct = 0; ct < 4; ++ct) sacc[ct] = *(const f32x4*)(P.in[ST_R] + (sb * 64 + 16 * w + fr) * 64 + 16 * ct + 4 * fq); }
#define WY_TOK(c, j) ((size_t)(q.base + (dir ? q.T - 1 - ((c) * 64 + (j)) : ((c) * 64 + (j)))))
    unsigned seen0 = 0u, seen1 = 0u;
#define CONS_FETCH(c, boff) do { const int p_ = (c) % NPROD; const unsigned need_ = (unsigned)((c) / NPROD + 1); \
        u32x4 vv_[2];   \
        _Pragma("unroll") for (int i_ = 0; i_ < 2; ++i_) vv_[i_] = *(const u32x4*)(RX + WY_TOK(c, lane) * RIN + RX_V + hc + 8 * (2 * (w - 4) + i_)); \
        if ((p_ ? seen1 : seen0) < need_) { unsigned v_ = 0u; if (lane == 0) v_ = fl_wait_ge(f_base + p_ * FL_STRIDE, need_, tmo); v_ = __builtin_amdgcn_readfirstlane(v_); \
            if (p_) seen1 = v_; else seen0 = v_; __builtin_amdgcn_fence(__ATOMIC_ACQUIRE, "agent"); } \
        _Pragma("unroll") for (int i_ = 0; i_ < 2; ++i_) { const unsigned wv_[4] = {vv_[i_].x, vv_[i_].y, vv_[i_].z, vv_[i_].w}; \
            _Pragma("unroll") for (int e_ = 0; e_ < 8; ++e_) *(LAS bf16*)(lds + (boff) + L_VS + (8 * (2 * (w - 4) + i_) + e_) * PVS + lane * 2) = (bf16)((wv_[e_ >> 1] >> ((e_ & 1) * 16)) & 0xffffu); } \
        const unsigned char* slot = ring + (size_t)((c) % RING) * PACK_BYTES; \
        for (int k = w - 4; k < PACK_BYTES / 1024; k += 4) \
            __builtin_amdgcn_global_load_lds((const unsigned*)(slot + (size_t)k * 1024 + lane * 16), (LAS unsigned*)(lds + (boff) + k * 1024), 16, 0, 0); \
        asm volatile("s_waitcnt vmcnt(0)" ::: "memory"); } while (0)
    if (w >= 4) CONS_FETCH(0, 0);
    LDS_BARRIER();
    if (tid == 256) __hip_atomic_store(f_ack, 1u, __ATOMIC_RELAXED, __HIP_MEMORY_SCOPE_AGENT);
    for (int c = 0; c < nchunk; ++c) {
        const int boff = (c & 1) * C_IMG;
        if (w >= 4) { if (c + 1 < nchunk) CONS_FETCH(c + 1, C_IMG - boff); }
        else {
            LAS unsigned char* pb = lds + boff;
#pragma unroll 1
            for (int sc = 0; sc < 4; ++sc) {
                const bf16x8 ah0 = ld_k32(pb, L_AH, PV, 16 * sc, 0, lane), ah1 = ld_k32(pb, L_AH, PV, 16 * sc, 32, lane), rh0 = ld_k32(pb, L_RH, PV, 16 * sc, 0, lane), rh1 = ld_k32(pb, L_RH, PV, 16 * sc, 32, lane);
                const bf16x8 nak = ld_k16(pb, L_NAKT, PS, 16 * sc, 0, lane), nrk = ld_k16(pb, L_NRKT, PS, 16 * sc, 0, lane), ttf = ld_k16(pb, L_TT, PS, 16 * sc, 0, lane), nrb = ld_k16(pb, L_NRBT, PS, 16 * sc, 0, lane);
                const bf16x8 vsf = ld_k16(pb, L_VS, PVS, 16 * w, 16 * sc, lane);
                bf16x8 btf[4], ktf[4]; f32x4 glv[4];
#pragma unroll
                for (int ct = 0; ct < 4; ++ct) { btf[ct] = ld_k16(pb, L_BT, PV, 16 * ct, 16 * sc, lane); ktf[ct] = ld_k16(pb, L_KT, PV, 16 * ct, 16 * sc, lane);
                    glv[ct] = *(const LAS f32x4*)(pb + L_GL + (sc * 64 + 16 * ct + 4 * fq) * 4); }
                const bf16x8 sb0 = pack_k32(sacc[0], sacc[1]), sb1 = pack_k32(sacc[2], sacc[3]);
                f32x4 XT = (f32x4){0.f, 0.f, 0.f, 0.f}, YT = (f32x4){0.f, 0.f, 0.f, 0.f};
                XT = ml::mma(ah0, sb0, XT); XT = ml::mma(ah1, sb1, XT); XT = ml::mma(nak, vsf, XT);
                YT = ml::mma(rh0, sb0, YT); YT = ml::mma(rh1, sb1, YT); YT = ml::mma(nrk, vsf, YT);
                f32x4 UT = (f32x4){0.f, 0.f, 0.f, 0.f};
                UT = ml::mma(ttf, pack_k16(XT), UT);
                const bf16x8 ub = pack_k16(UT);
                YT = ml::mma(nrb, ub, YT);
#pragma unroll
                for (int r = 0; r < 4; ++r) stb(lds, C_YS + (16 * sc + 4 * fq + r) * PV + (16 * w + fr) * 2, YT[r]);
#pragma unroll
                for (int ct = 0; ct < 4; ++ct) { sacc[ct] = ml::mma(btf[ct], ub, sacc[ct]); sacc[ct] = ml::mma(ktf[ct], vsf, sacc[ct]); sacc[ct] = sacc[ct] * glv[ct]; }
            }
            { const LAS unsigned char* yp = lds + C_YS + lane * PV + 32 * w; const u32x4 y0 = *(const LAS u32x4*)yp, y1 = *(const LAS u32x4*)(yp + 16);
              bf16* up = U + WY_TOK(c, lane) * PU + OFF_R + dir * RW + hc + 16 * w; *(u32x4*)up = y0; *(u32x4*)(up + 8) = y1; }
        }
        LDS_BARRIER();
        if (tid == 256 && c + 1 < nchunk) __hip_atomic_store(f_ack, (unsigned)(c + 2), __ATOMIC_RELAXED, __HIP_MEMORY_SCOPE_AGENT);
    }
    if (!q.grid && w < 4) { const size_t sb = (((size_t)q.b * DEPTH + l) * 2 + dir) * RH + head;
#pragma unroll
        for (int ct = 0; ct < 4; ++ct) *(f32x4*)(P.out + OUT_S + (sb * 64 + 16 * w + fr) * 64 + 16 * ct + 4 * fq) = sacc[ct]; }
    LDS_BARRIER();
#undef WY_TOK
#undef CONS_FETCH
}
constexpr int N_ITEMS = NSEQ * RH * 2;
__device__ __forceinline__ void decode_item(int it, int& s, int& head, int& dir) {
    dir = it & 1; int ch = it >> 1; head = ch % RH; const int sq = ch / RH;
    s = sq < LB ? CB + sq : sq - LB;
}
}

namespace ms {
using ml::PQ; using ml::PT; using ml::mma; using ml::frag; using wy::bf16x8; using wy::f32x4; using wy::u32x4;
constexpr int P_QS = 0, P_KT = P_QS + 64 * PQ, P_SB = P_KT + 128 * PT, P_SC = P_SB + 64 * PT, P_VT = P_SC + 4096, VT_BYTES = 21504, ML_PACK = P_VT + VT_BYTES, P_KS = ML_PACK, P_END = P_KS + 64 * PQ;
constexpr int ML_RING = 4, ML_PACK_U = ML_PACK / 16, N_MLAT = LB * MH * 2, CW_MF = 32768, MLPROD = 2;
static_assert(MLPROD == 2 && ML_RING % MLPROD == 0, "two producers per chain: even / odd chunks");
static_assert(ML_PACK % 1024 == 0 && ML_PACK_U <= 9 * 512 && 145 * PT <= VT_BYTES && P_END <= 131072 && 2 * ML_PACK <= 146432, "mLSTM pack layout");
static_assert(WS_END + (size_t)N_MLAT * ML_RING * ML_PACK <= ((size_t)256 << 20), "mLSTM ring fits behind the activations");
__device__ __forceinline__ void ml_prod(LAS unsigned char* lds, CParams& P, int l, int s, int head, int dir, int chain, int pp, unsigned* ctl) {
    const int tid = wy::tid_opaque(), w = __builtin_amdgcn_readfirstlane(tid >> 6), lane = tid & 63, fr = lane & 15, fq = lane >> 4;
    const int rt = w & 3, half = w >> 2;
    const SeqInfo q = seqinfo(s); const int nchunk = q.T / 64;
    const bf16* QK = WSP(bf16, WS_QKC); const bf16* U = WSP(bf16, WS_U1);
    LAS float* SC = (LAS float*)(lds + P_SC);
    unsigned char* ring = P.ws + WS_END + (size_t)chain * ML_RING * ML_PACK;
    unsigned* f_base = ctl + CW_MF + (size_t)((l * N_MLAT + chain) * 4) * wy::FL_STRIDE; unsigned* f_ready = f_base + pp * wy::FL_STRIDE; unsigned* f_ack = f_base + MLPROD * wy::FL_STRIDE; unsigned* tmo = ctl + 4096 + 128;
    float m_prev = 0.f;
    if (q.grid) m_prev = P.in[ST_M][(((size_t)q.b * DEPTH + l) * 2 + dir) * MH + head];
    const float bi = P.in[M_GATE_B][(size_t)l * 4 * MH + (2 * dir) * MH + head], bfg = P.in[M_GATE_B][(size_t)l * 4 * MH + (2 * dir + 1) * MH + head];
    for (int i = tid; i < (VT_BYTES - 128 * PT) / 2; i += 512) *(LAS bf16*)(lds + P_VT + 128 * PT + i * 2) = (i < 64) ? (bf16)0x3f80 : (bf16)0;
    u32x4 pqk[4]; u32x4 pv[2]; bf16 pgi = 0, pgf = 0, sgi = 0, sgf = 0;
#define ML_TOK(c, j) ((size_t)(q.base + (dir ? q.T - 1 - ((c) * 64 + (j)) : ((c) * 64 + (j)))))
#define ML_PREFETCH(c) do { _Pragma("unroll") for (int i = 0; i < 4; ++i) { const int id = tid + 512 * i, j = id >> 5, pc = id & 31; \
            pqk[i] = *(const u32x4*)(QK + ML_TOK(c, j) * (2 * MW) + (pc < 16 ? head * 128 + 8 * pc : MW + head * 128 + 8 * (pc - 16))); } \
        _Pragma("unroll") for (int i = 0; i < 2; ++i) { const int id = tid + 512 * i, j = id >> 4, pc = id & 15; pv[i] = *(const u32x4*)(U + ML_TOK(c, j) * PU + OFF_V + head * 128 + 8 * pc); } \
        if (w == 0) { const bf16* g = U + ML_TOK(c, lane) * PU + OFF_G; pgi = g[(2 * dir) * MH + head]; pgf = g[(2 * dir + 1) * MH + head]; \
            if ((c) >= 1) { const bf16* g2 = U + ML_TOK((c) - 1, lane) * PU + OFF_G; sgi = g2[(2 * dir) * MH + head]; sgf = g2[(2 * dir + 1) * MH + head]; } } } while (0)
#define ML_TOUCH() asm volatile("" :: "v"(pqk[0]), "v"(pqk[1]), "v"(pqk[2]), "v"(pqk[3]), "v"(pv[0]), "v"(pv[1]), "v"((unsigned)pgi), "v"((unsigned)pgf), "v"((unsigned)sgi), "v"((unsigned)sgf) : "memory")
#define ML_SCAN(gi_, gf_) \
            const float gi = bf2f(gi_) + bi, gf = bf2f(gf_) + bfg; \
            const float lf = fminf(gf, 0.f) - log1pf(__expf(-fabsf(gf))); \
            float b = lf; \
            _Pragma("unroll") for (int o = 1; o < 64; o <<= 1) { const float t = __shfl_up(b, o); if (lane >= o) b += t; } \
            const float a = gi - b; float pm = a; \
            _Pragma("unroll") for (int o = 1; o < 64; o <<= 1) { const float t = __shfl_up(pm, o); if (lane >= o) pm = fmaxf(pm, t); } \
            pm = fmaxf(pm, m_prev); \
            const float pm63 = __shfl(pm, 63), b63 = __shfl(b, 63);
    ML_PREFETCH(pp);
    ML_TOUCH();
    unsigned acked = 0u;
    for (int c = pp; c < nchunk; c += MLPROD) {
        if (w == 0 && c >= 1) { ML_SCAN(sgi, sgf) m_prev = b63 + pm63; }
#pragma unroll
        for (int i = 0; i < 4; ++i) { const int id = tid + 512 * i, j = id >> 5, pc = id & 31;
            *(LAS u32x4*)(lds + (pc < 16 ? P_QS : P_KS) + j * PQ + (pc & 15) * 16) = pqk[i]; }
#pragma unroll
        for (int i = 0; i < 2; ++i) { const int id = tid + 512 * i, j = id >> 4, pc = id & 15; const unsigned wv[4] = {pv[i].x, pv[i].y, pv[i].z, pv[i].w};
#pragma unroll
            for (int e = 0; e < 8; ++e) *(LAS bf16*)(lds + P_VT + (8 * pc + e) * PT + j * 2) = (bf16)((wv[e >> 1] >> ((e & 1) * 16)) & 0xffffu); }
        if (w == 0) {
            ML_SCAN(pgi, pgf)
            SC[ml::SC_A + lane] = a; SC[ml::SC_PM + lane] = pm; SC[ml::SC_WI + lane] = __expf(m_prev - pm); SC[ml::SC_EMT + lane] = __expf(-(b + pm)); SC[ml::SC_WE + lane] = __expf(a - pm63);
            if (lane == 0) { SC[ml::SC_MISC] = __expf(m_prev - pm63); SC[ml::SC_MISC + 1] = b63 + pm63; }
            m_prev = b63 + pm63;
        }
        LDS_BARRIER();
        if (c + MLPROD < nchunk) ML_PREFETCH(c + MLPROD);
#pragma unroll
        for (int i = 0; i < 2; ++i) { const int id = tid + 512 * i, j = id & 63, pc = id >> 6; const float we = SC[ml::SC_WE + j];
            const u32x4 kv = *(const LAS u32x4*)(lds + P_KS + j * PQ + pc * 16); const unsigned wv[4] = {kv.x, kv.y, kv.z, kv.w};
#pragma unroll
            for (int e = 0; e < 8; ++e) { const float kf = __builtin_bit_cast(float, (e & 1) ? (wv[e >> 1] & 0xffff0000u) : (wv[e >> 1] << 16));
                *(LAS bf16*)(lds + P_KT + (8 * pc + e) * PT + j * 2) = f2bf(kf * we); } }
#pragma unroll
        for (int cc = 0; cc < 2; ++cc) { const int ct = 2 * half + cc;
            f32x4 acc = (f32x4){0.f, 0.f, 0.f, 0.f};
            if (ct <= rt) {
#pragma unroll
                for (int k = 0; k < 4; ++k) acc = mma(frag(lds, P_QS, PQ, 16 * rt, 32 * k, lane), frag(lds, P_KS, PQ, 16 * ct, 32 * k, lane), acc);
            }
            const int sp = 16 * ct + fr; const float as = SC[ml::SC_A + sp];
#pragma unroll
            for (int r = 0; r < 4; ++r) { const int t = 16 * rt + 4 * fq + r; const float v = (sp <= t) ? acc[r] * __expf(as - SC[ml::SC_PM + t]) : 0.f;
                *(LAS bf16*)(lds + P_SB + t * PT + sp * 2) = f2bf(v); } }
        asm volatile("s_waitcnt vmcnt(0)" ::: "memory");
        if (tid == 0 && c >= ML_RING && acked < (unsigned)(c - ML_RING + 1)) acked = wy::fl_wait_ge(f_ack, (unsigned)(c - ML_RING + 1), tmo);
        LDS_BARRIER();
        if (tid == 0 && c > pp) __hip_atomic_store(f_ready, (unsigned)((c - pp) / MLPROD), __ATOMIC_RELAXED, __HIP_MEMORY_SCOPE_AGENT);
        ML_TOUCH();
        { unsigned char* slot = ring + (size_t)(c % ML_RING) * ML_PACK;
#pragma unroll
          for (int k = 0; k < 9; ++k) { const int u = tid + 512 * k;
              if (u < ML_PACK_U) { const u32x4 v = *(const LAS u32x4*)(lds + 16 * u); const u32x4* gp = (const u32x4*)(slot + (size_t)16 * u);
                  asm volatile("global_store_dwordx4 %0, %1, off sc1" :: "v"(gp), "v"(v) : "memory"); } } }
        LDS_BARRIER();
    }
    asm volatile("s_waitcnt vmcnt(0)" ::: "memory");
    __syncthreads();
    if (tid == 0) __hip_atomic_store(f_ready, (unsigned)((nchunk - pp + MLPROD - 1) / MLPROD), __ATOMIC_RELAXED, __HIP_MEMORY_SCOPE_AGENT);
    LDS_BARRIER();
#undef ML_TOK
#undef ML_PREFETCH
#undef ML_TOUCH
#undef ML_SCAN
}
__device__ __forceinline__ void ml_cons(LAS unsigned char* lds, CParams& P, int l, int s, int head, int dir, int chain, unsigned* ctl) {
    const int tid = wy::tid_opaque(), w = __builtin_amdgcn_readfirstlane(tid >> 6), lane = tid & 63, fr = lane & 15, fq = lane >> 4;
    const SeqInfo q = seqinfo(s); const int nchunk = q.T / 64;
    bf16* U = WSP(bf16, WS_U1);
    const unsigned char* ring = P.ws + WS_END + (size_t)chain * ML_RING * ML_PACK;
    unsigned* f_base = ctl + CW_MF + (size_t)((l * N_MLAT + chain) * 4) * wy::FL_STRIDE; unsigned* f_ack = f_base + MLPROD * wy::FL_STRIDE; unsigned* tmo = ctl + 4096 + 128;
    f32x4 cst[8][3];
#pragma unroll
    for (int kt = 0; kt < 8; ++kt)
#pragma unroll
        for (int j = 0; j < 3; ++j) cst[kt][j] = (f32x4){0.f, 0.f, 0.f, 0.f};
    if (w < 4 && q.grid) { const size_t sb = (((size_t)q.b * DEPTH + l) * 2 + dir) * MH + head;
#pragma unroll
        for (int kt = 0; kt < 8; ++kt)
#pragma unroll
            for (int r = 0; r < 4; ++r) { const int d = 16 * kt + 4 * fq + r;
                cst[kt][0][r] = P.in[ST_C][(sb * 128 + d) * 128 + 32 * w + fr]; cst[kt][1][r] = P.in[ST_C][(sb * 128 + d) * 128 + 32 * w + 16 + fr];
                cst[kt][2][r] = (fr == 0) ? P.in[ST_N][sb * 128 + d] : 0.f; } }
#define ML_TOK(c, j) ((size_t)(q.base + (dir ? q.T - 1 - ((c) * 64 + (j)) : ((c) * 64 + (j)))))
    unsigned seen0 = 0u, seen1 = 0u;
#define MLC_FETCH(c, boff) do { const int p_ = (c) % MLPROD; const unsigned need_ = (unsigned)((c) / MLPROD + 1); \
        if ((p_ ? seen1 : seen0) < need_) { unsigned v_ = 0u; if (lane == 0) v_ = wy::fl_wait_ge(f_base + p_ * wy::FL_STRIDE, need_, tmo); v_ = __builtin_amdgcn_readfirstlane(v_); \
            if (p_) seen1 = v_; else seen0 = v_; __builtin_amdgcn_fence(__ATOMIC_ACQUIRE, "agent"); } \
        const unsigned char* slot = ring + (size_t)((c) % ML_RING) * ML_PACK; \
        for (int k = w - 4; k < ML_PACK / 1024; k += 4) \
            __builtin_amdgcn_global_load_lds((const unsigned*)(slot + (size_t)k * 1024 + lane * 16), (LAS unsigned*)(lds + (boff) + k * 1024), 16, 0, 0); \
        asm volatile("s_waitcnt vmcnt(0)" ::: "memory"); } while (0)
    if (w >= 4) MLC_FETCH(0, 0);
    LDS_BARRIER();
    if (tid == 256) __hip_atomic_store(f_ack, 1u, __ATOMIC_RELAXED, __HIP_MEMORY_SCOPE_AGENT);
    for (int c = 0; c < nchunk; ++c) {
        const int boff = (c & 1) * ML_PACK;
        if (w >= 4) { if (c + 1 < nchunk) MLC_FETCH(c + 1, ML_PACK - boff); }
        else {
            LAS unsigned char* pb = lds + boff; const LAS float* SC = (const LAS float*)(pb + P_SC);
            const float wie = SC[ml::SC_MISC];
            bf16x8 vf[3][2];
#pragma unroll
            for (int j = 0; j < 3; ++j)
#pragma unroll
                for (int k = 0; k < 2; ++k) vf[j][k] = frag(pb, P_VT, PT, j < 2 ? 32 * w + 16 * j : 128, 32 * k, lane);
            asm volatile("s_waitcnt lgkmcnt(0)" ::: "memory");
            LAS unsigned char* hp = pb + P_VT + 32 * w * PT;
#pragma unroll
            for (int rt = 0; rt < 4; ++rt) {
                f32x4 num[3];
#pragma unroll
                for (int j = 0; j < 3; ++j) { f32x4 a1 = (f32x4){0.f, 0.f, 0.f, 0.f}, a2 = (f32x4){0.f, 0.f, 0.f, 0.f};
#pragma unroll
                    for (int k = 0; k < 2; ++k) a1 = mma(frag(pb, P_SB, PT, 16 * rt, 32 * k, lane), vf[j][k], a1);
#pragma unroll
                    for (int kb = 0; kb < 4; ++kb) a2 = mma(wy::ld_k32(pb, P_QS, PQ, 16 * rt, 32 * kb, lane), wy::pack_k32(cst[2 * kb][j], cst[2 * kb + 1][j]), a2);
#pragma unroll
                    for (int r = 0; r < 4; ++r) a1[r] += SC[ml::SC_WI + 16 * rt + 4 * fq + r] * a2[r];
                    num[j] = a1; }
#pragma unroll
                for (int r = 0; r < 4; ++r) { const int t = 16 * rt + 4 * fq + r; const float dn = __shfl(num[2][r], lane & 48);
                    const float rden = __builtin_amdgcn_rcpf(fmaxf(fabsf(dn), SC[ml::SC_EMT + t]));
                    *(LAS bf16*)(hp + t * 64 + fr * 2) = f2bf(num[0][r] * rden); *(LAS bf16*)(hp + t * 64 + (16 + fr) * 2) = f2bf(num[1][r] * rden); }
            }
#pragma unroll
            for (int kt = 0; kt < 8; ++kt) { const bf16x8 k0 = frag(pb, P_KT, PT, 16 * kt, 0, lane), k1 = frag(pb, P_KT, PT, 16 * kt, 32, lane);
#pragma unroll
                for (int j = 0; j < 3; ++j) { cst[kt][j] = cst[kt][j] * wie; cst[kt][j] = mma(k0, vf[j][0], cst[kt][j]); cst[kt][j] = mma(k1, vf[j][1], cst[kt][j]); } }
            { const LAS unsigned char* yp = hp + lane * 64; bf16* up = U + ML_TOK(c, lane) * PU + dir * MW + head * 128 + 32 * w;
#pragma unroll
              for (int i = 0; i < 4; ++i) *(u32x4*)(up + 8 * i) = *(const LAS u32x4*)(yp + 16 * i); }
        }
        LDS_BARRIER();
        if (tid == 256 && c + 1 < nchunk) __hip_atomic_store(f_ack, (unsigned)(c + 2), __ATOMIC_RELAXED, __HIP_MEMORY_SCOPE_AGENT);
    }
    LDS_BARRIER();
#undef ML_TOK
#undef MLC_FETCH
}
}

namespace el {
typedef float f32x4 __attribute__((ext_vector_type(4)));
typedef unsigned u32x4 __attribute__((ext_vector_type(4)));
typedef unsigned u32x2 __attribute__((ext_vector_type(2)));
typedef short bf16x8 __attribute__((ext_vector_type(8)));
__device__ __forceinline__ float wave_sum(float v) {
#pragma unroll
    for (int o = 1; o < 64; o <<= 1) v += __shfl_xor(v, o);
    return v;
}
__device__ __forceinline__ void unpack8(const u32x4 p, float (&f)[8]) {
    f[0] = pg8::bflo(p.x); f[1] = pg8::bfhi(p.x); f[2] = pg8::bflo(p.y); f[3] = pg8::bfhi(p.y); f[4] = pg8::bflo(p.z); f[5] = pg8::bfhi(p.z); f[6] = pg8::bflo(p.w); f[7] = pg8::bfhi(p.w);
}
__device__ __forceinline__ u32x4 pack8(const float (&f)[8]) {
    u32x4 o; o.x = pg8::cvt_pk_bf16(f[0], f[1]); o.y = pg8::cvt_pk_bf16(f[2], f[3]); o.z = pg8::cvt_pk_bf16(f[4], f[5]); o.w = pg8::cvt_pk_bf16(f[6], f[7]); return o;
}
__device__ __forceinline__ void init_phase(LAS unsigned char* lds, CParams& P, int vb, int G) {
    const int tid = threadIdx.x, w = tid >> 6, lane = tid & 63;
    LAS float* red = (LAS float*)lds;
    LAS float* sil = (LAS float*)(lds + 8192);
    constexpr int KW = D / 8;
    if (vb < DEPTH * (6 * D / 64)) {
        for (int i = tid; i < NCOND * D; i += 512) { const int ci = i / D, k = i % D; const float cv = ci == 0 ? P.in[C_CTX][k] : P.in[C_LAT][(size_t)(ci - 1) * D + k]; sil[i] = cv * pg8::fsigmoid(cv); }
        __syncthreads();
    }
    for (int it = vb; it < DEPTH * (6 * D / 64); it += G) {
        const int l = it / (6 * D / 64), j = (it % (6 * D / 64)) * 64 + lane;
        const float* wp = P.in[ADA_W] + ((size_t)l * D + w * KW) * 6 * D + j;
        float acc[NCOND];
#pragma unroll
        for (int ci = 0; ci < NCOND; ++ci) acc[ci] = 0.f;
#pragma unroll 16
        for (int k = 0; k < KW; ++k) { const float wv = wp[(size_t)k * 6 * D];
#pragma unroll
            for (int ci = 0; ci < NCOND; ++ci) acc[ci] += sil[ci * D + w * KW + k] * wv; }
#pragma unroll
        for (int ci = 0; ci < NCOND; ++ci) red[(w * NCOND + ci) * 64 + lane] = acc[ci];
        __syncthreads();
        if (w < NCOND) { float sum = P.in[ADA_B][(size_t)l * 6 * D + j];
#pragma unroll
            for (int ww = 0; ww < 8; ++ww) sum += red[(ww * NCOND + w) * 64 + lane];
            WSP(float, WS_MOD)[((size_t)l * NCOND + w) * 6 * D + j] = sum; }
        __syncthreads();
    }
}
__device__ __forceinline__ int perm5(int n) { return (((n >> 2) & 1) << 4) | (((n >> 3) & 3) << 2) | (n & 3); }
__device__ __forceinline__ void transpose_item(const float* W, int ldw, int nvalid, bf16* dst, int K, int k0, int drow0, bool perm, LAS float* scr, int lane) {
    f32x4 tv[8];
#pragma unroll
    for (int i = 0; i < 8; ++i) { const int kk = 8 * i + (lane >> 3), n4 = (lane & 7) * 4; tv[i] = n4 < nvalid ? *(const f32x4*)(W + (size_t)kk * ldw + n4) : (f32x4){0.f, 0.f, 0.f, 0.f}; }
#pragma unroll
    for (int i = 0; i < 8; ++i) { const int kk = 8 * i + (lane >> 3), n4 = (lane & 7) * 4;
#pragma unroll
        for (int e = 0; e < 4; ++e) scr[kk * 33 + n4 + e] = tv[i][e]; }
    asm volatile("s_waitcnt lgkmcnt(0)" ::: "memory");
    const int c = lane & 7;
#pragma unroll
    for (int j = 0; j < 4; ++j) { const int n = (lane >> 3) + 8 * j; const LAS float* sp = scr + (8 * c) * 33 + n;
        u32x4 o; o.x = pg8::cvt_pk_bf16(sp[0 * 33], sp[1 * 33]); o.y = pg8::cvt_pk_bf16(sp[2 * 33], sp[3 * 33]); o.z = pg8::cvt_pk_bf16(sp[4 * 33], sp[5 * 33]); o.w = pg8::cvt_pk_bf16(sp[6 * 33], sp[7 * 33]);
        *(u32x4*)(dst + (size_t)(drow0 + (perm ? perm5(n) : n)) * K + k0 + 8 * c) = o; }
    asm volatile("s_waitcnt lgkmcnt(0)" ::: "memory");
}
constexpr int WI_0 = (N1P / 32) * (D / 64), WI_1 = WI_0 + (2 * D / 32) * (D / 64), WI_2 = WI_1 + (D / 32) * (MW / 64), WI_3 = WI_2 + (D / 32) * (RW / 64),
              WI_4 = WI_3 + (D / 32) * (D / 64), WI_5 = WI_4 + 2 * (FF / 32) * (D / 64), WI_6 = WI_5 + (D / 32) * (FF / 64), WI_7 = WI_6 + (RW / 32) * (128 / 64), WI_8 = WI_7 + 4 * (RW / 32);
__device__ __forceinline__ void wconv_phase(LAS unsigned char* lds, CParams& P, int l, int vb, int G) {
    const int tid = threadIdx.x, w = tid >> 6, lane = tid & 63;
    LAS float* scr = (LAS float*)(lds + w * 8704);
    for (int it = vb * 8 + w; it < WI_8; it += G * 8) {
        if (it < WI_0) { const int nb = it / (D / 64), kb = it % (D / 64); const int n0 = nb * 32; const int nv = n0 >= N1 ? 0 : (N1 - n0 < 32 ? N1 - n0 : 32);
            transpose_item(P.in[W_IN] + ((size_t)l * D + kb * 64) * PIN + n0, PIN, nv, WSP(bf16, O_WIN1), D, kb * 64, n0, true, scr, lane); }
        else if (it < WI_1) { const int r = it - WI_0, nb = r / (D / 64), kb = r % (D / 64);
            transpose_item(P.in[W_IN] + ((size_t)l * D + kb * 64) * PIN + N1 + nb * 32, PIN, 32, WSP(bf16, O_WIN2), D, kb * 64, nb * 32, true, scr, lane); }
        else if (it < WI_2) { const int r = it - WI_1, nb = r / (MW / 64), kb = r % (MW / 64);
            transpose_item(P.in[PROJ_M] + ((size_t)l * MW + kb * 64) * D + nb * 32, D, 32, WSP(bf16, O_PM), MW, kb * 64, nb * 32, true, scr, lane); }
        else if (it < WI_3) { const int r = it - WI_2, nb = r / (RW / 64), kb = r % (RW / 64);
            transpose_item(P.in[PROJ_R] + ((size_t)l * RW + kb * 64) * D + nb * 32, D, 32, WSP(bf16, O_PR), RW, kb * 64, nb * 32, true, scr, lane); }
        else if (it < WI_4) { const int r = it - WI_3, nb = r / (D / 64), kb = r % (D / 64);
            transpose_item(P.in[W_OUT] + ((size_t)l * D + kb * 64) * D + nb * 32, D, 32, WSP(bf16, O_WO), D, kb * 64, nb * 32, false, scr, lane); }
        else if (it < WI_5) { const int r = it - WI_4, which = r / ((FF / 32) * (D / 64)), r2 = r % ((FF / 32) * (D / 64)), nb = r2 / (D / 64), kb = r2 % (D / 64);
            const int j0 = nb * 32, pn = j0 >> 7, drow0 = pn * 256 + which * 128 + (j0 & 127);
            transpose_item((which ? P.in[FFN_W3] : P.in[FFN_W1]) + ((size_t)l * D + kb * 64) * FF + j0, FF, 32, WSP(bf16, O_W13), D, kb * 64, drow0, true, scr, lane); }
        else if (it < WI_6) { const int r = it - WI_5, nb = r / (FF / 64), kb = r % (FF / 64);
            transpose_item(P.in[FFN_W2] + ((size_t)l * FF + kb * 64) * D + nb * 32, D, 32, WSP(bf16, O_W2), FF, kb * 64, nb * 32, false, scr, lane); }
        else if (it < WI_7) { const int r = it - WI_6, nb = r / 2, kb = r % 2;
            transpose_item(P.in[R_G2] + ((size_t)l * 128 + kb * 64) * RW + nb * 32, RW, 32, WSP(bf16, O_G2T), 128, kb * 64, nb * 32, false, scr, lane); }
        else { const int r = it - WI_7, which = r / (2 * (RW / 32)), d = (r / (RW / 32)) & 1, nb = r % (RW / 32);
            transpose_item((which ? P.in[R_A2] : P.in[R_W2]) + ((size_t)l * 2 + d) * 64 * RW + nb * 32, RW, 32, WSP(bf16, which ? O_A2T : O_W2T) + (size_t)d * RW * 64, 64, 0, nb * 32, false, scr, lane); }
    }
}
__device__ __forceinline__ void norm_phase(CParams& P, int l, int mode, int vb, int G) {
    const int tid = threadIdx.x, w = tid >> 6, lane = tid & 63;
#define NORM_SRC(m_) ((l == 0 && mode < 2) ? ((m_) < NC ? P.in[X_PROMPT] + (size_t)(m_) * D : P.in[X_SAMPLE] + (size_t)((m_) - NC) * D) : P.out + (size_t)(m_) * D)
    f32x4 vn[D / 256];
    { const int m0 = vb * 8 + w; if (m0 < NT) { const float* xs = NORM_SRC(m0);
#pragma unroll
        for (int j = 0; j < D / 256; ++j) vn[j] = *(const f32x4*)(xs + 256 * j + 4 * lane); } }
    for (int m = vb * 8 + w; m < NT; m += G * 8) {
        float* xr = P.out + (size_t)m * D;
        f32x4 v[D / 256]; float ss = 0.f;
#pragma unroll
        for (int j = 0; j < D / 256; ++j) v[j] = vn[j];
        if (m + G * 8 < NT) { const float* xs = NORM_SRC(m + G * 8);
#pragma unroll
            for (int j = 0; j < D / 256; ++j) vn[j] = *(const f32x4*)(xs + 256 * j + 4 * lane); }
#pragma unroll
        for (int j = 0; j < D / 256; ++j) ss += (v[j][0] * v[j][0] + v[j][1] * v[j][1]) + (v[j][2] * v[j][2] + v[j][3] * v[j][3]);
        const float rs = 1.0f / sqrtf(wave_sum(ss) * (1.0f / D) + RMS_EPS);
        if (mode == 3) {
#pragma unroll
            for (int j = 0; j < D / 256; ++j) { const f32x4 g = *(const f32x4*)(P.in[FINAL_G] + 256 * j + 4 * lane); *(f32x4*)(xr + 256 * j + 4 * lane) = v[j] * rs * g; }
        } else {
            const int second = (mode == 2); const int cond = seqinfo(seq_of_token(m)).cond;
            const float* gp = P.in[second ? NORM2 : NORM1] + (size_t)l * D; const float* mod = WSP(float, WS_MOD) + ((size_t)l * NCOND + cond) * 6 * D + (second ? 3 * D : 0);
            bf16* o = WSP(bf16, mode == 1 ? WS_RXC : WS_QKC) + (size_t)m * D;
#pragma unroll
            for (int j = 0; j < D / 256; ++j) { const int c = 256 * j + 4 * lane; const f32x4 g = *(const f32x4*)(gp + c), sh = *(const f32x4*)(mod + c), sc = *(const f32x4*)(mod + D + c);
                const f32x4 y = v[j] * rs * g * (sc + 1.0f) + sh; u32x2 pk; pk.x = pg8::cvt_pk_bf16(y[0], y[1]); pk.y = pg8::cvt_pk_bf16(y[2], y[3]); *(u32x2*)(o + c) = pk; }
        }
    }
#undef NORM_SRC
}
constexpr int CV_NCH = 2 * MW + RIN, CV_NG = CV_NCH / 4, CV_NCHUNK = (CV_NG + 63) / 64, CV_SEG = 16, CV_PAIRS = NC / (2 * CV_SEG);
static_assert(CV_NCHUNK == 12 && NC == NT - NC && GW % CV_SEG == 0 && CT % CV_SEG == 0 && 2 * MW == 1024 && RX_WL == 1536, "conv item layout");
typedef float f32x2 __attribute__((ext_vector_type(2)));
struct CvAct { float alpha, cA, cB, cC, cD; bool any; };
template <int NR> struct CvState { f32x2 wt[NR * 3][2]; f32x2 fw[NR][3][2]; u32x2 p[3][NR]; };
__device__ __forceinline__ void cv_unpk(const u32x2 p, f32x2 (&f)[2]) { f[0].x = pg8::bflo(p.x); f[0].y = pg8::bfhi(p.x); f[1].x = pg8::bflo(p.y); f[1].y = pg8::bfhi(p.y); }
template <int NR> __device__ __forceinline__ u32x2 cv_ld(const bf16* const (&rowp)[NR], const bool (&rok)[NR], int a, int col, int W) {
    const u32x2 zero2 = {0u, 0u};
    return (rok[a] && col >= 0 && col < W) ? *(const u32x2*)(rowp[a] + (size_t)col * PU) : zero2;
}
template <int NR, int S> __device__ __forceinline__ void cv_col(CvState<NR>& st, const bf16* const (&rowp)[NR], const bool (&rok)[NR], int cs, int W, int o, const CvAct& act, bf16* dst) {
#pragma unroll
    for (int a = 0; a < NR; ++a) { cv_unpk(st.p[S][a], st.fw[a][(S + 2) % 3]); const u32x2 zero2 = {0u, 0u}; st.p[S][a] = (o + 4 <= CV_SEG) ? cv_ld<NR>(rowp, rok, a, cs + o + 4, W) : zero2; }
    f32x2 acc[2];
#pragma unroll
    for (int e = 0; e < 2; ++e) acc[e] = st.wt[0][e] * st.fw[0][S][e];
#pragma unroll
    for (int a = 0; a < NR; ++a)
#pragma unroll
        for (int b = 0; b < 3; ++b) if (a + b > 0) {
#pragma unroll
            for (int e = 0; e < 2; ++e) acc[e] = __builtin_elementwise_fma(st.wt[a * 3 + b][e], st.fw[a][(S + b) % 3][e], acc[e]); }
    float v[4] = {acc[0].x, acc[0].y, acc[1].x, acc[1].y};
    if (act.any) {
#pragma unroll
        for (int e = 0; e < 4; ++e) { const float t = __builtin_amdgcn_rcpf(__builtin_amdgcn_exp2f(act.alpha * v[e]) + 1.0f); v[e] = (act.cA * v[e] + act.cB) * t + (act.cC * v[e] + act.cD); }
    }
    u32x2 pk; pk.x = pg8::cvt_pk_bf16(v[0], v[1]); pk.y = pg8::cvt_pk_bf16(v[2], v[3]);
    *(u32x2*)dst = pk;
}
template <int NR> __device__ __forceinline__ void conv_item(const bf16* const (&rowp)[NR], const bool (&rok)[NR], int cs, int W, const float* wsrc, int CH, const CvAct& act, bf16* dst, int dpitch) {
    CvState<NR> st;
#pragma unroll
    for (int a = 0; a < NR * 3; ++a) { const int tap = NR == 3 ? a : 3 + a; const f32x4 w0 = *(const f32x4*)(wsrc + (size_t)tap * CH);
        st.wt[a][0].x = w0[0]; st.wt[a][0].y = w0[1]; st.wt[a][1].x = w0[2]; st.wt[a][1].y = w0[3]; }
#pragma unroll
    for (int a = 0; a < NR; ++a) { cv_unpk(cv_ld<NR>(rowp, rok, a, cs - 1, W), st.fw[a][0]); cv_unpk(cv_ld<NR>(rowp, rok, a, cs, W), st.fw[a][1]); }
#pragma unroll
    for (int s3 = 0; s3 < 3; ++s3)
#pragma unroll
        for (int a = 0; a < NR; ++a) st.p[s3][a] = cv_ld<NR>(rowp, rok, a, cs + 1 + s3, W);
#pragma unroll 1
    for (int o = 0; o < CV_SEG - 1; o += 3) {
        cv_col<NR, 0>(st, rowp, rok, cs, W, o, act, dst + (size_t)o * dpitch);
        cv_col<NR, 1>(st, rowp, rok, cs, W, o + 1, act, dst + (size_t)(o + 1) * dpitch);
        cv_col<NR, 2>(st, rowp, rok, cs, W, o + 2, act, dst + (size_t)(o + 2) * dpitch);
    }
    cv_col<NR, 0>(st, rowp, rok, cs, W, CV_SEG - 1, act, dst + (size_t)(CV_SEG - 1) * dpitch);
}
__device__ __forceinline__ void conv_phase(LAS unsigned char* lds, CParams& P, int l, int vb, int G) {
    const int tid = threadIdx.x, lane = tid & 63;
    const bf16* U = WSP(bf16, WS_U1);
    LAS unsigned* cnt = (LAS unsigned*)lds;
    for (int sp = vb; sp < CV_PAIRS; sp += G) {
        __syncthreads();
        if (tid == 0) *cnt = 0u;
        __syncthreads();
        for (;;) {
            unsigned j = 0; if (lane == 0) j = __hip_atomic_fetch_add(cnt, 1u, __ATOMIC_RELAXED, __HIP_MEMORY_SCOPE_WORKGROUP);
            j = __builtin_amdgcn_readfirstlane(j);
            if (j >= 48u) break;
            const int cls = j / 12, jj = j % 12, lat = (cls & 1) == 0, heavy = cls < 2, ci = jj >> 1, chunk = heavy ? (ci >= 4 ? 6 + ci : ci) : 4 + ci;
            const int seg = (lat ? NC / CV_SEG : 0) + 2 * sp + (jj & 1), g = chunk * 64 + lane;
            if (g >= CV_NG) continue;
            const int ch = 4 * g; const bool isqk = ch < 2 * MW; const int c = isqk ? ch : ch - 2 * MW;
            const int ucol = isqk ? OFF_QK + c : OFF_R + c, CH = isqk ? 2 * MW : RIN;
            const float* wsrc = (isqk ? P.in[M_CONV] : P.in[R_CONV]) + (size_t)l * 9 * CH + c;
            const int kind = isqk ? (c < MW ? 0 : 1) : (c >= RX_GL ? 4 : (c >= RX_AL ? 2 : (c >= RX_WL ? 3 : 2)));
            CvAct act; act.alpha = kind == 3 ? 2.8853900817779268f : -1.4426950408889634f;
            act.cA = kind == 0 ? 0.08838834764831845f : (kind == 1 ? 1.0f : 0.0f); act.cB = kind == 3 ? -2.0f : (kind == 4 ? 1.0f : 0.0f); act.cC = kind == 2 ? 1.0f : 0.0f; act.cD = kind == 3 ? 1.0f : 0.0f;
            act.any = heavy;
            const int m0 = seg * CV_SEG; const SeqInfo q = seqinfo(seq_of_token(m0)); const int t0 = m0 - q.base;
            bf16* dst = isqk ? WSP(bf16, WS_QKC) + (size_t)m0 * (2 * MW) + c : WSP(bf16, WS_RXC) + (size_t)m0 * RIN + c; const int dpitch = isqk ? 2 * MW : RIN;
            if (q.grid) {
                const int r = t0 / GW, cs = t0 % GW, rows = q.T / GW;
                const bf16* rowp[3]; bool rok[3];
#pragma unroll
                for (int a = 0; a < 3; ++a) { const int rr = r + a - 1; rok[a] = rr >= 0 && rr < rows; rowp[a] = U + (size_t)(q.base + (rok[a] ? rr : r) * GW) * PU + ucol; }
                conv_item<3>(rowp, rok, cs, GW, wsrc, CH, act, dst, dpitch);
            } else {
                const bf16* rowp[1] = {U + (size_t)q.base * PU + ucol}; const bool rok[1] = {true};
                conv_item<1>(rowp, rok, t0, q.T, wsrc, CH, act, dst, dpitch);
            }
        }
    }
}
constexpr int PO_ITEMS = (NT / 16) * 2, PO_HC = RW / 2;
__device__ __forceinline__ void post_phase(LAS unsigned char* lds, CParams& P, int l, int vb, int G) {
    const int tid = threadIdx.x, w = tid >> 6, lane = tid & 63, fr = lane & 15, fq = lane >> 4, l32 = lane & 31, th = lane >> 5;
    constexpr int GP = PO_HC * 2 + 16;
    LAS unsigned char* gt = lds + w * (16 * GP);
    const bf16* U = WSP(bf16, WS_U1); const bf16* RX = WSP(bf16, WS_RXC); const bf16* G2T = WSP(bf16, O_G2T); bf16* O = WSP(bf16, WS_QKC);
    for (int it = vb * 8 + w; it < PO_ITEMS; it += G * 8) {
        const int tile = it >> 1, h = it & 1; const size_t tok0 = (size_t)tile * 16;
        bf16x8 af[4];
#pragma unroll
        for (int ks = 0; ks < 4; ++ks) af[ks] = *(const bf16x8*)(RX + (tok0 + fr) * RIN + RX_GL + 32 * ks + 8 * fq);
        for (int ct = 0; ct < PO_HC / 16; ++ct) { f32x4 acc = (f32x4){0.f, 0.f, 0.f, 0.f};
#pragma unroll
            for (int ks = 0; ks < 4; ++ks) acc = ml::mma(af[ks], *(const bf16x8*)(G2T + (size_t)(h * PO_HC + 16 * ct + fr) * 128 + 32 * ks + 8 * fq), acc);
#pragma unroll
            for (int r = 0; r < 4; ++r) *(LAS bf16*)(gt + (4 * fq + r) * GP + (16 * ct + fr) * 2) = f2bf(acc[r]); }
        asm volatile("s_waitcnt lgkmcnt(0)" ::: "memory");
        const int cb = h * PO_HC + 8 * l32;
        float gn[8], gw[8], gb[8], rk[8];
        { const f32x4 a0 = *(const f32x4*)(P.in[M_NORM_G] + (size_t)l * MW + cb), a1 = *(const f32x4*)(P.in[M_NORM_G] + (size_t)l * MW + cb + 4);
          const f32x4 b0 = *(const f32x4*)(P.in[R_GN_W] + (size_t)l * RW + cb), b1 = *(const f32x4*)(P.in[R_GN_W] + (size_t)l * RW + cb + 4);
          const f32x4 c0 = *(const f32x4*)(P.in[R_GN_B] + (size_t)l * RW + cb), c1 = *(const f32x4*)(P.in[R_GN_B] + (size_t)l * RW + cb + 4);
          const f32x4 d0 = *(const f32x4*)(P.in[R_RK] + (size_t)l * RW + cb), d1 = *(const f32x4*)(P.in[R_RK] + (size_t)l * RW + cb + 4);
#pragma unroll
          for (int e = 0; e < 4; ++e) { gn[e] = a0[e]; gn[4 + e] = a1[e]; gw[e] = b0[e]; gw[4 + e] = b1[e]; gb[e] = c0[e]; gb[4 + e] = c1[e]; rk[e] = d0[e]; rk[4 + e] = d1[e]; } }
        for (int tp = 0; tp < 8; ++tp) { const int tl = 2 * tp + th; const size_t m = tok0 + tl; const bf16* u = U + m * PU; const bf16* rx = RX + m * RIN;
            float hf[8], hb[8], ov[8], x[8]; unpack8(*(const u32x4*)(u + cb), hf); unpack8(*(const u32x4*)(u + MW + cb), hb); unpack8(*(const u32x4*)(u + OFF_O + cb), ov);
            float ss = 0.f;
#pragma unroll
            for (int e = 0; e < 8; ++e) { x[e] = hf[e] + hb[e]; ss += x[e] * x[e]; }
            ss = rw::allsum16(ss); const float rs = 1.0f / sqrtf(ss * (1.0f / 128.f) + RMS_EPS);
#pragma unroll
            for (int e = 0; e < 8; ++e) x[e] = x[e] * rs * gn[e] * pg8::fsigmoid(ov[e]);
            *(u32x4*)(O + m * D + cb) = pack8(x);
            float yf[8], yb[8], rr[8], kk[8], vv[8], gg[8], y[8]; unpack8(*(const u32x4*)(u + OFF_R + cb), yf); unpack8(*(const u32x4*)(u + OFF_R + RW + cb), yb);
            unpack8(*(const u32x4*)(rx + RX_R + cb), rr); unpack8(*(const u32x4*)(rx + RX_K + cb), kk); unpack8(*(const u32x4*)(rx + RX_V + cb), vv);
            unpack8(*(const LAS u32x4*)(gt + tl * GP + l32 * 16), gg);
            float mu = 0.f, bs = 0.f;
#pragma unroll
            for (int e = 0; e < 8; ++e) { y[e] = yf[e] + yb[e]; mu += y[e]; bs += rr[e] * kk[e] * rk[e]; }
            mu += rw::dpp_xor1(mu); mu += rw::dpp_xor2(mu); mu += __shfl_xor(mu, 4); mu *= (1.0f / 64.f);
            bs += rw::dpp_xor1(bs); bs += rw::dpp_xor2(bs); bs += __shfl_xor(bs, 4);
            float var = 0.f;
#pragma unroll
            for (int e = 0; e < 8; ++e) { y[e] -= mu; var += y[e] * y[e]; }
            var += rw::dpp_xor1(var); var += rw::dpp_xor2(var); var += __shfl_xor(var, 4); var *= (1.0f / 64.f);
            const float rsd = 1.0f / sqrtf(var + GN_EPS);
#pragma unroll
            for (int e = 0; e < 8; ++e) y[e] = (y[e] * rsd * gw[e] + gb[e] + bs * vv[e]) * gg[e];
            *(u32x4*)(O + m * D + MW + cb) = pack8(y);
        }
        asm volatile("s_waitcnt lgkmcnt(0)" ::: "memory");
    }
}
}

constexpr int LDS_BYTES = 147456;
constexpr int LDS_MISC = 147456 - 1024;
constexpr size_t CTL_ZERO_BYTES = 262144;
constexpr int CW_BAR = 4096, CW_Q = 8192;

#define XB_TMO      128
#define XB_XCNT(j)  (256  + 64 * (j))
#define XB_XSUB(j)  (1280 + 64 * (j))
#define XB_XGEN(j)  (2304 + 64 * (j))
#define XB_TOP      3328
#define XB_TOPGEN   3392
#define XCD_BAR_WORDS 3456
#define XB_SPIN_CAP (1u << 18)
__device__ __forceinline__ unsigned xb_ld(unsigned* p)              { return __hip_atomic_load(p, __ATOMIC_RELAXED, __HIP_MEMORY_SCOPE_AGENT); }
__device__ __forceinline__ unsigned xb_add(unsigned* p, unsigned v) { return __hip_atomic_fetch_add(p, v, __ATOMIC_RELAXED, __HIP_MEMORY_SCOPE_AGENT); }
__device__ __forceinline__ unsigned xb_xcc_id() { return (unsigned)__builtin_amdgcn_s_getreg((3 << 11) | 20) & 0xFu; }
#define XB_SPIN(cond, bar) do { unsigned _sp = 0; while (cond) { __builtin_amdgcn_s_sleep(1); \
    if ((++_sp & 255u) == 0u) { if (xb_ld(&(bar)[XB_TMO])) break; if (_sp > XB_SPIN_CAP) { atomicAdd(&(bar)[XB_TMO], 1u); break; } } } } while (0)
struct XcdBarrier { unsigned* bar; unsigned x; volatile LAS unsigned* st; };
__device__ __forceinline__ XcdBarrier xcd_barrier_post(unsigned* bar, volatile LAS unsigned* st) {
    XcdBarrier b; b.bar = bar; b.x = xb_xcc_id(); b.st = st;
    if (threadIdx.x == 0) (void)xb_add(&bar[XB_XCNT(b.x)], 1u);
    return b;
}
__device__ __forceinline__ void xcd_barrier_complete(unsigned* bar, unsigned x, unsigned& nloc, unsigned& nx) {
    const unsigned G = gridDim.x * gridDim.y * gridDim.z;
    unsigned sum, cnt, mine, sp = 0u;
    for (;;) {
        sum = 0u; cnt = 0u; mine = 0u;
#pragma unroll
        for (unsigned j = 0; j < 16; ++j) { const unsigned c = xb_ld(&bar[XB_XCNT(j)]); sum += c; cnt += (c > 0u) ? 1u : 0u; mine = (j == x) ? c : mine; }
        if (sum == G) break;
        __builtin_amdgcn_s_sleep(1);
        if ((++sp & 255u) == 0u) { if (xb_ld(&bar[XB_TMO])) break; if (sp > XB_SPIN_CAP) { atomicAdd(&bar[XB_TMO], 1u); break; } }
    }
    nloc = mine > 0u ? mine : 1u; nx = cnt > 0u ? cnt : 1u;
}
__device__ __forceinline__ void xcd_barrier(const XcdBarrier& b) {
    asm volatile("s_waitcnt vmcnt(0)" ::: "memory");
    __syncthreads();
    if (threadIdx.x == 0) {
        unsigned* bar = b.bar;
        __builtin_amdgcn_s_waitcnt(0);
        unsigned nloc = b.st[0], nx = b.st[1];
        if (nloc == 0u) { xcd_barrier_complete(bar, b.x, nloc, nx); b.st[0] = nloc; b.st[1] = nx; }
        const unsigned old = xb_add(&bar[XB_XSUB(b.x)], 1u);
        const unsigned gen = old / nloc;
        if (old + 1u == (gen + 1u) * nloc) {
            __builtin_amdgcn_fence(__ATOMIC_RELEASE, "agent");
            asm volatile("s_waitcnt vmcnt(0)" ::: "memory");
            const unsigned og = xb_add(&bar[XB_TOP], 1u);
            const unsigned tg = og / nx;
            if (og + 1u == (tg + 1u) * nx) xb_add(&bar[XB_TOPGEN], 1u);
            else XB_SPIN(xb_ld(&bar[XB_TOPGEN]) == tg, bar);
            __builtin_amdgcn_fence(__ATOMIC_ACQUIRE, "agent");
            xb_add(&bar[XB_XGEN(b.x)], 1u);
            asm volatile("s_waitcnt vmcnt(0)" ::: "memory");
        } else {
            XB_SPIN(xb_ld(&bar[XB_XGEN(b.x)]) == gen, bar);
            __builtin_amdgcn_fence(__ATOMIC_ACQUIRE, "agent");
            asm volatile("s_waitcnt vmcnt(0)" ::: "memory");
        }
    }
    __syncthreads();
}

constexpr int MX_RL = LB * RH * 2 * 4, MX_ML = LB * MH * 2 * ml::NVB, MX_RC = CB * RH * 2 * 4, MX_MC = CB * MH * 2 * ml::NVB;
constexpr int MX_ITEMS = MX_RL + MX_ML + MX_RC + MX_MC;

constexpr int ML_SPLIT = 0;
__device__ __forceinline__ void scan_phase(LAS unsigned char* lds, CParams& P, int l, unsigned* ctl) {
    unsigned* qhead = ctl + CW_Q + 64 * l;
    const bool split = gridDim.x >= 4 * wy::N_LAT * (1 + wy::NPROD) / 2;
    volatile LAS unsigned* bc = (volatile LAS unsigned*)(lds + LDS_MISC) + 16;
    for (;;) {
        if (threadIdx.x == 0) bc[0] = xb_add(qhead, 1u);
        __syncthreads();
        const int it = (int)bc[0];
        __syncthreads();
        if (!split || it >= wy::N_LAT) break;
        int s_, head, dir; wy::decode_item(it, s_, head, dir);
        wy::rwkv_cons(lds, P, l, s_, head, dir, it, ctl);
    }
    for (;;) {
        if (threadIdx.x == 0) bc[0] = xb_add(qhead + 8, 1u);
        __syncthreads();
        const int it = (int)bc[0];
        __syncthreads();
        if (it >= ML_SPLIT * ms::N_MLAT) break;
        int s_, head, dir, sub; ml::decode_item(it * ml::NVB, s_, head, dir, sub);
        ms::ml_cons(lds, P, l, s_, head, dir, it, ctl);
    }
    for (;;) {
        if (threadIdx.x == 0) bc[0] = xb_add(qhead + 48, 1u);
        __syncthreads();
        const int it = (int)bc[0];
        __syncthreads();
        if (!split || it >= wy::N_LAT * wy::NPROD) break;
        const int chain = it % wy::N_LAT;
        int s_, head, dir; wy::decode_item(chain, s_, head, dir);
        wy::rwkv_prod(lds, P, l, s_, head, dir, chain, it / wy::N_LAT, ctl);
    }
    for (;;) {
        if (threadIdx.x == 0) bc[0] = xb_add(qhead + 24, 1u);
        __syncthreads();
        const int it = (int)bc[0];
        __syncthreads();
        if (it >= ML_SPLIT * ms::N_MLAT * ms::MLPROD) break;
        const int chain = it % ms::N_MLAT;
        int s_, head, dir, sub; ml::decode_item(chain * ml::NVB, s_, head, dir, sub);
        ms::ml_prod(lds, P, l, s_, head, dir, chain, it / ms::N_MLAT, ctl);
    }
    for (;;) {
        if (threadIdx.x == 0) bc[0] = xb_add(qhead + 16, 1u);
        __syncthreads();
        const int it = (int)bc[0] + ML_SPLIT * ms::N_MLAT * ml::NVB;
        __syncthreads();
        if (it >= ml::N_ITEMS) break;
        int s_, head, dir, sub; ml::decode_item(it, s_, head, dir, sub);
        ml::mlstm_item2(lds, P, l, s_, head, dir, sub);
    }
    for (;;) {
        if (threadIdx.x == 0) bc[0] = xb_add(qhead + 32, 1u);
        __syncthreads();
        const int it = (int)bc[0] + (split ? LB * RH * 2 : 0);
        __syncthreads();
        if (it >= wy::N_ITEMS) break;
        int s_, head, dir; wy::decode_item(it, s_, head, dir);
        wy::rwkv_item(lds, P, l, s_, head, dir);
    }
}

enum { ST_N0 = 0, ST_A1, ST_CV, ST_MX, ST_PO, ST_N1, ST_A2, ST_PJ, ST_WO, ST_N2, ST_F1, ST_F2, ST_PER_LAYER };
constexpr int N_STEPS = 1 + DEPTH * ST_PER_LAYER + 1;
struct MkArgs { Params P; int ph_lo, ph_hi; };
__global__ void __launch_bounds__(512, 2) mk(MkArgs a) {
    extern __shared__ __attribute__((aligned(16))) unsigned char lds_raw[];
    LAS unsigned char* lds = (LAS unsigned char*)lds_raw;
    const int G = gridDim.x, vb = (int)blockIdx.x;
    unsigned* ctl = (unsigned*)(a.P.ws + WS_CTL);
    volatile LAS unsigned* MISC = (volatile LAS unsigned*)(lds + LDS_MISC);
    for (int u = threadIdx.x; u < 64; u += 512) MISC[u] = 0u;
    __syncthreads();
    const bool multi = a.ph_hi - a.ph_lo > 1;
    XcdBarrier bar; bar.bar = ctl + CW_BAR; bar.x = 0; bar.st = nullptr;
    if (multi) bar = xcd_barrier_post(ctl + CW_BAR, MISC + 8);
    const int lo = a.ph_lo, hi = a.ph_hi;
    const int fuse = (multi && lo == 0 && hi == N_STEPS && G == (NT / pg8::BM) * (D / pg8::BM)) ? 1 : 0;
#define STEP_BEGIN(id) if (lo <= (id) && (id) < hi) { unsigned long long kp_ = (unsigned long long)__builtin_amdgcn_kernarg_segment_ptr(); asm volatile("" : "+s"(kp_)); CParams& P = *(CParams*)kp_;
#define STEP_END(id) if ((id) + 1 < hi) xcd_barrier(bar); }
    STEP_BEGIN(0) el::init_phase(lds, P, vb, G); el::wconv_phase(lds, P, 0, vb, G); STEP_END(0)
#define LAYER(l) { \
        const int base = 1 + (l) * ST_PER_LAYER; \
        STEP_BEGIN(base + ST_N0) if ((l) > 0) el::wconv_phase(lds, P, (l), vb, G); if ((l) == 0 || !fuse) el::norm_phase(P, (l), 0, vb, G); STEP_END(base + ST_N0) \
        STEP_BEGIN(base + ST_A1) { pg8::Gemm g{WSP(bf16, WS_QKC), WSP(bf16, O_WIN1), D, D}; pg8::StaticOrder S; S.init(NT, N1P, G, vb); \
            pg8::EpiA1 E{WSP(bf16, WS_U1)}; pg8::gemm_phase(lds, g, S, E); } STEP_END(base + ST_A1) \
        STEP_BEGIN(base + ST_CV) el::conv_phase(lds, P, (l), vb, G); STEP_END(base + ST_CV) \
        STEP_BEGIN(base + ST_MX) scan_phase(lds, P, (l), ctl); STEP_END(base + ST_MX) \
        STEP_BEGIN(base + ST_PO) el::post_phase(lds, P, (l), vb, G); STEP_END(base + ST_PO) \
        STEP_BEGIN(base + ST_N1) el::norm_phase(P, (l), 1, vb, G); STEP_END(base + ST_N1) \
        STEP_BEGIN(base + ST_A2) { pg8::Gemm g{WSP(bf16, WS_RXC), WSP(bf16, O_WIN2), D, D}; pg8::StaticOrder S; S.init(NT, 2 * D, G, vb); \
            pg8::EpiA2 E{WSP(bf16, WS_U1)}; pg8::gemm_phase(lds, g, S, E); } STEP_END(base + ST_A2) \
        STEP_BEGIN(base + ST_PJ) { pg8::Gemm g{WSP(bf16, WS_QKC), WSP(bf16, O_PM), MW, D}; pg8::PairOrder S; S.init(NT, G, vb); \
            pg8::EpiPJ E{WSP(bf16, WS_U1)}; pg8::gemm_phase(lds, g, S, E); } STEP_END(base + ST_PJ) \
        STEP_BEGIN(base + ST_WO) { pg8::Gemm g{WSP(bf16, WS_U1), WSP(bf16, O_WO), D, PU}; pg8::StaticOrder S; S.init(NT, D, G, vb); \
            pg8::EpiResNorm E{P.out, WSP(float, WS_MOD) + (size_t)(l) * NCOND * 6 * D + 2 * D, (l) == 0 ? P.in[X_PROMPT] : nullptr, (l) == 0 ? P.in[X_SAMPLE] : nullptr, \
                fuse, P.in[NORM2] + (size_t)(l) * D, WSP(float, WS_MOD) + (size_t)(l) * NCOND * 6 * D + 3 * D, WSP(bf16, WS_QKC), P.ws, 1u + 2u * (l), lds}; pg8::gemm_phase(lds, g, S, E); } STEP_END(base + ST_WO) \
        if (!fuse) { STEP_BEGIN(base + ST_N2) el::norm_phase(P, (l), 2, vb, G); STEP_END(base + ST_N2) } \
        STEP_BEGIN(base + ST_F1) { pg8::Gemm g{WSP(bf16, WS_QKC), WSP(bf16, O_W13), D, D}; pg8::StaticOrder S; S.init(NT, 2 * FF, G, vb); \
            pg8::EpiF1 E{WSP(bf16, WS_U1)}; pg8::gemm_phase(lds, g, S, E); } STEP_END(base + ST_F1) \
        STEP_BEGIN(base + ST_F2) { pg8::Gemm g{WSP(bf16, WS_U1), WSP(bf16, O_W2), FF, FF}; pg8::StaticOrder S; S.init(NT, D, G, vb); \
            pg8::EpiResNorm E{P.out, WSP(float, WS_MOD) + (size_t)(l) * NCOND * 6 * D + 5 * D, nullptr, nullptr, fuse, \
                (l) + 1 < DEPTH ? P.in[NORM1] + (size_t)((l) + 1) * D : P.in[FINAL_G], (l) + 1 < DEPTH ? WSP(float, WS_MOD) + (size_t)((l) + 1) * NCOND * 6 * D : nullptr, \
                (l) + 1 < DEPTH ? WSP(bf16, WS_QKC) : nullptr, P.ws, 2u + 2u * (l), lds}; pg8::gemm_phase(lds, g, S, E); } \
            if ((l) + 1 < DEPTH || !fuse) { if (base + ST_F2 + 1 < hi) xcd_barrier(bar); } } \
    }
    static_assert(DEPTH == 2, "layers are unrolled by hand");
    LAYER(0)
    LAYER(1)
#undef LAYER
    if (!fuse) { STEP_BEGIN(N_STEPS - 1) el::norm_phase(P, 0, 3, vb, G); STEP_END(N_STEPS - 1) }
#undef STEP_BEGIN
#undef STEP_END
}
#endif

typedef void (*BodyFn)(const Params&, long);
#ifndef HOST_EMU
template <BodyFn F, int BLOCK> __global__ void __launch_bounds__(BLOCK) run_k(Params P, long n) {
    const long i = (long)blockIdx.x * BLOCK + threadIdx.x;
    if (i < n) F(P, i);
}
#define RUN(F, BLOCK, n) do { const long n_ = (n); run_k<F, BLOCK><<<dim3((unsigned)((n_ + BLOCK - 1) / BLOCK)), dim3(BLOCK), 0, stream>>>(P, n_); } while (0)
static int g_grid = 0;
#else
#define RUN(F, BLOCK, n) do { const long n_ = (n); for (long i_ = 0; i_ < n_; ++i_) F(P, i_); } while (0)
typedef void* hipStream_t;
#endif

static void forward(Params P, hipStream_t stream) {
    (void)stream;
#ifndef HOST_EMU
    if (hipMemsetAsync(P.ws + WS_CTL, 0, CTL_ZERO_BYTES, stream) != hipSuccess) return;
#ifdef MK_PER_STEP
    for (int st = 0; st < N_STEPS; ++st) { MkArgs a_{}; a_.P = P; a_.ph_lo = st; a_.ph_hi = st + 1; mk<<<dim3(g_grid), dim3(512), LDS_BYTES, stream>>>(a_); }
#else
    { MkArgs a_{}; a_.P = P; a_.ph_lo = 0; a_.ph_hi = N_STEPS; mk<<<dim3(g_grid), dim3(512), LDS_BYTES, stream>>>(a_); }
#endif
#else
    RUN(k_init_x, 256, (long)NT * D);
    RUN(k_mod, 256, (long)DEPTH * NCOND * 6 * D);
    for (int l = 0; l < DEPTH; ++l) {
        P.layer = l;
        RUN(k_wconv, 256, WC_N6);
        P.mode = 0; RUN(k_norm, 64, (long)NT);
        RUN(k_gemm_a1, 256, (long)NT * N1);
        RUN(k_conv, 256, (long)NT * (2 * MW + RIN));
        RUN(k_mlstm, 128, (long)NSEQ * MH * 2 * 128);
        for (int dir = 0; dir < 2; ++dir) { P.mode = dir; RUN(k_rwkv_prep, 256, (long)NT * RW); RUN(k_rwkv, 64, (long)NSEQ * RH * 64); }
        RUN(k_post, 256, (long)NT * D);
        P.mode = 1; RUN(k_norm, 64, (long)NT);
        RUN(k_gemm_a2, 256, (long)NT * 2 * D);
        RUN(k_gemm_pj, 256, (long)NT * D);
        RUN(k_gemm_wo, 256, (long)NT * D);
        P.mode = 2; RUN(k_norm, 64, (long)NT);
        RUN(k_gemm_f1, 256, (long)NT * FF);
        RUN(k_gemm_f2, 256, (long)NT * D);
    }
    RUN(k_final, 64, (long)NT);
#endif
}

#ifndef HOST_EMU
extern "C" void kernel_launch(void* const* d_in, const int* in_sizes, int n_in, void* d_out, int out_size, void* d_ws, size_t ws_size, hipStream_t stream) {
    if (n_in != N_IN || (size_t)out_size != OUT_END || ws_size < WS_END) return;
    if (g_grid == 0) {
        int dev = 0, cus = 0;
        if (hipGetDevice(&dev) != hipSuccess || hipDeviceGetAttribute(&cus, hipDeviceAttributeMultiprocessorCount, dev) != hipSuccess) { g_grid = -1; return; }
        if (hipFuncSetAttribute((const void*)mk, hipFuncAttributeMaxDynamicSharedMemorySize, LDS_BYTES) != hipSuccess) { g_grid = -1; return; }
        g_grid = cus;
    }
    if (g_grid < 0) return;
    Params P{};
    for (int i = 0; i < N_IN; ++i) P.in[i] = (const float*)d_in[i];
    P.out = (float*)d_out; P.ws = (unsigned char*)d_ws; P.layer = 0; P.mode = 0;
    forward(P, stream);
}
#endif
```

```cpp
#ifndef HOST_EMU
#include <hip/hip_runtime.h>
#define HD __host__ __device__ __forceinline__
#define DEV __device__ __forceinline__
#else
#include <cmath>
#include <cstring>
#include <cstdio>
#include <cstdlib>
#define HD inline
#define DEV inline
#endif
#include <cstddef>

#ifdef SMALL_CFG
constexpr int D = 256, CB = 2, CT = 128, DEPTH = 2, LB = 1, LT = 256, GW = 16;
#else
constexpr int D = 1024, CB = 32, CT = 256, DEPTH = 2, LB = 2, LT = 4096, GW = 64;
#endif
constexpr int MW = D / 2, MD = 128, MH = MW / MD, RW = D / 2, RD = 64, RH = RW / RD;
constexpr int RIN = 3 * RW + 384, FF = ((8 * D + 767) / 768) * 256, PIN = 2 * MW + MW + MW + 4 * MH + RIN + 2 * D;
constexpr int NC = CB * CT, NL = LB * LT, NT = NC + NL, NSEQ = CB + LB, NCOND = 1 + LB;
constexpr int N1 = PIN - 2 * D;
constexpr int N1P = ((N1 + 255) / 256) * 256;
constexpr int PU = N1;
constexpr int OFF_QK = 0, OFF_V = 2 * MW, OFF_O = 3 * MW, OFF_G = 4 * MW, OFF_R = 4 * MW + 4 * MH;
constexpr int RX_R = 0, RX_K = RW, RX_V = 2 * RW, RX_WL = 3 * RW, RX_AL = 3 * RW + 128, RX_GL = 3 * RW + 256;
constexpr float RMS_EPS = 1e-6f, GN_EPS = 64e-5f;
static_assert(3 * D <= N1, "G + merged must fit the dead columns of U1");

enum { X_PROMPT = 0, X_SAMPLE, ST_C, ST_N, ST_M, ST_R, C_LAT, C_CTX, ADA_W, ADA_B, NORM1, NORM2, W_IN, M_CONV, M_GATE_B, M_NORM_G,
       R_CONV, R_W0, R_W2, R_A0, R_A2, R_G2, R_KK, R_KA, R_RK, R_GN_W, R_GN_B, PROJ_M, PROJ_R, W_OUT, FFN_W1, FFN_W3, FFN_W2, FINAL_G, N_IN };

constexpr size_t OUT_X = 0;
constexpr size_t OUT_C = (size_t)NT * D;
constexpr size_t OUT_N = OUT_C + (size_t)CB * DEPTH * 2 * MH * 128 * 128;
constexpr size_t OUT_M = OUT_N + (size_t)CB * DEPTH * 2 * MH * 128;
constexpr size_t OUT_S = OUT_M + (size_t)CB * DEPTH * 2 * MH;
constexpr size_t OUT_END = OUT_S + (size_t)CB * DEPTH * 2 * RH * 64 * 64;

constexpr size_t al256(size_t x) { return (x + 255) & ~(size_t)255; }
constexpr size_t cmax(size_t a, size_t b) { return a > b ? a : b; }
constexpr size_t WS_CTL = 0;
constexpr size_t WS_MOD = (size_t)1 << 20;
constexpr size_t WS_WREG = (size_t)2 << 20;
constexpr size_t O_WIN1 = WS_WREG;
constexpr size_t O_WIN2 = O_WIN1 + (size_t)N1P * D * 2;
constexpr size_t O_PM = O_WIN2 + (size_t)2 * D * D * 2;
constexpr size_t O_PR = O_PM + (size_t)D * MW * 2;
constexpr size_t O_WO = O_PR + (size_t)D * RW * 2;
constexpr size_t O_W13 = O_WO + (size_t)D * D * 2;
constexpr size_t O_W2 = O_W13 + (size_t)2 * FF * D * 2;
constexpr size_t O_G2T = O_W2 + (size_t)D * FF * 2;
constexpr size_t O_W2T = O_G2T + (size_t)RW * 128 * 2;
constexpr size_t O_A2T = O_W2T + (size_t)2 * RW * 64 * 2;
constexpr size_t WS_U1 = al256(O_A2T + (size_t)2 * RW * 64 * 2);
constexpr size_t SZ_U1 = al256(cmax((size_t)NT * PU * 2, (size_t)NT * FF * 2));
constexpr size_t WS_QKC = WS_U1 + SZ_U1;
constexpr size_t WS_RXC = WS_QKC + (size_t)NT * D * 2;
constexpr size_t WS_END = WS_RXC + al256(cmax((size_t)NT * RIN * 2, (size_t)NT * D * 2));
#ifndef SMALL_CFG
static_assert(WS_END <= ((size_t)256 << 20), "workspace map must fit 256 MiB");
#endif

typedef unsigned short bf16;
HD float bf2f(bf16 b) { unsigned u = ((unsigned)b) << 16; return __builtin_bit_cast(float, u); }
#if defined(__HIP_DEVICE_COMPILE__)
HD bf16 f2bf(float f) { return __builtin_bit_cast(bf16, (__bf16)f); }
#else
HD bf16 f2bf(float f) { unsigned u = __builtin_bit_cast(unsigned, f); u += 0x7fffu + ((u >> 16) & 1u); return (bf16)(u >> 16); }
#endif
HD float sigmoidf_(float x) { return 1.0f / (1.0f + expf(-x)); }
HD float siluf_(float x) { return x / (1.0f + expf(-x)); }
HD float softplusf_(float x) { return fmaxf(x, 0.f) + log1pf(expf(-fabsf(x))); }
HD float logsigmoidf_(float x) { return -softplusf_(-x); }
HD int prow(int c) { return (c & ~31) | (((c >> 2) & 1) << 4) | (((c >> 3) & 3) << 2) | (c & 3); }

struct Params {
    const float* in[N_IN];
    float* out;
    unsigned char* ws;
    int layer;
    int mode;
};

struct SeqInfo { int T; int base; int grid; int cond; int b; };
HD SeqInfo seqinfo(int s) {
    SeqInfo q;
    if (s < CB) { q.T = CT; q.base = s * CT; q.grid = 0; q.cond = 0; q.b = s; }
    else { q.T = LT; q.base = NC + (s - CB) * LT; q.grid = 1; q.cond = 1 + (s - CB); q.b = s - CB; }
    return q;
}
HD int seq_of_token(int m) { return m < NC ? m / CT : CB + (m - NC) / LT; }

#define WSP(T, off) ((T*)(P.ws + (off)))

DEV void k_init_x(const Params& P, long i) {
    const size_t ncd = (size_t)NC * D;
    P.out[i] = (size_t)i < ncd ? P.in[X_PROMPT][i] : P.in[X_SAMPLE][i - ncd];
}
DEV void k_mod(const Params& P, long i) {
    const int j = (int)(i % (6 * D)); const int ci = (int)((i / (6 * D)) % NCOND); const int l = (int)(i / ((long)6 * D * NCOND));
    const float* cv = ci == 0 ? P.in[C_CTX] : P.in[C_LAT] + (size_t)(ci - 1) * D;
    const float* w = P.in[ADA_W] + (size_t)l * D * 6 * D;
    float acc = P.in[ADA_B][(size_t)l * 6 * D + j];
    for (int k = 0; k < D; ++k) acc += siluf_(cv[k]) * w[(size_t)k * 6 * D + j];
    WSP(float, WS_MOD)[i] = acc;
}
constexpr long WC_N0 = (long)N1P * D, WC_N1 = WC_N0 + (long)2 * D * D, WC_N2 = WC_N1 + (long)D * MW, WC_N3 = WC_N2 + (long)D * RW,
               WC_N4 = WC_N3 + (long)D * D, WC_N5 = WC_N4 + (long)2 * FF * D, WC_N6 = WC_N5 + (long)D * FF;
HD int unprow(int r) { return (r & ~31) | (((r >> 2) & 3) << 3) | (((r >> 4) & 1) << 2) | (r & 3); }
DEV void k_wconv(const Params& P, long i) {
    const int l = P.layer;
    if (i < WC_N0) { const int r = (int)(i / D), k = (int)(i % D); const int c = unprow(r);
        WSP(bf16, O_WIN1)[i] = c < N1 ? f2bf(P.in[W_IN][((size_t)l * D + k) * PIN + c]) : (bf16)0; return; }
    if (i < WC_N1) { const long j = i - WC_N0; const int r = (int)(j / D), k = (int)(j % D); const int c = unprow(r);
        WSP(bf16, O_WIN2)[j] = f2bf(P.in[W_IN][((size_t)l * D + k) * PIN + N1 + c]); return; }
    if (i < WC_N2) { const long j = i - WC_N1; const int r = (int)(j / MW), k = (int)(j % MW); const int c = unprow(r);
        WSP(bf16, O_PM)[j] = f2bf(P.in[PROJ_M][((size_t)l * MW + k) * D + c]); return; }
    if (i < WC_N3) { const long j = i - WC_N2; const int r = (int)(j / RW), k = (int)(j % RW); const int c = unprow(r);
        WSP(bf16, O_PR)[j] = f2bf(P.in[PROJ_R][((size_t)l * RW + k) * D + c]); return; }
    if (i < WC_N4) { const long j = i - WC_N3; const int r = (int)(j / D), k = (int)(j % D);
        WSP(bf16, O_WO)[j] = f2bf(P.in[W_OUT][((size_t)l * D + k) * D + r]); return; }
    if (i < WC_N5) { const long j = i - WC_N4; const int r = (int)(j / D), k = (int)(j % D);
        const int pn = r >> 8, rl = r & 255, which = rl >> 7, rho = rl & 127; const int jj = pn * 128 + unprow(rho);
        const float* W = which ? P.in[FFN_W3] : P.in[FFN_W1];
        WSP(bf16, O_W13)[j] = f2bf(W[((size_t)l * D + k) * FF + jj]); return; }
    { const long j = i - WC_N5; const int r = (int)(j / FF), k = (int)(j % FF);
        WSP(bf16, O_W2)[j] = f2bf(P.in[FFN_W2][((size_t)l * FF + k) * D + r]); }
}
DEV void k_norm(const Params& P, long m) {
    const int l = P.layer; const int second = (P.mode == 2);
    const float* x = P.out + (size_t)m * D;
    const float* g = P.in[second ? NORM2 : NORM1] + (size_t)l * D;
    const int cond = seqinfo(seq_of_token((int)m)).cond;
    const float* mod = WSP(float, WS_MOD) + ((size_t)l * NCOND + cond) * 6 * D + (second ? 3 * D : 0);
    float ss = 0.f;
    for (int k = 0; k < D; ++k) ss += x[k] * x[k];
    const float rs = 1.0f / sqrtf(ss / D + RMS_EPS);
    bf16* o = WSP(bf16, P.mode == 1 ? WS_RXC : WS_QKC) + (size_t)m * D;
    for (int k = 0; k < D; ++k) o[k] = f2bf(x[k] * rs * g[k] * (1.0f + mod[D + k]) + mod[k]);
}
DEV float dot_bf(const bf16* a, const bf16* b, int K) { float s = 0.f; for (int k = 0; k < K; ++k) s += bf2f(a[k]) * bf2f(b[k]); return s; }
DEV void k_gemm_a1(const Params& P, long i) {
    const int n = (int)(i % N1); const long m = i / N1;
    WSP(bf16, WS_U1)[(size_t)m * PU + n] = f2bf(dot_bf(WSP(bf16, WS_QKC) + (size_t)m * D, WSP(bf16, O_WIN1) + (size_t)prow(n) * D, D));
}
DEV void k_gemm_a2(const Params& P, long i) {
    const int n = (int)(i % (2 * D)); const long m = i / (2 * D);
    WSP(bf16, WS_U1)[(size_t)m * PU + D + n] = f2bf(sigmoidf_(dot_bf(WSP(bf16, WS_RXC) + (size_t)m * D, WSP(bf16, O_WIN2) + (size_t)prow(n) * D, D)));
}
DEV void k_gemm_pj(const Params& P, long i) {
    const int n = (int)(i % D); const long m = i / D;
    const bf16* hmr = WSP(bf16, WS_QKC) + (size_t)m * D; bf16* u = WSP(bf16, WS_U1) + (size_t)m * PU;
    const float a = dot_bf(hmr, WSP(bf16, O_PM) + (size_t)prow(n) * MW, MW), b = dot_bf(hmr + MW, WSP(bf16, O_PR) + (size_t)prow(n) * RW, RW);
    const float first = bf2f(f2bf(bf2f(u[D + n]) * a));
    u[n] = f2bf(first + bf2f(u[2 * D + n]) * b);
}
DEV void k_gemm_wo(const Params& P, long i) {
    const int n = (int)(i % D); const long m = i / D; const int l = P.layer;
    const int cond = seqinfo(seq_of_token((int)m)).cond;
    const float g1 = WSP(float, WS_MOD)[((size_t)l * NCOND + cond) * 6 * D + 2 * D + n];
    P.out[(size_t)m * D + n] += g1 * dot_bf(WSP(bf16, WS_U1) + (size_t)m * PU, WSP(bf16, O_WO) + (size_t)n * D, D);
}
DEV void k_gemm_f1(const Params& P, long i) {
    const int j = (int)(i % FF); const long m = i / FF;
    const int pn = j >> 7, rho = prow(j & 127);
    const bf16* h = WSP(bf16, WS_QKC) + (size_t)m * D;
    const float a = dot_bf(h, WSP(bf16, O_W13) + (size_t)(pn * 256 + rho) * D, D), b = dot_bf(h, WSP(bf16, O_W13) + (size_t)(pn * 256 + 128 + rho) * D, D);
    WSP(bf16, WS_U1)[(size_t)m * FF + j] = f2bf(siluf_(a) * b);
}
DEV void k_gemm_f2(const Params& P, long i) {
    const int n = (int)(i % D); const long m = i / D; const int l = P.layer;
    const int cond = seqinfo(seq_of_token((int)m)).cond;
    const float g2 = WSP(float, WS_MOD)[((size_t)l * NCOND + cond) * 6 * D + 5 * D + n];
    P.out[(size_t)m * D + n] += g2 * dot_bf(WSP(bf16, WS_U1) + (size_t)m * FF, WSP(bf16, O_W2) + (size_t)n * FF, FF);
}
DEV void k_conv(const Params& P, long i) {
    constexpr int NCH = 2 * MW + RIN;
    const int ch = (int)(i % NCH); const int m = (int)(i / NCH); const int l = P.layer;
    const int s = seq_of_token(m); const SeqInfo q = seqinfo(s); const int t = m - q.base;
    const bool isqk = ch < 2 * MW; const int c = isqk ? ch : ch - 2 * MW;
    const int ucol = isqk ? OFF_QK + c : OFF_R + c;
    const int CH = isqk ? 2 * MW : RIN;
    const float* w = (isqk ? P.in[M_CONV] : P.in[R_CONV]) + (size_t)l * 9 * CH;
    const bf16* U = WSP(bf16, WS_U1);
    float acc = 0.f;
    if (q.grid) {
        const int r = t / GW, cc = t % GW, rows = q.T / GW;
        for (int a = 0; a < 3; ++a) for (int b = 0; b < 3; ++b) {
            const int rr = r + a - 1, c2 = cc + b - 1;
            if (rr >= 0 && rr < rows && c2 >= 0 && c2 < GW) acc += w[(a * 3 + b) * CH + c] * bf2f(U[(size_t)(q.base + rr * GW + c2) * PU + ucol]);
        }
    } else {
        for (int b = 0; b < 3; ++b) { const int t2 = t + b - 1; if (t2 >= 0 && t2 < q.T) acc += w[(3 + b) * CH + c] * bf2f(U[(size_t)(q.base + t2) * PU + ucol]); }
    }
    if (isqk) { float v = siluf_(acc); if (c < MW) v *= 0.08838834764831845f; WSP(bf16, WS_QKC)[(size_t)m * (2 * MW) + c] = f2bf(v); }
    else { float v = acc; if (c >= RX_WL && c < RX_AL) v = tanhf(v); else if (c >= RX_GL) v = sigmoidf_(v); WSP(bf16, WS_RXC)[(size_t)m * RIN + c] = f2bf(v); }
}
DEV void k_mlstm(const Params& P, long i) {
    const int e = (int)(i % 128); const int chain = (int)(i / 128); const int dir = chain & 1, head = (chain >> 1) % MH, s = chain / (2 * MH);
    const int l = P.layer; const SeqInfo q = seqinfo(s);
    float C[128], n[128]; float m;
    if (!q.grid) {
#pragma unroll
        for (int d = 0; d < 128; ++d) { C[d] = 0.f; n[d] = 0.f; }
        m = 0.f;
    } else {
        const size_t sb = (((size_t)q.b * DEPTH + l) * 2 + dir) * MH + head;
#pragma unroll
        for (int d = 0; d < 128; ++d) { C[d] = P.in[ST_C][(sb * 128 + d) * 128 + e]; n[d] = P.in[ST_N][sb * 128 + d]; }
        m = P.in[ST_M][sb];
    }
    const float bi = P.in[M_GATE_B][(size_t)l * 4 * MH + (2 * dir) * MH + head], bfg = P.in[M_GATE_B][(size_t)l * 4 * MH + (2 * dir + 1) * MH + head];
    bf16* U = WSP(bf16, WS_U1); const bf16* QK = WSP(bf16, WS_QKC);
    float nsel = 0.f;
    for (int p = 0; p < q.T; ++p) {
        const int t = dir ? q.T - 1 - p : p; const size_t tok = (size_t)(q.base + t);
        const bf16* qk = QK + tok * (2 * MW); bf16* u = U + tok * PU;
        const float gi = bf2f(u[OFF_G + (2 * dir) * MH + head]) + bi, gf = bf2f(u[OFF_G + (2 * dir + 1) * MH + head]) + bfg;
        const float lf = logsigmoidf_(gf);
        const float mn = fmaxf(lf + m, gi); const float fw = expf(lf + m - mn), iw = expf(gi - mn);
        const float v = bf2f(u[OFF_V + head * 128 + e]);
        float num = 0.f, den = 0.f;
#pragma unroll
        for (int d = 0; d < 128; ++d) {
            const float kd = bf2f(qk[MW + head * 128 + d]), qd = bf2f(qk[head * 128 + d]);
            C[d] = fw * C[d] + iw * kd * v; n[d] = fw * n[d] + iw * kd; num += qd * C[d]; den += qd * n[d];
        }
        m = mn;
        u[dir * MW + head * 128 + e] = f2bf(num / fmaxf(fabsf(den), expf(-m)));
    }
    if (!q.grid) {
        const size_t sb = (((size_t)q.b * DEPTH + l) * 2 + dir) * MH + head;
#pragma unroll
        for (int d = 0; d < 128; ++d) { P.out[OUT_C + (sb * 128 + d) * 128 + e] = C[d]; if (d == e) nsel = n[d]; }
        P.out[OUT_N + sb * 128 + e] = nsel;
        if (e == 0) P.out[OUT_M + sb] = m;
    }
}
DEV void k_rwkv_prep(const Params& P, long i) {
    const int c = (int)(i % RW); const size_t tok = (size_t)(i / RW); const int l = P.layer, dir = P.mode;
    const bf16* rx = WSP(bf16, WS_RXC) + tok * RIN;
    const float* w2 = P.in[R_W2] + ((size_t)l * 2 + dir) * 64 * RW + c; const float* a2 = P.in[R_A2] + ((size_t)l * 2 + dir) * 64 * RW + c;
    float wr = P.in[R_W0][((size_t)l * 2 + dir) * RW + c], ar = P.in[R_A0][((size_t)l * 2 + dir) * RW + c];
    for (int j = 0; j < 64; ++j) { wr += bf2f(rx[RX_WL + dir * 64 + j]) * w2[(size_t)j * RW]; ar += bf2f(rx[RX_AL + dir * 64 + j]) * a2[(size_t)j * RW]; }
    bf16* o = WSP(bf16, WS_QKC) + tok * (2 * RW);
    o[c] = f2bf(wr); o[RW + c] = f2bf(ar);
}
DEV void k_rwkv(const Params& P, long i) {
    const int row = (int)(i % 64); const int chain = (int)(i / 64); const int dir = P.mode, head = chain % RH, s = chain / RH;
    const int l = P.layer; const SeqInfo q = seqinfo(s); const int hc = head * 64;
    float S[64];
    if (!q.grid) {
#pragma unroll
        for (int c = 0; c < 64; ++c) S[c] = 0.f;
    } else {
        const size_t sb = (((size_t)q.b * DEPTH + l) * 2 + dir) * RH + head;
#pragma unroll
        for (int c = 0; c < 64; ++c) S[c] = P.in[ST_R][(sb * 64 + row) * 64 + c];
    }
    const float* rkk = P.in[R_KK] + (size_t)l * RW + hc; const float* rka = P.in[R_KA] + (size_t)l * RW + hc;
    bf16* U = WSP(bf16, WS_U1); const bf16* RX = WSP(bf16, WS_RXC); const bf16* WA = WSP(bf16, WS_QKC);
    for (int p = 0; p < q.T; ++p) {
        const int t = dir ? q.T - 1 - p : p; const size_t tok = (size_t)(q.base + t);
        const bf16* rx = RX + tok * RIN; const bf16* wa = WA + tok * (2 * RW);
        float ss = 0.f;
        for (int c = 0; c < 64; ++c) { const float kc = bf2f(rx[RX_K + hc + c]) * rkk[c]; ss += kc * kc; }
        const float inv = 1.0f / fmaxf(sqrtf(ss), 1e-12f);
        float sa = 0.f;
#pragma unroll
        for (int c = 0; c < 64; ++c) sa -= S[c] * (bf2f(rx[RX_K + hc + c]) * rkk[c] * inv);
        const float v = bf2f(rx[RX_V + hc + row]);
        float y = 0.f;
#pragma unroll
        for (int c = 0; c < 64; ++c) {
            const float wr = bf2f(wa[hc + c]), ar = bf2f(wa[RW + hc + c]);
            const float decay = expf(-0.6065306597126334f * sigmoidf_(wr));
            const float alpha = sigmoidf_(ar);
            const float kr = bf2f(rx[RX_K + hc + c]);
            const float kt = kr * (1.0f + (alpha - 1.0f) * rka[c]);
            const float bb = kr * rkk[c] * inv * alpha;
            S[c] = S[c] * decay + sa * bb + v * kt;
            y += S[c] * bf2f(rx[RX_R + hc + c]);
        }
        U[tok * PU + OFF_R + dir * RW + hc + row] = f2bf(y);
    }
    if (!q.grid) {
        const size_t sb = (((size_t)q.b * DEPTH + l) * 2 + dir) * RH + head;
#pragma unroll
        for (int c = 0; c < 64; ++c) P.out[OUT_S + (sb * 64 + row) * 64 + c] = S[c];
    }
}
DEV void k_post(const Params& P, long i) {
    const int ch = (int)(i % D); const size_t m = (size_t)(i / D); const int l = P.layer;
    const bf16* u = WSP(bf16, WS_U1) + m * PU; const bf16* rx = WSP(bf16, WS_RXC) + m * RIN;
    bf16* o = WSP(bf16, WS_QKC) + m * D;
    if (ch < MW) {
        const int h0 = (ch / 128) * 128; float ss = 0.f;
        for (int d = 0; d < 128; ++d) { const float x = bf2f(u[h0 + d]) + bf2f(u[MW + h0 + d]); ss += x * x; }
        const float x = bf2f(u[ch]) + bf2f(u[MW + ch]);
        o[ch] = f2bf(x / sqrtf(ss / 128.f + RMS_EPS) * P.in[M_NORM_G][(size_t)l * MW + ch] * sigmoidf_(bf2f(u[OFF_O + ch])));
    } else {
        const int c = ch - MW; const int h0 = (c / 64) * 64;
        float mu = 0.f, bsum = 0.f;
        for (int d = 0; d < 64; ++d) { mu += bf2f(u[OFF_R + h0 + d]) + bf2f(u[OFF_R + RW + h0 + d]);
            bsum += bf2f(rx[RX_R + h0 + d]) * bf2f(rx[RX_K + h0 + d]) * P.in[R_RK][(size_t)l * RW + h0 + d]; }
        mu *= (1.0f / 64.f); float var = 0.f;
        for (int d = 0; d < 64; ++d) { const float x = bf2f(u[OFF_R + h0 + d]) + bf2f(u[OFF_R + RW + h0 + d]) - mu; var += x * x; }
        var *= (1.0f / 64.f);
        const float y = bf2f(u[OFF_R + c]) + bf2f(u[OFF_R + RW + c]);
        const float yn = (y - mu) / sqrtf(var + GN_EPS) * P.in[R_GN_W][(size_t)l * RW + c] + P.in[R_GN_B][(size_t)l * RW + c];
        float gate = 0.f;
        for (int j = 0; j < 128; ++j) gate += bf2f(rx[RX_GL + j]) * P.in[R_G2][((size_t)l * 128 + j) * RW + c];
        o[ch] = f2bf((yn + bsum * bf2f(rx[RX_V + c])) * gate);
    }
}
DEV void k_final(const Params& P, long m) {
    float* x = P.out + (size_t)m * D; float ss = 0.f;
    for (int k = 0; k < D; ++k) ss += x[k] * x[k];
    const float rs = 1.0f / sqrtf(ss / D + RMS_EPS);
    for (int k = 0; k < D; ++k) x[k] = x[k] * rs * P.in[FINAL_G][k];
}


#ifndef HOST_EMU
typedef const __attribute__((address_space(4))) Params CParams;
namespace pg8 {
#define PG8_LAS __attribute__((address_space(3)))
typedef short bf16x8 __attribute__((ext_vector_type(8)));
typedef float f32x4 __attribute__((ext_vector_type(4)));
typedef unsigned u32x4 __attribute__((ext_vector_type(4)));
constexpr int BM = 256, BK = 64, HALF = 128, HTB = HALF * BK * 2, STAGE_BYTES = 8 * HTB, NXCD = 8, WGM = 8;
__device__ __forceinline__ int lds_byte(int r, int c) { const int st = (r >> 4) * 2 + (c >> 5), rr = r & 15, cc = c & 31, ob = rr * 64 + cc * 2; return st * 1024 + (ob ^ (((ob >> 9) & 1) << 5)); }
__device__ __forceinline__ void stage_rc(int b, int& R, int& C) { const int st = b / 1024, sb = b % 1024, swz = sb ^ (((sb >> 9) & 1) << 5); R = (st >> 1) * 16 + swz / 64; C = (st & 1) * 32 + (swz % 64) / 2; }
struct Unit { int pm, pn, aoff; };
struct Gemm { const bf16* A; const bf16* Bt; int K, lda; };
struct StaticOrder {
    int nM, nN, nwg, G, c;
    __device__ __forceinline__ void init(int M, int N, int G_, int c_) { nM = M / BM; nN = N / BM; nwg = nM * nN; G = G_; c = c_; }
    __device__ __forceinline__ bool next(int i, Unit& u) const {
        const long L = (long)i * G + c; if (L >= nwg) return false;
        int wgid = (int)L; { const int q = nwg / NXCD, r = nwg % NXCD, xcd = wgid % NXCD, off = wgid / NXCD; wgid = (xcd < r ? xcd * (q + 1) : r * (q + 1) + (xcd - r) * q) + off; }
        const int nig = WGM * nN, gid = wgid / nig, fm = gid * WGM, gsz = (nM - fm) < WGM ? (nM - fm) : WGM;
        u.pm = fm + ((wgid % nig) % gsz); u.pn = (wgid % nig) / gsz; u.aoff = 0; return true;
    }
};
struct PairOrder {
    int nbase, G, v, nct;
    __device__ __forceinline__ void init(int M, int G_, int c_) { nct = D / BM; nbase = (M / BM) * nct; G = G_; v = (G_ % 8 == 0) ? (c_ % 8) * (G_ / 8) + c_ / 8 : c_; }
    __device__ __forceinline__ bool next(int i, Unit& u) const {
        const int j = v + (i >> 1) * G; if (j >= nbase) return false;
        const int half = i & 1; u.pm = j / nct; u.pn = half * nct + (j % nct); u.aoff = half * MW; return true;
    }
};
typedef float f32x2_t __attribute__((ext_vector_type(2)));
typedef __bf16 bf16x2_t __attribute__((ext_vector_type(2)));
__device__ __forceinline__ unsigned cvt_pk_bf16(float lo, float hi) { f32x2_t v = {lo, hi}; bf16x2_t b = __builtin_convertvector(v, bf16x2_t); return __builtin_bit_cast(unsigned, b); }
__device__ __forceinline__ float fsigmoid(float x) { return __builtin_amdgcn_rcpf(1.0f + __expf(-x)); }
__device__ __forceinline__ float bflo(unsigned w) { return __builtin_bit_cast(float, w << 16); }
__device__ __forceinline__ float bfhi(unsigned w) { return __builtin_bit_cast(float, w & 0xffff0000u); }

struct EpiA1 {
    bf16* U;
    __device__ __forceinline__ void operator()(const f32x4 (&acc)[2][2][4][2], const Unit& u, int wr, int wc, int fr, int fq) const {
        const int row0 = u.pm * BM + wr * 64 + fr, col0 = u.pn * BM + wc * 32 + 8 * fq;
#pragma unroll
        for (int ai = 0; ai < 2; ++ai)
#pragma unroll
            for (int m = 0; m < 4; ++m) { bf16* rowp = U + (size_t)(row0 + ai * HALF + m * 16) * PU + col0;
#pragma unroll
                for (int bj = 0; bj < 2; ++bj) { if (col0 + bj * HALF < N1) { const f32x4 v0 = acc[ai][bj][m][0], v1 = acc[ai][bj][m][1];
                    u32x4 w; w.x = cvt_pk_bf16(v0[0], v0[1]); w.y = cvt_pk_bf16(v0[2], v0[3]); w.z = cvt_pk_bf16(v1[0], v1[1]); w.w = cvt_pk_bf16(v1[2], v1[3]);
                    *(u32x4*)(rowp + bj * HALF) = w; } } }
    }
};
struct EpiA2 {
    bf16* U;
    __device__ __forceinline__ void operator()(const f32x4 (&acc)[2][2][4][2], const Unit& u, int wr, int wc, int fr, int fq) const {
        const int row0 = u.pm * BM + wr * 64 + fr, col0 = D + u.pn * BM + wc * 32 + 8 * fq;
#pragma unroll
        for (int ai = 0; ai < 2; ++ai)
#pragma unroll
            for (int m = 0; m < 4; ++m) { bf16* rowp = U + (size_t)(row0 + ai * HALF + m * 16) * PU + col0;
#pragma unroll
                for (int bj = 0; bj < 2; ++bj) { const f32x4 v0 = acc[ai][bj][m][0], v1 = acc[ai][bj][m][1];
                    u32x4 w; w.x = cvt_pk_bf16(fsigmoid(v0[0]), fsigmoid(v0[1])); w.y = cvt_pk_bf16(fsigmoid(v0[2]), fsigmoid(v0[3]));
                    w.z = cvt_pk_bf16(fsigmoid(v1[0]), fsigmoid(v1[1])); w.w = cvt_pk_bf16(fsigmoid(v1[2]), fsigmoid(v1[3]));
                    *(u32x4*)(rowp + bj * HALF) = w; } }
    }
};
struct EpiPJ {
    bf16* U;
    __device__ __forceinline__ void operator()(const f32x4 (&acc)[2][2][4][2], const Unit& u, int wr, int wc, int fr, int fq) const {
        const int nct = D / BM, half = u.pn >= nct ? 1 : 0, ct = u.pn - half * nct;
        const int row0 = u.pm * BM + wr * 64 + fr, col0 = ct * BM + wc * 32 + 8 * fq;
#pragma unroll
        for (int ai = 0; ai < 2; ++ai)
#pragma unroll
            for (int mp = 0; mp < 4; mp += 2) { u32x4 gq[2][2], pq[2][2];
#pragma unroll
                for (int mm = 0; mm < 2; ++mm) { const bf16* rowp = U + (size_t)(row0 + ai * HALF + (mp + mm) * 16) * PU + col0;
#pragma unroll
                    for (int bj = 0; bj < 2; ++bj) { gq[mm][bj] = *(const u32x4*)(rowp + (1 + half) * D + bj * HALF); if (half) pq[mm][bj] = *(const u32x4*)(rowp + bj * HALF); } }
#pragma unroll
                for (int mm = 0; mm < 2; ++mm) { const int m = mp + mm; bf16* rowp = U + (size_t)(row0 + ai * HALF + m * 16) * PU + col0;
#pragma unroll
                    for (int bj = 0; bj < 2; ++bj) { const f32x4 v0 = acc[ai][bj][m][0], v1 = acc[ai][bj][m][1]; const u32x4 g = gq[mm][bj];
                        float o[8] = { bflo(g.x) * v0[0], bfhi(g.x) * v0[1], bflo(g.y) * v0[2], bfhi(g.y) * v0[3], bflo(g.z) * v1[0], bfhi(g.z) * v1[1], bflo(g.w) * v1[2], bfhi(g.w) * v1[3] };
                        if (half) { const u32x4 p = pq[mm][bj];
                            o[0] += bflo(p.x); o[1] += bfhi(p.x); o[2] += bflo(p.y); o[3] += bfhi(p.y); o[4] += bflo(p.z); o[5] += bfhi(p.z); o[6] += bflo(p.w); o[7] += bfhi(p.w); }
                        u32x4 w; w.x = cvt_pk_bf16(o[0], o[1]); w.y = cvt_pk_bf16(o[2], o[3]); w.z = cvt_pk_bf16(o[4], o[5]); w.w = cvt_pk_bf16(o[6], o[7]);
                        *(u32x4*)(rowp + bj * HALF) = w; } }
                asm volatile("" ::: "memory"); }
    }
};
struct EpiRes {
    float* X; const float* gate;
    const float* sa; const float* sb;
    __device__ __forceinline__ void operator()(const f32x4 (&acc)[2][2][4][2], const Unit& u, int wr, int wc, int fr, int fq) const {
        const int row0 = u.pm * BM + wr * 64 + fr, col0 = u.pn * BM + wc * 32 + 4 * fq;
        const float* S = sa ? (u.pm * BM < NC ? sa : sb - (size_t)NC * D) : X;
        const int cond = seqinfo(seq_of_token(u.pm * BM)).cond;
        const float* gp = gate + (size_t)cond * 6 * D + col0;
        f32x4 gv[2][2];
#pragma unroll
        for (int bj = 0; bj < 2; ++bj)
#pragma unroll
            for (int n = 0; n < 2; ++n) gv[bj][n] = *(const f32x4*)(gp + bj * HALF + n * 16);
#pragma unroll
        for (int ai = 0; ai < 2; ++ai)
#pragma unroll
            for (int m = 0; m < 4; ++m) { const size_t ro = (size_t)(row0 + ai * HALF + m * 16) * D + col0; float* rowp = X + ro; const float* srow = S + ro;
#pragma unroll
                for (int bj = 0; bj < 2; ++bj)
#pragma unroll
                    for (int n = 0; n < 2; ++n) { *(f32x4*)(rowp + bj * HALF + n * 16) = *(const f32x4*)(srow + bj * HALF + n * 16) + gv[bj][n] * acc[ai][bj][m][n]; }
                asm volatile("" ::: "memory"); }
    }
};
typedef unsigned u32x2 __attribute__((ext_vector_type(2)));
constexpr int CW_NX = 45056, CW_NX_STRIDE = 16, NX_EXCH_BYTE = 512 * 1024, NX_LDS = 131072;
struct EpiResNorm {
    float* X; const float* gate; const float* sa; const float* sb;
    int fuse;
    const float* ng; const float* nmod;
    bf16* H;
    unsigned char* ctlb; unsigned epoch; PG8_LAS unsigned char* lds;
    __device__ __forceinline__ void operator()(const f32x4 (&acc_)[2][2][4][2], const Unit& u, int wr, int wc, int fr, int fq) const {
        f32x4 (&acc)[2][2][4][2] = const_cast<f32x4 (&)[2][2][4][2]>(acc_);
        const int tid = threadIdx.x;
        const int row0 = u.pm * BM + wr * 64 + fr, col0 = u.pn * BM + wc * 32 + 4 * fq;
        const int cond = seqinfo(seq_of_token(u.pm * BM)).cond;
        const float* S = sa ? (u.pm * BM < NC ? sa : sb - (size_t)NC * D) : X;
        { const float* gp = gate + (size_t)cond * 6 * D + col0;
          f32x4 gv[2][2];
#pragma unroll
          for (int bj = 0; bj < 2; ++bj)
#pragma unroll
              for (int n = 0; n < 2; ++n) gv[bj][n] = *(const f32x4*)(gp + bj * HALF + n * 16);
#pragma unroll
          for (int ai = 0; ai < 2; ++ai)
#pragma unroll
              for (int mp = 0; mp < 4; mp += 2) { f32x4 xr[2][2][2];
#pragma unroll
                  for (int mm = 0; mm < 2; ++mm) { const float* srow = S + (size_t)(row0 + ai * HALF + (mp + mm) * 16) * D + col0;
#pragma unroll
                      for (int bj = 0; bj < 2; ++bj)
#pragma unroll
                          for (int n = 0; n < 2; ++n) xr[mm][bj][n] = *(const f32x4*)(srow + bj * HALF + n * 16); }
#pragma unroll
                  for (int mm = 0; mm < 2; ++mm) { const int m = mp + mm; float* rowp = X + (size_t)(row0 + ai * HALF + m * 16) * D + col0;
#pragma unroll
                      for (int bj = 0; bj < 2; ++bj)
#pragma unroll
                          for (int n = 0; n < 2; ++n) { const f32x4 xn = xr[mm][bj][n] + gv[bj][n] * acc[ai][bj][m][n]; acc[ai][bj][m][n] = xn;
                              if (!fuse || H) *(f32x4*)(rowp + bj * HALF + n * 16) = xn; } }
                  asm volatile("" ::: "memory"); } }
        if (!fuse) return;
        PG8_LAS float* red = (PG8_LAS float*)(lds + NX_LDS); PG8_LAS float* rsl = red + 1024;
#pragma unroll
        for (int ai = 0; ai < 2; ++ai)
#pragma unroll
            for (int m = 0; m < 4; ++m) { float sacc = 0.f;
#pragma unroll
                for (int bj = 0; bj < 2; ++bj)
#pragma unroll
                    for (int n = 0; n < 2; ++n) { const f32x4 v = acc[ai][bj][m][n]; sacc += (v[0] * v[0] + v[1] * v[1]) + (v[2] * v[2] + v[3] * v[3]); }
                sacc += __shfl_xor(sacc, 16); sacc += __shfl_xor(sacc, 32);
                if (fq == 0) red[(ai * HALF + wr * 64 + m * 16 + fr) * 4 + wc] = sacc; }
        __syncthreads();
        unsigned* flags = (unsigned*)ctlb + CW_NX; float* exch = (float*)(ctlb + NX_EXCH_BYTE);
        float mine = 0.f;
        if (tid < BM) { const f32x4 r4 = *(const PG8_LAS f32x4*)(red + tid * 4); mine = (r4[0] + r4[1]) + (r4[2] + r4[3]);
            float* gp = exch + ((size_t)(u.pm * 4 + u.pn) * BM + tid);
            asm volatile("global_store_dword %0, %1, off sc1" :: "v"(gp), "v"(mine) : "memory"); }
        asm volatile("s_waitcnt vmcnt(0)" ::: "memory");
        __syncthreads();
        if (tid == 0) {
            __hip_atomic_store(flags + (u.pm * 4 + u.pn) * CW_NX_STRIDE, epoch, __ATOMIC_RELAXED, __HIP_MEMORY_SCOPE_AGENT);
            unsigned* tmo = (unsigned*)ctlb + 4096 + 128;
#pragma unroll 1
            for (int q = 0; q < 4; ++q) { if (q == u.pn) continue; unsigned sp = 0;
                while (__hip_atomic_load(flags + (u.pm * 4 + q) * CW_NX_STRIDE, __ATOMIC_RELAXED, __HIP_MEMORY_SCOPE_AGENT) < epoch) { __builtin_amdgcn_s_sleep(1);
                    if ((++sp & 255u) == 0u) { if (__hip_atomic_load(tmo, __ATOMIC_RELAXED, __HIP_MEMORY_SCOPE_AGENT)) break; if (sp > (1u << 18)) { atomicAdd(tmo, 1u); break; } } } }
            __builtin_amdgcn_fence(__ATOMIC_ACQUIRE, "agent");
        }
        asm volatile("s_waitcnt vmcnt(0)" ::: "memory");
        __syncthreads();
        if (tid < BM) { float tot = mine;
#pragma unroll
            for (int q = 0; q < 4; ++q) if (q != u.pn) tot += exch[(size_t)(u.pm * 4 + q) * BM + tid];
            rsl[tid] = 1.0f / sqrtf(tot * (1.0f / D) + 1e-6f); }
        __syncthreads();
        f32x4 g4[2][2], sc4[2][2], sh4[2][2];
#pragma unroll
        for (int bj = 0; bj < 2; ++bj)
#pragma unroll
            for (int n = 0; n < 2; ++n) { const int c = col0 + bj * HALF + n * 16; g4[bj][n] = *(const f32x4*)(ng + c);
                if (nmod) { sh4[bj][n] = *(const f32x4*)(nmod + (size_t)cond * 6 * D + c); sc4[bj][n] = *(const f32x4*)(nmod + (size_t)cond * 6 * D + D + c) + 1.0f; g4[bj][n] = g4[bj][n] * sc4[bj][n]; }
                else sh4[bj][n] = (f32x4){0.f, 0.f, 0.f, 0.f}; }
#pragma unroll
        for (int ai = 0; ai < 2; ++ai)
#pragma unroll
            for (int m = 0; m < 4; ++m) { const int rl = ai * HALF + wr * 64 + m * 16 + fr; const float r = rsl[rl]; const size_t ro = (size_t)(u.pm * BM + rl) * D + col0;
#pragma unroll
                for (int bj = 0; bj < 2; ++bj)
#pragma unroll
                    for (int n = 0; n < 2; ++n) { const f32x4 y = acc[ai][bj][m][n] * r * g4[bj][n] + sh4[bj][n];
                        if (H) { u32x2 pk; pk.x = cvt_pk_bf16(y[0], y[1]); pk.y = cvt_pk_bf16(y[2], y[3]); *(u32x2*)(H + ro + bj * HALF + n * 16) = pk; }
                        else *(f32x4*)(X + ro + bj * HALF + n * 16) = y; } }
    }
};
struct EpiF1 {
    bf16* Hd;
    __device__ __forceinline__ void operator()(const f32x4 (&acc)[2][2][4][2], const Unit& u, int wr, int wc, int fr, int fq) const {
        const int row0 = u.pm * BM + wr * 64 + fr, col0 = u.pn * HALF + wc * 32 + 8 * fq;
#pragma unroll
        for (int ai = 0; ai < 2; ++ai)
#pragma unroll
            for (int m = 0; m < 4; ++m) { bf16* rowp = Hd + (size_t)(row0 + ai * HALF + m * 16) * FF + col0;
                float o[8];
#pragma unroll
                for (int n = 0; n < 2; ++n)
#pragma unroll
                    for (int e = 0; e < 4; ++e) { const float a = acc[ai][0][m][n][e], b = acc[ai][1][m][n][e]; o[n * 4 + e] = a * fsigmoid(a) * b; }
                u32x4 w; w.x = cvt_pk_bf16(o[0], o[1]); w.y = cvt_pk_bf16(o[2], o[3]); w.z = cvt_pk_bf16(o[4], o[5]); w.w = cvt_pk_bf16(o[6], o[7]);
                *(u32x4*)rowp = w; }
    }
};

template <class Epi, class Sched, bool ALIGN_EPI = true, bool SP2 = true>
__device__ __forceinline__ void gemm_phase(PG8_LAS unsigned char* lds, const Gemm g, const Sched& S, const Epi& E) {
    const int tid = threadIdx.x, wid = __builtin_amdgcn_readfirstlane(tid >> 6), lane = tid & 63, wr = wid >> 2, wc = wid & 3, fr = lane & 15, fq = lane >> 4;
    const int K = g.K, nt = K / BK;
    unsigned voffA[2], voffB[2];
#pragma unroll
    for (int i = 0; i < 2; ++i) { int R, C; stage_rc(tid * 16 + i * 8192, R, C);
        voffA[i] = (unsigned)(R * g.lda + C) * 2u; voffB[i] = (unsigned)(R * K + C) * 2u; }
    const size_t kstep = (size_t)(BK * 2);
    const size_t hstepA = (size_t)HALF * g.lda * 2, hstepB = (size_t)HALF * K * 2;
    const size_t tstepA = 2 * hstepA, tstepB = 2 * hstepB;
    const unsigned ldsw = (unsigned)wid * 1024u;
    const int aoff = lds_byte(wr * 64 + fr, fq * 8), boff = lds_byte(wc * 32 + fr, fq * 8);
#define PG8_SA(b, h) (((b) * 2 + (h)) * HTB)
#define PG8_SB(b, h) ((4 + (b) * 2 + (h)) * HTB)
#define PG8_STAGE(bufoff, gbase, voff) do { _Pragma("unroll") for (int _i = 0; _i < 2; ++_i) \
        __builtin_amdgcn_global_load_lds((const unsigned*)((const char*)(gbase) + (voff)[_i]), (PG8_LAS unsigned*)(lds + (bufoff) + ldsw + _i * 8192), 16, 0, 0); } while (0)
#define PG8_LDA(dst, b, h) do { _Pragma("unroll") for (int m = 0; m < 4; ++m) _Pragma("unroll") for (int k = 0; k < 2; ++k) dst[m][k] = *(const PG8_LAS bf16x8*)(lds + PG8_SA(b, h) + aoff + m * 2048 + k * 1024); } while (0)
#define PG8_LDB(dst, b, h) do { _Pragma("unroll") for (int n = 0; n < 2; ++n) _Pragma("unroll") for (int k = 0; k < 2; ++k) dst[n][k] = *(const PG8_LAS bf16x8*)(lds + PG8_SB(b, h) + boff + n * 2048 + k * 1024); } while (0)
#define PG8_MMA(ai, bj, At, Bt) do { __builtin_amdgcn_s_setprio(1); _Pragma("unroll") for (int m = 0; m < 4; ++m) _Pragma("unroll") for (int n = 0; n < 2; ++n) _Pragma("unroll") for (int k = 0; k < 2; ++k) \
        acc[ai][bj][m][n] = __builtin_amdgcn_mfma_f32_16x16x32_bf16(Bt[n][k], At[m][k], acc[ai][bj][m][n], 0, 0, 0); __builtin_amdgcn_s_setprio(0); } while (0)
#define PG8_WAIT_V(n) asm volatile("s_waitcnt vmcnt(" #n ")" ::: "memory")
#define PG8_WAIT_L(n) asm volatile("s_waitcnt lgkmcnt(" #n ")" ::: "memory")
#define PG8_BAR __builtin_amdgcn_s_barrier()
#define PG8_SCHED __builtin_amdgcn_sched_barrier(0)
    Unit cur, nxt; int ui = 0;
    if (!S.next(0, cur)) return;
    f32x4 acc[2][2][4][2];
#pragma unroll
    for (int a = 0; a < 2; ++a)
#pragma unroll
        for (int b = 0; b < 2; ++b)
#pragma unroll
            for (int m = 0; m < 4; ++m)
#pragma unroll
                for (int n = 0; n < 2; ++n) acc[a][b][m][n] = (f32x4){0.f, 0.f, 0.f, 0.f};
    bf16x8 At[4][2], B0[2][2], B1[2][2];
    const char* cA = (const char*)g.A + (size_t)cur.pm * tstepA + (size_t)cur.aoff * 2; const char* cB = (const char*)g.Bt + (size_t)cur.pn * tstepB;
    if constexpr (SP2) {
        PG8_STAGE(PG8_SB(0, 0), cB, voffB); PG8_STAGE(PG8_SB(0, 1), cB + hstepB, voffB); PG8_STAGE(PG8_SA(0, 0), cA, voffA); PG8_STAGE(PG8_SA(0, 1), cA + hstepA, voffA);
        if (wr == 1) PG8_BAR;
        PG8_WAIT_V(2); PG8_BAR;
        PG8_STAGE(PG8_SB(1, 0), cB + kstep, voffB); PG8_STAGE(PG8_SA(1, 0), cA + kstep, voffA); PG8_STAGE(PG8_SB(1, 1), cB + hstepB + kstep, voffB);
        PG8_WAIT_V(6); PG8_BAR;
    } else {
        PG8_STAGE(PG8_SB(0, 0), cB, voffB); PG8_STAGE(PG8_SA(0, 0), cA, voffA); PG8_STAGE(PG8_SB(0, 1), cB + hstepB, voffB); PG8_STAGE(PG8_SA(0, 1), cA + hstepA, voffA);
        if (wr == 1) PG8_BAR;
        PG8_WAIT_V(4); PG8_BAR;
        PG8_STAGE(PG8_SB(1, 0), cB + kstep, voffB); PG8_STAGE(PG8_SA(1, 0), cA + kstep, voffA); PG8_STAGE(PG8_SB(1, 1), cB + hstepB + kstep, voffB);
        PG8_WAIT_V(6); PG8_BAR;
    }
    for (;;) {
        const bool has_next = S.next(ui + 1, nxt);
        const char* nA = has_next ? (const char*)g.A + (size_t)nxt.pm * tstepA + (size_t)nxt.aoff * 2 : cA; const char* nB = has_next ? (const char*)g.Bt + (size_t)nxt.pn * tstepB : cB;
        for (int t = 0; t < nt; t += 2) {
            const bool last = (t == nt - 2);
            const char* a1 = cA + (size_t)(t + 1) * kstep;
            const char* a2 = last ? nA : cA + (size_t)(t + 2) * kstep; const char* b2 = last ? nB : cB + (size_t)(t + 2) * kstep;
            const char* a3 = a2 + kstep; const char* b3 = b2 + kstep;
            if constexpr (SP2) {
            PG8_LDB(B0, 0, 0); PG8_LDB(B1, 0, 1); PG8_SCHED; PG8_LDA(At, 0, 0); PG8_STAGE(PG8_SA(1, 1), a1 + hstepA, voffA);
            PG8_WAIT_V(8); PG8_WAIT_L(0); PG8_BAR; PG8_MMA(0, 0, At, B0); PG8_MMA(0, 1, At, B1); PG8_BAR; PG8_SCHED;
            PG8_LDA(At, 0, 1); PG8_STAGE(PG8_SB(0, 0), b2, voffB); PG8_STAGE(PG8_SB(0, 1), b2 + hstepB, voffB); PG8_STAGE(PG8_SA(0, 0), a2, voffA);
            PG8_WAIT_V(8); PG8_WAIT_L(0); PG8_BAR; PG8_MMA(1, 0, At, B0); PG8_MMA(1, 1, At, B1); PG8_BAR; PG8_SCHED;
            PG8_LDB(B0, 1, 0); PG8_LDB(B1, 1, 1); PG8_SCHED; PG8_LDA(At, 1, 0); PG8_STAGE(PG8_SA(0, 1), a2 + hstepA, voffA);
            PG8_WAIT_V(8); PG8_WAIT_L(0); PG8_BAR; PG8_MMA(0, 0, At, B0); PG8_MMA(0, 1, At, B1); PG8_BAR; PG8_SCHED;
            PG8_LDA(At, 1, 1); PG8_STAGE(PG8_SB(1, 0), b3, voffB); PG8_STAGE(PG8_SB(1, 1), b3 + hstepB, voffB); PG8_STAGE(PG8_SA(1, 0), a3, voffA);
            PG8_WAIT_V(8); PG8_WAIT_L(0); PG8_BAR; PG8_MMA(1, 0, At, B0); PG8_MMA(1, 1, At, B1); PG8_BAR; PG8_SCHED;
            } else {
            PG8_LDB(B0, 0, 0); PG8_SCHED; PG8_LDA(At, 0, 0); PG8_STAGE(PG8_SA(1, 1), a1 + hstepA, voffA);
            PG8_WAIT_L(8); PG8_BAR; PG8_WAIT_L(0); PG8_MMA(0, 0, At, B0); PG8_BAR; PG8_SCHED;
            PG8_LDB(B1, 0, 1); PG8_STAGE(PG8_SB(0, 0), b2, voffB);
            PG8_BAR; PG8_WAIT_L(0); PG8_MMA(0, 1, At, B1); PG8_BAR;
            PG8_LDA(At, 0, 1); PG8_STAGE(PG8_SA(0, 0), a2, voffA);
            PG8_BAR; PG8_WAIT_L(0); PG8_MMA(1, 0, At, B0); PG8_BAR; PG8_SCHED;
            PG8_STAGE(PG8_SB(0, 1), b2 + hstepB, voffB);
            PG8_WAIT_V(6); PG8_BAR; PG8_MMA(1, 1, At, B1); PG8_BAR;
            PG8_LDB(B0, 1, 0); PG8_SCHED; PG8_LDA(At, 1, 0); PG8_STAGE(PG8_SA(0, 1), a2 + hstepA, voffA);
            PG8_WAIT_L(8); PG8_BAR; PG8_WAIT_L(0); PG8_MMA(0, 0, At, B0); PG8_BAR; PG8_SCHED;
            PG8_LDB(B1, 1, 1); PG8_STAGE(PG8_SB(1, 0), b3, voffB);
            PG8_BAR; PG8_WAIT_L(0); PG8_MMA(0, 1, At, B1); PG8_BAR;
            PG8_LDA(At, 1, 1); PG8_STAGE(PG8_SA(1, 0), a3, voffA);
            PG8_BAR; PG8_WAIT_L(0); PG8_MMA(1, 0, At, B0); PG8_BAR; PG8_SCHED;
            PG8_STAGE(PG8_SB(1, 1), b3 + hstepB, voffB);
            PG8_WAIT_V(6); PG8_BAR; PG8_MMA(1, 1, At, B1); PG8_BAR;
            }
        }
        if constexpr (ALIGN_EPI) { if (wr == 0) PG8_BAR; }
        E(acc, cur, wr, wc, fr, fq);
        if (!has_next) break;
#pragma unroll
        for (int a = 0; a < 2; ++a)
#pragma unroll
            for (int b = 0; b < 2; ++b)
#pragma unroll
                for (int m = 0; m < 4; ++m)
#pragma unroll
                    for (int n = 0; n < 2; ++n) acc[a][b][m][n] = (f32x4){0.f, 0.f, 0.f, 0.f};
        cur = nxt; cA = nA; cB = nB; ++ui;
        if constexpr (ALIGN_EPI) { if (wr == 1) PG8_BAR; }
    }
    PG8_WAIT_V(0);
    if constexpr (!ALIGN_EPI) { if (wr == 0) PG8_BAR; }
    PG8_BAR;
#undef PG8_SA
#undef PG8_SB
#undef PG8_STAGE
#undef PG8_LDA
#undef PG8_LDB
#undef PG8_MMA
#undef PG8_WAIT_V
#undef PG8_WAIT_L
#undef PG8_BAR
#undef PG8_SCHED
}
}


#define LDS_BARRIER() do { asm volatile("s_waitcnt lgkmcnt(0)" ::: "memory"); __builtin_amdgcn_s_barrier(); asm volatile("" ::: "memory"); } while (0)
namespace ml {
#define LAS __attribute__((address_space(3)))
typedef short bf16x8 __attribute__((ext_vector_type(8)));
typedef float f32x4 __attribute__((ext_vector_type(4)));
typedef unsigned u32x4 __attribute__((ext_vector_type(4)));
constexpr int NVB = 4, EV = MD / NVB;
constexpr int PQ = 272, PT = 144;
constexpr int L_QS = 0, L_KS = L_QS + 64 * PQ, L_KT = L_KS + 64 * PQ, L_VT = L_KT + 128 * PT, L_SB = L_VT + 48 * PT, L_CT = L_SB + 64 * PT,
              L_HS = L_CT + 48 * PQ, L_SC = L_HS + 64 * 80, L_END = L_SC + 4096;
static_assert(L_END <= 131072, "mLSTM LDS map");
enum { SC_A = 0, SC_PM = 64, SC_WI = 128, SC_EMT = 192, SC_WE = 256, SC_DEN = 320, SC_MISC = 384 };
__device__ __forceinline__ f32x4 mma(bf16x8 a, bf16x8 b, f32x4 c) { return __builtin_amdgcn_mfma_f32_16x16x32_bf16(a, b, c, 0, 0, 0); }
__device__ __forceinline__ bf16x8 frag(LAS unsigned char* lds, int base, int pitch, int row0, int k0, int lane) {
    return *(const LAS bf16x8*)(lds + base + (row0 + (lane & 15)) * pitch + (k0 + 8 * (lane >> 4)) * 2);
}
template <int N> __device__ __forceinline__ float dpp_row_shr(float x, float ident) {
    return __builtin_bit_cast(float, __builtin_amdgcn_update_dpp(__builtin_bit_cast(int, ident), __builtin_bit_cast(int, x), 0x110 + N, 0xf, 0xf, false));
}
__device__ __forceinline__ float lane_get(float x, int l) { return __builtin_bit_cast(float, __builtin_amdgcn_readlane(__builtin_bit_cast(int, x), l)); }
__device__ __forceinline__ float wave_scan_add(float x, int lane) {
    x += dpp_row_shr<1>(x, 0.f); x += dpp_row_shr<2>(x, 0.f); x += dpp_row_shr<4>(x, 0.f); x += dpp_row_shr<8>(x, 0.f);
    const float t0 = lane_get(x, 15), t1 = lane_get(x, 31), t2 = lane_get(x, 47); const int row = lane >> 4;
    return x + ((row >= 1 ? t0 : 0.f) + (row >= 2 ? t1 : 0.f) + (row >= 3 ? t2 : 0.f));
}
__device__ __forceinline__ float wave_scan_max(float x, int lane) {
    constexpr float NI = -3.0e38f;
    x = fmaxf(x, dpp_row_shr<1>(x, NI)); x = fmaxf(x, dpp_row_shr<2>(x, NI)); x = fmaxf(x, dpp_row_shr<4>(x, NI)); x = fmaxf(x, dpp_row_shr<8>(x, NI));
    const float t0 = lane_get(x, 15), t1 = lane_get(x, 31), t2 = lane_get(x, 47); const int row = lane >> 4;
    return fmaxf(fmaxf(x, row >= 1 ? t0 : NI), fmaxf(row >= 2 ? t1 : NI, row >= 3 ? t2 : NI));
}
__device__ __forceinline__ void mlstm_item(LAS unsigned char* lds, CParams& P, int l, int s, int head, int dir, int vb) {
    const int tid = threadIdx.x, w = __builtin_amdgcn_readfirstlane(tid >> 6), lane = tid & 63, fr = lane & 15, fq = lane >> 4;
    const int rt = w & 3, half = w >> 2;
    const SeqInfo q = seqinfo(s); const int nchunk = q.T / 64;
    const bf16* QK = WSP(bf16, WS_QKC); bf16* U = WSP(bf16, WS_U1);
    LAS float* SC = (LAS float*)(lds + L_SC);
    f32x4 cacc[3];
    float m_prev;
    if (!q.grid) { cacc[0] = cacc[1] = cacc[2] = (f32x4){0.f, 0.f, 0.f, 0.f}; m_prev = 0.f; }
    else {
        const size_t sb = (((size_t)q.b * DEPTH + l) * 2 + dir) * MH + head; const int d = 16 * w + fr;
#pragma unroll
        for (int et = 0; et < 2; ++et)
#pragma unroll
            for (int r = 0; r < 4; ++r) cacc[et][r] = P.in[ST_C][(sb * 128 + d) * 128 + vb * EV + 16 * et + 4 * fq + r];
        cacc[2] = (f32x4){0.f, 0.f, 0.f, 0.f}; if (fq == 0) cacc[2][0] = P.in[ST_N][sb * 128 + d];
        m_prev = P.in[ST_M][sb];
    }
    const float bi = P.in[M_GATE_B][(size_t)l * 4 * MH + (2 * dir) * MH + head], bfg = P.in[M_GATE_B][(size_t)l * 4 * MH + (2 * dir + 1) * MH + head];
    for (int i = tid; i < 16 * 64; i += 512) { const int r = i >> 6, c = i & 63; *(LAS bf16*)(lds + L_VT + (32 + r) * PT + c * 2) = (r == 0) ? (bf16)0x3f80 : (bf16)0; }
    u32x4 pqk[4]; u32x4 pv; bf16 pgi = 0, pgf = 0;
#define ML_TOK(c, j) ((size_t)(q.base + (dir ? q.T - 1 - ((c) * 64 + (j)) : ((c) * 64 + (j)))))
#define ML_PREFETCH(c) do { _Pragma("unroll") for (int i = 0; i < 4; ++i) { const int id = tid + 512 * i, j = id >> 5, pc = id & 31; \
            pqk[i] = *(const u32x4*)(QK + ML_TOK(c, j) * (2 * MW) + (pc < 16 ? head * 128 + 8 * pc : MW + head * 128 + 8 * (pc - 16))); } \
        if (tid < 256) { const int j = tid >> 2, pc = tid & 3; pv = *(const u32x4*)(U + ML_TOK(c, j) * PU + OFF_V + head * 128 + vb * EV + 8 * pc); } \
        if (w == 0) { const bf16* g = U + ML_TOK(c, lane) * PU + OFF_G; pgi = g[(2 * dir) * MH + head]; pgf = g[(2 * dir + 1) * MH + head]; } } while (0)
    ML_PREFETCH(0);
    for (int c = 0; c < nchunk; ++c) {
#pragma unroll
        for (int i = 0; i < 4; ++i) { const int id = tid + 512 * i, j = id >> 5, pc = id & 31;
            *(LAS u32x4*)(lds + (pc < 16 ? L_QS : L_KS) + j * PQ + (pc & 15) * 16) = pqk[i]; }
        if (tid < 256) { const int j = tid >> 2, pc = tid & 3; const unsigned wv[4] = {pv.x, pv.y, pv.z, pv.w};
#pragma unroll
            for (int e = 0; e < 8; ++e) *(LAS bf16*)(lds + L_VT + (8 * pc + e) * PT + j * 2) = (bf16)((wv[e >> 1] >> ((e & 1) * 16)) & 0xffffu); }
#pragma unroll
        for (int et = 0; et < 3; ++et)
#pragma unroll
            for (int r = 0; r < 4; ++r) *(LAS bf16*)(lds + L_CT + (16 * et + 4 * fq + r) * PQ + (16 * w + fr) * 2) = f2bf(cacc[et][r]);
        float wie = 1.f;
        if (w == 0) {
            const float gi = bf2f(pgi) + bi, gf = bf2f(pgf) + bfg;
            const float lf = fminf(gf, 0.f) - log1pf(__expf(-fabsf(gf)));
            const float b = wave_scan_add(lf, lane);
            const float a = gi - b; float pm = wave_scan_max(a, lane);
            pm = fmaxf(pm, m_prev);
            const float pm63 = lane_get(pm, 63), b63 = lane_get(b, 63);
            SC[SC_A + lane] = a; SC[SC_PM + lane] = pm; SC[SC_WI + lane] = __expf(m_prev - pm); SC[SC_EMT + lane] = __expf(-(b + pm)); SC[SC_WE + lane] = __expf(a - pm63);
            if (lane == 0) { SC[SC_MISC] = __expf(m_prev - pm63); SC[SC_MISC + 1] = b63 + pm63; }
        }
        LDS_BARRIER();
        if (c + 1 < nchunk) ML_PREFETCH(c + 1);
        wie = SC[SC_MISC]; m_prev = SC[SC_MISC + 1];
#pragma unroll
        for (int i = 0; i < 2; ++i) { const int id = tid + 512 * i, j = id & 63, pc = id >> 6; const float we = SC[SC_WE + j];
            const u32x4 kv = *(const LAS u32x4*)(lds + L_KS + j * PQ + pc * 16); const unsigned wv[4] = {kv.x, kv.y, kv.z, kv.w};
#pragma unroll
            for (int e = 0; e < 8; ++e) { const float kf = __builtin_bit_cast(float, (e & 1) ? (wv[e >> 1] & 0xffff0000u) : (wv[e >> 1] << 16));
                *(LAS bf16*)(lds + L_KT + (8 * pc + e) * PT + j * 2) = f2bf(kf * we); } }
#pragma unroll
        for (int cc = 0; cc < 2; ++cc) { const int ct = 2 * half + cc;
            f32x4 acc = (f32x4){0.f, 0.f, 0.f, 0.f};
            if (ct <= rt) {
#pragma unroll
                for (int k = 0; k < 4; ++k) acc = mma(frag(lds, L_QS, PQ, 16 * rt, 32 * k, lane), frag(lds, L_KS, PQ, 16 * ct, 32 * k, lane), acc);
            }
            const int sp = 16 * ct + fr; const float as = SC[SC_A + sp];
#pragma unroll
            for (int r = 0; r < 4; ++r) { const int t = 16 * rt + 4 * fq + r; const float v = (sp <= t) ? acc[r] * __expf(as - SC[SC_PM + t]) : 0.f;
                *(LAS bf16*)(lds + L_SB + t * PT + sp * 2) = f2bf(v); } }
        LDS_BARRIER();
        f32x4 nacc[2]; const int nct = half ? 1 : 2;
#pragma unroll
        for (int cc = 0; cc < 2; ++cc) { if (cc < nct) { const int ct = half ? 2 : cc;
            f32x4 a1 = (f32x4){0.f, 0.f, 0.f, 0.f}, a2 = (f32x4){0.f, 0.f, 0.f, 0.f};
#pragma unroll
            for (int k = 0; k < 2; ++k) a1 = mma(frag(lds, L_SB, PT, 16 * rt, 32 * k, lane), frag(lds, L_VT, PT, 16 * ct, 32 * k, lane), a1);
#pragma unroll
            for (int k = 0; k < 4; ++k) a2 = mma(frag(lds, L_QS, PQ, 16 * rt, 32 * k, lane), frag(lds, L_CT, PQ, 16 * ct, 32 * k, lane), a2);
#pragma unroll
            for (int r = 0; r < 4; ++r) a1[r] += SC[SC_WI + 16 * rt + 4 * fq + r] * a2[r];
            nacc[cc] = a1; } }
        if (half && fr == 0) {
#pragma unroll
            for (int r = 0; r < 4; ++r) SC[SC_DEN + 16 * rt + 4 * fq + r] = nacc[0][r];
        }
#pragma unroll
        for (int et = 0; et < 3; ++et) { cacc[et] = cacc[et] * wie;
#pragma unroll
            for (int k = 0; k < 2; ++k) cacc[et] = mma(frag(lds, L_VT, PT, 16 * et, 32 * k, lane), frag(lds, L_KT, PT, 16 * w, 32 * k, lane), cacc[et]); }
        LDS_BARRIER();
        if (!half) {
#pragma unroll
            for (int cc = 0; cc < 2; ++cc)
#pragma unroll
                for (int r = 0; r < 4; ++r) { const int t = 16 * rt + 4 * fq + r; const float den = fmaxf(fabsf(SC[SC_DEN + t]), SC[SC_EMT + t]);
                    *(LAS bf16*)(lds + L_HS + t * 80 + (16 * cc + fr) * 2) = f2bf(nacc[cc][r] * __builtin_amdgcn_rcpf(den)); }
        }
        LDS_BARRIER();
        if (tid < 256) { const int j = tid >> 2, pc = tid & 3;
            *(u32x4*)(U + ML_TOK(c, j) * PU + dir * MW + head * 128 + vb * EV + 8 * pc) = *(const LAS u32x4*)(lds + L_HS + j * 80 + pc * 16); }
    }
    if (!q.grid) {
        const size_t sb = (((size_t)q.b * DEPTH + l) * 2 + dir) * MH + head; const int d = 16 * w + fr;
#pragma unroll
        for (int et = 0; et < 2; ++et)
#pragma unroll
            for (int r = 0; r < 4; ++r) P.out[OUT_C + (sb * 128 + d) * 128 + vb * EV + 16 * et + 4 * fq + r] = cacc[et][r];
        if (vb == 0) { if (fq == 0) P.out[OUT_N + sb * 128 + d] = cacc[2][0]; if (tid == 0) P.out[OUT_M + sb] = m_prev; }
    }
    LDS_BARRIER();
#undef ML_TOK
#undef ML_PREFETCH
}
constexpr int M_QS = 0, M_KS = M_QS + 2 * 64 * PQ, M_KT = M_KS + 64 * PQ, M_VT = M_KT + 128 * PT, M_SB = M_VT + 2 * 48 * PT, M_CT = M_SB + 64 * PT, M_HS = M_CT + 48 * PQ, M_SC = M_HS + 64 * 80, M_END = M_SC + 2 * 4096;
static_assert(M_END <= 131072, "pipelined mLSTM LDS map");
__device__ __forceinline__ void mlstm_item2(LAS unsigned char* lds, CParams& P, int l, int s, int head, int dir, int vb) {
    const int tid = threadIdx.x, w = __builtin_amdgcn_readfirstlane(tid >> 6), lane = tid & 63, fr = lane & 15, fq = lane >> 4;
    const int rt = w & 3, half = w >> 2;
    const SeqInfo q = seqinfo(s); const int nchunk = q.T / 64;
    const bf16* QK = WSP(bf16, WS_QKC); bf16* U = WSP(bf16, WS_U1);
    f32x4 cacc[3];
    float m_prev;
    const size_t sb = (((size_t)q.b * DEPTH + l) * 2 + dir) * MH + head;
    if (!q.grid) { cacc[0] = cacc[1] = cacc[2] = (f32x4){0.f, 0.f, 0.f, 0.f}; m_prev = 0.f; }
    else {
        const int d = 16 * w + fr;
#pragma unroll
        for (int et = 0; et < 2; ++et)
#pragma unroll
            for (int r = 0; r < 4; ++r) cacc[et][r] = P.in[ST_C][(sb * 128 + d) * 128 + vb * EV + 16 * et + 4 * fq + r];
        cacc[2] = (f32x4){0.f, 0.f, 0.f, 0.f}; if (fq == 0) cacc[2][0] = P.in[ST_N][sb * 128 + d];
        m_prev = P.in[ST_M][sb];
    }
    const float bi = P.in[M_GATE_B][(size_t)l * 4 * MH + (2 * dir) * MH + head], bfg = P.in[M_GATE_B][(size_t)l * 4 * MH + (2 * dir + 1) * MH + head];
    for (int i = tid; i < 2 * 16 * 64; i += 512) { const int b = i >> 10, r = (i >> 6) & 15, c = i & 63; *(LAS bf16*)(lds + M_VT + b * 48 * PT + (32 + r) * PT + c * 2) = (r == 0) ? (bf16)0x3f80 : (bf16)0; }
    u32x4 pqk[4]; u32x4 pv; bf16 pgi = 0, pgf = 0;
#define ML_TOK(c, j) ((size_t)(q.base + (dir ? q.T - 1 - ((c) * 64 + (j)) : ((c) * 64 + (j)))))
#define ML_PREFETCH(c) do { _Pragma("unroll") for (int i = 0; i < 4; ++i) { const int id = tid + 512 * i, j = id >> 5, pc = id & 31; \
            pqk[i] = *(const u32x4*)(QK + ML_TOK(c, j) * (2 * MW) + (pc < 16 ? head * 128 + 8 * pc : MW + head * 128 + 8 * (pc - 16))); } \
        if (tid < 256) { const int j = tid >> 2, pc = tid & 3; pv = *(const u32x4*)(U + ML_TOK(c, j) * PU + OFF_V + head * 128 + vb * EV + 8 * pc); } \
        if (w == 4) { const bf16* g = U + ML_TOK(c, lane) * PU + OFF_G; pgi = g[(2 * dir) * MH + head]; pgf = g[(2 * dir + 1) * MH + head]; } } while (0)
#define ML_STAGE_A(pb) do { \
        _Pragma("unroll") for (int i = 0; i < 4; ++i) { const int id = tid + 512 * i, j = id >> 5, pc = id & 31; \
            *(LAS u32x4*)(lds + (pc < 16 ? M_QS + (pb) * 64 * PQ : M_KS) + j * PQ + (pc & 15) * 16) = pqk[i]; } \
        if (tid < 256) { const int j = tid >> 2, pc = tid & 3; const unsigned wv[4] = {pv.x, pv.y, pv.z, pv.w}; \
            _Pragma("unroll") for (int e = 0; e < 8; ++e) *(LAS bf16*)(lds + M_VT + (pb) * 48 * PT + (8 * pc + e) * PT + j * 2) = (bf16)((wv[e >> 1] >> ((e & 1) * 16)) & 0xffffu); } \
        if (w == 4) { LAS float* SCn = (LAS float*)(lds + M_SC + (pb) * 4096); \
            const float gi = bf2f(pgi) + bi, gf = bf2f(pgf) + bfg; \
            const float lf = fminf(gf, 0.f) - log1pf(__expf(-fabsf(gf))); \
            const float b = wave_scan_add(lf, lane); \
            const float a = gi - b; float pm = wave_scan_max(a, lane); \
            pm = fmaxf(pm, m_prev); \
            const float pm63 = lane_get(pm, 63), b63 = lane_get(b, 63); \
            SCn[SC_A + lane] = a; SCn[SC_PM + lane] = pm; SCn[SC_WI + lane] = __expf(m_prev - pm); SCn[SC_EMT + lane] = __expf(-(b + pm)); SCn[SC_WE + lane] = __expf(a - pm63); \
            if (lane == 0) SCn[SC_MISC] = __expf(m_prev - pm63); \
            m_prev = b63 + pm63; } } while (0)
#define ML_STAGE_D(pb) do { const LAS float* SCn = (const LAS float*)(lds + M_SC + (pb) * 4096); \
        _Pragma("unroll") for (int i = 0; i < 2; ++i) { const int id = tid + 512 * i, j = id & 63, pc = id >> 6; const float we = SCn[SC_WE + j]; \
            const u32x4 kv = *(const LAS u32x4*)(lds + M_KS + j * PQ + pc * 16); const unsigned wv[4] = {kv.x, kv.y, kv.z, kv.w}; \
            _Pragma("unroll") for (int e = 0; e < 8; ++e) { const float kf = __builtin_bit_cast(float, (e & 1) ? (wv[e >> 1] & 0xffff0000u) : (wv[e >> 1] << 16)); \
                *(LAS bf16*)(lds + M_KT + (8 * pc + e) * PT + j * 2) = f2bf(kf * we); } } \
        _Pragma("unroll") for (int cc = 0; cc < 2; ++cc) { const int ct = 2 * half + cc; \
            f32x4 acc = (f32x4){0.f, 0.f, 0.f, 0.f}; \
            if (ct <= rt) { \
                _Pragma("unroll") for (int k = 0; k < 4; ++k) acc = mma(frag(lds, M_QS + (pb) * 64 * PQ, PQ, 16 * rt, 32 * k, lane), frag(lds, M_KS, PQ, 16 * ct, 32 * k, lane), acc); } \
            const int sp = 16 * ct + fr; const float as = SCn[SC_A + sp]; \
            _Pragma("unroll") for (int r = 0; r < 4; ++r) { const int t = 16 * rt + 4 * fq + r; const float v = (sp <= t) ? acc[r] * __expf(as - SCn[SC_PM + t]) : 0.f; \
                *(LAS bf16*)(lds + M_SB + t * PT + sp * 2) = f2bf(v); } } \
        _Pragma("unroll") for (int et = 0; et < 3; ++et) \
            _Pragma("unroll") for (int r = 0; r < 4; ++r) *(LAS bf16*)(lds + M_CT + (16 * et + 4 * fq + r) * PQ + (16 * w + fr) * 2) = f2bf(cacc[et][r]); } while (0)
#define ML_STORE(c) do { if (tid < 256) { const int j = tid >> 2, pc = tid & 3; \
            *(u32x4*)(U + ML_TOK(c, j) * PU + dir * MW + head * 128 + vb * EV + 8 * pc) = *(const LAS u32x4*)(lds + M_HS + j * 80 + pc * 16); } } while (0)
    ML_PREFETCH(0);
    ML_STAGE_A(0);
    LDS_BARRIER();
    if (nchunk > 1) ML_PREFETCH(1);
    ML_STAGE_D(0);
    LDS_BARRIER();
    for (int c = 0; c < nchunk; ++c) {
        const int pb = c & 1;
        if (c + 1 < nchunk) { ML_STAGE_A(pb ^ 1); if (c + 2 < nchunk) ML_PREFETCH(c + 2); }
        if (c >= 1) ML_STORE(c - 1);
        LAS float* SC = (LAS float*)(lds + M_SC + pb * 4096);
        const float wie = SC[SC_MISC];
        f32x4 nacc[2]; const int nct = half ? 1 : 2;
#pragma unroll
        for (int cc = 0; cc < 2; ++cc) { if (cc < nct) { const int ct = half ? 2 : cc;
            f32x4 a1 = (f32x4){0.f, 0.f, 0.f, 0.f}, a2 = (f32x4){0.f, 0.f, 0.f, 0.f};
#pragma unroll
            for (int k = 0; k < 2; ++k) a1 = mma(frag(lds, M_SB, PT, 16 * rt, 32 * k, lane), frag(lds, M_VT + pb * 48 * PT, PT, 16 * ct, 32 * k, lane), a1);
#pragma unroll
            for (int k = 0; k < 4; ++k) a2 = mma(frag(lds, M_QS + pb * 64 * PQ, PQ, 16 * rt, 32 * k, lane), frag(lds, M_CT, PQ, 16 * ct, 32 * k, lane), a2);
#pragma unroll
            for (int r = 0; r < 4; ++r) a1[r] += SC[SC_WI + 16 * rt + 4 * fq + r] * a2[r];
            nacc[cc] = a1; } }
        if (half && fr == 0) {
#pragma unroll
            for (int r = 0; r < 4; ++r) SC[SC_DEN + 16 * rt + 4 * fq + r] = nacc[0][r];
        }
#pragma unroll
        for (int et = 0; et < 3; ++et) { cacc[et] = cacc[et] * wie;
#pragma unroll
            for (int k = 0; k < 2; ++k) cacc[et] = mma(frag(lds, M_VT + pb * 48 * PT, PT, 16 * et, 32 * k, lane), frag(lds, M_KT, PT, 16 * w, 32 * k, lane), cacc[et]); }
        LDS_BARRIER();
        if (!half) {
#pragma unroll
            for (int cc = 0; cc < 2; ++cc)
#pragma unroll
                for (int r = 0; r < 4; ++r) { const int t = 16 * rt + 4 * fq + r; const float den = fmaxf(fabsf(SC[SC_DEN + t]), SC[SC_EMT + t]);
                    *(LAS bf16*)(lds + M_HS + t * 80 + (16 * cc + fr) * 2) = f2bf(nacc[cc][r] * __builtin_amdgcn_rcpf(den)); }
        }
        if (c + 1 < nchunk) ML_STAGE_D(pb ^ 1);
        LDS_BARRIER();
    }
    ML_STORE(nchunk - 1);
    if (!q.grid) {
        const int d = 16 * w + fr;
#pragma unroll
        for (int et = 0; et < 2; ++et)
#pragma unroll
            for (int r = 0; r < 4; ++r) P.out[OUT_C + (sb * 128 + d) * 128 + vb * EV + 16 * et + 4 * fq + r] = cacc[et][r];
        if (vb == 0) { if (fq == 0) P.out[OUT_N + sb * 128 + d] = cacc[2][0]; if (tid == 256) P.out[OUT_M + sb] = m_prev; }
    }
    LDS_BARRIER();
#undef ML_TOK
#undef ML_PREFETCH
#undef ML_STAGE_A
#undef ML_STAGE_D
#undef ML_STORE
}
constexpr int N_ITEMS = NSEQ * MH * 2 * NVB;
__device__ __forceinline__ void decode_item(int it, int& s, int& head, int& dir, int& vb) {
    vb = it % NVB; int ch = it / NVB; dir = ch & 1; ch >>= 1; head = ch % MH; const int sq = ch / MH;
    s = sq < LB ? CB + sq : sq - LB;
}
}


namespace rw {
typedef short bf16x8 __attribute__((ext_vector_type(8)));
typedef float f32x4 __attribute__((ext_vector_type(4)));
typedef unsigned u32x4 __attribute__((ext_vector_type(4)));
enum { V_A = 0, V_W, V_B, V_K, V_R, NVEC };
constexpr int REC = NVEC * 64 * 4;
constexpr int PT = 144;
constexpr int L_SBUF = 0, L_VT = L_SBUF + 64 * REC, L_TW = L_VT + 64 * 256, L_AL = L_TW + 64 * PT, L_YS = L_AL + 64 * PT, L_INV = L_YS + 64 * 16 * 4, L_END = L_INV + 256;
__device__ __forceinline__ int vt_off(int row, int tt) { return row * 256 + ((tt ^ (((row >> 3) & 7) << 2)) << 2); }
static_assert(L_END <= 131072, "RWKV LDS map");
__device__ __forceinline__ float dpp_xor1(float x) { return __builtin_bit_cast(float, __builtin_amdgcn_update_dpp(0, __builtin_bit_cast(int, x), 0xB1, 0xF, 0xF, true)); }
__device__ __forceinline__ float dpp_xor2(float x) { return __builtin_bit_cast(float, __builtin_amdgcn_update_dpp(0, __builtin_bit_cast(int, x), 0x4E, 0xF, 0xF, true)); }
__device__ __forceinline__ float dpp_ror4(float x) { return __builtin_bit_cast(float, __builtin_amdgcn_update_dpp(0, __builtin_bit_cast(int, x), 0x124, 0xF, 0xF, true)); }
__device__ __forceinline__ float dpp_ror8(float x) { return __builtin_bit_cast(float, __builtin_amdgcn_update_dpp(0, __builtin_bit_cast(int, x), 0x128, 0xF, 0xF, true)); }
__device__ __forceinline__ float allsum16(float x) { x += dpp_xor1(x); x += dpp_xor2(x); x += dpp_ror4(x); x += dpp_ror8(x); return x; }
__device__ __forceinline__ f32x4 cvt_lo4(unsigned a, unsigned b) { return (f32x4){__builtin_bit_cast(float, a << 16), __builtin_bit_cast(float, a & 0xffff0000u), __builtin_bit_cast(float, b << 16), __builtin_bit_cast(float, b & 0xffff0000u)}; }
__device__ __forceinline__ float allsum32(float x) {
    x = allsum16(x);
    float xa = x, xb = x;
    asm volatile("v_mov_b32 %1, %0\n\ts_nop 1\n\tv_permlane32_swap_b32 %0, %1\n\ts_nop 1" : "+v"(xa), "=&v"(xb));
    return xa + xb;
}
__device__ __forceinline__ void rwkv_item(LAS unsigned char* lds, CParams& P, int l, int s, int head, int dir, int rh) {
    const int tid = threadIdx.x, w = __builtin_amdgcn_readfirstlane(tid >> 6), lane = tid & 63, fr = lane & 15, fq = lane >> 4;
    const int rt = w & 3, half = w >> 2, hc = head * 64;
    const SeqInfo q = seqinfo(s); const int nchunk = q.T / 64;
    const bf16* RX = WSP(bf16, WS_RXC); bf16* U = WSP(bf16, WS_U1);
    const int pj = tid >> 3, psub = tid & 7;
    const int hh = lane >> 5, rsel = (lane >> 4) & 1, cg = lane & 15;
    const int row = 16 * rh + 2 * w + rsel, col0 = 32 * hh + 2 * cg;
    typedef float f32x2 __attribute__((ext_vector_type(2)));
    f32x2 S2;
    if (!q.grid) S2 = (f32x2){0.f, 0.f};
    else { const size_t sb = (((size_t)q.b * DEPTH + l) * 2 + dir) * RH + head; S2 = *(const f32x2*)(P.in[ST_R] + (sb * 64 + row) * 64 + col0); }
    float rkk8[8];
#pragma unroll
    for (int e = 0; e < 8; ++e) rkk8[e] = P.in[R_KK][(size_t)l * RW + hc + 8 * psub + e];
    float c_w0[2], c_a0[2], c_kk[2], c_ka[2];
    bf16x8 bw[2][2], ba[2][2];
#pragma unroll
    for (int cc = 0; cc < 2; ++cc) { const int c = 16 * (2 * half + cc) + fr;
        c_w0[cc] = P.in[R_W0][((size_t)l * 2 + dir) * RW + hc + c]; c_a0[cc] = P.in[R_A0][((size_t)l * 2 + dir) * RW + hc + c];
        c_kk[cc] = P.in[R_KK][(size_t)l * RW + hc + c]; c_ka[cc] = P.in[R_KA][(size_t)l * RW + hc + c];
#pragma unroll
        for (int ks = 0; ks < 2; ++ks)
#pragma unroll
            for (int e = 0; e < 8; ++e) { const int j = 32 * ks + 8 * fq + e;
                bw[cc][ks][e] = (short)f2bf(P.in[R_W2][(((size_t)l * 2 + dir) * 64 + j) * RW + hc + c]);
                ba[cc][ks][e] = (short)f2bf(P.in[R_A2][(((size_t)l * 2 + dir) * 64 + j) * RW + hc + c]); } }
    u32x4 pf[5];
#define RW_TOK(c, j) ((size_t)(q.base + (dir ? q.T - 1 - ((c) * 64 + (j)) : ((c) * 64 + (j)))))
#define RW_PREFETCH(c) do { const bf16* rx = RX + RW_TOK(c, pj) * RIN + 8 * psub; \
        pf[0] = *(const u32x4*)(rx + RX_R + hc); pf[1] = *(const u32x4*)(rx + RX_K + hc); pf[2] = *(const u32x4*)(rx + RX_V + hc); \
        pf[3] = *(const u32x4*)(rx + RX_WL + dir * 64); pf[4] = *(const u32x4*)(rx + RX_AL + dir * 64); } while (0)
    RW_PREFETCH(0);
    for (int c = 0; c < nchunk; ++c) {
        { LAS unsigned char* rec = lds + L_SBUF + pj * REC + psub * 32;
          *(LAS f32x4*)(rec + V_R * 256) = cvt_lo4(pf[0].x, pf[0].y); *(LAS f32x4*)(rec + V_R * 256 + 16) = cvt_lo4(pf[0].z, pf[0].w);
          { const f32x4 v0 = cvt_lo4(pf[2].x, pf[2].y), v1 = cvt_lo4(pf[2].z, pf[2].w);
#pragma unroll
            for (int e = 0; e < 4; ++e) { *(LAS float*)(lds + L_VT + vt_off(8 * psub + e, pj)) = v0[e]; *(LAS float*)(lds + L_VT + vt_off(8 * psub + 4 + e, pj)) = v1[e]; } }
          const f32x4 k0 = cvt_lo4(pf[1].x, pf[1].y), k1 = cvt_lo4(pf[1].z, pf[1].w);
          *(LAS f32x4*)(rec + V_K * 256) = k0; *(LAS f32x4*)(rec + V_K * 256 + 16) = k1;
          float ss = 0.f;
#pragma unroll
          for (int e = 0; e < 4; ++e) { const float x0 = k0[e] * rkk8[e], x1 = k1[e] * rkk8[4 + e]; ss += x0 * x0 + x1 * x1; }
          ss += dpp_xor1(ss); ss += dpp_xor2(ss); ss += __shfl_xor(ss, 4);
          if (psub == 0) *(LAS float*)(lds + L_INV + pj * 4) = 1.0f / fmaxf(sqrtf(ss), 1e-12f);
          *(LAS u32x4*)(lds + L_TW + pj * PT + psub * 16) = pf[3]; *(LAS u32x4*)(lds + L_AL + pj * PT + psub * 16) = pf[4]; }
        __syncthreads();
        if (c + 1 < nchunk) RW_PREFETCH(c + 1);
#pragma unroll
        for (int cc = 0; cc < 2; ++cc) { const int ct = 2 * half + cc; const int cidx = 16 * ct + fr;
            f32x4 aw = (f32x4){0.f, 0.f, 0.f, 0.f}, aa = (f32x4){0.f, 0.f, 0.f, 0.f};
#pragma unroll
            for (int ks = 0; ks < 2; ++ks) { aw = ml::mma(ml::frag(lds, L_TW, PT, 16 * rt, 32 * ks, lane), bw[cc][ks], aw); aa = ml::mma(ml::frag(lds, L_AL, PT, 16 * rt, 32 * ks, lane), ba[cc][ks], aa); }
#pragma unroll
            for (int r = 0; r < 4; ++r) { const int tok = 16 * rt + 4 * fq + r; LAS float* rec = (LAS float*)(lds + L_SBUF + tok * REC) + cidx;
                const float decay = __expf(-0.6065306597126334f * pg8::fsigmoid(c_w0[cc] + aw[r])); const float alpha = pg8::fsigmoid(c_a0[cc] + aa[r]);
                const float kraw = rec[V_K * 64]; const float kkn = kraw * c_kk[cc] * *(LAS float*)(lds + L_INV + tok * 4);
                rec[V_A * 64] = -kkn; rec[V_W * 64] = decay; rec[V_B * 64] = kkn * alpha; rec[V_K * 64] = kraw * (1.0f + (alpha - 1.0f) * c_ka[cc]); } }
        __syncthreads();
        {
            const LAS unsigned char* rbase = lds + L_SBUF + col0 * 4;
            f32x2 ca = *(const LAS f32x2*)(rbase + V_A * 256), cw = *(const LAS f32x2*)(rbase + V_W * 256), cb = *(const LAS f32x2*)(rbase + V_B * 256),
                  ck = *(const LAS f32x2*)(rbase + V_K * 256), cr = *(const LAS f32x2*)(rbase + V_R * 256);
#pragma unroll 1
            for (int blk = 0; blk < 4; ++blk) {
                float ykeep = 0.f;
#pragma unroll
                for (int g4 = 0; g4 < 4; ++g4) {
                    const f32x4 v4 = *(const LAS f32x4*)(lds + L_VT + vt_off(row, 16 * blk + 4 * g4));
#pragma unroll
                    for (int i4 = 0; i4 < 4; ++i4) {
                        const int i = 4 * g4 + i4, tt = 16 * blk + i, tn = tt < 63 ? tt + 1 : 63;
                        const LAS unsigned char* rn = rbase + tn * REC;
                        const f32x2 na = *(const LAS f32x2*)(rn + V_A * 256), nw = *(const LAS f32x2*)(rn + V_W * 256), nb = *(const LAS f32x2*)(rn + V_B * 256),
                                    nk = *(const LAS f32x2*)(rn + V_K * 256), nr = *(const LAS f32x2*)(rn + V_R * 256);
                        const float vv = v4[i4];
                        const f32x2 p = S2 * ca;
                        const float sa = allsum32(p.x + p.y);
                        S2 = S2 * cw + ck * vv;
                        S2 = cb * sa + S2;
                        const f32x2 yq = S2 * cr;
                        const float y = allsum32(yq.x + yq.y);
                        ykeep = (cg == i) ? y : ykeep;
                        ca = na; cw = nw; cb = nb; ck = nk; cr = nr;
                    }
                }
                if (hh == 0) *(LAS float*)(lds + L_YS + ((16 * blk + cg) * 16 + 2 * w + rsel) * 4) = ykeep;
            }
        }
        __syncthreads();
        if (tid < 128) { const int j = tid >> 1, pc = tid & 1; const LAS float* ys = (const LAS float*)(lds + L_YS) + j * 16 + 8 * pc;
            u32x4 o; o.x = pg8::cvt_pk_bf16(ys[0], ys[1]); o.y = pg8::cvt_pk_bf16(ys[2], ys[3]); o.z = pg8::cvt_pk_bf16(ys[4], ys[5]); o.w = pg8::cvt_pk_bf16(ys[6], ys[7]);
            *(u32x4*)(U + RW_TOK(c, j) * PU + OFF_R + dir * RW + hc + 16 * rh + 8 * pc) = o; }
    }
    if (!q.grid) { const size_t sb = (((size_t)q.b * DEPTH + l) * 2 + dir) * RH + head; *(f32x2*)(P.out + OUT_S + (sb * 64 + row) * 64 + col0) = S2; }
    __syncthreads();
#undef RW_TOK
#undef RW_PREFETCH
}
constexpr int N_ITEMS = NSEQ * RH * 2 * 4;
__device__ __forceinline__ void decode_item(int it, int& s, int& head, int& dir, int& rh) {
    rh = it & 3; int ch = it >> 2; dir = ch & 1; ch >>= 1; head = ch % RH; const int sq = ch / RH;
    s = sq < LB ? CB + sq : sq - LB;
}
}


namespace wy {
typedef short bf16x8 __attribute__((ext_vector_type(8)));
typedef float f32x4 __attribute__((ext_vector_type(4)));
typedef unsigned u32x4 __attribute__((ext_vector_type(4)));
constexpr int PV = 144, PS = 48, PVS = 136;
constexpr int L_AH = 0, L_RH = L_AH + 64 * PV, L_BT = L_RH + 64 * PV, L_KT = L_BT + 64 * PV, L_NAKT = L_KT + 64 * PV, L_NRKT = L_NAKT + 4 * 16 * PS,
              L_NRBT = L_NRKT + 4 * 16 * PS, L_TT = L_NRBT + 4 * 16 * PS, L_GL = L_TT + 4 * 16 * PS, PACK_BYTES = L_GL + 1024,
              L_VS = PACK_BYTES, L_BH = L_VS + 64 * PV, L_KH = L_BH + 64 * PV, L_YS = L_KH + 64 * PV, L_TW = L_YS + 64 * PV, L_AL = L_TW + 64 * PV, L_NAB = L_AL + 64 * PV, L_INV = L_NAB + 4096, L_END = L_INV + 256;
constexpr int RING = 8, PACK_U = PACK_BYTES / 16, N_LAT = LB * RH * 2, RING_A = 20;
static_assert(PACK_BYTES % 1024 == 0 && PACK_U <= 8 * 512 && (size_t)RING_A * RING * PACK_BYTES <= (size_t)N1P * D * 2 && WS_END + (size_t)(N_LAT - RING_A) * RING * PACK_BYTES <= ((size_t)256 << 20), "ring placement");
static_assert(L_END <= 131072, "WY LDS map");
__device__ __forceinline__ bf16x8 fragk16(LAS unsigned char* lds, int base, int pitch, int row0, int k0, int lane) {
    const bf16x8 v = *(const LAS bf16x8*)(lds + base + (row0 + (lane & 15)) * pitch + (k0 + 8 * ((lane >> 4) & 1)) * 2);
    const bf16x8 z = {0, 0, 0, 0, 0, 0, 0, 0};
    return (lane < 32) ? v : z;
}
__device__ __forceinline__ void stb(LAS unsigned char* lds, int off, float v) { *(LAS bf16*)(lds + off) = f2bf(v); }
typedef unsigned u32x2 __attribute__((ext_vector_type(2)));
__device__ __forceinline__ bf16x8 pack_k16(const f32x4 v) { u32x4 o; o.x = pg8::cvt_pk_bf16(v[0], v[1]); o.y = pg8::cvt_pk_bf16(v[2], v[3]); o.z = 0u; o.w = 0u; return __builtin_bit_cast(bf16x8, o); }
__device__ __forceinline__ bf16x8 pack_k32(const f32x4 a, const f32x4 b) { u32x4 o; o.x = pg8::cvt_pk_bf16(a[0], a[1]); o.y = pg8::cvt_pk_bf16(a[2], a[3]); o.z = pg8::cvt_pk_bf16(b[0], b[1]); o.w = pg8::cvt_pk_bf16(b[2], b[3]);
    return __builtin_bit_cast(bf16x8, o); }
__device__ __forceinline__ bf16x8 ld_k16(LAS unsigned char* lds, int base, int pitch, int row0, int col0, int lane) {
    const u32x2 v = *(const LAS u32x2*)(lds + base + (row0 + (lane & 15)) * pitch + (col0 + 4 * (lane >> 4)) * 2); u32x4 o; o.x = v.x; o.y = v.y; o.z = 0u; o.w = 0u; return __builtin_bit_cast(bf16x8, o); }
__device__ __forceinline__ bf16x8 ld_k32(LAS unsigned char* lds, int base, int pitch, int row0, int col0, int lane) {
    const LAS unsigned char* p = lds + base + (row0 + (lane & 15)) * pitch + (col0 + 4 * (lane >> 4)) * 2;
    const u32x2 v0 = *(const LAS u32x2*)p, v1 = *(const LAS u32x2*)(p + 32); u32x4 o; o.x = v0.x; o.y = v0.y; o.z = v1.x; o.w = v1.y; return __builtin_bit_cast(bf16x8, o); }
__device__ __forceinline__ void rwkv_item(LAS unsigned char* lds, CParams& P, int l, int s, int head, int dir) {
    const int tid = threadIdx.x, w = __builtin_amdgcn_readfirstlane(tid >> 6), lane = tid & 63, fr = lane & 15, fq = lane >> 4;
    const int rt = w & 3, half = w >> 2, hc = head * 64;
    const SeqInfo q = seqinfo(s); const int nchunk = q.T / 64;
    const bf16* RX = WSP(bf16, WS_RXC); bf16* U = WSP(bf16, WS_U1);
    const int pj = tid >> 3, psub = tid & 7;
    f32x4 sacc[4];
#pragma unroll
    for (int ct = 0; ct < 4; ++ct) sacc[ct] = (f32x4){0.f, 0.f, 0.f, 0.f};
    if (w < 4 && q.grid) { const size_t sb = (((size_t)q.b * DEPTH + l) * 2 + dir) * RH + head;
#pragma unroll
        for (int ct = 0; ct < 4; ++ct) sacc[ct] = *(const f32x4*)(P.in[ST_R] + (sb * 64 + 16 * w + fr) * 64 + 16 * ct + 4 * fq); }
    float rkk8[8];
#pragma unroll
    for (int e = 0; e < 8; ++e) rkk8[e] = P.in[R_KK][(size_t)l * RW + hc + 8 * psub + e];
    float c_w0[2], c_a0[2], c_kk[2], c_ka[2];
#pragma unroll
    for (int cc = 0; cc < 2; ++cc) { const int c = 16 * (2 * half + cc) + fr;
        c_w0[cc] = P.in[R_W0][((size_t)l * 2 + dir) * RW + hc + c]; c_a0[cc] = P.in[R_A0][((size_t)l * 2 + dir) * RW + hc + c];
        c_kk[cc] = P.in[R_KK][(size_t)l * RW + hc + c]; c_ka[cc] = P.in[R_KA][(size_t)l * RW + hc + c]; }
    const bf16* w2t = WSP(bf16, O_W2T) + ((size_t)dir * RW + hc) * 64; const bf16* a2t = WSP(bf16, O_A2T) + ((size_t)dir * RW + hc) * 64;
    u32x4 pf[5];
#define WY_TOK(c, j) ((size_t)(q.base + (dir ? q.T - 1 - ((c) * 64 + (j)) : ((c) * 64 + (j)))))
#define WY_PREFETCH(c) do { const bf16* rx = RX + WY_TOK(c, pj) * RIN + 8 * psub; \
        pf[0] = *(const u32x4*)(rx + RX_R + hc); pf[1] = *(const u32x4*)(rx + RX_K + hc); pf[2] = *(const u32x4*)(rx + RX_V + hc); \
        pf[3] = *(const u32x4*)(rx + RX_WL + dir * 64); pf[4] = *(const u32x4*)(rx + RX_AL + dir * 64); } while (0)
    WY_PREFETCH(0);
    for (int c = 0; c < nchunk; ++c) {
        { *(LAS u32x4*)(lds + L_RH + pj * PV + psub * 16) = pf[0]; *(LAS u32x4*)(lds + L_KH + pj * PV + psub * 16) = pf[1];
          const unsigned kw[4] = {pf[1].x, pf[1].y, pf[1].z, pf[1].w}, vw[4] = {pf[2].x, pf[2].y, pf[2].z, pf[2].w};
          float ss = 0.f;
#pragma unroll
          for (int e = 0; e < 8; ++e) { const float kf = __builtin_bit_cast(float, (e & 1) ? (kw[e >> 1] & 0xffff0000u) : (kw[e >> 1] << 16)) * rkk8[e]; ss += kf * kf;
              *(LAS bf16*)(lds + L_VS + (8 * psub + e) * PVS + pj * 2) = (bf16)((vw[e >> 1] >> ((e & 1) * 16)) & 0xffffu); }
          ss += rw::dpp_xor1(ss); ss += rw::dpp_xor2(ss); ss += __shfl_xor(ss, 4);
          if (psub == 0) *(LAS float*)(lds + L_INV + pj * 4) = 1.0f / fmaxf(sqrtf(ss), 1e-12f);
          *(LAS u32x4*)(lds + L_TW + pj * PV + psub * 16) = pf[3]; *(LAS u32x4*)(lds + L_AL + pj * PV + psub * 16) = pf[4]; }
        LDS_BARRIER();
        if (c + 1 < nchunk) WY_PREFETCH(c + 1);
#pragma unroll
        for (int cc = 0; cc < 2; ++cc) { const int ct = 2 * half + cc; const int cidx = 16 * ct + fr;
            f32x4 aw = (f32x4){0.f, 0.f, 0.f, 0.f}, aa = (f32x4){0.f, 0.f, 0.f, 0.f};
#pragma unroll
            for (int ks = 0; ks < 2; ++ks) { const size_t bo = (size_t)cidx * 64 + 32 * ks + 8 * fq;
                aw = ml::mma(ml::frag(lds, L_TW, PV, 16 * rt, 32 * ks, lane), *(const bf16x8*)(w2t + bo), aw); aa = ml::mma(ml::frag(lds, L_AL, PV, 16 * rt, 32 * ks, lane), *(const bf16x8*)(a2t + bo), aa); }
            float kr4[4], rr4[4], iv4[4];
#pragma unroll
            for (int r = 0; r < 4; ++r) { const int tok = 16 * rt + 4 * fq + r; kr4[r] = bf2f(*(const LAS bf16*)(lds + L_KH + tok * PV + cidx * 2)); rr4[r] = bf2f(*(const LAS bf16*)(lds + L_RH + tok * PV + cidx * 2));
                iv4[r] = *(const LAS float*)(lds + L_INV + tok * 4); }
            float lw[4], cum[4];
#pragma unroll
            for (int r = 0; r < 4; ++r) { lw[r] = -0.6065306597126334f * pg8::fsigmoid(c_w0[cc] + aw[r]); cum[r] = (r ? cum[r - 1] : 0.f) + lw[r]; }
            const float tot = cum[3]; const float p1 = __shfl_up(tot, 16), p2 = __shfl_up(tot, 32), p3 = __shfl_up(tot, 48);
            const float off = (fq >= 1 ? p1 : 0.f) + (fq >= 2 ? p2 : 0.f) + (fq >= 3 ? p3 : 0.f);
            float gprev = __expf(off);
#pragma unroll
            for (int r = 0; r < 4; ++r) { const int tok = 16 * rt + 4 * fq + r; const float lam = off + cum[r]; const float g = __expf(lam), gi = __builtin_amdgcn_rcpf(g);
                const float alpha = pg8::fsigmoid(c_a0[cc] + aa[r]);
                const float kraw = kr4[r], rraw = rr4[r];
                const float kkn = kraw * c_kk[cc] * iv4[r];
                const bf16 bh = f2bf(kkn * alpha * gi), kh = f2bf(kraw * (1.0f + (alpha - 1.0f) * c_ka[cc]) * gi);
                stb(lds, L_AH + tok * PV + cidx * 2, -kkn * gprev); stb(lds, L_RH + tok * PV + cidx * 2, rraw * g);
                *(LAS bf16*)(lds + L_BH + tok * PV + cidx * 2) = bh; *(LAS bf16*)(lds + L_KH + tok * PV + cidx * 2) = kh;
                *(LAS bf16*)(lds + L_BT + cidx * PV + tok * 2) = bh; *(LAS bf16*)(lds + L_KT + cidx * PV + tok * 2) = kh;
                if (fq == 3 && r == 3) *(LAS float*)(lds + L_GL + (rt * 64 + cidx) * 4) = g;
                gprev = g; } }
        LDS_BARRIER();
        { const int sc = w >> 1, side = w & 1; f32x4 gB = (f32x4){0.f, 0.f, 0.f, 0.f}, gK = (f32x4){0.f, 0.f, 0.f, 0.f};
#pragma unroll
          for (int ks = 0; ks < 2; ++ks) { const bf16x8 af = ml::frag(lds, side ? L_RH : L_AH, PV, 16 * sc, 32 * ks, lane);
              gB = ml::mma(af, ml::frag(lds, L_BH, PV, 16 * sc, 32 * ks, lane), gB); gK = ml::mma(af, ml::frag(lds, L_KH, PV, 16 * sc, 32 * ks, lane), gK); }
#pragma unroll
          for (int r = 0; r < 4; ++r) { const int t = 4 * fq + r; const bool keep = side ? (fr <= t) : (fr < t); const float vB = keep ? gB[r] : 0.f, vK = keep ? gK[r] : 0.f;
              if (side == 0) { *(LAS float*)(lds + L_NAB + ((sc * 16 + t) * 16 + fr) * 4) = vB; stb(lds, L_NAKT + (sc * 16 + t) * PS + fr * 2, vK); }
              else { stb(lds, L_NRBT + (sc * 16 + t) * PS + fr * 2, vB); stb(lds, L_NRKT + (sc * 16 + t) * PS + fr * 2, vK); } } }
        if ((w & 1) == 0 && lane < 16) { const int sc = w >> 1; float Tr[16];
            asm volatile("" ::: "memory");
#pragma unroll
            for (int ph = 0; ph < 4; ++ph) { f32x4 nv[4][4];
#pragma unroll
                for (int tq = 0; tq < 4; ++tq)
#pragma unroll
                    for (int u4 = 0; u4 <= ph; ++u4) nv[tq][u4] = *(const LAS f32x4*)(lds + L_NAB + ((sc * 16 + 4 * ph + tq) * 16 + 4 * u4) * 4);
#pragma unroll
                for (int tq = 0; tq < 4; ++tq) { const int t = 4 * ph + tq; float x0 = (lane == t) ? 1.f : 0.f, x1 = 0.f;
#pragma unroll
                    for (int u = 0; u < 16; ++u) if (u < t) { if (u & 1) x1 += Tr[u] * nv[tq][u >> 2][u & 3]; else x0 += Tr[u] * nv[tq][u >> 2][u & 3]; }
                    Tr[t] = x0 + x1; stb(lds, L_TT + (sc * 16 + t) * PS + lane * 2, Tr[t]); } } }
        LDS_BARRIER();
        if (w < 4) {
#pragma unroll 1
            for (int sc = 0; sc < 4; ++sc) {
                const bf16x8 ah0 = ld_k32(lds, L_AH, PV, 16 * sc, 0, lane), ah1 = ld_k32(lds, L_AH, PV, 16 * sc, 32, lane), rh0 = ld_k32(lds, L_RH, PV, 16 * sc, 0, lane), rh1 = ld_k32(lds, L_RH, PV, 16 * sc, 32, lane);
                const bf16x8 nak = ld_k16(lds, L_NAKT, PS, 16 * sc, 0, lane), nrk = ld_k16(lds, L_NRKT, PS, 16 * sc, 0, lane), ttf = ld_k16(lds, L_TT, PS, 16 * sc, 0, lane), nrb = ld_k16(lds, L_NRBT, PS, 16 * sc, 0, lane);
                const bf16x8 vsf = ld_k16(lds, L_VS, PVS, 16 * w, 16 * sc, lane);
                bf16x8 btf[4], ktf[4]; f32x4 glv[4];
#pragma unroll
                for (int ct = 0; ct < 4; ++ct) { btf[ct] = ld_k16(lds, L_BT, PV, 16 * ct, 16 * sc, lane); ktf[ct] = ld_k16(lds, L_KT, PV, 16 * ct, 16 * sc, lane);
                    glv[ct] = *(const LAS f32x4*)(lds + L_GL + (sc * 64 + 16 * ct + 4 * fq) * 4); }
                const bf16x8 sb0 = pack_k32(sacc[0], sacc[1]), sb1 = pack_k32(sacc[2], sacc[3]);
                f32x4 XT = (f32x4){0.f, 0.f, 0.f, 0.f}, YT = (f32x4){0.f, 0.f, 0.f, 0.f};
                XT = ml::mma(ah0, sb0, XT); XT = ml::mma(ah1, sb1, XT); XT = ml::mma(nak, vsf, XT);
                YT = ml::mma(rh0, sb0, YT); YT = ml::mma(rh1, sb1, YT); YT = ml::mma(nrk, vsf, YT);
                f32x4 UT = (f32x4){0.f, 0.f, 0.f, 0.f};
                UT = ml::mma(ttf, pack_k16(XT), UT);
                const bf16x8 ub = pack_k16(UT);
                YT = ml::mma(nrb, ub, YT);
#pragma unroll
                for (int r = 0; r < 4; ++r) stb(lds, L_YS + (16 * sc + 4 * fq + r) * PV + (16 * w + fr) * 2, YT[r]);
#pragma unroll
                for (int ct = 0; ct < 4; ++ct) { sacc[ct] = ml::mma(btf[ct], ub, sacc[ct]); sacc[ct] = ml::mma(ktf[ct], vsf, sacc[ct]); sacc[ct] = sacc[ct] * glv[ct]; }
            }
        }
        LDS_BARRIER();
        *(u32x4*)(U + WY_TOK(c, pj) * PU + OFF_R + dir * RW + hc + 8 * psub) = *(const LAS u32x4*)(lds + L_YS + pj * PV + psub * 16);
    }
    if (!q.grid && w < 4) { const size_t sb = (((size_t)q.b * DEPTH + l) * 2 + dir) * RH + head;
#pragma unroll
        for (int ct = 0; ct < 4; ++ct) *(f32x4*)(P.out + OUT_S + (sb * 64 + 16 * w + fr) * 64 + 16 * ct + 4 * fq) = sacc[ct]; }
    LDS_BARRIER();
#undef WY_TOK
#undef WY_PREFETCH
}
__device__ __forceinline__ int tid_opaque() { int t = threadIdx.x; asm volatile("" : "+v"(t)); return t; }
constexpr int CW_F = 16384, FL_STRIDE = 64, NPROD = 2;
static_assert(RING % NPROD == 0 && NPROD + 1 <= 4 && CW_F + DEPTH * N_LAT * 4 * FL_STRIDE <= 32768, "flag block");
constexpr unsigned FL_SPIN_CAP = 1u << 18;
__device__ __forceinline__ unsigned fl_ld(unsigned* p) { return __hip_atomic_load(p, __ATOMIC_RELAXED, __HIP_MEMORY_SCOPE_AGENT); }
__device__ __forceinline__ unsigned fl_wait_ge(unsigned* p, unsigned want, unsigned* tmo) {
    unsigned sp = 0, v;
    while ((v = fl_ld(p)) < want) { __builtin_amdgcn_s_sleep(1); if ((++sp & 255u) == 0u) { if (fl_ld(tmo)) break; if (sp > FL_SPIN_CAP) { atomicAdd(tmo, 1u); break; } } }
    return v;
}
__device__ __forceinline__ void rwkv_prod(LAS unsigned char* lds, CParams& P, int l, int s, int head, int dir, int chain, int pp, unsigned* ctl) {
    const int tid = tid_opaque(), w = __builtin_amdgcn_readfirstlane(tid >> 6), lane = tid & 63, fr = lane & 15, fq = lane >> 4;
    const int rt = w & 3, half = w >> 2, hc = head * 64;
    const SeqInfo q = seqinfo(s); const int nchunk = q.T / 64;
    const bf16* RX = WSP(bf16, WS_RXC);
    const int pj = tid >> 3, psub = tid & 7;
    unsigned char* ring = P.ws + (chain < RING_A ? O_WIN1 + (size_t)chain * RING * PACK_BYTES : WS_END + (size_t)(chain - RING_A) * RING * PACK_BYTES);
    unsigned* f_base = ctl + CW_F + (size_t)((l * N_LAT + chain) * 4) * FL_STRIDE; unsigned* f_ready = f_base + pp * FL_STRIDE; unsigned* f_ack = f_base + NPROD * FL_STRIDE; unsigned* tmo = ctl + 4096 + 128;
    float rkk8[8];
#pragma unroll
    for (int e = 0; e < 8; ++e) rkk8[e] = P.in[R_KK][(size_t)l * RW + hc + 8 * psub + e];
    float c_w0[2], c_a0[2], c_kk[2], c_ka[2];
#pragma unroll
    for (int cc = 0; cc < 2; ++cc) { const int c = 16 * (2 * half + cc) + fr;
        c_w0[cc] = P.in[R_W0][((size_t)l * 2 + dir) * RW + hc + c]; c_a0[cc] = P.in[R_A0][((size_t)l * 2 + dir) * RW + hc + c];
        c_kk[cc] = P.in[R_KK][(size_t)l * RW + hc + c]; c_ka[cc] = P.in[R_KA][(size_t)l * RW + hc + c]; }
    const bf16* w2t = WSP(bf16, O_W2T) + ((size_t)dir * RW + hc) * 64; const bf16* a2t = WSP(bf16, O_A2T) + ((size_t)dir * RW + hc) * 64;
    bf16x8 lw2[2][2], la2[2][2];
#pragma unroll
    for (int cc = 0; cc < 2; ++cc)
#pragma unroll
        for (int ks = 0; ks < 2; ++ks) { const size_t bo = (size_t)(16 * (2 * half + cc) + fr) * 64 + 32 * ks + 8 * fq; lw2[cc][ks] = *(const bf16x8*)(w2t + bo); la2[cc][ks] = *(const bf16x8*)(a2t + bo); }
    u32x4 pf[5];
#define WY_TOK(c, j) ((size_t)(q.base + (dir ? q.T - 1 - ((c) * 64 + (j)) : ((c) * 64 + (j)))))
#define WY_PREFETCH(c) do { const bf16* rx = RX + WY_TOK(c, pj) * RIN + 8 * psub; \
        pf[0] = *(const u32x4*)(rx + RX_R + hc); pf[1] = *(const u32x4*)(rx + RX_K + hc); pf[2] = pf[0]; \
        pf[3] = *(const u32x4*)(rx + RX_WL + dir * 64); pf[4] = *(const u32x4*)(rx + RX_AL + dir * 64); } while (0)
    WY_PREFETCH(pp);
    asm volatile("" :: "v"(pf[0]), "v"(pf[1]), "v"(pf[2]), "v"(pf[3]), "v"(pf[4]) : "memory");
    unsigned acked = 0u;
    for (int c = pp; c < nchunk; c += NPROD) {
        { *(LAS u32x4*)(lds + L_RH + pj * PV + psub * 16) = pf[0]; *(LAS u32x4*)(lds + L_KH + pj * PV + psub * 16) = pf[1];
          const unsigned kw[4] = {pf[1].x, pf[1].y, pf[1].z, pf[1].w};
          float ss = 0.f;
#pragma unroll
          for (int e = 0; e < 8; ++e) { const float kf = __builtin_bit_cast(float, (e & 1) ? (kw[e >> 1] & 0xffff0000u) : (kw[e >> 1] << 16)) * rkk8[e]; ss += kf * kf; }
          ss += rw::dpp_xor1(ss); ss += rw::dpp_xor2(ss); ss += __shfl_xor(ss, 4);
          if (psub == 0) *(LAS float*)(lds + L_INV + pj * 4) = 1.0f / fmaxf(sqrtf(ss), 1e-12f);
          *(LAS u32x4*)(lds + L_TW + pj * PV + psub * 16) = pf[3]; *(LAS u32x4*)(lds + L_AL + pj * PV + psub * 16) = pf[4]; }
        LDS_BARRIER();
        if (c + NPROD < nchunk) WY_PREFETCH(c + NPROD);
#pragma unroll
        for (int cc = 0; cc < 2; ++cc) { const int ct = 2 * half + cc; const int cidx = 16 * ct + fr;
            f32x4 aw = (f32x4){0.f, 0.f, 0.f, 0.f}, aa = (f32x4){0.f, 0.f, 0.f, 0.f};
#pragma unroll
            for (int ks = 0; ks < 2; ++ks) {
                aw = ml::mma(ml::frag(lds, L_TW, PV, 16 * rt, 32 * ks, lane), lw2[cc][ks], aw); aa = ml::mma(ml::frag(lds, L_AL, PV, 16 * rt, 32 * ks, lane), la2[cc][ks], aa); }
            float kr4[4], rr4[4], iv4[4];
#pragma unroll
            for (int r = 0; r < 4; ++r) { const int tok = 16 * rt + 4 * fq + r; kr4[r] = bf2f(*(const LAS bf16*)(lds + L_KH + tok * PV + cidx * 2)); rr4[r] = bf2f(*(const LAS bf16*)(lds + L_RH + tok * PV + cidx * 2));
                iv4[r] = *(const LAS float*)(lds + L_INV + tok * 4); }
            float lw[4], cum[4];
#pragma unroll
            for (int r = 0; r < 4; ++r) { lw[r] = -0.6065306597126334f * pg8::fsigmoid(c_w0[cc] + aw[r]); cum[r] = (r ? cum[r - 1] : 0.f) + lw[r]; }
            const float tot = cum[3]; const float p1 = __shfl_up(tot, 16), p2 = __shfl_up(tot, 32), p3 = __shfl_up(tot, 48);
            const float off = (fq >= 1 ? p1 : 0.f) + (fq >= 2 ? p2 : 0.f) + (fq >= 3 ? p3 : 0.f);
            float gprev = __expf(off);
#pragma unroll
            for (int r = 0; r < 4; ++r) { const int tok = 16 * rt + 4 * fq + r; const float lam = off + cum[r]; const float g = __expf(lam), gi = __builtin_amdgcn_rcpf(g);
                const float alpha = pg8::fsigmoid(c_a0[cc] + aa[r]);
                const float kraw = kr4[r], rraw = rr4[r];
                const float kkn = kraw * c_kk[cc] * iv4[r];
                const bf16 bh = f2bf(kkn * alpha * gi), kh = f2bf(kraw * (1.0f + (alpha - 1.0f) * c_ka[cc]) * gi);
                stb(lds, L_AH + tok * PV + cidx * 2, -kkn * gprev); stb(lds, L_RH + tok * PV + cidx * 2, rraw * g);
                *(LAS bf16*)(lds + L_BH + tok * PV + cidx * 2) = bh; *(LAS bf16*)(lds + L_KH + tok * PV + cidx * 2) = kh;
                *(LAS bf16*)(lds + L_BT + cidx * PV + tok * 2) = bh; *(LAS bf16*)(lds + L_KT + cidx * PV + tok * 2) = kh;
                if (fq == 3 && r == 3) *(LAS float*)(lds + L_GL + (rt * 64 + cidx) * 4) = g;
                gprev = g; } }
        asm volatile("s_waitcnt vmcnt(0)" ::: "memory");
        LDS_BARRIER();
        if (tid == 0 && c > pp) __hip_atomic_store(f_ready, (unsigned)((c - pp) / NPROD), __ATOMIC_RELAXED, __HIP_MEMORY_SCOPE_AGENT);
        { const int sc = w >> 1, side = w & 1; f32x4 gB = (f32x4){0.f, 0.f, 0.f, 0.f}, gK = (f32x4){0.f, 0.f, 0.f, 0.f};
#pragma unroll
          for (int ks = 0; ks < 2; ++ks) { const bf16x8 af = ml::frag(lds, side ? L_RH : L_AH, PV, 16 * sc, 32 * ks, lane);
              gB = ml::mma(af, ml::frag(lds, L_BH, PV, 16 * sc, 32 * ks, lane), gB); gK = ml::mma(af, ml::frag(lds, L_KH, PV, 16 * sc, 32 * ks, lane), gK); }
#pragma unroll
          for (int r = 0; r < 4; ++r) { const int t = 4 * fq + r; const bool keep = side ? (fr <= t) : (fr < t); const float vB = keep ? gB[r] : 0.f, vK = keep ? gK[r] : 0.f;
              if (side == 0) { *(LAS float*)(lds + L_NAB + ((sc * 16 + t) * 16 + fr) * 4) = vB; stb(lds, L_NAKT + (sc * 16 + t) * PS + fr * 2, vK); }
              else { stb(lds, L_NRBT + (sc * 16 + t) * PS + fr * 2, vB); stb(lds, L_NRKT + (sc * 16 + t) * PS + fr * 2, vK); } } }
        if ((w & 1) == 0 && lane < 16) { const int sc = w >> 1; float Tr[16];
            asm volatile("" ::: "memory");
#pragma unroll
            for (int ph = 0; ph < 4; ++ph) { f32x4 nv[4][4];
#pragma unroll
                for (int tq = 0; tq < 4; ++tq)
#pragma unroll
                    for (int u4 = 0; u4 <= ph; ++u4) nv[tq][u4] = *(const LAS f32x4*)(lds + L_NAB + ((sc * 16 + 4 * ph + tq) * 16 + 4 * u4) * 4);
#pragma unroll
                for (int tq = 0; tq < 4; ++tq) { const int t = 4 * ph + tq; float x0 = (lane == t) ? 1.f : 0.f, x1 = 0.f;
#pragma unroll
                    for (int u = 0; u < 16; ++u) if (u < t) { if (u & 1) x1 += Tr[u] * nv[tq][u >> 2][u & 3]; else x0 += Tr[u] * nv[tq][u >> 2][u & 3]; }
                    Tr[t] = x0 + x1; stb(lds, L_TT + (sc * 16 + t) * PS + lane * 2, Tr[t]); } } }
        if (tid == 0 && c >= RING && acked < (unsigned)(c - RING + 1)) acked = fl_wait_ge(f_ack, (unsigned)(c - RING + 1), tmo);
        LDS_BARRIER();
        asm volatile("" :: "v"(pf[0]), "v"(pf[1]), "v"(pf[2]), "v"(pf[3]), "v"(pf[4]) : "memory");
        { unsigned char* slot = ring + (size_t)(c % RING) * PACK_BYTES;
#pragma unroll
          for (int k = 0; k < 8; ++k) { const int u = tid + 512 * k;
              if (u < PACK_U) { const u32x4 v = *(const LAS u32x4*)(lds + 16 * u); const u32x4* gp = (const u32x4*)(slot + (size_t)16 * u);
                  asm volatile("global_store_dwordx4 %0, %1, off sc1" :: "v"(gp), "v"(v) : "memory"); } } }
        LDS_BARRIER();
    }
    asm volatile("s_waitcnt vmcnt(0)" ::: "memory");
    __syncthreads();
    if (tid == 0) __hip_atomic_store(f_ready, (unsigned)((nchunk - pp + NPROD - 1) / NPROD), __ATOMIC_RELAXED, __HIP_MEMORY_SCOPE_AGENT);
    LDS_BARRIER();
#undef WY_TOK
#undef WY_PREFETCH
}
__device__ __forceinline__ void rwkv_cons(LAS unsigned char* lds, CParams& P, int l, int s, int head, int dir, int chain, unsigned* ctl) {
    const int tid = tid_opaque(), w = __builtin_amdgcn_readfirstlane(tid >> 6), lane = tid & 63, fr = lane & 15, fq = lane >> 4;
    const int hc = head * 64;
    const SeqInfo q = seqinfo(s); const int nchunk = q.T / 64;
    bf16* U = WSP(bf16, WS_U1);
    const unsigned char* ring = P.ws + (chain < RING_A ? O_WIN1 + (size_t)chain * RING * PACK_BYTES : WS_END + (size_t)(chain - RING_A) * RING * PACK_BYTES);
    unsigned* f_base = ctl + CW_F + (size_t)((l * N_LAT + chain) * 4) * FL_STRIDE; unsigned* f_ack = f_base + NPROD * FL_STRIDE; unsigned* tmo = ctl + 4096 + 128;
    constexpr int C_IMG = PACK_BYTES + 64 * PV, C_YS = 2 * C_IMG;
    const bf16* RX = WSP(bf16, WS_RXC);
    static_assert(C_YS + 64 * PV <= 131072, "consumer LDS map");
    f32x4 sacc[4];
#pragma unroll
    for (int ct = 0; ct < 4; ++ct) sacc[ct] = (f32x4){0.f, 0.f, 0.f, 0.f};
    if (w < 4 && q.grid) { const size_t sb = (((size_t)q.b * DEPTH + l) * 2 + dir) * RH + head;
#pragma unroll
        for (int ct = 0; ct < 4; ++ct) sacc[ct] = *(const f32x4*)(P.in[ST_R] + (sb * 64 + 16 * w + fr) * 64 + 16 * ct + 4 * fq); }
#define WY_TOK(c, j) ((size_t)(q.base + (dir ? q.T - 1 - ((c) * 64 + (j)) : ((c) * 64 + (j)))))
    unsigned seen0 = 0u, seen1 = 0u;
#define CONS_FETCH(c, boff) do { const int p_ = (c) % NPROD; const unsigned need_ = (unsigned)((c) / NPROD + 1); \
        u32x4 vv_[2];   \
        _Pragma("unroll") for (int i_ = 0; i_ < 2; ++i_) vv_[i_] = *(const u32x4*)(RX + WY_TOK(c, lane) * RIN + RX_V + hc + 8 * (2 * (w - 4) + i_)); \
        if ((p_ ? seen1 : seen0) < need_) { unsigned v_ = 0u; if (lane == 0) v_ = fl_wait_ge(f_base + p_ * FL_STRIDE, need_, tmo); v_ = __builtin_amdgcn_readfirstlane(v_); \
            if (p_) seen1 = v_; else seen0 = v_; __builtin_amdgcn_fence(__ATOMIC_ACQUIRE, "agent"); } \
        _Pragma("unroll") for (int i_ = 0; i_ < 2; ++i_) { const unsigned wv_[4] = {vv_[i_].x, vv_[i_].y, vv_[i_].z, vv_[i_].w}; \
            _Pragma("unroll") for (int e_ = 0; e_ < 8; ++e_) *(LAS bf16*)(lds + (boff) + L_VS + (8 * (2 * (w - 4) + i_) + e_) * PVS + lane * 2) = (bf16)((wv_[e_ >> 1] >> ((e_ & 1) * 16)) & 0xffffu); } \
        const unsigned char* slot = ring + (size_t)((c) % RING) * PACK_BYTES; \
        for (int k = w - 4; k < PACK_BYTES / 1024; k += 4) \
            __builtin_amdgcn_global_load_lds((const unsigned*)(slot + (size_t)k * 1024 + lane * 16), (LAS unsigned*)(lds + (boff) + k * 1024), 16, 0, 0); \
        asm volatile("s_waitcnt vmcnt(0)" ::: "memory"); } while (0)
    if (w >= 4) CONS_FETCH(0, 0);
    LDS_BARRIER();
    if (tid == 256) __hip_atomic_store(f_ack, 1u, __ATOMIC_RELAXED, __HIP_MEMORY_SCOPE_AGENT);
    for (int c = 0; c < nchunk; ++c) {
        const int boff = (c & 1) * C_IMG;
        if (w >= 4) { if (c + 1 < nchunk) CONS_FETCH(c + 1, C_IMG - boff); }
        else {
            LAS unsigned char* pb = lds + boff;
#pragma unroll 1
            for (int sc = 0; sc < 4; ++sc) {
                const bf16x8 ah0 = ld_k32(pb, L_AH, PV, 16 * sc, 0, lane), ah1 = ld_k32(pb, L_AH, PV, 16 * sc, 32, lane), rh0 = ld_k32(pb, L_RH, PV, 16 * sc, 0, lane), rh1 = ld_k32(pb, L_RH, PV, 16 * sc, 32, lane);
                const bf16x8 nak = ld_k16(pb, L_NAKT, PS, 16 * sc, 0, lane), nrk = ld_k16(pb, L_NRKT, PS, 16 * sc, 0, lane), ttf = ld_k16(pb, L_TT, PS, 16 * sc, 0, lane), nrb = ld_k16(pb, L_NRBT, PS, 16 * sc, 0, lane);
                const bf16x8 vsf = ld_k16(pb, L_VS, PVS, 16 * w, 16 * sc, lane);
                bf16x8 btf[4], ktf[4]; f32x4 glv[4];
#pragma unroll
                for (int ct = 0; ct < 4; ++ct) { btf[ct] = ld_k16(pb, L_BT, PV, 16 * ct, 16 * sc, lane); ktf[ct] = ld_k16(pb, L_KT, PV, 16 * ct, 16 * sc, lane);
                    glv[ct] = *(const LAS f32x4*)(pb + L_GL + (sc * 64 + 16 * ct + 4 * fq) * 4); }
                const bf16x8 sb0 = pack_k32(sacc[0], sacc[1]), sb1 = pack_k32(sacc[2], sacc[3]);
                f32x4 XT = (f32x4){0.f, 0.f, 0.f, 0.f}, YT = (f32x4){0.f, 0.f, 0.f, 0.f};
                XT = ml::mma(ah0, sb0, XT); XT = ml::mma(ah1, sb1, XT); XT = ml::mma(nak, vsf, XT);
                YT = ml::mma(rh0, sb0, YT); YT = ml::mma(rh1, sb1, YT); YT = ml::mma(nrk, vsf, YT);
                f32x4 UT = (f32x4){0.f, 0.f, 0.f, 0.f};
                UT = ml::mma(ttf, pack_k16(XT), UT);
                const bf16x8 ub = pack_k16(UT);
                YT = ml::mma(nrb, ub, YT);
#pragma unroll
                for (int r = 0; r < 4; ++r) stb(lds, C_YS + (16 * sc + 4 * fq + r) * PV + (16 * w + fr) * 2, YT[r]);
#pragma unroll
                for (int ct = 0; ct < 4; ++ct) { sacc[ct] = ml::mma(btf[ct], ub, sacc[ct]); sacc[ct] = ml::mma(ktf[ct], vsf, sacc[ct]); sacc[ct] = sacc[ct] * glv[ct]; }
            }
            { const LAS unsigned char* yp = lds + C_YS + lane * PV + 32 * w; const u32x4 y0 = *(const LAS u32x4*)yp, y1 = *(const LAS u32x4*)(yp + 16);
              bf16* up = U + WY_TOK(c, lane) * PU + OFF_R + dir * RW + hc + 16 * w; *(u32x4*)up = y0; *(u32x4*)(up + 8) = y1; }
        }
        LDS_BARRIER();
        if (tid == 256 && c + 1 < nchunk) __hip_atomic_store(f_ack, (unsigned)(c + 2), __ATOMIC_RELAXED, __HIP_MEMORY_SCOPE_AGENT);
    }
    if (!q.grid && w < 4) { const size_t sb = (((size_t)q.b * DEPTH + l) * 2 + dir) * RH + head;
#pragma unroll
        for (int ct = 0; ct < 4; ++ct) *(f32x4*)(P.out + OUT_S + (sb * 64 + 16 * w + fr) * 64 + 16 * ct + 4 * fq) = sacc[ct]; }
    LDS_BARRIER();
#undef WY_TOK
#undef CONS_FETCH
}
constexpr int N_ITEMS = NSEQ * RH * 2;
__device__ __forceinline__ void decode_item(int it, int& s, int& head, int& dir) {
    dir = it & 1; int ch = it >> 1; head = ch % RH; const int sq = ch / RH;
    s = sq < LB ? CB + sq : sq - LB;
}
}

namespace ms {
using ml::PQ; using ml::PT; using ml::mma; using ml::frag; using wy::bf16x8; using wy::f32x4; using wy::u32x4;
constexpr int P_QS = 0, P_KT = P_QS + 64 * PQ, P_SB = P_KT + 128 * PT, P_SC = P_SB + 64 * PT, P_VT = P_SC + 4096, VT_BYTES = 21504, ML_PACK = P_VT + VT_BYTES, P_KS = ML_PACK, P_END = P_KS + 64 * PQ;
constexpr int ML_RING = 4, ML_PACK_U = ML_PACK / 16, N_MLAT = LB * MH * 2, CW_MF = 32768, MLPROD = 2;
static_assert(MLPROD == 2 && ML_RING % MLPROD == 0, "two producers per chain: even / odd chunks");
static_assert(ML_PACK % 1024 == 0 && ML_PACK_U <= 9 * 512 && 145 * PT <= VT_BYTES && P_END <= 131072 && 2 * ML_PACK <= 146432, "mLSTM pack layout");
static_assert(WS_END + (size_t)N_MLAT * ML_RING * ML_PACK <= ((size_t)256 << 20), "mLSTM ring fits behind the activations");
__device__ __forceinline__ void ml_prod(LAS unsigned char* lds, CParams& P, int l, int s, int head, int dir, int chain, int pp, unsigned* ctl) {
    const int tid = wy::tid_opaque(), w = __builtin_amdgcn_readfirstlane(tid >> 6), lane = tid & 63, fr = lane & 15, fq = lane >> 4;
    const int rt = w & 3, half = w >> 2;
    const SeqInfo q = seqinfo(s); const int nchunk = q.T / 64;
    const bf16* QK = WSP(bf16, WS_QKC); const bf16* U = WSP(bf16, WS_U1);
    LAS float* SC = (LAS float*)(lds + P_SC);
    unsigned char* ring = P.ws + WS_END + (size_t)chain * ML_RING * ML_PACK;
    unsigned* f_base = ctl + CW_MF + (size_t)((l * N_MLAT + chain) * 4) * wy::FL_STRIDE; unsigned* f_ready = f_base + pp * wy::FL_STRIDE; unsigned* f_ack = f_base + MLPROD * wy::FL_STRIDE; unsigned* tmo = ctl + 4096 + 128;
    float m_prev = 0.f;
    if (q.grid) m_prev = P.in[ST_M][(((size_t)q.b * DEPTH + l) * 2 + dir) * MH + head];
    const float bi = P.in[M_GATE_B][(size_t)l * 4 * MH + (2 * dir) * MH + head], bfg = P.in[M_GATE_B][(size_t)l * 4 * MH + (2 * dir + 1) * MH + head];
    for (int i = tid; i < (VT_BYTES - 128 * PT) / 2; i += 512) *(LAS bf16*)(lds + P_VT + 128 * PT + i * 2) = (i < 64) ? (bf16)0x3f80 : (bf16)0;
    u32x4 pqk[4]; u32x4 pv[2]; bf16 pgi = 0, pgf = 0, sgi = 0, sgf = 0;
#define ML_TOK(c, j) ((size_t)(q.base + (dir ? q.T - 1 - ((c) * 64 + (j)) : ((c) * 64 + (j)))))
#define ML_PREFETCH(c) do { _Pragma("unroll") for (int i = 0; i < 4; ++i) { const int id = tid + 512 * i, j = id >> 5, pc = id & 31; \
            pqk[i] = *(const u32x4*)(QK + ML_TOK(c, j) * (2 * MW) + (pc < 16 ? head * 128 + 8 * pc : MW + head * 128 + 8 * (pc - 16))); } \
        _Pragma("unroll") for (int i = 0; i < 2; ++i) { const int id = tid + 512 * i, j = id >> 4, pc = id & 15; pv[i] = *(const u32x4*)(U + ML_TOK(c, j) * PU + OFF_V + head * 128 + 8 * pc); } \
        if (w == 0) { const bf16* g = U + ML_TOK(c, lane) * PU + OFF_G; pgi = g[(2 * dir) * MH + head]; pgf = g[(2 * dir + 1) * MH + head]; \
            if ((c) >= 1) { const bf16* g2 = U + ML_TOK((c) - 1, lane) * PU + OFF_G; sgi = g2[(2 * dir) * MH + head]; sgf = g2[(2 * dir + 1) * MH + head]; } } } while (0)
#define ML_TOUCH() asm volatile("" :: "v"(pqk[0]), "v"(pqk[1]), "v"(pqk[2]), "v"(pqk[3]), "v"(pv[0]), "v"(pv[1]), "v"((unsigned)pgi), "v"((unsigned)pgf), "v"((unsigned)sgi), "v"((unsigned)sgf) : "memory")
#define ML_SCAN(gi_, gf_) \
            const float gi = bf2f(gi_) + bi, gf = bf2f(gf_) + bfg; \
            const float lf = fminf(gf, 0.f) - log1pf(__expf(-fabsf(gf))); \
            float b = lf; \
            _Pragma("unroll") for (int o = 1; o < 64; o <<= 1) { const float t = __shfl_up(b, o); if (lane >= o) b += t; } \
            const float a = gi - b; float pm = a; \
            _Pragma("unroll") for (int o = 1; o < 64; o <<= 1) { const float t = __shfl_up(pm, o); if (lane >= o) pm = fmaxf(pm, t); } \
            pm = fmaxf(pm, m_prev); \
            const float pm63 = __shfl(pm, 63), b63 = __shfl(b, 63);
    ML_PREFETCH(pp);
    ML_TOUCH();
    unsigned acked = 0u;
    for (int c = pp; c < nchunk; c += MLPROD) {
        if (w == 0 && c >= 1) { ML_SCAN(sgi, sgf) m_prev = b63 + pm63; }
#pragma unroll
        for (int i = 0; i < 4; ++i) { const int id = tid + 512 * i, j = id >> 5, pc = id & 31;
            *(LAS u32x4*)(lds + (pc < 16 ? P_QS : P_KS) + j * PQ + (pc & 15) * 16) = pqk[i]; }
#pragma unroll
        for (int i = 0; i < 2; ++i) { const int id = tid + 512 * i, j = id >> 4, pc = id & 15; const unsigned wv[4] = {pv[i].x, pv[i].y, pv[i].z, pv[i].w};
#pragma unroll
            for (int e = 0; e < 8; ++e) *(LAS bf16*)(lds + P_VT + (8 * pc + e) * PT + j * 2) = (bf16)((wv[e >> 1] >> ((e & 1) * 16)) & 0xffffu); }
        if (w == 0) {
            ML_SCAN(pgi, pgf)
            SC[ml::SC_A + lane] = a; SC[ml::SC_PM + lane] = pm; SC[ml::SC_WI + lane] = __expf(m_prev - pm); SC[ml::SC_EMT + lane] = __expf(-(b + pm)); SC[ml::SC_WE + lane] = __expf(a - pm63);
            if (lane == 0) { SC[ml::SC_MISC] = __expf(m_prev - pm63); SC[ml::SC_MISC + 1] = b63 + pm63; }
            m_prev = b63 + pm63;
        }
        LDS_BARRIER();
        if (c + MLPROD < nchunk) ML_PREFETCH(c + MLPROD);
#pragma unroll
        for (int i = 0; i < 2; ++i) { const int id = tid + 512 * i, j = id & 63, pc = id >> 6; const float we = SC[ml::SC_WE + j];
            const u32x4 kv = *(const LAS u32x4*)(lds + P_KS + j * PQ + pc * 16); const unsigned wv[4] = {kv.x, kv.y, kv.z, kv.w};
#pragma unroll
            for (int e = 0; e < 8; ++e) { const float kf = __builtin_bit_cast(float, (e & 1) ? (wv[e >> 1] & 0xffff0000u) : (wv[e >> 1] << 16));
                *(LAS bf16*)(lds + P_KT + (8 * pc + e) * PT + j * 2) = f2bf(kf * we); } }
#pragma unroll
        for (int cc = 0; cc < 2; ++cc) { const int ct = 2 * half + cc;
            f32x4 acc = (f32x4){0.f, 0.f, 0.f, 0.f};
            if (ct <= rt) {
#pragma unroll
                for (int k = 0; k < 4; ++k) acc = mma(frag(lds, P_QS, PQ, 16 * rt, 32 * k, lane), frag(lds, P_KS, PQ, 16 * ct, 32 * k, lane), acc);
            }
            const int sp = 16 * ct + fr; const float as = SC[ml::SC_A + sp];
#pragma unroll
            for (int r = 0; r < 4; ++r) { const int t = 16 * rt + 4 * fq + r; const float v = (sp <= t) ? acc[r] * __expf(as - SC[ml::SC_PM + t]) : 0.f;
                *(LAS bf16*)(lds + P_SB + t * PT + sp * 2) = f2bf(v); } }
        asm volatile("s_waitcnt vmcnt(0)" ::: "memory");
        if (tid == 0 && c >= ML_RING && acked < (unsigned)(c - ML_RING + 1)) acked = wy::fl_wait_ge(f_ack, (unsigned)(c - ML_RING + 1), tmo);
        LDS_BARRIER();
        if (tid == 0 && c > pp) __hip_atomic_store(f_ready, (unsigned)((c - pp) / MLPROD), __ATOMIC_RELAXED, __HIP_MEMORY_SCOPE_AGENT);
        ML_TOUCH();
        { unsigned char* slot = ring + (size_t)(c % ML_RING) * ML_PACK;
#pragma unroll
          for (int k = 0; k < 9; ++k) { const int u = tid + 512 * k;
              if (u < ML_PACK_U) { const u32x4 v = *(const LAS u32x4*)(lds + 16 * u); const u32x4* gp = (const u32x4*)(slot + (size_t)16 * u);
                  asm volatile("global_store_dwordx4 %0, %1, off sc1" :: "v"(gp), "v"(v) : "memory"); } } }
        LDS_BARRIER();
    }
    asm volatile("s_waitcnt vmcnt(0)" ::: "memory");
    __syncthreads();
    if (tid == 0) __hip_atomic_store(f_ready, (unsigned)((nchunk - pp + MLPROD - 1) / MLPROD), __ATOMIC_RELAXED, __HIP_MEMORY_SCOPE_AGENT);
    LDS_BARRIER();
#undef ML_TOK
#undef ML_PREFETCH
#undef ML_TOUCH
#undef ML_SCAN
}
__device__ __forceinline__ void ml_cons(LAS unsigned char* lds, CParams& P, int l, int s, int head, int dir, int chain, unsigned* ctl) {
    const int tid = wy::tid_opaque(), w = __builtin_amdgcn_readfirstlane(tid >> 6), lane = tid & 63, fr = lane & 15, fq = lane >> 4;
    const SeqInfo q = seqinfo(s); const int nchunk = q.T / 64;
    bf16* U = WSP(bf16, WS_U1);
    const unsigned char* ring = P.ws + WS_END + (size_t)chain * ML_RING * ML_PACK;
    unsigned* f_base = ctl + CW_MF + (size_t)((l * N_MLAT + chain) * 4) * wy::FL_STRIDE; unsigned* f_ack = f_base + MLPROD * wy::FL_STRIDE; unsigned* tmo = ctl + 4096 + 128;
    f32x4 cst[8][3];
#pragma unroll
    for (int kt = 0; kt < 8; ++kt)
#pragma unroll
        for (int j = 0; j < 3; ++j) cst[kt][j] = (f32x4){0.f, 0.f, 0.f, 0.f};
    if (w < 4 && q.grid) { const size_t sb = (((size_t)q.b * DEPTH + l) * 2 + dir) * MH + head;
#pragma unroll
        for (int kt = 0; kt < 8; ++kt)
#pragma unroll
            for (int r = 0; r < 4; ++r) { const int d = 16 * kt + 4 * fq + r;
                cst[kt][0][r] = P.in[ST_C][(sb * 128 + d) * 128 + 32 * w + fr]; cst[kt][1][r] = P.in[ST_C][(sb * 128 + d) * 128 + 32 * w + 16 + fr];
                cst[kt][2][r] = (fr == 0) ? P.in[ST_N][sb * 128 + d] : 0.f; } }
#define ML_TOK(c, j) ((size_t)(q.base + (dir ? q.T - 1 - ((c) * 64 + (j)) : ((c) * 64 + (j)))))
    unsigned seen0 = 0u, seen1 = 0u;
#define MLC_FETCH(c, boff) do { const int p_ = (c) % MLPROD; const unsigned need_ = (unsigned)((c) / MLPROD + 1); \
        if ((p_ ? seen1 : seen0) < need_) { unsigned v_ = 0u; if (lane == 0) v_ = wy::fl_wait_ge(f_base + p_ * wy::FL_STRIDE, need_, tmo); v_ = __builtin_amdgcn_readfirstlane(v_); \
            if (p_) seen1 = v_; else seen0 = v_; __builtin_amdgcn_fence(__ATOMIC_ACQUIRE, "agent"); } \
        const unsigned char* slot = ring + (size_t)((c) % ML_RING) * ML_PACK; \
        for (int k = w - 4; k < ML_PACK / 1024; k += 4) \
            __builtin_amdgcn_global_load_lds((const unsigned*)(slot + (size_t)k * 1024 + lane * 16), (LAS unsigned*)(lds + (boff) + k * 1024), 16, 0, 0); \
        asm volatile("s_waitcnt vmcnt(0)" ::: "memory"); } while (0)
    if (w >= 4) MLC_FETCH(0, 0);
    LDS_BARRIER();
    if (tid == 256) __hip_atomic_store(f_ack, 1u, __ATOMIC_RELAXED, __HIP_MEMORY_SCOPE_AGENT);
    for (int c = 0; c < nchunk; ++c) {
        const int boff = (c & 1) * ML_PACK;
        if (w >= 4) { if (c + 1 < nchunk) MLC_FETCH(c + 1, ML_PACK - boff); }
        else {
            LAS unsigned char* pb = lds + boff; const LAS float* SC = (const LAS float*)(pb + P_SC);
            const float wie = SC[ml::SC_MISC];
            bf16x8 vf[3][2];
#pragma unroll
            for (int j = 0; j < 3; ++j)
#pragma unroll
                for (int k = 0; k < 2; ++k) vf[j][k] = frag(pb, P_VT, PT, j < 2 ? 32 * w + 16 * j : 128, 32 * k, lane);
            asm volatile("s_waitcnt lgkmcnt(0)" ::: "memory");
            LAS unsigned char* hp = pb + P_VT + 32 * w * PT;
#pragma unroll
            for (int rt = 0; rt < 4; ++rt) {
                f32x4 num[3];
#pragma unroll
                for (int j = 0; j < 3; ++j) { f32x4 a1 = (f32x4){0.f, 0.f, 0.f, 0.f}, a2 = (f32x4){0.f, 0.f, 0.f, 0.f};
#pragma unroll
                    for (int k = 0; k < 2; ++k) a1 = mma(frag(pb, P_SB, PT, 16 * rt, 32 * k, lane), vf[j][k], a1);
#pragma unroll
                    for (int kb = 0; kb < 4; ++kb) a2 = mma(wy::ld_k32(pb, P_QS, PQ, 16 * rt, 32 * kb, lane), wy::pack_k32(cst[2 * kb][j], cst[2 * kb + 1][j]), a2);
#pragma unroll
                    for (int r = 0; r < 4; ++r) a1[r] += SC[ml::SC_WI + 16 * rt + 4 * fq + r] * a2[r];
                    num[j] = a1; }
#pragma unroll
                for (int r = 0; r < 4; ++r) { const int t = 16 * rt + 4 * fq + r; const float dn = __shfl(num[2][r], lane & 48);
                    const float rden = __builtin_amdgcn_rcpf(fmaxf(fabsf(dn), SC[ml::SC_EMT + t]));
                    *(LAS bf16*)(hp + t * 64 + fr * 2) = f2bf(num[0][r] * rden); *(LAS bf16*)(hp + t * 64 + (16 + fr) * 2) = f2bf(num[1][r] * rden); }
            }
#pragma unroll
            for (int kt = 0; kt < 8; ++kt) { const bf16x8 k0 = frag(pb, P_KT, PT, 16 * kt, 0, lane), k1 = frag(pb, P_KT, PT, 16 * kt, 32, lane);
#pragma unroll
                for (int j = 0; j < 3; ++j) { cst[kt][j] = cst[kt][j] * wie; cst[kt][j] = mma(k0, vf[j][0], cst[kt][j]); cst[kt][j] = mma(k1, vf[j][1], cst[kt][j]); } }
            { const LAS unsigned char* yp = hp + lane * 64; bf16* up = U + ML_TOK(c, lane) * PU + dir * MW + head * 128 + 32 * w;
#pragma unroll
              for (int i = 0; i < 4; ++i) *(u32x4*)(up + 8 * i) = *(const LAS u32x4*)(yp + 16 * i); }
        }
        LDS_BARRIER();
        if (tid == 256 && c + 1 < nchunk) __hip_atomic_store(f_ack, (unsigned)(c + 2), __ATOMIC_RELAXED, __HIP_MEMORY_SCOPE_AGENT);
    }
    LDS_BARRIER();
#undef ML_TOK
#undef MLC_FETCH
}
}

namespace el {
typedef float f32x4 __attribute__((ext_vector_type(4)));
typedef unsigned u32x4 __attribute__((ext_vector_type(4)));
typedef unsigned u32x2 __attribute__((ext_vector_type(2)));
typedef short bf16x8 __attribute__((ext_vector_type(8)));
__device__ __forceinline__ float wave_sum(float v) {
#pragma unroll
    for (int o = 1; o < 64; o <<= 1) v += __shfl_xor(v, o);
    return v;
}
__device__ __forceinline__ void unpack8(const u32x4 p, float (&f)[8]) {
    f[0] = pg8::bflo(p.x); f[1] = pg8::bfhi(p.x); f[2] = pg8::bflo(p.y); f[3] = pg8::bfhi(p.y); f[4] = pg8::bflo(p.z); f[5] = pg8::bfhi(p.z); f[6] = pg8::bflo(p.w); f[7] = pg8::bfhi(p.w);
}
__device__ __forceinline__ u32x4 pack8(const float (&f)[8]) {
    u32x4 o; o.x = pg8::cvt_pk_bf16(f[0], f[1]); o.y = pg8::cvt_pk_bf16(f[2], f[3]); o.z = pg8::cvt_pk_bf16(f[4], f[5]); o.w = pg8::cvt_pk_bf16(f[6], f[7]); return o;
}
__device__ __forceinline__ void init_phase(LAS unsigned char* lds, CParams& P, int vb, int G) {
    const int tid = threadIdx.x, w = tid >> 6, lane = tid & 63;
    LAS float* red = (LAS float*)lds;
    LAS float* sil = (LAS float*)(lds + 8192);
    constexpr int KW = D / 8;
    if (vb < DEPTH * (6 * D / 64)) {
        for (int i = tid; i < NCOND * D; i += 512) { const int ci = i / D, k = i % D; const float cv = ci == 0 ? P.in[C_CTX][k] : P.in[C_LAT][(size_t)(ci - 1) * D + k]; sil[i] = cv * pg8::fsigmoid(cv); }
        __syncthreads();
    }
    for (int it = vb; it < DEPTH * (6 * D / 64); it += G) {
        const int l = it / (6 * D / 64), j = (it % (6 * D / 64)) * 64 + lane;
        const float* wp = P.in[ADA_W] + ((size_t)l * D + w * KW) * 6 * D + j;
        float acc[NCOND];
#pragma unroll
        for (int ci = 0; ci < NCOND; ++ci) acc[ci] = 0.f;
#pragma unroll 16
        for (int k = 0; k < KW; ++k) { const float wv = wp[(size_t)k * 6 * D];
#pragma unroll
            for (int ci = 0; ci < NCOND; ++ci) acc[ci] += sil[ci * D + w * KW + k] * wv; }
#pragma unroll
        for (int ci = 0; ci < NCOND; ++ci) red[(w * NCOND + ci) * 64 + lane] = acc[ci];
        __syncthreads();
        if (w < NCOND) { float sum = P.in[ADA_B][(size_t)l * 6 * D + j];
#pragma unroll
            for (int ww = 0; ww < 8; ++ww) sum += red[(ww * NCOND + w) * 64 + lane];
            WSP(float, WS_MOD)[((size_t)l * NCOND + w) * 6 * D + j] = sum; }
        __syncthreads();
    }
}
__device__ __forceinline__ int perm5(int n) { return (((n >> 2) & 1) << 4) | (((n >> 3) & 3) << 2) | (n & 3); }
__device__ __forceinline__ void transpose_item(const float* W, int ldw, int nvalid, bf16* dst, int K, int k0, int drow0, bool perm, LAS float* scr, int lane) {
    f32x4 tv[8];
#pragma unroll
    for (int i = 0; i < 8; ++i) { const int kk = 8 * i + (lane >> 3), n4 = (lane & 7) * 4; tv[i] = n4 < nvalid ? *(const f32x4*)(W + (size_t)kk * ldw + n4) : (f32x4){0.f, 0.f, 0.f, 0.f}; }
#pragma unroll
    for (int i = 0; i < 8; ++i) { const int kk = 8 * i + (lane >> 3), n4 = (lane & 7) * 4;
#pragma unroll
        for (int e = 0; e < 4; ++e) scr[kk * 33 + n4 + e] = tv[i][e]; }
    asm volatile("s_waitcnt lgkmcnt(0)" ::: "memory");
    const int c = lane & 7;
#pragma unroll
    for (int j = 0; j < 4; ++j) { const int n = (lane >> 3) + 8 * j; const LAS float* sp = scr + (8 * c) * 33 + n;
        u32x4 o; o.x = pg8::cvt_pk_bf16(sp[0 * 33], sp[1 * 33]); o.y = pg8::cvt_pk_bf16(sp[2 * 33], sp[3 * 33]); o.z = pg8::cvt_pk_bf16(sp[4 * 33], sp[5 * 33]); o.w = pg8::cvt_pk_bf16(sp[6 * 33], sp[7 * 33]);
        *(u32x4*)(dst + (size_t)(drow0 + (perm ? perm5(n) : n)) * K + k0 + 8 * c) = o; }
    asm volatile("s_waitcnt lgkmcnt(0)" ::: "memory");
}
constexpr int WI_0 = (N1P / 32) * (D / 64), WI_1 = WI_0 + (2 * D / 32) * (D / 64), WI_2 = WI_1 + (D / 32) * (MW / 64), WI_3 = WI_2 + (D / 32) * (RW / 64),
              WI_4 = WI_3 + (D / 32) * (D / 64), WI_5 = WI_4 + 2 * (FF / 32) * (D / 64), WI_6 = WI_5 + (D / 32) * (FF / 64), WI_7 = WI_6 + (RW / 32) * (128 / 64), WI_8 = WI_7 + 4 * (RW / 32);
__device__ __forceinline__ void wconv_phase(LAS unsigned char* lds, CParams& P, int l, int vb, int G) {
    const int tid = threadIdx.x, w = tid >> 6, lane = tid & 63;
    LAS float* scr = (LAS float*)(lds + w * 8704);
    for (int it = vb * 8 + w; it < WI_8; it += G * 8) {
        if (it < WI_0) { const int nb = it / (D / 64), kb = it % (D / 64); const int n0 = nb * 32; const int nv = n0 >= N1 ? 0 : (N1 - n0 < 32 ? N1 - n0 : 32);
            transpose_item(P.in[W_IN] + ((size_t)l * D + kb * 64) * PIN + n0, PIN, nv, WSP(bf16, O_WIN1), D, kb * 64, n0, true, scr, lane); }
        else if (it < WI_1) { const int r = it - WI_0, nb = r / (D / 64), kb = r % (D / 64);
            transpose_item(P.in[W_IN] + ((size_t)l * D + kb * 64) * PIN + N1 + nb * 32, PIN, 32, WSP(bf16, O_WIN2), D, kb * 64, nb * 32, true, scr, lane); }
        else if (it < WI_2) { const int r = it - WI_1, nb = r / (MW / 64), kb = r % (MW / 64);
            transpose_item(P.in[PROJ_M] + ((size_t)l * MW + kb * 64) * D + nb * 32, D, 32, WSP(bf16, O_PM), MW, kb * 64, nb * 32, true, scr, lane); }
        else if (it < WI_3) { const int r = it - WI_2, nb = r / (RW / 64), kb = r % (RW / 64);
            transpose_item(P.in[PROJ_R] + ((size_t)l * RW + kb * 64) * D + nb * 32, D, 32, WSP(bf16, O_PR), RW, kb * 64, nb * 32, true, scr, lane); }
        else if (it < WI_4) { const int r = it - WI_3, nb = r / (D / 64), kb = r % (D / 64);
            transpose_item(P.in[W_OUT] + ((size_t)l * D + kb * 64) * D + nb * 32, D, 32, WSP(bf16, O_WO), D, kb * 64, nb * 32, false, scr, lane); }
        else if (it < WI_5) { const int r = it - WI_4, which = r / ((FF / 32) * (D / 64)), r2 = r % ((FF / 32) * (D / 64)), nb = r2 / (D / 64), kb = r2 % (D / 64);
            const int j0 = nb * 32, pn = j0 >> 7, drow0 = pn * 256 + which * 128 + (j0 & 127);
            transpose_item((which ? P.in[FFN_W3] : P.in[FFN_W1]) + ((size_t)l * D + kb * 64) * FF + j0, FF, 32, WSP(bf16, O_W13), D, kb * 64, drow0, true, scr, lane); }
        else if (it < WI_6) { const int r = it - WI_5, nb = r / (FF / 64), kb = r % (FF / 64);
            transpose_item(P.in[FFN_W2] + ((size_t)l * FF + kb * 64) * D + nb * 32, D, 32, WSP(bf16, O_W2), FF, kb * 64, nb * 32, false, scr, lane); }
        else if (it < WI_7) { const int r = it - WI_6, nb = r / 2, kb = r % 2;
            transpose_item(P.in[R_G2] + ((size_t)l * 128 + kb * 64) * RW + nb * 32, RW, 32, WSP(bf16, O_G2T), 128, kb * 64, nb * 32, false, scr, lane); }
        else { const int r = it - WI_7, which = r / (2 * (RW / 32)), d = (r / (RW / 32)) & 1, nb = r % (RW / 32);
            transpose_item((which ? P.in[R_A2] : P.in[R_W2]) + ((size_t)l * 2 + d) * 64 * RW + nb * 32, RW, 32, WSP(bf16, which ? O_A2T : O_W2T) + (size_t)d * RW * 64, 64, 0, nb * 32, false, scr, lane); }
    }
}
__device__ __forceinline__ void norm_phase(CParams& P, int l, int mode, int vb, int G) {
    const int tid = threadIdx.x, w = tid >> 6, lane = tid & 63;
#define NORM_SRC(m_) ((l == 0 && mode < 2) ? ((m_) < NC ? P.in[X_PROMPT] + (size_t)(m_) * D : P.in[X_SAMPLE] + (size_t)((m_) - NC) * D) : P.out + (size_t)(m_) * D)
    f32x4 vn[D / 256];
    { const int m0 = vb * 8 + w; if (m0 < NT) { const float* xs = NORM_SRC(m0);
#pragma unroll
        for (int j = 0; j < D / 256; ++j) vn[j] = *(const f32x4*)(xs + 256 * j + 4 * lane); } }
    for (int m = vb * 8 + w; m < NT; m += G * 8) {
        float* xr = P.out + (size_t)m * D;
        f32x4 v[D / 256]; float ss = 0.f;
#pragma unroll
        for (int j = 0; j < D / 256; ++j) v[j] = vn[j];
        if (m + G * 8 < NT) { const float* xs = NORM_SRC(m + G * 8);
#pragma unroll
            for (int j = 0; j < D / 256; ++j) vn[j] = *(const f32x4*)(xs + 256 * j + 4 * lane); }
#pragma unroll
        for (int j = 0; j < D / 256; ++j) ss += (v[j][0] * v[j][0] + v[j][1] * v[j][1]) + (v[j][2] * v[j][2] + v[j][3] * v[j][3]);
        const float rs = 1.0f / sqrtf(wave_sum(ss) * (1.0f / D) + RMS_EPS);
        if (mode == 3) {
#pragma unroll
            for (int j = 0; j < D / 256; ++j) { const f32x4 g = *(const f32x4*)(P.in[FINAL_G] + 256 * j + 4 * lane); *(f32x4*)(xr + 256 * j + 4 * lane) = v[j] * rs * g; }
        } else {
            const int second = (mode == 2); const int cond = seqinfo(seq_of_token(m)).cond;
            const float* gp = P.in[second ? NORM2 : NORM1] + (size_t)l * D; const float* mod = WSP(float, WS_MOD) + ((size_t)l * NCOND + cond) * 6 * D + (second ? 3 * D : 0);
            bf16* o = WSP(bf16, mode == 1 ? WS_RXC : WS_QKC) + (size_t)m * D;
#pragma unroll
            for (int j = 0; j < D / 256; ++j) { const int c = 256 * j + 4 * lane; const f32x4 g = *(const f32x4*)(gp + c), sh = *(const f32x4*)(mod + c), sc = *(const f32x4*)(mod + D + c);
                const f32x4 y = v[j] * rs * g * (sc + 1.0f) + sh; u32x2 pk; pk.x = pg8::cvt_pk_bf16(y[0], y[1]); pk.y = pg8::cvt_pk_bf16(y[2], y[3]); *(u32x2*)(o + c) = pk; }
        }
    }
#undef NORM_SRC
}
constexpr int CV_NCH = 2 * MW + RIN, CV_NG = CV_NCH / 4, CV_NCHUNK = (CV_NG + 63) / 64, CV_SEG = 16, CV_PAIRS = NC / (2 * CV_SEG);
static_assert(CV_NCHUNK == 12 && NC == NT - NC && GW % CV_SEG == 0 && CT % CV_SEG == 0 && 2 * MW == 1024 && RX_WL == 1536, "conv item layout");
typedef float f32x2 __attribute__((ext_vector_type(2)));
struct CvAct { float alpha, cA, cB, cC, cD; bool any; };
template <int NR> struct CvState { f32x2 wt[NR * 3][2]; f32x2 fw[NR][3][2]; u32x2 p[3][NR]; };
__device__ __forceinline__ void cv_unpk(const u32x2 p, f32x2 (&f)[2]) { f[0].x = pg8::bflo(p.x); f[0].y = pg8::bfhi(p.x); f[1].x = pg8::bflo(p.y); f[1].y = pg8::bfhi(p.y); }
template <int NR> __device__ __forceinline__ u32x2 cv_ld(const bf16* const (&rowp)[NR], const bool (&rok)[NR], int a, int col, int W) {
    const u32x2 zero2 = {0u, 0u};
    return (rok[a] && col >= 0 && col < W) ? *(const u32x2*)(rowp[a] + (size_t)col * PU) : zero2;
}
template <int NR, int S> __device__ __forceinline__ void cv_col(CvState<NR>& st, const bf16* const (&rowp)[NR], const bool (&rok)[NR], int cs, int W, int o, const CvAct& act, bf16* dst) {
#pragma unroll
    for (int a = 0; a < NR; ++a) { cv_unpk(st.p[S][a], st.fw[a][(S + 2) % 3]); const u32x2 zero2 = {0u, 0u}; st.p[S][a] = (o + 4 <= CV_SEG) ? cv_ld<NR>(rowp, rok, a, cs + o + 4, W) : zero2; }
    f32x2 acc[2];
#pragma unroll
    for (int e = 0; e < 2; ++e) acc[e] = st.wt[0][e] * st.fw[0][S][e];
#pragma unroll
    for (int a = 0; a < NR; ++a)
#pragma unroll
        for (int b = 0; b < 3; ++b) if (a + b > 0) {
#pragma unroll
            for (int e = 0; e < 2; ++e) acc[e] = __builtin_elementwise_fma(st.wt[a * 3 + b][e], st.fw[a][(S + b) % 3][e], acc[e]); }
    float v[4] = {acc[0].x, acc[0].y, acc[1].x, acc[1].y};
    if (act.any) {
#pragma unroll
        for (int e = 0; e < 4; ++e) { const float t = __builtin_amdgcn_rcpf(__builtin_amdgcn_exp2f(act.alpha * v[e]) + 1.0f); v[e] = (act.cA * v[e] + act.cB) * t + (act.cC * v[e] + act.cD); }
    }
    u32x2 pk; pk.x = pg8::cvt_pk_bf16(v[0], v[1]); pk.y = pg8::cvt_pk_bf16(v[2], v[3]);
    *(u32x2*)dst = pk;
}
template <int NR> __device__ __forceinline__ void conv_item(const bf16* const (&rowp)[NR], const bool (&rok)[NR], int cs, int W, const float* wsrc, int CH, const CvAct& act, bf16* dst, int dpitch) {
    CvState<NR> st;
#pragma unroll
    for (int a = 0; a < NR * 3; ++a) { const int tap = NR == 3 ? a : 3 + a; const f32x4 w0 = *(const f32x4*)(wsrc + (size_t)tap * CH);
        st.wt[a][0].x = w0[0]; st.wt[a][0].y = w0[1]; st.wt[a][1].x = w0[2]; st.wt[a][1].y = w0[3]; }
#pragma unroll
    for (int a = 0; a < NR; ++a) { cv_unpk(cv_ld<NR>(rowp, rok, a, cs - 1, W), st.fw[a][0]); cv_unpk(cv_ld<NR>(rowp, rok, a, cs, W), st.fw[a][1]); }
#pragma unroll
    for (int s3 = 0; s3 < 3; ++s3)
#pragma unroll
        for (int a = 0; a < NR; ++a) st.p[s3][a] = cv_ld<NR>(rowp, rok, a, cs + 1 + s3, W);
#pragma unroll 1
    for (int o = 0; o < CV_SEG - 1; o += 3) {
        cv_col<NR, 0>(st, rowp, rok, cs, W, o, act, dst + (size_t)o * dpitch);
        cv_col<NR, 1>(st, rowp, rok, cs, W, o + 1, act, dst + (size_t)(o + 1) * dpitch);
        cv_col<NR, 2>(st, rowp, rok, cs, W, o + 2, act, dst + (size_t)(o + 2) * dpitch);
    }
    cv_col<NR, 0>(st, rowp, rok, cs, W, CV_SEG - 1, act, dst + (size_t)(CV_SEG - 1) * dpitch);
}
__device__ __forceinline__ void conv_phase(LAS unsigned char* lds, CParams& P, int l, int vb, int G) {
    const int tid = threadIdx.x, lane = tid & 63;
    const bf16* U = WSP(bf16, WS_U1);
    LAS unsigned* cnt = (LAS unsigned*)lds;
    for (int sp = vb; sp < CV_PAIRS; sp += G) {
        __syncthreads();
        if (tid == 0) *cnt = 0u;
        __syncthreads();
        for (;;) {
            unsigned j = 0; if (lane == 0) j = __hip_atomic_fetch_add(cnt, 1u, __ATOMIC_RELAXED, __HIP_MEMORY_SCOPE_WORKGROUP);
            j = __builtin_amdgcn_readfirstlane(j);
            if (j >= 48u) break;
            const int cls = j / 12, jj = j % 12, lat = (cls & 1) == 0, heavy = cls < 2, ci = jj >> 1, chunk = heavy ? (ci >= 4 ? 6 + ci : ci) : 4 + ci;
            const int seg = (lat ? NC / CV_SEG : 0) + 2 * sp + (jj & 1), g = chunk * 64 + lane;
            if (g >= CV_NG) continue;
            const int ch = 4 * g; const bool isqk = ch < 2 * MW; const int c = isqk ? ch : ch - 2 * MW;
            const int ucol = isqk ? OFF_QK + c : OFF_R + c, CH = isqk ? 2 * MW : RIN;
            const float* wsrc = (isqk ? P.in[M_CONV] : P.in[R_CONV]) + (size_t)l * 9 * CH + c;
            const int kind = isqk ? (c < MW ? 0 : 1) : (c >= RX_GL ? 4 : (c >= RX_AL ? 2 : (c >= RX_WL ? 3 : 2)));
            CvAct act; act.alpha = kind == 3 ? 2.8853900817779268f : -1.4426950408889634f;
            act.cA = kind == 0 ? 0.08838834764831845f : (kind == 1 ? 1.0f : 0.0f); act.cB = kind == 3 ? -2.0f : (kind == 4 ? 1.0f : 0.0f); act.cC = kind == 2 ? 1.0f : 0.0f; act.cD = kind == 3 ? 1.0f : 0.0f;
            act.any = heavy;
            const int m0 = seg * CV_SEG; const SeqInfo q = seqinfo(seq_of_token(m0)); const int t0 = m0 - q.base;
            bf16* dst = isqk ? WSP(bf16, WS_QKC) + (size_t)m0 * (2 * MW) + c : WSP(bf16, WS_RXC) + (size_t)m0 * RIN + c; const int dpitch = isqk ? 2 * MW : RIN;
            if (q.grid) {
                const int r = t0 / GW, cs = t0 % GW, rows = q.T / GW;
                const bf16* rowp[3]; bool rok[3];
#pragma unroll
                for (int a = 0; a < 3; ++a) { const int rr = r + a - 1; rok[a] = rr >= 0 && rr < rows; rowp[a] = U + (size_t)(q.base + (rok[a] ? rr : r) * GW) * PU + ucol; }
                conv_item<3>(rowp, rok, cs, GW, wsrc, CH, act, dst, dpitch);
            } else {
                const bf16* rowp[1] = {U + (size_t)q.base * PU + ucol}; const bool rok[1] = {true};
                conv_item<1>(rowp, rok, t0, q.T, wsrc, CH, act, dst, dpitch);
            }
        }
    }
}
constexpr int PO_ITEMS = (NT / 16) * 2, PO_HC = RW / 2;
__device__ __forceinline__ void post_phase(LAS unsigned char* lds, CParams& P, int l, int vb, int G) {
    const int tid = threadIdx.x, w = tid >> 6, lane = tid & 63, fr = lane & 15, fq = lane >> 4, l32 = lane & 31, th = lane >> 5;
    constexpr int GP = PO_HC * 2 + 16;
    LAS unsigned char* gt = lds + w * (16 * GP);
    const bf16* U = WSP(bf16, WS_U1); const bf16* RX = WSP(bf16, WS_RXC); const bf16* G2T = WSP(bf16, O_G2T); bf16* O = WSP(bf16, WS_QKC);
    for (int it = vb * 8 + w; it < PO_ITEMS; it += G * 8) {
        const int tile = it >> 1, h = it & 1; const size_t tok0 = (size_t)tile * 16;
        bf16x8 af[4];
#pragma unroll
        for (int ks = 0; ks < 4; ++ks) af[ks] = *(const bf16x8*)(RX + (tok0 + fr) * RIN + RX_GL + 32 * ks + 8 * fq);
        for (int ct = 0; ct < PO_HC / 16; ++ct) { f32x4 acc = (f32x4){0.f, 0.f, 0.f, 0.f};
#pragma unroll
            for (int ks = 0; ks < 4; ++ks) acc = ml::mma(af[ks], *(const bf16x8*)(G2T + (size_t)(h * PO_HC + 16 * ct + fr) * 128 + 32 * ks + 8 * fq), acc);
#pragma unroll
            for (int r = 0; r < 4; ++r) *(LAS bf16*)(gt + (4 * fq + r) * GP + (16 * ct + fr) * 2) = f2bf(acc[r]); }
        asm volatile("s_waitcnt lgkmcnt(0)" ::: "memory");
        const int cb = h * PO_HC + 8 * l32;
        float gn[8], gw[8], gb[8], rk[8];
        { const f32x4 a0 = *(const f32x4*)(P.in[M_NORM_G] + (size_t)l * MW + cb), a1 = *(const f32x4*)(P.in[M_NORM_G] + (size_t)l * MW + cb + 4);
          const f32x4 b0 = *(const f32x4*)(P.in[R_GN_W] + (size_t)l * RW + cb), b1 = *(const f32x4*)(P.in[R_GN_W] + (size_t)l * RW + cb + 4);
          const f32x4 c0 = *(const f32x4*)(P.in[R_GN_B] + (size_t)l * RW + cb), c1 = *(const f32x4*)(P.in[R_GN_B] + (size_t)l * RW + cb + 4);
          const f32x4 d0 = *(const f32x4*)(P.in[R_RK] + (size_t)l * RW + cb), d1 = *(const f32x4*)(P.in[R_RK] + (size_t)l * RW + cb + 4);
#pragma unroll
          for (int e = 0; e < 4; ++e) { gn[e] = a0[e]; gn[4 + e] = a1[e]; gw[e] = b0[e]; gw[4 + e] = b1[e]; gb[e] = c0[e]; gb[4 + e] = c1[e]; rk[e] = d0[e]; rk[4 + e] = d1[e]; } }
        for (int tp = 0; tp < 8; ++tp) { const int tl = 2 * tp + th; const size_t m = tok0 + tl; const bf16* u = U + m * PU; const bf16* rx = RX + m * RIN;
            float hf[8], hb[8], ov[8], x[8]; unpack8(*(const u32x4*)(u + cb), hf); unpack8(*(const u32x4*)(u + MW + cb), hb); unpack8(*(const u32x4*)(u + OFF_O + cb), ov);
            float ss = 0.f;
#pragma unroll
            for (int e = 0; e < 8; ++e) { x[e] = hf[e] + hb[e]; ss += x[e] * x[e]; }
            ss = rw::allsum16(ss); const float rs = 1.0f / sqrtf(ss * (1.0f / 128.f) + RMS_EPS);
#pragma unroll
            for (int e = 0; e < 8; ++e) x[e] = x[e] * rs * gn[e] * pg8::fsigmoid(ov[e]);
            *(u32x4*)(O + m * D + cb) = pack8(x);
            float yf[8], yb[8], rr[8], kk[8], vv[8], gg[8], y[8]; unpack8(*(const u32x4*)(u + OFF_R + cb), yf); unpack8(*(const u32x4*)(u + OFF_R + RW + cb), yb);
            unpack8(*(const u32x4*)(rx + RX_R + cb), rr); unpack8(*(const u32x4*)(rx + RX_K + cb), kk); unpack8(*(const u32x4*)(rx + RX_V + cb), vv);
            unpack8(*(const LAS u32x4*)(gt + tl * GP + l32 * 16), gg);
            float mu = 0.f, bs = 0.f;
#pragma unroll
            for (int e = 0; e < 8; ++e) { y[e] = yf[e] + yb[e]; mu += y[e]; bs += rr[e] * kk[e] * rk[e]; }
            mu += rw::dpp_xor1(mu); mu += rw::dpp_xor2(mu); mu += __shfl_xor(mu, 4); mu *= (1.0f / 64.f);
            bs += rw::dpp_xor1(bs); bs += rw::dpp_xor2(bs); bs += __shfl_xor(bs, 4);
            float var = 0.f;
#pragma unroll
            for (int e = 0; e < 8; ++e) { y[e] -= mu; var += y[e] * y[e]; }
            var += rw::dpp_xor1(var); var += rw::dpp_xor2(var); var += __shfl_xor(var, 4); var *= (1.0f / 64.f);
            const float rsd = 1.0f / sqrtf(var + GN_EPS);
#pragma unroll
            for (int e = 0; e < 8; ++e) y[e] = (y[e] * rsd * gw[e] + gb[e] + bs * vv[e]) * gg[e];
            *(u32x4*)(O + m * D + MW + cb) = pack8(y);
        }
        asm volatile("s_waitcnt lgkmcnt(0)" ::: "memory");
    }
}
}

constexpr int LDS_BYTES = 147456;
constexpr int LDS_MISC = 147456 - 1024;
constexpr size_t CTL_ZERO_BYTES = 262144;
constexpr int CW_BAR = 4096, CW_Q = 8192;

#define XB_TMO      128
#define XB_XCNT(j)  (256  + 64 * (j))
#define XB_XSUB(j)  (1280 + 64 * (j))
#define XB_XGEN(j)  (2304 + 64 * (j))
#define XB_TOP      3328
#define XB_TOPGEN   3392
#define XCD_BAR_WORDS 3456
#define XB_SPIN_CAP (1u << 18)
__device__ __forceinline__ unsigned xb_ld(unsigned* p)              { return __hip_atomic_load(p, __ATOMIC_RELAXED, __HIP_MEMORY_SCOPE_AGENT); }
__device__ __forceinline__ unsigned xb_add(unsigned* p, unsigned v) { return __hip_atomic_fetch_add(p, v, __ATOMIC_RELAXED, __HIP_MEMORY_SCOPE_AGENT); }
__device__ __forceinline__ unsigned xb_xcc_id() { return (unsigned)__builtin_amdgcn_s_getreg((3 << 11) | 20) & 0xFu; }
#define XB_SPIN(cond, bar) do { unsigned _sp = 0; while (cond) { __builtin_amdgcn_s_sleep(1); \
    if ((++_sp & 255u) == 0u) { if (xb_ld(&(bar)[XB_TMO])) break; if (_sp > XB_SPIN_CAP) { atomicAdd(&(bar)[XB_TMO], 1u); break; } } } } while (0)
struct XcdBarrier { unsigned* bar; unsigned x; volatile LAS unsigned* st; };
__device__ __forceinline__ XcdBarrier xcd_barrier_post(unsigned* bar, volatile LAS unsigned* st) {
    XcdBarrier b; b.bar = bar; b.x = xb_xcc_id(); b.st = st;
    if (threadIdx.x == 0) (void)xb_add(&bar[XB_XCNT(b.x)], 1u);
    return b;
}
__device__ __forceinline__ void xcd_barrier_complete(unsigned* bar, unsigned x, unsigned& nloc, unsigned& nx) {
    const unsigned G = gridDim.x * gridDim.y * gridDim.z;
    unsigned sum, cnt, mine, sp = 0u;
    for (;;) {
        sum = 0u; cnt = 0u; mine = 0u;
#pragma unroll
        for (unsigned j = 0; j < 16; ++j) { const unsigned c = xb_ld(&bar[XB_XCNT(j)]); sum += c; cnt += (c > 0u) ? 1u : 0u; mine = (j == x) ? c : mine; }
        if (sum == G) break;
        __builtin_amdgcn_s_sleep(1);
        if ((++sp & 255u) == 0u) { if (xb_ld(&bar[XB_TMO])) break; if (sp > XB_SPIN_CAP) { atomicAdd(&bar[XB_TMO], 1u); break; } }
    }
    nloc = mine > 0u ? mine : 1u; nx = cnt > 0u ? cnt : 1u;
}
__device__ __forceinline__ void xcd_barrier(const XcdBarrier& b) {
    asm volatile("s_waitcnt vmcnt(0)" ::: "memory");
    __syncthreads();
    if (threadIdx.x == 0) {
        unsigned* bar = b.bar;
        __builtin_amdgcn_s_waitcnt(0);
        unsigned nloc = b.st[0], nx = b.st[1];
        if (nloc == 0u) { xcd_barrier_complete(bar, b.x, nloc, nx); b.st[0] = nloc; b.st[1] = nx; }
        const unsigned old = xb_add(&bar[XB_XSUB(b.x)], 1u);
        const unsigned gen = old / nloc;
        if (old + 1u == (gen + 1u) * nloc) {
            __builtin_amdgcn_fence(__ATOMIC_RELEASE, "agent");
            asm volatile("s_waitcnt vmcnt(0)" ::: "memory");
            const unsigned og = xb_add(&bar[XB_TOP], 1u);
            const unsigned tg = og / nx;
            if (og + 1u == (tg + 1u) * nx) xb_add(&bar[XB_TOPGEN], 1u);
            else XB_SPIN(xb_ld(&bar[XB_TOPGEN]) == tg, bar);
            __builtin_amdgcn_fence(__ATOMIC_ACQUIRE, "agent");
            xb_add(&bar[XB_XGEN(b.x)], 1u);
            asm volatile("s_waitcnt vmcnt(0)" ::: "memory");
        } else {
            XB_SPIN(xb_ld(&bar[XB_XGEN(b.x)]) == gen, bar);
            __builtin_amdgcn_fence(__ATOMIC_ACQUIRE, "agent");
            asm volatile("s_waitcnt vmcnt(0)" ::: "memory");
        }
    }
    __syncthreads();
}

constexpr int MX_RL = LB * RH * 2 * 4, MX_ML = LB * MH * 2 * ml::NVB, MX_RC = CB * RH * 2 * 4, MX_MC = CB * MH * 2 * ml::NVB;
constexpr int MX_ITEMS = MX_RL + MX_ML + MX_RC + MX_MC;

constexpr int ML_SPLIT = 0;
__device__ __forceinline__ void scan_phase(LAS unsigned char* lds, CParams& P, int l, unsigned* ctl) {
    unsigned* qhead = ctl + CW_Q + 64 * l;
    const bool split = gridDim.x >= 4 * wy::N_LAT * (1 + wy::NPROD) / 2;
    volatile LAS unsigned* bc = (volatile LAS unsigned*)(lds + LDS_MISC) + 16;
    for (;;) {
        if (threadIdx.x == 0) bc[0] = xb_add(qhead, 1u);
        __syncthreads();
        const int it = (int)bc[0];
        __syncthreads();
        if (!split || it >= wy::N_LAT) break;
        int s_, head, dir; wy::decode_item(it, s_, head, dir);
        wy::rwkv_cons(lds, P, l, s_, head, dir, it, ctl);
    }
    for (;;) {
        if (threadIdx.x == 0) bc[0] = xb_add(qhead + 8, 1u);
        __syncthreads();
        const int it = (int)bc[0];
        __syncthreads();
        if (it >= ML_SPLIT * ms::N_MLAT) break;
        int s_, head, dir, sub; ml::decode_item(it * ml::NVB, s_, head, dir, sub);
        ms::ml_cons(lds, P, l, s_, head, dir, it, ctl);
    }
    for (;;) {
        if (threadIdx.x == 0) bc[0] = xb_add(qhead + 48, 1u);
        __syncthreads();
        const int it = (int)bc[0];
        __syncthreads();
        if (!split || it >= wy::N_LAT * wy::NPROD) break;
        const int chain = it % wy::N_LAT;
        int s_, head, dir; wy::decode_item(chain, s_, head, dir);
        wy::rwkv_prod(lds, P, l, s_, head, dir, chain, it / wy::N_LAT, ctl);
    }
    for (;;) {
        if (threadIdx.x == 0) bc[0] = xb_add(qhead + 24, 1u);
        __syncthreads();
        const int it = (int)bc[0];
        __syncthreads();
        if (it >= ML_SPLIT * ms::N_MLAT * ms::MLPROD) break;
        const int chain = it % ms::N_MLAT;
        int s_, head, dir, sub; ml::decode_item(chain * ml::NVB, s_, head, dir, sub);
        ms::ml_prod(lds, P, l, s_, head, dir, chain, it / ms::N_MLAT, ctl);
    }
    for (;;) {
        if (threadIdx.x == 0) bc[0] = xb_add(qhead + 16, 1u);
        __syncthreads();
        const int it = (int)bc[0] + ML_SPLIT * ms::N_MLAT * ml::NVB;
        __syncthreads();
        if (it >= ml::N_ITEMS) break;
        int s_, head, dir, sub; ml::decode_item(it, s_, head, dir, sub);
        ml::mlstm_item2(lds, P, l, s_, head, dir, sub);
    }
    for (;;) {
        if (threadIdx.x == 0) bc[0] = xb_add(qhead + 32, 1u);
        __syncthreads();
        const int it = (int)bc[0] + (split ? LB * RH * 2 : 0);
        __syncthreads();
        if (it >= wy::N_ITEMS) break;
        int s_, head, dir; wy::decode_item(it, s_, head, dir);
        wy::rwkv_item(lds, P, l, s_, head, dir);
    }
}

enum { ST_N0 = 0, ST_A1, ST_CV, ST_MX, ST_PO, ST_N1, ST_A2, ST_PJ, ST_WO, ST_N2, ST_F1, ST_F2, ST_PER_LAYER };
constexpr int N_STEPS = 1 + DEPTH * ST_PER_LAYER + 1;
struct MkArgs { Params P; int ph_lo, ph_hi; };
__global__ void __launch_bounds__(512, 2) mk(MkArgs a) {
    extern __shared__ __attribute__((aligned(16))) unsigned char lds_raw[];
    LAS unsigned char* lds = (LAS unsigned char*)lds_raw;
    const int G = gridDim.x, vb = (int)blockIdx.x;
    unsigned* ctl = (unsigned*)(a.P.ws + WS_CTL);
    volatile LAS unsigned* MISC = (volatile LAS unsigned*)(lds + LDS_MISC);
    for (int u = threadIdx.x; u < 64; u += 512) MISC[u] = 0u;
    __syncthreads();
    const bool multi = a.ph_hi - a.ph_lo > 1;
    XcdBarrier bar; bar.bar = ctl + CW_BAR; bar.x = 0; bar.st = nullptr;
    if (multi) bar = xcd_barrier_post(ctl + CW_BAR, MISC + 8);
    const int lo = a.ph_lo, hi = a.ph_hi;
    const int fuse = (multi && lo == 0 && hi == N_STEPS && G == (NT / pg8::BM) * (D / pg8::BM)) ? 1 : 0;
#define STEP_BEGIN(id) if (lo <= (id) && (id) < hi) { unsigned long long kp_ = (unsigned long long)__builtin_amdgcn_kernarg_segment_ptr(); asm volatile("" : "+s"(kp_)); CParams& P = *(CParams*)kp_;
#define STEP_END(id) if ((id) + 1 < hi) xcd_barrier(bar); }
    STEP_BEGIN(0) el::init_phase(lds, P, vb, G); el::wconv_phase(lds, P, 0, vb, G); STEP_END(0)
#define LAYER(l) { \
        const int base = 1 + (l) * ST_PER_LAYER; \
        STEP_BEGIN(base + ST_N0) if ((l) > 0) el::wconv_phase(lds, P, (l), vb, G); if ((l) == 0 || !fuse) el::norm_phase(P, (l), 0, vb, G); STEP_END(base + ST_N0) \
        STEP_BEGIN(base + ST_A1) { pg8::Gemm g{WSP(bf16, WS_QKC), WSP(bf16, O_WIN1), D, D}; pg8::StaticOrder S; S.init(NT, N1P, G, vb); \
            pg8::EpiA1 E{WSP(bf16, WS_U1)}; pg8::gemm_phase(lds, g, S, E); } STEP_END(base + ST_A1) \
        STEP_BEGIN(base + ST_CV) el::conv_phase(lds, P, (l), vb, G); STEP_END(base + ST_CV) \
        STEP_BEGIN(base + ST_MX) scan_phase(lds, P, (l), ctl); STEP_END(base + ST_MX) \
        STEP_BEGIN(base + ST_PO) el::post_phase(lds, P, (l), vb, G); STEP_END(base + ST_PO) \
        STEP_BEGIN(base + ST_N1) el::norm_phase(P, (l), 1, vb, G); STEP_END(base + ST_N1) \
        STEP_BEGIN(base + ST_A2) { pg8::Gemm g{WSP(bf16, WS_RXC), WSP(bf16, O_WIN2), D, D}; pg8::StaticOrder S; S.init(NT, 2 * D, G, vb); \
            pg8::EpiA2 E{WSP(bf16, WS_U1)}; pg8::gemm_phase(lds, g, S, E); } STEP_END(base + ST_A2) \
        STEP_BEGIN(base + ST_PJ) { pg8::Gemm g{WSP(bf16, WS_QKC), WSP(bf16, O_PM), MW, D}; pg8::PairOrder S; S.init(NT, G, vb); \
            pg8::EpiPJ E{WSP(bf16, WS_U1)}; pg8::gemm_phase(lds, g, S, E); } STEP_END(base + ST_PJ) \
        STEP_BEGIN(base + ST_WO) { pg8::Gemm g{WSP(bf16, WS_U1), WSP(bf16, O_WO), D, PU}; pg8::StaticOrder S; S.init(NT, D, G, vb); \
            pg8::EpiResNorm E{P.out, WSP(float, WS_MOD) + (size_t)(l) * NCOND * 6 * D + 2 * D, (l) == 0 ? P.in[X_PROMPT] : nullptr, (l) == 0 ? P.in[X_SAMPLE] : nullptr, \
                fuse, P.in[NORM2] + (size_t)(l) * D, WSP(float, WS_MOD) + (size_t)(l) * NCOND * 6 * D + 3 * D, WSP(bf16, WS_QKC), P.ws, 1u + 2u * (l), lds}; pg8::gemm_phase(lds, g, S, E); } STEP_END(base + ST_WO) \
        if (!fuse) { STEP_BEGIN(base + ST_N2) el::norm_phase(P, (l), 2, vb, G); STEP_END(base + ST_N2) } \
        STEP_BEGIN(base + ST_F1) { pg8::Gemm g{WSP(bf16, WS_QKC), WSP(bf16, O_W13), D, D}; pg8::StaticOrder S; S.init(NT, 2 * FF, G, vb); \
            pg8::EpiF1 E{WSP(bf16, WS_U1)}; pg8::gemm_phase(lds, g, S, E); } STEP_END(base + ST_F1) \
        STEP_BEGIN(base + ST_F2) { pg8::Gemm g{WSP(bf16, WS_U1), WSP(bf16, O_W2), FF, FF}; pg8::StaticOrder S; S.init(NT, D, G, vb); \
            pg8::EpiResNorm E{P.out, WSP(float, WS_MOD) + (size_t)(l) * NCOND * 6 * D + 5 * D, nullptr, nullptr, fuse, \
                (l) + 1 < DEPTH ? P.in[NORM1] + (size_t)((l) + 1) * D : P.in[FINAL_G], (l) + 1 < DEPTH ? WSP(float, WS_MOD) + (size_t)((l) + 1) * NCOND * 6 * D : nullptr, \
                (l) + 1 < DEPTH ? WSP(bf16, WS_QKC) : nullptr, P.ws, 2u + 2u * (l), lds}; pg8::gemm_phase(lds, g, S, E); } \
            if ((l) + 1 < DEPTH || !fuse) { if (base + ST_F2 + 1 < hi) xcd_barrier(bar); } } \
    }
    static_assert(DEPTH == 2, "layers are unrolled by hand");
    LAYER(0)
    LAYER(1)
#undef LAYER
    if (!fuse) { STEP_BEGIN(N_STEPS - 1) el::norm_phase(P, 0, 3, vb, G); STEP_END(N_STEPS - 1) }
#undef STEP_BEGIN
#undef STEP_END
}
#endif

typedef void (*BodyFn)(const Params&, long);
#ifndef HOST_EMU
template <BodyFn F, int BLOCK> __global__ void __launch_bounds__(BLOCK) run_k(Params P, long n) {
    const long i = (long)blockIdx.x * BLOCK + threadIdx.x;
    if (i < n) F(P, i);
}
#define RUN(F, BLOCK, n) do { const long n_ = (n); run_k<F, BLOCK><<<dim3((unsigned)((n_ + BLOCK - 1) / BLOCK)), dim3(BLOCK), 0, stream>>>(P, n_); } while (0)
static int g_grid = 0;
#else
#define RUN(F, BLOCK, n) do { const long n_ = (n); for (long i_ = 0; i_ < n_; ++i_) F(P, i_); } while (0)
typedef void* hipStream_t;
#endif

static void forward(Params P, hipStream_t stream) {
    (void)stream;
#ifndef HOST_EMU
    if (hipMemsetAsync(P.ws + WS_CTL, 0, CTL_ZERO_BYTES, stream) != hipSuccess) return;
#ifdef MK_PER_STEP
    for (int st = 0; st < N_STEPS; ++st) { MkArgs a_{}; a_.P = P; a_.ph_lo = st; a_.ph_hi = st + 1; mk<<<dim3(g_grid), dim3(512), LDS_BYTES, stream>>>(a_); }
#else
    { MkArgs a_{}; a_.P = P; a_.ph_lo = 0; a_.ph_hi = N_STEPS; mk<<<dim3(g_grid), dim3(512), LDS_BYTES, stream>>>(a_); }
#endif
#else
    RUN(k_init_x, 256, (long)NT * D);
    RUN(k_mod, 256, (long)DEPTH * NCOND * 6 * D);
    for (int l = 0; l < DEPTH; ++l) {
        P.layer = l;
        RUN(k_wconv, 256, WC_N6);
        P.mode = 0; RUN(k_norm, 64, (long)NT);
        RUN(k_gemm_a1, 256, (long)NT * N1);
        RUN(k_conv, 256, (long)NT * (2 * MW + RIN));
        RUN(k_mlstm, 128, (long)NSEQ * MH * 2 * 128);
        for (int dir = 0; dir < 2; ++dir) { P.mode = dir; RUN(k_rwkv_prep, 256, (long)NT * RW); RUN(k_rwkv, 64, (long)NSEQ * RH * 64); }
        RUN(k_post, 256, (long)NT * D);
        P.mode = 1; RUN(k_norm, 64, (long)NT);
        RUN(k_gemm_a2, 256, (long)NT * 2 * D);
        RUN(k_gemm_pj, 256, (long)NT * D);
        RUN(k_gemm_wo, 256, (long)NT * D);
        P.mode = 2; RUN(k_norm, 64, (long)NT);
        RUN(k_gemm_f1, 256, (long)NT * FF);
        RUN(k_gemm_f2, 256, (long)NT * D);
    }
    RUN(k_final, 64, (long)NT);
#endif
}

#ifndef HOST_EMU
extern "C" void kernel_launch(void* const* d_in, const int* in_sizes, int n_in, void* d_out, int out_size, void* d_ws, size_t ws_size, hipStream_t stream) {
    if (n_in != N_IN || (size_t)out_size != OUT_END || ws_size < WS_END) return;
    if (g_grid == 0) {
        int dev = 0, cus = 0;
        if (hipGetDevice(&dev) != hipSuccess || hipDeviceGetAttribute(&cus, hipDeviceAttributeMultiprocessorCount, dev) != hipSuccess) { g_grid = -1; return; }
        if (hipFuncSetAttribute((const void*)mk, hipFuncAttributeMaxDynamicSharedMemorySize, LDS_BYTES) != hipSuccess) { g_grid = -1; return; }
        g_grid = cus;
    }
    if (g_grid < 0) return;
    Params P{};
    for (int i = 0; i < N_IN; ++i) P.in[i] = (const float*)d_in[i];
    P.out = (float*)d_out; P.ws = (unsigned char*)d_ws; P.layer = 0; P.mode = 0;
    forward(P, stream);
}
#endif
```
